# Optimizing an MI355X kernel written in HIP

```python
import jax, jax.numpy as jnp
from jax import lax
import numpy as np

D_MODEL = 1024
BATCH = 4
SEQ = 4096
DEPTH = 1

MEM_LEN = 256
RMS_EPS = 1e-6
F_GROUPS = 8
F_GROUP_DIM = 64
F_WIDTH = F_GROUPS * F_GROUP_DIM
MLA_HEADS = 8
QK_NOPE_DIM = 64
QK_ROPE_DIM = 32
V_HEAD_DIM = 64
Q_LORA_RANK = 384
KV_LORA_RANK = 256
ROPE_THETA = 10000.0
Q_BLOCK = 128
MLA_OUT = MLA_HEADS * V_HEAD_DIM
MIX_WIDTH = F_WIDTH + MLA_OUT
IN_WIDTH = F_WIDTH + Q_LORA_RANK + KV_LORA_RANK + QK_ROPE_DIM
IN_SPLITS = (F_WIDTH, F_WIDTH + Q_LORA_RANK, F_WIDTH + Q_LORA_RANK + KV_LORA_RANK)
MEM_HEADS = 4
MEM_HEAD_DIM = D_MODEL // MEM_HEADS
N_EXPERTS = 16
CAPACITY_FACTOR = 2
D_EXPERT = D_MODEL

kernel_name = "hybrid_fourier_mla_ec_moe_encoder"


def rms_norm(x, g):
    xf = x.astype(jnp.float32)
    y = xf * lax.rsqrt(jnp.mean(xf * xf, axis=-1, keepdims=True) + RMS_EPS)
    return (y * g.astype(jnp.float32)).astype(x.dtype)


def rope_tables(positions):
    freqs = 1.0 / (ROPE_THETA ** (jnp.arange(0, QK_ROPE_DIM, 2, dtype=jnp.float32) / QK_ROPE_DIM))
    ang = positions.astype(jnp.float32)[..., None] * freqs
    return jnp.cos(ang), jnp.sin(ang)


def apply_rope(x, cos, sin):
    xf = x.astype(jnp.float32)
    x1, x2 = jnp.split(xf, 2, axis=-1)
    out = jnp.concatenate([x1 * cos - x2 * sin, x1 * sin + x2 * cos], axis=-1)
    return out.astype(x.dtype)


def fourier_mix(u_f, w_fourier):
    B, S, _ = u_f.shape
    ug = u_f.reshape(B, S, F_GROUPS, F_GROUP_DIM).astype(jnp.float32)
    z = jnp.fft.fft2(ug, axes=(1, 3), norm="ortho").real.astype(u_f.dtype)
    y = jnp.einsum("bsgc,gce->bsge", z, w_fourier)
    return y.reshape(B, S, F_WIDTH)


def mla_attention(u_q, u_kv, u_kr, cos, sin, g_q_lat, w_q_up, g_kv_lat, w_kv_up):
    B, S, _ = u_q.shape
    q = (rms_norm(u_q, g_q_lat) @ w_q_up).reshape(B, S, MLA_HEADS, QK_NOPE_DIM + QK_ROPE_DIM)
    q_nope, q_rope = q[..., :QK_NOPE_DIM], q[..., QK_NOPE_DIM:]
    q_rope = apply_rope(q_rope, cos[:, :, None, :], sin[:, :, None, :])
    kv = (rms_norm(u_kv, g_kv_lat) @ w_kv_up).reshape(B, S, MLA_HEADS, QK_NOPE_DIM + V_HEAD_DIM)
    k_nope, v = kv[..., :QK_NOPE_DIM], kv[..., QK_NOPE_DIM:]
    k_rope = apply_rope(u_kr, cos, sin)
    scale = (QK_NOPE_DIM + QK_ROPE_DIM) ** -0.5
    nb = S // Q_BLOCK
    qn = q_nope.reshape(B, nb, Q_BLOCK, MLA_HEADS, QK_NOPE_DIM).swapaxes(0, 1)
    qr = q_rope.reshape(B, nb, Q_BLOCK, MLA_HEADS, QK_ROPE_DIM).swapaxes(0, 1)

    def block(args):
        qn_b, qr_b = args
        s = (jnp.einsum("bqhd,bkhd->bhqk", qn_b, k_nope)
             + jnp.einsum("bqhd,bkd->bhqk", qr_b, k_rope))
        p = jax.nn.softmax(s.astype(jnp.float32) * scale, axis=-1).astype(v.dtype)
        return jnp.einsum("bhqk,bkhd->bqhd", p, v)

    o = lax.map(block, (qn, qr))
    return o.swapaxes(0, 1).reshape(B, S, MLA_OUT)


def memory_cross_attention(hq, mn, w_mem_q, w_mem_kv, w_mem_o):
    B, S, D = hq.shape
    M = mn.shape[1]
    q = (hq @ w_mem_q).reshape(B, S, MEM_HEADS, MEM_HEAD_DIM)
    k, v = jnp.split(mn @ w_mem_kv, 2, axis=-1)
    k = k.reshape(B, M, MEM_HEADS, MEM_HEAD_DIM)
    v = v.reshape(B, M, MEM_HEADS, MEM_HEAD_DIM)
    s = jnp.einsum("bshd,bmhd->bhsm", q, k).astype(jnp.float32) * (MEM_HEAD_DIM ** -0.5)
    p = jax.nn.softmax(s, axis=-1).astype(v.dtype)
    o = jnp.einsum("bhsm,bmhd->bshd", p, v).reshape(B, S, D)
    return o @ w_mem_o


def expert_choice_moe(h, w_router, w_gate, w_up, w_down):
    B, S, D = h.shape
    cap = CAPACITY_FACTOR * S // N_EXPERTS
    aff = jax.nn.softmax((h @ w_router).astype(jnp.float32), axis=-1)
    gates, idx = lax.top_k(aff.swapaxes(1, 2), cap)
    xin = jax.vmap(lambda hb, ib: hb[ib])(h, idx)
    a = jnp.einsum("becd,edf->becf", xin, w_gate)
    b = jnp.einsum("becd,edf->becf", xin, w_up)
    y = jnp.einsum("becf,efd->becd", jax.nn.silu(a) * b, w_down)
    y = y * gates.astype(y.dtype)[..., None]
    out = jax.vmap(lambda ib, yb: jnp.zeros((S, D), yb.dtype).at[ib].add(yb))(
        idx.reshape(B, -1), y.reshape(B, -1, D))
    return out


def setup_inputs(seed: int = 0) -> dict:
    key = jax.random.key(seed)
    ks = jax.random.split(key, 24)
    f32 = jnp.float32

    def nrm(k, shape, fan_in):
        return jax.random.normal(k, shape, f32) * (fan_in ** -0.5)

    def gain(k, shape):
        return 1.0 + 0.02 * jax.random.normal(k, shape, f32)

    L = DEPTH
    x = jax.random.normal(ks[0], (BATCH, SEQ, D_MODEL), f32)
    mem = jax.random.normal(ks[1], (BATCH, MEM_LEN, D_MODEL), f32)
    offs = jax.random.randint(ks[2], (BATCH, 1), 0, 1024, dtype=jnp.int32)
    positions = offs + jnp.arange(SEQ, dtype=jnp.int32)[None, :]
    return {
        "x": x,
        "mem": mem,
        "positions": positions,
        "g_mix": gain(ks[3], (L, D_MODEL)),
        "w_in": nrm(ks[4], (L, D_MODEL, IN_WIDTH), D_MODEL),
        "g_q_lat": gain(ks[5], (L, Q_LORA_RANK)),
        "w_q_up": nrm(ks[6], (L, Q_LORA_RANK, MLA_HEADS * (QK_NOPE_DIM + QK_ROPE_DIM)), Q_LORA_RANK),
        "g_kv_lat": gain(ks[7], (L, KV_LORA_RANK)),
        "w_kv_up": nrm(ks[8], (L, KV_LORA_RANK, MLA_HEADS * (QK_NOPE_DIM + V_HEAD_DIM)), KV_LORA_RANK),
        "w_fourier": nrm(ks[9], (L, F_GROUPS, F_GROUP_DIM, F_GROUP_DIM), F_GROUP_DIM),
        "w_out": nrm(ks[10], (L, MIX_WIDTH, D_MODEL), MIX_WIDTH),
        "g_mem_q": gain(ks[11], (L, D_MODEL)),
        "g_mem_kv": gain(ks[12], (L, D_MODEL)),
        "w_mem_q": nrm(ks[13], (L, D_MODEL, D_MODEL), D_MODEL),
        "w_mem_kv": nrm(ks[14], (L, D_MODEL, 2 * D_MODEL), D_MODEL),
        "w_mem_o": nrm(ks[15], (L, D_MODEL, D_MODEL), D_MODEL),
        "g_ffn": gain(ks[16], (L, D_MODEL)),
        "w_router": nrm(ks[17], (L, D_MODEL, N_EXPERTS), D_MODEL),
        "w_exp_gate": nrm(ks[18], (L, N_EXPERTS, D_MODEL, D_EXPERT), D_MODEL),
        "w_exp_up": nrm(ks[19], (L, N_EXPERTS, D_MODEL, D_EXPERT), D_MODEL),
        "w_exp_down": nrm(ks[20], (L, N_EXPERTS, D_EXPERT, D_MODEL), D_EXPERT),
        "g_final": gain(ks[21], (D_MODEL,)),
    }


def reference(x, mem, positions, g_mix, w_in, g_q_lat, w_q_up, g_kv_lat, w_kv_up, w_fourier,
              w_out, g_mem_q, g_mem_kv, w_mem_q, w_mem_kv, w_mem_o, g_ffn, w_router,
              w_exp_gate, w_exp_up, w_exp_down, g_final):
    cos, sin = rope_tables(positions)
    for l in range(DEPTH):
        h = rms_norm(x, g_mix[l])
        u = h @ w_in[l]
        u_f, u_q, u_kv, u_kr = jnp.split(u, IN_SPLITS, axis=-1)
        y_f = fourier_mix(u_f, w_fourier[l])
        y_a = mla_attention(u_q, u_kv, u_kr, cos, sin, g_q_lat[l], w_q_up[l], g_kv_lat[l], w_kv_up[l])
        x = x + jnp.concatenate([y_f, y_a], axis=-1) @ w_out[l]
        x = x + memory_cross_attention(rms_norm(x, g_mem_q[l]), rms_norm(mem, g_mem_kv[l]),
                                       w_mem_q[l], w_mem_kv[l], w_mem_o[l])
        x = x + expert_choice_moe(rms_norm(x, g_ffn[l]), w_router[l],
                                  w_exp_gate[l], w_exp_up[l], w_exp_down[l])
    return rms_norm(x, g_final)
```

```cpp
#include <hip/hip_runtime.h>
#include <stdint.h>

#define NB 4
#define NS 4096
#define ND 1024
#define NT (NB * NS)
#define INW 1184
#define NE 16
#define CAP 512
#define MEML 256

struct GemmP {
    const float* A; const float* B; float* C; const float* R;
    long lda, ldb, ldc, ldr;
    long sA, sB, sC, sR;
    int M, N, K;
    int ksplit; long koff;
    int amode; const float2* tw;
    float alpha;
};

__global__ __launch_bounds__(256) void k_gemm(GemmP p) {
    __shared__ float As[16][68];
    __shared__ float Bs[16][68];
    const int bz = blockIdx.z, m0 = blockIdx.y * 64, n0 = blockIdx.x * 64;
    const float* A = p.A + (long)bz * p.sA;
    const float* B = p.B + (long)bz * p.sB;
    const int tid = threadIdx.x, tx = tid & 15, ty = tid >> 4;
    float acc[4][4];
#pragma unroll
    for (int i = 0; i < 4; i++)
#pragma unroll
        for (int j = 0; j < 4; j++) acc[i][j] = 0.f;
    for (int k0 = 0; k0 < p.K; k0 += 16) {
#pragma unroll
        for (int i = 0; i < 4; i++) {
            int e = tid + i * 256; int r = e >> 4, kk = e & 15;
            int m = m0 + r, k = k0 + kk;
            float v;
            if (p.amode == 0) v = A[(long)m * p.lda + k];
            else { int ks = k & 4095; int idx = (m * ks) & 4095; float2 t = p.tw[idx]; v = (k < 4096) ? t.x : -t.y; }
            As[kk][r] = v;
        }
#pragma unroll
        for (int i = 0; i < 4; i++) {
            int e = tid + i * 256; int kk = e >> 6, c = e & 63;
            int k = k0 + kk, n = n0 + c;
            float v = 0.f;
            if (n < p.N) v = B[(long)k * p.ldb + n + (k >= p.ksplit ? p.koff : 0)];
            Bs[kk][c] = v;
        }
        __syncthreads();
#pragma unroll
        for (int kk = 0; kk < 16; kk++) {
            float a[4], b[4];
#pragma unroll
            for (int i = 0; i < 4; i++) { a[i] = As[kk][ty * 4 + i]; b[i] = Bs[kk][tx * 4 + i]; }
#pragma unroll
            for (int i = 0; i < 4; i++)
#pragma unroll
                for (int j = 0; j < 4; j++) acc[i][j] += a[i] * b[j];
        }
        __syncthreads();
    }
#pragma unroll
    for (int i = 0; i < 4; i++)
#pragma unroll
        for (int j = 0; j < 4; j++) {
            int m = m0 + ty * 4 + i, n = n0 + tx * 4 + j;
            if (n < p.N) {
                float v = p.alpha * acc[i][j];
                if (p.R) v += p.R[(long)bz * p.sR + (long)m * p.ldr + n];
                p.C[(long)bz * p.sC + (long)m * p.ldc + n] = v;
            }
        }
}

static void gemm(hipStream_t st, const float* A, long lda, const float* B, long ldb, float* C, long ldc,
                 int M, int N, int K, int batch = 1, long sA = 0, long sB = 0, long sC = 0,
                 const float* R = nullptr, long ldr = 0, long sR = 0, float alpha = 1.f,
                 int amode = 0, const float2* tw = nullptr, int ksplit = 1 << 30, long koff = 0) {
    GemmP p{};
    p.A = A; p.B = B; p.C = C; p.R = R; p.lda = lda; p.ldb = ldb; p.ldc = ldc; p.ldr = ldr;
    p.sA = sA; p.sB = sB; p.sC = sC; p.sR = sR; p.M = M; p.N = N; p.K = K;
    p.ksplit = ksplit; p.koff = koff; p.amode = amode; p.tw = tw; p.alpha = alpha;
    dim3 grid((N + 63) / 64, M / 64, batch);
    hipLaunchKernelGGL(k_gemm, grid, dim3(256), 0, st, p);
}

__global__ __launch_bounds__(256) void k_rmsnorm(const float* in, long ldi, const float* g, float* out, long ldo, int n) {
    __shared__ float red[4];
    const long row = blockIdx.x;
    const float* x = in + row * ldi;
    float s = 0.f;
    for (int i = threadIdx.x; i < n; i += 256) { float v = x[i]; s += v * v; }
    for (int o = 32; o > 0; o >>= 1) s += __shfl_xor(s, o);
    if ((threadIdx.x & 63) == 0) red[threadIdx.x >> 6] = s;
    __syncthreads();
    s = red[0] + red[1] + red[2] + red[3];
    const float r = rsqrtf(s / (float)n + 1e-6f);
    for (int i = threadIdx.x; i < n; i += 256) out[row * ldo + i] = x[i] * r * g[i];
}

__global__ void k_tables(float2* tw, float* c64, float* s64, const int* pos, float* rc, float* rs) {
    const int i = blockIdx.x * 256 + threadIdx.x;
    const double PI2 = 6.283185307179586476925286766559;
    if (i < 4096) {
        double a = PI2 * (double)i / 4096.0;
        tw[i] = make_float2((float)cos(a), (float)sin(a));
        int m = ((i >> 6) * (i & 63)) & 63;
        double b = PI2 * (double)m / 64.0;
        c64[i] = (float)cos(b); s64[i] = (float)sin(b);
    }
    if (i < NT * 16) {
        int t = i >> 4, j = i & 15;
        double f = pow(10000.0, -(double)(2 * j) / 32.0);
        double ang = (double)pos[t] * f;
        rc[i] = (float)cos(ang); rs[i] = (float)sin(ang);
    }
}

__global__ void k_rope_q(float* q, const float* rc, const float* rs) {
    const int i = blockIdx.x * 256 + threadIdx.x;
    if (i >= NT * 8 * 16) return;
    const int j = i & 15, h = (i >> 4) & 7, t = i >> 7;
    float* p = q + (long)t * 768 + h * 96 + 64;
    const float c = rc[t * 16 + j], s = rs[t * 16 + j];
    const float x1 = p[j], x2 = p[16 + j];
    p[j] = x1 * c - x2 * s; p[16 + j] = x1 * s + x2 * c;
}
__global__ void k_rope_k(const float* u, float* kr, const float* rc, const float* rs) {
    const int i = blockIdx.x * 256 + threadIdx.x;
    if (i >= NT * 16) return;
    const int j = i & 15, t = i >> 4;
    const float* p = u + (long)t * INW + 1152;
    const float c = rc[i], s = rs[i];
    const float x1 = p[j], x2 = p[16 + j];
    kr[(long)t * 32 + j] = x1 * c - x2 * s; kr[(long)t * 32 + 16 + j] = x1 * s + x2 * c;
}

struct AttnP {
    const float* Q; long ldq, qhs;
    const float* K1; long ldk1, k1hs;
    const float* K2; long ldk2;
    const float* V; long ldv, vhs;
    float* O; long ldo, ohs;
    int nq, nk; float scale;
};

template <int DK1, int DK2, int DV>
__global__ __launch_bounds__(256) void k_attn(AttnP p) {
    __shared__ float Qc[64][33];
    __shared__ float Kc[64][33];
    __shared__ float Ps[64][65];
    __shared__ float Vs[64][65];
    const int tid = threadIdx.x, tx = tid & 15, ty = tid >> 4;
    const int qt = blockIdx.x, h = blockIdx.y, b = blockIdx.z;
    const float* Q = p.Q + ((long)b * p.nq + qt * 64) * p.ldq + h * p.qhs;
    const float* K1 = p.K1 + ((long)b * p.nk) * p.ldk1 + h * p.k1hs;
    const float* K2 = DK2 ? p.K2 + ((long)b * p.nk) * p.ldk2 : nullptr;
    const float* V = p.V + ((long)b * p.nk) * p.ldv + h * p.vhs;
    float* O = p.O + ((long)b * p.nq + qt * 64) * p.ldo + h * p.ohs;
    constexpr int NVC = DV / 64;
    constexpr int NQC = (DK1 + DK2) / 32;
    float o[NVC][4][4];
#pragma unroll
    for (int c = 0; c < NVC; c++)
#pragma unroll
        for (int i = 0; i < 4; i++)
#pragma unroll
            for (int j = 0; j < 4; j++) o[c][i][j] = 0.f;
    float mrow[4], lrow[4];
#pragma unroll
    for (int i = 0; i < 4; i++) { mrow[i] = -1e30f; lrow[i] = 0.f; }

    for (int kt = 0; kt < p.nk; kt += 64) {
        float s[4][4];
#pragma unroll
        for (int i = 0; i < 4; i++)
#pragma unroll
            for (int j = 0; j < 4; j++) s[i][j] = 0.f;
#pragma unroll 1
        for (int c = 0; c < NQC; c++) {
#pragma unroll
            for (int i = 0; i < 8; i++) {
                int e = tid + i * 256; int r = e >> 5, d = e & 31;
                Qc[r][d] = Q[(long)r * p.ldq + c * 32 + d];
                float kv;
                if (c * 32 < DK1) kv = K1[(long)(kt + r) * p.ldk1 + c * 32 + d];
                else kv = K2[(long)(kt + r) * p.ldk2 + (c * 32 - DK1) + d];
                Kc[r][d] = kv;
            }
            __syncthreads();
#pragma unroll
            for (int d = 0; d < 32; d++) {
                float a[4], bb[4];
#pragma unroll
                for (int i = 0; i < 4; i++) { a[i] = Qc[ty * 4 + i][d]; bb[i] = Kc[tx * 4 + i][d]; }
#pragma unroll
                for (int i = 0; i < 4; i++)
#pragma unroll
                    for (int j = 0; j < 4; j++) s[i][j] += a[i] * bb[j];
            }
            __syncthreads();
        }
#pragma unroll
        for (int i = 0; i < 4; i++) {
            float mx = -1e30f;
#pragma unroll
            for (int j = 0; j < 4; j++) { s[i][j] *= p.scale; mx = fmaxf(mx, s[i][j]); }
            for (int o2 = 1; o2 < 16; o2 <<= 1) mx = fmaxf(mx, __shfl_xor(mx, o2));
            const float mn = fmaxf(mrow[i], mx);
            const float alpha = __expf(mrow[i] - mn);
            float rs = 0.f;
#pragma unroll
            for (int j = 0; j < 4; j++) { float pv = __expf(s[i][j] - mn); rs += pv; Ps[ty * 4 + i][tx * 4 + j] = pv; }
            for (int o2 = 1; o2 < 16; o2 <<= 1) rs += __shfl_xor(rs, o2);
            lrow[i] = lrow[i] * alpha + rs; mrow[i] = mn;
#pragma unroll
            for (int c = 0; c < NVC; c++)
#pragma unroll
                for (int j = 0; j < 4; j++) o[c][i][j] *= alpha;
        }
        __syncthreads();
#pragma unroll
        for (int c = 0; c < NVC; c++) {
#pragma unroll
            for (int i = 0; i < 16; i++) {
                int e = tid + i * 256; int r = e >> 6, d = e & 63;
                Vs[r][d] = V[(long)(kt + r) * p.ldv + c * 64 + d];
            }
            __syncthreads();
#pragma unroll 8
            for (int k = 0; k < 64; k++) {
                float a[4], bb[4];
#pragma unroll
                for (int i = 0; i < 4; i++) { a[i] = Ps[ty * 4 + i][k]; bb[i] = Vs[k][tx * 4 + i]; }
#pragma unroll
                for (int i = 0; i < 4; i++)
#pragma unroll
                    for (int j = 0; j < 4; j++) o[c][i][j] += a[i] * bb[j];
            }
            __syncthreads();
        }
    }
#pragma unroll
    for (int c = 0; c < NVC; c++)
#pragma unroll
        for (int i = 0; i < 4; i++) {
            const float inv = 1.f / lrow[i];
#pragma unroll
            for (int j = 0; j < 4; j++) O[(long)(ty * 4 + i) * p.ldo + c * 64 + tx * 4 + j] = o[c][i][j] * inv;
        }
}

__global__ void k_softmax16(float* l) {
    const int t = blockIdx.x * 256 + threadIdx.x;
    if (t >= NT) return;
    float v[16]; float mx = -1e30f;
#pragma unroll
    for (int e = 0; e < 16; e++) { v[e] = l[t * 16 + e]; mx = fmaxf(mx, v[e]); }
    float s = 0.f;
#pragma unroll
    for (int e = 0; e < 16; e++) { v[e] = expf(v[e] - mx); s += v[e]; }
    const float inv = 1.f / s;
#pragma unroll
    for (int e = 0; e < 16; e++) l[t * 16 + e] = v[e] * inv;
}

__global__ __launch_bounds__(256) void k_rank(const float* aff, int* slots, int* idx, float* gate) {
    __shared__ float a[NS];
    const int e = blockIdx.x, b = blockIdx.y;
    for (int t = threadIdx.x; t < NS; t += 256) a[t] = aff[((long)b * NS + t) * 16 + e];
    __syncthreads();
    for (int t = threadIdx.x; t < NS; t += 256) {
        const float v = a[t]; int r = 0;
        for (int u = 0; u < NS; u++) { float w = a[u]; r += (w > v || (w == v && u < t)) ? 1 : 0; }
        int sl = r < CAP ? r : -1;
        slots[((long)b * NE + e) * NS + t] = sl;
        if (sl >= 0) { idx[((long)b * NE + e) * CAP + sl] = t; gate[((long)b * NE + e) * CAP + sl] = v; }
    }
}

__global__ __launch_bounds__(256) void k_gather(const float* h, const int* idx, float* xin, int b) {
    const int es = blockIdx.x;
    const int t = idx[(long)b * NE * CAP + es];
    const float4* src = (const float4*)(h + ((long)b * NS + t) * ND);
    float4* dst = (float4*)(xin + (long)es * ND);
    dst[threadIdx.x] = src[threadIdx.x];
}
__global__ void k_silu_mul(float* a, const float* bb, long n) {
    const long i = (long)blockIdx.x * 256 + threadIdx.x;
    if (i < n) { float x = a[i]; a[i] = x / (1.f + expf(-x)) * bb[i]; }
}
__global__ __launch_bounds__(256) void k_combine(float* x, const float* y, const int* slots, const float* gate, int b) {
    const int t = blockIdx.x;
    float4 acc = make_float4(0.f, 0.f, 0.f, 0.f);
    for (int e = 0; e < NE; e++) {
        const int sl = slots[((long)b * NE + e) * NS + t];
        if (sl >= 0) {
            const float g = gate[((long)b * NE + e) * CAP + sl];
            const float4 v = ((const float4*)(y + ((long)e * CAP + sl) * ND))[threadIdx.x];
            acc.x += g * v.x; acc.y += g * v.y; acc.z += g * v.z; acc.w += g * v.w;
        }
    }
    float4* xp = (float4*)(x + ((long)b * NS + t) * ND);
    float4 xv = xp[threadIdx.x];
    xv.x += acc.x; xv.y += acc.y; xv.z += acc.z; xv.w += acc.w;
    xp[threadIdx.x] = xv;
}

extern "C" void kernel_launch(void* const* d_in, const int* in_sizes, int n_in,
                              void* d_out, int out_size, void* d_ws, size_t ws_size,
                              hipStream_t st) {
    const float* x = (const float*)d_in[0];
    const float* mem = (const float*)d_in[1];
    const int* pos = (const int*)d_in[2];
    const float* g_mix = (const float*)d_in[3];
    const float* w_in = (const float*)d_in[4];
    const float* g_q_lat = (const float*)d_in[5];
    const float* w_q_up = (const float*)d_in[6];
    const float* g_kv_lat = (const float*)d_in[7];
    const float* w_kv_up = (const float*)d_in[8];
    const float* w_fourier = (const float*)d_in[9];
    const float* w_out = (const float*)d_in[10];
    const float* g_mem_q = (const float*)d_in[11];
    const float* g_mem_kv = (const float*)d_in[12];
    const float* w_mem_q = (const float*)d_in[13];
    const float* w_mem_kv = (const float*)d_in[14];
    const float* w_mem_o = (const float*)d_in[15];
    const float* g_ffn = (const float*)d_in[16];
    const float* w_router = (const float*)d_in[17];
    const float* w_exp_gate = (const float*)d_in[18];
    const float* w_exp_up = (const float*)d_in[19];
    const float* w_exp_down = (const float*)d_in[20];
    const float* g_final = (const float*)d_in[21];
    float* out = (float*)d_out;
    float* ws = (float*)d_ws;

    float* RA = ws;
    float* RB = ws + 20000000L;
    float* RC = RB + 16777216L;
    float* RD = RC + 16777216L;
    float* RE = RD + 8388608L;
    float2* tw = (float2*)RE;
    float* c64 = RE + 8192;
    float* s64 = c64 + 4096;
    float* rc = s64 + 4096;
    float* rs = rc + NT * 16;

    hipLaunchKernelGGL(k_tables, dim3(NT * 16 / 256), dim3(256), 0, st, tw, c64, s64, pos, rc, rs);
    hipLaunchKernelGGL(k_rmsnorm, dim3(NT), dim3(256), 0, st, x, (long)ND, g_mix, RB, (long)ND, ND);
    float* u = RA;
    gemm(st, RB, ND, w_in, INW, u, INW, NT, INW, ND);
    float* FA = RC; float* FB = RC + (long)NT * 512;
    gemm(st, u, INW, c64, 64, FA, 512, NT, 64, 64, 8, 64, 0, 64);
    gemm(st, u, INW, s64, 64, FB, 512, NT, 64, 64, 8, 64, 0, 64);
    float* z = RD;
    gemm(st, nullptr, 0, FA, 512, z, 512, NS, 512, 8192, NB, 0, (long)NS * 512, (long)NS * 512,
         nullptr, 0, 0, 1.0f / 512.0f, 1, tw, 4096, (long)NT * 512 - 4096L * 512);
    float* mix = RB;
    gemm(st, z, 512, w_fourier, 64, mix, ND, NT, 64, 64, 8, 64, 4096, 64);
    float* qn = RD;
    hipLaunchKernelGGL(k_rmsnorm, dim3(NT), dim3(256), 0, st, u + 512, (long)INW, g_q_lat, qn, 384L, 384);
    float* q = RC;
    gemm(st, qn, 384, w_q_up, 768, q, 768, NT, 768, 384);
    hipLaunchKernelGGL(k_rope_q, dim3(NT * 8 * 16 / 256), dim3(256), 0, st, q, rc, rs);
    float* kvn = RD;
    hipLaunchKernelGGL(k_rmsnorm, dim3(NT), dim3(256), 0, st, u + 896, (long)INW, g_kv_lat, kvn, 256L, 256);
    float* kv = out;
    gemm(st, kvn, 256, w_kv_up, 1024, kv, 1024, NT, 1024, 256);
    float* kr = RC + (long)NT * 768;
    hipLaunchKernelGGL(k_rope_k, dim3(NT * 16 / 256), dim3(256), 0, st, u, kr, rc, rs);
    {
        AttnP a{};
        a.Q = q; a.ldq = 768; a.qhs = 96;
        a.K1 = kv; a.ldk1 = 1024; a.k1hs = 128;
        a.K2 = kr; a.ldk2 = 32;
        a.V = kv + 64; a.ldv = 1024; a.vhs = 128;
        a.O = mix + 512; a.ldo = 1024; a.ohs = 64;
        a.nq = NS; a.nk = NS; a.scale = 0.10206207261596575f;
        hipLaunchKernelGGL((k_attn<64, 32, 64>), dim3(NS / 64, 8, NB), dim3(256), 0, st, a);
    }
    float* x1 = RA;
    gemm(st, mix, ND, w_out, ND, x1, ND, NT, ND, ND, 1, 0, 0, 0, x, ND, 0);
    float* hq = RC;
    hipLaunchKernelGGL(k_rmsnorm, dim3(NT), dim3(256), 0, st, x1, (long)ND, g_mem_q, hq, (long)ND, ND);
    float* qm = out;
    gemm(st, hq, ND, w_mem_q, ND, qm, ND, NT, ND, ND);
    float* mn = RD;
    hipLaunchKernelGGL(k_rmsnorm, dim3(NB * MEML), dim3(256), 0, st, mem, (long)ND, g_mem_kv, mn, (long)ND, ND);
    float* kvm = RD + 1048576L;
    gemm(st, mn, ND, w_mem_kv, 2048, kvm, 2048, NB * MEML, 2048, ND);
    float* om = RC;
    {
        AttnP a{};
        a.Q = qm; a.ldq = 1024; a.qhs = 256;
        a.K1 = kvm; a.ldk1 = 2048; a.k1hs = 256;
        a.K2 = nullptr; a.ldk2 = 0;
        a.V = kvm + 1024; a.ldv = 2048; a.vhs = 256;
        a.O = om; a.ldo = 1024; a.ohs = 256;
        a.nq = NS; a.nk = MEML; a.scale = 0.0625f;
        hipLaunchKernelGGL((k_attn<256, 0, 256>), dim3(NS / 64, 4, NB), dim3(256), 0, st, a);
    }
    gemm(st, om, ND, w_mem_o, ND, x1, ND, NT, ND, ND, 1, 0, 0, 0, x1, ND, 0);
    float* hf = RC;
    hipLaunchKernelGGL(k_rmsnorm, dim3(NT), dim3(256), 0, st, x1, (long)ND, g_ffn, hf, (long)ND, ND);
    float* aff = RD;
    gemm(st, hf, ND, w_router, 16, aff, 16, NT, 16, ND);
    hipLaunchKernelGGL(k_softmax16, dim3(NT / 256), dim3(256), 0, st, aff);
    int* slots = (int*)(RD + 1048576L);
    int* idx = (int*)(RD + 2 * 1048576L);
    float* gate = RD + 3 * 1048576L;
    hipLaunchKernelGGL(k_rank, dim3(NE, NB), dim3(256), 0, st, aff, slots, idx, gate);
    for (int b = 0; b < NB; b++) {
        float* xin = RB;
        float* ga = RB + 8388608L;
        float* up = out;
        float* y = out + 8388608L;
        hipLaunchKernelGGL(k_gather, dim3(NE * CAP), dim3(256), 0, st, hf, idx, xin, b);
        gemm(st, xin, ND, w_exp_gate, ND, ga, ND, CAP, ND, ND, NE, (long)CAP * ND, (long)ND * ND, (long)CAP * ND);
        gemm(st, xin, ND, w_exp_up, ND, up, ND, CAP, ND, ND, NE, (long)CAP * ND, (long)ND * ND, (long)CAP * ND);
        hipLaunchKernelGGL(k_silu_mul, dim3(NE * CAP * ND / 256), dim3(256), 0, st, ga, up, (long)NE * CAP * ND);
        gemm(st, ga, ND, w_exp_down, ND, y, ND, CAP, ND, ND, NE, (long)CAP * ND, (long)ND * ND, (long)CAP * ND);
        hipLaunchKernelGGL(k_combine, dim3(NS), dim3(256), 0, st, x1, y, slots, gate, b);
    }
    hipLaunchKernelGGL(k_rmsnorm, dim3(NT), dim3(256), 0, st, x1, (long)ND, g_final, out, (long)ND, ND);
}
```

```cpp
#include <hip/hip_runtime.h>
#include <stdint.h>
#include <cstdio>
#include <hip/hip_cooperative_groups.h>
namespace cg = cooperative_groups;
#ifndef USE_CG_SYNC
#define USE_CG_SYNC 0
#endif

#ifndef MK_CUTS
#define MK_CUTS {0, 13}
#endif

#define NB 4
#define NS 4096
#define ND 1024
#define NT (NB * NS)
#define INW 1184
#define NE 16
#define CAP 512
#define MEML 256
#define NPHASE 13

typedef unsigned short bf16_t;
typedef short bf16x8 __attribute__((ext_vector_type(8)));
typedef float f32x4 __attribute__((ext_vector_type(4)));
typedef float f32x16 __attribute__((ext_vector_type(16)));
typedef unsigned u32x4 __attribute__((ext_vector_type(4)));
typedef unsigned u32x2 __attribute__((ext_vector_type(2)));

__device__ __forceinline__ unsigned f2bf(float f) {
    unsigned u = __float_as_uint(f);
    u += 0x7FFFu + ((u >> 16) & 1u);
    return u >> 16;
}
typedef __bf16 hbf2 __attribute__((ext_vector_type(2)));
typedef float f32x2 __attribute__((ext_vector_type(2)));
__device__ __forceinline__ unsigned pack2bf(float lo, float hi) { f32x2 v = {lo, hi}; return __builtin_bit_cast(unsigned, __builtin_convertvector(v, hbf2)); }
__device__ __forceinline__ float bf2f(unsigned short b) { return __uint_as_float(((unsigned)b) << 16); }

__device__ __forceinline__ int tile_off(int row, int chunk) { return row * 128 + ((chunk ^ ((row >> 1) & 7)) << 4); }

#define GT_LDS_BYTES 65536

struct GemmTile { const bf16_t* A; long lda; const int* arow; const bf16_t* Bt; long ldb; int K; };

__device__ __forceinline__ void gemm_tile_128(const GemmTile& g, char* lds, f32x4 (&acc)[4][4]) {
    const int tid = threadIdx.x, lane = tid & 63, wid = tid >> 6, wm = wid >> 1, wn = wid & 1;
    const int lr = tid >> 3, lc = tid & 7;
    const bf16_t* ap[4]; const bf16_t* bp[4];
#pragma unroll
    for (int i = 0; i < 4; i++) {
        const int r = lr + 32 * i;
        const long ro = g.arow ? (long)g.arow[r] * g.lda : (long)r * g.lda;
        ap[i] = g.A + ro + lc * 8;
        bp[i] = g.Bt + (long)r * g.ldb + lc * 8;
    }
#pragma unroll
    for (int mi = 0; mi < 4; mi++)
#pragma unroll
        for (int ni = 0; ni < 4; ni++) acc[mi][ni] = (f32x4){0.f, 0.f, 0.f, 0.f};
    u32x4 ra[4], rb[4];
#pragma unroll
    for (int i = 0; i < 4; i++) { ra[i] = *(const u32x4*)(ap[i]); rb[i] = *(const u32x4*)(bp[i]); }
    const int nk = g.K >> 6;
    __syncthreads();
#pragma unroll
    for (int i = 0; i < 4; i++) {
        *(u32x4*)(lds + tile_off(lr + 32 * i, lc)) = ra[i];
        *(u32x4*)(lds + 16384 + tile_off(lr + 32 * i, lc)) = rb[i];
    }
    __syncthreads();
    for (int kt = 0; kt < nk; kt++) {
        char* cur = lds + (kt & 1) * 32768;
        char* nxt = lds + ((kt + 1) & 1) * 32768;
        if (kt + 1 < nk) {
#pragma unroll
            for (int i = 0; i < 4; i++) { ra[i] = *(const u32x4*)(ap[i] + (kt + 1) * 64); rb[i] = *(const u32x4*)(bp[i] + (kt + 1) * 64); }
        }
#pragma unroll
        for (int ks = 0; ks < 2; ks++) {
            bf16x8 af[4], bfr[4];
#pragma unroll
            for (int i = 0; i < 4; i++) {
                af[i] = *(const bf16x8*)(cur + tile_off(wm * 64 + i * 16 + (lane & 15), ks * 4 + (lane >> 4)));
                bfr[i] = *(const bf16x8*)(cur + 16384 + tile_off(wn * 64 + i * 16 + (lane & 15), ks * 4 + (lane >> 4)));
            }
#pragma unroll
            for (int mi = 0; mi < 4; mi++)
#pragma unroll
                for (int ni = 0; ni < 4; ni++)
                    acc[mi][ni] = __builtin_amdgcn_mfma_f32_16x16x32_bf16(bfr[ni], af[mi], acc[mi][ni], 0, 0, 0);
        }
        if (kt + 1 < nk) {
#pragma unroll
            for (int i = 0; i < 4; i++) {
                *(u32x4*)(nxt + tile_off(lr + 32 * i, lc)) = ra[i];
                *(u32x4*)(nxt + 16384 + tile_off(lr + 32 * i, lc)) = rb[i];
            }
        }
        __syncthreads();
    }
}


template <int DQK, int DVT, int KT>
struct AttnCfg {
    static constexpr int KROW = DQK * 2 + 16;
    static constexpr int VROW = KT * 2 + 8;
    static constexpr int KBYTES = KT * KROW;
    static constexpr int VBYTES = DVT * VROW;
    static constexpr int STAGE = KBYTES + VBYTES;
    static constexpr int LDS = 2 * STAGE;
};

template <int DQK, int DVT, int KT, class Out>
__device__ __forceinline__ void attn_block(const bf16_t* Qp, const bf16_t* Kp, const bf16_t* Vtp, long ldv, int nk, char* lds, Out&& out) {
    typedef AttnCfg<DQK, DVT, KT> C;
    constexpr int NKS = DQK / 16, NST = KT / 32, NDT = DVT / 32, NPS = KT / 16;
    constexpr int KCPR = DQK / 8;
    constexpr int KCH = KT * KCPR / 256;
    constexpr int VCPR = KT / 8;
    constexpr int VCH = DVT * VCPR / 256;
    const int tid = threadIdx.x, lane = tid & 63, wid = tid >> 6, h = lane >> 5, c = lane & 31;

    bf16x8 qf[NKS];
    {
        const bf16_t* qrow = Qp + (long)(wid * 32 + c) * DQK + 8 * h;
#pragma unroll
        for (int ks = 0; ks < NKS; ks++) qf[ks] = *(const bf16x8*)(qrow + 16 * ks);
    }
    f32x16 o[NDT];
#pragma unroll
    for (int dt = 0; dt < NDT; dt++)
#pragma unroll
        for (int r = 0; r < 16; r++) o[dt][r] = 0.f;
    float m = -1e30f, l = 0.f;

    u32x4 kr[KCH], vr[VCH];
    auto gload = [&](int t) {
#pragma unroll
        for (int i = 0; i < KCH; i++) {
            const int ci = tid + 256 * i, row = ci / KCPR, cc = ci % KCPR;
            kr[i] = *(const u32x4*)(Kp + (long)(t * KT + row) * DQK + cc * 8);
        }
#pragma unroll
        for (int i = 0; i < VCH; i++) {
            const int ci = tid + 256 * i, row = ci / VCPR, cc = ci % VCPR;
            vr[i] = *(const u32x4*)(Vtp + (long)row * ldv + t * KT + cc * 8);
        }
    };
    auto lwrite = [&](char* st) {
#pragma unroll
        for (int i = 0; i < KCH; i++) {
            const int ci = tid + 256 * i, row = ci / KCPR, cc = ci % KCPR;
            *(u32x4*)(st + row * C::KROW + cc * 16) = kr[i];
        }
#pragma unroll
        for (int i = 0; i < VCH; i++) {
            const int ci = tid + 256 * i, row = ci / VCPR, cc = ci % VCPR;
            char* p = st + C::KBYTES + row * C::VROW + cc * 16;
            *(u32x2*)(p) = (u32x2){vr[i].x, vr[i].y};
            *(u32x2*)(p + 8) = (u32x2){vr[i].z, vr[i].w};
        }
    };
    const int nt = nk / KT;
    gload(0);
    __syncthreads();
    lwrite(lds);
    __syncthreads();
    for (int t = 0; t < nt; t++) {
        char* cur = lds + (t & 1) * C::STAGE;
        if (t + 1 < nt) gload(t + 1);
        f32x16 s[NST];
#pragma unroll
        for (int st = 0; st < NST; st++) {
#pragma unroll
            for (int r = 0; r < 16; r++) s[st][r] = 0.f;
#pragma unroll
            for (int ks = 0; ks < NKS; ks++) {
                const bf16x8 kf = *(const bf16x8*)(cur + (st * 32 + c) * C::KROW + ks * 32 + h * 16);
                s[st] = __builtin_amdgcn_mfma_f32_32x32x16_bf16(kf, qf[ks], s[st], 0, 0, 0);
            }
        }
        float mx = s[0][0];
#pragma unroll
        for (int st = 0; st < NST; st++)
#pragma unroll
            for (int r = 0; r < 16; r++) mx = fmaxf(mx, s[st][r]);
        mx = fmaxf(mx, __shfl_xor(mx, 32));
        const float mn = fmaxf(m, mx);
        const float alpha = __builtin_amdgcn_exp2f(m - mn);
        m = mn;
        float rs = 0.f;
#pragma unroll
        for (int st = 0; st < NST; st++)
#pragma unroll
            for (int r = 0; r < 16; r++) { const float p = __builtin_amdgcn_exp2f(s[st][r] - mn); rs += p; s[st][r] = p; }
        l = l * alpha + rs;
#pragma unroll
        for (int dt = 0; dt < NDT; dt++)
#pragma unroll
            for (int r = 0; r < 16; r++) o[dt][r] *= alpha;
#pragma unroll
        for (int ps = 0; ps < NPS; ps++) {
            const int st = ps >> 1, u = ps & 1;
            u32x4 pw;
            pw.x = pack2bf(s[st][8 * u + 0], s[st][8 * u + 1]);
            pw.y = pack2bf(s[st][8 * u + 2], s[st][8 * u + 3]);
            pw.z = pack2bf(s[st][8 * u + 4], s[st][8 * u + 5]);
            pw.w = pack2bf(s[st][8 * u + 6], s[st][8 * u + 7]);
            const bf16x8 pf = __builtin_bit_cast(bf16x8, pw);
#pragma unroll
            for (int dt = 0; dt < NDT; dt++) {
                const char* vp = cur + C::KBYTES + (dt * 32 + c) * C::VROW + (ps * 16 + 4 * h) * 2;
                const u32x2 v0 = *(const u32x2*)(vp);
                const u32x2 v1 = *(const u32x2*)(vp + 16);
                const bf16x8 vf = __builtin_bit_cast(bf16x8, ((u32x4){v0.x, v0.y, v1.x, v1.y}));
                o[dt] = __builtin_amdgcn_mfma_f32_32x32x16_bf16(vf, pf, o[dt], 0, 0, 0);
            }
        }
        if (t + 1 < nt) lwrite(lds + ((t + 1) & 1) * C::STAGE);
        __syncthreads();
    }
    l += __shfl_xor(l, 32);
    const float inv = 1.f / l;
#pragma unroll
    for (int dt = 0; dt < NDT; dt++)
#pragma unroll
        for (int g4 = 0; g4 < 4; g4++) {
            f32x4 v = {o[dt][4 * g4 + 0] * inv, o[dt][4 * g4 + 1] * inv, o[dt][4 * g4 + 2] * inv, o[dt][4 * g4 + 3] * inv};
            out(wid * 32 + c, dt * 32 + 8 * g4 + 4 * h, v);
        }
}


constexpr size_t SLOT = 33554432;
constexpr size_t OFF_W1T = 0;
constexpr size_t OFF_WQT = OFF_W1T + 1280UL * 1024 * 2;
constexpr size_t OFF_WKVT = OFF_WQT + 768UL * 384 * 2;
constexpr size_t OFF_WOUTT = OFF_WKVT + 1024UL * 256 * 2;
constexpr size_t OFF_WMQT = OFF_WOUTT + 1024UL * 1024 * 2;
constexpr size_t OFF_WMKVT = OFF_WMQT + 1024UL * 1024 * 2;
constexpr size_t OFF_WMOT = OFF_WMKVT + 2048UL * 1024 * 2;
constexpr size_t OFF_WGUT = OFF_WMOT + 1024UL * 1024 * 2;
constexpr size_t OFF_WDT = OFF_WGUT + 16UL * 2048 * 1024 * 2;
constexpr size_t OFF_T64 = OFF_WDT + 16UL * 1024 * 1024 * 2;
constexpr size_t OFF_M1 = OFF_T64 + 16384;
constexpr size_t OFF_M3 = OFF_M1 + 32768;
constexpr size_t OFF_WFT = OFF_M3 + 16384;
constexpr size_t OFF_TW = OFF_WFT + 65536;
constexpr size_t OFF_ROPE = OFF_TW + 32768;
constexpr size_t OFF_R0 = OFF_ROPE + (size_t)NT * 16 * 8;
constexpr size_t OFF_RMEM = OFF_R0 + (size_t)NT * 4;
constexpr size_t OFF_SSQ = OFF_RMEM + 4096;
constexpr size_t OFF_SSKV = OFF_SSQ + (size_t)NT * 6 * 4;
constexpr size_t OFF_SS1 = OFF_SSKV + (size_t)NT * 4 * 4;
constexpr size_t OFF_SS2 = OFF_SS1 + (size_t)NT * 16 * 4;
constexpr size_t OFF_AFF = OFF_SS2 + (size_t)NT * 16 * 4;
constexpr size_t OFF_SLOTS = OFF_AFF + (size_t)NT * 16 * 4;
constexpr size_t OFF_IDX = OFF_SLOTS + 4UL * 16 * 4096 * 4;
constexpr size_t OFF_GATE = OFF_IDX + 4UL * 16 * 512 * 4;
constexpr size_t OFF_MEMB = OFF_GATE + 4UL * 16 * 512 * 4;
constexpr size_t OFF_KMEM = OFF_MEMB + 1024UL * 1024 * 2;
constexpr size_t OFF_VTMEM = OFF_KMEM + 1024UL * 1024 * 2;
constexpr size_t OFF_KR = OFF_VTMEM + 1024UL * 1024 * 2;
constexpr size_t OFF_BAR = OFF_KR + (size_t)NT * 32 * 2;
constexpr size_t OFF_S0 = (OFF_BAR + 16384 + 255) / 256 * 256;
constexpr size_t OFF_S1 = OFF_S0 + SLOT;
constexpr size_t OFF_S2 = OFF_S1 + SLOT;
constexpr size_t OFF_S3 = OFF_S2 + SLOT;
constexpr size_t OFF_S4 = OFF_S3 + SLOT;
constexpr size_t WS_END = OFF_S4 + SLOT;
static_assert(WS_END <= 300964352UL, "workspace map exceeds the guaranteed scratch size");
constexpr size_t OFF_XB = OFF_S0, OFF_YR = OFF_S0, OFF_YI = OFF_S0 + SLOT / 2, OFF_X1B = OFF_S0, OFF_OM = OFF_S0, OFF_ACT = OFF_S0;
constexpr size_t OFF_UF = OFF_S1, OFF_UQ = OFF_S1 + (size_t)NT * 512 * 2, OFF_ZA = OFF_S1, OFF_QM = OFF_S1;
constexpr size_t OFF_Q = OFF_S2, OFF_UKV = OFF_S2 + (size_t)NT * 768 * 2, OFF_X2B = OFF_S2;
constexpr size_t OFF_K = OFF_S3, OFF_Y = OFF_S3;
constexpr size_t OFF_VT = OFF_S4;

struct Params {
    const float *x, *mem; const int* pos;
    const float *g_mix, *w_in, *g_q_lat, *w_q_up, *g_kv_lat, *w_kv_up, *w_fourier, *w_out, *g_mem_q, *g_mem_kv, *w_mem_q, *w_mem_kv, *w_mem_o,
        *g_ffn, *w_router, *w_exp_gate, *w_exp_up, *w_exp_down, *g_final;
    float* out; char* ws;
};
template <class T> __device__ __forceinline__ T* wsp(const Params& p, size_t off) { return (T*)(p.ws + off); }

#define LDS_MAIN 65536
#define LDS_TOTAL (LDS_MAIN + 16)
#define LAS __attribute__((address_space(3)))

#define XB_TMO      128
#define XB_XCNT(j)  (256  + 64 * (j))
#define XB_XSUB(j)  (1280 + 64 * (j))
#define XB_XGEN(j)  (2304 + 64 * (j))
#define XB_TOP      3328
#define XB_TOPGEN   3392
#define XCD_BAR_WORDS 3456
#define XB_SPIN_CAP (1u << 25)
__device__ __forceinline__ unsigned xb_ld(unsigned* p)              { return __hip_atomic_load(p, __ATOMIC_RELAXED, __HIP_MEMORY_SCOPE_AGENT); }
__device__ __forceinline__ unsigned xb_add(unsigned* p, unsigned v) { return __hip_atomic_fetch_add(p, v, __ATOMIC_RELAXED, __HIP_MEMORY_SCOPE_AGENT); }
__device__ __forceinline__ unsigned xb_xcc_id() { return (unsigned)__builtin_amdgcn_s_getreg((3 << 11) | 20) & 0xFu; }
#define XB_SPIN(cond, bar) do { unsigned _sp = 0; while (cond) { __builtin_amdgcn_s_sleep(1); \
    if ((++_sp & 255u) == 0u) { if (xb_ld(&(bar)[XB_TMO])) break; if (_sp > XB_SPIN_CAP) { atomicAdd(&(bar)[XB_TMO], 1u); break; } } } } while (0)
struct XcdBarrier { unsigned* bar; unsigned x; volatile LAS unsigned* st; };
__device__ __forceinline__ XcdBarrier xcd_barrier_post(unsigned* bar, volatile LAS unsigned* st) {
    XcdBarrier b; b.bar = bar; b.x = xb_xcc_id(); b.st = st;
    if (threadIdx.x == 0) (void)xb_add(&bar[XB_XCNT(b.x)], 1u);
    return b;
}
__device__ __forceinline__ void xcd_barrier_complete(unsigned* bar, unsigned x, unsigned& nloc, unsigned& nx) {
    const unsigned G = gridDim.x * gridDim.y * gridDim.z;
    unsigned sum, cnt, mine, sp = 0u;
    for (;;) {
        sum = 0u; cnt = 0u; mine = 0u;
#pragma unroll
        for (unsigned j = 0; j < 16; ++j) { const unsigned c = xb_ld(&bar[XB_XCNT(j)]); sum += c; cnt += (c > 0u) ? 1u : 0u; mine = (j == x) ? c : mine; }
        if (sum == G) break;
        __builtin_amdgcn_s_sleep(1);
        if ((++sp & 255u) == 0u) { if (xb_ld(&bar[XB_TMO])) break; if (sp > XB_SPIN_CAP) { atomicAdd(&bar[XB_TMO], 1u); break; } }
    }
    nloc = mine > 0u ? mine : 1u; nx = cnt > 0u ? cnt : 1u;
}
__device__ __forceinline__ void xcd_barrier(const XcdBarrier& b) {
    asm volatile("s_waitcnt vmcnt(0)" ::: "memory");
    __syncthreads();
    if (threadIdx.x == 0) {
        unsigned* bar = b.bar;
        __builtin_amdgcn_s_waitcnt(0);
        unsigned nloc = b.st[0], nx = b.st[1];
        if (nloc == 0u) { xcd_barrier_complete(bar, b.x, nloc, nx); b.st[0] = nloc; b.st[1] = nx; }
        const unsigned old = xb_add(&bar[XB_XSUB(b.x)], 1u);
        const unsigned gen = old / nloc;
        if (old + 1u == (gen + 1u) * nloc) {
            __builtin_amdgcn_fence(__ATOMIC_RELEASE, "agent");
            asm volatile("s_waitcnt vmcnt(0)" ::: "memory");
            const unsigned og = xb_add(&bar[XB_TOP], 1u);
            const unsigned tg = og / nx;
            if (og + 1u == (tg + 1u) * nx) xb_add(&bar[XB_TOPGEN], 1u);
            else XB_SPIN(xb_ld(&bar[XB_TOPGEN]) == tg, bar);
            __builtin_amdgcn_fence(__ATOMIC_ACQUIRE, "agent");
            xb_add(&bar[XB_XGEN(b.x)], 1u);
            asm volatile("s_waitcnt vmcnt(0)" ::: "memory");
        } else {
            XB_SPIN(xb_ld(&bar[XB_XGEN(b.x)]) == gen, bar);
            __builtin_amdgcn_fence(__ATOMIC_ACQUIRE, "agent");
            asm volatile("s_waitcnt vmcnt(0)" ::: "memory");
        }
    }
    __syncthreads();
}

__device__ __forceinline__ u32x2 pack4bf(float a, float b, float c, float d) { return (u32x2){pack2bf(a, b), pack2bf(c, d)}; }
__device__ __forceinline__ u32x2 pack4bf(f32x4 v) { return (u32x2){pack2bf(v[0], v[1]), pack2bf(v[2], v[3])}; }
__device__ __forceinline__ float wave_sum(float v) {
#pragma unroll
    for (int o = 32; o > 0; o >>= 1) v += __shfl_xor(v, o);
    return v;
}

__device__ __forceinline__ void tr_tile(const float* W, long ldw, int k0, int n0, int nvalid, const float* gain, bf16_t* Wt, long ldt, int mode, char* lds) {
    float (*t)[65] = (float (*)[65])lds;
    __syncthreads();
    for (int i = threadIdx.x; i < 4096; i += 256) {
        const int kk = i >> 6, nn = i & 63;
        float v = (n0 + nn < nvalid) ? W[(long)(k0 + kk) * ldw + n0 + nn] : 0.f;
        if (gain) v *= gain[k0 + kk];
        t[kk][nn] = v;
    }
    __syncthreads();
    for (int i = threadIdx.x; i < 512; i += 256) {
        const int nn = i >> 3, kc = i & 7;
        const int n = n0 + nn;
        int row = n;
        if (mode) row = (n >> 5) * 64 + ((n >> 4) & 1) * 32 + (mode - 1) * 16 + (n & 15);
        u32x4 w;
        w.x = pack2bf(t[kc * 8 + 0][nn], t[kc * 8 + 1][nn]);
        w.y = pack2bf(t[kc * 8 + 2][nn], t[kc * 8 + 3][nn]);
        w.z = pack2bf(t[kc * 8 + 4][nn], t[kc * 8 + 5][nn]);
        w.w = pack2bf(t[kc * 8 + 6][nn], t[kc * 8 + 7][nn]);
        *(u32x4*)(Wt + (long)row * ldt + k0 + kc * 8) = w;
    }
}

__device__ __forceinline__ void phase0(const Params& p, char* lds) {
    constexpr int J_W1 = 320, J_WQ = 72, J_WKV = 64, J_WOUT = 256, J_WMQ = 256, J_WMKV = 512, J_WMO = 256, J_WG = 4096, J_WU = 4096, J_WD = 4096;
    constexpr int J_TR = J_W1 + J_WQ + J_WKV + J_WOUT + J_WMQ + J_WMKV + J_WMO + J_WG + J_WU + J_WD;
    constexpr int J_XR = NT / 4, J_MR = 1024 / 4, J_ROPE = NT * 16 / 256, J_TAB = (4096 + 8192 + 16384 + 8192 + 32768) / 256;
    constexpr int J_ALL = J_TR + J_XR + J_MR + J_ROPE + J_TAB;
    const int tid = threadIdx.x, lane = tid & 63, wid = tid >> 6;
    const double PI2 = 6.283185307179586476925286766559;
    for (int job = blockIdx.x; job < J_ALL; job += gridDim.x) {
        int j = job;
        if (j < J_TR) {
            if (j < J_W1) { tr_tile(p.w_in, INW, (j / 20) * 64, (j % 20) * 64, INW, p.g_mix, wsp<bf16_t>(p, OFF_W1T), 1024, 0, lds); continue; } j -= J_W1;
            if (j < J_WQ) { tr_tile(p.w_q_up, 768, (j / 12) * 64, (j % 12) * 64, 768, p.g_q_lat, wsp<bf16_t>(p, OFF_WQT), 384, 0, lds); continue; } j -= J_WQ;
            if (j < J_WKV) { tr_tile(p.w_kv_up, 1024, (j / 16) * 64, (j % 16) * 64, 1024, p.g_kv_lat, wsp<bf16_t>(p, OFF_WKVT), 256, 0, lds); continue; } j -= J_WKV;
            if (j < J_WOUT) { tr_tile(p.w_out, 1024, (j / 16) * 64, (j % 16) * 64, 1024, nullptr, wsp<bf16_t>(p, OFF_WOUTT), 1024, 0, lds); continue; } j -= J_WOUT;
            if (j < J_WMQ) { tr_tile(p.w_mem_q, 1024, (j / 16) * 64, (j % 16) * 64, 1024, p.g_mem_q, wsp<bf16_t>(p, OFF_WMQT), 1024, 0, lds); continue; } j -= J_WMQ;
            if (j < J_WMKV) { tr_tile(p.w_mem_kv, 2048, (j / 32) * 64, (j % 32) * 64, 2048, p.g_mem_kv, wsp<bf16_t>(p, OFF_WMKVT), 1024, 0, lds); continue; } j -= J_WMKV;
            if (j < J_WMO) { tr_tile(p.w_mem_o, 1024, (j / 16) * 64, (j % 16) * 64, 1024, nullptr, wsp<bf16_t>(p, OFF_WMOT), 1024, 0, lds); continue; } j -= J_WMO;
            if (j < J_WG) { const int e = j >> 8, r = j & 255; tr_tile(p.w_exp_gate + (long)e * 1048576, 1024, (r / 16) * 64, (r % 16) * 64, 1024, p.g_ffn, wsp<bf16_t>(p, OFF_WGUT) + (long)e * 2048 * 1024, 1024, 1, lds); continue; } j -= J_WG;
            if (j < J_WU) { const int e = j >> 8, r = j & 255; tr_tile(p.w_exp_up + (long)e * 1048576, 1024, (r / 16) * 64, (r % 16) * 64, 1024, p.g_ffn, wsp<bf16_t>(p, OFF_WGUT) + (long)e * 2048 * 1024, 1024, 2, lds); continue; } j -= J_WU;
            { const int e = j >> 8, r = j & 255; tr_tile(p.w_exp_down + (long)e * 1048576, 1024, (r / 16) * 64, (r % 16) * 64, 1024, nullptr, wsp<bf16_t>(p, OFF_WDT) + (long)e * 1048576, 1024, 0, lds); continue; }
        }
        j -= J_TR;
        if (j < J_XR + J_MR) {
            const bool isx = j < J_XR;
            const int row = (isx ? j : j - J_XR) * 4 + wid;
            const float* src = (isx ? p.x : p.mem) + (long)row * ND;
            bf16_t* dst = (isx ? wsp<bf16_t>(p, OFF_XB) : wsp<bf16_t>(p, OFF_MEMB)) + (long)row * ND;
            float ss = 0.f;
#pragma unroll
            for (int i = 0; i < 4; i++) {
                const f32x4 v = *(const f32x4*)(src + i * 256 + lane * 4);
                ss += v[0] * v[0] + v[1] * v[1] + v[2] * v[2] + v[3] * v[3];
                *(u32x2*)(dst + i * 256 + lane * 4) = pack4bf(v);
            }
            ss = wave_sum(ss);
            if (lane == 0) (isx ? wsp<float>(p, OFF_R0) : wsp<float>(p, OFF_RMEM))[row] = rsqrtf(ss * (1.f / ND) + 1e-6f);
            continue;
        }
        j -= J_XR + J_MR;
        if (j < J_ROPE) {
            const int i = j * 256 + tid; const int t = i >> 4, jj = i & 15;
            const double f = pow(10000.0, -(double)(2 * jj) / 32.0);
            const double ang = (double)p.pos[t] * f;
            wsp<float2>(p, OFF_ROPE)[i] = make_float2((float)cos(ang), (float)sin(ang));
            continue;
        }
        j -= J_ROPE;
        {
            int i = j * 256 + tid;
            if (i < 4096) { const double a = PI2 * (double)i / 4096.0; wsp<float2>(p, OFF_TW)[i] = make_float2((float)cos(a), (float)sin(a)); continue; } i -= 4096;
            if (i < 8192) {
                const int T = i >> 12, a = (i >> 6) & 63, b = i & 63;
                const double th = PI2 * (double)((a * b) & 63) / 64.0;
                wsp<bf16_t>(p, OFF_T64)[i] = (bf16_t)f2bf((float)(T ? sin(th) : cos(th))); continue;
            } i -= 8192;
            if (i < 16384) {
                const int rho = i >> 7, k = i & 127;
                const int wm = rho >> 6, mi = (rho >> 4) & 3, lr = rho & 15, ri = mi >> 1, k1 = 32 * wm + 16 * (mi & 1) + lr, ab = k >> 6, s1 = k & 63;
                const double th = PI2 * (double)((k1 * s1) & 63) / 64.0;
                const double c = cos(th), s = sin(th);
                const double v = ri == 0 ? (ab == 0 ? c : -s) : (ab == 0 ? s : c);
                wsp<bf16_t>(p, OFF_M1)[i] = (bf16_t)f2bf((float)v); continue;
            } i -= 16384;
            if (i < 8192) {
                const int k2 = i >> 7, k = i & 127, s2 = k & 63;
                const double th = PI2 * (double)((k2 * s2) & 63) / 64.0;
                wsp<bf16_t>(p, OFF_M3)[i] = (bf16_t)f2bf((float)(k < 64 ? cos(th) : -sin(th))); continue;
            } i -= 8192;
            if (i < 32768) {
                const int g = i >> 12, e = (i >> 6) & 63, ch = i & 63;
                wsp<bf16_t>(p, OFF_WFT)[i] = (bf16_t)f2bf(p.w_fourier[(g * 64 + ch) * 64 + e]); continue;
            }
        }
    }
}

__device__ __forceinline__ void phase1(const Params& p, char* lds) {
    const int tid = threadIdx.x, lane = tid & 63, wid = tid >> 6, wm = wid >> 1, wn = wid & 1, lq = lane >> 4, lr = lane & 15;
    constexpr int N_U = 128 * 10, N_M = 8 * 16;
    for (int item = blockIdx.x; item < N_U + N_M; item += gridDim.x) {
        f32x4 acc[4][4];
        if (item < N_U) {
            const int tm = item / 10, tn = item % 10;
            GemmTile g; g.A = wsp<bf16_t>(p, OFF_XB) + (long)tm * 128 * ND; g.lda = ND; g.arow = nullptr;
            g.Bt = wsp<bf16_t>(p, OFF_W1T) + (long)tn * 128 * ND; g.ldb = ND; g.K = ND;
            gemm_tile_128(g, lds, acc);
            const float* r0 = wsp<float>(p, OFF_R0);
#pragma unroll
            for (int mi = 0; mi < 4; mi++) {
                const int row = tm * 128 + wm * 64 + mi * 16 + lr;
                const float rs = r0[row];
#pragma unroll
                for (int ni = 0; ni < 4; ni++) acc[mi][ni] *= rs;
                if (tn < 4) {
#pragma unroll
                    for (int ni = 0; ni < 4; ni++)
                        *(u32x2*)(wsp<bf16_t>(p, OFF_UF) + (long)row * 512 + tn * 128 + wn * 64 + ni * 16 + 4 * lq) = pack4bf(acc[mi][ni]);
                } else if (tn < 9) {
                    float ss = 0.f;
#pragma unroll
                    for (int ni = 0; ni < 4; ni++) { const f32x4 v = acc[mi][ni]; ss += v[0] * v[0] + v[1] * v[1] + v[2] * v[2] + v[3] * v[3]; }
                    ss += __shfl_xor(ss, 16); ss += __shfl_xor(ss, 32);
                    if (tn < 7) {
#pragma unroll
                        for (int ni = 0; ni < 4; ni++)
                            *(u32x2*)(wsp<bf16_t>(p, OFF_UQ) + (long)row * 384 + (tn - 4) * 128 + wn * 64 + ni * 16 + 4 * lq) = pack4bf(acc[mi][ni]);
                        if (lq == 0) wsp<float>(p, OFF_SSQ)[row * 6 + (tn - 4) * 2 + wn] = ss;
                    } else {
#pragma unroll
                        for (int ni = 0; ni < 4; ni++)
                            *(u32x2*)(wsp<bf16_t>(p, OFF_UKV) + (long)row * 256 + (tn - 7) * 128 + wn * 64 + ni * 16 + 4 * lq) = pack4bf(acc[mi][ni]);
                        if (lq == 0) wsp<float>(p, OFF_SSKV)[row * 4 + (tn - 7) * 2 + wn] = ss;
                    }
                } else if (wn == 0) {
                    const float2* rp = wsp<float2>(p, OFF_ROPE) + (long)row * 16 + 4 * lq;
                    f32x4 o1, o2;
#pragma unroll
                    for (int r = 0; r < 4; r++) {
                        const float2 cs = rp[r];
                        const float x1 = acc[mi][0][r], x2 = acc[mi][1][r];
                        o1[r] = x1 * cs.x - x2 * cs.y; o2[r] = x1 * cs.y + x2 * cs.x;
                    }
                    bf16_t* kr = wsp<bf16_t>(p, OFF_KR) + (long)row * 32;
                    *(u32x2*)(kr + 4 * lq) = pack4bf(o1);
                    *(u32x2*)(kr + 16 + 4 * lq) = pack4bf(o2);
                }
            }
        } else {
            const int it = item - N_U, tm = it / 16, tn = it % 16;
            GemmTile g; g.A = wsp<bf16_t>(p, OFF_MEMB) + (long)tm * 128 * ND; g.lda = ND; g.arow = nullptr;
            g.Bt = wsp<bf16_t>(p, OFF_WMKVT) + (long)tn * 128 * ND; g.ldb = ND; g.K = ND;
            gemm_tile_128(g, lds, acc);
            const float* rm = wsp<float>(p, OFF_RMEM);
#pragma unroll
            for (int mi = 0; mi < 4; mi++) {
                const int row = tm * 128 + wm * 64 + mi * 16 + lr;
                const int b = row >> 8, m = row & 255;
                const float rs = rm[row];
#pragma unroll
                for (int ni = 0; ni < 4; ni++) {
                    const f32x4 v = acc[mi][ni] * rs;
                    const int col = tn * 128 + wn * 64 + ni * 16 + 4 * lq;
                    if (col < 1024) {
                        const int h = col >> 8, d = col & 255;
                        *(u32x2*)(wsp<bf16_t>(p, OFF_KMEM) + ((long)(b * 4 + h) * 256 + m) * 256 + d) = pack4bf(v);
                    } else {
                        const int c2 = col - 1024, h = c2 >> 8, dv = c2 & 255;
                        bf16_t* vt = wsp<bf16_t>(p, OFF_VTMEM) + ((long)(b * 4 + h) * 256 + dv) * 256 + m;
#pragma unroll
                        for (int r = 0; r < 4; r++) vt[r * 256] = (bf16_t)f2bf(v[r]);
                    }
                }
            }
        }
    }
}

template <int MI>
__device__ __forceinline__ void dft_mma(const bf16_t* Ag, int arow0, const char* ximg, int ncol0, f32x4 (&acc)[MI][4]) {
    const int lane = threadIdx.x & 63, lq = lane >> 4, lr = lane & 15;
#pragma unroll
    for (int ks = 0; ks < 4; ks++) {
        bf16x8 af[MI], bfr[4];
#pragma unroll
        for (int mi = 0; mi < MI; mi++) af[mi] = *(const bf16x8*)(Ag + (long)(arow0 + mi * 16 + lr) * 128 + ks * 32 + lq * 8);
#pragma unroll
        for (int ni = 0; ni < 4; ni++) {
            const char* bp = ximg + (ks * 32 + lq * 8) * 272 + (ncol0 + ni * 16 + lr) * 2;
#pragma unroll
            for (int j = 0; j < 8; j++) bfr[ni][j] = *(const short*)(bp + j * 272);
        }
#pragma unroll
        for (int mi = 0; mi < MI; mi++)
#pragma unroll
            for (int ni = 0; ni < 4; ni++) acc[mi][ni] = __builtin_amdgcn_mfma_f32_16x16x32_bf16(bfr[ni], af[mi], acc[mi][ni], 0, 0, 0);
    }
}

__device__ __forceinline__ void f2a_item(const Params& p, int it, char* lds) {
    const int tid = threadIdx.x, lane = tid & 63, wid = tid >> 6, wm = wid >> 1, wn = wid & 1, lq = lane >> 4, lr = lane & 15;
    const int nc = it & 3, s2 = (it >> 2) & 63, b = it >> 8;
    char* uimg = lds; char* ximg = lds + 17408;
    __syncthreads();
#pragma unroll
    for (int i = 0; i < 4; i++) {
        const int ci = tid + 256 * i, row = ci >> 4, cc = ci & 15;
        *(u32x4*)(uimg + row * 272 + cc * 16) = *(const u32x4*)(wsp<bf16_t>(p, OFF_UF) + ((long)(b * NS + 64 * row + s2)) * 512 + nc * 128 + cc * 8);
    }
    __syncthreads();
    {
        const int g2 = wid >> 1, T = wid & 1;
        f32x4 a1[4][4];
#pragma unroll
        for (int mi = 0; mi < 4; mi++)
#pragma unroll
            for (int ni = 0; ni < 4; ni++) a1[mi][ni] = (f32x4){0.f, 0.f, 0.f, 0.f};
        const bf16_t* t64 = wsp<bf16_t>(p, OFF_T64) + T * 4096;
#pragma unroll
        for (int ks = 0; ks < 2; ks++) {
            bf16x8 af[4], bfr[4];
#pragma unroll
            for (int i = 0; i < 4; i++) {
                af[i] = *(const bf16x8*)(uimg + (i * 16 + lr) * 272 + (g2 * 64 + ks * 32 + lq * 8) * 2);
                bfr[i] = *(const bf16x8*)(t64 + (i * 16 + lr) * 64 + ks * 32 + lq * 8);
            }
#pragma unroll
            for (int mi = 0; mi < 4; mi++)
#pragma unroll
                for (int ni = 0; ni < 4; ni++) a1[mi][ni] = __builtin_amdgcn_mfma_f32_16x16x32_bf16(bfr[ni], af[mi], a1[mi][ni], 0, 0, 0);
        }
#pragma unroll
        for (int mi = 0; mi < 4; mi++)
#pragma unroll
            for (int ni = 0; ni < 4; ni++)
                *(u32x2*)(ximg + (T * 64 + mi * 16 + lr) * 272 + (g2 * 64 + ni * 16 + 4 * lq) * 2) = pack4bf(a1[mi][ni]);
    }
    __syncthreads();
    f32x4 acc[4][4];
#pragma unroll
    for (int mi = 0; mi < 4; mi++)
#pragma unroll
        for (int ni = 0; ni < 4; ni++) acc[mi][ni] = (f32x4){0.f, 0.f, 0.f, 0.f};
    dft_mma<4>(wsp<bf16_t>(p, OFF_M1), wm * 64, ximg, wn * 64, acc);
    const float2* tw = wsp<float2>(p, OFF_TW);
#pragma unroll
    for (int m2 = 0; m2 < 2; m2++) {
        const int k1 = 32 * wm + 16 * m2 + lr;
        float2 cs; { const float rev = (float)((s2 * k1) & 4095) * (1.0f / 4096.0f); cs.x = __builtin_amdgcn_cosf(rev); cs.y = __builtin_amdgcn_sinf(rev); (void)tw; }
        const long base = ((long)(b * 64 + k1) * 64 + s2) * 512 + nc * 128 + wn * 64 + 4 * lq;
#pragma unroll
        for (int ni = 0; ni < 4; ni++) {
            const f32x4 yr = acc[m2][ni], yi = acc[m2 + 2][ni];
            const f32x4 orr = yr * cs.x - yi * cs.y, oi = yi * cs.x + yr * cs.y;
            *(u32x2*)(wsp<bf16_t>(p, OFF_YR) + base + ni * 16) = pack4bf(orr);
            *(u32x2*)(wsp<bf16_t>(p, OFF_YI) + base + ni * 16) = pack4bf(oi);
        }
    }
}

__device__ __forceinline__ void f2b_item(const Params& p, int it, char* lds) {
    const int tid = threadIdx.x, lane = tid & 63, wid = tid >> 6, wm = wid >> 1, wn = wid & 1, lq = lane >> 4, lr = lane & 15;
    const int nc = it & 3, k1 = (it >> 2) & 63, b = it >> 8;
    char* ximg = lds; char* zimg = lds + 34816;
    __syncthreads();
#pragma unroll
    for (int i = 0; i < 8; i++) {
        const int ci = tid + 256 * i, row = ci >> 4, cc = ci & 15;
        const bf16_t* src = (row < 64 ? wsp<bf16_t>(p, OFF_YR) : wsp<bf16_t>(p, OFF_YI)) + ((long)(b * 64 + k1) * 64 + (row & 63)) * 512 + nc * 128 + cc * 8;
        *(u32x4*)(ximg + row * 272 + cc * 16) = *(const u32x4*)src;
    }
    __syncthreads();
    f32x4 acc[2][4];
#pragma unroll
    for (int mi = 0; mi < 2; mi++)
#pragma unroll
        for (int ni = 0; ni < 4; ni++) acc[mi][ni] = (f32x4){0.f, 0.f, 0.f, 0.f};
    dft_mma<2>(wsp<bf16_t>(p, OFF_M3), wm * 32, ximg, wn * 64, acc);
#pragma unroll
    for (int mi = 0; mi < 2; mi++)
#pragma unroll
        for (int ni = 0; ni < 4; ni++)
            *(u32x2*)(zimg + (wm * 32 + mi * 16 + lr) * 272 + (wn * 64 + ni * 16 + 4 * lq) * 2) = pack4bf(acc[mi][ni] * (1.0f / 512.0f));
    __syncthreads();
    f32x4 a3[2][4];
#pragma unroll
    for (int mi = 0; mi < 2; mi++)
#pragma unroll
        for (int ni = 0; ni < 4; ni++) a3[mi][ni] = (f32x4){0.f, 0.f, 0.f, 0.f};
    const bf16_t* wft = wsp<bf16_t>(p, OFF_WFT) + (long)(nc * 2 + wn) * 4096;
#pragma unroll
    for (int ks = 0; ks < 2; ks++) {
        bf16x8 af[2], bfr[4];
#pragma unroll
        for (int i = 0; i < 2; i++) af[i] = *(const bf16x8*)(zimg + (wm * 32 + i * 16 + lr) * 272 + (wn * 64 + ks * 32 + lq * 8) * 2);
#pragma unroll
        for (int i = 0; i < 4; i++) bfr[i] = *(const bf16x8*)(wft + (i * 16 + lr) * 64 + ks * 32 + lq * 8);
#pragma unroll
        for (int mi = 0; mi < 2; mi++)
#pragma unroll
            for (int ni = 0; ni < 4; ni++) a3[mi][ni] = __builtin_amdgcn_mfma_f32_16x16x32_bf16(bfr[ni], af[mi], a3[mi][ni], 0, 0, 0);
    }
#pragma unroll
    for (int mi = 0; mi < 2; mi++) {
        const int k2 = wm * 32 + mi * 16 + lr;
        bf16_t* dst = wsp<bf16_t>(p, OFF_ZA) + ((long)(b * NS + k1 + 64 * k2)) * 1024 + nc * 128 + wn * 64 + 4 * lq;
#pragma unroll
        for (int ni = 0; ni < 4; ni++) *(u32x2*)(dst + ni * 16) = pack4bf(a3[mi][ni]);
    }
}

__device__ __forceinline__ void phase2(const Params& p, char* lds) {
    const int tid = threadIdx.x, lane = tid & 63, wid = tid >> 6, wm = wid >> 1, wn = wid & 1, lq = lane >> 4, lr = lane & 15;
    constexpr int N_Q = 128 * 6, N_KV = 128 * 8, N_F = 1024;
    for (int item = blockIdx.x; item < N_Q + N_KV + N_F; item += gridDim.x) {
        f32x4 acc[4][4];
        if (item < N_Q) {
            const int tm = item / 6, tn = item % 6;
            GemmTile g; g.A = wsp<bf16_t>(p, OFF_UQ) + (long)tm * 128 * 384; g.lda = 384; g.arow = nullptr;
            g.Bt = wsp<bf16_t>(p, OFF_WQT) + (long)tn * 128 * 384; g.ldb = 384; g.K = 384;
            gemm_tile_128(g, lds, acc);
            const float qmul = 0.10206207261596575f * 1.4426950408889634f;
#pragma unroll
            for (int mi = 0; mi < 4; mi++) {
                const int row = tm * 128 + wm * 64 + mi * 16 + lr;
                const int b = row >> 12, s = row & 4095;
                const float* sq = wsp<float>(p, OFF_SSQ) + (long)row * 6;
                const float ss = sq[0] + sq[1] + sq[2] + sq[3] + sq[4] + sq[5];
                const float rs = rsqrtf(ss * (1.f / 384.f) + 1e-6f) * qmul;
                const int cb0 = tn * 128 + wn * 64;
#pragma unroll
                for (int ni = 0; ni < 4; ni++) {
                    const int cb = cb0 + ni * 16, hd = cb / 96, hob = cb % 96;
                    bf16_t* qd = wsp<bf16_t>(p, OFF_Q) + ((long)(b * 8 + hd) * NS + s) * 96;
                    if (hob < 64) {
                        *(u32x2*)(qd + hob + 4 * lq) = pack4bf(acc[mi][ni] * rs);
                    } else if (hob == 64) {
                        if (ni < 3) {
                            const float2* rp = wsp<float2>(p, OFF_ROPE) + (long)row * 16 + 4 * lq;
                            f32x4 o1, o2;
#pragma unroll
                            for (int r = 0; r < 4; r++) {
                                const float2 cs = rp[r];
                                const float x1 = acc[mi][ni][r] * rs, x2 = acc[mi][ni < 3 ? ni + 1 : 3][r] * rs;
                                o1[r] = x1 * cs.x - x2 * cs.y; o2[r] = x1 * cs.y + x2 * cs.x;
                            }
                            *(u32x2*)(qd + 64 + 4 * lq) = pack4bf(o1);
                            *(u32x2*)(qd + 80 + 4 * lq) = pack4bf(o2);
                        }
                    }
                }
            }
        } else if (item < N_Q + N_KV) {
            const int it = item - N_Q, tm = it >> 3, hd = it & 7;
            GemmTile g; g.A = wsp<bf16_t>(p, OFF_UKV) + (long)tm * 128 * 256; g.lda = 256; g.arow = nullptr;
            g.Bt = wsp<bf16_t>(p, OFF_WKVT) + (long)hd * 128 * 256; g.ldb = 256; g.K = 256;
            gemm_tile_128(g, lds, acc);
#pragma unroll
            for (int mi = 0; mi < 4; mi++) {
                const int row = tm * 128 + wm * 64 + mi * 16 + lr;
                const int b = row >> 12, s = row & 4095;
                const float* sq = wsp<float>(p, OFF_SSKV) + (long)row * 4;
                const float rs = rsqrtf((sq[0] + sq[1] + sq[2] + sq[3]) * (1.f / 256.f) + 1e-6f);
                if (wn == 0) {
                    bf16_t* kd = wsp<bf16_t>(p, OFF_K) + ((long)(b * 8 + hd) * NS + s) * 96;
#pragma unroll
                    for (int ni = 0; ni < 4; ni++) *(u32x2*)(kd + ni * 16 + 4 * lq) = pack4bf(acc[mi][ni] * rs);
                } else {
#pragma unroll
                    for (int ni = 0; ni < 4; ni++) {
                        bf16_t* vd = wsp<bf16_t>(p, OFF_VT) + ((long)(b * 8 + hd) * 64 + ni * 16 + 4 * lq) * NS + s;
#pragma unroll
                        for (int r = 0; r < 4; r++) vd[(long)r * NS] = (bf16_t)f2bf(acc[mi][ni][r] * rs);
                    }
                }
            }
#pragma unroll
            for (int i = 0; i < 2; i++) {
                const int ci = tid + 256 * i, r = ci >> 2, cc = ci & 3;
                const int row = tm * 128 + r, b = row >> 12, s = row & 4095;
                *(u32x4*)(wsp<bf16_t>(p, OFF_K) + ((long)(b * 8 + hd) * NS + s) * 96 + 64 + cc * 8) = *(const u32x4*)(wsp<bf16_t>(p, OFF_KR) + (long)row * 32 + cc * 8);
            }
        } else {
            f2a_item(p, item - N_Q - N_KV, lds);
        }
    }
}

__device__ __forceinline__ void phase3(const Params& p, char* lds) {
    constexpr int N_A = NB * 8 * (NS / 128), N_F = 1024;
    for (int item = blockIdx.x; item < N_A + N_F; item += gridDim.x) {
        if (item < N_A) {
            const int qt = item & 31, h = (item >> 5) & 7, b = item >> 8;
            const bf16_t* Qp = wsp<bf16_t>(p, OFF_Q) + ((long)(b * 8 + h) * NS + qt * 128) * 96;
            const bf16_t* Kp = wsp<bf16_t>(p, OFF_K) + ((long)(b * 8 + h) * NS) * 96;
            const bf16_t* Vtp = wsp<bf16_t>(p, OFF_VT) + ((long)(b * 8 + h) * 64) * NS;
            bf16_t* Op = wsp<bf16_t>(p, OFF_ZA) + ((long)b * NS + qt * 128) * 1024 + 512 + h * 64;
            attn_block<96, 64, 64>(Qp, Kp, Vtp, (long)NS, NS, lds, [&](int q, int dv, f32x4 v) { *(u32x2*)(Op + (long)q * 1024 + dv) = pack4bf(v); });
        } else {
            f2b_item(p, item - N_A, lds);
        }
    }
}

__device__ __forceinline__ void phase_resid(const Params& p, char* lds, size_t offA, size_t offW, const float* resid, size_t offXb, size_t offSS) {
    const int tid = threadIdx.x, lane = tid & 63, wid = tid >> 6, wm = wid >> 1, wn = wid & 1, lq = lane >> 4, lr = lane & 15;
    for (int item = blockIdx.x; item < 128 * 8; item += gridDim.x) {
        const int tm = item >> 3, tn = item & 7;
        f32x4 acc[4][4];
        GemmTile g; g.A = wsp<bf16_t>(p, offA) + (long)tm * 128 * ND; g.lda = ND; g.arow = nullptr;
        g.Bt = wsp<bf16_t>(p, offW) + (long)tn * 128 * ND; g.ldb = ND; g.K = ND;
        gemm_tile_128(g, lds, acc);
#pragma unroll
        for (int mi = 0; mi < 4; mi++) {
            const int row = tm * 128 + wm * 64 + mi * 16 + lr;
            float ss = 0.f;
#pragma unroll
            for (int ni = 0; ni < 4; ni++) {
                const long o = (long)row * ND + tn * 128 + wn * 64 + ni * 16 + 4 * lq;
                const f32x4 v = *(const f32x4*)(resid + o) + acc[mi][ni];
                *(f32x4*)(p.out + o) = v;
                *(u32x2*)(wsp<bf16_t>(p, offXb) + o) = pack4bf(v);
                ss += v[0] * v[0] + v[1] * v[1] + v[2] * v[2] + v[3] * v[3];
            }
            ss += __shfl_xor(ss, 16); ss += __shfl_xor(ss, 32);
            if (lq == 0) wsp<float>(p, offSS)[row * 16 + tn * 2 + wn] = ss;
        }
    }
}
__device__ __forceinline__ float row_rs16(const float* ss) {
    const f32x4 a = *(const f32x4*)ss, b = *(const f32x4*)(ss + 4), c = *(const f32x4*)(ss + 8), d = *(const f32x4*)(ss + 12);
    const f32x4 t = (a + b) + (c + d);
    return rsqrtf(((t[0] + t[1]) + (t[2] + t[3])) * (1.f / 1024.f) + 1e-6f);
}

__device__ __forceinline__ void phase5a(const Params& p, char* lds) {
    const int tid = threadIdx.x, lane = tid & 63, wid = tid >> 6, wm = wid >> 1, wn = wid & 1, lq = lane >> 4, lr = lane & 15;
    for (int item = blockIdx.x; item < 128 * 8; item += gridDim.x) {
        const int tm = item >> 3, tn = item & 7;
        f32x4 acc[4][4];
        GemmTile g; g.A = wsp<bf16_t>(p, OFF_X1B) + (long)tm * 128 * ND; g.lda = ND; g.arow = nullptr;
        g.Bt = wsp<bf16_t>(p, OFF_WMQT) + (long)tn * 128 * ND; g.ldb = ND; g.K = ND;
        gemm_tile_128(g, lds, acc);
        const int h = tn >> 1;
#pragma unroll
        for (int mi = 0; mi < 4; mi++) {
            const int row = tm * 128 + wm * 64 + mi * 16 + lr, b = row >> 12, s = row & 4095;
            const float rs = row_rs16(wsp<float>(p, OFF_SS1) + (long)row * 16) * (0.0625f * 1.4426950408889634f);
            bf16_t* qd = wsp<bf16_t>(p, OFF_QM) + ((long)(b * 4 + h) * NS + s) * 256 + (tn & 1) * 128 + wn * 64 + 4 * lq;
#pragma unroll
            for (int ni = 0; ni < 4; ni++) *(u32x2*)(qd + ni * 16) = pack4bf(acc[mi][ni] * rs);
        }
    }
}
__device__ __forceinline__ void phase5b(const Params& p, char* lds) {
    for (int item = blockIdx.x; item < NB * 4 * 32 * 2; item += gridDim.x) {
        const int dvh = item & 1, qt = (item >> 1) & 31, h = (item >> 6) & 3, b = item >> 8;
        const bf16_t* Qp = wsp<bf16_t>(p, OFF_QM) + ((long)(b * 4 + h) * NS + qt * 128) * 256;
        const bf16_t* Kp = wsp<bf16_t>(p, OFF_KMEM) + ((long)(b * 4 + h) * 256) * 256;
        const bf16_t* Vtp = wsp<bf16_t>(p, OFF_VTMEM) + ((long)(b * 4 + h) * 256 + dvh * 128) * 256;
        bf16_t* Op = wsp<bf16_t>(p, OFF_OM) + ((long)b * NS + qt * 128) * 1024 + h * 256 + dvh * 128;
        attn_block<256, 128, 32>(Qp, Kp, Vtp, 256L, 256, lds, [&](int q, int dv, f32x4 v) { *(u32x2*)(Op + (long)q * 1024 + dv) = pack4bf(v); });
    }
}

__device__ __forceinline__ void phase7(const Params& p, char* lds) {
    const int tid = threadIdx.x, lane = tid & 63, wid = tid >> 6;
    float* wr = (float*)lds;
    __syncthreads();
    for (int i = tid; i < 16384; i += 256) { const int k = i >> 4, e = i & 15; wr[e * 1024 + k] = p.w_router[i] * p.g_ffn[k]; }
    __syncthreads();
    for (int tok = blockIdx.x * 4 + wid; tok < NT; tok += gridDim.x * 4) {
        const float* xr = p.out + (long)tok * ND;
        float a[16];
#pragma unroll
        for (int e = 0; e < 16; e++) a[e] = 0.f;
#pragma unroll 4
        for (int j = 0; j < 16; j++) {
            const float xv = xr[lane + 64 * j];
#pragma unroll
            for (int e = 0; e < 16; e++) a[e] += xv * wr[e * 1024 + lane + 64 * j];
        }
#pragma unroll
        for (int i = 0; i < 8; i++) { const bool hi = lane & 32; const float send = hi ? a[i] : a[i + 8], keep = hi ? a[i + 8] : a[i]; a[i] = keep + __shfl_xor(send, 32); }
#pragma unroll
        for (int i = 0; i < 4; i++) { const bool hi = lane & 16; const float send = hi ? a[i] : a[i + 4], keep = hi ? a[i + 4] : a[i]; a[i] = keep + __shfl_xor(send, 16); }
#pragma unroll
        for (int i = 0; i < 2; i++) { const bool hi = lane & 8; const float send = hi ? a[i] : a[i + 2], keep = hi ? a[i + 2] : a[i]; a[i] = keep + __shfl_xor(send, 8); }
        { const bool hi = lane & 4; const float send = hi ? a[0] : a[1], keep = hi ? a[1] : a[0]; a[0] = keep + __shfl_xor(send, 4); }
        float lg = a[0];
        lg += __shfl_xor(lg, 2); lg += __shfl_xor(lg, 1);
        const int e = ((lane >> 5) & 1) * 8 + ((lane >> 4) & 1) * 4 + ((lane >> 3) & 1) * 2 + ((lane >> 2) & 1);
        lg *= row_rs16(wsp<float>(p, OFF_SS2) + (long)tok * 16);
        float mx = lg;
#pragma unroll
        for (int o = 4; o < 64; o <<= 1) mx = fmaxf(mx, __shfl_xor(mx, o));
        const float ex = expf(lg - mx);
        float sm = ex;
#pragma unroll
        for (int o = 4; o < 64; o <<= 1) sm += __shfl_xor(sm, o);
        if ((lane & 3) == 0) wsp<float>(p, OFF_AFF)[(long)tok * 16 + e] = ex / sm;
    }
}

__device__ __forceinline__ int block_sum_i(int v, int* red) {
    const int lane = threadIdx.x & 63, wid = threadIdx.x >> 6;
#pragma unroll
    for (int o = 32; o > 0; o >>= 1) v += __shfl_xor(v, o);
    __syncthreads();
    if (lane == 0) red[wid] = v;
    __syncthreads();
    return red[0] + red[1] + red[2] + red[3];
}
__device__ __forceinline__ int block_excl_scan_i(int v, int* red, int& total) {
    const int lane = threadIdx.x & 63, wid = threadIdx.x >> 6;
    int inc = v;
#pragma unroll
    for (int o = 1; o < 64; o <<= 1) { const int t = __shfl_up(inc, o); if (lane >= o) inc += t; }
    __syncthreads();
    if (lane == 63) red[wid] = inc;
    __syncthreads();
    int base = 0;
#pragma unroll
    for (int w = 0; w < 4; w++) if (w < wid) base += red[w];
    total = red[0] + red[1] + red[2] + red[3];
    return base + inc - v;
}
__device__ __forceinline__ void phase8(const Params& p, char* lds) {
    int* red = (int*)lds;
    const int tid = threadIdx.x;
    for (int item = blockIdx.x; item < NB * NE; item += gridDim.x) {
        const int e = item & 15, b = item >> 4;
        const float* aff = wsp<float>(p, OFF_AFF) + (long)b * NS * 16 + e;
        unsigned v[16];
#pragma unroll
        for (int i = 0; i < 16; i++) v[i] = __float_as_uint(aff[(long)(tid * 16 + i) * 16]);
        unsigned T = 0;
        for (int bit = 30; bit >= 0; bit--) {
            const unsigned cand = T | (1u << bit);
            int c = 0;
#pragma unroll
            for (int i = 0; i < 16; i++) c += (v[i] >= cand) ? 1 : 0;
            if (block_sum_i(c, red) >= CAP) T = cand;
        }
        int cg = 0, ce = 0;
#pragma unroll
        for (int i = 0; i < 16; i++) { cg += (v[i] > T) ? 1 : 0; ce += (v[i] == T) ? 1 : 0; }
        int tot;
        const int pk = block_excl_scan_i(cg | (ce << 16), red, tot);
        const int need = CAP - (tot & 0xFFFF);
        const int pe = pk >> 16;
        int nse = need - pe; nse = nse < 0 ? 0 : (nse > ce ? ce : nse);
        int tot2;
        int slot = block_excl_scan_i(cg + nse, red, tot2);
        int* slots = wsp<int>(p, OFF_SLOTS) + (long)(b * NE + e) * NS;
        int* idx = wsp<int>(p, OFF_IDX) + (long)(b * NE + e) * CAP;
        float* gate = wsp<float>(p, OFF_GATE) + (long)(b * NE + e) * CAP;
        int eqs = 0;
#pragma unroll
        for (int i = 0; i < 16; i++) {
            const int t = tid * 16 + i;
            bool sel = v[i] > T;
            if (v[i] == T) { sel = eqs < nse; eqs++; }
            if (sel) { slots[t] = slot; idx[slot] = b * NS + t; gate[slot] = __uint_as_float(v[i]); slot++; }
            else slots[t] = -1;
        }
    }
}

__device__ __forceinline__ void phase9(const Params& p, char* lds) {
    const int tid = threadIdx.x, lane = tid & 63, wid = tid >> 6, wm = wid >> 1, wn = wid & 1, lq = lane >> 4, lr = lane & 15;
    for (int item = blockIdx.x; item < NE * 16 * NB * 4; item += gridDim.x) {
        const int rt = item & 3, b = (item >> 2) & 3, ct = (item >> 4) & 15, e = item >> 8;
        const int* arow = wsp<int>(p, OFF_IDX) + (long)(b * NE + e) * CAP + rt * 128;
        f32x4 acc[4][4];
        GemmTile g; g.A = wsp<bf16_t>(p, OFF_X2B); g.lda = ND; g.arow = arow;
        g.Bt = wsp<bf16_t>(p, OFF_WGUT) + ((long)e * 2048 + ct * 128) * ND; g.ldb = ND; g.K = ND;
        gemm_tile_128(g, lds, acc);
#pragma unroll
        for (int mi = 0; mi < 4; mi++) {
            const int r = wm * 64 + mi * 16 + lr;
            const int tok = arow[r];
            const float rs = row_rs16(wsp<float>(p, OFF_SS2) + (long)tok * 16);
            bf16_t* ad = wsp<bf16_t>(p, OFF_ACT) + ((long)(e * NB + b) * CAP + rt * 128 + r) * ND + ct * 64 + wn * 32 + 4 * lq;
#pragma unroll
            for (int pp = 0; pp < 2; pp++) {
                f32x4 o;
#pragma unroll
                for (int q = 0; q < 4; q++) {
                    const float ga = acc[mi][2 * pp][q] * rs, up = acc[mi][2 * pp + 1][q] * rs;
                    o[q] = ga / (1.f + __expf(-ga)) * up;
                }
                *(u32x2*)(ad + pp * 16) = pack4bf(o);
            }
        }
    }
}
__device__ __forceinline__ void phase10(const Params& p, char* lds) {
    const int tid = threadIdx.x, lane = tid & 63, wid = tid >> 6, wm = wid >> 1, wn = wid & 1, lq = lane >> 4, lr = lane & 15;
    for (int item = blockIdx.x; item < NE * 8 * NB * 4; item += gridDim.x) {
        const int rt = item & 3, b = (item >> 2) & 3, ct = (item >> 4) & 7, e = item >> 7;
        const long row0 = (long)(e * NB + b) * CAP + rt * 128;
        f32x4 acc[4][4];
        GemmTile g; g.A = wsp<bf16_t>(p, OFF_ACT) + row0 * ND; g.lda = ND; g.arow = nullptr;
        g.Bt = wsp<bf16_t>(p, OFF_WDT) + ((long)e * 1024 + ct * 128) * ND; g.ldb = ND; g.K = ND;
        gemm_tile_128(g, lds, acc);
        const float* gate = wsp<float>(p, OFF_GATE) + (long)(b * NE + e) * CAP + rt * 128;
#pragma unroll
        for (int mi = 0; mi < 4; mi++) {
            const int r = wm * 64 + mi * 16 + lr;
            const float gv = gate[r];
            bf16_t* yd = wsp<bf16_t>(p, OFF_Y) + (row0 + r) * ND + ct * 128 + wn * 64 + 4 * lq;
#pragma unroll
            for (int ni = 0; ni < 4; ni++) *(u32x2*)(yd + ni * 16) = pack4bf(acc[mi][ni] * gv);
        }
    }
}

__device__ __forceinline__ void phase11(const Params& p, char* lds) {
    const int tid = threadIdx.x, lane = tid & 63, wid = tid >> 6;
    for (int tok = blockIdx.x * 4 + wid; tok < NT; tok += gridDim.x * 4) {
        const int b = tok >> 12, t = tok & 4095;
        float* xr = p.out + (long)tok * ND;
        f32x4 v[4];
#pragma unroll
        for (int i = 0; i < 4; i++) v[i] = *(const f32x4*)(xr + i * 256 + lane * 4);
        for (int e = 0; e < NE; e++) {
            const int sl = wsp<int>(p, OFF_SLOTS)[(long)(b * NE + e) * NS + t];
            if (sl >= 0) {
                const bf16_t* yr = wsp<bf16_t>(p, OFF_Y) + ((long)(e * NB + b) * CAP + sl) * ND;
#pragma unroll
                for (int i = 0; i < 4; i++) {
                    const u32x2 w = *(const u32x2*)(yr + i * 256 + lane * 4);
                    v[i][0] += __uint_as_float(w.x << 16); v[i][1] += __uint_as_float(w.x & 0xFFFF0000u);
                    v[i][2] += __uint_as_float(w.y << 16); v[i][3] += __uint_as_float(w.y & 0xFFFF0000u);
                }
            }
        }
        float ss = 0.f;
#pragma unroll
        for (int i = 0; i < 4; i++) ss += v[i][0] * v[i][0] + v[i][1] * v[i][1] + v[i][2] * v[i][2] + v[i][3] * v[i][3];
        ss = wave_sum(ss);
        const float rs = rsqrtf(ss * (1.f / ND) + 1e-6f);
#pragma unroll
        for (int i = 0; i < 4; i++) {
            const f32x4 gf = *(const f32x4*)(p.g_final + i * 256 + lane * 4);
            *(f32x4*)(xr + i * 256 + lane * 4) = v[i] * rs * gf;
        }
    }
}

__global__ void __launch_bounds__(256, 2) k_fwd(Params p, int ph_lo, int ph_hi) {
    extern __shared__ __attribute__((aligned(16))) char lds[];
    volatile LAS unsigned* st = (volatile LAS unsigned*)(lds + LDS_MAIN);
    if (threadIdx.x == 0) { st[0] = 0u; st[1] = 0u; }
    __syncthreads();
    XcdBarrier bar = xcd_barrier_post(wsp<unsigned>(p, OFF_BAR), st);
#if USE_CG_SYNC
#define GRID_BARRIER() do { asm volatile("s_waitcnt vmcnt(0)" ::: "memory"); __syncthreads(); cg::this_grid().sync(); asm volatile("s_waitcnt vmcnt(0)" ::: "memory"); __syncthreads(); } while (0)
#else
#define GRID_BARRIER() xcd_barrier(bar)
#endif
#define RUN_PHASE(k, call) if (ph_lo <= (k) && (k) < ph_hi) { if ((k) > ph_lo) { GRID_BARRIER(); } call; }
    RUN_PHASE(0, phase0(p, lds))
    RUN_PHASE(1, phase1(p, lds))
    RUN_PHASE(2, phase2(p, lds))
    RUN_PHASE(3, phase3(p, lds))
    RUN_PHASE(4, phase_resid(p, lds, OFF_ZA, OFF_WOUTT, p.x, OFF_X1B, OFF_SS1))
    RUN_PHASE(5, phase5a(p, lds))
    RUN_PHASE(6, phase5b(p, lds))
    RUN_PHASE(7, phase_resid(p, lds, OFF_OM, OFF_WMOT, p.out, OFF_X2B, OFF_SS2))
    RUN_PHASE(8, phase7(p, lds))
    RUN_PHASE(9, phase8(p, lds))
    RUN_PHASE(10, phase9(p, lds))
    RUN_PHASE(11, phase10(p, lds))
    RUN_PHASE(12, phase11(p, lds))
}

extern "C" void kernel_launch(void* const* d_in, const int* in_sizes, int n_in,
                              void* d_out, int out_size, void* d_ws, size_t ws_size,
                              hipStream_t stream) {
    static int grid = 0;
    if (grid == 0) {
        if (n_in != 22 || ws_size < WS_END) { fprintf(stderr, "kernel_launch: unexpected inputs (n_in %d, ws %zu < %zu)\n", n_in, ws_size, (size_t)WS_END); grid = -1; return; }
        int dev = 0, cus = 0, per_cu = 0;
        (void)hipGetDevice(&dev);
        (void)hipDeviceGetAttribute(&cus, hipDeviceAttributeMultiprocessorCount, dev);
        if (hipFuncSetAttribute((const void*)k_fwd, hipFuncAttributeMaxDynamicSharedMemorySize, LDS_TOTAL) != hipSuccess) { fprintf(stderr, "kernel_launch: hipFuncSetAttribute failed\n"); grid = -1; return; }
        if (hipOccupancyMaxActiveBlocksPerMultiprocessor(&per_cu, (const void*)k_fwd, 256, LDS_TOTAL) != hipSuccess || per_cu < 1) { fprintf(stderr, "kernel_launch: occupancy query failed (%d)\n", per_cu); (void)hipGetLastError(); per_cu = 1; }
        if (per_cu > 2) per_cu = 2;
        grid = cus * per_cu;
        fprintf(stderr, "kernel_launch: %d CUs x %d blocks\n", cus, per_cu);
    }
    if (grid < 0) return;
    Params p{};
    p.x = (const float*)d_in[0]; p.mem = (const float*)d_in[1]; p.pos = (const int*)d_in[2];
    p.g_mix = (const float*)d_in[3]; p.w_in = (const float*)d_in[4]; p.g_q_lat = (const float*)d_in[5]; p.w_q_up = (const float*)d_in[6];
    p.g_kv_lat = (const float*)d_in[7]; p.w_kv_up = (const float*)d_in[8]; p.w_fourier = (const float*)d_in[9]; p.w_out = (const float*)d_in[10];
    p.g_mem_q = (const float*)d_in[11]; p.g_mem_kv = (const float*)d_in[12]; p.w_mem_q = (const float*)d_in[13]; p.w_mem_kv = (const float*)d_in[14];
    p.w_mem_o = (const float*)d_in[15]; p.g_ffn = (const float*)d_in[16]; p.w_router = (const float*)d_in[17];
    p.w_exp_gate = (const float*)d_in[18]; p.w_exp_up = (const float*)d_in[19]; p.w_exp_down = (const float*)d_in[20]; p.g_final = (const float*)d_in[21];
    p.out = (float*)d_out; p.ws = (char*)d_ws;
    static const int cuts[] = MK_CUTS;
    const int ncut = (int)(sizeof(cuts) / sizeof(int));
    for (int li = 0; li + 1 < ncut; li++) {
        (void)hipMemsetAsync((char*)d_ws + OFF_BAR, 0, 16384, stream);
        int lo = cuts[li], hi = cuts[li + 1];
        void* args[] = {&p, &lo, &hi};
        hipError_t e = hipLaunchCooperativeKernel((const void*)k_fwd, dim3(grid), dim3(256), args, LDS_TOTAL, stream);
        if (e != hipSuccess) fprintf(stderr, "cooperative launch failed: %s (grid %d)\n", hipGetErrorString(e), grid);
    }
}
```

```cpp
#include <hip/hip_runtime.h>
#include <stdint.h>
#include <cstdio>
#include <hip/hip_cooperative_groups.h>
namespace cg = cooperative_groups;
#ifndef USE_CG_SYNC
#define USE_CG_SYNC 0
#endif

#ifndef MK_CUTS
#define MK_CUTS {0, 13}
#endif

#define NB 4
#define NS 4096
#define ND 1024
#define NT (NB * NS)
#define INW 1184
#define NE 16
#define CAP 512
#define MEML 256
#define NPHASE 13

typedef unsigned short bf16_t;
typedef short bf16x8 __attribute__((ext_vector_type(8)));
typedef float f32x4 __attribute__((ext_vector_type(4)));
typedef float f32x16 __attribute__((ext_vector_type(16)));
typedef unsigned u32x4 __attribute__((ext_vector_type(4)));
typedef unsigned u32x2 __attribute__((ext_vector_type(2)));

__device__ __forceinline__ unsigned f2bf(float f) {
    unsigned u = __float_as_uint(f);
    u += 0x7FFFu + ((u >> 16) & 1u);
    return u >> 16;
}
typedef __bf16 hbf2 __attribute__((ext_vector_type(2)));
typedef float f32x2 __attribute__((ext_vector_type(2)));
__device__ __forceinline__ unsigned pack2bf(float lo, float hi) { f32x2 v = {lo, hi}; return __builtin_bit_cast(unsigned, __builtin_convertvector(v, hbf2)); }
__device__ __forceinline__ float bf2f(unsigned short b) { return __uint_as_float(((unsigned)b) << 16); }

__device__ __forceinline__ int tile_off(int row, int chunk) { return row * 128 + ((chunk ^ ((row >> 1) & 7)) << 4); }

#define GT_LDS_BYTES 65536

struct GemmTile { const bf16_t* A; long lda; const int* arow; const bf16_t* Bt; long ldb; int K; };

__device__ __forceinline__ void gemm_tile_128(const GemmTile& g, char* lds, f32x4 (&acc)[4][4]) {
    const int tid = threadIdx.x, lane = tid & 63, wid = tid >> 6, wm = wid >> 1, wn = wid & 1;
    const int lrow = lane >> 3, pc = lane & 7;
    const bf16_t* ap[4]; const bf16_t* bp[4];
#pragma unroll
    for (int i = 0; i < 4; i++) {
        const int r = (wid * 4 + i) * 8 + lrow;
        const int c = pc ^ ((r >> 1) & 7);
        const long ro = g.arow ? (long)g.arow[r] * g.lda : (long)r * g.lda;
        ap[i] = g.A + ro + c * 8;
        bp[i] = g.Bt + (long)r * g.ldb + c * 8;
    }
#pragma unroll
    for (int mi = 0; mi < 4; mi++)
#pragma unroll
        for (int ni = 0; ni < 4; ni++) acc[mi][ni] = (f32x4){0.f, 0.f, 0.f, 0.f};
    const int nk = g.K >> 6;
    auto stage = [&](int kt, char* st) {
#pragma unroll
        for (int i = 0; i < 4; i++) {
            __builtin_amdgcn_global_load_lds((const unsigned*)(ap[i] + kt * 64), (unsigned*)(st + (wid * 4 + i) * 1024), 16, 0, 0);
            __builtin_amdgcn_global_load_lds((const unsigned*)(bp[i] + kt * 64), (unsigned*)(st + 16384 + (wid * 4 + i) * 1024), 16, 0, 0);
        }
    };
    __syncthreads();
    stage(0, lds);
    asm volatile("s_waitcnt vmcnt(0)" ::: "memory");
    __syncthreads();
    for (int kt = 0; kt < nk; kt++) {
        char* cur = lds + (kt & 1) * 32768;
        if (kt + 1 < nk) stage(kt + 1, lds + ((kt + 1) & 1) * 32768);
#pragma unroll
        for (int ks = 0; ks < 2; ks++) {
            bf16x8 af[4], bfr[4];
#pragma unroll
            for (int i = 0; i < 4; i++) {
                af[i] = *(const bf16x8*)(cur + tile_off(wm * 64 + i * 16 + (lane & 15), ks * 4 + (lane >> 4)));
                bfr[i] = *(const bf16x8*)(cur + 16384 + tile_off(wn * 64 + i * 16 + (lane & 15), ks * 4 + (lane >> 4)));
            }
#pragma unroll
            for (int mi = 0; mi < 4; mi++)
#pragma unroll
                for (int ni = 0; ni < 4; ni++)
                    acc[mi][ni] = __builtin_amdgcn_mfma_f32_16x16x32_bf16(bfr[ni], af[mi], acc[mi][ni], 0, 0, 0);
        }
        asm volatile("s_waitcnt vmcnt(0)" ::: "memory");
        __syncthreads();
    }
}

template <int DQK, int DVT, int KT>
struct AttnCfg {
    static constexpr int KROW = DQK * 2 + 16;
    static constexpr int VROW = KT * 2 + 8;
    static constexpr int KBYTES = KT * KROW;
    static constexpr int VBYTES = DVT * VROW;
    static constexpr int STAGE = KBYTES + VBYTES;
    static constexpr int LDS = 2 * STAGE;
};

template <int DQK, int DVT, int KT, class Out>
__device__ __forceinline__ void attn_block(const bf16_t* Qp, const bf16_t* Kp, const bf16_t* Vtp, long ldv, int nk, char* lds, Out&& out) {
    typedef AttnCfg<DQK, DVT, KT> C;
    constexpr int NKS = DQK / 16, NST = KT / 32, NDT = DVT / 32, NPS = KT / 16;
    constexpr int KCPR = DQK / 8;
    constexpr int KCH = KT * KCPR / 256;
    constexpr int VCPR = KT / 8;
    constexpr int VCH = DVT * VCPR / 256;
    const int tid = threadIdx.x, lane = tid & 63, wid = tid >> 6, h = lane >> 5, c = lane & 31;

    bf16x8 qf[NKS];
    {
        const bf16_t* qrow = Qp + (long)(wid * 32 + c) * DQK + 8 * h;
#pragma unroll
        for (int ks = 0; ks < NKS; ks++) qf[ks] = *(const bf16x8*)(qrow + 16 * ks);
    }
    f32x16 o[NDT];
#pragma unroll
    for (int dt = 0; dt < NDT; dt++)
#pragma unroll
        for (int r = 0; r < 16; r++) o[dt][r] = 0.f;
    float m = -1e30f, l = 0.f;

    u32x4 kr[KCH], vr[VCH];
    auto gload = [&](int t) {
#pragma unroll
        for (int i = 0; i < KCH; i++) {
            const int ci = tid + 256 * i, row = ci / KCPR, cc = ci % KCPR;
            kr[i] = *(const u32x4*)(Kp + (long)(t * KT + row) * DQK + cc * 8);
        }
#pragma unroll
        for (int i = 0; i < VCH; i++) {
            const int ci = tid + 256 * i, row = ci / VCPR, cc = ci % VCPR;
            vr[i] = *(const u32x4*)(Vtp + (long)row * ldv + t * KT + cc * 8);
        }
    };
    auto lwrite = [&](char* st) {
#pragma unroll
        for (int i = 0; i < KCH; i++) {
            const int ci = tid + 256 * i, row = ci / KCPR, cc = ci % KCPR;
            *(u32x4*)(st + row * C::KROW + cc * 16) = kr[i];
        }
#pragma unroll
        for (int i = 0; i < VCH; i++) {
            const int ci = tid + 256 * i, row = ci / VCPR, cc = ci % VCPR;
            char* p = st + C::KBYTES + row * C::VROW + cc * 16;
            *(u32x2*)(p) = (u32x2){vr[i].x, vr[i].y};
            *(u32x2*)(p + 8) = (u32x2){vr[i].z, vr[i].w};
        }
    };
    const int nt = nk / KT;
    gload(0);
    __syncthreads();
    lwrite(lds);
    __syncthreads();
    for (int t = 0; t < nt; t++) {
        char* cur = lds + (t & 1) * C::STAGE;
        if (t + 1 < nt) gload(t + 1);
        f32x16 s[NST];
#pragma unroll
        for (int st = 0; st < NST; st++) {
#pragma unroll
            for (int r = 0; r < 16; r++) s[st][r] = 0.f;
#pragma unroll
            for (int ks = 0; ks < NKS; ks++) {
                const bf16x8 kf = *(const bf16x8*)(cur + (st * 32 + c) * C::KROW + ks * 32 + h * 16);
                s[st] = __builtin_amdgcn_mfma_f32_32x32x16_bf16(kf, qf[ks], s[st], 0, 0, 0);
            }
        }
        float mx = s[0][0];
#pragma unroll
        for (int st = 0; st < NST; st++)
#pragma unroll
            for (int r = 0; r < 16; r++) mx = fmaxf(mx, s[st][r]);
        mx = fmaxf(mx, __shfl_xor(mx, 32));
        const float mn = fmaxf(m, mx);
        const float alpha = __builtin_amdgcn_exp2f(m - mn);
        m = mn;
        float rs = 0.f;
#pragma unroll
        for (int st = 0; st < NST; st++)
#pragma unroll
            for (int r = 0; r < 16; r++) { const float p = __builtin_amdgcn_exp2f(s[st][r] - mn); rs += p; s[st][r] = p; }
        l = l * alpha + rs;
#pragma unroll
        for (int dt = 0; dt < NDT; dt++)
#pragma unroll
            for (int r = 0; r < 16; r++) o[dt][r] *= alpha;
#pragma unroll
        for (int ps = 0; ps < NPS; ps++) {
            const int st = ps >> 1, u = ps & 1;
            u32x4 pw;
            pw.x = pack2bf(s[st][8 * u + 0], s[st][8 * u + 1]);
            pw.y = pack2bf(s[st][8 * u + 2], s[st][8 * u + 3]);
            pw.z = pack2bf(s[st][8 * u + 4], s[st][8 * u + 5]);
            pw.w = pack2bf(s[st][8 * u + 6], s[st][8 * u + 7]);
            const bf16x8 pf = __builtin_bit_cast(bf16x8, pw);
#pragma unroll
            for (int dt = 0; dt < NDT; dt++) {
                const char* vp = cur + C::KBYTES + (dt * 32 + c) * C::VROW + (ps * 16 + 4 * h) * 2;
                const u32x2 v0 = *(const u32x2*)(vp);
                const u32x2 v1 = *(const u32x2*)(vp + 16);
                const bf16x8 vf = __builtin_bit_cast(bf16x8, ((u32x4){v0.x, v0.y, v1.x, v1.y}));
                o[dt] = __builtin_amdgcn_mfma_f32_32x32x16_bf16(vf, pf, o[dt], 0, 0, 0);
            }
        }
        if (t + 1 < nt) lwrite(lds + ((t + 1) & 1) * C::STAGE);
        __syncthreads();
    }
    l += __shfl_xor(l, 32);
    const float inv = 1.f / l;
#pragma unroll
    for (int dt = 0; dt < NDT; dt++)
#pragma unroll
        for (int g4 = 0; g4 < 4; g4++) {
            f32x4 v = {o[dt][4 * g4 + 0] * inv, o[dt][4 * g4 + 1] * inv, o[dt][4 * g4 + 2] * inv, o[dt][4 * g4 + 3] * inv};
            out(wid * 32 + c, dt * 32 + 8 * g4 + 4 * h, v);
        }
}


constexpr size_t SLOT = 33554432;
constexpr size_t OFF_W1T = 0;
constexpr size_t OFF_WQT = OFF_W1T + 1280UL * 1024 * 2;
constexpr size_t OFF_WKVT = OFF_WQT + 768UL * 384 * 2;
constexpr size_t OFF_WOUTT = OFF_WKVT + 1024UL * 256 * 2;
constexpr size_t OFF_WMQT = OFF_WOUTT + 1024UL * 1024 * 2;
constexpr size_t OFF_WMKVT = OFF_WMQT + 1024UL * 1024 * 2;
constexpr size_t OFF_WMOT = OFF_WMKVT + 2048UL * 1024 * 2;
constexpr size_t OFF_WGUT = OFF_WMOT + 1024UL * 1024 * 2;
constexpr size_t OFF_WDT = OFF_WGUT + 16UL * 2048 * 1024 * 2;
constexpr size_t OFF_T64 = OFF_WDT + 16UL * 1024 * 1024 * 2;
constexpr size_t OFF_M1 = OFF_T64 + 16384;
constexpr size_t OFF_M3 = OFF_M1 + 32768;
constexpr size_t OFF_WFT = OFF_M3 + 16384;
constexpr size_t OFF_TW = OFF_WFT + 65536;
constexpr size_t OFF_ROPE = OFF_TW + 32768;
constexpr size_t OFF_R0 = OFF_ROPE + (size_t)NT * 16 * 8;
constexpr size_t OFF_RMEM = OFF_R0 + (size_t)NT * 4;
constexpr size_t OFF_SSQ = OFF_RMEM + 4096;
constexpr size_t OFF_SSKV = OFF_SSQ + (size_t)NT * 6 * 4;
constexpr size_t OFF_SS1 = OFF_SSKV + (size_t)NT * 4 * 4;
constexpr size_t OFF_SS2 = OFF_SS1 + (size_t)NT * 16 * 4;
constexpr size_t OFF_AFF = OFF_SS2 + (size_t)NT * 16 * 4;
constexpr size_t OFF_SLOTS = OFF_AFF + (size_t)NT * 16 * 4;
constexpr size_t OFF_IDX = OFF_SLOTS + 4UL * 16 * 4096 * 4;
constexpr size_t OFF_GATE = OFF_IDX + 4UL * 16 * 512 * 4;
constexpr size_t OFF_MEMB = OFF_GATE + 4UL * 16 * 512 * 4;
constexpr size_t OFF_KMEM = OFF_MEMB + 1024UL * 1024 * 2;
constexpr size_t OFF_VTMEM = OFF_KMEM + 1024UL * 1024 * 2;
constexpr size_t OFF_KR = OFF_VTMEM + 1024UL * 1024 * 2;
constexpr size_t OFF_BAR = OFF_KR + (size_t)NT * 32 * 2;
constexpr size_t OFF_S0 = (OFF_BAR + 16384 + 255) / 256 * 256;
constexpr size_t OFF_S1 = OFF_S0 + SLOT;
constexpr size_t OFF_S2 = OFF_S1 + SLOT;
constexpr size_t OFF_S3 = OFF_S2 + SLOT;
constexpr size_t OFF_S4 = OFF_S3 + SLOT;
constexpr size_t WS_END = OFF_S4 + SLOT;
static_assert(WS_END <= 300964352UL, "workspace map exceeds the guaranteed scratch size");
constexpr size_t OFF_XB = OFF_S0, OFF_YR = OFF_S0, OFF_YI = OFF_S0 + SLOT / 2, OFF_X1B = OFF_S0, OFF_OM = OFF_S0, OFF_ACT = OFF_S0;
constexpr size_t OFF_UF = OFF_S1, OFF_UQ = OFF_S1 + (size_t)NT * 512 * 2, OFF_ZA = OFF_S1, OFF_QM = OFF_S1;
constexpr size_t OFF_Q = OFF_S2, OFF_UKV = OFF_S2 + (size_t)NT * 768 * 2, OFF_X2B = OFF_S2;
constexpr size_t OFF_K = OFF_S3, OFF_Y = OFF_S3;
constexpr size_t OFF_VT = OFF_S4;

struct Params {
    const float *x, *mem; const int* pos;
    const float *g_mix, *w_in, *g_q_lat, *w_q_up, *g_kv_lat, *w_kv_up, *w_fourier, *w_out, *g_mem_q, *g_mem_kv, *w_mem_q, *w_mem_kv, *w_mem_o,
        *g_ffn, *w_router, *w_exp_gate, *w_exp_up, *w_exp_down, *g_final;
    float* out; char* ws;
};
template <class T> __device__ __forceinline__ T* wsp(const Params& p, size_t off) { return (T*)(p.ws + off); }

#define LDS_MAIN 65536
#define LDS_TOTAL (LDS_MAIN + 16)
#define LAS __attribute__((address_space(3)))

#define XB_TMO      128
#define XB_XCNT(j)  (256  + 64 * (j))
#define XB_XSUB(j)  (1280 + 64 * (j))
#define XB_XGEN(j)  (2304 + 64 * (j))
#define XB_TOP      3328
#define XB_TOPGEN   3392
#define XCD_BAR_WORDS 3456
#define XB_SPIN_CAP (1u << 25)
__device__ __forceinline__ unsigned xb_ld(unsigned* p)              { return __hip_atomic_load(p, __ATOMIC_RELAXED, __HIP_MEMORY_SCOPE_AGENT); }
__device__ __forceinline__ unsigned xb_add(unsigned* p, unsigned v) { return __hip_atomic_fetch_add(p, v, __ATOMIC_RELAXED, __HIP_MEMORY_SCOPE_AGENT); }
__device__ __forceinline__ unsigned xb_xcc_id() { return (unsigned)__builtin_amdgcn_s_getreg((3 << 11) | 20) & 0xFu; }
#define XB_SPIN(cond, bar) do { unsigned _sp = 0; while (cond) { __builtin_amdgcn_s_sleep(1); \
    if ((++_sp & 255u) == 0u) { if (xb_ld(&(bar)[XB_TMO])) break; if (_sp > XB_SPIN_CAP) { atomicAdd(&(bar)[XB_TMO], 1u); break; } } } } while (0)
struct XcdBarrier { unsigned* bar; unsigned x; volatile LAS unsigned* st; };
__device__ __forceinline__ XcdBarrier xcd_barrier_post(unsigned* bar, volatile LAS unsigned* st) {
    XcdBarrier b; b.bar = bar; b.x = xb_xcc_id(); b.st = st;
    if (threadIdx.x == 0) (void)xb_add(&bar[XB_XCNT(b.x)], 1u);
    return b;
}
__device__ __forceinline__ void xcd_barrier_complete(unsigned* bar, unsigned x, unsigned& nloc, unsigned& nx) {
    const unsigned G = gridDim.x * gridDim.y * gridDim.z;
    unsigned sum, cnt, mine, sp = 0u;
    for (;;) {
        sum = 0u; cnt = 0u; mine = 0u;
#pragma unroll
        for (unsigned j = 0; j < 16; ++j) { const unsigned c = xb_ld(&bar[XB_XCNT(j)]); sum += c; cnt += (c > 0u) ? 1u : 0u; mine = (j == x) ? c : mine; }
        if (sum == G) break;
        __builtin_amdgcn_s_sleep(1);
        if ((++sp & 255u) == 0u) { if (xb_ld(&bar[XB_TMO])) break; if (sp > XB_SPIN_CAP) { atomicAdd(&bar[XB_TMO], 1u); break; } }
    }
    nloc = mine > 0u ? mine : 1u; nx = cnt > 0u ? cnt : 1u;
}
__device__ __forceinline__ void xcd_barrier(const XcdBarrier& b) {
    asm volatile("s_waitcnt vmcnt(0)" ::: "memory");
    __syncthreads();
    if (threadIdx.x == 0) {
        unsigned* bar = b.bar;
        __builtin_amdgcn_s_waitcnt(0);
        unsigned nloc = b.st[0], nx = b.st[1];
        if (nloc == 0u) { xcd_barrier_complete(bar, b.x, nloc, nx); b.st[0] = nloc; b.st[1] = nx; }
        const unsigned old = xb_add(&bar[XB_XSUB(b.x)], 1u);
        const unsigned gen = old / nloc;
        if (old + 1u == (gen + 1u) * nloc) {
            __builtin_amdgcn_fence(__ATOMIC_RELEASE, "agent");
            asm volatile("s_waitcnt vmcnt(0)" ::: "memory");
            const unsigned og = xb_add(&bar[XB_TOP], 1u);
            const unsigned tg = og / nx;
            if (og + 1u == (tg + 1u) * nx) xb_add(&bar[XB_TOPGEN], 1u);
            else XB_SPIN(xb_ld(&bar[XB_TOPGEN]) == tg, bar);
            __builtin_amdgcn_fence(__ATOMIC_ACQUIRE, "agent");
            xb_add(&bar[XB_XGEN(b.x)], 1u);
            asm volatile("s_waitcnt vmcnt(0)" ::: "memory");
        } else {
            XB_SPIN(xb_ld(&bar[XB_XGEN(b.x)]) == gen, bar);
            __builtin_amdgcn_fence(__ATOMIC_ACQUIRE, "agent");
            asm volatile("s_waitcnt vmcnt(0)" ::: "memory");
        }
    }
    __syncthreads();
}

__device__ __forceinline__ u32x2 pack4bf(float a, float b, float c, float d) { return (u32x2){pack2bf(a, b), pack2bf(c, d)}; }
__device__ __forceinline__ u32x2 pack4bf(f32x4 v) { return (u32x2){pack2bf(v[0], v[1]), pack2bf(v[2], v[3])}; }
__device__ __forceinline__ float wave_sum(float v) {
#pragma unroll
    for (int o = 32; o > 0; o >>= 1) v += __shfl_xor(v, o);
    return v;
}

__device__ __forceinline__ void tr_tile(const float* W, long ldw, int k0, int n0, int nvalid, const float* gain, bf16_t* Wt, long ldt, int mode, char* lds) {
    float (*t)[132] = (float (*)[132])lds;
    const int tid = threadIdx.x, c4 = tid & 31, r0 = tid >> 5;
    f32x4 v[8];
#pragma unroll
    for (int i = 0; i < 8; i++) {
        const int kk = r0 + 8 * i, n = n0 + c4 * 4;
        v[i] = (n < nvalid) ? *(const f32x4*)(W + (long)(k0 + kk) * ldw + n) : (f32x4){0.f, 0.f, 0.f, 0.f};
        if (gain) v[i] *= gain[k0 + kk];
    }
    __syncthreads();
#pragma unroll
    for (int i = 0; i < 8; i++) *(f32x4*)(&t[r0 + 8 * i][c4 * 4]) = v[i];
    __syncthreads();
#pragma unroll
    for (int i = 0; i < 4; i++) {
        const int ci = tid + 256 * i, nn = ci >> 3, kc = ci & 7;
        const int n = n0 + nn;
        int row = n;
        if (mode) row = (n >> 5) * 64 + ((n >> 4) & 1) * 32 + (mode - 1) * 16 + (n & 15);
        u32x4 w;
        w.x = pack2bf(t[kc * 8 + 0][nn], t[kc * 8 + 1][nn]);
        w.y = pack2bf(t[kc * 8 + 2][nn], t[kc * 8 + 3][nn]);
        w.z = pack2bf(t[kc * 8 + 4][nn], t[kc * 8 + 5][nn]);
        w.w = pack2bf(t[kc * 8 + 6][nn], t[kc * 8 + 7][nn]);
        *(u32x4*)(Wt + (long)row * ldt + k0 + kc * 8) = w;
    }
}

__device__ __forceinline__ void phase0(const Params& p, char* lds) {
    constexpr int J_W1 = 160, J_WQ = 36, J_WKV = 32, J_WOUT = 128, J_WMQ = 128, J_WMKV = 256, J_WMO = 128, J_WG = 2048, J_WU = 2048, J_WD = 2048;
    constexpr int J_TR = J_W1 + J_WQ + J_WKV + J_WOUT + J_WMQ + J_WMKV + J_WMO + J_WG + J_WU + J_WD;
    constexpr int J_XR = NT / 4, J_MR = 1024 / 4, J_ROPE = NT * 16 / 256, J_TAB = (4096 + 8192 + 16384 + 8192 + 32768) / 256;
    constexpr int J_ALL = J_TR + J_XR + J_MR + J_ROPE + J_TAB;
    const int tid = threadIdx.x, lane = tid & 63, wid = tid >> 6;
    const double PI2 = 6.283185307179586476925286766559;
    for (int job = blockIdx.x; job < J_ALL; job += gridDim.x) {
        int j = job;
        if (j < J_TR) {
            if (j < J_W1) { tr_tile(p.w_in, INW, (j / 10) * 64, (j % 10) * 128, INW, p.g_mix, wsp<bf16_t>(p, OFF_W1T), 1024, 0, lds); continue; } j -= J_W1;
            if (j < J_WQ) { tr_tile(p.w_q_up, 768, (j / 6) * 64, (j % 6) * 128, 768, p.g_q_lat, wsp<bf16_t>(p, OFF_WQT), 384, 0, lds); continue; } j -= J_WQ;
            if (j < J_WKV) { tr_tile(p.w_kv_up, 1024, (j / 8) * 64, (j % 8) * 128, 1024, p.g_kv_lat, wsp<bf16_t>(p, OFF_WKVT), 256, 0, lds); continue; } j -= J_WKV;
            if (j < J_WOUT) { tr_tile(p.w_out, 1024, (j / 8) * 64, (j % 8) * 128, 1024, nullptr, wsp<bf16_t>(p, OFF_WOUTT), 1024, 0, lds); continue; } j -= J_WOUT;
            if (j < J_WMQ) { tr_tile(p.w_mem_q, 1024, (j / 8) * 64, (j % 8) * 128, 1024, p.g_mem_q, wsp<bf16_t>(p, OFF_WMQT), 1024, 0, lds); continue; } j -= J_WMQ;
            if (j < J_WMKV) { tr_tile(p.w_mem_kv, 2048, (j / 16) * 64, (j % 16) * 128, 2048, p.g_mem_kv, wsp<bf16_t>(p, OFF_WMKVT), 1024, 0, lds); continue; } j -= J_WMKV;
            if (j < J_WMO) { tr_tile(p.w_mem_o, 1024, (j / 8) * 64, (j % 8) * 128, 1024, nullptr, wsp<bf16_t>(p, OFF_WMOT), 1024, 0, lds); continue; } j -= J_WMO;
            if (j < J_WG) { const int e = j >> 7, r = j & 127; tr_tile(p.w_exp_gate + (long)e * 1048576, 1024, (r / 8) * 64, (r % 8) * 128, 1024, p.g_ffn, wsp<bf16_t>(p, OFF_WGUT) + (long)e * 2048 * 1024, 1024, 1, lds); continue; } j -= J_WG;
            if (j < J_WU) { const int e = j >> 7, r = j & 127; tr_tile(p.w_exp_up + (long)e * 1048576, 1024, (r / 8) * 64, (r % 8) * 128, 1024, p.g_ffn, wsp<bf16_t>(p, OFF_WGUT) + (long)e * 2048 * 1024, 1024, 2, lds); continue; } j -= J_WU;
            { const int e = j >> 7, r = j & 127; tr_tile(p.w_exp_down + (long)e * 1048576, 1024, (r / 8) * 64, (r % 8) * 128, 1024, nullptr, wsp<bf16_t>(p, OFF_WDT) + (long)e * 1048576, 1024, 0, lds); continue; }
        }
        j -= J_TR;
        if (j < J_XR + J_MR) {
            const bool isx = j < J_XR;
            const int row = (isx ? j : j - J_XR) * 4 + wid;
            const float* src = (isx ? p.x : p.mem) + (long)row * ND;
            bf16_t* dst = (isx ? wsp<bf16_t>(p, OFF_XB) : wsp<bf16_t>(p, OFF_MEMB)) + (long)row * ND;
            float ss = 0.f;
#pragma unroll
            for (int i = 0; i < 4; i++) {
                const f32x4 v = *(const f32x4*)(src + i * 256 + lane * 4);
                ss += v[0] * v[0] + v[1] * v[1] + v[2] * v[2] + v[3] * v[3];
                *(u32x2*)(dst + i * 256 + lane * 4) = pack4bf(v);
            }
            ss = wave_sum(ss);
            if (lane == 0) (isx ? wsp<float>(p, OFF_R0) : wsp<float>(p, OFF_RMEM))[row] = rsqrtf(ss * (1.f / ND) + 1e-6f);
            continue;
        }
        j -= J_XR + J_MR;
        if (j < J_ROPE) {
            const int i = j * 256 + tid; const int t = i >> 4, jj = i & 15;
            const double f = pow(10000.0, -(double)(2 * jj) / 32.0);
            const double ang = (double)p.pos[t] * f;
            wsp<float2>(p, OFF_ROPE)[i] = make_float2((float)cos(ang), (float)sin(ang));
            continue;
        }
        j -= J_ROPE;
        {
            int i = j * 256 + tid;
            if (i < 4096) { const double a = PI2 * (double)i / 4096.0; wsp<float2>(p, OFF_TW)[i] = make_float2((float)cos(a), (float)sin(a)); continue; } i -= 4096;
            if (i < 8192) {
                const int T = i >> 12, a = (i >> 6) & 63, b = i & 63;
                const double th = PI2 * (double)((a * b) & 63) / 64.0;
                wsp<bf16_t>(p, OFF_T64)[i] = (bf16_t)f2bf((float)(T ? sin(th) : cos(th))); continue;
            } i -= 8192;
            if (i < 16384) {
                const int rho = i >> 7, k = i & 127;
                const int wm = rho >> 6, mi = (rho >> 4) & 3, lr = rho & 15, ri = mi >> 1, k1 = 32 * wm + 16 * (mi & 1) + lr, ab = k >> 6, s1 = k & 63;
                const double th = PI2 * (double)((k1 * s1) & 63) / 64.0;
                const double c = cos(th), s = sin(th);
                const double v = ri == 0 ? (ab == 0 ? c : -s) : (ab == 0 ? s : c);
                wsp<bf16_t>(p, OFF_M1)[i] = (bf16_t)f2bf((float)v); continue;
            } i -= 16384;
            if (i < 8192) {
                const int k2 = i >> 7, k = i & 127, s2 = k & 63;
                const double th = PI2 * (double)((k2 * s2) & 63) / 64.0;
                wsp<bf16_t>(p, OFF_M3)[i] = (bf16_t)f2bf((float)(k < 64 ? cos(th) : -sin(th))); continue;
            } i -= 8192;
            if (i < 32768) {
                const int g = i >> 12, e = (i >> 6) & 63, ch = i & 63;
                wsp<bf16_t>(p, OFF_WFT)[i] = (bf16_t)f2bf(p.w_fourier[(g * 64 + ch) * 64 + e]); continue;
            }
        }
    }
}

__device__ __forceinline__ void phase1(const Params& p, char* lds) {
    const int tid = threadIdx.x, lane = tid & 63, wid = tid >> 6, wm = wid >> 1, wn = wid & 1, lq = lane >> 4, lr = lane & 15;
    constexpr int N_U = 128 * 10, N_M = 8 * 16;
    for (int item = blockIdx.x; item < N_U + N_M; item += gridDim.x) {
        f32x4 acc[4][4];
        if (item < N_U) {
            const int tm = item / 10, tn = item % 10;
            GemmTile g; g.A = wsp<bf16_t>(p, OFF_XB) + (long)tm * 128 * ND; g.lda = ND; g.arow = nullptr;
            g.Bt = wsp<bf16_t>(p, OFF_W1T) + (long)tn * 128 * ND; g.ldb = ND; g.K = ND;
            gemm_tile_128(g, lds, acc);
            const float* r0 = wsp<float>(p, OFF_R0);
#pragma unroll
            for (int mi = 0; mi < 4; mi++) {
                const int row = tm * 128 + wm * 64 + mi * 16 + lr;
                const float rs = r0[row];
#pragma unroll
                for (int ni = 0; ni < 4; ni++) acc[mi][ni] *= rs;
                if (tn < 4) {
#pragma unroll
                    for (int ni = 0; ni < 4; ni++)
                        *(u32x2*)(wsp<bf16_t>(p, OFF_UF) + (long)row * 512 + tn * 128 + wn * 64 + ni * 16 + 4 * lq) = pack4bf(acc[mi][ni]);
                } else if (tn < 9) {
                    float ss = 0.f;
#pragma unroll
                    for (int ni = 0; ni < 4; ni++) { const f32x4 v = acc[mi][ni]; ss += v[0] * v[0] + v[1] * v[1] + v[2] * v[2] + v[3] * v[3]; }
                    ss += __shfl_xor(ss, 16); ss += __shfl_xor(ss, 32);
                    if (tn < 7) {
#pragma unroll
                        for (int ni = 0; ni < 4; ni++)
                            *(u32x2*)(wsp<bf16_t>(p, OFF_UQ) + (long)row * 384 + (tn - 4) * 128 + wn * 64 + ni * 16 + 4 * lq) = pack4bf(acc[mi][ni]);
                        if (lq == 0) wsp<float>(p, OFF_SSQ)[row * 6 + (tn - 4) * 2 + wn] = ss;
                    } else {
#pragma unroll
                        for (int ni = 0; ni < 4; ni++)
                            *(u32x2*)(wsp<bf16_t>(p, OFF_UKV) + (long)row * 256 + (tn - 7) * 128 + wn * 64 + ni * 16 + 4 * lq) = pack4bf(acc[mi][ni]);
                        if (lq == 0) wsp<float>(p, OFF_SSKV)[row * 4 + (tn - 7) * 2 + wn] = ss;
                    }
                } else if (wn == 0) {
                    const float2* rp = wsp<float2>(p, OFF_ROPE) + (long)row * 16 + 4 * lq;
                    f32x4 o1, o2;
#pragma unroll
                    for (int r = 0; r < 4; r++) {
                        const float2 cs = rp[r];
                        const float x1 = acc[mi][0][r], x2 = acc[mi][1][r];
                        o1[r] = x1 * cs.x - x2 * cs.y; o2[r] = x1 * cs.y + x2 * cs.x;
                    }
                    bf16_t* kr = wsp<bf16_t>(p, OFF_KR) + (long)row * 32;
                    *(u32x2*)(kr + 4 * lq) = pack4bf(o1);
                    *(u32x2*)(kr + 16 + 4 * lq) = pack4bf(o2);
                }
            }
        } else {
            const int it = item - N_U, tm = it / 16, tn = it % 16;
            GemmTile g; g.A = wsp<bf16_t>(p, OFF_MEMB) + (long)tm * 128 * ND; g.lda = ND; g.arow = nullptr;
            g.Bt = wsp<bf16_t>(p, OFF_WMKVT) + (long)tn * 128 * ND; g.ldb = ND; g.K = ND;
            gemm_tile_128(g, lds, acc);
            const float* rm = wsp<float>(p, OFF_RMEM);
#pragma unroll
            for (int mi = 0; mi < 4; mi++) {
                const int row = tm * 128 + wm * 64 + mi * 16 + lr;
                const int b = row >> 8, m = row & 255;
                const float rs = rm[row];
#pragma unroll
                for (int ni = 0; ni < 4; ni++) {
                    const f32x4 v = acc[mi][ni] * rs;
                    const int col = tn * 128 + wn * 64 + ni * 16 + 4 * lq;
                    if (col < 1024) {
                        const int h = col >> 8, d = col & 255;
                        *(u32x2*)(wsp<bf16_t>(p, OFF_KMEM) + ((long)(b * 4 + h) * 256 + m) * 256 + d) = pack4bf(v);
                    } else {
                        const int c2 = col - 1024, h = c2 >> 8, dv = c2 & 255;
                        bf16_t* vt = wsp<bf16_t>(p, OFF_VTMEM) + ((long)(b * 4 + h) * 256 + dv) * 256 + m;
#pragma unroll
                        for (int r = 0; r < 4; r++) vt[r * 256] = (bf16_t)f2bf(v[r]);
                    }
                }
            }
        }
    }
}

template <int MI>
__device__ __forceinline__ void dft_mma(const bf16_t* Ag, int arow0, const char* ximg, int ncol0, f32x4 (&acc)[MI][4]) {
    const int lane = threadIdx.x & 63, lq = lane >> 4, lr = lane & 15;
#pragma unroll
    for (int ks = 0; ks < 4; ks++) {
        bf16x8 af[MI], bfr[4];
#pragma unroll
        for (int mi = 0; mi < MI; mi++) af[mi] = *(const bf16x8*)(Ag + (long)(arow0 + mi * 16 + lr) * 128 + ks * 32 + lq * 8);
#pragma unroll
        for (int ni = 0; ni < 4; ni++) {
            const char* bp = ximg + (ks * 32 + lq * 8) * 272 + (ncol0 + ni * 16 + lr) * 2;
#pragma unroll
            for (int j = 0; j < 8; j++) bfr[ni][j] = *(const short*)(bp + j * 272);
        }
#pragma unroll
        for (int mi = 0; mi < MI; mi++)
#pragma unroll
            for (int ni = 0; ni < 4; ni++) acc[mi][ni] = __builtin_amdgcn_mfma_f32_16x16x32_bf16(bfr[ni], af[mi], acc[mi][ni], 0, 0, 0);
    }
}

__device__ __forceinline__ void f2a_item(const Params& p, int it, char* lds) {
    const int tid = threadIdx.x, lane = tid & 63, wid = tid >> 6, wm = wid >> 1, wn = wid & 1, lq = lane >> 4, lr = lane & 15;
    const int nc = it & 3, s2 = (it >> 2) & 63, b = it >> 8;
    char* uimg = lds; char* ximg = lds + 17408;
    __syncthreads();
#pragma unroll
    for (int i = 0; i < 4; i++) {
        const int ci = tid + 256 * i, row = ci >> 4, cc = ci & 15;
        *(u32x4*)(uimg + row * 272 + cc * 16) = *(const u32x4*)(wsp<bf16_t>(p, OFF_UF) + ((long)(b * NS + 64 * row + s2)) * 512 + nc * 128 + cc * 8);
    }
    __syncthreads();
    {
        const int g2 = wid >> 1, T = wid & 1;
        f32x4 a1[4][4];
#pragma unroll
        for (int mi = 0; mi < 4; mi++)
#pragma unroll
            for (int ni = 0; ni < 4; ni++) a1[mi][ni] = (f32x4){0.f, 0.f, 0.f, 0.f};
        const bf16_t* t64 = wsp<bf16_t>(p, OFF_T64) + T * 4096;
#pragma unroll
        for (int ks = 0; ks < 2; ks++) {
            bf16x8 af[4], bfr[4];
#pragma unroll
            for (int i = 0; i < 4; i++) {
                af[i] = *(const bf16x8*)(uimg + (i * 16 + lr) * 272 + (g2 * 64 + ks * 32 + lq * 8) * 2);
                bfr[i] = *(const bf16x8*)(t64 + (i * 16 + lr) * 64 + ks * 32 + lq * 8);
            }
#pragma unroll
            for (int mi = 0; mi < 4; mi++)
#pragma unroll
                for (int ni = 0; ni < 4; ni++) a1[mi][ni] = __builtin_amdgcn_mfma_f32_16x16x32_bf16(bfr[ni], af[mi], a1[mi][ni], 0, 0, 0);
        }
#pragma unroll
        for (int mi = 0; mi < 4; mi++)
#pragma unroll
            for (int ni = 0; ni < 4; ni++)
                *(u32x2*)(ximg + (T * 64 + mi * 16 + lr) * 272 + (g2 * 64 + ni * 16 + 4 * lq) * 2) = pack4bf(a1[mi][ni]);
    }
    __syncthreads();
    f32x4 acc[4][4];
#pragma unroll
    for (int mi = 0; mi < 4; mi++)
#pragma unroll
        for (int ni = 0; ni < 4; ni++) acc[mi][ni] = (f32x4){0.f, 0.f, 0.f, 0.f};
    dft_mma<4>(wsp<bf16_t>(p, OFF_M1), wm * 64, ximg, wn * 64, acc);
    const float2* tw = wsp<float2>(p, OFF_TW);
#pragma unroll
    for (int m2 = 0; m2 < 2; m2++) {
        const int k1 = 32 * wm + 16 * m2 + lr;
        float2 cs; { const float rev = (float)((s2 * k1) & 4095) * (1.0f / 4096.0f); cs.x = __builtin_amdgcn_cosf(rev); cs.y = __builtin_amdgcn_sinf(rev); (void)tw; }
        const long base = ((long)(b * 64 + k1) * 64 + s2) * 512 + nc * 128 + wn * 64 + 4 * lq;
#pragma unroll
        for (int ni = 0; ni < 4; ni++) {
            const f32x4 yr = acc[m2][ni], yi = acc[m2 + 2][ni];
            const f32x4 orr = yr * cs.x - yi * cs.y, oi = yi * cs.x + yr * cs.y;
            *(u32x2*)(wsp<bf16_t>(p, OFF_YR) + base + ni * 16) = pack4bf(orr);
            *(u32x2*)(wsp<bf16_t>(p, OFF_YI) + base + ni * 16) = pack4bf(oi);
        }
    }
}

__device__ __forceinline__ void f2b_item(const Params& p, int it, char* lds) {
    const int tid = threadIdx.x, lane = tid & 63, wid = tid >> 6, wm = wid >> 1, wn = wid & 1, lq = lane >> 4, lr = lane & 15;
    const int nc = it & 3, k1 = (it >> 2) & 63, b = it >> 8;
    char* ximg = lds; char* zimg = lds + 34816;
    __syncthreads();
#pragma unroll
    for (int i = 0; i < 8; i++) {
        const int ci = tid + 256 * i, row = ci >> 4, cc = ci & 15;
        const bf16_t* src = (row < 64 ? wsp<bf16_t>(p, OFF_YR) : wsp<bf16_t>(p, OFF_YI)) + ((long)(b * 64 + k1) * 64 + (row & 63)) * 512 + nc * 128 + cc * 8;
        *(u32x4*)(ximg + row * 272 + cc * 16) = *(const u32x4*)src;
    }
    __syncthreads();
    f32x4 acc[2][4];
#pragma unroll
    for (int mi = 0; mi < 2; mi++)
#pragma unroll
        for (int ni = 0; ni < 4; ni++) acc[mi][ni] = (f32x4){0.f, 0.f, 0.f, 0.f};
    dft_mma<2>(wsp<bf16_t>(p, OFF_M3), wm * 32, ximg, wn * 64, acc);
#pragma unroll
    for (int mi = 0; mi < 2; mi++)
#pragma unroll
        for (int ni = 0; ni < 4; ni++)
            *(u32x2*)(zimg + (wm * 32 + mi * 16 + lr) * 272 + (wn * 64 + ni * 16 + 4 * lq) * 2) = pack4bf(acc[mi][ni] * (1.0f / 512.0f));
    __syncthreads();
    f32x4 a3[2][4];
#pragma unroll
    for (int mi = 0; mi < 2; mi++)
#pragma unroll
        for (int ni = 0; ni < 4; ni++) a3[mi][ni] = (f32x4){0.f, 0.f, 0.f, 0.f};
    const bf16_t* wft = wsp<bf16_t>(p, OFF_WFT) + (long)(nc * 2 + wn) * 4096;
#pragma unroll
    for (int ks = 0; ks < 2; ks++) {
        bf16x8 af[2], bfr[4];
#pragma unroll
        for (int i = 0; i < 2; i++) af[i] = *(const bf16x8*)(zimg + (wm * 32 + i * 16 + lr) * 272 + (wn * 64 + ks * 32 + lq * 8) * 2);
#pragma unroll
        for (int i = 0; i < 4; i++) bfr[i] = *(const bf16x8*)(wft + (i * 16 + lr) * 64 + ks * 32 + lq * 8);
#pragma unroll
        for (int mi = 0; mi < 2; mi++)
#pragma unroll
            for (int ni = 0; ni < 4; ni++) a3[mi][ni] = __builtin_amdgcn_mfma_f32_16x16x32_bf16(bfr[ni], af[mi], a3[mi][ni], 0, 0, 0);
    }
#pragma unroll
    for (int mi = 0; mi < 2; mi++) {
        const int k2 = wm * 32 + mi * 16 + lr;
        bf16_t* dst = wsp<bf16_t>(p, OFF_ZA) + ((long)(b * NS + k1 + 64 * k2)) * 1024 + nc * 128 + wn * 64 + 4 * lq;
#pragma unroll
        for (int ni = 0; ni < 4; ni++) *(u32x2*)(dst + ni * 16) = pack4bf(a3[mi][ni]);
    }
}

__device__ __forceinline__ void phase2(const Params& p, char* lds) {
    const int tid = threadIdx.x, lane = tid & 63, wid = tid >> 6, wm = wid >> 1, wn = wid & 1, lq = lane >> 4, lr = lane & 15;
    constexpr int N_Q = 128 * 6, N_KV = 128 * 8, N_F = 1024;
    for (int item = blockIdx.x; item < N_Q + N_KV + N_F; item += gridDim.x) {
        f32x4 acc[4][4];
        if (item < N_Q) {
            const int tm = item / 6, tn = item % 6;
            GemmTile g; g.A = wsp<bf16_t>(p, OFF_UQ) + (long)tm * 128 * 384; g.lda = 384; g.arow = nullptr;
            g.Bt = wsp<bf16_t>(p, OFF_WQT) + (long)tn * 128 * 384; g.ldb = 384; g.K = 384;
            gemm_tile_128(g, lds, acc);
            const float qmul = 0.10206207261596575f * 1.4426950408889634f;
#pragma unroll
            for (int mi = 0; mi < 4; mi++) {
                const int row = tm * 128 + wm * 64 + mi * 16 + lr;
                const int b = row >> 12, s = row & 4095;
                const float* sq = wsp<float>(p, OFF_SSQ) + (long)row * 6;
                const float ss = sq[0] + sq[1] + sq[2] + sq[3] + sq[4] + sq[5];
                const float rs = rsqrtf(ss * (1.f / 384.f) + 1e-6f) * qmul;
                const int cb0 = tn * 128 + wn * 64;
#pragma unroll
                for (int ni = 0; ni < 4; ni++) {
                    const int cb = cb0 + ni * 16, hd = cb / 96, hob = cb % 96;
                    bf16_t* qd = wsp<bf16_t>(p, OFF_Q) + ((long)(b * 8 + hd) * NS + s) * 96;
                    if (hob < 64) {
                        *(u32x2*)(qd + hob + 4 * lq) = pack4bf(acc[mi][ni] * rs);
                    } else if (hob == 64) {
                        if (ni < 3) {
                            const float2* rp = wsp<float2>(p, OFF_ROPE) + (long)row * 16 + 4 * lq;
                            f32x4 o1, o2;
#pragma unroll
                            for (int r = 0; r < 4; r++) {
                                const float2 cs = rp[r];
                                const float x1 = acc[mi][ni][r] * rs, x2 = acc[mi][ni < 3 ? ni + 1 : 3][r] * rs;
                                o1[r] = x1 * cs.x - x2 * cs.y; o2[r] = x1 * cs.y + x2 * cs.x;
                            }
                            *(u32x2*)(qd + 64 + 4 * lq) = pack4bf(o1);
                            *(u32x2*)(qd + 80 + 4 * lq) = pack4bf(o2);
                        }
                    }
                }
            }
        } else if (item < N_Q + N_KV) {
            const int it = item - N_Q, tm = it >> 3, hd = it & 7;
            GemmTile g; g.A = wsp<bf16_t>(p, OFF_UKV) + (long)tm * 128 * 256; g.lda = 256; g.arow = nullptr;
            g.Bt = wsp<bf16_t>(p, OFF_WKVT) + (long)hd * 128 * 256; g.ldb = 256; g.K = 256;
            gemm_tile_128(g, lds, acc);
#pragma unroll
            for (int mi = 0; mi < 4; mi++) {
                const int row = tm * 128 + wm * 64 + mi * 16 + lr;
                const int b = row >> 12, s = row & 4095;
                const float* sq = wsp<float>(p, OFF_SSKV) + (long)row * 4;
                const float rs = rsqrtf((sq[0] + sq[1] + sq[2] + sq[3]) * (1.f / 256.f) + 1e-6f);
                if (wn == 0) {
                    bf16_t* kd = wsp<bf16_t>(p, OFF_K) + ((long)(b * 8 + hd) * NS + s) * 96;
#pragma unroll
                    for (int ni = 0; ni < 4; ni++) *(u32x2*)(kd + ni * 16 + 4 * lq) = pack4bf(acc[mi][ni] * rs);
                } else {
#pragma unroll
                    for (int ni = 0; ni < 4; ni++) {
                        bf16_t* vd = wsp<bf16_t>(p, OFF_VT) + ((long)(b * 8 + hd) * 64 + ni * 16 + 4 * lq) * NS + s;
#pragma unroll
                        for (int r = 0; r < 4; r++) vd[(long)r * NS] = (bf16_t)f2bf(acc[mi][ni][r] * rs);
                    }
                }
            }
#pragma unroll
            for (int i = 0; i < 2; i++) {
                const int ci = tid + 256 * i, r = ci >> 2, cc = ci & 3;
                const int row = tm * 128 + r, b = row >> 12, s = row & 4095;
                *(u32x4*)(wsp<bf16_t>(p, OFF_K) + ((long)(b * 8 + hd) * NS + s) * 96 + 64 + cc * 8) = *(const u32x4*)(wsp<bf16_t>(p, OFF_KR) + (long)row * 32 + cc * 8);
            }
        } else {
            f2a_item(p, item - N_Q - N_KV, lds);
        }
    }
}

__device__ __forceinline__ void phase3(const Params& p, char* lds) {
    constexpr int N_A = NB * 8 * (NS / 128), N_F = 1024;
    for (int item = blockIdx.x; item < N_A + N_F; item += gridDim.x) {
        if (item < N_A) {
            const int qt = item & 31, h = (item >> 5) & 7, b = item >> 8;
            const bf16_t* Qp = wsp<bf16_t>(p, OFF_Q) + ((long)(b * 8 + h) * NS + qt * 128) * 96;
            const bf16_t* Kp = wsp<bf16_t>(p, OFF_K) + ((long)(b * 8 + h) * NS) * 96;
            const bf16_t* Vtp = wsp<bf16_t>(p, OFF_VT) + ((long)(b * 8 + h) * 64) * NS;
            bf16_t* Op = wsp<bf16_t>(p, OFF_ZA) + ((long)b * NS + qt * 128) * 1024 + 512 + h * 64;
            attn_block<96, 64, 64>(Qp, Kp, Vtp, (long)NS, NS, lds, [&](int q, int dv, f32x4 v) { *(u32x2*)(Op + (long)q * 1024 + dv) = pack4bf(v); });
        } else {
            f2b_item(p, item - N_A, lds);
        }
    }
}

__device__ __forceinline__ void phase_resid(const Params& p, char* lds, size_t offA, size_t offW, const float* resid, size_t offXb, size_t offSS) {
    const int tid = threadIdx.x, lane = tid & 63, wid = tid >> 6, wm = wid >> 1, wn = wid & 1, lq = lane >> 4, lr = lane & 15;
    for (int item = blockIdx.x; item < 128 * 8; item += gridDim.x) {
        const int tm = item >> 3, tn = item & 7;
        f32x4 acc[4][4];
        GemmTile g; g.A = wsp<bf16_t>(p, offA) + (long)tm * 128 * ND; g.lda = ND; g.arow = nullptr;
        g.Bt = wsp<bf16_t>(p, offW) + (long)tn * 128 * ND; g.ldb = ND; g.K = ND;
        gemm_tile_128(g, lds, acc);
#pragma unroll
        for (int mi = 0; mi < 4; mi++) {
            const int row = tm * 128 + wm * 64 + mi * 16 + lr;
            float ss = 0.f;
#pragma unroll
            for (int ni = 0; ni < 4; ni++) {
                const long o = (long)row * ND + tn * 128 + wn * 64 + ni * 16 + 4 * lq;
                const f32x4 v = *(const f32x4*)(resid + o) + acc[mi][ni];
                *(f32x4*)(p.out + o) = v;
                *(u32x2*)(wsp<bf16_t>(p, offXb) + o) = pack4bf(v);
                ss += v[0] * v[0] + v[1] * v[1] + v[2] * v[2] + v[3] * v[3];
            }
            ss += __shfl_xor(ss, 16); ss += __shfl_xor(ss, 32);
            if (lq == 0) wsp<float>(p, offSS)[row * 16 + tn * 2 + wn] = ss;
        }
    }
}
__device__ __forceinline__ float row_rs16(const float* ss) {
    const f32x4 a = *(const f32x4*)ss, b = *(const f32x4*)(ss + 4), c = *(const f32x4*)(ss + 8), d = *(const f32x4*)(ss + 12);
    const f32x4 t = (a + b) + (c + d);
    return rsqrtf(((t[0] + t[1]) + (t[2] + t[3])) * (1.f / 1024.f) + 1e-6f);
}

__device__ __forceinline__ void phase5a(const Params& p, char* lds) {
    const int tid = threadIdx.x, lane = tid & 63, wid = tid >> 6, wm = wid >> 1, wn = wid & 1, lq = lane >> 4, lr = lane & 15;
    for (int item = blockIdx.x; item < 128 * 8; item += gridDim.x) {
        const int tm = item >> 3, tn = item & 7;
        f32x4 acc[4][4];
        GemmTile g; g.A = wsp<bf16_t>(p, OFF_X1B) + (long)tm * 128 * ND; g.lda = ND; g.arow = nullptr;
        g.Bt = wsp<bf16_t>(p, OFF_WMQT) + (long)tn * 128 * ND; g.ldb = ND; g.K = ND;
        gemm_tile_128(g, lds, acc);
        const int h = tn >> 1;
#pragma unroll
        for (int mi = 0; mi < 4; mi++) {
            const int row = tm * 128 + wm * 64 + mi * 16 + lr, b = row >> 12, s = row & 4095;
            const float rs = row_rs16(wsp<float>(p, OFF_SS1) + (long)row * 16) * (0.0625f * 1.4426950408889634f);
            bf16_t* qd = wsp<bf16_t>(p, OFF_QM) + ((long)(b * 4 + h) * NS + s) * 256 + (tn & 1) * 128 + wn * 64 + 4 * lq;
#pragma unroll
            for (int ni = 0; ni < 4; ni++) *(u32x2*)(qd + ni * 16) = pack4bf(acc[mi][ni] * rs);
        }
    }
}
__device__ __forceinline__ void phase5b(const Params& p, char* lds) {
    for (int item = blockIdx.x; item < NB * 4 * 32 * 2; item += gridDim.x) {
        const int dvh = item & 1, qt = (item >> 1) & 31, h = (item >> 6) & 3, b = item >> 8;
        const bf16_t* Qp = wsp<bf16_t>(p, OFF_QM) + ((long)(b * 4 + h) * NS + qt * 128) * 256;
        const bf16_t* Kp = wsp<bf16_t>(p, OFF_KMEM) + ((long)(b * 4 + h) * 256) * 256;
        const bf16_t* Vtp = wsp<bf16_t>(p, OFF_VTMEM) + ((long)(b * 4 + h) * 256 + dvh * 128) * 256;
        bf16_t* Op = wsp<bf16_t>(p, OFF_OM) + ((long)b * NS + qt * 128) * 1024 + h * 256 + dvh * 128;
        attn_block<256, 128, 32>(Qp, Kp, Vtp, 256L, 256, lds, [&](int q, int dv, f32x4 v) { *(u32x2*)(Op + (long)q * 1024 + dv) = pack4bf(v); });
    }
}

__device__ __forceinline__ void phase7(const Params& p, char* lds) {
    const int tid = threadIdx.x, lane = tid & 63, wid = tid >> 6;
    float* wr = (float*)lds;
    __syncthreads();
    for (int i = tid; i < 16384; i += 256) { const int k = i >> 4, e = i & 15; wr[e * 1024 + k] = p.w_router[i] * p.g_ffn[k]; }
    __syncthreads();
    for (int tok = blockIdx.x * 4 + wid; tok < NT; tok += gridDim.x * 4) {
        const float* xr = p.out + (long)tok * ND;
        float a[16];
#pragma unroll
        for (int e = 0; e < 16; e++) a[e] = 0.f;
#pragma unroll 4
        for (int j = 0; j < 16; j++) {
            const float xv = xr[lane + 64 * j];
#pragma unroll
            for (int e = 0; e < 16; e++) a[e] += xv * wr[e * 1024 + lane + 64 * j];
        }
#pragma unroll
        for (int i = 0; i < 8; i++) { const bool hi = lane & 32; const float send = hi ? a[i] : a[i + 8], keep = hi ? a[i + 8] : a[i]; a[i] = keep + __shfl_xor(send, 32); }
#pragma unroll
        for (int i = 0; i < 4; i++) { const bool hi = lane & 16; const float send = hi ? a[i] : a[i + 4], keep = hi ? a[i + 4] : a[i]; a[i] = keep + __shfl_xor(send, 16); }
#pragma unroll
        for (int i = 0; i < 2; i++) { const bool hi = lane & 8; const float send = hi ? a[i] : a[i + 2], keep = hi ? a[i + 2] : a[i]; a[i] = keep + __shfl_xor(send, 8); }
        { const bool hi = lane & 4; const float send = hi ? a[0] : a[1], keep = hi ? a[1] : a[0]; a[0] = keep + __shfl_xor(send, 4); }
        float lg = a[0];
        lg += __shfl_xor(lg, 2); lg += __shfl_xor(lg, 1);
        const int e = ((lane >> 5) & 1) * 8 + ((lane >> 4) & 1) * 4 + ((lane >> 3) & 1) * 2 + ((lane >> 2) & 1);
        lg *= row_rs16(wsp<float>(p, OFF_SS2) + (long)tok * 16);
        float mx = lg;
#pragma unroll
        for (int o = 4; o < 64; o <<= 1) mx = fmaxf(mx, __shfl_xor(mx, o));
        const float ex = expf(lg - mx);
        float sm = ex;
#pragma unroll
        for (int o = 4; o < 64; o <<= 1) sm += __shfl_xor(sm, o);
        if ((lane & 3) == 0) wsp<float>(p, OFF_AFF)[(long)tok * 16 + e] = ex / sm;
    }
}

__device__ __forceinline__ int block_sum_i(int v, int* red) {
    const int lane = threadIdx.x & 63, wid = threadIdx.x >> 6;
#pragma unroll
    for (int o = 32; o > 0; o >>= 1) v += __shfl_xor(v, o);
    __syncthreads();
    if (lane == 0) red[wid] = v;
    __syncthreads();
    return red[0] + red[1] + red[2] + red[3];
}
__device__ __forceinline__ int block_excl_scan_i(int v, int* red, int& total) {
    const int lane = threadIdx.x & 63, wid = threadIdx.x >> 6;
    int inc = v;
#pragma unroll
    for (int o = 1; o < 64; o <<= 1) { const int t = __shfl_up(inc, o); if (lane >= o) inc += t; }
    __syncthreads();
    if (lane == 63) red[wid] = inc;
    __syncthreads();
    int base = 0;
#pragma unroll
    for (int w = 0; w < 4; w++) if (w < wid) base += red[w];
    total = red[0] + red[1] + red[2] + red[3];
    return base + inc - v;
}
__device__ __forceinline__ void phase8(const Params& p, char* lds) {
    int* red = (int*)lds;
    const int tid = threadIdx.x;
    for (int item = blockIdx.x; item < NB * NE; item += gridDim.x) {
        const int e = item & 15, b = item >> 4;
        const float* aff = wsp<float>(p, OFF_AFF) + (long)b * NS * 16 + e;
        unsigned v[16];
#pragma unroll
        for (int i = 0; i < 16; i++) v[i] = __float_as_uint(aff[(long)(tid * 16 + i) * 16]);
        unsigned T = 0;
        for (int bit = 30; bit >= 0; bit--) {
            const unsigned cand = T | (1u << bit);
            int c = 0;
#pragma unroll
            for (int i = 0; i < 16; i++) c += (v[i] >= cand) ? 1 : 0;
            if (block_sum_i(c, red) >= CAP) T = cand;
        }
        int cg = 0, ce = 0;
#pragma unroll
        for (int i = 0; i < 16; i++) { cg += (v[i] > T) ? 1 : 0; ce += (v[i] == T) ? 1 : 0; }
        int tot;
        const int pk = block_excl_scan_i(cg | (ce << 16), red, tot);
        const int need = CAP - (tot & 0xFFFF);
        const int pe = pk >> 16;
        int nse = need - pe; nse = nse < 0 ? 0 : (nse > ce ? ce : nse);
        int tot2;
        int slot = block_excl_scan_i(cg + nse, red, tot2);
        int* slots = wsp<int>(p, OFF_SLOTS) + (long)(b * NE + e) * NS;
        int* idx = wsp<int>(p, OFF_IDX) + (long)(b * NE + e) * CAP;
        float* gate = wsp<float>(p, OFF_GATE) + (long)(b * NE + e) * CAP;
        int eqs = 0;
#pragma unroll
        for (int i = 0; i < 16; i++) {
            const int t = tid * 16 + i;
            bool sel = v[i] > T;
            if (v[i] == T) { sel = eqs < nse; eqs++; }
            if (sel) { slots[t] = slot; idx[slot] = b * NS + t; gate[slot] = __uint_as_float(v[i]); slot++; }
            else slots[t] = -1;
        }
    }
}

__device__ __forceinline__ void phase9(const Params& p, char* lds) {
    const int tid = threadIdx.x, lane = tid & 63, wid = tid >> 6, wm = wid >> 1, wn = wid & 1, lq = lane >> 4, lr = lane & 15;
    for (int item = blockIdx.x; item < NE * 16 * NB * 4; item += gridDim.x) {
        const int rt = item & 3, b = (item >> 2) & 3, ct = (item >> 4) & 15, e = item >> 8;
        const int* arow = wsp<int>(p, OFF_IDX) + (long)(b * NE + e) * CAP + rt * 128;
        f32x4 acc[4][4];
        GemmTile g; g.A = wsp<bf16_t>(p, OFF_X2B); g.lda = ND; g.arow = arow;
        g.Bt = wsp<bf16_t>(p, OFF_WGUT) + ((long)e * 2048 + ct * 128) * ND; g.ldb = ND; g.K = ND;
        gemm_tile_128(g, lds, acc);
#pragma unroll
        for (int mi = 0; mi < 4; mi++) {
            const int r = wm * 64 + mi * 16 + lr;
            const int tok = arow[r];
            const float rs = row_rs16(wsp<float>(p, OFF_SS2) + (long)tok * 16);
            bf16_t* ad = wsp<bf16_t>(p, OFF_ACT) + ((long)(e * NB + b) * CAP + rt * 128 + r) * ND + ct * 64 + wn * 32 + 4 * lq;
#pragma unroll
            for (int pp = 0; pp < 2; pp++) {
                f32x4 o;
#pragma unroll
                for (int q = 0; q < 4; q++) {
                    const float ga = acc[mi][2 * pp][q] * rs, up = acc[mi][2 * pp + 1][q] * rs;
                    o[q] = ga / (1.f + __expf(-ga)) * up;
                }
                *(u32x2*)(ad + pp * 16) = pack4bf(o);
            }
        }
    }
}
__device__ __forceinline__ void phase10(const Params& p, char* lds) {
    const int tid = threadIdx.x, lane = tid & 63, wid = tid >> 6, wm = wid >> 1, wn = wid & 1, lq = lane >> 4, lr = lane & 15;
    for (int item = blockIdx.x; item < NE * 8 * NB * 4; item += gridDim.x) {
        const int rt = item & 3, b = (item >> 2) & 3, ct = (item >> 4) & 7, e = item >> 7;
        const long row0 = (long)(e * NB + b) * CAP + rt * 128;
        f32x4 acc[4][4];
        GemmTile g; g.A = wsp<bf16_t>(p, OFF_ACT) + row0 * ND; g.lda = ND; g.arow = nullptr;
        g.Bt = wsp<bf16_t>(p, OFF_WDT) + ((long)e * 1024 + ct * 128) * ND; g.ldb = ND; g.K = ND;
        gemm_tile_128(g, lds, acc);
        const float* gate = wsp<float>(p, OFF_GATE) + (long)(b * NE + e) * CAP + rt * 128;
#pragma unroll
        for (int mi = 0; mi < 4; mi++) {
            const int r = wm * 64 + mi * 16 + lr;
            const float gv = gate[r];
            bf16_t* yd = wsp<bf16_t>(p, OFF_Y) + (row0 + r) * ND + ct * 128 + wn * 64 + 4 * lq;
#pragma unroll
            for (int ni = 0; ni < 4; ni++) *(u32x2*)(yd + ni * 16) = pack4bf(acc[mi][ni] * gv);
        }
    }
}

__device__ __forceinline__ void phase11(const Params& p, char* lds) {
    const int tid = threadIdx.x, lane = tid & 63, wid = tid >> 6;
    for (int tok = blockIdx.x * 4 + wid; tok < NT; tok += gridDim.x * 4) {
        const int b = tok >> 12, t = tok & 4095;
        float* xr = p.out + (long)tok * ND;
        f32x4 v[4];
#pragma unroll
        for (int i = 0; i < 4; i++) v[i] = *(const f32x4*)(xr + i * 256 + lane * 4);
        for (int e = 0; e < NE; e++) {
            const int sl = wsp<int>(p, OFF_SLOTS)[(long)(b * NE + e) * NS + t];
            if (sl >= 0) {
                const bf16_t* yr = wsp<bf16_t>(p, OFF_Y) + ((long)(e * NB + b) * CAP + sl) * ND;
#pragma unroll
                for (int i = 0; i < 4; i++) {
                    const u32x2 w = *(const u32x2*)(yr + i * 256 + lane * 4);
                    v[i][0] += __uint_as_float(w.x << 16); v[i][1] += __uint_as_float(w.x & 0xFFFF0000u);
                    v[i][2] += __uint_as_float(w.y << 16); v[i][3] += __uint_as_float(w.y & 0xFFFF0000u);
                }
            }
        }
        float ss = 0.f;
#pragma unroll
        for (int i = 0; i < 4; i++) ss += v[i][0] * v[i][0] + v[i][1] * v[i][1] + v[i][2] * v[i][2] + v[i][3] * v[i][3];
        ss = wave_sum(ss);
        const float rs = rsqrtf(ss * (1.f / ND) + 1e-6f);
#pragma unroll
        for (int i = 0; i < 4; i++) {
            const f32x4 gf = *(const f32x4*)(p.g_final + i * 256 + lane * 4);
            *(f32x4*)(xr + i * 256 + lane * 4) = v[i] * rs * gf;
        }
    }
}

__global__ void __launch_bounds__(256, 2) k_fwd(Params p, int ph_lo, int ph_hi) {
    extern __shared__ __attribute__((aligned(16))) char lds[];
    volatile LAS unsigned* st = (volatile LAS unsigned*)(lds + LDS_MAIN);
    if (threadIdx.x == 0) { st[0] = 0u; st[1] = 0u; }
    __syncthreads();
    XcdBarrier bar = xcd_barrier_post(wsp<unsigned>(p, OFF_BAR), st);
#if USE_CG_SYNC
#define GRID_BARRIER() do { asm volatile("s_waitcnt vmcnt(0)" ::: "memory"); __syncthreads(); cg::this_grid().sync(); asm volatile("s_waitcnt vmcnt(0)" ::: "memory"); __syncthreads(); } while (0)
#else
#define GRID_BARRIER() xcd_barrier(bar)
#endif
#define RUN_PHASE(k, call) if (ph_lo <= (k) && (k) < ph_hi) { if ((k) > ph_lo) { GRID_BARRIER(); } call; }
    RUN_PHASE(0, phase0(p, lds))
    RUN_PHASE(1, phase1(p, lds))
    RUN_PHASE(2, phase2(p, lds))
    RUN_PHASE(3, phase3(p, lds))
    RUN_PHASE(4, phase_resid(p, lds, OFF_ZA, OFF_WOUTT, p.x, OFF_X1B, OFF_SS1))
    RUN_PHASE(5, phase5a(p, lds))
    RUN_PHASE(6, phase5b(p, lds))
    RUN_PHASE(7, phase_resid(p, lds, OFF_OM, OFF_WMOT, p.out, OFF_X2B, OFF_SS2))
    RUN_PHASE(8, phase7(p, lds))
    RUN_PHASE(9, phase8(p, lds))
    RUN_PHASE(10, phase9(p, lds))
    RUN_PHASE(11, phase10(p, lds))
    RUN_PHASE(12, phase11(p, lds))
}

extern "C" void kernel_launch(void* const* d_in, const int* in_sizes, int n_in,
                              void* d_out, int out_size, void* d_ws, size_t ws_size,
                              hipStream_t stream) {
    static int grid = 0;
    if (grid == 0) {
        if (n_in != 22 || ws_size < WS_END) { fprintf(stderr, "kernel_launch: unexpected inputs (n_in %d, ws %zu < %zu)\n", n_in, ws_size, (size_t)WS_END); grid = -1; return; }
        int dev = 0, cus = 0, per_cu = 0;
        (void)hipGetDevice(&dev);
        (void)hipDeviceGetAttribute(&cus, hipDeviceAttributeMultiprocessorCount, dev);
        if (hipFuncSetAttribute((const void*)k_fwd, hipFuncAttributeMaxDynamicSharedMemorySize, LDS_TOTAL) != hipSuccess) { fprintf(stderr, "kernel_launch: hipFuncSetAttribute failed\n"); grid = -1; return; }
        if (hipOccupancyMaxActiveBlocksPerMultiprocessor(&per_cu, (const void*)k_fwd, 256, LDS_TOTAL) != hipSuccess || per_cu < 1) { fprintf(stderr, "kernel_launch: occupancy query failed (%d)\n", per_cu); (void)hipGetLastError(); per_cu = 1; }
        if (per_cu > 2) per_cu = 2;
        grid = cus * per_cu;
        fprintf(stderr, "kernel_launch: %d CUs x %d blocks\n", cus, per_cu);
    }
    if (grid < 0) return;
    Params p{};
    p.x = (const float*)d_in[0]; p.mem = (const float*)d_in[1]; p.pos = (const int*)d_in[2];
    p.g_mix = (const float*)d_in[3]; p.w_in = (const float*)d_in[4]; p.g_q_lat = (const float*)d_in[5]; p.w_q_up = (const float*)d_in[6];
    p.g_kv_lat = (const float*)d_in[7]; p.w_kv_up = (const float*)d_in[8]; p.w_fourier = (const float*)d_in[9]; p.w_out = (const float*)d_in[10];
    p.g_mem_q = (const float*)d_in[11]; p.g_mem_kv = (const float*)d_in[12]; p.w_mem_q = (const float*)d_in[13]; p.w_mem_kv = (const float*)d_in[14];
    p.w_mem_o = (const float*)d_in[15]; p.g_ffn = (const float*)d_in[16]; p.w_router = (const float*)d_in[17];
    p.w_exp_gate = (const float*)d_in[18]; p.w_exp_up = (const float*)d_in[19]; p.w_exp_down = (const float*)d_in[20]; p.g_final = (const float*)d_in[21];
    p.out = (float*)d_out; p.ws = (char*)d_ws;
    static const int cuts[] = MK_CUTS;
    const int ncut = (int)(sizeof(cuts) / sizeof(int));
    for (int li = 0; li + 1 < ncut; li++) {
        (void)hipMemsetAsync((char*)d_ws + OFF_BAR, 0, 16384, stream);
        int lo = cuts[li], hi = cuts[li + 1];
        void* args[] = {&p, &lo, &hi};
        hipError_t e = hipLaunchCooperativeKernel((const void*)k_fwd, dim3(grid), dim3(256), args, LDS_TOTAL, stream);
        if (e != hipSuccess) fprintf(stderr, "cooperative launch failed: %s (grid %d)\n", hipGetErrorString(e), grid);
    }
}
```

```cpp
#include <hip/hip_runtime.h>
#include <stdint.h>
#include <cstdio>
#include <hip/hip_cooperative_groups.h>
namespace cg = cooperative_groups;
#ifndef USE_CG_SYNC
#define USE_CG_SYNC 0
#endif

#ifndef MK_CUTS
#define MK_CUTS {0, 13}
#endif

#define NB 4
#define NS 4096
#define ND 1024
#define NT (NB * NS)
#define INW 1184
#define NE 16
#define CAP 512
#define MEML 256
#define NPHASE 13

typedef unsigned short bf16_t;
typedef short bf16x8 __attribute__((ext_vector_type(8)));
typedef float f32x4 __attribute__((ext_vector_type(4)));
typedef float f32x16 __attribute__((ext_vector_type(16)));
typedef unsigned u32x4 __attribute__((ext_vector_type(4)));
typedef unsigned u32x2 __attribute__((ext_vector_type(2)));

__device__ __forceinline__ unsigned f2bf(float f) {
    unsigned u = __float_as_uint(f);
    u += 0x7FFFu + ((u >> 16) & 1u);
    return u >> 16;
}
typedef __bf16 hbf2 __attribute__((ext_vector_type(2)));
typedef float f32x2 __attribute__((ext_vector_type(2)));
__device__ __forceinline__ unsigned pack2bf(float lo, float hi) { f32x2 v = {lo, hi}; return __builtin_bit_cast(unsigned, __builtin_convertvector(v, hbf2)); }
__device__ __forceinline__ float bf2f(unsigned short b) { return __uint_as_float(((unsigned)b) << 16); }

__device__ __forceinline__ int tile_off(int row, int chunk) { return row * 128 + ((chunk ^ ((row >> 1) & 7)) << 4); }

#define GT_LDS_BYTES 65536

struct GemmTile { const bf16_t* A; long lda; const int* arow; const bf16_t* Bt; long ldb; int K; };

__device__ __forceinline__ void gemm_tile_128(const GemmTile& g, char* lds, f32x4 (&acc)[4][4]) {
    const int tid = threadIdx.x, lane = tid & 63, wid = tid >> 6, wm = wid >> 1, wn = wid & 1;
    const int lrow = lane >> 3, pc = lane & 7;
    const bf16_t* ap[4]; const bf16_t* bp[4];
#pragma unroll
    for (int i = 0; i < 4; i++) {
        const int r = (wid * 4 + i) * 8 + lrow;
        const int c = pc ^ ((r >> 1) & 7);
        const long ro = g.arow ? (long)g.arow[r] * g.lda : (long)r * g.lda;
        ap[i] = g.A + ro + c * 8;
        bp[i] = g.Bt + (long)r * g.ldb + c * 8;
    }
#pragma unroll
    for (int mi = 0; mi < 4; mi++)
#pragma unroll
        for (int ni = 0; ni < 4; ni++) acc[mi][ni] = (f32x4){0.f, 0.f, 0.f, 0.f};
    const int nk = g.K >> 6;
    auto stage = [&](int kt, char* st) {
#pragma unroll
        for (int i = 0; i < 4; i++) {
            __builtin_amdgcn_global_load_lds((const unsigned*)(ap[i] + kt * 64), (unsigned*)(st + (wid * 4 + i) * 1024), 16, 0, 0);
            __builtin_amdgcn_global_load_lds((const unsigned*)(bp[i] + kt * 64), (unsigned*)(st + 16384 + (wid * 4 + i) * 1024), 16, 0, 0);
        }
    };
    __syncthreads();
    stage(0, lds);
    asm volatile("s_waitcnt vmcnt(0)" ::: "memory");
    __syncthreads();
    for (int kt = 0; kt < nk; kt++) {
        char* cur = lds + (kt & 1) * 32768;
        if (kt + 1 < nk) stage(kt + 1, lds + ((kt + 1) & 1) * 32768);
#pragma unroll
        for (int ks = 0; ks < 2; ks++) {
            bf16x8 af[4], bfr[4];
#pragma unroll
            for (int i = 0; i < 4; i++) {
                af[i] = *(const bf16x8*)(cur + tile_off(wm * 64 + i * 16 + (lane & 15), ks * 4 + (lane >> 4)));
                bfr[i] = *(const bf16x8*)(cur + 16384 + tile_off(wn * 64 + i * 16 + (lane & 15), ks * 4 + (lane >> 4)));
            }
            __builtin_amdgcn_s_setprio(1);
#pragma unroll
            for (int mi = 0; mi < 4; mi++)
#pragma unroll
                for (int ni = 0; ni < 4; ni++)
                    acc[mi][ni] = __builtin_amdgcn_mfma_f32_16x16x32_bf16(bfr[ni], af[mi], acc[mi][ni], 0, 0, 0);
            __builtin_amdgcn_s_setprio(0);
        }
        asm volatile("s_waitcnt vmcnt(0)" ::: "memory");
        __syncthreads();
    }
}

template <int DQK, int DVT, int KT>
struct AttnCfg {
    static constexpr int KROW = DQK * 2 + 16;
    static constexpr int VROW = KT * 2 + 8;
    static constexpr int KBYTES = KT * KROW;
    static constexpr int VBYTES = DVT * VROW;
    static constexpr int STAGE = KBYTES + VBYTES;
    static constexpr int LDS = 2 * STAGE;
};

template <int DQK, int DVT, int KT, class Out>
__device__ __forceinline__ void attn_block(const bf16_t* Qp, const bf16_t* Kp, const bf16_t* Vtp, long ldv, int nk, char* lds, Out&& out) {
    typedef AttnCfg<DQK, DVT, KT> C;
    constexpr int NKS = DQK / 16, NST = KT / 32, NDT = DVT / 32, NPS = KT / 16;
    constexpr int KCPR = DQK / 8;
    constexpr int KCH = KT * KCPR / 256;
    constexpr int VCPR = KT / 8;
    constexpr int VCH = DVT * VCPR / 256;
    const int tid = threadIdx.x, lane = tid & 63, wid = tid >> 6, h = lane >> 5, c = lane & 31;

    bf16x8 qf[NKS];
    {
        const bf16_t* qrow = Qp + (long)(wid * 32 + c) * DQK + 8 * h;
#pragma unroll
        for (int ks = 0; ks < NKS; ks++) qf[ks] = *(const bf16x8*)(qrow + 16 * ks);
    }
    f32x16 o[NDT];
#pragma unroll
    for (int dt = 0; dt < NDT; dt++)
#pragma unroll
        for (int r = 0; r < 16; r++) o[dt][r] = 0.f;
    float m = 0.f, l = 0.f;

    u32x4 kr[KCH], vr[VCH];
    auto gload = [&](int t) {
#pragma unroll
        for (int i = 0; i < KCH; i++) {
            const int ci = tid + 256 * i, row = ci / KCPR, cc = ci % KCPR;
            kr[i] = *(const u32x4*)(Kp + (long)(t * KT + row) * DQK + cc * 8);
        }
#pragma unroll
        for (int i = 0; i < VCH; i++) {
            const int ci = tid + 256 * i, row = ci / VCPR, cc = ci % VCPR;
            vr[i] = *(const u32x4*)(Vtp + (long)row * ldv + t * KT + cc * 8);
        }
    };
    auto lwrite = [&](char* st) {
#pragma unroll
        for (int i = 0; i < KCH; i++) {
            const int ci = tid + 256 * i, row = ci / KCPR, cc = ci % KCPR;
            *(u32x4*)(st + row * C::KROW + cc * 16) = kr[i];
        }
#pragma unroll
        for (int i = 0; i < VCH; i++) {
            const int ci = tid + 256 * i, row = ci / VCPR, cc = ci % VCPR;
            char* p = st + C::KBYTES + row * C::VROW + cc * 16;
            *(u32x2*)(p) = (u32x2){vr[i].x, vr[i].y};
            *(u32x2*)(p + 8) = (u32x2){vr[i].z, vr[i].w};
        }
    };
    const int nt = nk / KT;
    gload(0);
    __syncthreads();
    lwrite(lds);
    __syncthreads();
    for (int t = 0; t < nt; t++) {
        char* cur = lds + (t & 1) * C::STAGE;
        if (t + 1 < nt) gload(t + 1);
        f32x16 s[NST];
        const float negm = -m;
#pragma unroll
        for (int st = 0; st < NST; st++) {
#pragma unroll
            for (int r = 0; r < 16; r++) s[st][r] = negm;
#pragma unroll
            for (int ks = 0; ks < NKS; ks++) {
                const bf16x8 kf = *(const bf16x8*)(cur + (st * 32 + c) * C::KROW + ks * 32 + h * 16);
                s[st] = __builtin_amdgcn_mfma_f32_32x32x16_bf16(kf, qf[ks], s[st], 0, 0, 0);
            }
        }
        float mx = s[0][0];
#pragma unroll
        for (int st = 0; st < NST; st++)
#pragma unroll
            for (int r = 0; r < 16; r++) mx = fmaxf(mx, s[st][r]);
        mx = fmaxf(mx, __shfl_xor(mx, 32));
        if (__any(mx > 8.0f)) {
            const float d = fmaxf(mx, 0.f);
            const float alpha = __builtin_amdgcn_exp2f(-d);
            m += d;
            l *= alpha;
#pragma unroll
            for (int dt = 0; dt < NDT; dt++)
#pragma unroll
                for (int r = 0; r < 16; r++) o[dt][r] *= alpha;
#pragma unroll
            for (int st = 0; st < NST; st++)
#pragma unroll
                for (int r = 0; r < 16; r++) s[st][r] -= d;
        }
        float rs = 0.f;
#pragma unroll
        for (int st = 0; st < NST; st++)
#pragma unroll
            for (int r = 0; r < 16; r++) { const float p = __builtin_amdgcn_exp2f(s[st][r]); rs += p; s[st][r] = p; }
        l += rs;
#pragma unroll
        for (int ps = 0; ps < NPS; ps++) {
            const int st = ps >> 1, u = ps & 1;
            u32x4 pw;
            pw.x = pack2bf(s[st][8 * u + 0], s[st][8 * u + 1]);
            pw.y = pack2bf(s[st][8 * u + 2], s[st][8 * u + 3]);
            pw.z = pack2bf(s[st][8 * u + 4], s[st][8 * u + 5]);
            pw.w = pack2bf(s[st][8 * u + 6], s[st][8 * u + 7]);
            const bf16x8 pf = __builtin_bit_cast(bf16x8, pw);
#pragma unroll
            for (int dt = 0; dt < NDT; dt++) {
                const char* vp = cur + C::KBYTES + (dt * 32 + c) * C::VROW + (ps * 16 + 4 * h) * 2;
                const u32x2 v0 = *(const u32x2*)(vp);
                const u32x2 v1 = *(const u32x2*)(vp + 16);
                const bf16x8 vf = __builtin_bit_cast(bf16x8, ((u32x4){v0.x, v0.y, v1.x, v1.y}));
                o[dt] = __builtin_amdgcn_mfma_f32_32x32x16_bf16(vf, pf, o[dt], 0, 0, 0);
            }
        }
        if (t + 1 < nt) lwrite(lds + ((t + 1) & 1) * C::STAGE);
        __syncthreads();
    }
    l += __shfl_xor(l, 32);
    const float inv = 1.f / l;
#pragma unroll
    for (int dt = 0; dt < NDT; dt++)
#pragma unroll
        for (int g4 = 0; g4 < 4; g4++) {
            f32x4 v = {o[dt][4 * g4 + 0] * inv, o[dt][4 * g4 + 1] * inv, o[dt][4 * g4 + 2] * inv, o[dt][4 * g4 + 3] * inv};
            out(wid * 32 + c, dt * 32 + 8 * g4 + 4 * h, v);
        }
}


constexpr size_t SLOT = 33554432;
constexpr size_t OFF_W1T = 0;
constexpr size_t OFF_WQT = OFF_W1T + 1280UL * 1024 * 2;
constexpr size_t OFF_WKVT = OFF_WQT + 768UL * 384 * 2;
constexpr size_t OFF_WOUTT = OFF_WKVT + 1024UL * 256 * 2;
constexpr size_t OFF_WMQT = OFF_WOUTT + 1024UL * 1024 * 2;
constexpr size_t OFF_WMKVT = OFF_WMQT + 1024UL * 1024 * 2;
constexpr size_t OFF_WMOT = OFF_WMKVT + 2048UL * 1024 * 2;
constexpr size_t OFF_WGUT = OFF_WMOT + 1024UL * 1024 * 2;
constexpr size_t OFF_WDT = OFF_WGUT + 16UL * 2048 * 1024 * 2;
constexpr size_t OFF_T64 = OFF_WDT + 16UL * 1024 * 1024 * 2;
constexpr size_t OFF_M1 = OFF_T64 + 16384;
constexpr size_t OFF_M3 = OFF_M1 + 32768;
constexpr size_t OFF_WFT = OFF_M3 + 16384;
constexpr size_t OFF_TW = OFF_WFT + 65536;
constexpr size_t OFF_ROPE = OFF_TW + 32768;
constexpr size_t OFF_R0 = OFF_ROPE + (size_t)NT * 16 * 8;
constexpr size_t OFF_RMEM = OFF_R0 + (size_t)NT * 4;
constexpr size_t OFF_SSQ = OFF_RMEM + 4096;
constexpr size_t OFF_SSKV = OFF_SSQ + (size_t)NT * 6 * 4;
constexpr size_t OFF_SS1 = OFF_SSKV + (size_t)NT * 4 * 4;
constexpr size_t OFF_SS2 = OFF_SS1 + (size_t)NT * 16 * 4;
constexpr size_t OFF_AFF = OFF_SS2 + (size_t)NT * 16 * 4;
constexpr size_t OFF_SLOTS = OFF_AFF + (size_t)NT * 16 * 4;
constexpr size_t OFF_IDX = OFF_SLOTS + 4UL * 16 * 4096 * 4;
constexpr size_t OFF_GATE = OFF_IDX + 4UL * 16 * 512 * 4;
constexpr size_t OFF_MEMB = OFF_GATE + 4UL * 16 * 512 * 4;
constexpr size_t OFF_KMEM = OFF_MEMB + 1024UL * 1024 * 2;
constexpr size_t OFF_VTMEM = OFF_KMEM + 1024UL * 1024 * 2;
constexpr size_t OFF_KR = OFF_VTMEM + 1024UL * 1024 * 2;
constexpr size_t OFF_BAR = OFF_KR + (size_t)NT * 32 * 2;
constexpr size_t OFF_S0 = (OFF_BAR + 16384 + 255) / 256 * 256;
constexpr size_t OFF_S1 = OFF_S0 + SLOT;
constexpr size_t OFF_S2 = OFF_S1 + SLOT;
constexpr size_t OFF_S3 = OFF_S2 + SLOT;
constexpr size_t OFF_S4 = OFF_S3 + SLOT;
constexpr size_t WS_END = OFF_S4 + SLOT;
static_assert(WS_END <= 300964352UL, "workspace map exceeds the guaranteed scratch size");
constexpr size_t OFF_XB = OFF_S0, OFF_YR = OFF_S0, OFF_YI = OFF_S0 + SLOT / 2, OFF_X1B = OFF_S0, OFF_OM = OFF_S0, OFF_ACT = OFF_S0;
constexpr size_t OFF_UF = OFF_S1, OFF_UQ = OFF_S1 + (size_t)NT * 512 * 2, OFF_ZA = OFF_S1, OFF_QM = OFF_S1;
constexpr size_t OFF_Q = OFF_S2, OFF_UKV = OFF_S2 + (size_t)NT * 768 * 2, OFF_X2B = OFF_S2;
constexpr size_t OFF_K = OFF_S3, OFF_Y = OFF_S3;
constexpr size_t OFF_VT = OFF_S4;

struct Params {
    const float *x, *mem; const int* pos;
    const float *g_mix, *w_in, *g_q_lat, *w_q_up, *g_kv_lat, *w_kv_up, *w_fourier, *w_out, *g_mem_q, *g_mem_kv, *w_mem_q, *w_mem_kv, *w_mem_o,
        *g_ffn, *w_router, *w_exp_gate, *w_exp_up, *w_exp_down, *g_final;
    float* out; char* ws;
};
template <class T> __device__ __forceinline__ T* wsp(const Params& p, size_t off) { return (T*)(p.ws + off); }

#define LDS_MAIN 65536
#define LDS_TOTAL (LDS_MAIN + 16)
#define LAS __attribute__((address_space(3)))

#define XB_TMO      128
#define XB_XCNT(j)  (256  + 64 * (j))
#define XB_XSUB(j)  (1280 + 64 * (j))
#define XB_XGEN(j)  (2304 + 64 * (j))
#define XB_TOP      3328
#define XB_TOPGEN   3392
#define XCD_BAR_WORDS 3456
#define XB_SPIN_CAP (1u << 25)
__device__ __forceinline__ unsigned xb_ld(unsigned* p)              { return __hip_atomic_load(p, __ATOMIC_RELAXED, __HIP_MEMORY_SCOPE_AGENT); }
__device__ __forceinline__ unsigned xb_add(unsigned* p, unsigned v) { return __hip_atomic_fetch_add(p, v, __ATOMIC_RELAXED, __HIP_MEMORY_SCOPE_AGENT); }
__device__ __forceinline__ unsigned xb_xcc_id() { return (unsigned)__builtin_amdgcn_s_getreg((3 << 11) | 20) & 0xFu; }
#define XB_SPIN(cond, bar) do { unsigned _sp = 0; while (cond) { __builtin_amdgcn_s_sleep(1); \
    if ((++_sp & 255u) == 0u) { if (xb_ld(&(bar)[XB_TMO])) break; if (_sp > XB_SPIN_CAP) { atomicAdd(&(bar)[XB_TMO], 1u); break; } } } } while (0)
struct XcdBarrier { unsigned* bar; unsigned x; volatile LAS unsigned* st; };
__device__ __forceinline__ XcdBarrier xcd_barrier_post(unsigned* bar, volatile LAS unsigned* st) {
    XcdBarrier b; b.bar = bar; b.x = xb_xcc_id(); b.st = st;
    if (threadIdx.x == 0) (void)xb_add(&bar[XB_XCNT(b.x)], 1u);
    return b;
}
__device__ __forceinline__ void xcd_barrier_complete(unsigned* bar, unsigned x, unsigned& nloc, unsigned& nx) {
    const unsigned G = gridDim.x * gridDim.y * gridDim.z;
    unsigned sum, cnt, mine, sp = 0u;
    for (;;) {
        sum = 0u; cnt = 0u; mine = 0u;
#pragma unroll
        for (unsigned j = 0; j < 16; ++j) { const unsigned c = xb_ld(&bar[XB_XCNT(j)]); sum += c; cnt += (c > 0u) ? 1u : 0u; mine = (j == x) ? c : mine; }
        if (sum == G) break;
        __builtin_amdgcn_s_sleep(1);
        if ((++sp & 255u) == 0u) { if (xb_ld(&bar[XB_TMO])) break; if (sp > XB_SPIN_CAP) { atomicAdd(&bar[XB_TMO], 1u); break; } }
    }
    nloc = mine > 0u ? mine : 1u; nx = cnt > 0u ? cnt : 1u;
}
__device__ __forceinline__ void xcd_barrier(const XcdBarrier& b) {
    asm volatile("s_waitcnt vmcnt(0)" ::: "memory");
    __syncthreads();
    if (threadIdx.x == 0) {
        unsigned* bar = b.bar;
        __builtin_amdgcn_s_waitcnt(0);
        unsigned nloc = b.st[0], nx = b.st[1];
        if (nloc == 0u) { xcd_barrier_complete(bar, b.x, nloc, nx); b.st[0] = nloc; b.st[1] = nx; }
        const unsigned old = xb_add(&bar[XB_XSUB(b.x)], 1u);
        const unsigned gen = old / nloc;
        if (old + 1u == (gen + 1u) * nloc) {
            __builtin_amdgcn_fence(__ATOMIC_RELEASE, "agent");
            asm volatile("s_waitcnt vmcnt(0)" ::: "memory");
            const unsigned og = xb_add(&bar[XB_TOP], 1u);
            const unsigned tg = og / nx;
            if (og + 1u == (tg + 1u) * nx) xb_add(&bar[XB_TOPGEN], 1u);
            else XB_SPIN(xb_ld(&bar[XB_TOPGEN]) == tg, bar);
            __builtin_amdgcn_fence(__ATOMIC_ACQUIRE, "agent");
            xb_add(&bar[XB_XGEN(b.x)], 1u);
            asm volatile("s_waitcnt vmcnt(0)" ::: "memory");
        } else {
            XB_SPIN(xb_ld(&bar[XB_XGEN(b.x)]) == gen, bar);
            __builtin_amdgcn_fence(__ATOMIC_ACQUIRE, "agent");
            asm volatile("s_waitcnt vmcnt(0)" ::: "memory");
        }
    }
    __syncthreads();
}

#define FOR_XCD_ITEMS(item, N) for (int _L = (int)(blockIdx.x >> 3), item; _L < (N) / 8 && ((item = (int)(blockIdx.x & 7) * ((N) / 8) + _L), true); _L += (int)(gridDim.x >> 3))

__device__ __forceinline__ u32x2 pack4bf(float a, float b, float c, float d) { return (u32x2){pack2bf(a, b), pack2bf(c, d)}; }
__device__ __forceinline__ u32x2 pack4bf(f32x4 v) { return (u32x2){pack2bf(v[0], v[1]), pack2bf(v[2], v[3])}; }
__device__ __forceinline__ float wave_sum(float v) {
#pragma unroll
    for (int o = 32; o > 0; o >>= 1) v += __shfl_xor(v, o);
    return v;
}

__device__ __forceinline__ void tr_tile(const float* W, long ldw, int k0, int n0, int nvalid, const float* gain, bf16_t* Wt, long ldt, int mode, char* lds) {
    float (*t)[132] = (float (*)[132])lds;
    const int tid = threadIdx.x, c4 = tid & 31, r0 = tid >> 5;
    f32x4 v[8];
#pragma unroll
    for (int i = 0; i < 8; i++) {
        const int kk = r0 + 8 * i, n = n0 + c4 * 4;
        v[i] = (n < nvalid) ? *(const f32x4*)(W + (long)(k0 + kk) * ldw + n) : (f32x4){0.f, 0.f, 0.f, 0.f};
        if (gain) v[i] *= gain[k0 + kk];
    }
    __syncthreads();
#pragma unroll
    for (int i = 0; i < 8; i++) *(f32x4*)(&t[r0 + 8 * i][c4 * 4]) = v[i];
    __syncthreads();
#pragma unroll
    for (int i = 0; i < 4; i++) {
        const int ci = tid + 256 * i, nn = ci >> 3, kc = ci & 7;
        const int n = n0 + nn;
        int row = n;
        if (mode) row = (n >> 5) * 64 + ((n >> 4) & 1) * 32 + (mode - 1) * 16 + (n & 15);
        u32x4 w;
        w.x = pack2bf(t[kc * 8 + 0][nn], t[kc * 8 + 1][nn]);
        w.y = pack2bf(t[kc * 8 + 2][nn], t[kc * 8 + 3][nn]);
        w.z = pack2bf(t[kc * 8 + 4][nn], t[kc * 8 + 5][nn]);
        w.w = pack2bf(t[kc * 8 + 6][nn], t[kc * 8 + 7][nn]);
        *(u32x4*)(Wt + (long)row * ldt + k0 + kc * 8) = w;
    }
}

__device__ __forceinline__ void phase0(const Params& p, char* lds) {
    constexpr int J_W1 = 160, J_WQ = 36, J_WKV = 32, J_WOUT = 128, J_WMQ = 128, J_WMKV = 256, J_WMO = 128, J_WG = 0, J_WU = 0, J_WD = 0;
    constexpr int J_TR = J_W1 + J_WQ + J_WKV + J_WOUT + J_WMQ + J_WMKV + J_WMO + J_WG + J_WU + J_WD;
    constexpr int J_XR = NT / 4, J_MR = 1024 / 4, J_ROPE = NT * 16 / 256, J_TAB = (4096 + 8192 + 16384 + 8192 + 32768) / 256;
    constexpr int J_ALL = J_TR + J_XR + J_MR + J_ROPE + J_TAB;
    const int tid = threadIdx.x, lane = tid & 63, wid = tid >> 6;
    const double PI2 = 6.283185307179586476925286766559;
    for (int job = blockIdx.x; job < J_ALL; job += gridDim.x) {
        int j = job;
        if (j < J_TR) {
            if (j < J_W1) { tr_tile(p.w_in, INW, (j / 10) * 64, (j % 10) * 128, INW, p.g_mix, wsp<bf16_t>(p, OFF_W1T), 1024, 0, lds); continue; } j -= J_W1;
            if (j < J_WQ) { tr_tile(p.w_q_up, 768, (j / 6) * 64, (j % 6) * 128, 768, p.g_q_lat, wsp<bf16_t>(p, OFF_WQT), 384, 0, lds); continue; } j -= J_WQ;
            if (j < J_WKV) { tr_tile(p.w_kv_up, 1024, (j / 8) * 64, (j % 8) * 128, 1024, p.g_kv_lat, wsp<bf16_t>(p, OFF_WKVT), 256, 0, lds); continue; } j -= J_WKV;
            if (j < J_WOUT) { tr_tile(p.w_out, 1024, (j / 8) * 64, (j % 8) * 128, 1024, nullptr, wsp<bf16_t>(p, OFF_WOUTT), 1024, 0, lds); continue; } j -= J_WOUT;
            if (j < J_WMQ) { tr_tile(p.w_mem_q, 1024, (j / 8) * 64, (j % 8) * 128, 1024, p.g_mem_q, wsp<bf16_t>(p, OFF_WMQT), 1024, 0, lds); continue; } j -= J_WMQ;
            if (j < J_WMKV) { tr_tile(p.w_mem_kv, 2048, (j / 16) * 64, (j % 16) * 128, 2048, p.g_mem_kv, wsp<bf16_t>(p, OFF_WMKVT), 1024, 0, lds); continue; } j -= J_WMKV;
            if (j < J_WMO) { tr_tile(p.w_mem_o, 1024, (j / 8) * 64, (j % 8) * 128, 1024, nullptr, wsp<bf16_t>(p, OFF_WMOT), 1024, 0, lds); continue; } j -= J_WMO;
            if (j < J_WG) { const int e = j >> 7, r = j & 127; tr_tile(p.w_exp_gate + (long)e * 1048576, 1024, (r / 8) * 64, (r % 8) * 128, 1024, p.g_ffn, wsp<bf16_t>(p, OFF_WGUT) + (long)e * 2048 * 1024, 1024, 1, lds); continue; } j -= J_WG;
            if (j < J_WU) { const int e = j >> 7, r = j & 127; tr_tile(p.w_exp_up + (long)e * 1048576, 1024, (r / 8) * 64, (r % 8) * 128, 1024, p.g_ffn, wsp<bf16_t>(p, OFF_WGUT) + (long)e * 2048 * 1024, 1024, 2, lds); continue; } j -= J_WU;
            { const int e = j >> 7, r = j & 127; tr_tile(p.w_exp_down + (long)e * 1048576, 1024, (r / 8) * 64, (r % 8) * 128, 1024, nullptr, wsp<bf16_t>(p, OFF_WDT) + (long)e * 1048576, 1024, 0, lds); continue; }
        }
        j -= J_TR;
        if (j < J_XR + J_MR) {
            const bool isx = j < J_XR;
            const int row = (isx ? j : j - J_XR) * 4 + wid;
            const float* src = (isx ? p.x : p.mem) + (long)row * ND;
            bf16_t* dst = (isx ? wsp<bf16_t>(p, OFF_XB) : wsp<bf16_t>(p, OFF_MEMB)) + (long)row * ND;
            float ss = 0.f;
#pragma unroll
            for (int i = 0; i < 4; i++) {
                const f32x4 v = *(const f32x4*)(src + i * 256 + lane * 4);
                ss += v[0] * v[0] + v[1] * v[1] + v[2] * v[2] + v[3] * v[3];
                *(u32x2*)(dst + i * 256 + lane * 4) = pack4bf(v);
            }
            ss = wave_sum(ss);
            if (lane == 0) (isx ? wsp<float>(p, OFF_R0) : wsp<float>(p, OFF_RMEM))[row] = rsqrtf(ss * (1.f / ND) + 1e-6f);
            continue;
        }
        j -= J_XR + J_MR;
        if (j < J_ROPE) {
            const int i = j * 256 + tid; const int t = i >> 4, jj = i & 15;
            const double f = pow(10000.0, -(double)(2 * jj) / 32.0);
            const double ang = (double)p.pos[t] * f;
            wsp<float2>(p, OFF_ROPE)[i] = make_float2((float)cos(ang), (float)sin(ang));
            continue;
        }
        j -= J_ROPE;
        {
            int i = j * 256 + tid;
            if (i < 4096) { const double a = PI2 * (double)i / 4096.0; wsp<float2>(p, OFF_TW)[i] = make_float2((float)cos(a), (float)sin(a)); continue; } i -= 4096;
            if (i < 8192) {
                const int T = i >> 12, a = (i >> 6) & 63, b = i & 63;
                const double th = PI2 * (double)((a * b) & 63) / 64.0;
                wsp<bf16_t>(p, OFF_T64)[i] = (bf16_t)f2bf((float)(T ? sin(th) : cos(th))); continue;
            } i -= 8192;
            if (i < 16384) {
                const int rho = i >> 7, k = i & 127;
                const int wm = rho >> 6, mi = (rho >> 4) & 3, lr = rho & 15, ri = mi >> 1, k1 = 32 * wm + 16 * (mi & 1) + lr, ab = k >> 6, s1 = k & 63;
                const double th = PI2 * (double)((k1 * s1) & 63) / 64.0;
                const double c = cos(th), s = sin(th);
                const double v = ri == 0 ? (ab == 0 ? c : -s) : (ab == 0 ? s : c);
                wsp<bf16_t>(p, OFF_M1)[i] = (bf16_t)f2bf((float)v); continue;
            } i -= 16384;
            if (i < 8192) {
                const int k2 = i >> 7, k = i & 127, s2 = k & 63;
                const double th = PI2 * (double)((k2 * s2) & 63) / 64.0;
                wsp<bf16_t>(p, OFF_M3)[i] = (bf16_t)f2bf((float)(k < 64 ? cos(th) : -sin(th))); continue;
            } i -= 8192;
            if (i < 32768) {
                const int g = i >> 12, e = (i >> 6) & 63, ch = i & 63;
                wsp<bf16_t>(p, OFF_WFT)[i] = (bf16_t)f2bf(p.w_fourier[(g * 64 + ch) * 64 + e]); continue;
            }
        }
    }
}

__device__ __forceinline__ void phase1(const Params& p, char* lds) {
    const int tid = threadIdx.x, lane = tid & 63, wid = tid >> 6, wm = wid >> 1, wn = wid & 1, lq = lane >> 4, lr = lane & 15;
    constexpr int N_U = 128 * 10, N_M = 8 * 16;
    {
      FOR_XCD_ITEMS(item, N_U) {
        f32x4 acc[4][4];
        {
            const int tm = item / 10, tn = item % 10;
            GemmTile g; g.A = wsp<bf16_t>(p, OFF_XB) + (long)tm * 128 * ND; g.lda = ND; g.arow = nullptr;
            g.Bt = wsp<bf16_t>(p, OFF_W1T) + (long)tn * 128 * ND; g.ldb = ND; g.K = ND;
            gemm_tile_128(g, lds, acc);
            const float* r0 = wsp<float>(p, OFF_R0);
#pragma unroll
            for (int mi = 0; mi < 4; mi++) {
                const int row = tm * 128 + wm * 64 + mi * 16 + lr;
                const float rs = r0[row];
#pragma unroll
                for (int ni = 0; ni < 4; ni++) acc[mi][ni] *= rs;
                if (tn < 4) {
#pragma unroll
                    for (int ni = 0; ni < 4; ni++)
                        *(u32x2*)(wsp<bf16_t>(p, OFF_UF) + (long)row * 512 + tn * 128 + wn * 64 + ni * 16 + 4 * lq) = pack4bf(acc[mi][ni]);
                } else if (tn < 9) {
                    float ss = 0.f;
#pragma unroll
                    for (int ni = 0; ni < 4; ni++) { const f32x4 v = acc[mi][ni]; ss += v[0] * v[0] + v[1] * v[1] + v[2] * v[2] + v[3] * v[3]; }
                    ss += __shfl_xor(ss, 16); ss += __shfl_xor(ss, 32);
                    if (tn < 7) {
#pragma unroll
                        for (int ni = 0; ni < 4; ni++)
                            *(u32x2*)(wsp<bf16_t>(p, OFF_UQ) + (long)row * 384 + (tn - 4) * 128 + wn * 64 + ni * 16 + 4 * lq) = pack4bf(acc[mi][ni]);
                        if (lq == 0) wsp<float>(p, OFF_SSQ)[row * 6 + (tn - 4) * 2 + wn] = ss;
                    } else {
#pragma unroll
                        for (int ni = 0; ni < 4; ni++)
                            *(u32x2*)(wsp<bf16_t>(p, OFF_UKV) + (long)row * 256 + (tn - 7) * 128 + wn * 64 + ni * 16 + 4 * lq) = pack4bf(acc[mi][ni]);
                        if (lq == 0) wsp<float>(p, OFF_SSKV)[row * 4 + (tn - 7) * 2 + wn] = ss;
                    }
                } else if (wn == 0) {
                    const float2* rp = wsp<float2>(p, OFF_ROPE) + (long)row * 16 + 4 * lq;
                    f32x4 o1, o2;
#pragma unroll
                    for (int r = 0; r < 4; r++) {
                        const float2 cs = rp[r];
                        const float x1 = acc[mi][0][r], x2 = acc[mi][1][r];
                        o1[r] = x1 * cs.x - x2 * cs.y; o2[r] = x1 * cs.y + x2 * cs.x;
                    }
                    bf16_t* kr = wsp<bf16_t>(p, OFF_KR) + (long)row * 32;
                    *(u32x2*)(kr + 4 * lq) = pack4bf(o1);
                    *(u32x2*)(kr + 16 + 4 * lq) = pack4bf(o2);
                }
            }
        }
      }
      FOR_XCD_ITEMS(it, N_M) {
        f32x4 acc[4][4];
        {
            const int tm = it / 16, tn = it % 16;
            GemmTile g; g.A = wsp<bf16_t>(p, OFF_MEMB) + (long)tm * 128 * ND; g.lda = ND; g.arow = nullptr;
            g.Bt = wsp<bf16_t>(p, OFF_WMKVT) + (long)tn * 128 * ND; g.ldb = ND; g.K = ND;
            gemm_tile_128(g, lds, acc);
            const float* rm = wsp<float>(p, OFF_RMEM);
#pragma unroll
            for (int mi = 0; mi < 4; mi++) {
                const int row = tm * 128 + wm * 64 + mi * 16 + lr;
                const int b = row >> 8, m = row & 255;
                const float rs = rm[row];
#pragma unroll
                for (int ni = 0; ni < 4; ni++) {
                    const f32x4 v = acc[mi][ni] * rs;
                    const int col = tn * 128 + wn * 64 + ni * 16 + 4 * lq;
                    if (col < 1024) {
                        const int h = col >> 8, d = col & 255;
                        *(u32x2*)(wsp<bf16_t>(p, OFF_KMEM) + ((long)(b * 4 + h) * 256 + m) * 256 + d) = pack4bf(v);
                    } else {
                        const int c2 = col - 1024, h = c2 >> 8, dv = c2 & 255;
                        bf16_t* vt = wsp<bf16_t>(p, OFF_VTMEM) + ((long)(b * 4 + h) * 256 + dv) * 256 + m;
#pragma unroll
                        for (int r = 0; r < 4; r++) vt[r * 256] = (bf16_t)f2bf(v[r]);
                    }
                }
            }
        }
      }
    }
}

template <int MI>
__device__ __forceinline__ void dft_mma(const bf16_t* Ag, int arow0, const char* ximg, int ncol0, f32x4 (&acc)[MI][4]) {
    const int lane = threadIdx.x & 63, lq = lane >> 4, lr = lane & 15;
#pragma unroll
    for (int ks = 0; ks < 4; ks++) {
        bf16x8 af[MI], bfr[4];
#pragma unroll
        for (int mi = 0; mi < MI; mi++) af[mi] = *(const bf16x8*)(Ag + (long)(arow0 + mi * 16 + lr) * 128 + ks * 32 + lq * 8);
#pragma unroll
        for (int ni = 0; ni < 4; ni++) {
            const char* bp = ximg + (ks * 32 + lq * 8) * 272 + (ncol0 + ni * 16 + lr) * 2;
#pragma unroll
            for (int j = 0; j < 8; j++) bfr[ni][j] = *(const short*)(bp + j * 272);
        }
#pragma unroll
        for (int mi = 0; mi < MI; mi++)
#pragma unroll
            for (int ni = 0; ni < 4; ni++) acc[mi][ni] = __builtin_amdgcn_mfma_f32_16x16x32_bf16(bfr[ni], af[mi], acc[mi][ni], 0, 0, 0);
    }
}

__device__ __forceinline__ void f2a_item(const Params& p, int it, char* lds) {
    const int tid = threadIdx.x, lane = tid & 63, wid = tid >> 6, wm = wid >> 1, wn = wid & 1, lq = lane >> 4, lr = lane & 15;
    const int nc = it & 3, s2 = (it >> 2) & 63, b = it >> 8;
    char* uimg = lds; char* ximg = lds + 17408;
    __syncthreads();
#pragma unroll
    for (int i = 0; i < 4; i++) {
        const int ci = tid + 256 * i, row = ci >> 4, cc = ci & 15;
        *(u32x4*)(uimg + row * 272 + cc * 16) = *(const u32x4*)(wsp<bf16_t>(p, OFF_UF) + ((long)(b * NS + 64 * row + s2)) * 512 + nc * 128 + cc * 8);
    }
    __syncthreads();
    {
        const int g2 = wid >> 1, T = wid & 1;
        f32x4 a1[4][4];
#pragma unroll
        for (int mi = 0; mi < 4; mi++)
#pragma unroll
            for (int ni = 0; ni < 4; ni++) a1[mi][ni] = (f32x4){0.f, 0.f, 0.f, 0.f};
        const bf16_t* t64 = wsp<bf16_t>(p, OFF_T64) + T * 4096;
#pragma unroll
        for (int ks = 0; ks < 2; ks++) {
            bf16x8 af[4], bfr[4];
#pragma unroll
            for (int i = 0; i < 4; i++) {
                af[i] = *(const bf16x8*)(uimg + (i * 16 + lr) * 272 + (g2 * 64 + ks * 32 + lq * 8) * 2);
                bfr[i] = *(const bf16x8*)(t64 + (i * 16 + lr) * 64 + ks * 32 + lq * 8);
            }
#pragma unroll
            for (int mi = 0; mi < 4; mi++)
#pragma unroll
                for (int ni = 0; ni < 4; ni++) a1[mi][ni] = __builtin_amdgcn_mfma_f32_16x16x32_bf16(bfr[ni], af[mi], a1[mi][ni], 0, 0, 0);
        }
#pragma unroll
        for (int mi = 0; mi < 4; mi++)
#pragma unroll
            for (int ni = 0; ni < 4; ni++)
                *(u32x2*)(ximg + (T * 64 + mi * 16 + lr) * 272 + (g2 * 64 + ni * 16 + 4 * lq) * 2) = pack4bf(a1[mi][ni]);
    }
    __syncthreads();
    f32x4 acc[4][4];
#pragma unroll
    for (int mi = 0; mi < 4; mi++)
#pragma unroll
        for (int ni = 0; ni < 4; ni++) acc[mi][ni] = (f32x4){0.f, 0.f, 0.f, 0.f};
    dft_mma<4>(wsp<bf16_t>(p, OFF_M1), wm * 64, ximg, wn * 64, acc);
    const float2* tw = wsp<float2>(p, OFF_TW);
#pragma unroll
    for (int m2 = 0; m2 < 2; m2++) {
        const int k1 = 32 * wm + 16 * m2 + lr;
        float2 cs; { const float rev = (float)((s2 * k1) & 4095) * (1.0f / 4096.0f); cs.x = __builtin_amdgcn_cosf(rev); cs.y = __builtin_amdgcn_sinf(rev); (void)tw; }
        const long base = ((long)(b * 64 + k1) * 64 + s2) * 512 + nc * 128 + wn * 64 + 4 * lq;
#pragma unroll
        for (int ni = 0; ni < 4; ni++) {
            const f32x4 yr = acc[m2][ni], yi = acc[m2 + 2][ni];
            const f32x4 orr = yr * cs.x - yi * cs.y, oi = yi * cs.x + yr * cs.y;
            *(u32x2*)(wsp<bf16_t>(p, OFF_YR) + base + ni * 16) = pack4bf(orr);
            *(u32x2*)(wsp<bf16_t>(p, OFF_YI) + base + ni * 16) = pack4bf(oi);
        }
    }
}

__device__ __forceinline__ void f2b_item(const Params& p, int it, char* lds) {
    const int tid = threadIdx.x, lane = tid & 63, wid = tid >> 6, wm = wid >> 1, wn = wid & 1, lq = lane >> 4, lr = lane & 15;
    const int nc = it & 3, k1 = (it >> 2) & 63, b = it >> 8;
    char* ximg = lds; char* zimg = lds + 34816;
    __syncthreads();
#pragma unroll
    for (int i = 0; i < 8; i++) {
        const int ci = tid + 256 * i, row = ci >> 4, cc = ci & 15;
        const bf16_t* src = (row < 64 ? wsp<bf16_t>(p, OFF_YR) : wsp<bf16_t>(p, OFF_YI)) + ((long)(b * 64 + k1) * 64 + (row & 63)) * 512 + nc * 128 + cc * 8;
        *(u32x4*)(ximg + row * 272 + cc * 16) = *(const u32x4*)src;
    }
    __syncthreads();
    f32x4 acc[2][4];
#pragma unroll
    for (int mi = 0; mi < 2; mi++)
#pragma unroll
        for (int ni = 0; ni < 4; ni++) acc[mi][ni] = (f32x4){0.f, 0.f, 0.f, 0.f};
    dft_mma<2>(wsp<bf16_t>(p, OFF_M3), wm * 32, ximg, wn * 64, acc);
#pragma unroll
    for (int mi = 0; mi < 2; mi++)
#pragma unroll
        for (int ni = 0; ni < 4; ni++)
            *(u32x2*)(zimg + (wm * 32 + mi * 16 + lr) * 272 + (wn * 64 + ni * 16 + 4 * lq) * 2) = pack4bf(acc[mi][ni] * (1.0f / 512.0f));
    __syncthreads();
    f32x4 a3[2][4];
#pragma unroll
    for (int mi = 0; mi < 2; mi++)
#pragma unroll
        for (int ni = 0; ni < 4; ni++) a3[mi][ni] = (f32x4){0.f, 0.f, 0.f, 0.f};
    const bf16_t* wft = wsp<bf16_t>(p, OFF_WFT) + (long)(nc * 2 + wn) * 4096;
#pragma unroll
    for (int ks = 0; ks < 2; ks++) {
        bf16x8 af[2], bfr[4];
#pragma unroll
        for (int i = 0; i < 2; i++) af[i] = *(const bf16x8*)(zimg + (wm * 32 + i * 16 + lr) * 272 + (wn * 64 + ks * 32 + lq * 8) * 2);
#pragma unroll
        for (int i = 0; i < 4; i++) bfr[i] = *(const bf16x8*)(wft + (i * 16 + lr) * 64 + ks * 32 + lq * 8);
#pragma unroll
        for (int mi = 0; mi < 2; mi++)
#pragma unroll
            for (int ni = 0; ni < 4; ni++) a3[mi][ni] = __builtin_amdgcn_mfma_f32_16x16x32_bf16(bfr[ni], af[mi], a3[mi][ni], 0, 0, 0);
    }
#pragma unroll
    for (int mi = 0; mi < 2; mi++) {
        const int k2 = wm * 32 + mi * 16 + lr;
        bf16_t* dst = wsp<bf16_t>(p, OFF_ZA) + ((long)(b * NS + k1 + 64 * k2)) * 1024 + nc * 128 + wn * 64 + 4 * lq;
#pragma unroll
        for (int ni = 0; ni < 4; ni++) *(u32x2*)(dst + ni * 16) = pack4bf(a3[mi][ni]);
    }
}

__device__ __forceinline__ void phase2(const Params& p, char* lds) {
    const int tid = threadIdx.x, lane = tid & 63, wid = tid >> 6, wm = wid >> 1, wn = wid & 1, lq = lane >> 4, lr = lane & 15;
    constexpr int N_Q = 128 * 6, N_KV = 128 * 8, N_F = 1024;
    {
      FOR_XCD_ITEMS(item, N_Q) {
        f32x4 acc[4][4];
        {
            const int tm = item / 6, tn = item % 6;
            GemmTile g; g.A = wsp<bf16_t>(p, OFF_UQ) + (long)tm * 128 * 384; g.lda = 384; g.arow = nullptr;
            g.Bt = wsp<bf16_t>(p, OFF_WQT) + (long)tn * 128 * 384; g.ldb = 384; g.K = 384;
            gemm_tile_128(g, lds, acc);
            const float qmul = 0.10206207261596575f * 1.4426950408889634f;
#pragma unroll
            for (int mi = 0; mi < 4; mi++) {
                const int row = tm * 128 + wm * 64 + mi * 16 + lr;
                const int b = row >> 12, s = row & 4095;
                const float* sq = wsp<float>(p, OFF_SSQ) + (long)row * 6;
                const float ss = sq[0] + sq[1] + sq[2] + sq[3] + sq[4] + sq[5];
                const float rs = rsqrtf(ss * (1.f / 384.f) + 1e-6f) * qmul;
                const int cb0 = tn * 128 + wn * 64;
#pragma unroll
                for (int ni = 0; ni < 4; ni++) {
                    const int cb = cb0 + ni * 16, hd = cb / 96, hob = cb % 96;
                    bf16_t* qd = wsp<bf16_t>(p, OFF_Q) + ((long)(b * 8 + hd) * NS + s) * 96;
                    if (hob < 64) {
                        *(u32x2*)(qd + hob + 4 * lq) = pack4bf(acc[mi][ni] * rs);
                    } else if (hob == 64) {
                        if (ni < 3) {
                            const float2* rp = wsp<float2>(p, OFF_ROPE) + (long)row * 16 + 4 * lq;
                            f32x4 o1, o2;
#pragma unroll
                            for (int r = 0; r < 4; r++) {
                                const float2 cs = rp[r];
                                const float x1 = acc[mi][ni][r] * rs, x2 = acc[mi][ni < 3 ? ni + 1 : 3][r] * rs;
                                o1[r] = x1 * cs.x - x2 * cs.y; o2[r] = x1 * cs.y + x2 * cs.x;
                            }
                            *(u32x2*)(qd + 64 + 4 * lq) = pack4bf(o1);
                            *(u32x2*)(qd + 80 + 4 * lq) = pack4bf(o2);
                        }
                    }
                }
            }
        }
      }
      FOR_XCD_ITEMS(it, N_KV) {
        f32x4 acc[4][4];
        {
            const int tm = it >> 3, hd = it & 7;
            GemmTile g; g.A = wsp<bf16_t>(p, OFF_UKV) + (long)tm * 128 * 256; g.lda = 256; g.arow = nullptr;
            g.Bt = wsp<bf16_t>(p, OFF_WKVT) + (long)hd * 128 * 256; g.ldb = 256; g.K = 256;
            gemm_tile_128(g, lds, acc);
#pragma unroll
            for (int mi = 0; mi < 4; mi++) {
                const int row = tm * 128 + wm * 64 + mi * 16 + lr;
                const int b = row >> 12, s = row & 4095;
                const float* sq = wsp<float>(p, OFF_SSKV) + (long)row * 4;
                const float rs = rsqrtf((sq[0] + sq[1] + sq[2] + sq[3]) * (1.f / 256.f) + 1e-6f);
                if (wn == 0) {
                    bf16_t* kd = wsp<bf16_t>(p, OFF_K) + ((long)(b * 8 + hd) * NS + s) * 96;
#pragma unroll
                    for (int ni = 0; ni < 4; ni++) *(u32x2*)(kd + ni * 16 + 4 * lq) = pack4bf(acc[mi][ni] * rs);
                } else {
#pragma unroll
                    for (int ni = 0; ni < 4; ni++) {
                        bf16_t* vd = wsp<bf16_t>(p, OFF_VT) + ((long)(b * 8 + hd) * 64 + ni * 16 + 4 * lq) * NS + s;
#pragma unroll
                        for (int r = 0; r < 4; r++) vd[(long)r * NS] = (bf16_t)f2bf(acc[mi][ni][r] * rs);
                    }
                }
            }
#pragma unroll
            for (int i = 0; i < 2; i++) {
                const int ci = tid + 256 * i, r = ci >> 2, cc = ci & 3;
                const int row = tm * 128 + r, b = row >> 12, s = row & 4095;
                *(u32x4*)(wsp<bf16_t>(p, OFF_K) + ((long)(b * 8 + hd) * NS + s) * 96 + 64 + cc * 8) = *(const u32x4*)(wsp<bf16_t>(p, OFF_KR) + (long)row * 32 + cc * 8);
            }
        }
      }
      FOR_XCD_ITEMS(it, N_F) { f2a_item(p, it, lds); }
    }
}


__device__ __forceinline__ void expert_tr_job(const Params& p, int j, char* lds) {
    const int which = j >> 11, r = j & 2047, e = r >> 7, t = r & 127;
    const int k0 = (t >> 3) * 64, n0 = (t & 7) * 128;
    if (which == 0) tr_tile(p.w_exp_gate + (long)e * 1048576, 1024, k0, n0, 1024, p.g_ffn, wsp<bf16_t>(p, OFF_WGUT) + (long)e * 2048 * 1024, 1024, 1, lds);
    else if (which == 1) tr_tile(p.w_exp_up + (long)e * 1048576, 1024, k0, n0, 1024, p.g_ffn, wsp<bf16_t>(p, OFF_WGUT) + (long)e * 2048 * 1024, 1024, 2, lds);
    else tr_tile(p.w_exp_down + (long)e * 1048576, 1024, k0, n0, 1024, nullptr, wsp<bf16_t>(p, OFF_WDT) + (long)e * 1048576, 1024, 0, lds);
}

__device__ __forceinline__ void phase3(const Params& p, char* lds) {
    constexpr int N_A = NB * 8 * (NS / 128), N_F = 1024;
    const bool tr_first = (blockIdx.x >> 8) & 1;
    if (tr_first) for (int j = blockIdx.x; j < 6144; j += gridDim.x) expert_tr_job(p, j, lds);
    {
      FOR_XCD_ITEMS(item, N_A) {
        {
            const int qt = item & 31, h = (item >> 5) & 7, b = item >> 8;
            const bf16_t* Qp = wsp<bf16_t>(p, OFF_Q) + ((long)(b * 8 + h) * NS + qt * 128) * 96;
            const bf16_t* Kp = wsp<bf16_t>(p, OFF_K) + ((long)(b * 8 + h) * NS) * 96;
            const bf16_t* Vtp = wsp<bf16_t>(p, OFF_VT) + ((long)(b * 8 + h) * 64) * NS;
            bf16_t* Op = wsp<bf16_t>(p, OFF_ZA) + ((long)b * NS + qt * 128) * 1024 + 512 + h * 64;
            attn_block<96, 64, 64>(Qp, Kp, Vtp, (long)NS, NS, lds, [&](int q, int dv, f32x4 v) { *(u32x2*)(Op + (long)q * 1024 + dv) = pack4bf(v); });
        }
      }
      FOR_XCD_ITEMS(it, N_F) { f2b_item(p, it, lds); }
    }
    if (!tr_first) for (int j = blockIdx.x; j < 6144; j += gridDim.x) expert_tr_job(p, j, lds);
}

__device__ __forceinline__ void phase_resid(const Params& p, char* lds, size_t offA, size_t offW, const float* resid, size_t offXb, size_t offSS) {
    const int tid = threadIdx.x, lane = tid & 63, wid = tid >> 6, wm = wid >> 1, wn = wid & 1, lq = lane >> 4, lr = lane & 15;
    FOR_XCD_ITEMS(item, 128 * 8) {
        const int tm = item >> 3, tn = item & 7;
        f32x4 acc[4][4];
        GemmTile g; g.A = wsp<bf16_t>(p, offA) + (long)tm * 128 * ND; g.lda = ND; g.arow = nullptr;
        g.Bt = wsp<bf16_t>(p, offW) + (long)tn * 128 * ND; g.ldb = ND; g.K = ND;
        gemm_tile_128(g, lds, acc);
#pragma unroll
        for (int mi = 0; mi < 4; mi++) {
            const int row = tm * 128 + wm * 64 + mi * 16 + lr;
            float ss = 0.f;
#pragma unroll
            for (int ni = 0; ni < 4; ni++) {
                const long o = (long)row * ND + tn * 128 + wn * 64 + ni * 16 + 4 * lq;
                const f32x4 v = *(const f32x4*)(resid + o) + acc[mi][ni];
                *(f32x4*)(p.out + o) = v;
                *(u32x2*)(wsp<bf16_t>(p, offXb) + o) = pack4bf(v);
                ss += v[0] * v[0] + v[1] * v[1] + v[2] * v[2] + v[3] * v[3];
            }
            ss += __shfl_xor(ss, 16); ss += __shfl_xor(ss, 32);
            if (lq == 0) wsp<float>(p, offSS)[row * 16 + tn * 2 + wn] = ss;
        }
    }
}
__device__ __forceinline__ float row_rs16(const float* ss) {
    const f32x4 a = *(const f32x4*)ss, b = *(const f32x4*)(ss + 4), c = *(const f32x4*)(ss + 8), d = *(const f32x4*)(ss + 12);
    const f32x4 t = (a + b) + (c + d);
    return rsqrtf(((t[0] + t[1]) + (t[2] + t[3])) * (1.f / 1024.f) + 1e-6f);
}

__device__ __forceinline__ void phase5a(const Params& p, char* lds) {
    const int tid = threadIdx.x, lane = tid & 63, wid = tid >> 6, wm = wid >> 1, wn = wid & 1, lq = lane >> 4, lr = lane & 15;
    FOR_XCD_ITEMS(item, 128 * 8) {
        const int tm = item >> 3, tn = item & 7;
        f32x4 acc[4][4];
        GemmTile g; g.A = wsp<bf16_t>(p, OFF_X1B) + (long)tm * 128 * ND; g.lda = ND; g.arow = nullptr;
        g.Bt = wsp<bf16_t>(p, OFF_WMQT) + (long)tn * 128 * ND; g.ldb = ND; g.K = ND;
        gemm_tile_128(g, lds, acc);
        const int h = tn >> 1;
#pragma unroll
        for (int mi = 0; mi < 4; mi++) {
            const int row = tm * 128 + wm * 64 + mi * 16 + lr, b = row >> 12, s = row & 4095;
            const float rs = row_rs16(wsp<float>(p, OFF_SS1) + (long)row * 16) * (0.0625f * 1.4426950408889634f);
            bf16_t* qd = wsp<bf16_t>(p, OFF_QM) + ((long)(b * 4 + h) * NS + s) * 256 + (tn & 1) * 128 + wn * 64 + 4 * lq;
#pragma unroll
            for (int ni = 0; ni < 4; ni++) *(u32x2*)(qd + ni * 16) = pack4bf(acc[mi][ni] * rs);
        }
    }
}
__device__ __forceinline__ void phase5b(const Params& p, char* lds) {
    FOR_XCD_ITEMS(item, NB * 4 * 32 * 2) {
        const int dvh = item & 1, qt = (item >> 1) & 31, h = (item >> 6) & 3, b = item >> 8;
        const bf16_t* Qp = wsp<bf16_t>(p, OFF_QM) + ((long)(b * 4 + h) * NS + qt * 128) * 256;
        const bf16_t* Kp = wsp<bf16_t>(p, OFF_KMEM) + ((long)(b * 4 + h) * 256) * 256;
        const bf16_t* Vtp = wsp<bf16_t>(p, OFF_VTMEM) + ((long)(b * 4 + h) * 256 + dvh * 128) * 256;
        bf16_t* Op = wsp<bf16_t>(p, OFF_OM) + ((long)b * NS + qt * 128) * 1024 + h * 256 + dvh * 128;
        attn_block<256, 128, 32>(Qp, Kp, Vtp, 256L, 256, lds, [&](int q, int dv, f32x4 v) { *(u32x2*)(Op + (long)q * 1024 + dv) = pack4bf(v); });
    }
}

__device__ __forceinline__ void phase7(const Params& p, char* lds) {
    const int tid = threadIdx.x, lane = tid & 63, wid = tid >> 6;
    float* wr = (float*)lds;
    __syncthreads();
    for (int i = tid; i < 16384; i += 256) { const int k = i >> 4, e = i & 15; wr[e * 1024 + k] = p.w_router[i] * p.g_ffn[k]; }
    __syncthreads();
    for (int tok = blockIdx.x * 4 + wid; tok < NT; tok += gridDim.x * 4) {
        const float* xr = p.out + (long)tok * ND;
        float a[16];
#pragma unroll
        for (int e = 0; e < 16; e++) a[e] = 0.f;
#pragma unroll 4
        for (int j = 0; j < 16; j++) {
            const float xv = xr[lane + 64 * j];
#pragma unroll
            for (int e = 0; e < 16; e++) a[e] += xv * wr[e * 1024 + lane + 64 * j];
        }
#pragma unroll
        for (int i = 0; i < 8; i++) { const bool hi = lane & 32; const float send = hi ? a[i] : a[i + 8], keep = hi ? a[i + 8] : a[i]; a[i] = keep + __shfl_xor(send, 32); }
#pragma unroll
        for (int i = 0; i < 4; i++) { const bool hi = lane & 16; const float send = hi ? a[i] : a[i + 4], keep = hi ? a[i + 4] : a[i]; a[i] = keep + __shfl_xor(send, 16); }
#pragma unroll
        for (int i = 0; i < 2; i++) { const bool hi = lane & 8; const float send = hi ? a[i] : a[i + 2], keep = hi ? a[i + 2] : a[i]; a[i] = keep + __shfl_xor(send, 8); }
        { const bool hi = lane & 4; const float send = hi ? a[0] : a[1], keep = hi ? a[1] : a[0]; a[0] = keep + __shfl_xor(send, 4); }
        float lg = a[0];
        lg += __shfl_xor(lg, 2); lg += __shfl_xor(lg, 1);
        const int e = ((lane >> 5) & 1) * 8 + ((lane >> 4) & 1) * 4 + ((lane >> 3) & 1) * 2 + ((lane >> 2) & 1);
        lg *= row_rs16(wsp<float>(p, OFF_SS2) + (long)tok * 16);
        float mx = lg;
#pragma unroll
        for (int o = 4; o < 64; o <<= 1) mx = fmaxf(mx, __shfl_xor(mx, o));
        const float ex = expf(lg - mx);
        float sm = ex;
#pragma unroll
        for (int o = 4; o < 64; o <<= 1) sm += __shfl_xor(sm, o);
        if ((lane & 3) == 0) wsp<float>(p, OFF_AFF)[(long)tok * 16 + e] = ex / sm;
    }
}

__device__ __forceinline__ int block_sum_i(int v, int* red) {
    const int lane = threadIdx.x & 63, wid = threadIdx.x >> 6;
#pragma unroll
    for (int o = 32; o > 0; o >>= 1) v += __shfl_xor(v, o);
    __syncthreads();
    if (lane == 0) red[wid] = v;
    __syncthreads();
    return red[0] + red[1] + red[2] + red[3];
}
__device__ __forceinline__ int block_excl_scan_i(int v, int* red, int& total) {
    const int lane = threadIdx.x & 63, wid = threadIdx.x >> 6;
    int inc = v;
#pragma unroll
    for (int o = 1; o < 64; o <<= 1) { const int t = __shfl_up(inc, o); if (lane >= o) inc += t; }
    __syncthreads();
    if (lane == 63) red[wid] = inc;
    __syncthreads();
    int base = 0;
#pragma unroll
    for (int w = 0; w < 4; w++) if (w < wid) base += red[w];
    total = red[0] + red[1] + red[2] + red[3];
    return base + inc - v;
}
__device__ __forceinline__ void phase8(const Params& p, char* lds) {
    int* red = (int*)lds;
    const int tid = threadIdx.x;
    for (int item = blockIdx.x; item < NB * NE; item += gridDim.x) {
        const int e = item & 15, b = item >> 4;
        const float* aff = wsp<float>(p, OFF_AFF) + (long)b * NS * 16 + e;
        unsigned v[16];
#pragma unroll
        for (int i = 0; i < 16; i++) v[i] = __float_as_uint(aff[(long)(tid * 16 + i) * 16]);
        unsigned T = 0;
        for (int bit = 30; bit >= 0; bit--) {
            const unsigned cand = T | (1u << bit);
            int c = 0;
#pragma unroll
            for (int i = 0; i < 16; i++) c += (v[i] >= cand) ? 1 : 0;
            if (block_sum_i(c, red) >= CAP) T = cand;
        }
        int cg = 0, ce = 0;
#pragma unroll
        for (int i = 0; i < 16; i++) { cg += (v[i] > T) ? 1 : 0; ce += (v[i] == T) ? 1 : 0; }
        int tot;
        const int pk = block_excl_scan_i(cg | (ce << 16), red, tot);
        const int need = CAP - (tot & 0xFFFF);
        const int pe = pk >> 16;
        int nse = need - pe; nse = nse < 0 ? 0 : (nse > ce ? ce : nse);
        int tot2;
        int slot = block_excl_scan_i(cg + nse, red, tot2);
        int* slots = wsp<int>(p, OFF_SLOTS) + (long)(b * NE + e) * NS;
        int* idx = wsp<int>(p, OFF_IDX) + (long)(b * NE + e) * CAP;
        float* gate = wsp<float>(p, OFF_GATE) + (long)(b * NE + e) * CAP;
        int eqs = 0;
#pragma unroll
        for (int i = 0; i < 16; i++) {
            const int t = tid * 16 + i;
            bool sel = v[i] > T;
            if (v[i] == T) { sel = eqs < nse; eqs++; }
            if (sel) { slots[t] = slot; idx[slot] = b * NS + t; gate[slot] = __uint_as_float(v[i]); slot++; }
            else slots[t] = -1;
        }
    }
}

__device__ __forceinline__ void phase9(const Params& p, char* lds) {
    const int tid = threadIdx.x, lane = tid & 63, wid = tid >> 6, wm = wid >> 1, wn = wid & 1, lq = lane >> 4, lr = lane & 15;
    FOR_XCD_ITEMS(item, NE * 16 * NB * 4) {
        const int rt = item & 3, b = (item >> 2) & 3, ct = (item >> 4) & 15, e = item >> 8;
        const int* arow = wsp<int>(p, OFF_IDX) + (long)(b * NE + e) * CAP + rt * 128;
        f32x4 acc[4][4];
        GemmTile g; g.A = wsp<bf16_t>(p, OFF_X2B); g.lda = ND; g.arow = arow;
        g.Bt = wsp<bf16_t>(p, OFF_WGUT) + ((long)e * 2048 + ct * 128) * ND; g.ldb = ND; g.K = ND;
        gemm_tile_128(g, lds, acc);
#pragma unroll
        for (int mi = 0; mi < 4; mi++) {
            const int r = wm * 64 + mi * 16 + lr;
            const int tok = arow[r];
            const float rs = row_rs16(wsp<float>(p, OFF_SS2) + (long)tok * 16);
            bf16_t* ad = wsp<bf16_t>(p, OFF_ACT) + ((long)(e * NB + b) * CAP + rt * 128 + r) * ND + ct * 64 + wn * 32 + 4 * lq;
#pragma unroll
            for (int pp = 0; pp < 2; pp++) {
                f32x4 o;
#pragma unroll
                for (int q = 0; q < 4; q++) {
                    const float ga = acc[mi][2 * pp][q] * rs, up = acc[mi][2 * pp + 1][q] * rs;
                    o[q] = ga / (1.f + __expf(-ga)) * up;
                }
                *(u32x2*)(ad + pp * 16) = pack4bf(o);
            }
        }
    }
}
__device__ __forceinline__ void phase10(const Params& p, char* lds) {
    const int tid = threadIdx.x, lane = tid & 63, wid = tid >> 6, wm = wid >> 1, wn = wid & 1, lq = lane >> 4, lr = lane & 15;
    FOR_XCD_ITEMS(item, NE * 8 * NB * 4) {
        const int rt = item & 3, b = (item >> 2) & 3, ct = (item >> 4) & 7, e = item >> 7;
        const long row0 = (long)(e * NB + b) * CAP + rt * 128;
        f32x4 acc[4][4];
        GemmTile g; g.A = wsp<bf16_t>(p, OFF_ACT) + row0 * ND; g.lda = ND; g.arow = nullptr;
        g.Bt = wsp<bf16_t>(p, OFF_WDT) + ((long)e * 1024 + ct * 128) * ND; g.ldb = ND; g.K = ND;
        gemm_tile_128(g, lds, acc);
        const float* gate = wsp<float>(p, OFF_GATE) + (long)(b * NE + e) * CAP + rt * 128;
#pragma unroll
        for (int mi = 0; mi < 4; mi++) {
            const int r = wm * 64 + mi * 16 + lr;
            const float gv = gate[r];
            bf16_t* yd = wsp<bf16_t>(p, OFF_Y) + (row0 + r) * ND + ct * 128 + wn * 64 + 4 * lq;
#pragma unroll
            for (int ni = 0; ni < 4; ni++) *(u32x2*)(yd + ni * 16) = pack4bf(acc[mi][ni] * gv);
        }
    }
}

__device__ __forceinline__ void phase11(const Params& p, char* lds) {
    const int tid = threadIdx.x, lane = tid & 63, wid = tid >> 6;
    for (int tok = blockIdx.x * 4 + wid; tok < NT; tok += gridDim.x * 4) {
        const int b = tok >> 12, t = tok & 4095;
        float* xr = p.out + (long)tok * ND;
        f32x4 v[4];
#pragma unroll
        for (int i = 0; i < 4; i++) v[i] = *(const f32x4*)(xr + i * 256 + lane * 4);
        for (int e = 0; e < NE; e++) {
            const int sl = wsp<int>(p, OFF_SLOTS)[(long)(b * NE + e) * NS + t];
            if (sl >= 0) {
                const bf16_t* yr = wsp<bf16_t>(p, OFF_Y) + ((long)(e * NB + b) * CAP + sl) * ND;
#pragma unroll
                for (int i = 0; i < 4; i++) {
                    const u32x2 w = *(const u32x2*)(yr + i * 256 + lane * 4);
                    v[i][0] += __uint_as_float(w.x << 16); v[i][1] += __uint_as_float(w.x & 0xFFFF0000u);
                    v[i][2] += __uint_as_float(w.y << 16); v[i][3] += __uint_as_float(w.y & 0xFFFF0000u);
                }
            }
        }
        float ss = 0.f;
#pragma unroll
        for (int i = 0; i < 4; i++) ss += v[i][0] * v[i][0] + v[i][1] * v[i][1] + v[i][2] * v[i][2] + v[i][3] * v[i][3];
        ss = wave_sum(ss);
        const float rs = rsqrtf(ss * (1.f / ND) + 1e-6f);
#pragma unroll
        for (int i = 0; i < 4; i++) {
            const f32x4 gf = *(const f32x4*)(p.g_final + i * 256 + lane * 4);
            *(f32x4*)(xr + i * 256 + lane * 4) = v[i] * rs * gf;
        }
    }
}

__global__ void __launch_bounds__(256, 2) k_fwd(Params p, int ph_lo, int ph_hi) {
    extern __shared__ __attribute__((aligned(16))) char lds[];
    volatile LAS unsigned* st = (volatile LAS unsigned*)(lds + LDS_MAIN);
    if (threadIdx.x == 0) { st[0] = 0u; st[1] = 0u; }
    __syncthreads();
    XcdBarrier bar = xcd_barrier_post(wsp<unsigned>(p, OFF_BAR), st);
#if USE_CG_SYNC
#define GRID_BARRIER() do { asm volatile("s_waitcnt vmcnt(0)" ::: "memory"); __syncthreads(); cg::this_grid().sync(); asm volatile("s_waitcnt vmcnt(0)" ::: "memory"); __syncthreads(); } while (0)
#else
#define GRID_BARRIER() xcd_barrier(bar)
#endif
#define RUN_PHASE(k, call) if (ph_lo <= (k) && (k) < ph_hi) { if ((k) > ph_lo) { GRID_BARRIER(); } call; }
    RUN_PHASE(0, phase0(p, lds))
    RUN_PHASE(1, phase1(p, lds))
    RUN_PHASE(2, phase2(p, lds))
    RUN_PHASE(3, phase3(p, lds))
    RUN_PHASE(4, phase_resid(p, lds, OFF_ZA, OFF_WOUTT, p.x, OFF_X1B, OFF_SS1))
    RUN_PHASE(5, phase5a(p, lds))
    RUN_PHASE(6, phase5b(p, lds))
    RUN_PHASE(7, phase_resid(p, lds, OFF_OM, OFF_WMOT, p.out, OFF_X2B, OFF_SS2))
    RUN_PHASE(8, phase7(p, lds))
    RUN_PHASE(9, phase8(p, lds))
    RUN_PHASE(10, phase9(p, lds))
    RUN_PHASE(11, phase10(p, lds))
    RUN_PHASE(12, phase11(p, lds))
}

extern "C" void kernel_launch(void* const* d_in, const int* in_sizes, int n_in,
                              void* d_out, int out_size, void* d_ws, size_t ws_size,
                              hipStream_t stream) {
    static int grid = 0;
    if (grid == 0) {
        if (n_in != 22 || ws_size < WS_END) { fprintf(stderr, "kernel_launch: unexpected inputs (n_in %d, ws %zu < %zu)\n", n_in, ws_size, (size_t)WS_END); grid = -1; return; }
        int dev = 0, cus = 0, per_cu = 0;
        (void)hipGetDevice(&dev);
        (void)hipDeviceGetAttribute(&cus, hipDeviceAttributeMultiprocessorCount, dev);
        if (hipFuncSetAttribute((const void*)k_fwd, hipFuncAttributeMaxDynamicSharedMemorySize, LDS_TOTAL) != hipSuccess) { fprintf(stderr, "kernel_launch: hipFuncSetAttribute failed\n"); grid = -1; return; }
        if (hipOccupancyMaxActiveBlocksPerMultiprocessor(&per_cu, (const void*)k_fwd, 256, LDS_TOTAL) != hipSuccess || per_cu < 1) { fprintf(stderr, "kernel_launch: occupancy query failed (%d)\n", per_cu); (void)hipGetLastError(); per_cu = 1; }
        if (per_cu > 2) per_cu = 2;
        grid = cus * per_cu;
        fprintf(stderr, "kernel_launch: %d CUs x %d blocks\n", cus, per_cu);
    }
    if (grid < 0) return;
    Params p{};
    p.x = (const float*)d_in[0]; p.mem = (const float*)d_in[1]; p.pos = (const int*)d_in[2];
    p.g_mix = (const float*)d_in[3]; p.w_in = (const float*)d_in[4]; p.g_q_lat = (const float*)d_in[5]; p.w_q_up = (const float*)d_in[6];
    p.g_kv_lat = (const float*)d_in[7]; p.w_kv_up = (const float*)d_in[8]; p.w_fourier = (const float*)d_in[9]; p.w_out = (const float*)d_in[10];
    p.g_mem_q = (const float*)d_in[11]; p.g_mem_kv = (const float*)d_in[12]; p.w_mem_q = (const float*)d_in[13]; p.w_mem_kv = (const float*)d_in[14];
    p.w_mem_o = (const float*)d_in[15]; p.g_ffn = (const float*)d_in[16]; p.w_router = (const float*)d_in[17];
    p.w_exp_gate = (const float*)d_in[18]; p.w_exp_up = (const float*)d_in[19]; p.w_exp_down = (const float*)d_in[20]; p.g_final = (const float*)d_in[21];
    p.out = (float*)d_out; p.ws = (char*)d_ws;
    static const int cuts[] = MK_CUTS;
    const int ncut = (int)(sizeof(cuts) / sizeof(int));
    for (int li = 0; li + 1 < ncut; li++) {
        (void)hipMemsetAsync((char*)d_ws + OFF_BAR, 0, 16384, stream);
        int lo = cuts[li], hi = cuts[li + 1];
        void* args[] = {&p, &lo, &hi};
        hipError_t e = hipLaunchCooperativeKernel((const void*)k_fwd, dim3(grid), dim3(256), args, LDS_TOTAL, stream);
        if (e != hipSuccess) fprintf(stderr, "cooperative launch failed: %s (grid %d)\n", hipGetErrorString(e), grid);
    }
}
```

```cpp
#include <hip/hip_runtime.h>
#include <stdint.h>
#include <cstdio>
#include <hip/hip_cooperative_groups.h>
namespace cg = cooperative_groups;
#ifndef USE_CG_SYNC
#define USE_CG_SYNC 0
#endif

#ifndef MK_CUTS
#define MK_CUTS {0, 13}
#endif

#define NB 4
#define NS 4096
#define ND 1024
#define NT (NB * NS)
#define INW 1184
#define NE 16
#define CAP 512
#define MEML 256
#define NPHASE 13

typedef unsigned short bf16_t;
typedef short bf16x8 __attribute__((ext_vector_type(8)));
typedef float f32x4 __attribute__((ext_vector_type(4)));
typedef float f32x16 __attribute__((ext_vector_type(16)));
typedef unsigned u32x4 __attribute__((ext_vector_type(4)));
typedef unsigned u32x2 __attribute__((ext_vector_type(2)));

__device__ __forceinline__ unsigned f2bf(float f) {
    unsigned u = __float_as_uint(f);
    u += 0x7FFFu + ((u >> 16) & 1u);
    return u >> 16;
}
typedef __bf16 hbf2 __attribute__((ext_vector_type(2)));
typedef float f32x2 __attribute__((ext_vector_type(2)));
__device__ __forceinline__ unsigned pack2bf(float lo, float hi) { f32x2 v = {lo, hi}; return __builtin_bit_cast(unsigned, __builtin_convertvector(v, hbf2)); }
__device__ __forceinline__ float bf2f(unsigned short b) { return __uint_as_float(((unsigned)b) << 16); }

__device__ __forceinline__ int tile_off(int row, int chunk) { return row * 128 + ((chunk ^ ((row >> 1) & 7)) << 4); }

#define GT_LDS_BYTES 65536

struct GemmTile { const bf16_t* A; long lda; const int* arow; const bf16_t* Bt; long ldb; int K; };

__device__ __forceinline__ void gemm_tile_128(const GemmTile& g, char* lds, f32x4 (&acc)[4][4]) {
    const int tid = threadIdx.x, lane = tid & 63, wid = tid >> 6, wm = wid >> 1, wn = wid & 1;
    const int lrow = lane >> 3, pc = lane & 7;
    const bf16_t* ap[4]; const bf16_t* bp[4];
#pragma unroll
    for (int i = 0; i < 4; i++) {
        const int r = (wid * 4 + i) * 8 + lrow;
        const int c = pc ^ ((r >> 1) & 7);
        const long ro = g.arow ? (long)g.arow[r] * g.lda : (long)r * g.lda;
        ap[i] = g.A + ro + c * 8;
        bp[i] = g.Bt + (long)r * g.ldb + c * 8;
    }
#pragma unroll
    for (int mi = 0; mi < 4; mi++)
#pragma unroll
        for (int ni = 0; ni < 4; ni++) acc[mi][ni] = (f32x4){0.f, 0.f, 0.f, 0.f};
    const int nk = g.K >> 6;
    auto stage = [&](int kt, char* st) {
#pragma unroll
        for (int i = 0; i < 4; i++) {
            __builtin_amdgcn_global_load_lds((const unsigned*)(ap[i] + kt * 64), (unsigned*)(st + (wid * 4 + i) * 1024), 16, 0, 0);
            __builtin_amdgcn_global_load_lds((const unsigned*)(bp[i] + kt * 64), (unsigned*)(st + 16384 + (wid * 4 + i) * 1024), 16, 0, 0);
        }
    };
    __syncthreads();
    stage(0, lds);
    asm volatile("s_waitcnt vmcnt(0)" ::: "memory");
    __syncthreads();
    for (int kt = 0; kt < nk; kt++) {
        char* cur = lds + (kt & 1) * 32768;
        if (kt + 1 < nk) stage(kt + 1, lds + ((kt + 1) & 1) * 32768);
#pragma unroll
        for (int ks = 0; ks < 2; ks++) {
            bf16x8 af[4], bfr[4];
#pragma unroll
            for (int i = 0; i < 4; i++) {
                af[i] = *(const bf16x8*)(cur + tile_off(wm * 64 + i * 16 + (lane & 15), ks * 4 + (lane >> 4)));
                bfr[i] = *(const bf16x8*)(cur + 16384 + tile_off(wn * 64 + i * 16 + (lane & 15), ks * 4 + (lane >> 4)));
            }
            __builtin_amdgcn_s_setprio(1);
#pragma unroll
            for (int mi = 0; mi < 4; mi++)
#pragma unroll
                for (int ni = 0; ni < 4; ni++)
                    acc[mi][ni] = __builtin_amdgcn_mfma_f32_16x16x32_bf16(bfr[ni], af[mi], acc[mi][ni], 0, 0, 0);
            __builtin_amdgcn_s_setprio(0);
        }
        asm volatile("s_waitcnt vmcnt(0)" ::: "memory");
        __syncthreads();
    }
}

template <int DQK, int DVT, int KT>
struct AttnCfg {
    static constexpr int KROW = DQK * 2 + 16;
    static constexpr int VROW = KT * 2 + 8;
    static constexpr int KBYTES = KT * KROW;
    static constexpr int VBYTES = DVT * VROW;
    static constexpr int STAGE = KBYTES + VBYTES;
    static constexpr int LDS = 2 * STAGE;
};

template <int DQK, int DVT, int KT, class Out>
__device__ __forceinline__ void attn_block(const bf16_t* Qp, const bf16_t* Kp, const bf16_t* Vtp, long ldv, int nk, char* lds, Out&& out) {
    typedef AttnCfg<DQK, DVT, KT> C;
    constexpr int NKS = DQK / 16, NST = KT / 32, NDT = DVT / 32, NPS = KT / 16;
    constexpr int KCPR = DQK / 8;
    constexpr int KCH = KT * KCPR / 256;
    constexpr int VCPR = KT / 8;
    constexpr int VCH = DVT * VCPR / 256;
    const int tid = threadIdx.x, lane = tid & 63, wid = tid >> 6, h = lane >> 5, c = lane & 31;

    bf16x8 qf[NKS];
    {
        const bf16_t* qrow = Qp + (long)(wid * 32 + c) * DQK + 8 * h;
#pragma unroll
        for (int ks = 0; ks < NKS; ks++) qf[ks] = *(const bf16x8*)(qrow + 16 * ks);
    }
    f32x16 o[NDT];
#pragma unroll
    for (int dt = 0; dt < NDT; dt++)
#pragma unroll
        for (int r = 0; r < 16; r++) o[dt][r] = 0.f;
    float m = 0.f, l = 0.f;

    u32x4 kr[KCH], vr[VCH];
    auto gload = [&](int t) {
#pragma unroll
        for (int i = 0; i < KCH; i++) {
            const int ci = tid + 256 * i, row = ci / KCPR, cc = ci % KCPR;
            kr[i] = *(const u32x4*)(Kp + (long)(t * KT + row) * DQK + cc * 8);
        }
#pragma unroll
        for (int i = 0; i < VCH; i++) {
            const int ci = tid + 256 * i, row = ci / VCPR, cc = ci % VCPR;
            vr[i] = *(const u32x4*)(Vtp + (long)row * ldv + t * KT + cc * 8);
        }
    };
    auto lwrite = [&](char* st) {
#pragma unroll
        for (int i = 0; i < KCH; i++) {
            const int ci = tid + 256 * i, row = ci / KCPR, cc = ci % KCPR;
            *(u32x4*)(st + row * C::KROW + cc * 16) = kr[i];
        }
#pragma unroll
        for (int i = 0; i < VCH; i++) {
            const int ci = tid + 256 * i, row = ci / VCPR, cc = ci % VCPR;
            char* p = st + C::KBYTES + row * C::VROW + cc * 16;
            *(u32x2*)(p) = (u32x2){vr[i].x, vr[i].y};
            *(u32x2*)(p + 8) = (u32x2){vr[i].z, vr[i].w};
        }
    };
    const int nt = nk / KT;
    gload(0);
    __syncthreads();
    lwrite(lds);
    __syncthreads();
    for (int t = 0; t < nt; t++) {
        char* cur = lds + (t & 1) * C::STAGE;
        if (t + 1 < nt) gload(t + 1);
        f32x16 s[NST];
        const float negm = -m;
#pragma unroll
        for (int st = 0; st < NST; st++) {
#pragma unroll
            for (int r = 0; r < 16; r++) s[st][r] = negm;
#pragma unroll
            for (int ks = 0; ks < NKS; ks++) {
                const bf16x8 kf = *(const bf16x8*)(cur + (st * 32 + c) * C::KROW + ks * 32 + h * 16);
                s[st] = __builtin_amdgcn_mfma_f32_32x32x16_bf16(kf, qf[ks], s[st], 0, 0, 0);
            }
        }
        float mx = s[0][0];
#pragma unroll
        for (int st = 0; st < NST; st++)
#pragma unroll
            for (int r = 0; r < 16; r++) mx = fmaxf(mx, s[st][r]);
        mx = fmaxf(mx, __shfl_xor(mx, 32));
        if (__any(mx > 8.0f)) {
            const float d = fmaxf(mx, 0.f);
            const float alpha = __builtin_amdgcn_exp2f(-d);
            m += d;
            l *= alpha;
#pragma unroll
            for (int dt = 0; dt < NDT; dt++)
#pragma unroll
                for (int r = 0; r < 16; r++) o[dt][r] *= alpha;
#pragma unroll
            for (int st = 0; st < NST; st++)
#pragma unroll
                for (int r = 0; r < 16; r++) s[st][r] -= d;
        }
        float rs = 0.f;
#pragma unroll
        for (int st = 0; st < NST; st++)
#pragma unroll
            for (int r = 0; r < 16; r++) { const float p = __builtin_amdgcn_exp2f(s[st][r]); rs += p; s[st][r] = p; }
        l += rs;
#pragma unroll
        for (int ps = 0; ps < NPS; ps++) {
            const int st = ps >> 1, u = ps & 1;
            u32x4 pw;
            pw.x = pack2bf(s[st][8 * u + 0], s[st][8 * u + 1]);
            pw.y = pack2bf(s[st][8 * u + 2], s[st][8 * u + 3]);
            pw.z = pack2bf(s[st][8 * u + 4], s[st][8 * u + 5]);
            pw.w = pack2bf(s[st][8 * u + 6], s[st][8 * u + 7]);
            const bf16x8 pf = __builtin_bit_cast(bf16x8, pw);
#pragma unroll
            for (int dt = 0; dt < NDT; dt++) {
                const char* vp = cur + C::KBYTES + (dt * 32 + c) * C::VROW + (ps * 16 + 4 * h) * 2;
                const u32x2 v0 = *(const u32x2*)(vp);
                const u32x2 v1 = *(const u32x2*)(vp + 16);
                const bf16x8 vf = __builtin_bit_cast(bf16x8, ((u32x4){v0.x, v0.y, v1.x, v1.y}));
                o[dt] = __builtin_amdgcn_mfma_f32_32x32x16_bf16(vf, pf, o[dt], 0, 0, 0);
            }
        }
        if (t + 1 < nt) lwrite(lds + ((t + 1) & 1) * C::STAGE);
        __syncthreads();
    }
    l += __shfl_xor(l, 32);
    const float inv = 1.f / l;
#pragma unroll
    for (int dt = 0; dt < NDT; dt++)
#pragma unroll
        for (int g4 = 0; g4 < 4; g4++) {
            f32x4 v = {o[dt][4 * g4 + 0] * inv, o[dt][4 * g4 + 1] * inv, o[dt][4 * g4 + 2] * inv, o[dt][4 * g4 + 3] * inv};
            out(wid * 32 + c, dt * 32 + 8 * g4 + 4 * h, v);
        }
}


constexpr size_t SLOT = 33554432;
constexpr size_t OFF_W1T = 0;
constexpr size_t OFF_WQT = OFF_W1T + 1280UL * 1024 * 2;
constexpr size_t OFF_WKVT = OFF_WQT + 768UL * 384 * 2;
constexpr size_t OFF_WOUTT = OFF_WKVT + 1024UL * 256 * 2;
constexpr size_t OFF_WMQT = OFF_WOUTT + 1024UL * 1024 * 2;
constexpr size_t OFF_WMKVT = OFF_WMQT + 1024UL * 1024 * 2;
constexpr size_t OFF_WMOT = OFF_WMKVT + 2048UL * 1024 * 2;
constexpr size_t OFF_WGUT = OFF_WMOT + 1024UL * 1024 * 2;
constexpr size_t OFF_WDT = OFF_WGUT + 16UL * 2048 * 1024 * 2;
constexpr size_t OFF_T64 = OFF_WDT + 16UL * 1024 * 1024 * 2;
constexpr size_t OFF_M1 = OFF_T64 + 16384;
constexpr size_t OFF_M3 = OFF_M1 + 32768;
constexpr size_t OFF_WFT = OFF_M3 + 16384;
constexpr size_t OFF_TW = OFF_WFT + 65536;
constexpr size_t OFF_ROPE = OFF_TW + 32768;
constexpr size_t OFF_R0 = OFF_ROPE + (size_t)NT * 16 * 8;
constexpr size_t OFF_RMEM = OFF_R0 + (size_t)NT * 4;
constexpr size_t OFF_SSQ = OFF_RMEM + 4096;
constexpr size_t OFF_SSKV = OFF_SSQ + (size_t)NT * 6 * 4;
constexpr size_t OFF_SS1 = OFF_SSKV + (size_t)NT * 4 * 4;
constexpr size_t OFF_SS2 = OFF_SS1 + (size_t)NT * 16 * 4;
constexpr size_t OFF_AFF = OFF_SS2 + (size_t)NT * 16 * 4;
constexpr size_t OFF_SLOTS = OFF_AFF + (size_t)NT * 16 * 4;
constexpr size_t OFF_IDX = OFF_SLOTS + 4UL * 16 * 4096 * 4;
constexpr size_t OFF_GATE = OFF_IDX + 4UL * 16 * 512 * 4;
constexpr size_t OFF_MEMB = OFF_GATE + 4UL * 16 * 512 * 4;
constexpr size_t OFF_KMEM = OFF_MEMB + 1024UL * 1024 * 2;
constexpr size_t OFF_VTMEM = OFF_KMEM + 1024UL * 1024 * 2;
constexpr size_t OFF_KR = OFF_VTMEM + 1024UL * 1024 * 2;
constexpr size_t OFF_BAR = OFF_KR + (size_t)NT * 32 * 2;
constexpr size_t OFF_S0 = (OFF_BAR + 16384 + 255) / 256 * 256;
constexpr size_t OFF_S1 = OFF_S0 + SLOT;
constexpr size_t OFF_S2 = OFF_S1 + SLOT;
constexpr size_t OFF_S3 = OFF_S2 + SLOT;
constexpr size_t OFF_S4 = OFF_S3 + SLOT;
constexpr size_t WS_END = OFF_S4 + SLOT;
static_assert(WS_END <= 300964352UL, "workspace map exceeds the guaranteed scratch size");
constexpr size_t OFF_XB = OFF_S0, OFF_YR = OFF_S0, OFF_YI = OFF_S0 + SLOT / 2, OFF_X1B = OFF_S3, OFF_OM = OFF_S0, OFF_ACT = OFF_S0;
constexpr size_t OFF_UF = OFF_S1, OFF_UQ = OFF_S1 + (size_t)NT * 512 * 2, OFF_ZA = OFF_S1, OFF_QM = OFF_S1;
constexpr size_t OFF_Q = OFF_S2, OFF_UKV = OFF_S2 + (size_t)NT * 768 * 2, OFF_X2B = OFF_S2;
constexpr size_t OFF_K = OFF_S3, OFF_Y = OFF_S3;
constexpr size_t OFF_VT = OFF_S4;

struct Params {
    const float *x, *mem; const int* pos;
    const float *g_mix, *w_in, *g_q_lat, *w_q_up, *g_kv_lat, *w_kv_up, *w_fourier, *w_out, *g_mem_q, *g_mem_kv, *w_mem_q, *w_mem_kv, *w_mem_o,
        *g_ffn, *w_router, *w_exp_gate, *w_exp_up, *w_exp_down, *g_final;
    float* out; char* ws;
};
template <class T> __device__ __forceinline__ T* wsp(const Params& p, size_t off) { return (T*)(p.ws + off); }

#define LDS_MAIN 65536
#define LDS_TOTAL (LDS_MAIN + 16)
#define LAS __attribute__((address_space(3)))

#define XB_TMO      128
#define XB_XCNT(j)  (256  + 64 * (j))
#define XB_XSUB(j)  (1280 + 64 * (j))
#define XB_XGEN(j)  (2304 + 64 * (j))
#define XB_TOP      3328
#define XB_TOPGEN   3392
#define XCD_BAR_WORDS 3456
#define XB_SPIN_CAP (1u << 25)
__device__ __forceinline__ unsigned xb_ld(unsigned* p)              { return __hip_atomic_load(p, __ATOMIC_RELAXED, __HIP_MEMORY_SCOPE_AGENT); }
__device__ __forceinline__ unsigned xb_add(unsigned* p, unsigned v) { return __hip_atomic_fetch_add(p, v, __ATOMIC_RELAXED, __HIP_MEMORY_SCOPE_AGENT); }
__device__ __forceinline__ unsigned xb_xcc_id() { return (unsigned)__builtin_amdgcn_s_getreg((3 << 11) | 20) & 0xFu; }
#define XB_SPIN(cond, bar) do { unsigned _sp = 0; while (cond) { __builtin_amdgcn_s_sleep(1); \
    if ((++_sp & 255u) == 0u) { if (xb_ld(&(bar)[XB_TMO])) break; if (_sp > XB_SPIN_CAP) { atomicAdd(&(bar)[XB_TMO], 1u); break; } } } } while (0)
struct XcdBarrier { unsigned* bar; unsigned x; volatile LAS unsigned* st; };
__device__ __forceinline__ XcdBarrier xcd_barrier_post(unsigned* bar, volatile LAS unsigned* st) {
    XcdBarrier b; b.bar = bar; b.x = xb_xcc_id(); b.st = st;
    if (threadIdx.x == 0) (void)xb_add(&bar[XB_XCNT(b.x)], 1u);
    return b;
}
__device__ __forceinline__ void xcd_barrier_complete(unsigned* bar, unsigned x, unsigned& nloc, unsigned& nx) {
    const unsigned G = gridDim.x * gridDim.y * gridDim.z;
    unsigned sum, cnt, mine, sp = 0u;
    for (;;) {
        sum = 0u; cnt = 0u; mine = 0u;
#pragma unroll
        for (unsigned j = 0; j < 16; ++j) { const unsigned c = xb_ld(&bar[XB_XCNT(j)]); sum += c; cnt += (c > 0u) ? 1u : 0u; mine = (j == x) ? c : mine; }
        if (sum == G) break;
        __builtin_amdgcn_s_sleep(1);
        if ((++sp & 255u) == 0u) { if (xb_ld(&bar[XB_TMO])) break; if (sp > XB_SPIN_CAP) { atomicAdd(&bar[XB_TMO], 1u); break; } }
    }
    nloc = mine > 0u ? mine : 1u; nx = cnt > 0u ? cnt : 1u;
}
__device__ __forceinline__ void xcd_barrier(const XcdBarrier& b) {
    asm volatile("s_waitcnt vmcnt(0)" ::: "memory");
    __syncthreads();
    if (threadIdx.x == 0) {
        unsigned* bar = b.bar;
        __builtin_amdgcn_s_waitcnt(0);
        unsigned nloc = b.st[0], nx = b.st[1];
        if (nloc == 0u) { xcd_barrier_complete(bar, b.x, nloc, nx); b.st[0] = nloc; b.st[1] = nx; }
        const unsigned old = xb_add(&bar[XB_XSUB(b.x)], 1u);
        const unsigned gen = old / nloc;
        if (old + 1u == (gen + 1u) * nloc) {
            __builtin_amdgcn_fence(__ATOMIC_RELEASE, "agent");
            asm volatile("s_waitcnt vmcnt(0)" ::: "memory");
            const unsigned og = xb_add(&bar[XB_TOP], 1u);
            const unsigned tg = og / nx;
            if (og + 1u == (tg + 1u) * nx) xb_add(&bar[XB_TOPGEN], 1u);
            else XB_SPIN(xb_ld(&bar[XB_TOPGEN]) == tg, bar);
            __builtin_amdgcn_fence(__ATOMIC_ACQUIRE, "agent");
            xb_add(&bar[XB_XGEN(b.x)], 1u);
            asm volatile("s_waitcnt vmcnt(0)" ::: "memory");
        } else {
            XB_SPIN(xb_ld(&bar[XB_XGEN(b.x)]) == gen, bar);
            __builtin_amdgcn_fence(__ATOMIC_ACQUIRE, "agent");
            asm volatile("s_waitcnt vmcnt(0)" ::: "memory");
        }
    }
    __syncthreads();
}

#define FOR_XCD_ITEMS(item, N) for (int _L = (int)(blockIdx.x >> 3), item; _L < (N) / 8 && ((item = (int)(blockIdx.x & 7) * ((N) / 8) + _L), true); _L += (int)(gridDim.x >> 3))

__device__ __forceinline__ u32x2 pack4bf(float a, float b, float c, float d) { return (u32x2){pack2bf(a, b), pack2bf(c, d)}; }
__device__ __forceinline__ u32x2 pack4bf(f32x4 v) { return (u32x2){pack2bf(v[0], v[1]), pack2bf(v[2], v[3])}; }
__device__ __forceinline__ float wave_sum(float v) {
#pragma unroll
    for (int o = 32; o > 0; o >>= 1) v += __shfl_xor(v, o);
    return v;
}

__device__ __forceinline__ void tr_tile(const float* W, long ldw, int k0, int n0, int nvalid, const float* gain, bf16_t* Wt, long ldt, int mode, char* lds) {
    float (*t)[132] = (float (*)[132])lds;
    const int tid = threadIdx.x, c4 = tid & 31, r0 = tid >> 5;
    f32x4 v[8];
#pragma unroll
    for (int i = 0; i < 8; i++) {
        const int kk = r0 + 8 * i, n = n0 + c4 * 4;
        v[i] = (n < nvalid) ? *(const f32x4*)(W + (long)(k0 + kk) * ldw + n) : (f32x4){0.f, 0.f, 0.f, 0.f};
        if (gain) v[i] *= gain[k0 + kk];
    }
    __syncthreads();
#pragma unroll
    for (int i = 0; i < 8; i++) *(f32x4*)(&t[r0 + 8 * i][c4 * 4]) = v[i];
    __syncthreads();
#pragma unroll
    for (int i = 0; i < 4; i++) {
        const int ci = tid + 256 * i, nn = ci >> 3, kc = ci & 7;
        const int n = n0 + nn;
        int row = n;
        if (mode) row = (n >> 5) * 64 + ((n >> 4) & 1) * 32 + (mode - 1) * 16 + (n & 15);
        u32x4 w;
        w.x = pack2bf(t[kc * 8 + 0][nn], t[kc * 8 + 1][nn]);
        w.y = pack2bf(t[kc * 8 + 2][nn], t[kc * 8 + 3][nn]);
        w.z = pack2bf(t[kc * 8 + 4][nn], t[kc * 8 + 5][nn]);
        w.w = pack2bf(t[kc * 8 + 6][nn], t[kc * 8 + 7][nn]);
        *(u32x4*)(Wt + (long)row * ldt + k0 + kc * 8) = w;
    }
}

__device__ __forceinline__ void phase0(const Params& p, char* lds) {
    constexpr int J_W1 = 160, J_WQ = 36, J_WKV = 32, J_WOUT = 128, J_WMQ = 128, J_WMKV = 256, J_WMO = 128, J_WG = 0, J_WU = 0, J_WD = 0;
    constexpr int J_TR = J_W1 + J_WQ + J_WKV + J_WOUT + J_WMQ + J_WMKV + J_WMO + J_WG + J_WU + J_WD;
    constexpr int J_XR = NT / 4, J_MR = 1024 / 4, J_ROPE = NT * 16 / 256, J_TAB = (4096 + 8192 + 16384 + 8192 + 32768) / 256;
    constexpr int J_ALL = J_TR + J_XR + J_MR + J_ROPE + J_TAB;
    const int tid = threadIdx.x, lane = tid & 63, wid = tid >> 6;
    const double PI2 = 6.283185307179586476925286766559;
    for (int job = blockIdx.x; job < J_ALL; job += gridDim.x) {
        int j = job;
        if (j < J_TR) {
            if (j < J_W1) { tr_tile(p.w_in, INW, (j / 10) * 64, (j % 10) * 128, INW, p.g_mix, wsp<bf16_t>(p, OFF_W1T), 1024, 0, lds); continue; } j -= J_W1;
            if (j < J_WQ) { tr_tile(p.w_q_up, 768, (j / 6) * 64, (j % 6) * 128, 768, p.g_q_lat, wsp<bf16_t>(p, OFF_WQT), 384, 0, lds); continue; } j -= J_WQ;
            if (j < J_WKV) { tr_tile(p.w_kv_up, 1024, (j / 8) * 64, (j % 8) * 128, 1024, p.g_kv_lat, wsp<bf16_t>(p, OFF_WKVT), 256, 0, lds); continue; } j -= J_WKV;
            if (j < J_WOUT) { tr_tile(p.w_out, 1024, (j / 8) * 64, (j % 8) * 128, 1024, nullptr, wsp<bf16_t>(p, OFF_WOUTT), 1024, 0, lds); continue; } j -= J_WOUT;
            if (j < J_WMQ) { tr_tile(p.w_mem_q, 1024, (j / 8) * 64, (j % 8) * 128, 1024, p.g_mem_q, wsp<bf16_t>(p, OFF_WMQT), 1024, 0, lds); continue; } j -= J_WMQ;
            if (j < J_WMKV) { tr_tile(p.w_mem_kv, 2048, (j / 16) * 64, (j % 16) * 128, 2048, p.g_mem_kv, wsp<bf16_t>(p, OFF_WMKVT), 1024, 0, lds); continue; } j -= J_WMKV;
            if (j < J_WMO) { tr_tile(p.w_mem_o, 1024, (j / 8) * 64, (j % 8) * 128, 1024, nullptr, wsp<bf16_t>(p, OFF_WMOT), 1024, 0, lds); continue; } j -= J_WMO;
            if (j < J_WG) { const int e = j >> 7, r = j & 127; tr_tile(p.w_exp_gate + (long)e * 1048576, 1024, (r / 8) * 64, (r % 8) * 128, 1024, p.g_ffn, wsp<bf16_t>(p, OFF_WGUT) + (long)e * 2048 * 1024, 1024, 1, lds); continue; } j -= J_WG;
            if (j < J_WU) { const int e = j >> 7, r = j & 127; tr_tile(p.w_exp_up + (long)e * 1048576, 1024, (r / 8) * 64, (r % 8) * 128, 1024, p.g_ffn, wsp<bf16_t>(p, OFF_WGUT) + (long)e * 2048 * 1024, 1024, 2, lds); continue; } j -= J_WU;
            { const int e = j >> 7, r = j & 127; tr_tile(p.w_exp_down + (long)e * 1048576, 1024, (r / 8) * 64, (r % 8) * 128, 1024, nullptr, wsp<bf16_t>(p, OFF_WDT) + (long)e * 1048576, 1024, 0, lds); continue; }
        }
        j -= J_TR;
        if (j < J_XR + J_MR) {
            const bool isx = j < J_XR;
            const int row = (isx ? j : j - J_XR) * 4 + wid;
            const float* src = (isx ? p.x : p.mem) + (long)row * ND;
            bf16_t* dst = (isx ? wsp<bf16_t>(p, OFF_XB) : wsp<bf16_t>(p, OFF_MEMB)) + (long)row * ND;
            float ss = 0.f;
#pragma unroll
            for (int i = 0; i < 4; i++) {
                const f32x4 v = *(const f32x4*)(src + i * 256 + lane * 4);
                ss += v[0] * v[0] + v[1] * v[1] + v[2] * v[2] + v[3] * v[3];
                *(u32x2*)(dst + i * 256 + lane * 4) = pack4bf(v);
            }
            ss = wave_sum(ss);
            if (lane == 0) (isx ? wsp<float>(p, OFF_R0) : wsp<float>(p, OFF_RMEM))[row] = rsqrtf(ss * (1.f / ND) + 1e-6f);
            continue;
        }
        j -= J_XR + J_MR;
        if (j < J_ROPE) {
            const int i = j * 256 + tid; const int t = i >> 4, jj = i & 15;
            const double f = pow(10000.0, -(double)(2 * jj) / 32.0);
            const double ang = (double)p.pos[t] * f;
            wsp<float2>(p, OFF_ROPE)[i] = make_float2((float)cos(ang), (float)sin(ang));
            continue;
        }
        j -= J_ROPE;
        {
            int i = j * 256 + tid;
            if (i < 4096) { const double a = PI2 * (double)i / 4096.0; wsp<float2>(p, OFF_TW)[i] = make_float2((float)cos(a), (float)sin(a)); continue; } i -= 4096;
            if (i < 8192) {
                const int T = i >> 12, a = (i >> 6) & 63, b = i & 63;
                const double th = PI2 * (double)((a * b) & 63) / 64.0;
                wsp<bf16_t>(p, OFF_T64)[i] = (bf16_t)f2bf((float)(T ? sin(th) : cos(th))); continue;
            } i -= 8192;
            if (i < 16384) {
                const int rho = i >> 7, k = i & 127;
                const int wm = rho >> 6, mi = (rho >> 4) & 3, lr = rho & 15, ri = mi >> 1, k1 = 32 * wm + 16 * (mi & 1) + lr, ab = k >> 6, s1 = k & 63;
                const double th = PI2 * (double)((k1 * s1) & 63) / 64.0;
                const double c = cos(th), s = sin(th);
                const double v = ri == 0 ? (ab == 0 ? c : -s) : (ab == 0 ? s : c);
                wsp<bf16_t>(p, OFF_M1)[i] = (bf16_t)f2bf((float)v); continue;
            } i -= 16384;
            if (i < 8192) {
                const int k2 = i >> 7, k = i & 127, s2 = k & 63;
                const double th = PI2 * (double)((k2 * s2) & 63) / 64.0;
                wsp<bf16_t>(p, OFF_M3)[i] = (bf16_t)f2bf((float)(k < 64 ? cos(th) : -sin(th))); continue;
            } i -= 8192;
            if (i < 32768) {
                const int g = i >> 12, e = (i >> 6) & 63, ch = i & 63;
                wsp<bf16_t>(p, OFF_WFT)[i] = (bf16_t)f2bf(p.w_fourier[(g * 64 + ch) * 64 + e]); continue;
            }
        }
    }
}

__device__ __forceinline__ void phase1(const Params& p, char* lds) {
    const int tid = threadIdx.x, lane = tid & 63, wid = tid >> 6, wm = wid >> 1, wn = wid & 1, lq = lane >> 4, lr = lane & 15;
    constexpr int N_U = 128 * 10, N_M = 8 * 16;
    {
      FOR_XCD_ITEMS(item, N_U) {
        f32x4 acc[4][4];
        {
            const int tm = item / 10, tn = item % 10;
            GemmTile g; g.A = wsp<bf16_t>(p, OFF_XB) + (long)tm * 128 * ND; g.lda = ND; g.arow = nullptr;
            g.Bt = wsp<bf16_t>(p, OFF_W1T) + (long)tn * 128 * ND; g.ldb = ND; g.K = ND;
            gemm_tile_128(g, lds, acc);
            const float* r0 = wsp<float>(p, OFF_R0);
#pragma unroll
            for (int mi = 0; mi < 4; mi++) {
                const int row = tm * 128 + wm * 64 + mi * 16 + lr;
                const float rs = r0[row];
#pragma unroll
                for (int ni = 0; ni < 4; ni++) acc[mi][ni] *= rs;
                if (tn < 4) {
#pragma unroll
                    for (int ni = 0; ni < 4; ni++)
                        *(u32x2*)(wsp<bf16_t>(p, OFF_UF) + (long)row * 512 + tn * 128 + wn * 64 + ni * 16 + 4 * lq) = pack4bf(acc[mi][ni]);
                } else if (tn < 9) {
                    float ss = 0.f;
#pragma unroll
                    for (int ni = 0; ni < 4; ni++) { const f32x4 v = acc[mi][ni]; ss += v[0] * v[0] + v[1] * v[1] + v[2] * v[2] + v[3] * v[3]; }
                    ss += __shfl_xor(ss, 16); ss += __shfl_xor(ss, 32);
                    if (tn < 7) {
#pragma unroll
                        for (int ni = 0; ni < 4; ni++)
                            *(u32x2*)(wsp<bf16_t>(p, OFF_UQ) + (long)row * 384 + (tn - 4) * 128 + wn * 64 + ni * 16 + 4 * lq) = pack4bf(acc[mi][ni]);
                        if (lq == 0) wsp<float>(p, OFF_SSQ)[row * 6 + (tn - 4) * 2 + wn] = ss;
                    } else {
#pragma unroll
                        for (int ni = 0; ni < 4; ni++)
                            *(u32x2*)(wsp<bf16_t>(p, OFF_UKV) + (long)row * 256 + (tn - 7) * 128 + wn * 64 + ni * 16 + 4 * lq) = pack4bf(acc[mi][ni]);
                        if (lq == 0) wsp<float>(p, OFF_SSKV)[row * 4 + (tn - 7) * 2 + wn] = ss;
                    }
                } else if (wn == 0) {
                    const float2* rp = wsp<float2>(p, OFF_ROPE) + (long)row * 16 + 4 * lq;
                    f32x4 o1, o2;
#pragma unroll
                    for (int r = 0; r < 4; r++) {
                        const float2 cs = rp[r];
                        const float x1 = acc[mi][0][r], x2 = acc[mi][1][r];
                        o1[r] = x1 * cs.x - x2 * cs.y; o2[r] = x1 * cs.y + x2 * cs.x;
                    }
                    bf16_t* kr = wsp<bf16_t>(p, OFF_KR) + (long)row * 32;
                    *(u32x2*)(kr + 4 * lq) = pack4bf(o1);
                    *(u32x2*)(kr + 16 + 4 * lq) = pack4bf(o2);
                }
            }
        }
      }
      FOR_XCD_ITEMS(it, N_M) {
        f32x4 acc[4][4];
        {
            const int tm = it / 16, tn = it % 16;
            GemmTile g; g.A = wsp<bf16_t>(p, OFF_MEMB) + (long)tm * 128 * ND; g.lda = ND; g.arow = nullptr;
            g.Bt = wsp<bf16_t>(p, OFF_WMKVT) + (long)tn * 128 * ND; g.ldb = ND; g.K = ND;
            gemm_tile_128(g, lds, acc);
            const float* rm = wsp<float>(p, OFF_RMEM);
#pragma unroll
            for (int mi = 0; mi < 4; mi++) {
                const int row = tm * 128 + wm * 64 + mi * 16 + lr;
                const int b = row >> 8, m = row & 255;
                const float rs = rm[row];
#pragma unroll
                for (int ni = 0; ni < 4; ni++) {
                    const f32x4 v = acc[mi][ni] * rs;
                    const int col = tn * 128 + wn * 64 + ni * 16 + 4 * lq;
                    if (col < 1024) {
                        const int h = col >> 8, d = col & 255;
                        *(u32x2*)(wsp<bf16_t>(p, OFF_KMEM) + ((long)(b * 4 + h) * 256 + m) * 256 + d) = pack4bf(v);
                    } else {
                        const int c2 = col - 1024, h = c2 >> 8, dv = c2 & 255;
                        bf16_t* vt = wsp<bf16_t>(p, OFF_VTMEM) + ((long)(b * 4 + h) * 256 + dv) * 256 + m;
#pragma unroll
                        for (int r = 0; r < 4; r++) vt[r * 256] = (bf16_t)f2bf(v[r]);
                    }
                }
            }
        }
      }
    }
}

template <int MI>
__device__ __forceinline__ void dft_mma(const bf16_t* Ag, int arow0, const char* ximg, int ncol0, f32x4 (&acc)[MI][4]) {
    const int lane = threadIdx.x & 63, lq = lane >> 4, lr = lane & 15;
#pragma unroll
    for (int ks = 0; ks < 4; ks++) {
        bf16x8 af[MI], bfr[4];
#pragma unroll
        for (int mi = 0; mi < MI; mi++) af[mi] = *(const bf16x8*)(Ag + (long)(arow0 + mi * 16 + lr) * 128 + ks * 32 + lq * 8);
#pragma unroll
        for (int ni = 0; ni < 4; ni++) {
            const char* bp = ximg + (ks * 32 + lq * 8) * 272 + (ncol0 + ni * 16 + lr) * 2;
#pragma unroll
            for (int j = 0; j < 8; j++) bfr[ni][j] = *(const short*)(bp + j * 272);
        }
#pragma unroll
        for (int mi = 0; mi < MI; mi++)
#pragma unroll
            for (int ni = 0; ni < 4; ni++) acc[mi][ni] = __builtin_amdgcn_mfma_f32_16x16x32_bf16(bfr[ni], af[mi], acc[mi][ni], 0, 0, 0);
    }
}

__device__ __forceinline__ void f2a_item(const Params& p, int it, char* lds) {
    const int tid = threadIdx.x, lane = tid & 63, wid = tid >> 6, wm = wid >> 1, wn = wid & 1, lq = lane >> 4, lr = lane & 15;
    const int nc = it & 3, s2 = (it >> 2) & 63, b = it >> 8;
    char* uimg = lds; char* ximg = lds + 17408;
    __syncthreads();
#pragma unroll
    for (int i = 0; i < 4; i++) {
        const int ci = tid + 256 * i, row = ci >> 4, cc = ci & 15;
        *(u32x4*)(uimg + row * 272 + cc * 16) = *(const u32x4*)(wsp<bf16_t>(p, OFF_UF) + ((long)(b * NS + 64 * row + s2)) * 512 + nc * 128 + cc * 8);
    }
    __syncthreads();
    {
        const int g2 = wid >> 1, T = wid & 1;
        f32x4 a1[4][4];
#pragma unroll
        for (int mi = 0; mi < 4; mi++)
#pragma unroll
            for (int ni = 0; ni < 4; ni++) a1[mi][ni] = (f32x4){0.f, 0.f, 0.f, 0.f};
        const bf16_t* t64 = wsp<bf16_t>(p, OFF_T64) + T * 4096;
#pragma unroll
        for (int ks = 0; ks < 2; ks++) {
            bf16x8 af[4], bfr[4];
#pragma unroll
            for (int i = 0; i < 4; i++) {
                af[i] = *(const bf16x8*)(uimg + (i * 16 + lr) * 272 + (g2 * 64 + ks * 32 + lq * 8) * 2);
                bfr[i] = *(const bf16x8*)(t64 + (i * 16 + lr) * 64 + ks * 32 + lq * 8);
            }
#pragma unroll
            for (int mi = 0; mi < 4; mi++)
#pragma unroll
                for (int ni = 0; ni < 4; ni++) a1[mi][ni] = __builtin_amdgcn_mfma_f32_16x16x32_bf16(bfr[ni], af[mi], a1[mi][ni], 0, 0, 0);
        }
#pragma unroll
        for (int mi = 0; mi < 4; mi++)
#pragma unroll
            for (int ni = 0; ni < 4; ni++)
                *(u32x2*)(ximg + (T * 64 + mi * 16 + lr) * 272 + (g2 * 64 + ni * 16 + 4 * lq) * 2) = pack4bf(a1[mi][ni]);
    }
    __syncthreads();
    f32x4 acc[4][4];
#pragma unroll
    for (int mi = 0; mi < 4; mi++)
#pragma unroll
        for (int ni = 0; ni < 4; ni++) acc[mi][ni] = (f32x4){0.f, 0.f, 0.f, 0.f};
    dft_mma<4>(wsp<bf16_t>(p, OFF_M1), wm * 64, ximg, wn * 64, acc);
    const float2* tw = wsp<float2>(p, OFF_TW);
#pragma unroll
    for (int m2 = 0; m2 < 2; m2++) {
        const int k1 = 32 * wm + 16 * m2 + lr;
        float2 cs; { const float rev = (float)((s2 * k1) & 4095) * (1.0f / 4096.0f); cs.x = __builtin_amdgcn_cosf(rev); cs.y = __builtin_amdgcn_sinf(rev); (void)tw; }
        const long base = ((long)(b * 64 + k1) * 64 + s2) * 512 + nc * 128 + wn * 64 + 4 * lq;
#pragma unroll
        for (int ni = 0; ni < 4; ni++) {
            const f32x4 yr = acc[m2][ni], yi = acc[m2 + 2][ni];
            const f32x4 orr = yr * cs.x - yi * cs.y, oi = yi * cs.x + yr * cs.y;
            *(u32x2*)(wsp<bf16_t>(p, OFF_YR) + base + ni * 16) = pack4bf(orr);
            *(u32x2*)(wsp<bf16_t>(p, OFF_YI) + base + ni * 16) = pack4bf(oi);
        }
    }
}

__device__ __forceinline__ void f2b_item(const Params& p, int it, char* lds) {
    const int tid = threadIdx.x, lane = tid & 63, wid = tid >> 6, wm = wid >> 1, wn = wid & 1, lq = lane >> 4, lr = lane & 15;
    const int nc = it & 3, k1 = (it >> 2) & 63, b = it >> 8;
    char* ximg = lds; char* zimg = lds + 34816;
    __syncthreads();
#pragma unroll
    for (int i = 0; i < 8; i++) {
        const int ci = tid + 256 * i, row = ci >> 4, cc = ci & 15;
        const bf16_t* src = (row < 64 ? wsp<bf16_t>(p, OFF_YR) : wsp<bf16_t>(p, OFF_YI)) + ((long)(b * 64 + k1) * 64 + (row & 63)) * 512 + nc * 128 + cc * 8;
        *(u32x4*)(ximg + row * 272 + cc * 16) = *(const u32x4*)src;
    }
    __syncthreads();
    f32x4 acc[2][4];
#pragma unroll
    for (int mi = 0; mi < 2; mi++)
#pragma unroll
        for (int ni = 0; ni < 4; ni++) acc[mi][ni] = (f32x4){0.f, 0.f, 0.f, 0.f};
    dft_mma<2>(wsp<bf16_t>(p, OFF_M3), wm * 32, ximg, wn * 64, acc);
#pragma unroll
    for (int mi = 0; mi < 2; mi++)
#pragma unroll
        for (int ni = 0; ni < 4; ni++)
            *(u32x2*)(zimg + (wm * 32 + mi * 16 + lr) * 272 + (wn * 64 + ni * 16 + 4 * lq) * 2) = pack4bf(acc[mi][ni] * (1.0f / 512.0f));
    __syncthreads();
    f32x4 a3[2][4];
#pragma unroll
    for (int mi = 0; mi < 2; mi++)
#pragma unroll
        for (int ni = 0; ni < 4; ni++) a3[mi][ni] = (f32x4){0.f, 0.f, 0.f, 0.f};
    const bf16_t* wft = wsp<bf16_t>(p, OFF_WFT) + (long)(nc * 2 + wn) * 4096;
#pragma unroll
    for (int ks = 0; ks < 2; ks++) {
        bf16x8 af[2], bfr[4];
#pragma unroll
        for (int i = 0; i < 2; i++) af[i] = *(const bf16x8*)(zimg + (wm * 32 + i * 16 + lr) * 272 + (wn * 64 + ks * 32 + lq * 8) * 2);
#pragma unroll
        for (int i = 0; i < 4; i++) bfr[i] = *(const bf16x8*)(wft + (i * 16 + lr) * 64 + ks * 32 + lq * 8);
#pragma unroll
        for (int mi = 0; mi < 2; mi++)
#pragma unroll
            for (int ni = 0; ni < 4; ni++) a3[mi][ni] = __builtin_amdgcn_mfma_f32_16x16x32_bf16(bfr[ni], af[mi], a3[mi][ni], 0, 0, 0);
    }
#pragma unroll
    for (int mi = 0; mi < 2; mi++) {
        const int k2 = wm * 32 + mi * 16 + lr;
        bf16_t* dst = wsp<bf16_t>(p, OFF_ZA) + ((long)(b * NS + k1 + 64 * k2)) * 1024 + nc * 128 + wn * 64 + 4 * lq;
#pragma unroll
        for (int ni = 0; ni < 4; ni++) *(u32x2*)(dst + ni * 16) = pack4bf(a3[mi][ni]);
    }
}

__device__ __forceinline__ void phase2(const Params& p, char* lds) {
    const int tid = threadIdx.x, lane = tid & 63, wid = tid >> 6, wm = wid >> 1, wn = wid & 1, lq = lane >> 4, lr = lane & 15;
    constexpr int N_Q = 128 * 6, N_KV = 128 * 8, N_F = 1024;
    {
      FOR_XCD_ITEMS(item, N_Q) {
        f32x4 acc[4][4];
        {
            const int tm = item / 6, tn = item % 6;
            GemmTile g; g.A = wsp<bf16_t>(p, OFF_UQ) + (long)tm * 128 * 384; g.lda = 384; g.arow = nullptr;
            g.Bt = wsp<bf16_t>(p, OFF_WQT) + (long)tn * 128 * 384; g.ldb = 384; g.K = 384;
            gemm_tile_128(g, lds, acc);
            const float qmul = 0.10206207261596575f * 1.4426950408889634f;
#pragma unroll
            for (int mi = 0; mi < 4; mi++) {
                const int row = tm * 128 + wm * 64 + mi * 16 + lr;
                const int b = row >> 12, s = row & 4095;
                const float* sq = wsp<float>(p, OFF_SSQ) + (long)row * 6;
                const float ss = sq[0] + sq[1] + sq[2] + sq[3] + sq[4] + sq[5];
                const float rs = rsqrtf(ss * (1.f / 384.f) + 1e-6f) * qmul;
                const int cb0 = tn * 128 + wn * 64;
#pragma unroll
                for (int ni = 0; ni < 4; ni++) {
                    const int cb = cb0 + ni * 16, hd = cb / 96, hob = cb % 96;
                    bf16_t* qd = wsp<bf16_t>(p, OFF_Q) + ((long)(b * 8 + hd) * NS + s) * 96;
                    if (hob < 64) {
                        *(u32x2*)(qd + hob + 4 * lq) = pack4bf(acc[mi][ni] * rs);
                    } else if (hob == 64) {
                        if (ni < 3) {
                            const float2* rp = wsp<float2>(p, OFF_ROPE) + (long)row * 16 + 4 * lq;
                            f32x4 o1, o2;
#pragma unroll
                            for (int r = 0; r < 4; r++) {
                                const float2 cs = rp[r];
                                const float x1 = acc[mi][ni][r] * rs, x2 = acc[mi][ni < 3 ? ni + 1 : 3][r] * rs;
                                o1[r] = x1 * cs.x - x2 * cs.y; o2[r] = x1 * cs.y + x2 * cs.x;
                            }
                            *(u32x2*)(qd + 64 + 4 * lq) = pack4bf(o1);
                            *(u32x2*)(qd + 80 + 4 * lq) = pack4bf(o2);
                        }
                    }
                }
            }
        }
      }
      FOR_XCD_ITEMS(it, N_KV) {
        f32x4 acc[4][4];
        {
            const int tm = it >> 3, hd = it & 7;
            GemmTile g; g.A = wsp<bf16_t>(p, OFF_UKV) + (long)tm * 128 * 256; g.lda = 256; g.arow = nullptr;
            g.Bt = wsp<bf16_t>(p, OFF_WKVT) + (long)hd * 128 * 256; g.ldb = 256; g.K = 256;
            gemm_tile_128(g, lds, acc);
#pragma unroll
            for (int mi = 0; mi < 4; mi++) {
                const int row = tm * 128 + wm * 64 + mi * 16 + lr;
                const int b = row >> 12, s = row & 4095;
                const float* sq = wsp<float>(p, OFF_SSKV) + (long)row * 4;
                const float rs = rsqrtf((sq[0] + sq[1] + sq[2] + sq[3]) * (1.f / 256.f) + 1e-6f);
                if (wn == 0) {
                    bf16_t* kd = wsp<bf16_t>(p, OFF_K) + ((long)(b * 8 + hd) * NS + s) * 96;
#pragma unroll
                    for (int ni = 0; ni < 4; ni++) *(u32x2*)(kd + ni * 16 + 4 * lq) = pack4bf(acc[mi][ni] * rs);
                } else {
#pragma unroll
                    for (int ni = 0; ni < 4; ni++) {
                        bf16_t* vd = wsp<bf16_t>(p, OFF_VT) + ((long)(b * 8 + hd) * 64 + ni * 16 + 4 * lq) * NS + s;
#pragma unroll
                        for (int r = 0; r < 4; r++) vd[(long)r * NS] = (bf16_t)f2bf(acc[mi][ni][r] * rs);
                    }
                }
            }
#pragma unroll
            for (int i = 0; i < 2; i++) {
                const int ci = tid + 256 * i, r = ci >> 2, cc = ci & 3;
                const int row = tm * 128 + r, b = row >> 12, s = row & 4095;
                *(u32x4*)(wsp<bf16_t>(p, OFF_K) + ((long)(b * 8 + hd) * NS + s) * 96 + 64 + cc * 8) = *(const u32x4*)(wsp<bf16_t>(p, OFF_KR) + (long)row * 32 + cc * 8);
            }
        }
      }
      FOR_XCD_ITEMS(it, N_F) { f2a_item(p, it, lds); }
    }
}


__device__ __forceinline__ void expert_tr_job(const Params& p, int j, char* lds) {
    const int which = j >> 11, r = j & 2047, e = r >> 7, t = r & 127;
    const int k0 = (t >> 3) * 64, n0 = (t & 7) * 128;
    if (which == 0) tr_tile(p.w_exp_gate + (long)e * 1048576, 1024, k0, n0, 1024, p.g_ffn, wsp<bf16_t>(p, OFF_WGUT) + (long)e * 2048 * 1024, 1024, 1, lds);
    else if (which == 1) tr_tile(p.w_exp_up + (long)e * 1048576, 1024, k0, n0, 1024, p.g_ffn, wsp<bf16_t>(p, OFF_WGUT) + (long)e * 2048 * 1024, 1024, 2, lds);
    else tr_tile(p.w_exp_down + (long)e * 1048576, 1024, k0, n0, 1024, nullptr, wsp<bf16_t>(p, OFF_WDT) + (long)e * 1048576, 1024, 0, lds);
}

__device__ __forceinline__ void phase3(const Params& p, char* lds) {
    constexpr int N_A = NB * 8 * (NS / 128), N_F = 1024;
    const bool tr_first = (blockIdx.x >> 8) & 1;
    if (tr_first) for (int j = blockIdx.x; j < 6144; j += gridDim.x) expert_tr_job(p, j, lds);
    {
      FOR_XCD_ITEMS(item, N_A) {
        {
            const int qt = item & 31, h = (item >> 5) & 7, b = item >> 8;
            const bf16_t* Qp = wsp<bf16_t>(p, OFF_Q) + ((long)(b * 8 + h) * NS + qt * 128) * 96;
            const bf16_t* Kp = wsp<bf16_t>(p, OFF_K) + ((long)(b * 8 + h) * NS) * 96;
            const bf16_t* Vtp = wsp<bf16_t>(p, OFF_VT) + ((long)(b * 8 + h) * 64) * NS;
            bf16_t* Op = wsp<bf16_t>(p, OFF_ZA) + ((long)b * NS + qt * 128) * 1024 + 512 + h * 64;
            attn_block<96, 64, 64>(Qp, Kp, Vtp, (long)NS, NS, lds, [&](int q, int dv, f32x4 v) { *(u32x2*)(Op + (long)q * 1024 + dv) = pack4bf(v); });
        }
      }
      FOR_XCD_ITEMS(it, N_F) { f2b_item(p, it, lds); }
    }
    if (!tr_first) for (int j = blockIdx.x; j < 6144; j += gridDim.x) expert_tr_job(p, j, lds);
}

__device__ __forceinline__ void phase_resid(const Params& p, char* lds, size_t offA, size_t offW, const float* residf, const bf16_t* residb, size_t offXb, size_t offSS) {
    const int tid = threadIdx.x, lane = tid & 63, wid = tid >> 6, wm = wid >> 1, wn = wid & 1, lq = lane >> 4, lr = lane & 15;
    FOR_XCD_ITEMS(item, 128 * 8) {
        const int tm = item >> 3, tn = item & 7;
        f32x4 acc[4][4];
        GemmTile g; g.A = wsp<bf16_t>(p, offA) + (long)tm * 128 * ND; g.lda = ND; g.arow = nullptr;
        g.Bt = wsp<bf16_t>(p, offW) + (long)tn * 128 * ND; g.ldb = ND; g.K = ND;
        gemm_tile_128(g, lds, acc);
#pragma unroll
        for (int mi = 0; mi < 4; mi++) {
            const int row = tm * 128 + wm * 64 + mi * 16 + lr;
            float ss = 0.f;
#pragma unroll
            for (int ni = 0; ni < 4; ni++) {
                const long o = (long)row * ND + tn * 128 + wn * 64 + ni * 16 + 4 * lq;
                f32x4 rv;
                if (residf) rv = *(const f32x4*)(residf + o);
                else { const u32x2 w = *(const u32x2*)(residb + o); rv = (f32x4){__uint_as_float(w.x << 16), __uint_as_float(w.x & 0xFFFF0000u), __uint_as_float(w.y << 16), __uint_as_float(w.y & 0xFFFF0000u)}; }
                const f32x4 v = rv + acc[mi][ni];
                *(u32x2*)(wsp<bf16_t>(p, offXb) + o) = pack4bf(v);
                ss += v[0] * v[0] + v[1] * v[1] + v[2] * v[2] + v[3] * v[3];
            }
            ss += __shfl_xor(ss, 16); ss += __shfl_xor(ss, 32);
            if (lq == 0) wsp<float>(p, offSS)[row * 16 + tn * 2 + wn] = ss;
        }
    }
}
__device__ __forceinline__ float row_rs16(const float* ss) {
    const f32x4 a = *(const f32x4*)ss, b = *(const f32x4*)(ss + 4), c = *(const f32x4*)(ss + 8), d = *(const f32x4*)(ss + 12);
    const f32x4 t = (a + b) + (c + d);
    return rsqrtf(((t[0] + t[1]) + (t[2] + t[3])) * (1.f / 1024.f) + 1e-6f);
}

__device__ __forceinline__ void phase5a(const Params& p, char* lds) {
    const int tid = threadIdx.x, lane = tid & 63, wid = tid >> 6, wm = wid >> 1, wn = wid & 1, lq = lane >> 4, lr = lane & 15;
    FOR_XCD_ITEMS(item, 128 * 8) {
        const int tm = item >> 3, tn = item & 7;
        f32x4 acc[4][4];
        GemmTile g; g.A = wsp<bf16_t>(p, OFF_X1B) + (long)tm * 128 * ND; g.lda = ND; g.arow = nullptr;
        g.Bt = wsp<bf16_t>(p, OFF_WMQT) + (long)tn * 128 * ND; g.ldb = ND; g.K = ND;
        gemm_tile_128(g, lds, acc);
        const int h = tn >> 1;
#pragma unroll
        for (int mi = 0; mi < 4; mi++) {
            const int row = tm * 128 + wm * 64 + mi * 16 + lr, b = row >> 12, s = row & 4095;
            const float rs = row_rs16(wsp<float>(p, OFF_SS1) + (long)row * 16) * (0.0625f * 1.4426950408889634f);
            bf16_t* qd = wsp<bf16_t>(p, OFF_QM) + ((long)(b * 4 + h) * NS + s) * 256 + (tn & 1) * 128 + wn * 64 + 4 * lq;
#pragma unroll
            for (int ni = 0; ni < 4; ni++) *(u32x2*)(qd + ni * 16) = pack4bf(acc[mi][ni] * rs);
        }
    }
}
__device__ __forceinline__ void phase5b(const Params& p, char* lds) {
    FOR_XCD_ITEMS(item, NB * 4 * 32 * 2) {
        const int dvh = item & 1, qt = (item >> 1) & 31, h = (item >> 6) & 3, b = item >> 8;
        const bf16_t* Qp = wsp<bf16_t>(p, OFF_QM) + ((long)(b * 4 + h) * NS + qt * 128) * 256;
        const bf16_t* Kp = wsp<bf16_t>(p, OFF_KMEM) + ((long)(b * 4 + h) * 256) * 256;
        const bf16_t* Vtp = wsp<bf16_t>(p, OFF_VTMEM) + ((long)(b * 4 + h) * 256 + dvh * 128) * 256;
        bf16_t* Op = wsp<bf16_t>(p, OFF_OM) + ((long)b * NS + qt * 128) * 1024 + h * 256 + dvh * 128;
        attn_block<256, 128, 32>(Qp, Kp, Vtp, 256L, 256, lds, [&](int q, int dv, f32x4 v) { *(u32x2*)(Op + (long)q * 1024 + dv) = pack4bf(v); });
    }
}

__device__ __forceinline__ void phase7(const Params& p, char* lds) {
    const int tid = threadIdx.x, lane = tid & 63, wid = tid >> 6;
    float* wr = (float*)lds;
    __syncthreads();
    for (int i = tid; i < 16384; i += 256) { const int k = i >> 4, e = i & 15; wr[e * 1024 + k] = p.w_router[i] * p.g_ffn[k]; }
    __syncthreads();
    for (int tok = blockIdx.x * 4 + wid; tok < NT; tok += gridDim.x * 4) {
        const bf16_t* xr = wsp<bf16_t>(p, OFF_X2B) + (long)tok * ND;
        float a[16];
#pragma unroll
        for (int e = 0; e < 16; e++) a[e] = 0.f;
#pragma unroll 4
        for (int j = 0; j < 16; j++) {
            const float xv = bf2f(xr[lane + 64 * j]);
#pragma unroll
            for (int e = 0; e < 16; e++) a[e] += xv * wr[e * 1024 + lane + 64 * j];
        }
#pragma unroll
        for (int i = 0; i < 8; i++) { const bool hi = lane & 32; const float send = hi ? a[i] : a[i + 8], keep = hi ? a[i + 8] : a[i]; a[i] = keep + __shfl_xor(send, 32); }
#pragma unroll
        for (int i = 0; i < 4; i++) { const bool hi = lane & 16; const float send = hi ? a[i] : a[i + 4], keep = hi ? a[i + 4] : a[i]; a[i] = keep + __shfl_xor(send, 16); }
#pragma unroll
        for (int i = 0; i < 2; i++) { const bool hi = lane & 8; const float send = hi ? a[i] : a[i + 2], keep = hi ? a[i + 2] : a[i]; a[i] = keep + __shfl_xor(send, 8); }
        { const bool hi = lane & 4; const float send = hi ? a[0] : a[1], keep = hi ? a[1] : a[0]; a[0] = keep + __shfl_xor(send, 4); }
        float lg = a[0];
        lg += __shfl_xor(lg, 2); lg += __shfl_xor(lg, 1);
        const int e = ((lane >> 5) & 1) * 8 + ((lane >> 4) & 1) * 4 + ((lane >> 3) & 1) * 2 + ((lane >> 2) & 1);
        lg *= row_rs16(wsp<float>(p, OFF_SS2) + (long)tok * 16);
        float mx = lg;
#pragma unroll
        for (int o = 4; o < 64; o <<= 1) mx = fmaxf(mx, __shfl_xor(mx, o));
        const float ex = expf(lg - mx);
        float sm = ex;
#pragma unroll
        for (int o = 4; o < 64; o <<= 1) sm += __shfl_xor(sm, o);
        if ((lane & 3) == 0) wsp<float>(p, OFF_AFF)[(long)tok * 16 + e] = ex / sm;
    }
}

__device__ __forceinline__ int block_sum_i(int v, int* red) {
    const int lane = threadIdx.x & 63, wid = threadIdx.x >> 6;
#pragma unroll
    for (int o = 32; o > 0; o >>= 1) v += __shfl_xor(v, o);
    __syncthreads();
    if (lane == 0) red[wid] = v;
    __syncthreads();
    return red[0] + red[1] + red[2] + red[3];
}
__device__ __forceinline__ int block_excl_scan_i(int v, int* red, int& total) {
    const int lane = threadIdx.x & 63, wid = threadIdx.x >> 6;
    int inc = v;
#pragma unroll
    for (int o = 1; o < 64; o <<= 1) { const int t = __shfl_up(inc, o); if (lane >= o) inc += t; }
    __syncthreads();
    if (lane == 63) red[wid] = inc;
    __syncthreads();
    int base = 0;
#pragma unroll
    for (int w = 0; w < 4; w++) if (w < wid) base += red[w];
    total = red[0] + red[1] + red[2] + red[3];
    return base + inc - v;
}
__device__ __forceinline__ void phase8(const Params& p, char* lds) {
    int* red = (int*)lds;
    const int tid = threadIdx.x;
    for (int item = blockIdx.x; item < NB * NE; item += gridDim.x) {
        const int e = item & 15, b = item >> 4;
        const float* aff = wsp<float>(p, OFF_AFF) + (long)b * NS * 16 + e;
        unsigned v[16];
#pragma unroll
        for (int i = 0; i < 16; i++) v[i] = __float_as_uint(aff[(long)(tid * 16 + i) * 16]);
        unsigned T = 0;
        for (int bit = 30; bit >= 0; bit--) {
            const unsigned cand = T | (1u << bit);
            int c = 0;
#pragma unroll
            for (int i = 0; i < 16; i++) c += (v[i] >= cand) ? 1 : 0;
            if (block_sum_i(c, red) >= CAP) T = cand;
        }
        int cg = 0, ce = 0;
#pragma unroll
        for (int i = 0; i < 16; i++) { cg += (v[i] > T) ? 1 : 0; ce += (v[i] == T) ? 1 : 0; }
        int tot;
        const int pk = block_excl_scan_i(cg | (ce << 16), red, tot);
        const int need = CAP - (tot & 0xFFFF);
        const int pe = pk >> 16;
        int nse = need - pe; nse = nse < 0 ? 0 : (nse > ce ? ce : nse);
        int tot2;
        int slot = block_excl_scan_i(cg + nse, red, tot2);
        int* slots = wsp<int>(p, OFF_SLOTS) + (long)(b * NE + e) * NS;
        int* idx = wsp<int>(p, OFF_IDX) + (long)(b * NE + e) * CAP;
        float* gate = wsp<float>(p, OFF_GATE) + (long)(b * NE + e) * CAP;
        int eqs = 0;
#pragma unroll
        for (int i = 0; i < 16; i++) {
            const int t = tid * 16 + i;
            bool sel = v[i] > T;
            if (v[i] == T) { sel = eqs < nse; eqs++; }
            if (sel) { slots[t] = slot; idx[slot] = b * NS + t; gate[slot] = __uint_as_float(v[i]); slot++; }
            else slots[t] = -1;
        }
    }
}

__device__ __forceinline__ void phase9(const Params& p, char* lds) {
    const int tid = threadIdx.x, lane = tid & 63, wid = tid >> 6, wm = wid >> 1, wn = wid & 1, lq = lane >> 4, lr = lane & 15;
    FOR_XCD_ITEMS(item, NE * 16 * NB * 4) {
        const int rt = item & 3, b = (item >> 2) & 3, ct = (item >> 4) & 15, e = item >> 8;
        const int* arow = wsp<int>(p, OFF_IDX) + (long)(b * NE + e) * CAP + rt * 128;
        f32x4 acc[4][4];
        GemmTile g; g.A = wsp<bf16_t>(p, OFF_X2B); g.lda = ND; g.arow = arow;
        g.Bt = wsp<bf16_t>(p, OFF_WGUT) + ((long)e * 2048 + ct * 128) * ND; g.ldb = ND; g.K = ND;
        gemm_tile_128(g, lds, acc);
#pragma unroll
        for (int mi = 0; mi < 4; mi++) {
            const int r = wm * 64 + mi * 16 + lr;
            const int tok = arow[r];
            const float rs = row_rs16(wsp<float>(p, OFF_SS2) + (long)tok * 16);
            bf16_t* ad = wsp<bf16_t>(p, OFF_ACT) + ((long)(e * NB + b) * CAP + rt * 128 + r) * ND + ct * 64 + wn * 32 + 4 * lq;
#pragma unroll
            for (int pp = 0; pp < 2; pp++) {
                f32x4 o;
#pragma unroll
                for (int q = 0; q < 4; q++) {
                    const float ga = acc[mi][2 * pp][q] * rs, up = acc[mi][2 * pp + 1][q] * rs;
                    o[q] = ga / (1.f + __expf(-ga)) * up;
                }
                *(u32x2*)(ad + pp * 16) = pack4bf(o);
            }
        }
    }
}
__device__ __forceinline__ void phase10(const Params& p, char* lds) {
    const int tid = threadIdx.x, lane = tid & 63, wid = tid >> 6, wm = wid >> 1, wn = wid & 1, lq = lane >> 4, lr = lane & 15;
    FOR_XCD_ITEMS(item, NE * 8 * NB * 4) {
        const int rt = item & 3, b = (item >> 2) & 3, ct = (item >> 4) & 7, e = item >> 7;
        const long row0 = (long)(e * NB + b) * CAP + rt * 128;
        f32x4 acc[4][4];
        GemmTile g; g.A = wsp<bf16_t>(p, OFF_ACT) + row0 * ND; g.lda = ND; g.arow = nullptr;
        g.Bt = wsp<bf16_t>(p, OFF_WDT) + ((long)e * 1024 + ct * 128) * ND; g.ldb = ND; g.K = ND;
        gemm_tile_128(g, lds, acc);
        const float* gate = wsp<float>(p, OFF_GATE) + (long)(b * NE + e) * CAP + rt * 128;
#pragma unroll
        for (int mi = 0; mi < 4; mi++) {
            const int r = wm * 64 + mi * 16 + lr;
            const float gv = gate[r];
            bf16_t* yd = wsp<bf16_t>(p, OFF_Y) + (row0 + r) * ND + ct * 128 + wn * 64 + 4 * lq;
#pragma unroll
            for (int ni = 0; ni < 4; ni++) *(u32x2*)(yd + ni * 16) = pack4bf(acc[mi][ni] * gv);
        }
    }
}

__device__ __forceinline__ void phase11(const Params& p, char* lds) {
    const int tid = threadIdx.x, lane = tid & 63, wid = tid >> 6;
    for (int tok = blockIdx.x * 4 + wid; tok < NT; tok += gridDim.x * 4) {
        const int b = tok >> 12, t = tok & 4095;
        float* xr = p.out + (long)tok * ND;
        const bf16_t* xb2 = wsp<bf16_t>(p, OFF_X2B) + (long)tok * ND;
        f32x4 v[4];
#pragma unroll
        for (int i = 0; i < 4; i++) {
            const u32x2 w = *(const u32x2*)(xb2 + i * 256 + lane * 4);
            v[i] = (f32x4){__uint_as_float(w.x << 16), __uint_as_float(w.x & 0xFFFF0000u), __uint_as_float(w.y << 16), __uint_as_float(w.y & 0xFFFF0000u)};
        }
        for (int e = 0; e < NE; e++) {
            const int sl = wsp<int>(p, OFF_SLOTS)[(long)(b * NE + e) * NS + t];
            if (sl >= 0) {
                const bf16_t* yr = wsp<bf16_t>(p, OFF_Y) + ((long)(e * NB + b) * CAP + sl) * ND;
#pragma unroll
                for (int i = 0; i < 4; i++) {
                    const u32x2 w = *(const u32x2*)(yr + i * 256 + lane * 4);
                    v[i][0] += __uint_as_float(w.x << 16); v[i][1] += __uint_as_float(w.x & 0xFFFF0000u);
                    v[i][2] += __uint_as_float(w.y << 16); v[i][3] += __uint_as_float(w.y & 0xFFFF0000u);
                }
            }
        }
        float ss = 0.f;
#pragma unroll
        for (int i = 0; i < 4; i++) ss += v[i][0] * v[i][0] + v[i][1] * v[i][1] + v[i][2] * v[i][2] + v[i][3] * v[i][3];
        ss = wave_sum(ss);
        const float rs = rsqrtf(ss * (1.f / ND) + 1e-6f);
#pragma unroll
        for (int i = 0; i < 4; i++) {
            const f32x4 gf = *(const f32x4*)(p.g_final + i * 256 + lane * 4);
            *(f32x4*)(xr + i * 256 + lane * 4) = v[i] * rs * gf;
        }
    }
}

__global__ void __launch_bounds__(256, 2) k_fwd(Params p, int ph_lo, int ph_hi) {
    extern __shared__ __attribute__((aligned(16))) char lds[];
    volatile LAS unsigned* st = (volatile LAS unsigned*)(lds + LDS_MAIN);
    if (threadIdx.x == 0) { st[0] = 0u; st[1] = 0u; }
    __syncthreads();
    XcdBarrier bar = xcd_barrier_post(wsp<unsigned>(p, OFF_BAR), st);
#if USE_CG_SYNC
#define GRID_BARRIER() do { asm volatile("s_waitcnt vmcnt(0)" ::: "memory"); __syncthreads(); cg::this_grid().sync(); asm volatile("s_waitcnt vmcnt(0)" ::: "memory"); __syncthreads(); } while (0)
#else
#define GRID_BARRIER() xcd_barrier(bar)
#endif
#define RUN_PHASE(k, call) if (ph_lo <= (k) && (k) < ph_hi) { if ((k) > ph_lo) { GRID_BARRIER(); } call; }
    RUN_PHASE(0, phase0(p, lds))
    RUN_PHASE(1, phase1(p, lds))
    RUN_PHASE(2, phase2(p, lds))
    RUN_PHASE(3, phase3(p, lds))
    RUN_PHASE(4, phase_resid(p, lds, OFF_ZA, OFF_WOUTT, p.x, nullptr, OFF_X1B, OFF_SS1))
    RUN_PHASE(5, phase5a(p, lds))
    RUN_PHASE(6, phase5b(p, lds))
    RUN_PHASE(7, phase_resid(p, lds, OFF_OM, OFF_WMOT, nullptr, wsp<bf16_t>(p, OFF_X1B), OFF_X2B, OFF_SS2))
    RUN_PHASE(8, phase7(p, lds))
    RUN_PHASE(9, phase8(p, lds))
    RUN_PHASE(10, phase9(p, lds))
    RUN_PHASE(11, phase10(p, lds))
    RUN_PHASE(12, phase11(p, lds))
}

extern "C" void kernel_launch(void* const* d_in, const int* in_sizes, int n_in,
                              void* d_out, int out_size, void* d_ws, size_t ws_size,
                              hipStream_t stream) {
    static int grid = 0;
    if (grid == 0) {
        if (n_in != 22 || ws_size < WS_END) { fprintf(stderr, "kernel_launch: unexpected inputs (n_in %d, ws %zu < %zu)\n", n_in, ws_size, (size_t)WS_END); grid = -1; return; }
        int dev = 0, cus = 0, per_cu = 0;
        (void)hipGetDevice(&dev);
        (void)hipDeviceGetAttribute(&cus, hipDeviceAttributeMultiprocessorCount, dev);
        if (hipFuncSetAttribute((const void*)k_fwd, hipFuncAttributeMaxDynamicSharedMemorySize, LDS_TOTAL) != hipSuccess) { fprintf(stderr, "kernel_launch: hipFuncSetAttribute failed\n"); grid = -1; return; }
        if (hipOccupancyMaxActiveBlocksPerMultiprocessor(&per_cu, (const void*)k_fwd, 256, LDS_TOTAL) != hipSuccess || per_cu < 1) { fprintf(stderr, "kernel_launch: occupancy query failed (%d)\n", per_cu); (void)hipGetLastError(); per_cu = 1; }
        if (per_cu > 2) per_cu = 2;
        grid = cus * per_cu;
        fprintf(stderr, "kernel_launch: %d CUs x %d blocks\n", cus, per_cu);
    }
    if (grid < 0) return;
    Params p{};
    p.x = (const float*)d_in[0]; p.mem = (const float*)d_in[1]; p.pos = (const int*)d_in[2];
    p.g_mix = (const float*)d_in[3]; p.w_in = (const float*)d_in[4]; p.g_q_lat = (const float*)d_in[5]; p.w_q_up = (const float*)d_in[6];
    p.g_kv_lat = (const float*)d_in[7]; p.w_kv_up = (const float*)d_in[8]; p.w_fourier = (const float*)d_in[9]; p.w_out = (const float*)d_in[10];
    p.g_mem_q = (const float*)d_in[11]; p.g_mem_kv = (const float*)d_in[12]; p.w_mem_q = (const float*)d_in[13]; p.w_mem_kv = (const float*)d_in[14];
    p.w_mem_o = (const float*)d_in[15]; p.g_ffn = (const float*)d_in[16]; p.w_router = (const float*)d_in[17];
    p.w_exp_gate = (const float*)d_in[18]; p.w_exp_up = (const float*)d_in[19]; p.w_exp_down = (const float*)d_in[20]; p.g_final = (const float*)d_in[21];
    p.out = (float*)d_out; p.ws = (char*)d_ws;
    static const int cuts[] = MK_CUTS;
    const int ncut = (int)(sizeof(cuts) / sizeof(int));
    for (int li = 0; li + 1 < ncut; li++) {
        (void)hipMemsetAsync((char*)d_ws + OFF_BAR, 0, 16384, stream);
        int lo = cuts[li], hi = cuts[li + 1];
        void* args[] = {&p, &lo, &hi};
        hipError_t e = hipLaunchCooperativeKernel((const void*)k_fwd, dim3(grid), dim3(256), args, LDS_TOTAL, stream);
        if (e != hipSuccess) fprintf(stderr, "cooperative launch failed: %s (grid %d)\n", hipGetErrorString(e), grid);
    }
}
```

```cpp
#include <hip/hip_runtime.h>
#include <stdint.h>
#include <cstdio>
#include <hip/hip_cooperative_groups.h>
namespace cg = cooperative_groups;
#ifndef USE_CG_SYNC
#define USE_CG_SYNC 0
#endif

#ifndef MK_CUTS
#define MK_CUTS {0, 13}
#endif

#define NB 4
#define NS 4096
#define ND 1024
#define NT (NB * NS)
#define INW 1184
#define NE 16
#define CAP 512
#define MEML 256
#define NPHASE 13

typedef unsigned short bf16_t;
typedef short bf16x8 __attribute__((ext_vector_type(8)));
typedef float f32x4 __attribute__((ext_vector_type(4)));
typedef float f32x16 __attribute__((ext_vector_type(16)));
typedef unsigned u32x4 __attribute__((ext_vector_type(4)));
typedef unsigned u32x2 __attribute__((ext_vector_type(2)));

__device__ __forceinline__ unsigned f2bf(float f) {
    unsigned u = __float_as_uint(f);
    u += 0x7FFFu + ((u >> 16) & 1u);
    return u >> 16;
}
typedef __bf16 hbf2 __attribute__((ext_vector_type(2)));
typedef float f32x2 __attribute__((ext_vector_type(2)));
__device__ __forceinline__ unsigned pack2bf(float lo, float hi) { f32x2 v = {lo, hi}; return __builtin_bit_cast(unsigned, __builtin_convertvector(v, hbf2)); }
__device__ __forceinline__ float bf2f(unsigned short b) { return __uint_as_float(((unsigned)b) << 16); }

__device__ __forceinline__ int tile_off(int row, int chunk) { return row * 128 + ((chunk ^ ((row >> 1) & 7)) << 4); }

#define GT_LDS_BYTES 65536

struct GemmTile { const bf16_t* A; long lda; const int* arow; const bf16_t* Bt; long ldb; int K; };

__device__ __forceinline__ void gemm_tile_128(const GemmTile& g, char* lds, f32x4 (&acc)[4][4]) {
    const int tid = threadIdx.x, lane = tid & 63, wid = tid >> 6, wm = wid >> 1, wn = wid & 1;
    const int lrow = lane >> 3, pc = lane & 7;
    const bf16_t* ap[4]; const bf16_t* bp[4];
#pragma unroll
    for (int i = 0; i < 4; i++) {
        const int r = (wid * 4 + i) * 8 + lrow;
        const int c = pc ^ ((r >> 1) & 7);
        const long ro = g.arow ? (long)g.arow[r] * g.lda : (long)r * g.lda;
        ap[i] = g.A + ro + c * 8;
        bp[i] = g.Bt + (long)r * g.ldb + c * 8;
    }
#pragma unroll
    for (int mi = 0; mi < 4; mi++)
#pragma unroll
        for (int ni = 0; ni < 4; ni++) acc[mi][ni] = (f32x4){0.f, 0.f, 0.f, 0.f};
    const int nk = g.K >> 6;
    auto stage = [&](int kt, char* st) {
#pragma unroll
        for (int i = 0; i < 4; i++) {
            __builtin_amdgcn_global_load_lds((const unsigned*)(ap[i] + kt * 64), (unsigned*)(st + (wid * 4 + i) * 1024), 16, 0, 0);
            __builtin_amdgcn_global_load_lds((const unsigned*)(bp[i] + kt * 64), (unsigned*)(st + 16384 + (wid * 4 + i) * 1024), 16, 0, 0);
        }
    };
    __syncthreads();
    stage(0, lds);
    asm volatile("s_waitcnt vmcnt(0)" ::: "memory");
    __syncthreads();
    for (int kt = 0; kt < nk; kt++) {
        char* cur = lds + (kt & 1) * 32768;
        if (kt + 1 < nk) stage(kt + 1, lds + ((kt + 1) & 1) * 32768);
        bf16x8 af[2][4], bfr[2][4];
#pragma unroll
        for (int ks = 0; ks < 2; ks++)
#pragma unroll
            for (int i = 0; i < 4; i++) {
                af[ks][i] = *(const bf16x8*)(cur + tile_off(wm * 64 + i * 16 + (lane & 15), ks * 4 + (lane >> 4)));
                bfr[ks][i] = *(const bf16x8*)(cur + 16384 + tile_off(wn * 64 + i * 16 + (lane & 15), ks * 4 + (lane >> 4)));
            }
        __builtin_amdgcn_s_setprio(1);
#pragma unroll
        for (int ks = 0; ks < 2; ks++)
#pragma unroll
            for (int mi = 0; mi < 4; mi++)
#pragma unroll
                for (int ni = 0; ni < 4; ni++)
                    acc[mi][ni] = __builtin_amdgcn_mfma_f32_16x16x32_bf16(bfr[ks][ni], af[ks][mi], acc[mi][ni], 0, 0, 0);
        __builtin_amdgcn_s_setprio(0);
        asm volatile("s_waitcnt vmcnt(0)" ::: "memory");
        __syncthreads();
    }
}

template <int DQK, int DVT, int KT>
struct AttnCfg {
    static constexpr int KROW = DQK * 2 + 16;
    static constexpr int VROW = KT * 2 + 8;
    static constexpr int KBYTES = KT * KROW;
    static constexpr int VBYTES = DVT * VROW;
    static constexpr int STAGE = KBYTES + VBYTES;
    static constexpr int LDS = 2 * STAGE;
};

template <int DQK, int DVT, int KT, class Out>
__device__ __forceinline__ void attn_block(const bf16_t* Qp, const bf16_t* Kp, const bf16_t* Vtp, long ldv, int nk, char* lds, Out&& out) {
    typedef AttnCfg<DQK, DVT, KT> C;
    constexpr int NKS = DQK / 16, NST = KT / 32, NDT = DVT / 32, NPS = KT / 16;
    constexpr int KCPR = DQK / 8;
    constexpr int KCH = KT * KCPR / 256;
    constexpr int VCPR = KT / 8;
    constexpr int VCH = DVT * VCPR / 256;
    const int tid = threadIdx.x, lane = tid & 63, wid = tid >> 6, h = lane >> 5, c = lane & 31;

    bf16x8 qf[NKS];
    {
        const bf16_t* qrow = Qp + (long)(wid * 32 + c) * DQK + 8 * h;
#pragma unroll
        for (int ks = 0; ks < NKS; ks++) qf[ks] = *(const bf16x8*)(qrow + 16 * ks);
    }
    f32x16 o[NDT];
#pragma unroll
    for (int dt = 0; dt < NDT; dt++)
#pragma unroll
        for (int r = 0; r < 16; r++) o[dt][r] = 0.f;
    float m = 0.f, l = 0.f;

    u32x4 kr[KCH], vr[VCH];
    auto gload = [&](int t) {
#pragma unroll
        for (int i = 0; i < KCH; i++) {
            const int ci = tid + 256 * i, row = ci / KCPR, cc = ci % KCPR;
            kr[i] = *(const u32x4*)(Kp + (long)(t * KT + row) * DQK + cc * 8);
        }
#pragma unroll
        for (int i = 0; i < VCH; i++) {
            const int ci = tid + 256 * i, row = ci / VCPR, cc = ci % VCPR;
            vr[i] = *(const u32x4*)(Vtp + (long)row * ldv + t * KT + cc * 8);
        }
    };
    auto lwrite = [&](char* st) {
#pragma unroll
        for (int i = 0; i < KCH; i++) {
            const int ci = tid + 256 * i, row = ci / KCPR, cc = ci % KCPR;
            *(u32x4*)(st + row * C::KROW + cc * 16) = kr[i];
        }
#pragma unroll
        for (int i = 0; i < VCH; i++) {
            const int ci = tid + 256 * i, row = ci / VCPR, cc = ci % VCPR;
            char* p = st + C::KBYTES + row * C::VROW + cc * 16;
            *(u32x2*)(p) = (u32x2){vr[i].x, vr[i].y};
            *(u32x2*)(p + 8) = (u32x2){vr[i].z, vr[i].w};
        }
    };
    const int nt = nk / KT;
    gload(0);
    __syncthreads();
    lwrite(lds);
    __syncthreads();
    for (int t = 0; t < nt; t++) {
        char* cur = lds + (t & 1) * C::STAGE;
        if (t + 1 < nt) gload(t + 1);
        f32x16 s[NST];
        const float negm = -m;
#pragma unroll
        for (int st = 0; st < NST; st++) {
#pragma unroll
            for (int r = 0; r < 16; r++) s[st][r] = negm;
#pragma unroll
            for (int ks = 0; ks < NKS; ks++) {
                const bf16x8 kf = *(const bf16x8*)(cur + (st * 32 + c) * C::KROW + ks * 32 + h * 16);
                s[st] = __builtin_amdgcn_mfma_f32_32x32x16_bf16(kf, qf[ks], s[st], 0, 0, 0);
            }
        }
        float mx = s[0][0];
#pragma unroll
        for (int st = 0; st < NST; st++)
#pragma unroll
            for (int r = 0; r < 16; r++) mx = fmaxf(mx, s[st][r]);
        mx = fmaxf(mx, __shfl_xor(mx, 32));
        if (__any(mx > 8.0f)) {
            const float d = fmaxf(mx, 0.f);
            const float alpha = __builtin_amdgcn_exp2f(-d);
            m += d;
            l *= alpha;
#pragma unroll
            for (int dt = 0; dt < NDT; dt++)
#pragma unroll
                for (int r = 0; r < 16; r++) o[dt][r] *= alpha;
#pragma unroll
            for (int st = 0; st < NST; st++)
#pragma unroll
                for (int r = 0; r < 16; r++) s[st][r] -= d;
        }
        float rs = 0.f;
#pragma unroll
        for (int st = 0; st < NST; st++)
#pragma unroll
            for (int r = 0; r < 16; r++) { const float p = __builtin_amdgcn_exp2f(s[st][r]); rs += p; s[st][r] = p; }
        l += rs;
#pragma unroll
        for (int ps = 0; ps < NPS; ps++) {
            const int st = ps >> 1, u = ps & 1;
            u32x4 pw;
            pw.x = pack2bf(s[st][8 * u + 0], s[st][8 * u + 1]);
            pw.y = pack2bf(s[st][8 * u + 2], s[st][8 * u + 3]);
            pw.z = pack2bf(s[st][8 * u + 4], s[st][8 * u + 5]);
            pw.w = pack2bf(s[st][8 * u + 6], s[st][8 * u + 7]);
            const bf16x8 pf = __builtin_bit_cast(bf16x8, pw);
#pragma unroll
            for (int dt = 0; dt < NDT; dt++) {
                const char* vp = cur + C::KBYTES + (dt * 32 + c) * C::VROW + (ps * 16 + 4 * h) * 2;
                const u32x2 v0 = *(const u32x2*)(vp);
                const u32x2 v1 = *(const u32x2*)(vp + 16);
                const bf16x8 vf = __builtin_bit_cast(bf16x8, ((u32x4){v0.x, v0.y, v1.x, v1.y}));
                o[dt] = __builtin_amdgcn_mfma_f32_32x32x16_bf16(vf, pf, o[dt], 0, 0, 0);
            }
        }
        if (t + 1 < nt) lwrite(lds + ((t + 1) & 1) * C::STAGE);
        __syncthreads();
    }
    l += __shfl_xor(l, 32);
    const float inv = 1.f / l;
#pragma unroll
    for (int dt = 0; dt < NDT; dt++)
#pragma unroll
        for (int g4 = 0; g4 < 4; g4++) {
            f32x4 v = {o[dt][4 * g4 + 0] * inv, o[dt][4 * g4 + 1] * inv, o[dt][4 * g4 + 2] * inv, o[dt][4 * g4 + 3] * inv};
            out(wid * 32 + c, dt * 32 + 8 * g4 + 4 * h, v);
        }
}


constexpr size_t SLOT = 33554432;
constexpr size_t OFF_W1T = 0;
constexpr size_t OFF_WQT = OFF_W1T + 1280UL * 1024 * 2;
constexpr size_t OFF_WKVT = OFF_WQT + 768UL * 384 * 2;
constexpr size_t OFF_WOUTT = OFF_WKVT + 1024UL * 256 * 2;
constexpr size_t OFF_WMQT = OFF_WOUTT + 1024UL * 1024 * 2;
constexpr size_t OFF_WMKVT = OFF_WMQT + 1024UL * 1024 * 2;
constexpr size_t OFF_WMOT = OFF_WMKVT + 2048UL * 1024 * 2;
constexpr size_t OFF_WGUT = OFF_WMOT + 1024UL * 1024 * 2;
constexpr size_t OFF_WDT = OFF_WGUT + 16UL * 2048 * 1024 * 2;
constexpr size_t OFF_T64 = OFF_WDT + 16UL * 1024 * 1024 * 2;
constexpr size_t OFF_M1 = OFF_T64 + 16384;
constexpr size_t OFF_M3 = OFF_M1 + 32768;
constexpr size_t OFF_WFT = OFF_M3 + 16384;
constexpr size_t OFF_TW = OFF_WFT + 65536;
constexpr size_t OFF_ROPE = OFF_TW + 32768;
constexpr size_t OFF_R0 = OFF_ROPE + (size_t)NT * 16 * 8;
constexpr size_t OFF_RMEM = OFF_R0 + (size_t)NT * 4;
constexpr size_t OFF_SSQ = OFF_RMEM + 4096;
constexpr size_t OFF_SSKV = OFF_SSQ + (size_t)NT * 6 * 4;
constexpr size_t OFF_SS1 = OFF_SSKV + (size_t)NT * 4 * 4;
constexpr size_t OFF_SS2 = OFF_SS1 + (size_t)NT * 16 * 4;
constexpr size_t OFF_AFF = OFF_SS2 + (size_t)NT * 16 * 4;
constexpr size_t OFF_SLOTS = OFF_AFF + (size_t)NT * 16 * 4;
constexpr size_t OFF_IDX = OFF_SLOTS + 4UL * 16 * 4096 * 4;
constexpr size_t OFF_GATE = OFF_IDX + 4UL * 16 * 512 * 4;
constexpr size_t OFF_MEMB = OFF_GATE + 4UL * 16 * 512 * 4;
constexpr size_t OFF_KMEM = OFF_MEMB + 1024UL * 1024 * 2;
constexpr size_t OFF_VTMEM = OFF_KMEM + 1024UL * 1024 * 2;
constexpr size_t OFF_KR = OFF_VTMEM + 1024UL * 1024 * 2;
constexpr size_t OFF_BAR = OFF_KR + (size_t)NT * 32 * 2;
constexpr size_t OFF_S0 = (OFF_BAR + 16384 + 255) / 256 * 256;
constexpr size_t OFF_S1 = OFF_S0 + SLOT;
constexpr size_t OFF_S2 = OFF_S1 + SLOT;
constexpr size_t OFF_S3 = OFF_S2 + SLOT;
constexpr size_t OFF_S4 = OFF_S3 + SLOT;
constexpr size_t WS_END = OFF_S4 + SLOT;
static_assert(WS_END <= 300964352UL, "workspace map exceeds the guaranteed scratch size");
constexpr size_t OFF_XB = OFF_S0, OFF_YR = OFF_S0, OFF_YI = OFF_S0 + SLOT / 2, OFF_X1B = OFF_S3, OFF_OM = OFF_S0, OFF_ACT = OFF_S0;
constexpr size_t OFF_UF = OFF_S1, OFF_UQ = OFF_S1 + (size_t)NT * 512 * 2, OFF_ZA = OFF_S1, OFF_QM = OFF_S1;
constexpr size_t OFF_Q = OFF_S2, OFF_UKV = OFF_S2 + (size_t)NT * 768 * 2, OFF_X2B = OFF_S2;
constexpr size_t OFF_K = OFF_S3, OFF_Y = OFF_S3;
constexpr size_t OFF_VT = OFF_S4;

struct Params {
    const float *x, *mem; const int* pos;
    const float *g_mix, *w_in, *g_q_lat, *w_q_up, *g_kv_lat, *w_kv_up, *w_fourier, *w_out, *g_mem_q, *g_mem_kv, *w_mem_q, *w_mem_kv, *w_mem_o,
        *g_ffn, *w_router, *w_exp_gate, *w_exp_up, *w_exp_down, *g_final;
    float* out; char* ws;
};
template <class T> __device__ __forceinline__ T* wsp(const Params& p, size_t off) { return (T*)(p.ws + off); }

#define LDS_MAIN 65536
#define LDS_TOTAL (LDS_MAIN + 16)
#define LAS __attribute__((address_space(3)))

#define XB_TMO      128
#define XB_XCNT(j)  (256  + 64 * (j))
#define XB_XSUB(j)  (1280 + 64 * (j))
#define XB_XGEN(j)  (2304 + 64 * (j))
#define XB_TOP      3328
#define XB_TOPGEN   3392
#define XCD_BAR_WORDS 3456
#define XB_SPIN_CAP (1u << 25)
__device__ __forceinline__ unsigned xb_ld(unsigned* p)              { return __hip_atomic_load(p, __ATOMIC_RELAXED, __HIP_MEMORY_SCOPE_AGENT); }
__device__ __forceinline__ unsigned xb_add(unsigned* p, unsigned v) { return __hip_atomic_fetch_add(p, v, __ATOMIC_RELAXED, __HIP_MEMORY_SCOPE_AGENT); }
__device__ __forceinline__ unsigned xb_xcc_id() { return (unsigned)__builtin_amdgcn_s_getreg((3 << 11) | 20) & 0xFu; }
#define XB_SPIN(cond, bar) do { unsigned _sp = 0; while (cond) { __builtin_amdgcn_s_sleep(1); \
    if ((++_sp & 255u) == 0u) { if (xb_ld(&(bar)[XB_TMO])) break; if (_sp > XB_SPIN_CAP) { atomicAdd(&(bar)[XB_TMO], 1u); break; } } } } while (0)
struct XcdBarrier { unsigned* bar; unsigned x; volatile LAS unsigned* st; };
__device__ __forceinline__ XcdBarrier xcd_barrier_post(unsigned* bar, volatile LAS unsigned* st) {
    XcdBarrier b; b.bar = bar; b.x = xb_xcc_id(); b.st = st;
    if (threadIdx.x == 0) (void)xb_add(&bar[XB_XCNT(b.x)], 1u);
    return b;
}
__device__ __forceinline__ void xcd_barrier_complete(unsigned* bar, unsigned x, unsigned& nloc, unsigned& nx) {
    const unsigned G = gridDim.x * gridDim.y * gridDim.z;
    unsigned sum, cnt, mine, sp = 0u;
    for (;;) {
        sum = 0u; cnt = 0u; mine = 0u;
#pragma unroll
        for (unsigned j = 0; j < 16; ++j) { const unsigned c = xb_ld(&bar[XB_XCNT(j)]); sum += c; cnt += (c > 0u) ? 1u : 0u; mine = (j == x) ? c : mine; }
        if (sum == G) break;
        __builtin_amdgcn_s_sleep(1);
        if ((++sp & 255u) == 0u) { if (xb_ld(&bar[XB_TMO])) break; if (sp > XB_SPIN_CAP) { atomicAdd(&bar[XB_TMO], 1u); break; } }
    }
    nloc = mine > 0u ? mine : 1u; nx = cnt > 0u ? cnt : 1u;
}
__device__ __forceinline__ void xcd_barrier(const XcdBarrier& b) {
    asm volatile("s_waitcnt vmcnt(0)" ::: "memory");
    __syncthreads();
    if (threadIdx.x == 0) {
        unsigned* bar = b.bar;
        __builtin_amdgcn_s_waitcnt(0);
        unsigned nloc = b.st[0], nx = b.st[1];
        if (nloc == 0u) { xcd_barrier_complete(bar, b.x, nloc, nx); b.st[0] = nloc; b.st[1] = nx; }
        const unsigned old = xb_add(&bar[XB_XSUB(b.x)], 1u);
        const unsigned gen = old / nloc;
        if (old + 1u == (gen + 1u) * nloc) {
            __builtin_amdgcn_fence(__ATOMIC_RELEASE, "agent");
            asm volatile("s_waitcnt vmcnt(0)" ::: "memory");
            const unsigned og = xb_add(&bar[XB_TOP], 1u);
            const unsigned tg = og / nx;
            if (og + 1u == (tg + 1u) * nx) xb_add(&bar[XB_TOPGEN], 1u);
            else XB_SPIN(xb_ld(&bar[XB_TOPGEN]) == tg, bar);
            __builtin_amdgcn_fence(__ATOMIC_ACQUIRE, "agent");
            xb_add(&bar[XB_XGEN(b.x)], 1u);
            asm volatile("s_waitcnt vmcnt(0)" ::: "memory");
        } else {
            XB_SPIN(xb_ld(&bar[XB_XGEN(b.x)]) == gen, bar);
            __builtin_amdgcn_fence(__ATOMIC_ACQUIRE, "agent");
            asm volatile("s_waitcnt vmcnt(0)" ::: "memory");
        }
    }
    __syncthreads();
}

#define FOR_XCD_ITEMS(item, N) for (int _L = (int)(blockIdx.x >> 3), item; _L < (N) / 8 && ((item = (int)(blockIdx.x & 7) * ((N) / 8) + _L), true); _L += (int)(gridDim.x >> 3))

__device__ __forceinline__ u32x2 pack4bf(float a, float b, float c, float d) { return (u32x2){pack2bf(a, b), pack2bf(c, d)}; }
__device__ __forceinline__ u32x2 pack4bf(f32x4 v) { return (u32x2){pack2bf(v[0], v[1]), pack2bf(v[2], v[3])}; }
__device__ __forceinline__ float wave_sum(float v) {
#pragma unroll
    for (int o = 32; o > 0; o >>= 1) v += __shfl_xor(v, o);
    return v;
}

__device__ __forceinline__ void tr_tile(const float* W, long ldw, int k0, int n0, int nvalid, const float* gain, bf16_t* Wt, long ldt, int mode, char* lds) {
    float (*t)[132] = (float (*)[132])lds;
    const int tid = threadIdx.x, c4 = tid & 31, r0 = tid >> 5;
    f32x4 v[8];
#pragma unroll
    for (int i = 0; i < 8; i++) {
        const int kk = r0 + 8 * i, n = n0 + c4 * 4;
        v[i] = (n < nvalid) ? *(const f32x4*)(W + (long)(k0 + kk) * ldw + n) : (f32x4){0.f, 0.f, 0.f, 0.f};
        if (gain) v[i] *= gain[k0 + kk];
    }
    __syncthreads();
#pragma unroll
    for (int i = 0; i < 8; i++) *(f32x4*)(&t[r0 + 8 * i][c4 * 4]) = v[i];
    __syncthreads();
#pragma unroll
    for (int i = 0; i < 4; i++) {
        const int ci = tid + 256 * i, nn = ci >> 3, kc = ci & 7;
        const int n = n0 + nn;
        int row = n;
        if (mode) row = (n >> 5) * 64 + ((n >> 4) & 1) * 32 + (mode - 1) * 16 + (n & 15);
        u32x4 w;
        w.x = pack2bf(t[kc * 8 + 0][nn], t[kc * 8 + 1][nn]);
        w.y = pack2bf(t[kc * 8 + 2][nn], t[kc * 8 + 3][nn]);
        w.z = pack2bf(t[kc * 8 + 4][nn], t[kc * 8 + 5][nn]);
        w.w = pack2bf(t[kc * 8 + 6][nn], t[kc * 8 + 7][nn]);
        *(u32x4*)(Wt + (long)row * ldt + k0 + kc * 8) = w;
    }
}

__device__ __forceinline__ void phase0(const Params& p, char* lds) {
    constexpr int J_W1 = 160, J_WQ = 36, J_WKV = 32, J_WOUT = 128, J_WMQ = 128, J_WMKV = 256, J_WMO = 128, J_WG = 0, J_WU = 0, J_WD = 0;
    constexpr int J_TR = J_W1 + J_WQ + J_WKV + J_WOUT + J_WMQ + J_WMKV + J_WMO + J_WG + J_WU + J_WD;
    constexpr int J_XR = NT / 4, J_MR = 1024 / 4, J_ROPE = NT * 16 / 256, J_TAB = (4096 + 8192 + 16384 + 8192 + 32768) / 256;
    constexpr int J_ALL = J_TR + J_XR + J_MR + J_ROPE + J_TAB;
    const int tid = threadIdx.x, lane = tid & 63, wid = tid >> 6;
    const double PI2 = 6.283185307179586476925286766559;
    for (int job = blockIdx.x; job < J_ALL; job += gridDim.x) {
        int j = job;
        if (j < J_TR) {
            if (j < J_W1) { tr_tile(p.w_in, INW, (j / 10) * 64, (j % 10) * 128, INW, p.g_mix, wsp<bf16_t>(p, OFF_W1T), 1024, 0, lds); continue; } j -= J_W1;
            if (j < J_WQ) { tr_tile(p.w_q_up, 768, (j / 6) * 64, (j % 6) * 128, 768, p.g_q_lat, wsp<bf16_t>(p, OFF_WQT), 384, 0, lds); continue; } j -= J_WQ;
            if (j < J_WKV) { tr_tile(p.w_kv_up, 1024, (j / 8) * 64, (j % 8) * 128, 1024, p.g_kv_lat, wsp<bf16_t>(p, OFF_WKVT), 256, 0, lds); continue; } j -= J_WKV;
            if (j < J_WOUT) { tr_tile(p.w_out, 1024, (j / 8) * 64, (j % 8) * 128, 1024, nullptr, wsp<bf16_t>(p, OFF_WOUTT), 1024, 0, lds); continue; } j -= J_WOUT;
            if (j < J_WMQ) { tr_tile(p.w_mem_q, 1024, (j / 8) * 64, (j % 8) * 128, 1024, p.g_mem_q, wsp<bf16_t>(p, OFF_WMQT), 1024, 0, lds); continue; } j -= J_WMQ;
            if (j < J_WMKV) { tr_tile(p.w_mem_kv, 2048, (j / 16) * 64, (j % 16) * 128, 2048, p.g_mem_kv, wsp<bf16_t>(p, OFF_WMKVT), 1024, 0, lds); continue; } j -= J_WMKV;
            if (j < J_WMO) { tr_tile(p.w_mem_o, 1024, (j / 8) * 64, (j % 8) * 128, 1024, nullptr, wsp<bf16_t>(p, OFF_WMOT), 1024, 0, lds); continue; } j -= J_WMO;
            if (j < J_WG) { const int e = j >> 7, r = j & 127; tr_tile(p.w_exp_gate + (long)e * 1048576, 1024, (r / 8) * 64, (r % 8) * 128, 1024, p.g_ffn, wsp<bf16_t>(p, OFF_WGUT) + (long)e * 2048 * 1024, 1024, 1, lds); continue; } j -= J_WG;
            if (j < J_WU) { const int e = j >> 7, r = j & 127; tr_tile(p.w_exp_up + (long)e * 1048576, 1024, (r / 8) * 64, (r % 8) * 128, 1024, p.g_ffn, wsp<bf16_t>(p, OFF_WGUT) + (long)e * 2048 * 1024, 1024, 2, lds); continue; } j -= J_WU;
            { const int e = j >> 7, r = j & 127; tr_tile(p.w_exp_down + (long)e * 1048576, 1024, (r / 8) * 64, (r % 8) * 128, 1024, nullptr, wsp<bf16_t>(p, OFF_WDT) + (long)e * 1048576, 1024, 0, lds); continue; }
        }
        j -= J_TR;
        if (j < J_XR + J_MR) {
            const bool isx = j < J_XR;
            const int row = (isx ? j : j - J_XR) * 4 + wid;
            const float* src = (isx ? p.x : p.mem) + (long)row * ND;
            bf16_t* dst = (isx ? wsp<bf16_t>(p, OFF_XB) : wsp<bf16_t>(p, OFF_MEMB)) + (long)row * ND;
            float ss = 0.f;
#pragma unroll
            for (int i = 0; i < 4; i++) {
                const f32x4 v = *(const f32x4*)(src + i * 256 + lane * 4);
                ss += v[0] * v[0] + v[1] * v[1] + v[2] * v[2] + v[3] * v[3];
                *(u32x2*)(dst + i * 256 + lane * 4) = pack4bf(v);
            }
            ss = wave_sum(ss);
            if (lane == 0) (isx ? wsp<float>(p, OFF_R0) : wsp<float>(p, OFF_RMEM))[row] = rsqrtf(ss * (1.f / ND) + 1e-6f);
            continue;
        }
        j -= J_XR + J_MR;
        if (j < J_ROPE) {
            const int i = j * 256 + tid; const int t = i >> 4, jj = i & 15;
            const double f = pow(10000.0, -(double)(2 * jj) / 32.0);
            const double ang = (double)p.pos[t] * f;
            wsp<float2>(p, OFF_ROPE)[i] = make_float2((float)cos(ang), (float)sin(ang));
            continue;
        }
        j -= J_ROPE;
        {
            int i = j * 256 + tid;
            if (i < 4096) { const double a = PI2 * (double)i / 4096.0; wsp<float2>(p, OFF_TW)[i] = make_float2((float)cos(a), (float)sin(a)); continue; } i -= 4096;
            if (i < 8192) {
                const int T = i >> 12, a = (i >> 6) & 63, b = i & 63;
                const double th = PI2 * (double)((a * b) & 63) / 64.0;
                wsp<bf16_t>(p, OFF_T64)[i] = (bf16_t)f2bf((float)(T ? sin(th) : cos(th))); continue;
            } i -= 8192;
            if (i < 16384) {
                const int rho = i >> 7, k = i & 127;
                const int wm = rho >> 6, mi = (rho >> 4) & 3, lr = rho & 15, ri = mi >> 1, k1 = 32 * wm + 16 * (mi & 1) + lr, ab = k >> 6, s1 = k & 63;
                const double th = PI2 * (double)((k1 * s1) & 63) / 64.0;
                const double c = cos(th), s = sin(th);
                const double v = ri == 0 ? (ab == 0 ? c : -s) : (ab == 0 ? s : c);
                wsp<bf16_t>(p, OFF_M1)[i] = (bf16_t)f2bf((float)v); continue;
            } i -= 16384;
            if (i < 8192) {
                const int k2 = i >> 7, k = i & 127, s2 = k & 63;
                const double th = PI2 * (double)((k2 * s2) & 63) / 64.0;
                wsp<bf16_t>(p, OFF_M3)[i] = (bf16_t)f2bf((float)(k < 64 ? cos(th) : -sin(th))); continue;
            } i -= 8192;
            if (i < 32768) {
                const int g = i >> 12, e = (i >> 6) & 63, ch = i & 63;
                wsp<bf16_t>(p, OFF_WFT)[i] = (bf16_t)f2bf(p.w_fourier[(g * 64 + ch) * 64 + e]); continue;
            }
        }
    }
}

__device__ __forceinline__ void phase1(const Params& p, char* lds) {
    const int tid = threadIdx.x, lane = tid & 63, wid = tid >> 6, wm = wid >> 1, wn = wid & 1, lq = lane >> 4, lr = lane & 15;
    constexpr int N_U = 128 * 10, N_M = 8 * 16;
    {
      FOR_XCD_ITEMS(item, N_U) {
        f32x4 acc[4][4];
        {
            const int tm = item / 10, tn = item % 10;
            GemmTile g; g.A = wsp<bf16_t>(p, OFF_XB) + (long)tm * 128 * ND; g.lda = ND; g.arow = nullptr;
            g.Bt = wsp<bf16_t>(p, OFF_W1T) + (long)tn * 128 * ND; g.ldb = ND; g.K = ND;
            gemm_tile_128(g, lds, acc);
            const float* r0 = wsp<float>(p, OFF_R0);
#pragma unroll
            for (int mi = 0; mi < 4; mi++) {
                const int row = tm * 128 + wm * 64 + mi * 16 + lr;
                const float rs = r0[row];
#pragma unroll
                for (int ni = 0; ni < 4; ni++) acc[mi][ni] *= rs;
                if (tn < 4) {
#pragma unroll
                    for (int ni = 0; ni < 4; ni++)
                        *(u32x2*)(wsp<bf16_t>(p, OFF_UF) + (long)row * 512 + tn * 128 + wn * 64 + ni * 16 + 4 * lq) = pack4bf(acc[mi][ni]);
                } else if (tn < 9) {
                    float ss = 0.f;
#pragma unroll
                    for (int ni = 0; ni < 4; ni++) { const f32x4 v = acc[mi][ni]; ss += v[0] * v[0] + v[1] * v[1] + v[2] * v[2] + v[3] * v[3]; }
                    ss += __shfl_xor(ss, 16); ss += __shfl_xor(ss, 32);
                    if (tn < 7) {
#pragma unroll
                        for (int ni = 0; ni < 4; ni++)
                            *(u32x2*)(wsp<bf16_t>(p, OFF_UQ) + (long)row * 384 + (tn - 4) * 128 + wn * 64 + ni * 16 + 4 * lq) = pack4bf(acc[mi][ni]);
                        if (lq == 0) wsp<float>(p, OFF_SSQ)[row * 6 + (tn - 4) * 2 + wn] = ss;
                    } else {
#pragma unroll
                        for (int ni = 0; ni < 4; ni++)
                            *(u32x2*)(wsp<bf16_t>(p, OFF_UKV) + (long)row * 256 + (tn - 7) * 128 + wn * 64 + ni * 16 + 4 * lq) = pack4bf(acc[mi][ni]);
                        if (lq == 0) wsp<float>(p, OFF_SSKV)[row * 4 + (tn - 7) * 2 + wn] = ss;
                    }
                } else if (wn == 0) {
                    const float2* rp = wsp<float2>(p, OFF_ROPE) + (long)row * 16 + 4 * lq;
                    f32x4 o1, o2;
#pragma unroll
                    for (int r = 0; r < 4; r++) {
                        const float2 cs = rp[r];
                        const float x1 = acc[mi][0][r], x2 = acc[mi][1][r];
                        o1[r] = x1 * cs.x - x2 * cs.y; o2[r] = x1 * cs.y + x2 * cs.x;
                    }
                    bf16_t* kr = wsp<bf16_t>(p, OFF_KR) + (long)row * 32;
                    *(u32x2*)(kr + 4 * lq) = pack4bf(o1);
                    *(u32x2*)(kr + 16 + 4 * lq) = pack4bf(o2);
                }
            }
        }
      }
      FOR_XCD_ITEMS(it, N_M) {
        f32x4 acc[4][4];
        {
            const int tm = it / 16, tn = it % 16;
            GemmTile g; g.A = wsp<bf16_t>(p, OFF_MEMB) + (long)tm * 128 * ND; g.lda = ND; g.arow = nullptr;
            g.Bt = wsp<bf16_t>(p, OFF_WMKVT) + (long)tn * 128 * ND; g.ldb = ND; g.K = ND;
            gemm_tile_128(g, lds, acc);
            const float* rm = wsp<float>(p, OFF_RMEM);
#pragma unroll
            for (int mi = 0; mi < 4; mi++) {
                const int row = tm * 128 + wm * 64 + mi * 16 + lr;
                const int b = row >> 8, m = row & 255;
                const float rs = rm[row];
#pragma unroll
                for (int ni = 0; ni < 4; ni++) {
                    const f32x4 v = acc[mi][ni] * rs;
                    const int col = tn * 128 + wn * 64 + ni * 16 + 4 * lq;
                    if (col < 1024) {
                        const int h = col >> 8, d = col & 255;
                        *(u32x2*)(wsp<bf16_t>(p, OFF_KMEM) + ((long)(b * 4 + h) * 256 + m) * 256 + d) = pack4bf(v);
                    } else {
                        const int c2 = col - 1024, h = c2 >> 8, dv = c2 & 255;
                        bf16_t* vt = wsp<bf16_t>(p, OFF_VTMEM) + ((long)(b * 4 + h) * 256 + dv) * 256 + m;
#pragma unroll
                        for (int r = 0; r < 4; r++) vt[r * 256] = (bf16_t)f2bf(v[r]);
                    }
                }
            }
        }
      }
    }
}

template <int MI>
__device__ __forceinline__ void dft_mma(const bf16_t* Ag, int arow0, const char* ximg, int ncol0, f32x4 (&acc)[MI][4]) {
    const int lane = threadIdx.x & 63, lq = lane >> 4, lr = lane & 15;
#pragma unroll
    for (int ks = 0; ks < 4; ks++) {
        bf16x8 af[MI], bfr[4];
#pragma unroll
        for (int mi = 0; mi < MI; mi++) af[mi] = *(const bf16x8*)(Ag + (long)(arow0 + mi * 16 + lr) * 128 + ks * 32 + lq * 8);
#pragma unroll
        for (int ni = 0; ni < 4; ni++) {
            const char* bp = ximg + (ks * 32 + lq * 8) * 272 + (ncol0 + ni * 16 + lr) * 2;
#pragma unroll
            for (int j = 0; j < 8; j++) bfr[ni][j] = *(const short*)(bp + j * 272);
        }
#pragma unroll
        for (int mi = 0; mi < MI; mi++)
#pragma unroll
            for (int ni = 0; ni < 4; ni++) acc[mi][ni] = __builtin_amdgcn_mfma_f32_16x16x32_bf16(bfr[ni], af[mi], acc[mi][ni], 0, 0, 0);
    }
}

__device__ __forceinline__ void f2a_item(const Params& p, int it, char* lds) {
    const int tid = threadIdx.x, lane = tid & 63, wid = tid >> 6, wm = wid >> 1, wn = wid & 1, lq = lane >> 4, lr = lane & 15;
    const int nc = it & 3, s2 = (it >> 2) & 63, b = it >> 8;
    char* uimg = lds; char* ximg = lds + 17408;
    __syncthreads();
#pragma unroll
    for (int i = 0; i < 4; i++) {
        const int ci = tid + 256 * i, row = ci >> 4, cc = ci & 15;
        *(u32x4*)(uimg + row * 272 + cc * 16) = *(const u32x4*)(wsp<bf16_t>(p, OFF_UF) + ((long)(b * NS + 64 * row + s2)) * 512 + nc * 128 + cc * 8);
    }
    __syncthreads();
    {
        const int g2 = wid >> 1, T = wid & 1;
        f32x4 a1[4][4];
#pragma unroll
        for (int mi = 0; mi < 4; mi++)
#pragma unroll
            for (int ni = 0; ni < 4; ni++) a1[mi][ni] = (f32x4){0.f, 0.f, 0.f, 0.f};
        const bf16_t* t64 = wsp<bf16_t>(p, OFF_T64) + T * 4096;
#pragma unroll
        for (int ks = 0; ks < 2; ks++) {
            bf16x8 af[4], bfr[4];
#pragma unroll
            for (int i = 0; i < 4; i++) {
                af[i] = *(const bf16x8*)(uimg + (i * 16 + lr) * 272 + (g2 * 64 + ks * 32 + lq * 8) * 2);
                bfr[i] = *(const bf16x8*)(t64 + (i * 16 + lr) * 64 + ks * 32 + lq * 8);
            }
#pragma unroll
            for (int mi = 0; mi < 4; mi++)
#pragma unroll
                for (int ni = 0; ni < 4; ni++) a1[mi][ni] = __builtin_amdgcn_mfma_f32_16x16x32_bf16(bfr[ni], af[mi], a1[mi][ni], 0, 0, 0);
        }
#pragma unroll
        for (int mi = 0; mi < 4; mi++)
#pragma unroll
            for (int ni = 0; ni < 4; ni++)
                *(u32x2*)(ximg + (T * 64 + mi * 16 + lr) * 272 + (g2 * 64 + ni * 16 + 4 * lq) * 2) = pack4bf(a1[mi][ni]);
    }
    __syncthreads();
    f32x4 acc[4][4];
#pragma unroll
    for (int mi = 0; mi < 4; mi++)
#pragma unroll
        for (int ni = 0; ni < 4; ni++) acc[mi][ni] = (f32x4){0.f, 0.f, 0.f, 0.f};
    dft_mma<4>(wsp<bf16_t>(p, OFF_M1), wm * 64, ximg, wn * 64, acc);
    const float2* tw = wsp<float2>(p, OFF_TW);
#pragma unroll
    for (int m2 = 0; m2 < 2; m2++) {
        const int k1 = 32 * wm + 16 * m2 + lr;
        float2 cs; { const float rev = (float)((s2 * k1) & 4095) * (1.0f / 4096.0f); cs.x = __builtin_amdgcn_cosf(rev); cs.y = __builtin_amdgcn_sinf(rev); (void)tw; }
        const long base = ((long)(b * 64 + k1) * 64 + s2) * 512 + nc * 128 + wn * 64 + 4 * lq;
#pragma unroll
        for (int ni = 0; ni < 4; ni++) {
            const f32x4 yr = acc[m2][ni], yi = acc[m2 + 2][ni];
            const f32x4 orr = yr * cs.x - yi * cs.y, oi = yi * cs.x + yr * cs.y;
            *(u32x2*)(wsp<bf16_t>(p, OFF_YR) + base + ni * 16) = pack4bf(orr);
            *(u32x2*)(wsp<bf16_t>(p, OFF_YI) + base + ni * 16) = pack4bf(oi);
        }
    }
}

__device__ __forceinline__ void f2b_item(const Params& p, int it, char* lds) {
    const int tid = threadIdx.x, lane = tid & 63, wid = tid >> 6, wm = wid >> 1, wn = wid & 1, lq = lane >> 4, lr = lane & 15;
    const int nc = it & 3, k1 = (it >> 2) & 63, b = it >> 8;
    char* ximg = lds; char* zimg = lds + 34816;
    __syncthreads();
#pragma unroll
    for (int i = 0; i < 8; i++) {
        const int ci = tid + 256 * i, row = ci >> 4, cc = ci & 15;
        const bf16_t* src = (row < 64 ? wsp<bf16_t>(p, OFF_YR) : wsp<bf16_t>(p, OFF_YI)) + ((long)(b * 64 + k1) * 64 + (row & 63)) * 512 + nc * 128 + cc * 8;
        *(u32x4*)(ximg + row * 272 + cc * 16) = *(const u32x4*)src;
    }
    __syncthreads();
    f32x4 acc[2][4];
#pragma unroll
    for (int mi = 0; mi < 2; mi++)
#pragma unroll
        for (int ni = 0; ni < 4; ni++) acc[mi][ni] = (f32x4){0.f, 0.f, 0.f, 0.f};
    dft_mma<2>(wsp<bf16_t>(p, OFF_M3), wm * 32, ximg, wn * 64, acc);
#pragma unroll
    for (int mi = 0; mi < 2; mi++)
#pragma unroll
        for (int ni = 0; ni < 4; ni++)
            *(u32x2*)(zimg + (wm * 32 + mi * 16 + lr) * 272 + (wn * 64 + ni * 16 + 4 * lq) * 2) = pack4bf(acc[mi][ni] * (1.0f / 512.0f));
    __syncthreads();
    f32x4 a3[2][4];
#pragma unroll
    for (int mi = 0; mi < 2; mi++)
#pragma unroll
        for (int ni = 0; ni < 4; ni++) a3[mi][ni] = (f32x4){0.f, 0.f, 0.f, 0.f};
    const bf16_t* wft = wsp<bf16_t>(p, OFF_WFT) + (long)(nc * 2 + wn) * 4096;
#pragma unroll
    for (int ks = 0; ks < 2; ks++) {
        bf16x8 af[2], bfr[4];
#pragma unroll
        for (int i = 0; i < 2; i++) af[i] = *(const bf16x8*)(zimg + (wm * 32 + i * 16 + lr) * 272 + (wn * 64 + ks * 32 + lq * 8) * 2);
#pragma unroll
        for (int i = 0; i < 4; i++) bfr[i] = *(const bf16x8*)(wft + (i * 16 + lr) * 64 + ks * 32 + lq * 8);
#pragma unroll
        for (int mi = 0; mi < 2; mi++)
#pragma unroll
            for (int ni = 0; ni < 4; ni++) a3[mi][ni] = __builtin_amdgcn_mfma_f32_16x16x32_bf16(bfr[ni], af[mi], a3[mi][ni], 0, 0, 0);
    }
#pragma unroll
    for (int mi = 0; mi < 2; mi++) {
        const int k2 = wm * 32 + mi * 16 + lr;
        bf16_t* dst = wsp<bf16_t>(p, OFF_ZA) + ((long)(b * NS + k1 + 64 * k2)) * 1024 + nc * 128 + wn * 64 + 4 * lq;
#pragma unroll
        for (int ni = 0; ni < 4; ni++) *(u32x2*)(dst + ni * 16) = pack4bf(a3[mi][ni]);
    }
}

__device__ __forceinline__ void phase2(const Params& p, char* lds) {
    const int tid = threadIdx.x, lane = tid & 63, wid = tid >> 6, wm = wid >> 1, wn = wid & 1, lq = lane >> 4, lr = lane & 15;
    constexpr int N_Q = 128 * 6, N_KV = 128 * 8, N_F = 1024;
    {
      FOR_XCD_ITEMS(item, N_Q) {
        f32x4 acc[4][4];
        {
            const int tm = item / 6, tn = item % 6;
            GemmTile g; g.A = wsp<bf16_t>(p, OFF_UQ) + (long)tm * 128 * 384; g.lda = 384; g.arow = nullptr;
            g.Bt = wsp<bf16_t>(p, OFF_WQT) + (long)tn * 128 * 384; g.ldb = 384; g.K = 384;
            gemm_tile_128(g, lds, acc);
            const float qmul = 0.10206207261596575f * 1.4426950408889634f;
#pragma unroll
            for (int mi = 0; mi < 4; mi++) {
                const int row = tm * 128 + wm * 64 + mi * 16 + lr;
                const int b = row >> 12, s = row & 4095;
                const float* sq = wsp<float>(p, OFF_SSQ) + (long)row * 6;
                const float ss = sq[0] + sq[1] + sq[2] + sq[3] + sq[4] + sq[5];
                const float rs = rsqrtf(ss * (1.f / 384.f) + 1e-6f) * qmul;
                const int cb0 = tn * 128 + wn * 64;
#pragma unroll
                for (int ni = 0; ni < 4; ni++) {
                    const int cb = cb0 + ni * 16, hd = cb / 96, hob = cb % 96;
                    bf16_t* qd = wsp<bf16_t>(p, OFF_Q) + ((long)(b * 8 + hd) * NS + s) * 96;
                    if (hob < 64) {
                        *(u32x2*)(qd + hob + 4 * lq) = pack4bf(acc[mi][ni] * rs);
                    } else if (hob == 64) {
                        if (ni < 3) {
                            const float2* rp = wsp<float2>(p, OFF_ROPE) + (long)row * 16 + 4 * lq;
                            f32x4 o1, o2;
#pragma unroll
                            for (int r = 0; r < 4; r++) {
                                const float2 cs = rp[r];
                                const float x1 = acc[mi][ni][r] * rs, x2 = acc[mi][ni < 3 ? ni + 1 : 3][r] * rs;
                                o1[r] = x1 * cs.x - x2 * cs.y; o2[r] = x1 * cs.y + x2 * cs.x;
                            }
                            *(u32x2*)(qd + 64 + 4 * lq) = pack4bf(o1);
                            *(u32x2*)(qd + 80 + 4 * lq) = pack4bf(o2);
                        }
                    }
                }
            }
        }
      }
      FOR_XCD_ITEMS(it, N_KV) {
        f32x4 acc[4][4];
        {
            const int tm = it >> 3, hd = it & 7;
            GemmTile g; g.A = wsp<bf16_t>(p, OFF_UKV) + (long)tm * 128 * 256; g.lda = 256; g.arow = nullptr;
            g.Bt = wsp<bf16_t>(p, OFF_WKVT) + (long)hd * 128 * 256; g.ldb = 256; g.K = 256;
            gemm_tile_128(g, lds, acc);
#pragma unroll
            for (int mi = 0; mi < 4; mi++) {
                const int row = tm * 128 + wm * 64 + mi * 16 + lr;
                const int b = row >> 12, s = row & 4095;
                const float* sq = wsp<float>(p, OFF_SSKV) + (long)row * 4;
                const float rs = rsqrtf((sq[0] + sq[1] + sq[2] + sq[3]) * (1.f / 256.f) + 1e-6f);
                if (wn == 0) {
                    bf16_t* kd = wsp<bf16_t>(p, OFF_K) + ((long)(b * 8 + hd) * NS + s) * 96;
#pragma unroll
                    for (int ni = 0; ni < 4; ni++) *(u32x2*)(kd + ni * 16 + 4 * lq) = pack4bf(acc[mi][ni] * rs);
                } else {
#pragma unroll
                    for (int ni = 0; ni < 4; ni++) {
                        bf16_t* vd = wsp<bf16_t>(p, OFF_VT) + ((long)(b * 8 + hd) * 64 + ni * 16 + 4 * lq) * NS + s;
#pragma unroll
                        for (int r = 0; r < 4; r++) vd[(long)r * NS] = (bf16_t)f2bf(acc[mi][ni][r] * rs);
                    }
                }
            }
#pragma unroll
            for (int i = 0; i < 2; i++) {
                const int ci = tid + 256 * i, r = ci >> 2, cc = ci & 3;
                const int row = tm * 128 + r, b = row >> 12, s = row & 4095;
                *(u32x4*)(wsp<bf16_t>(p, OFF_K) + ((long)(b * 8 + hd) * NS + s) * 96 + 64 + cc * 8) = *(const u32x4*)(wsp<bf16_t>(p, OFF_KR) + (long)row * 32 + cc * 8);
            }
        }
      }
      FOR_XCD_ITEMS(it, N_F) { f2a_item(p, it, lds); }
    }
}


__device__ __forceinline__ void expert_tr_job(const Params& p, int j, char* lds) {
    const int which = j >> 11, r = j & 2047, e = r >> 7, t = r & 127;
    const int k0 = (t >> 3) * 64, n0 = (t & 7) * 128;
    if (which == 0) tr_tile(p.w_exp_gate + (long)e * 1048576, 1024, k0, n0, 1024, p.g_ffn, wsp<bf16_t>(p, OFF_WGUT) + (long)e * 2048 * 1024, 1024, 1, lds);
    else if (which == 1) tr_tile(p.w_exp_up + (long)e * 1048576, 1024, k0, n0, 1024, p.g_ffn, wsp<bf16_t>(p, OFF_WGUT) + (long)e * 2048 * 1024, 1024, 2, lds);
    else tr_tile(p.w_exp_down + (long)e * 1048576, 1024, k0, n0, 1024, nullptr, wsp<bf16_t>(p, OFF_WDT) + (long)e * 1048576, 1024, 0, lds);
}

__device__ __forceinline__ void phase3(const Params& p, char* lds) {
    constexpr int N_A = NB * 8 * (NS / 128), N_F = 1024;
    const bool tr_first = (blockIdx.x >> 8) & 1;
    if (tr_first) for (int j = blockIdx.x; j < 6144; j += gridDim.x) expert_tr_job(p, j, lds);
    {
      FOR_XCD_ITEMS(item, N_A) {
        {
            const int qt = item & 31, h = (item >> 5) & 7, b = item >> 8;
            const bf16_t* Qp = wsp<bf16_t>(p, OFF_Q) + ((long)(b * 8 + h) * NS + qt * 128) * 96;
            const bf16_t* Kp = wsp<bf16_t>(p, OFF_K) + ((long)(b * 8 + h) * NS) * 96;
            const bf16_t* Vtp = wsp<bf16_t>(p, OFF_VT) + ((long)(b * 8 + h) * 64) * NS;
            bf16_t* Op = wsp<bf16_t>(p, OFF_ZA) + ((long)b * NS + qt * 128) * 1024 + 512 + h * 64;
            attn_block<96, 64, 64>(Qp, Kp, Vtp, (long)NS, NS, lds, [&](int q, int dv, f32x4 v) { *(u32x2*)(Op + (long)q * 1024 + dv) = pack4bf(v); });
        }
      }
      FOR_XCD_ITEMS(it, N_F) { f2b_item(p, it, lds); }
    }
    if (!tr_first) for (int j = blockIdx.x; j < 6144; j += gridDim.x) expert_tr_job(p, j, lds);
}

__device__ __forceinline__ void phase_resid(const Params& p, char* lds, size_t offA, size_t offW, const float* residf, const bf16_t* residb, size_t offXb, size_t offSS) {
    const int tid = threadIdx.x, lane = tid & 63, wid = tid >> 6, wm = wid >> 1, wn = wid & 1, lq = lane >> 4, lr = lane & 15;
    FOR_XCD_ITEMS(item, 128 * 8) {
        const int tm = item >> 3, tn = item & 7;
        f32x4 acc[4][4];
        GemmTile g; g.A = wsp<bf16_t>(p, offA) + (long)tm * 128 * ND; g.lda = ND; g.arow = nullptr;
        g.Bt = wsp<bf16_t>(p, offW) + (long)tn * 128 * ND; g.ldb = ND; g.K = ND;
        gemm_tile_128(g, lds, acc);
#pragma unroll
        for (int mi = 0; mi < 4; mi++) {
            const int row = tm * 128 + wm * 64 + mi * 16 + lr;
            float ss = 0.f;
#pragma unroll
            for (int ni = 0; ni < 4; ni++) {
                const long o = (long)row * ND + tn * 128 + wn * 64 + ni * 16 + 4 * lq;
                f32x4 rv;
                if (residf) rv = *(const f32x4*)(residf + o);
                else { const u32x2 w = *(const u32x2*)(residb + o); rv = (f32x4){__uint_as_float(w.x << 16), __uint_as_float(w.x & 0xFFFF0000u), __uint_as_float(w.y << 16), __uint_as_float(w.y & 0xFFFF0000u)}; }
                const f32x4 v = rv + acc[mi][ni];
                *(u32x2*)(wsp<bf16_t>(p, offXb) + o) = pack4bf(v);
                ss += v[0] * v[0] + v[1] * v[1] + v[2] * v[2] + v[3] * v[3];
            }
            ss += __shfl_xor(ss, 16); ss += __shfl_xor(ss, 32);
            if (lq == 0) wsp<float>(p, offSS)[row * 16 + tn * 2 + wn] = ss;
        }
    }
}
__device__ __forceinline__ float row_rs16(const float* ss) {
    const f32x4 a = *(const f32x4*)ss, b = *(const f32x4*)(ss + 4), c = *(const f32x4*)(ss + 8), d = *(const f32x4*)(ss + 12);
    const f32x4 t = (a + b) + (c + d);
    return rsqrtf(((t[0] + t[1]) + (t[2] + t[3])) * (1.f / 1024.f) + 1e-6f);
}

__device__ __forceinline__ void phase5a(const Params& p, char* lds) {
    const int tid = threadIdx.x, lane = tid & 63, wid = tid >> 6, wm = wid >> 1, wn = wid & 1, lq = lane >> 4, lr = lane & 15;
    FOR_XCD_ITEMS(item, 128 * 8) {
        const int tm = item >> 3, tn = item & 7;
        f32x4 acc[4][4];
        GemmTile g; g.A = wsp<bf16_t>(p, OFF_X1B) + (long)tm * 128 * ND; g.lda = ND; g.arow = nullptr;
        g.Bt = wsp<bf16_t>(p, OFF_WMQT) + (long)tn * 128 * ND; g.ldb = ND; g.K = ND;
        gemm_tile_128(g, lds, acc);
        const int h = tn >> 1;
#pragma unroll
        for (int mi = 0; mi < 4; mi++) {
            const int row = tm * 128 + wm * 64 + mi * 16 + lr, b = row >> 12, s = row & 4095;
            const float rs = row_rs16(wsp<float>(p, OFF_SS1) + (long)row * 16) * (0.0625f * 1.4426950408889634f);
            bf16_t* qd = wsp<bf16_t>(p, OFF_QM) + ((long)(b * 4 + h) * NS + s) * 256 + (tn & 1) * 128 + wn * 64 + 4 * lq;
#pragma unroll
            for (int ni = 0; ni < 4; ni++) *(u32x2*)(qd + ni * 16) = pack4bf(acc[mi][ni] * rs);
        }
    }
}
__device__ __forceinline__ void phase5b(const Params& p, char* lds) {
    FOR_XCD_ITEMS(item, NB * 4 * 32 * 2) {
        const int dvh = item & 1, qt = (item >> 1) & 31, h = (item >> 6) & 3, b = item >> 8;
        const bf16_t* Qp = wsp<bf16_t>(p, OFF_QM) + ((long)(b * 4 + h) * NS + qt * 128) * 256;
        const bf16_t* Kp = wsp<bf16_t>(p, OFF_KMEM) + ((long)(b * 4 + h) * 256) * 256;
        const bf16_t* Vtp = wsp<bf16_t>(p, OFF_VTMEM) + ((long)(b * 4 + h) * 256 + dvh * 128) * 256;
        bf16_t* Op = wsp<bf16_t>(p, OFF_OM) + ((long)b * NS + qt * 128) * 1024 + h * 256 + dvh * 128;
        attn_block<256, 128, 32>(Qp, Kp, Vtp, 256L, 256, lds, [&](int q, int dv, f32x4 v) { *(u32x2*)(Op + (long)q * 1024 + dv) = pack4bf(v); });
    }
}

__device__ __forceinline__ void phase7(const Params& p, char* lds) {
    const int tid = threadIdx.x, lane = tid & 63, wid = tid >> 6;
    float* wr = (float*)lds;
    __syncthreads();
    for (int i = tid; i < 16384; i += 256) { const int k = i >> 4, e = i & 15; wr[e * 1024 + k] = p.w_router[i] * p.g_ffn[k]; }
    __syncthreads();
    for (int tok = blockIdx.x * 4 + wid; tok < NT; tok += gridDim.x * 4) {
        const bf16_t* xr = wsp<bf16_t>(p, OFF_X2B) + (long)tok * ND;
        float a[16];
#pragma unroll
        for (int e = 0; e < 16; e++) a[e] = 0.f;
#pragma unroll 2
        for (int j = 0; j < 8; j++) {
            const unsigned xw = *(const unsigned*)(xr + 2 * lane + 128 * j);
            const float x0 = __uint_as_float(xw << 16), x1 = __uint_as_float(xw & 0xFFFF0000u);
#pragma unroll
            for (int e = 0; e < 16; e++) {
                const f32x2 w = *(const f32x2*)(wr + e * 1024 + 2 * lane + 128 * j);
                a[e] += x0 * w[0] + x1 * w[1];
            }
        }
#pragma unroll
        for (int i = 0; i < 8; i++) { const bool hi = lane & 32; const float send = hi ? a[i] : a[i + 8], keep = hi ? a[i + 8] : a[i]; a[i] = keep + __shfl_xor(send, 32); }
#pragma unroll
        for (int i = 0; i < 4; i++) { const bool hi = lane & 16; const float send = hi ? a[i] : a[i + 4], keep = hi ? a[i + 4] : a[i]; a[i] = keep + __shfl_xor(send, 16); }
#pragma unroll
        for (int i = 0; i < 2; i++) { const bool hi = lane & 8; const float send = hi ? a[i] : a[i + 2], keep = hi ? a[i + 2] : a[i]; a[i] = keep + __shfl_xor(send, 8); }
        { const bool hi = lane & 4; const float send = hi ? a[0] : a[1], keep = hi ? a[1] : a[0]; a[0] = keep + __shfl_xor(send, 4); }
        float lg = a[0];
        lg += __shfl_xor(lg, 2); lg += __shfl_xor(lg, 1);
        const int e = ((lane >> 5) & 1) * 8 + ((lane >> 4) & 1) * 4 + ((lane >> 3) & 1) * 2 + ((lane >> 2) & 1);
        lg *= row_rs16(wsp<float>(p, OFF_SS2) + (long)tok * 16);
        float mx = lg;
#pragma unroll
        for (int o = 4; o < 64; o <<= 1) mx = fmaxf(mx, __shfl_xor(mx, o));
        const float ex = expf(lg - mx);
        float sm = ex;
#pragma unroll
        for (int o = 4; o < 64; o <<= 1) sm += __shfl_xor(sm, o);
        if ((lane & 3) == 0) wsp<float>(p, OFF_AFF)[(long)tok * 16 + e] = ex / sm;
    }
}

__device__ __forceinline__ int block_sum_i(int v, int* red) {
    const int lane = threadIdx.x & 63, wid = threadIdx.x >> 6;
#pragma unroll
    for (int o = 32; o > 0; o >>= 1) v += __shfl_xor(v, o);
    __syncthreads();
    if (lane == 0) red[wid] = v;
    __syncthreads();
    return red[0] + red[1] + red[2] + red[3];
}
__device__ __forceinline__ int block_excl_scan_i(int v, int* red, int& total) {
    const int lane = threadIdx.x & 63, wid = threadIdx.x >> 6;
    int inc = v;
#pragma unroll
    for (int o = 1; o < 64; o <<= 1) { const int t = __shfl_up(inc, o); if (lane >= o) inc += t; }
    __syncthreads();
    if (lane == 63) red[wid] = inc;
    __syncthreads();
    int base = 0;
#pragma unroll
    for (int w = 0; w < 4; w++) if (w < wid) base += red[w];
    total = red[0] + red[1] + red[2] + red[3];
    return base + inc - v;
}
__device__ __forceinline__ void phase8(const Params& p, char* lds) {
    int* red = (int*)lds;
    const int tid = threadIdx.x;
    for (int item = blockIdx.x; item < NB * NE; item += gridDim.x) {
        const int e = item & 15, b = item >> 4;
        const float* aff = wsp<float>(p, OFF_AFF) + (long)b * NS * 16 + e;
        unsigned v[16];
#pragma unroll
        for (int i = 0; i < 16; i++) v[i] = __float_as_uint(aff[(long)(tid * 16 + i) * 16]);
        unsigned T = 0;
        for (int bit = 30; bit >= 0; bit--) {
            const unsigned cand = T | (1u << bit);
            int c = 0;
#pragma unroll
            for (int i = 0; i < 16; i++) c += (v[i] >= cand) ? 1 : 0;
            if (block_sum_i(c, red) >= CAP) T = cand;
        }
        int cg = 0, ce = 0;
#pragma unroll
        for (int i = 0; i < 16; i++) { cg += (v[i] > T) ? 1 : 0; ce += (v[i] == T) ? 1 : 0; }
        int tot;
        const int pk = block_excl_scan_i(cg | (ce << 16), red, tot);
        const int need = CAP - (tot & 0xFFFF);
        const int pe = pk >> 16;
        int nse = need - pe; nse = nse < 0 ? 0 : (nse > ce ? ce : nse);
        int tot2;
        int slot = block_excl_scan_i(cg + nse, red, tot2);
        int* slots = wsp<int>(p, OFF_SLOTS) + (long)(b * NE + e) * NS;
        int* idx = wsp<int>(p, OFF_IDX) + (long)(b * NE + e) * CAP;
        float* gate = wsp<float>(p, OFF_GATE) + (long)(b * NE + e) * CAP;
        int eqs = 0;
#pragma unroll
        for (int i = 0; i < 16; i++) {
            const int t = tid * 16 + i;
            bool sel = v[i] > T;
            if (v[i] == T) { sel = eqs < nse; eqs++; }
            if (sel) { slots[t] = slot; idx[slot] = b * NS + t; gate[slot] = __uint_as_float(v[i]); slot++; }
            else slots[t] = -1;
        }
    }
}

__device__ __forceinline__ void phase9(const Params& p, char* lds) {
    const int tid = threadIdx.x, lane = tid & 63, wid = tid >> 6, wm = wid >> 1, wn = wid & 1, lq = lane >> 4, lr = lane & 15;
    FOR_XCD_ITEMS(item, NE * 16 * NB * 4) {
        const int rt = item & 3, b = (item >> 2) & 3, ct = (item >> 4) & 15, e = item >> 8;
        const int* arow = wsp<int>(p, OFF_IDX) + (long)(b * NE + e) * CAP + rt * 128;
        f32x4 acc[4][4];
        GemmTile g; g.A = wsp<bf16_t>(p, OFF_X2B); g.lda = ND; g.arow = arow;
        g.Bt = wsp<bf16_t>(p, OFF_WGUT) + ((long)e * 2048 + ct * 128) * ND; g.ldb = ND; g.K = ND;
        gemm_tile_128(g, lds, acc);
#pragma unroll
        for (int mi = 0; mi < 4; mi++) {
            const int r = wm * 64 + mi * 16 + lr;
            const int tok = arow[r];
            const float rs = row_rs16(wsp<float>(p, OFF_SS2) + (long)tok * 16);
            bf16_t* ad = wsp<bf16_t>(p, OFF_ACT) + ((long)(e * NB + b) * CAP + rt * 128 + r) * ND + ct * 64 + wn * 32 + 4 * lq;
#pragma unroll
            for (int pp = 0; pp < 2; pp++) {
                f32x4 o;
#pragma unroll
                for (int q = 0; q < 4; q++) {
                    const float ga = acc[mi][2 * pp][q] * rs, up = acc[mi][2 * pp + 1][q] * rs;
                    o[q] = ga / (1.f + __expf(-ga)) * up;
                }
                *(u32x2*)(ad + pp * 16) = pack4bf(o);
            }
        }
    }
}
__device__ __forceinline__ void phase10(const Params& p, char* lds) {
    const int tid = threadIdx.x, lane = tid & 63, wid = tid >> 6, wm = wid >> 1, wn = wid & 1, lq = lane >> 4, lr = lane & 15;
    FOR_XCD_ITEMS(item, NE * 8 * NB * 4) {
        const int rt = item & 3, b = (item >> 2) & 3, ct = (item >> 4) & 7, e = item >> 7;
        const long row0 = (long)(e * NB + b) * CAP + rt * 128;
        f32x4 acc[4][4];
        GemmTile g; g.A = wsp<bf16_t>(p, OFF_ACT) + row0 * ND; g.lda = ND; g.arow = nullptr;
        g.Bt = wsp<bf16_t>(p, OFF_WDT) + ((long)e * 1024 + ct * 128) * ND; g.ldb = ND; g.K = ND;
        gemm_tile_128(g, lds, acc);
        const float* gate = wsp<float>(p, OFF_GATE) + (long)(b * NE + e) * CAP + rt * 128;
#pragma unroll
        for (int mi = 0; mi < 4; mi++) {
            const int r = wm * 64 + mi * 16 + lr;
            const float gv = gate[r];
            bf16_t* yd = wsp<bf16_t>(p, OFF_Y) + (row0 + r) * ND + ct * 128 + wn * 64 + 4 * lq;
#pragma unroll
            for (int ni = 0; ni < 4; ni++) *(u32x2*)(yd + ni * 16) = pack4bf(acc[mi][ni] * gv);
        }
    }
}

__device__ __forceinline__ void phase11(const Params& p, char* lds) {
    const int tid = threadIdx.x, lane = tid & 63, wid = tid >> 6;
    for (int tok = blockIdx.x * 4 + wid; tok < NT; tok += gridDim.x * 4) {
        const int b = tok >> 12, t = tok & 4095;
        float* xr = p.out + (long)tok * ND;
        const bf16_t* xb2 = wsp<bf16_t>(p, OFF_X2B) + (long)tok * ND;
        f32x4 v[4];
#pragma unroll
        for (int i = 0; i < 4; i++) {
            const u32x2 w = *(const u32x2*)(xb2 + i * 256 + lane * 4);
            v[i] = (f32x4){__uint_as_float(w.x << 16), __uint_as_float(w.x & 0xFFFF0000u), __uint_as_float(w.y << 16), __uint_as_float(w.y & 0xFFFF0000u)};
        }
        for (int e = 0; e < NE; e++) {
            const int sl = wsp<int>(p, OFF_SLOTS)[(long)(b * NE + e) * NS + t];
            if (sl >= 0) {
                const bf16_t* yr = wsp<bf16_t>(p, OFF_Y) + ((long)(e * NB + b) * CAP + sl) * ND;
#pragma unroll
                for (int i = 0; i < 4; i++) {
                    const u32x2 w = *(const u32x2*)(yr + i * 256 + lane * 4);
                    v[i][0] += __uint_as_float(w.x << 16); v[i][1] += __uint_as_float(w.x & 0xFFFF0000u);
                    v[i][2] += __uint_as_float(w.y << 16); v[i][3] += __uint_as_float(w.y & 0xFFFF0000u);
                }
            }
        }
        float ss = 0.f;
#pragma unroll
        for (int i = 0; i < 4; i++) ss += v[i][0] * v[i][0] + v[i][1] * v[i][1] + v[i][2] * v[i][2] + v[i][3] * v[i][3];
        ss = wave_sum(ss);
        const float rs = rsqrtf(ss * (1.f / ND) + 1e-6f);
#pragma unroll
        for (int i = 0; i < 4; i++) {
            const f32x4 gf = *(const f32x4*)(p.g_final + i * 256 + lane * 4);
            *(f32x4*)(xr + i * 256 + lane * 4) = v[i] * rs * gf;
        }
    }
}

__global__ void __launch_bounds__(256, 2) k_fwd(Params p, int ph_lo, int ph_hi) {
    extern __shared__ __attribute__((aligned(16))) char lds[];
    volatile LAS unsigned* st = (volatile LAS unsigned*)(lds + LDS_MAIN);
    if (threadIdx.x == 0) { st[0] = 0u; st[1] = 0u; }
    __syncthreads();
    XcdBarrier bar = xcd_barrier_post(wsp<unsigned>(p, OFF_BAR), st);
#if USE_CG_SYNC
#define GRID_BARRIER() do { asm volatile("s_waitcnt vmcnt(0)" ::: "memory"); __syncthreads(); cg::this_grid().sync(); asm volatile("s_waitcnt vmcnt(0)" ::: "memory"); __syncthreads(); } while (0)
#else
#define GRID_BARRIER() xcd_barrier(bar)
#endif
#define RUN_PHASE(k, call) if (ph_lo <= (k) && (k) < ph_hi) { if ((k) > ph_lo) { GRID_BARRIER(); } call; }
    RUN_PHASE(0, phase0(p, lds))
    RUN_PHASE(1, phase1(p, lds))
    RUN_PHASE(2, phase2(p, lds))
    RUN_PHASE(3, phase3(p, lds))
    RUN_PHASE(4, phase_resid(p, lds, OFF_ZA, OFF_WOUTT, p.x, nullptr, OFF_X1B, OFF_SS1))
    RUN_PHASE(5, phase5a(p, lds))
    RUN_PHASE(6, phase5b(p, lds))
    RUN_PHASE(7, phase_resid(p, lds, OFF_OM, OFF_WMOT, nullptr, wsp<bf16_t>(p, OFF_X1B), OFF_X2B, OFF_SS2))
    RUN_PHASE(8, phase7(p, lds))
    RUN_PHASE(9, phase8(p, lds))
    RUN_PHASE(10, phase9(p, lds))
    RUN_PHASE(11, phase10(p, lds))
    RUN_PHASE(12, phase11(p, lds))
}

extern "C" void kernel_launch(void* const* d_in, const int* in_sizes, int n_in,
                              void* d_out, int out_size, void* d_ws, size_t ws_size,
                              hipStream_t stream) {
    static int grid = 0;
    if (grid == 0) {
        if (n_in != 22 || ws_size < WS_END) { fprintf(stderr, "kernel_launch: unexpected inputs (n_in %d, ws %zu < %zu)\n", n_in, ws_size, (size_t)WS_END); grid = -1; return; }
        int dev = 0, cus = 0, per_cu = 0;
        (void)hipGetDevice(&dev);
        (void)hipDeviceGetAttribute(&cus, hipDeviceAttributeMultiprocessorCount, dev);
        if (hipFuncSetAttribute((const void*)k_fwd, hipFuncAttributeMaxDynamicSharedMemorySize, LDS_TOTAL) != hipSuccess) { fprintf(stderr, "kernel_launch: hipFuncSetAttribute failed\n"); grid = -1; return; }
        if (hipOccupancyMaxActiveBlocksPerMultiprocessor(&per_cu, (const void*)k_fwd, 256, LDS_TOTAL) != hipSuccess || per_cu < 1) { fprintf(stderr, "kernel_launch: occupancy query failed (%d)\n", per_cu); (void)hipGetLastError(); per_cu = 1; }
        if (per_cu > 2) per_cu = 2;
        grid = cus * per_cu;
        fprintf(stderr, "kernel_launch: %d CUs x %d blocks\n", cus, per_cu);
    }
    if (grid < 0) return;
    Params p{};
    p.x = (const float*)d_in[0]; p.mem = (const float*)d_in[1]; p.pos = (const int*)d_in[2];
    p.g_mix = (const float*)d_in[3]; p.w_in = (const float*)d_in[4]; p.g_q_lat = (const float*)d_in[5]; p.w_q_up = (const float*)d_in[6];
    p.g_kv_lat = (const float*)d_in[7]; p.w_kv_up = (const float*)d_in[8]; p.w_fourier = (const float*)d_in[9]; p.w_out = (const float*)d_in[10];
    p.g_mem_q = (const float*)d_in[11]; p.g_mem_kv = (const float*)d_in[12]; p.w_mem_q = (const float*)d_in[13]; p.w_mem_kv = (const float*)d_in[14];
    p.w_mem_o = (const float*)d_in[15]; p.g_ffn = (const float*)d_in[16]; p.w_router = (const float*)d_in[17];
    p.w_exp_gate = (const float*)d_in[18]; p.w_exp_up = (const float*)d_in[19]; p.w_exp_down = (const float*)d_in[20]; p.g_final = (const float*)d_in[21];
    p.out = (float*)d_out; p.ws = (char*)d_ws;
    static const int cuts[] = MK_CUTS;
    const int ncut = (int)(sizeof(cuts) / sizeof(int));
    for (int li = 0; li + 1 < ncut; li++) {
        (void)hipMemsetAsync((char*)d_ws + OFF_BAR, 0, 16384, stream);
        int lo = cuts[li], hi = cuts[li + 1];
        void* args[] = {&p, &lo, &hi};
        hipError_t e = hipLaunchCooperativeKernel((const void*)k_fwd, dim3(grid), dim3(256), args, LDS_TOTAL, stream);
        if (e != hipSuccess) fprintf(stderr, "cooperative launch failed: %s (grid %d)\n", hipGetErrorString(e), grid);
    }
}
```

```cpp
#include <hip/hip_runtime.h>
#include <stdint.h>
#include <cstdio>
#include <hip/hip_cooperative_groups.h>
namespace cg = cooperative_groups;
#ifndef USE_CG_SYNC
#define USE_CG_SYNC 0
#endif

#ifndef MK_CUTS
#define MK_CUTS {0, 13}
#endif

#define NB 4
#define NS 4096
#define ND 1024
#define NT (NB * NS)
#define INW 1184
#define NE 16
#define CAP 512
#define MEML 256
#define NPHASE 13
#define VTID ((int)(threadIdx.x & 255))
#define VHALF (__builtin_amdgcn_readfirstlane((int)(threadIdx.x >> 8)))
#define VBLK ((int)(blockIdx.x * 2) + VHALF)
#define VGRID ((int)(gridDim.x * 2))

typedef unsigned short bf16_t;
typedef short bf16x8 __attribute__((ext_vector_type(8)));
typedef float f32x4 __attribute__((ext_vector_type(4)));
typedef float f32x16 __attribute__((ext_vector_type(16)));
typedef unsigned u32x4 __attribute__((ext_vector_type(4)));
typedef unsigned u32x2 __attribute__((ext_vector_type(2)));

__device__ __forceinline__ unsigned f2bf(float f) {
    unsigned u = __float_as_uint(f);
    u += 0x7FFFu + ((u >> 16) & 1u);
    return u >> 16;
}
typedef __bf16 hbf2 __attribute__((ext_vector_type(2)));
typedef float f32x2 __attribute__((ext_vector_type(2)));
__device__ __forceinline__ unsigned pack2bf(float lo, float hi) { f32x2 v = {lo, hi}; return __builtin_bit_cast(unsigned, __builtin_convertvector(v, hbf2)); }
__device__ __forceinline__ float bf2f(unsigned short b) { return __uint_as_float(((unsigned)b) << 16); }

__device__ __forceinline__ int tile_off(int row, int chunk) { return row * 128 + ((chunk ^ ((row >> 1) & 7)) << 4); }

#define GT_LDS_BYTES 65536

struct GemmTile { const bf16_t* A; long lda; const int* arow; const bf16_t* Bt; long ldb; int K; };

__device__ __forceinline__ void gemm_tile_128(const GemmTile& g, char* lds, f32x4 (&acc)[4][4]) {
    const int tid = VTID, lane = tid & 63, wid = tid >> 6, wm = wid >> 1, wn = wid & 1;
    const int lrow = lane >> 3, pc = lane & 7;
    const bf16_t* ap[4]; const bf16_t* bp[4];
#pragma unroll
    for (int i = 0; i < 4; i++) {
        const int r = (wid * 4 + i) * 8 + lrow;
        const int c = pc ^ ((r >> 1) & 7);
        const long ro = g.arow ? (long)g.arow[r] * g.lda : (long)r * g.lda;
        ap[i] = g.A + ro + c * 8;
        bp[i] = g.Bt + (long)r * g.ldb + c * 8;
    }
#pragma unroll
    for (int mi = 0; mi < 4; mi++)
#pragma unroll
        for (int ni = 0; ni < 4; ni++) acc[mi][ni] = (f32x4){0.f, 0.f, 0.f, 0.f};
    const int nk = g.K >> 6;
    auto stage = [&](int kt, char* st) {
#pragma unroll
        for (int i = 0; i < 4; i++) {
            __builtin_amdgcn_global_load_lds((const unsigned*)(ap[i] + kt * 64), (unsigned*)(st + (wid * 4 + i) * 1024), 16, 0, 0);
            __builtin_amdgcn_global_load_lds((const unsigned*)(bp[i] + kt * 64), (unsigned*)(st + 16384 + (wid * 4 + i) * 1024), 16, 0, 0);
        }
    };
    __syncthreads();
    stage(0, lds);
    asm volatile("s_waitcnt vmcnt(0)" ::: "memory");
    __syncthreads();
    for (int kt = 0; kt < nk; kt++) {
        char* cur = lds + (kt & 1) * 32768;
        if (kt + 1 < nk) stage(kt + 1, lds + ((kt + 1) & 1) * 32768);
        bf16x8 af[2][4], bfr[2][4];
#pragma unroll
        for (int ks = 0; ks < 2; ks++)
#pragma unroll
            for (int i = 0; i < 4; i++) {
                af[ks][i] = *(const bf16x8*)(cur + tile_off(wm * 64 + i * 16 + (lane & 15), ks * 4 + (lane >> 4)));
                bfr[ks][i] = *(const bf16x8*)(cur + 16384 + tile_off(wn * 64 + i * 16 + (lane & 15), ks * 4 + (lane >> 4)));
            }
        __builtin_amdgcn_s_setprio(1);
#pragma unroll
        for (int ks = 0; ks < 2; ks++)
#pragma unroll
            for (int mi = 0; mi < 4; mi++)
#pragma unroll
                for (int ni = 0; ni < 4; ni++)
                    acc[mi][ni] = __builtin_amdgcn_mfma_f32_16x16x32_bf16(bfr[ks][ni], af[ks][mi], acc[mi][ni], 0, 0, 0);
        __builtin_amdgcn_s_setprio(0);
        asm volatile("s_waitcnt vmcnt(0)" ::: "memory");
        __syncthreads();
    }
}

template <int DQK, int DVT, int KT>
struct AttnCfg {
    static constexpr int KROW = DQK * 2 + 16;
    static constexpr int VROW = KT * 2 + 8;
    static constexpr int KBYTES = KT * KROW;
    static constexpr int VBYTES = DVT * VROW;
    static constexpr int STAGE = KBYTES + VBYTES;
    static constexpr int LDS = 2 * STAGE;
};

template <int DQK, int DVT, int KT, int NTH, class Out>
__device__ __forceinline__ void attn_block(const bf16_t* Qp, const bf16_t* Kp, const bf16_t* Vtp, long ldv, int nk, char* lds, Out&& out) {
    typedef AttnCfg<DQK, DVT, KT> C;
    constexpr int NKS = DQK / 16, NST = KT / 32, NDT = DVT / 32, NPS = KT / 16;
    constexpr int KCPR = DQK / 8;
    constexpr int KTOT = KT * KCPR, KCH = (KTOT + NTH - 1) / NTH;
    constexpr int VCPR = KT / 8;
    constexpr int VTOT = DVT * VCPR, VCH = (VTOT + NTH - 1) / NTH;
    const int tid = NTH == 512 ? (int)threadIdx.x : VTID, lane = tid & 63, wid = tid >> 6, h = lane >> 5, c = lane & 31;

    bf16x8 qf[NKS];
    {
        const bf16_t* qrow = Qp + (long)(wid * 32 + c) * DQK + 8 * h;
#pragma unroll
        for (int ks = 0; ks < NKS; ks++) qf[ks] = *(const bf16x8*)(qrow + 16 * ks);
    }
    f32x16 o[NDT];
#pragma unroll
    for (int dt = 0; dt < NDT; dt++)
#pragma unroll
        for (int r = 0; r < 16; r++) o[dt][r] = 0.f;
    float m = 0.f, l = 0.f;

    u32x4 kr[KCH], vr[VCH];
    auto gload = [&](int t) {
#pragma unroll
        for (int i = 0; i < KCH; i++) {
            const int ci = tid + NTH * i, row = ci / KCPR, cc = ci % KCPR;
            if (KTOT % NTH == 0 || ci < KTOT) kr[i] = *(const u32x4*)(Kp + (long)(t * KT + row) * DQK + cc * 8);
        }
#pragma unroll
        for (int i = 0; i < VCH; i++) {
            const int ci = tid + NTH * i, row = ci / VCPR, cc = ci % VCPR;
            if (VTOT % NTH == 0 || ci < VTOT) vr[i] = *(const u32x4*)(Vtp + (long)row * ldv + t * KT + cc * 8);
        }
    };
    auto lwrite = [&](char* st) {
#pragma unroll
        for (int i = 0; i < KCH; i++) {
            const int ci = tid + NTH * i, row = ci / KCPR, cc = ci % KCPR;
            if (KTOT % NTH == 0 || ci < KTOT) *(u32x4*)(st + row * C::KROW + cc * 16) = kr[i];
        }
#pragma unroll
        for (int i = 0; i < VCH; i++) {
            const int ci = tid + NTH * i, row = ci / VCPR, cc = ci % VCPR;
            if (VTOT % NTH == 0 || ci < VTOT) {
                char* p = st + C::KBYTES + row * C::VROW + cc * 16;
                *(u32x2*)(p) = (u32x2){vr[i].x, vr[i].y};
                *(u32x2*)(p + 8) = (u32x2){vr[i].z, vr[i].w};
            }
        }
    };
    const int nt = nk / KT;
    gload(0);
    __syncthreads();
    lwrite(lds);
    __syncthreads();
    for (int t = 0; t < nt; t++) {
        char* cur = lds + (t & 1) * C::STAGE;
        if (t + 1 < nt) gload(t + 1);
        f32x16 s[NST];
        const float negm = -m;
#pragma unroll
        for (int st = 0; st < NST; st++) {
#pragma unroll
            for (int r = 0; r < 16; r++) s[st][r] = negm;
#pragma unroll
            for (int ks = 0; ks < NKS; ks++) {
                const bf16x8 kf = *(const bf16x8*)(cur + (st * 32 + c) * C::KROW + ks * 32 + h * 16);
                s[st] = __builtin_amdgcn_mfma_f32_32x32x16_bf16(kf, qf[ks], s[st], 0, 0, 0);
            }
        }
        float mx = s[0][0];
#pragma unroll
        for (int st = 0; st < NST; st++)
#pragma unroll
            for (int r = 0; r < 16; r++) mx = fmaxf(mx, s[st][r]);
        mx = fmaxf(mx, __shfl_xor(mx, 32));
        if (__any(mx > 8.0f)) {
            const float d = fmaxf(mx, 0.f);
            const float alpha = __builtin_amdgcn_exp2f(-d);
            m += d;
            l *= alpha;
#pragma unroll
            for (int dt = 0; dt < NDT; dt++)
#pragma unroll
                for (int r = 0; r < 16; r++) o[dt][r] *= alpha;
#pragma unroll
            for (int st = 0; st < NST; st++)
#pragma unroll
                for (int r = 0; r < 16; r++) s[st][r] -= d;
        }
        float rs = 0.f;
#pragma unroll
        for (int st = 0; st < NST; st++)
#pragma unroll
            for (int r = 0; r < 16; r++) { const float p = __builtin_amdgcn_exp2f(s[st][r]); rs += p; s[st][r] = p; }
        l += rs;
#pragma unroll
        for (int ps = 0; ps < NPS; ps++) {
            const int st = ps >> 1, u = ps & 1;
            u32x4 pw;
            pw.x = pack2bf(s[st][8 * u + 0], s[st][8 * u + 1]);
            pw.y = pack2bf(s[st][8 * u + 2], s[st][8 * u + 3]);
            pw.z = pack2bf(s[st][8 * u + 4], s[st][8 * u + 5]);
            pw.w = pack2bf(s[st][8 * u + 6], s[st][8 * u + 7]);
            const bf16x8 pf = __builtin_bit_cast(bf16x8, pw);
#pragma unroll
            for (int dt = 0; dt < NDT; dt++) {
                const char* vp = cur + C::KBYTES + (dt * 32 + c) * C::VROW + (ps * 16 + 4 * h) * 2;
                const u32x2 v0 = *(const u32x2*)(vp);
                const u32x2 v1 = *(const u32x2*)(vp + 16);
                const bf16x8 vf = __builtin_bit_cast(bf16x8, ((u32x4){v0.x, v0.y, v1.x, v1.y}));
                o[dt] = __builtin_amdgcn_mfma_f32_32x32x16_bf16(vf, pf, o[dt], 0, 0, 0);
            }
        }
        if (t + 1 < nt) lwrite(lds + ((t + 1) & 1) * C::STAGE);
        __syncthreads();
    }
    l += __shfl_xor(l, 32);
    const float inv = 1.f / l;
#pragma unroll
    for (int dt = 0; dt < NDT; dt++)
#pragma unroll
        for (int g4 = 0; g4 < 4; g4++) {
            f32x4 v = {o[dt][4 * g4 + 0] * inv, o[dt][4 * g4 + 1] * inv, o[dt][4 * g4 + 2] * inv, o[dt][4 * g4 + 3] * inv};
            out(wid * 32 + c, dt * 32 + 8 * g4 + 4 * h, v);
        }
}


constexpr size_t SLOT = 33554432;
constexpr size_t OFF_W1T = 0;
constexpr size_t OFF_WQT = OFF_W1T + 1280UL * 1024 * 2;
constexpr size_t OFF_WKVT = OFF_WQT + 768UL * 384 * 2;
constexpr size_t OFF_WOUTT = OFF_WKVT + 1024UL * 256 * 2;
constexpr size_t OFF_WMQT = OFF_WOUTT + 1024UL * 1024 * 2;
constexpr size_t OFF_WMKVT = OFF_WMQT + 1024UL * 1024 * 2;
constexpr size_t OFF_WMOT = OFF_WMKVT + 2048UL * 1024 * 2;
constexpr size_t OFF_WGUT = OFF_WMOT + 1024UL * 1024 * 2;
constexpr size_t OFF_WDT = OFF_WGUT + 16UL * 2048 * 1024 * 2;
constexpr size_t OFF_T64 = OFF_WDT + 16UL * 1024 * 1024 * 2;
constexpr size_t OFF_M1 = OFF_T64 + 16384;
constexpr size_t OFF_M3 = OFF_M1 + 32768;
constexpr size_t OFF_WFT = OFF_M3 + 16384;
constexpr size_t OFF_TW = OFF_WFT + 65536;
constexpr size_t OFF_ROPE = OFF_TW + 32768;
constexpr size_t OFF_R0 = OFF_ROPE + (size_t)NT * 16 * 8;
constexpr size_t OFF_RMEM = OFF_R0 + (size_t)NT * 4;
constexpr size_t OFF_SSQ = OFF_RMEM + 4096;
constexpr size_t OFF_SSKV = OFF_SSQ + (size_t)NT * 6 * 4;
constexpr size_t OFF_SS1 = OFF_SSKV + (size_t)NT * 4 * 4;
constexpr size_t OFF_SS2 = OFF_SS1 + (size_t)NT * 16 * 4;
constexpr size_t OFF_AFF = OFF_SS2 + (size_t)NT * 16 * 4;
constexpr size_t OFF_SLOTS = OFF_AFF + (size_t)NT * 16 * 4;
constexpr size_t OFF_IDX = OFF_SLOTS + 4UL * 16 * 4096 * 4;
constexpr size_t OFF_GATE = OFF_IDX + 4UL * 16 * 512 * 4;
constexpr size_t OFF_MEMB = OFF_GATE + 4UL * 16 * 512 * 4;
constexpr size_t OFF_KMEM = OFF_MEMB + 1024UL * 1024 * 2;
constexpr size_t OFF_VTMEM = OFF_KMEM + 1024UL * 1024 * 2;
constexpr size_t OFF_KR = OFF_VTMEM + 1024UL * 1024 * 2;
constexpr size_t OFF_BAR = OFF_KR + (size_t)NT * 32 * 2;
constexpr size_t OFF_S0 = (OFF_BAR + 16384 + 255) / 256 * 256;
constexpr size_t OFF_S1 = OFF_S0 + SLOT;
constexpr size_t OFF_S2 = OFF_S1 + SLOT;
constexpr size_t OFF_S3 = OFF_S2 + SLOT;
constexpr size_t OFF_S4 = OFF_S3 + SLOT;
constexpr size_t WS_END = OFF_S4 + SLOT;
static_assert(WS_END <= 300964352UL, "workspace map exceeds the guaranteed scratch size");
constexpr size_t OFF_XB = OFF_S0, OFF_YR = OFF_S0, OFF_YI = OFF_S0 + SLOT / 2, OFF_X1B = OFF_S3, OFF_OM = OFF_S0, OFF_ACT = OFF_S0;
constexpr size_t OFF_UF = OFF_S1, OFF_UQ = OFF_S1 + (size_t)NT * 512 * 2, OFF_ZA = OFF_S1, OFF_QM = OFF_S1;
constexpr size_t OFF_Q = OFF_S2, OFF_UKV = OFF_S2 + (size_t)NT * 768 * 2, OFF_X2B = OFF_S2;
constexpr size_t OFF_K = OFF_S3, OFF_Y = OFF_S3;
constexpr size_t OFF_VT = OFF_S4;

struct Params {
    const float *x, *mem; const int* pos;
    const float *g_mix, *w_in, *g_q_lat, *w_q_up, *g_kv_lat, *w_kv_up, *w_fourier, *w_out, *g_mem_q, *g_mem_kv, *w_mem_q, *w_mem_kv, *w_mem_o,
        *g_ffn, *w_router, *w_exp_gate, *w_exp_up, *w_exp_down, *g_final;
    float* out; char* ws;
};
template <class T> __device__ __forceinline__ T* wsp(const Params& p, size_t off) { return (T*)(p.ws + off); }

#define LDS_HALF 65536
#define LDS_MAIN 131072
#define LDS_TOTAL (LDS_MAIN + 16)
#define LAS __attribute__((address_space(3)))

#define XB_TMO      128
#define XB_XCNT(j)  (256  + 64 * (j))
#define XB_XSUB(j)  (1280 + 64 * (j))
#define XB_XGEN(j)  (2304 + 64 * (j))
#define XB_TOP      3328
#define XB_TOPGEN   3392
#define XCD_BAR_WORDS 3456
#define XB_SPIN_CAP (1u << 25)
__device__ __forceinline__ unsigned xb_ld(unsigned* p)              { return __hip_atomic_load(p, __ATOMIC_RELAXED, __HIP_MEMORY_SCOPE_AGENT); }
__device__ __forceinline__ unsigned xb_add(unsigned* p, unsigned v) { return __hip_atomic_fetch_add(p, v, __ATOMIC_RELAXED, __HIP_MEMORY_SCOPE_AGENT); }
__device__ __forceinline__ unsigned xb_xcc_id() { return (unsigned)__builtin_amdgcn_s_getreg((3 << 11) | 20) & 0xFu; }
#define XB_SPIN(cond, bar) do { unsigned _sp = 0; while (cond) { __builtin_amdgcn_s_sleep(1); \
    if ((++_sp & 255u) == 0u) { if (xb_ld(&(bar)[XB_TMO])) break; if (_sp > XB_SPIN_CAP) { atomicAdd(&(bar)[XB_TMO], 1u); break; } } } } while (0)
struct XcdBarrier { unsigned* bar; unsigned x; volatile LAS unsigned* st; };
__device__ __forceinline__ XcdBarrier xcd_barrier_post(unsigned* bar, volatile LAS unsigned* st) {
    XcdBarrier b; b.bar = bar; b.x = xb_xcc_id(); b.st = st;
    if (threadIdx.x == 0) (void)xb_add(&bar[XB_XCNT(b.x)], 1u);
    return b;
}
__device__ __forceinline__ void xcd_barrier_complete(unsigned* bar, unsigned x, unsigned& nloc, unsigned& nx) {
    const unsigned G = gridDim.x * gridDim.y * gridDim.z;
    unsigned sum, cnt, mine, sp = 0u;
    for (;;) {
        sum = 0u; cnt = 0u; mine = 0u;
#pragma unroll
        for (unsigned j = 0; j < 16; ++j) { const unsigned c = xb_ld(&bar[XB_XCNT(j)]); sum += c; cnt += (c > 0u) ? 1u : 0u; mine = (j == x) ? c : mine; }
        if (sum == G) break;
        __builtin_amdgcn_s_sleep(1);
        if ((++sp & 255u) == 0u) { if (xb_ld(&bar[XB_TMO])) break; if (sp > XB_SPIN_CAP) { atomicAdd(&bar[XB_TMO], 1u); break; } }
    }
    nloc = mine > 0u ? mine : 1u; nx = cnt > 0u ? cnt : 1u;
}
__device__ __forceinline__ void xcd_barrier(const XcdBarrier& b) {
    asm volatile("s_waitcnt vmcnt(0)" ::: "memory");
    __syncthreads();
    if (threadIdx.x == 0) {
        unsigned* bar = b.bar;
        __builtin_amdgcn_s_waitcnt(0);
        unsigned nloc = b.st[0], nx = b.st[1];
        if (nloc == 0u) { xcd_barrier_complete(bar, b.x, nloc, nx); b.st[0] = nloc; b.st[1] = nx; }
        const unsigned old = xb_add(&bar[XB_XSUB(b.x)], 1u);
        const unsigned gen = old / nloc;
        if (old + 1u == (gen + 1u) * nloc) {
            __builtin_amdgcn_fence(__ATOMIC_RELEASE, "agent");
            asm volatile("s_waitcnt vmcnt(0)" ::: "memory");
            const unsigned og = xb_add(&bar[XB_TOP], 1u);
            const unsigned tg = og / nx;
            if (og + 1u == (tg + 1u) * nx) xb_add(&bar[XB_TOPGEN], 1u);
            else XB_SPIN(xb_ld(&bar[XB_TOPGEN]) == tg, bar);
            __builtin_amdgcn_fence(__ATOMIC_ACQUIRE, "agent");
            xb_add(&bar[XB_XGEN(b.x)], 1u);
            asm volatile("s_waitcnt vmcnt(0)" ::: "memory");
        } else {
            XB_SPIN(xb_ld(&bar[XB_XGEN(b.x)]) == gen, bar);
            __builtin_amdgcn_fence(__ATOMIC_ACQUIRE, "agent");
            asm volatile("s_waitcnt vmcnt(0)" ::: "memory");
        }
    }
    __syncthreads();
}

#define FOR_XCD_ITEMS(item, N) for (int _L = (int)((blockIdx.x >> 3) << 1) | VHALF, item; _L < (N) / 8 && ((item = (int)(blockIdx.x & 7) * ((N) / 8) + _L), true); _L += (int)(gridDim.x >> 2))

__device__ __forceinline__ u32x2 pack4bf(float a, float b, float c, float d) { return (u32x2){pack2bf(a, b), pack2bf(c, d)}; }
__device__ __forceinline__ u32x2 pack4bf(f32x4 v) { return (u32x2){pack2bf(v[0], v[1]), pack2bf(v[2], v[3])}; }
__device__ __forceinline__ float wave_sum(float v) {
#pragma unroll
    for (int o = 32; o > 0; o >>= 1) v += __shfl_xor(v, o);
    return v;
}

__device__ __forceinline__ void tr_tile(const float* W, long ldw, int k0, int n0, int nvalid, const float* gain, bf16_t* Wt, long ldt, int mode, char* lds) {
    float (*t)[132] = (float (*)[132])lds;
    const int tid = VTID, c4 = tid & 31, r0 = tid >> 5;
    f32x4 v[8];
#pragma unroll
    for (int i = 0; i < 8; i++) {
        const int kk = r0 + 8 * i, n = n0 + c4 * 4;
        v[i] = (n < nvalid) ? *(const f32x4*)(W + (long)(k0 + kk) * ldw + n) : (f32x4){0.f, 0.f, 0.f, 0.f};
        if (gain) v[i] *= gain[k0 + kk];
    }
    __syncthreads();
#pragma unroll
    for (int i = 0; i < 8; i++) *(f32x4*)(&t[r0 + 8 * i][c4 * 4]) = v[i];
    __syncthreads();
#pragma unroll
    for (int i = 0; i < 4; i++) {
        const int ci = tid + 256 * i, nn = ci >> 3, kc = ci & 7;
        const int n = n0 + nn;
        int row = n;
        if (mode) row = (n >> 5) * 64 + ((n >> 4) & 1) * 32 + (mode - 1) * 16 + (n & 15);
        u32x4 w;
        w.x = pack2bf(t[kc * 8 + 0][nn], t[kc * 8 + 1][nn]);
        w.y = pack2bf(t[kc * 8 + 2][nn], t[kc * 8 + 3][nn]);
        w.z = pack2bf(t[kc * 8 + 4][nn], t[kc * 8 + 5][nn]);
        w.w = pack2bf(t[kc * 8 + 6][nn], t[kc * 8 + 7][nn]);
        *(u32x4*)(Wt + (long)row * ldt + k0 + kc * 8) = w;
    }
}

__device__ __forceinline__ void phase0(const Params& p, char* lds) {
    constexpr int J_W1 = 160, J_WQ = 36, J_WKV = 32, J_WOUT = 128, J_WMQ = 128, J_WMKV = 256, J_WMO = 128, J_WG = 0, J_WU = 0, J_WD = 0;
    constexpr int J_TR = J_W1 + J_WQ + J_WKV + J_WOUT + J_WMQ + J_WMKV + J_WMO + J_WG + J_WU + J_WD;
    constexpr int J_XR = NT / 4, J_MR = 1024 / 4, J_ROPE = NT * 16 / 256, J_TAB = (4096 + 8192 + 16384 + 8192 + 32768) / 256;
    constexpr int J_ALL = J_TR + J_XR + J_MR + J_ROPE + J_TAB;
    const int tid = VTID, lane = tid & 63, wid = tid >> 6;
    const double PI2 = 6.283185307179586476925286766559;
    for (int job = VBLK; job < J_ALL; job += VGRID) {
        int j = job;
        if (j < J_TR) {
            if (j < J_W1) { tr_tile(p.w_in, INW, (j / 10) * 64, (j % 10) * 128, INW, p.g_mix, wsp<bf16_t>(p, OFF_W1T), 1024, 0, lds); continue; } j -= J_W1;
            if (j < J_WQ) { tr_tile(p.w_q_up, 768, (j / 6) * 64, (j % 6) * 128, 768, p.g_q_lat, wsp<bf16_t>(p, OFF_WQT), 384, 0, lds); continue; } j -= J_WQ;
            if (j < J_WKV) { tr_tile(p.w_kv_up, 1024, (j / 8) * 64, (j % 8) * 128, 1024, p.g_kv_lat, wsp<bf16_t>(p, OFF_WKVT), 256, 0, lds); continue; } j -= J_WKV;
            if (j < J_WOUT) { tr_tile(p.w_out, 1024, (j / 8) * 64, (j % 8) * 128, 1024, nullptr, wsp<bf16_t>(p, OFF_WOUTT), 1024, 0, lds); continue; } j -= J_WOUT;
            if (j < J_WMQ) { tr_tile(p.w_mem_q, 1024, (j / 8) * 64, (j % 8) * 128, 1024, p.g_mem_q, wsp<bf16_t>(p, OFF_WMQT), 1024, 0, lds); continue; } j -= J_WMQ;
            if (j < J_WMKV) { tr_tile(p.w_mem_kv, 2048, (j / 16) * 64, (j % 16) * 128, 2048, p.g_mem_kv, wsp<bf16_t>(p, OFF_WMKVT), 1024, 0, lds); continue; } j -= J_WMKV;
            if (j < J_WMO) { tr_tile(p.w_mem_o, 1024, (j / 8) * 64, (j % 8) * 128, 1024, nullptr, wsp<bf16_t>(p, OFF_WMOT), 1024, 0, lds); continue; } j -= J_WMO;
            if (j < J_WG) { const int e = j >> 7, r = j & 127; tr_tile(p.w_exp_gate + (long)e * 1048576, 1024, (r / 8) * 64, (r % 8) * 128, 1024, p.g_ffn, wsp<bf16_t>(p, OFF_WGUT) + (long)e * 2048 * 1024, 1024, 1, lds); continue; } j -= J_WG;
            if (j < J_WU) { const int e = j >> 7, r = j & 127; tr_tile(p.w_exp_up + (long)e * 1048576, 1024, (r / 8) * 64, (r % 8) * 128, 1024, p.g_ffn, wsp<bf16_t>(p, OFF_WGUT) + (long)e * 2048 * 1024, 1024, 2, lds); continue; } j -= J_WU;
            { const int e = j >> 7, r = j & 127; tr_tile(p.w_exp_down + (long)e * 1048576, 1024, (r / 8) * 64, (r % 8) * 128, 1024, nullptr, wsp<bf16_t>(p, OFF_WDT) + (long)e * 1048576, 1024, 0, lds); continue; }
        }
        j -= J_TR;
        if (j < J_XR + J_MR) {
            const bool isx = j < J_XR;
            const int row = (isx ? j : j - J_XR) * 4 + wid;
            const float* src = (isx ? p.x : p.mem) + (long)row * ND;
            bf16_t* dst = (isx ? wsp<bf16_t>(p, OFF_XB) : wsp<bf16_t>(p, OFF_MEMB)) + (long)row * ND;
            float ss = 0.f;
#pragma unroll
            for (int i = 0; i < 4; i++) {
                const f32x4 v = *(const f32x4*)(src + i * 256 + lane * 4);
                ss += v[0] * v[0] + v[1] * v[1] + v[2] * v[2] + v[3] * v[3];
                *(u32x2*)(dst + i * 256 + lane * 4) = pack4bf(v);
            }
            ss = wave_sum(ss);
            if (lane == 0) (isx ? wsp<float>(p, OFF_R0) : wsp<float>(p, OFF_RMEM))[row] = rsqrtf(ss * (1.f / ND) + 1e-6f);
            continue;
        }
        j -= J_XR + J_MR;
        if (j < J_ROPE) {
            const int i = j * 256 + tid; const int t = i >> 4, jj = i & 15;
            const double f = pow(10000.0, -(double)(2 * jj) / 32.0);
            const double ang = (double)p.pos[t] * f;
            wsp<float2>(p, OFF_ROPE)[i] = make_float2((float)cos(ang), (float)sin(ang));
            continue;
        }
        j -= J_ROPE;
        {
            int i = j * 256 + tid;
            if (i < 4096) { const double a = PI2 * (double)i / 4096.0; wsp<float2>(p, OFF_TW)[i] = make_float2((float)cos(a), (float)sin(a)); continue; } i -= 4096;
            if (i < 8192) {
                const int T = i >> 12, a = (i >> 6) & 63, b = i & 63;
                const double th = PI2 * (double)((a * b) & 63) / 64.0;
                wsp<bf16_t>(p, OFF_T64)[i] = (bf16_t)f2bf((float)(T ? sin(th) : cos(th))); continue;
            } i -= 8192;
            if (i < 16384) {
                const int rho = i >> 7, k = i & 127;
                const int wm = rho >> 6, mi = (rho >> 4) & 3, lr = rho & 15, ri = mi >> 1, k1 = 32 * wm + 16 * (mi & 1) + lr, ab = k >> 6, s1 = k & 63;
                const double th = PI2 * (double)((k1 * s1) & 63) / 64.0;
                const double c = cos(th), s = sin(th);
                const double v = ri == 0 ? (ab == 0 ? c : -s) : (ab == 0 ? s : c);
                wsp<bf16_t>(p, OFF_M1)[i] = (bf16_t)f2bf((float)v); continue;
            } i -= 16384;
            if (i < 8192) {
                const int k2 = i >> 7, k = i & 127, s2 = k & 63;
                const double th = PI2 * (double)((k2 * s2) & 63) / 64.0;
                wsp<bf16_t>(p, OFF_M3)[i] = (bf16_t)f2bf((float)(k < 64 ? cos(th) : -sin(th))); continue;
            } i -= 8192;
            if (i < 32768) {
                const int g = i >> 12, e = (i >> 6) & 63, ch = i & 63;
                wsp<bf16_t>(p, OFF_WFT)[i] = (bf16_t)f2bf(p.w_fourier[(g * 64 + ch) * 64 + e]); continue;
            }
        }
    }
}

__device__ __forceinline__ void phase1(const Params& p, char* lds) {
    const int tid = VTID, lane = tid & 63, wid = tid >> 6, wm = wid >> 1, wn = wid & 1, lq = lane >> 4, lr = lane & 15;
    constexpr int N_U = 128 * 2, N_M = 8 * 16;
    {
      FOR_XCD_ITEMS(item, N_U) {
        f32x4 acc[4][4];
        {
            const int tm = item >> 1, tn = 8 + (item & 1);
            GemmTile g; g.A = wsp<bf16_t>(p, OFF_XB) + (long)tm * 128 * ND; g.lda = ND; g.arow = nullptr;
            g.Bt = wsp<bf16_t>(p, OFF_W1T) + (long)tn * 128 * ND; g.ldb = ND; g.K = ND;
            gemm_tile_128(g, lds, acc);
            const float* r0 = wsp<float>(p, OFF_R0);
#pragma unroll
            for (int mi = 0; mi < 4; mi++) {
                const int row = tm * 128 + wm * 64 + mi * 16 + lr;
                const float rs = r0[row];
#pragma unroll
                for (int ni = 0; ni < 4; ni++) acc[mi][ni] *= rs;
                if (tn < 4) {
#pragma unroll
                    for (int ni = 0; ni < 4; ni++)
                        *(u32x2*)(wsp<bf16_t>(p, OFF_UF) + (long)row * 512 + tn * 128 + wn * 64 + ni * 16 + 4 * lq) = pack4bf(acc[mi][ni]);
                } else if (tn < 9) {
                    float ss = 0.f;
#pragma unroll
                    for (int ni = 0; ni < 4; ni++) { const f32x4 v = acc[mi][ni]; ss += v[0] * v[0] + v[1] * v[1] + v[2] * v[2] + v[3] * v[3]; }
                    ss += __shfl_xor(ss, 16); ss += __shfl_xor(ss, 32);
                    if (tn < 7) {
#pragma unroll
                        for (int ni = 0; ni < 4; ni++)
                            *(u32x2*)(wsp<bf16_t>(p, OFF_UQ) + (long)row * 384 + (tn - 4) * 128 + wn * 64 + ni * 16 + 4 * lq) = pack4bf(acc[mi][ni]);
                        if (lq == 0) wsp<float>(p, OFF_SSQ)[row * 6 + (tn - 4) * 2 + wn] = ss;
                    } else {
#pragma unroll
                        for (int ni = 0; ni < 4; ni++)
                            *(u32x2*)(wsp<bf16_t>(p, OFF_UKV) + (long)row * 256 + (tn - 7) * 128 + wn * 64 + ni * 16 + 4 * lq) = pack4bf(acc[mi][ni]);
                        if (lq == 0) wsp<float>(p, OFF_SSKV)[row * 4 + (tn - 7) * 2 + wn] = ss;
                    }
                } else if (wn == 0) {
                    const float2* rp = wsp<float2>(p, OFF_ROPE) + (long)row * 16 + 4 * lq;
                    f32x4 o1, o2;
#pragma unroll
                    for (int r = 0; r < 4; r++) {
                        const float2 cs = rp[r];
                        const float x1 = acc[mi][0][r], x2 = acc[mi][1][r];
                        o1[r] = x1 * cs.x - x2 * cs.y; o2[r] = x1 * cs.y + x2 * cs.x;
                    }
                    bf16_t* kr = wsp<bf16_t>(p, OFF_KR) + (long)row * 32;
                    *(u32x2*)(kr + 4 * lq) = pack4bf(o1);
                    *(u32x2*)(kr + 16 + 4 * lq) = pack4bf(o2);
                }
            }
        }
      }
      FOR_XCD_ITEMS(it, N_M) {
        f32x4 acc[4][4];
        {
            const int tm = it / 16, tn = it % 16;
            GemmTile g; g.A = wsp<bf16_t>(p, OFF_MEMB) + (long)tm * 128 * ND; g.lda = ND; g.arow = nullptr;
            g.Bt = wsp<bf16_t>(p, OFF_WMKVT) + (long)tn * 128 * ND; g.ldb = ND; g.K = ND;
            gemm_tile_128(g, lds, acc);
            const float* rm = wsp<float>(p, OFF_RMEM);
#pragma unroll
            for (int mi = 0; mi < 4; mi++) {
                const int row = tm * 128 + wm * 64 + mi * 16 + lr;
                const int b = row >> 8, m = row & 255;
                const float rs = rm[row];
#pragma unroll
                for (int ni = 0; ni < 4; ni++) {
                    const f32x4 v = acc[mi][ni] * rs;
                    const int col = tn * 128 + wn * 64 + ni * 16 + 4 * lq;
                    if (col < 1024) {
                        const int h = col >> 8, d = col & 255;
                        *(u32x2*)(wsp<bf16_t>(p, OFF_KMEM) + ((long)(b * 4 + h) * 256 + m) * 256 + d) = pack4bf(v);
                    } else {
                        const int c2 = col - 1024, h = c2 >> 8, dv = c2 & 255;
                        bf16_t* vt = wsp<bf16_t>(p, OFF_VTMEM) + ((long)(b * 4 + h) * 256 + dv) * 256 + m;
#pragma unroll
                        for (int r = 0; r < 4; r++) vt[r * 256] = (bf16_t)f2bf(v[r]);
                    }
                }
            }
        }
      }
    }
}

template <int MI>
__device__ __forceinline__ void dft_mma(const bf16_t* Ag, int arow0, const char* ximg, int ncol0, f32x4 (&acc)[MI][4]) {
    const int lane = VTID & 63, lq = lane >> 4, lr = lane & 15;
#pragma unroll
    for (int ks = 0; ks < 4; ks++) {
        bf16x8 af[MI], bfr[4];
#pragma unroll
        for (int mi = 0; mi < MI; mi++) af[mi] = *(const bf16x8*)(Ag + (long)(arow0 + mi * 16 + lr) * 128 + ks * 32 + lq * 8);
#pragma unroll
        for (int ni = 0; ni < 4; ni++) {
            const char* bp = ximg + (ks * 32 + lq * 8) * 272 + (ncol0 + ni * 16 + lr) * 2;
#pragma unroll
            for (int j = 0; j < 8; j++) bfr[ni][j] = *(const short*)(bp + j * 272);
        }
#pragma unroll
        for (int mi = 0; mi < MI; mi++)
#pragma unroll
            for (int ni = 0; ni < 4; ni++) acc[mi][ni] = __builtin_amdgcn_mfma_f32_16x16x32_bf16(bfr[ni], af[mi], acc[mi][ni], 0, 0, 0);
    }
}

__device__ __forceinline__ void f2a_item(const Params& p, int it, char* lds) {
    const int tid = VTID, lane = tid & 63, wid = tid >> 6, wm = wid >> 1, wn = wid & 1, lq = lane >> 4, lr = lane & 15;
    const int nc = it & 3, s2 = (it >> 2) & 63, b = it >> 8;
    char* uimg = lds; char* ximg = lds + 17408;
    __syncthreads();
#pragma unroll
    for (int i = 0; i < 4; i++) {
        const int ci = tid + 256 * i, row = ci >> 4, cc = ci & 15;
        *(u32x4*)(uimg + row * 272 + cc * 16) = *(const u32x4*)(wsp<bf16_t>(p, OFF_UF) + ((long)(b * NS + 64 * row + s2)) * 512 + nc * 128 + cc * 8);
    }
    __syncthreads();
    {
        const int g2 = wid >> 1, T = wid & 1;
        f32x4 a1[4][4];
#pragma unroll
        for (int mi = 0; mi < 4; mi++)
#pragma unroll
            for (int ni = 0; ni < 4; ni++) a1[mi][ni] = (f32x4){0.f, 0.f, 0.f, 0.f};
        const bf16_t* t64 = wsp<bf16_t>(p, OFF_T64) + T * 4096;
#pragma unroll
        for (int ks = 0; ks < 2; ks++) {
            bf16x8 af[4], bfr[4];
#pragma unroll
            for (int i = 0; i < 4; i++) {
                af[i] = *(const bf16x8*)(uimg + (i * 16 + lr) * 272 + (g2 * 64 + ks * 32 + lq * 8) * 2);
                bfr[i] = *(const bf16x8*)(t64 + (i * 16 + lr) * 64 + ks * 32 + lq * 8);
            }
#pragma unroll
            for (int mi = 0; mi < 4; mi++)
#pragma unroll
                for (int ni = 0; ni < 4; ni++) a1[mi][ni] = __builtin_amdgcn_mfma_f32_16x16x32_bf16(bfr[ni], af[mi], a1[mi][ni], 0, 0, 0);
        }
#pragma unroll
        for (int mi = 0; mi < 4; mi++)
#pragma unroll
            for (int ni = 0; ni < 4; ni++)
                *(u32x2*)(ximg + (T * 64 + mi * 16 + lr) * 272 + (g2 * 64 + ni * 16 + 4 * lq) * 2) = pack4bf(a1[mi][ni]);
    }
    __syncthreads();
    f32x4 acc[4][4];
#pragma unroll
    for (int mi = 0; mi < 4; mi++)
#pragma unroll
        for (int ni = 0; ni < 4; ni++) acc[mi][ni] = (f32x4){0.f, 0.f, 0.f, 0.f};
    dft_mma<4>(wsp<bf16_t>(p, OFF_M1), wm * 64, ximg, wn * 64, acc);
    const float2* tw = wsp<float2>(p, OFF_TW);
#pragma unroll
    for (int m2 = 0; m2 < 2; m2++) {
        const int k1 = 32 * wm + 16 * m2 + lr;
        float2 cs; { const float rev = (float)((s2 * k1) & 4095) * (1.0f / 4096.0f); cs.x = __builtin_amdgcn_cosf(rev); cs.y = __builtin_amdgcn_sinf(rev); (void)tw; }
        const long base = ((long)(b * 64 + k1) * 64 + s2) * 512 + nc * 128 + wn * 64 + 4 * lq;
#pragma unroll
        for (int ni = 0; ni < 4; ni++) {
            const f32x4 yr = acc[m2][ni], yi = acc[m2 + 2][ni];
            const f32x4 orr = yr * cs.x - yi * cs.y, oi = yi * cs.x + yr * cs.y;
            *(u32x2*)(wsp<bf16_t>(p, OFF_YR) + base + ni * 16) = pack4bf(orr);
            *(u32x2*)(wsp<bf16_t>(p, OFF_YI) + base + ni * 16) = pack4bf(oi);
        }
    }
}

__device__ __forceinline__ void f2b_item(const Params& p, int it, char* lds) {
    const int tid = VTID, lane = tid & 63, wid = tid >> 6, wm = wid >> 1, wn = wid & 1, lq = lane >> 4, lr = lane & 15;
    const int nc = it & 3, k1 = (it >> 2) & 63, b = it >> 8;
    char* ximg = lds; char* zimg = lds + 34816;
    __syncthreads();
#pragma unroll
    for (int i = 0; i < 8; i++) {
        const int ci = tid + 256 * i, row = ci >> 4, cc = ci & 15;
        const bf16_t* src = (row < 64 ? wsp<bf16_t>(p, OFF_YR) : wsp<bf16_t>(p, OFF_YI)) + ((long)(b * 64 + k1) * 64 + (row & 63)) * 512 + nc * 128 + cc * 8;
        *(u32x4*)(ximg + row * 272 + cc * 16) = *(const u32x4*)src;
    }
    __syncthreads();
    f32x4 acc[2][4];
#pragma unroll
    for (int mi = 0; mi < 2; mi++)
#pragma unroll
        for (int ni = 0; ni < 4; ni++) acc[mi][ni] = (f32x4){0.f, 0.f, 0.f, 0.f};
    dft_mma<2>(wsp<bf16_t>(p, OFF_M3), wm * 32, ximg, wn * 64, acc);
#pragma unroll
    for (int mi = 0; mi < 2; mi++)
#pragma unroll
        for (int ni = 0; ni < 4; ni++)
            *(u32x2*)(zimg + (wm * 32 + mi * 16 + lr) * 272 + (wn * 64 + ni * 16 + 4 * lq) * 2) = pack4bf(acc[mi][ni] * (1.0f / 512.0f));
    __syncthreads();
    f32x4 a3[2][4];
#pragma unroll
    for (int mi = 0; mi < 2; mi++)
#pragma unroll
        for (int ni = 0; ni < 4; ni++) a3[mi][ni] = (f32x4){0.f, 0.f, 0.f, 0.f};
    const bf16_t* wft = wsp<bf16_t>(p, OFF_WFT) + (long)(nc * 2 + wn) * 4096;
#pragma unroll
    for (int ks = 0; ks < 2; ks++) {
        bf16x8 af[2], bfr[4];
#pragma unroll
        for (int i = 0; i < 2; i++) af[i] = *(const bf16x8*)(zimg + (wm * 32 + i * 16 + lr) * 272 + (wn * 64 + ks * 32 + lq * 8) * 2);
#pragma unroll
        for (int i = 0; i < 4; i++) bfr[i] = *(const bf16x8*)(wft + (i * 16 + lr) * 64 + ks * 32 + lq * 8);
#pragma unroll
        for (int mi = 0; mi < 2; mi++)
#pragma unroll
            for (int ni = 0; ni < 4; ni++) a3[mi][ni] = __builtin_amdgcn_mfma_f32_16x16x32_bf16(bfr[ni], af[mi], a3[mi][ni], 0, 0, 0);
    }
#pragma unroll
    for (int mi = 0; mi < 2; mi++) {
        const int k2 = wm * 32 + mi * 16 + lr;
        bf16_t* dst = wsp<bf16_t>(p, OFF_ZA) + ((long)(b * NS + k1 + 64 * k2)) * 1024 + nc * 128 + wn * 64 + 4 * lq;
#pragma unroll
        for (int ni = 0; ni < 4; ni++) *(u32x2*)(dst + ni * 16) = pack4bf(a3[mi][ni]);
    }
}

__device__ __forceinline__ void phase2(const Params& p, char* lds) {
    const int tid = VTID, lane = tid & 63, wid = tid >> 6, wm = wid >> 1, wn = wid & 1, lq = lane >> 4, lr = lane & 15;
    constexpr int N_Q = 128 * 6, N_KV = 128 * 8, N_F = 1024;
    {
      FOR_XCD_ITEMS(item, N_Q) {
        f32x4 acc[4][4];
        {
            const int tm = item / 6, tn = item % 6;
            GemmTile g; g.A = wsp<bf16_t>(p, OFF_UQ) + (long)tm * 128 * 384; g.lda = 384; g.arow = nullptr;
            g.Bt = wsp<bf16_t>(p, OFF_WQT) + (long)tn * 128 * 384; g.ldb = 384; g.K = 384;
            gemm_tile_128(g, lds, acc);
            const float qmul = 0.10206207261596575f * 1.4426950408889634f;
#pragma unroll
            for (int mi = 0; mi < 4; mi++) {
                const int row = tm * 128 + wm * 64 + mi * 16 + lr;
                const int b = row >> 12, s = row & 4095;
                const float* sq = wsp<float>(p, OFF_SSQ) + (long)row * 6;
                const float ss = sq[0] + sq[1] + sq[2] + sq[3] + sq[4] + sq[5];
                const float rs = rsqrtf(ss * (1.f / 384.f) + 1e-6f) * qmul;
                const int cb0 = tn * 128 + wn * 64;
#pragma unroll
                for (int ni = 0; ni < 4; ni++) {
                    const int cb = cb0 + ni * 16, hd = cb / 96, hob = cb % 96;
                    bf16_t* qd = wsp<bf16_t>(p, OFF_Q) + ((long)(b * 8 + hd) * NS + s) * 96;
                    if (hob < 64) {
                        *(u32x2*)(qd + hob + 4 * lq) = pack4bf(acc[mi][ni] * rs);
                    } else if (hob == 64) {
                        if (ni < 3) {
                            const float2* rp = wsp<float2>(p, OFF_ROPE) + (long)row * 16 + 4 * lq;
                            f32x4 o1, o2;
#pragma unroll
                            for (int r = 0; r < 4; r++) {
                                const float2 cs = rp[r];
                                const float x1 = acc[mi][ni][r] * rs, x2 = acc[mi][ni < 3 ? ni + 1 : 3][r] * rs;
                                o1[r] = x1 * cs.x - x2 * cs.y; o2[r] = x1 * cs.y + x2 * cs.x;
                            }
                            *(u32x2*)(qd + 64 + 4 * lq) = pack4bf(o1);
                            *(u32x2*)(qd + 80 + 4 * lq) = pack4bf(o2);
                        }
                    }
                }
            }
        }
      }
      FOR_XCD_ITEMS(it, N_KV) {
        f32x4 acc[4][4];
        {
            const int tm = it >> 3, hd = it & 7;
            GemmTile g; g.A = wsp<bf16_t>(p, OFF_UKV) + (long)tm * 128 * 256; g.lda = 256; g.arow = nullptr;
            g.Bt = wsp<bf16_t>(p, OFF_WKVT) + (long)hd * 128 * 256; g.ldb = 256; g.K = 256;
            gemm_tile_128(g, lds, acc);
#pragma unroll
            for (int mi = 0; mi < 4; mi++) {
                const int row = tm * 128 + wm * 64 + mi * 16 + lr;
                const int b = row >> 12, s = row & 4095;
                const float* sq = wsp<float>(p, OFF_SSKV) + (long)row * 4;
                const float rs = rsqrtf((sq[0] + sq[1] + sq[2] + sq[3]) * (1.f / 256.f) + 1e-6f);
                if (wn == 0) {
                    bf16_t* kd = wsp<bf16_t>(p, OFF_K) + ((long)(b * 8 + hd) * NS + s) * 96;
#pragma unroll
                    for (int ni = 0; ni < 4; ni++) *(u32x2*)(kd + ni * 16 + 4 * lq) = pack4bf(acc[mi][ni] * rs);
                } else {
#pragma unroll
                    for (int ni = 0; ni < 4; ni++) {
                        bf16_t* vd = wsp<bf16_t>(p, OFF_VT) + ((long)(b * 8 + hd) * 64 + ni * 16 + 4 * lq) * NS + s;
#pragma unroll
                        for (int r = 0; r < 4; r++) vd[(long)r * NS] = (bf16_t)f2bf(acc[mi][ni][r] * rs);
                    }
                }
            }
#pragma unroll
            for (int i = 0; i < 2; i++) {
                const int ci = tid + 256 * i, r = ci >> 2, cc = ci & 3;
                const int row = tm * 128 + r, b = row >> 12, s = row & 4095;
                *(u32x4*)(wsp<bf16_t>(p, OFF_K) + ((long)(b * 8 + hd) * NS + s) * 96 + 64 + cc * 8) = *(const u32x4*)(wsp<bf16_t>(p, OFF_KR) + (long)row * 32 + cc * 8);
            }
        }
      }
      FOR_XCD_ITEMS(it, N_F) { f2a_item(p, it, lds); }
    }
}


__device__ __forceinline__ void expert_tr_job(const Params& p, int j, char* lds) {
    const int which = j >> 11, r = j & 2047, e = r >> 7, t = r & 127;
    const int k0 = (t >> 3) * 64, n0 = (t & 7) * 128;
    if (which == 0) tr_tile(p.w_exp_gate + (long)e * 1048576, 1024, k0, n0, 1024, p.g_ffn, wsp<bf16_t>(p, OFF_WGUT) + (long)e * 2048 * 1024, 1024, 1, lds);
    else if (which == 1) tr_tile(p.w_exp_up + (long)e * 1048576, 1024, k0, n0, 1024, p.g_ffn, wsp<bf16_t>(p, OFF_WGUT) + (long)e * 2048 * 1024, 1024, 2, lds);
    else tr_tile(p.w_exp_down + (long)e * 1048576, 1024, k0, n0, 1024, nullptr, wsp<bf16_t>(p, OFF_WDT) + (long)e * 1048576, 1024, 0, lds);
}

__device__ __forceinline__ void phase3_tr(const Params& p, char* lds) {
    for (int j = VBLK; j < 6144; j += VGRID) expert_tr_job(p, j, lds);
}
__device__ __forceinline__ void phase3_f2b(const Params& p, char* lds) {
    FOR_XCD_ITEMS(it, 1024) { f2b_item(p, it, lds); }
}

__device__ __forceinline__ void phase_resid(const Params& p, char* lds, size_t offA, size_t offW, const float* residf, const bf16_t* residb, size_t offXb, size_t offSS) {
    const int tid = VTID, lane = tid & 63, wid = tid >> 6, wm = wid >> 1, wn = wid & 1, lq = lane >> 4, lr = lane & 15;
    FOR_XCD_ITEMS(item, 128 * 8) {
        const int tm = item >> 3, tn = item & 7;
        f32x4 acc[4][4];
        GemmTile g; g.A = wsp<bf16_t>(p, offA) + (long)tm * 128 * ND; g.lda = ND; g.arow = nullptr;
        g.Bt = wsp<bf16_t>(p, offW) + (long)tn * 128 * ND; g.ldb = ND; g.K = ND;
        gemm_tile_128(g, lds, acc);
#pragma unroll
        for (int mi = 0; mi < 4; mi++) {
            const int row = tm * 128 + wm * 64 + mi * 16 + lr;
            float ss = 0.f;
#pragma unroll
            for (int ni = 0; ni < 4; ni++) {
                const long o = (long)row * ND + tn * 128 + wn * 64 + ni * 16 + 4 * lq;
                f32x4 rv;
                if (residf) rv = *(const f32x4*)(residf + o);
                else { const u32x2 w = *(const u32x2*)(residb + o); rv = (f32x4){__uint_as_float(w.x << 16), __uint_as_float(w.x & 0xFFFF0000u), __uint_as_float(w.y << 16), __uint_as_float(w.y & 0xFFFF0000u)}; }
                const f32x4 v = rv + acc[mi][ni];
                *(u32x2*)(wsp<bf16_t>(p, offXb) + o) = pack4bf(v);
                ss += v[0] * v[0] + v[1] * v[1] + v[2] * v[2] + v[3] * v[3];
            }
            ss += __shfl_xor(ss, 16); ss += __shfl_xor(ss, 32);
            if (lq == 0) wsp<float>(p, offSS)[row * 16 + tn * 2 + wn] = ss;
        }
    }
}
__device__ __forceinline__ float row_rs16(const float* ss) {
    const f32x4 a = *(const f32x4*)ss, b = *(const f32x4*)(ss + 4), c = *(const f32x4*)(ss + 8), d = *(const f32x4*)(ss + 12);
    const f32x4 t = (a + b) + (c + d);
    return rsqrtf(((t[0] + t[1]) + (t[2] + t[3])) * (1.f / 1024.f) + 1e-6f);
}

__device__ __forceinline__ void phase5a(const Params& p, char* lds) {
    const int tid = VTID, lane = tid & 63, wid = tid >> 6, wm = wid >> 1, wn = wid & 1, lq = lane >> 4, lr = lane & 15;
    FOR_XCD_ITEMS(item, 128 * 8) {
        const int tm = item >> 3, tn = item & 7;
        f32x4 acc[4][4];
        GemmTile g; g.A = wsp<bf16_t>(p, OFF_X1B) + (long)tm * 128 * ND; g.lda = ND; g.arow = nullptr;
        g.Bt = wsp<bf16_t>(p, OFF_WMQT) + (long)tn * 128 * ND; g.ldb = ND; g.K = ND;
        gemm_tile_128(g, lds, acc);
        const int h = tn >> 1;
#pragma unroll
        for (int mi = 0; mi < 4; mi++) {
            const int row = tm * 128 + wm * 64 + mi * 16 + lr, b = row >> 12, s = row & 4095;
            const float rs = row_rs16(wsp<float>(p, OFF_SS1) + (long)row * 16) * (0.0625f * 1.4426950408889634f);
            bf16_t* qd = wsp<bf16_t>(p, OFF_QM) + ((long)(b * 4 + h) * NS + s) * 256 + (tn & 1) * 128 + wn * 64 + 4 * lq;
#pragma unroll
            for (int ni = 0; ni < 4; ni++) *(u32x2*)(qd + ni * 16) = pack4bf(acc[mi][ni] * rs);
        }
    }
}
__device__ __forceinline__ void phase5b(const Params& p, char* lds) {
    FOR_XCD_ITEMS(item, NB * 4 * 32 * 2) {
        const int dvh = item & 1, qt = (item >> 1) & 31, h = (item >> 6) & 3, b = item >> 8;
        const bf16_t* Qp = wsp<bf16_t>(p, OFF_QM) + ((long)(b * 4 + h) * NS + qt * 128) * 256;
        const bf16_t* Kp = wsp<bf16_t>(p, OFF_KMEM) + ((long)(b * 4 + h) * 256) * 256;
        const bf16_t* Vtp = wsp<bf16_t>(p, OFF_VTMEM) + ((long)(b * 4 + h) * 256 + dvh * 128) * 256;
        bf16_t* Op = wsp<bf16_t>(p, OFF_OM) + ((long)b * NS + qt * 128) * 1024 + h * 256 + dvh * 128;
        attn_block<256, 128, 32, 256>(Qp, Kp, Vtp, 256L, 256, lds, [&](int q, int dv, f32x4 v) { *(u32x2*)(Op + (long)q * 1024 + dv) = pack4bf(v); });
    }
}

__device__ __forceinline__ void phase7(const Params& p, char* lds) {
    const int tid = VTID, lane = tid & 63, wid = tid >> 6;
    float* wr = (float*)lds;
    __syncthreads();
    for (int i = tid; i < 16384; i += 256) { const int k = i >> 4, e = i & 15; wr[e * 1024 + k] = p.w_router[i] * p.g_ffn[k]; }
    __syncthreads();
    for (int tok = VBLK * 4 + wid; tok < NT; tok += VGRID * 4) {
        const bf16_t* xr = wsp<bf16_t>(p, OFF_X2B) + (long)tok * ND;
        float a[16];
#pragma unroll
        for (int e = 0; e < 16; e++) a[e] = 0.f;
#pragma unroll 2
        for (int j = 0; j < 8; j++) {
            const unsigned xw = *(const unsigned*)(xr + 2 * lane + 128 * j);
            const float x0 = __uint_as_float(xw << 16), x1 = __uint_as_float(xw & 0xFFFF0000u);
#pragma unroll
            for (int e = 0; e < 16; e++) {
                const f32x2 w = *(const f32x2*)(wr + e * 1024 + 2 * lane + 128 * j);
                a[e] += x0 * w[0] + x1 * w[1];
            }
        }
#pragma unroll
        for (int i = 0; i < 8; i++) { const bool hi = lane & 32; const float send = hi ? a[i] : a[i + 8], keep = hi ? a[i + 8] : a[i]; a[i] = keep + __shfl_xor(send, 32); }
#pragma unroll
        for (int i = 0; i < 4; i++) { const bool hi = lane & 16; const float send = hi ? a[i] : a[i + 4], keep = hi ? a[i + 4] : a[i]; a[i] = keep + __shfl_xor(send, 16); }
#pragma unroll
        for (int i = 0; i < 2; i++) { const bool hi = lane & 8; const float send = hi ? a[i] : a[i + 2], keep = hi ? a[i + 2] : a[i]; a[i] = keep + __shfl_xor(send, 8); }
        { const bool hi = lane & 4; const float send = hi ? a[0] : a[1], keep = hi ? a[1] : a[0]; a[0] = keep + __shfl_xor(send, 4); }
        float lg = a[0];
        lg += __shfl_xor(lg, 2); lg += __shfl_xor(lg, 1);
        const int e = ((lane >> 5) & 1) * 8 + ((lane >> 4) & 1) * 4 + ((lane >> 3) & 1) * 2 + ((lane >> 2) & 1);
        lg *= row_rs16(wsp<float>(p, OFF_SS2) + (long)tok * 16);
        float mx = lg;
#pragma unroll
        for (int o = 4; o < 64; o <<= 1) mx = fmaxf(mx, __shfl_xor(mx, o));
        const float ex = expf(lg - mx);
        float sm = ex;
#pragma unroll
        for (int o = 4; o < 64; o <<= 1) sm += __shfl_xor(sm, o);
        if ((lane & 3) == 0) wsp<float>(p, OFF_AFF)[(long)tok * 16 + e] = ex / sm;
    }
}

__device__ __forceinline__ int block_sum_i(int v, int* red) {
    const int lane = VTID & 63, wid = VTID >> 6;
#pragma unroll
    for (int o = 32; o > 0; o >>= 1) v += __shfl_xor(v, o);
    __syncthreads();
    if (lane == 0) red[wid] = v;
    __syncthreads();
    return red[0] + red[1] + red[2] + red[3];
}
__device__ __forceinline__ int block_excl_scan_i(int v, int* red, int& total) {
    const int lane = VTID & 63, wid = VTID >> 6;
    int inc = v;
#pragma unroll
    for (int o = 1; o < 64; o <<= 1) { const int t = __shfl_up(inc, o); if (lane >= o) inc += t; }
    __syncthreads();
    if (lane == 63) red[wid] = inc;
    __syncthreads();
    int base = 0;
#pragma unroll
    for (int w = 0; w < 4; w++) if (w < wid) base += red[w];
    total = red[0] + red[1] + red[2] + red[3];
    return base + inc - v;
}
__device__ __forceinline__ void phase8(const Params& p, char* lds) {
    int* red = (int*)lds;
    const int tid = VTID;
    for (int item = VBLK; item < NB * NE; item += VGRID) {
        const int e = item & 15, b = item >> 4;
        const float* aff = wsp<float>(p, OFF_AFF) + (long)b * NS * 16 + e;
        unsigned v[16];
#pragma unroll
        for (int i = 0; i < 16; i++) v[i] = __float_as_uint(aff[(long)(tid * 16 + i) * 16]);
        unsigned T = 0;
        for (int bit = 30; bit >= 0; bit--) {
            const unsigned cand = T | (1u << bit);
            int c = 0;
#pragma unroll
            for (int i = 0; i < 16; i++) c += (v[i] >= cand) ? 1 : 0;
            if (block_sum_i(c, red) >= CAP) T = cand;
        }
        int cg = 0, ce = 0;
#pragma unroll
        for (int i = 0; i < 16; i++) { cg += (v[i] > T) ? 1 : 0; ce += (v[i] == T) ? 1 : 0; }
        int tot;
        const int pk = block_excl_scan_i(cg | (ce << 16), red, tot);
        const int need = CAP - (tot & 0xFFFF);
        const int pe = pk >> 16;
        int nse = need - pe; nse = nse < 0 ? 0 : (nse > ce ? ce : nse);
        int tot2;
        int slot = block_excl_scan_i(cg + nse, red, tot2);
        int* slots = wsp<int>(p, OFF_SLOTS) + (long)(b * NE + e) * NS;
        int* idx = wsp<int>(p, OFF_IDX) + (long)(b * NE + e) * CAP;
        float* gate = wsp<float>(p, OFF_GATE) + (long)(b * NE + e) * CAP;
        int eqs = 0;
#pragma unroll
        for (int i = 0; i < 16; i++) {
            const int t = tid * 16 + i;
            bool sel = v[i] > T;
            if (v[i] == T) { sel = eqs < nse; eqs++; }
            if (sel) { slots[t] = slot; idx[slot] = b * NS + t; gate[slot] = __uint_as_float(v[i]); slot++; }
            else slots[t] = -1;
        }
    }
}

__device__ __forceinline__ void phase9(const Params& p, char* lds) {
    const int tid = VTID, lane = tid & 63, wid = tid >> 6, wm = wid >> 1, wn = wid & 1, lq = lane >> 4, lr = lane & 15;
    FOR_XCD_ITEMS(item, NE * 16 * NB * 4) {
        const int rt = item & 3, b = (item >> 2) & 3, ct = (item >> 4) & 15, e = item >> 8;
        const int* arow = wsp<int>(p, OFF_IDX) + (long)(b * NE + e) * CAP + rt * 128;
        f32x4 acc[4][4];
        GemmTile g; g.A = wsp<bf16_t>(p, OFF_X2B); g.lda = ND; g.arow = arow;
        g.Bt = wsp<bf16_t>(p, OFF_WGUT) + ((long)e * 2048 + ct * 128) * ND; g.ldb = ND; g.K = ND;
        gemm_tile_128(g, lds, acc);
#pragma unroll
        for (int mi = 0; mi < 4; mi++) {
            const int r = wm * 64 + mi * 16 + lr;
            const int tok = arow[r];
            const float rs = row_rs16(wsp<float>(p, OFF_SS2) + (long)tok * 16);
            bf16_t* ad = wsp<bf16_t>(p, OFF_ACT) + ((long)(e * NB + b) * CAP + rt * 128 + r) * ND + ct * 64 + wn * 32 + 4 * lq;
#pragma unroll
            for (int pp = 0; pp < 2; pp++) {
                f32x4 o;
#pragma unroll
                for (int q = 0; q < 4; q++) {
                    const float ga = acc[mi][2 * pp][q] * rs, up = acc[mi][2 * pp + 1][q] * rs;
                    o[q] = ga / (1.f + __expf(-ga)) * up;
                }
                *(u32x2*)(ad + pp * 16) = pack4bf(o);
            }
        }
    }
}
__device__ __forceinline__ void phase10(const Params& p, char* lds) {
    const int tid = VTID, lane = tid & 63, wid = tid >> 6, wm = wid >> 1, wn = wid & 1, lq = lane >> 4, lr = lane & 15;
    FOR_XCD_ITEMS(item, NE * 8 * NB * 4) {
        const int rt = item & 3, b = (item >> 2) & 3, ct = (item >> 4) & 7, e = item >> 7;
        const long row0 = (long)(e * NB + b) * CAP + rt * 128;
        f32x4 acc[4][4];
        GemmTile g; g.A = wsp<bf16_t>(p, OFF_ACT) + row0 * ND; g.lda = ND; g.arow = nullptr;
        g.Bt = wsp<bf16_t>(p, OFF_WDT) + ((long)e * 1024 + ct * 128) * ND; g.ldb = ND; g.K = ND;
        gemm_tile_128(g, lds, acc);
        const float* gate = wsp<float>(p, OFF_GATE) + (long)(b * NE + e) * CAP + rt * 128;
#pragma unroll
        for (int mi = 0; mi < 4; mi++) {
            const int r = wm * 64 + mi * 16 + lr;
            const float gv = gate[r];
            bf16_t* yd = wsp<bf16_t>(p, OFF_Y) + (row0 + r) * ND + ct * 128 + wn * 64 + 4 * lq;
#pragma unroll
            for (int ni = 0; ni < 4; ni++) *(u32x2*)(yd + ni * 16) = pack4bf(acc[mi][ni] * gv);
        }
    }
}

__device__ __forceinline__ void phase11(const Params& p, char* lds) {
    const int tid = VTID, lane = tid & 63, wid = tid >> 6;
    for (int tok = VBLK * 4 + wid; tok < NT; tok += VGRID * 4) {
        const int b = tok >> 12, t = tok & 4095;
        float* xr = p.out + (long)tok * ND;
        const bf16_t* xb2 = wsp<bf16_t>(p, OFF_X2B) + (long)tok * ND;
        f32x4 v[4];
#pragma unroll
        for (int i = 0; i < 4; i++) {
            const u32x2 w = *(const u32x2*)(xb2 + i * 256 + lane * 4);
            v[i] = (f32x4){__uint_as_float(w.x << 16), __uint_as_float(w.x & 0xFFFF0000u), __uint_as_float(w.y << 16), __uint_as_float(w.y & 0xFFFF0000u)};
        }
        for (int e = 0; e < NE; e++) {
            const int sl = wsp<int>(p, OFF_SLOTS)[(long)(b * NE + e) * NS + t];
            if (sl >= 0) {
                const bf16_t* yr = wsp<bf16_t>(p, OFF_Y) + ((long)(e * NB + b) * CAP + sl) * ND;
#pragma unroll
                for (int i = 0; i < 4; i++) {
                    const u32x2 w = *(const u32x2*)(yr + i * 256 + lane * 4);
                    v[i][0] += __uint_as_float(w.x << 16); v[i][1] += __uint_as_float(w.x & 0xFFFF0000u);
                    v[i][2] += __uint_as_float(w.y << 16); v[i][3] += __uint_as_float(w.y & 0xFFFF0000u);
                }
            }
        }
        float ss = 0.f;
#pragma unroll
        for (int i = 0; i < 4; i++) ss += v[i][0] * v[i][0] + v[i][1] * v[i][1] + v[i][2] * v[i][2] + v[i][3] * v[i][3];
        ss = wave_sum(ss);
        const float rs = rsqrtf(ss * (1.f / ND) + 1e-6f);
#pragma unroll
        for (int i = 0; i < 4; i++) {
            const f32x4 gf = *(const f32x4*)(p.g_final + i * 256 + lane * 4);
            *(f32x4*)(xr + i * 256 + lane * 4) = v[i] * rs * gf;
        }
    }
}


#define FOR_XCD_ITEMS_R(item, N) for (int _L = (int)(blockIdx.x >> 3), item; _L < (N) / 8 && ((item = (int)(blockIdx.x & 7) * ((N) / 8) + _L), true); _L += (int)(gridDim.x >> 3))
__device__ __forceinline__ void gemm_tile_256sq(const GemmTile& g, char* lds, f32x4 (&acc)[8][4]) {
    const int tid = threadIdx.x, lane = tid & 63, wid = tid >> 6, wm = wid >> 2, wn = wid & 3;
    const int lrow = lane >> 3, pc = lane & 7;
    const bf16_t* ap[4]; const bf16_t* bp[4];
#pragma unroll
    for (int i = 0; i < 4; i++) {
        const int r = (wid * 4 + i) * 8 + lrow;
        const int c = pc ^ ((r >> 1) & 7);
        const long ro = g.arow ? (long)g.arow[r] * g.lda : (long)r * g.lda;
        ap[i] = g.A + ro + c * 8;
        bp[i] = g.Bt + (long)r * g.ldb + c * 8;
    }
#pragma unroll
    for (int mi = 0; mi < 8; mi++)
#pragma unroll
        for (int ni = 0; ni < 4; ni++) acc[mi][ni] = (f32x4){0.f, 0.f, 0.f, 0.f};
    const int nk = g.K >> 6;
    auto stage = [&](int kt, char* st) {
#pragma unroll
        for (int i = 0; i < 4; i++) {
            __builtin_amdgcn_global_load_lds((const unsigned*)(ap[i] + kt * 64), (unsigned*)(st + (wid * 4 + i) * 1024), 16, 0, 0);
            __builtin_amdgcn_global_load_lds((const unsigned*)(bp[i] + kt * 64), (unsigned*)(st + 32768 + (wid * 4 + i) * 1024), 16, 0, 0);
        }
    };
    __syncthreads();
    stage(0, lds);
    asm volatile("s_waitcnt vmcnt(0)" ::: "memory");
    __syncthreads();
    for (int kt = 0; kt < nk; kt++) {
        char* cur = lds + (kt & 1) * 65536;
        if (kt + 1 < nk) stage(kt + 1, lds + ((kt + 1) & 1) * 65536);
#pragma unroll
        for (int ks = 0; ks < 2; ks++) {
            bf16x8 af[8], bfr[4];
#pragma unroll
            for (int i = 0; i < 8; i++) af[i] = *(const bf16x8*)(cur + tile_off(wm * 128 + i * 16 + (lane & 15), ks * 4 + (lane >> 4)));
#pragma unroll
            for (int i = 0; i < 4; i++) bfr[i] = *(const bf16x8*)(cur + 32768 + tile_off(wn * 64 + i * 16 + (lane & 15), ks * 4 + (lane >> 4)));
            __builtin_amdgcn_s_setprio(1);
#pragma unroll
            for (int mi = 0; mi < 8; mi++)
#pragma unroll
                for (int ni = 0; ni < 4; ni++)
                    acc[mi][ni] = __builtin_amdgcn_mfma_f32_16x16x32_bf16(bfr[ni], af[mi], acc[mi][ni], 0, 0, 0);
            __builtin_amdgcn_s_setprio(0);
        }
        asm volatile("s_waitcnt vmcnt(0)" ::: "memory");
        __syncthreads();
    }
}

__device__ __forceinline__ void phase_resid8(const Params& p, char* lds, size_t offA, size_t offW, const float* residf, const bf16_t* residb, size_t offXb, size_t offSS) {
    const int tid = threadIdx.x, lane = tid & 63, wid = tid >> 6, wm = wid >> 2, wn = wid & 3, lq = lane >> 4, lr = lane & 15;
    FOR_XCD_ITEMS_R(item, 64 * 4) {
        const int tm = item >> 2, tn = item & 3;
        f32x4 acc[8][4];
        GemmTile g; g.A = wsp<bf16_t>(p, offA) + (long)tm * 256 * ND; g.lda = ND; g.arow = nullptr;
        g.Bt = wsp<bf16_t>(p, offW) + (long)tn * 256 * ND; g.ldb = ND; g.K = ND;
        gemm_tile_256sq(g, lds, acc);
#pragma unroll
        for (int mi = 0; mi < 8; mi++) {
            const int row = tm * 256 + wm * 128 + mi * 16 + lr;
            float ss = 0.f;
#pragma unroll
            for (int ni = 0; ni < 4; ni++) {
                const long o = (long)row * ND + tn * 256 + wn * 64 + ni * 16 + 4 * lq;
                f32x4 rv;
                if (residf) rv = *(const f32x4*)(residf + o);
                else { const u32x2 w = *(const u32x2*)(residb + o); rv = (f32x4){__uint_as_float(w.x << 16), __uint_as_float(w.x & 0xFFFF0000u), __uint_as_float(w.y << 16), __uint_as_float(w.y & 0xFFFF0000u)}; }
                const f32x4 v = rv + acc[mi][ni];
                *(u32x2*)(wsp<bf16_t>(p, offXb) + o) = pack4bf(v);
                ss += v[0] * v[0] + v[1] * v[1] + v[2] * v[2] + v[3] * v[3];
            }
            ss += __shfl_xor(ss, 16); ss += __shfl_xor(ss, 32);
            if (lq == 0) wsp<float>(p, offSS)[row * 16 + tn * 4 + wn] = ss;
        }
    }
}
__device__ __forceinline__ void phase5a8(const Params& p, char* lds) {
    const int tid = threadIdx.x, lane = tid & 63, wid = tid >> 6, wm = wid >> 2, wn = wid & 3, lq = lane >> 4, lr = lane & 15;
    FOR_XCD_ITEMS_R(item, 64 * 4) {
        const int tm = item >> 2, tn = item & 3;
        f32x4 acc[8][4];
        GemmTile g; g.A = wsp<bf16_t>(p, OFF_X1B) + (long)tm * 256 * ND; g.lda = ND; g.arow = nullptr;
        g.Bt = wsp<bf16_t>(p, OFF_WMQT) + (long)tn * 256 * ND; g.ldb = ND; g.K = ND;
        gemm_tile_256sq(g, lds, acc);
#pragma unroll
        for (int mi = 0; mi < 8; mi++) {
            const int row = tm * 256 + wm * 128 + mi * 16 + lr, b = row >> 12, s = row & 4095;
            const float rs = row_rs16(wsp<float>(p, OFF_SS1) + (long)row * 16) * (0.0625f * 1.4426950408889634f);
            bf16_t* qd = wsp<bf16_t>(p, OFF_QM) + ((long)(b * 4 + tn) * NS + s) * 256 + wn * 64 + 4 * lq;
#pragma unroll
            for (int ni = 0; ni < 4; ni++) *(u32x2*)(qd + ni * 16) = pack4bf(acc[mi][ni] * rs);
        }
    }
}


__device__ __forceinline__ void phase9_8(const Params& p, char* lds) {
    const int tid = threadIdx.x, lane = tid & 63, wid = tid >> 6, wm = wid >> 2, wn = wid & 3, lq = lane >> 4, lr = lane & 15;
    FOR_XCD_ITEMS_R(item, NE * 8 * NB * 2) {
        const int rt = item & 1, b = (item >> 1) & 3, ct = (item >> 3) & 7, e = item >> 6;
        const int* arow = wsp<int>(p, OFF_IDX) + (long)(b * NE + e) * CAP + rt * 256;
        f32x4 acc[8][4];
        GemmTile g; g.A = wsp<bf16_t>(p, OFF_X2B); g.lda = ND; g.arow = arow;
        g.Bt = wsp<bf16_t>(p, OFF_WGUT) + ((long)e * 2048 + ct * 256) * ND; g.ldb = ND; g.K = ND;
        gemm_tile_256sq(g, lds, acc);
#pragma unroll
        for (int mi = 0; mi < 8; mi++) {
            const int r = wm * 128 + mi * 16 + lr;
            const int tok = arow[r];
            const float rs = row_rs16(wsp<float>(p, OFF_SS2) + (long)tok * 16);
            bf16_t* ad = wsp<bf16_t>(p, OFF_ACT) + ((long)(e * NB + b) * CAP + rt * 256 + r) * ND + ct * 128 + wn * 32 + 4 * lq;
#pragma unroll
            for (int pp = 0; pp < 2; pp++) {
                f32x4 o;
#pragma unroll
                for (int q = 0; q < 4; q++) {
                    const float ga = acc[mi][2 * pp][q] * rs, up = acc[mi][2 * pp + 1][q] * rs;
                    o[q] = ga / (1.f + __expf(-ga)) * up;
                }
                *(u32x2*)(ad + pp * 16) = pack4bf(o);
            }
        }
    }
}
__device__ __forceinline__ void phase10_8(const Params& p, char* lds) {
    const int tid = threadIdx.x, lane = tid & 63, wid = tid >> 6, wm = wid >> 2, wn = wid & 3, lq = lane >> 4, lr = lane & 15;
    FOR_XCD_ITEMS_R(item, NE * 4 * NB * 2) {
        const int rt = item & 1, b = (item >> 1) & 3, ct = (item >> 3) & 3, e = item >> 5;
        const long row0 = (long)(e * NB + b) * CAP + rt * 256;
        f32x4 acc[8][4];
        GemmTile g; g.A = wsp<bf16_t>(p, OFF_ACT) + row0 * ND; g.lda = ND; g.arow = nullptr;
        g.Bt = wsp<bf16_t>(p, OFF_WDT) + ((long)e * 1024 + ct * 256) * ND; g.ldb = ND; g.K = ND;
        gemm_tile_256sq(g, lds, acc);
        const float* gate = wsp<float>(p, OFF_GATE) + (long)(b * NE + e) * CAP + rt * 256;
#pragma unroll
        for (int mi = 0; mi < 8; mi++) {
            const int r = wm * 128 + mi * 16 + lr;
            const float gv = gate[r];
            bf16_t* yd = wsp<bf16_t>(p, OFF_Y) + (row0 + r) * ND + ct * 256 + wn * 64 + 4 * lq;
#pragma unroll
            for (int ni = 0; ni < 4; ni++) *(u32x2*)(yd + ni * 16) = pack4bf(acc[mi][ni] * gv);
        }
    }
}


__device__ __forceinline__ void phase1_big(const Params& p, char* lds) {
    const int tid = threadIdx.x, lane = tid & 63, wid = tid >> 6, wm = wid >> 2, wn = wid & 3, lq = lane >> 4, lr = lane & 15;
    FOR_XCD_ITEMS_R(item, 64 * 4) {
        const int tm = item >> 2, tn = item & 3;
        f32x4 acc[8][4];
        GemmTile g; g.A = wsp<bf16_t>(p, OFF_XB) + (long)tm * 256 * ND; g.lda = ND; g.arow = nullptr;
        g.Bt = wsp<bf16_t>(p, OFF_W1T) + (long)tn * 256 * ND; g.ldb = ND; g.K = ND;
        gemm_tile_256sq(g, lds, acc);
        const float* r0 = wsp<float>(p, OFF_R0);
        const int col0 = tn * 256 + wn * 64;
#pragma unroll
        for (int mi = 0; mi < 8; mi++) {
            const int row = tm * 256 + wm * 128 + mi * 16 + lr;
            const float rs = r0[row];
#pragma unroll
            for (int ni = 0; ni < 4; ni++) acc[mi][ni] *= rs;
            if (col0 < 512) {
#pragma unroll
                for (int ni = 0; ni < 4; ni++)
                    *(u32x2*)(wsp<bf16_t>(p, OFF_UF) + (long)row * 512 + col0 + ni * 16 + 4 * lq) = pack4bf(acc[mi][ni]);
            } else {
                float ss = 0.f;
#pragma unroll
                for (int ni = 0; ni < 4; ni++) { const f32x4 v = acc[mi][ni]; ss += v[0] * v[0] + v[1] * v[1] + v[2] * v[2] + v[3] * v[3]; }
                ss += __shfl_xor(ss, 16); ss += __shfl_xor(ss, 32);
                if (col0 < 896) {
#pragma unroll
                    for (int ni = 0; ni < 4; ni++)
                        *(u32x2*)(wsp<bf16_t>(p, OFF_UQ) + (long)row * 384 + (col0 - 512) + ni * 16 + 4 * lq) = pack4bf(acc[mi][ni]);
                    if (lq == 0) wsp<float>(p, OFF_SSQ)[row * 6 + ((col0 - 512) >> 6)] = ss;
                } else {
#pragma unroll
                    for (int ni = 0; ni < 4; ni++)
                        *(u32x2*)(wsp<bf16_t>(p, OFF_UKV) + (long)row * 256 + (col0 - 896) + ni * 16 + 4 * lq) = pack4bf(acc[mi][ni]);
                    if (lq == 0) wsp<float>(p, OFF_SSKV)[row * 4 + ((col0 - 896) >> 6)] = ss;
                }
            }
        }
    }
}


__device__ __forceinline__ void phase3_attn8(const Params& p, char* lds) {
    FOR_XCD_ITEMS_R(item, NB * 8 * (NS / 256)) {
        const int qt = item & 15, h = (item >> 4) & 7, b = item >> 7;
        const bf16_t* Qp = wsp<bf16_t>(p, OFF_Q) + ((long)(b * 8 + h) * NS + qt * 256) * 96;
        const bf16_t* Kp = wsp<bf16_t>(p, OFF_K) + ((long)(b * 8 + h) * NS) * 96;
        const bf16_t* Vtp = wsp<bf16_t>(p, OFF_VT) + ((long)(b * 8 + h) * 64) * NS;
        bf16_t* Op = wsp<bf16_t>(p, OFF_ZA) + ((long)b * NS + qt * 256) * 1024 + 512 + h * 64;
        attn_block<96, 64, 64, 512>(Qp, Kp, Vtp, (long)NS, NS, lds, [&](int q, int dv, f32x4 v) { *(u32x2*)(Op + (long)q * 1024 + dv) = pack4bf(v); });
    }
}
__device__ __forceinline__ void phase5b_8(const Params& p, char* lds) {
    FOR_XCD_ITEMS_R(item, NB * 4 * 16 * 2) {
        const int dvh = item & 1, qt = (item >> 1) & 15, h = (item >> 5) & 3, b = item >> 7;
        const bf16_t* Qp = wsp<bf16_t>(p, OFF_QM) + ((long)(b * 4 + h) * NS + qt * 256) * 256;
        const bf16_t* Kp = wsp<bf16_t>(p, OFF_KMEM) + ((long)(b * 4 + h) * 256) * 256;
        const bf16_t* Vtp = wsp<bf16_t>(p, OFF_VTMEM) + ((long)(b * 4 + h) * 256 + dvh * 128) * 256;
        bf16_t* Op = wsp<bf16_t>(p, OFF_OM) + ((long)b * NS + qt * 256) * 1024 + h * 256 + dvh * 128;
        attn_block<256, 128, 32, 512>(Qp, Kp, Vtp, 256L, 256, lds, [&](int q, int dv, f32x4 v) { *(u32x2*)(Op + (long)q * 1024 + dv) = pack4bf(v); });
    }
}

__global__ void __launch_bounds__(512, 1) k_fwd(Params p, int ph_lo, int ph_hi) {
    extern __shared__ __attribute__((aligned(16))) char lds_all[];
    char* lds = lds_all + VHALF * LDS_HALF;
    volatile LAS unsigned* st = (volatile LAS unsigned*)(lds_all + LDS_MAIN);
    if (threadIdx.x == 0) { st[0] = 0u; st[1] = 0u; }
    __syncthreads();
    XcdBarrier bar = xcd_barrier_post(wsp<unsigned>(p, OFF_BAR), st);
#if USE_CG_SYNC
#define GRID_BARRIER() do { asm volatile("s_waitcnt vmcnt(0)" ::: "memory"); __syncthreads(); cg::this_grid().sync(); asm volatile("s_waitcnt vmcnt(0)" ::: "memory"); __syncthreads(); } while (0)
#else
#define GRID_BARRIER() xcd_barrier(bar)
#endif
#define RUN_PHASE(k, call) if (ph_lo <= (k) && (k) < ph_hi) { if ((k) > ph_lo) { GRID_BARRIER(); } call; }
    RUN_PHASE(0, phase0(p, lds))
    RUN_PHASE(1, (phase1_big(p, lds_all), phase1(p, lds)))
    RUN_PHASE(2, phase2(p, lds))
    RUN_PHASE(3, ((blockIdx.x & 1) ? phase3_tr(p, lds) : (void)0, phase3_attn8(p, lds_all), phase3_f2b(p, lds), (blockIdx.x & 1) ? (void)0 : phase3_tr(p, lds)))
    RUN_PHASE(4, phase_resid8(p, lds_all, OFF_ZA, OFF_WOUTT, p.x, nullptr, OFF_X1B, OFF_SS1))
    RUN_PHASE(5, phase5a8(p, lds_all))
    RUN_PHASE(6, phase5b_8(p, lds_all))
    RUN_PHASE(7, phase_resid8(p, lds_all, OFF_OM, OFF_WMOT, nullptr, wsp<bf16_t>(p, OFF_X1B), OFF_X2B, OFF_SS2))
    RUN_PHASE(8, phase7(p, lds))
    RUN_PHASE(9, phase8(p, lds))
    RUN_PHASE(10, phase9_8(p, lds_all))
    RUN_PHASE(11, phase10_8(p, lds_all))
    RUN_PHASE(12, phase11(p, lds))
}

extern "C" void kernel_launch(void* const* d_in, const int* in_sizes, int n_in,
                              void* d_out, int out_size, void* d_ws, size_t ws_size,
                              hipStream_t stream) {
    static int grid = 0;
    if (grid == 0) {
        if (n_in != 22 || ws_size < WS_END) { fprintf(stderr, "kernel_launch: unexpected inputs (n_in %d, ws %zu < %zu)\n", n_in, ws_size, (size_t)WS_END); grid = -1; return; }
        int dev = 0, cus = 0, per_cu = 0;
        (void)hipGetDevice(&dev);
        (void)hipDeviceGetAttribute(&cus, hipDeviceAttributeMultiprocessorCount, dev);
        if (hipFuncSetAttribute((const void*)k_fwd, hipFuncAttributeMaxDynamicSharedMemorySize, LDS_TOTAL) != hipSuccess) { fprintf(stderr, "kernel_launch: hipFuncSetAttribute failed\n"); grid = -1; return; }
        if (hipOccupancyMaxActiveBlocksPerMultiprocessor(&per_cu, (const void*)k_fwd, 512, LDS_TOTAL) != hipSuccess || per_cu < 1) { fprintf(stderr, "kernel_launch: occupancy query failed (%d)\n", per_cu); (void)hipGetLastError(); per_cu = 1; }
        if (per_cu > 1) per_cu = 1;
        grid = cus * per_cu;
        fprintf(stderr, "kernel_launch: %d CUs x %d blocks\n", cus, per_cu);
    }
    if (grid < 0) return;
    Params p{};
    p.x = (const float*)d_in[0]; p.mem = (const float*)d_in[1]; p.pos = (const int*)d_in[2];
    p.g_mix = (const float*)d_in[3]; p.w_in = (const float*)d_in[4]; p.g_q_lat = (const float*)d_in[5]; p.w_q_up = (const float*)d_in[6];
    p.g_kv_lat = (const float*)d_in[7]; p.w_kv_up = (const float*)d_in[8]; p.w_fourier = (const float*)d_in[9]; p.w_out = (const float*)d_in[10];
    p.g_mem_q = (const float*)d_in[11]; p.g_mem_kv = (const float*)d_in[12]; p.w_mem_q = (const float*)d_in[13]; p.w_mem_kv = (const float*)d_in[14];
    p.w_mem_o = (const float*)d_in[15]; p.g_ffn = (const float*)d_in[16]; p.w_router = (const float*)d_in[17];
    p.w_exp_gate = (const float*)d_in[18]; p.w_exp_up = (const float*)d_in[19]; p.w_exp_down = (const float*)d_in[20]; p.g_final = (const float*)d_in[21];
    p.out = (float*)d_out; p.ws = (char*)d_ws;
    static const int cuts[] = MK_CUTS;
    const int ncut = (int)(sizeof(cuts) / sizeof(int));
    for (int li = 0; li + 1 < ncut; li++) {
        (void)hipMemsetAsync((char*)d_ws + OFF_BAR, 0, 16384, stream);
        int lo = cuts[li], hi = cuts[li + 1];
        void* args[] = {&p, &lo, &hi};
        hipError_t e = hipLaunchCooperativeKernel((const void*)k_fwd, dim3(grid), dim3(512), args, LDS_TOTAL, stream);
        if (e != hipSuccess) fprintf(stderr, "cooperative launch failed: %s (grid %d)\n", hipGetErrorString(e), grid);
    }
}
```

```cpp
#include <hip/hip_runtime.h>
#include <stdint.h>
#include <cstdio>
#include <hip/hip_cooperative_groups.h>
namespace cg = cooperative_groups;
#ifndef USE_CG_SYNC
#define USE_CG_SYNC 0
#endif

#ifndef MK_CUTS
#define MK_CUTS {0, 13}
#endif

#define NB 4
#define NS 4096
#define ND 1024
#define NT (NB * NS)
#define INW 1184
#define NE 16
#define CAP 512
#define MEML 256
#define NPHASE 13
#define VTID ((int)(threadIdx.x & 255))
#define VHALF (__builtin_amdgcn_readfirstlane((int)(threadIdx.x >> 8)))
#define VBLK ((int)(blockIdx.x * 2) + VHALF)
#define VGRID ((int)(gridDim.x * 2))

typedef unsigned short bf16_t;
typedef short bf16x8 __attribute__((ext_vector_type(8)));
typedef float f32x4 __attribute__((ext_vector_type(4)));
typedef float f32x16 __attribute__((ext_vector_type(16)));
typedef unsigned u32x4 __attribute__((ext_vector_type(4)));
typedef unsigned u32x2 __attribute__((ext_vector_type(2)));

__device__ __forceinline__ unsigned f2bf(float f) {
    unsigned u = __float_as_uint(f);
    u += 0x7FFFu + ((u >> 16) & 1u);
    return u >> 16;
}
typedef __bf16 hbf2 __attribute__((ext_vector_type(2)));
typedef float f32x2 __attribute__((ext_vector_type(2)));
__device__ __forceinline__ unsigned pack2bf(float lo, float hi) { f32x2 v = {lo, hi}; return __builtin_bit_cast(unsigned, __builtin_convertvector(v, hbf2)); }
__device__ __forceinline__ float bf2f(unsigned short b) { return __uint_as_float(((unsigned)b) << 16); }

__device__ __forceinline__ int tile_off(int row, int chunk) { return row * 128 + ((chunk ^ ((row >> 1) & 7)) << 4); }

#define GT_LDS_BYTES 65536

struct GemmTile { const bf16_t* A; long lda; const int* arow; const bf16_t* Bt; long ldb; int K; };

__device__ __forceinline__ void gemm_tile_128(const GemmTile& g, char* lds, f32x4 (&acc)[4][4]) {
    const int tid = VTID, lane = tid & 63, wid = tid >> 6, wm = wid >> 1, wn = wid & 1;
    const int lrow = lane >> 3, pc = lane & 7;
    const bf16_t* ap[4]; const bf16_t* bp[4];
#pragma unroll
    for (int i = 0; i < 4; i++) {
        const int r = (wid * 4 + i) * 8 + lrow;
        const int c = pc ^ ((r >> 1) & 7);
        const long ro = g.arow ? (long)g.arow[r] * g.lda : (long)r * g.lda;
        ap[i] = g.A + ro + c * 8;
        bp[i] = g.Bt + (long)r * g.ldb + c * 8;
    }
#pragma unroll
    for (int mi = 0; mi < 4; mi++)
#pragma unroll
        for (int ni = 0; ni < 4; ni++) acc[mi][ni] = (f32x4){0.f, 0.f, 0.f, 0.f};
    const int nk = g.K >> 6;
    auto stage = [&](int kt, char* st) {
#pragma unroll
        for (int i = 0; i < 4; i++) {
            __builtin_amdgcn_global_load_lds((const unsigned*)(ap[i] + kt * 64), (unsigned*)(st + (wid * 4 + i) * 1024), 16, 0, 0);
            __builtin_amdgcn_global_load_lds((const unsigned*)(bp[i] + kt * 64), (unsigned*)(st + 16384 + (wid * 4 + i) * 1024), 16, 0, 0);
        }
    };
    __syncthreads();
    stage(0, lds);
    asm volatile("s_waitcnt vmcnt(0)" ::: "memory");
    __syncthreads();
    for (int kt = 0; kt < nk; kt++) {
        char* cur = lds + (kt & 1) * 32768;
        if (kt + 1 < nk) stage(kt + 1, lds + ((kt + 1) & 1) * 32768);
        bf16x8 af[2][4], bfr[2][4];
#pragma unroll
        for (int ks = 0; ks < 2; ks++)
#pragma unroll
            for (int i = 0; i < 4; i++) {
                af[ks][i] = *(const bf16x8*)(cur + tile_off(wm * 64 + i * 16 + (lane & 15), ks * 4 + (lane >> 4)));
                bfr[ks][i] = *(const bf16x8*)(cur + 16384 + tile_off(wn * 64 + i * 16 + (lane & 15), ks * 4 + (lane >> 4)));
            }
        __builtin_amdgcn_s_setprio(1);
#pragma unroll
        for (int ks = 0; ks < 2; ks++)
#pragma unroll
            for (int mi = 0; mi < 4; mi++)
#pragma unroll
                for (int ni = 0; ni < 4; ni++)
                    acc[mi][ni] = __builtin_amdgcn_mfma_f32_16x16x32_bf16(bfr[ks][ni], af[ks][mi], acc[mi][ni], 0, 0, 0);
        __builtin_amdgcn_s_setprio(0);
        asm volatile("s_waitcnt vmcnt(0)" ::: "memory");
        __syncthreads();
    }
}

template <int DQK, int DVT, int KT>
struct AttnCfg {
    static constexpr int KROW = DQK * 2 + 16;
    static constexpr int VROW = KT * 2 + 8;
    static constexpr int KBYTES = KT * KROW;
    static constexpr int VBYTES = DVT * VROW;
    static constexpr int STAGE = KBYTES + VBYTES;
    static constexpr int LDS = 2 * STAGE;
};

template <int DQK, int DVT, int KT, int NTH, class Out>
__device__ __forceinline__ void attn_block(const bf16_t* Qp, const bf16_t* Kp, const bf16_t* Vtp, long ldv, int nk, char* lds, Out&& out) {
    typedef AttnCfg<DQK, DVT, KT> C;
    constexpr int NKS = DQK / 16, NST = KT / 32, NDT = DVT / 32, NPS = KT / 16;
    constexpr int KCPR = DQK / 8;
    constexpr int KTOT = KT * KCPR, KCH = (KTOT + NTH - 1) / NTH;
    constexpr int VCPR = KT / 8;
    constexpr int VTOT = DVT * VCPR, VCH = (VTOT + NTH - 1) / NTH;
    const int tid = NTH == 512 ? (int)threadIdx.x : VTID, lane = tid & 63, wid = tid >> 6, h = lane >> 5, c = lane & 31;

    bf16x8 qf[NKS];
    {
        const bf16_t* qrow = Qp + (long)(wid * 32 + c) * DQK + 8 * h;
#pragma unroll
        for (int ks = 0; ks < NKS; ks++) qf[ks] = *(const bf16x8*)(qrow + 16 * ks);
    }
    f32x16 o[NDT];
#pragma unroll
    for (int dt = 0; dt < NDT; dt++)
#pragma unroll
        for (int r = 0; r < 16; r++) o[dt][r] = 0.f;
    float m = 0.f, l = 0.f;

    u32x4 kr[KCH], vr[VCH];
    auto gload = [&](int t) {
#pragma unroll
        for (int i = 0; i < KCH; i++) {
            const int ci = tid + NTH * i, row = ci / KCPR, cc = ci % KCPR;
            if (KTOT % NTH == 0 || ci < KTOT) kr[i] = *(const u32x4*)(Kp + (long)(t * KT + row) * DQK + cc * 8);
        }
#pragma unroll
        for (int i = 0; i < VCH; i++) {
            const int ci = tid + NTH * i, row = ci / VCPR, cc = ci % VCPR;
            if (VTOT % NTH == 0 || ci < VTOT) vr[i] = *(const u32x4*)(Vtp + (long)row * ldv + t * KT + cc * 8);
        }
    };
    auto lwrite = [&](char* st) {
#pragma unroll
        for (int i = 0; i < KCH; i++) {
            const int ci = tid + NTH * i, row = ci / KCPR, cc = ci % KCPR;
            if (KTOT % NTH == 0 || ci < KTOT) *(u32x4*)(st + row * C::KROW + cc * 16) = kr[i];
        }
#pragma unroll
        for (int i = 0; i < VCH; i++) {
            const int ci = tid + NTH * i, row = ci / VCPR, cc = ci % VCPR;
            if (VTOT % NTH == 0 || ci < VTOT) {
                char* p = st + C::KBYTES + row * C::VROW + cc * 16;
                *(u32x2*)(p) = (u32x2){vr[i].x, vr[i].y};
                *(u32x2*)(p + 8) = (u32x2){vr[i].z, vr[i].w};
            }
        }
    };
    const int nt = nk / KT;
    gload(0);
    __syncthreads();
    lwrite(lds);
    __syncthreads();
    for (int t = 0; t < nt; t++) {
        char* cur = lds + (t & 1) * C::STAGE;
        if (t + 1 < nt) gload(t + 1);
        f32x16 s[NST];
        const float negm = -m;
#pragma unroll
        for (int st = 0; st < NST; st++) {
#pragma unroll
            for (int r = 0; r < 16; r++) s[st][r] = negm;
#pragma unroll
            for (int ks = 0; ks < NKS; ks++) {
                const bf16x8 kf = *(const bf16x8*)(cur + (st * 32 + c) * C::KROW + ks * 32 + h * 16);
                s[st] = __builtin_amdgcn_mfma_f32_32x32x16_bf16(kf, qf[ks], s[st], 0, 0, 0);
            }
        }
        float mx = s[0][0];
#pragma unroll
        for (int st = 0; st < NST; st++)
#pragma unroll
            for (int r = 0; r < 16; r++) mx = fmaxf(mx, s[st][r]);
        mx = fmaxf(mx, __shfl_xor(mx, 32));
        if (__any(mx > 8.0f)) {
            const float d = fmaxf(mx, 0.f);
            const float alpha = __builtin_amdgcn_exp2f(-d);
            m += d;
            l *= alpha;
#pragma unroll
            for (int dt = 0; dt < NDT; dt++)
#pragma unroll
                for (int r = 0; r < 16; r++) o[dt][r] *= alpha;
#pragma unroll
            for (int st = 0; st < NST; st++)
#pragma unroll
                for (int r = 0; r < 16; r++) s[st][r] -= d;
        }
        float rs = 0.f;
#pragma unroll
        for (int st = 0; st < NST; st++)
#pragma unroll
            for (int r = 0; r < 16; r++) { const float p = __builtin_amdgcn_exp2f(s[st][r]); rs += p; s[st][r] = p; }
        l += rs;
#pragma unroll
        for (int ps = 0; ps < NPS; ps++) {
            const int st = ps >> 1, u = ps & 1;
            u32x4 pw;
            pw.x = pack2bf(s[st][8 * u + 0], s[st][8 * u + 1]);
            pw.y = pack2bf(s[st][8 * u + 2], s[st][8 * u + 3]);
            pw.z = pack2bf(s[st][8 * u + 4], s[st][8 * u + 5]);
            pw.w = pack2bf(s[st][8 * u + 6], s[st][8 * u + 7]);
            const bf16x8 pf = __builtin_bit_cast(bf16x8, pw);
#pragma unroll
            for (int dt = 0; dt < NDT; dt++) {
                const char* vp = cur + C::KBYTES + (dt * 32 + c) * C::VROW + (ps * 16 + 4 * h) * 2;
                const u32x2 v0 = *(const u32x2*)(vp);
                const u32x2 v1 = *(const u32x2*)(vp + 16);
                const bf16x8 vf = __builtin_bit_cast(bf16x8, ((u32x4){v0.x, v0.y, v1.x, v1.y}));
                o[dt] = __builtin_amdgcn_mfma_f32_32x32x16_bf16(vf, pf, o[dt], 0, 0, 0);
            }
        }
        if (t + 1 < nt) lwrite(lds + ((t + 1) & 1) * C::STAGE);
        __syncthreads();
    }
    l += __shfl_xor(l, 32);
    const float inv = 1.f / l;
#pragma unroll
    for (int dt = 0; dt < NDT; dt++)
#pragma unroll
        for (int g4 = 0; g4 < 4; g4++) {
            f32x4 v = {o[dt][4 * g4 + 0] * inv, o[dt][4 * g4 + 1] * inv, o[dt][4 * g4 + 2] * inv, o[dt][4 * g4 + 3] * inv};
            out(wid * 32 + c, dt * 32 + 8 * g4 + 4 * h, v);
        }
}


constexpr size_t SLOT = 33554432;
constexpr size_t OFF_W1T = 0;
constexpr size_t OFF_WQT = OFF_W1T + 1280UL * 1024 * 2;
constexpr size_t OFF_WKVT = OFF_WQT + 768UL * 384 * 2;
constexpr size_t OFF_WOUTT = OFF_WKVT + 1024UL * 256 * 2;
constexpr size_t OFF_WMQT = OFF_WOUTT + 1024UL * 1024 * 2;
constexpr size_t OFF_WMKVT = OFF_WMQT + 1024UL * 1024 * 2;
constexpr size_t OFF_WMOT = OFF_WMKVT + 2048UL * 1024 * 2;
constexpr size_t OFF_WGUT = OFF_WMOT + 1024UL * 1024 * 2;
constexpr size_t OFF_WDT = OFF_WGUT + 16UL * 2048 * 1024 * 2;
constexpr size_t OFF_T64 = OFF_WDT + 16UL * 1024 * 1024 * 2;
constexpr size_t OFF_M1 = OFF_T64 + 16384;
constexpr size_t OFF_M3 = OFF_M1 + 32768;
constexpr size_t OFF_WFT = OFF_M3 + 16384;
constexpr size_t OFF_TW = OFF_WFT + 65536;
constexpr size_t OFF_ROPE = OFF_TW + 32768;
constexpr size_t OFF_R0 = OFF_ROPE + (size_t)NT * 16 * 8;
constexpr size_t OFF_RMEM = OFF_R0 + (size_t)NT * 4;
constexpr size_t OFF_SSQ = OFF_RMEM + 4096;
constexpr size_t OFF_SSKV = OFF_SSQ + (size_t)NT * 6 * 4;
constexpr size_t OFF_SS1 = OFF_SSKV + (size_t)NT * 4 * 4;
constexpr size_t OFF_SS2 = OFF_SS1 + (size_t)NT * 16 * 4;
constexpr size_t OFF_AFF = OFF_SS2 + (size_t)NT * 16 * 4;
constexpr size_t OFF_SLOTS = OFF_AFF + (size_t)NT * 16 * 4;
constexpr size_t OFF_IDX = OFF_SLOTS + 4UL * 16 * 4096 * 4;
constexpr size_t OFF_GATE = OFF_IDX + 4UL * 16 * 512 * 4;
constexpr size_t OFF_MEMB = OFF_GATE + 4UL * 16 * 512 * 4;
constexpr size_t OFF_KMEM = OFF_MEMB + 1024UL * 1024 * 2;
constexpr size_t OFF_VTMEM = OFF_KMEM + 1024UL * 1024 * 2;
constexpr size_t OFF_KR = OFF_VTMEM + 1024UL * 1024 * 2;
constexpr size_t OFF_BAR = OFF_KR + (size_t)NT * 32 * 2;
constexpr size_t OFF_S0 = (OFF_BAR + 16384 + 255) / 256 * 256;
constexpr size_t OFF_S1 = OFF_S0 + SLOT;
constexpr size_t OFF_S2 = OFF_S1 + SLOT;
constexpr size_t OFF_S3 = OFF_S2 + SLOT;
constexpr size_t OFF_S4 = OFF_S3 + SLOT;
constexpr size_t WS_END = OFF_S4 + SLOT;
static_assert(WS_END <= 300964352UL, "workspace map exceeds the guaranteed scratch size");
constexpr size_t OFF_XB = OFF_S0, OFF_YR = OFF_S0, OFF_YI = OFF_S0 + SLOT / 2, OFF_X1B = OFF_S3, OFF_OM = OFF_S0, OFF_ACT = OFF_S0;
constexpr size_t OFF_UF = OFF_S1, OFF_UQ = OFF_S1 + (size_t)NT * 512 * 2, OFF_ZA = OFF_S1, OFF_QM = OFF_S1;
constexpr size_t OFF_Q = OFF_S2, OFF_UKV = OFF_S2 + (size_t)NT * 768 * 2, OFF_X2B = OFF_S2;
constexpr size_t OFF_K = OFF_S3, OFF_Y = OFF_S3;
constexpr size_t OFF_VT = OFF_S4;

struct Params {
    const float *x, *mem; const int* pos;
    const float *g_mix, *w_in, *g_q_lat, *w_q_up, *g_kv_lat, *w_kv_up, *w_fourier, *w_out, *g_mem_q, *g_mem_kv, *w_mem_q, *w_mem_kv, *w_mem_o,
        *g_ffn, *w_router, *w_exp_gate, *w_exp_up, *w_exp_down, *g_final;
    float* out; char* ws;
};
template <class T> __device__ __forceinline__ T* wsp(const Params& p, size_t off) { return (T*)(p.ws + off); }

#define LDS_HALF 65536
#define LDS_MAIN 131072
#define LDS_TOTAL (LDS_MAIN + 16)
#define LAS __attribute__((address_space(3)))

#define XB_TMO      128
#define XB_XCNT(j)  (256  + 64 * (j))
#define XB_XSUB(j)  (1280 + 64 * (j))
#define XB_XGEN(j)  (2304 + 64 * (j))
#define XB_TOP      3328
#define XB_TOPGEN   3392
#define XCD_BAR_WORDS 3456
#define XB_SPIN_CAP (1u << 25)
__device__ __forceinline__ unsigned xb_ld(unsigned* p)              { return __hip_atomic_load(p, __ATOMIC_RELAXED, __HIP_MEMORY_SCOPE_AGENT); }
__device__ __forceinline__ unsigned xb_add(unsigned* p, unsigned v) { return __hip_atomic_fetch_add(p, v, __ATOMIC_RELAXED, __HIP_MEMORY_SCOPE_AGENT); }
__device__ __forceinline__ unsigned xb_xcc_id() { return (unsigned)__builtin_amdgcn_s_getreg((3 << 11) | 20) & 0xFu; }
#define XB_SPIN(cond, bar) do { unsigned _sp = 0; while (cond) { __builtin_amdgcn_s_sleep(1); \
    if ((++_sp & 255u) == 0u) { if (xb_ld(&(bar)[XB_TMO])) break; if (_sp > XB_SPIN_CAP) { atomicAdd(&(bar)[XB_TMO], 1u); break; } } } } while (0)
struct XcdBarrier { unsigned* bar; unsigned x; volatile LAS unsigned* st; };
__device__ __forceinline__ XcdBarrier xcd_barrier_post(unsigned* bar, volatile LAS unsigned* st) {
    XcdBarrier b; b.bar = bar; b.x = xb_xcc_id(); b.st = st;
    if (threadIdx.x == 0) (void)xb_add(&bar[XB_XCNT(b.x)], 1u);
    return b;
}
__device__ __forceinline__ void xcd_barrier_complete(unsigned* bar, unsigned x, unsigned& nloc, unsigned& nx) {
    const unsigned G = gridDim.x * gridDim.y * gridDim.z;
    unsigned sum, cnt, mine, sp = 0u;
    for (;;) {
        sum = 0u; cnt = 0u; mine = 0u;
#pragma unroll
        for (unsigned j = 0; j < 16; ++j) { const unsigned c = xb_ld(&bar[XB_XCNT(j)]); sum += c; cnt += (c > 0u) ? 1u : 0u; mine = (j == x) ? c : mine; }
        if (sum == G) break;
        __builtin_amdgcn_s_sleep(1);
        if ((++sp & 255u) == 0u) { if (xb_ld(&bar[XB_TMO])) break; if (sp > XB_SPIN_CAP) { atomicAdd(&bar[XB_TMO], 1u); break; } }
    }
    nloc = mine > 0u ? mine : 1u; nx = cnt > 0u ? cnt : 1u;
}
__device__ __forceinline__ void xcd_barrier(const XcdBarrier& b) {
    asm volatile("s_waitcnt vmcnt(0)" ::: "memory");
    __syncthreads();
    if (threadIdx.x == 0) {
        unsigned* bar = b.bar;
        __builtin_amdgcn_s_waitcnt(0);
        unsigned nloc = b.st[0], nx = b.st[1];
        if (nloc == 0u) { xcd_barrier_complete(bar, b.x, nloc, nx); b.st[0] = nloc; b.st[1] = nx; }
        const unsigned old = xb_add(&bar[XB_XSUB(b.x)], 1u);
        const unsigned gen = old / nloc;
        if (old + 1u == (gen + 1u) * nloc) {
            __builtin_amdgcn_fence(__ATOMIC_RELEASE, "agent");
            asm volatile("s_waitcnt vmcnt(0)" ::: "memory");
            const unsigned og = xb_add(&bar[XB_TOP], 1u);
            const unsigned tg = og / nx;
            if (og + 1u == (tg + 1u) * nx) xb_add(&bar[XB_TOPGEN], 1u);
            else XB_SPIN(xb_ld(&bar[XB_TOPGEN]) == tg, bar);
            __builtin_amdgcn_fence(__ATOMIC_ACQUIRE, "agent");
            xb_add(&bar[XB_XGEN(b.x)], 1u);
            asm volatile("s_waitcnt vmcnt(0)" ::: "memory");
        } else {
            XB_SPIN(xb_ld(&bar[XB_XGEN(b.x)]) == gen, bar);
            __builtin_amdgcn_fence(__ATOMIC_ACQUIRE, "agent");
            asm volatile("s_waitcnt vmcnt(0)" ::: "memory");
        }
    }
    __syncthreads();
}

#define FOR_XCD_ITEMS(item, N) for (int _L = (int)((blockIdx.x >> 3) << 1) | VHALF, item; _L < (N) / 8 && ((item = (int)(blockIdx.x & 7) * ((N) / 8) + _L), true); _L += (int)(gridDim.x >> 2))

__device__ __forceinline__ u32x2 pack4bf(float a, float b, float c, float d) { return (u32x2){pack2bf(a, b), pack2bf(c, d)}; }
__device__ __forceinline__ u32x2 pack4bf(f32x4 v) { return (u32x2){pack2bf(v[0], v[1]), pack2bf(v[2], v[3])}; }
__device__ __forceinline__ float wave_sum(float v) {
#pragma unroll
    for (int o = 32; o > 0; o >>= 1) v += __shfl_xor(v, o);
    return v;
}

__device__ __forceinline__ void tr_tile(const float* W, long ldw, int k0, int n0, int nvalid, const float* gain, bf16_t* Wt, long ldt, int mode, char* lds) {
    float (*t)[132] = (float (*)[132])lds;
    const int tid = VTID, c4 = tid & 31, r0 = tid >> 5;
    f32x4 v[8];
#pragma unroll
    for (int i = 0; i < 8; i++) {
        const int kk = r0 + 8 * i, n = n0 + c4 * 4;
        v[i] = (n < nvalid) ? *(const f32x4*)(W + (long)(k0 + kk) * ldw + n) : (f32x4){0.f, 0.f, 0.f, 0.f};
        if (gain) v[i] *= gain[k0 + kk];
    }
    __syncthreads();
#pragma unroll
    for (int i = 0; i < 8; i++) *(f32x4*)(&t[r0 + 8 * i][c4 * 4]) = v[i];
    __syncthreads();
#pragma unroll
    for (int i = 0; i < 4; i++) {
        const int ci = tid + 256 * i, nn = ci >> 3, kc = ci & 7;
        const int n = n0 + nn;
        int row = n;
        if (mode) row = (n >> 5) * 64 + ((n >> 4) & 1) * 32 + (mode - 1) * 16 + (n & 15);
        u32x4 w;
        w.x = pack2bf(t[kc * 8 + 0][nn], t[kc * 8 + 1][nn]);
        w.y = pack2bf(t[kc * 8 + 2][nn], t[kc * 8 + 3][nn]);
        w.z = pack2bf(t[kc * 8 + 4][nn], t[kc * 8 + 5][nn]);
        w.w = pack2bf(t[kc * 8 + 6][nn], t[kc * 8 + 7][nn]);
        *(u32x4*)(Wt + (long)row * ldt + k0 + kc * 8) = w;
    }
}

__device__ __forceinline__ void phase0(const Params& p, char* lds) {
    constexpr int J_W1 = 160, J_WQ = 36, J_WKV = 32, J_WOUT = 128, J_WMQ = 128, J_WMKV = 256, J_WMO = 128, J_WG = 0, J_WU = 0, J_WD = 0;
    constexpr int J_TR = J_W1 + J_WQ + J_WKV + J_WOUT + J_WMQ + J_WMKV + J_WMO + J_WG + J_WU + J_WD;
    constexpr int J_XR = NT / 4, J_MR = 1024 / 4, J_ROPE = NT * 16 / 256, J_TAB = (4096 + 8192 + 16384 + 8192 + 32768) / 256;
    constexpr int J_ALL = J_TR + J_XR + J_MR + J_ROPE + J_TAB;
    const int tid = VTID, lane = tid & 63, wid = tid >> 6;
    const double PI2 = 6.283185307179586476925286766559;
    for (int job = VBLK; job < J_ALL; job += VGRID) {
        int j = job;
        if (j < J_TR) {
            if (j < J_W1) { tr_tile(p.w_in, INW, (j / 10) * 64, (j % 10) * 128, INW, p.g_mix, wsp<bf16_t>(p, OFF_W1T), 1024, 0, lds); continue; } j -= J_W1;
            if (j < J_WQ) { tr_tile(p.w_q_up, 768, (j / 6) * 64, (j % 6) * 128, 768, p.g_q_lat, wsp<bf16_t>(p, OFF_WQT), 384, 0, lds); continue; } j -= J_WQ;
            if (j < J_WKV) { tr_tile(p.w_kv_up, 1024, (j / 8) * 64, (j % 8) * 128, 1024, p.g_kv_lat, wsp<bf16_t>(p, OFF_WKVT), 256, 0, lds); continue; } j -= J_WKV;
            if (j < J_WOUT) { tr_tile(p.w_out, 1024, (j / 8) * 64, (j % 8) * 128, 1024, nullptr, wsp<bf16_t>(p, OFF_WOUTT), 1024, 0, lds); continue; } j -= J_WOUT;
            if (j < J_WMQ) { tr_tile(p.w_mem_q, 1024, (j / 8) * 64, (j % 8) * 128, 1024, p.g_mem_q, wsp<bf16_t>(p, OFF_WMQT), 1024, 0, lds); continue; } j -= J_WMQ;
            if (j < J_WMKV) { tr_tile(p.w_mem_kv, 2048, (j / 16) * 64, (j % 16) * 128, 2048, p.g_mem_kv, wsp<bf16_t>(p, OFF_WMKVT), 1024, 0, lds); continue; } j -= J_WMKV;
            if (j < J_WMO) { tr_tile(p.w_mem_o, 1024, (j / 8) * 64, (j % 8) * 128, 1024, nullptr, wsp<bf16_t>(p, OFF_WMOT), 1024, 0, lds); continue; } j -= J_WMO;
            if (j < J_WG) { const int e = j >> 7, r = j & 127; tr_tile(p.w_exp_gate + (long)e * 1048576, 1024, (r / 8) * 64, (r % 8) * 128, 1024, p.g_ffn, wsp<bf16_t>(p, OFF_WGUT) + (long)e * 2048 * 1024, 1024, 1, lds); continue; } j -= J_WG;
            if (j < J_WU) { const int e = j >> 7, r = j & 127; tr_tile(p.w_exp_up + (long)e * 1048576, 1024, (r / 8) * 64, (r % 8) * 128, 1024, p.g_ffn, wsp<bf16_t>(p, OFF_WGUT) + (long)e * 2048 * 1024, 1024, 2, lds); continue; } j -= J_WU;
            { const int e = j >> 7, r = j & 127; tr_tile(p.w_exp_down + (long)e * 1048576, 1024, (r / 8) * 64, (r % 8) * 128, 1024, nullptr, wsp<bf16_t>(p, OFF_WDT) + (long)e * 1048576, 1024, 0, lds); continue; }
        }
        j -= J_TR;
        if (j < J_XR + J_MR) {
            const bool isx = j < J_XR;
            const int row = (isx ? j : j - J_XR) * 4 + wid;
            const float* src = (isx ? p.x : p.mem) + (long)row * ND;
            bf16_t* dst = (isx ? wsp<bf16_t>(p, OFF_XB) : wsp<bf16_t>(p, OFF_MEMB)) + (long)row * ND;
            float ss = 0.f;
#pragma unroll
            for (int i = 0; i < 4; i++) {
                const f32x4 v = *(const f32x4*)(src + i * 256 + lane * 4);
                ss += v[0] * v[0] + v[1] * v[1] + v[2] * v[2] + v[3] * v[3];
                *(u32x2*)(dst + i * 256 + lane * 4) = pack4bf(v);
            }
            ss = wave_sum(ss);
            if (lane == 0) (isx ? wsp<float>(p, OFF_R0) : wsp<float>(p, OFF_RMEM))[row] = rsqrtf(ss * (1.f / ND) + 1e-6f);
            continue;
        }
        j -= J_XR + J_MR;
        if (j < J_ROPE) {
            const int i = j * 256 + tid; const int t = i >> 4, jj = i & 15;
            const double f = pow(10000.0, -(double)(2 * jj) / 32.0);
            const double ang = (double)p.pos[t] * f;
            wsp<float2>(p, OFF_ROPE)[i] = make_float2((float)cos(ang), (float)sin(ang));
            continue;
        }
        j -= J_ROPE;
        {
            int i = j * 256 + tid;
            if (i < 4096) { const double a = PI2 * (double)i / 4096.0; wsp<float2>(p, OFF_TW)[i] = make_float2((float)cos(a), (float)sin(a)); continue; } i -= 4096;
            if (i < 8192) {
                const int T = i >> 12, a = (i >> 6) & 63, b = i & 63;
                const double th = PI2 * (double)((a * b) & 63) / 64.0;
                wsp<bf16_t>(p, OFF_T64)[i] = (bf16_t)f2bf((float)(T ? sin(th) : cos(th))); continue;
            } i -= 8192;
            if (i < 16384) {
                const int rho = i >> 7, k = i & 127;
                const int wm = rho >> 6, mi = (rho >> 4) & 3, lr = rho & 15, ri = mi >> 1, k1 = 32 * wm + 16 * (mi & 1) + lr, ab = k >> 6, s1 = k & 63;
                const double th = PI2 * (double)((k1 * s1) & 63) / 64.0;
                const double c = cos(th), s = sin(th);
                const double v = ri == 0 ? (ab == 0 ? c : -s) : (ab == 0 ? s : c);
                wsp<bf16_t>(p, OFF_M1)[i] = (bf16_t)f2bf((float)v); continue;
            } i -= 16384;
            if (i < 8192) {
                const int k2 = i >> 7, k = i & 127, s2 = k & 63;
                const double th = PI2 * (double)((k2 * s2) & 63) / 64.0;
                wsp<bf16_t>(p, OFF_M3)[i] = (bf16_t)f2bf((float)(k < 64 ? cos(th) : -sin(th))); continue;
            } i -= 8192;
            if (i < 32768) {
                const int g = i >> 12, e = (i >> 6) & 63, ch = i & 63;
                wsp<bf16_t>(p, OFF_WFT)[i] = (bf16_t)f2bf(p.w_fourier[(g * 64 + ch) * 64 + e]); continue;
            }
        }
    }
}

#define FOR_XCD_ITEMS_R(item, N) for (int _L = (int)(blockIdx.x >> 3), item; _L < (N) / 8 && ((item = (int)(blockIdx.x & 7) * ((N) / 8) + _L), true); _L += (int)(gridDim.x >> 3))
__device__ __forceinline__ void gemm_tile_256sq(const GemmTile& g, char* lds, f32x4 (&acc)[8][4]) {
    const int tid = threadIdx.x, lane = tid & 63, wid = tid >> 6, wm = wid >> 2, wn = wid & 3;
    const int lrow = lane >> 3, pc = lane & 7;
    const bf16_t* ap[4]; const bf16_t* bp[4];
#pragma unroll
    for (int i = 0; i < 4; i++) {
        const int r = (wid * 4 + i) * 8 + lrow;
        const int c = pc ^ ((r >> 1) & 7);
        const long ro = g.arow ? (long)g.arow[r] * g.lda : (long)r * g.lda;
        ap[i] = g.A + ro + c * 8;
        bp[i] = g.Bt + (long)r * g.ldb + c * 8;
    }
#pragma unroll
    for (int mi = 0; mi < 8; mi++)
#pragma unroll
        for (int ni = 0; ni < 4; ni++) acc[mi][ni] = (f32x4){0.f, 0.f, 0.f, 0.f};
    const int nk = g.K >> 6;
    auto stage = [&](int kt, char* st) {
#pragma unroll
        for (int i = 0; i < 4; i++) {
            __builtin_amdgcn_global_load_lds((const unsigned*)(ap[i] + kt * 64), (unsigned*)(st + (wid * 4 + i) * 1024), 16, 0, 0);
            __builtin_amdgcn_global_load_lds((const unsigned*)(bp[i] + kt * 64), (unsigned*)(st + 32768 + (wid * 4 + i) * 1024), 16, 0, 0);
        }
    };
    __syncthreads();
    stage(0, lds);
    asm volatile("s_waitcnt vmcnt(0)" ::: "memory");
    __syncthreads();
    for (int kt = 0; kt < nk; kt++) {
        char* cur = lds + (kt & 1) * 65536;
        if (kt + 1 < nk) stage(kt + 1, lds + ((kt + 1) & 1) * 65536);
#pragma unroll
        for (int ks = 0; ks < 2; ks++) {
            bf16x8 af[8], bfr[4];
#pragma unroll
            for (int i = 0; i < 8; i++) af[i] = *(const bf16x8*)(cur + tile_off(wm * 128 + i * 16 + (lane & 15), ks * 4 + (lane >> 4)));
#pragma unroll
            for (int i = 0; i < 4; i++) bfr[i] = *(const bf16x8*)(cur + 32768 + tile_off(wn * 64 + i * 16 + (lane & 15), ks * 4 + (lane >> 4)));
            __builtin_amdgcn_s_setprio(1);
#pragma unroll
            for (int mi = 0; mi < 8; mi++)
#pragma unroll
                for (int ni = 0; ni < 4; ni++)
                    acc[mi][ni] = __builtin_amdgcn_mfma_f32_16x16x32_bf16(bfr[ni], af[mi], acc[mi][ni], 0, 0, 0);
            __builtin_amdgcn_s_setprio(0);
        }
        asm volatile("s_waitcnt vmcnt(0)" ::: "memory");
        __syncthreads();
    }
}


__device__ __forceinline__ void gemm_tile_256x128(const GemmTile& g, char* lds, f32x4 (&acc)[4][4]) {
    const int tid = threadIdx.x, lane = tid & 63, wid = tid >> 6, wm = wid >> 1, wn = wid & 1;
    const int lrow = lane >> 3, pc = lane & 7;
    const bf16_t* ap[4]; const bf16_t* bp[2];
#pragma unroll
    for (int i = 0; i < 4; i++) {
        const int r = (wid * 4 + i) * 8 + lrow;
        const int c = pc ^ ((r >> 1) & 7);
        const long ro = g.arow ? (long)g.arow[r] * g.lda : (long)r * g.lda;
        ap[i] = g.A + ro + c * 8;
    }
#pragma unroll
    for (int i = 0; i < 2; i++) {
        const int r = (wid * 2 + i) * 8 + lrow;
        const int c = pc ^ ((r >> 1) & 7);
        bp[i] = g.Bt + (long)r * g.ldb + c * 8;
    }
#pragma unroll
    for (int mi = 0; mi < 4; mi++)
#pragma unroll
        for (int ni = 0; ni < 4; ni++) acc[mi][ni] = (f32x4){0.f, 0.f, 0.f, 0.f};
    const int nk = g.K >> 6;
    auto stage = [&](int kt, char* st) {
#pragma unroll
        for (int i = 0; i < 4; i++)
            __builtin_amdgcn_global_load_lds((const unsigned*)(ap[i] + kt * 64), (unsigned*)(st + (wid * 4 + i) * 1024), 16, 0, 0);
#pragma unroll
        for (int i = 0; i < 2; i++)
            __builtin_amdgcn_global_load_lds((const unsigned*)(bp[i] + kt * 64), (unsigned*)(st + 32768 + (wid * 2 + i) * 1024), 16, 0, 0);
    };
    __syncthreads();
    stage(0, lds);
    asm volatile("s_waitcnt vmcnt(0)" ::: "memory");
    __syncthreads();
    for (int kt = 0; kt < nk; kt++) {
        char* cur = lds + (kt & 1) * 49152;
        if (kt + 1 < nk) stage(kt + 1, lds + ((kt + 1) & 1) * 49152);
        bf16x8 af[2][4], bfr[2][4];
#pragma unroll
        for (int ks = 0; ks < 2; ks++)
#pragma unroll
            for (int i = 0; i < 4; i++) {
                af[ks][i] = *(const bf16x8*)(cur + tile_off(wm * 64 + i * 16 + (lane & 15), ks * 4 + (lane >> 4)));
                bfr[ks][i] = *(const bf16x8*)(cur + 32768 + tile_off(wn * 64 + i * 16 + (lane & 15), ks * 4 + (lane >> 4)));
            }
        __builtin_amdgcn_s_setprio(1);
#pragma unroll
        for (int ks = 0; ks < 2; ks++)
#pragma unroll
            for (int mi = 0; mi < 4; mi++)
#pragma unroll
                for (int ni = 0; ni < 4; ni++)
                    acc[mi][ni] = __builtin_amdgcn_mfma_f32_16x16x32_bf16(bfr[ks][ni], af[ks][mi], acc[mi][ni], 0, 0, 0);
        __builtin_amdgcn_s_setprio(0);
        asm volatile("s_waitcnt vmcnt(0)" ::: "memory");
        __syncthreads();
    }
}


__device__ __forceinline__ void phase1(const Params& p, char* lds) {
    const int tid = threadIdx.x, lane = tid & 63, wid = tid >> 6, wm = wid >> 1, wn = wid & 1, lq = lane >> 4, lr = lane & 15;
    constexpr int N_U = 64 * 2, N_M = 4 * 16;
    {
      FOR_XCD_ITEMS_R(item, N_U) {
        f32x4 acc[4][4];
        {
            const int tm = item >> 1, tn = 8 + (item & 1);
            GemmTile g; g.A = wsp<bf16_t>(p, OFF_XB) + (long)tm * 256 * ND; g.lda = ND; g.arow = nullptr;
            g.Bt = wsp<bf16_t>(p, OFF_W1T) + (long)tn * 128 * ND; g.ldb = ND; g.K = ND;
            gemm_tile_256x128(g, lds, acc);
            const float* r0 = wsp<float>(p, OFF_R0);
#pragma unroll
            for (int mi = 0; mi < 4; mi++) {
                const int row = tm * 256 + wm * 64 + mi * 16 + lr;
                const float rs = r0[row];
#pragma unroll
                for (int ni = 0; ni < 4; ni++) acc[mi][ni] *= rs;
                if (tn < 4) {
#pragma unroll
                    for (int ni = 0; ni < 4; ni++)
                        *(u32x2*)(wsp<bf16_t>(p, OFF_UF) + (long)row * 512 + tn * 128 + wn * 64 + ni * 16 + 4 * lq) = pack4bf(acc[mi][ni]);
                } else if (tn < 9) {
                    float ss = 0.f;
#pragma unroll
                    for (int ni = 0; ni < 4; ni++) { const f32x4 v = acc[mi][ni]; ss += v[0] * v[0] + v[1] * v[1] + v[2] * v[2] + v[3] * v[3]; }
                    ss += __shfl_xor(ss, 16); ss += __shfl_xor(ss, 32);
                    if (tn < 7) {
#pragma unroll
                        for (int ni = 0; ni < 4; ni++)
                            *(u32x2*)(wsp<bf16_t>(p, OFF_UQ) + (long)row * 384 + (tn - 4) * 128 + wn * 64 + ni * 16 + 4 * lq) = pack4bf(acc[mi][ni]);
                        if (lq == 0) wsp<float>(p, OFF_SSQ)[row * 6 + (tn - 4) * 2 + wn] = ss;
                    } else {
#pragma unroll
                        for (int ni = 0; ni < 4; ni++)
                            *(u32x2*)(wsp<bf16_t>(p, OFF_UKV) + (long)row * 256 + (tn - 7) * 128 + wn * 64 + ni * 16 + 4 * lq) = pack4bf(acc[mi][ni]);
                        if (lq == 0) wsp<float>(p, OFF_SSKV)[row * 4 + (tn - 7) * 2 + wn] = ss;
                    }
                } else if (wn == 0) {
                    const float2* rp = wsp<float2>(p, OFF_ROPE) + (long)row * 16 + 4 * lq;
                    f32x4 o1, o2;
#pragma unroll
                    for (int r = 0; r < 4; r++) {
                        const float2 cs = rp[r];
                        const float x1 = acc[mi][0][r], x2 = acc[mi][1][r];
                        o1[r] = x1 * cs.x - x2 * cs.y; o2[r] = x1 * cs.y + x2 * cs.x;
                    }
                    bf16_t* kr = wsp<bf16_t>(p, OFF_KR) + (long)row * 32;
                    *(u32x2*)(kr + 4 * lq) = pack4bf(o1);
                    *(u32x2*)(kr + 16 + 4 * lq) = pack4bf(o2);
                }
            }
        }
      }
      FOR_XCD_ITEMS_R(it, N_M) {
        f32x4 acc[4][4];
        {
            const int tm = it / 16, tn = it % 16;
            GemmTile g; g.A = wsp<bf16_t>(p, OFF_MEMB) + (long)tm * 256 * ND; g.lda = ND; g.arow = nullptr;
            g.Bt = wsp<bf16_t>(p, OFF_WMKVT) + (long)tn * 128 * ND; g.ldb = ND; g.K = ND;
            gemm_tile_256x128(g, lds, acc);
            const float* rm = wsp<float>(p, OFF_RMEM);
#pragma unroll
            for (int mi = 0; mi < 4; mi++) {
                const int row = tm * 256 + wm * 64 + mi * 16 + lr;
                const int b = row >> 8, m = row & 255;
                const float rs = rm[row];
#pragma unroll
                for (int ni = 0; ni < 4; ni++) {
                    const f32x4 v = acc[mi][ni] * rs;
                    const int col = tn * 128 + wn * 64 + ni * 16 + 4 * lq;
                    if (col < 1024) {
                        const int h = col >> 8, d = col & 255;
                        *(u32x2*)(wsp<bf16_t>(p, OFF_KMEM) + ((long)(b * 4 + h) * 256 + m) * 256 + d) = pack4bf(v);
                    } else {
                        const int c2 = col - 1024, h = c2 >> 8, dv = c2 & 255;
                        bf16_t* vt = wsp<bf16_t>(p, OFF_VTMEM) + ((long)(b * 4 + h) * 256 + dv) * 256 + m;
#pragma unroll
                        for (int r = 0; r < 4; r++) vt[r * 256] = (bf16_t)f2bf(v[r]);
                    }
                }
            }
        }
      }
    }
}

template <int MI>
__device__ __forceinline__ void dft_mma(const bf16_t* Ag, int arow0, const char* ximg, int ncol0, f32x4 (&acc)[MI][4]) {
    const int lane = VTID & 63, lq = lane >> 4, lr = lane & 15;
#pragma unroll
    for (int ks = 0; ks < 4; ks++) {
        bf16x8 af[MI], bfr[4];
#pragma unroll
        for (int mi = 0; mi < MI; mi++) af[mi] = *(const bf16x8*)(Ag + (long)(arow0 + mi * 16 + lr) * 128 + ks * 32 + lq * 8);
#pragma unroll
        for (int ni = 0; ni < 4; ni++) {
            const char* bp = ximg + (ks * 32 + lq * 8) * 272 + (ncol0 + ni * 16 + lr) * 2;
#pragma unroll
            for (int j = 0; j < 8; j++) bfr[ni][j] = *(const short*)(bp + j * 272);
        }
#pragma unroll
        for (int mi = 0; mi < MI; mi++)
#pragma unroll
            for (int ni = 0; ni < 4; ni++) acc[mi][ni] = __builtin_amdgcn_mfma_f32_16x16x32_bf16(bfr[ni], af[mi], acc[mi][ni], 0, 0, 0);
    }
}

__device__ __forceinline__ void f2a_item(const Params& p, int it, char* lds) {
    const int tid = VTID, lane = tid & 63, wid = tid >> 6, wm = wid >> 1, wn = wid & 1, lq = lane >> 4, lr = lane & 15;
    const int nc = it & 3, s2 = (it >> 2) & 63, b = it >> 8;
    char* uimg = lds; char* ximg = lds + 17408;
    __syncthreads();
#pragma unroll
    for (int i = 0; i < 4; i++) {
        const int ci = tid + 256 * i, row = ci >> 4, cc = ci & 15;
        *(u32x4*)(uimg + row * 272 + cc * 16) = *(const u32x4*)(wsp<bf16_t>(p, OFF_UF) + ((long)(b * NS + 64 * row + s2)) * 512 + nc * 128 + cc * 8);
    }
    __syncthreads();
    {
        const int g2 = wid >> 1, T = wid & 1;
        f32x4 a1[4][4];
#pragma unroll
        for (int mi = 0; mi < 4; mi++)
#pragma unroll
            for (int ni = 0; ni < 4; ni++) a1[mi][ni] = (f32x4){0.f, 0.f, 0.f, 0.f};
        const bf16_t* t64 = wsp<bf16_t>(p, OFF_T64) + T * 4096;
#pragma unroll
        for (int ks = 0; ks < 2; ks++) {
            bf16x8 af[4], bfr[4];
#pragma unroll
            for (int i = 0; i < 4; i++) {
                af[i] = *(const bf16x8*)(uimg + (i * 16 + lr) * 272 + (g2 * 64 + ks * 32 + lq * 8) * 2);
                bfr[i] = *(const bf16x8*)(t64 + (i * 16 + lr) * 64 + ks * 32 + lq * 8);
            }
#pragma unroll
            for (int mi = 0; mi < 4; mi++)
#pragma unroll
                for (int ni = 0; ni < 4; ni++) a1[mi][ni] = __builtin_amdgcn_mfma_f32_16x16x32_bf16(bfr[ni], af[mi], a1[mi][ni], 0, 0, 0);
        }
#pragma unroll
        for (int mi = 0; mi < 4; mi++)
#pragma unroll
            for (int ni = 0; ni < 4; ni++)
                *(u32x2*)(ximg + (T * 64 + mi * 16 + lr) * 272 + (g2 * 64 + ni * 16 + 4 * lq) * 2) = pack4bf(a1[mi][ni]);
    }
    __syncthreads();
    f32x4 acc[4][4];
#pragma unroll
    for (int mi = 0; mi < 4; mi++)
#pragma unroll
        for (int ni = 0; ni < 4; ni++) acc[mi][ni] = (f32x4){0.f, 0.f, 0.f, 0.f};
    dft_mma<4>(wsp<bf16_t>(p, OFF_M1), wm * 64, ximg, wn * 64, acc);
    const float2* tw = wsp<float2>(p, OFF_TW);
#pragma unroll
    for (int m2 = 0; m2 < 2; m2++) {
        const int k1 = 32 * wm + 16 * m2 + lr;
        float2 cs; { const float rev = (float)((s2 * k1) & 4095) * (1.0f / 4096.0f); cs.x = __builtin_amdgcn_cosf(rev); cs.y = __builtin_amdgcn_sinf(rev); (void)tw; }
        const long base = ((long)(b * 64 + k1) * 64 + s2) * 512 + nc * 128 + wn * 64 + 4 * lq;
#pragma unroll
        for (int ni = 0; ni < 4; ni++) {
            const f32x4 yr = acc[m2][ni], yi = acc[m2 + 2][ni];
            const f32x4 orr = yr * cs.x - yi * cs.y, oi = yi * cs.x + yr * cs.y;
            *(u32x2*)(wsp<bf16_t>(p, OFF_YR) + base + ni * 16) = pack4bf(orr);
            *(u32x2*)(wsp<bf16_t>(p, OFF_YI) + base + ni * 16) = pack4bf(oi);
        }
    }
}

__device__ __forceinline__ void f2b_item(const Params& p, int it, char* lds) {
    const int tid = VTID, lane = tid & 63, wid = tid >> 6, wm = wid >> 1, wn = wid & 1, lq = lane >> 4, lr = lane & 15;
    const int nc = it & 3, k1 = (it >> 2) & 63, b = it >> 8;
    char* ximg = lds; char* zimg = lds + 34816;
    __syncthreads();
#pragma unroll
    for (int i = 0; i < 8; i++) {
        const int ci = tid + 256 * i, row = ci >> 4, cc = ci & 15;
        const bf16_t* src = (row < 64 ? wsp<bf16_t>(p, OFF_YR) : wsp<bf16_t>(p, OFF_YI)) + ((long)(b * 64 + k1) * 64 + (row & 63)) * 512 + nc * 128 + cc * 8;
        *(u32x4*)(ximg + row * 272 + cc * 16) = *(const u32x4*)src;
    }
    __syncthreads();
    f32x4 acc[2][4];
#pragma unroll
    for (int mi = 0; mi < 2; mi++)
#pragma unroll
        for (int ni = 0; ni < 4; ni++) acc[mi][ni] = (f32x4){0.f, 0.f, 0.f, 0.f};
    dft_mma<2>(wsp<bf16_t>(p, OFF_M3), wm * 32, ximg, wn * 64, acc);
#pragma unroll
    for (int mi = 0; mi < 2; mi++)
#pragma unroll
        for (int ni = 0; ni < 4; ni++)
            *(u32x2*)(zimg + (wm * 32 + mi * 16 + lr) * 272 + (wn * 64 + ni * 16 + 4 * lq) * 2) = pack4bf(acc[mi][ni] * (1.0f / 512.0f));
    __syncthreads();
    f32x4 a3[2][4];
#pragma unroll
    for (int mi = 0; mi < 2; mi++)
#pragma unroll
        for (int ni = 0; ni < 4; ni++) a3[mi][ni] = (f32x4){0.f, 0.f, 0.f, 0.f};
    const bf16_t* wft = wsp<bf16_t>(p, OFF_WFT) + (long)(nc * 2 + wn) * 4096;
#pragma unroll
    for (int ks = 0; ks < 2; ks++) {
        bf16x8 af[2], bfr[4];
#pragma unroll
        for (int i = 0; i < 2; i++) af[i] = *(const bf16x8*)(zimg + (wm * 32 + i * 16 + lr) * 272 + (wn * 64 + ks * 32 + lq * 8) * 2);
#pragma unroll
        for (int i = 0; i < 4; i++) bfr[i] = *(const bf16x8*)(wft + (i * 16 + lr) * 64 + ks * 32 + lq * 8);
#pragma unroll
        for (int mi = 0; mi < 2; mi++)
#pragma unroll
            for (int ni = 0; ni < 4; ni++) a3[mi][ni] = __builtin_amdgcn_mfma_f32_16x16x32_bf16(bfr[ni], af[mi], a3[mi][ni], 0, 0, 0);
    }
#pragma unroll
    for (int mi = 0; mi < 2; mi++) {
        const int k2 = wm * 32 + mi * 16 + lr;
        bf16_t* dst = wsp<bf16_t>(p, OFF_ZA) + ((long)(b * NS + k1 + 64 * k2)) * 1024 + nc * 128 + wn * 64 + 4 * lq;
#pragma unroll
        for (int ni = 0; ni < 4; ni++) *(u32x2*)(dst + ni * 16) = pack4bf(a3[mi][ni]);
    }
}

__device__ __forceinline__ void phase2(const Params& p, char* lds) {
    const int tid = threadIdx.x, lane = tid & 63, wid = tid >> 6, wm = wid >> 1, wn = wid & 1, lq = lane >> 4, lr = lane & 15;
    constexpr int N_Q = 64 * 6, N_KV = 64 * 8;
    {
      FOR_XCD_ITEMS_R(item, N_Q) {
        f32x4 acc[4][4];
        {
            const int tm = item / 6, tn = item % 6;
            GemmTile g; g.A = wsp<bf16_t>(p, OFF_UQ) + (long)tm * 256 * 384; g.lda = 384; g.arow = nullptr;
            g.Bt = wsp<bf16_t>(p, OFF_WQT) + (long)tn * 128 * 384; g.ldb = 384; g.K = 384;
            gemm_tile_256x128(g, lds, acc);
            const float qmul = 0.10206207261596575f * 1.4426950408889634f;
#pragma unroll
            for (int mi = 0; mi < 4; mi++) {
                const int row = tm * 256 + wm * 64 + mi * 16 + lr;
                const int b = row >> 12, s = row & 4095;
                const float* sq = wsp<float>(p, OFF_SSQ) + (long)row * 6;
                const float ss = sq[0] + sq[1] + sq[2] + sq[3] + sq[4] + sq[5];
                const float rs = rsqrtf(ss * (1.f / 384.f) + 1e-6f) * qmul;
                const int cb0 = tn * 128 + wn * 64;
#pragma unroll
                for (int ni = 0; ni < 4; ni++) {
                    const int cb = cb0 + ni * 16, hd = cb / 96, hob = cb % 96;
                    bf16_t* qd = wsp<bf16_t>(p, OFF_Q) + ((long)(b * 8 + hd) * NS + s) * 96;
                    if (hob < 64) {
                        *(u32x2*)(qd + hob + 4 * lq) = pack4bf(acc[mi][ni] * rs);
                    } else if (hob == 64) {
                        if (ni < 3) {
                            const float2* rp = wsp<float2>(p, OFF_ROPE) + (long)row * 16 + 4 * lq;
                            f32x4 o1, o2;
#pragma unroll
                            for (int r = 0; r < 4; r++) {
                                const float2 cs = rp[r];
                                const float x1 = acc[mi][ni][r] * rs, x2 = acc[mi][ni < 3 ? ni + 1 : 3][r] * rs;
                                o1[r] = x1 * cs.x - x2 * cs.y; o2[r] = x1 * cs.y + x2 * cs.x;
                            }
                            *(u32x2*)(qd + 64 + 4 * lq) = pack4bf(o1);
                            *(u32x2*)(qd + 80 + 4 * lq) = pack4bf(o2);
                        }
                    }
                }
            }
        }
      }
      FOR_XCD_ITEMS_R(it, N_KV) {
        f32x4 acc[4][4];
        {
            const int tm = it >> 3, hd = it & 7;
            GemmTile g; g.A = wsp<bf16_t>(p, OFF_UKV) + (long)tm * 256 * 256; g.lda = 256; g.arow = nullptr;
            g.Bt = wsp<bf16_t>(p, OFF_WKVT) + (long)hd * 128 * 256; g.ldb = 256; g.K = 256;
            gemm_tile_256x128(g, lds, acc);
#pragma unroll
            for (int mi = 0; mi < 4; mi++) {
                const int row = tm * 256 + wm * 64 + mi * 16 + lr;
                const int b = row >> 12, s = row & 4095;
                const float* sq = wsp<float>(p, OFF_SSKV) + (long)row * 4;
                const float rs = rsqrtf((sq[0] + sq[1] + sq[2] + sq[3]) * (1.f / 256.f) + 1e-6f);
                if (wn == 0) {
                    bf16_t* kd = wsp<bf16_t>(p, OFF_K) + ((long)(b * 8 + hd) * NS + s) * 96;
#pragma unroll
                    for (int ni = 0; ni < 4; ni++) *(u32x2*)(kd + ni * 16 + 4 * lq) = pack4bf(acc[mi][ni] * rs);
                } else {
#pragma unroll
                    for (int ni = 0; ni < 4; ni++) {
                        bf16_t* vd = wsp<bf16_t>(p, OFF_VT) + ((long)(b * 8 + hd) * 64 + ni * 16 + 4 * lq) * NS + s;
#pragma unroll
                        for (int r = 0; r < 4; r++) vd[(long)r * NS] = (bf16_t)f2bf(acc[mi][ni][r] * rs);
                    }
                }
            }
#pragma unroll
            for (int i = 0; i < 2; i++) {
                const int ci = tid + 512 * i, r = ci >> 2, cc = ci & 3;
                const int row = tm * 256 + r, b = row >> 12, s = row & 4095;
                *(u32x4*)(wsp<bf16_t>(p, OFF_K) + ((long)(b * 8 + hd) * NS + s) * 96 + 64 + cc * 8) = *(const u32x4*)(wsp<bf16_t>(p, OFF_KR) + (long)row * 32 + cc * 8);
            }
        }
      }
    }
}


__device__ __forceinline__ void phase2_f2a(const Params& p, char* lds) {
    FOR_XCD_ITEMS(it, 1024) { f2a_item(p, it, lds); }
}

__device__ __forceinline__ void expert_tr_job(const Params& p, int j, char* lds) {
    const int which = j >> 11, r = j & 2047, e = r >> 7, t = r & 127;
    const int k0 = (t >> 3) * 64, n0 = (t & 7) * 128;
    if (which == 0) tr_tile(p.w_exp_gate + (long)e * 1048576, 1024, k0, n0, 1024, p.g_ffn, wsp<bf16_t>(p, OFF_WGUT) + (long)e * 2048 * 1024, 1024, 1, lds);
    else if (which == 1) tr_tile(p.w_exp_up + (long)e * 1048576, 1024, k0, n0, 1024, p.g_ffn, wsp<bf16_t>(p, OFF_WGUT) + (long)e * 2048 * 1024, 1024, 2, lds);
    else tr_tile(p.w_exp_down + (long)e * 1048576, 1024, k0, n0, 1024, nullptr, wsp<bf16_t>(p, OFF_WDT) + (long)e * 1048576, 1024, 0, lds);
}

__device__ __forceinline__ void phase3_tr(const Params& p, char* lds) {
    for (int j = VBLK; j < 6144; j += VGRID) expert_tr_job(p, j, lds);
}
__device__ __forceinline__ void phase3_f2b(const Params& p, char* lds) {
    FOR_XCD_ITEMS(it, 1024) { f2b_item(p, it, lds); }
}

__device__ __forceinline__ void phase_resid(const Params& p, char* lds, size_t offA, size_t offW, const float* residf, const bf16_t* residb, size_t offXb, size_t offSS) {
    const int tid = VTID, lane = tid & 63, wid = tid >> 6, wm = wid >> 1, wn = wid & 1, lq = lane >> 4, lr = lane & 15;
    FOR_XCD_ITEMS(item, 128 * 8) {
        const int tm = item >> 3, tn = item & 7;
        f32x4 acc[4][4];
        GemmTile g; g.A = wsp<bf16_t>(p, offA) + (long)tm * 128 * ND; g.lda = ND; g.arow = nullptr;
        g.Bt = wsp<bf16_t>(p, offW) + (long)tn * 128 * ND; g.ldb = ND; g.K = ND;
        gemm_tile_128(g, lds, acc);
#pragma unroll
        for (int mi = 0; mi < 4; mi++) {
            const int row = tm * 128 + wm * 64 + mi * 16 + lr;
            float ss = 0.f;
#pragma unroll
            for (int ni = 0; ni < 4; ni++) {
                const long o = (long)row * ND + tn * 128 + wn * 64 + ni * 16 + 4 * lq;
                f32x4 rv;
                if (residf) rv = *(const f32x4*)(residf + o);
                else { const u32x2 w = *(const u32x2*)(residb + o); rv = (f32x4){__uint_as_float(w.x << 16), __uint_as_float(w.x & 0xFFFF0000u), __uint_as_float(w.y << 16), __uint_as_float(w.y & 0xFFFF0000u)}; }
                const f32x4 v = rv + acc[mi][ni];
                *(u32x2*)(wsp<bf16_t>(p, offXb) + o) = pack4bf(v);
                ss += v[0] * v[0] + v[1] * v[1] + v[2] * v[2] + v[3] * v[3];
            }
            ss += __shfl_xor(ss, 16); ss += __shfl_xor(ss, 32);
            if (lq == 0) wsp<float>(p, offSS)[row * 16 + tn * 2 + wn] = ss;
        }
    }
}
__device__ __forceinline__ float row_rs16(const float* ss) {
    const f32x4 a = *(const f32x4*)ss, b = *(const f32x4*)(ss + 4), c = *(const f32x4*)(ss + 8), d = *(const f32x4*)(ss + 12);
    const f32x4 t = (a + b) + (c + d);
    return rsqrtf(((t[0] + t[1]) + (t[2] + t[3])) * (1.f / 1024.f) + 1e-6f);
}

__device__ __forceinline__ void phase5a(const Params& p, char* lds) {
    const int tid = VTID, lane = tid & 63, wid = tid >> 6, wm = wid >> 1, wn = wid & 1, lq = lane >> 4, lr = lane & 15;
    FOR_XCD_ITEMS(item, 128 * 8) {
        const int tm = item >> 3, tn = item & 7;
        f32x4 acc[4][4];
        GemmTile g; g.A = wsp<bf16_t>(p, OFF_X1B) + (long)tm * 128 * ND; g.lda = ND; g.arow = nullptr;
        g.Bt = wsp<bf16_t>(p, OFF_WMQT) + (long)tn * 128 * ND; g.ldb = ND; g.K = ND;
        gemm_tile_128(g, lds, acc);
        const int h = tn >> 1;
#pragma unroll
        for (int mi = 0; mi < 4; mi++) {
            const int row = tm * 128 + wm * 64 + mi * 16 + lr, b = row >> 12, s = row & 4095;
            const float rs = row_rs16(wsp<float>(p, OFF_SS1) + (long)row * 16) * (0.0625f * 1.4426950408889634f);
            bf16_t* qd = wsp<bf16_t>(p, OFF_QM) + ((long)(b * 4 + h) * NS + s) * 256 + (tn & 1) * 128 + wn * 64 + 4 * lq;
#pragma unroll
            for (int ni = 0; ni < 4; ni++) *(u32x2*)(qd + ni * 16) = pack4bf(acc[mi][ni] * rs);
        }
    }
}
__device__ __forceinline__ void phase5b(const Params& p, char* lds) {
    FOR_XCD_ITEMS(item, NB * 4 * 32 * 2) {
        const int dvh = item & 1, qt = (item >> 1) & 31, h = (item >> 6) & 3, b = item >> 8;
        const bf16_t* Qp = wsp<bf16_t>(p, OFF_QM) + ((long)(b * 4 + h) * NS + qt * 128) * 256;
        const bf16_t* Kp = wsp<bf16_t>(p, OFF_KMEM) + ((long)(b * 4 + h) * 256) * 256;
        const bf16_t* Vtp = wsp<bf16_t>(p, OFF_VTMEM) + ((long)(b * 4 + h) * 256 + dvh * 128) * 256;
        bf16_t* Op = wsp<bf16_t>(p, OFF_OM) + ((long)b * NS + qt * 128) * 1024 + h * 256 + dvh * 128;
        attn_block<256, 128, 32, 256>(Qp, Kp, Vtp, 256L, 256, lds, [&](int q, int dv, f32x4 v) { *(u32x2*)(Op + (long)q * 1024 + dv) = pack4bf(v); });
    }
}

__device__ __forceinline__ void phase7(const Params& p, char* lds) {
    const int tid = VTID, lane = tid & 63, wid = tid >> 6;
    float* wr = (float*)lds;
    __syncthreads();
    for (int i = tid; i < 16384; i += 256) { const int k = i >> 4, e = i & 15; wr[e * 1024 + k] = p.w_router[i] * p.g_ffn[k]; }
    __syncthreads();
    for (int tok = VBLK * 4 + wid; tok < NT; tok += VGRID * 4) {
        const bf16_t* xr = wsp<bf16_t>(p, OFF_X2B) + (long)tok * ND;
        float a[16];
#pragma unroll
        for (int e = 0; e < 16; e++) a[e] = 0.f;
#pragma unroll 2
        for (int j = 0; j < 8; j++) {
            const unsigned xw = *(const unsigned*)(xr + 2 * lane + 128 * j);
            const float x0 = __uint_as_float(xw << 16), x1 = __uint_as_float(xw & 0xFFFF0000u);
#pragma unroll
            for (int e = 0; e < 16; e++) {
                const f32x2 w = *(const f32x2*)(wr + e * 1024 + 2 * lane + 128 * j);
                a[e] += x0 * w[0] + x1 * w[1];
            }
        }
#pragma unroll
        for (int i = 0; i < 8; i++) { const bool hi = lane & 32; const float send = hi ? a[i] : a[i + 8], keep = hi ? a[i + 8] : a[i]; a[i] = keep + __shfl_xor(send, 32); }
#pragma unroll
        for (int i = 0; i < 4; i++) { const bool hi = lane & 16; const float send = hi ? a[i] : a[i + 4], keep = hi ? a[i + 4] : a[i]; a[i] = keep + __shfl_xor(send, 16); }
#pragma unroll
        for (int i = 0; i < 2; i++) { const bool hi = lane & 8; const float send = hi ? a[i] : a[i + 2], keep = hi ? a[i + 2] : a[i]; a[i] = keep + __shfl_xor(send, 8); }
        { const bool hi = lane & 4; const float send = hi ? a[0] : a[1], keep = hi ? a[1] : a[0]; a[0] = keep + __shfl_xor(send, 4); }
        float lg = a[0];
        lg += __shfl_xor(lg, 2); lg += __shfl_xor(lg, 1);
        const int e = ((lane >> 5) & 1) * 8 + ((lane >> 4) & 1) * 4 + ((lane >> 3) & 1) * 2 + ((lane >> 2) & 1);
        lg *= row_rs16(wsp<float>(p, OFF_SS2) + (long)tok * 16);
        float mx = lg;
#pragma unroll
        for (int o = 4; o < 64; o <<= 1) mx = fmaxf(mx, __shfl_xor(mx, o));
        const float ex = expf(lg - mx);
        float sm = ex;
#pragma unroll
        for (int o = 4; o < 64; o <<= 1) sm += __shfl_xor(sm, o);
        if ((lane & 3) == 0) wsp<float>(p, OFF_AFF)[(long)tok * 16 + e] = ex / sm;
    }
}

__device__ __forceinline__ int block_sum_i(int v, int* red) {
    const int lane = VTID & 63, wid = VTID >> 6;
#pragma unroll
    for (int o = 32; o > 0; o >>= 1) v += __shfl_xor(v, o);
    __syncthreads();
    if (lane == 0) red[wid] = v;
    __syncthreads();
    return red[0] + red[1] + red[2] + red[3];
}
__device__ __forceinline__ int block_excl_scan_i(int v, int* red, int& total) {
    const int lane = VTID & 63, wid = VTID >> 6;
    int inc = v;
#pragma unroll
    for (int o = 1; o < 64; o <<= 1) { const int t = __shfl_up(inc, o); if (lane >= o) inc += t; }
    __syncthreads();
    if (lane == 63) red[wid] = inc;
    __syncthreads();
    int base = 0;
#pragma unroll
    for (int w = 0; w < 4; w++) if (w < wid) base += red[w];
    total = red[0] + red[1] + red[2] + red[3];
    return base + inc - v;
}
__device__ __forceinline__ void phase8(const Params& p, char* lds) {
    int* red = (int*)lds;
    const int tid = VTID;
    for (int item = VBLK; item < NB * NE; item += VGRID) {
        const int e = item & 15, b = item >> 4;
        const float* aff = wsp<float>(p, OFF_AFF) + (long)b * NS * 16 + e;
        unsigned v[16];
#pragma unroll
        for (int i = 0; i < 16; i++) v[i] = __float_as_uint(aff[(long)(tid * 16 + i) * 16]);
        unsigned T = 0;
        for (int bit = 30; bit >= 0; bit--) {
            const unsigned cand = T | (1u << bit);
            int c = 0;
#pragma unroll
            for (int i = 0; i < 16; i++) c += (v[i] >= cand) ? 1 : 0;
            if (block_sum_i(c, red) >= CAP) T = cand;
        }
        int cg = 0, ce = 0;
#pragma unroll
        for (int i = 0; i < 16; i++) { cg += (v[i] > T) ? 1 : 0; ce += (v[i] == T) ? 1 : 0; }
        int tot;
        const int pk = block_excl_scan_i(cg | (ce << 16), red, tot);
        const int need = CAP - (tot & 0xFFFF);
        const int pe = pk >> 16;
        int nse = need - pe; nse = nse < 0 ? 0 : (nse > ce ? ce : nse);
        int tot2;
        int slot = block_excl_scan_i(cg + nse, red, tot2);
        int* slots = wsp<int>(p, OFF_SLOTS) + (long)(b * NE + e) * NS;
        int* idx = wsp<int>(p, OFF_IDX) + (long)(b * NE + e) * CAP;
        float* gate = wsp<float>(p, OFF_GATE) + (long)(b * NE + e) * CAP;
        int eqs = 0;
#pragma unroll
        for (int i = 0; i < 16; i++) {
            const int t = tid * 16 + i;
            bool sel = v[i] > T;
            if (v[i] == T) { sel = eqs < nse; eqs++; }
            if (sel) { slots[t] = slot; idx[slot] = b * NS + t; gate[slot] = __uint_as_float(v[i]); slot++; }
            else slots[t] = -1;
        }
    }
}

__device__ __forceinline__ void phase9(const Params& p, char* lds) {
    const int tid = VTID, lane = tid & 63, wid = tid >> 6, wm = wid >> 1, wn = wid & 1, lq = lane >> 4, lr = lane & 15;
    FOR_XCD_ITEMS(item, NE * 16 * NB * 4) {
        const int rt = item & 3, b = (item >> 2) & 3, ct = (item >> 4) & 15, e = item >> 8;
        const int* arow = wsp<int>(p, OFF_IDX) + (long)(b * NE + e) * CAP + rt * 128;
        f32x4 acc[4][4];
        GemmTile g; g.A = wsp<bf16_t>(p, OFF_X2B); g.lda = ND; g.arow = arow;
        g.Bt = wsp<bf16_t>(p, OFF_WGUT) + ((long)e * 2048 + ct * 128) * ND; g.ldb = ND; g.K = ND;
        gemm_tile_128(g, lds, acc);
#pragma unroll
        for (int mi = 0; mi < 4; mi++) {
            const int r = wm * 64 + mi * 16 + lr;
            const int tok = arow[r];
            const float rs = row_rs16(wsp<float>(p, OFF_SS2) + (long)tok * 16);
            bf16_t* ad = wsp<bf16_t>(p, OFF_ACT) + ((long)(e * NB + b) * CAP + rt * 128 + r) * ND + ct * 64 + wn * 32 + 4 * lq;
#pragma unroll
            for (int pp = 0; pp < 2; pp++) {
                f32x4 o;
#pragma unroll
                for (int q = 0; q < 4; q++) {
                    const float ga = acc[mi][2 * pp][q] * rs, up = acc[mi][2 * pp + 1][q] * rs;
                    o[q] = ga / (1.f + __expf(-ga)) * up;
                }
                *(u32x2*)(ad + pp * 16) = pack4bf(o);
            }
        }
    }
}
__device__ __forceinline__ void phase10(const Params& p, char* lds) {
    const int tid = VTID, lane = tid & 63, wid = tid >> 6, wm = wid >> 1, wn = wid & 1, lq = lane >> 4, lr = lane & 15;
    FOR_XCD_ITEMS(item, NE * 8 * NB * 4) {
        const int rt = item & 3, b = (item >> 2) & 3, ct = (item >> 4) & 7, e = item >> 7;
        const long row0 = (long)(e * NB + b) * CAP + rt * 128;
        f32x4 acc[4][4];
        GemmTile g; g.A = wsp<bf16_t>(p, OFF_ACT) + row0 * ND; g.lda = ND; g.arow = nullptr;
        g.Bt = wsp<bf16_t>(p, OFF_WDT) + ((long)e * 1024 + ct * 128) * ND; g.ldb = ND; g.K = ND;
        gemm_tile_128(g, lds, acc);
        const float* gate = wsp<float>(p, OFF_GATE) + (long)(b * NE + e) * CAP + rt * 128;
#pragma unroll
        for (int mi = 0; mi < 4; mi++) {
            const int r = wm * 64 + mi * 16 + lr;
            const float gv = gate[r];
            bf16_t* yd = wsp<bf16_t>(p, OFF_Y) + (row0 + r) * ND + ct * 128 + wn * 64 + 4 * lq;
#pragma unroll
            for (int ni = 0; ni < 4; ni++) *(u32x2*)(yd + ni * 16) = pack4bf(acc[mi][ni] * gv);
        }
    }
}

__device__ __forceinline__ void phase11(const Params& p, char* lds) {
    const int tid = VTID, lane = tid & 63, wid = tid >> 6;
    for (int tok = VBLK * 4 + wid; tok < NT; tok += VGRID * 4) {
        const int b = tok >> 12, t = tok & 4095;
        float* xr = p.out + (long)tok * ND;
        const bf16_t* xb2 = wsp<bf16_t>(p, OFF_X2B) + (long)tok * ND;
        f32x4 v[4];
#pragma unroll
        for (int i = 0; i < 4; i++) {
            const u32x2 w = *(const u32x2*)(xb2 + i * 256 + lane * 4);
            v[i] = (f32x4){__uint_as_float(w.x << 16), __uint_as_float(w.x & 0xFFFF0000u), __uint_as_float(w.y << 16), __uint_as_float(w.y & 0xFFFF0000u)};
        }
        for (int e = 0; e < NE; e++) {
            const int sl = wsp<int>(p, OFF_SLOTS)[(long)(b * NE + e) * NS + t];
            if (sl >= 0) {
                const bf16_t* yr = wsp<bf16_t>(p, OFF_Y) + ((long)(e * NB + b) * CAP + sl) * ND;
#pragma unroll
                for (int i = 0; i < 4; i++) {
                    const u32x2 w = *(const u32x2*)(yr + i * 256 + lane * 4);
                    v[i][0] += __uint_as_float(w.x << 16); v[i][1] += __uint_as_float(w.x & 0xFFFF0000u);
                    v[i][2] += __uint_as_float(w.y << 16); v[i][3] += __uint_as_float(w.y & 0xFFFF0000u);
                }
            }
        }
        float ss = 0.f;
#pragma unroll
        for (int i = 0; i < 4; i++) ss += v[i][0] * v[i][0] + v[i][1] * v[i][1] + v[i][2] * v[i][2] + v[i][3] * v[i][3];
        ss = wave_sum(ss);
        const float rs = rsqrtf(ss * (1.f / ND) + 1e-6f);
#pragma unroll
        for (int i = 0; i < 4; i++) {
            const f32x4 gf = *(const f32x4*)(p.g_final + i * 256 + lane * 4);
            *(f32x4*)(xr + i * 256 + lane * 4) = v[i] * rs * gf;
        }
    }
}


__device__ __forceinline__ void phase_resid8(const Params& p, char* lds, size_t offA, size_t offW, const float* residf, const bf16_t* residb, size_t offXb, size_t offSS) {
    const int tid = threadIdx.x, lane = tid & 63, wid = tid >> 6, wm = wid >> 2, wn = wid & 3, lq = lane >> 4, lr = lane & 15;
    FOR_XCD_ITEMS_R(item, 64 * 4) {
        const int tm = item >> 2, tn = item & 3;
        f32x4 acc[8][4];
        GemmTile g; g.A = wsp<bf16_t>(p, offA) + (long)tm * 256 * ND; g.lda = ND; g.arow = nullptr;
        g.Bt = wsp<bf16_t>(p, offW) + (long)tn * 256 * ND; g.ldb = ND; g.K = ND;
        gemm_tile_256sq(g, lds, acc);
#pragma unroll
        for (int mi = 0; mi < 8; mi++) {
            const int row = tm * 256 + wm * 128 + mi * 16 + lr;
            float ss = 0.f;
#pragma unroll
            for (int ni = 0; ni < 4; ni++) {
                const long o = (long)row * ND + tn * 256 + wn * 64 + ni * 16 + 4 * lq;
                f32x4 rv;
                if (residf) rv = *(const f32x4*)(residf + o);
                else { const u32x2 w = *(const u32x2*)(residb + o); rv = (f32x4){__uint_as_float(w.x << 16), __uint_as_float(w.x & 0xFFFF0000u), __uint_as_float(w.y << 16), __uint_as_float(w.y & 0xFFFF0000u)}; }
                const f32x4 v = rv + acc[mi][ni];
                *(u32x2*)(wsp<bf16_t>(p, offXb) + o) = pack4bf(v);
                ss += v[0] * v[0] + v[1] * v[1] + v[2] * v[2] + v[3] * v[3];
            }
            ss += __shfl_xor(ss, 16); ss += __shfl_xor(ss, 32);
            if (lq == 0) wsp<float>(p, offSS)[row * 16 + tn * 4 + wn] = ss;
        }
    }
}
__device__ __forceinline__ void phase5a8(const Params& p, char* lds) {
    const int tid = threadIdx.x, lane = tid & 63, wid = tid >> 6, wm = wid >> 2, wn = wid & 3, lq = lane >> 4, lr = lane & 15;
    FOR_XCD_ITEMS_R(item, 64 * 4) {
        const int tm = item >> 2, tn = item & 3;
        f32x4 acc[8][4];
        GemmTile g; g.A = wsp<bf16_t>(p, OFF_X1B) + (long)tm * 256 * ND; g.lda = ND; g.arow = nullptr;
        g.Bt = wsp<bf16_t>(p, OFF_WMQT) + (long)tn * 256 * ND; g.ldb = ND; g.K = ND;
        gemm_tile_256sq(g, lds, acc);
#pragma unroll
        for (int mi = 0; mi < 8; mi++) {
            const int row = tm * 256 + wm * 128 + mi * 16 + lr, b = row >> 12, s = row & 4095;
            const float rs = row_rs16(wsp<float>(p, OFF_SS1) + (long)row * 16) * (0.0625f * 1.4426950408889634f);
            bf16_t* qd = wsp<bf16_t>(p, OFF_QM) + ((long)(b * 4 + tn) * NS + s) * 256 + wn * 64 + 4 * lq;
#pragma unroll
            for (int ni = 0; ni < 4; ni++) *(u32x2*)(qd + ni * 16) = pack4bf(acc[mi][ni] * rs);
        }
    }
}


__device__ __forceinline__ void phase9_8(const Params& p, char* lds) {
    const int tid = threadIdx.x, lane = tid & 63, wid = tid >> 6, wm = wid >> 2, wn = wid & 3, lq = lane >> 4, lr = lane & 15;
    FOR_XCD_ITEMS_R(item, NE * 8 * NB * 2) {
        const int rt = item & 1, b = (item >> 1) & 3, ct = (item >> 3) & 7, e = item >> 6;
        const int* arow = wsp<int>(p, OFF_IDX) + (long)(b * NE + e) * CAP + rt * 256;
        f32x4 acc[8][4];
        GemmTile g; g.A = wsp<bf16_t>(p, OFF_X2B); g.lda = ND; g.arow = arow;
        g.Bt = wsp<bf16_t>(p, OFF_WGUT) + ((long)e * 2048 + ct * 256) * ND; g.ldb = ND; g.K = ND;
        gemm_tile_256sq(g, lds, acc);
#pragma unroll
        for (int mi = 0; mi < 8; mi++) {
            const int r = wm * 128 + mi * 16 + lr;
            const int tok = arow[r];
            const float rs = row_rs16(wsp<float>(p, OFF_SS2) + (long)tok * 16);
            bf16_t* ad = wsp<bf16_t>(p, OFF_ACT) + ((long)(e * NB + b) * CAP + rt * 256 + r) * ND + ct * 128 + wn * 32 + 4 * lq;
#pragma unroll
            for (int pp = 0; pp < 2; pp++) {
                f32x4 o;
#pragma unroll
                for (int q = 0; q < 4; q++) {
                    const float ga = acc[mi][2 * pp][q] * rs, up = acc[mi][2 * pp + 1][q] * rs;
                    o[q] = ga / (1.f + __expf(-ga)) * up;
                }
                *(u32x2*)(ad + pp * 16) = pack4bf(o);
            }
        }
    }
}
__device__ __forceinline__ void phase10_8(const Params& p, char* lds) {
    const int tid = threadIdx.x, lane = tid & 63, wid = tid >> 6, wm = wid >> 2, wn = wid & 3, lq = lane >> 4, lr = lane & 15;
    FOR_XCD_ITEMS_R(item, NE * 4 * NB * 2) {
        const int rt = item & 1, b = (item >> 1) & 3, ct = (item >> 3) & 3, e = item >> 5;
        const long row0 = (long)(e * NB + b) * CAP + rt * 256;
        f32x4 acc[8][4];
        GemmTile g; g.A = wsp<bf16_t>(p, OFF_ACT) + row0 * ND; g.lda = ND; g.arow = nullptr;
        g.Bt = wsp<bf16_t>(p, OFF_WDT) + ((long)e * 1024 + ct * 256) * ND; g.ldb = ND; g.K = ND;
        gemm_tile_256sq(g, lds, acc);
        const float* gate = wsp<float>(p, OFF_GATE) + (long)(b * NE + e) * CAP + rt * 256;
#pragma unroll
        for (int mi = 0; mi < 8; mi++) {
            const int r = wm * 128 + mi * 16 + lr;
            const float gv = gate[r];
            bf16_t* yd = wsp<bf16_t>(p, OFF_Y) + (row0 + r) * ND + ct * 256 + wn * 64 + 4 * lq;
#pragma unroll
            for (int ni = 0; ni < 4; ni++) *(u32x2*)(yd + ni * 16) = pack4bf(acc[mi][ni] * gv);
        }
    }
}


__device__ __forceinline__ void phase1_big(const Params& p, char* lds) {
    const int tid = threadIdx.x, lane = tid & 63, wid = tid >> 6, wm = wid >> 2, wn = wid & 3, lq = lane >> 4, lr = lane & 15;
    FOR_XCD_ITEMS_R(item, 64 * 4) {
        const int tm = item >> 2, tn = item & 3;
        f32x4 acc[8][4];
        GemmTile g; g.A = wsp<bf16_t>(p, OFF_XB) + (long)tm * 256 * ND; g.lda = ND; g.arow = nullptr;
        g.Bt = wsp<bf16_t>(p, OFF_W1T) + (long)tn * 256 * ND; g.ldb = ND; g.K = ND;
        gemm_tile_256sq(g, lds, acc);
        const float* r0 = wsp<float>(p, OFF_R0);
        const int col0 = tn * 256 + wn * 64;
#pragma unroll
        for (int mi = 0; mi < 8; mi++) {
            const int row = tm * 256 + wm * 128 + mi * 16 + lr;
            const float rs = r0[row];
#pragma unroll
            for (int ni = 0; ni < 4; ni++) acc[mi][ni] *= rs;
            if (col0 < 512) {
#pragma unroll
                for (int ni = 0; ni < 4; ni++)
                    *(u32x2*)(wsp<bf16_t>(p, OFF_UF) + (long)row * 512 + col0 + ni * 16 + 4 * lq) = pack4bf(acc[mi][ni]);
            } else {
                float ss = 0.f;
#pragma unroll
                for (int ni = 0; ni < 4; ni++) { const f32x4 v = acc[mi][ni]; ss += v[0] * v[0] + v[1] * v[1] + v[2] * v[2] + v[3] * v[3]; }
                ss += __shfl_xor(ss, 16); ss += __shfl_xor(ss, 32);
                if (col0 < 896) {
#pragma unroll
                    for (int ni = 0; ni < 4; ni++)
                        *(u32x2*)(wsp<bf16_t>(p, OFF_UQ) + (long)row * 384 + (col0 - 512) + ni * 16 + 4 * lq) = pack4bf(acc[mi][ni]);
                    if (lq == 0) wsp<float>(p, OFF_SSQ)[row * 6 + ((col0 - 512) >> 6)] = ss;
                } else {
#pragma unroll
                    for (int ni = 0; ni < 4; ni++)
                        *(u32x2*)(wsp<bf16_t>(p, OFF_UKV) + (long)row * 256 + (col0 - 896) + ni * 16 + 4 * lq) = pack4bf(acc[mi][ni]);
                    if (lq == 0) wsp<float>(p, OFF_SSKV)[row * 4 + ((col0 - 896) >> 6)] = ss;
                }
            }
        }
    }
}


__device__ __forceinline__ void phase3_attn8(const Params& p, char* lds) {
    FOR_XCD_ITEMS_R(item, NB * 8 * (NS / 256)) {
        const int qt = item & 15, h = (item >> 4) & 7, b = item >> 7;
        const bf16_t* Qp = wsp<bf16_t>(p, OFF_Q) + ((long)(b * 8 + h) * NS + qt * 256) * 96;
        const bf16_t* Kp = wsp<bf16_t>(p, OFF_K) + ((long)(b * 8 + h) * NS) * 96;
        const bf16_t* Vtp = wsp<bf16_t>(p, OFF_VT) + ((long)(b * 8 + h) * 64) * NS;
        bf16_t* Op = wsp<bf16_t>(p, OFF_ZA) + ((long)b * NS + qt * 256) * 1024 + 512 + h * 64;
        attn_block<96, 64, 64, 512>(Qp, Kp, Vtp, (long)NS, NS, lds, [&](int q, int dv, f32x4 v) { *(u32x2*)(Op + (long)q * 1024 + dv) = pack4bf(v); });
    }
}
__device__ __forceinline__ void phase5b_8(const Params& p, char* lds) {
    FOR_XCD_ITEMS_R(item, NB * 4 * 16 * 2) {
        const int dvh = item & 1, qt = (item >> 1) & 15, h = (item >> 5) & 3, b = item >> 7;
        const bf16_t* Qp = wsp<bf16_t>(p, OFF_QM) + ((long)(b * 4 + h) * NS + qt * 256) * 256;
        const bf16_t* Kp = wsp<bf16_t>(p, OFF_KMEM) + ((long)(b * 4 + h) * 256) * 256;
        const bf16_t* Vtp = wsp<bf16_t>(p, OFF_VTMEM) + ((long)(b * 4 + h) * 256 + dvh * 128) * 256;
        bf16_t* Op = wsp<bf16_t>(p, OFF_OM) + ((long)b * NS + qt * 256) * 1024 + h * 256 + dvh * 128;
        attn_block<256, 128, 32, 512>(Qp, Kp, Vtp, 256L, 256, lds, [&](int q, int dv, f32x4 v) { *(u32x2*)(Op + (long)q * 1024 + dv) = pack4bf(v); });
    }
}

__global__ void __launch_bounds__(512, 1) k_fwd(Params p, int ph_lo, int ph_hi) {
    extern __shared__ __attribute__((aligned(16))) char lds_all[];
    char* lds = lds_all + VHALF * LDS_HALF;
    volatile LAS unsigned* st = (volatile LAS unsigned*)(lds_all + LDS_MAIN);
    if (threadIdx.x == 0) { st[0] = 0u; st[1] = 0u; }
    __syncthreads();
    XcdBarrier bar = xcd_barrier_post(wsp<unsigned>(p, OFF_BAR), st);
#if USE_CG_SYNC
#define GRID_BARRIER() do { asm volatile("s_waitcnt vmcnt(0)" ::: "memory"); __syncthreads(); cg::this_grid().sync(); asm volatile("s_waitcnt vmcnt(0)" ::: "memory"); __syncthreads(); } while (0)
#else
#define GRID_BARRIER() xcd_barrier(bar)
#endif
#define RUN_PHASE(k, call) if (ph_lo <= (k) && (k) < ph_hi) { if ((k) > ph_lo) { GRID_BARRIER(); } call; }
    RUN_PHASE(0, phase0(p, lds))
    RUN_PHASE(1, (phase1_big(p, lds_all), phase1(p, lds_all)))
    RUN_PHASE(2, (phase2(p, lds_all), phase2_f2a(p, lds)))
    RUN_PHASE(3, ((blockIdx.x & 1) ? phase3_tr(p, lds) : (void)0, phase3_attn8(p, lds_all), phase3_f2b(p, lds), (blockIdx.x & 1) ? (void)0 : phase3_tr(p, lds)))
    RUN_PHASE(4, phase_resid8(p, lds_all, OFF_ZA, OFF_WOUTT, p.x, nullptr, OFF_X1B, OFF_SS1))
    RUN_PHASE(5, phase5a8(p, lds_all))
    RUN_PHASE(6, phase5b_8(p, lds_all))
    RUN_PHASE(7, phase_resid8(p, lds_all, OFF_OM, OFF_WMOT, nullptr, wsp<bf16_t>(p, OFF_X1B), OFF_X2B, OFF_SS2))
    RUN_PHASE(8, phase7(p, lds))
    RUN_PHASE(9, phase8(p, lds))
    RUN_PHASE(10, phase9_8(p, lds_all))
    RUN_PHASE(11, phase10_8(p, lds_all))
    RUN_PHASE(12, phase11(p, lds))
}

extern "C" void kernel_launch(void* const* d_in, const int* in_sizes, int n_in,
                              void* d_out, int out_size, void* d_ws, size_t ws_size,
                              hipStream_t stream) {
    static int grid = 0;
    if (grid == 0) {
        if (n_in != 22 || ws_size < WS_END) { fprintf(stderr, "kernel_launch: unexpected inputs (n_in %d, ws %zu < %zu)\n", n_in, ws_size, (size_t)WS_END); grid = -1; return; }
        int dev = 0, cus = 0, per_cu = 0;
        (void)hipGetDevice(&dev);
        (void)hipDeviceGetAttribute(&cus, hipDeviceAttributeMultiprocessorCount, dev);
        if (hipFuncSetAttribute((const void*)k_fwd, hipFuncAttributeMaxDynamicSharedMemorySize, LDS_TOTAL) != hipSuccess) { fprintf(stderr, "kernel_launch: hipFuncSetAttribute failed\n"); grid = -1; return; }
        if (hipOccupancyMaxActiveBlocksPerMultiprocessor(&per_cu, (const void*)k_fwd, 512, LDS_TOTAL) != hipSuccess || per_cu < 1) { fprintf(stderr, "kernel_launch: occupancy query failed (%d)\n", per_cu); (void)hipGetLastError(); per_cu = 1; }
        if (per_cu > 1) per_cu = 1;
        grid = cus * per_cu;
        fprintf(stderr, "kernel_launch: %d CUs x %d blocks\n", cus, per_cu);
    }
    if (grid < 0) return;
    Params p{};
    p.x = (const float*)d_in[0]; p.mem = (const float*)d_in[1]; p.pos = (const int*)d_in[2];
    p.g_mix = (const float*)d_in[3]; p.w_in = (const float*)d_in[4]; p.g_q_lat = (const float*)d_in[5]; p.w_q_up = (const float*)d_in[6];
    p.g_kv_lat = (const float*)d_in[7]; p.w_kv_up = (const float*)d_in[8]; p.w_fourier = (const float*)d_in[9]; p.w_out = (const float*)d_in[10];
    p.g_mem_q = (const float*)d_in[11]; p.g_mem_kv = (const float*)d_in[12]; p.w_mem_q = (const float*)d_in[13]; p.w_mem_kv = (const float*)d_in[14];
    p.w_mem_o = (const float*)d_in[15]; p.g_ffn = (const float*)d_in[16]; p.w_router = (const float*)d_in[17];
    p.w_exp_gate = (const float*)d_in[18]; p.w_exp_up = (const float*)d_in[19]; p.w_exp_down = (const float*)d_in[20]; p.g_final = (const float*)d_in[21];
    p.out = (float*)d_out; p.ws = (char*)d_ws;
    static const int cuts[] = MK_CUTS;
    const int ncut = (int)(sizeof(cuts) / sizeof(int));
    for (int li = 0; li + 1 < ncut; li++) {
        (void)hipMemsetAsync((char*)d_ws + OFF_BAR, 0, 16384, stream);
        int lo = cuts[li], hi = cuts[li + 1];
        void* args[] = {&p, &lo, &hi};
        hipError_t e = hipLaunchCooperativeKernel((const void*)k_fwd, dim3(grid), dim3(512), args, LDS_TOTAL, stream);
        if (e != hipSuccess) fprintf(stderr, "cooperative launch failed: %s (grid %d)\n", hipGetErrorString(e), grid);
    }
}
```

```cpp
#include <hip/hip_runtime.h>
#include <stdint.h>
#include <cstdio>
#include <hip/hip_cooperative_groups.h>
namespace cg = cooperative_groups;
#ifndef USE_CG_SYNC
#define USE_CG_SYNC 0
#endif

#ifndef MK_CUTS
#define MK_CUTS {0, 13}
#endif

#define NB 4
#define NS 4096
#define ND 1024
#define NT (NB * NS)
#define INW 1184
#define NE 16
#define CAP 512
#define MEML 256
#define NPHASE 13
#define VTID ((int)(threadIdx.x & 255))
#define VHALF (__builtin_amdgcn_readfirstlane((int)(threadIdx.x >> 8)))
#define VBLK ((int)(blockIdx.x * 2) + VHALF)
#define VGRID ((int)(gridDim.x * 2))

typedef unsigned short bf16_t;
typedef short bf16x8 __attribute__((ext_vector_type(8)));
typedef float f32x4 __attribute__((ext_vector_type(4)));
typedef float f32x16 __attribute__((ext_vector_type(16)));
typedef unsigned u32x4 __attribute__((ext_vector_type(4)));
typedef unsigned u32x2 __attribute__((ext_vector_type(2)));

__device__ __forceinline__ unsigned f2bf(float f) {
    unsigned u = __float_as_uint(f);
    u += 0x7FFFu + ((u >> 16) & 1u);
    return u >> 16;
}
typedef __bf16 hbf2 __attribute__((ext_vector_type(2)));
typedef float f32x2 __attribute__((ext_vector_type(2)));
__device__ __forceinline__ unsigned pack2bf(float lo, float hi) { f32x2 v = {lo, hi}; return __builtin_bit_cast(unsigned, __builtin_convertvector(v, hbf2)); }
__device__ __forceinline__ float bf2f(unsigned short b) { return __uint_as_float(((unsigned)b) << 16); }

__device__ __forceinline__ int tile_off(int row, int chunk) { return row * 128 + ((chunk ^ ((row >> 1) & 7)) << 4); }

#define GT_LDS_BYTES 65536

struct GemmTile { const bf16_t* A; long lda; const int* arow; const bf16_t* Bt; long ldb; int K; };

__device__ __forceinline__ void gemm_tile_128(const GemmTile& g, char* lds, f32x4 (&acc)[4][4]) {
    const int tid = VTID, lane = tid & 63, wid = tid >> 6, wm = wid >> 1, wn = wid & 1;
    const int lrow = lane >> 3, pc = lane & 7;
    const bf16_t* ap[4]; const bf16_t* bp[4];
#pragma unroll
    for (int i = 0; i < 4; i++) {
        const int r = (wid * 4 + i) * 8 + lrow;
        const int c = pc ^ ((r >> 1) & 7);
        const long ro = g.arow ? (long)g.arow[r] * g.lda : (long)r * g.lda;
        ap[i] = g.A + ro + c * 8;
        bp[i] = g.Bt + (long)r * g.ldb + c * 8;
    }
#pragma unroll
    for (int mi = 0; mi < 4; mi++)
#pragma unroll
        for (int ni = 0; ni < 4; ni++) acc[mi][ni] = (f32x4){0.f, 0.f, 0.f, 0.f};
    const int nk = g.K >> 6;
    auto stage = [&](int kt, char* st) {
#pragma unroll
        for (int i = 0; i < 4; i++) {
            __builtin_amdgcn_global_load_lds((const unsigned*)(ap[i] + kt * 64), (unsigned*)(st + (wid * 4 + i) * 1024), 16, 0, 0);
            __builtin_amdgcn_global_load_lds((const unsigned*)(bp[i] + kt * 64), (unsigned*)(st + 16384 + (wid * 4 + i) * 1024), 16, 0, 0);
        }
    };
    __syncthreads();
    stage(0, lds);
    asm volatile("s_waitcnt vmcnt(0)" ::: "memory");
    __syncthreads();
    for (int kt = 0; kt < nk; kt++) {
        char* cur = lds + (kt & 1) * 32768;
        if (kt + 1 < nk) stage(kt + 1, lds + ((kt + 1) & 1) * 32768);
        bf16x8 af[2][4], bfr[2][4];
#pragma unroll
        for (int ks = 0; ks < 2; ks++)
#pragma unroll
            for (int i = 0; i < 4; i++) {
                af[ks][i] = *(const bf16x8*)(cur + tile_off(wm * 64 + i * 16 + (lane & 15), ks * 4 + (lane >> 4)));
                bfr[ks][i] = *(const bf16x8*)(cur + 16384 + tile_off(wn * 64 + i * 16 + (lane & 15), ks * 4 + (lane >> 4)));
            }
        __builtin_amdgcn_s_setprio(1);
#pragma unroll
        for (int ks = 0; ks < 2; ks++)
#pragma unroll
            for (int mi = 0; mi < 4; mi++)
#pragma unroll
                for (int ni = 0; ni < 4; ni++)
                    acc[mi][ni] = __builtin_amdgcn_mfma_f32_16x16x32_bf16(bfr[ks][ni], af[ks][mi], acc[mi][ni], 0, 0, 0);
        __builtin_amdgcn_s_setprio(0);
        asm volatile("s_waitcnt vmcnt(0)" ::: "memory");
        __syncthreads();
    }
}

template <int DQK, int DVT, int KT>
struct AttnCfg {
    static constexpr int KROW = DQK * 2 + 16;
    static constexpr int VROW = KT * 2 + 8;
    static constexpr int KBYTES = KT * KROW;
    static constexpr int VBYTES = DVT * VROW;
    static constexpr int STAGE = KBYTES + VBYTES;
    static constexpr int LDS = 2 * STAGE;
};

template <int DQK, int DVT, int KT, int NTH, class Out>
__device__ __forceinline__ void attn_block(const bf16_t* Qp, const bf16_t* Kp, const bf16_t* Vtp, long ldv, int nk, char* lds, Out&& out) {
    typedef AttnCfg<DQK, DVT, KT> C;
    constexpr int NKS = DQK / 16, NST = KT / 32, NDT = DVT / 32, NPS = KT / 16;
    constexpr int KCPR = DQK / 8;
    constexpr int KTOT = KT * KCPR, KCH = (KTOT + NTH - 1) / NTH;
    constexpr int VCPR = KT / 8;
    constexpr int VTOT = DVT * VCPR, VCH = (VTOT + NTH - 1) / NTH;
    const int tid = NTH == 512 ? (int)threadIdx.x : VTID, lane = tid & 63, wid = tid >> 6, h = lane >> 5, c = lane & 31;

    bf16x8 qf[NKS];
    {
        const bf16_t* qrow = Qp + (long)(wid * 32 + c) * DQK + 8 * h;
#pragma unroll
        for (int ks = 0; ks < NKS; ks++) qf[ks] = *(const bf16x8*)(qrow + 16 * ks);
    }
    f32x16 o[NDT];
#pragma unroll
    for (int dt = 0; dt < NDT; dt++)
#pragma unroll
        for (int r = 0; r < 16; r++) o[dt][r] = 0.f;
    float m = 0.f, l = 0.f;

    u32x4 kr[KCH], vr[VCH];
    auto gload = [&](int t) {
#pragma unroll
        for (int i = 0; i < KCH; i++) {
            const int ci = tid + NTH * i, row = ci / KCPR, cc = ci % KCPR;
            if (KTOT % NTH == 0 || ci < KTOT) kr[i] = *(const u32x4*)(Kp + (long)(t * KT + row) * DQK + cc * 8);
        }
#pragma unroll
        for (int i = 0; i < VCH; i++) {
            const int ci = tid + NTH * i, row = ci / VCPR, cc = ci % VCPR;
            if (VTOT % NTH == 0 || ci < VTOT) vr[i] = *(const u32x4*)(Vtp + (long)row * ldv + t * KT + cc * 8);
        }
    };
    auto lwrite = [&](char* st) {
#pragma unroll
        for (int i = 0; i < KCH; i++) {
            const int ci = tid + NTH * i, row = ci / KCPR, cc = ci % KCPR;
            if (KTOT % NTH == 0 || ci < KTOT) *(u32x4*)(st + row * C::KROW + cc * 16) = kr[i];
        }
#pragma unroll
        for (int i = 0; i < VCH; i++) {
            const int ci = tid + NTH * i, row = ci / VCPR, cc = ci % VCPR;
            if (VTOT % NTH == 0 || ci < VTOT) {
                char* p = st + C::KBYTES + row * C::VROW + cc * 16;
                *(u32x2*)(p) = (u32x2){vr[i].x, vr[i].y};
                *(u32x2*)(p + 8) = (u32x2){vr[i].z, vr[i].w};
            }
        }
    };
    const int nt = nk / KT;
    gload(0);
    __syncthreads();
    lwrite(lds);
    __syncthreads();
    for (int t = 0; t < nt; t++) {
        char* cur = lds + (t & 1) * C::STAGE;
        if (t + 1 < nt) gload(t + 1);
        f32x16 s[NST];
        const float negm = -m;
#pragma unroll
        for (int st = 0; st < NST; st++) {
#pragma unroll
            for (int r = 0; r < 16; r++) s[st][r] = negm;
#pragma unroll
            for (int ks = 0; ks < NKS; ks++) {
                const bf16x8 kf = *(const bf16x8*)(cur + (st * 32 + c) * C::KROW + ks * 32 + h * 16);
                s[st] = __builtin_amdgcn_mfma_f32_32x32x16_bf16(kf, qf[ks], s[st], 0, 0, 0);
            }
        }
        float mx = s[0][0];
#pragma unroll
        for (int st = 0; st < NST; st++)
#pragma unroll
            for (int r = 0; r < 16; r++) mx = fmaxf(mx, s[st][r]);
        mx = fmaxf(mx, __shfl_xor(mx, 32));
        if (__any(mx > 8.0f)) {
            const float d = fmaxf(mx, 0.f);
            const float alpha = __builtin_amdgcn_exp2f(-d);
            m += d;
            l *= alpha;
#pragma unroll
            for (int dt = 0; dt < NDT; dt++)
#pragma unroll
                for (int r = 0; r < 16; r++) o[dt][r] *= alpha;
#pragma unroll
            for (int st = 0; st < NST; st++)
#pragma unroll
                for (int r = 0; r < 16; r++) s[st][r] -= d;
        }
        float rs = 0.f;
#pragma unroll
        for (int st = 0; st < NST; st++)
#pragma unroll
            for (int r = 0; r < 16; r++) { const float p = __builtin_amdgcn_exp2f(s[st][r]); rs += p; s[st][r] = p; }
        l += rs;
#pragma unroll
        for (int ps = 0; ps < NPS; ps++) {
            const int st = ps >> 1, u = ps & 1;
            u32x4 pw;
            pw.x = pack2bf(s[st][8 * u + 0], s[st][8 * u + 1]);
            pw.y = pack2bf(s[st][8 * u + 2], s[st][8 * u + 3]);
            pw.z = pack2bf(s[st][8 * u + 4], s[st][8 * u + 5]);
            pw.w = pack2bf(s[st][8 * u + 6], s[st][8 * u + 7]);
            const bf16x8 pf = __builtin_bit_cast(bf16x8, pw);
#pragma unroll
            for (int dt = 0; dt < NDT; dt++) {
                const char* vp = cur + C::KBYTES + (dt * 32 + c) * C::VROW + (ps * 16 + 4 * h) * 2;
                const u32x2 v0 = *(const u32x2*)(vp);
                const u32x2 v1 = *(const u32x2*)(vp + 16);
                const bf16x8 vf = __builtin_bit_cast(bf16x8, ((u32x4){v0.x, v0.y, v1.x, v1.y}));
                o[dt] = __builtin_amdgcn_mfma_f32_32x32x16_bf16(vf, pf, o[dt], 0, 0, 0);
            }
        }
        if (t + 1 < nt) lwrite(lds + ((t + 1) & 1) * C::STAGE);
        __syncthreads();
    }
    l += __shfl_xor(l, 32);
    const float inv = 1.f / l;
#pragma unroll
    for (int dt = 0; dt < NDT; dt++)
#pragma unroll
        for (int g4 = 0; g4 < 4; g4++) {
            f32x4 v = {o[dt][4 * g4 + 0] * inv, o[dt][4 * g4 + 1] * inv, o[dt][4 * g4 + 2] * inv, o[dt][4 * g4 + 3] * inv};
            out(wid * 32 + c, dt * 32 + 8 * g4 + 4 * h, v);
        }
}


constexpr size_t SLOT = 33554432;
constexpr size_t OFF_W1T = 0;
constexpr size_t OFF_WQT = OFF_W1T + 1280UL * 1024 * 2;
constexpr size_t OFF_WKVT = OFF_WQT + 768UL * 384 * 2;
constexpr size_t OFF_WOUTT = OFF_WKVT + 1024UL * 256 * 2;
constexpr size_t OFF_WMQT = OFF_WOUTT + 1024UL * 1024 * 2;
constexpr size_t OFF_WMKVT = OFF_WMQT + 1024UL * 1024 * 2;
constexpr size_t OFF_WMOT = OFF_WMKVT + 2048UL * 1024 * 2;
constexpr size_t OFF_WGUT = OFF_WMOT + 1024UL * 1024 * 2;
constexpr size_t OFF_WDT = OFF_WGUT + 16UL * 2048 * 1024 * 2;
constexpr size_t OFF_T64 = OFF_WDT + 16UL * 1024 * 1024 * 2;
constexpr size_t OFF_M1 = OFF_T64 + 16384;
constexpr size_t OFF_M3 = OFF_M1 + 32768;
constexpr size_t OFF_WFT = OFF_M3 + 16384;
constexpr size_t OFF_TW = OFF_WFT + 65536;
constexpr size_t OFF_ROPE = OFF_TW + 32768;
constexpr size_t OFF_R0 = OFF_ROPE + (size_t)NT * 16 * 8;
constexpr size_t OFF_RMEM = OFF_R0 + (size_t)NT * 4;
constexpr size_t OFF_SSQ = OFF_RMEM + 4096;
constexpr size_t OFF_SSKV = OFF_SSQ + (size_t)NT * 6 * 4;
constexpr size_t OFF_SS1 = OFF_SSKV + (size_t)NT * 4 * 4;
constexpr size_t OFF_SS2 = OFF_SS1 + (size_t)NT * 16 * 4;
constexpr size_t OFF_AFF = OFF_SS2 + (size_t)NT * 16 * 4;
constexpr size_t OFF_SLOTS = OFF_AFF + (size_t)NT * 16 * 4;
constexpr size_t OFF_IDX = OFF_SLOTS + 4UL * 16 * 4096 * 4;
constexpr size_t OFF_GATE = OFF_IDX + 4UL * 16 * 512 * 4;
constexpr size_t OFF_MEMB = OFF_GATE + 4UL * 16 * 512 * 4;
constexpr size_t OFF_KMEM = OFF_MEMB + 1024UL * 1024 * 2;
constexpr size_t OFF_VTMEM = OFF_KMEM + 1024UL * 1024 * 2;
constexpr size_t OFF_KR = OFF_VTMEM + 1024UL * 1024 * 2;
constexpr size_t OFF_BAR = OFF_KR + (size_t)NT * 32 * 2;
constexpr size_t OFF_S0 = (OFF_BAR + 16384 + 255) / 256 * 256;
constexpr size_t OFF_S1 = OFF_S0 + SLOT;
constexpr size_t OFF_S2 = OFF_S1 + SLOT;
constexpr size_t OFF_S3 = OFF_S2 + SLOT;
constexpr size_t OFF_S4 = OFF_S3 + SLOT;
constexpr size_t WS_END = OFF_S4 + SLOT;
static_assert(WS_END <= 300964352UL, "workspace map exceeds the guaranteed scratch size");
constexpr size_t OFF_XB = OFF_S0, OFF_YR = OFF_S0, OFF_YI = OFF_S0 + SLOT / 2, OFF_X1B = OFF_S3, OFF_OM = OFF_S0, OFF_ACT = OFF_S0;
constexpr size_t OFF_UF = OFF_S1, OFF_UQ = OFF_S1 + (size_t)NT * 512 * 2, OFF_ZA = OFF_S1, OFF_QM = OFF_S1;
constexpr size_t OFF_Q = OFF_S2, OFF_UKV = OFF_S2 + (size_t)NT * 768 * 2, OFF_X2B = OFF_S2;
constexpr size_t OFF_K = OFF_S3, OFF_Y = OFF_S3;
constexpr size_t OFF_VT = OFF_S4;

struct Params {
    const float *x, *mem; const int* pos;
    const float *g_mix, *w_in, *g_q_lat, *w_q_up, *g_kv_lat, *w_kv_up, *w_fourier, *w_out, *g_mem_q, *g_mem_kv, *w_mem_q, *w_mem_kv, *w_mem_o,
        *g_ffn, *w_router, *w_exp_gate, *w_exp_up, *w_exp_down, *g_final;
    float* out; char* ws;
};
template <class T> __device__ __forceinline__ T* wsp(const Params& p, size_t off) { return (T*)(p.ws + off); }

#define LDS_HALF 65536
#define LDS_MAIN 131072
#define LDS_TOTAL (LDS_MAIN + 16)
#define LAS __attribute__((address_space(3)))

#define XB_TMO      128
#define XB_XCNT(j)  (256  + 64 * (j))
#define XB_XSUB(j)  (1280 + 64 * (j))
#define XB_XGEN(j)  (2304 + 64 * (j))
#define XB_TOP      3328
#define XB_TOPGEN   3392
#define XCD_BAR_WORDS 3456
#define XB_SPIN_CAP (1u << 25)
__device__ __forceinline__ unsigned xb_ld(unsigned* p)              { return __hip_atomic_load(p, __ATOMIC_RELAXED, __HIP_MEMORY_SCOPE_AGENT); }
__device__ __forceinline__ unsigned xb_add(unsigned* p, unsigned v) { return __hip_atomic_fetch_add(p, v, __ATOMIC_RELAXED, __HIP_MEMORY_SCOPE_AGENT); }
__device__ __forceinline__ unsigned xb_xcc_id() { return (unsigned)__builtin_amdgcn_s_getreg((3 << 11) | 20) & 0xFu; }
#define XB_SPIN(cond, bar) do { unsigned _sp = 0; while (cond) { __builtin_amdgcn_s_sleep(1); \
    if ((++_sp & 255u) == 0u) { if (xb_ld(&(bar)[XB_TMO])) break; if (_sp > XB_SPIN_CAP) { atomicAdd(&(bar)[XB_TMO], 1u); break; } } } } while (0)
struct XcdBarrier { unsigned* bar; unsigned x; volatile LAS unsigned* st; };
__device__ __forceinline__ XcdBarrier xcd_barrier_post(unsigned* bar, volatile LAS unsigned* st) {
    XcdBarrier b; b.bar = bar; b.x = xb_xcc_id(); b.st = st;
    if (threadIdx.x == 0) (void)xb_add(&bar[XB_XCNT(b.x)], 1u);
    return b;
}
__device__ __forceinline__ void xcd_barrier_complete(unsigned* bar, unsigned x, unsigned& nloc, unsigned& nx) {
    const unsigned G = gridDim.x * gridDim.y * gridDim.z;
    unsigned sum, cnt, mine, sp = 0u;
    for (;;) {
        sum = 0u; cnt = 0u; mine = 0u;
#pragma unroll
        for (unsigned j = 0; j < 16; ++j) { const unsigned c = xb_ld(&bar[XB_XCNT(j)]); sum += c; cnt += (c > 0u) ? 1u : 0u; mine = (j == x) ? c : mine; }
        if (sum == G) break;
        __builtin_amdgcn_s_sleep(1);
        if ((++sp & 255u) == 0u) { if (xb_ld(&bar[XB_TMO])) break; if (sp > XB_SPIN_CAP) { atomicAdd(&bar[XB_TMO], 1u); break; } }
    }
    nloc = mine > 0u ? mine : 1u; nx = cnt > 0u ? cnt : 1u;
}
__device__ __forceinline__ void xcd_barrier(const XcdBarrier& b) {
    asm volatile("s_waitcnt vmcnt(0)" ::: "memory");
    __syncthreads();
    if (threadIdx.x == 0) {
        unsigned* bar = b.bar;
        __builtin_amdgcn_s_waitcnt(0);
        unsigned nloc = b.st[0], nx = b.st[1];
        if (nloc == 0u) { xcd_barrier_complete(bar, b.x, nloc, nx); b.st[0] = nloc; b.st[1] = nx; }
        const unsigned old = xb_add(&bar[XB_XSUB(b.x)], 1u);
        const unsigned gen = old / nloc;
        if (old + 1u == (gen + 1u) * nloc) {
            __builtin_amdgcn_fence(__ATOMIC_RELEASE, "agent");
            asm volatile("s_waitcnt vmcnt(0)" ::: "memory");
            const unsigned og = xb_add(&bar[XB_TOP], 1u);
            const unsigned tg = og / nx;
            if (og + 1u == (tg + 1u) * nx) xb_add(&bar[XB_TOPGEN], 1u);
            else XB_SPIN(xb_ld(&bar[XB_TOPGEN]) == tg, bar);
            __builtin_amdgcn_fence(__ATOMIC_ACQUIRE, "agent");
            xb_add(&bar[XB_XGEN(b.x)], 1u);
            asm volatile("s_waitcnt vmcnt(0)" ::: "memory");
        } else {
            XB_SPIN(xb_ld(&bar[XB_XGEN(b.x)]) == gen, bar);
            __builtin_amdgcn_fence(__ATOMIC_ACQUIRE, "agent");
            asm volatile("s_waitcnt vmcnt(0)" ::: "memory");
        }
    }
    __syncthreads();
}

#define FOR_XCD_ITEMS(item, N) for (int _L = (int)((blockIdx.x >> 3) << 1) | VHALF, item; _L < (N) / 8 && ((item = (int)(blockIdx.x & 7) * ((N) / 8) + _L), true); _L += (int)(gridDim.x >> 2))

__device__ __forceinline__ u32x2 pack4bf(float a, float b, float c, float d) { return (u32x2){pack2bf(a, b), pack2bf(c, d)}; }
__device__ __forceinline__ u32x2 pack4bf(f32x4 v) { return (u32x2){pack2bf(v[0], v[1]), pack2bf(v[2], v[3])}; }
__device__ __forceinline__ float wave_sum(float v) {
#pragma unroll
    for (int o = 32; o > 0; o >>= 1) v += __shfl_xor(v, o);
    return v;
}

__device__ __forceinline__ void tr_tile(const float* W, long ldw, int k0, int n0, int nvalid, const float* gain, bf16_t* Wt, long ldt, int mode, char* lds) {
    float (*t)[132] = (float (*)[132])lds;
    const int tid = VTID, c4 = tid & 31, r0 = tid >> 5;
    f32x4 v[8];
#pragma unroll
    for (int i = 0; i < 8; i++) {
        const int kk = r0 + 8 * i, n = n0 + c4 * 4;
        v[i] = (n < nvalid) ? *(const f32x4*)(W + (long)(k0 + kk) * ldw + n) : (f32x4){0.f, 0.f, 0.f, 0.f};
        if (gain) v[i] *= gain[k0 + kk];
    }
    __syncthreads();
#pragma unroll
    for (int i = 0; i < 8; i++) *(f32x4*)(&t[r0 + 8 * i][c4 * 4]) = v[i];
    __syncthreads();
#pragma unroll
    for (int i = 0; i < 4; i++) {
        const int ci = tid + 256 * i, nn = ci >> 3, kc = ci & 7;
        const int n = n0 + nn;
        int row = n;
        if (mode) row = (n >> 5) * 64 + ((n >> 4) & 1) * 32 + (mode - 1) * 16 + (n & 15);
        u32x4 w;
        w.x = pack2bf(t[kc * 8 + 0][nn], t[kc * 8 + 1][nn]);
        w.y = pack2bf(t[kc * 8 + 2][nn], t[kc * 8 + 3][nn]);
        w.z = pack2bf(t[kc * 8 + 4][nn], t[kc * 8 + 5][nn]);
        w.w = pack2bf(t[kc * 8 + 6][nn], t[kc * 8 + 7][nn]);
        *(u32x4*)(Wt + (long)row * ldt + k0 + kc * 8) = w;
    }
}

__device__ __forceinline__ void phase0(const Params& p, char* lds) {
    constexpr int J_W1 = 160, J_WQ = 36, J_WKV = 32, J_WOUT = 128, J_WMQ = 128, J_WMKV = 256, J_WMO = 128, J_WG = 0, J_WU = 0, J_WD = 0;
    constexpr int J_TR = J_W1 + J_WQ + J_WKV + J_WOUT + J_WMQ + J_WMKV + J_WMO + J_WG + J_WU + J_WD;
    constexpr int J_XR = NT / 4, J_MR = 1024 / 4, J_ROPE = NT * 16 / 256, J_TAB = (4096 + 8192 + 16384 + 8192 + 32768) / 256;
    constexpr int J_ALL = J_TR + J_XR + J_MR + J_ROPE + J_TAB;
    const int tid = VTID, lane = tid & 63, wid = tid >> 6;
    const double PI2 = 6.283185307179586476925286766559;
    for (int job = VBLK; job < J_ALL; job += VGRID) {
        int j = job;
        if (j < J_TR) {
            if (j < J_W1) { tr_tile(p.w_in, INW, (j / 10) * 64, (j % 10) * 128, INW, p.g_mix, wsp<bf16_t>(p, OFF_W1T), 1024, 0, lds); continue; } j -= J_W1;
            if (j < J_WQ) { tr_tile(p.w_q_up, 768, (j / 6) * 64, (j % 6) * 128, 768, p.g_q_lat, wsp<bf16_t>(p, OFF_WQT), 384, 0, lds); continue; } j -= J_WQ;
            if (j < J_WKV) { tr_tile(p.w_kv_up, 1024, (j / 8) * 64, (j % 8) * 128, 1024, p.g_kv_lat, wsp<bf16_t>(p, OFF_WKVT), 256, 0, lds); continue; } j -= J_WKV;
            if (j < J_WOUT) { tr_tile(p.w_out, 1024, (j / 8) * 64, (j % 8) * 128, 1024, nullptr, wsp<bf16_t>(p, OFF_WOUTT), 1024, 0, lds); continue; } j -= J_WOUT;
            if (j < J_WMQ) { tr_tile(p.w_mem_q, 1024, (j / 8) * 64, (j % 8) * 128, 1024, p.g_mem_q, wsp<bf16_t>(p, OFF_WMQT), 1024, 0, lds); continue; } j -= J_WMQ;
            if (j < J_WMKV) { tr_tile(p.w_mem_kv, 2048, (j / 16) * 64, (j % 16) * 128, 2048, p.g_mem_kv, wsp<bf16_t>(p, OFF_WMKVT), 1024, 0, lds); continue; } j -= J_WMKV;
            if (j < J_WMO) { tr_tile(p.w_mem_o, 1024, (j / 8) * 64, (j % 8) * 128, 1024, nullptr, wsp<bf16_t>(p, OFF_WMOT), 1024, 0, lds); continue; } j -= J_WMO;
            if (j < J_WG) { const int e = j >> 7, r = j & 127; tr_tile(p.w_exp_gate + (long)e * 1048576, 1024, (r / 8) * 64, (r % 8) * 128, 1024, p.g_ffn, wsp<bf16_t>(p, OFF_WGUT) + (long)e * 2048 * 1024, 1024, 1, lds); continue; } j -= J_WG;
            if (j < J_WU) { const int e = j >> 7, r = j & 127; tr_tile(p.w_exp_up + (long)e * 1048576, 1024, (r / 8) * 64, (r % 8) * 128, 1024, p.g_ffn, wsp<bf16_t>(p, OFF_WGUT) + (long)e * 2048 * 1024, 1024, 2, lds); continue; } j -= J_WU;
            { const int e = j >> 7, r = j & 127; tr_tile(p.w_exp_down + (long)e * 1048576, 1024, (r / 8) * 64, (r % 8) * 128, 1024, nullptr, wsp<bf16_t>(p, OFF_WDT) + (long)e * 1048576, 1024, 0, lds); continue; }
        }
        j -= J_TR;
        if (j < J_XR + J_MR) {
            const bool isx = j < J_XR;
            const int row = (isx ? j : j - J_XR) * 4 + wid;
            const float* src = (isx ? p.x : p.mem) + (long)row * ND;
            bf16_t* dst = (isx ? wsp<bf16_t>(p, OFF_XB) : wsp<bf16_t>(p, OFF_MEMB)) + (long)row * ND;
            float ss = 0.f;
#pragma unroll
            for (int i = 0; i < 4; i++) {
                const f32x4 v = *(const f32x4*)(src + i * 256 + lane * 4);
                ss += v[0] * v[0] + v[1] * v[1] + v[2] * v[2] + v[3] * v[3];
                *(u32x2*)(dst + i * 256 + lane * 4) = pack4bf(v);
            }
            ss = wave_sum(ss);
            if (lane == 0) (isx ? wsp<float>(p, OFF_R0) : wsp<float>(p, OFF_RMEM))[row] = rsqrtf(ss * (1.f / ND) + 1e-6f);
            continue;
        }
        j -= J_XR + J_MR;
        if (j < J_ROPE) {
            const int i = j * 256 + tid; const int t = i >> 4, jj = i & 15;
            const double f = pow(10000.0, -(double)(2 * jj) / 32.0);
            const double ang = (double)p.pos[t] * f;
            wsp<float2>(p, OFF_ROPE)[i] = make_float2((float)cos(ang), (float)sin(ang));
            continue;
        }
        j -= J_ROPE;
        {
            int i = j * 256 + tid;
            if (i < 4096) { const double a = PI2 * (double)i / 4096.0; wsp<float2>(p, OFF_TW)[i] = make_float2((float)cos(a), (float)sin(a)); continue; } i -= 4096;
            if (i < 8192) {
                const int T = i >> 12, a = (i >> 6) & 63, b = i & 63;
                const double th = PI2 * (double)((a * b) & 63) / 64.0;
                wsp<bf16_t>(p, OFF_T64)[i] = (bf16_t)f2bf((float)(T ? sin(th) : cos(th))); continue;
            } i -= 8192;
            if (i < 16384) {
                const int rho = i >> 7, k = i & 127;
                const int wm = rho >> 6, mi = (rho >> 4) & 3, lr = rho & 15, ri = mi >> 1, k1 = 32 * wm + 16 * (mi & 1) + lr, ab = k >> 6, s1 = k & 63;
                const double th = PI2 * (double)((k1 * s1) & 63) / 64.0;
                const double c = cos(th), s = sin(th);
                const double v = ri == 0 ? (ab == 0 ? c : -s) : (ab == 0 ? s : c);
                wsp<bf16_t>(p, OFF_M1)[i] = (bf16_t)f2bf((float)v); continue;
            } i -= 16384;
            if (i < 8192) {
                const int k2 = i >> 7, k = i & 127, s2 = k & 63;
                const double th = PI2 * (double)((k2 * s2) & 63) / 64.0;
                wsp<bf16_t>(p, OFF_M3)[i] = (bf16_t)f2bf((float)(k < 64 ? cos(th) : -sin(th))); continue;
            } i -= 8192;
            if (i < 32768) {
                const int g = i >> 12, e = (i >> 6) & 63, ch = i & 63;
                wsp<bf16_t>(p, OFF_WFT)[i] = (bf16_t)f2bf(p.w_fourier[(g * 64 + ch) * 64 + e]); continue;
            }
        }
    }
}

#define FOR_XCD_ITEMS_R(item, N) for (int _L = (int)(blockIdx.x >> 3), item; _L < (N) / 8 && ((item = (int)(blockIdx.x & 7) * ((N) / 8) + _L), true); _L += (int)(gridDim.x >> 3))
__device__ __forceinline__ void gemm_tile_256sq(const GemmTile& g, char* lds, f32x4 (&acc)[8][4]) {
    const int tid = threadIdx.x, lane = tid & 63, wid = tid >> 6, wm = wid >> 2, wn = wid & 3;
    const int lrow = lane >> 3, pc = lane & 7;
    const bf16_t* ap[4]; const bf16_t* bp[4];
#pragma unroll
    for (int i = 0; i < 4; i++) {
        const int r = (wid * 4 + i) * 8 + lrow;
        const int c = pc ^ ((r >> 1) & 7);
        const long ro = g.arow ? (long)g.arow[r] * g.lda : (long)r * g.lda;
        ap[i] = g.A + ro + c * 8;
        bp[i] = g.Bt + (long)r * g.ldb + c * 8;
    }
#pragma unroll
    for (int mi = 0; mi < 8; mi++)
#pragma unroll
        for (int ni = 0; ni < 4; ni++) acc[mi][ni] = (f32x4){0.f, 0.f, 0.f, 0.f};
    const int nk = g.K >> 6;
    auto stage = [&](int kt, char* st) {
#pragma unroll
        for (int i = 0; i < 4; i++) {
            __builtin_amdgcn_global_load_lds((const unsigned*)(ap[i] + kt * 64), (unsigned*)(st + (wid * 4 + i) * 1024), 16, 0, 0);
            __builtin_amdgcn_global_load_lds((const unsigned*)(bp[i] + kt * 64), (unsigned*)(st + 32768 + (wid * 4 + i) * 1024), 16, 0, 0);
        }
    };
    __syncthreads();
    stage(0, lds);
    asm volatile("s_waitcnt vmcnt(0)" ::: "memory");
    __syncthreads();
    for (int kt = 0; kt < nk; kt++) {
        char* cur = lds + (kt & 1) * 65536;
        if (kt + 1 < nk) stage(kt + 1, lds + ((kt + 1) & 1) * 65536);
#pragma unroll
        for (int ks = 0; ks < 2; ks++) {
            bf16x8 af[8], bfr[4];
#pragma unroll
            for (int i = 0; i < 8; i++) af[i] = *(const bf16x8*)(cur + tile_off(wm * 128 + i * 16 + (lane & 15), ks * 4 + (lane >> 4)));
#pragma unroll
            for (int i = 0; i < 4; i++) bfr[i] = *(const bf16x8*)(cur + 32768 + tile_off(wn * 64 + i * 16 + (lane & 15), ks * 4 + (lane >> 4)));
            __builtin_amdgcn_s_setprio(1);
#pragma unroll
            for (int mi = 0; mi < 8; mi++)
#pragma unroll
                for (int ni = 0; ni < 4; ni++)
                    acc[mi][ni] = __builtin_amdgcn_mfma_f32_16x16x32_bf16(bfr[ni], af[mi], acc[mi][ni], 0, 0, 0);
            __builtin_amdgcn_s_setprio(0);
        }
        asm volatile("s_waitcnt vmcnt(0)" ::: "memory");
        __syncthreads();
    }
}


__device__ __forceinline__ void gemm_tile_256x128(const GemmTile& g, char* lds, f32x4 (&acc)[4][4]) {
    const int tid = threadIdx.x, lane = tid & 63, wid = tid >> 6, wm = wid >> 1, wn = wid & 1;
    const int lrow = lane >> 3, pc = lane & 7;
    const bf16_t* ap[4]; const bf16_t* bp[2];
#pragma unroll
    for (int i = 0; i < 4; i++) {
        const int r = (wid * 4 + i) * 8 + lrow;
        const int c = pc ^ ((r >> 1) & 7);
        const long ro = g.arow ? (long)g.arow[r] * g.lda : (long)r * g.lda;
        ap[i] = g.A + ro + c * 8;
    }
#pragma unroll
    for (int i = 0; i < 2; i++) {
        const int r = (wid * 2 + i) * 8 + lrow;
        const int c = pc ^ ((r >> 1) & 7);
        bp[i] = g.Bt + (long)r * g.ldb + c * 8;
    }
#pragma unroll
    for (int mi = 0; mi < 4; mi++)
#pragma unroll
        for (int ni = 0; ni < 4; ni++) acc[mi][ni] = (f32x4){0.f, 0.f, 0.f, 0.f};
    const int nk = g.K >> 6;
    auto stage = [&](int kt, char* st) {
#pragma unroll
        for (int i = 0; i < 4; i++)
            __builtin_amdgcn_global_load_lds((const unsigned*)(ap[i] + kt * 64), (unsigned*)(st + (wid * 4 + i) * 1024), 16, 0, 0);
#pragma unroll
        for (int i = 0; i < 2; i++)
            __builtin_amdgcn_global_load_lds((const unsigned*)(bp[i] + kt * 64), (unsigned*)(st + 32768 + (wid * 2 + i) * 1024), 16, 0, 0);
    };
    __syncthreads();
    stage(0, lds);
    asm volatile("s_waitcnt vmcnt(0)" ::: "memory");
    __syncthreads();
    for (int kt = 0; kt < nk; kt++) {
        char* cur = lds + (kt & 1) * 49152;
        if (kt + 1 < nk) stage(kt + 1, lds + ((kt + 1) & 1) * 49152);
        bf16x8 af[2][4], bfr[2][4];
#pragma unroll
        for (int ks = 0; ks < 2; ks++)
#pragma unroll
            for (int i = 0; i < 4; i++) {
                af[ks][i] = *(const bf16x8*)(cur + tile_off(wm * 64 + i * 16 + (lane & 15), ks * 4 + (lane >> 4)));
                bfr[ks][i] = *(const bf16x8*)(cur + 32768 + tile_off(wn * 64 + i * 16 + (lane & 15), ks * 4 + (lane >> 4)));
            }
        __builtin_amdgcn_s_setprio(1);
#pragma unroll
        for (int ks = 0; ks < 2; ks++)
#pragma unroll
            for (int mi = 0; mi < 4; mi++)
#pragma unroll
                for (int ni = 0; ni < 4; ni++)
                    acc[mi][ni] = __builtin_amdgcn_mfma_f32_16x16x32_bf16(bfr[ks][ni], af[ks][mi], acc[mi][ni], 0, 0, 0);
        __builtin_amdgcn_s_setprio(0);
        asm volatile("s_waitcnt vmcnt(0)" ::: "memory");
        __syncthreads();
    }
}


__device__ __forceinline__ void phase1(const Params& p, char* lds) {
    const int tid = threadIdx.x, lane = tid & 63, wid = tid >> 6, wm = wid >> 1, wn = wid & 1, lq = lane >> 4, lr = lane & 15;
    constexpr int N_U = 64 * 2, N_M = 4 * 16;
    {
      FOR_XCD_ITEMS_R(item, N_U) {
        f32x4 acc[4][4];
        {
            const int tm = item >> 1, tn = 8 + (item & 1);
            GemmTile g; g.A = wsp<bf16_t>(p, OFF_XB) + (long)tm * 256 * ND; g.lda = ND; g.arow = nullptr;
            g.Bt = wsp<bf16_t>(p, OFF_W1T) + (long)tn * 128 * ND; g.ldb = ND; g.K = ND;
            gemm_tile_256x128(g, lds, acc);
            const float* r0 = wsp<float>(p, OFF_R0);
#pragma unroll
            for (int mi = 0; mi < 4; mi++) {
                const int row = tm * 256 + wm * 64 + mi * 16 + lr;
                const float rs = r0[row];
#pragma unroll
                for (int ni = 0; ni < 4; ni++) acc[mi][ni] *= rs;
                if (tn < 4) {
#pragma unroll
                    for (int ni = 0; ni < 4; ni++)
                        *(u32x2*)(wsp<bf16_t>(p, OFF_UF) + (long)row * 512 + tn * 128 + wn * 64 + ni * 16 + 4 * lq) = pack4bf(acc[mi][ni]);
                } else if (tn < 9) {
                    float ss = 0.f;
#pragma unroll
                    for (int ni = 0; ni < 4; ni++) { const f32x4 v = acc[mi][ni]; ss += v[0] * v[0] + v[1] * v[1] + v[2] * v[2] + v[3] * v[3]; }
                    ss += __shfl_xor(ss, 16); ss += __shfl_xor(ss, 32);
                    if (tn < 7) {
#pragma unroll
                        for (int ni = 0; ni < 4; ni++)
                            *(u32x2*)(wsp<bf16_t>(p, OFF_UQ) + (long)row * 384 + (tn - 4) * 128 + wn * 64 + ni * 16 + 4 * lq) = pack4bf(acc[mi][ni]);
                        if (lq == 0) wsp<float>(p, OFF_SSQ)[row * 6 + (tn - 4) * 2 + wn] = ss;
                    } else {
#pragma unroll
                        for (int ni = 0; ni < 4; ni++)
                            *(u32x2*)(wsp<bf16_t>(p, OFF_UKV) + (long)row * 256 + (tn - 7) * 128 + wn * 64 + ni * 16 + 4 * lq) = pack4bf(acc[mi][ni]);
                        if (lq == 0) wsp<float>(p, OFF_SSKV)[row * 4 + (tn - 7) * 2 + wn] = ss;
                    }
                } else if (wn == 0) {
                    const float2* rp = wsp<float2>(p, OFF_ROPE) + (long)row * 16 + 4 * lq;
                    f32x4 o1, o2;
#pragma unroll
                    for (int r = 0; r < 4; r++) {
                        const float2 cs = rp[r];
                        const float x1 = acc[mi][0][r], x2 = acc[mi][1][r];
                        o1[r] = x1 * cs.x - x2 * cs.y; o2[r] = x1 * cs.y + x2 * cs.x;
                    }
                    bf16_t* kr = wsp<bf16_t>(p, OFF_KR) + (long)row * 32;
                    *(u32x2*)(kr + 4 * lq) = pack4bf(o1);
                    *(u32x2*)(kr + 16 + 4 * lq) = pack4bf(o2);
                }
            }
        }
      }
      FOR_XCD_ITEMS_R(it, N_M) {
        f32x4 acc[4][4];
        {
            const int tm = it / 16, tn = it % 16;
            GemmTile g; g.A = wsp<bf16_t>(p, OFF_MEMB) + (long)tm * 256 * ND; g.lda = ND; g.arow = nullptr;
            g.Bt = wsp<bf16_t>(p, OFF_WMKVT) + (long)tn * 128 * ND; g.ldb = ND; g.K = ND;
            gemm_tile_256x128(g, lds, acc);
            const float* rm = wsp<float>(p, OFF_RMEM);
#pragma unroll
            for (int mi = 0; mi < 4; mi++) {
                const int row = tm * 256 + wm * 64 + mi * 16 + lr;
                const int b = row >> 8, m = row & 255;
                const float rs = rm[row];
#pragma unroll
                for (int ni = 0; ni < 4; ni++) {
                    const f32x4 v = acc[mi][ni] * rs;
                    const int col = tn * 128 + wn * 64 + ni * 16 + 4 * lq;
                    if (col < 1024) {
                        const int h = col >> 8, d = col & 255;
                        *(u32x2*)(wsp<bf16_t>(p, OFF_KMEM) + ((long)(b * 4 + h) * 256 + m) * 256 + d) = pack4bf(v);
                    } else {
                        const int c2 = col - 1024, h = c2 >> 8, dv = c2 & 255;
                        bf16_t* vt = wsp<bf16_t>(p, OFF_VTMEM) + ((long)(b * 4 + h) * 256 + dv) * 256 + m;
#pragma unroll
                        for (int r = 0; r < 4; r++) vt[r * 256] = (bf16_t)f2bf(v[r]);
                    }
                }
            }
        }
      }
    }
}

template <int MI>
__device__ __forceinline__ void dft_mma(const bf16_t* Ag, int arow0, const char* ximg, int ncol0, f32x4 (&acc)[MI][4]) {
    const int lane = VTID & 63, lq = lane >> 4, lr = lane & 15;
#pragma unroll
    for (int ks = 0; ks < 4; ks++) {
        bf16x8 af[MI], bfr[4];
#pragma unroll
        for (int mi = 0; mi < MI; mi++) af[mi] = *(const bf16x8*)(Ag + (long)(arow0 + mi * 16 + lr) * 128 + ks * 32 + lq * 8);
#pragma unroll
        for (int ni = 0; ni < 4; ni++) {
            const char* bp = ximg + (ks * 32 + lq * 8) * 272 + (ncol0 + ni * 16 + lr) * 2;
#pragma unroll
            for (int j = 0; j < 8; j++) bfr[ni][j] = *(const short*)(bp + j * 272);
        }
#pragma unroll
        for (int mi = 0; mi < MI; mi++)
#pragma unroll
            for (int ni = 0; ni < 4; ni++) acc[mi][ni] = __builtin_amdgcn_mfma_f32_16x16x32_bf16(bfr[ni], af[mi], acc[mi][ni], 0, 0, 0);
    }
}

__device__ __forceinline__ void f2a_item(const Params& p, int it, char* lds) {
    const int tid = VTID, lane = tid & 63, wid = tid >> 6, wm = wid >> 1, wn = wid & 1, lq = lane >> 4, lr = lane & 15;
    const int nc = it & 3, s2 = (it >> 2) & 63, b = it >> 8;
    char* uimg = lds; char* ximg = lds + 17408;
    __syncthreads();
#pragma unroll
    for (int i = 0; i < 4; i++) {
        const int ci = tid + 256 * i, row = ci >> 4, cc = ci & 15;
        *(u32x4*)(uimg + row * 272 + cc * 16) = *(const u32x4*)(wsp<bf16_t>(p, OFF_UF) + ((long)(b * NS + 64 * row + s2)) * 512 + nc * 128 + cc * 8);
    }
    __syncthreads();
    {
        const int g2 = wid >> 1, T = wid & 1;
        f32x4 a1[4][4];
#pragma unroll
        for (int mi = 0; mi < 4; mi++)
#pragma unroll
            for (int ni = 0; ni < 4; ni++) a1[mi][ni] = (f32x4){0.f, 0.f, 0.f, 0.f};
        const bf16_t* t64 = wsp<bf16_t>(p, OFF_T64) + T * 4096;
#pragma unroll
        for (int ks = 0; ks < 2; ks++) {
            bf16x8 af[4], bfr[4];
#pragma unroll
            for (int i = 0; i < 4; i++) {
                af[i] = *(const bf16x8*)(uimg + (i * 16 + lr) * 272 + (g2 * 64 + ks * 32 + lq * 8) * 2);
                bfr[i] = *(const bf16x8*)(t64 + (i * 16 + lr) * 64 + ks * 32 + lq * 8);
            }
#pragma unroll
            for (int mi = 0; mi < 4; mi++)
#pragma unroll
                for (int ni = 0; ni < 4; ni++) a1[mi][ni] = __builtin_amdgcn_mfma_f32_16x16x32_bf16(bfr[ni], af[mi], a1[mi][ni], 0, 0, 0);
        }
#pragma unroll
        for (int mi = 0; mi < 4; mi++)
#pragma unroll
            for (int ni = 0; ni < 4; ni++)
                *(u32x2*)(ximg + (T * 64 + mi * 16 + lr) * 272 + (g2 * 64 + ni * 16 + 4 * lq) * 2) = pack4bf(a1[mi][ni]);
    }
    __syncthreads();
    f32x4 acc[4][4];
#pragma unroll
    for (int mi = 0; mi < 4; mi++)
#pragma unroll
        for (int ni = 0; ni < 4; ni++) acc[mi][ni] = (f32x4){0.f, 0.f, 0.f, 0.f};
    dft_mma<4>(wsp<bf16_t>(p, OFF_M1), wm * 64, ximg, wn * 64, acc);
    const float2* tw = wsp<float2>(p, OFF_TW);
#pragma unroll
    for (int m2 = 0; m2 < 2; m2++) {
        const int k1 = 32 * wm + 16 * m2 + lr;
        float2 cs; { const float rev = (float)((s2 * k1) & 4095) * (1.0f / 4096.0f); cs.x = __builtin_amdgcn_cosf(rev); cs.y = __builtin_amdgcn_sinf(rev); (void)tw; }
        const long base = ((long)(b * 64 + k1) * 64 + s2) * 512 + nc * 128 + wn * 64 + 4 * lq;
#pragma unroll
        for (int ni = 0; ni < 4; ni++) {
            const f32x4 yr = acc[m2][ni], yi = acc[m2 + 2][ni];
            const f32x4 orr = yr * cs.x - yi * cs.y, oi = yi * cs.x + yr * cs.y;
            *(u32x2*)(wsp<bf16_t>(p, OFF_YR) + base + ni * 16) = pack4bf(orr);
            *(u32x2*)(wsp<bf16_t>(p, OFF_YI) + base + ni * 16) = pack4bf(oi);
        }
    }
}

__device__ __forceinline__ void f2b_item(const Params& p, int it, char* lds) {
    const int tid = VTID, lane = tid & 63, wid = tid >> 6, wm = wid >> 1, wn = wid & 1, lq = lane >> 4, lr = lane & 15;
    const int nc = it & 3, k1 = (it >> 2) & 63, b = it >> 8;
    char* ximg = lds; char* zimg = lds + 34816;
    __syncthreads();
#pragma unroll
    for (int i = 0; i < 8; i++) {
        const int ci = tid + 256 * i, row = ci >> 4, cc = ci & 15;
        const bf16_t* src = (row < 64 ? wsp<bf16_t>(p, OFF_YR) : wsp<bf16_t>(p, OFF_YI)) + ((long)(b * 64 + k1) * 64 + (row & 63)) * 512 + nc * 128 + cc * 8;
        *(u32x4*)(ximg + row * 272 + cc * 16) = *(const u32x4*)src;
    }
    __syncthreads();
    f32x4 acc[2][4];
#pragma unroll
    for (int mi = 0; mi < 2; mi++)
#pragma unroll
        for (int ni = 0; ni < 4; ni++) acc[mi][ni] = (f32x4){0.f, 0.f, 0.f, 0.f};
    dft_mma<2>(wsp<bf16_t>(p, OFF_M3), wm * 32, ximg, wn * 64, acc);
#pragma unroll
    for (int mi = 0; mi < 2; mi++)
#pragma unroll
        for (int ni = 0; ni < 4; ni++)
            *(u32x2*)(zimg + (wm * 32 + mi * 16 + lr) * 272 + (wn * 64 + ni * 16 + 4 * lq) * 2) = pack4bf(acc[mi][ni] * (1.0f / 512.0f));
    __syncthreads();
    f32x4 a3[2][4];
#pragma unroll
    for (int mi = 0; mi < 2; mi++)
#pragma unroll
        for (int ni = 0; ni < 4; ni++) a3[mi][ni] = (f32x4){0.f, 0.f, 0.f, 0.f};
    const bf16_t* wft = wsp<bf16_t>(p, OFF_WFT) + (long)(nc * 2 + wn) * 4096;
#pragma unroll
    for (int ks = 0; ks < 2; ks++) {
        bf16x8 af[2], bfr[4];
#pragma unroll
        for (int i = 0; i < 2; i++) af[i] = *(const bf16x8*)(zimg + (wm * 32 + i * 16 + lr) * 272 + (wn * 64 + ks * 32 + lq * 8) * 2);
#pragma unroll
        for (int i = 0; i < 4; i++) bfr[i] = *(const bf16x8*)(wft + (i * 16 + lr) * 64 + ks * 32 + lq * 8);
#pragma unroll
        for (int mi = 0; mi < 2; mi++)
#pragma unroll
            for (int ni = 0; ni < 4; ni++) a3[mi][ni] = __builtin_amdgcn_mfma_f32_16x16x32_bf16(bfr[ni], af[mi], a3[mi][ni], 0, 0, 0);
    }
#pragma unroll
    for (int mi = 0; mi < 2; mi++) {
        const int k2 = wm * 32 + mi * 16 + lr;
        bf16_t* dst = wsp<bf16_t>(p, OFF_ZA) + ((long)(b * NS + k1 + 64 * k2)) * 1024 + nc * 128 + wn * 64 + 4 * lq;
#pragma unroll
        for (int ni = 0; ni < 4; ni++) *(u32x2*)(dst + ni * 16) = pack4bf(a3[mi][ni]);
    }
}

__device__ __forceinline__ void phase2(const Params& p, char* lds) {
    const int tid = threadIdx.x, lane = tid & 63, wid = tid >> 6, wm = wid >> 1, wn = wid & 1, lq = lane >> 4, lr = lane & 15;
    constexpr int N_Q = 64 * 6, N_KV = 64 * 8;
    {
      FOR_XCD_ITEMS_R(item, N_Q) {
        f32x4 acc[4][4];
        {
            const int tm = item / 6, tn = item % 6;
            GemmTile g; g.A = wsp<bf16_t>(p, OFF_UQ) + (long)tm * 256 * 384; g.lda = 384; g.arow = nullptr;
            g.Bt = wsp<bf16_t>(p, OFF_WQT) + (long)tn * 128 * 384; g.ldb = 384; g.K = 384;
            gemm_tile_256x128(g, lds, acc);
            const float qmul = 0.10206207261596575f * 1.4426950408889634f;
#pragma unroll
            for (int mi = 0; mi < 4; mi++) {
                const int row = tm * 256 + wm * 64 + mi * 16 + lr;
                const int b = row >> 12, s = row & 4095;
                const float* sq = wsp<float>(p, OFF_SSQ) + (long)row * 6;
                const float ss = sq[0] + sq[1] + sq[2] + sq[3] + sq[4] + sq[5];
                const float rs = rsqrtf(ss * (1.f / 384.f) + 1e-6f) * qmul;
                const int cb0 = tn * 128 + wn * 64;
#pragma unroll
                for (int ni = 0; ni < 4; ni++) {
                    const int cb = cb0 + ni * 16, hd = cb / 96, hob = cb % 96;
                    bf16_t* qd = wsp<bf16_t>(p, OFF_Q) + ((long)(b * 8 + hd) * NS + s) * 96;
                    if (hob < 64) {
                        *(u32x2*)(qd + hob + 4 * lq) = pack4bf(acc[mi][ni] * rs);
                    } else if (hob == 64) {
                        if (ni < 3) {
                            const float2* rp = wsp<float2>(p, OFF_ROPE) + (long)row * 16 + 4 * lq;
                            f32x4 o1, o2;
#pragma unroll
                            for (int r = 0; r < 4; r++) {
                                const float2 cs = rp[r];
                                const float x1 = acc[mi][ni][r] * rs, x2 = acc[mi][ni < 3 ? ni + 1 : 3][r] * rs;
                                o1[r] = x1 * cs.x - x2 * cs.y; o2[r] = x1 * cs.y + x2 * cs.x;
                            }
                            *(u32x2*)(qd + 64 + 4 * lq) = pack4bf(o1);
                            *(u32x2*)(qd + 80 + 4 * lq) = pack4bf(o2);
                        }
                    }
                }
            }
        }
      }
      FOR_XCD_ITEMS_R(it, N_KV) {
        f32x4 acc[4][4];
        {
            const int tm = it >> 3, hd = it & 7;
            GemmTile g; g.A = wsp<bf16_t>(p, OFF_UKV) + (long)tm * 256 * 256; g.lda = 256; g.arow = nullptr;
            g.Bt = wsp<bf16_t>(p, OFF_WKVT) + (long)hd * 128 * 256; g.ldb = 256; g.K = 256;
            gemm_tile_256x128(g, lds, acc);
#pragma unroll
            for (int mi = 0; mi < 4; mi++) {
                const int row = tm * 256 + wm * 64 + mi * 16 + lr;
                const int b = row >> 12, s = row & 4095;
                const float* sq = wsp<float>(p, OFF_SSKV) + (long)row * 4;
                const float rs = rsqrtf((sq[0] + sq[1] + sq[2] + sq[3]) * (1.f / 256.f) + 1e-6f);
                if (wn == 0) {
                    bf16_t* kd = wsp<bf16_t>(p, OFF_K) + ((long)(b * 8 + hd) * NS + s) * 96;
#pragma unroll
                    for (int ni = 0; ni < 4; ni++) *(u32x2*)(kd + ni * 16 + 4 * lq) = pack4bf(acc[mi][ni] * rs);
                } else {
#pragma unroll
                    for (int ni = 0; ni < 4; ni++) {
                        bf16_t* vd = wsp<bf16_t>(p, OFF_VT) + ((long)(b * 8 + hd) * 64 + ni * 16 + 4 * lq) * NS + s;
#pragma unroll
                        for (int r = 0; r < 4; r++) vd[(long)r * NS] = (bf16_t)f2bf(acc[mi][ni][r] * rs);
                    }
                }
            }
#pragma unroll
            for (int i = 0; i < 2; i++) {
                const int ci = tid + 512 * i, r = ci >> 2, cc = ci & 3;
                const int row = tm * 256 + r, b = row >> 12, s = row & 4095;
                *(u32x4*)(wsp<bf16_t>(p, OFF_K) + ((long)(b * 8 + hd) * NS + s) * 96 + 64 + cc * 8) = *(const u32x4*)(wsp<bf16_t>(p, OFF_KR) + (long)row * 32 + cc * 8);
            }
        }
      }
    }
}


__device__ __forceinline__ void phase2_f2a(const Params& p, char* lds) {
    FOR_XCD_ITEMS(it, 1024) { f2a_item(p, it, lds); }
}

__device__ __forceinline__ void expert_tr_job(const Params& p, int j, char* lds) {
    const int which = j >> 11, r = j & 2047, e = r >> 7, t = r & 127;
    const int k0 = (t >> 3) * 64, n0 = (t & 7) * 128;
    if (which == 0) tr_tile(p.w_exp_gate + (long)e * 1048576, 1024, k0, n0, 1024, p.g_ffn, wsp<bf16_t>(p, OFF_WGUT) + (long)e * 2048 * 1024, 1024, 1, lds);
    else if (which == 1) tr_tile(p.w_exp_up + (long)e * 1048576, 1024, k0, n0, 1024, p.g_ffn, wsp<bf16_t>(p, OFF_WGUT) + (long)e * 2048 * 1024, 1024, 2, lds);
    else tr_tile(p.w_exp_down + (long)e * 1048576, 1024, k0, n0, 1024, nullptr, wsp<bf16_t>(p, OFF_WDT) + (long)e * 1048576, 1024, 0, lds);
}

__device__ __forceinline__ void phase3_tr(const Params& p, char* lds) {
    for (int j = VBLK; j < 6144; j += VGRID) expert_tr_job(p, j, lds);
}
__device__ __forceinline__ void phase3_f2b(const Params& p, char* lds) {
    FOR_XCD_ITEMS(it, 1024) { f2b_item(p, it, lds); }
}

__device__ __forceinline__ void phase_resid(const Params& p, char* lds, size_t offA, size_t offW, const float* residf, const bf16_t* residb, size_t offXb, size_t offSS) {
    const int tid = VTID, lane = tid & 63, wid = tid >> 6, wm = wid >> 1, wn = wid & 1, lq = lane >> 4, lr = lane & 15;
    FOR_XCD_ITEMS(item, 128 * 8) {
        const int tm = item >> 3, tn = item & 7;
        f32x4 acc[4][4];
        GemmTile g; g.A = wsp<bf16_t>(p, offA) + (long)tm * 128 * ND; g.lda = ND; g.arow = nullptr;
        g.Bt = wsp<bf16_t>(p, offW) + (long)tn * 128 * ND; g.ldb = ND; g.K = ND;
        gemm_tile_128(g, lds, acc);
#pragma unroll
        for (int mi = 0; mi < 4; mi++) {
            const int row = tm * 128 + wm * 64 + mi * 16 + lr;
            float ss = 0.f;
#pragma unroll
            for (int ni = 0; ni < 4; ni++) {
                const long o = (long)row * ND + tn * 128 + wn * 64 + ni * 16 + 4 * lq;
                f32x4 rv;
                if (residf) rv = *(const f32x4*)(residf + o);
                else { const u32x2 w = *(const u32x2*)(residb + o); rv = (f32x4){__uint_as_float(w.x << 16), __uint_as_float(w.x & 0xFFFF0000u), __uint_as_float(w.y << 16), __uint_as_float(w.y & 0xFFFF0000u)}; }
                const f32x4 v = rv + acc[mi][ni];
                *(u32x2*)(wsp<bf16_t>(p, offXb) + o) = pack4bf(v);
                ss += v[0] * v[0] + v[1] * v[1] + v[2] * v[2] + v[3] * v[3];
            }
            ss += __shfl_xor(ss, 16); ss += __shfl_xor(ss, 32);
            if (lq == 0) wsp<float>(p, offSS)[row * 16 + tn * 2 + wn] = ss;
        }
    }
}
__device__ __forceinline__ float row_rs16(const float* ss) {
    const f32x4 a = *(const f32x4*)ss, b = *(const f32x4*)(ss + 4), c = *(const f32x4*)(ss + 8), d = *(const f32x4*)(ss + 12);
    const f32x4 t = (a + b) + (c + d);
    return rsqrtf(((t[0] + t[1]) + (t[2] + t[3])) * (1.f / 1024.f) + 1e-6f);
}

__device__ __forceinline__ void phase5a(const Params& p, char* lds) {
    const int tid = VTID, lane = tid & 63, wid = tid >> 6, wm = wid >> 1, wn = wid & 1, lq = lane >> 4, lr = lane & 15;
    FOR_XCD_ITEMS(item, 128 * 8) {
        const int tm = item >> 3, tn = item & 7;
        f32x4 acc[4][4];
        GemmTile g; g.A = wsp<bf16_t>(p, OFF_X1B) + (long)tm * 128 * ND; g.lda = ND; g.arow = nullptr;
        g.Bt = wsp<bf16_t>(p, OFF_WMQT) + (long)tn * 128 * ND; g.ldb = ND; g.K = ND;
        gemm_tile_128(g, lds, acc);
        const int h = tn >> 1;
#pragma unroll
        for (int mi = 0; mi < 4; mi++) {
            const int row = tm * 128 + wm * 64 + mi * 16 + lr, b = row >> 12, s = row & 4095;
            const float rs = row_rs16(wsp<float>(p, OFF_SS1) + (long)row * 16) * (0.0625f * 1.4426950408889634f);
            bf16_t* qd = wsp<bf16_t>(p, OFF_QM) + ((long)(b * 4 + h) * NS + s) * 256 + (tn & 1) * 128 + wn * 64 + 4 * lq;
#pragma unroll
            for (int ni = 0; ni < 4; ni++) *(u32x2*)(qd + ni * 16) = pack4bf(acc[mi][ni] * rs);
        }
    }
}
__device__ __forceinline__ void phase5b(const Params& p, char* lds) {
    FOR_XCD_ITEMS(item, NB * 4 * 32 * 2) {
        const int dvh = item & 1, qt = (item >> 1) & 31, h = (item >> 6) & 3, b = item >> 8;
        const bf16_t* Qp = wsp<bf16_t>(p, OFF_QM) + ((long)(b * 4 + h) * NS + qt * 128) * 256;
        const bf16_t* Kp = wsp<bf16_t>(p, OFF_KMEM) + ((long)(b * 4 + h) * 256) * 256;
        const bf16_t* Vtp = wsp<bf16_t>(p, OFF_VTMEM) + ((long)(b * 4 + h) * 256 + dvh * 128) * 256;
        bf16_t* Op = wsp<bf16_t>(p, OFF_OM) + ((long)b * NS + qt * 128) * 1024 + h * 256 + dvh * 128;
        attn_block<256, 128, 32, 256>(Qp, Kp, Vtp, 256L, 256, lds, [&](int q, int dv, f32x4 v) { *(u32x2*)(Op + (long)q * 1024 + dv) = pack4bf(v); });
    }
}

__device__ __forceinline__ void phase7(const Params& p, char* lds) {
    const int tid = VTID, lane = tid & 63, wid = tid >> 6;
    float* wr = (float*)lds;
    __syncthreads();
    for (int i = tid; i < 16384; i += 256) { const int k = i >> 4, e = i & 15; wr[e * 1024 + k] = p.w_router[i] * p.g_ffn[k]; }
    __syncthreads();
    for (int tok = VBLK * 4 + wid; tok < NT; tok += VGRID * 4) {
        const bf16_t* xr = wsp<bf16_t>(p, OFF_X2B) + (long)tok * ND;
        float a[16];
#pragma unroll
        for (int e = 0; e < 16; e++) a[e] = 0.f;
#pragma unroll 2
        for (int j = 0; j < 8; j++) {
            const unsigned xw = *(const unsigned*)(xr + 2 * lane + 128 * j);
            const float x0 = __uint_as_float(xw << 16), x1 = __uint_as_float(xw & 0xFFFF0000u);
#pragma unroll
            for (int e = 0; e < 16; e++) {
                const f32x2 w = *(const f32x2*)(wr + e * 1024 + 2 * lane + 128 * j);
                a[e] += x0 * w[0] + x1 * w[1];
            }
        }
#pragma unroll
        for (int i = 0; i < 8; i++) { const bool hi = lane & 32; const float send = hi ? a[i] : a[i + 8], keep = hi ? a[i + 8] : a[i]; a[i] = keep + __shfl_xor(send, 32); }
#pragma unroll
        for (int i = 0; i < 4; i++) { const bool hi = lane & 16; const float send = hi ? a[i] : a[i + 4], keep = hi ? a[i + 4] : a[i]; a[i] = keep + __shfl_xor(send, 16); }
#pragma unroll
        for (int i = 0; i < 2; i++) { const bool hi = lane & 8; const float send = hi ? a[i] : a[i + 2], keep = hi ? a[i + 2] : a[i]; a[i] = keep + __shfl_xor(send, 8); }
        { const bool hi = lane & 4; const float send = hi ? a[0] : a[1], keep = hi ? a[1] : a[0]; a[0] = keep + __shfl_xor(send, 4); }
        float lg = a[0];
        lg += __shfl_xor(lg, 2); lg += __shfl_xor(lg, 1);
        const int e = ((lane >> 5) & 1) * 8 + ((lane >> 4) & 1) * 4 + ((lane >> 3) & 1) * 2 + ((lane >> 2) & 1);
        lg *= row_rs16(wsp<float>(p, OFF_SS2) + (long)tok * 16);
        float mx = lg;
#pragma unroll
        for (int o = 4; o < 64; o <<= 1) mx = fmaxf(mx, __shfl_xor(mx, o));
        const float ex = expf(lg - mx);
        float sm = ex;
#pragma unroll
        for (int o = 4; o < 64; o <<= 1) sm += __shfl_xor(sm, o);
        if ((lane & 3) == 0) wsp<float>(p, OFF_AFF)[(long)tok * 16 + e] = ex / sm;
    }
}

__device__ __forceinline__ int block_sum_i(int v, int* red) {
    const int lane = VTID & 63, wid = VTID >> 6;
#pragma unroll
    for (int o = 32; o > 0; o >>= 1) v += __shfl_xor(v, o);
    __syncthreads();
    if (lane == 0) red[wid] = v;
    __syncthreads();
    return red[0] + red[1] + red[2] + red[3];
}
__device__ __forceinline__ int block_excl_scan_i(int v, int* red, int& total) {
    const int lane = VTID & 63, wid = VTID >> 6;
    int inc = v;
#pragma unroll
    for (int o = 1; o < 64; o <<= 1) { const int t = __shfl_up(inc, o); if (lane >= o) inc += t; }
    __syncthreads();
    if (lane == 63) red[wid] = inc;
    __syncthreads();
    int base = 0;
#pragma unroll
    for (int w = 0; w < 4; w++) if (w < wid) base += red[w];
    total = red[0] + red[1] + red[2] + red[3];
    return base + inc - v;
}
__device__ __forceinline__ void phase8(const Params& p, char* lds) {
    int* red = (int*)lds;
    const int tid = VTID;
    for (int item = VBLK; item < NB * NE; item += VGRID) {
        const int e = item & 15, b = item >> 4;
        const float* aff = wsp<float>(p, OFF_AFF) + (long)b * NS * 16 + e;
        unsigned v[16];
#pragma unroll
        for (int i = 0; i < 16; i++) v[i] = __float_as_uint(aff[(long)(tid * 16 + i) * 16]);
        unsigned T = 0;
        for (int bit = 30; bit >= 0; bit--) {
            const unsigned cand = T | (1u << bit);
            int c = 0;
#pragma unroll
            for (int i = 0; i < 16; i++) c += (v[i] >= cand) ? 1 : 0;
            if (block_sum_i(c, red) >= CAP) T = cand;
        }
        int cg = 0, ce = 0;
#pragma unroll
        for (int i = 0; i < 16; i++) { cg += (v[i] > T) ? 1 : 0; ce += (v[i] == T) ? 1 : 0; }
        int tot;
        const int pk = block_excl_scan_i(cg | (ce << 16), red, tot);
        const int need = CAP - (tot & 0xFFFF);
        const int pe = pk >> 16;
        int nse = need - pe; nse = nse < 0 ? 0 : (nse > ce ? ce : nse);
        int tot2;
        int slot = block_excl_scan_i(cg + nse, red, tot2);
        int* slots = wsp<int>(p, OFF_SLOTS) + (long)(b * NE + e) * NS;
        int* idx = wsp<int>(p, OFF_IDX) + (long)(b * NE + e) * CAP;
        float* gate = wsp<float>(p, OFF_GATE) + (long)(b * NE + e) * CAP;
        int eqs = 0;
#pragma unroll
        for (int i = 0; i < 16; i++) {
            const int t = tid * 16 + i;
            bool sel = v[i] > T;
            if (v[i] == T) { sel = eqs < nse; eqs++; }
            if (sel) { slots[t] = slot; idx[slot] = b * NS + t; gate[slot] = __uint_as_float(v[i]); slot++; }
            else slots[t] = -1;
        }
    }
}

__device__ __forceinline__ void phase9(const Params& p, char* lds) {
    const int tid = VTID, lane = tid & 63, wid = tid >> 6, wm = wid >> 1, wn = wid & 1, lq = lane >> 4, lr = lane & 15;
    FOR_XCD_ITEMS(item, NE * 16 * NB * 4) {
        const int rt = item & 3, b = (item >> 2) & 3, ct = (item >> 4) & 15, e = item >> 8;
        const int* arow = wsp<int>(p, OFF_IDX) + (long)(b * NE + e) * CAP + rt * 128;
        f32x4 acc[4][4];
        GemmTile g; g.A = wsp<bf16_t>(p, OFF_X2B); g.lda = ND; g.arow = arow;
        g.Bt = wsp<bf16_t>(p, OFF_WGUT) + ((long)e * 2048 + ct * 128) * ND; g.ldb = ND; g.K = ND;
        gemm_tile_128(g, lds, acc);
#pragma unroll
        for (int mi = 0; mi < 4; mi++) {
            const int r = wm * 64 + mi * 16 + lr;
            const int tok = arow[r];
            const float rs = row_rs16(wsp<float>(p, OFF_SS2) + (long)tok * 16);
            bf16_t* ad = wsp<bf16_t>(p, OFF_ACT) + ((long)(e * NB + b) * CAP + rt * 128 + r) * ND + ct * 64 + wn * 32 + 4 * lq;
#pragma unroll
            for (int pp = 0; pp < 2; pp++) {
                f32x4 o;
#pragma unroll
                for (int q = 0; q < 4; q++) {
                    const float ga = acc[mi][2 * pp][q] * rs, up = acc[mi][2 * pp + 1][q] * rs;
                    o[q] = ga / (1.f + __expf(-ga)) * up;
                }
                *(u32x2*)(ad + pp * 16) = pack4bf(o);
            }
        }
    }
}
__device__ __forceinline__ void phase10(const Params& p, char* lds) {
    const int tid = VTID, lane = tid & 63, wid = tid >> 6, wm = wid >> 1, wn = wid & 1, lq = lane >> 4, lr = lane & 15;
    FOR_XCD_ITEMS(item, NE * 8 * NB * 4) {
        const int rt = item & 3, b = (item >> 2) & 3, ct = (item >> 4) & 7, e = item >> 7;
        const long row0 = (long)(e * NB + b) * CAP + rt * 128;
        f32x4 acc[4][4];
        GemmTile g; g.A = wsp<bf16_t>(p, OFF_ACT) + row0 * ND; g.lda = ND; g.arow = nullptr;
        g.Bt = wsp<bf16_t>(p, OFF_WDT) + ((long)e * 1024 + ct * 128) * ND; g.ldb = ND; g.K = ND;
        gemm_tile_128(g, lds, acc);
        const float* gate = wsp<float>(p, OFF_GATE) + (long)(b * NE + e) * CAP + rt * 128;
#pragma unroll
        for (int mi = 0; mi < 4; mi++) {
            const int r = wm * 64 + mi * 16 + lr;
            const float gv = gate[r];
            bf16_t* yd = wsp<bf16_t>(p, OFF_Y) + (row0 + r) * ND + ct * 128 + wn * 64 + 4 * lq;
#pragma unroll
            for (int ni = 0; ni < 4; ni++) *(u32x2*)(yd + ni * 16) = pack4bf(acc[mi][ni] * gv);
        }
    }
}

__device__ __forceinline__ void phase11(const Params& p, char* lds) {
    const int tid = VTID, lane = tid & 63, wid = tid >> 6;
    for (int tok = VBLK * 4 + wid; tok < NT; tok += VGRID * 4) {
        const int b = tok >> 12, t = tok & 4095;
        float* xr = p.out + (long)tok * ND;
        const bf16_t* xb2 = wsp<bf16_t>(p, OFF_X2B) + (long)tok * ND;
        f32x4 v[4];
#pragma unroll
        for (int i = 0; i < 4; i++) {
            const u32x2 w = *(const u32x2*)(xb2 + i * 256 + lane * 4);
            v[i] = (f32x4){__uint_as_float(w.x << 16), __uint_as_float(w.x & 0xFFFF0000u), __uint_as_float(w.y << 16), __uint_as_float(w.y & 0xFFFF0000u)};
        }
        for (int e = 0; e < NE; e++) {
            const int sl = wsp<int>(p, OFF_SLOTS)[(long)(b * NE + e) * NS + t];
            if (sl >= 0) {
                const bf16_t* yr = wsp<bf16_t>(p, OFF_Y) + ((long)(e * NB + b) * CAP + sl) * ND;
#pragma unroll
                for (int i = 0; i < 4; i++) {
                    const u32x2 w = *(const u32x2*)(yr + i * 256 + lane * 4);
                    v[i][0] += __uint_as_float(w.x << 16); v[i][1] += __uint_as_float(w.x & 0xFFFF0000u);
                    v[i][2] += __uint_as_float(w.y << 16); v[i][3] += __uint_as_float(w.y & 0xFFFF0000u);
                }
            }
        }
        float ss = 0.f;
#pragma unroll
        for (int i = 0; i < 4; i++) ss += v[i][0] * v[i][0] + v[i][1] * v[i][1] + v[i][2] * v[i][2] + v[i][3] * v[i][3];
        ss = wave_sum(ss);
        const float rs = rsqrtf(ss * (1.f / ND) + 1e-6f);
#pragma unroll
        for (int i = 0; i < 4; i++) {
            const f32x4 gf = *(const f32x4*)(p.g_final + i * 256 + lane * 4);
            *(f32x4*)(xr + i * 256 + lane * 4) = v[i] * rs * gf;
        }
    }
}


__device__ __forceinline__ void phase_resid8(const Params& p, char* lds, size_t offA, size_t offW, const float* residf, const bf16_t* residb, size_t offXb, size_t offSS) {
    const int tid = threadIdx.x, lane = tid & 63, wid = tid >> 6, wm = wid >> 2, wn = wid & 3, lq = lane >> 4, lr = lane & 15;
    FOR_XCD_ITEMS_R(item, 64 * 4) {
        const int tm = item >> 2, tn = item & 3;
        f32x4 acc[8][4];
        GemmTile g; g.A = wsp<bf16_t>(p, offA) + (long)tm * 256 * ND; g.lda = ND; g.arow = nullptr;
        g.Bt = wsp<bf16_t>(p, offW) + (long)tn * 256 * ND; g.ldb = ND; g.K = ND;
        gemm_tile_256sq(g, lds, acc);
#pragma unroll
        for (int mi = 0; mi < 8; mi++) {
            const int row = tm * 256 + wm * 128 + mi * 16 + lr;
            float ss = 0.f;
#pragma unroll
            for (int ni = 0; ni < 4; ni++) {
                const long o = (long)row * ND + tn * 256 + wn * 64 + ni * 16 + 4 * lq;
                f32x4 rv;
                if (residf) rv = *(const f32x4*)(residf + o);
                else { const u32x2 w = *(const u32x2*)(residb + o); rv = (f32x4){__uint_as_float(w.x << 16), __uint_as_float(w.x & 0xFFFF0000u), __uint_as_float(w.y << 16), __uint_as_float(w.y & 0xFFFF0000u)}; }
                const f32x4 v = rv + acc[mi][ni];
                *(u32x2*)(wsp<bf16_t>(p, offXb) + o) = pack4bf(v);
                ss += v[0] * v[0] + v[1] * v[1] + v[2] * v[2] + v[3] * v[3];
            }
            ss += __shfl_xor(ss, 16); ss += __shfl_xor(ss, 32);
            if (lq == 0) wsp<float>(p, offSS)[row * 16 + tn * 4 + wn] = ss;
        }
    }
}
__device__ __forceinline__ void phase5a8(const Params& p, char* lds) {
    const int tid = threadIdx.x, lane = tid & 63, wid = tid >> 6, wm = wid >> 2, wn = wid & 3, lq = lane >> 4, lr = lane & 15;
    FOR_XCD_ITEMS_R(item, 64 * 4) {
        const int tm = item >> 2, tn = item & 3;
        f32x4 acc[8][4];
        GemmTile g; g.A = wsp<bf16_t>(p, OFF_X1B) + (long)tm * 256 * ND; g.lda = ND; g.arow = nullptr;
        g.Bt = wsp<bf16_t>(p, OFF_WMQT) + (long)tn * 256 * ND; g.ldb = ND; g.K = ND;
        gemm_tile_256sq(g, lds, acc);
#pragma unroll
        for (int mi = 0; mi < 8; mi++) {
            const int row = tm * 256 + wm * 128 + mi * 16 + lr, b = row >> 12, s = row & 4095;
            const float rs = row_rs16(wsp<float>(p, OFF_SS1) + (long)row * 16) * (0.0625f * 1.4426950408889634f);
            bf16_t* qd = wsp<bf16_t>(p, OFF_QM) + ((long)(b * 4 + tn) * NS + s) * 256 + wn * 64 + 4 * lq;
#pragma unroll
            for (int ni = 0; ni < 4; ni++) *(u32x2*)(qd + ni * 16) = pack4bf(acc[mi][ni] * rs);
        }
    }
}


__device__ __forceinline__ void phase9_8(const Params& p, char* lds) {
    const int tid = threadIdx.x, lane = tid & 63, wid = tid >> 6, wm = wid >> 2, wn = wid & 3, lq = lane >> 4, lr = lane & 15;
    FOR_XCD_ITEMS_R(item, NE * 8 * NB * 2) {
        const int rt = item & 1, b = (item >> 1) & 3, ct = (item >> 3) & 7, e = item >> 6;
        const int* arow = wsp<int>(p, OFF_IDX) + (long)(b * NE + e) * CAP + rt * 256;
        f32x4 acc[8][4];
        GemmTile g; g.A = wsp<bf16_t>(p, OFF_X2B); g.lda = ND; g.arow = arow;
        g.Bt = wsp<bf16_t>(p, OFF_WGUT) + ((long)e * 2048 + ct * 256) * ND; g.ldb = ND; g.K = ND;
        gemm_tile_256sq(g, lds, acc);
#pragma unroll
        for (int mi = 0; mi < 8; mi++) {
            const int r = wm * 128 + mi * 16 + lr;
            const int tok = arow[r];
            const float rs = row_rs16(wsp<float>(p, OFF_SS2) + (long)tok * 16);
            bf16_t* ad = wsp<bf16_t>(p, OFF_ACT) + ((long)(e * NB + b) * CAP + rt * 256 + r) * ND + ct * 128 + wn * 32 + 4 * lq;
#pragma unroll
            for (int pp = 0; pp < 2; pp++) {
                f32x4 o;
#pragma unroll
                for (int q = 0; q < 4; q++) {
                    const float ga = acc[mi][2 * pp][q] * rs, up = acc[mi][2 * pp + 1][q] * rs;
                    o[q] = ga / (1.f + __expf(-ga)) * up;
                }
                *(u32x2*)(ad + pp * 16) = pack4bf(o);
            }
        }
    }
}
__device__ __forceinline__ void phase10_8(const Params& p, char* lds) {
    const int tid = threadIdx.x, lane = tid & 63, wid = tid >> 6, wm = wid >> 2, wn = wid & 3, lq = lane >> 4, lr = lane & 15;
    FOR_XCD_ITEMS_R(item, NE * 4 * NB * 2) {
        const int rt = item & 1, b = (item >> 1) & 3, ct = (item >> 3) & 3, e = item >> 5;
        const long row0 = (long)(e * NB + b) * CAP + rt * 256;
        f32x4 acc[8][4];
        GemmTile g; g.A = wsp<bf16_t>(p, OFF_ACT) + row0 * ND; g.lda = ND; g.arow = nullptr;
        g.Bt = wsp<bf16_t>(p, OFF_WDT) + ((long)e * 1024 + ct * 256) * ND; g.ldb = ND; g.K = ND;
        gemm_tile_256sq(g, lds, acc);
        const float* gate = wsp<float>(p, OFF_GATE) + (long)(b * NE + e) * CAP + rt * 256;
#pragma unroll
        for (int mi = 0; mi < 8; mi++) {
            const int r = wm * 128 + mi * 16 + lr;
            const float gv = gate[r];
            bf16_t* yd = wsp<bf16_t>(p, OFF_Y) + (row0 + r) * ND + ct * 256 + wn * 64 + 4 * lq;
#pragma unroll
            for (int ni = 0; ni < 4; ni++) *(u32x2*)(yd + ni * 16) = pack4bf(acc[mi][ni] * gv);
        }
    }
}


__device__ __forceinline__ void phase1_big(const Params& p, char* lds) {
    const int tid = threadIdx.x, lane = tid & 63, wid = tid >> 6, wm = wid >> 2, wn = wid & 3, lq = lane >> 4, lr = lane & 15;
    FOR_XCD_ITEMS_R(item, 64 * 4) {
        const int tm = item >> 2, tn = item & 3;
        f32x4 acc[8][4];
        GemmTile g; g.A = wsp<bf16_t>(p, OFF_XB) + (long)tm * 256 * ND; g.lda = ND; g.arow = nullptr;
        g.Bt = wsp<bf16_t>(p, OFF_W1T) + (long)tn * 256 * ND; g.ldb = ND; g.K = ND;
        gemm_tile_256sq(g, lds, acc);
        const float* r0 = wsp<float>(p, OFF_R0);
        const int col0 = tn * 256 + wn * 64;
#pragma unroll
        for (int mi = 0; mi < 8; mi++) {
            const int row = tm * 256 + wm * 128 + mi * 16 + lr;
            const float rs = r0[row];
#pragma unroll
            for (int ni = 0; ni < 4; ni++) acc[mi][ni] *= rs;
            if (col0 < 512) {
#pragma unroll
                for (int ni = 0; ni < 4; ni++)
                    *(u32x2*)(wsp<bf16_t>(p, OFF_UF) + (long)row * 512 + col0 + ni * 16 + 4 * lq) = pack4bf(acc[mi][ni]);
            } else {
                float ss = 0.f;
#pragma unroll
                for (int ni = 0; ni < 4; ni++) { const f32x4 v = acc[mi][ni]; ss += v[0] * v[0] + v[1] * v[1] + v[2] * v[2] + v[3] * v[3]; }
                ss += __shfl_xor(ss, 16); ss += __shfl_xor(ss, 32);
                if (col0 < 896) {
#pragma unroll
                    for (int ni = 0; ni < 4; ni++)
                        *(u32x2*)(wsp<bf16_t>(p, OFF_UQ) + (long)row * 384 + (col0 - 512) + ni * 16 + 4 * lq) = pack4bf(acc[mi][ni]);
                    if (lq == 0) wsp<float>(p, OFF_SSQ)[row * 6 + ((col0 - 512) >> 6)] = ss;
                } else {
#pragma unroll
                    for (int ni = 0; ni < 4; ni++)
                        *(u32x2*)(wsp<bf16_t>(p, OFF_UKV) + (long)row * 256 + (col0 - 896) + ni * 16 + 4 * lq) = pack4bf(acc[mi][ni]);
                    if (lq == 0) wsp<float>(p, OFF_SSKV)[row * 4 + ((col0 - 896) >> 6)] = ss;
                }
            }
        }
    }
}


__device__ __forceinline__ void phase3_attn8(const Params& p, char* lds) {
    FOR_XCD_ITEMS_R(item, NB * 8 * (NS / 256)) {
        const int qt = item & 15, h = (item >> 4) & 7, b = item >> 7;
        const bf16_t* Qp = wsp<bf16_t>(p, OFF_Q) + ((long)(b * 8 + h) * NS + qt * 256) * 96;
        const bf16_t* Kp = wsp<bf16_t>(p, OFF_K) + ((long)(b * 8 + h) * NS) * 96;
        const bf16_t* Vtp = wsp<bf16_t>(p, OFF_VT) + ((long)(b * 8 + h) * 64) * NS;
        bf16_t* Op = wsp<bf16_t>(p, OFF_ZA) + ((long)b * NS + qt * 256) * 1024 + 512 + h * 64;
        attn_block<96, 64, 128, 512>(Qp, Kp, Vtp, (long)NS, NS, lds, [&](int q, int dv, f32x4 v) { *(u32x2*)(Op + (long)q * 1024 + dv) = pack4bf(v); });
    }
}
__device__ __forceinline__ void phase5b_8(const Params& p, char* lds) {
    FOR_XCD_ITEMS_R(item, NB * 4 * 16 * 2) {
        const int dvh = item & 1, qt = (item >> 1) & 15, h = (item >> 5) & 3, b = item >> 7;
        const bf16_t* Qp = wsp<bf16_t>(p, OFF_QM) + ((long)(b * 4 + h) * NS + qt * 256) * 256;
        const bf16_t* Kp = wsp<bf16_t>(p, OFF_KMEM) + ((long)(b * 4 + h) * 256) * 256;
        const bf16_t* Vtp = wsp<bf16_t>(p, OFF_VTMEM) + ((long)(b * 4 + h) * 256 + dvh * 128) * 256;
        bf16_t* Op = wsp<bf16_t>(p, OFF_OM) + ((long)b * NS + qt * 256) * 1024 + h * 256 + dvh * 128;
        attn_block<256, 128, 32, 512>(Qp, Kp, Vtp, 256L, 256, lds, [&](int q, int dv, f32x4 v) { *(u32x2*)(Op + (long)q * 1024 + dv) = pack4bf(v); });
    }
}

__global__ void __launch_bounds__(512, 1) k_fwd(Params p, int ph_lo, int ph_hi) {
    extern __shared__ __attribute__((aligned(16))) char lds_all[];
    char* lds = lds_all + VHALF * LDS_HALF;
    volatile LAS unsigned* st = (volatile LAS unsigned*)(lds_all + LDS_MAIN);
    if (threadIdx.x == 0) { st[0] = 0u; st[1] = 0u; }
    __syncthreads();
    XcdBarrier bar = xcd_barrier_post(wsp<unsigned>(p, OFF_BAR), st);
#if USE_CG_SYNC
#define GRID_BARRIER() do { asm volatile("s_waitcnt vmcnt(0)" ::: "memory"); __syncthreads(); cg::this_grid().sync(); asm volatile("s_waitcnt vmcnt(0)" ::: "memory"); __syncthreads(); } while (0)
#else
#define GRID_BARRIER() xcd_barrier(bar)
#endif
#define RUN_PHASE(k, call) if (ph_lo <= (k) && (k) < ph_hi) { if ((k) > ph_lo) { GRID_BARRIER(); } call; }
    RUN_PHASE(0, phase0(p, lds))
    RUN_PHASE(1, (phase1_big(p, lds_all), phase1(p, lds_all)))
    RUN_PHASE(2, (phase2(p, lds_all), phase2_f2a(p, lds)))
    RUN_PHASE(3, ((blockIdx.x & 1) ? phase3_tr(p, lds) : (void)0, phase3_attn8(p, lds_all), phase3_f2b(p, lds), (blockIdx.x & 1) ? (void)0 : phase3_tr(p, lds)))
    RUN_PHASE(4, phase_resid8(p, lds_all, OFF_ZA, OFF_WOUTT, p.x, nullptr, OFF_X1B, OFF_SS1))
    RUN_PHASE(5, phase5a8(p, lds_all))
    RUN_PHASE(6, phase5b_8(p, lds_all))
    RUN_PHASE(7, phase_resid8(p, lds_all, OFF_OM, OFF_WMOT, nullptr, wsp<bf16_t>(p, OFF_X1B), OFF_X2B, OFF_SS2))
    RUN_PHASE(8, phase7(p, lds))
    RUN_PHASE(9, phase8(p, lds))
    RUN_PHASE(10, phase9_8(p, lds_all))
    RUN_PHASE(11, phase10_8(p, lds_all))
    RUN_PHASE(12, phase11(p, lds))
}

extern "C" void kernel_launch(void* const* d_in, const int* in_sizes, int n_in,
                              void* d_out, int out_size, void* d_ws, size_t ws_size,
                              hipStream_t stream) {
    static int grid = 0;
    if (grid == 0) {
        if (n_in != 22 || ws_size < WS_END) { fprintf(stderr, "kernel_launch: unexpected inputs (n_in %d, ws %zu < %zu)\n", n_in, ws_size, (size_t)WS_END); grid = -1; return; }
        int dev = 0, cus = 0, per_cu = 0;
        (void)hipGetDevice(&dev);
        (void)hipDeviceGetAttribute(&cus, hipDeviceAttributeMultiprocessorCount, dev);
        if (hipFuncSetAttribute((const void*)k_fwd, hipFuncAttributeMaxDynamicSharedMemorySize, LDS_TOTAL) != hipSuccess) { fprintf(stderr, "kernel_launch: hipFuncSetAttribute failed\n"); grid = -1; return; }
        if (hipOccupancyMaxActiveBlocksPerMultiprocessor(&per_cu, (const void*)k_fwd, 512, LDS_TOTAL) != hipSuccess || per_cu < 1) { fprintf(stderr, "kernel_launch: occupancy query failed (%d)\n", per_cu); (void)hipGetLastError(); per_cu = 1; }
        if (per_cu > 1) per_cu = 1;
        grid = cus * per_cu;
        fprintf(stderr, "kernel_launch: %d CUs x %d blocks\n", cus, per_cu);
    }
    if (grid < 0) return;
    Params p{};
    p.x = (const float*)d_in[0]; p.mem = (const float*)d_in[1]; p.pos = (const int*)d_in[2];
    p.g_mix = (const float*)d_in[3]; p.w_in = (const float*)d_in[4]; p.g_q_lat = (const float*)d_in[5]; p.w_q_up = (const float*)d_in[6];
    p.g_kv_lat = (const float*)d_in[7]; p.w_kv_up = (const float*)d_in[8]; p.w_fourier = (const float*)d_in[9]; p.w_out = (const float*)d_in[10];
    p.g_mem_q = (const float*)d_in[11]; p.g_mem_kv = (const float*)d_in[12]; p.w_mem_q = (const float*)d_in[13]; p.w_mem_kv = (const float*)d_in[14];
    p.w_mem_o = (const float*)d_in[15]; p.g_ffn = (const float*)d_in[16]; p.w_router = (const float*)d_in[17];
    p.w_exp_gate = (const float*)d_in[18]; p.w_exp_up = (const float*)d_in[19]; p.w_exp_down = (const float*)d_in[20]; p.g_final = (const float*)d_in[21];
    p.out = (float*)d_out; p.ws = (char*)d_ws;
    static const int cuts[] = MK_CUTS;
    const int ncut = (int)(sizeof(cuts) / sizeof(int));
    for (int li = 0; li + 1 < ncut; li++) {
        (void)hipMemsetAsync((char*)d_ws + OFF_BAR, 0, 16384, stream);
        int lo = cuts[li], hi = cuts[li + 1];
        void* args[] = {&p, &lo, &hi};
        hipError_t e = hipLaunchCooperativeKernel((const void*)k_fwd, dim3(grid), dim3(512), args, LDS_TOTAL, stream);
        if (e != hipSuccess) fprintf(stderr, "cooperative launch failed: %s (grid %d)\n", hipGetErrorString(e), grid);
    }
}
```

```cpp
#include <hip/hip_runtime.h>
#include <stdint.h>
#include <cstdio>
#include <hip/hip_cooperative_groups.h>
namespace cg = cooperative_groups;
#ifndef USE_CG_SYNC
#define USE_CG_SYNC 0
#endif

#ifndef MK_CUTS
#define MK_CUTS {0, 13}
#endif

#define NB 4
#define NS 4096
#define ND 1024
#define NT (NB * NS)
#define INW 1184
#define NE 16
#define CAP 512
#define MEML 256
#define NPHASE 13
#define VTID ((int)(threadIdx.x & 255))
#define VHALF (__builtin_amdgcn_readfirstlane((int)(threadIdx.x >> 8)))
#define VBLK ((int)(blockIdx.x * 2) + VHALF)
#define VGRID ((int)(gridDim.x * 2))

typedef unsigned short bf16_t;
typedef short bf16x8 __attribute__((ext_vector_type(8)));
typedef float f32x4 __attribute__((ext_vector_type(4)));
typedef float f32x16 __attribute__((ext_vector_type(16)));
typedef unsigned u32x4 __attribute__((ext_vector_type(4)));
typedef unsigned u32x2 __attribute__((ext_vector_type(2)));

__device__ __forceinline__ unsigned f2bf(float f) {
    unsigned u = __float_as_uint(f);
    u += 0x7FFFu + ((u >> 16) & 1u);
    return u >> 16;
}
typedef __bf16 hbf2 __attribute__((ext_vector_type(2)));
typedef float f32x2 __attribute__((ext_vector_type(2)));
__device__ __forceinline__ unsigned pack2bf(float lo, float hi) { f32x2 v = {lo, hi}; return __builtin_bit_cast(unsigned, __builtin_convertvector(v, hbf2)); }
__device__ __forceinline__ float bf2f(unsigned short b) { return __uint_as_float(((unsigned)b) << 16); }

__device__ __forceinline__ int tile_off(int row, int chunk) { return row * 128 + ((chunk ^ ((row >> 1) & 7)) << 4); }

#define GT_LDS_BYTES 65536

struct GemmTile { const bf16_t* A; long lda; const int* arow; const bf16_t* Bt; long ldb; int K; };

__device__ __forceinline__ void gemm_tile_128(const GemmTile& g, char* lds, f32x4 (&acc)[4][4]) {
    const int tid = VTID, lane = tid & 63, wid = tid >> 6, wm = wid >> 1, wn = wid & 1;
    const int lrow = lane >> 3, pc = lane & 7;
    const bf16_t* ap[4]; const bf16_t* bp[4];
#pragma unroll
    for (int i = 0; i < 4; i++) {
        const int r = (wid * 4 + i) * 8 + lrow;
        const int c = pc ^ ((r >> 1) & 7);
        const long ro = g.arow ? (long)g.arow[r] * g.lda : (long)r * g.lda;
        ap[i] = g.A + ro + c * 8;
        bp[i] = g.Bt + (long)r * g.ldb + c * 8;
    }
#pragma unroll
    for (int mi = 0; mi < 4; mi++)
#pragma unroll
        for (int ni = 0; ni < 4; ni++) acc[mi][ni] = (f32x4){0.f, 0.f, 0.f, 0.f};
    const int nk = g.K >> 6;
    auto stage = [&](int kt, char* st) {
#pragma unroll
        for (int i = 0; i < 4; i++) {
            __builtin_amdgcn_global_load_lds((const unsigned*)(ap[i] + kt * 64), (unsigned*)(st + (wid * 4 + i) * 1024), 16, 0, 0);
            __builtin_amdgcn_global_load_lds((const unsigned*)(bp[i] + kt * 64), (unsigned*)(st + 16384 + (wid * 4 + i) * 1024), 16, 0, 0);
        }
    };
    __syncthreads();
    stage(0, lds);
    asm volatile("s_waitcnt vmcnt(0)" ::: "memory");
    __syncthreads();
    for (int kt = 0; kt < nk; kt++) {
        char* cur = lds + (kt & 1) * 32768;
        if (kt + 1 < nk) stage(kt + 1, lds + ((kt + 1) & 1) * 32768);
        bf16x8 af[2][4], bfr[2][4];
#pragma unroll
        for (int ks = 0; ks < 2; ks++)
#pragma unroll
            for (int i = 0; i < 4; i++) {
                af[ks][i] = *(const bf16x8*)(cur + tile_off(wm * 64 + i * 16 + (lane & 15), ks * 4 + (lane >> 4)));
                bfr[ks][i] = *(const bf16x8*)(cur + 16384 + tile_off(wn * 64 + i * 16 + (lane & 15), ks * 4 + (lane >> 4)));
            }
        __builtin_amdgcn_s_setprio(1);
#pragma unroll
        for (int ks = 0; ks < 2; ks++)
#pragma unroll
            for (int mi = 0; mi < 4; mi++)
#pragma unroll
                for (int ni = 0; ni < 4; ni++)
                    acc[mi][ni] = __builtin_amdgcn_mfma_f32_16x16x32_bf16(bfr[ks][ni], af[ks][mi], acc[mi][ni], 0, 0, 0);
        __builtin_amdgcn_s_setprio(0);
        asm volatile("s_waitcnt vmcnt(0)" ::: "memory");
        __syncthreads();
    }
}

template <int DQK, int DVT, int KT>
struct AttnCfg {
    static constexpr int KROW = DQK * 2 + 16;
    static constexpr int VROW = KT * 2 + 8;
    static constexpr int KBYTES = KT * KROW;
    static constexpr int VBYTES = DVT * VROW;
    static constexpr int STAGE = KBYTES + VBYTES;
    static constexpr int LDS = 2 * STAGE;
};

template <int DQK, int DVT, int KT, int NTH, class Out>
__device__ __forceinline__ void attn_block(const bf16_t* Qp, const bf16_t* Kp, const bf16_t* Vtp, long ldv, int nk, char* lds, Out&& out) {
    typedef AttnCfg<DQK, DVT, KT> C;
    constexpr int NKS = DQK / 16, NST = KT / 32, NDT = DVT / 32, NPS = KT / 16;
    constexpr int KCPR = DQK / 8;
    constexpr int KTOT = KT * KCPR, KCH = (KTOT + NTH - 1) / NTH;
    constexpr int VCPR = KT / 8;
    constexpr int VTOT = DVT * VCPR, VCH = (VTOT + NTH - 1) / NTH;
    const int tid = NTH == 512 ? (int)threadIdx.x : VTID, lane = tid & 63, wid = tid >> 6, h = lane >> 5, c = lane & 31;

    bf16x8 qf[NKS];
    {
        const bf16_t* qrow = Qp + (long)(wid * 32 + c) * DQK + 8 * h;
#pragma unroll
        for (int ks = 0; ks < NKS; ks++) qf[ks] = *(const bf16x8*)(qrow + 16 * ks);
    }
    f32x16 o[NDT];
#pragma unroll
    for (int dt = 0; dt < NDT; dt++)
#pragma unroll
        for (int r = 0; r < 16; r++) o[dt][r] = 0.f;
    float m = 0.f, l = 0.f;

    u32x4 kr[KCH], vr[VCH];
    auto gload = [&](int t) {
#pragma unroll
        for (int i = 0; i < KCH; i++) {
            const int ci = tid + NTH * i, row = ci / KCPR, cc = ci % KCPR;
            if (KTOT % NTH == 0 || ci < KTOT) kr[i] = *(const u32x4*)(Kp + (long)(t * KT + row) * DQK + cc * 8);
        }
#pragma unroll
        for (int i = 0; i < VCH; i++) {
            const int ci = tid + NTH * i, row = ci / VCPR, cc = ci % VCPR;
            if (VTOT % NTH == 0 || ci < VTOT) vr[i] = *(const u32x4*)(Vtp + (long)row * ldv + t * KT + cc * 8);
        }
    };
    auto lwrite = [&](char* st) {
#pragma unroll
        for (int i = 0; i < KCH; i++) {
            const int ci = tid + NTH * i, row = ci / KCPR, cc = ci % KCPR;
            if (KTOT % NTH == 0 || ci < KTOT) *(u32x4*)(st + row * C::KROW + cc * 16) = kr[i];
        }
#pragma unroll
        for (int i = 0; i < VCH; i++) {
            const int ci = tid + NTH * i, row = ci / VCPR, cc = ci % VCPR;
            if (VTOT % NTH == 0 || ci < VTOT) {
                char* p = st + C::KBYTES + row * C::VROW + cc * 16;
                *(u32x2*)(p) = (u32x2){vr[i].x, vr[i].y};
                *(u32x2*)(p + 8) = (u32x2){vr[i].z, vr[i].w};
            }
        }
    };
    const int nt = nk / KT;
    gload(0);
    __syncthreads();
    lwrite(lds);
    __syncthreads();
    for (int t = 0; t < nt; t++) {
        char* cur = lds + (t & 1) * C::STAGE;
        if (t + 1 < nt) gload(t + 1);
        f32x16 s[NST];
        const float negm = -m;
#pragma unroll
        for (int st = 0; st < NST; st++) {
#pragma unroll
            for (int r = 0; r < 16; r++) s[st][r] = negm;
#pragma unroll
            for (int ks = 0; ks < NKS; ks++) {
                const bf16x8 kf = *(const bf16x8*)(cur + (st * 32 + c) * C::KROW + ks * 32 + h * 16);
                s[st] = __builtin_amdgcn_mfma_f32_32x32x16_bf16(kf, qf[ks], s[st], 0, 0, 0);
            }
        }
        float mx = s[0][0];
#pragma unroll
        for (int st = 0; st < NST; st++)
#pragma unroll
            for (int r = 0; r < 16; r++) mx = fmaxf(mx, s[st][r]);
        mx = fmaxf(mx, __shfl_xor(mx, 32));
        if (__any(mx > 8.0f)) {
            const float d = fmaxf(mx, 0.f);
            const float alpha = __builtin_amdgcn_exp2f(-d);
            m += d;
            l *= alpha;
#pragma unroll
            for (int dt = 0; dt < NDT; dt++)
#pragma unroll
                for (int r = 0; r < 16; r++) o[dt][r] *= alpha;
#pragma unroll
            for (int st = 0; st < NST; st++)
#pragma unroll
                for (int r = 0; r < 16; r++) s[st][r] -= d;
        }
        float rs = 0.f;
#pragma unroll
        for (int st = 0; st < NST; st++)
#pragma unroll
            for (int r = 0; r < 16; r++) { const float p = __builtin_amdgcn_exp2f(s[st][r]); rs += p; s[st][r] = p; }
        l += rs;
#pragma unroll
        for (int ps = 0; ps < NPS; ps++) {
            const int st = ps >> 1, u = ps & 1;
            u32x4 pw;
            pw.x = pack2bf(s[st][8 * u + 0], s[st][8 * u + 1]);
            pw.y = pack2bf(s[st][8 * u + 2], s[st][8 * u + 3]);
            pw.z = pack2bf(s[st][8 * u + 4], s[st][8 * u + 5]);
            pw.w = pack2bf(s[st][8 * u + 6], s[st][8 * u + 7]);
            const bf16x8 pf = __builtin_bit_cast(bf16x8, pw);
#pragma unroll
            for (int dt = 0; dt < NDT; dt++) {
                const char* vp = cur + C::KBYTES + (dt * 32 + c) * C::VROW + (ps * 16 + 4 * h) * 2;
                const u32x2 v0 = *(const u32x2*)(vp);
                const u32x2 v1 = *(const u32x2*)(vp + 16);
                const bf16x8 vf = __builtin_bit_cast(bf16x8, ((u32x4){v0.x, v0.y, v1.x, v1.y}));
                o[dt] = __builtin_amdgcn_mfma_f32_32x32x16_bf16(vf, pf, o[dt], 0, 0, 0);
            }
        }
        if (t + 1 < nt) lwrite(lds + ((t + 1) & 1) * C::STAGE);
        __syncthreads();
    }
    l += __shfl_xor(l, 32);
    const float inv = 1.f / l;
#pragma unroll
    for (int dt = 0; dt < NDT; dt++)
#pragma unroll
        for (int g4 = 0; g4 < 4; g4++) {
            f32x4 v = {o[dt][4 * g4 + 0] * inv, o[dt][4 * g4 + 1] * inv, o[dt][4 * g4 + 2] * inv, o[dt][4 * g4 + 3] * inv};
            out(wid * 32 + c, dt * 32 + 8 * g4 + 4 * h, v);
        }
}


constexpr size_t SLOT = 33554432;
constexpr size_t OFF_W1T = 0;
constexpr size_t OFF_WQT = OFF_W1T + 1280UL * 1024 * 2;
constexpr size_t OFF_WKVT = OFF_WQT + 768UL * 384 * 2;
constexpr size_t OFF_WOUTT = OFF_WKVT + 1024UL * 256 * 2;
constexpr size_t OFF_WMQT = OFF_WOUTT + 1024UL * 1024 * 2;
constexpr size_t OFF_WMKVT = OFF_WMQT + 1024UL * 1024 * 2;
constexpr size_t OFF_WMOT = OFF_WMKVT + 2048UL * 1024 * 2;
constexpr size_t OFF_WGUT = OFF_WMOT + 1024UL * 1024 * 2;
constexpr size_t OFF_WDT = OFF_WGUT + 16UL * 2048 * 1024 * 2;
constexpr size_t OFF_T64 = OFF_WDT + 16UL * 1024 * 1024 * 2;
constexpr size_t OFF_M1 = OFF_T64 + 16384;
constexpr size_t OFF_M3 = OFF_M1 + 32768;
constexpr size_t OFF_WFT = OFF_M3 + 16384;
constexpr size_t OFF_TW = OFF_WFT + 65536;
constexpr size_t OFF_ROPE = OFF_TW + 32768;
constexpr size_t OFF_R0 = OFF_ROPE + (size_t)NT * 16 * 8;
constexpr size_t OFF_RMEM = OFF_R0 + (size_t)NT * 4;
constexpr size_t OFF_SSQ = OFF_RMEM + 4096;
constexpr size_t OFF_SSKV = OFF_SSQ + (size_t)NT * 6 * 4;
constexpr size_t OFF_SS1 = OFF_SSKV + (size_t)NT * 4 * 4;
constexpr size_t OFF_SS2 = OFF_SS1 + (size_t)NT * 16 * 4;
constexpr size_t OFF_AFF = OFF_SS2 + (size_t)NT * 16 * 4;
constexpr size_t OFF_SLOTS = OFF_AFF + (size_t)NT * 16 * 4;
constexpr size_t OFF_IDX = OFF_SLOTS + 4UL * 16 * 4096 * 4;
constexpr size_t OFF_GATE = OFF_IDX + 4UL * 16 * 512 * 4;
constexpr size_t OFF_MEMB = OFF_GATE + 4UL * 16 * 512 * 4;
constexpr size_t OFF_KMEM = OFF_MEMB + 1024UL * 1024 * 2;
constexpr size_t OFF_VTMEM = OFF_KMEM + 1024UL * 1024 * 2;
constexpr size_t OFF_KR = OFF_VTMEM + 1024UL * 1024 * 2;
constexpr size_t OFF_BAR = OFF_KR + (size_t)NT * 32 * 2;
constexpr size_t OFF_S0 = (OFF_BAR + 16384 + 255) / 256 * 256;
constexpr size_t OFF_S1 = OFF_S0 + SLOT;
constexpr size_t OFF_S2 = OFF_S1 + SLOT;
constexpr size_t OFF_S3 = OFF_S2 + SLOT;
constexpr size_t OFF_S4 = OFF_S3 + SLOT;
constexpr size_t WS_END = OFF_S4 + SLOT;
static_assert(WS_END <= 300964352UL, "workspace map exceeds the guaranteed scratch size");
constexpr size_t OFF_XB = OFF_S0, OFF_YR = OFF_S0, OFF_YI = OFF_S0 + SLOT / 2, OFF_X1B = OFF_S3, OFF_OM = OFF_S0, OFF_ACT = OFF_S0;
constexpr size_t OFF_UF = OFF_S1, OFF_UQ = OFF_S1 + (size_t)NT * 512 * 2, OFF_ZA = OFF_S1, OFF_QM = OFF_S1;
constexpr size_t OFF_Q = OFF_S2, OFF_UKV = OFF_S2 + (size_t)NT * 768 * 2, OFF_X2B = OFF_S2;
constexpr size_t OFF_K = OFF_S3, OFF_Y = OFF_S3;
constexpr size_t OFF_VT = OFF_S4;

struct Params {
    const float *x, *mem; const int* pos;
    const float *g_mix, *w_in, *g_q_lat, *w_q_up, *g_kv_lat, *w_kv_up, *w_fourier, *w_out, *g_mem_q, *g_mem_kv, *w_mem_q, *w_mem_kv, *w_mem_o,
        *g_ffn, *w_router, *w_exp_gate, *w_exp_up, *w_exp_down, *g_final;
    float* out; char* ws;
};
template <class T> __device__ __forceinline__ T* wsp(const Params& p, size_t off) { return (T*)(p.ws + off); }

#define LDS_HALF 65536
#define LDS_MAIN 131072
#define LDS_TOTAL (LDS_MAIN + 16)
#define LAS __attribute__((address_space(3)))

#define XB_TMO      128
#define XB_XCNT(j)  (256  + 64 * (j))
#define XB_XSUB(j)  (1280 + 64 * (j))
#define XB_XGEN(j)  (2304 + 64 * (j))
#define XB_TOP      3328
#define XB_TOPGEN   3392
#define XCD_BAR_WORDS 3456
#define XB_SPIN_CAP (1u << 25)
__device__ __forceinline__ unsigned xb_ld(unsigned* p)              { return __hip_atomic_load(p, __ATOMIC_RELAXED, __HIP_MEMORY_SCOPE_AGENT); }
__device__ __forceinline__ unsigned xb_add(unsigned* p, unsigned v) { return __hip_atomic_fetch_add(p, v, __ATOMIC_RELAXED, __HIP_MEMORY_SCOPE_AGENT); }
__device__ __forceinline__ unsigned xb_xcc_id() { return (unsigned)__builtin_amdgcn_s_getreg((3 << 11) | 20) & 0xFu; }
#define XB_SPIN(cond, bar) do { unsigned _sp = 0; while (cond) { __builtin_amdgcn_s_sleep(1); \
    if ((++_sp & 255u) == 0u) { if (xb_ld(&(bar)[XB_TMO])) break; if (_sp > XB_SPIN_CAP) { atomicAdd(&(bar)[XB_TMO], 1u); break; } } } } while (0)
struct XcdBarrier { unsigned* bar; unsigned x; volatile LAS unsigned* st; };
__device__ __forceinline__ XcdBarrier xcd_barrier_post(unsigned* bar, volatile LAS unsigned* st) {
    XcdBarrier b; b.bar = bar; b.x = xb_xcc_id(); b.st = st;
    if (threadIdx.x == 0) (void)xb_add(&bar[XB_XCNT(b.x)], 1u);
    return b;
}
__device__ __forceinline__ void xcd_barrier_complete(unsigned* bar, unsigned x, unsigned& nloc, unsigned& nx) {
    const unsigned G = gridDim.x * gridDim.y * gridDim.z;
    unsigned sum, cnt, mine, sp = 0u;
    for (;;) {
        sum = 0u; cnt = 0u; mine = 0u;
#pragma unroll
        for (unsigned j = 0; j < 16; ++j) { const unsigned c = xb_ld(&bar[XB_XCNT(j)]); sum += c; cnt += (c > 0u) ? 1u : 0u; mine = (j == x) ? c : mine; }
        if (sum == G) break;
        __builtin_amdgcn_s_sleep(1);
        if ((++sp & 255u) == 0u) { if (xb_ld(&bar[XB_TMO])) break; if (sp > XB_SPIN_CAP) { atomicAdd(&bar[XB_TMO], 1u); break; } }
    }
    nloc = mine > 0u ? mine : 1u; nx = cnt > 0u ? cnt : 1u;
}
__device__ __forceinline__ void xcd_barrier(const XcdBarrier& b) {
    asm volatile("s_waitcnt vmcnt(0)" ::: "memory");
    __syncthreads();
    if (threadIdx.x == 0) {
        unsigned* bar = b.bar;
        __builtin_amdgcn_s_waitcnt(0);
        unsigned nloc = b.st[0], nx = b.st[1];
        if (nloc == 0u) { xcd_barrier_complete(bar, b.x, nloc, nx); b.st[0] = nloc; b.st[1] = nx; }
        const unsigned old = xb_add(&bar[XB_XSUB(b.x)], 1u);
        const unsigned gen = old / nloc;
        if (old + 1u == (gen + 1u) * nloc) {
            __builtin_amdgcn_fence(__ATOMIC_RELEASE, "agent");
            asm volatile("s_waitcnt vmcnt(0)" ::: "memory");
            const unsigned og = xb_add(&bar[XB_TOP], 1u);
            const unsigned tg = og / nx;
            if (og + 1u == (tg + 1u) * nx) xb_add(&bar[XB_TOPGEN], 1u);
            else XB_SPIN(xb_ld(&bar[XB_TOPGEN]) == tg, bar);
            __builtin_amdgcn_fence(__ATOMIC_ACQUIRE, "agent");
            xb_add(&bar[XB_XGEN(b.x)], 1u);
            asm volatile("s_waitcnt vmcnt(0)" ::: "memory");
        } else {
            XB_SPIN(xb_ld(&bar[XB_XGEN(b.x)]) == gen, bar);
            __builtin_amdgcn_fence(__ATOMIC_ACQUIRE, "agent");
            asm volatile("s_waitcnt vmcnt(0)" ::: "memory");
        }
    }
    __syncthreads();
}

#define FOR_XCD_ITEMS(item, N) for (int _L = (int)((blockIdx.x >> 3) << 1) | VHALF, item; _L < (N) / 8 && ((item = (int)(blockIdx.x & 7) * ((N) / 8) + _L), true); _L += (int)(gridDim.x >> 2))

__device__ __forceinline__ u32x2 pack4bf(float a, float b, float c, float d) { return (u32x2){pack2bf(a, b), pack2bf(c, d)}; }
__device__ __forceinline__ u32x2 pack4bf(f32x4 v) { return (u32x2){pack2bf(v[0], v[1]), pack2bf(v[2], v[3])}; }
__device__ __forceinline__ float wave_sum(float v) {
#pragma unroll
    for (int o = 32; o > 0; o >>= 1) v += __shfl_xor(v, o);
    return v;
}

__device__ __forceinline__ void tr_tile(const float* W, long ldw, int k0, int n0, int nvalid, const float* gain, bf16_t* Wt, long ldt, int mode, char* lds) {
    float (*t)[132] = (float (*)[132])lds;
    const int tid = VTID, c4 = tid & 31, r0 = tid >> 5;
    f32x4 v[8];
#pragma unroll
    for (int i = 0; i < 8; i++) {
        const int kk = r0 + 8 * i, n = n0 + c4 * 4;
        v[i] = (n < nvalid) ? *(const f32x4*)(W + (long)(k0 + kk) * ldw + n) : (f32x4){0.f, 0.f, 0.f, 0.f};
        if (gain) v[i] *= gain[k0 + kk];
    }
    __syncthreads();
#pragma unroll
    for (int i = 0; i < 8; i++) *(f32x4*)(&t[r0 + 8 * i][c4 * 4]) = v[i];
    __syncthreads();
#pragma unroll
    for (int i = 0; i < 4; i++) {
        const int ci = tid + 256 * i, nn = ci >> 3, kc = ci & 7;
        const int n = n0 + nn;
        int row = n;
        if (mode) row = (n >> 5) * 64 + ((n >> 4) & 1) * 32 + (mode - 1) * 16 + (n & 15);
        u32x4 w;
        w.x = pack2bf(t[kc * 8 + 0][nn], t[kc * 8 + 1][nn]);
        w.y = pack2bf(t[kc * 8 + 2][nn], t[kc * 8 + 3][nn]);
        w.z = pack2bf(t[kc * 8 + 4][nn], t[kc * 8 + 5][nn]);
        w.w = pack2bf(t[kc * 8 + 6][nn], t[kc * 8 + 7][nn]);
        *(u32x4*)(Wt + (long)row * ldt + k0 + kc * 8) = w;
    }
}

__device__ __forceinline__ void phase0(const Params& p, char* lds) {
    constexpr int J_W1 = 160, J_WQ = 36, J_WKV = 32, J_WOUT = 128, J_WMQ = 128, J_WMKV = 256, J_WMO = 128, J_WG = 0, J_WU = 0, J_WD = 0;
    constexpr int J_TR = J_W1 + J_WQ + J_WKV + J_WOUT + J_WMQ + J_WMKV + J_WMO + J_WG + J_WU + J_WD;
    constexpr int J_XR = NT / 4, J_MR = 1024 / 4, J_ROPE = NT * 16 / 256, J_TAB = (4096 + 8192 + 16384 + 8192 + 32768) / 256;
    constexpr int J_ALL = J_TR + J_XR + J_MR + J_ROPE + J_TAB;
    const int tid = VTID, lane = tid & 63, wid = tid >> 6;
    const double PI2 = 6.283185307179586476925286766559;
    for (int job = VBLK; job < J_ALL; job += VGRID) {
        int j = job;
        if (j < J_TR) {
            if (j < J_W1) { tr_tile(p.w_in, INW, (j / 10) * 64, (j % 10) * 128, INW, p.g_mix, wsp<bf16_t>(p, OFF_W1T), 1024, 0, lds); continue; } j -= J_W1;
            if (j < J_WQ) { tr_tile(p.w_q_up, 768, (j / 6) * 64, (j % 6) * 128, 768, p.g_q_lat, wsp<bf16_t>(p, OFF_WQT), 384, 0, lds); continue; } j -= J_WQ;
            if (j < J_WKV) { tr_tile(p.w_kv_up, 1024, (j / 8) * 64, (j % 8) * 128, 1024, p.g_kv_lat, wsp<bf16_t>(p, OFF_WKVT), 256, 0, lds); continue; } j -= J_WKV;
            if (j < J_WOUT) { tr_tile(p.w_out, 1024, (j / 8) * 64, (j % 8) * 128, 1024, nullptr, wsp<bf16_t>(p, OFF_WOUTT), 1024, 0, lds); continue; } j -= J_WOUT;
            if (j < J_WMQ) { tr_tile(p.w_mem_q, 1024, (j / 8) * 64, (j % 8) * 128, 1024, p.g_mem_q, wsp<bf16_t>(p, OFF_WMQT), 1024, 0, lds); continue; } j -= J_WMQ;
            if (j < J_WMKV) { tr_tile(p.w_mem_kv, 2048, (j / 16) * 64, (j % 16) * 128, 2048, p.g_mem_kv, wsp<bf16_t>(p, OFF_WMKVT), 1024, 0, lds); continue; } j -= J_WMKV;
            if (j < J_WMO) { tr_tile(p.w_mem_o, 1024, (j / 8) * 64, (j % 8) * 128, 1024, nullptr, wsp<bf16_t>(p, OFF_WMOT), 1024, 0, lds); continue; } j -= J_WMO;
            if (j < J_WG) { const int e = j >> 7, r = j & 127; tr_tile(p.w_exp_gate + (long)e * 1048576, 1024, (r / 8) * 64, (r % 8) * 128, 1024, p.g_ffn, wsp<bf16_t>(p, OFF_WGUT) + (long)e * 2048 * 1024, 1024, 1, lds); continue; } j -= J_WG;
            if (j < J_WU) { const int e = j >> 7, r = j & 127; tr_tile(p.w_exp_up + (long)e * 1048576, 1024, (r / 8) * 64, (r % 8) * 128, 1024, p.g_ffn, wsp<bf16_t>(p, OFF_WGUT) + (long)e * 2048 * 1024, 1024, 2, lds); continue; } j -= J_WU;
            { const int e = j >> 7, r = j & 127; tr_tile(p.w_exp_down + (long)e * 1048576, 1024, (r / 8) * 64, (r % 8) * 128, 1024, nullptr, wsp<bf16_t>(p, OFF_WDT) + (long)e * 1048576, 1024, 0, lds); continue; }
        }
        j -= J_TR;
        if (j < J_XR + J_MR) {
            const bool isx = j < J_XR;
            const int row = (isx ? j : j - J_XR) * 4 + wid;
            const float* src = (isx ? p.x : p.mem) + (long)row * ND;
            bf16_t* dst = (isx ? wsp<bf16_t>(p, OFF_XB) : wsp<bf16_t>(p, OFF_MEMB)) + (long)row * ND;
            float ss = 0.f;
#pragma unroll
            for (int i = 0; i < 4; i++) {
                const f32x4 v = *(const f32x4*)(src + i * 256 + lane * 4);
                ss += v[0] * v[0] + v[1] * v[1] + v[2] * v[2] + v[3] * v[3];
                *(u32x2*)(dst + i * 256 + lane * 4) = pack4bf(v);
            }
            ss = wave_sum(ss);
            if (lane == 0) (isx ? wsp<float>(p, OFF_R0) : wsp<float>(p, OFF_RMEM))[row] = rsqrtf(ss * (1.f / ND) + 1e-6f);
            continue;
        }
        j -= J_XR + J_MR;
        if (j < J_ROPE) {
            const int i = j * 256 + tid; const int t = i >> 4, jj = i & 15;
            const double f = pow(10000.0, -(double)(2 * jj) / 32.0);
            const double ang = (double)p.pos[t] * f;
            wsp<float2>(p, OFF_ROPE)[i] = make_float2((float)cos(ang), (float)sin(ang));
            continue;
        }
        j -= J_ROPE;
        {
            int i = j * 256 + tid;
            if (i < 4096) { const double a = PI2 * (double)i / 4096.0; wsp<float2>(p, OFF_TW)[i] = make_float2((float)cos(a), (float)sin(a)); continue; } i -= 4096;
            if (i < 8192) {
                const int T = i >> 12, a = (i >> 6) & 63, b = i & 63;
                const double th = PI2 * (double)((a * b) & 63) / 64.0;
                wsp<bf16_t>(p, OFF_T64)[i] = (bf16_t)f2bf((float)(T ? sin(th) : cos(th))); continue;
            } i -= 8192;
            if (i < 16384) {
                const int rho = i >> 7, k = i & 127;
                const int wm = rho >> 6, mi = (rho >> 4) & 3, lr = rho & 15, ri = mi >> 1, k1 = 32 * wm + 16 * (mi & 1) + lr, ab = k >> 6, s1 = k & 63;
                const double th = PI2 * (double)((k1 * s1) & 63) / 64.0;
                const double c = cos(th), s = sin(th);
                const double v = ri == 0 ? (ab == 0 ? c : -s) : (ab == 0 ? s : c);
                wsp<bf16_t>(p, OFF_M1)[i] = (bf16_t)f2bf((float)v); continue;
            } i -= 16384;
            if (i < 8192) {
                const int k2 = i >> 7, k = i & 127, s2 = k & 63;
                const double th = PI2 * (double)((k2 * s2) & 63) / 64.0;
                wsp<bf16_t>(p, OFF_M3)[i] = (bf16_t)f2bf((float)(k < 64 ? cos(th) : -sin(th))); continue;
            } i -= 8192;
            if (i < 32768) {
                const int g = i >> 12, e = (i >> 6) & 63, ch = i & 63;
                wsp<bf16_t>(p, OFF_WFT)[i] = (bf16_t)f2bf(p.w_fourier[(g * 64 + ch) * 64 + e]); continue;
            }
        }
    }
}

#define FOR_XCD_ITEMS_R(item, N) for (int _L = (int)(blockIdx.x >> 3), item; _L < (N) / 8 && ((item = (int)(blockIdx.x & 7) * ((N) / 8) + _L), true); _L += (int)(gridDim.x >> 3))
__device__ __forceinline__ void gemm_tile_256sq(const GemmTile& g, char* lds, f32x4 (&acc)[8][4]) {
    const int tid = threadIdx.x, lane = tid & 63, wid = tid >> 6, wm = wid >> 2, wn = wid & 3;
    const int lrow = lane >> 3, pc = lane & 7;
    const bf16_t* ap[4]; const bf16_t* bp[4];
#pragma unroll
    for (int i = 0; i < 4; i++) {
        const int r = (wid * 4 + i) * 8 + lrow;
        const int c = pc ^ ((r >> 1) & 7);
        const long ro = g.arow ? (long)g.arow[r] * g.lda : (long)r * g.lda;
        ap[i] = g.A + ro + c * 8;
        bp[i] = g.Bt + (long)r * g.ldb + c * 8;
    }
#pragma unroll
    for (int mi = 0; mi < 8; mi++)
#pragma unroll
        for (int ni = 0; ni < 4; ni++) acc[mi][ni] = (f32x4){0.f, 0.f, 0.f, 0.f};
    const int nk = g.K >> 6;
    auto stage = [&](int kt, char* st) {
#pragma unroll
        for (int i = 0; i < 4; i++) {
            __builtin_amdgcn_global_load_lds((const unsigned*)(ap[i] + kt * 64), (unsigned*)(st + (wid * 4 + i) * 1024), 16, 0, 0);
            __builtin_amdgcn_global_load_lds((const unsigned*)(bp[i] + kt * 64), (unsigned*)(st + 32768 + (wid * 4 + i) * 1024), 16, 0, 0);
        }
    };
    __syncthreads();
    stage(0, lds);
    asm volatile("s_waitcnt vmcnt(0)" ::: "memory");
    __syncthreads();
    for (int kt = 0; kt < nk; kt++) {
        char* cur = lds + (kt & 1) * 65536;
        if (kt + 1 < nk) stage(kt + 1, lds + ((kt + 1) & 1) * 65536);
#pragma unroll
        for (int ks = 0; ks < 2; ks++) {
            bf16x8 af[8], bfr[4];
#pragma unroll
            for (int i = 0; i < 8; i++) af[i] = *(const bf16x8*)(cur + tile_off(wm * 128 + i * 16 + (lane & 15), ks * 4 + (lane >> 4)));
#pragma unroll
            for (int i = 0; i < 4; i++) bfr[i] = *(const bf16x8*)(cur + 32768 + tile_off(wn * 64 + i * 16 + (lane & 15), ks * 4 + (lane >> 4)));
            __builtin_amdgcn_s_setprio(1);
#pragma unroll
            for (int mi = 0; mi < 8; mi++)
#pragma unroll
                for (int ni = 0; ni < 4; ni++)
                    acc[mi][ni] = __builtin_amdgcn_mfma_f32_16x16x32_bf16(bfr[ni], af[mi], acc[mi][ni], 0, 0, 0);
            __builtin_amdgcn_s_setprio(0);
        }
        asm volatile("s_waitcnt vmcnt(0)" ::: "memory");
        __syncthreads();
    }
}


__device__ __forceinline__ void gemm_tile_256x128(const GemmTile& g, char* lds, f32x4 (&acc)[4][4]) {
    const int tid = threadIdx.x, lane = tid & 63, wid = tid >> 6, wm = wid >> 1, wn = wid & 1;
    const int lrow = lane >> 3, pc = lane & 7;
    const bf16_t* ap[4]; const bf16_t* bp[2];
#pragma unroll
    for (int i = 0; i < 4; i++) {
        const int r = (wid * 4 + i) * 8 + lrow;
        const int c = pc ^ ((r >> 1) & 7);
        const long ro = g.arow ? (long)g.arow[r] * g.lda : (long)r * g.lda;
        ap[i] = g.A + ro + c * 8;
    }
#pragma unroll
    for (int i = 0; i < 2; i++) {
        const int r = (wid * 2 + i) * 8 + lrow;
        const int c = pc ^ ((r >> 1) & 7);
        bp[i] = g.Bt + (long)r * g.ldb + c * 8;
    }
#pragma unroll
    for (int mi = 0; mi < 4; mi++)
#pragma unroll
        for (int ni = 0; ni < 4; ni++) acc[mi][ni] = (f32x4){0.f, 0.f, 0.f, 0.f};
    const int nk = g.K >> 6;
    auto stage = [&](int kt, char* st) {
#pragma unroll
        for (int i = 0; i < 4; i++)
            __builtin_amdgcn_global_load_lds((const unsigned*)(ap[i] + kt * 64), (unsigned*)(st + (wid * 4 + i) * 1024), 16, 0, 0);
#pragma unroll
        for (int i = 0; i < 2; i++)
            __builtin_amdgcn_global_load_lds((const unsigned*)(bp[i] + kt * 64), (unsigned*)(st + 32768 + (wid * 2 + i) * 1024), 16, 0, 0);
    };
    __syncthreads();
    stage(0, lds);
    asm volatile("s_waitcnt vmcnt(0)" ::: "memory");
    __syncthreads();
    for (int kt = 0; kt < nk; kt++) {
        char* cur = lds + (kt & 1) * 49152;
        if (kt + 1 < nk) stage(kt + 1, lds + ((kt + 1) & 1) * 49152);
        bf16x8 af[2][4], bfr[2][4];
#pragma unroll
        for (int ks = 0; ks < 2; ks++)
#pragma unroll
            for (int i = 0; i < 4; i++) {
                af[ks][i] = *(const bf16x8*)(cur + tile_off(wm * 64 + i * 16 + (lane & 15), ks * 4 + (lane >> 4)));
                bfr[ks][i] = *(const bf16x8*)(cur + 32768 + tile_off(wn * 64 + i * 16 + (lane & 15), ks * 4 + (lane >> 4)));
            }
        __builtin_amdgcn_s_setprio(1);
#pragma unroll
        for (int ks = 0; ks < 2; ks++)
#pragma unroll
            for (int mi = 0; mi < 4; mi++)
#pragma unroll
                for (int ni = 0; ni < 4; ni++)
                    acc[mi][ni] = __builtin_amdgcn_mfma_f32_16x16x32_bf16(bfr[ks][ni], af[ks][mi], acc[mi][ni], 0, 0, 0);
        __builtin_amdgcn_s_setprio(0);
        asm volatile("s_waitcnt vmcnt(0)" ::: "memory");
        __syncthreads();
    }
}


__device__ __forceinline__ void phase1(const Params& p, char* lds) {
    const int tid = threadIdx.x, lane = tid & 63, wid = tid >> 6, wm = wid >> 1, wn = wid & 1, lq = lane >> 4, lr = lane & 15;
    constexpr int N_U = 64 * 2, N_M = 4 * 16;
    {
      FOR_XCD_ITEMS_R(item, N_U) {
        f32x4 acc[4][4];
        {
            const int tm = item >> 1, tn = 8 + (item & 1);
            GemmTile g; g.A = wsp<bf16_t>(p, OFF_XB) + (long)tm * 256 * ND; g.lda = ND; g.arow = nullptr;
            g.Bt = wsp<bf16_t>(p, OFF_W1T) + (long)tn * 128 * ND; g.ldb = ND; g.K = ND;
            gemm_tile_256x128(g, lds, acc);
            const float* r0 = wsp<float>(p, OFF_R0);
#pragma unroll
            for (int mi = 0; mi < 4; mi++) {
                const int row = tm * 256 + wm * 64 + mi * 16 + lr;
                const float rs = r0[row];
#pragma unroll
                for (int ni = 0; ni < 4; ni++) acc[mi][ni] *= rs;
                if (tn < 4) {
#pragma unroll
                    for (int ni = 0; ni < 4; ni++)
                        *(u32x2*)(wsp<bf16_t>(p, OFF_UF) + (long)row * 512 + tn * 128 + wn * 64 + ni * 16 + 4 * lq) = pack4bf(acc[mi][ni]);
                } else if (tn < 9) {
                    float ss = 0.f;
#pragma unroll
                    for (int ni = 0; ni < 4; ni++) { const f32x4 v = acc[mi][ni]; ss += v[0] * v[0] + v[1] * v[1] + v[2] * v[2] + v[3] * v[3]; }
                    ss += __shfl_xor(ss, 16); ss += __shfl_xor(ss, 32);
                    if (tn < 7) {
#pragma unroll
                        for (int ni = 0; ni < 4; ni++)
                            *(u32x2*)(wsp<bf16_t>(p, OFF_UQ) + (long)row * 384 + (tn - 4) * 128 + wn * 64 + ni * 16 + 4 * lq) = pack4bf(acc[mi][ni]);
                        if (lq == 0) wsp<float>(p, OFF_SSQ)[row * 6 + (tn - 4) * 2 + wn] = ss;
                    } else {
#pragma unroll
                        for (int ni = 0; ni < 4; ni++)
                            *(u32x2*)(wsp<bf16_t>(p, OFF_UKV) + (long)row * 256 + (tn - 7) * 128 + wn * 64 + ni * 16 + 4 * lq) = pack4bf(acc[mi][ni]);
                        if (lq == 0) wsp<float>(p, OFF_SSKV)[row * 4 + (tn - 7) * 2 + wn] = ss;
                    }
                } else if (wn == 0) {
                    const float2* rp = wsp<float2>(p, OFF_ROPE) + (long)row * 16 + 4 * lq;
                    f32x4 o1, o2;
#pragma unroll
                    for (int r = 0; r < 4; r++) {
                        const float2 cs = rp[r];
                        const float x1 = acc[mi][0][r], x2 = acc[mi][1][r];
                        o1[r] = x1 * cs.x - x2 * cs.y; o2[r] = x1 * cs.y + x2 * cs.x;
                    }
                    bf16_t* kr = wsp<bf16_t>(p, OFF_KR) + (long)row * 32;
                    *(u32x2*)(kr + 4 * lq) = pack4bf(o1);
                    *(u32x2*)(kr + 16 + 4 * lq) = pack4bf(o2);
                }
            }
        }
      }
      FOR_XCD_ITEMS_R(it, N_M) {
        f32x4 acc[4][4];
        {
            const int tm = it / 16, tn = it % 16;
            GemmTile g; g.A = wsp<bf16_t>(p, OFF_MEMB) + (long)tm * 256 * ND; g.lda = ND; g.arow = nullptr;
            g.Bt = wsp<bf16_t>(p, OFF_WMKVT) + (long)tn * 128 * ND; g.ldb = ND; g.K = ND;
            gemm_tile_256x128(g, lds, acc);
            const float* rm = wsp<float>(p, OFF_RMEM);
#pragma unroll
            for (int mi = 0; mi < 4; mi++) {
                const int row = tm * 256 + wm * 64 + mi * 16 + lr;
                const int b = row >> 8, m = row & 255;
                const float rs = rm[row];
#pragma unroll
                for (int ni = 0; ni < 4; ni++) {
                    const f32x4 v = acc[mi][ni] * rs;
                    const int col = tn * 128 + wn * 64 + ni * 16 + 4 * lq;
                    if (col < 1024) {
                        const int h = col >> 8, d = col & 255;
                        *(u32x2*)(wsp<bf16_t>(p, OFF_KMEM) + ((long)(b * 4 + h) * 256 + m) * 256 + d) = pack4bf(v);
                    } else {
                        const int c2 = col - 1024, h = c2 >> 8, dv = c2 & 255;
                        bf16_t* vt = wsp<bf16_t>(p, OFF_VTMEM) + ((long)(b * 4 + h) * 256 + dv) * 256 + m;
#pragma unroll
                        for (int r = 0; r < 4; r++) vt[r * 256] = (bf16_t)f2bf(v[r]);
                    }
                }
            }
        }
      }
    }
}

template <int MI>
__device__ __forceinline__ void dft_mma(const bf16_t* Ag, int arow0, const char* ximg, int ncol0, f32x4 (&acc)[MI][4]) {
    const int lane = VTID & 63, lq = lane >> 4, lr = lane & 15;
#pragma unroll
    for (int ks = 0; ks < 4; ks++) {
        bf16x8 af[MI], bfr[4];
#pragma unroll
        for (int mi = 0; mi < MI; mi++) af[mi] = *(const bf16x8*)(Ag + (long)(arow0 + mi * 16 + lr) * 128 + ks * 32 + lq * 8);
#pragma unroll
        for (int ni = 0; ni < 4; ni++) {
            const char* bp = ximg + (ks * 32 + lq * 8) * 272 + (ncol0 + ni * 16 + lr) * 2;
#pragma unroll
            for (int j = 0; j < 8; j++) bfr[ni][j] = *(const short*)(bp + j * 272);
        }
#pragma unroll
        for (int mi = 0; mi < MI; mi++)
#pragma unroll
            for (int ni = 0; ni < 4; ni++) acc[mi][ni] = __builtin_amdgcn_mfma_f32_16x16x32_bf16(bfr[ni], af[mi], acc[mi][ni], 0, 0, 0);
    }
}

__device__ __forceinline__ void f2a_item(const Params& p, int it, char* lds) {
    const int tid = VTID, lane = tid & 63, wid = tid >> 6, wm = wid >> 1, wn = wid & 1, lq = lane >> 4, lr = lane & 15;
    const int nc = it & 3, s2 = (it >> 2) & 63, b = it >> 8;
    char* uimg = lds; char* ximg = lds + 17408;
    __syncthreads();
#pragma unroll
    for (int i = 0; i < 4; i++) {
        const int ci = tid + 256 * i, row = ci >> 4, cc = ci & 15;
        *(u32x4*)(uimg + row * 272 + cc * 16) = *(const u32x4*)(wsp<bf16_t>(p, OFF_UF) + ((long)(b * NS + 64 * row + s2)) * 512 + nc * 128 + cc * 8);
    }
    __syncthreads();
    {
        const int g2 = wid >> 1, T = wid & 1;
        f32x4 a1[4][4];
#pragma unroll
        for (int mi = 0; mi < 4; mi++)
#pragma unroll
            for (int ni = 0; ni < 4; ni++) a1[mi][ni] = (f32x4){0.f, 0.f, 0.f, 0.f};
        const bf16_t* t64 = wsp<bf16_t>(p, OFF_T64) + T * 4096;
#pragma unroll
        for (int ks = 0; ks < 2; ks++) {
            bf16x8 af[4], bfr[4];
#pragma unroll
            for (int i = 0; i < 4; i++) {
                af[i] = *(const bf16x8*)(uimg + (i * 16 + lr) * 272 + (g2 * 64 + ks * 32 + lq * 8) * 2);
                bfr[i] = *(const bf16x8*)(t64 + (i * 16 + lr) * 64 + ks * 32 + lq * 8);
            }
#pragma unroll
            for (int mi = 0; mi < 4; mi++)
#pragma unroll
                for (int ni = 0; ni < 4; ni++) a1[mi][ni] = __builtin_amdgcn_mfma_f32_16x16x32_bf16(bfr[ni], af[mi], a1[mi][ni], 0, 0, 0);
        }
#pragma unroll
        for (int mi = 0; mi < 4; mi++)
#pragma unroll
            for (int ni = 0; ni < 4; ni++)
                *(u32x2*)(ximg + (T * 64 + mi * 16 + lr) * 272 + (g2 * 64 + ni * 16 + 4 * lq) * 2) = pack4bf(a1[mi][ni]);
    }
    __syncthreads();
    f32x4 acc[4][4];
#pragma unroll
    for (int mi = 0; mi < 4; mi++)
#pragma unroll
        for (int ni = 0; ni < 4; ni++) acc[mi][ni] = (f32x4){0.f, 0.f, 0.f, 0.f};
    dft_mma<4>(wsp<bf16_t>(p, OFF_M1), wm * 64, ximg, wn * 64, acc);
    const float2* tw = wsp<float2>(p, OFF_TW);
#pragma unroll
    for (int m2 = 0; m2 < 2; m2++) {
        const int k1 = 32 * wm + 16 * m2 + lr;
        float2 cs; { const float rev = (float)((s2 * k1) & 4095) * (1.0f / 4096.0f); cs.x = __builtin_amdgcn_cosf(rev); cs.y = __builtin_amdgcn_sinf(rev); (void)tw; }
        const long base = ((long)(b * 64 + k1) * 64 + s2) * 512 + nc * 128 + wn * 64 + 4 * lq;
#pragma unroll
        for (int ni = 0; ni < 4; ni++) {
            const f32x4 yr = acc[m2][ni], yi = acc[m2 + 2][ni];
            const f32x4 orr = yr * cs.x - yi * cs.y, oi = yi * cs.x + yr * cs.y;
            *(u32x2*)(wsp<bf16_t>(p, OFF_YR) + base + ni * 16) = pack4bf(orr);
            *(u32x2*)(wsp<bf16_t>(p, OFF_YI) + base + ni * 16) = pack4bf(oi);
        }
    }
}

__device__ __forceinline__ void f2b_item(const Params& p, int it, char* lds) {
    const int tid = VTID, lane = tid & 63, wid = tid >> 6, wm = wid >> 1, wn = wid & 1, lq = lane >> 4, lr = lane & 15;
    const int nc = it & 3, k1 = (it >> 2) & 63, b = it >> 8;
    char* ximg = lds; char* zimg = lds + 34816;
    __syncthreads();
#pragma unroll
    for (int i = 0; i < 8; i++) {
        const int ci = tid + 256 * i, row = ci >> 4, cc = ci & 15;
        const bf16_t* src = (row < 64 ? wsp<bf16_t>(p, OFF_YR) : wsp<bf16_t>(p, OFF_YI)) + ((long)(b * 64 + k1) * 64 + (row & 63)) * 512 + nc * 128 + cc * 8;
        *(u32x4*)(ximg + row * 272 + cc * 16) = *(const u32x4*)src;
    }
    __syncthreads();
    f32x4 acc[2][4];
#pragma unroll
    for (int mi = 0; mi < 2; mi++)
#pragma unroll
        for (int ni = 0; ni < 4; ni++) acc[mi][ni] = (f32x4){0.f, 0.f, 0.f, 0.f};
    dft_mma<2>(wsp<bf16_t>(p, OFF_M3), wm * 32, ximg, wn * 64, acc);
#pragma unroll
    for (int mi = 0; mi < 2; mi++)
#pragma unroll
        for (int ni = 0; ni < 4; ni++)
            *(u32x2*)(zimg + (wm * 32 + mi * 16 + lr) * 272 + (wn * 64 + ni * 16 + 4 * lq) * 2) = pack4bf(acc[mi][ni] * (1.0f / 512.0f));
    __syncthreads();
    f32x4 a3[2][4];
#pragma unroll
    for (int mi = 0; mi < 2; mi++)
#pragma unroll
        for (int ni = 0; ni < 4; ni++) a3[mi][ni] = (f32x4){0.f, 0.f, 0.f, 0.f};
    const bf16_t* wft = wsp<bf16_t>(p, OFF_WFT) + (long)(nc * 2 + wn) * 4096;
#pragma unroll
    for (int ks = 0; ks < 2; ks++) {
        bf16x8 af[2], bfr[4];
#pragma unroll
        for (int i = 0; i < 2; i++) af[i] = *(const bf16x8*)(zimg + (wm * 32 + i * 16 + lr) * 272 + (wn * 64 + ks * 32 + lq * 8) * 2);
#pragma unroll
        for (int i = 0; i < 4; i++) bfr[i] = *(const bf16x8*)(wft + (i * 16 + lr) * 64 + ks * 32 + lq * 8);
#pragma unroll
        for (int mi = 0; mi < 2; mi++)
#pragma unroll
            for (int ni = 0; ni < 4; ni++) a3[mi][ni] = __builtin_amdgcn_mfma_f32_16x16x32_bf16(bfr[ni], af[mi], a3[mi][ni], 0, 0, 0);
    }
#pragma unroll
    for (int mi = 0; mi < 2; mi++) {
        const int k2 = wm * 32 + mi * 16 + lr;
        bf16_t* dst = wsp<bf16_t>(p, OFF_ZA) + ((long)(b * NS + k1 + 64 * k2)) * 1024 + nc * 128 + wn * 64 + 4 * lq;
#pragma unroll
        for (int ni = 0; ni < 4; ni++) *(u32x2*)(dst + ni * 16) = pack4bf(a3[mi][ni]);
    }
}

__device__ __forceinline__ void phase2(const Params& p, char* lds) {
    const int tid = threadIdx.x, lane = tid & 63, wid = tid >> 6, wm = wid >> 1, wn = wid & 1, lq = lane >> 4, lr = lane & 15;
    constexpr int N_Q = 64 * 6, N_KV = 64 * 8;
    {
      FOR_XCD_ITEMS_R(item, N_Q) {
        f32x4 acc[4][4];
        {
            const int tm = item / 6, tn = item % 6;
            GemmTile g; g.A = wsp<bf16_t>(p, OFF_UQ) + (long)tm * 256 * 384; g.lda = 384; g.arow = nullptr;
            g.Bt = wsp<bf16_t>(p, OFF_WQT) + (long)tn * 128 * 384; g.ldb = 384; g.K = 384;
            gemm_tile_256x128(g, lds, acc);
            const float qmul = 0.10206207261596575f * 1.4426950408889634f;
#pragma unroll
            for (int mi = 0; mi < 4; mi++) {
                const int row = tm * 256 + wm * 64 + mi * 16 + lr;
                const int b = row >> 12, s = row & 4095;
                const float* sq = wsp<float>(p, OFF_SSQ) + (long)row * 6;
                const float ss = sq[0] + sq[1] + sq[2] + sq[3] + sq[4] + sq[5];
                const float rs = rsqrtf(ss * (1.f / 384.f) + 1e-6f) * qmul;
                const int cb0 = tn * 128 + wn * 64;
#pragma unroll
                for (int ni = 0; ni < 4; ni++) {
                    const int cb = cb0 + ni * 16, hd = cb / 96, hob = cb % 96;
                    bf16_t* qd = wsp<bf16_t>(p, OFF_Q) + ((long)(b * 8 + hd) * NS + s) * 96;
                    if (hob < 64) {
                        *(u32x2*)(qd + hob + 4 * lq) = pack4bf(acc[mi][ni] * rs);
                    } else if (hob == 64) {
                        if (ni < 3) {
                            const float2* rp = wsp<float2>(p, OFF_ROPE) + (long)row * 16 + 4 * lq;
                            f32x4 o1, o2;
#pragma unroll
                            for (int r = 0; r < 4; r++) {
                                const float2 cs = rp[r];
                                const float x1 = acc[mi][ni][r] * rs, x2 = acc[mi][ni < 3 ? ni + 1 : 3][r] * rs;
                                o1[r] = x1 * cs.x - x2 * cs.y; o2[r] = x1 * cs.y + x2 * cs.x;
                            }
                            *(u32x2*)(qd + 64 + 4 * lq) = pack4bf(o1);
                            *(u32x2*)(qd + 80 + 4 * lq) = pack4bf(o2);
                        }
                    }
                }
            }
        }
      }
      FOR_XCD_ITEMS_R(it, N_KV) {
        f32x4 acc[4][4];
        {
            const int tm = it >> 3, hd = it & 7;
            GemmTile g; g.A = wsp<bf16_t>(p, OFF_UKV) + (long)tm * 256 * 256; g.lda = 256; g.arow = nullptr;
            g.Bt = wsp<bf16_t>(p, OFF_WKVT) + (long)hd * 128 * 256; g.ldb = 256; g.K = 256;
            gemm_tile_256x128(g, lds, acc);
#pragma unroll
            for (int mi = 0; mi < 4; mi++) {
                const int row = tm * 256 + wm * 64 + mi * 16 + lr;
                const int b = row >> 12, s = row & 4095;
                const float* sq = wsp<float>(p, OFF_SSKV) + (long)row * 4;
                const float rs = rsqrtf((sq[0] + sq[1] + sq[2] + sq[3]) * (1.f / 256.f) + 1e-6f);
                if (wn == 0) {
                    bf16_t* kd = wsp<bf16_t>(p, OFF_K) + ((long)(b * 8 + hd) * NS + s) * 96;
#pragma unroll
                    for (int ni = 0; ni < 4; ni++) *(u32x2*)(kd + ni * 16 + 4 * lq) = pack4bf(acc[mi][ni] * rs);
                } else {
#pragma unroll
                    for (int ni = 0; ni < 4; ni++) {
                        bf16_t* vd = wsp<bf16_t>(p, OFF_VT) + ((long)(b * 8 + hd) * 64 + ni * 16 + 4 * lq) * NS + s;
#pragma unroll
                        for (int r = 0; r < 4; r++) vd[(long)r * NS] = (bf16_t)f2bf(acc[mi][ni][r] * rs);
                    }
                }
            }
#pragma unroll
            for (int i = 0; i < 2; i++) {
                const int ci = tid + 512 * i, r = ci >> 2, cc = ci & 3;
                const int row = tm * 256 + r, b = row >> 12, s = row & 4095;
                *(u32x4*)(wsp<bf16_t>(p, OFF_K) + ((long)(b * 8 + hd) * NS + s) * 96 + 64 + cc * 8) = *(const u32x4*)(wsp<bf16_t>(p, OFF_KR) + (long)row * 32 + cc * 8);
            }
        }
      }
    }
}


__device__ __forceinline__ void phase2_f2a(const Params& p, char* lds) {
    FOR_XCD_ITEMS(it, 1024) { f2a_item(p, it, lds); }
}

__device__ __forceinline__ void expert_tr_job(const Params& p, int j, char* lds) {
    const int which = j >> 11, r = j & 2047, e = r >> 7, t = r & 127;
    const int k0 = (t >> 3) * 64, n0 = (t & 7) * 128;
    if (which == 0) tr_tile(p.w_exp_gate + (long)e * 1048576, 1024, k0, n0, 1024, p.g_ffn, wsp<bf16_t>(p, OFF_WGUT) + (long)e * 2048 * 1024, 1024, 1, lds);
    else if (which == 1) tr_tile(p.w_exp_up + (long)e * 1048576, 1024, k0, n0, 1024, p.g_ffn, wsp<bf16_t>(p, OFF_WGUT) + (long)e * 2048 * 1024, 1024, 2, lds);
    else tr_tile(p.w_exp_down + (long)e * 1048576, 1024, k0, n0, 1024, nullptr, wsp<bf16_t>(p, OFF_WDT) + (long)e * 1048576, 1024, 0, lds);
}

__device__ __forceinline__ void phase3_tr(const Params& p, char* lds) {
    for (int j = VBLK; j < 6144; j += VGRID) expert_tr_job(p, j, lds);
}
__device__ __forceinline__ void phase3_f2b(const Params& p, char* lds) {
    FOR_XCD_ITEMS(it, 1024) { f2b_item(p, it, lds); }
}

__device__ __forceinline__ void phase_resid(const Params& p, char* lds, size_t offA, size_t offW, const float* residf, const bf16_t* residb, size_t offXb, size_t offSS) {
    const int tid = VTID, lane = tid & 63, wid = tid >> 6, wm = wid >> 1, wn = wid & 1, lq = lane >> 4, lr = lane & 15;
    FOR_XCD_ITEMS(item, 128 * 8) {
        const int tm = item >> 3, tn = item & 7;
        f32x4 acc[4][4];
        GemmTile g; g.A = wsp<bf16_t>(p, offA) + (long)tm * 128 * ND; g.lda = ND; g.arow = nullptr;
        g.Bt = wsp<bf16_t>(p, offW) + (long)tn * 128 * ND; g.ldb = ND; g.K = ND;
        gemm_tile_128(g, lds, acc);
#pragma unroll
        for (int mi = 0; mi < 4; mi++) {
            const int row = tm * 128 + wm * 64 + mi * 16 + lr;
            float ss = 0.f;
#pragma unroll
            for (int ni = 0; ni < 4; ni++) {
                const long o = (long)row * ND + tn * 128 + wn * 64 + ni * 16 + 4 * lq;
                f32x4 rv;
                if (residf) rv = *(const f32x4*)(residf + o);
                else { const u32x2 w = *(const u32x2*)(residb + o); rv = (f32x4){__uint_as_float(w.x << 16), __uint_as_float(w.x & 0xFFFF0000u), __uint_as_float(w.y << 16), __uint_as_float(w.y & 0xFFFF0000u)}; }
                const f32x4 v = rv + acc[mi][ni];
                *(u32x2*)(wsp<bf16_t>(p, offXb) + o) = pack4bf(v);
                ss += v[0] * v[0] + v[1] * v[1] + v[2] * v[2] + v[3] * v[3];
            }
            ss += __shfl_xor(ss, 16); ss += __shfl_xor(ss, 32);
            if (lq == 0) wsp<float>(p, offSS)[row * 16 + tn * 2 + wn] = ss;
        }
    }
}
__device__ __forceinline__ float row_rs16(const float* ss) {
    const f32x4 a = *(const f32x4*)ss, b = *(const f32x4*)(ss + 4), c = *(const f32x4*)(ss + 8), d = *(const f32x4*)(ss + 12);
    const f32x4 t = (a + b) + (c + d);
    return rsqrtf(((t[0] + t[1]) + (t[2] + t[3])) * (1.f / 1024.f) + 1e-6f);
}

__device__ __forceinline__ void phase5a(const Params& p, char* lds) {
    const int tid = VTID, lane = tid & 63, wid = tid >> 6, wm = wid >> 1, wn = wid & 1, lq = lane >> 4, lr = lane & 15;
    FOR_XCD_ITEMS(item, 128 * 8) {
        const int tm = item >> 3, tn = item & 7;
        f32x4 acc[4][4];
        GemmTile g; g.A = wsp<bf16_t>(p, OFF_X1B) + (long)tm * 128 * ND; g.lda = ND; g.arow = nullptr;
        g.Bt = wsp<bf16_t>(p, OFF_WMQT) + (long)tn * 128 * ND; g.ldb = ND; g.K = ND;
        gemm_tile_128(g, lds, acc);
        const int h = tn >> 1;
#pragma unroll
        for (int mi = 0; mi < 4; mi++) {
            const int row = tm * 128 + wm * 64 + mi * 16 + lr, b = row >> 12, s = row & 4095;
            const float rs = row_rs16(wsp<float>(p, OFF_SS1) + (long)row * 16) * (0.0625f * 1.4426950408889634f);
            bf16_t* qd = wsp<bf16_t>(p, OFF_QM) + ((long)(b * 4 + h) * NS + s) * 256 + (tn & 1) * 128 + wn * 64 + 4 * lq;
#pragma unroll
            for (int ni = 0; ni < 4; ni++) *(u32x2*)(qd + ni * 16) = pack4bf(acc[mi][ni] * rs);
        }
    }
}
__device__ __forceinline__ void phase5b(const Params& p, char* lds) {
    FOR_XCD_ITEMS(item, NB * 4 * 32 * 2) {
        const int dvh = item & 1, qt = (item >> 1) & 31, h = (item >> 6) & 3, b = item >> 8;
        const bf16_t* Qp = wsp<bf16_t>(p, OFF_QM) + ((long)(b * 4 + h) * NS + qt * 128) * 256;
        const bf16_t* Kp = wsp<bf16_t>(p, OFF_KMEM) + ((long)(b * 4 + h) * 256) * 256;
        const bf16_t* Vtp = wsp<bf16_t>(p, OFF_VTMEM) + ((long)(b * 4 + h) * 256 + dvh * 128) * 256;
        bf16_t* Op = wsp<bf16_t>(p, OFF_OM) + ((long)b * NS + qt * 128) * 1024 + h * 256 + dvh * 128;
        attn_block<256, 128, 32, 256>(Qp, Kp, Vtp, 256L, 256, lds, [&](int q, int dv, f32x4 v) { *(u32x2*)(Op + (long)q * 1024 + dv) = pack4bf(v); });
    }
}

__device__ __forceinline__ void phase7(const Params& p, char* lds) {
    const int tid = VTID, lane = tid & 63, wid = tid >> 6;
    float* wr = (float*)lds;
    __syncthreads();
    for (int i = tid; i < 16384; i += 256) { const int k = i >> 4, e = i & 15; wr[e * 1024 + k] = p.w_router[i] * p.g_ffn[k]; }
    __syncthreads();
    for (int tok = VBLK * 4 + wid; tok < NT; tok += VGRID * 4) {
        const bf16_t* xr = wsp<bf16_t>(p, OFF_X2B) + (long)tok * ND;
        float a[16];
#pragma unroll
        for (int e = 0; e < 16; e++) a[e] = 0.f;
#pragma unroll 2
        for (int j = 0; j < 8; j++) {
            const unsigned xw = *(const unsigned*)(xr + 2 * lane + 128 * j);
            const float x0 = __uint_as_float(xw << 16), x1 = __uint_as_float(xw & 0xFFFF0000u);
#pragma unroll
            for (int e = 0; e < 16; e++) {
                const f32x2 w = *(const f32x2*)(wr + e * 1024 + 2 * lane + 128 * j);
                a[e] += x0 * w[0] + x1 * w[1];
            }
        }
#pragma unroll
        for (int i = 0; i < 8; i++) { const bool hi = lane & 32; const float send = hi ? a[i] : a[i + 8], keep = hi ? a[i + 8] : a[i]; a[i] = keep + __shfl_xor(send, 32); }
#pragma unroll
        for (int i = 0; i < 4; i++) { const bool hi = lane & 16; const float send = hi ? a[i] : a[i + 4], keep = hi ? a[i + 4] : a[i]; a[i] = keep + __shfl_xor(send, 16); }
#pragma unroll
        for (int i = 0; i < 2; i++) { const bool hi = lane & 8; const float send = hi ? a[i] : a[i + 2], keep = hi ? a[i + 2] : a[i]; a[i] = keep + __shfl_xor(send, 8); }
        { const bool hi = lane & 4; const float send = hi ? a[0] : a[1], keep = hi ? a[1] : a[0]; a[0] = keep + __shfl_xor(send, 4); }
        float lg = a[0];
        lg += __shfl_xor(lg, 2); lg += __shfl_xor(lg, 1);
        const int e = ((lane >> 5) & 1) * 8 + ((lane >> 4) & 1) * 4 + ((lane >> 3) & 1) * 2 + ((lane >> 2) & 1);
        lg *= row_rs16(wsp<float>(p, OFF_SS2) + (long)tok * 16);
        float mx = lg;
#pragma unroll
        for (int o = 4; o < 64; o <<= 1) mx = fmaxf(mx, __shfl_xor(mx, o));
        const float ex = expf(lg - mx);
        float sm = ex;
#pragma unroll
        for (int o = 4; o < 64; o <<= 1) sm += __shfl_xor(sm, o);
        if ((lane & 3) == 0) wsp<float>(p, OFF_AFF)[(long)tok * 16 + e] = ex / sm;
    }
}

__device__ __forceinline__ int block_sum_i(int v, int* red) {
    const int lane = VTID & 63, wid = VTID >> 6;
#pragma unroll
    for (int o = 32; o > 0; o >>= 1) v += __shfl_xor(v, o);
    __syncthreads();
    if (lane == 0) red[wid] = v;
    __syncthreads();
    return red[0] + red[1] + red[2] + red[3];
}
__device__ __forceinline__ int block_excl_scan_i(int v, int* red, int& total) {
    const int lane = VTID & 63, wid = VTID >> 6;
    int inc = v;
#pragma unroll
    for (int o = 1; o < 64; o <<= 1) { const int t = __shfl_up(inc, o); if (lane >= o) inc += t; }
    __syncthreads();
    if (lane == 63) red[wid] = inc;
    __syncthreads();
    int base = 0;
#pragma unroll
    for (int w = 0; w < 4; w++) if (w < wid) base += red[w];
    total = red[0] + red[1] + red[2] + red[3];
    return base + inc - v;
}
__device__ __forceinline__ void phase8(const Params& p, char* lds) {
    int* red = (int*)lds;
    const int tid = VTID;
    for (int item = VBLK; item < NB * NE; item += VGRID) {
        const int e = item & 15, b = item >> 4;
        const float* aff = wsp<float>(p, OFF_AFF) + (long)b * NS * 16 + e;
        unsigned v[16];
#pragma unroll
        for (int i = 0; i < 16; i++) v[i] = __float_as_uint(aff[(long)(tid * 16 + i) * 16]);
        unsigned T = 0;
        for (int bit = 30; bit >= 0; bit--) {
            const unsigned cand = T | (1u << bit);
            int c = 0;
#pragma unroll
            for (int i = 0; i < 16; i++) c += (v[i] >= cand) ? 1 : 0;
            if (block_sum_i(c, red) >= CAP) T = cand;
        }
        int cg = 0, ce = 0;
#pragma unroll
        for (int i = 0; i < 16; i++) { cg += (v[i] > T) ? 1 : 0; ce += (v[i] == T) ? 1 : 0; }
        int tot;
        const int pk = block_excl_scan_i(cg | (ce << 16), red, tot);
        const int need = CAP - (tot & 0xFFFF);
        const int pe = pk >> 16;
        int nse = need - pe; nse = nse < 0 ? 0 : (nse > ce ? ce : nse);
        int tot2;
        int slot = block_excl_scan_i(cg + nse, red, tot2);
        int* slots = wsp<int>(p, OFF_SLOTS) + (long)(b * NE + e) * NS;
        int* idx = wsp<int>(p, OFF_IDX) + (long)(b * NE + e) * CAP;
        float* gate = wsp<float>(p, OFF_GATE) + (long)(b * NE + e) * CAP;
        int eqs = 0;
#pragma unroll
        for (int i = 0; i < 16; i++) {
            const int t = tid * 16 + i;
            bool sel = v[i] > T;
            if (v[i] == T) { sel = eqs < nse; eqs++; }
            if (sel) { slots[t] = slot; idx[slot] = b * NS + t; gate[slot] = __uint_as_float(v[i]); slot++; }
            else slots[t] = -1;
        }
    }
}

__device__ __forceinline__ void phase9(const Params& p, char* lds) {
    const int tid = VTID, lane = tid & 63, wid = tid >> 6, wm = wid >> 1, wn = wid & 1, lq = lane >> 4, lr = lane & 15;
    FOR_XCD_ITEMS(item, NE * 16 * NB * 4) {
        const int rt = item & 3, b = (item >> 2) & 3, ct = (item >> 4) & 15, e = item >> 8;
        const int* arow = wsp<int>(p, OFF_IDX) + (long)(b * NE + e) * CAP + rt * 128;
        f32x4 acc[4][4];
        GemmTile g; g.A = wsp<bf16_t>(p, OFF_X2B); g.lda = ND; g.arow = arow;
        g.Bt = wsp<bf16_t>(p, OFF_WGUT) + ((long)e * 2048 + ct * 128) * ND; g.ldb = ND; g.K = ND;
        gemm_tile_128(g, lds, acc);
#pragma unroll
        for (int mi = 0; mi < 4; mi++) {
            const int r = wm * 64 + mi * 16 + lr;
            const int tok = arow[r];
            const float rs = row_rs16(wsp<float>(p, OFF_SS2) + (long)tok * 16);
            bf16_t* ad = wsp<bf16_t>(p, OFF_ACT) + ((long)(e * NB + b) * CAP + rt * 128 + r) * ND + ct * 64 + wn * 32 + 4 * lq;
#pragma unroll
            for (int pp = 0; pp < 2; pp++) {
                f32x4 o;
#pragma unroll
                for (int q = 0; q < 4; q++) {
                    const float ga = acc[mi][2 * pp][q] * rs, up = acc[mi][2 * pp + 1][q] * rs;
                    o[q] = ga / (1.f + __expf(-ga)) * up;
                }
                *(u32x2*)(ad + pp * 16) = pack4bf(o);
            }
        }
    }
}
__device__ __forceinline__ void phase10(const Params& p, char* lds) {
    const int tid = VTID, lane = tid & 63, wid = tid >> 6, wm = wid >> 1, wn = wid & 1, lq = lane >> 4, lr = lane & 15;
    FOR_XCD_ITEMS(item, NE * 8 * NB * 4) {
        const int rt = item & 3, b = (item >> 2) & 3, ct = (item >> 4) & 7, e = item >> 7;
        const long row0 = (long)(e * NB + b) * CAP + rt * 128;
        f32x4 acc[4][4];
        GemmTile g; g.A = wsp<bf16_t>(p, OFF_ACT) + row0 * ND; g.lda = ND; g.arow = nullptr;
        g.Bt = wsp<bf16_t>(p, OFF_WDT) + ((long)e * 1024 + ct * 128) * ND; g.ldb = ND; g.K = ND;
        gemm_tile_128(g, lds, acc);
        const float* gate = wsp<float>(p, OFF_GATE) + (long)(b * NE + e) * CAP + rt * 128;
#pragma unroll
        for (int mi = 0; mi < 4; mi++) {
            const int r = wm * 64 + mi * 16 + lr;
            const float gv = gate[r];
            bf16_t* yd = wsp<bf16_t>(p, OFF_Y) + (row0 + r) * ND + ct * 128 + wn * 64 + 4 * lq;
#pragma unroll
            for (int ni = 0; ni < 4; ni++) *(u32x2*)(yd + ni * 16) = pack4bf(acc[mi][ni] * gv);
        }
    }
}

__device__ __forceinline__ void phase11(const Params& p, char* lds) {
    const int tid = VTID, lane = tid & 63, wid = tid >> 6;
    for (int tok = VBLK * 4 + wid; tok < NT; tok += VGRID * 4) {
        const int b = tok >> 12, t = tok & 4095;
        float* xr = p.out + (long)tok * ND;
        const bf16_t* xb2 = wsp<bf16_t>(p, OFF_X2B) + (long)tok * ND;
        f32x4 v[4];
#pragma unroll
        for (int i = 0; i < 4; i++) {
            const u32x2 w = *(const u32x2*)(xb2 + i * 256 + lane * 4);
            v[i] = (f32x4){__uint_as_float(w.x << 16), __uint_as_float(w.x & 0xFFFF0000u), __uint_as_float(w.y << 16), __uint_as_float(w.y & 0xFFFF0000u)};
        }
        for (int e = 0; e < NE; e++) {
            const int sl = wsp<int>(p, OFF_SLOTS)[(long)(b * NE + e) * NS + t];
            if (sl >= 0) {
                const bf16_t* yr = wsp<bf16_t>(p, OFF_Y) + ((long)(e * NB + b) * CAP + sl) * ND;
#pragma unroll
                for (int i = 0; i < 4; i++) {
                    const u32x2 w = *(const u32x2*)(yr + i * 256 + lane * 4);
                    v[i][0] += __uint_as_float(w.x << 16); v[i][1] += __uint_as_float(w.x & 0xFFFF0000u);
                    v[i][2] += __uint_as_float(w.y << 16); v[i][3] += __uint_as_float(w.y & 0xFFFF0000u);
                }
            }
        }
        float ss = 0.f;
#pragma unroll
        for (int i = 0; i < 4; i++) ss += v[i][0] * v[i][0] + v[i][1] * v[i][1] + v[i][2] * v[i][2] + v[i][3] * v[i][3];
        ss = wave_sum(ss);
        const float rs = rsqrtf(ss * (1.f / ND) + 1e-6f);
#pragma unroll
        for (int i = 0; i < 4; i++) {
            const f32x4 gf = *(const f32x4*)(p.g_final + i * 256 + lane * 4);
            *(f32x4*)(xr + i * 256 + lane * 4) = v[i] * rs * gf;
        }
    }
}


__device__ __forceinline__ void phase_resid8(const Params& p, char* lds, size_t offA, size_t offW, const float* residf, const bf16_t* residb, size_t offXb, size_t offSS) {
    const int tid = threadIdx.x, lane = tid & 63, wid = tid >> 6, wm = wid >> 2, wn = wid & 3, lq = lane >> 4, lr = lane & 15;
    FOR_XCD_ITEMS_R(item, 64 * 4) {
        const int tm = item >> 2, tn = item & 3;
        f32x4 acc[8][4];
        GemmTile g; g.A = wsp<bf16_t>(p, offA) + (long)tm * 256 * ND; g.lda = ND; g.arow = nullptr;
        g.Bt = wsp<bf16_t>(p, offW) + (long)tn * 256 * ND; g.ldb = ND; g.K = ND;
        gemm_tile_256sq(g, lds, acc);
#pragma unroll
        for (int mi = 0; mi < 8; mi++) {
            const int row = tm * 256 + wm * 128 + mi * 16 + lr;
            float ss = 0.f;
#pragma unroll
            for (int ni = 0; ni < 4; ni++) {
                const long o = (long)row * ND + tn * 256 + wn * 64 + ni * 16 + 4 * lq;
                f32x4 rv;
                if (residf) rv = *(const f32x4*)(residf + o);
                else { const u32x2 w = *(const u32x2*)(residb + o); rv = (f32x4){__uint_as_float(w.x << 16), __uint_as_float(w.x & 0xFFFF0000u), __uint_as_float(w.y << 16), __uint_as_float(w.y & 0xFFFF0000u)}; }
                const f32x4 v = rv + acc[mi][ni];
                *(u32x2*)(wsp<bf16_t>(p, offXb) + o) = pack4bf(v);
                ss += v[0] * v[0] + v[1] * v[1] + v[2] * v[2] + v[3] * v[3];
            }
            ss += __shfl_xor(ss, 16); ss += __shfl_xor(ss, 32);
            if (lq == 0) wsp<float>(p, offSS)[row * 16 + tn * 4 + wn] = ss;
        }
    }
}
__device__ __forceinline__ void phase5a8(const Params& p, char* lds) {
    const int tid = threadIdx.x, lane = tid & 63, wid = tid >> 6, wm = wid >> 2, wn = wid & 3, lq = lane >> 4, lr = lane & 15;
    FOR_XCD_ITEMS_R(item, 64 * 4) {
        const int tm = item >> 2, tn = item & 3;
        f32x4 acc[8][4];
        GemmTile g; g.A = wsp<bf16_t>(p, OFF_X1B) + (long)tm * 256 * ND; g.lda = ND; g.arow = nullptr;
        g.Bt = wsp<bf16_t>(p, OFF_WMQT) + (long)tn * 256 * ND; g.ldb = ND; g.K = ND;
        gemm_tile_256sq(g, lds, acc);
#pragma unroll
        for (int mi = 0; mi < 8; mi++) {
            const int row = tm * 256 + wm * 128 + mi * 16 + lr, b = row >> 12, s = row & 4095;
            const float rs = row_rs16(wsp<float>(p, OFF_SS1) + (long)row * 16) * (0.0625f * 1.4426950408889634f);
            bf16_t* qd = wsp<bf16_t>(p, OFF_QM) + ((long)(b * 4 + tn) * NS + s) * 256 + wn * 64 + 4 * lq;
#pragma unroll
            for (int ni = 0; ni < 4; ni++) *(u32x2*)(qd + ni * 16) = pack4bf(acc[mi][ni] * rs);
        }
    }
}


__device__ __forceinline__ void phase9_8(const Params& p, char* lds) {
    const int tid = threadIdx.x, lane = tid & 63, wid = tid >> 6, wm = wid >> 2, wn = wid & 3, lq = lane >> 4, lr = lane & 15;
    FOR_XCD_ITEMS_R(item, NE * 8 * NB * 2) {
        const int rt = item & 1, b = (item >> 1) & 3, ct = (item >> 3) & 7, e = item >> 6;
        const int* arow = wsp<int>(p, OFF_IDX) + (long)(b * NE + e) * CAP + rt * 256;
        f32x4 acc[8][4];
        GemmTile g; g.A = wsp<bf16_t>(p, OFF_X2B); g.lda = ND; g.arow = arow;
        g.Bt = wsp<bf16_t>(p, OFF_WGUT) + ((long)e * 2048 + ct * 256) * ND; g.ldb = ND; g.K = ND;
        gemm_tile_256sq(g, lds, acc);
#pragma unroll
        for (int mi = 0; mi < 8; mi++) {
            const int r = wm * 128 + mi * 16 + lr;
            const int tok = arow[r];
            const float rs = row_rs16(wsp<float>(p, OFF_SS2) + (long)tok * 16);
            bf16_t* ad = wsp<bf16_t>(p, OFF_ACT) + ((long)(e * NB + b) * CAP + rt * 256 + r) * ND + ct * 128 + wn * 32 + 4 * lq;
#pragma unroll
            for (int pp = 0; pp < 2; pp++) {
                f32x4 o;
#pragma unroll
                for (int q = 0; q < 4; q++) {
                    const float ga = acc[mi][2 * pp][q] * rs, up = acc[mi][2 * pp + 1][q] * rs;
                    o[q] = ga / (1.f + __expf(-ga)) * up;
                }
                *(u32x2*)(ad + pp * 16) = pack4bf(o);
            }
        }
    }
}
__device__ __forceinline__ void phase10_8(const Params& p, char* lds) {
    const int tid = threadIdx.x, lane = tid & 63, wid = tid >> 6, wm = wid >> 2, wn = wid & 3, lq = lane >> 4, lr = lane & 15;
    FOR_XCD_ITEMS_R(item, NE * 4 * NB * 2) {
        const int rt = item & 1, b = (item >> 1) & 3, ct = (item >> 3) & 3, e = item >> 5;
        const long row0 = (long)(e * NB + b) * CAP + rt * 256;
        f32x4 acc[8][4];
        GemmTile g; g.A = wsp<bf16_t>(p, OFF_ACT) + row0 * ND; g.lda = ND; g.arow = nullptr;
        g.Bt = wsp<bf16_t>(p, OFF_WDT) + ((long)e * 1024 + ct * 256) * ND; g.ldb = ND; g.K = ND;
        gemm_tile_256sq(g, lds, acc);
        const float* gate = wsp<float>(p, OFF_GATE) + (long)(b * NE + e) * CAP + rt * 256;
#pragma unroll
        for (int mi = 0; mi < 8; mi++) {
            const int r = wm * 128 + mi * 16 + lr;
            const float gv = gate[r];
            bf16_t* yd = wsp<bf16_t>(p, OFF_Y) + (row0 + r) * ND + ct * 256 + wn * 64 + 4 * lq;
#pragma unroll
            for (int ni = 0; ni < 4; ni++) *(u32x2*)(yd + ni * 16) = pack4bf(acc[mi][ni] * gv);
        }
    }
}


__device__ __forceinline__ void phase1_big(const Params& p, char* lds) {
    const int tid = threadIdx.x, lane = tid & 63, wid = tid >> 6, wm = wid >> 2, wn = wid & 3, lq = lane >> 4, lr = lane & 15;
    FOR_XCD_ITEMS_R(item, 64 * 4) {
        const int tm = item >> 2, tn = item & 3;
        f32x4 acc[8][4];
        GemmTile g; g.A = wsp<bf16_t>(p, OFF_XB) + (long)tm * 256 * ND; g.lda = ND; g.arow = nullptr;
        g.Bt = wsp<bf16_t>(p, OFF_W1T) + (long)tn * 256 * ND; g.ldb = ND; g.K = ND;
        gemm_tile_256sq(g, lds, acc);
        const float* r0 = wsp<float>(p, OFF_R0);
        const int col0 = tn * 256 + wn * 64;
#pragma unroll
        for (int mi = 0; mi < 8; mi++) {
            const int row = tm * 256 + wm * 128 + mi * 16 + lr;
            const float rs = r0[row];
#pragma unroll
            for (int ni = 0; ni < 4; ni++) acc[mi][ni] *= rs;
            if (col0 < 512) {
#pragma unroll
                for (int ni = 0; ni < 4; ni++)
                    *(u32x2*)(wsp<bf16_t>(p, OFF_UF) + (long)row * 512 + col0 + ni * 16 + 4 * lq) = pack4bf(acc[mi][ni]);
            } else {
                float ss = 0.f;
#pragma unroll
                for (int ni = 0; ni < 4; ni++) { const f32x4 v = acc[mi][ni]; ss += v[0] * v[0] + v[1] * v[1] + v[2] * v[2] + v[3] * v[3]; }
                ss += __shfl_xor(ss, 16); ss += __shfl_xor(ss, 32);
                if (col0 < 896) {
#pragma unroll
                    for (int ni = 0; ni < 4; ni++)
                        *(u32x2*)(wsp<bf16_t>(p, OFF_UQ) + (long)row * 384 + (col0 - 512) + ni * 16 + 4 * lq) = pack4bf(acc[mi][ni]);
                    if (lq == 0) wsp<float>(p, OFF_SSQ)[row * 6 + ((col0 - 512) >> 6)] = ss;
                } else {
#pragma unroll
                    for (int ni = 0; ni < 4; ni++)
                        *(u32x2*)(wsp<bf16_t>(p, OFF_UKV) + (long)row * 256 + (col0 - 896) + ni * 16 + 4 * lq) = pack4bf(acc[mi][ni]);
                    if (lq == 0) wsp<float>(p, OFF_SSKV)[row * 4 + ((col0 - 896) >> 6)] = ss;
                }
            }
        }
    }
}


__device__ __forceinline__ void phase3_attn8(const Params& p, char* lds) {
    FOR_XCD_ITEMS_R(item, NB * 8 * (NS / 256)) {
        const int qt = item & 15, h = (item >> 4) & 7, b = item >> 7;
        const bf16_t* Qp = wsp<bf16_t>(p, OFF_Q) + ((long)(b * 8 + h) * NS + qt * 256) * 96;
        const bf16_t* Kp = wsp<bf16_t>(p, OFF_K) + ((long)(b * 8 + h) * NS) * 96;
        const bf16_t* Vtp = wsp<bf16_t>(p, OFF_VT) + ((long)(b * 8 + h) * 64) * NS;
        bf16_t* Op = wsp<bf16_t>(p, OFF_ZA) + ((long)b * NS + qt * 256) * 1024 + 512 + h * 64;
        attn_block<96, 64, 128, 512>(Qp, Kp, Vtp, (long)NS, NS, lds, [&](int q, int dv, f32x4 v) { *(u32x2*)(Op + (long)q * 1024 + dv) = pack4bf(v); });
    }
}
__device__ __forceinline__ void phase5b_8(const Params& p, char* lds) {
    FOR_XCD_ITEMS_R(item, NB * 4 * 16 * 2) {
        const int dvh = item & 1, qt = (item >> 1) & 15, h = (item >> 5) & 3, b = item >> 7;
        const bf16_t* Qp = wsp<bf16_t>(p, OFF_QM) + ((long)(b * 4 + h) * NS + qt * 256) * 256;
        const bf16_t* Kp = wsp<bf16_t>(p, OFF_KMEM) + ((long)(b * 4 + h) * 256) * 256;
        const bf16_t* Vtp = wsp<bf16_t>(p, OFF_VTMEM) + ((long)(b * 4 + h) * 256 + dvh * 128) * 256;
        bf16_t* Op = wsp<bf16_t>(p, OFF_OM) + ((long)b * NS + qt * 256) * 1024 + h * 256 + dvh * 128;
        attn_block<256, 128, 32, 512>(Qp, Kp, Vtp, 256L, 256, lds, [&](int q, int dv, f32x4 v) { *(u32x2*)(Op + (long)q * 1024 + dv) = pack4bf(v); });
    }
}

__global__ void __launch_bounds__(512, 1) k_fwd(Params p, int ph_lo, int ph_hi) {
    extern __shared__ __attribute__((aligned(16))) char lds_all[];
    char* lds = lds_all + VHALF * LDS_HALF;
    volatile LAS unsigned* st = (volatile LAS unsigned*)(lds_all + LDS_MAIN);
    if (threadIdx.x == 0) { st[0] = 0u; st[1] = 0u; }
    __syncthreads();
    XcdBarrier bar = xcd_barrier_post(wsp<unsigned>(p, OFF_BAR), st);
#if USE_CG_SYNC
#define GRID_BARRIER() do { asm volatile("s_waitcnt vmcnt(0)" ::: "memory"); __syncthreads(); cg::this_grid().sync(); asm volatile("s_waitcnt vmcnt(0)" ::: "memory"); __syncthreads(); } while (0)
#else
#define GRID_BARRIER() xcd_barrier(bar)
#endif
#define RUN_PHASE(k, call) if (ph_lo <= (k) && (k) < ph_hi) { if ((k) > ph_lo) { GRID_BARRIER(); } call; }
    RUN_PHASE(0, phase0(p, lds))
    RUN_PHASE(1, (phase1_big(p, lds_all), phase1(p, lds_all)))
    RUN_PHASE(2, (phase2(p, lds_all), phase2_f2a(p, lds)))
    RUN_PHASE(3, ((blockIdx.x & 1) ? phase3_tr(p, lds) : (void)0, phase3_attn8(p, lds_all), phase3_f2b(p, lds), (blockIdx.x & 1) ? (void)0 : phase3_tr(p, lds)))
    RUN_PHASE(4, phase_resid8(p, lds_all, OFF_ZA, OFF_WOUTT, p.x, nullptr, OFF_X1B, OFF_SS1))
    RUN_PHASE(5, phase5a8(p, lds_all))
    RUN_PHASE(6, phase5b_8(p, lds_all))
    RUN_PHASE(7, phase_resid8(p, lds_all, OFF_OM, OFF_WMOT, nullptr, wsp<bf16_t>(p, OFF_X1B), OFF_X2B, OFF_SS2))
    RUN_PHASE(8, phase7(p, lds))
    RUN_PHASE(9, phase8(p, lds))
    RUN_PHASE(10, phase9_8(p, lds_all))
    RUN_PHASE(11, phase10_8(p, lds_all))
    RUN_PHASE(12, phase11(p, lds))
}

extern "C" void kernel_launch(void* const* d_in, const int* in_sizes, int n_in,
                              void* d_out, int out_size, void* d_ws, size_t ws_size,
                              hipStream_t stream) {
    static int grid = 0;
    if (grid == 0) {
        if (n_in != 22 || ws_size < WS_END) { fprintf(stderr, "kernel_launch: unexpected inputs (n_in %d, ws %zu < %zu)\n", n_in, ws_size, (size_t)WS_END); grid = -1; return; }
        int dev = 0, cus = 0, per_cu = 0;
        (void)hipGetDevice(&dev);
        (void)hipDeviceGetAttribute(&cus, hipDeviceAttributeMultiprocessorCount, dev);
        if (hipFuncSetAttribute((const void*)k_fwd, hipFuncAttributeMaxDynamicSharedMemorySize, LDS_TOTAL) != hipSuccess) { fprintf(stderr, "kernel_launch: hipFuncSetAttribute failed\n"); grid = -1; return; }
        if (hipOccupancyMaxActiveBlocksPerMultiprocessor(&per_cu, (const void*)k_fwd, 512, LDS_TOTAL) != hipSuccess || per_cu < 1) { fprintf(stderr, "kernel_launch: occupancy query failed (%d)\n", per_cu); (void)hipGetLastError(); per_cu = 1; }
        if (per_cu > 1) per_cu = 1;
        grid = (cus * per_cu) & ~7;
        if (grid < 8) { fprintf(stderr, "kernel_launch: unexpected device (%d CUs)\n", cus); grid = -1; return; }
        fprintf(stderr, "kernel_launch: %d CUs x %d blocks\n", cus, per_cu);
    }
    if (grid < 0) return;
    Params p{};
    p.x = (const float*)d_in[0]; p.mem = (const float*)d_in[1]; p.pos = (const int*)d_in[2];
    p.g_mix = (const float*)d_in[3]; p.w_in = (const float*)d_in[4]; p.g_q_lat = (const float*)d_in[5]; p.w_q_up = (const float*)d_in[6];
    p.g_kv_lat = (const float*)d_in[7]; p.w_kv_up = (const float*)d_in[8]; p.w_fourier = (const float*)d_in[9]; p.w_out = (const float*)d_in[10];
    p.g_mem_q = (const float*)d_in[11]; p.g_mem_kv = (const float*)d_in[12]; p.w_mem_q = (const float*)d_in[13]; p.w_mem_kv = (const float*)d_in[14];
    p.w_mem_o = (const float*)d_in[15]; p.g_ffn = (const float*)d_in[16]; p.w_router = (const float*)d_in[17];
    p.w_exp_gate = (const float*)d_in[18]; p.w_exp_up = (const float*)d_in[19]; p.w_exp_down = (const float*)d_in[20]; p.g_final = (const float*)d_in[21];
    p.out = (float*)d_out; p.ws = (char*)d_ws;
    static const int cuts[] = MK_CUTS;
    const int ncut = (int)(sizeof(cuts) / sizeof(int));
    for (int li = 0; li + 1 < ncut; li++) {
        (void)hipMemsetAsync((char*)d_ws + OFF_BAR, 0, 16384, stream);
        int lo = cuts[li], hi = cuts[li + 1];
        void* args[] = {&p, &lo, &hi};
        hipError_t e = hipLaunchCooperativeKernel((const void*)k_fwd, dim3(grid), dim3(512), args, LDS_TOTAL, stream);
        if (e != hipSuccess) fprintf(stderr, "cooperative launch failed: %s (grid %d)\n", hipGetErrorString(e), grid);
    }
}
```

```cpp
#include <hip/hip_runtime.h>
#include <stdint.h>
#include <cstdio>
#include <hip/hip_cooperative_groups.h>
namespace cg = cooperative_groups;
#ifndef USE_CG_SYNC
#define USE_CG_SYNC 0
#endif

#ifndef MK_CUTS
#define MK_CUTS {0, 13}
#endif

#define NB 4
#define NS 4096
#define ND 1024
#define NT (NB * NS)
#define INW 1184
#define NE 16
#define CAP 512
#define MEML 256
#define NPHASE 13
#define VTID ((int)(threadIdx.x & 255))
#define VHALF (__builtin_amdgcn_readfirstlane((int)(threadIdx.x >> 8)))
#define VBLK ((int)(blockIdx.x * 2) + VHALF)
#define VGRID ((int)(gridDim.x * 2))

typedef unsigned short bf16_t;
typedef short bf16x8 __attribute__((ext_vector_type(8)));
typedef float f32x4 __attribute__((ext_vector_type(4)));
typedef float f32x16 __attribute__((ext_vector_type(16)));
typedef unsigned u32x4 __attribute__((ext_vector_type(4)));
typedef unsigned u32x2 __attribute__((ext_vector_type(2)));

__device__ __forceinline__ unsigned f2bf(float f) {
    unsigned u = __float_as_uint(f);
    u += 0x7FFFu + ((u >> 16) & 1u);
    return u >> 16;
}
typedef __bf16 hbf2 __attribute__((ext_vector_type(2)));
typedef float f32x2 __attribute__((ext_vector_type(2)));
__device__ __forceinline__ unsigned pack2bf(float lo, float hi) { f32x2 v = {lo, hi}; return __builtin_bit_cast(unsigned, __builtin_convertvector(v, hbf2)); }
__device__ __forceinline__ float bf2f(unsigned short b) { return __uint_as_float(((unsigned)b) << 16); }

__device__ __forceinline__ int tile_off(int row, int chunk) { return row * 128 + ((chunk ^ ((row >> 1) & 7)) << 4); }

#define GT_LDS_BYTES 65536

struct GemmTile { const bf16_t* A; long lda; const int* arow; const bf16_t* Bt; long ldb; int K; };

__device__ __forceinline__ void gemm_tile_128(const GemmTile& g, char* lds, f32x4 (&acc)[4][4]) {
    const int tid = VTID, lane = tid & 63, wid = tid >> 6, wm = wid >> 1, wn = wid & 1;
    const int lrow = lane >> 3, pc = lane & 7;
    const bf16_t* ap[4]; const bf16_t* bp[4];
#pragma unroll
    for (int i = 0; i < 4; i++) {
        const int r = (wid * 4 + i) * 8 + lrow;
        const int c = pc ^ ((r >> 1) & 7);
        const long ro = g.arow ? (long)g.arow[r] * g.lda : (long)r * g.lda;
        ap[i] = g.A + ro + c * 8;
        bp[i] = g.Bt + (long)r * g.ldb + c * 8;
    }
#pragma unroll
    for (int mi = 0; mi < 4; mi++)
#pragma unroll
        for (int ni = 0; ni < 4; ni++) acc[mi][ni] = (f32x4){0.f, 0.f, 0.f, 0.f};
    const int nk = g.K >> 6;
    auto stage = [&](int kt, char* st) {
#pragma unroll
        for (int i = 0; i < 4; i++) {
            __builtin_amdgcn_global_load_lds((const unsigned*)(ap[i] + kt * 64), (unsigned*)(st + (wid * 4 + i) * 1024), 16, 0, 0);
            __builtin_amdgcn_global_load_lds((const unsigned*)(bp[i] + kt * 64), (unsigned*)(st + 16384 + (wid * 4 + i) * 1024), 16, 0, 0);
        }
    };
    __syncthreads();
    stage(0, lds);
    asm volatile("s_waitcnt vmcnt(0)" ::: "memory");
    __syncthreads();
    for (int kt = 0; kt < nk; kt++) {
        char* cur = lds + (kt & 1) * 32768;
        if (kt + 1 < nk) stage(kt + 1, lds + ((kt + 1) & 1) * 32768);
        bf16x8 af[2][4], bfr[2][4];
#pragma unroll
        for (int ks = 0; ks < 2; ks++)
#pragma unroll
            for (int i = 0; i < 4; i++) {
                af[ks][i] = *(const bf16x8*)(cur + tile_off(wm * 64 + i * 16 + (lane & 15), ks * 4 + (lane >> 4)));
                bfr[ks][i] = *(const bf16x8*)(cur + 16384 + tile_off(wn * 64 + i * 16 + (lane & 15), ks * 4 + (lane >> 4)));
            }
        __builtin_amdgcn_s_setprio(1);
#pragma unroll
        for (int ks = 0; ks < 2; ks++)
#pragma unroll
            for (int mi = 0; mi < 4; mi++)
#pragma unroll
                for (int ni = 0; ni < 4; ni++)
                    acc[mi][ni] = __builtin_amdgcn_mfma_f32_16x16x32_bf16(bfr[ks][ni], af[ks][mi], acc[mi][ni], 0, 0, 0);
        __builtin_amdgcn_s_setprio(0);
        asm volatile("s_waitcnt vmcnt(0)" ::: "memory");
        __syncthreads();
    }
}

template <int DQK, int DVT, int KT>
struct AttnCfg {
    static constexpr int KROW = DQK * 2 + 16;
    static constexpr int VROW = KT * 2 + 8;
    static constexpr int KBYTES = KT * KROW;
    static constexpr int VBYTES = DVT * VROW;
    static constexpr int STAGE = KBYTES + VBYTES;
    static constexpr int LDS = 2 * STAGE;
};

template <int DQK, int DVT, int KT, int NTH, class Out>
__device__ __forceinline__ void attn_block(const bf16_t* Qp, const bf16_t* Kp, const bf16_t* Vtp, long ldv, int nk, char* lds, Out&& out) {
    typedef AttnCfg<DQK, DVT, KT> C;
    constexpr int NKS = DQK / 16, NST = KT / 32, NDT = DVT / 32, NPS = KT / 16;
    constexpr int KCPR = DQK / 8;
    constexpr int KTOT = KT * KCPR, KCH = (KTOT + NTH - 1) / NTH;
    constexpr int VCPR = KT / 8;
    constexpr int VTOT = DVT * VCPR, VCH = (VTOT + NTH - 1) / NTH;
    const int tid = NTH == 512 ? (int)threadIdx.x : VTID, lane = tid & 63, wid = tid >> 6, h = lane >> 5, c = lane & 31;

    bf16x8 qf[NKS];
    {
        const bf16_t* qrow = Qp + (long)(wid * 32 + c) * DQK + 8 * h;
#pragma unroll
        for (int ks = 0; ks < NKS; ks++) qf[ks] = *(const bf16x8*)(qrow + 16 * ks);
    }
    f32x16 o[NDT];
#pragma unroll
    for (int dt = 0; dt < NDT; dt++)
#pragma unroll
        for (int r = 0; r < 16; r++) o[dt][r] = 0.f;
    float m = 0.f, l = 0.f;

    u32x4 kr[KCH], vr[VCH];
    auto gload = [&](int t) {
#pragma unroll
        for (int i = 0; i < KCH; i++) {
            const int ci = tid + NTH * i, row = ci / KCPR, cc = ci % KCPR;
            if (KTOT % NTH == 0 || ci < KTOT) kr[i] = *(const u32x4*)(Kp + (long)(t * KT + row) * DQK + cc * 8);
        }
#pragma unroll
        for (int i = 0; i < VCH; i++) {
            const int ci = tid + NTH * i, row = ci / VCPR, cc = ci % VCPR;
            if (VTOT % NTH == 0 || ci < VTOT) vr[i] = *(const u32x4*)(Vtp + (long)row * ldv + t * KT + cc * 8);
        }
    };
    auto lwrite = [&](char* st) {
#pragma unroll
        for (int i = 0; i < KCH; i++) {
            const int ci = tid + NTH * i, row = ci / KCPR, cc = ci % KCPR;
            if (KTOT % NTH == 0 || ci < KTOT) *(u32x4*)(st + row * C::KROW + cc * 16) = kr[i];
        }
#pragma unroll
        for (int i = 0; i < VCH; i++) {
            const int ci = tid + NTH * i, row = ci / VCPR, cc = ci % VCPR;
            if (VTOT % NTH == 0 || ci < VTOT) {
                char* p = st + C::KBYTES + row * C::VROW + cc * 16;
                *(u32x2*)(p) = (u32x2){vr[i].x, vr[i].y};
                *(u32x2*)(p + 8) = (u32x2){vr[i].z, vr[i].w};
            }
        }
    };
    const int nt = nk / KT;
    gload(0);
    __syncthreads();
    lwrite(lds);
    __syncthreads();
    for (int t = 0; t < nt; t++) {
        char* cur = lds + (t & 1) * C::STAGE;
        if (t + 1 < nt) gload(t + 1);
        f32x16 s[NST];
        const float negm = -m;
#pragma unroll
        for (int st = 0; st < NST; st++) {
#pragma unroll
            for (int r = 0; r < 16; r++) s[st][r] = negm;
#pragma unroll
            for (int ks = 0; ks < NKS; ks++) {
                const bf16x8 kf = *(const bf16x8*)(cur + (st * 32 + c) * C::KROW + ks * 32 + h * 16);
                s[st] = __builtin_amdgcn_mfma_f32_32x32x16_bf16(kf, qf[ks], s[st], 0, 0, 0);
            }
        }
        float mx = s[0][0];
#pragma unroll
        for (int st = 0; st < NST; st++)
#pragma unroll
            for (int r = 0; r < 16; r++) mx = fmaxf(mx, s[st][r]);
        mx = fmaxf(mx, __shfl_xor(mx, 32));
        if (__any(mx > 8.0f)) {
            const float d = fmaxf(mx, 0.f);
            const float alpha = __builtin_amdgcn_exp2f(-d);
            m += d;
            l *= alpha;
#pragma unroll
            for (int dt = 0; dt < NDT; dt++)
#pragma unroll
                for (int r = 0; r < 16; r++) o[dt][r] *= alpha;
#pragma unroll
            for (int st = 0; st < NST; st++)
#pragma unroll
                for (int r = 0; r < 16; r++) s[st][r] -= d;
        }
        float rs = 0.f;
#pragma unroll
        for (int st = 0; st < NST; st++)
#pragma unroll
            for (int r = 0; r < 16; r++) { const float p = __builtin_amdgcn_exp2f(s[st][r]); rs += p; s[st][r] = p; }
        l += rs;
#pragma unroll
        for (int ps = 0; ps < NPS; ps++) {
            const int st = ps >> 1, u = ps & 1;
            u32x4 pw;
            pw.x = pack2bf(s[st][8 * u + 0], s[st][8 * u + 1]);
            pw.y = pack2bf(s[st][8 * u + 2], s[st][8 * u + 3]);
            pw.z = pack2bf(s[st][8 * u + 4], s[st][8 * u + 5]);
            pw.w = pack2bf(s[st][8 * u + 6], s[st][8 * u + 7]);
            const bf16x8 pf = __builtin_bit_cast(bf16x8, pw);
#pragma unroll
            for (int dt = 0; dt < NDT; dt++) {
                const char* vp = cur + C::KBYTES + (dt * 32 + c) * C::VROW + (ps * 16 + 4 * h) * 2;
                const u32x2 v0 = *(const u32x2*)(vp);
                const u32x2 v1 = *(const u32x2*)(vp + 16);
                const bf16x8 vf = __builtin_bit_cast(bf16x8, ((u32x4){v0.x, v0.y, v1.x, v1.y}));
                o[dt] = __builtin_amdgcn_mfma_f32_32x32x16_bf16(vf, pf, o[dt], 0, 0, 0);
            }
        }
        if (t + 1 < nt) lwrite(lds + ((t + 1) & 1) * C::STAGE);
        __syncthreads();
    }
    l += __shfl_xor(l, 32);
    const float inv = 1.f / l;
#pragma unroll
    for (int dt = 0; dt < NDT; dt++)
#pragma unroll
        for (int g4 = 0; g4 < 4; g4++) {
            f32x4 v = {o[dt][4 * g4 + 0] * inv, o[dt][4 * g4 + 1] * inv, o[dt][4 * g4 + 2] * inv, o[dt][4 * g4 + 3] * inv};
            out(wid * 32 + c, dt * 32 + 8 * g4 + 4 * h, v);
        }
}


constexpr size_t SLOT = 33554432;
constexpr size_t OFF_W1T = 0;
constexpr size_t OFF_WQT = OFF_W1T + 1280UL * 1024 * 2;
constexpr size_t OFF_WKVT = OFF_WQT + 768UL * 384 * 2;
constexpr size_t OFF_WOUTT = OFF_WKVT + 1024UL * 256 * 2;
constexpr size_t OFF_WMQT = OFF_WOUTT + 1024UL * 1024 * 2;
constexpr size_t OFF_WMKVT = OFF_WMQT + 1024UL * 1024 * 2;
constexpr size_t OFF_WMOT = OFF_WMKVT + 2048UL * 1024 * 2;
constexpr size_t OFF_WGUT = OFF_WMOT + 1024UL * 1024 * 2;
constexpr size_t OFF_WDT = OFF_WGUT + 16UL * 2048 * 1024 * 2;
constexpr size_t OFF_T64 = OFF_WDT + 16UL * 1024 * 1024 * 2;
constexpr size_t OFF_M1 = OFF_T64 + 16384;
constexpr size_t OFF_M3 = OFF_M1 + 32768;
constexpr size_t OFF_WFT = OFF_M3 + 16384;
constexpr size_t OFF_TW = OFF_WFT + 65536;
constexpr size_t OFF_ROPE = OFF_TW + 32768;
constexpr size_t OFF_R0 = OFF_ROPE + (size_t)NT * 16 * 8;
constexpr size_t OFF_RMEM = OFF_R0 + (size_t)NT * 4;
constexpr size_t OFF_SSQ = OFF_RMEM + 4096;
constexpr size_t OFF_SSKV = OFF_SSQ + (size_t)NT * 6 * 4;
constexpr size_t OFF_SS1 = OFF_SSKV + (size_t)NT * 4 * 4;
constexpr size_t OFF_SS2 = OFF_SS1 + (size_t)NT * 16 * 4;
constexpr size_t OFF_AFF = OFF_SS2 + (size_t)NT * 16 * 4;
constexpr size_t OFF_SLOTS = OFF_AFF + (size_t)NT * 16 * 4;
constexpr size_t OFF_IDX = OFF_SLOTS + 4UL * 16 * 4096 * 4;
constexpr size_t OFF_GATE = OFF_IDX + 4UL * 16 * 512 * 4;
constexpr size_t OFF_MEMB = OFF_GATE + 4UL * 16 * 512 * 4;
constexpr size_t OFF_KMEM = OFF_MEMB + 1024UL * 1024 * 2;
constexpr size_t OFF_VTMEM = OFF_KMEM + 1024UL * 1024 * 2;
constexpr size_t OFF_KR = OFF_VTMEM + 1024UL * 1024 * 2;
constexpr size_t OFF_BAR = OFF_KR + (size_t)NT * 32 * 2;
constexpr size_t OFF_S0 = (OFF_BAR + 16384 + 255) / 256 * 256;
constexpr size_t OFF_S1 = OFF_S0 + SLOT;
constexpr size_t OFF_S2 = OFF_S1 + SLOT;
constexpr size_t OFF_S3 = OFF_S2 + SLOT;
constexpr size_t OFF_S4 = OFF_S3 + SLOT;
constexpr size_t WS_END = OFF_S4 + SLOT;
static_assert(WS_END <= 300964352UL, "workspace map exceeds the guaranteed scratch size");
constexpr size_t OFF_XB = OFF_S0, OFF_YR = OFF_S0, OFF_YI = OFF_S0 + SLOT / 2, OFF_X1B = OFF_S3, OFF_OM = OFF_S0, OFF_ACT = OFF_S0;
constexpr size_t OFF_UF = OFF_S1, OFF_UQ = OFF_S1 + (size_t)NT * 512 * 2, OFF_ZA = OFF_S1, OFF_QM = OFF_S1;
constexpr size_t OFF_Q = OFF_S2, OFF_UKV = OFF_S2 + (size_t)NT * 768 * 2, OFF_X2B = OFF_S2;
constexpr size_t OFF_K = OFF_S3, OFF_Y = OFF_S3;
constexpr size_t OFF_VT = OFF_S4;

struct Params {
    const float *x, *mem; const int* pos;
    const float *g_mix, *w_in, *g_q_lat, *w_q_up, *g_kv_lat, *w_kv_up, *w_fourier, *w_out, *g_mem_q, *g_mem_kv, *w_mem_q, *w_mem_kv, *w_mem_o,
        *g_ffn, *w_router, *w_exp_gate, *w_exp_up, *w_exp_down, *g_final;
    float* out; char* ws;
};
template <class T> __device__ __forceinline__ T* wsp(const Params& p, size_t off) { return (T*)(p.ws + off); }

#define LDS_HALF 65536
#define LDS_MAIN 131072
#define LDS_TOTAL (LDS_MAIN + 16)
#define LAS __attribute__((address_space(3)))

#define XB_TMO      128
#define XB_XCNT(j)  (256  + 64 * (j))
#define XB_XSUB(j)  (1280 + 64 * (j))
#define XB_XGEN(j)  (2304 + 64 * (j))
#define XB_TOP      3328
#define XB_TOPGEN   3392
#define XCD_BAR_WORDS 3456
#define XB_SPIN_CAP (1u << 25)
__device__ __forceinline__ unsigned xb_ld(unsigned* p)              { return __hip_atomic_load(p, __ATOMIC_RELAXED, __HIP_MEMORY_SCOPE_AGENT); }
__device__ __forceinline__ unsigned xb_add(unsigned* p, unsigned v) { return __hip_atomic_fetch_add(p, v, __ATOMIC_RELAXED, __HIP_MEMORY_SCOPE_AGENT); }
__device__ __forceinline__ unsigned xb_xcc_id() { return (unsigned)__builtin_amdgcn_s_getreg((3 << 11) | 20) & 0xFu; }
#define XB_SPIN(cond, bar) do { unsigned _sp = 0; while (cond) { __builtin_amdgcn_s_sleep(1); \
    if ((++_sp & 255u) == 0u) { if (xb_ld(&(bar)[XB_TMO])) break; if (_sp > XB_SPIN_CAP) { atomicAdd(&(bar)[XB_TMO], 1u); break; } } } } while (0)
struct XcdBarrier { unsigned* bar; unsigned x; volatile LAS unsigned* st; };
__device__ __forceinline__ XcdBarrier xcd_barrier_post(unsigned* bar, volatile LAS unsigned* st) {
    XcdBarrier b; b.bar = bar; b.x = xb_xcc_id(); b.st = st;
    if (threadIdx.x == 0) (void)xb_add(&bar[XB_XCNT(b.x)], 1u);
    return b;
}
__device__ __forceinline__ void xcd_barrier_complete(unsigned* bar, unsigned x, unsigned& nloc, unsigned& nx) {
    const unsigned G = gridDim.x * gridDim.y * gridDim.z;
    unsigned sum, cnt, mine, sp = 0u;
    for (;;) {
        sum = 0u; cnt = 0u; mine = 0u;
#pragma unroll
        for (unsigned j = 0; j < 16; ++j) { const unsigned c = xb_ld(&bar[XB_XCNT(j)]); sum += c; cnt += (c > 0u) ? 1u : 0u; mine = (j == x) ? c : mine; }
        if (sum == G) break;
        __builtin_amdgcn_s_sleep(1);
        if ((++sp & 255u) == 0u) { if (xb_ld(&bar[XB_TMO])) break; if (sp > XB_SPIN_CAP) { atomicAdd(&bar[XB_TMO], 1u); break; } }
    }
    nloc = mine > 0u ? mine : 1u; nx = cnt > 0u ? cnt : 1u;
}
__device__ __forceinline__ void xcd_barrier(const XcdBarrier& b) {
    asm volatile("s_waitcnt vmcnt(0)" ::: "memory");
    __syncthreads();
    if (threadIdx.x == 0) {
        unsigned* bar = b.bar;
        __builtin_amdgcn_s_waitcnt(0);
        unsigned nloc = b.st[0], nx = b.st[1];
        if (nloc == 0u) { xcd_barrier_complete(bar, b.x, nloc, nx); b.st[0] = nloc; b.st[1] = nx; }
        const unsigned old = xb_add(&bar[XB_XSUB(b.x)], 1u);
        const unsigned gen = old / nloc;
        if (old + 1u == (gen + 1u) * nloc) {
            __builtin_amdgcn_fence(__ATOMIC_RELEASE, "agent");
            asm volatile("s_waitcnt vmcnt(0)" ::: "memory");
            const unsigned og = xb_add(&bar[XB_TOP], 1u);
            const unsigned tg = og / nx;
            if (og + 1u == (tg + 1u) * nx) xb_add(&bar[XB_TOPGEN], 1u);
            else XB_SPIN(xb_ld(&bar[XB_TOPGEN]) == tg, bar);
            __builtin_amdgcn_fence(__ATOMIC_ACQUIRE, "agent");
            xb_add(&bar[XB_XGEN(b.x)], 1u);
            asm volatile("s_waitcnt vmcnt(0)" ::: "memory");
        } else {
            XB_SPIN(xb_ld(&bar[XB_XGEN(b.x)]) == gen, bar);
            __builtin_amdgcn_fence(__ATOMIC_ACQUIRE, "agent");
            asm volatile("s_waitcnt vmcnt(0)" ::: "memory");
        }
    }
    __syncthreads();
}

#define FOR_XCD_ITEMS(item, N) for (int _L = (int)((blockIdx.x >> 3) << 1) | VHALF, item; _L < (N) / 8 && ((item = (int)(blockIdx.x & 7) * ((N) / 8) + _L), true); _L += (int)(gridDim.x >> 2))

__device__ __forceinline__ u32x2 pack4bf(float a, float b, float c, float d) { return (u32x2){pack2bf(a, b), pack2bf(c, d)}; }
__device__ __forceinline__ u32x2 pack4bf(f32x4 v) { return (u32x2){pack2bf(v[0], v[1]), pack2bf(v[2], v[3])}; }
__device__ __forceinline__ float wave_sum(float v) {
#pragma unroll
    for (int o = 32; o > 0; o >>= 1) v += __shfl_xor(v, o);
    return v;
}

__device__ __forceinline__ void tr_tile(const float* W, long ldw, int k0, int n0, int nvalid, const float* gain, bf16_t* Wt, long ldt, int mode, char* lds) {
    float (*t)[132] = (float (*)[132])lds;
    const int tid = VTID, c4 = tid & 31, r0 = tid >> 5;
    f32x4 v[8];
#pragma unroll
    for (int i = 0; i < 8; i++) {
        const int kk = r0 + 8 * i, n = n0 + c4 * 4;
        v[i] = (n < nvalid) ? *(const f32x4*)(W + (long)(k0 + kk) * ldw + n) : (f32x4){0.f, 0.f, 0.f, 0.f};
        if (gain) v[i] *= gain[k0 + kk];
    }
    __syncthreads();
#pragma unroll
    for (int i = 0; i < 8; i++) *(f32x4*)(&t[r0 + 8 * i][c4 * 4]) = v[i];
    __syncthreads();
#pragma unroll
    for (int i = 0; i < 4; i++) {
        const int ci = tid + 256 * i, nn = ci >> 3, kc = ci & 7;
        const int n = n0 + nn;
        int row = n;
        if (mode) row = (n >> 5) * 64 + ((n >> 4) & 1) * 32 + (mode - 1) * 16 + (n & 15);
        u32x4 w;
        w.x = pack2bf(t[kc * 8 + 0][nn], t[kc * 8 + 1][nn]);
        w.y = pack2bf(t[kc * 8 + 2][nn], t[kc * 8 + 3][nn]);
        w.z = pack2bf(t[kc * 8 + 4][nn], t[kc * 8 + 5][nn]);
        w.w = pack2bf(t[kc * 8 + 6][nn], t[kc * 8 + 7][nn]);
        *(u32x4*)(Wt + (long)row * ldt + k0 + kc * 8) = w;
    }
}

__device__ __forceinline__ void phase0(const Params& p, char* lds) {
    constexpr int J_W1 = 160, J_WQ = 36, J_WKV = 32, J_WOUT = 128, J_WMQ = 128, J_WMKV = 256, J_WMO = 128, J_WG = 0, J_WU = 0, J_WD = 0;
    constexpr int J_TR = J_W1 + J_WQ + J_WKV + J_WOUT + J_WMQ + J_WMKV + J_WMO + J_WG + J_WU + J_WD;
    constexpr int J_XR = NT / 16, J_MR = 1024 / 16, J_ROPE = NT * 16 / 256, J_TAB = (4096 + 8192 + 16384 + 8192 + 32768) / 256;
    constexpr int J_ALL = J_TR + J_XR + J_MR + J_ROPE + J_TAB;
    const int tid = VTID, lane = tid & 63, wid = tid >> 6;
    const double PI2 = 6.283185307179586476925286766559;
    for (int job = VBLK; job < J_ALL; job += VGRID) {
        int j = job;
        if (j < J_TR) {
            if (j < J_W1) { tr_tile(p.w_in, INW, (j / 10) * 64, (j % 10) * 128, INW, p.g_mix, wsp<bf16_t>(p, OFF_W1T), 1024, 0, lds); continue; } j -= J_W1;
            if (j < J_WQ) { tr_tile(p.w_q_up, 768, (j / 6) * 64, (j % 6) * 128, 768, p.g_q_lat, wsp<bf16_t>(p, OFF_WQT), 384, 0, lds); continue; } j -= J_WQ;
            if (j < J_WKV) { tr_tile(p.w_kv_up, 1024, (j / 8) * 64, (j % 8) * 128, 1024, p.g_kv_lat, wsp<bf16_t>(p, OFF_WKVT), 256, 0, lds); continue; } j -= J_WKV;
            if (j < J_WOUT) { tr_tile(p.w_out, 1024, (j / 8) * 64, (j % 8) * 128, 1024, nullptr, wsp<bf16_t>(p, OFF_WOUTT), 1024, 0, lds); continue; } j -= J_WOUT;
            if (j < J_WMQ) { tr_tile(p.w_mem_q, 1024, (j / 8) * 64, (j % 8) * 128, 1024, p.g_mem_q, wsp<bf16_t>(p, OFF_WMQT), 1024, 0, lds); continue; } j -= J_WMQ;
            if (j < J_WMKV) { tr_tile(p.w_mem_kv, 2048, (j / 16) * 64, (j % 16) * 128, 2048, p.g_mem_kv, wsp<bf16_t>(p, OFF_WMKVT), 1024, 0, lds); continue; } j -= J_WMKV;
            if (j < J_WMO) { tr_tile(p.w_mem_o, 1024, (j / 8) * 64, (j % 8) * 128, 1024, nullptr, wsp<bf16_t>(p, OFF_WMOT), 1024, 0, lds); continue; } j -= J_WMO;
            if (j < J_WG) { const int e = j >> 7, r = j & 127; tr_tile(p.w_exp_gate + (long)e * 1048576, 1024, (r / 8) * 64, (r % 8) * 128, 1024, p.g_ffn, wsp<bf16_t>(p, OFF_WGUT) + (long)e * 2048 * 1024, 1024, 1, lds); continue; } j -= J_WG;
            if (j < J_WU) { const int e = j >> 7, r = j & 127; tr_tile(p.w_exp_up + (long)e * 1048576, 1024, (r / 8) * 64, (r % 8) * 128, 1024, p.g_ffn, wsp<bf16_t>(p, OFF_WGUT) + (long)e * 2048 * 1024, 1024, 2, lds); continue; } j -= J_WU;
            { const int e = j >> 7, r = j & 127; tr_tile(p.w_exp_down + (long)e * 1048576, 1024, (r / 8) * 64, (r % 8) * 128, 1024, nullptr, wsp<bf16_t>(p, OFF_WDT) + (long)e * 1048576, 1024, 0, lds); continue; }
        }
        j -= J_TR;
        if (j < J_XR + J_MR) {
            const bool isx = j < J_XR;
            const int row0 = (isx ? j : j - J_XR) * 16 + wid * 4;
            const float* src = (isx ? p.x : p.mem) + (long)row0 * ND;
            bf16_t* dst = (isx ? wsp<bf16_t>(p, OFF_XB) : wsp<bf16_t>(p, OFF_MEMB)) + (long)row0 * ND;
            f32x4 v[4][4];
#pragma unroll
            for (int r = 0; r < 4; r++)
#pragma unroll
                for (int i = 0; i < 4; i++) v[r][i] = *(const f32x4*)(src + (long)r * ND + i * 256 + lane * 4);
#pragma unroll
            for (int r = 0; r < 4; r++) {
                float ss = 0.f;
#pragma unroll
                for (int i = 0; i < 4; i++) {
                    ss += v[r][i][0] * v[r][i][0] + v[r][i][1] * v[r][i][1] + v[r][i][2] * v[r][i][2] + v[r][i][3] * v[r][i][3];
                    *(u32x2*)(dst + (long)r * ND + i * 256 + lane * 4) = pack4bf(v[r][i]);
                }
                ss = wave_sum(ss);
                if (lane == 0) (isx ? wsp<float>(p, OFF_R0) : wsp<float>(p, OFF_RMEM))[row0 + r] = rsqrtf(ss * (1.f / ND) + 1e-6f);
            }
            continue;
        }
        j -= J_XR + J_MR;
        if (j < J_ROPE) {
            const int i = j * 256 + tid; const int t = i >> 4, jj = i & 15;
            const double f = pow(10000.0, -(double)(2 * jj) / 32.0);
            const double ang = (double)p.pos[t] * f;
            wsp<float2>(p, OFF_ROPE)[i] = make_float2((float)cos(ang), (float)sin(ang));
            continue;
        }
        j -= J_ROPE;
        {
            int i = j * 256 + tid;
            if (i < 4096) { const double a = PI2 * (double)i / 4096.0; wsp<float2>(p, OFF_TW)[i] = make_float2((float)cos(a), (float)sin(a)); continue; } i -= 4096;
            if (i < 8192) {
                const int T = i >> 12, a = (i >> 6) & 63, b = i & 63;
                const double th = PI2 * (double)((a * b) & 63) / 64.0;
                wsp<bf16_t>(p, OFF_T64)[i] = (bf16_t)f2bf((float)(T ? sin(th) : cos(th))); continue;
            } i -= 8192;
            if (i < 16384) {
                const int rho = i >> 7, k = i & 127;
                const int wm = rho >> 6, mi = (rho >> 4) & 3, lr = rho & 15, ri = mi >> 1, k1 = 32 * wm + 16 * (mi & 1) + lr, ab = k >> 6, s1 = k & 63;
                const double th = PI2 * (double)((k1 * s1) & 63) / 64.0;
                const double c = cos(th), s = sin(th);
                const double v = ri == 0 ? (ab == 0 ? c : -s) : (ab == 0 ? s : c);
                wsp<bf16_t>(p, OFF_M1)[i] = (bf16_t)f2bf((float)v); continue;
            } i -= 16384;
            if (i < 8192) {
                const int k2 = i >> 7, k = i & 127, s2 = k & 63;
                const double th = PI2 * (double)((k2 * s2) & 63) / 64.0;
                wsp<bf16_t>(p, OFF_M3)[i] = (bf16_t)f2bf((float)(k < 64 ? cos(th) : -sin(th))); continue;
            } i -= 8192;
            if (i < 32768) {
                const int g = i >> 12, e = (i >> 6) & 63, ch = i & 63;
                wsp<bf16_t>(p, OFF_WFT)[i] = (bf16_t)f2bf(p.w_fourier[(g * 64 + ch) * 64 + e]); continue;
            }
        }
    }
}

#define FOR_XCD_ITEMS_R(item, N) for (int _L = (int)(blockIdx.x >> 3), item; _L < (N) / 8 && ((item = (int)(blockIdx.x & 7) * ((N) / 8) + _L), true); _L += (int)(gridDim.x >> 3))
__device__ __forceinline__ void gemm_tile_256sq(const GemmTile& g, char* lds, f32x4 (&acc)[8][4]) {
    const int tid = threadIdx.x, lane = tid & 63, wid = tid >> 6, wm = wid >> 2, wn = wid & 3;
    const int lrow = lane >> 3, pc = lane & 7;
    const bf16_t* ap[4]; const bf16_t* bp[4];
#pragma unroll
    for (int i = 0; i < 4; i++) {
        const int r = (wid * 4 + i) * 8 + lrow;
        const int c = pc ^ ((r >> 1) & 7);
        const long ro = g.arow ? (long)g.arow[r] * g.lda : (long)r * g.lda;
        ap[i] = g.A + ro + c * 8;
        bp[i] = g.Bt + (long)r * g.ldb + c * 8;
    }
#pragma unroll
    for (int mi = 0; mi < 8; mi++)
#pragma unroll
        for (int ni = 0; ni < 4; ni++) acc[mi][ni] = (f32x4){0.f, 0.f, 0.f, 0.f};
    const int nk = g.K >> 6;
    auto stage = [&](int kt, char* st) {
#pragma unroll
        for (int i = 0; i < 4; i++) {
            __builtin_amdgcn_global_load_lds((const unsigned*)(ap[i] + kt * 64), (unsigned*)(st + (wid * 4 + i) * 1024), 16, 0, 0);
            __builtin_amdgcn_global_load_lds((const unsigned*)(bp[i] + kt * 64), (unsigned*)(st + 32768 + (wid * 4 + i) * 1024), 16, 0, 0);
        }
    };
    __syncthreads();
    stage(0, lds);
    asm volatile("s_waitcnt vmcnt(0)" ::: "memory");
    __syncthreads();
    for (int kt = 0; kt < nk; kt++) {
        char* cur = lds + (kt & 1) * 65536;
        if (kt + 1 < nk) stage(kt + 1, lds + ((kt + 1) & 1) * 65536);
#pragma unroll
        for (int ks = 0; ks < 2; ks++) {
            bf16x8 af[8], bfr[4];
#pragma unroll
            for (int i = 0; i < 8; i++) af[i] = *(const bf16x8*)(cur + tile_off(wm * 128 + i * 16 + (lane & 15), ks * 4 + (lane >> 4)));
#pragma unroll
            for (int i = 0; i < 4; i++) bfr[i] = *(const bf16x8*)(cur + 32768 + tile_off(wn * 64 + i * 16 + (lane & 15), ks * 4 + (lane >> 4)));
            __builtin_amdgcn_s_setprio(1);
#pragma unroll
            for (int mi = 0; mi < 8; mi++)
#pragma unroll
                for (int ni = 0; ni < 4; ni++)
                    acc[mi][ni] = __builtin_amdgcn_mfma_f32_16x16x32_bf16(bfr[ni], af[mi], acc[mi][ni], 0, 0, 0);
            __builtin_amdgcn_s_setprio(0);
        }
        asm volatile("s_waitcnt vmcnt(0)" ::: "memory");
        __syncthreads();
    }
}


__device__ __forceinline__ void gemm_tile_256x128(const GemmTile& g, char* lds, f32x4 (&acc)[4][4]) {
    const int tid = threadIdx.x, lane = tid & 63, wid = tid >> 6, wm = wid >> 1, wn = wid & 1;
    const int lrow = lane >> 3, pc = lane & 7;
    const bf16_t* ap[4]; const bf16_t* bp[2];
#pragma unroll
    for (int i = 0; i < 4; i++) {
        const int r = (wid * 4 + i) * 8 + lrow;
        const int c = pc ^ ((r >> 1) & 7);
        const long ro = g.arow ? (long)g.arow[r] * g.lda : (long)r * g.lda;
        ap[i] = g.A + ro + c * 8;
    }
#pragma unroll
    for (int i = 0; i < 2; i++) {
        const int r = (wid * 2 + i) * 8 + lrow;
        const int c = pc ^ ((r >> 1) & 7);
        bp[i] = g.Bt + (long)r * g.ldb + c * 8;
    }
#pragma unroll
    for (int mi = 0; mi < 4; mi++)
#pragma unroll
        for (int ni = 0; ni < 4; ni++) acc[mi][ni] = (f32x4){0.f, 0.f, 0.f, 0.f};
    const int nk = g.K >> 6;
    auto stage = [&](int kt, char* st) {
#pragma unroll
        for (int i = 0; i < 4; i++)
            __builtin_amdgcn_global_load_lds((const unsigned*)(ap[i] + kt * 64), (unsigned*)(st + (wid * 4 + i) * 1024), 16, 0, 0);
#pragma unroll
        for (int i = 0; i < 2; i++)
            __builtin_amdgcn_global_load_lds((const unsigned*)(bp[i] + kt * 64), (unsigned*)(st + 32768 + (wid * 2 + i) * 1024), 16, 0, 0);
    };
    __syncthreads();
    stage(0, lds);
    asm volatile("s_waitcnt vmcnt(0)" ::: "memory");
    __syncthreads();
    for (int kt = 0; kt < nk; kt++) {
        char* cur = lds + (kt & 1) * 49152;
        if (kt + 1 < nk) stage(kt + 1, lds + ((kt + 1) & 1) * 49152);
        bf16x8 af[2][4], bfr[2][4];
#pragma unroll
        for (int ks = 0; ks < 2; ks++)
#pragma unroll
            for (int i = 0; i < 4; i++) {
                af[ks][i] = *(const bf16x8*)(cur + tile_off(wm * 64 + i * 16 + (lane & 15), ks * 4 + (lane >> 4)));
                bfr[ks][i] = *(const bf16x8*)(cur + 32768 + tile_off(wn * 64 + i * 16 + (lane & 15), ks * 4 + (lane >> 4)));
            }
        __builtin_amdgcn_s_setprio(1);
#pragma unroll
        for (int ks = 0; ks < 2; ks++)
#pragma unroll
            for (int mi = 0; mi < 4; mi++)
#pragma unroll
                for (int ni = 0; ni < 4; ni++)
                    acc[mi][ni] = __builtin_amdgcn_mfma_f32_16x16x32_bf16(bfr[ks][ni], af[ks][mi], acc[mi][ni], 0, 0, 0);
        __builtin_amdgcn_s_setprio(0);
        asm volatile("s_waitcnt vmcnt(0)" ::: "memory");
        __syncthreads();
    }
}


__device__ __forceinline__ void phase1(const Params& p, char* lds) {
    const int tid = threadIdx.x, lane = tid & 63, wid = tid >> 6, wm = wid >> 1, wn = wid & 1, lq = lane >> 4, lr = lane & 15;
    constexpr int N_U = 64 * 2, N_M = 4 * 16;
    {
      FOR_XCD_ITEMS_R(item, N_U) {
        f32x4 acc[4][4];
        {
            const int tm = item >> 1, tn = 8 + (item & 1);
            GemmTile g; g.A = wsp<bf16_t>(p, OFF_XB) + (long)tm * 256 * ND; g.lda = ND; g.arow = nullptr;
            g.Bt = wsp<bf16_t>(p, OFF_W1T) + (long)tn * 128 * ND; g.ldb = ND; g.K = ND;
            gemm_tile_256x128(g, lds, acc);
            const float* r0 = wsp<float>(p, OFF_R0);
#pragma unroll
            for (int mi = 0; mi < 4; mi++) {
                const int row = tm * 256 + wm * 64 + mi * 16 + lr;
                const float rs = r0[row];
#pragma unroll
                for (int ni = 0; ni < 4; ni++) acc[mi][ni] *= rs;
                if (tn < 4) {
#pragma unroll
                    for (int ni = 0; ni < 4; ni++)
                        *(u32x2*)(wsp<bf16_t>(p, OFF_UF) + (long)row * 512 + tn * 128 + wn * 64 + ni * 16 + 4 * lq) = pack4bf(acc[mi][ni]);
                } else if (tn < 9) {
                    float ss = 0.f;
#pragma unroll
                    for (int ni = 0; ni < 4; ni++) { const f32x4 v = acc[mi][ni]; ss += v[0] * v[0] + v[1] * v[1] + v[2] * v[2] + v[3] * v[3]; }
                    ss += __shfl_xor(ss, 16); ss += __shfl_xor(ss, 32);
                    if (tn < 7) {
#pragma unroll
                        for (int ni = 0; ni < 4; ni++)
                            *(u32x2*)(wsp<bf16_t>(p, OFF_UQ) + (long)row * 384 + (tn - 4) * 128 + wn * 64 + ni * 16 + 4 * lq) = pack4bf(acc[mi][ni]);
                        if (lq == 0) wsp<float>(p, OFF_SSQ)[row * 6 + (tn - 4) * 2 + wn] = ss;
                    } else {
#pragma unroll
                        for (int ni = 0; ni < 4; ni++)
                            *(u32x2*)(wsp<bf16_t>(p, OFF_UKV) + (long)row * 256 + (tn - 7) * 128 + wn * 64 + ni * 16 + 4 * lq) = pack4bf(acc[mi][ni]);
                        if (lq == 0) wsp<float>(p, OFF_SSKV)[row * 4 + (tn - 7) * 2 + wn] = ss;
                    }
                } else if (wn == 0) {
                    const float2* rp = wsp<float2>(p, OFF_ROPE) + (long)row * 16 + 4 * lq;
                    f32x4 o1, o2;
#pragma unroll
                    for (int r = 0; r < 4; r++) {
                        const float2 cs = rp[r];
                        const float x1 = acc[mi][0][r], x2 = acc[mi][1][r];
                        o1[r] = x1 * cs.x - x2 * cs.y; o2[r] = x1 * cs.y + x2 * cs.x;
                    }
                    bf16_t* kr = wsp<bf16_t>(p, OFF_KR) + (long)row * 32;
                    *(u32x2*)(kr + 4 * lq) = pack4bf(o1);
                    *(u32x2*)(kr + 16 + 4 * lq) = pack4bf(o2);
                }
            }
        }
      }
      FOR_XCD_ITEMS_R(it, N_M) {
        f32x4 acc[4][4];
        {
            const int tm = it / 16, tn = it % 16;
            GemmTile g; g.A = wsp<bf16_t>(p, OFF_MEMB) + (long)tm * 256 * ND; g.lda = ND; g.arow = nullptr;
            g.Bt = wsp<bf16_t>(p, OFF_WMKVT) + (long)tn * 128 * ND; g.ldb = ND; g.K = ND;
            gemm_tile_256x128(g, lds, acc);
            const float* rm = wsp<float>(p, OFF_RMEM);
#pragma unroll
            for (int mi = 0; mi < 4; mi++) {
                const int row = tm * 256 + wm * 64 + mi * 16 + lr;
                const int b = row >> 8, m = row & 255;
                const float rs = rm[row];
#pragma unroll
                for (int ni = 0; ni < 4; ni++) {
                    const f32x4 v = acc[mi][ni] * rs;
                    const int col = tn * 128 + wn * 64 + ni * 16 + 4 * lq;
                    if (col < 1024) {
                        const int h = col >> 8, d = col & 255;
                        *(u32x2*)(wsp<bf16_t>(p, OFF_KMEM) + ((long)(b * 4 + h) * 256 + m) * 256 + d) = pack4bf(v);
                    } else {
                        const int c2 = col - 1024, h = c2 >> 8, dv = c2 & 255;
                        bf16_t* vt = wsp<bf16_t>(p, OFF_VTMEM) + ((long)(b * 4 + h) * 256 + dv) * 256 + m;
#pragma unroll
                        for (int r = 0; r < 4; r++) vt[r * 256] = (bf16_t)f2bf(v[r]);
                    }
                }
            }
        }
      }
    }
}

template <int MI>
__device__ __forceinline__ void dft_mma(const bf16_t* Ag, int arow0, const char* ximg, int ncol0, f32x4 (&acc)[MI][4]) {
    const int lane = VTID & 63, lq = lane >> 4, lr = lane & 15;
#pragma unroll
    for (int ks = 0; ks < 4; ks++) {
        bf16x8 af[MI], bfr[4];
#pragma unroll
        for (int mi = 0; mi < MI; mi++) af[mi] = *(const bf16x8*)(Ag + (long)(arow0 + mi * 16 + lr) * 128 + ks * 32 + lq * 8);
#pragma unroll
        for (int ni = 0; ni < 4; ni++) {
            const char* bp = ximg + (ks * 32 + lq * 8) * 272 + (ncol0 + ni * 16 + lr) * 2;
#pragma unroll
            for (int j = 0; j < 8; j++) bfr[ni][j] = *(const short*)(bp + j * 272);
        }
#pragma unroll
        for (int mi = 0; mi < MI; mi++)
#pragma unroll
            for (int ni = 0; ni < 4; ni++) acc[mi][ni] = __builtin_amdgcn_mfma_f32_16x16x32_bf16(bfr[ni], af[mi], acc[mi][ni], 0, 0, 0);
    }
}

__device__ __forceinline__ void f2a_item(const Params& p, int it, char* lds) {
    const int tid = VTID, lane = tid & 63, wid = tid >> 6, wm = wid >> 1, wn = wid & 1, lq = lane >> 4, lr = lane & 15;
    const int nc = it & 3, s2 = (it >> 2) & 63, b = it >> 8;
    char* uimg = lds; char* ximg = lds + 17408;
    __syncthreads();
#pragma unroll
    for (int i = 0; i < 4; i++) {
        const int ci = tid + 256 * i, row = ci >> 4, cc = ci & 15;
        *(u32x4*)(uimg + row * 272 + cc * 16) = *(const u32x4*)(wsp<bf16_t>(p, OFF_UF) + ((long)(b * NS + 64 * row + s2)) * 512 + nc * 128 + cc * 8);
    }
    __syncthreads();
    {
        const int g2 = wid >> 1, T = wid & 1;
        f32x4 a1[4][4];
#pragma unroll
        for (int mi = 0; mi < 4; mi++)
#pragma unroll
            for (int ni = 0; ni < 4; ni++) a1[mi][ni] = (f32x4){0.f, 0.f, 0.f, 0.f};
        const bf16_t* t64 = wsp<bf16_t>(p, OFF_T64) + T * 4096;
#pragma unroll
        for (int ks = 0; ks < 2; ks++) {
            bf16x8 af[4], bfr[4];
#pragma unroll
            for (int i = 0; i < 4; i++) {
                af[i] = *(const bf16x8*)(uimg + (i * 16 + lr) * 272 + (g2 * 64 + ks * 32 + lq * 8) * 2);
                bfr[i] = *(const bf16x8*)(t64 + (i * 16 + lr) * 64 + ks * 32 + lq * 8);
            }
#pragma unroll
            for (int mi = 0; mi < 4; mi++)
#pragma unroll
                for (int ni = 0; ni < 4; ni++) a1[mi][ni] = __builtin_amdgcn_mfma_f32_16x16x32_bf16(bfr[ni], af[mi], a1[mi][ni], 0, 0, 0);
        }
#pragma unroll
        for (int mi = 0; mi < 4; mi++)
#pragma unroll
            for (int ni = 0; ni < 4; ni++)
                *(u32x2*)(ximg + (T * 64 + mi * 16 + lr) * 272 + (g2 * 64 + ni * 16 + 4 * lq) * 2) = pack4bf(a1[mi][ni]);
    }
    __syncthreads();
    f32x4 acc[4][4];
#pragma unroll
    for (int mi = 0; mi < 4; mi++)
#pragma unroll
        for (int ni = 0; ni < 4; ni++) acc[mi][ni] = (f32x4){0.f, 0.f, 0.f, 0.f};
    dft_mma<4>(wsp<bf16_t>(p, OFF_M1), wm * 64, ximg, wn * 64, acc);
    const float2* tw = wsp<float2>(p, OFF_TW);
#pragma unroll
    for (int m2 = 0; m2 < 2; m2++) {
        const int k1 = 32 * wm + 16 * m2 + lr;
        float2 cs; { const float rev = (float)((s2 * k1) & 4095) * (1.0f / 4096.0f); cs.x = __builtin_amdgcn_cosf(rev); cs.y = __builtin_amdgcn_sinf(rev); (void)tw; }
        const long base = ((long)(b * 64 + k1) * 64 + s2) * 512 + nc * 128 + wn * 64 + 4 * lq;
#pragma unroll
        for (int ni = 0; ni < 4; ni++) {
            const f32x4 yr = acc[m2][ni], yi = acc[m2 + 2][ni];
            const f32x4 orr = yr * cs.x - yi * cs.y, oi = yi * cs.x + yr * cs.y;
            *(u32x2*)(wsp<bf16_t>(p, OFF_YR) + base + ni * 16) = pack4bf(orr);
            *(u32x2*)(wsp<bf16_t>(p, OFF_YI) + base + ni * 16) = pack4bf(oi);
        }
    }
}

__device__ __forceinline__ void f2b_item(const Params& p, int it, char* lds) {
    const int tid = VTID, lane = tid & 63, wid = tid >> 6, wm = wid >> 1, wn = wid & 1, lq = lane >> 4, lr = lane & 15;
    const int nc = it & 3, k1 = (it >> 2) & 63, b = it >> 8;
    char* ximg = lds; char* zimg = lds + 34816;
    __syncthreads();
#pragma unroll
    for (int i = 0; i < 8; i++) {
        const int ci = tid + 256 * i, row = ci >> 4, cc = ci & 15;
        const bf16_t* src = (row < 64 ? wsp<bf16_t>(p, OFF_YR) : wsp<bf16_t>(p, OFF_YI)) + ((long)(b * 64 + k1) * 64 + (row & 63)) * 512 + nc * 128 + cc * 8;
        *(u32x4*)(ximg + row * 272 + cc * 16) = *(const u32x4*)src;
    }
    __syncthreads();
    f32x4 acc[2][4];
#pragma unroll
    for (int mi = 0; mi < 2; mi++)
#pragma unroll
        for (int ni = 0; ni < 4; ni++) acc[mi][ni] = (f32x4){0.f, 0.f, 0.f, 0.f};
    dft_mma<2>(wsp<bf16_t>(p, OFF_M3), wm * 32, ximg, wn * 64, acc);
#pragma unroll
    for (int mi = 0; mi < 2; mi++)
#pragma unroll
        for (int ni = 0; ni < 4; ni++)
            *(u32x2*)(zimg + (wm * 32 + mi * 16 + lr) * 272 + (wn * 64 + ni * 16 + 4 * lq) * 2) = pack4bf(acc[mi][ni] * (1.0f / 512.0f));
    __syncthreads();
    f32x4 a3[2][4];
#pragma unroll
    for (int mi = 0; mi < 2; mi++)
#pragma unroll
        for (int ni = 0; ni < 4; ni++) a3[mi][ni] = (f32x4){0.f, 0.f, 0.f, 0.f};
    const bf16_t* wft = wsp<bf16_t>(p, OFF_WFT) + (long)(nc * 2 + wn) * 4096;
#pragma unroll
    for (int ks = 0; ks < 2; ks++) {
        bf16x8 af[2], bfr[4];
#pragma unroll
        for (int i = 0; i < 2; i++) af[i] = *(const bf16x8*)(zimg + (wm * 32 + i * 16 + lr) * 272 + (wn * 64 + ks * 32 + lq * 8) * 2);
#pragma unroll
        for (int i = 0; i < 4; i++) bfr[i] = *(const bf16x8*)(wft + (i * 16 + lr) * 64 + ks * 32 + lq * 8);
#pragma unroll
        for (int mi = 0; mi < 2; mi++)
#pragma unroll
            for (int ni = 0; ni < 4; ni++) a3[mi][ni] = __builtin_amdgcn_mfma_f32_16x16x32_bf16(bfr[ni], af[mi], a3[mi][ni], 0, 0, 0);
    }
#pragma unroll
    for (int mi = 0; mi < 2; mi++) {
        const int k2 = wm * 32 + mi * 16 + lr;
        bf16_t* dst = wsp<bf16_t>(p, OFF_ZA) + ((long)(b * NS + k1 + 64 * k2)) * 1024 + nc * 128 + wn * 64 + 4 * lq;
#pragma unroll
        for (int ni = 0; ni < 4; ni++) *(u32x2*)(dst + ni * 16) = pack4bf(a3[mi][ni]);
    }
}

__device__ __forceinline__ void phase2(const Params& p, char* lds) {
    const int tid = threadIdx.x, lane = tid & 63, wid = tid >> 6, wm = wid >> 1, wn = wid & 1, lq = lane >> 4, lr = lane & 15;
    constexpr int N_Q = 64 * 6, N_KV = 64 * 8;
    {
      FOR_XCD_ITEMS_R(item, N_Q) {
        f32x4 acc[4][4];
        {
            const int tm = item / 6, tn = item % 6;
            GemmTile g; g.A = wsp<bf16_t>(p, OFF_UQ) + (long)tm * 256 * 384; g.lda = 384; g.arow = nullptr;
            g.Bt = wsp<bf16_t>(p, OFF_WQT) + (long)tn * 128 * 384; g.ldb = 384; g.K = 384;
            gemm_tile_256x128(g, lds, acc);
            const float qmul = 0.10206207261596575f * 1.4426950408889634f;
#pragma unroll
            for (int mi = 0; mi < 4; mi++) {
                const int row = tm * 256 + wm * 64 + mi * 16 + lr;
                const int b = row >> 12, s = row & 4095;
                const float* sq = wsp<float>(p, OFF_SSQ) + (long)row * 6;
                const float ss = sq[0] + sq[1] + sq[2] + sq[3] + sq[4] + sq[5];
                const float rs = rsqrtf(ss * (1.f / 384.f) + 1e-6f) * qmul;
                const int cb0 = tn * 128 + wn * 64;
#pragma unroll
                for (int ni = 0; ni < 4; ni++) {
                    const int cb = cb0 + ni * 16, hd = cb / 96, hob = cb % 96;
                    bf16_t* qd = wsp<bf16_t>(p, OFF_Q) + ((long)(b * 8 + hd) * NS + s) * 96;
                    if (hob < 64) {
                        *(u32x2*)(qd + hob + 4 * lq) = pack4bf(acc[mi][ni] * rs);
                    } else if (hob == 64) {
                        if (ni < 3) {
                            const float2* rp = wsp<float2>(p, OFF_ROPE) + (long)row * 16 + 4 * lq;
                            f32x4 o1, o2;
#pragma unroll
                            for (int r = 0; r < 4; r++) {
                                const float2 cs = rp[r];
                                const float x1 = acc[mi][ni][r] * rs, x2 = acc[mi][ni < 3 ? ni + 1 : 3][r] * rs;
                                o1[r] = x1 * cs.x - x2 * cs.y; o2[r] = x1 * cs.y + x2 * cs.x;
                            }
                            *(u32x2*)(qd + 64 + 4 * lq) = pack4bf(o1);
                            *(u32x2*)(qd + 80 + 4 * lq) = pack4bf(o2);
                        }
                    }
                }
            }
        }
      }
      FOR_XCD_ITEMS_R(it, N_KV) {
        f32x4 acc[4][4];
        {
            const int tm = it >> 3, hd = it & 7;
            GemmTile g; g.A = wsp<bf16_t>(p, OFF_UKV) + (long)tm * 256 * 256; g.lda = 256; g.arow = nullptr;
            g.Bt = wsp<bf16_t>(p, OFF_WKVT) + (long)hd * 128 * 256; g.ldb = 256; g.K = 256;
            gemm_tile_256x128(g, lds, acc);
#pragma unroll
            for (int mi = 0; mi < 4; mi++) {
                const int row = tm * 256 + wm * 64 + mi * 16 + lr;
                const int b = row >> 12, s = row & 4095;
                const float* sq = wsp<float>(p, OFF_SSKV) + (long)row * 4;
                const float rs = rsqrtf((sq[0] + sq[1] + sq[2] + sq[3]) * (1.f / 256.f) + 1e-6f);
                if (wn == 0) {
                    bf16_t* kd = wsp<bf16_t>(p, OFF_K) + ((long)(b * 8 + hd) * NS + s) * 96;
#pragma unroll
                    for (int ni = 0; ni < 4; ni++) *(u32x2*)(kd + ni * 16 + 4 * lq) = pack4bf(acc[mi][ni] * rs);
                } else {
#pragma unroll
                    for (int ni = 0; ni < 4; ni++) {
                        bf16_t* vd = wsp<bf16_t>(p, OFF_VT) + ((long)(b * 8 + hd) * 64 + ni * 16 + 4 * lq) * NS + s;
#pragma unroll
                        for (int r = 0; r < 4; r++) vd[(long)r * NS] = (bf16_t)f2bf(acc[mi][ni][r] * rs);
                    }
                }
            }
#pragma unroll
            for (int i = 0; i < 2; i++) {
                const int ci = tid + 512 * i, r = ci >> 2, cc = ci & 3;
                const int row = tm * 256 + r, b = row >> 12, s = row & 4095;
                *(u32x4*)(wsp<bf16_t>(p, OFF_K) + ((long)(b * 8 + hd) * NS + s) * 96 + 64 + cc * 8) = *(const u32x4*)(wsp<bf16_t>(p, OFF_KR) + (long)row * 32 + cc * 8);
            }
        }
      }
    }
}


__device__ __forceinline__ void phase2_f2a(const Params& p, char* lds) {
    FOR_XCD_ITEMS(it, 1024) { f2a_item(p, it, lds); }
}

__device__ __forceinline__ void expert_tr_job(const Params& p, int j, char* lds) {
    const int which = j >> 11, r = j & 2047, e = r >> 7, t = r & 127;
    const int k0 = (t >> 3) * 64, n0 = (t & 7) * 128;
    if (which == 0) tr_tile(p.w_exp_gate + (long)e * 1048576, 1024, k0, n0, 1024, p.g_ffn, wsp<bf16_t>(p, OFF_WGUT) + (long)e * 2048 * 1024, 1024, 1, lds);
    else if (which == 1) tr_tile(p.w_exp_up + (long)e * 1048576, 1024, k0, n0, 1024, p.g_ffn, wsp<bf16_t>(p, OFF_WGUT) + (long)e * 2048 * 1024, 1024, 2, lds);
    else tr_tile(p.w_exp_down + (long)e * 1048576, 1024, k0, n0, 1024, nullptr, wsp<bf16_t>(p, OFF_WDT) + (long)e * 1048576, 1024, 0, lds);
}

__device__ __forceinline__ void phase3_tr(const Params& p, char* lds) {
    for (int j = VBLK; j < 6144; j += VGRID) expert_tr_job(p, j, lds);
}
__device__ __forceinline__ void phase3_f2b(const Params& p, char* lds) {
    FOR_XCD_ITEMS(it, 1024) { f2b_item(p, it, lds); }
}

__device__ __forceinline__ void phase_resid(const Params& p, char* lds, size_t offA, size_t offW, const float* residf, const bf16_t* residb, size_t offXb, size_t offSS) {
    const int tid = VTID, lane = tid & 63, wid = tid >> 6, wm = wid >> 1, wn = wid & 1, lq = lane >> 4, lr = lane & 15;
    FOR_XCD_ITEMS(item, 128 * 8) {
        const int tm = item >> 3, tn = item & 7;
        f32x4 acc[4][4];
        GemmTile g; g.A = wsp<bf16_t>(p, offA) + (long)tm * 128 * ND; g.lda = ND; g.arow = nullptr;
        g.Bt = wsp<bf16_t>(p, offW) + (long)tn * 128 * ND; g.ldb = ND; g.K = ND;
        gemm_tile_128(g, lds, acc);
#pragma unroll
        for (int mi = 0; mi < 4; mi++) {
            const int row = tm * 128 + wm * 64 + mi * 16 + lr;
            float ss = 0.f;
#pragma unroll
            for (int ni = 0; ni < 4; ni++) {
                const long o = (long)row * ND + tn * 128 + wn * 64 + ni * 16 + 4 * lq;
                f32x4 rv;
                if (residf) rv = *(const f32x4*)(residf + o);
                else { const u32x2 w = *(const u32x2*)(residb + o); rv = (f32x4){__uint_as_float(w.x << 16), __uint_as_float(w.x & 0xFFFF0000u), __uint_as_float(w.y << 16), __uint_as_float(w.y & 0xFFFF0000u)}; }
                const f32x4 v = rv + acc[mi][ni];
                *(u32x2*)(wsp<bf16_t>(p, offXb) + o) = pack4bf(v);
                ss += v[0] * v[0] + v[1] * v[1] + v[2] * v[2] + v[3] * v[3];
            }
            ss += __shfl_xor(ss, 16); ss += __shfl_xor(ss, 32);
            if (lq == 0) wsp<float>(p, offSS)[row * 16 + tn * 2 + wn] = ss;
        }
    }
}
__device__ __forceinline__ float row_rs16(const float* ss) {
    const f32x4 a = *(const f32x4*)ss, b = *(const f32x4*)(ss + 4), c = *(const f32x4*)(ss + 8), d = *(const f32x4*)(ss + 12);
    const f32x4 t = (a + b) + (c + d);
    return rsqrtf(((t[0] + t[1]) + (t[2] + t[3])) * (1.f / 1024.f) + 1e-6f);
}

__device__ __forceinline__ void phase5a(const Params& p, char* lds) {
    const int tid = VTID, lane = tid & 63, wid = tid >> 6, wm = wid >> 1, wn = wid & 1, lq = lane >> 4, lr = lane & 15;
    FOR_XCD_ITEMS(item, 128 * 8) {
        const int tm = item >> 3, tn = item & 7;
        f32x4 acc[4][4];
        GemmTile g; g.A = wsp<bf16_t>(p, OFF_X1B) + (long)tm * 128 * ND; g.lda = ND; g.arow = nullptr;
        g.Bt = wsp<bf16_t>(p, OFF_WMQT) + (long)tn * 128 * ND; g.ldb = ND; g.K = ND;
        gemm_tile_128(g, lds, acc);
        const int h = tn >> 1;
#pragma unroll
        for (int mi = 0; mi < 4; mi++) {
            const int row = tm * 128 + wm * 64 + mi * 16 + lr, b = row >> 12, s = row & 4095;
            const float rs = row_rs16(wsp<float>(p, OFF_SS1) + (long)row * 16) * (0.0625f * 1.4426950408889634f);
            bf16_t* qd = wsp<bf16_t>(p, OFF_QM) + ((long)(b * 4 + h) * NS + s) * 256 + (tn & 1) * 128 + wn * 64 + 4 * lq;
#pragma unroll
            for (int ni = 0; ni < 4; ni++) *(u32x2*)(qd + ni * 16) = pack4bf(acc[mi][ni] * rs);
        }
    }
}
__device__ __forceinline__ void phase5b(const Params& p, char* lds) {
    FOR_XCD_ITEMS(item, NB * 4 * 32 * 2) {
        const int dvh = item & 1, qt = (item >> 1) & 31, h = (item >> 6) & 3, b = item >> 8;
        const bf16_t* Qp = wsp<bf16_t>(p, OFF_QM) + ((long)(b * 4 + h) * NS + qt * 128) * 256;
        const bf16_t* Kp = wsp<bf16_t>(p, OFF_KMEM) + ((long)(b * 4 + h) * 256) * 256;
        const bf16_t* Vtp = wsp<bf16_t>(p, OFF_VTMEM) + ((long)(b * 4 + h) * 256 + dvh * 128) * 256;
        bf16_t* Op = wsp<bf16_t>(p, OFF_OM) + ((long)b * NS + qt * 128) * 1024 + h * 256 + dvh * 128;
        attn_block<256, 128, 32, 256>(Qp, Kp, Vtp, 256L, 256, lds, [&](int q, int dv, f32x4 v) { *(u32x2*)(Op + (long)q * 1024 + dv) = pack4bf(v); });
    }
}

__device__ __forceinline__ void phase7(const Params& p, char* lds) {
    const int tid = VTID, lane = tid & 63, wid = tid >> 6;
    float* wr = (float*)lds;
    __syncthreads();
    {
        f32x4 wv[16];
#pragma unroll
        for (int it = 0; it < 16; it++) wv[it] = *(const f32x4*)(p.w_router + (size_t)(tid + 256 * it) * 4);
#pragma unroll
        for (int it = 0; it < 16; it++) {
            const int i4 = tid + 256 * it, k = i4 >> 2, e0 = (i4 & 3) * 4;
            const float gk = p.g_ffn[k];
            wr[(e0 + 0) * 1024 + k] = wv[it][0] * gk; wr[(e0 + 1) * 1024 + k] = wv[it][1] * gk;
            wr[(e0 + 2) * 1024 + k] = wv[it][2] * gk; wr[(e0 + 3) * 1024 + k] = wv[it][3] * gk;
        }
    }
    __syncthreads();
    for (int tok = VBLK * 4 + wid; tok < NT; tok += VGRID * 4) {
        const bf16_t* xr = wsp<bf16_t>(p, OFF_X2B) + (long)tok * ND;
        float a[16];
#pragma unroll
        for (int e = 0; e < 16; e++) a[e] = 0.f;
#pragma unroll 2
        for (int j = 0; j < 8; j++) {
            const unsigned xw = *(const unsigned*)(xr + 2 * lane + 128 * j);
            const float x0 = __uint_as_float(xw << 16), x1 = __uint_as_float(xw & 0xFFFF0000u);
#pragma unroll
            for (int e = 0; e < 16; e++) {
                const f32x2 w = *(const f32x2*)(wr + e * 1024 + 2 * lane + 128 * j);
                a[e] += x0 * w[0] + x1 * w[1];
            }
        }
#pragma unroll
        for (int i = 0; i < 8; i++) { const bool hi = lane & 32; const float send = hi ? a[i] : a[i + 8], keep = hi ? a[i + 8] : a[i]; a[i] = keep + __shfl_xor(send, 32); }
#pragma unroll
        for (int i = 0; i < 4; i++) { const bool hi = lane & 16; const float send = hi ? a[i] : a[i + 4], keep = hi ? a[i + 4] : a[i]; a[i] = keep + __shfl_xor(send, 16); }
#pragma unroll
        for (int i = 0; i < 2; i++) { const bool hi = lane & 8; const float send = hi ? a[i] : a[i + 2], keep = hi ? a[i + 2] : a[i]; a[i] = keep + __shfl_xor(send, 8); }
        { const bool hi = lane & 4; const float send = hi ? a[0] : a[1], keep = hi ? a[1] : a[0]; a[0] = keep + __shfl_xor(send, 4); }
        float lg = a[0];
        lg += __shfl_xor(lg, 2); lg += __shfl_xor(lg, 1);
        const int e = ((lane >> 5) & 1) * 8 + ((lane >> 4) & 1) * 4 + ((lane >> 3) & 1) * 2 + ((lane >> 2) & 1);
        lg *= row_rs16(wsp<float>(p, OFF_SS2) + (long)tok * 16);
        float mx = lg;
#pragma unroll
        for (int o = 4; o < 64; o <<= 1) mx = fmaxf(mx, __shfl_xor(mx, o));
        const float ex = expf(lg - mx);
        float sm = ex;
#pragma unroll
        for (int o = 4; o < 64; o <<= 1) sm += __shfl_xor(sm, o);
        if ((lane & 3) == 0) wsp<float>(p, OFF_AFF)[(long)tok * 16 + e] = ex / sm;
    }
}

__device__ __forceinline__ int block_sum_i(int v, int* red) {
    const int lane = VTID & 63, wid = VTID >> 6;
#pragma unroll
    for (int o = 32; o > 0; o >>= 1) v += __shfl_xor(v, o);
    __syncthreads();
    if (lane == 0) red[wid] = v;
    __syncthreads();
    return red[0] + red[1] + red[2] + red[3];
}
__device__ __forceinline__ int block_excl_scan_i(int v, int* red, int& total) {
    const int lane = VTID & 63, wid = VTID >> 6;
    int inc = v;
#pragma unroll
    for (int o = 1; o < 64; o <<= 1) { const int t = __shfl_up(inc, o); if (lane >= o) inc += t; }
    __syncthreads();
    if (lane == 63) red[wid] = inc;
    __syncthreads();
    int base = 0;
#pragma unroll
    for (int w = 0; w < 4; w++) if (w < wid) base += red[w];
    total = red[0] + red[1] + red[2] + red[3];
    return base + inc - v;
}
__device__ __forceinline__ void phase8(const Params& p, char* lds) {
    int* red = (int*)lds;
    const int tid = VTID;
    for (int item = VBLK; item < NB * NE; item += VGRID) {
        const int e = item & 15, b = item >> 4;
        const float* aff = wsp<float>(p, OFF_AFF) + (long)b * NS * 16 + e;
        unsigned v[16];
#pragma unroll
        for (int i = 0; i < 16; i++) v[i] = __float_as_uint(aff[(long)(tid * 16 + i) * 16]);
        unsigned T = 0;
        for (int bit = 30; bit >= 0; bit--) {
            const unsigned cand = T | (1u << bit);
            int c = 0;
#pragma unroll
            for (int i = 0; i < 16; i++) c += (v[i] >= cand) ? 1 : 0;
            if (block_sum_i(c, red) >= CAP) T = cand;
        }
        int cg = 0, ce = 0;
#pragma unroll
        for (int i = 0; i < 16; i++) { cg += (v[i] > T) ? 1 : 0; ce += (v[i] == T) ? 1 : 0; }
        int tot;
        const int pk = block_excl_scan_i(cg | (ce << 16), red, tot);
        const int need = CAP - (tot & 0xFFFF);
        const int pe = pk >> 16;
        int nse = need - pe; nse = nse < 0 ? 0 : (nse > ce ? ce : nse);
        int tot2;
        int slot = block_excl_scan_i(cg + nse, red, tot2);
        int* slots = wsp<int>(p, OFF_SLOTS) + (long)(b * NE + e) * NS;
        int* idx = wsp<int>(p, OFF_IDX) + (long)(b * NE + e) * CAP;
        float* gate = wsp<float>(p, OFF_GATE) + (long)(b * NE + e) * CAP;
        int eqs = 0;
#pragma unroll
        for (int i = 0; i < 16; i++) {
            const int t = tid * 16 + i;
            bool sel = v[i] > T;
            if (v[i] == T) { sel = eqs < nse; eqs++; }
            if (sel) { slots[t] = slot; idx[slot] = b * NS + t; gate[slot] = __uint_as_float(v[i]); slot++; }
            else slots[t] = -1;
        }
    }
}

__device__ __forceinline__ void phase9(const Params& p, char* lds) {
    const int tid = VTID, lane = tid & 63, wid = tid >> 6, wm = wid >> 1, wn = wid & 1, lq = lane >> 4, lr = lane & 15;
    FOR_XCD_ITEMS(item, NE * 16 * NB * 4) {
        const int rt = item & 3, b = (item >> 2) & 3, ct = (item >> 4) & 15, e = item >> 8;
        const int* arow = wsp<int>(p, OFF_IDX) + (long)(b * NE + e) * CAP + rt * 128;
        f32x4 acc[4][4];
        GemmTile g; g.A = wsp<bf16_t>(p, OFF_X2B); g.lda = ND; g.arow = arow;
        g.Bt = wsp<bf16_t>(p, OFF_WGUT) + ((long)e * 2048 + ct * 128) * ND; g.ldb = ND; g.K = ND;
        gemm_tile_128(g, lds, acc);
#pragma unroll
        for (int mi = 0; mi < 4; mi++) {
            const int r = wm * 64 + mi * 16 + lr;
            const int tok = arow[r];
            const float rs = row_rs16(wsp<float>(p, OFF_SS2) + (long)tok * 16);
            bf16_t* ad = wsp<bf16_t>(p, OFF_ACT) + ((long)(e * NB + b) * CAP + rt * 128 + r) * ND + ct * 64 + wn * 32 + 4 * lq;
#pragma unroll
            for (int pp = 0; pp < 2; pp++) {
                f32x4 o;
#pragma unroll
                for (int q = 0; q < 4; q++) {
                    const float ga = acc[mi][2 * pp][q] * rs, up = acc[mi][2 * pp + 1][q] * rs;
                    o[q] = ga / (1.f + __expf(-ga)) * up;
                }
                *(u32x2*)(ad + pp * 16) = pack4bf(o);
            }
        }
    }
}
__device__ __forceinline__ void phase10(const Params& p, char* lds) {
    const int tid = VTID, lane = tid & 63, wid = tid >> 6, wm = wid >> 1, wn = wid & 1, lq = lane >> 4, lr = lane & 15;
    FOR_XCD_ITEMS(item, NE * 8 * NB * 4) {
        const int rt = item & 3, b = (item >> 2) & 3, ct = (item >> 4) & 7, e = item >> 7;
        const long row0 = (long)(e * NB + b) * CAP + rt * 128;
        f32x4 acc[4][4];
        GemmTile g; g.A = wsp<bf16_t>(p, OFF_ACT) + row0 * ND; g.lda = ND; g.arow = nullptr;
        g.Bt = wsp<bf16_t>(p, OFF_WDT) + ((long)e * 1024 + ct * 128) * ND; g.ldb = ND; g.K = ND;
        gemm_tile_128(g, lds, acc);
        const float* gate = wsp<float>(p, OFF_GATE) + (long)(b * NE + e) * CAP + rt * 128;
#pragma unroll
        for (int mi = 0; mi < 4; mi++) {
            const int r = wm * 64 + mi * 16 + lr;
            const float gv = gate[r];
            bf16_t* yd = wsp<bf16_t>(p, OFF_Y) + (row0 + r) * ND + ct * 128 + wn * 64 + 4 * lq;
#pragma unroll
            for (int ni = 0; ni < 4; ni++) *(u32x2*)(yd + ni * 16) = pack4bf(acc[mi][ni] * gv);
        }
    }
}

__device__ __forceinline__ void phase11(const Params& p, char* lds) {
    const int tid = VTID, lane = tid & 63, wid = tid >> 6;
    const int* slots = wsp<int>(p, OFF_SLOTS);
    auto slot_of = [&](int tok) { const int b = tok >> 12, t = tok & 4095; return slots[(long)(b * NE + (lane & 15)) * NS + t]; };
    int tok = VBLK * 4 + wid;
    int sl_next = tok < NT ? slot_of(tok) : -1;
    u32x2 xn[4];
#pragma unroll
    for (int i = 0; i < 4; i++) xn[i] = *(const u32x2*)(wsp<bf16_t>(p, OFF_X2B) + (long)(tok < NT ? tok : 0) * ND + i * 256 + lane * 4);
    for (; tok < NT; tok += VGRID * 4) {
        const int b = tok >> 12;
        float* xr = p.out + (long)tok * ND;
        const int slv = sl_next;
        f32x4 v[4];
#pragma unroll
        for (int i = 0; i < 4; i++)
            v[i] = (f32x4){__uint_as_float(xn[i].x << 16), __uint_as_float(xn[i].x & 0xFFFF0000u), __uint_as_float(xn[i].y << 16), __uint_as_float(xn[i].y & 0xFFFF0000u)};
        {
            const int tn = tok + VGRID * 4;
            sl_next = tn < NT ? slot_of(tn) : -1;
#pragma unroll
            for (int i = 0; i < 4; i++) xn[i] = *(const u32x2*)(wsp<bf16_t>(p, OFF_X2B) + (long)(tn < NT ? tn : tok) * ND + i * 256 + lane * 4);
        }
        unsigned long long sel = __ballot(slv >= 0) & 0xFFFFull;
        while (sel) {
            const int e = __builtin_ctzll(sel); sel &= sel - 1;
            const int sl = __builtin_amdgcn_readlane(slv, e);
            const bf16_t* yr = wsp<bf16_t>(p, OFF_Y) + ((long)(e * NB + b) * CAP + sl) * ND;
#pragma unroll
            for (int i = 0; i < 4; i++) {
                const u32x2 w = *(const u32x2*)(yr + i * 256 + lane * 4);
                v[i][0] += __uint_as_float(w.x << 16); v[i][1] += __uint_as_float(w.x & 0xFFFF0000u);
                v[i][2] += __uint_as_float(w.y << 16); v[i][3] += __uint_as_float(w.y & 0xFFFF0000u);
            }
        }
        float ss = 0.f;
#pragma unroll
        for (int i = 0; i < 4; i++) ss += v[i][0] * v[i][0] + v[i][1] * v[i][1] + v[i][2] * v[i][2] + v[i][3] * v[i][3];
        ss = wave_sum(ss);
        const float rs = rsqrtf(ss * (1.f / ND) + 1e-6f);
#pragma unroll
        for (int i = 0; i < 4; i++) {
            const f32x4 gf = *(const f32x4*)(p.g_final + i * 256 + lane * 4);
            *(f32x4*)(xr + i * 256 + lane * 4) = v[i] * rs * gf;
        }
    }
}


__device__ __forceinline__ void phase_resid8(const Params& p, char* lds, size_t offA, size_t offW, const float* residf, const bf16_t* residb, size_t offXb, size_t offSS) {
    const int tid = threadIdx.x, lane = tid & 63, wid = tid >> 6, wm = wid >> 2, wn = wid & 3, lq = lane >> 4, lr = lane & 15;
    FOR_XCD_ITEMS_R(item, 64 * 4) {
        const int tm = item >> 2, tn = item & 3;
        f32x4 acc[8][4];
        GemmTile g; g.A = wsp<bf16_t>(p, offA) + (long)tm * 256 * ND; g.lda = ND; g.arow = nullptr;
        g.Bt = wsp<bf16_t>(p, offW) + (long)tn * 256 * ND; g.ldb = ND; g.K = ND;
        gemm_tile_256sq(g, lds, acc);
#pragma unroll
        for (int mi = 0; mi < 8; mi++) {
            const int row = tm * 256 + wm * 128 + mi * 16 + lr;
            float ss = 0.f;
#pragma unroll
            for (int ni = 0; ni < 4; ni++) {
                const long o = (long)row * ND + tn * 256 + wn * 64 + ni * 16 + 4 * lq;
                f32x4 rv;
                if (residf) rv = *(const f32x4*)(residf + o);
                else { const u32x2 w = *(const u32x2*)(residb + o); rv = (f32x4){__uint_as_float(w.x << 16), __uint_as_float(w.x & 0xFFFF0000u), __uint_as_float(w.y << 16), __uint_as_float(w.y & 0xFFFF0000u)}; }
                const f32x4 v = rv + acc[mi][ni];
                *(u32x2*)(wsp<bf16_t>(p, offXb) + o) = pack4bf(v);
                ss += v[0] * v[0] + v[1] * v[1] + v[2] * v[2] + v[3] * v[3];
            }
            ss += __shfl_xor(ss, 16); ss += __shfl_xor(ss, 32);
            if (lq == 0) wsp<float>(p, offSS)[row * 16 + tn * 4 + wn] = ss;
        }
    }
}
__device__ __forceinline__ void phase5a8(const Params& p, char* lds) {
    const int tid = threadIdx.x, lane = tid & 63, wid = tid >> 6, wm = wid >> 2, wn = wid & 3, lq = lane >> 4, lr = lane & 15;
    FOR_XCD_ITEMS_R(item, 64 * 4) {
        const int tm = item >> 2, tn = item & 3;
        f32x4 acc[8][4];
        GemmTile g; g.A = wsp<bf16_t>(p, OFF_X1B) + (long)tm * 256 * ND; g.lda = ND; g.arow = nullptr;
        g.Bt = wsp<bf16_t>(p, OFF_WMQT) + (long)tn * 256 * ND; g.ldb = ND; g.K = ND;
        gemm_tile_256sq(g, lds, acc);
#pragma unroll
        for (int mi = 0; mi < 8; mi++) {
            const int row = tm * 256 + wm * 128 + mi * 16 + lr, b = row >> 12, s = row & 4095;
            const float rs = row_rs16(wsp<float>(p, OFF_SS1) + (long)row * 16) * (0.0625f * 1.4426950408889634f);
            bf16_t* qd = wsp<bf16_t>(p, OFF_QM) + ((long)(b * 4 + tn) * NS + s) * 256 + wn * 64 + 4 * lq;
#pragma unroll
            for (int ni = 0; ni < 4; ni++) *(u32x2*)(qd + ni * 16) = pack4bf(acc[mi][ni] * rs);
        }
    }
}


__device__ __forceinline__ void phase9_8(const Params& p, char* lds) {
    const int tid = threadIdx.x, lane = tid & 63, wid = tid >> 6, wm = wid >> 2, wn = wid & 3, lq = lane >> 4, lr = lane & 15;
    FOR_XCD_ITEMS_R(item, NE * 8 * NB * 2) {
        const int rt = item & 1, b = (item >> 1) & 3, ct = (item >> 3) & 7, e = item >> 6;
        const int* arow = wsp<int>(p, OFF_IDX) + (long)(b * NE + e) * CAP + rt * 256;
        f32x4 acc[8][4];
        GemmTile g; g.A = wsp<bf16_t>(p, OFF_X2B); g.lda = ND; g.arow = arow;
        g.Bt = wsp<bf16_t>(p, OFF_WGUT) + ((long)e * 2048 + ct * 256) * ND; g.ldb = ND; g.K = ND;
        gemm_tile_256sq(g, lds, acc);
#pragma unroll
        for (int mi = 0; mi < 8; mi++) {
            const int r = wm * 128 + mi * 16 + lr;
            const int tok = arow[r];
            const float rs = row_rs16(wsp<float>(p, OFF_SS2) + (long)tok * 16);
            bf16_t* ad = wsp<bf16_t>(p, OFF_ACT) + ((long)(e * NB + b) * CAP + rt * 256 + r) * ND + ct * 128 + wn * 32 + 4 * lq;
#pragma unroll
            for (int pp = 0; pp < 2; pp++) {
                f32x4 o;
#pragma unroll
                for (int q = 0; q < 4; q++) {
                    const float ga = acc[mi][2 * pp][q] * rs, up = acc[mi][2 * pp + 1][q] * rs;
                    o[q] = ga / (1.f + __expf(-ga)) * up;
                }
                *(u32x2*)(ad + pp * 16) = pack4bf(o);
            }
        }
    }
}
__device__ __forceinline__ void phase10_8(const Params& p, char* lds) {
    const int tid = threadIdx.x, lane = tid & 63, wid = tid >> 6, wm = wid >> 2, wn = wid & 3, lq = lane >> 4, lr = lane & 15;
    FOR_XCD_ITEMS_R(item, NE * 4 * NB * 2) {
        const int rt = item & 1, b = (item >> 1) & 3, ct = (item >> 3) & 3, e = item >> 5;
        const long row0 = (long)(e * NB + b) * CAP + rt * 256;
        f32x4 acc[8][4];
        GemmTile g; g.A = wsp<bf16_t>(p, OFF_ACT) + row0 * ND; g.lda = ND; g.arow = nullptr;
        g.Bt = wsp<bf16_t>(p, OFF_WDT) + ((long)e * 1024 + ct * 256) * ND; g.ldb = ND; g.K = ND;
        gemm_tile_256sq(g, lds, acc);
        const float* gate = wsp<float>(p, OFF_GATE) + (long)(b * NE + e) * CAP + rt * 256;
#pragma unroll
        for (int mi = 0; mi < 8; mi++) {
            const int r = wm * 128 + mi * 16 + lr;
            const float gv = gate[r];
            bf16_t* yd = wsp<bf16_t>(p, OFF_Y) + (row0 + r) * ND + ct * 256 + wn * 64 + 4 * lq;
#pragma unroll
            for (int ni = 0; ni < 4; ni++) *(u32x2*)(yd + ni * 16) = pack4bf(acc[mi][ni] * gv);
        }
    }
}


__device__ __forceinline__ void phase1_big(const Params& p, char* lds) {
    const int tid = threadIdx.x, lane = tid & 63, wid = tid >> 6, wm = wid >> 2, wn = wid & 3, lq = lane >> 4, lr = lane & 15;
    FOR_XCD_ITEMS_R(item, 64 * 4) {
        const int tm = item >> 2, tn = item & 3;
        f32x4 acc[8][4];
        GemmTile g; g.A = wsp<bf16_t>(p, OFF_XB) + (long)tm * 256 * ND; g.lda = ND; g.arow = nullptr;
        g.Bt = wsp<bf16_t>(p, OFF_W1T) + (long)tn * 256 * ND; g.ldb = ND; g.K = ND;
        gemm_tile_256sq(g, lds, acc);
        const float* r0 = wsp<float>(p, OFF_R0);
        const int col0 = tn * 256 + wn * 64;
#pragma unroll
        for (int mi = 0; mi < 8; mi++) {
            const int row = tm * 256 + wm * 128 + mi * 16 + lr;
            const float rs = r0[row];
#pragma unroll
            for (int ni = 0; ni < 4; ni++) acc[mi][ni] *= rs;
            if (col0 < 512) {
#pragma unroll
                for (int ni = 0; ni < 4; ni++)
                    *(u32x2*)(wsp<bf16_t>(p, OFF_UF) + (long)row * 512 + col0 + ni * 16 + 4 * lq) = pack4bf(acc[mi][ni]);
            } else {
                float ss = 0.f;
#pragma unroll
                for (int ni = 0; ni < 4; ni++) { const f32x4 v = acc[mi][ni]; ss += v[0] * v[0] + v[1] * v[1] + v[2] * v[2] + v[3] * v[3]; }
                ss += __shfl_xor(ss, 16); ss += __shfl_xor(ss, 32);
                if (col0 < 896) {
#pragma unroll
                    for (int ni = 0; ni < 4; ni++)
                        *(u32x2*)(wsp<bf16_t>(p, OFF_UQ) + (long)row * 384 + (col0 - 512) + ni * 16 + 4 * lq) = pack4bf(acc[mi][ni]);
                    if (lq == 0) wsp<float>(p, OFF_SSQ)[row * 6 + ((col0 - 512) >> 6)] = ss;
                } else {
#pragma unroll
                    for (int ni = 0; ni < 4; ni++)
                        *(u32x2*)(wsp<bf16_t>(p, OFF_UKV) + (long)row * 256 + (col0 - 896) + ni * 16 + 4 * lq) = pack4bf(acc[mi][ni]);
                    if (lq == 0) wsp<float>(p, OFF_SSKV)[row * 4 + ((col0 - 896) >> 6)] = ss;
                }
            }
        }
    }
}


__device__ __forceinline__ void phase3_attn8(const Params& p, char* lds) {
    FOR_XCD_ITEMS_R(item, NB * 8 * (NS / 256)) {
        const int qt = item & 15, h = (item >> 4) & 7, b = item >> 7;
        const bf16_t* Qp = wsp<bf16_t>(p, OFF_Q) + ((long)(b * 8 + h) * NS + qt * 256) * 96;
        const bf16_t* Kp = wsp<bf16_t>(p, OFF_K) + ((long)(b * 8 + h) * NS) * 96;
        const bf16_t* Vtp = wsp<bf16_t>(p, OFF_VT) + ((long)(b * 8 + h) * 64) * NS;
        bf16_t* Op = wsp<bf16_t>(p, OFF_ZA) + ((long)b * NS + qt * 256) * 1024 + 512 + h * 64;
        attn_block<96, 64, 128, 512>(Qp, Kp, Vtp, (long)NS, NS, lds, [&](int q, int dv, f32x4 v) { *(u32x2*)(Op + (long)q * 1024 + dv) = pack4bf(v); });
    }
}
__device__ __forceinline__ void phase5b_8(const Params& p, char* lds) {
    FOR_XCD_ITEMS_R(item, NB * 4 * 16 * 2) {
        const int dvh = item & 1, qt = (item >> 1) & 15, h = (item >> 5) & 3, b = item >> 7;
        const bf16_t* Qp = wsp<bf16_t>(p, OFF_QM) + ((long)(b * 4 + h) * NS + qt * 256) * 256;
        const bf16_t* Kp = wsp<bf16_t>(p, OFF_KMEM) + ((long)(b * 4 + h) * 256) * 256;
        const bf16_t* Vtp = wsp<bf16_t>(p, OFF_VTMEM) + ((long)(b * 4 + h) * 256 + dvh * 128) * 256;
        bf16_t* Op = wsp<bf16_t>(p, OFF_OM) + ((long)b * NS + qt * 256) * 1024 + h * 256 + dvh * 128;
        attn_block<256, 128, 32, 512>(Qp, Kp, Vtp, 256L, 256, lds, [&](int q, int dv, f32x4 v) { *(u32x2*)(Op + (long)q * 1024 + dv) = pack4bf(v); });
    }
}

__global__ void __launch_bounds__(512, 1) k_fwd(Params p, int ph_lo, int ph_hi) {
    extern __shared__ __attribute__((aligned(16))) char lds_all[];
    char* lds = lds_all + VHALF * LDS_HALF;
    volatile LAS unsigned* st = (volatile LAS unsigned*)(lds_all + LDS_MAIN);
    if (threadIdx.x == 0) { st[0] = 0u; st[1] = 0u; }
    __syncthreads();
    XcdBarrier bar = xcd_barrier_post(wsp<unsigned>(p, OFF_BAR), st);
#if USE_CG_SYNC
#define GRID_BARRIER() do { asm volatile("s_waitcnt vmcnt(0)" ::: "memory"); __syncthreads(); cg::this_grid().sync(); asm volatile("s_waitcnt vmcnt(0)" ::: "memory"); __syncthreads(); } while (0)
#else
#define GRID_BARRIER() xcd_barrier(bar)
#endif
#define RUN_PHASE(k, call) if (ph_lo <= (k) && (k) < ph_hi) { if ((k) > ph_lo) { GRID_BARRIER(); } call; }
    RUN_PHASE(0, phase0(p, lds))
    RUN_PHASE(1, (phase1_big(p, lds_all), phase1(p, lds_all)))
    RUN_PHASE(2, (phase2(p, lds_all), phase2_f2a(p, lds)))
    RUN_PHASE(3, ((blockIdx.x & 1) ? phase3_tr(p, lds) : (void)0, phase3_attn8(p, lds_all), phase3_f2b(p, lds), (blockIdx.x & 1) ? (void)0 : phase3_tr(p, lds)))
    RUN_PHASE(4, phase_resid8(p, lds_all, OFF_ZA, OFF_WOUTT, p.x, nullptr, OFF_X1B, OFF_SS1))
    RUN_PHASE(5, phase5a8(p, lds_all))
    RUN_PHASE(6, phase5b_8(p, lds_all))
    RUN_PHASE(7, phase_resid8(p, lds_all, OFF_OM, OFF_WMOT, nullptr, wsp<bf16_t>(p, OFF_X1B), OFF_X2B, OFF_SS2))
    RUN_PHASE(8, phase7(p, lds))
    RUN_PHASE(9, phase8(p, lds))
    RUN_PHASE(10, phase9_8(p, lds_all))
    RUN_PHASE(11, phase10_8(p, lds_all))
    RUN_PHASE(12, phase11(p, lds))
}

extern "C" void kernel_launch(void* const* d_in, const int* in_sizes, int n_in,
                              void* d_out, int out_size, void* d_ws, size_t ws_size,
                              hipStream_t stream) {
    static int grid = 0;
    if (grid == 0) {
        if (n_in != 22 || ws_size < WS_END) { fprintf(stderr, "kernel_launch: unexpected inputs (n_in %d, ws %zu < %zu)\n", n_in, ws_size, (size_t)WS_END); grid = -1; return; }
        int dev = 0, cus = 0, per_cu = 0;
        (void)hipGetDevice(&dev);
        (void)hipDeviceGetAttribute(&cus, hipDeviceAttributeMultiprocessorCount, dev);
        if (hipFuncSetAttribute((const void*)k_fwd, hipFuncAttributeMaxDynamicSharedMemorySize, LDS_TOTAL) != hipSuccess) { fprintf(stderr, "kernel_launch: hipFuncSetAttribute failed\n"); grid = -1; return; }
        if (hipOccupancyMaxActiveBlocksPerMultiprocessor(&per_cu, (const void*)k_fwd, 512, LDS_TOTAL) != hipSuccess || per_cu < 1) { fprintf(stderr, "kernel_launch: occupancy query failed (%d)\n", per_cu); (void)hipGetLastError(); per_cu = 1; }
        if (per_cu > 1) per_cu = 1;
        grid = (cus * per_cu) & ~7;
        if (grid < 8) { fprintf(stderr, "kernel_launch: unexpected device (%d CUs)\n", cus); grid = -1; return; }
        fprintf(stderr, "kernel_launch: %d CUs x %d blocks\n", cus, per_cu);
    }
    if (grid < 0) return;
    Params p{};
    p.x = (const float*)d_in[0]; p.mem = (const float*)d_in[1]; p.pos = (const int*)d_in[2];
    p.g_mix = (const float*)d_in[3]; p.w_in = (const float*)d_in[4]; p.g_q_lat = (const float*)d_in[5]; p.w_q_up = (const float*)d_in[6];
    p.g_kv_lat = (const float*)d_in[7]; p.w_kv_up = (const float*)d_in[8]; p.w_fourier = (const float*)d_in[9]; p.w_out = (const float*)d_in[10];
    p.g_mem_q = (const float*)d_in[11]; p.g_mem_kv = (const float*)d_in[12]; p.w_mem_q = (const float*)d_in[13]; p.w_mem_kv = (const float*)d_in[14];
    p.w_mem_o = (const float*)d_in[15]; p.g_ffn = (const float*)d_in[16]; p.w_router = (const float*)d_in[17];
    p.w_exp_gate = (const float*)d_in[18]; p.w_exp_up = (const float*)d_in[19]; p.w_exp_down = (const float*)d_in[20]; p.g_final = (const float*)d_in[21];
    p.out = (float*)d_out; p.ws = (char*)d_ws;
    static const int cuts[] = MK_CUTS;
    const int ncut = (int)(sizeof(cuts) / sizeof(int));
    for (int li = 0; li + 1 < ncut; li++) {
        (void)hipMemsetAsync((char*)d_ws + OFF_BAR, 0, 16384, stream);
        int lo = cuts[li], hi = cuts[li + 1];
        void* args[] = {&p, &lo, &hi};
        hipError_t e = hipLaunchCooperativeKernel((const void*)k_fwd, dim3(grid), dim3(512), args, LDS_TOTAL, stream);
        if (e != hipSuccess) fprintf(stderr, "cooperative launch failed: %s (grid %d)\n", hipGetErrorString(e), grid);
    }
}
```

```cpp
#include <hip/hip_runtime.h>
#include <stdint.h>
#include <cstdio>
#include <hip/hip_cooperative_groups.h>
namespace cg = cooperative_groups;
#ifndef USE_CG_SYNC
#define USE_CG_SYNC 0
#endif

#ifndef MK_CUTS
#define MK_CUTS {0, 13}
#endif

#define NB 4
#define NS 4096
#define ND 1024
#define NT (NB * NS)
#define INW 1184
#define NE 16
#define CAP 512
#define MEML 256
#define NPHASE 13
#define VTID ((int)(threadIdx.x & 255))
#define VHALF (__builtin_amdgcn_readfirstlane((int)(threadIdx.x >> 8)))
#define VBLK ((int)(blockIdx.x * 2) + VHALF)
#define VGRID ((int)(gridDim.x * 2))

typedef unsigned short bf16_t;
typedef short bf16x8 __attribute__((ext_vector_type(8)));
typedef float f32x4 __attribute__((ext_vector_type(4)));
typedef float f32x16 __attribute__((ext_vector_type(16)));
typedef unsigned u32x4 __attribute__((ext_vector_type(4)));
typedef unsigned u32x2 __attribute__((ext_vector_type(2)));

__device__ __forceinline__ unsigned f2bf(float f) {
    unsigned u = __float_as_uint(f);
    u += 0x7FFFu + ((u >> 16) & 1u);
    return u >> 16;
}
typedef __bf16 hbf2 __attribute__((ext_vector_type(2)));
typedef float f32x2 __attribute__((ext_vector_type(2)));
__device__ __forceinline__ unsigned pack2bf(float lo, float hi) { f32x2 v = {lo, hi}; return __builtin_bit_cast(unsigned, __builtin_convertvector(v, hbf2)); }
__device__ __forceinline__ float bf2f(unsigned short b) { return __uint_as_float(((unsigned)b) << 16); }

__device__ __forceinline__ int tile_off(int row, int chunk) { return row * 128 + ((chunk ^ ((row >> 1) & 7)) << 4); }

#define GT_LDS_BYTES 65536

struct GemmTile { const bf16_t* A; long lda; const int* arow; const bf16_t* Bt; long ldb; int K; };

__device__ __forceinline__ void gemm_tile_128(const GemmTile& g, char* lds, f32x4 (&acc)[4][4]) {
    const int tid = VTID, lane = tid & 63, wid = tid >> 6, wm = wid >> 1, wn = wid & 1;
    const int lrow = lane >> 3, pc = lane & 7;
    const bf16_t* ap[4]; const bf16_t* bp[4];
#pragma unroll
    for (int i = 0; i < 4; i++) {
        const int r = (wid * 4 + i) * 8 + lrow;
        const int c = pc ^ ((r >> 1) & 7);
        const long ro = g.arow ? (long)g.arow[r] * g.lda : (long)r * g.lda;
        ap[i] = g.A + ro + c * 8;
        bp[i] = g.Bt + (long)r * g.ldb + c * 8;
    }
#pragma unroll
    for (int mi = 0; mi < 4; mi++)
#pragma unroll
        for (int ni = 0; ni < 4; ni++) acc[mi][ni] = (f32x4){0.f, 0.f, 0.f, 0.f};
    const int nk = g.K >> 6;
    auto stage = [&](int kt, char* st) {
#pragma unroll
        for (int i = 0; i < 4; i++) {
            __builtin_amdgcn_global_load_lds((const unsigned*)(ap[i] + kt * 64), (unsigned*)(st + (wid * 4 + i) * 1024), 16, 0, 0);
            __builtin_amdgcn_global_load_lds((const unsigned*)(bp[i] + kt * 64), (unsigned*)(st + 16384 + (wid * 4 + i) * 1024), 16, 0, 0);
        }
    };
    __syncthreads();
    stage(0, lds);
    asm volatile("s_waitcnt vmcnt(0)" ::: "memory");
    __syncthreads();
    for (int kt = 0; kt < nk; kt++) {
        char* cur = lds + (kt & 1) * 32768;
        if (kt + 1 < nk) stage(kt + 1, lds + ((kt + 1) & 1) * 32768);
        bf16x8 af[2][4], bfr[2][4];
#pragma unroll
        for (int ks = 0; ks < 2; ks++)
#pragma unroll
            for (int i = 0; i < 4; i++) {
                af[ks][i] = *(const bf16x8*)(cur + tile_off(wm * 64 + i * 16 + (lane & 15), ks * 4 + (lane >> 4)));
                bfr[ks][i] = *(const bf16x8*)(cur + 16384 + tile_off(wn * 64 + i * 16 + (lane & 15), ks * 4 + (lane >> 4)));
            }
        __builtin_amdgcn_s_setprio(1);
#pragma unroll
        for (int ks = 0; ks < 2; ks++)
#pragma unroll
            for (int mi = 0; mi < 4; mi++)
#pragma unroll
                for (int ni = 0; ni < 4; ni++)
                    acc[mi][ni] = __builtin_amdgcn_mfma_f32_16x16x32_bf16(bfr[ks][ni], af[ks][mi], acc[mi][ni], 0, 0, 0);
        __builtin_amdgcn_s_setprio(0);
        asm volatile("s_waitcnt vmcnt(0)" ::: "memory");
        __syncthreads();
    }
}

template <int DQK, int DVT, int KT>
struct AttnCfg {
    static constexpr int KROW = DQK * 2 + 16;
    static constexpr int VROW = KT * 2 + 8;
    static constexpr int KBYTES = KT * KROW;
    static constexpr int VBYTES = DVT * VROW;
    static constexpr int STAGE = KBYTES + VBYTES;
    static constexpr int LDS = 2 * STAGE;
};

template <int DQK, int DVT, int KT, int NTH, class Out>
__device__ __forceinline__ void attn_block(const bf16_t* Qp, const bf16_t* Kp, const bf16_t* Vtp, long ldv, int nk, char* lds, Out&& out) {
    typedef AttnCfg<DQK, DVT, KT> C;
    constexpr int NKS = DQK / 16, NST = KT / 32, NDT = DVT / 32, NPS = KT / 16;
    constexpr int KCPR = DQK / 8;
    constexpr int KTOT = KT * KCPR, KCH = (KTOT + NTH - 1) / NTH;
    constexpr int VCPR = KT / 8;
    constexpr int VTOT = DVT * VCPR, VCH = (VTOT + NTH - 1) / NTH;
    const int tid = NTH == 512 ? (int)threadIdx.x : VTID, lane = tid & 63, wid = tid >> 6, h = lane >> 5, c = lane & 31;

    bf16x8 qf[NKS];
    {
        const bf16_t* qrow = Qp + (long)(wid * 32 + c) * DQK + 8 * h;
#pragma unroll
        for (int ks = 0; ks < NKS; ks++) qf[ks] = *(const bf16x8*)(qrow + 16 * ks);
    }
    f32x16 o[NDT];
#pragma unroll
    for (int dt = 0; dt < NDT; dt++)
#pragma unroll
        for (int r = 0; r < 16; r++) o[dt][r] = 0.f;
    float m = 0.f, l = 0.f;

    u32x4 kr[KCH], vr[VCH];
    auto gload = [&](int t) {
#pragma unroll
        for (int i = 0; i < KCH; i++) {
            const int ci = tid + NTH * i, row = ci / KCPR, cc = ci % KCPR;
            if (KTOT % NTH == 0 || ci < KTOT) kr[i] = *(const u32x4*)(Kp + (long)(t * KT + row) * DQK + cc * 8);
        }
#pragma unroll
        for (int i = 0; i < VCH; i++) {
            const int ci = tid + NTH * i, row = ci / VCPR, cc = ci % VCPR;
            if (VTOT % NTH == 0 || ci < VTOT) vr[i] = *(const u32x4*)(Vtp + (long)row * ldv + t * KT + cc * 8);
        }
    };
    auto lwrite = [&](char* st) {
#pragma unroll
        for (int i = 0; i < KCH; i++) {
            const int ci = tid + NTH * i, row = ci / KCPR, cc = ci % KCPR;
            if (KTOT % NTH == 0 || ci < KTOT) *(u32x4*)(st + row * C::KROW + cc * 16) = kr[i];
        }
#pragma unroll
        for (int i = 0; i < VCH; i++) {
            const int ci = tid + NTH * i, row = ci / VCPR, cc = ci % VCPR;
            if (VTOT % NTH == 0 || ci < VTOT) {
                char* p = st + C::KBYTES + row * C::VROW + cc * 16;
                *(u32x2*)(p) = (u32x2){vr[i].x, vr[i].y};
                *(u32x2*)(p + 8) = (u32x2){vr[i].z, vr[i].w};
            }
        }
    };
    const int nt = nk / KT;
    gload(0);
    __syncthreads();
    lwrite(lds);
    __syncthreads();
    for (int t = 0; t < nt; t++) {
        char* cur = lds + (t & 1) * C::STAGE;
        if (t + 1 < nt) gload(t + 1);
        f32x16 s[NST];
        const float negm = -m;
#pragma unroll
        for (int st = 0; st < NST; st++) {
#pragma unroll
            for (int r = 0; r < 16; r++) s[st][r] = negm;
#pragma unroll
            for (int ks = 0; ks < NKS; ks++) {
                const bf16x8 kf = *(const bf16x8*)(cur + (st * 32 + c) * C::KROW + ks * 32 + h * 16);
                s[st] = __builtin_amdgcn_mfma_f32_32x32x16_bf16(kf, qf[ks], s[st], 0, 0, 0);
            }
        }
        float mx = s[0][0];
#pragma unroll
        for (int st = 0; st < NST; st++)
#pragma unroll
            for (int r = 0; r < 16; r++) mx = fmaxf(mx, s[st][r]);
        mx = fmaxf(mx, __shfl_xor(mx, 32));
        if (__any(mx > 8.0f)) {
            const float d = fmaxf(mx, 0.f);
            const float alpha = __builtin_amdgcn_exp2f(-d);
            m += d;
            l *= alpha;
#pragma unroll
            for (int dt = 0; dt < NDT; dt++)
#pragma unroll
                for (int r = 0; r < 16; r++) o[dt][r] *= alpha;
#pragma unroll
            for (int st = 0; st < NST; st++)
#pragma unroll
                for (int r = 0; r < 16; r++) s[st][r] -= d;
        }
        float rs = 0.f;
#pragma unroll
        for (int st = 0; st < NST; st++)
#pragma unroll
            for (int r = 0; r < 16; r++) { const float p = __builtin_amdgcn_exp2f(s[st][r]); rs += p; s[st][r] = p; }
        l += rs;
#pragma unroll
        for (int ps = 0; ps < NPS; ps++) {
            const int st = ps >> 1, u = ps & 1;
            u32x4 pw;
            pw.x = pack2bf(s[st][8 * u + 0], s[st][8 * u + 1]);
            pw.y = pack2bf(s[st][8 * u + 2], s[st][8 * u + 3]);
            pw.z = pack2bf(s[st][8 * u + 4], s[st][8 * u + 5]);
            pw.w = pack2bf(s[st][8 * u + 6], s[st][8 * u + 7]);
            const bf16x8 pf = __builtin_bit_cast(bf16x8, pw);
#pragma unroll
            for (int dt = 0; dt < NDT; dt++) {
                const char* vp = cur + C::KBYTES + (dt * 32 + c) * C::VROW + (ps * 16 + 4 * h) * 2;
                const u32x2 v0 = *(const u32x2*)(vp);
                const u32x2 v1 = *(const u32x2*)(vp + 16);
                const bf16x8 vf = __builtin_bit_cast(bf16x8, ((u32x4){v0.x, v0.y, v1.x, v1.y}));
                o[dt] = __builtin_amdgcn_mfma_f32_32x32x16_bf16(vf, pf, o[dt], 0, 0, 0);
            }
        }
        if (t + 1 < nt) lwrite(lds + ((t + 1) & 1) * C::STAGE);
        __syncthreads();
    }
    l += __shfl_xor(l, 32);
    const float inv = 1.f / l;
#pragma unroll
    for (int dt = 0; dt < NDT; dt++)
#pragma unroll
        for (int g4 = 0; g4 < 4; g4++) {
            f32x4 v = {o[dt][4 * g4 + 0] * inv, o[dt][4 * g4 + 1] * inv, o[dt][4 * g4 + 2] * inv, o[dt][4 * g4 + 3] * inv};
            out(wid * 32 + c, dt * 32 + 8 * g4 + 4 * h, v);
        }
}


constexpr size_t SLOT = 33554432;
constexpr size_t OFF_W1T = 0;
constexpr size_t OFF_WQT = OFF_W1T + 1280UL * 1024 * 2;
constexpr size_t OFF_WKVT = OFF_WQT + 768UL * 384 * 2;
constexpr size_t OFF_WOUTT = OFF_WKVT + 1024UL * 256 * 2;
constexpr size_t OFF_WMQT = OFF_WOUTT + 1024UL * 1024 * 2;
constexpr size_t OFF_WMKVT = OFF_WMQT + 1024UL * 1024 * 2;
constexpr size_t OFF_WMOT = OFF_WMKVT + 2048UL * 1024 * 2;
constexpr size_t OFF_WGUT = OFF_WMOT + 1024UL * 1024 * 2;
constexpr size_t OFF_WDT = OFF_WGUT + 16UL * 2048 * 1024 * 2;
constexpr size_t OFF_T64 = OFF_WDT + 16UL * 1024 * 1024 * 2;
constexpr size_t OFF_M1 = OFF_T64 + 16384;
constexpr size_t OFF_M3 = OFF_M1 + 32768;
constexpr size_t OFF_WFT = OFF_M3 + 16384;
constexpr size_t OFF_TW = OFF_WFT + 65536;
constexpr size_t OFF_ROPE = OFF_TW + 32768;
constexpr size_t OFF_R0 = OFF_ROPE + (size_t)NT * 16 * 8;
constexpr size_t OFF_RMEM = OFF_R0 + (size_t)NT * 4;
constexpr size_t OFF_SSQ = OFF_RMEM + 4096;
constexpr size_t OFF_SSKV = OFF_SSQ + (size_t)NT * 6 * 4;
constexpr size_t OFF_SS1 = OFF_SSKV + (size_t)NT * 4 * 4;
constexpr size_t OFF_SS2 = OFF_SS1 + (size_t)NT * 16 * 4;
constexpr size_t OFF_AFF = OFF_SS2 + (size_t)NT * 16 * 4;
constexpr size_t OFF_SLOTS = OFF_AFF + (size_t)NT * 16 * 4;
constexpr size_t OFF_IDX = OFF_SLOTS + 4UL * 16 * 4096 * 4;
constexpr size_t OFF_GATE = OFF_IDX + 4UL * 16 * 512 * 4;
constexpr size_t OFF_MEMB = OFF_GATE + 4UL * 16 * 512 * 4;
constexpr size_t OFF_KMEM = OFF_MEMB + 1024UL * 1024 * 2;
constexpr size_t OFF_VTMEM = OFF_KMEM + 1024UL * 1024 * 2;
constexpr size_t OFF_KR = OFF_VTMEM + 1024UL * 1024 * 2;
constexpr size_t OFF_BAR = OFF_KR + (size_t)NT * 32 * 2;
constexpr size_t OFF_RS2 = OFF_BAR + 16384;
constexpr size_t OFF_RSS = OFF_RS2 + (size_t)NT * 4;
constexpr size_t OFF_S0 = (OFF_RSS + 4UL * 16 * 512 * 4 + 255) / 256 * 256;
constexpr size_t OFF_S1 = OFF_S0 + SLOT;
constexpr size_t OFF_S2 = OFF_S1 + SLOT;
constexpr size_t OFF_S3 = OFF_S2 + SLOT;
constexpr size_t OFF_S4 = OFF_S3 + SLOT;
constexpr size_t WS_END = OFF_S4 + SLOT;
static_assert(WS_END <= 300964352UL, "workspace map exceeds the guaranteed scratch size");
constexpr size_t OFF_XB = OFF_S0, OFF_YR = OFF_S0, OFF_YI = OFF_S0 + SLOT / 2, OFF_X1B = OFF_S3, OFF_OM = OFF_S0, OFF_ACT = OFF_S0;
constexpr size_t OFF_UF = OFF_S1, OFF_UQ = OFF_S1 + (size_t)NT * 512 * 2, OFF_ZA = OFF_S1, OFF_QM = OFF_S1;
constexpr size_t OFF_Q = OFF_S2, OFF_UKV = OFF_S2 + (size_t)NT * 768 * 2, OFF_X2B = OFF_S2;
constexpr size_t OFF_K = OFF_S3, OFF_Y = OFF_S3;
constexpr size_t OFF_VT = OFF_S4;

struct Params {
    const float *x, *mem; const int* pos;
    const float *g_mix, *w_in, *g_q_lat, *w_q_up, *g_kv_lat, *w_kv_up, *w_fourier, *w_out, *g_mem_q, *g_mem_kv, *w_mem_q, *w_mem_kv, *w_mem_o,
        *g_ffn, *w_router, *w_exp_gate, *w_exp_up, *w_exp_down, *g_final;
    float* out; char* ws;
};
template <class T> __device__ __forceinline__ T* wsp(const Params& p, size_t off) { return (T*)(p.ws + off); }

#define LDS_HALF 65536
#define LDS_MAIN 131072
#define LDS_TOTAL (LDS_MAIN + 16)
#define LAS __attribute__((address_space(3)))

#define XB_TMO      128
#define XB_XCNT(j)  (256  + 64 * (j))
#define XB_XSUB(j)  (1280 + 64 * (j))
#define XB_XGEN(j)  (2304 + 64 * (j))
#define XB_TOP      3328
#define XB_TOPGEN   3392
#define XCD_BAR_WORDS 3456
#define XB_SPIN_CAP (1u << 25)
__device__ __forceinline__ unsigned xb_ld(unsigned* p)              { return __hip_atomic_load(p, __ATOMIC_RELAXED, __HIP_MEMORY_SCOPE_AGENT); }
__device__ __forceinline__ unsigned xb_add(unsigned* p, unsigned v) { return __hip_atomic_fetch_add(p, v, __ATOMIC_RELAXED, __HIP_MEMORY_SCOPE_AGENT); }
__device__ __forceinline__ unsigned xb_xcc_id() { return (unsigned)__builtin_amdgcn_s_getreg((3 << 11) | 20) & 0xFu; }
#define XB_SPIN(cond, bar) do { unsigned _sp = 0; while (cond) { __builtin_amdgcn_s_sleep(1); \
    if ((++_sp & 255u) == 0u) { if (xb_ld(&(bar)[XB_TMO])) break; if (_sp > XB_SPIN_CAP) { atomicAdd(&(bar)[XB_TMO], 1u); break; } } } } while (0)
struct XcdBarrier { unsigned* bar; unsigned x; volatile LAS unsigned* st; };
__device__ __forceinline__ XcdBarrier xcd_barrier_post(unsigned* bar, volatile LAS unsigned* st) {
    XcdBarrier b; b.bar = bar; b.x = xb_xcc_id(); b.st = st;
    if (threadIdx.x == 0) (void)xb_add(&bar[XB_XCNT(b.x)], 1u);
    return b;
}
__device__ __forceinline__ void xcd_barrier_complete(unsigned* bar, unsigned x, unsigned& nloc, unsigned& nx) {
    const unsigned G = gridDim.x * gridDim.y * gridDim.z;
    unsigned sum, cnt, mine, sp = 0u;
    for (;;) {
        sum = 0u; cnt = 0u; mine = 0u;
#pragma unroll
        for (unsigned j = 0; j < 16; ++j) { const unsigned c = xb_ld(&bar[XB_XCNT(j)]); sum += c; cnt += (c > 0u) ? 1u : 0u; mine = (j == x) ? c : mine; }
        if (sum == G) break;
        __builtin_amdgcn_s_sleep(1);
        if ((++sp & 255u) == 0u) { if (xb_ld(&bar[XB_TMO])) break; if (sp > XB_SPIN_CAP) { atomicAdd(&bar[XB_TMO], 1u); break; } }
    }
    nloc = mine > 0u ? mine : 1u; nx = cnt > 0u ? cnt : 1u;
}
__device__ __forceinline__ void xcd_barrier(const XcdBarrier& b) {
    asm volatile("s_waitcnt vmcnt(0)" ::: "memory");
    __syncthreads();
    if (threadIdx.x == 0) {
        unsigned* bar = b.bar;
        __builtin_amdgcn_s_waitcnt(0);
        unsigned nloc = b.st[0], nx = b.st[1];
        if (nloc == 0u) { xcd_barrier_complete(bar, b.x, nloc, nx); b.st[0] = nloc; b.st[1] = nx; }
        const unsigned old = xb_add(&bar[XB_XSUB(b.x)], 1u);
        const unsigned gen = old / nloc;
        if (old + 1u == (gen + 1u) * nloc) {
            __builtin_amdgcn_fence(__ATOMIC_RELEASE, "agent");
            asm volatile("s_waitcnt vmcnt(0)" ::: "memory");
            const unsigned og = xb_add(&bar[XB_TOP], 1u);
            const unsigned tg = og / nx;
            if (og + 1u == (tg + 1u) * nx) xb_add(&bar[XB_TOPGEN], 1u);
            else XB_SPIN(xb_ld(&bar[XB_TOPGEN]) == tg, bar);
            __builtin_amdgcn_fence(__ATOMIC_ACQUIRE, "agent");
            xb_add(&bar[XB_XGEN(b.x)], 1u);
            asm volatile("s_waitcnt vmcnt(0)" ::: "memory");
        } else {
            XB_SPIN(xb_ld(&bar[XB_XGEN(b.x)]) == gen, bar);
            __builtin_amdgcn_fence(__ATOMIC_ACQUIRE, "agent");
            asm volatile("s_waitcnt vmcnt(0)" ::: "memory");
        }
    }
    __syncthreads();
}

#define FOR_XCD_ITEMS(item, N) for (int _L = (int)((blockIdx.x >> 3) << 1) | VHALF, item; _L < (N) / 8 && ((item = (int)(blockIdx.x & 7) * ((N) / 8) + _L), true); _L += (int)(gridDim.x >> 2))

__device__ __forceinline__ u32x2 pack4bf(float a, float b, float c, float d) { return (u32x2){pack2bf(a, b), pack2bf(c, d)}; }
__device__ __forceinline__ u32x2 pack4bf(f32x4 v) { return (u32x2){pack2bf(v[0], v[1]), pack2bf(v[2], v[3])}; }
__device__ __forceinline__ float wave_sum(float v) {
#pragma unroll
    for (int o = 32; o > 0; o >>= 1) v += __shfl_xor(v, o);
    return v;
}

__device__ __forceinline__ void tr_tile(const float* W, long ldw, int k0, int n0, int nvalid, const float* gain, bf16_t* Wt, long ldt, int mode, char* lds) {
    float (*t)[132] = (float (*)[132])lds;
    const int tid = VTID, c4 = tid & 31, r0 = tid >> 5;
    f32x4 v[8];
#pragma unroll
    for (int i = 0; i < 8; i++) {
        const int kk = r0 + 8 * i, n = n0 + c4 * 4;
        v[i] = (n < nvalid) ? *(const f32x4*)(W + (long)(k0 + kk) * ldw + n) : (f32x4){0.f, 0.f, 0.f, 0.f};
        if (gain) v[i] *= gain[k0 + kk];
    }
    __syncthreads();
#pragma unroll
    for (int i = 0; i < 8; i++) *(f32x4*)(&t[r0 + 8 * i][c4 * 4]) = v[i];
    __syncthreads();
#pragma unroll
    for (int i = 0; i < 4; i++) {
        const int ci = tid + 256 * i, nn = ci >> 3, kc = ci & 7;
        const int n = n0 + nn;
        int row = n;
        if (mode) row = (n >> 5) * 64 + ((n >> 4) & 1) * 32 + (mode - 1) * 16 + (n & 15);
        u32x4 w;
        w.x = pack2bf(t[kc * 8 + 0][nn], t[kc * 8 + 1][nn]);
        w.y = pack2bf(t[kc * 8 + 2][nn], t[kc * 8 + 3][nn]);
        w.z = pack2bf(t[kc * 8 + 4][nn], t[kc * 8 + 5][nn]);
        w.w = pack2bf(t[kc * 8 + 6][nn], t[kc * 8 + 7][nn]);
        *(u32x4*)(Wt + (long)row * ldt + k0 + kc * 8) = w;
    }
}

__device__ __forceinline__ void phase0(const Params& p, char* lds) {
    constexpr int J_W1 = 160, J_WQ = 36, J_WKV = 32, J_WOUT = 128, J_WMQ = 128, J_WMKV = 256, J_WMO = 128, J_WG = 0, J_WU = 0, J_WD = 0;
    constexpr int J_TR = J_W1 + J_WQ + J_WKV + J_WOUT + J_WMQ + J_WMKV + J_WMO + J_WG + J_WU + J_WD;
    constexpr int J_XR = NT / 16, J_MR = 1024 / 16, J_ROPE = NT * 16 / 256, J_TAB = (4096 + 8192 + 16384 + 8192 + 32768) / 256;
    constexpr int J_ALL = J_TR + J_XR + J_MR + J_ROPE + J_TAB;
    const int tid = VTID, lane = tid & 63, wid = tid >> 6;
    const double PI2 = 6.283185307179586476925286766559;
    for (int job = VBLK; job < J_ALL; job += VGRID) {
        int j = job;
        if (j < J_TR) {
            if (j < J_W1) { tr_tile(p.w_in, INW, (j / 10) * 64, (j % 10) * 128, INW, p.g_mix, wsp<bf16_t>(p, OFF_W1T), 1024, 0, lds); continue; } j -= J_W1;
            if (j < J_WQ) { tr_tile(p.w_q_up, 768, (j / 6) * 64, (j % 6) * 128, 768, p.g_q_lat, wsp<bf16_t>(p, OFF_WQT), 384, 0, lds); continue; } j -= J_WQ;
            if (j < J_WKV) { tr_tile(p.w_kv_up, 1024, (j / 8) * 64, (j % 8) * 128, 1024, p.g_kv_lat, wsp<bf16_t>(p, OFF_WKVT), 256, 0, lds); continue; } j -= J_WKV;
            if (j < J_WOUT) { tr_tile(p.w_out, 1024, (j / 8) * 64, (j % 8) * 128, 1024, nullptr, wsp<bf16_t>(p, OFF_WOUTT), 1024, 0, lds); continue; } j -= J_WOUT;
            if (j < J_WMQ) { tr_tile(p.w_mem_q, 1024, (j / 8) * 64, (j % 8) * 128, 1024, p.g_mem_q, wsp<bf16_t>(p, OFF_WMQT), 1024, 0, lds); continue; } j -= J_WMQ;
            if (j < J_WMKV) { tr_tile(p.w_mem_kv, 2048, (j / 16) * 64, (j % 16) * 128, 2048, p.g_mem_kv, wsp<bf16_t>(p, OFF_WMKVT), 1024, 0, lds); continue; } j -= J_WMKV;
            if (j < J_WMO) { tr_tile(p.w_mem_o, 1024, (j / 8) * 64, (j % 8) * 128, 1024, nullptr, wsp<bf16_t>(p, OFF_WMOT), 1024, 0, lds); continue; } j -= J_WMO;
            if (j < J_WG) { const int e = j >> 7, r = j & 127; tr_tile(p.w_exp_gate + (long)e * 1048576, 1024, (r / 8) * 64, (r % 8) * 128, 1024, p.g_ffn, wsp<bf16_t>(p, OFF_WGUT) + (long)e * 2048 * 1024, 1024, 1, lds); continue; } j -= J_WG;
            if (j < J_WU) { const int e = j >> 7, r = j & 127; tr_tile(p.w_exp_up + (long)e * 1048576, 1024, (r / 8) * 64, (r % 8) * 128, 1024, p.g_ffn, wsp<bf16_t>(p, OFF_WGUT) + (long)e * 2048 * 1024, 1024, 2, lds); continue; } j -= J_WU;
            { const int e = j >> 7, r = j & 127; tr_tile(p.w_exp_down + (long)e * 1048576, 1024, (r / 8) * 64, (r % 8) * 128, 1024, nullptr, wsp<bf16_t>(p, OFF_WDT) + (long)e * 1048576, 1024, 0, lds); continue; }
        }
        j -= J_TR;
        if (j < J_XR + J_MR) {
            const bool isx = j < J_XR;
            const int row0 = (isx ? j : j - J_XR) * 16 + wid * 4;
            const float* src = (isx ? p.x : p.mem) + (long)row0 * ND;
            bf16_t* dst = (isx ? wsp<bf16_t>(p, OFF_XB) : wsp<bf16_t>(p, OFF_MEMB)) + (long)row0 * ND;
            f32x4 v[4][4];
#pragma unroll
            for (int r = 0; r < 4; r++)
#pragma unroll
                for (int i = 0; i < 4; i++) v[r][i] = *(const f32x4*)(src + (long)r * ND + i * 256 + lane * 4);
#pragma unroll
            for (int r = 0; r < 4; r++) {
                float ss = 0.f;
#pragma unroll
                for (int i = 0; i < 4; i++) {
                    ss += v[r][i][0] * v[r][i][0] + v[r][i][1] * v[r][i][1] + v[r][i][2] * v[r][i][2] + v[r][i][3] * v[r][i][3];
                    *(u32x2*)(dst + (long)r * ND + i * 256 + lane * 4) = pack4bf(v[r][i]);
                }
                ss = wave_sum(ss);
                if (lane == 0) (isx ? wsp<float>(p, OFF_R0) : wsp<float>(p, OFF_RMEM))[row0 + r] = rsqrtf(ss * (1.f / ND) + 1e-6f);
            }
            continue;
        }
        j -= J_XR + J_MR;
        if (j < J_ROPE) {
            const int i = j * 256 + tid; const int t = i >> 4, jj = i & 15;
            const double f = pow(10000.0, -(double)(2 * jj) / 32.0);
            const double ang = (double)p.pos[t] * f;
            wsp<float2>(p, OFF_ROPE)[i] = make_float2((float)cos(ang), (float)sin(ang));
            continue;
        }
        j -= J_ROPE;
        {
            int i = j * 256 + tid;
            if (i < 4096) { const double a = PI2 * (double)i / 4096.0; wsp<float2>(p, OFF_TW)[i] = make_float2((float)cos(a), (float)sin(a)); continue; } i -= 4096;
            if (i < 8192) {
                const int T = i >> 12, a = (i >> 6) & 63, b = i & 63;
                const double th = PI2 * (double)((a * b) & 63) / 64.0;
                wsp<bf16_t>(p, OFF_T64)[i] = (bf16_t)f2bf((float)(T ? sin(th) : cos(th))); continue;
            } i -= 8192;
            if (i < 16384) {
                const int rho = i >> 7, k = i & 127;
                const int wm = rho >> 6, mi = (rho >> 4) & 3, lr = rho & 15, ri = mi >> 1, k1 = 32 * wm + 16 * (mi & 1) + lr, ab = k >> 6, s1 = k & 63;
                const double th = PI2 * (double)((k1 * s1) & 63) / 64.0;
                const double c = cos(th), s = sin(th);
                const double v = ri == 0 ? (ab == 0 ? c : -s) : (ab == 0 ? s : c);
                wsp<bf16_t>(p, OFF_M1)[i] = (bf16_t)f2bf((float)v); continue;
            } i -= 16384;
            if (i < 8192) {
                const int k2 = i >> 7, k = i & 127, s2 = k & 63;
                const double th = PI2 * (double)((k2 * s2) & 63) / 64.0;
                wsp<bf16_t>(p, OFF_M3)[i] = (bf16_t)f2bf((float)(k < 64 ? cos(th) : -sin(th))); continue;
            } i -= 8192;
            if (i < 32768) {
                const int g = i >> 12, e = (i >> 6) & 63, ch = i & 63;
                wsp<bf16_t>(p, OFF_WFT)[i] = (bf16_t)f2bf(p.w_fourier[(g * 64 + ch) * 64 + e]); continue;
            }
        }
    }
}

#define FOR_XCD_ITEMS_R(item, N) for (int _L = (int)(blockIdx.x >> 3), item; _L < (N) / 8 && ((item = (int)(blockIdx.x & 7) * ((N) / 8) + _L), true); _L += (int)(gridDim.x >> 3))
__device__ __forceinline__ void gemm_tile_256sq(const GemmTile& g, char* lds, f32x4 (&acc)[8][4]) {
    const int tid = threadIdx.x, lane = tid & 63, wid = tid >> 6, wm = wid >> 2, wn = wid & 3;
    const int lrow = lane >> 3, pc = lane & 7;
    const bf16_t* ap[4]; const bf16_t* bp[4];
#pragma unroll
    for (int i = 0; i < 4; i++) {
        const int r = (wid * 4 + i) * 8 + lrow;
        const int c = pc ^ ((r >> 1) & 7);
        const long ro = g.arow ? (long)g.arow[r] * g.lda : (long)r * g.lda;
        ap[i] = g.A + ro + c * 8;
        bp[i] = g.Bt + (long)r * g.ldb + c * 8;
    }
#pragma unroll
    for (int mi = 0; mi < 8; mi++)
#pragma unroll
        for (int ni = 0; ni < 4; ni++) acc[mi][ni] = (f32x4){0.f, 0.f, 0.f, 0.f};
    const int nk = g.K >> 6;
    auto stage = [&](int kt, char* st) {
#pragma unroll
        for (int i = 0; i < 4; i++) {
            __builtin_amdgcn_global_load_lds((const unsigned*)(ap[i] + kt * 64), (unsigned*)(st + (wid * 4 + i) * 1024), 16, 0, 0);
            __builtin_amdgcn_global_load_lds((const unsigned*)(bp[i] + kt * 64), (unsigned*)(st + 32768 + (wid * 4 + i) * 1024), 16, 0, 0);
        }
    };
    __syncthreads();
    stage(0, lds);
    asm volatile("s_waitcnt vmcnt(0)" ::: "memory");
    __syncthreads();
    for (int kt = 0; kt < nk; kt++) {
        char* cur = lds + (kt & 1) * 65536;
        if (kt + 1 < nk) stage(kt + 1, lds + ((kt + 1) & 1) * 65536);
#pragma unroll
        for (int ks = 0; ks < 2; ks++) {
            bf16x8 af[8], bfr[4];
#pragma unroll
            for (int i = 0; i < 8; i++) af[i] = *(const bf16x8*)(cur + tile_off(wm * 128 + i * 16 + (lane & 15), ks * 4 + (lane >> 4)));
#pragma unroll
            for (int i = 0; i < 4; i++) bfr[i] = *(const bf16x8*)(cur + 32768 + tile_off(wn * 64 + i * 16 + (lane & 15), ks * 4 + (lane >> 4)));
            __builtin_amdgcn_s_setprio(1);
#pragma unroll
            for (int mi = 0; mi < 8; mi++)
#pragma unroll
                for (int ni = 0; ni < 4; ni++)
                    acc[mi][ni] = __builtin_amdgcn_mfma_f32_16x16x32_bf16(bfr[ni], af[mi], acc[mi][ni], 0, 0, 0);
            __builtin_amdgcn_s_setprio(0);
        }
        asm volatile("s_waitcnt vmcnt(0)" ::: "memory");
        __syncthreads();
    }
}


__device__ __forceinline__ void gemm_tile_256x128(const GemmTile& g, char* lds, f32x4 (&acc)[4][4]) {
    const int tid = threadIdx.x, lane = tid & 63, wid = tid >> 6, wm = wid >> 1, wn = wid & 1;
    const int lrow = lane >> 3, pc = lane & 7;
    const bf16_t* ap[4]; const bf16_t* bp[2];
#pragma unroll
    for (int i = 0; i < 4; i++) {
        const int r = (wid * 4 + i) * 8 + lrow;
        const int c = pc ^ ((r >> 1) & 7);
        const long ro = g.arow ? (long)g.arow[r] * g.lda : (long)r * g.lda;
        ap[i] = g.A + ro + c * 8;
    }
#pragma unroll
    for (int i = 0; i < 2; i++) {
        const int r = (wid * 2 + i) * 8 + lrow;
        const int c = pc ^ ((r >> 1) & 7);
        bp[i] = g.Bt + (long)r * g.ldb + c * 8;
    }
#pragma unroll
    for (int mi = 0; mi < 4; mi++)
#pragma unroll
        for (int ni = 0; ni < 4; ni++) acc[mi][ni] = (f32x4){0.f, 0.f, 0.f, 0.f};
    const int nk = g.K >> 6;
    auto stage = [&](int kt, char* st) {
#pragma unroll
        for (int i = 0; i < 4; i++)
            __builtin_amdgcn_global_load_lds((const unsigned*)(ap[i] + kt * 64), (unsigned*)(st + (wid * 4 + i) * 1024), 16, 0, 0);
#pragma unroll
        for (int i = 0; i < 2; i++)
            __builtin_amdgcn_global_load_lds((const unsigned*)(bp[i] + kt * 64), (unsigned*)(st + 32768 + (wid * 2 + i) * 1024), 16, 0, 0);
    };
    __syncthreads();
    stage(0, lds);
    asm volatile("s_waitcnt vmcnt(0)" ::: "memory");
    __syncthreads();
    for (int kt = 0; kt < nk; kt++) {
        char* cur = lds + (kt & 1) * 49152;
        if (kt + 1 < nk) stage(kt + 1, lds + ((kt + 1) & 1) * 49152);
        bf16x8 af[2][4], bfr[2][4];
#pragma unroll
        for (int ks = 0; ks < 2; ks++)
#pragma unroll
            for (int i = 0; i < 4; i++) {
                af[ks][i] = *(const bf16x8*)(cur + tile_off(wm * 64 + i * 16 + (lane & 15), ks * 4 + (lane >> 4)));
                bfr[ks][i] = *(const bf16x8*)(cur + 32768 + tile_off(wn * 64 + i * 16 + (lane & 15), ks * 4 + (lane >> 4)));
            }
        __builtin_amdgcn_s_setprio(1);
#pragma unroll
        for (int ks = 0; ks < 2; ks++)
#pragma unroll
            for (int mi = 0; mi < 4; mi++)
#pragma unroll
                for (int ni = 0; ni < 4; ni++)
                    acc[mi][ni] = __builtin_amdgcn_mfma_f32_16x16x32_bf16(bfr[ks][ni], af[ks][mi], acc[mi][ni], 0, 0, 0);
        __builtin_amdgcn_s_setprio(0);
        asm volatile("s_waitcnt vmcnt(0)" ::: "memory");
        __syncthreads();
    }
}

template <class Setup, class Epi>
__device__ __forceinline__ void gemm_256x128_stream(int nitems, char* lds, Setup setup, Epi epi) {
    const int tid = threadIdx.x, lane = tid & 63, wid = tid >> 6, wm = wid >> 1, wn = wid & 1;
    const int lrow = lane >> 3, pc = lane & 7;
    const int LN = nitems / 8, LS = (int)(gridDim.x >> 3), xb = (int)(blockIdx.x & 7) * LN;
    int L = (int)(blockIdx.x >> 3);
    if (L >= LN) return;
    const bf16_t* ap[4]; const bf16_t* bp[2];
    auto setptr = [&](const GemmTile& g) {
#pragma unroll
        for (int i = 0; i < 4; i++) {
            const int r = (wid * 4 + i) * 8 + lrow;
            const int c = pc ^ ((r >> 1) & 7);
            ap[i] = g.A + (long)r * g.lda + c * 8;
        }
#pragma unroll
        for (int i = 0; i < 2; i++) {
            const int r = (wid * 2 + i) * 8 + lrow;
            const int c = pc ^ ((r >> 1) & 7);
            bp[i] = g.Bt + (long)r * g.ldb + c * 8;
        }
    };
    auto stage = [&](int kt, char* st) {
#pragma unroll
        for (int i = 0; i < 4; i++)
            __builtin_amdgcn_global_load_lds((const unsigned*)(ap[i] + kt * 64), (unsigned*)(st + (wid * 4 + i) * 1024), 16, 0, 0);
#pragma unroll
        for (int i = 0; i < 2; i++)
            __builtin_amdgcn_global_load_lds((const unsigned*)(bp[i] + kt * 64), (unsigned*)(st + 32768 + (wid * 2 + i) * 1024), 16, 0, 0);
    };
    GemmTile g; g.arow = nullptr;
    setup(xb + L, g);
    const int nk = g.K >> 6;
    setptr(g);
    __syncthreads();
    stage(0, lds);
    asm volatile("s_waitcnt vmcnt(0)" ::: "memory");
    __syncthreads();
    int q = 0;
    for (; L < LN; L += LS) {
        f32x4 acc[4][4];
#pragma unroll
        for (int mi = 0; mi < 4; mi++)
#pragma unroll
            for (int ni = 0; ni < 4; ni++) acc[mi][ni] = (f32x4){0.f, 0.f, 0.f, 0.f};
        for (int kt = 0; kt < nk; kt++, q++) {
            char* cur = lds + (q & 1) * 49152;
            char* nxt = lds + ((q + 1) & 1) * 49152;
            if (kt + 1 < nk) stage(kt + 1, nxt);
            else if (L + LS < LN) { setup(xb + L + LS, g); setptr(g); stage(0, nxt); }
            bf16x8 af[2][4], bfr[2][4];
#pragma unroll
            for (int ks = 0; ks < 2; ks++)
#pragma unroll
                for (int i = 0; i < 4; i++) {
                    af[ks][i] = *(const bf16x8*)(cur + tile_off(wm * 64 + i * 16 + (lane & 15), ks * 4 + (lane >> 4)));
                    bfr[ks][i] = *(const bf16x8*)(cur + 32768 + tile_off(wn * 64 + i * 16 + (lane & 15), ks * 4 + (lane >> 4)));
                }
            __builtin_amdgcn_s_setprio(1);
#pragma unroll
            for (int ks = 0; ks < 2; ks++)
#pragma unroll
                for (int mi = 0; mi < 4; mi++)
#pragma unroll
                    for (int ni = 0; ni < 4; ni++)
                        acc[mi][ni] = __builtin_amdgcn_mfma_f32_16x16x32_bf16(bfr[ks][ni], af[ks][mi], acc[mi][ni], 0, 0, 0);
            __builtin_amdgcn_s_setprio(0);
            asm volatile("s_waitcnt vmcnt(0)" ::: "memory");
            __syncthreads();
        }
        epi(xb + L, acc);
    }
}


__device__ __forceinline__ void phase1(const Params& p, char* lds) {
    const int tid = threadIdx.x, lane = tid & 63, wid = tid >> 6, wm = wid >> 1, wn = wid & 1, lq = lane >> 4, lr = lane & 15;
    constexpr int N_U = 64 * 2, N_M = 4 * 16;
    {
      gemm_256x128_stream(N_U, lds, [&](int item, GemmTile& g) {
            const int tm = item >> 1, tn = 8 + (item & 1);
            g.A = wsp<bf16_t>(p, OFF_XB) + (long)tm * 256 * ND; g.lda = ND;
            g.Bt = wsp<bf16_t>(p, OFF_W1T) + (long)tn * 128 * ND; g.ldb = ND; g.K = ND;
        }, [&](int item, f32x4 (&acc)[4][4]) {
            const int tm = item >> 1, tn = 8 + (item & 1);
            const float* r0 = wsp<float>(p, OFF_R0);
#pragma unroll
            for (int mi = 0; mi < 4; mi++) {
                const int row = tm * 256 + wm * 64 + mi * 16 + lr;
                const float rs = r0[row];
#pragma unroll
                for (int ni = 0; ni < 4; ni++) acc[mi][ni] *= rs;
                if (tn < 4) {
#pragma unroll
                    for (int ni = 0; ni < 4; ni++)
                        *(u32x2*)(wsp<bf16_t>(p, OFF_UF) + (long)row * 512 + tn * 128 + wn * 64 + ni * 16 + 4 * lq) = pack4bf(acc[mi][ni]);
                } else if (tn < 9) {
                    float ss = 0.f;
#pragma unroll
                    for (int ni = 0; ni < 4; ni++) { const f32x4 v = acc[mi][ni]; ss += v[0] * v[0] + v[1] * v[1] + v[2] * v[2] + v[3] * v[3]; }
                    ss += __shfl_xor(ss, 16); ss += __shfl_xor(ss, 32);
                    if (tn < 7) {
#pragma unroll
                        for (int ni = 0; ni < 4; ni++)
                            *(u32x2*)(wsp<bf16_t>(p, OFF_UQ) + (long)row * 384 + (tn - 4) * 128 + wn * 64 + ni * 16 + 4 * lq) = pack4bf(acc[mi][ni]);
                        if (lq == 0) wsp<float>(p, OFF_SSQ)[row * 6 + (tn - 4) * 2 + wn] = ss;
                    } else {
#pragma unroll
                        for (int ni = 0; ni < 4; ni++)
                            *(u32x2*)(wsp<bf16_t>(p, OFF_UKV) + (long)row * 256 + (tn - 7) * 128 + wn * 64 + ni * 16 + 4 * lq) = pack4bf(acc[mi][ni]);
                        if (lq == 0) wsp<float>(p, OFF_SSKV)[row * 4 + (tn - 7) * 2 + wn] = ss;
                    }
                } else if (wn == 0) {
                    const float2* rp = wsp<float2>(p, OFF_ROPE) + (long)row * 16 + 4 * lq;
                    f32x4 o1, o2;
#pragma unroll
                    for (int r = 0; r < 4; r++) {
                        const float2 cs = rp[r];
                        const float x1 = acc[mi][0][r], x2 = acc[mi][1][r];
                        o1[r] = x1 * cs.x - x2 * cs.y; o2[r] = x1 * cs.y + x2 * cs.x;
                    }
                    bf16_t* kr = wsp<bf16_t>(p, OFF_KR) + (long)row * 32;
                    *(u32x2*)(kr + 4 * lq) = pack4bf(o1);
                    *(u32x2*)(kr + 16 + 4 * lq) = pack4bf(o2);
                }
            }
        });
      gemm_256x128_stream(N_M, lds, [&](int it, GemmTile& g) {
            const int tm = it / 16, tn = it % 16;
            g.A = wsp<bf16_t>(p, OFF_MEMB) + (long)tm * 256 * ND; g.lda = ND;
            g.Bt = wsp<bf16_t>(p, OFF_WMKVT) + (long)tn * 128 * ND; g.ldb = ND; g.K = ND;
        }, [&](int it, f32x4 (&acc)[4][4]) {
            const int tm = it / 16, tn = it % 16;
            const float* rm = wsp<float>(p, OFF_RMEM);
#pragma unroll
            for (int mi = 0; mi < 4; mi++) {
                const int row = tm * 256 + wm * 64 + mi * 16 + lr;
                const int b = row >> 8, m = row & 255;
                const float rs = rm[row];
#pragma unroll
                for (int ni = 0; ni < 4; ni++) {
                    const f32x4 v = acc[mi][ni] * rs;
                    const int col = tn * 128 + wn * 64 + ni * 16 + 4 * lq;
                    if (col < 1024) {
                        const int h = col >> 8, d = col & 255;
                        *(u32x2*)(wsp<bf16_t>(p, OFF_KMEM) + ((long)(b * 4 + h) * 256 + m) * 256 + d) = pack4bf(v);
                    } else {
                        const int c2 = col - 1024, h = c2 >> 8, dv = c2 & 255;
                        bf16_t* vt = wsp<bf16_t>(p, OFF_VTMEM) + ((long)(b * 4 + h) * 256 + dv) * 256 + m;
#pragma unroll
                        for (int r = 0; r < 4; r++) vt[r * 256] = (bf16_t)f2bf(v[r]);
                    }
                }
            }
        });
    }
}

template <int MI>
__device__ __forceinline__ void dft_mma(const bf16_t* Ag, int arow0, const char* ximg, int ncol0, f32x4 (&acc)[MI][4]) {
    const int lane = VTID & 63, lq = lane >> 4, lr = lane & 15;
#pragma unroll
    for (int ks = 0; ks < 4; ks++) {
        bf16x8 af[MI], bfr[4];
#pragma unroll
        for (int mi = 0; mi < MI; mi++) af[mi] = *(const bf16x8*)(Ag + (long)(arow0 + mi * 16 + lr) * 128 + ks * 32 + lq * 8);
#pragma unroll
        for (int ni = 0; ni < 4; ni++) {
            const char* bp = ximg + (ks * 32 + lq * 8) * 272 + (ncol0 + ni * 16 + lr) * 2;
#pragma unroll
            for (int j = 0; j < 8; j++) bfr[ni][j] = *(const short*)(bp + j * 272);
        }
#pragma unroll
        for (int mi = 0; mi < MI; mi++)
#pragma unroll
            for (int ni = 0; ni < 4; ni++) acc[mi][ni] = __builtin_amdgcn_mfma_f32_16x16x32_bf16(bfr[ni], af[mi], acc[mi][ni], 0, 0, 0);
    }
}

__device__ __forceinline__ void f2a_item(const Params& p, int it, char* lds) {
    const int tid = VTID, lane = tid & 63, wid = tid >> 6, wm = wid >> 1, wn = wid & 1, lq = lane >> 4, lr = lane & 15;
    const int nc = it & 3, s2 = (it >> 2) & 63, b = it >> 8;
    char* uimg = lds; char* ximg = lds + 17408;
    __syncthreads();
#pragma unroll
    for (int i = 0; i < 4; i++) {
        const int ci = tid + 256 * i, row = ci >> 4, cc = ci & 15;
        *(u32x4*)(uimg + row * 272 + cc * 16) = *(const u32x4*)(wsp<bf16_t>(p, OFF_UF) + ((long)(b * NS + 64 * row + s2)) * 512 + nc * 128 + cc * 8);
    }
    __syncthreads();
    {
        const int g2 = wid >> 1, T = wid & 1;
        f32x4 a1[4][4];
#pragma unroll
        for (int mi = 0; mi < 4; mi++)
#pragma unroll
            for (int ni = 0; ni < 4; ni++) a1[mi][ni] = (f32x4){0.f, 0.f, 0.f, 0.f};
        const bf16_t* t64 = wsp<bf16_t>(p, OFF_T64) + T * 4096;
#pragma unroll
        for (int ks = 0; ks < 2; ks++) {
            bf16x8 af[4], bfr[4];
#pragma unroll
            for (int i = 0; i < 4; i++) {
                af[i] = *(const bf16x8*)(uimg + (i * 16 + lr) * 272 + (g2 * 64 + ks * 32 + lq * 8) * 2);
                bfr[i] = *(const bf16x8*)(t64 + (i * 16 + lr) * 64 + ks * 32 + lq * 8);
            }
#pragma unroll
            for (int mi = 0; mi < 4; mi++)
#pragma unroll
                for (int ni = 0; ni < 4; ni++) a1[mi][ni] = __builtin_amdgcn_mfma_f32_16x16x32_bf16(bfr[ni], af[mi], a1[mi][ni], 0, 0, 0);
        }
#pragma unroll
        for (int mi = 0; mi < 4; mi++)
#pragma unroll
            for (int ni = 0; ni < 4; ni++)
                *(u32x2*)(ximg + (T * 64 + mi * 16 + lr) * 272 + (g2 * 64 + ni * 16 + 4 * lq) * 2) = pack4bf(a1[mi][ni]);
    }
    __syncthreads();
    f32x4 acc[4][4];
#pragma unroll
    for (int mi = 0; mi < 4; mi++)
#pragma unroll
        for (int ni = 0; ni < 4; ni++) acc[mi][ni] = (f32x4){0.f, 0.f, 0.f, 0.f};
    dft_mma<4>(wsp<bf16_t>(p, OFF_M1), wm * 64, ximg, wn * 64, acc);
    const float2* tw = wsp<float2>(p, OFF_TW);
#pragma unroll
    for (int m2 = 0; m2 < 2; m2++) {
        const int k1 = 32 * wm + 16 * m2 + lr;
        float2 cs; { const float rev = (float)((s2 * k1) & 4095) * (1.0f / 4096.0f); cs.x = __builtin_amdgcn_cosf(rev); cs.y = __builtin_amdgcn_sinf(rev); (void)tw; }
        const long base = ((long)(b * 64 + k1) * 64 + s2) * 512 + nc * 128 + wn * 64 + 4 * lq;
#pragma unroll
        for (int ni = 0; ni < 4; ni++) {
            const f32x4 yr = acc[m2][ni], yi = acc[m2 + 2][ni];
            const f32x4 orr = yr * cs.x - yi * cs.y, oi = yi * cs.x + yr * cs.y;
            *(u32x2*)(wsp<bf16_t>(p, OFF_YR) + base + ni * 16) = pack4bf(orr);
            *(u32x2*)(wsp<bf16_t>(p, OFF_YI) + base + ni * 16) = pack4bf(oi);
        }
    }
}

__device__ __forceinline__ void f2b_item(const Params& p, int it, char* lds) {
    const int tid = VTID, lane = tid & 63, wid = tid >> 6, wm = wid >> 1, wn = wid & 1, lq = lane >> 4, lr = lane & 15;
    const int nc = it & 3, k1 = (it >> 2) & 63, b = it >> 8;
    char* ximg = lds; char* zimg = lds + 34816;
    __syncthreads();
#pragma unroll
    for (int i = 0; i < 8; i++) {
        const int ci = tid + 256 * i, row = ci >> 4, cc = ci & 15;
        const bf16_t* src = (row < 64 ? wsp<bf16_t>(p, OFF_YR) : wsp<bf16_t>(p, OFF_YI)) + ((long)(b * 64 + k1) * 64 + (row & 63)) * 512 + nc * 128 + cc * 8;
        *(u32x4*)(ximg + row * 272 + cc * 16) = *(const u32x4*)src;
    }
    __syncthreads();
    f32x4 acc[2][4];
#pragma unroll
    for (int mi = 0; mi < 2; mi++)
#pragma unroll
        for (int ni = 0; ni < 4; ni++) acc[mi][ni] = (f32x4){0.f, 0.f, 0.f, 0.f};
    dft_mma<2>(wsp<bf16_t>(p, OFF_M3), wm * 32, ximg, wn * 64, acc);
#pragma unroll
    for (int mi = 0; mi < 2; mi++)
#pragma unroll
        for (int ni = 0; ni < 4; ni++)
            *(u32x2*)(zimg + (wm * 32 + mi * 16 + lr) * 272 + (wn * 64 + ni * 16 + 4 * lq) * 2) = pack4bf(acc[mi][ni] * (1.0f / 512.0f));
    __syncthreads();
    f32x4 a3[2][4];
#pragma unroll
    for (int mi = 0; mi < 2; mi++)
#pragma unroll
        for (int ni = 0; ni < 4; ni++) a3[mi][ni] = (f32x4){0.f, 0.f, 0.f, 0.f};
    const bf16_t* wft = wsp<bf16_t>(p, OFF_WFT) + (long)(nc * 2 + wn) * 4096;
#pragma unroll
    for (int ks = 0; ks < 2; ks++) {
        bf16x8 af[2], bfr[4];
#pragma unroll
        for (int i = 0; i < 2; i++) af[i] = *(const bf16x8*)(zimg + (wm * 32 + i * 16 + lr) * 272 + (wn * 64 + ks * 32 + lq * 8) * 2);
#pragma unroll
        for (int i = 0; i < 4; i++) bfr[i] = *(const bf16x8*)(wft + (i * 16 + lr) * 64 + ks * 32 + lq * 8);
#pragma unroll
        for (int mi = 0; mi < 2; mi++)
#pragma unroll
            for (int ni = 0; ni < 4; ni++) a3[mi][ni] = __builtin_amdgcn_mfma_f32_16x16x32_bf16(bfr[ni], af[mi], a3[mi][ni], 0, 0, 0);
    }
#pragma unroll
    for (int mi = 0; mi < 2; mi++) {
        const int k2 = wm * 32 + mi * 16 + lr;
        bf16_t* dst = wsp<bf16_t>(p, OFF_ZA) + ((long)(b * NS + k1 + 64 * k2)) * 1024 + nc * 128 + wn * 64 + 4 * lq;
#pragma unroll
        for (int ni = 0; ni < 4; ni++) *(u32x2*)(dst + ni * 16) = pack4bf(a3[mi][ni]);
    }
}

__device__ __forceinline__ void phase2(const Params& p, char* lds) {
    const int tid = threadIdx.x, lane = tid & 63, wid = tid >> 6, wm = wid >> 1, wn = wid & 1, lq = lane >> 4, lr = lane & 15;
    constexpr int N_Q = 64 * 6, N_KV = 64 * 8;
    {
      gemm_256x128_stream(N_Q, lds, [&](int item, GemmTile& g) {
            const int tm = item / 6, tn = item % 6;
            g.A = wsp<bf16_t>(p, OFF_UQ) + (long)tm * 256 * 384; g.lda = 384;
            g.Bt = wsp<bf16_t>(p, OFF_WQT) + (long)tn * 128 * 384; g.ldb = 384; g.K = 384;
        }, [&](int item, f32x4 (&acc)[4][4]) {
            const int tm = item / 6, tn = item % 6;
            const float qmul = 0.10206207261596575f * 1.4426950408889634f;
#pragma unroll
            for (int mi = 0; mi < 4; mi++) {
                const int row = tm * 256 + wm * 64 + mi * 16 + lr;
                const int b = row >> 12, s = row & 4095;
                const float* sq = wsp<float>(p, OFF_SSQ) + (long)row * 6;
                const float ss = sq[0] + sq[1] + sq[2] + sq[3] + sq[4] + sq[5];
                const float rs = rsqrtf(ss * (1.f / 384.f) + 1e-6f) * qmul;
                const int cb0 = tn * 128 + wn * 64;
#pragma unroll
                for (int ni = 0; ni < 4; ni++) {
                    const int cb = cb0 + ni * 16, hd = cb / 96, hob = cb % 96;
                    bf16_t* qd = wsp<bf16_t>(p, OFF_Q) + ((long)(b * 8 + hd) * NS + s) * 96;
                    if (hob < 64) {
                        *(u32x2*)(qd + hob + 4 * lq) = pack4bf(acc[mi][ni] * rs);
                    } else if (hob == 64) {
                        if (ni < 3) {
                            const float2* rp = wsp<float2>(p, OFF_ROPE) + (long)row * 16 + 4 * lq;
                            f32x4 o1, o2;
#pragma unroll
                            for (int r = 0; r < 4; r++) {
                                const float2 cs = rp[r];
                                const float x1 = acc[mi][ni][r] * rs, x2 = acc[mi][ni < 3 ? ni + 1 : 3][r] * rs;
                                o1[r] = x1 * cs.x - x2 * cs.y; o2[r] = x1 * cs.y + x2 * cs.x;
                            }
                            *(u32x2*)(qd + 64 + 4 * lq) = pack4bf(o1);
                            *(u32x2*)(qd + 80 + 4 * lq) = pack4bf(o2);
                        }
                    }
                }
            }
        });
      gemm_256x128_stream(N_KV, lds, [&](int it, GemmTile& g) {
            const int tm = it >> 3, hd = it & 7;
            g.A = wsp<bf16_t>(p, OFF_UKV) + (long)tm * 256 * 256; g.lda = 256;
            g.Bt = wsp<bf16_t>(p, OFF_WKVT) + (long)hd * 128 * 256; g.ldb = 256; g.K = 256;
        }, [&](int it, f32x4 (&acc)[4][4]) {
            const int tm = it >> 3, hd = it & 7;
#pragma unroll
            for (int mi = 0; mi < 4; mi++) {
                const int row = tm * 256 + wm * 64 + mi * 16 + lr;
                const int b = row >> 12, s = row & 4095;
                const float* sq = wsp<float>(p, OFF_SSKV) + (long)row * 4;
                const float rs = rsqrtf((sq[0] + sq[1] + sq[2] + sq[3]) * (1.f / 256.f) + 1e-6f);
                if (wn == 0) {
                    bf16_t* kd = wsp<bf16_t>(p, OFF_K) + ((long)(b * 8 + hd) * NS + s) * 96;
#pragma unroll
                    for (int ni = 0; ni < 4; ni++) *(u32x2*)(kd + ni * 16 + 4 * lq) = pack4bf(acc[mi][ni] * rs);
                } else {
#pragma unroll
                    for (int ni = 0; ni < 4; ni++) {
                        bf16_t* vd = wsp<bf16_t>(p, OFF_VT) + ((long)(b * 8 + hd) * 64 + ni * 16 + 4 * lq) * NS + s;
#pragma unroll
                        for (int r = 0; r < 4; r++) vd[(long)r * NS] = (bf16_t)f2bf(acc[mi][ni][r] * rs);
                    }
                }
            }
#pragma unroll
            for (int i = 0; i < 2; i++) {
                const int ci = tid + 512 * i, r = ci >> 2, cc = ci & 3;
                const int row = tm * 256 + r, b = row >> 12, s = row & 4095;
                *(u32x4*)(wsp<bf16_t>(p, OFF_K) + ((long)(b * 8 + hd) * NS + s) * 96 + 64 + cc * 8) = *(const u32x4*)(wsp<bf16_t>(p, OFF_KR) + (long)row * 32 + cc * 8);
            }
        });
    }
}


__device__ __forceinline__ void phase2_f2a(const Params& p, char* lds) {
    FOR_XCD_ITEMS(it, 1024) { f2a_item(p, it, lds); }
}

__device__ __forceinline__ void expert_tr_job(const Params& p, int j, char* lds) {
    const int which = j >> 11, r = j & 2047, e = r >> 7, t = r & 127;
    const int k0 = (t >> 3) * 64, n0 = (t & 7) * 128;
    if (which == 0) tr_tile(p.w_exp_gate + (long)e * 1048576, 1024, k0, n0, 1024, p.g_ffn, wsp<bf16_t>(p, OFF_WGUT) + (long)e * 2048 * 1024, 1024, 1, lds);
    else if (which == 1) tr_tile(p.w_exp_up + (long)e * 1048576, 1024, k0, n0, 1024, p.g_ffn, wsp<bf16_t>(p, OFF_WGUT) + (long)e * 2048 * 1024, 1024, 2, lds);
    else tr_tile(p.w_exp_down + (long)e * 1048576, 1024, k0, n0, 1024, nullptr, wsp<bf16_t>(p, OFF_WDT) + (long)e * 1048576, 1024, 0, lds);
}

__device__ __forceinline__ void phase3_tr(const Params& p, char* lds) {
    for (int j = VBLK; j < 6144; j += VGRID) expert_tr_job(p, j, lds);
}
__device__ __forceinline__ void phase3_f2b(const Params& p, char* lds) {
    FOR_XCD_ITEMS(it, 1024) { f2b_item(p, it, lds); }
}

__device__ __forceinline__ void phase_resid(const Params& p, char* lds, size_t offA, size_t offW, const float* residf, const bf16_t* residb, size_t offXb, size_t offSS) {
    const int tid = VTID, lane = tid & 63, wid = tid >> 6, wm = wid >> 1, wn = wid & 1, lq = lane >> 4, lr = lane & 15;
    FOR_XCD_ITEMS(item, 128 * 8) {
        const int tm = item >> 3, tn = item & 7;
        f32x4 acc[4][4];
        GemmTile g; g.A = wsp<bf16_t>(p, offA) + (long)tm * 128 * ND; g.lda = ND; g.arow = nullptr;
        g.Bt = wsp<bf16_t>(p, offW) + (long)tn * 128 * ND; g.ldb = ND; g.K = ND;
        gemm_tile_128(g, lds, acc);
#pragma unroll
        for (int mi = 0; mi < 4; mi++) {
            const int row = tm * 128 + wm * 64 + mi * 16 + lr;
            float ss = 0.f;
#pragma unroll
            for (int ni = 0; ni < 4; ni++) {
                const long o = (long)row * ND + tn * 128 + wn * 64 + ni * 16 + 4 * lq;
                f32x4 rv;
                if (residf) rv = *(const f32x4*)(residf + o);
                else { const u32x2 w = *(const u32x2*)(residb + o); rv = (f32x4){__uint_as_float(w.x << 16), __uint_as_float(w.x & 0xFFFF0000u), __uint_as_float(w.y << 16), __uint_as_float(w.y & 0xFFFF0000u)}; }
                const f32x4 v = rv + acc[mi][ni];
                *(u32x2*)(wsp<bf16_t>(p, offXb) + o) = pack4bf(v);
                ss += v[0] * v[0] + v[1] * v[1] + v[2] * v[2] + v[3] * v[3];
            }
            ss += __shfl_xor(ss, 16); ss += __shfl_xor(ss, 32);
            if (lq == 0) wsp<float>(p, offSS)[row * 16 + tn * 2 + wn] = ss;
        }
    }
}
__device__ __forceinline__ float row_rs16(const float* ss) {
    const f32x4 a = *(const f32x4*)ss, b = *(const f32x4*)(ss + 4), c = *(const f32x4*)(ss + 8), d = *(const f32x4*)(ss + 12);
    const f32x4 t = (a + b) + (c + d);
    return rsqrtf(((t[0] + t[1]) + (t[2] + t[3])) * (1.f / 1024.f) + 1e-6f);
}

__device__ __forceinline__ void phase5a(const Params& p, char* lds) {
    const int tid = VTID, lane = tid & 63, wid = tid >> 6, wm = wid >> 1, wn = wid & 1, lq = lane >> 4, lr = lane & 15;
    FOR_XCD_ITEMS(item, 128 * 8) {
        const int tm = item >> 3, tn = item & 7;
        f32x4 acc[4][4];
        GemmTile g; g.A = wsp<bf16_t>(p, OFF_X1B) + (long)tm * 128 * ND; g.lda = ND; g.arow = nullptr;
        g.Bt = wsp<bf16_t>(p, OFF_WMQT) + (long)tn * 128 * ND; g.ldb = ND; g.K = ND;
        gemm_tile_128(g, lds, acc);
        const int h = tn >> 1;
#pragma unroll
        for (int mi = 0; mi < 4; mi++) {
            const int row = tm * 128 + wm * 64 + mi * 16 + lr, b = row >> 12, s = row & 4095;
            const float rs = row_rs16(wsp<float>(p, OFF_SS1) + (long)row * 16) * (0.0625f * 1.4426950408889634f);
            bf16_t* qd = wsp<bf16_t>(p, OFF_QM) + ((long)(b * 4 + h) * NS + s) * 256 + (tn & 1) * 128 + wn * 64 + 4 * lq;
#pragma unroll
            for (int ni = 0; ni < 4; ni++) *(u32x2*)(qd + ni * 16) = pack4bf(acc[mi][ni] * rs);
        }
    }
}
__device__ __forceinline__ void phase5b(const Params& p, char* lds) {
    FOR_XCD_ITEMS(item, NB * 4 * 32 * 2) {
        const int dvh = item & 1, qt = (item >> 1) & 31, h = (item >> 6) & 3, b = item >> 8;
        const bf16_t* Qp = wsp<bf16_t>(p, OFF_QM) + ((long)(b * 4 + h) * NS + qt * 128) * 256;
        const bf16_t* Kp = wsp<bf16_t>(p, OFF_KMEM) + ((long)(b * 4 + h) * 256) * 256;
        const bf16_t* Vtp = wsp<bf16_t>(p, OFF_VTMEM) + ((long)(b * 4 + h) * 256 + dvh * 128) * 256;
        bf16_t* Op = wsp<bf16_t>(p, OFF_OM) + ((long)b * NS + qt * 128) * 1024 + h * 256 + dvh * 128;
        attn_block<256, 128, 32, 256>(Qp, Kp, Vtp, 256L, 256, lds, [&](int q, int dv, f32x4 v) { *(u32x2*)(Op + (long)q * 1024 + dv) = pack4bf(v); });
    }
}

__device__ __forceinline__ void phase7(const Params& p, char* lds) {
    const int tid = VTID, lane = tid & 63, wid = tid >> 6;
    float* wr = (float*)lds;
    __syncthreads();
    {
        f32x4 wv[16];
#pragma unroll
        for (int it = 0; it < 16; it++) wv[it] = *(const f32x4*)(p.w_router + (size_t)(tid + 256 * it) * 4);
#pragma unroll
        for (int it = 0; it < 16; it++) {
            const int i4 = tid + 256 * it, k = i4 >> 2, e0 = (i4 & 3) * 4;
            const float gk = p.g_ffn[k];
            wr[(e0 + 0) * 1024 + k] = wv[it][0] * gk; wr[(e0 + 1) * 1024 + k] = wv[it][1] * gk;
            wr[(e0 + 2) * 1024 + k] = wv[it][2] * gk; wr[(e0 + 3) * 1024 + k] = wv[it][3] * gk;
        }
    }
    __syncthreads();
    for (int tok = VBLK * 4 + wid; tok < NT; tok += VGRID * 4) {
        const bf16_t* xr = wsp<bf16_t>(p, OFF_X2B) + (long)tok * ND;
        float a[16];
#pragma unroll
        for (int e = 0; e < 16; e++) a[e] = 0.f;
#pragma unroll 2
        for (int j = 0; j < 8; j++) {
            const unsigned xw = *(const unsigned*)(xr + 2 * lane + 128 * j);
            const float x0 = __uint_as_float(xw << 16), x1 = __uint_as_float(xw & 0xFFFF0000u);
#pragma unroll
            for (int e = 0; e < 16; e++) {
                const f32x2 w = *(const f32x2*)(wr + e * 1024 + 2 * lane + 128 * j);
                a[e] += x0 * w[0] + x1 * w[1];
            }
        }
#pragma unroll
        for (int i = 0; i < 8; i++) { const bool hi = lane & 32; const float send = hi ? a[i] : a[i + 8], keep = hi ? a[i + 8] : a[i]; a[i] = keep + __shfl_xor(send, 32); }
#pragma unroll
        for (int i = 0; i < 4; i++) { const bool hi = lane & 16; const float send = hi ? a[i] : a[i + 4], keep = hi ? a[i + 4] : a[i]; a[i] = keep + __shfl_xor(send, 16); }
#pragma unroll
        for (int i = 0; i < 2; i++) { const bool hi = lane & 8; const float send = hi ? a[i] : a[i + 2], keep = hi ? a[i + 2] : a[i]; a[i] = keep + __shfl_xor(send, 8); }
        { const bool hi = lane & 4; const float send = hi ? a[0] : a[1], keep = hi ? a[1] : a[0]; a[0] = keep + __shfl_xor(send, 4); }
        float lg = a[0];
        lg += __shfl_xor(lg, 2); lg += __shfl_xor(lg, 1);
        const int e = ((lane >> 5) & 1) * 8 + ((lane >> 4) & 1) * 4 + ((lane >> 3) & 1) * 2 + ((lane >> 2) & 1);
        const float rs2 = row_rs16(wsp<float>(p, OFF_SS2) + (long)tok * 16);
        if (lane == 0) wsp<float>(p, OFF_RS2)[tok] = rs2;
        lg *= rs2;
        float mx = lg;
#pragma unroll
        for (int o = 4; o < 64; o <<= 1) mx = fmaxf(mx, __shfl_xor(mx, o));
        const float ex = expf(lg - mx);
        float sm = ex;
#pragma unroll
        for (int o = 4; o < 64; o <<= 1) sm += __shfl_xor(sm, o);
        if ((lane & 3) == 0) wsp<float>(p, OFF_AFF)[(long)tok * 16 + e] = ex / sm;
    }
}

__device__ __forceinline__ int block_sum_i(int v, int* red) {
    const int lane = VTID & 63, wid = VTID >> 6;
#pragma unroll
    for (int o = 32; o > 0; o >>= 1) v += __shfl_xor(v, o);
    __syncthreads();
    if (lane == 0) red[wid] = v;
    __syncthreads();
    return red[0] + red[1] + red[2] + red[3];
}
__device__ __forceinline__ int block_excl_scan_i(int v, int* red, int& total) {
    const int lane = VTID & 63, wid = VTID >> 6;
    int inc = v;
#pragma unroll
    for (int o = 1; o < 64; o <<= 1) { const int t = __shfl_up(inc, o); if (lane >= o) inc += t; }
    __syncthreads();
    if (lane == 63) red[wid] = inc;
    __syncthreads();
    int base = 0;
#pragma unroll
    for (int w = 0; w < 4; w++) if (w < wid) base += red[w];
    total = red[0] + red[1] + red[2] + red[3];
    return base + inc - v;
}
__device__ __forceinline__ void phase8(const Params& p, char* lds) {
    int* red = (int*)lds;
    const int tid = VTID;
    for (int item = VBLK; item < NB * NE; item += VGRID) {
        const int e = item & 15, b = item >> 4;
        const float* aff = wsp<float>(p, OFF_AFF) + (long)b * NS * 16 + e;
        unsigned v[16];
#pragma unroll
        for (int i = 0; i < 16; i++) v[i] = __float_as_uint(aff[(long)(tid * 16 + i) * 16]);
        unsigned T = 0;
        for (int bit = 30; bit >= 0; bit--) {
            const unsigned cand = T | (1u << bit);
            int c = 0;
#pragma unroll
            for (int i = 0; i < 16; i++) c += (v[i] >= cand) ? 1 : 0;
            if (block_sum_i(c, red) >= CAP) T = cand;
        }
        int cg = 0, ce = 0;
#pragma unroll
        for (int i = 0; i < 16; i++) { cg += (v[i] > T) ? 1 : 0; ce += (v[i] == T) ? 1 : 0; }
        int tot;
        const int pk = block_excl_scan_i(cg | (ce << 16), red, tot);
        const int need = CAP - (tot & 0xFFFF);
        const int pe = pk >> 16;
        int nse = need - pe; nse = nse < 0 ? 0 : (nse > ce ? ce : nse);
        int tot2;
        int slot = block_excl_scan_i(cg + nse, red, tot2);
        int* slots = wsp<int>(p, OFF_SLOTS) + (long)(b * NE + e) * NS;
        int* idx = wsp<int>(p, OFF_IDX) + (long)(b * NE + e) * CAP;
        float* gate = wsp<float>(p, OFF_GATE) + (long)(b * NE + e) * CAP;
        float* rss = wsp<float>(p, OFF_RSS) + (long)(b * NE + e) * CAP;
        const float* rs2 = wsp<float>(p, OFF_RS2) + (long)b * NS + tid * 16;
        int eqs = 0;
#pragma unroll
        for (int i = 0; i < 16; i++) {
            const int t = tid * 16 + i;
            bool sel = v[i] > T;
            if (v[i] == T) { sel = eqs < nse; eqs++; }
            if (sel) { slots[t] = slot; idx[slot] = b * NS + t; gate[slot] = __uint_as_float(v[i]); rss[slot] = rs2[i]; slot++; }
            else slots[t] = -1;
        }
    }
}

__device__ __forceinline__ void phase9(const Params& p, char* lds) {
    const int tid = VTID, lane = tid & 63, wid = tid >> 6, wm = wid >> 1, wn = wid & 1, lq = lane >> 4, lr = lane & 15;
    FOR_XCD_ITEMS(item, NE * 16 * NB * 4) {
        const int rt = item & 3, b = (item >> 2) & 3, ct = (item >> 4) & 15, e = item >> 8;
        const int* arow = wsp<int>(p, OFF_IDX) + (long)(b * NE + e) * CAP + rt * 128;
        f32x4 acc[4][4];
        GemmTile g; g.A = wsp<bf16_t>(p, OFF_X2B); g.lda = ND; g.arow = arow;
        g.Bt = wsp<bf16_t>(p, OFF_WGUT) + ((long)e * 2048 + ct * 128) * ND; g.ldb = ND; g.K = ND;
        gemm_tile_128(g, lds, acc);
#pragma unroll
        for (int mi = 0; mi < 4; mi++) {
            const int r = wm * 64 + mi * 16 + lr;
            const int tok = arow[r];
            const float rs = row_rs16(wsp<float>(p, OFF_SS2) + (long)tok * 16);
            bf16_t* ad = wsp<bf16_t>(p, OFF_ACT) + ((long)(e * NB + b) * CAP + rt * 128 + r) * ND + ct * 64 + wn * 32 + 4 * lq;
#pragma unroll
            for (int pp = 0; pp < 2; pp++) {
                f32x4 o;
#pragma unroll
                for (int q = 0; q < 4; q++) {
                    const float ga = acc[mi][2 * pp][q] * rs, up = acc[mi][2 * pp + 1][q] * rs;
                    o[q] = ga / (1.f + __expf(-ga)) * up;
                }
                *(u32x2*)(ad + pp * 16) = pack4bf(o);
            }
        }
    }
}
__device__ __forceinline__ void phase10(const Params& p, char* lds) {
    const int tid = VTID, lane = tid & 63, wid = tid >> 6, wm = wid >> 1, wn = wid & 1, lq = lane >> 4, lr = lane & 15;
    FOR_XCD_ITEMS(item, NE * 8 * NB * 4) {
        const int rt = item & 3, b = (item >> 2) & 3, ct = (item >> 4) & 7, e = item >> 7;
        const long row0 = (long)(e * NB + b) * CAP + rt * 128;
        f32x4 acc[4][4];
        GemmTile g; g.A = wsp<bf16_t>(p, OFF_ACT) + row0 * ND; g.lda = ND; g.arow = nullptr;
        g.Bt = wsp<bf16_t>(p, OFF_WDT) + ((long)e * 1024 + ct * 128) * ND; g.ldb = ND; g.K = ND;
        gemm_tile_128(g, lds, acc);
        const float* gate = wsp<float>(p, OFF_GATE) + (long)(b * NE + e) * CAP + rt * 128;
#pragma unroll
        for (int mi = 0; mi < 4; mi++) {
            const int r = wm * 64 + mi * 16 + lr;
            const float gv = gate[r];
            bf16_t* yd = wsp<bf16_t>(p, OFF_Y) + (row0 + r) * ND + ct * 128 + wn * 64 + 4 * lq;
#pragma unroll
            for (int ni = 0; ni < 4; ni++) *(u32x2*)(yd + ni * 16) = pack4bf(acc[mi][ni] * gv);
        }
    }
}

__device__ __forceinline__ void phase11(const Params& p, char* lds) {
    const int tid = VTID, lane = tid & 63, wid = tid >> 6;
    const int* slots = wsp<int>(p, OFF_SLOTS);
    auto slot_of = [&](int tok) { const int b = tok >> 12, t = tok & 4095; return slots[(long)(b * NE + (lane & 15)) * NS + t]; };
    int tok = VBLK * 4 + wid;
    int sl_next = tok < NT ? slot_of(tok) : -1;
    u32x2 xn[4];
#pragma unroll
    for (int i = 0; i < 4; i++) xn[i] = *(const u32x2*)(wsp<bf16_t>(p, OFF_X2B) + (long)(tok < NT ? tok : 0) * ND + i * 256 + lane * 4);
    for (; tok < NT; tok += VGRID * 4) {
        const int b = tok >> 12;
        float* xr = p.out + (long)tok * ND;
        const int slv = sl_next;
        f32x4 v[4];
#pragma unroll
        for (int i = 0; i < 4; i++)
            v[i] = (f32x4){__uint_as_float(xn[i].x << 16), __uint_as_float(xn[i].x & 0xFFFF0000u), __uint_as_float(xn[i].y << 16), __uint_as_float(xn[i].y & 0xFFFF0000u)};
        {
            const int tn = tok + VGRID * 4;
            sl_next = tn < NT ? slot_of(tn) : -1;
#pragma unroll
            for (int i = 0; i < 4; i++) xn[i] = *(const u32x2*)(wsp<bf16_t>(p, OFF_X2B) + (long)(tn < NT ? tn : tok) * ND + i * 256 + lane * 4);
        }
        unsigned long long sel = __ballot(slv >= 0) & 0xFFFFull;
        while (sel) {
            const int e = __builtin_ctzll(sel); sel &= sel - 1;
            const int sl = __builtin_amdgcn_readlane(slv, e);
            const bf16_t* yr = wsp<bf16_t>(p, OFF_Y) + ((long)(e * NB + b) * CAP + sl) * ND;
#pragma unroll
            for (int i = 0; i < 4; i++) {
                const u32x2 w = *(const u32x2*)(yr + i * 256 + lane * 4);
                v[i][0] += __uint_as_float(w.x << 16); v[i][1] += __uint_as_float(w.x & 0xFFFF0000u);
                v[i][2] += __uint_as_float(w.y << 16); v[i][3] += __uint_as_float(w.y & 0xFFFF0000u);
            }
        }
        float ss = 0.f;
#pragma unroll
        for (int i = 0; i < 4; i++) ss += v[i][0] * v[i][0] + v[i][1] * v[i][1] + v[i][2] * v[i][2] + v[i][3] * v[i][3];
        ss = wave_sum(ss);
        const float rs = rsqrtf(ss * (1.f / ND) + 1e-6f);
#pragma unroll
        for (int i = 0; i < 4; i++) {
            const f32x4 gf = *(const f32x4*)(p.g_final + i * 256 + lane * 4);
            *(f32x4*)(xr + i * 256 + lane * 4) = v[i] * rs * gf;
        }
    }
}


__device__ __forceinline__ void phase_resid8(const Params& p, char* lds, size_t offA, size_t offW, const float* residf, const bf16_t* residb, size_t offXb, size_t offSS) {
    const int tid = threadIdx.x, lane = tid & 63, wid = tid >> 6, wm = wid >> 2, wn = wid & 3, lq = lane >> 4, lr = lane & 15;
    FOR_XCD_ITEMS_R(item, 64 * 4) {
        const int tm = item >> 2, tn = item & 3;
        f32x4 acc[8][4];
        GemmTile g; g.A = wsp<bf16_t>(p, offA) + (long)tm * 256 * ND; g.lda = ND; g.arow = nullptr;
        g.Bt = wsp<bf16_t>(p, offW) + (long)tn * 256 * ND; g.ldb = ND; g.K = ND;
        gemm_tile_256sq(g, lds, acc);
#pragma unroll
        for (int mi = 0; mi < 8; mi++) {
            const int row = tm * 256 + wm * 128 + mi * 16 + lr;
            float ss = 0.f;
#pragma unroll
            for (int ni = 0; ni < 4; ni++) {
                const long o = (long)row * ND + tn * 256 + wn * 64 + ni * 16 + 4 * lq;
                f32x4 rv;
                if (residf) rv = *(const f32x4*)(residf + o);
                else { const u32x2 w = *(const u32x2*)(residb + o); rv = (f32x4){__uint_as_float(w.x << 16), __uint_as_float(w.x & 0xFFFF0000u), __uint_as_float(w.y << 16), __uint_as_float(w.y & 0xFFFF0000u)}; }
                const f32x4 v = rv + acc[mi][ni];
                *(u32x2*)(wsp<bf16_t>(p, offXb) + o) = pack4bf(v);
                ss += v[0] * v[0] + v[1] * v[1] + v[2] * v[2] + v[3] * v[3];
            }
            ss += __shfl_xor(ss, 16); ss += __shfl_xor(ss, 32);
            if (lq == 0) wsp<float>(p, offSS)[row * 16 + tn * 4 + wn] = ss;
        }
    }
}
__device__ __forceinline__ void phase5a8(const Params& p, char* lds) {
    const int tid = threadIdx.x, lane = tid & 63, wid = tid >> 6, wm = wid >> 2, wn = wid & 3, lq = lane >> 4, lr = lane & 15;
    FOR_XCD_ITEMS_R(item, 64 * 4) {
        const int tm = item >> 2, tn = item & 3;
        f32x4 acc[8][4];
        GemmTile g; g.A = wsp<bf16_t>(p, OFF_X1B) + (long)tm * 256 * ND; g.lda = ND; g.arow = nullptr;
        g.Bt = wsp<bf16_t>(p, OFF_WMQT) + (long)tn * 256 * ND; g.ldb = ND; g.K = ND;
        gemm_tile_256sq(g, lds, acc);
#pragma unroll
        for (int mi = 0; mi < 8; mi++) {
            const int row = tm * 256 + wm * 128 + mi * 16 + lr, b = row >> 12, s = row & 4095;
            const float rs = row_rs16(wsp<float>(p, OFF_SS1) + (long)row * 16) * (0.0625f * 1.4426950408889634f);
            bf16_t* qd = wsp<bf16_t>(p, OFF_QM) + ((long)(b * 4 + tn) * NS + s) * 256 + wn * 64 + 4 * lq;
#pragma unroll
            for (int ni = 0; ni < 4; ni++) *(u32x2*)(qd + ni * 16) = pack4bf(acc[mi][ni] * rs);
        }
    }
}


template <class Epi>
__device__ __forceinline__ void gemm_256sq_multi(const bf16_t* A, int lda, const int* arow, const bf16_t* Bt, int ldb, long bstep,
                                                 int K, int ntile, char* lds, Epi epi) {
    const int tid = threadIdx.x, lane = tid & 63, wid = tid >> 6, wm = wid >> 2, wn = wid & 3;
    const int lrow = lane >> 3, pc = lane & 7;
    const char* Ab = (const char*)A; const char* Bb = (const char*)Bt;
    unsigned ao[4], bo[4];
#pragma unroll
    for (int i = 0; i < 4; i++) {
        const int r = (wid * 4 + i) * 8 + lrow;
        const int c = pc ^ ((r >> 1) & 7);
        ao[i] = (unsigned)((arow ? arow[r] : r) * lda + c * 8) * 2u;
        bo[i] = (unsigned)(r * ldb + c * 8) * 2u;
    }
    const int nk = K >> 6;
    auto stage = [&](int kt, long boff, char* st) {
        const char* a0 = Ab + kt * 128;
        const char* b0 = Bb + boff * 2 + kt * 128;
#pragma unroll
        for (int i = 0; i < 4; i++) {
            __builtin_amdgcn_global_load_lds((const unsigned*)(a0 + ao[i]), (unsigned*)(st + (wid * 4 + i) * 1024), 16, 0, 0);
            __builtin_amdgcn_global_load_lds((const unsigned*)(b0 + bo[i]), (unsigned*)(st + 32768 + (wid * 4 + i) * 1024), 16, 0, 0);
        }
    };
    f32x4 acc[8][4];
    __syncthreads();
    stage(0, 0, lds);
    asm volatile("s_waitcnt vmcnt(0)" ::: "memory");
    __syncthreads();
    int q = 0;
    for (int t = 0; t < ntile; t++) {
#pragma unroll
        for (int mi = 0; mi < 8; mi++)
#pragma unroll
            for (int ni = 0; ni < 4; ni++) acc[mi][ni] = (f32x4){0.f, 0.f, 0.f, 0.f};
        const long boff = (long)t * bstep;
        for (int kt = 0; kt < nk; kt++, q++) {
            char* cur = lds + (q & 1) * 65536;
            char* nxt = lds + ((q + 1) & 1) * 65536;
            if (kt + 1 < nk) stage(kt + 1, boff, nxt);
            else if (t + 1 < ntile) stage(0, boff + bstep, nxt);
#pragma unroll
            for (int ks = 0; ks < 2; ks++) {
                bf16x8 af[8], bfr[4];
#pragma unroll
                for (int i = 0; i < 8; i++) af[i] = *(const bf16x8*)(cur + tile_off(wm * 128 + i * 16 + (lane & 15), ks * 4 + (lane >> 4)));
#pragma unroll
                for (int i = 0; i < 4; i++) bfr[i] = *(const bf16x8*)(cur + 32768 + tile_off(wn * 64 + i * 16 + (lane & 15), ks * 4 + (lane >> 4)));
                __builtin_amdgcn_s_setprio(1);
#pragma unroll
                for (int mi = 0; mi < 8; mi++)
#pragma unroll
                    for (int ni = 0; ni < 4; ni++)
                        acc[mi][ni] = __builtin_amdgcn_mfma_f32_16x16x32_bf16(bfr[ni], af[mi], acc[mi][ni], 0, 0, 0);
                __builtin_amdgcn_s_setprio(0);
            }
            asm volatile("s_waitcnt vmcnt(0)" ::: "memory");
            __syncthreads();
        }
        epi(t, acc);
    }
}
__device__ __forceinline__ void phase9_8(const Params& p, char* lds) {
    const int tid = threadIdx.x, lane = tid & 63, wid = tid >> 6, wm = wid >> 2, wn = wid & 3, lq = lane >> 4, lr = lane & 15;
    FOR_XCD_ITEMS_R(si, NE * NB * 2 * 2) {
        const int cth = si & 1, rt = (si >> 1) & 1, b = (si >> 2) & 3, e = si >> 4;
        const int* arow = wsp<int>(p, OFF_IDX) + (long)(b * NE + e) * CAP + rt * 256;
        const float* rss = wsp<float>(p, OFF_RSS) + (long)(b * NE + e) * CAP + rt * 256;
        gemm_256sq_multi(wsp<bf16_t>(p, OFF_X2B), ND, arow, wsp<bf16_t>(p, OFF_WGUT) + ((long)e * 2048 + cth * 1024) * ND, ND, 256L * ND,
                         ND, 4, lds, [&](int t, f32x4 (&acc)[8][4]) {
            const int ct = cth * 4 + t;
            char* adb = (char*)(wsp<bf16_t>(p, OFF_ACT) + ((long)(e * NB + b) * CAP + rt * 256) * ND + ct * 128);
            const unsigned ado = (unsigned)((wm * 128 + lr) * ND + wn * 32 + 4 * lq) * 2u;
#pragma unroll
            for (int mi = 0; mi < 8; mi++) {
                const float rs = rss[wm * 128 + mi * 16 + lr];
#pragma unroll
                for (int pp = 0; pp < 2; pp++) {
                    f32x4 o;
#pragma unroll
                    for (int q = 0; q < 4; q++) {
                        const float ga = acc[mi][2 * pp][q] * rs, up = acc[mi][2 * pp + 1][q] * rs;
                        o[q] = ga / (1.f + __expf(-ga)) * up;
                    }
                    *(u32x2*)(adb + (ado + (unsigned)(mi * 16 * ND * 2 + pp * 32))) = pack4bf(o);
                }
            }
        });
    }
}
__device__ __forceinline__ void phase10_8(const Params& p, char* lds) {
    const int tid = threadIdx.x, lane = tid & 63, wid = tid >> 6, wm = wid >> 2, wn = wid & 3, lq = lane >> 4, lr = lane & 15;
    FOR_XCD_ITEMS_R(si, NE * NB * 2 * 2) {
        const int cth = si & 1, rt = (si >> 1) & 1, b = (si >> 2) & 3, e = si >> 4;
        const long row0 = (long)(e * NB + b) * CAP + rt * 256;
        const float* gate = wsp<float>(p, OFF_GATE) + (long)(b * NE + e) * CAP + rt * 256;
        gemm_256sq_multi(wsp<bf16_t>(p, OFF_ACT) + row0 * ND, ND, nullptr, wsp<bf16_t>(p, OFF_WDT) + ((long)e * 1024 + cth * 512) * ND, ND, 256L * ND,
                         ND, 2, lds, [&](int t, f32x4 (&acc)[8][4]) {
            const int ct = cth * 2 + t;
            char* yb = (char*)(wsp<bf16_t>(p, OFF_Y) + row0 * ND + ct * 256);
            const unsigned yo = (unsigned)((wm * 128 + lr) * ND + wn * 64 + 4 * lq) * 2u;
#pragma unroll
            for (int mi = 0; mi < 8; mi++) {
                const float gv = gate[wm * 128 + mi * 16 + lr];
#pragma unroll
                for (int ni = 0; ni < 4; ni++) *(u32x2*)(yb + (yo + (unsigned)(mi * 16 * ND * 2 + ni * 32))) = pack4bf(acc[mi][ni] * gv);
            }
        });
    }
}


__device__ __forceinline__ void phase1_big(const Params& p, char* lds) {
    const int tid = threadIdx.x, lane = tid & 63, wid = tid >> 6, wm = wid >> 2, wn = wid & 3, lq = lane >> 4, lr = lane & 15;
    FOR_XCD_ITEMS_R(item, 64 * 4) {
        const int tm = item >> 2, tn = item & 3;
        f32x4 acc[8][4];
        GemmTile g; g.A = wsp<bf16_t>(p, OFF_XB) + (long)tm * 256 * ND; g.lda = ND; g.arow = nullptr;
        g.Bt = wsp<bf16_t>(p, OFF_W1T) + (long)tn * 256 * ND; g.ldb = ND; g.K = ND;
        gemm_tile_256sq(g, lds, acc);
        const float* r0 = wsp<float>(p, OFF_R0);
        const int col0 = tn * 256 + wn * 64;
#pragma unroll
        for (int mi = 0; mi < 8; mi++) {
            const int row = tm * 256 + wm * 128 + mi * 16 + lr;
            const float rs = r0[row];
#pragma unroll
            for (int ni = 0; ni < 4; ni++) acc[mi][ni] *= rs;
            if (col0 < 512) {
#pragma unroll
                for (int ni = 0; ni < 4; ni++)
                    *(u32x2*)(wsp<bf16_t>(p, OFF_UF) + (long)row * 512 + col0 + ni * 16 + 4 * lq) = pack4bf(acc[mi][ni]);
            } else {
                float ss = 0.f;
#pragma unroll
                for (int ni = 0; ni < 4; ni++) { const f32x4 v = acc[mi][ni]; ss += v[0] * v[0] + v[1] * v[1] + v[2] * v[2] + v[3] * v[3]; }
                ss += __shfl_xor(ss, 16); ss += __shfl_xor(ss, 32);
                if (col0 < 896) {
#pragma unroll
                    for (int ni = 0; ni < 4; ni++)
                        *(u32x2*)(wsp<bf16_t>(p, OFF_UQ) + (long)row * 384 + (col0 - 512) + ni * 16 + 4 * lq) = pack4bf(acc[mi][ni]);
                    if (lq == 0) wsp<float>(p, OFF_SSQ)[row * 6 + ((col0 - 512) >> 6)] = ss;
                } else {
#pragma unroll
                    for (int ni = 0; ni < 4; ni++)
                        *(u32x2*)(wsp<bf16_t>(p, OFF_UKV) + (long)row * 256 + (col0 - 896) + ni * 16 + 4 * lq) = pack4bf(acc[mi][ni]);
                    if (lq == 0) wsp<float>(p, OFF_SSKV)[row * 4 + ((col0 - 896) >> 6)] = ss;
                }
            }
        }
    }
}


__device__ __forceinline__ void phase3_attn8(const Params& p, char* lds) {
    FOR_XCD_ITEMS_R(item, NB * 8 * (NS / 256)) {
        const int qt = item & 15, h = (item >> 4) & 7, b = item >> 7;
        const bf16_t* Qp = wsp<bf16_t>(p, OFF_Q) + ((long)(b * 8 + h) * NS + qt * 256) * 96;
        const bf16_t* Kp = wsp<bf16_t>(p, OFF_K) + ((long)(b * 8 + h) * NS) * 96;
        const bf16_t* Vtp = wsp<bf16_t>(p, OFF_VT) + ((long)(b * 8 + h) * 64) * NS;
        bf16_t* Op = wsp<bf16_t>(p, OFF_ZA) + ((long)b * NS + qt * 256) * 1024 + 512 + h * 64;
        attn_block<96, 64, 128, 512>(Qp, Kp, Vtp, (long)NS, NS, lds, [&](int q, int dv, f32x4 v) { *(u32x2*)(Op + (long)q * 1024 + dv) = pack4bf(v); });
    }
}
__device__ __forceinline__ void phase5b_8(const Params& p, char* lds) {
    FOR_XCD_ITEMS_R(item, NB * 4 * 16 * 2) {
        const int dvh = item & 1, qt = (item >> 1) & 15, h = (item >> 5) & 3, b = item >> 7;
        const bf16_t* Qp = wsp<bf16_t>(p, OFF_QM) + ((long)(b * 4 + h) * NS + qt * 256) * 256;
        const bf16_t* Kp = wsp<bf16_t>(p, OFF_KMEM) + ((long)(b * 4 + h) * 256) * 256;
        const bf16_t* Vtp = wsp<bf16_t>(p, OFF_VTMEM) + ((long)(b * 4 + h) * 256 + dvh * 128) * 256;
        bf16_t* Op = wsp<bf16_t>(p, OFF_OM) + ((long)b * NS + qt * 256) * 1024 + h * 256 + dvh * 128;
        attn_block<256, 128, 32, 512>(Qp, Kp, Vtp, 256L, 256, lds, [&](int q, int dv, f32x4 v) { *(u32x2*)(Op + (long)q * 1024 + dv) = pack4bf(v); });
    }
}

__global__ void __launch_bounds__(512, 1) k_fwd(Params p, int ph_lo, int ph_hi) {
    extern __shared__ __attribute__((aligned(16))) char lds_all[];
    char* lds = lds_all + VHALF * LDS_HALF;
    volatile LAS unsigned* st = (volatile LAS unsigned*)(lds_all + LDS_MAIN);
    if (threadIdx.x == 0) { st[0] = 0u; st[1] = 0u; }
    __syncthreads();
    XcdBarrier bar = xcd_barrier_post(wsp<unsigned>(p, OFF_BAR), st);
#if USE_CG_SYNC
#define GRID_BARRIER() do { asm volatile("s_waitcnt vmcnt(0)" ::: "memory"); __syncthreads(); cg::this_grid().sync(); asm volatile("s_waitcnt vmcnt(0)" ::: "memory"); __syncthreads(); } while (0)
#else
#define GRID_BARRIER() xcd_barrier(bar)
#endif
#define RUN_PHASE(k, call) if (ph_lo <= (k) && (k) < ph_hi) { if ((k) > ph_lo) { GRID_BARRIER(); } call; }
    RUN_PHASE(0, phase0(p, lds))
    RUN_PHASE(1, (phase1_big(p, lds_all), phase1(p, lds_all)))
    RUN_PHASE(2, (phase2(p, lds_all), phase2_f2a(p, lds)))
    RUN_PHASE(3, ((blockIdx.x & 1) ? phase3_tr(p, lds) : (void)0, phase3_attn8(p, lds_all), phase3_f2b(p, lds), (blockIdx.x & 1) ? (void)0 : phase3_tr(p, lds)))
    RUN_PHASE(4, phase_resid8(p, lds_all, OFF_ZA, OFF_WOUTT, p.x, nullptr, OFF_X1B, OFF_SS1))
    RUN_PHASE(5, phase5a8(p, lds_all))
    RUN_PHASE(6, phase5b_8(p, lds_all))
    RUN_PHASE(7, phase_resid8(p, lds_all, OFF_OM, OFF_WMOT, nullptr, wsp<bf16_t>(p, OFF_X1B), OFF_X2B, OFF_SS2))
    RUN_PHASE(8, phase7(p, lds))
    RUN_PHASE(9, phase8(p, lds))
    RUN_PHASE(10, phase9_8(p, lds_all))
    RUN_PHASE(11, phase10_8(p, lds_all))
    RUN_PHASE(12, phase11(p, lds))
}

extern "C" void kernel_launch(void* const* d_in, const int* in_sizes, int n_in,
                              void* d_out, int out_size, void* d_ws, size_t ws_size,
                              hipStream_t stream) {
    static int grid = 0;
    if (grid == 0) {
        if (n_in != 22 || ws_size < WS_END) { fprintf(stderr, "kernel_launch: unexpected inputs (n_in %d, ws %zu < %zu)\n", n_in, ws_size, (size_t)WS_END); grid = -1; return; }
        int dev = 0, cus = 0, per_cu = 0;
        (void)hipGetDevice(&dev);
        (void)hipDeviceGetAttribute(&cus, hipDeviceAttributeMultiprocessorCount, dev);
        if (hipFuncSetAttribute((const void*)k_fwd, hipFuncAttributeMaxDynamicSharedMemorySize, LDS_TOTAL) != hipSuccess) { fprintf(stderr, "kernel_launch: hipFuncSetAttribute failed\n"); grid = -1; return; }
        if (hipOccupancyMaxActiveBlocksPerMultiprocessor(&per_cu, (const void*)k_fwd, 512, LDS_TOTAL) != hipSuccess || per_cu < 1) { fprintf(stderr, "kernel_launch: occupancy query failed (%d)\n", per_cu); (void)hipGetLastError(); per_cu = 1; }
        if (per_cu > 1) per_cu = 1;
        grid = (cus * per_cu) & ~7;
        if (grid < 8) { fprintf(stderr, "kernel_launch: unexpected device (%d CUs)\n", cus); grid = -1; return; }
        fprintf(stderr, "kernel_launch: %d CUs x %d blocks\n", cus, per_cu);
    }
    if (grid < 0) return;
    Params p{};
    p.x = (const float*)d_in[0]; p.mem = (const float*)d_in[1]; p.pos = (const int*)d_in[2];
    p.g_mix = (const float*)d_in[3]; p.w_in = (const float*)d_in[4]; p.g_q_lat = (const float*)d_in[5]; p.w_q_up = (const float*)d_in[6];
    p.g_kv_lat = (const float*)d_in[7]; p.w_kv_up = (const float*)d_in[8]; p.w_fourier = (const float*)d_in[9]; p.w_out = (const float*)d_in[10];
    p.g_mem_q = (const float*)d_in[11]; p.g_mem_kv = (const float*)d_in[12]; p.w_mem_q = (const float*)d_in[13]; p.w_mem_kv = (const float*)d_in[14];
    p.w_mem_o = (const float*)d_in[15]; p.g_ffn = (const float*)d_in[16]; p.w_router = (const float*)d_in[17];
    p.w_exp_gate = (const float*)d_in[18]; p.w_exp_up = (const float*)d_in[19]; p.w_exp_down = (const float*)d_in[20]; p.g_final = (const float*)d_in[21];
    p.out = (float*)d_out; p.ws = (char*)d_ws;
    static const int cuts[] = MK_CUTS;
    const int ncut = (int)(sizeof(cuts) / sizeof(int));
    for (int li = 0; li + 1 < ncut; li++) {
        (void)hipMemsetAsync((char*)d_ws + OFF_BAR, 0, 16384, stream);
        int lo = cuts[li], hi = cuts[li + 1];
        void* args[] = {&p, &lo, &hi};
        hipError_t e = hipLaunchCooperativeKernel((const void*)k_fwd, dim3(grid), dim3(512), args, LDS_TOTAL, stream);
        if (e != hipSuccess) fprintf(stderr, "cooperative launch failed: %s (grid %d)\n", hipGetErrorString(e), grid);
    }
}
```

```cpp
#include <hip/hip_runtime.h>
#include <stdint.h>
#include <cstdio>
#include <hip/hip_cooperative_groups.h>
namespace cg = cooperative_groups;
#ifndef USE_CG_SYNC
#define USE_CG_SYNC 0
#endif

#ifndef MK_CUTS
#define MK_CUTS {0, 13}
#endif

#define NB 4
#define NS 4096
#define ND 1024
#define NT (NB * NS)
#define INW 1184
#define NE 16
#define CAP 512
#define MEML 256
#define NPHASE 13
#define VTID ((int)(threadIdx.x & 255))
#define VHALF (__builtin_amdgcn_readfirstlane((int)(threadIdx.x >> 8)))
#define VBLK ((int)(blockIdx.x * 2) + VHALF)
#define VGRID ((int)(gridDim.x * 2))

typedef unsigned short bf16_t;
typedef short bf16x8 __attribute__((ext_vector_type(8)));
typedef float f32x4 __attribute__((ext_vector_type(4)));
typedef float f32x16 __attribute__((ext_vector_type(16)));
typedef unsigned u32x4 __attribute__((ext_vector_type(4)));
typedef unsigned u32x2 __attribute__((ext_vector_type(2)));

__device__ __forceinline__ unsigned f2bf(float f) {
    unsigned u = __float_as_uint(f);
    u += 0x7FFFu + ((u >> 16) & 1u);
    return u >> 16;
}
typedef __bf16 hbf2 __attribute__((ext_vector_type(2)));
typedef float f32x2 __attribute__((ext_vector_type(2)));
__device__ __forceinline__ unsigned pack2bf(float lo, float hi) { f32x2 v = {lo, hi}; return __builtin_bit_cast(unsigned, __builtin_convertvector(v, hbf2)); }
__device__ __forceinline__ float bf2f(unsigned short b) { return __uint_as_float(((unsigned)b) << 16); }

__device__ __forceinline__ int tile_off(int row, int chunk) { return row * 128 + ((chunk ^ ((row >> 1) & 7)) << 4); }

#define GT_LDS_BYTES 65536

struct GemmTile { const bf16_t* A; long lda; const int* arow; const bf16_t* Bt; long ldb; int K; };

__device__ __forceinline__ void gemm_tile_128(const GemmTile& g, char* lds, f32x4 (&acc)[4][4]) {
    const int tid = VTID, lane = tid & 63, wid = tid >> 6, wm = wid >> 1, wn = wid & 1;
    const int lrow = lane >> 3, pc = lane & 7;
    const bf16_t* ap[4]; const bf16_t* bp[4];
#pragma unroll
    for (int i = 0; i < 4; i++) {
        const int r = (wid * 4 + i) * 8 + lrow;
        const int c = pc ^ ((r >> 1) & 7);
        const long ro = g.arow ? (long)g.arow[r] * g.lda : (long)r * g.lda;
        ap[i] = g.A + ro + c * 8;
        bp[i] = g.Bt + (long)r * g.ldb + c * 8;
    }
#pragma unroll
    for (int mi = 0; mi < 4; mi++)
#pragma unroll
        for (int ni = 0; ni < 4; ni++) acc[mi][ni] = (f32x4){0.f, 0.f, 0.f, 0.f};
    const int nk = g.K >> 6;
    auto stage = [&](int kt, char* st) {
#pragma unroll
        for (int i = 0; i < 4; i++) {
            __builtin_amdgcn_global_load_lds((const unsigned*)(ap[i] + kt * 64), (unsigned*)(st + (wid * 4 + i) * 1024), 16, 0, 0);
            __builtin_amdgcn_global_load_lds((const unsigned*)(bp[i] + kt * 64), (unsigned*)(st + 16384 + (wid * 4 + i) * 1024), 16, 0, 0);
        }
    };
    __syncthreads();
    stage(0, lds);
    asm volatile("s_waitcnt vmcnt(0)" ::: "memory");
    __syncthreads();
    for (int kt = 0; kt < nk; kt++) {
        char* cur = lds + (kt & 1) * 32768;
        if (kt + 1 < nk) stage(kt + 1, lds + ((kt + 1) & 1) * 32768);
        bf16x8 af[2][4], bfr[2][4];
#pragma unroll
        for (int ks = 0; ks < 2; ks++)
#pragma unroll
            for (int i = 0; i < 4; i++) {
                af[ks][i] = *(const bf16x8*)(cur + tile_off(wm * 64 + i * 16 + (lane & 15), ks * 4 + (lane >> 4)));
                bfr[ks][i] = *(const bf16x8*)(cur + 16384 + tile_off(wn * 64 + i * 16 + (lane & 15), ks * 4 + (lane >> 4)));
            }
        __builtin_amdgcn_s_setprio(1);
#pragma unroll
        for (int ks = 0; ks < 2; ks++)
#pragma unroll
            for (int mi = 0; mi < 4; mi++)
#pragma unroll
                for (int ni = 0; ni < 4; ni++)
                    acc[mi][ni] = __builtin_amdgcn_mfma_f32_16x16x32_bf16(bfr[ks][ni], af[ks][mi], acc[mi][ni], 0, 0, 0);
        __builtin_amdgcn_s_setprio(0);
        asm volatile("s_waitcnt vmcnt(0)" ::: "memory");
        __syncthreads();
    }
}

template <int DQK, int DVT, int KT>
struct AttnCfg {
    static constexpr int KROW = DQK * 2 + 16;
    static constexpr int VROW = KT * 2 + 8;
    static constexpr int KBYTES = KT * KROW;
    static constexpr int VBYTES = DVT * VROW;
    static constexpr int STAGE = KBYTES + VBYTES;
    static constexpr int LDS = 2 * STAGE;
};

template <int DQK, int DVT, int KT, int NTH, class Out>
__device__ __forceinline__ void attn_block(const bf16_t* Qp, const bf16_t* Kp, const bf16_t* Vtp, long ldv, int nk, char* lds, Out&& out) {
    typedef AttnCfg<DQK, DVT, KT> C;
    constexpr int NKS = DQK / 16, NST = KT / 32, NDT = DVT / 32, NPS = KT / 16;
    constexpr int KCPR = DQK / 8;
    constexpr int KTOT = KT * KCPR, KCH = (KTOT + NTH - 1) / NTH;
    constexpr int VCPR = KT / 8;
    constexpr int VTOT = DVT * VCPR, VCH = (VTOT + NTH - 1) / NTH;
    const int tid = NTH == 512 ? (int)threadIdx.x : VTID, lane = tid & 63, wid = tid >> 6, h = lane >> 5, c = lane & 31;

    bf16x8 qf[NKS];
    {
        const bf16_t* qrow = Qp + (long)(wid * 32 + c) * DQK + 8 * h;
#pragma unroll
        for (int ks = 0; ks < NKS; ks++) qf[ks] = *(const bf16x8*)(qrow + 16 * ks);
    }
    f32x16 o[NDT];
#pragma unroll
    for (int dt = 0; dt < NDT; dt++)
#pragma unroll
        for (int r = 0; r < 16; r++) o[dt][r] = 0.f;
    float m = 0.f, l = 0.f;

    u32x4 kr[KCH], vr[VCH];
    auto gload = [&](int t) {
#pragma unroll
        for (int i = 0; i < KCH; i++) {
            const int ci = tid + NTH * i, row = ci / KCPR, cc = ci % KCPR;
            if (KTOT % NTH == 0 || ci < KTOT) kr[i] = *(const u32x4*)(Kp + (long)(t * KT + row) * DQK + cc * 8);
        }
#pragma unroll
        for (int i = 0; i < VCH; i++) {
            const int ci = tid + NTH * i, row = ci / VCPR, cc = ci % VCPR;
            if (VTOT % NTH == 0 || ci < VTOT) vr[i] = *(const u32x4*)(Vtp + (long)row * ldv + t * KT + cc * 8);
        }
    };
    auto lwrite = [&](char* st) {
#pragma unroll
        for (int i = 0; i < KCH; i++) {
            const int ci = tid + NTH * i, row = ci / KCPR, cc = ci % KCPR;
            if (KTOT % NTH == 0 || ci < KTOT) *(u32x4*)(st + row * C::KROW + cc * 16) = kr[i];
        }
#pragma unroll
        for (int i = 0; i < VCH; i++) {
            const int ci = tid + NTH * i, row = ci / VCPR, cc = ci % VCPR;
            if (VTOT % NTH == 0 || ci < VTOT) {
                char* p = st + C::KBYTES + row * C::VROW + cc * 16;
                *(u32x2*)(p) = (u32x2){vr[i].x, vr[i].y};
                *(u32x2*)(p + 8) = (u32x2){vr[i].z, vr[i].w};
            }
        }
    };
    const int nt = nk / KT;
    gload(0);
    __syncthreads();
    lwrite(lds);
    __syncthreads();
    for (int t = 0; t < nt; t++) {
        char* cur = lds + (t & 1) * C::STAGE;
        if (t + 1 < nt) gload(t + 1);
        f32x16 s[NST];
        const float negm = -m;
#pragma unroll
        for (int st = 0; st < NST; st++) {
#pragma unroll
            for (int r = 0; r < 16; r++) s[st][r] = negm;
#pragma unroll
            for (int ks = 0; ks < NKS; ks++) {
                const bf16x8 kf = *(const bf16x8*)(cur + (st * 32 + c) * C::KROW + ks * 32 + h * 16);
                s[st] = __builtin_amdgcn_mfma_f32_32x32x16_bf16(kf, qf[ks], s[st], 0, 0, 0);
            }
        }
        float mx = s[0][0];
#pragma unroll
        for (int st = 0; st < NST; st++)
#pragma unroll
            for (int r = 0; r < 16; r++) mx = fmaxf(mx, s[st][r]);
        mx = fmaxf(mx, __shfl_xor(mx, 32));
        if (__any(mx > 8.0f)) {
            const float d = fmaxf(mx, 0.f);
            const float alpha = __builtin_amdgcn_exp2f(-d);
            m += d;
            l *= alpha;
#pragma unroll
            for (int dt = 0; dt < NDT; dt++)
#pragma unroll
                for (int r = 0; r < 16; r++) o[dt][r] *= alpha;
#pragma unroll
            for (int st = 0; st < NST; st++)
#pragma unroll
                for (int r = 0; r < 16; r++) s[st][r] -= d;
        }
        float rs = 0.f;
#pragma unroll
        for (int st = 0; st < NST; st++)
#pragma unroll
            for (int r = 0; r < 16; r++) { const float p = __builtin_amdgcn_exp2f(s[st][r]); rs += p; s[st][r] = p; }
        l += rs;
#pragma unroll
        for (int ps = 0; ps < NPS; ps++) {
            const int st = ps >> 1, u = ps & 1;
            u32x4 pw;
            pw.x = pack2bf(s[st][8 * u + 0], s[st][8 * u + 1]);
            pw.y = pack2bf(s[st][8 * u + 2], s[st][8 * u + 3]);
            pw.z = pack2bf(s[st][8 * u + 4], s[st][8 * u + 5]);
            pw.w = pack2bf(s[st][8 * u + 6], s[st][8 * u + 7]);
            const bf16x8 pf = __builtin_bit_cast(bf16x8, pw);
#pragma unroll
            for (int dt = 0; dt < NDT; dt++) {
                const char* vp = cur + C::KBYTES + (dt * 32 + c) * C::VROW + (ps * 16 + 4 * h) * 2;
                const u32x2 v0 = *(const u32x2*)(vp);
                const u32x2 v1 = *(const u32x2*)(vp + 16);
                const bf16x8 vf = __builtin_bit_cast(bf16x8, ((u32x4){v0.x, v0.y, v1.x, v1.y}));
                o[dt] = __builtin_amdgcn_mfma_f32_32x32x16_bf16(vf, pf, o[dt], 0, 0, 0);
            }
        }
        if (t + 1 < nt) lwrite(lds + ((t + 1) & 1) * C::STAGE);
        __syncthreads();
    }
    l += __shfl_xor(l, 32);
    const float inv = 1.f / l;
#pragma unroll
    for (int dt = 0; dt < NDT; dt++)
#pragma unroll
        for (int g4 = 0; g4 < 4; g4++) {
            f32x4 v = {o[dt][4 * g4 + 0] * inv, o[dt][4 * g4 + 1] * inv, o[dt][4 * g4 + 2] * inv, o[dt][4 * g4 + 3] * inv};
            out(wid * 32 + c, dt * 32 + 8 * g4 + 4 * h, v);
        }
}


constexpr size_t SLOT = 33554432;
constexpr size_t OFF_W1T = 0;
constexpr size_t OFF_WQT = OFF_W1T + 1280UL * 1024 * 2;
constexpr size_t OFF_WKVT = OFF_WQT + 768UL * 384 * 2;
constexpr size_t OFF_WOUTT = OFF_WKVT + 1024UL * 256 * 2;
constexpr size_t OFF_WMQT = OFF_WOUTT + 1024UL * 1024 * 2;
constexpr size_t OFF_WMKVT = OFF_WMQT + 1024UL * 1024 * 2;
constexpr size_t OFF_WMOT = OFF_WMKVT + 2048UL * 1024 * 2;
constexpr size_t OFF_WGUT = OFF_WMOT + 1024UL * 1024 * 2;
constexpr size_t OFF_WDT = OFF_WGUT + 16UL * 2048 * 1024 * 2;
constexpr size_t OFF_T64 = OFF_WDT + 16UL * 1024 * 1024 * 2;
constexpr size_t OFF_M1 = OFF_T64 + 16384;
constexpr size_t OFF_M3 = OFF_M1 + 32768;
constexpr size_t OFF_WFT = OFF_M3 + 16384;
constexpr size_t OFF_TW = OFF_WFT + 65536;
constexpr size_t OFF_ROPE = OFF_TW + 32768;
constexpr size_t OFF_R0 = OFF_ROPE + (size_t)NT * 16 * 8;
constexpr size_t OFF_RMEM = OFF_R0 + (size_t)NT * 4;
constexpr size_t OFF_SSQ = OFF_RMEM + 4096;
constexpr size_t OFF_SSKV = OFF_SSQ + (size_t)NT * 6 * 4;
constexpr size_t OFF_SS1 = OFF_SSKV + (size_t)NT * 4 * 4;
constexpr size_t OFF_SS2 = OFF_SS1 + (size_t)NT * 16 * 4;
constexpr size_t OFF_AFF = OFF_SS2 + (size_t)NT * 16 * 4;
constexpr size_t OFF_SLOTS = OFF_AFF + (size_t)NT * 16 * 4;
constexpr size_t OFF_IDX = OFF_SLOTS + 4UL * 16 * 4096 * 4;
constexpr size_t OFF_GATE = OFF_IDX + 4UL * 16 * 512 * 4;
constexpr size_t OFF_MEMB = OFF_GATE + 4UL * 16 * 512 * 4;
constexpr size_t OFF_KMEM = OFF_MEMB + 1024UL * 1024 * 2;
constexpr size_t OFF_VTMEM = OFF_KMEM + 1024UL * 1024 * 2;
constexpr size_t OFF_KR = OFF_VTMEM + 1024UL * 1024 * 2;
constexpr size_t OFF_BAR = OFF_KR + (size_t)NT * 32 * 2;
constexpr size_t OFF_RS2 = OFF_BAR + 16384;
constexpr size_t OFF_RSS = OFF_RS2 + (size_t)NT * 4;
constexpr size_t OFF_S0 = (OFF_RSS + 4UL * 16 * 512 * 4 + 255) / 256 * 256;
constexpr size_t OFF_S1 = OFF_S0 + SLOT;
constexpr size_t OFF_S2 = OFF_S1 + SLOT;
constexpr size_t OFF_S3 = OFF_S2 + SLOT;
constexpr size_t OFF_S4 = OFF_S3 + SLOT;
constexpr size_t WS_END = OFF_S4 + SLOT;
static_assert(WS_END <= 300964352UL, "workspace map exceeds the guaranteed scratch size");
constexpr size_t OFF_XB = OFF_S0, OFF_YR = OFF_S0, OFF_YI = OFF_S0 + SLOT / 2, OFF_X1B = OFF_S3, OFF_OM = OFF_S0, OFF_ACT = OFF_S0;
constexpr size_t OFF_UF = OFF_S1, OFF_UQ = OFF_S1 + (size_t)NT * 512 * 2, OFF_ZA = OFF_S1, OFF_QM = OFF_S1;
constexpr size_t OFF_Q = OFF_S2, OFF_UKV = OFF_S2 + (size_t)NT * 768 * 2, OFF_X2B = OFF_S2;
constexpr size_t OFF_K = OFF_S3, OFF_Y = OFF_S3;
constexpr size_t OFF_VT = OFF_S4;

struct Params {
    const float *x, *mem; const int* pos;
    const float *g_mix, *w_in, *g_q_lat, *w_q_up, *g_kv_lat, *w_kv_up, *w_fourier, *w_out, *g_mem_q, *g_mem_kv, *w_mem_q, *w_mem_kv, *w_mem_o,
        *g_ffn, *w_router, *w_exp_gate, *w_exp_up, *w_exp_down, *g_final;
    float* out; char* ws;
};
template <class T> __device__ __forceinline__ T* wsp(const Params& p, size_t off) { return (T*)(p.ws + off); }

#define LDS_HALF 65536
#define LDS_MAIN 131072
#define LDS_TOTAL (LDS_MAIN + 16)
#define LAS __attribute__((address_space(3)))

#define XB_TMO      128
#define XB_XCNT(j)  (256  + 64 * (j))
#define XB_XSUB(j)  (1280 + 64 * (j))
#define XB_XGEN(j)  (2304 + 64 * (j))
#define XB_TOP      3328
#define XB_TOPGEN   3392
#define XCD_BAR_WORDS 3456
#define XB_SPIN_CAP (1u << 25)
__device__ __forceinline__ unsigned xb_ld(unsigned* p)              { return __hip_atomic_load(p, __ATOMIC_RELAXED, __HIP_MEMORY_SCOPE_AGENT); }
__device__ __forceinline__ unsigned xb_add(unsigned* p, unsigned v) { return __hip_atomic_fetch_add(p, v, __ATOMIC_RELAXED, __HIP_MEMORY_SCOPE_AGENT); }
__device__ __forceinline__ unsigned xb_xcc_id() { return (unsigned)__builtin_amdgcn_s_getreg((3 << 11) | 20) & 0xFu; }
#define XB_SPIN(cond, bar) do { unsigned _sp = 0; while (cond) { __builtin_amdgcn_s_sleep(1); \
    if ((++_sp & 255u) == 0u) { if (xb_ld(&(bar)[XB_TMO])) break; if (_sp > XB_SPIN_CAP) { atomicAdd(&(bar)[XB_TMO], 1u); break; } } } } while (0)
struct XcdBarrier { unsigned* bar; unsigned x; volatile LAS unsigned* st; };
__device__ __forceinline__ XcdBarrier xcd_barrier_post(unsigned* bar, volatile LAS unsigned* st) {
    XcdBarrier b; b.bar = bar; b.x = xb_xcc_id(); b.st = st;
    if (threadIdx.x == 0) (void)xb_add(&bar[XB_XCNT(b.x)], 1u);
    return b;
}
__device__ __forceinline__ void xcd_barrier_complete(unsigned* bar, unsigned x, unsigned& nloc, unsigned& nx) {
    const unsigned G = gridDim.x * gridDim.y * gridDim.z;
    unsigned sum, cnt, mine, sp = 0u;
    for (;;) {
        sum = 0u; cnt = 0u; mine = 0u;
#pragma unroll
        for (unsigned j = 0; j < 16; ++j) { const unsigned c = xb_ld(&bar[XB_XCNT(j)]); sum += c; cnt += (c > 0u) ? 1u : 0u; mine = (j == x) ? c : mine; }
        if (sum == G) break;
        __builtin_amdgcn_s_sleep(1);
        if ((++sp & 255u) == 0u) { if (xb_ld(&bar[XB_TMO])) break; if (sp > XB_SPIN_CAP) { atomicAdd(&bar[XB_TMO], 1u); break; } }
    }
    nloc = mine > 0u ? mine : 1u; nx = cnt > 0u ? cnt : 1u;
}
__device__ __forceinline__ void xcd_barrier(const XcdBarrier& b) {
    asm volatile("s_waitcnt vmcnt(0)" ::: "memory");
    __syncthreads();
    if (threadIdx.x == 0) {
        unsigned* bar = b.bar;
        __builtin_amdgcn_s_waitcnt(0);
        unsigned nloc = b.st[0], nx = b.st[1];
        if (nloc == 0u) { xcd_barrier_complete(bar, b.x, nloc, nx); b.st[0] = nloc; b.st[1] = nx; }
        const unsigned old = xb_add(&bar[XB_XSUB(b.x)], 1u);
        const unsigned gen = old / nloc;
        if (old + 1u == (gen + 1u) * nloc) {
            __builtin_amdgcn_fence(__ATOMIC_RELEASE, "agent");
            asm volatile("s_waitcnt vmcnt(0)" ::: "memory");
            const unsigned og = xb_add(&bar[XB_TOP], 1u);
            const unsigned tg = og / nx;
            if (og + 1u == (tg + 1u) * nx) xb_add(&bar[XB_TOPGEN], 1u);
            else XB_SPIN(xb_ld(&bar[XB_TOPGEN]) == tg, bar);
            __builtin_amdgcn_fence(__ATOMIC_ACQUIRE, "agent");
            xb_add(&bar[XB_XGEN(b.x)], 1u);
            asm volatile("s_waitcnt vmcnt(0)" ::: "memory");
        } else {
            XB_SPIN(xb_ld(&bar[XB_XGEN(b.x)]) == gen, bar);
            __builtin_amdgcn_fence(__ATOMIC_ACQUIRE, "agent");
            asm volatile("s_waitcnt vmcnt(0)" ::: "memory");
        }
    }
    __syncthreads();
}

#define FOR_XCD_ITEMS(item, N) for (int _L = (int)((blockIdx.x >> 3) << 1) | VHALF, item; _L < (N) / 8 && ((item = (int)(blockIdx.x & 7) * ((N) / 8) + _L), true); _L += (int)(gridDim.x >> 2))

__device__ __forceinline__ u32x2 pack4bf(float a, float b, float c, float d) { return (u32x2){pack2bf(a, b), pack2bf(c, d)}; }
__device__ __forceinline__ u32x2 pack4bf(f32x4 v) { return (u32x2){pack2bf(v[0], v[1]), pack2bf(v[2], v[3])}; }
__device__ __forceinline__ float wave_sum(float v) {
#pragma unroll
    for (int o = 32; o > 0; o >>= 1) v += __shfl_xor(v, o);
    return v;
}

__device__ __forceinline__ void tr_tile(const float* W, long ldw, int k0, int n0, int nvalid, const float* gain, bf16_t* Wt, long ldt, int mode, char* lds) {
    float (*t)[132] = (float (*)[132])lds;
    const int tid = VTID, c4 = tid & 31, r0 = tid >> 5;
    f32x4 v[8];
#pragma unroll
    for (int i = 0; i < 8; i++) {
        const int kk = r0 + 8 * i, n = n0 + c4 * 4;
        v[i] = (n < nvalid) ? *(const f32x4*)(W + (long)(k0 + kk) * ldw + n) : (f32x4){0.f, 0.f, 0.f, 0.f};
        if (gain) v[i] *= gain[k0 + kk];
    }
    __syncthreads();
#pragma unroll
    for (int i = 0; i < 8; i++) *(f32x4*)(&t[r0 + 8 * i][c4 * 4]) = v[i];
    __syncthreads();
#pragma unroll
    for (int i = 0; i < 4; i++) {
        const int ci = tid + 256 * i, nn = ci >> 3, kc = ci & 7;
        const int n = n0 + nn;
        int row = n;
        if (mode) row = (n >> 5) * 64 + ((n >> 4) & 1) * 32 + (mode - 1) * 16 + (n & 15);
        u32x4 w;
        w.x = pack2bf(t[kc * 8 + 0][nn], t[kc * 8 + 1][nn]);
        w.y = pack2bf(t[kc * 8 + 2][nn], t[kc * 8 + 3][nn]);
        w.z = pack2bf(t[kc * 8 + 4][nn], t[kc * 8 + 5][nn]);
        w.w = pack2bf(t[kc * 8 + 6][nn], t[kc * 8 + 7][nn]);
        *(u32x4*)(Wt + (long)row * ldt + k0 + kc * 8) = w;
    }
}

__device__ __forceinline__ void phase0(const Params& p, char* lds) {
    constexpr int J_W1 = 160, J_WQ = 36, J_WKV = 32, J_WOUT = 128, J_WMQ = 128, J_WMKV = 256, J_WMO = 128, J_WG = 0, J_WU = 0, J_WD = 0;
    constexpr int J_TR = J_W1 + J_WQ + J_WKV + J_WOUT + J_WMQ + J_WMKV + J_WMO + J_WG + J_WU + J_WD;
    constexpr int J_XR = NT / 16, J_MR = 1024 / 16, J_ROPE = NT * 16 / 256, J_TAB = (4096 + 8192 + 16384 + 8192 + 32768) / 256;
    constexpr int J_ALL = J_TR + J_XR + J_MR + J_ROPE + J_TAB;
    const int tid = VTID, lane = tid & 63, wid = tid >> 6;
    const double PI2 = 6.283185307179586476925286766559;
    for (int job = VBLK; job < J_ALL; job += VGRID) {
        int j = job;
        if (j < J_TR) {
            if (j < J_W1) { tr_tile(p.w_in, INW, (j / 10) * 64, (j % 10) * 128, INW, p.g_mix, wsp<bf16_t>(p, OFF_W1T), 1024, 0, lds); continue; } j -= J_W1;
            if (j < J_WQ) { tr_tile(p.w_q_up, 768, (j / 6) * 64, (j % 6) * 128, 768, p.g_q_lat, wsp<bf16_t>(p, OFF_WQT), 384, 0, lds); continue; } j -= J_WQ;
            if (j < J_WKV) { tr_tile(p.w_kv_up, 1024, (j / 8) * 64, (j % 8) * 128, 1024, p.g_kv_lat, wsp<bf16_t>(p, OFF_WKVT), 256, 0, lds); continue; } j -= J_WKV;
            if (j < J_WOUT) { tr_tile(p.w_out, 1024, (j / 8) * 64, (j % 8) * 128, 1024, nullptr, wsp<bf16_t>(p, OFF_WOUTT), 1024, 0, lds); continue; } j -= J_WOUT;
            if (j < J_WMQ) { tr_tile(p.w_mem_q, 1024, (j / 8) * 64, (j % 8) * 128, 1024, p.g_mem_q, wsp<bf16_t>(p, OFF_WMQT), 1024, 0, lds); continue; } j -= J_WMQ;
            if (j < J_WMKV) { tr_tile(p.w_mem_kv, 2048, (j / 16) * 64, (j % 16) * 128, 2048, p.g_mem_kv, wsp<bf16_t>(p, OFF_WMKVT), 1024, 0, lds); continue; } j -= J_WMKV;
            if (j < J_WMO) { tr_tile(p.w_mem_o, 1024, (j / 8) * 64, (j % 8) * 128, 1024, nullptr, wsp<bf16_t>(p, OFF_WMOT), 1024, 0, lds); continue; } j -= J_WMO;
            if (j < J_WG) { const int e = j >> 7, r = j & 127; tr_tile(p.w_exp_gate + (long)e * 1048576, 1024, (r / 8) * 64, (r % 8) * 128, 1024, p.g_ffn, wsp<bf16_t>(p, OFF_WGUT) + (long)e * 2048 * 1024, 1024, 1, lds); continue; } j -= J_WG;
            if (j < J_WU) { const int e = j >> 7, r = j & 127; tr_tile(p.w_exp_up + (long)e * 1048576, 1024, (r / 8) * 64, (r % 8) * 128, 1024, p.g_ffn, wsp<bf16_t>(p, OFF_WGUT) + (long)e * 2048 * 1024, 1024, 2, lds); continue; } j -= J_WU;
            { const int e = j >> 7, r = j & 127; tr_tile(p.w_exp_down + (long)e * 1048576, 1024, (r / 8) * 64, (r % 8) * 128, 1024, nullptr, wsp<bf16_t>(p, OFF_WDT) + (long)e * 1048576, 1024, 0, lds); continue; }
        }
        j -= J_TR;
        if (j < J_XR + J_MR) {
            const bool isx = j < J_XR;
            const int row0 = (isx ? j : j - J_XR) * 16 + wid * 4;
            const float* src = (isx ? p.x : p.mem) + (long)row0 * ND;
            bf16_t* dst = (isx ? wsp<bf16_t>(p, OFF_XB) : wsp<bf16_t>(p, OFF_MEMB)) + (long)row0 * ND;
            f32x4 v[4][4];
#pragma unroll
            for (int r = 0; r < 4; r++)
#pragma unroll
                for (int i = 0; i < 4; i++) v[r][i] = *(const f32x4*)(src + (long)r * ND + i * 256 + lane * 4);
#pragma unroll
            for (int r = 0; r < 4; r++) {
                float ss = 0.f;
#pragma unroll
                for (int i = 0; i < 4; i++) {
                    ss += v[r][i][0] * v[r][i][0] + v[r][i][1] * v[r][i][1] + v[r][i][2] * v[r][i][2] + v[r][i][3] * v[r][i][3];
                    *(u32x2*)(dst + (long)r * ND + i * 256 + lane * 4) = pack4bf(v[r][i]);
                }
                ss = wave_sum(ss);
                if (lane == 0) (isx ? wsp<float>(p, OFF_R0) : wsp<float>(p, OFF_RMEM))[row0 + r] = rsqrtf(ss * (1.f / ND) + 1e-6f);
            }
            continue;
        }
        j -= J_XR + J_MR;
        if (j < J_ROPE) {
            const int i = j * 256 + tid; const int t = i >> 4, jj = i & 15;
            const double f = pow(10000.0, -(double)(2 * jj) / 32.0);
            const double ang = (double)p.pos[t] * f;
            wsp<float2>(p, OFF_ROPE)[i] = make_float2((float)cos(ang), (float)sin(ang));
            continue;
        }
        j -= J_ROPE;
        {
            int i = j * 256 + tid;
            if (i < 4096) { const double a = PI2 * (double)i / 4096.0; wsp<float2>(p, OFF_TW)[i] = make_float2((float)cos(a), (float)sin(a)); continue; } i -= 4096;
            if (i < 8192) {
                const int T = i >> 12, a = (i >> 6) & 63, b = i & 63;
                const double th = PI2 * (double)((a * b) & 63) / 64.0;
                wsp<bf16_t>(p, OFF_T64)[i] = (bf16_t)f2bf((float)(T ? sin(th) : cos(th))); continue;
            } i -= 8192;
            if (i < 16384) {
                const int rho = i >> 7, k = i & 127;
                const int wm = rho >> 6, mi = (rho >> 4) & 3, lr = rho & 15, ri = mi >> 1, k1 = 32 * wm + 16 * (mi & 1) + lr, ab = k >> 6, s1 = k & 63;
                const double th = PI2 * (double)((k1 * s1) & 63) / 64.0;
                const double c = cos(th), s = sin(th);
                const double v = ri == 0 ? (ab == 0 ? c : -s) : (ab == 0 ? s : c);
                wsp<bf16_t>(p, OFF_M1)[i] = (bf16_t)f2bf((float)v); continue;
            } i -= 16384;
            if (i < 8192) {
                const int k2 = i >> 7, k = i & 127, s2 = k & 63;
                const double th = PI2 * (double)((k2 * s2) & 63) / 64.0;
                wsp<bf16_t>(p, OFF_M3)[i] = (bf16_t)f2bf((float)(k < 64 ? cos(th) : -sin(th))); continue;
            } i -= 8192;
            if (i < 32768) {
                const int g = i >> 12, e = (i >> 6) & 63, ch = i & 63;
                wsp<bf16_t>(p, OFF_WFT)[i] = (bf16_t)f2bf(p.w_fourier[(g * 64 + ch) * 64 + e]); continue;
            }
        }
    }
}

#define FOR_XCD_ITEMS_R(item, N) for (int _L = (int)(blockIdx.x >> 3), item; _L < (N) / 8 && ((item = (int)(blockIdx.x & 7) * ((N) / 8) + _L), true); _L += (int)(gridDim.x >> 3))
__device__ __forceinline__ void gemm_tile_256sq(const GemmTile& g, char* lds, f32x4 (&acc)[8][4]) {
    const int tid = threadIdx.x, lane = tid & 63, wid = tid >> 6, wm = wid >> 2, wn = wid & 3;
    const int lrow = lane >> 3, pc = lane & 7;
    const bf16_t* ap[4]; const bf16_t* bp[4];
#pragma unroll
    for (int i = 0; i < 4; i++) {
        const int r = (wid * 4 + i) * 8 + lrow;
        const int c = pc ^ ((r >> 1) & 7);
        const long ro = g.arow ? (long)g.arow[r] * g.lda : (long)r * g.lda;
        ap[i] = g.A + ro + c * 8;
        bp[i] = g.Bt + (long)r * g.ldb + c * 8;
    }
#pragma unroll
    for (int mi = 0; mi < 8; mi++)
#pragma unroll
        for (int ni = 0; ni < 4; ni++) acc[mi][ni] = (f32x4){0.f, 0.f, 0.f, 0.f};
    const int nk = g.K >> 6;
    auto stage = [&](int kt, char* st) {
#pragma unroll
        for (int i = 0; i < 4; i++) {
            __builtin_amdgcn_global_load_lds((const unsigned*)(ap[i] + kt * 64), (unsigned*)(st + (wid * 4 + i) * 1024), 16, 0, 0);
            __builtin_amdgcn_global_load_lds((const unsigned*)(bp[i] + kt * 64), (unsigned*)(st + 32768 + (wid * 4 + i) * 1024), 16, 0, 0);
        }
    };
    __syncthreads();
    stage(0, lds);
    asm volatile("s_waitcnt vmcnt(0)" ::: "memory");
    __syncthreads();
    for (int kt = 0; kt < nk; kt++) {
        char* cur = lds + (kt & 1) * 65536;
        if (kt + 1 < nk) stage(kt + 1, lds + ((kt + 1) & 1) * 65536);
#pragma unroll
        for (int ks = 0; ks < 2; ks++) {
            bf16x8 af[8], bfr[4];
#pragma unroll
            for (int i = 0; i < 8; i++) af[i] = *(const bf16x8*)(cur + tile_off(wm * 128 + i * 16 + (lane & 15), ks * 4 + (lane >> 4)));
#pragma unroll
            for (int i = 0; i < 4; i++) bfr[i] = *(const bf16x8*)(cur + 32768 + tile_off(wn * 64 + i * 16 + (lane & 15), ks * 4 + (lane >> 4)));
            __builtin_amdgcn_s_setprio(1);
#pragma unroll
            for (int mi = 0; mi < 8; mi++)
#pragma unroll
                for (int ni = 0; ni < 4; ni++)
                    acc[mi][ni] = __builtin_amdgcn_mfma_f32_16x16x32_bf16(bfr[ni], af[mi], acc[mi][ni], 0, 0, 0);
            __builtin_amdgcn_s_setprio(0);
        }
        asm volatile("s_waitcnt vmcnt(0)" ::: "memory");
        __syncthreads();
    }
}


__device__ __forceinline__ void gemm_tile_256x128(const GemmTile& g, char* lds, f32x4 (&acc)[4][4]) {
    const int tid = threadIdx.x, lane = tid & 63, wid = tid >> 6, wm = wid >> 1, wn = wid & 1;
    const int lrow = lane >> 3, pc = lane & 7;
    const bf16_t* ap[4]; const bf16_t* bp[2];
#pragma unroll
    for (int i = 0; i < 4; i++) {
        const int r = (wid * 4 + i) * 8 + lrow;
        const int c = pc ^ ((r >> 1) & 7);
        const long ro = g.arow ? (long)g.arow[r] * g.lda : (long)r * g.lda;
        ap[i] = g.A + ro + c * 8;
    }
#pragma unroll
    for (int i = 0; i < 2; i++) {
        const int r = (wid * 2 + i) * 8 + lrow;
        const int c = pc ^ ((r >> 1) & 7);
        bp[i] = g.Bt + (long)r * g.ldb + c * 8;
    }
#pragma unroll
    for (int mi = 0; mi < 4; mi++)
#pragma unroll
        for (int ni = 0; ni < 4; ni++) acc[mi][ni] = (f32x4){0.f, 0.f, 0.f, 0.f};
    const int nk = g.K >> 6;
    auto stage = [&](int kt, char* st) {
#pragma unroll
        for (int i = 0; i < 4; i++)
            __builtin_amdgcn_global_load_lds((const unsigned*)(ap[i] + kt * 64), (unsigned*)(st + (wid * 4 + i) * 1024), 16, 0, 0);
#pragma unroll
        for (int i = 0; i < 2; i++)
            __builtin_amdgcn_global_load_lds((const unsigned*)(bp[i] + kt * 64), (unsigned*)(st + 32768 + (wid * 2 + i) * 1024), 16, 0, 0);
    };
    __syncthreads();
    stage(0, lds);
    asm volatile("s_waitcnt vmcnt(0)" ::: "memory");
    __syncthreads();
    for (int kt = 0; kt < nk; kt++) {
        char* cur = lds + (kt & 1) * 49152;
        if (kt + 1 < nk) stage(kt + 1, lds + ((kt + 1) & 1) * 49152);
        bf16x8 af[2][4], bfr[2][4];
#pragma unroll
        for (int ks = 0; ks < 2; ks++)
#pragma unroll
            for (int i = 0; i < 4; i++) {
                af[ks][i] = *(const bf16x8*)(cur + tile_off(wm * 64 + i * 16 + (lane & 15), ks * 4 + (lane >> 4)));
                bfr[ks][i] = *(const bf16x8*)(cur + 32768 + tile_off(wn * 64 + i * 16 + (lane & 15), ks * 4 + (lane >> 4)));
            }
        __builtin_amdgcn_s_setprio(1);
#pragma unroll
        for (int ks = 0; ks < 2; ks++)
#pragma unroll
            for (int mi = 0; mi < 4; mi++)
#pragma unroll
                for (int ni = 0; ni < 4; ni++)
                    acc[mi][ni] = __builtin_amdgcn_mfma_f32_16x16x32_bf16(bfr[ks][ni], af[ks][mi], acc[mi][ni], 0, 0, 0);
        __builtin_amdgcn_s_setprio(0);
        asm volatile("s_waitcnt vmcnt(0)" ::: "memory");
        __syncthreads();
    }
}

template <class Setup, class Epi>
__device__ __forceinline__ void gemm_256x128_stream(int nitems, char* lds, Setup setup, Epi epi) {
    const int tid = threadIdx.x, lane = tid & 63, wid = tid >> 6, wm = wid >> 1, wn = wid & 1;
    const int lrow = lane >> 3, pc = lane & 7;
    const int LN = nitems / 8, LS = (int)(gridDim.x >> 3), xb = (int)(blockIdx.x & 7) * LN;
    int L = (int)(blockIdx.x >> 3);
    if (L >= LN) return;
    const bf16_t* ap[4]; const bf16_t* bp[2];
    auto setptr = [&](const GemmTile& g) {
#pragma unroll
        for (int i = 0; i < 4; i++) {
            const int r = (wid * 4 + i) * 8 + lrow;
            const int c = pc ^ ((r >> 1) & 7);
            ap[i] = g.A + (long)r * g.lda + c * 8;
        }
#pragma unroll
        for (int i = 0; i < 2; i++) {
            const int r = (wid * 2 + i) * 8 + lrow;
            const int c = pc ^ ((r >> 1) & 7);
            bp[i] = g.Bt + (long)r * g.ldb + c * 8;
        }
    };
    auto stage = [&](int kt, char* st) {
#pragma unroll
        for (int i = 0; i < 4; i++)
            __builtin_amdgcn_global_load_lds((const unsigned*)(ap[i] + kt * 64), (unsigned*)(st + (wid * 4 + i) * 1024), 16, 0, 0);
#pragma unroll
        for (int i = 0; i < 2; i++)
            __builtin_amdgcn_global_load_lds((const unsigned*)(bp[i] + kt * 64), (unsigned*)(st + 32768 + (wid * 2 + i) * 1024), 16, 0, 0);
    };
    GemmTile g; g.arow = nullptr;
    setup(xb + L, g);
    const int nk = g.K >> 6;
    setptr(g);
    __syncthreads();
    stage(0, lds);
    asm volatile("s_waitcnt vmcnt(0)" ::: "memory");
    __syncthreads();
    int q = 0;
    for (; L < LN; L += LS) {
        f32x4 acc[4][4];
#pragma unroll
        for (int mi = 0; mi < 4; mi++)
#pragma unroll
            for (int ni = 0; ni < 4; ni++) acc[mi][ni] = (f32x4){0.f, 0.f, 0.f, 0.f};
        for (int kt = 0; kt < nk; kt++, q++) {
            char* cur = lds + (q & 1) * 49152;
            char* nxt = lds + ((q + 1) & 1) * 49152;
            if (kt + 1 < nk) stage(kt + 1, nxt);
            else if (L + LS < LN) { setup(xb + L + LS, g); setptr(g); stage(0, nxt); }
            bf16x8 af[2][4], bfr[2][4];
#pragma unroll
            for (int ks = 0; ks < 2; ks++)
#pragma unroll
                for (int i = 0; i < 4; i++) {
                    af[ks][i] = *(const bf16x8*)(cur + tile_off(wm * 64 + i * 16 + (lane & 15), ks * 4 + (lane >> 4)));
                    bfr[ks][i] = *(const bf16x8*)(cur + 32768 + tile_off(wn * 64 + i * 16 + (lane & 15), ks * 4 + (lane >> 4)));
                }
            __builtin_amdgcn_s_setprio(1);
#pragma unroll
            for (int ks = 0; ks < 2; ks++)
#pragma unroll
                for (int mi = 0; mi < 4; mi++)
#pragma unroll
                    for (int ni = 0; ni < 4; ni++)
                        acc[mi][ni] = __builtin_amdgcn_mfma_f32_16x16x32_bf16(bfr[ks][ni], af[ks][mi], acc[mi][ni], 0, 0, 0);
            __builtin_amdgcn_s_setprio(0);
            asm volatile("s_waitcnt vmcnt(0)" ::: "memory");
            __syncthreads();
        }
        epi(xb + L, acc);
    }
}


__device__ __forceinline__ void phase1(const Params& p, char* lds) {
    const int tid = threadIdx.x, lane = tid & 63, wid = tid >> 6, wm = wid >> 1, wn = wid & 1, lq = lane >> 4, lr = lane & 15;
    constexpr int N_U = 64 * 2, N_M = 4 * 16;
    {
      gemm_256x128_stream(N_U, lds, [&](int item, GemmTile& g) {
            const int tm = item >> 1, tn = 8 + (item & 1);
            g.A = wsp<bf16_t>(p, OFF_XB) + (long)tm * 256 * ND; g.lda = ND;
            g.Bt = wsp<bf16_t>(p, OFF_W1T) + (long)tn * 128 * ND; g.ldb = ND; g.K = ND;
        }, [&](int item, f32x4 (&acc)[4][4]) {
            const int tm = item >> 1, tn = 8 + (item & 1);
            const float* r0 = wsp<float>(p, OFF_R0);
#pragma unroll
            for (int mi = 0; mi < 4; mi++) {
                const int row = tm * 256 + wm * 64 + mi * 16 + lr;
                const float rs = r0[row];
#pragma unroll
                for (int ni = 0; ni < 4; ni++) acc[mi][ni] *= rs;
                if (tn < 4) {
#pragma unroll
                    for (int ni = 0; ni < 4; ni++)
                        *(u32x2*)(wsp<bf16_t>(p, OFF_UF) + (long)row * 512 + tn * 128 + wn * 64 + ni * 16 + 4 * lq) = pack4bf(acc[mi][ni]);
                } else if (tn < 9) {
                    float ss = 0.f;
#pragma unroll
                    for (int ni = 0; ni < 4; ni++) { const f32x4 v = acc[mi][ni]; ss += v[0] * v[0] + v[1] * v[1] + v[2] * v[2] + v[3] * v[3]; }
                    ss += __shfl_xor(ss, 16); ss += __shfl_xor(ss, 32);
                    if (tn < 7) {
#pragma unroll
                        for (int ni = 0; ni < 4; ni++)
                            *(u32x2*)(wsp<bf16_t>(p, OFF_UQ) + (long)row * 384 + (tn - 4) * 128 + wn * 64 + ni * 16 + 4 * lq) = pack4bf(acc[mi][ni]);
                        if (lq == 0) wsp<float>(p, OFF_SSQ)[row * 6 + (tn - 4) * 2 + wn] = ss;
                    } else {
#pragma unroll
                        for (int ni = 0; ni < 4; ni++)
                            *(u32x2*)(wsp<bf16_t>(p, OFF_UKV) + (long)row * 256 + (tn - 7) * 128 + wn * 64 + ni * 16 + 4 * lq) = pack4bf(acc[mi][ni]);
                        if (lq == 0) wsp<float>(p, OFF_SSKV)[row * 4 + (tn - 7) * 2 + wn] = ss;
                    }
                } else if (wn == 0) {
                    const float2* rp = wsp<float2>(p, OFF_ROPE) + (long)row * 16 + 4 * lq;
                    f32x4 o1, o2;
#pragma unroll
                    for (int r = 0; r < 4; r++) {
                        const float2 cs = rp[r];
                        const float x1 = acc[mi][0][r], x2 = acc[mi][1][r];
                        o1[r] = x1 * cs.x - x2 * cs.y; o2[r] = x1 * cs.y + x2 * cs.x;
                    }
                    bf16_t* kr = wsp<bf16_t>(p, OFF_KR) + (long)row * 32;
                    *(u32x2*)(kr + 4 * lq) = pack4bf(o1);
                    *(u32x2*)(kr + 16 + 4 * lq) = pack4bf(o2);
                }
            }
        });
      gemm_256x128_stream(N_M, lds, [&](int it, GemmTile& g) {
            const int tm = it / 16, tn = it % 16;
            g.A = wsp<bf16_t>(p, OFF_MEMB) + (long)tm * 256 * ND; g.lda = ND;
            g.Bt = wsp<bf16_t>(p, OFF_WMKVT) + (long)tn * 128 * ND; g.ldb = ND; g.K = ND;
        }, [&](int it, f32x4 (&acc)[4][4]) {
            const int tm = it / 16, tn = it % 16;
            const float* rm = wsp<float>(p, OFF_RMEM);
#pragma unroll
            for (int mi = 0; mi < 4; mi++) {
                const int row = tm * 256 + wm * 64 + mi * 16 + lr;
                const int b = row >> 8, m = row & 255;
                const float rs = rm[row];
#pragma unroll
                for (int ni = 0; ni < 4; ni++) {
                    const f32x4 v = acc[mi][ni] * rs;
                    const int col = tn * 128 + wn * 64 + ni * 16 + 4 * lq;
                    if (col < 1024) {
                        const int h = col >> 8, d = col & 255;
                        *(u32x2*)(wsp<bf16_t>(p, OFF_KMEM) + ((long)(b * 4 + h) * 256 + m) * 256 + d) = pack4bf(v);
                    } else {
                        const int c2 = col - 1024, h = c2 >> 8, dv = c2 & 255;
                        bf16_t* vt = wsp<bf16_t>(p, OFF_VTMEM) + ((long)(b * 4 + h) * 256 + dv) * 256 + m;
#pragma unroll
                        for (int r = 0; r < 4; r++) vt[r * 256] = (bf16_t)f2bf(v[r]);
                    }
                }
            }
        });
    }
}

template <int MI>
__device__ __forceinline__ void dft_mma(const bf16_t* Ag, int arow0, const char* ximg, int ncol0, f32x4 (&acc)[MI][4]) {
    const int lane = VTID & 63, lq = lane >> 4, lr = lane & 15;
#pragma unroll
    for (int ks = 0; ks < 4; ks++) {
        bf16x8 af[MI], bfr[4];
#pragma unroll
        for (int mi = 0; mi < MI; mi++) af[mi] = *(const bf16x8*)(Ag + (long)(arow0 + mi * 16 + lr) * 128 + ks * 32 + lq * 8);
#pragma unroll
        for (int ni = 0; ni < 4; ni++) {
            const char* bp = ximg + (ks * 32 + lq * 8) * 272 + (ncol0 + ni * 16 + lr) * 2;
#pragma unroll
            for (int j = 0; j < 8; j++) bfr[ni][j] = *(const short*)(bp + j * 272);
        }
#pragma unroll
        for (int mi = 0; mi < MI; mi++)
#pragma unroll
            for (int ni = 0; ni < 4; ni++) acc[mi][ni] = __builtin_amdgcn_mfma_f32_16x16x32_bf16(bfr[ni], af[mi], acc[mi][ni], 0, 0, 0);
    }
}

__device__ __forceinline__ void f2a_item(const Params& p, int it, char* lds) {
    const int tid = VTID, lane = tid & 63, wid = tid >> 6, wm = wid >> 1, wn = wid & 1, lq = lane >> 4, lr = lane & 15;
    const int nc = it & 3, s2 = (it >> 2) & 63, b = it >> 8;
    char* uimg = lds; char* ximg = lds + 17408;
    __syncthreads();
#pragma unroll
    for (int i = 0; i < 4; i++) {
        const int ci = tid + 256 * i, row = ci >> 4, cc = ci & 15;
        *(u32x4*)(uimg + row * 272 + cc * 16) = *(const u32x4*)(wsp<bf16_t>(p, OFF_UF) + ((long)(b * NS + 64 * row + s2)) * 512 + nc * 128 + cc * 8);
    }
    __syncthreads();
    {
        const int g2 = wid >> 1, T = wid & 1;
        f32x4 a1[4][4];
#pragma unroll
        for (int mi = 0; mi < 4; mi++)
#pragma unroll
            for (int ni = 0; ni < 4; ni++) a1[mi][ni] = (f32x4){0.f, 0.f, 0.f, 0.f};
        const bf16_t* t64 = wsp<bf16_t>(p, OFF_T64) + T * 4096;
#pragma unroll
        for (int ks = 0; ks < 2; ks++) {
            bf16x8 af[4], bfr[4];
#pragma unroll
            for (int i = 0; i < 4; i++) {
                af[i] = *(const bf16x8*)(uimg + (i * 16 + lr) * 272 + (g2 * 64 + ks * 32 + lq * 8) * 2);
                bfr[i] = *(const bf16x8*)(t64 + (i * 16 + lr) * 64 + ks * 32 + lq * 8);
            }
#pragma unroll
            for (int mi = 0; mi < 4; mi++)
#pragma unroll
                for (int ni = 0; ni < 4; ni++) a1[mi][ni] = __builtin_amdgcn_mfma_f32_16x16x32_bf16(bfr[ni], af[mi], a1[mi][ni], 0, 0, 0);
        }
#pragma unroll
        for (int mi = 0; mi < 4; mi++)
#pragma unroll
            for (int ni = 0; ni < 4; ni++)
                *(u32x2*)(ximg + (T * 64 + mi * 16 + lr) * 272 + (g2 * 64 + ni * 16 + 4 * lq) * 2) = pack4bf(a1[mi][ni]);
    }
    __syncthreads();
    f32x4 acc[4][4];
#pragma unroll
    for (int mi = 0; mi < 4; mi++)
#pragma unroll
        for (int ni = 0; ni < 4; ni++) acc[mi][ni] = (f32x4){0.f, 0.f, 0.f, 0.f};
    dft_mma<4>(wsp<bf16_t>(p, OFF_M1), wm * 64, ximg, wn * 64, acc);
    const float2* tw = wsp<float2>(p, OFF_TW);
#pragma unroll
    for (int m2 = 0; m2 < 2; m2++) {
        const int k1 = 32 * wm + 16 * m2 + lr;
        float2 cs; { const float rev = (float)((s2 * k1) & 4095) * (1.0f / 4096.0f); cs.x = __builtin_amdgcn_cosf(rev); cs.y = __builtin_amdgcn_sinf(rev); (void)tw; }
        const long base = ((long)(b * 64 + k1) * 64 + s2) * 512 + nc * 128 + wn * 64 + 4 * lq;
#pragma unroll
        for (int ni = 0; ni < 4; ni++) {
            const f32x4 yr = acc[m2][ni], yi = acc[m2 + 2][ni];
            const f32x4 orr = yr * cs.x - yi * cs.y, oi = yi * cs.x + yr * cs.y;
            *(u32x2*)(wsp<bf16_t>(p, OFF_YR) + base + ni * 16) = pack4bf(orr);
            *(u32x2*)(wsp<bf16_t>(p, OFF_YI) + base + ni * 16) = pack4bf(oi);
        }
    }
}

__device__ __forceinline__ void f2b_item(const Params& p, int it, char* lds) {
    const int tid = VTID, lane = tid & 63, wid = tid >> 6, wm = wid >> 1, wn = wid & 1, lq = lane >> 4, lr = lane & 15;
    const int nc = it & 3, k1 = (it >> 2) & 63, b = it >> 8;
    char* ximg = lds; char* zimg = lds + 34816;
    __syncthreads();
#pragma unroll
    for (int i = 0; i < 8; i++) {
        const int ci = tid + 256 * i, row = ci >> 4, cc = ci & 15;
        const bf16_t* src = (row < 64 ? wsp<bf16_t>(p, OFF_YR) : wsp<bf16_t>(p, OFF_YI)) + ((long)(b * 64 + k1) * 64 + (row & 63)) * 512 + nc * 128 + cc * 8;
        *(u32x4*)(ximg + row * 272 + cc * 16) = *(const u32x4*)src;
    }
    __syncthreads();
    f32x4 acc[2][4];
#pragma unroll
    for (int mi = 0; mi < 2; mi++)
#pragma unroll
        for (int ni = 0; ni < 4; ni++) acc[mi][ni] = (f32x4){0.f, 0.f, 0.f, 0.f};
    dft_mma<2>(wsp<bf16_t>(p, OFF_M3), wm * 32, ximg, wn * 64, acc);
#pragma unroll
    for (int mi = 0; mi < 2; mi++)
#pragma unroll
        for (int ni = 0; ni < 4; ni++)
            *(u32x2*)(zimg + (wm * 32 + mi * 16 + lr) * 272 + (wn * 64 + ni * 16 + 4 * lq) * 2) = pack4bf(acc[mi][ni] * (1.0f / 512.0f));
    __syncthreads();
    f32x4 a3[2][4];
#pragma unroll
    for (int mi = 0; mi < 2; mi++)
#pragma unroll
        for (int ni = 0; ni < 4; ni++) a3[mi][ni] = (f32x4){0.f, 0.f, 0.f, 0.f};
    const bf16_t* wft = wsp<bf16_t>(p, OFF_WFT) + (long)(nc * 2 + wn) * 4096;
#pragma unroll
    for (int ks = 0; ks < 2; ks++) {
        bf16x8 af[2], bfr[4];
#pragma unroll
        for (int i = 0; i < 2; i++) af[i] = *(const bf16x8*)(zimg + (wm * 32 + i * 16 + lr) * 272 + (wn * 64 + ks * 32 + lq * 8) * 2);
#pragma unroll
        for (int i = 0; i < 4; i++) bfr[i] = *(const bf16x8*)(wft + (i * 16 + lr) * 64 + ks * 32 + lq * 8);
#pragma unroll
        for (int mi = 0; mi < 2; mi++)
#pragma unroll
            for (int ni = 0; ni < 4; ni++) a3[mi][ni] = __builtin_amdgcn_mfma_f32_16x16x32_bf16(bfr[ni], af[mi], a3[mi][ni], 0, 0, 0);
    }
#pragma unroll
    for (int mi = 0; mi < 2; mi++) {
        const int k2 = wm * 32 + mi * 16 + lr;
        bf16_t* dst = wsp<bf16_t>(p, OFF_ZA) + ((long)(b * NS + k1 + 64 * k2)) * 1024 + nc * 128 + wn * 64 + 4 * lq;
#pragma unroll
        for (int ni = 0; ni < 4; ni++) *(u32x2*)(dst + ni * 16) = pack4bf(a3[mi][ni]);
    }
}

__device__ __forceinline__ void phase2(const Params& p, char* lds) {
    const int tid = threadIdx.x, lane = tid & 63, wid = tid >> 6, wm = wid >> 1, wn = wid & 1, lq = lane >> 4, lr = lane & 15;
    constexpr int N_Q = 64 * 6, N_KV = 64 * 8;
    {
      gemm_256x128_stream(N_Q, lds, [&](int item, GemmTile& g) {
            const int tm = item / 6, tn = item % 6;
            g.A = wsp<bf16_t>(p, OFF_UQ) + (long)tm * 256 * 384; g.lda = 384;
            g.Bt = wsp<bf16_t>(p, OFF_WQT) + (long)tn * 128 * 384; g.ldb = 384; g.K = 384;
        }, [&](int item, f32x4 (&acc)[4][4]) {
            const int tm = item / 6, tn = item % 6;
            const float qmul = 0.10206207261596575f * 1.4426950408889634f;
#pragma unroll
            for (int mi = 0; mi < 4; mi++) {
                const int row = tm * 256 + wm * 64 + mi * 16 + lr;
                const int b = row >> 12, s = row & 4095;
                const float* sq = wsp<float>(p, OFF_SSQ) + (long)row * 6;
                const float ss = sq[0] + sq[1] + sq[2] + sq[3] + sq[4] + sq[5];
                const float rs = rsqrtf(ss * (1.f / 384.f) + 1e-6f) * qmul;
                const int cb0 = tn * 128 + wn * 64;
#pragma unroll
                for (int ni = 0; ni < 4; ni++) {
                    const int cb = cb0 + ni * 16, hd = cb / 96, hob = cb % 96;
                    bf16_t* qd = wsp<bf16_t>(p, OFF_Q) + ((long)(b * 8 + hd) * NS + s) * 96;
                    if (hob < 64) {
                        *(u32x2*)(qd + hob + 4 * lq) = pack4bf(acc[mi][ni] * rs);
                    } else if (hob == 64) {
                        if (ni < 3) {
                            const float2* rp = wsp<float2>(p, OFF_ROPE) + (long)row * 16 + 4 * lq;
                            f32x4 o1, o2;
#pragma unroll
                            for (int r = 0; r < 4; r++) {
                                const float2 cs = rp[r];
                                const float x1 = acc[mi][ni][r] * rs, x2 = acc[mi][ni < 3 ? ni + 1 : 3][r] * rs;
                                o1[r] = x1 * cs.x - x2 * cs.y; o2[r] = x1 * cs.y + x2 * cs.x;
                            }
                            *(u32x2*)(qd + 64 + 4 * lq) = pack4bf(o1);
                            *(u32x2*)(qd + 80 + 4 * lq) = pack4bf(o2);
                        }
                    }
                }
            }
        });
      gemm_256x128_stream(N_KV, lds, [&](int it, GemmTile& g) {
            const int tm = it >> 3, hd = it & 7;
            g.A = wsp<bf16_t>(p, OFF_UKV) + (long)tm * 256 * 256; g.lda = 256;
            g.Bt = wsp<bf16_t>(p, OFF_WKVT) + (long)hd * 128 * 256; g.ldb = 256; g.K = 256;
        }, [&](int it, f32x4 (&acc)[4][4]) {
            const int tm = it >> 3, hd = it & 7;
#pragma unroll
            for (int mi = 0; mi < 4; mi++) {
                const int row = tm * 256 + wm * 64 + mi * 16 + lr;
                const int b = row >> 12, s = row & 4095;
                const float* sq = wsp<float>(p, OFF_SSKV) + (long)row * 4;
                const float rs = rsqrtf((sq[0] + sq[1] + sq[2] + sq[3]) * (1.f / 256.f) + 1e-6f);
                if (wn == 0) {
                    bf16_t* kd = wsp<bf16_t>(p, OFF_K) + ((long)(b * 8 + hd) * NS + s) * 96;
#pragma unroll
                    for (int ni = 0; ni < 4; ni++) *(u32x2*)(kd + ni * 16 + 4 * lq) = pack4bf(acc[mi][ni] * rs);
                } else {
#pragma unroll
                    for (int ni = 0; ni < 4; ni++) {
                        bf16_t* vd = wsp<bf16_t>(p, OFF_VT) + ((long)(b * 8 + hd) * 64 + ni * 16 + 4 * lq) * NS + s;
#pragma unroll
                        for (int r = 0; r < 4; r++) vd[(long)r * NS] = (bf16_t)f2bf(acc[mi][ni][r] * rs);
                    }
                }
            }
#pragma unroll
            for (int i = 0; i < 2; i++) {
                const int ci = tid + 512 * i, r = ci >> 2, cc = ci & 3;
                const int row = tm * 256 + r, b = row >> 12, s = row & 4095;
                *(u32x4*)(wsp<bf16_t>(p, OFF_K) + ((long)(b * 8 + hd) * NS + s) * 96 + 64 + cc * 8) = *(const u32x4*)(wsp<bf16_t>(p, OFF_KR) + (long)row * 32 + cc * 8);
            }
        });
    }
}


__device__ __forceinline__ void phase2_f2a(const Params& p, char* lds) {
    FOR_XCD_ITEMS(it, 1024) { f2a_item(p, it, lds); }
}

__device__ __forceinline__ void expert_tr_job(const Params& p, int j, char* lds) {
    const int which = j >> 11, r = j & 2047, e = r >> 7, t = r & 127;
    const int k0 = (t >> 3) * 64, n0 = (t & 7) * 128;
    if (which == 0) tr_tile(p.w_exp_gate + (long)e * 1048576, 1024, k0, n0, 1024, p.g_ffn, wsp<bf16_t>(p, OFF_WGUT) + (long)e * 2048 * 1024, 1024, 1, lds);
    else if (which == 1) tr_tile(p.w_exp_up + (long)e * 1048576, 1024, k0, n0, 1024, p.g_ffn, wsp<bf16_t>(p, OFF_WGUT) + (long)e * 2048 * 1024, 1024, 2, lds);
    else tr_tile(p.w_exp_down + (long)e * 1048576, 1024, k0, n0, 1024, nullptr, wsp<bf16_t>(p, OFF_WDT) + (long)e * 1048576, 1024, 0, lds);
}

__device__ __forceinline__ void phase3_tr(const Params& p, char* lds) {
    for (int j = VBLK; j < 6144; j += VGRID) expert_tr_job(p, j, lds);
}
__device__ __forceinline__ void phase3_f2b(const Params& p, char* lds) {
    FOR_XCD_ITEMS(it, 1024) { f2b_item(p, it, lds); }
}

__device__ __forceinline__ void phase_resid(const Params& p, char* lds, size_t offA, size_t offW, const float* residf, const bf16_t* residb, size_t offXb, size_t offSS) {
    const int tid = VTID, lane = tid & 63, wid = tid >> 6, wm = wid >> 1, wn = wid & 1, lq = lane >> 4, lr = lane & 15;
    FOR_XCD_ITEMS(item, 128 * 8) {
        const int tm = item >> 3, tn = item & 7;
        f32x4 acc[4][4];
        GemmTile g; g.A = wsp<bf16_t>(p, offA) + (long)tm * 128 * ND; g.lda = ND; g.arow = nullptr;
        g.Bt = wsp<bf16_t>(p, offW) + (long)tn * 128 * ND; g.ldb = ND; g.K = ND;
        gemm_tile_128(g, lds, acc);
#pragma unroll
        for (int mi = 0; mi < 4; mi++) {
            const int row = tm * 128 + wm * 64 + mi * 16 + lr;
            float ss = 0.f;
#pragma unroll
            for (int ni = 0; ni < 4; ni++) {
                const long o = (long)row * ND + tn * 128 + wn * 64 + ni * 16 + 4 * lq;
                f32x4 rv;
                if (residf) rv = *(const f32x4*)(residf + o);
                else { const u32x2 w = *(const u32x2*)(residb + o); rv = (f32x4){__uint_as_float(w.x << 16), __uint_as_float(w.x & 0xFFFF0000u), __uint_as_float(w.y << 16), __uint_as_float(w.y & 0xFFFF0000u)}; }
                const f32x4 v = rv + acc[mi][ni];
                *(u32x2*)(wsp<bf16_t>(p, offXb) + o) = pack4bf(v);
                ss += v[0] * v[0] + v[1] * v[1] + v[2] * v[2] + v[3] * v[3];
            }
            ss += __shfl_xor(ss, 16); ss += __shfl_xor(ss, 32);
            if (lq == 0) wsp<float>(p, offSS)[row * 16 + tn * 2 + wn] = ss;
        }
    }
}
__device__ __forceinline__ float row_rs16(const float* ss) {
    const f32x4 a = *(const f32x4*)ss, b = *(const f32x4*)(ss + 4), c = *(const f32x4*)(ss + 8), d = *(const f32x4*)(ss + 12);
    const f32x4 t = (a + b) + (c + d);
    return rsqrtf(((t[0] + t[1]) + (t[2] + t[3])) * (1.f / 1024.f) + 1e-6f);
}

__device__ __forceinline__ void phase5a(const Params& p, char* lds) {
    const int tid = VTID, lane = tid & 63, wid = tid >> 6, wm = wid >> 1, wn = wid & 1, lq = lane >> 4, lr = lane & 15;
    FOR_XCD_ITEMS(item, 128 * 8) {
        const int tm = item >> 3, tn = item & 7;
        f32x4 acc[4][4];
        GemmTile g; g.A = wsp<bf16_t>(p, OFF_X1B) + (long)tm * 128 * ND; g.lda = ND; g.arow = nullptr;
        g.Bt = wsp<bf16_t>(p, OFF_WMQT) + (long)tn * 128 * ND; g.ldb = ND; g.K = ND;
        gemm_tile_128(g, lds, acc);
        const int h = tn >> 1;
#pragma unroll
        for (int mi = 0; mi < 4; mi++) {
            const int row = tm * 128 + wm * 64 + mi * 16 + lr, b = row >> 12, s = row & 4095;
            const float rs = row_rs16(wsp<float>(p, OFF_SS1) + (long)row * 16) * (0.0625f * 1.4426950408889634f);
            bf16_t* qd = wsp<bf16_t>(p, OFF_QM) + ((long)(b * 4 + h) * NS + s) * 256 + (tn & 1) * 128 + wn * 64 + 4 * lq;
#pragma unroll
            for (int ni = 0; ni < 4; ni++) *(u32x2*)(qd + ni * 16) = pack4bf(acc[mi][ni] * rs);
        }
    }
}
__device__ __forceinline__ void phase5b(const Params& p, char* lds) {
    FOR_XCD_ITEMS(item, NB * 4 * 32 * 2) {
        const int dvh = item & 1, qt = (item >> 1) & 31, h = (item >> 6) & 3, b = item >> 8;
        const bf16_t* Qp = wsp<bf16_t>(p, OFF_QM) + ((long)(b * 4 + h) * NS + qt * 128) * 256;
        const bf16_t* Kp = wsp<bf16_t>(p, OFF_KMEM) + ((long)(b * 4 + h) * 256) * 256;
        const bf16_t* Vtp = wsp<bf16_t>(p, OFF_VTMEM) + ((long)(b * 4 + h) * 256 + dvh * 128) * 256;
        bf16_t* Op = wsp<bf16_t>(p, OFF_OM) + ((long)b * NS + qt * 128) * 1024 + h * 256 + dvh * 128;
        attn_block<256, 128, 32, 256>(Qp, Kp, Vtp, 256L, 256, lds, [&](int q, int dv, f32x4 v) { *(u32x2*)(Op + (long)q * 1024 + dv) = pack4bf(v); });
    }
}

__device__ __forceinline__ void phase7(const Params& p, char* lds) {
    const int tid = threadIdx.x, lane = tid & 63, wid = tid >> 6, lq = lane >> 4, lr = lane & 15;
    __syncthreads();
    {
        f32x4 w0[4], w1[4];
#pragma unroll
        for (int it = 0; it < 4; it++) {
            const int u = tid + 512 * it, kp = u >> 2, eq = u & 3;
            w0[it] = *(const f32x4*)(p.w_router + (size_t)(2 * kp) * 16 + eq * 4);
            w1[it] = *(const f32x4*)(p.w_router + (size_t)(2 * kp + 1) * 16 + eq * 4);
        }
#pragma unroll
        for (int it = 0; it < 4; it++) {
            const int u = tid + 512 * it, kp = u >> 2, eq = u & 3, k = 2 * kp;
            const float g0 = p.g_ffn[k], g1 = p.g_ffn[k + 1];
#pragma unroll
            for (int j = 0; j < 4; j++) {
                const int e = eq * 4 + j;
                const float a0 = w0[it][j] * g0, a1 = w1[it][j] * g1;
                const unsigned h0 = f2bf(a0), h1 = f2bf(a1);
                const float r0 = a0 - __uint_as_float(h0 << 16), r1 = a1 - __uint_as_float(h1 << 16);
                const unsigned l0 = f2bf(r0), l1 = f2bf(r1);
                const int off = e * 2048 + ((((k >> 3) ^ e) & 127) << 4) + (k & 7) * 2;
                *(unsigned*)(lds + off) = h0 | (h1 << 16);
                *(unsigned*)(lds + 32768 + off) = l0 | (l1 << 16);
            }
        }
    }
    __syncthreads();
    for (int g = wid * (int)gridDim.x + (int)blockIdx.x; g < NT / 16; g += 8 * (int)gridDim.x) {
        const int t0 = g * 16;
        const bf16_t* xr = wsp<bf16_t>(p, OFF_X2B) + (long)(t0 + lr) * ND + lq * 8;
        bf16x8 xa[32];
#pragma unroll
        for (int ks = 0; ks < 32; ks++) xa[ks] = *(const bf16x8*)(xr + ks * 32);
        const float rsv = row_rs16(wsp<float>(p, OFF_SS2) + (long)(t0 + lr) * 16);
        if (lane < 16) wsp<float>(p, OFF_RS2)[t0 + lane] = rsv;
        f32x4 acc = (f32x4){0.f, 0.f, 0.f, 0.f};
#pragma unroll
        for (int ks = 0; ks < 32; ks++) {
            const int off = lr * 2048 + ((((ks * 4 + lq) ^ lr) & 127) << 4);
            const bf16x8 bh = *(const bf16x8*)(lds + off), bl = *(const bf16x8*)(lds + 32768 + off);
            acc = __builtin_amdgcn_mfma_f32_16x16x32_bf16(xa[ks], bh, acc, 0, 0, 0);
            acc = __builtin_amdgcn_mfma_f32_16x16x32_bf16(xa[ks], bl, acc, 0, 0, 0);
            if ((ks & 3) == 3) asm volatile("" ::: "memory");
        }
#pragma unroll
        for (int r = 0; r < 4; r++) {
            const float lg = acc[r] * __shfl(rsv, lq * 4 + r);
            float mx = lg;
#pragma unroll
            for (int o = 1; o < 16; o <<= 1) mx = fmaxf(mx, __shfl_xor(mx, o));
            const float ex = expf(lg - mx);
            float sm = ex;
#pragma unroll
            for (int o = 1; o < 16; o <<= 1) sm += __shfl_xor(sm, o);
            wsp<float>(p, OFF_AFF)[(long)(t0 + lq * 4 + r) * 16 + lr] = ex / sm;
        }
    }
}

__device__ __forceinline__ int block_sum_i(int v, int* red) {
    const int lane = VTID & 63, wid = VTID >> 6;
#pragma unroll
    for (int o = 32; o > 0; o >>= 1) v += __shfl_xor(v, o);
    __syncthreads();
    if (lane == 0) red[wid] = v;
    __syncthreads();
    return red[0] + red[1] + red[2] + red[3];
}
__device__ __forceinline__ int block_excl_scan_i(int v, int* red, int& total) {
    const int lane = VTID & 63, wid = VTID >> 6;
    int inc = v;
#pragma unroll
    for (int o = 1; o < 64; o <<= 1) { const int t = __shfl_up(inc, o); if (lane >= o) inc += t; }
    __syncthreads();
    if (lane == 63) red[wid] = inc;
    __syncthreads();
    int base = 0;
#pragma unroll
    for (int w = 0; w < 4; w++) if (w < wid) base += red[w];
    total = red[0] + red[1] + red[2] + red[3];
    return base + inc - v;
}
__device__ __forceinline__ void phase8(const Params& p, char* lds) {
    int* red = (int*)lds;
    const int tid = VTID;
    for (int item = VBLK; item < NB * NE; item += VGRID) {
        const int e = item & 15, b = item >> 4;
        const float* aff = wsp<float>(p, OFF_AFF) + (long)b * NS * 16 + e;
        unsigned v[16];
#pragma unroll
        for (int i = 0; i < 16; i++) v[i] = __float_as_uint(aff[(long)(tid * 16 + i) * 16]);
        unsigned T = 0;
        for (int bit = 30; bit >= 0; bit--) {
            const unsigned cand = T | (1u << bit);
            int c = 0;
#pragma unroll
            for (int i = 0; i < 16; i++) c += (v[i] >= cand) ? 1 : 0;
            if (block_sum_i(c, red) >= CAP) T = cand;
        }
        int cg = 0, ce = 0;
#pragma unroll
        for (int i = 0; i < 16; i++) { cg += (v[i] > T) ? 1 : 0; ce += (v[i] == T) ? 1 : 0; }
        int tot;
        const int pk = block_excl_scan_i(cg | (ce << 16), red, tot);
        const int need = CAP - (tot & 0xFFFF);
        const int pe = pk >> 16;
        int nse = need - pe; nse = nse < 0 ? 0 : (nse > ce ? ce : nse);
        int tot2;
        int slot = block_excl_scan_i(cg + nse, red, tot2);
        int* slots = wsp<int>(p, OFF_SLOTS) + (long)(b * NE + e) * NS;
        int* idx = wsp<int>(p, OFF_IDX) + (long)(b * NE + e) * CAP;
        float* gate = wsp<float>(p, OFF_GATE) + (long)(b * NE + e) * CAP;
        float* rss = wsp<float>(p, OFF_RSS) + (long)(b * NE + e) * CAP;
        const float* rs2 = wsp<float>(p, OFF_RS2) + (long)b * NS + tid * 16;
        int eqs = 0;
#pragma unroll
        for (int i = 0; i < 16; i++) {
            const int t = tid * 16 + i;
            bool sel = v[i] > T;
            if (v[i] == T) { sel = eqs < nse; eqs++; }
            if (sel) { slots[t] = slot; idx[slot] = b * NS + t; gate[slot] = __uint_as_float(v[i]); rss[slot] = rs2[i]; slot++; }
            else slots[t] = -1;
        }
    }
}

__device__ __forceinline__ void phase9(const Params& p, char* lds) {
    const int tid = VTID, lane = tid & 63, wid = tid >> 6, wm = wid >> 1, wn = wid & 1, lq = lane >> 4, lr = lane & 15;
    FOR_XCD_ITEMS(item, NE * 16 * NB * 4) {
        const int rt = item & 3, b = (item >> 2) & 3, ct = (item >> 4) & 15, e = item >> 8;
        const int* arow = wsp<int>(p, OFF_IDX) + (long)(b * NE + e) * CAP + rt * 128;
        f32x4 acc[4][4];
        GemmTile g; g.A = wsp<bf16_t>(p, OFF_X2B); g.lda = ND; g.arow = arow;
        g.Bt = wsp<bf16_t>(p, OFF_WGUT) + ((long)e * 2048 + ct * 128) * ND; g.ldb = ND; g.K = ND;
        gemm_tile_128(g, lds, acc);
#pragma unroll
        for (int mi = 0; mi < 4; mi++) {
            const int r = wm * 64 + mi * 16 + lr;
            const int tok = arow[r];
            const float rs = row_rs16(wsp<float>(p, OFF_SS2) + (long)tok * 16);
            bf16_t* ad = wsp<bf16_t>(p, OFF_ACT) + ((long)(e * NB + b) * CAP + rt * 128 + r) * ND + ct * 64 + wn * 32 + 4 * lq;
#pragma unroll
            for (int pp = 0; pp < 2; pp++) {
                f32x4 o;
#pragma unroll
                for (int q = 0; q < 4; q++) {
                    const float ga = acc[mi][2 * pp][q] * rs, up = acc[mi][2 * pp + 1][q] * rs;
                    o[q] = ga / (1.f + __expf(-ga)) * up;
                }
                *(u32x2*)(ad + pp * 16) = pack4bf(o);
            }
        }
    }
}
__device__ __forceinline__ void phase10(const Params& p, char* lds) {
    const int tid = VTID, lane = tid & 63, wid = tid >> 6, wm = wid >> 1, wn = wid & 1, lq = lane >> 4, lr = lane & 15;
    FOR_XCD_ITEMS(item, NE * 8 * NB * 4) {
        const int rt = item & 3, b = (item >> 2) & 3, ct = (item >> 4) & 7, e = item >> 7;
        const long row0 = (long)(e * NB + b) * CAP + rt * 128;
        f32x4 acc[4][4];
        GemmTile g; g.A = wsp<bf16_t>(p, OFF_ACT) + row0 * ND; g.lda = ND; g.arow = nullptr;
        g.Bt = wsp<bf16_t>(p, OFF_WDT) + ((long)e * 1024 + ct * 128) * ND; g.ldb = ND; g.K = ND;
        gemm_tile_128(g, lds, acc);
        const float* gate = wsp<float>(p, OFF_GATE) + (long)(b * NE + e) * CAP + rt * 128;
#pragma unroll
        for (int mi = 0; mi < 4; mi++) {
            const int r = wm * 64 + mi * 16 + lr;
            const float gv = gate[r];
            bf16_t* yd = wsp<bf16_t>(p, OFF_Y) + (row0 + r) * ND + ct * 128 + wn * 64 + 4 * lq;
#pragma unroll
            for (int ni = 0; ni < 4; ni++) *(u32x2*)(yd + ni * 16) = pack4bf(acc[mi][ni] * gv);
        }
    }
}

__device__ __forceinline__ void phase11(const Params& p, char* lds) {
    const int tid = VTID, lane = tid & 63, wid = tid >> 6;
    const int* slots = wsp<int>(p, OFF_SLOTS);
    auto slot_of = [&](int tok) { const int b = tok >> 12, t = tok & 4095; return slots[(long)(b * NE + (lane & 15)) * NS + t]; };
    int tok = VBLK * 4 + wid;
    int sl_next = tok < NT ? slot_of(tok) : -1;
    u32x2 xn[4];
#pragma unroll
    for (int i = 0; i < 4; i++) xn[i] = *(const u32x2*)(wsp<bf16_t>(p, OFF_X2B) + (long)(tok < NT ? tok : 0) * ND + i * 256 + lane * 4);
    for (; tok < NT; tok += VGRID * 4) {
        const int b = tok >> 12;
        float* xr = p.out + (long)tok * ND;
        const int slv = sl_next;
        f32x4 v[4];
#pragma unroll
        for (int i = 0; i < 4; i++)
            v[i] = (f32x4){__uint_as_float(xn[i].x << 16), __uint_as_float(xn[i].x & 0xFFFF0000u), __uint_as_float(xn[i].y << 16), __uint_as_float(xn[i].y & 0xFFFF0000u)};
        {
            const int tn = tok + VGRID * 4;
            sl_next = tn < NT ? slot_of(tn) : -1;
#pragma unroll
            for (int i = 0; i < 4; i++) xn[i] = *(const u32x2*)(wsp<bf16_t>(p, OFF_X2B) + (long)(tn < NT ? tn : tok) * ND + i * 256 + lane * 4);
        }
        unsigned long long sel = __ballot(slv >= 0) & 0xFFFFull;
        while (sel) {
            const int e = __builtin_ctzll(sel); sel &= sel - 1;
            const int sl = __builtin_amdgcn_readlane(slv, e);
            const bf16_t* yr = wsp<bf16_t>(p, OFF_Y) + ((long)(e * NB + b) * CAP + sl) * ND;
#pragma unroll
            for (int i = 0; i < 4; i++) {
                const u32x2 w = *(const u32x2*)(yr + i * 256 + lane * 4);
                v[i][0] += __uint_as_float(w.x << 16); v[i][1] += __uint_as_float(w.x & 0xFFFF0000u);
                v[i][2] += __uint_as_float(w.y << 16); v[i][3] += __uint_as_float(w.y & 0xFFFF0000u);
            }
        }
        float ss = 0.f;
#pragma unroll
        for (int i = 0; i < 4; i++) ss += v[i][0] * v[i][0] + v[i][1] * v[i][1] + v[i][2] * v[i][2] + v[i][3] * v[i][3];
        ss = wave_sum(ss);
        const float rs = rsqrtf(ss * (1.f / ND) + 1e-6f);
#pragma unroll
        for (int i = 0; i < 4; i++) {
            const f32x4 gf = *(const f32x4*)(p.g_final + i * 256 + lane * 4);
            *(f32x4*)(xr + i * 256 + lane * 4) = v[i] * rs * gf;
        }
    }
}


__device__ __forceinline__ void phase_resid8(const Params& p, char* lds, size_t offA, size_t offW, const float* residf, const bf16_t* residb, size_t offXb, size_t offSS) {
    const int tid = threadIdx.x, lane = tid & 63, wid = tid >> 6, wm = wid >> 2, wn = wid & 3, lq = lane >> 4, lr = lane & 15;
    FOR_XCD_ITEMS_R(item, 64 * 4) {
        const int tm = item >> 2, tn = item & 3;
        f32x4 acc[8][4];
        GemmTile g; g.A = wsp<bf16_t>(p, offA) + (long)tm * 256 * ND; g.lda = ND; g.arow = nullptr;
        g.Bt = wsp<bf16_t>(p, offW) + (long)tn * 256 * ND; g.ldb = ND; g.K = ND;
        gemm_tile_256sq(g, lds, acc);
#pragma unroll
        for (int mi = 0; mi < 8; mi++) {
            const int row = tm * 256 + wm * 128 + mi * 16 + lr;
            float ss = 0.f;
#pragma unroll
            for (int ni = 0; ni < 4; ni++) {
                const long o = (long)row * ND + tn * 256 + wn * 64 + ni * 16 + 4 * lq;
                f32x4 rv;
                if (residf) rv = *(const f32x4*)(residf + o);
                else { const u32x2 w = *(const u32x2*)(residb + o); rv = (f32x4){__uint_as_float(w.x << 16), __uint_as_float(w.x & 0xFFFF0000u), __uint_as_float(w.y << 16), __uint_as_float(w.y & 0xFFFF0000u)}; }
                const f32x4 v = rv + acc[mi][ni];
                *(u32x2*)(wsp<bf16_t>(p, offXb) + o) = pack4bf(v);
                ss += v[0] * v[0] + v[1] * v[1] + v[2] * v[2] + v[3] * v[3];
            }
            ss += __shfl_xor(ss, 16); ss += __shfl_xor(ss, 32);
            if (lq == 0) wsp<float>(p, offSS)[row * 16 + tn * 4 + wn] = ss;
        }
    }
}
__device__ __forceinline__ void phase5a8(const Params& p, char* lds) {
    const int tid = threadIdx.x, lane = tid & 63, wid = tid >> 6, wm = wid >> 2, wn = wid & 3, lq = lane >> 4, lr = lane & 15;
    FOR_XCD_ITEMS_R(item, 64 * 4) {
        const int tm = item >> 2, tn = item & 3;
        f32x4 acc[8][4];
        GemmTile g; g.A = wsp<bf16_t>(p, OFF_X1B) + (long)tm * 256 * ND; g.lda = ND; g.arow = nullptr;
        g.Bt = wsp<bf16_t>(p, OFF_WMQT) + (long)tn * 256 * ND; g.ldb = ND; g.K = ND;
        gemm_tile_256sq(g, lds, acc);
#pragma unroll
        for (int mi = 0; mi < 8; mi++) {
            const int row = tm * 256 + wm * 128 + mi * 16 + lr, b = row >> 12, s = row & 4095;
            const float rs = row_rs16(wsp<float>(p, OFF_SS1) + (long)row * 16) * (0.0625f * 1.4426950408889634f);
            bf16_t* qd = wsp<bf16_t>(p, OFF_QM) + ((long)(b * 4 + tn) * NS + s) * 256 + wn * 64 + 4 * lq;
#pragma unroll
            for (int ni = 0; ni < 4; ni++) *(u32x2*)(qd + ni * 16) = pack4bf(acc[mi][ni] * rs);
        }
    }
}


template <class Epi>
__device__ __forceinline__ void gemm_256sq_multi(const bf16_t* A, int lda, const int* arow, const bf16_t* Bt, int ldb, long bstep,
                                                 int K, int ntile, char* lds, Epi epi) {
    const int tid = threadIdx.x, lane = tid & 63, wid = tid >> 6, wm = wid >> 2, wn = wid & 3;
    const int lrow = lane >> 3, pc = lane & 7;
    const char* Ab = (const char*)A; const char* Bb = (const char*)Bt;
    unsigned ao[4], bo[4];
#pragma unroll
    for (int i = 0; i < 4; i++) {
        const int r = (wid * 4 + i) * 8 + lrow;
        const int c = pc ^ ((r >> 1) & 7);
        ao[i] = (unsigned)((arow ? arow[r] : r) * lda + c * 8) * 2u;
        bo[i] = (unsigned)(r * ldb + c * 8) * 2u;
    }
    const int nk = K >> 6;
    auto stage = [&](int kt, long boff, char* st) {
        const char* a0 = Ab + kt * 128;
        const char* b0 = Bb + boff * 2 + kt * 128;
#pragma unroll
        for (int i = 0; i < 4; i++) {
            __builtin_amdgcn_global_load_lds((const unsigned*)(a0 + ao[i]), (unsigned*)(st + (wid * 4 + i) * 1024), 16, 0, 0);
            __builtin_amdgcn_global_load_lds((const unsigned*)(b0 + bo[i]), (unsigned*)(st + 32768 + (wid * 4 + i) * 1024), 16, 0, 0);
        }
    };
    f32x4 acc[8][4];
    __syncthreads();
    stage(0, 0, lds);
    asm volatile("s_waitcnt vmcnt(0)" ::: "memory");
    __syncthreads();
    int q = 0;
    for (int t = 0; t < ntile; t++) {
#pragma unroll
        for (int mi = 0; mi < 8; mi++)
#pragma unroll
            for (int ni = 0; ni < 4; ni++) acc[mi][ni] = (f32x4){0.f, 0.f, 0.f, 0.f};
        const long boff = (long)t * bstep;
        for (int kt = 0; kt < nk; kt++, q++) {
            char* cur = lds + (q & 1) * 65536;
            char* nxt = lds + ((q + 1) & 1) * 65536;
            if (kt + 1 < nk) stage(kt + 1, boff, nxt);
            else if (t + 1 < ntile) stage(0, boff + bstep, nxt);
#pragma unroll
            for (int ks = 0; ks < 2; ks++) {
                bf16x8 af[8], bfr[4];
#pragma unroll
                for (int i = 0; i < 8; i++) af[i] = *(const bf16x8*)(cur + tile_off(wm * 128 + i * 16 + (lane & 15), ks * 4 + (lane >> 4)));
#pragma unroll
                for (int i = 0; i < 4; i++) bfr[i] = *(const bf16x8*)(cur + 32768 + tile_off(wn * 64 + i * 16 + (lane & 15), ks * 4 + (lane >> 4)));
                __builtin_amdgcn_s_setprio(1);
#pragma unroll
                for (int mi = 0; mi < 8; mi++)
#pragma unroll
                    for (int ni = 0; ni < 4; ni++)
                        acc[mi][ni] = __builtin_amdgcn_mfma_f32_16x16x32_bf16(bfr[ni], af[mi], acc[mi][ni], 0, 0, 0);
                __builtin_amdgcn_s_setprio(0);
            }
            asm volatile("s_waitcnt vmcnt(0)" ::: "memory");
            __syncthreads();
        }
        epi(t, acc);
    }
}
__device__ __forceinline__ void phase9_8(const Params& p, char* lds) {
    const int tid = threadIdx.x, lane = tid & 63, wid = tid >> 6, wm = wid >> 2, wn = wid & 3, lq = lane >> 4, lr = lane & 15;
    FOR_XCD_ITEMS_R(si, NE * NB * 2 * 2) {
        const int cth = si & 1, rt = (si >> 1) & 1, b = (si >> 2) & 3, e = si >> 4;
        const int* arow = wsp<int>(p, OFF_IDX) + (long)(b * NE + e) * CAP + rt * 256;
        const float* rss = wsp<float>(p, OFF_RSS) + (long)(b * NE + e) * CAP + rt * 256;
        gemm_256sq_multi(wsp<bf16_t>(p, OFF_X2B), ND, arow, wsp<bf16_t>(p, OFF_WGUT) + ((long)e * 2048 + cth * 1024) * ND, ND, 256L * ND,
                         ND, 4, lds, [&](int t, f32x4 (&acc)[8][4]) {
            const int ct = cth * 4 + t;
            char* adb = (char*)(wsp<bf16_t>(p, OFF_ACT) + ((long)(e * NB + b) * CAP + rt * 256) * ND + ct * 128);
            const unsigned ado = (unsigned)((wm * 128 + lr) * ND + wn * 32 + 4 * lq) * 2u;
#pragma unroll
            for (int mi = 0; mi < 8; mi++) {
                const float rs = rss[wm * 128 + mi * 16 + lr];
#pragma unroll
                for (int pp = 0; pp < 2; pp++) {
                    f32x4 o;
#pragma unroll
                    for (int q = 0; q < 4; q++) {
                        const float ga = acc[mi][2 * pp][q] * rs, up = acc[mi][2 * pp + 1][q] * rs;
                        o[q] = ga / (1.f + __expf(-ga)) * up;
                    }
                    *(u32x2*)(adb + (ado + (unsigned)(mi * 16 * ND * 2 + pp * 32))) = pack4bf(o);
                }
            }
        });
    }
}
__device__ __forceinline__ void phase10_8(const Params& p, char* lds) {
    const int tid = threadIdx.x, lane = tid & 63, wid = tid >> 6, wm = wid >> 2, wn = wid & 3, lq = lane >> 4, lr = lane & 15;
    FOR_XCD_ITEMS_R(si, NE * NB * 2 * 2) {
        const int cth = si & 1, rt = (si >> 1) & 1, b = (si >> 2) & 3, e = si >> 4;
        const long row0 = (long)(e * NB + b) * CAP + rt * 256;
        const float* gate = wsp<float>(p, OFF_GATE) + (long)(b * NE + e) * CAP + rt * 256;
        gemm_256sq_multi(wsp<bf16_t>(p, OFF_ACT) + row0 * ND, ND, nullptr, wsp<bf16_t>(p, OFF_WDT) + ((long)e * 1024 + cth * 512) * ND, ND, 256L * ND,
                         ND, 2, lds, [&](int t, f32x4 (&acc)[8][4]) {
            const int ct = cth * 2 + t;
            char* yb = (char*)(wsp<bf16_t>(p, OFF_Y) + row0 * ND + ct * 256);
            const unsigned yo = (unsigned)((wm * 128 + lr) * ND + wn * 64 + 4 * lq) * 2u;
#pragma unroll
            for (int mi = 0; mi < 8; mi++) {
                const float gv = gate[wm * 128 + mi * 16 + lr];
#pragma unroll
                for (int ni = 0; ni < 4; ni++) *(u32x2*)(yb + (yo + (unsigned)(mi * 16 * ND * 2 + ni * 32))) = pack4bf(acc[mi][ni] * gv);
            }
        });
    }
}


__device__ __forceinline__ void phase1_big(const Params& p, char* lds) {
    const int tid = threadIdx.x, lane = tid & 63, wid = tid >> 6, wm = wid >> 2, wn = wid & 3, lq = lane >> 4, lr = lane & 15;
    FOR_XCD_ITEMS_R(item, 64 * 4) {
        const int tm = item >> 2, tn = item & 3;
        f32x4 acc[8][4];
        GemmTile g; g.A = wsp<bf16_t>(p, OFF_XB) + (long)tm * 256 * ND; g.lda = ND; g.arow = nullptr;
        g.Bt = wsp<bf16_t>(p, OFF_W1T) + (long)tn * 256 * ND; g.ldb = ND; g.K = ND;
        gemm_tile_256sq(g, lds, acc);
        const float* r0 = wsp<float>(p, OFF_R0);
        const int col0 = tn * 256 + wn * 64;
#pragma unroll
        for (int mi = 0; mi < 8; mi++) {
            const int row = tm * 256 + wm * 128 + mi * 16 + lr;
            const float rs = r0[row];
#pragma unroll
            for (int ni = 0; ni < 4; ni++) acc[mi][ni] *= rs;
            if (col0 < 512) {
#pragma unroll
                for (int ni = 0; ni < 4; ni++)
                    *(u32x2*)(wsp<bf16_t>(p, OFF_UF) + (long)row * 512 + col0 + ni * 16 + 4 * lq) = pack4bf(acc[mi][ni]);
            } else {
                float ss = 0.f;
#pragma unroll
                for (int ni = 0; ni < 4; ni++) { const f32x4 v = acc[mi][ni]; ss += v[0] * v[0] + v[1] * v[1] + v[2] * v[2] + v[3] * v[3]; }
                ss += __shfl_xor(ss, 16); ss += __shfl_xor(ss, 32);
                if (col0 < 896) {
#pragma unroll
                    for (int ni = 0; ni < 4; ni++)
                        *(u32x2*)(wsp<bf16_t>(p, OFF_UQ) + (long)row * 384 + (col0 - 512) + ni * 16 + 4 * lq) = pack4bf(acc[mi][ni]);
                    if (lq == 0) wsp<float>(p, OFF_SSQ)[row * 6 + ((col0 - 512) >> 6)] = ss;
                } else {
#pragma unroll
                    for (int ni = 0; ni < 4; ni++)
                        *(u32x2*)(wsp<bf16_t>(p, OFF_UKV) + (long)row * 256 + (col0 - 896) + ni * 16 + 4 * lq) = pack4bf(acc[mi][ni]);
                    if (lq == 0) wsp<float>(p, OFF_SSKV)[row * 4 + ((col0 - 896) >> 6)] = ss;
                }
            }
        }
    }
}


__device__ __forceinline__ void phase3_attn8(const Params& p, char* lds) {
    FOR_XCD_ITEMS_R(item, NB * 8 * (NS / 256)) {
        const int qt = item & 15, h = (item >> 4) & 7, b = item >> 7;
        const bf16_t* Qp = wsp<bf16_t>(p, OFF_Q) + ((long)(b * 8 + h) * NS + qt * 256) * 96;
        const bf16_t* Kp = wsp<bf16_t>(p, OFF_K) + ((long)(b * 8 + h) * NS) * 96;
        const bf16_t* Vtp = wsp<bf16_t>(p, OFF_VT) + ((long)(b * 8 + h) * 64) * NS;
        bf16_t* Op = wsp<bf16_t>(p, OFF_ZA) + ((long)b * NS + qt * 256) * 1024 + 512 + h * 64;
        attn_block<96, 64, 128, 512>(Qp, Kp, Vtp, (long)NS, NS, lds, [&](int q, int dv, f32x4 v) { *(u32x2*)(Op + (long)q * 1024 + dv) = pack4bf(v); });
    }
}
__device__ __forceinline__ void phase5b_8(const Params& p, char* lds) {
    FOR_XCD_ITEMS_R(item, NB * 4 * 16 * 2) {
        const int dvh = item & 1, qt = (item >> 1) & 15, h = (item >> 5) & 3, b = item >> 7;
        const bf16_t* Qp = wsp<bf16_t>(p, OFF_QM) + ((long)(b * 4 + h) * NS + qt * 256) * 256;
        const bf16_t* Kp = wsp<bf16_t>(p, OFF_KMEM) + ((long)(b * 4 + h) * 256) * 256;
        const bf16_t* Vtp = wsp<bf16_t>(p, OFF_VTMEM) + ((long)(b * 4 + h) * 256 + dvh * 128) * 256;
        bf16_t* Op = wsp<bf16_t>(p, OFF_OM) + ((long)b * NS + qt * 256) * 1024 + h * 256 + dvh * 128;
        attn_block<256, 128, 32, 512>(Qp, Kp, Vtp, 256L, 256, lds, [&](int q, int dv, f32x4 v) { *(u32x2*)(Op + (long)q * 1024 + dv) = pack4bf(v); });
    }
}

__global__ void __launch_bounds__(512, 1) k_fwd(Params p, int ph_lo, int ph_hi) {
    extern __shared__ __attribute__((aligned(16))) char lds_all[];
    char* lds = lds_all + VHALF * LDS_HALF;
    volatile LAS unsigned* st = (volatile LAS unsigned*)(lds_all + LDS_MAIN);
    if (threadIdx.x == 0) { st[0] = 0u; st[1] = 0u; }
    __syncthreads();
    XcdBarrier bar = xcd_barrier_post(wsp<unsigned>(p, OFF_BAR), st);
#if USE_CG_SYNC
#define GRID_BARRIER() do { asm volatile("s_waitcnt vmcnt(0)" ::: "memory"); __syncthreads(); cg::this_grid().sync(); asm volatile("s_waitcnt vmcnt(0)" ::: "memory"); __syncthreads(); } while (0)
#else
#define GRID_BARRIER() xcd_barrier(bar)
#endif
#define RUN_PHASE(k, call) if (ph_lo <= (k) && (k) < ph_hi) { if ((k) > ph_lo) { GRID_BARRIER(); } call; }
    RUN_PHASE(0, phase0(p, lds))
    RUN_PHASE(1, (phase1_big(p, lds_all), phase1(p, lds_all)))
    RUN_PHASE(2, (phase2(p, lds_all), phase2_f2a(p, lds)))
    RUN_PHASE(3, ((blockIdx.x & 1) ? phase3_tr(p, lds) : (void)0, phase3_attn8(p, lds_all), phase3_f2b(p, lds), (blockIdx.x & 1) ? (void)0 : phase3_tr(p, lds)))
    RUN_PHASE(4, phase_resid8(p, lds_all, OFF_ZA, OFF_WOUTT, p.x, nullptr, OFF_X1B, OFF_SS1))
    RUN_PHASE(5, phase5a8(p, lds_all))
    RUN_PHASE(6, phase5b_8(p, lds_all))
    RUN_PHASE(7, phase_resid8(p, lds_all, OFF_OM, OFF_WMOT, nullptr, wsp<bf16_t>(p, OFF_X1B), OFF_X2B, OFF_SS2))
    RUN_PHASE(8, phase7(p, lds_all))
    RUN_PHASE(9, phase8(p, lds))
    RUN_PHASE(10, phase9_8(p, lds_all))
    RUN_PHASE(11, phase10_8(p, lds_all))
    RUN_PHASE(12, phase11(p, lds))
}

extern "C" void kernel_launch(void* const* d_in, const int* in_sizes, int n_in,
                              void* d_out, int out_size, void* d_ws, size_t ws_size,
                              hipStream_t stream) {
    static int grid = 0;
    if (grid == 0) {
        if (n_in != 22 || ws_size < WS_END) { fprintf(stderr, "kernel_launch: unexpected inputs (n_in %d, ws %zu < %zu)\n", n_in, ws_size, (size_t)WS_END); grid = -1; return; }
        int dev = 0, cus = 0, per_cu = 0;
        (void)hipGetDevice(&dev);
        (void)hipDeviceGetAttribute(&cus, hipDeviceAttributeMultiprocessorCount, dev);
        if (hipFuncSetAttribute((const void*)k_fwd, hipFuncAttributeMaxDynamicSharedMemorySize, LDS_TOTAL) != hipSuccess) { fprintf(stderr, "kernel_launch: hipFuncSetAttribute failed\n"); grid = -1; return; }
        if (hipOccupancyMaxActiveBlocksPerMultiprocessor(&per_cu, (const void*)k_fwd, 512, LDS_TOTAL) != hipSuccess || per_cu < 1) { fprintf(stderr, "kernel_launch: occupancy query failed (%d)\n", per_cu); (void)hipGetLastError(); per_cu = 1; }
        if (per_cu > 1) per_cu = 1;
        grid = (cus * per_cu) & ~7;
        if (grid < 8) { fprintf(stderr, "kernel_launch: unexpected device (%d CUs)\n", cus); grid = -1; return; }
        fprintf(stderr, "kernel_launch: %d CUs x %d blocks\n", cus, per_cu);
    }
    if (grid < 0) return;
    Params p{};
    p.x = (const float*)d_in[0]; p.mem = (const float*)d_in[1]; p.pos = (const int*)d_in[2];
    p.g_mix = (const float*)d_in[3]; p.w_in = (const float*)d_in[4]; p.g_q_lat = (const float*)d_in[5]; p.w_q_up = (const float*)d_in[6];
    p.g_kv_lat = (const float*)d_in[7]; p.w_kv_up = (const float*)d_in[8]; p.w_fourier = (const float*)d_in[9]; p.w_out = (const float*)d_in[10];
    p.g_mem_q = (const float*)d_in[11]; p.g_mem_kv = (const float*)d_in[12]; p.w_mem_q = (const float*)d_in[13]; p.w_mem_kv = (const float*)d_in[14];
    p.w_mem_o = (const float*)d_in[15]; p.g_ffn = (const float*)d_in[16]; p.w_router = (const float*)d_in[17];
    p.w_exp_gate = (const float*)d_in[18]; p.w_exp_up = (const float*)d_in[19]; p.w_exp_down = (const float*)d_in[20]; p.g_final = (const float*)d_in[21];
    p.out = (float*)d_out; p.ws = (char*)d_ws;
    static const int cuts[] = MK_CUTS;
    const int ncut = (int)(sizeof(cuts) / sizeof(int));
    for (int li = 0; li + 1 < ncut; li++) {
        (void)hipMemsetAsync((char*)d_ws + OFF_BAR, 0, 16384, stream);
        int lo = cuts[li], hi = cuts[li + 1];
        void* args[] = {&p, &lo, &hi};
        hipError_t e = hipLaunchCooperativeKernel((const void*)k_fwd, dim3(grid), dim3(512), args, LDS_TOTAL, stream);
        if (e != hipSuccess) fprintf(stderr, "cooperative launch failed: %s (grid %d)\n", hipGetErrorString(e), grid);
    }
}
```

```cpp
#include <hip/hip_runtime.h>
#include <stdint.h>
#include <cstdio>
#include <hip/hip_cooperative_groups.h>
namespace cg = cooperative_groups;
#ifndef USE_CG_SYNC
#define USE_CG_SYNC 0
#endif

#ifndef MK_CUTS
#define MK_CUTS {0, 13}
#endif

#define NB 4
#define NS 4096
#define ND 1024
#define NT (NB * NS)
#define INW 1184
#define NE 16
#define CAP 512
#define MEML 256
#define NPHASE 13
#define VTID ((int)(threadIdx.x & 255))
#define VHALF (__builtin_amdgcn_readfirstlane((int)(threadIdx.x >> 8)))
#define VBLK ((int)(blockIdx.x * 2) + VHALF)
#define VGRID ((int)(gridDim.x * 2))

typedef unsigned short bf16_t;
typedef short bf16x8 __attribute__((ext_vector_type(8)));
typedef float f32x4 __attribute__((ext_vector_type(4)));
typedef float f32x16 __attribute__((ext_vector_type(16)));
typedef unsigned u32x4 __attribute__((ext_vector_type(4)));
typedef int i32x4 __attribute__((ext_vector_type(4)));
typedef unsigned u32x2 __attribute__((ext_vector_type(2)));

__device__ __forceinline__ unsigned f2bf(float f) {
    unsigned u = __float_as_uint(f);
    u += 0x7FFFu + ((u >> 16) & 1u);
    return u >> 16;
}
typedef __bf16 hbf2 __attribute__((ext_vector_type(2)));
typedef float f32x2 __attribute__((ext_vector_type(2)));
__device__ __forceinline__ unsigned pack2bf(float lo, float hi) { f32x2 v = {lo, hi}; return __builtin_bit_cast(unsigned, __builtin_convertvector(v, hbf2)); }
__device__ __forceinline__ float bf2f(unsigned short b) { return __uint_as_float(((unsigned)b) << 16); }

__device__ __forceinline__ int tile_off(int row, int chunk) { return row * 128 + ((chunk ^ ((row >> 1) & 7)) << 4); }

#define GT_LDS_BYTES 65536

struct GemmTile { const bf16_t* A; long lda; const int* arow; const bf16_t* Bt; long ldb; int K; };

__device__ __forceinline__ void gemm_tile_128(const GemmTile& g, char* lds, f32x4 (&acc)[4][4]) {
    const int tid = VTID, lane = tid & 63, wid = tid >> 6, wm = wid >> 1, wn = wid & 1;
    const int lrow = lane >> 3, pc = lane & 7;
    const bf16_t* ap[4]; const bf16_t* bp[4];
#pragma unroll
    for (int i = 0; i < 4; i++) {
        const int r = (wid * 4 + i) * 8 + lrow;
        const int c = pc ^ ((r >> 1) & 7);
        const long ro = g.arow ? (long)g.arow[r] * g.lda : (long)r * g.lda;
        ap[i] = g.A + ro + c * 8;
        bp[i] = g.Bt + (long)r * g.ldb + c * 8;
    }
#pragma unroll
    for (int mi = 0; mi < 4; mi++)
#pragma unroll
        for (int ni = 0; ni < 4; ni++) acc[mi][ni] = (f32x4){0.f, 0.f, 0.f, 0.f};
    const int nk = g.K >> 6;
    auto stage = [&](int kt, char* st) {
#pragma unroll
        for (int i = 0; i < 4; i++) {
            __builtin_amdgcn_global_load_lds((const unsigned*)(ap[i] + kt * 64), (unsigned*)(st + (wid * 4 + i) * 1024), 16, 0, 0);
            __builtin_amdgcn_global_load_lds((const unsigned*)(bp[i] + kt * 64), (unsigned*)(st + 16384 + (wid * 4 + i) * 1024), 16, 0, 0);
        }
    };
    __syncthreads();
    stage(0, lds);
    asm volatile("s_waitcnt vmcnt(0)" ::: "memory");
    __syncthreads();
    for (int kt = 0; kt < nk; kt++) {
        char* cur = lds + (kt & 1) * 32768;
        if (kt + 1 < nk) stage(kt + 1, lds + ((kt + 1) & 1) * 32768);
        bf16x8 af[2][4], bfr[2][4];
#pragma unroll
        for (int ks = 0; ks < 2; ks++)
#pragma unroll
            for (int i = 0; i < 4; i++) {
                af[ks][i] = *(const bf16x8*)(cur + tile_off(wm * 64 + i * 16 + (lane & 15), ks * 4 + (lane >> 4)));
                bfr[ks][i] = *(const bf16x8*)(cur + 16384 + tile_off(wn * 64 + i * 16 + (lane & 15), ks * 4 + (lane >> 4)));
            }
        __builtin_amdgcn_s_setprio(1);
#pragma unroll
        for (int ks = 0; ks < 2; ks++)
#pragma unroll
            for (int mi = 0; mi < 4; mi++)
#pragma unroll
                for (int ni = 0; ni < 4; ni++)
                    acc[mi][ni] = __builtin_amdgcn_mfma_f32_16x16x32_bf16(bfr[ks][ni], af[ks][mi], acc[mi][ni], 0, 0, 0);
        __builtin_amdgcn_s_setprio(0);
        asm volatile("s_waitcnt vmcnt(0)" ::: "memory");
        __syncthreads();
    }
}

template <int DQK, int DVT, int KT>
struct AttnCfg {
    static constexpr int KROW = DQK * 2 + 16;
    static constexpr int VROW = KT * 2 + 8;
    static constexpr int KBYTES = KT * KROW;
    static constexpr int VBYTES = DVT * VROW;
    static constexpr int STAGE = KBYTES + VBYTES;
    static constexpr int LDS = 2 * STAGE;
};

template <int DQK, int DVT, int KT, int NTH, class Out>
__device__ __forceinline__ void attn_block(const bf16_t* Qp, const bf16_t* Kp, const bf16_t* Vtp, long ldv, int nk, char* lds, Out&& out) {
    typedef AttnCfg<DQK, DVT, KT> C;
    constexpr int NKS = DQK / 16, NST = KT / 32, NDT = DVT / 32, NPS = KT / 16;
    constexpr int KCPR = DQK / 8;
    constexpr int KTOT = KT * KCPR, KCH = (KTOT + NTH - 1) / NTH;
    constexpr int VCPR = KT / 8;
    constexpr int VTOT = DVT * VCPR, VCH = (VTOT + NTH - 1) / NTH;
    const int tid = NTH == 512 ? (int)threadIdx.x : VTID, lane = tid & 63, wid = tid >> 6, h = lane >> 5, c = lane & 31;

    bf16x8 qf[NKS];
    {
        const bf16_t* qrow = Qp + (long)(wid * 32 + c) * DQK + 8 * h;
#pragma unroll
        for (int ks = 0; ks < NKS; ks++) qf[ks] = *(const bf16x8*)(qrow + 16 * ks);
    }
    f32x16 o[NDT];
#pragma unroll
    for (int dt = 0; dt < NDT; dt++)
#pragma unroll
        for (int r = 0; r < 16; r++) o[dt][r] = 0.f;
    float m = 0.f, l = 0.f;

    u32x4 kr[KCH], vr[VCH];
    auto gload = [&](int t) {
#pragma unroll
        for (int i = 0; i < KCH; i++) {
            const int ci = tid + NTH * i, row = ci / KCPR, cc = ci % KCPR;
            if (KTOT % NTH == 0 || ci < KTOT) kr[i] = *(const u32x4*)(Kp + (long)(t * KT + row) * DQK + cc * 8);
        }
#pragma unroll
        for (int i = 0; i < VCH; i++) {
            const int ci = tid + NTH * i, row = ci / VCPR, cc = ci % VCPR;
            if (VTOT % NTH == 0 || ci < VTOT) vr[i] = *(const u32x4*)(Vtp + (long)row * ldv + t * KT + cc * 8);
        }
    };
    auto lwrite = [&](char* st) {
#pragma unroll
        for (int i = 0; i < KCH; i++) {
            const int ci = tid + NTH * i, row = ci / KCPR, cc = ci % KCPR;
            if (KTOT % NTH == 0 || ci < KTOT) *(u32x4*)(st + row * C::KROW + cc * 16) = kr[i];
        }
#pragma unroll
        for (int i = 0; i < VCH; i++) {
            const int ci = tid + NTH * i, row = ci / VCPR, cc = ci % VCPR;
            if (VTOT % NTH == 0 || ci < VTOT) {
                char* p = st + C::KBYTES + row * C::VROW + cc * 16;
                *(u32x2*)(p) = (u32x2){vr[i].x, vr[i].y};
                *(u32x2*)(p + 8) = (u32x2){vr[i].z, vr[i].w};
            }
        }
    };
    const int nt = nk / KT;
    gload(0);
    __syncthreads();
    lwrite(lds);
    __syncthreads();
    for (int t = 0; t < nt; t++) {
        char* cur = lds + (t & 1) * C::STAGE;
        if (t + 1 < nt) gload(t + 1);
        f32x16 s[NST];
        const float negm = -m;
#pragma unroll
        for (int st = 0; st < NST; st++) {
#pragma unroll
            for (int r = 0; r < 16; r++) s[st][r] = negm;
#pragma unroll
            for (int ks = 0; ks < NKS; ks++) {
                const bf16x8 kf = *(const bf16x8*)(cur + (st * 32 + c) * C::KROW + ks * 32 + h * 16);
                s[st] = __builtin_amdgcn_mfma_f32_32x32x16_bf16(kf, qf[ks], s[st], 0, 0, 0);
            }
        }
        float mx = s[0][0];
#pragma unroll
        for (int st = 0; st < NST; st++)
#pragma unroll
            for (int r = 0; r < 16; r++) mx = fmaxf(mx, s[st][r]);
        mx = fmaxf(mx, __shfl_xor(mx, 32));
        if (__any(mx > 8.0f)) {
            const float d = fmaxf(mx, 0.f);
            const float alpha = __builtin_amdgcn_exp2f(-d);
            m += d;
            l *= alpha;
#pragma unroll
            for (int dt = 0; dt < NDT; dt++)
#pragma unroll
                for (int r = 0; r < 16; r++) o[dt][r] *= alpha;
#pragma unroll
            for (int st = 0; st < NST; st++)
#pragma unroll
                for (int r = 0; r < 16; r++) s[st][r] -= d;
        }
        float rs = 0.f;
#pragma unroll
        for (int st = 0; st < NST; st++)
#pragma unroll
            for (int r = 0; r < 16; r++) { const float p = __builtin_amdgcn_exp2f(s[st][r]); rs += p; s[st][r] = p; }
        l += rs;
#pragma unroll
        for (int ps = 0; ps < NPS; ps++) {
            const int st = ps >> 1, u = ps & 1;
            u32x4 pw;
            pw.x = pack2bf(s[st][8 * u + 0], s[st][8 * u + 1]);
            pw.y = pack2bf(s[st][8 * u + 2], s[st][8 * u + 3]);
            pw.z = pack2bf(s[st][8 * u + 4], s[st][8 * u + 5]);
            pw.w = pack2bf(s[st][8 * u + 6], s[st][8 * u + 7]);
            const bf16x8 pf = __builtin_bit_cast(bf16x8, pw);
#pragma unroll
            for (int dt = 0; dt < NDT; dt++) {
                const char* vp = cur + C::KBYTES + (dt * 32 + c) * C::VROW + (ps * 16 + 4 * h) * 2;
                const u32x2 v0 = *(const u32x2*)(vp);
                const u32x2 v1 = *(const u32x2*)(vp + 16);
                const bf16x8 vf = __builtin_bit_cast(bf16x8, ((u32x4){v0.x, v0.y, v1.x, v1.y}));
                o[dt] = __builtin_amdgcn_mfma_f32_32x32x16_bf16(vf, pf, o[dt], 0, 0, 0);
            }
        }
        if (t + 1 < nt) lwrite(lds + ((t + 1) & 1) * C::STAGE);
        __syncthreads();
    }
    l += __shfl_xor(l, 32);
    const float inv = 1.f / l;
#pragma unroll
    for (int dt = 0; dt < NDT; dt++)
#pragma unroll
        for (int g4 = 0; g4 < 4; g4++) {
            f32x4 v = {o[dt][4 * g4 + 0] * inv, o[dt][4 * g4 + 1] * inv, o[dt][4 * g4 + 2] * inv, o[dt][4 * g4 + 3] * inv};
            out(wid * 32 + c, dt * 32 + 8 * g4 + 4 * h, v);
        }
}


constexpr size_t SLOT = 33554432;
constexpr size_t OFF_W1T = 0;
constexpr size_t OFF_WQT = OFF_W1T + 1280UL * 1024 * 2;
constexpr size_t OFF_WKVT = OFF_WQT + 768UL * 384 * 2;
constexpr size_t OFF_WOUTT = OFF_WKVT + 1024UL * 256 * 2;
constexpr size_t OFF_WMQT = OFF_WOUTT + 1024UL * 1024 * 2;
constexpr size_t OFF_WMKVT = OFF_WMQT + 1024UL * 1024 * 2;
constexpr size_t OFF_WMOT = OFF_WMKVT + 2048UL * 1024 * 2;
constexpr size_t OFF_WGUT = OFF_WMOT + 1024UL * 1024 * 2;
constexpr size_t OFF_WDT = OFF_WGUT + 16UL * 2048 * 1024 * 2;
constexpr size_t OFF_T64 = OFF_WDT + 16UL * 1024 * 1024 * 2;
constexpr size_t OFF_M1 = OFF_T64 + 16384;
constexpr size_t OFF_M3 = OFF_M1 + 32768;
constexpr size_t OFF_WFT = OFF_M3 + 16384;
constexpr size_t OFF_TW = OFF_WFT + 65536;
constexpr size_t OFF_ROPE = OFF_TW + 32768;
constexpr size_t OFF_R0 = OFF_ROPE + (size_t)NT * 16 * 8;
constexpr size_t OFF_RMEM = OFF_R0 + (size_t)NT * 4;
constexpr size_t OFF_SSQ = OFF_RMEM + 4096;
constexpr size_t OFF_SSKV = OFF_SSQ + (size_t)NT * 6 * 4;
constexpr size_t OFF_SS1 = OFF_SSKV + (size_t)NT * 4 * 4;
constexpr size_t OFF_SS2 = OFF_SS1 + (size_t)NT * 16 * 4;
constexpr size_t OFF_AFF = OFF_SS2 + (size_t)NT * 16 * 4;
constexpr size_t OFF_SLOTS = OFF_AFF + (size_t)NT * 16 * 4;
constexpr size_t OFF_IDX = OFF_SLOTS + 4UL * 16 * 4096 * 4;
constexpr size_t OFF_GATE = OFF_IDX + 4UL * 16 * 512 * 4;
constexpr size_t OFF_MEMB = OFF_GATE + 4UL * 16 * 512 * 4;
constexpr size_t OFF_KMEM = OFF_MEMB + 1024UL * 1024 * 2;
constexpr size_t OFF_VTMEM = OFF_KMEM + 1024UL * 1024 * 2;
constexpr size_t OFF_KR = OFF_VTMEM + 1024UL * 1024 * 2;
constexpr size_t OFF_BAR = OFF_KR + (size_t)NT * 32 * 2;
constexpr size_t OFF_RS2 = OFF_BAR + 16384;
constexpr size_t OFF_RSS = OFF_RS2 + (size_t)NT * 4;
constexpr size_t OFF_S0 = (OFF_RSS + 4UL * 16 * 512 * 4 + 255) / 256 * 256;
constexpr size_t OFF_S1 = OFF_S0 + SLOT;
constexpr size_t OFF_S2 = OFF_S1 + SLOT;
constexpr size_t OFF_S3 = OFF_S2 + SLOT;
constexpr size_t OFF_S4 = OFF_S3 + SLOT;
constexpr size_t WS_END = OFF_S4 + SLOT;
static_assert(WS_END <= 300964352UL, "workspace map exceeds the guaranteed scratch size");
constexpr size_t OFF_XB = OFF_S0, OFF_YR = OFF_S0, OFF_YI = OFF_S0 + SLOT / 2, OFF_X1B = OFF_S3, OFF_OM = OFF_S0, OFF_ACT = OFF_S0;
constexpr size_t OFF_UF = OFF_S1, OFF_UQ = OFF_S1 + (size_t)NT * 512 * 2, OFF_ZA = OFF_S1, OFF_QM = OFF_S1;
constexpr size_t OFF_Q = OFF_S2, OFF_UKV = OFF_S2 + (size_t)NT * 768 * 2, OFF_X2B = OFF_S2;
constexpr size_t OFF_K = OFF_S3, OFF_Y = OFF_S3;
constexpr size_t OFF_VT = OFF_S4;

struct Params {
    const float *x, *mem; const int* pos;
    const float *g_mix, *w_in, *g_q_lat, *w_q_up, *g_kv_lat, *w_kv_up, *w_fourier, *w_out, *g_mem_q, *g_mem_kv, *w_mem_q, *w_mem_kv, *w_mem_o,
        *g_ffn, *w_router, *w_exp_gate, *w_exp_up, *w_exp_down, *g_final;
    float* out; char* ws;
};
template <class T> __device__ __forceinline__ T* wsp(const Params& p, size_t off) { return (T*)(p.ws + off); }

#define LDS_HALF 65536
#define LDS_MAIN 131072
#define LDS_TOTAL (LDS_MAIN + 16)
#define LAS __attribute__((address_space(3)))

#define XB_TMO      128
#define XB_XCNT(j)  (256  + 64 * (j))
#define XB_XSUB(j)  (1280 + 64 * (j))
#define XB_XGEN(j)  (2304 + 64 * (j))
#define XB_TOP      3328
#define XB_TOPGEN   3392
#define XCD_BAR_WORDS 3456
#define XB_SPIN_CAP (1u << 25)
__device__ __forceinline__ unsigned xb_ld(unsigned* p)              { return __hip_atomic_load(p, __ATOMIC_RELAXED, __HIP_MEMORY_SCOPE_AGENT); }
__device__ __forceinline__ unsigned xb_add(unsigned* p, unsigned v) { return __hip_atomic_fetch_add(p, v, __ATOMIC_RELAXED, __HIP_MEMORY_SCOPE_AGENT); }
__device__ __forceinline__ unsigned xb_xcc_id() { return (unsigned)__builtin_amdgcn_s_getreg((3 << 11) | 20) & 0xFu; }
#define XB_SPIN(cond, bar) do { unsigned _sp = 0; while (cond) { __builtin_amdgcn_s_sleep(1); \
    if ((++_sp & 255u) == 0u) { if (xb_ld(&(bar)[XB_TMO])) break; if (_sp > XB_SPIN_CAP) { atomicAdd(&(bar)[XB_TMO], 1u); break; } } } } while (0)
struct XcdBarrier { unsigned* bar; unsigned x; volatile LAS unsigned* st; };
__device__ __forceinline__ XcdBarrier xcd_barrier_post(unsigned* bar, volatile LAS unsigned* st) {
    XcdBarrier b; b.bar = bar; b.x = xb_xcc_id(); b.st = st;
    if (threadIdx.x == 0) (void)xb_add(&bar[XB_XCNT(b.x)], 1u);
    return b;
}
__device__ __forceinline__ void xcd_barrier_complete(unsigned* bar, unsigned x, unsigned& nloc, unsigned& nx) {
    const unsigned G = gridDim.x * gridDim.y * gridDim.z;
    unsigned sum, cnt, mine, sp = 0u;
    for (;;) {
        sum = 0u; cnt = 0u; mine = 0u;
#pragma unroll
        for (unsigned j = 0; j < 16; ++j) { const unsigned c = xb_ld(&bar[XB_XCNT(j)]); sum += c; cnt += (c > 0u) ? 1u : 0u; mine = (j == x) ? c : mine; }
        if (sum == G) break;
        __builtin_amdgcn_s_sleep(1);
        if ((++sp & 255u) == 0u) { if (xb_ld(&bar[XB_TMO])) break; if (sp > XB_SPIN_CAP) { atomicAdd(&bar[XB_TMO], 1u); break; } }
    }
    nloc = mine > 0u ? mine : 1u; nx = cnt > 0u ? cnt : 1u;
}
__device__ __forceinline__ void xcd_barrier(const XcdBarrier& b) {
    asm volatile("s_waitcnt vmcnt(0)" ::: "memory");
    __syncthreads();
    if (threadIdx.x == 0) {
        unsigned* bar = b.bar;
        __builtin_amdgcn_s_waitcnt(0);
        unsigned nloc = b.st[0], nx = b.st[1];
        if (nloc == 0u) { xcd_barrier_complete(bar, b.x, nloc, nx); b.st[0] = nloc; b.st[1] = nx; }
        const unsigned old = xb_add(&bar[XB_XSUB(b.x)], 1u);
        const unsigned gen = old / nloc;
        if (old + 1u == (gen + 1u) * nloc) {
            __builtin_amdgcn_fence(__ATOMIC_RELEASE, "agent");
            asm volatile("s_waitcnt vmcnt(0)" ::: "memory");
            const unsigned og = xb_add(&bar[XB_TOP], 1u);
            const unsigned tg = og / nx;
            if (og + 1u == (tg + 1u) * nx) xb_add(&bar[XB_TOPGEN], 1u);
            else XB_SPIN(xb_ld(&bar[XB_TOPGEN]) == tg, bar);
            __builtin_amdgcn_fence(__ATOMIC_ACQUIRE, "agent");
            xb_add(&bar[XB_XGEN(b.x)], 1u);
            asm volatile("s_waitcnt vmcnt(0)" ::: "memory");
        } else {
            XB_SPIN(xb_ld(&bar[XB_XGEN(b.x)]) == gen, bar);
            __builtin_amdgcn_fence(__ATOMIC_ACQUIRE, "agent");
            asm volatile("s_waitcnt vmcnt(0)" ::: "memory");
        }
    }
    __syncthreads();
}

#define FOR_XCD_ITEMS(item, N) for (int _L = (int)((blockIdx.x >> 3) << 1) | VHALF, item; _L < (N) / 8 && ((item = (int)(blockIdx.x & 7) * ((N) / 8) + _L), true); _L += (int)(gridDim.x >> 2))

__device__ __forceinline__ u32x2 pack4bf(float a, float b, float c, float d) { return (u32x2){pack2bf(a, b), pack2bf(c, d)}; }
__device__ __forceinline__ u32x2 pack4bf(f32x4 v) { return (u32x2){pack2bf(v[0], v[1]), pack2bf(v[2], v[3])}; }
__device__ __forceinline__ float wave_sum(float v) {
#pragma unroll
    for (int o = 32; o > 0; o >>= 1) v += __shfl_xor(v, o);
    return v;
}

__device__ __forceinline__ void tr_tile(const float* W, long ldw, int k0, int n0, int nvalid, const float* gain, bf16_t* Wt, long ldt, int mode, char* lds) {
    float (*t)[132] = (float (*)[132])lds;
    const int tid = VTID, c4 = tid & 31, r0 = tid >> 5;
    f32x4 v[8];
#pragma unroll
    for (int i = 0; i < 8; i++) {
        const int kk = r0 + 8 * i, n = n0 + c4 * 4;
        v[i] = (n < nvalid) ? *(const f32x4*)(W + (long)(k0 + kk) * ldw + n) : (f32x4){0.f, 0.f, 0.f, 0.f};
        if (gain) v[i] *= gain[k0 + kk];
    }
    __syncthreads();
#pragma unroll
    for (int i = 0; i < 8; i++) *(f32x4*)(&t[r0 + 8 * i][c4 * 4]) = v[i];
    __syncthreads();
#pragma unroll
    for (int i = 0; i < 4; i++) {
        const int ci = tid + 256 * i, nn = ci >> 3, kc = ci & 7;
        const int n = n0 + nn;
        int row = n;
        if (mode) row = (n >> 5) * 64 + ((n >> 4) & 1) * 32 + (mode - 1) * 16 + (n & 15);
        u32x4 w;
        w.x = pack2bf(t[kc * 8 + 0][nn], t[kc * 8 + 1][nn]);
        w.y = pack2bf(t[kc * 8 + 2][nn], t[kc * 8 + 3][nn]);
        w.z = pack2bf(t[kc * 8 + 4][nn], t[kc * 8 + 5][nn]);
        w.w = pack2bf(t[kc * 8 + 6][nn], t[kc * 8 + 7][nn]);
        *(u32x4*)(Wt + (long)row * ldt + k0 + kc * 8) = w;
    }
}

__device__ __forceinline__ void phase0(const Params& p, char* lds) {
    constexpr int J_W1 = 160, J_WQ = 36, J_WKV = 32, J_WOUT = 128, J_WMQ = 128, J_WMKV = 256, J_WMO = 128, J_WG = 0, J_WU = 0, J_WD = 0;
    constexpr int J_TR = J_W1 + J_WQ + J_WKV + J_WOUT + J_WMQ + J_WMKV + J_WMO + J_WG + J_WU + J_WD;
    constexpr int J_XR = NT / 16, J_MR = 1024 / 16, J_ROPE = NT * 16 / 256, J_TAB = (4096 + 8192 + 16384 + 8192 + 32768) / 256;
    constexpr int J_ALL = J_TR + J_XR + J_MR + J_ROPE + J_TAB;
    const int tid = VTID, lane = tid & 63, wid = tid >> 6;
    const double PI2 = 6.283185307179586476925286766559;
    for (int job = VBLK; job < J_ALL; job += VGRID) {
        int j = job;
        if (j < J_TR) {
            if (j < J_W1) { tr_tile(p.w_in, INW, (j / 10) * 64, (j % 10) * 128, INW, p.g_mix, wsp<bf16_t>(p, OFF_W1T), 1024, 0, lds); continue; } j -= J_W1;
            if (j < J_WQ) { tr_tile(p.w_q_up, 768, (j / 6) * 64, (j % 6) * 128, 768, p.g_q_lat, wsp<bf16_t>(p, OFF_WQT), 384, 0, lds); continue; } j -= J_WQ;
            if (j < J_WKV) { tr_tile(p.w_kv_up, 1024, (j / 8) * 64, (j % 8) * 128, 1024, p.g_kv_lat, wsp<bf16_t>(p, OFF_WKVT), 256, 0, lds); continue; } j -= J_WKV;
            if (j < J_WOUT) { tr_tile(p.w_out, 1024, (j / 8) * 64, (j % 8) * 128, 1024, nullptr, wsp<bf16_t>(p, OFF_WOUTT), 1024, 0, lds); continue; } j -= J_WOUT;
            if (j < J_WMQ) { tr_tile(p.w_mem_q, 1024, (j / 8) * 64, (j % 8) * 128, 1024, p.g_mem_q, wsp<bf16_t>(p, OFF_WMQT), 1024, 0, lds); continue; } j -= J_WMQ;
            if (j < J_WMKV) { tr_tile(p.w_mem_kv, 2048, (j / 16) * 64, (j % 16) * 128, 2048, p.g_mem_kv, wsp<bf16_t>(p, OFF_WMKVT), 1024, 0, lds); continue; } j -= J_WMKV;
            if (j < J_WMO) { tr_tile(p.w_mem_o, 1024, (j / 8) * 64, (j % 8) * 128, 1024, nullptr, wsp<bf16_t>(p, OFF_WMOT), 1024, 0, lds); continue; } j -= J_WMO;
            if (j < J_WG) { const int e = j >> 7, r = j & 127; tr_tile(p.w_exp_gate + (long)e * 1048576, 1024, (r / 8) * 64, (r % 8) * 128, 1024, p.g_ffn, wsp<bf16_t>(p, OFF_WGUT) + (long)e * 2048 * 1024, 1024, 1, lds); continue; } j -= J_WG;
            if (j < J_WU) { const int e = j >> 7, r = j & 127; tr_tile(p.w_exp_up + (long)e * 1048576, 1024, (r / 8) * 64, (r % 8) * 128, 1024, p.g_ffn, wsp<bf16_t>(p, OFF_WGUT) + (long)e * 2048 * 1024, 1024, 2, lds); continue; } j -= J_WU;
            { const int e = j >> 7, r = j & 127; tr_tile(p.w_exp_down + (long)e * 1048576, 1024, (r / 8) * 64, (r % 8) * 128, 1024, nullptr, wsp<bf16_t>(p, OFF_WDT) + (long)e * 1048576, 1024, 0, lds); continue; }
        }
        j -= J_TR;
        if (j < J_XR + J_MR) {
            const bool isx = j < J_XR;
            const int row0 = (isx ? j : j - J_XR) * 16 + wid * 4;
            const float* src = (isx ? p.x : p.mem) + (long)row0 * ND;
            bf16_t* dst = (isx ? wsp<bf16_t>(p, OFF_XB) : wsp<bf16_t>(p, OFF_MEMB)) + (long)row0 * ND;
            f32x4 v[4][4];
#pragma unroll
            for (int r = 0; r < 4; r++)
#pragma unroll
                for (int i = 0; i < 4; i++) v[r][i] = *(const f32x4*)(src + (long)r * ND + i * 256 + lane * 4);
#pragma unroll
            for (int r = 0; r < 4; r++) {
                float ss = 0.f;
#pragma unroll
                for (int i = 0; i < 4; i++) {
                    ss += v[r][i][0] * v[r][i][0] + v[r][i][1] * v[r][i][1] + v[r][i][2] * v[r][i][2] + v[r][i][3] * v[r][i][3];
                    *(u32x2*)(dst + (long)r * ND + i * 256 + lane * 4) = pack4bf(v[r][i]);
                }
                ss = wave_sum(ss);
                if (lane == 0) (isx ? wsp<float>(p, OFF_R0) : wsp<float>(p, OFF_RMEM))[row0 + r] = rsqrtf(ss * (1.f / ND) + 1e-6f);
            }
            continue;
        }
        j -= J_XR + J_MR;
        if (j < J_ROPE) {
            const int i = j * 256 + tid; const int t = i >> 4, jj = i & 15;
            const double f = pow(10000.0, -(double)(2 * jj) / 32.0);
            const double ang = (double)p.pos[t] * f;
            wsp<float2>(p, OFF_ROPE)[i] = make_float2((float)cos(ang), (float)sin(ang));
            continue;
        }
        j -= J_ROPE;
        {
            int i = j * 256 + tid;
            if (i < 4096) { const double a = PI2 * (double)i / 4096.0; wsp<float2>(p, OFF_TW)[i] = make_float2((float)cos(a), (float)sin(a)); continue; } i -= 4096;
            if (i < 8192) {
                const int T = i >> 12, a = (i >> 6) & 63, b = i & 63;
                const double th = PI2 * (double)((a * b) & 63) / 64.0;
                wsp<bf16_t>(p, OFF_T64)[i] = (bf16_t)f2bf((float)(T ? sin(th) : cos(th))); continue;
            } i -= 8192;
            if (i < 16384) {
                const int rho = i >> 7, k = i & 127;
                const int wm = rho >> 6, mi = (rho >> 4) & 3, lr = rho & 15, ri = mi >> 1, k1 = 32 * wm + 16 * (mi & 1) + lr, ab = k >> 6, s1 = k & 63;
                const double th = PI2 * (double)((k1 * s1) & 63) / 64.0;
                const double c = cos(th), s = sin(th);
                const double v = ri == 0 ? (ab == 0 ? c : -s) : (ab == 0 ? s : c);
                wsp<bf16_t>(p, OFF_M1)[i] = (bf16_t)f2bf((float)v); continue;
            } i -= 16384;
            if (i < 8192) {
                const int k2 = i >> 7, k = i & 127, s2 = k & 63;
                const double th = PI2 * (double)((k2 * s2) & 63) / 64.0;
                wsp<bf16_t>(p, OFF_M3)[i] = (bf16_t)f2bf((float)(k < 64 ? cos(th) : -sin(th))); continue;
            } i -= 8192;
            if (i < 32768) {
                const int g = i >> 12, e = (i >> 6) & 63, ch = i & 63;
                wsp<bf16_t>(p, OFF_WFT)[i] = (bf16_t)f2bf(p.w_fourier[(g * 64 + ch) * 64 + e]); continue;
            }
        }
    }
}

#define FOR_XCD_ITEMS_R(item, N) for (int _L = (int)(blockIdx.x >> 3), item; _L < (N) / 8 && ((item = (int)(blockIdx.x & 7) * ((N) / 8) + _L), true); _L += (int)(gridDim.x >> 3))
__device__ __forceinline__ void gemm_tile_256sq(const GemmTile& g, char* lds, f32x4 (&acc)[8][4]) {
    const int tid = threadIdx.x, lane = tid & 63, wid = tid >> 6, wm = wid >> 2, wn = wid & 3;
    const int lrow = lane >> 3, pc = lane & 7;
    const bf16_t* ap[4]; const bf16_t* bp[4];
#pragma unroll
    for (int i = 0; i < 4; i++) {
        const int r = (wid * 4 + i) * 8 + lrow;
        const int c = pc ^ ((r >> 1) & 7);
        const long ro = g.arow ? (long)g.arow[r] * g.lda : (long)r * g.lda;
        ap[i] = g.A + ro + c * 8;
        bp[i] = g.Bt + (long)r * g.ldb + c * 8;
    }
#pragma unroll
    for (int mi = 0; mi < 8; mi++)
#pragma unroll
        for (int ni = 0; ni < 4; ni++) acc[mi][ni] = (f32x4){0.f, 0.f, 0.f, 0.f};
    const int nk = g.K >> 6;
    auto stage = [&](int kt, char* st) {
#pragma unroll
        for (int i = 0; i < 4; i++) {
            __builtin_amdgcn_global_load_lds((const unsigned*)(ap[i] + kt * 64), (unsigned*)(st + (wid * 4 + i) * 1024), 16, 0, 0);
            __builtin_amdgcn_global_load_lds((const unsigned*)(bp[i] + kt * 64), (unsigned*)(st + 32768 + (wid * 4 + i) * 1024), 16, 0, 0);
        }
    };
    __syncthreads();
    stage(0, lds);
    asm volatile("s_waitcnt vmcnt(0)" ::: "memory");
    __syncthreads();
    for (int kt = 0; kt < nk; kt++) {
        char* cur = lds + (kt & 1) * 65536;
        if (kt + 1 < nk) stage(kt + 1, lds + ((kt + 1) & 1) * 65536);
#pragma unroll
        for (int ks = 0; ks < 2; ks++) {
            bf16x8 af[8], bfr[4];
#pragma unroll
            for (int i = 0; i < 8; i++) af[i] = *(const bf16x8*)(cur + tile_off(wm * 128 + i * 16 + (lane & 15), ks * 4 + (lane >> 4)));
#pragma unroll
            for (int i = 0; i < 4; i++) bfr[i] = *(const bf16x8*)(cur + 32768 + tile_off(wn * 64 + i * 16 + (lane & 15), ks * 4 + (lane >> 4)));
            __builtin_amdgcn_s_setprio(1);
#pragma unroll
            for (int mi = 0; mi < 8; mi++)
#pragma unroll
                for (int ni = 0; ni < 4; ni++)
                    acc[mi][ni] = __builtin_amdgcn_mfma_f32_16x16x32_bf16(bfr[ni], af[mi], acc[mi][ni], 0, 0, 0);
            __builtin_amdgcn_s_setprio(0);
        }
        asm volatile("s_waitcnt vmcnt(0)" ::: "memory");
        __syncthreads();
    }
}


__device__ __forceinline__ void gemm_tile_256x128(const GemmTile& g, char* lds, f32x4 (&acc)[4][4]) {
    const int tid = threadIdx.x, lane = tid & 63, wid = tid >> 6, wm = wid >> 1, wn = wid & 1;
    const int lrow = lane >> 3, pc = lane & 7;
    const bf16_t* ap[4]; const bf16_t* bp[2];
#pragma unroll
    for (int i = 0; i < 4; i++) {
        const int r = (wid * 4 + i) * 8 + lrow;
        const int c = pc ^ ((r >> 1) & 7);
        const long ro = g.arow ? (long)g.arow[r] * g.lda : (long)r * g.lda;
        ap[i] = g.A + ro + c * 8;
    }
#pragma unroll
    for (int i = 0; i < 2; i++) {
        const int r = (wid * 2 + i) * 8 + lrow;
        const int c = pc ^ ((r >> 1) & 7);
        bp[i] = g.Bt + (long)r * g.ldb + c * 8;
    }
#pragma unroll
    for (int mi = 0; mi < 4; mi++)
#pragma unroll
        for (int ni = 0; ni < 4; ni++) acc[mi][ni] = (f32x4){0.f, 0.f, 0.f, 0.f};
    const int nk = g.K >> 6;
    auto stage = [&](int kt, char* st) {
#pragma unroll
        for (int i = 0; i < 4; i++)
            __builtin_amdgcn_global_load_lds((const unsigned*)(ap[i] + kt * 64), (unsigned*)(st + (wid * 4 + i) * 1024), 16, 0, 0);
#pragma unroll
        for (int i = 0; i < 2; i++)
            __builtin_amdgcn_global_load_lds((const unsigned*)(bp[i] + kt * 64), (unsigned*)(st + 32768 + (wid * 2 + i) * 1024), 16, 0, 0);
    };
    __syncthreads();
    stage(0, lds);
    asm volatile("s_waitcnt vmcnt(0)" ::: "memory");
    __syncthreads();
    for (int kt = 0; kt < nk; kt++) {
        char* cur = lds + (kt & 1) * 49152;
        if (kt + 1 < nk) stage(kt + 1, lds + ((kt + 1) & 1) * 49152);
        bf16x8 af[2][4], bfr[2][4];
#pragma unroll
        for (int ks = 0; ks < 2; ks++)
#pragma unroll
            for (int i = 0; i < 4; i++) {
                af[ks][i] = *(const bf16x8*)(cur + tile_off(wm * 64 + i * 16 + (lane & 15), ks * 4 + (lane >> 4)));
                bfr[ks][i] = *(const bf16x8*)(cur + 32768 + tile_off(wn * 64 + i * 16 + (lane & 15), ks * 4 + (lane >> 4)));
            }
        __builtin_amdgcn_s_setprio(1);
#pragma unroll
        for (int ks = 0; ks < 2; ks++)
#pragma unroll
            for (int mi = 0; mi < 4; mi++)
#pragma unroll
                for (int ni = 0; ni < 4; ni++)
                    acc[mi][ni] = __builtin_amdgcn_mfma_f32_16x16x32_bf16(bfr[ks][ni], af[ks][mi], acc[mi][ni], 0, 0, 0);
        __builtin_amdgcn_s_setprio(0);
        asm volatile("s_waitcnt vmcnt(0)" ::: "memory");
        __syncthreads();
    }
}

template <class Setup, class Epi>
__device__ __forceinline__ void gemm_256x128_stream(int nitems, char* lds, Setup setup, Epi epi) {
    const int tid = threadIdx.x, lane = tid & 63, wid = tid >> 6, wm = wid >> 1, wn = wid & 1;
    const int lrow = lane >> 3, pc = lane & 7;
    const int LN = nitems / 8, LS = (int)(gridDim.x >> 3), xb = (int)(blockIdx.x & 7) * LN;
    int L = (int)(blockIdx.x >> 3);
    if (L >= LN) return;
    const bf16_t* ap[4]; const bf16_t* bp[2];
    auto setptr = [&](const GemmTile& g) {
#pragma unroll
        for (int i = 0; i < 4; i++) {
            const int r = (wid * 4 + i) * 8 + lrow;
            const int c = pc ^ ((r >> 1) & 7);
            ap[i] = g.A + (long)r * g.lda + c * 8;
        }
#pragma unroll
        for (int i = 0; i < 2; i++) {
            const int r = (wid * 2 + i) * 8 + lrow;
            const int c = pc ^ ((r >> 1) & 7);
            bp[i] = g.Bt + (long)r * g.ldb + c * 8;
        }
    };
    auto stage = [&](int kt, char* st) {
#pragma unroll
        for (int i = 0; i < 4; i++)
            __builtin_amdgcn_global_load_lds((const unsigned*)(ap[i] + kt * 64), (unsigned*)(st + (wid * 4 + i) * 1024), 16, 0, 0);
#pragma unroll
        for (int i = 0; i < 2; i++)
            __builtin_amdgcn_global_load_lds((const unsigned*)(bp[i] + kt * 64), (unsigned*)(st + 32768 + (wid * 2 + i) * 1024), 16, 0, 0);
    };
    GemmTile g; g.arow = nullptr;
    setup(xb + L, g);
    const int nk = g.K >> 6;
    setptr(g);
    __syncthreads();
    stage(0, lds);
    asm volatile("s_waitcnt vmcnt(0)" ::: "memory");
    __syncthreads();
    int q = 0;
    for (; L < LN; L += LS) {
        f32x4 acc[4][4];
#pragma unroll
        for (int mi = 0; mi < 4; mi++)
#pragma unroll
            for (int ni = 0; ni < 4; ni++) acc[mi][ni] = (f32x4){0.f, 0.f, 0.f, 0.f};
        for (int kt = 0; kt < nk; kt++, q++) {
            char* cur = lds + (q & 1) * 49152;
            char* nxt = lds + ((q + 1) & 1) * 49152;
            if (kt + 1 < nk) stage(kt + 1, nxt);
            else if (L + LS < LN) { setup(xb + L + LS, g); setptr(g); stage(0, nxt); }
            bf16x8 af[2][4], bfr[2][4];
#pragma unroll
            for (int ks = 0; ks < 2; ks++)
#pragma unroll
                for (int i = 0; i < 4; i++) {
                    af[ks][i] = *(const bf16x8*)(cur + tile_off(wm * 64 + i * 16 + (lane & 15), ks * 4 + (lane >> 4)));
                    bfr[ks][i] = *(const bf16x8*)(cur + 32768 + tile_off(wn * 64 + i * 16 + (lane & 15), ks * 4 + (lane >> 4)));
                }
            __builtin_amdgcn_s_setprio(1);
#pragma unroll
            for (int ks = 0; ks < 2; ks++)
#pragma unroll
                for (int mi = 0; mi < 4; mi++)
#pragma unroll
                    for (int ni = 0; ni < 4; ni++)
                        acc[mi][ni] = __builtin_amdgcn_mfma_f32_16x16x32_bf16(bfr[ks][ni], af[ks][mi], acc[mi][ni], 0, 0, 0);
            __builtin_amdgcn_s_setprio(0);
            asm volatile("s_waitcnt vmcnt(0)" ::: "memory");
            __syncthreads();
        }
        epi(xb + L, acc);
    }
}


__device__ __forceinline__ void phase1(const Params& p, char* lds) {
    const int tid = threadIdx.x, lane = tid & 63, wid = tid >> 6, wm = wid >> 1, wn = wid & 1, lq = lane >> 4, lr = lane & 15;
    constexpr int N_U = 64 * 2, N_M = 4 * 16;
    {
      gemm_256x128_stream(N_U, lds, [&](int item, GemmTile& g) {
            const int tm = item >> 1, tn = 8 + (item & 1);
            g.A = wsp<bf16_t>(p, OFF_XB) + (long)tm * 256 * ND; g.lda = ND;
            g.Bt = wsp<bf16_t>(p, OFF_W1T) + (long)tn * 128 * ND; g.ldb = ND; g.K = ND;
        }, [&](int item, f32x4 (&acc)[4][4]) {
            const int tm = item >> 1, tn = 8 + (item & 1);
            const float* r0 = wsp<float>(p, OFF_R0);
#pragma unroll
            for (int mi = 0; mi < 4; mi++) {
                const int row = tm * 256 + wm * 64 + mi * 16 + lr;
                const float rs = r0[row];
#pragma unroll
                for (int ni = 0; ni < 4; ni++) acc[mi][ni] *= rs;
                if (tn < 4) {
#pragma unroll
                    for (int ni = 0; ni < 4; ni++)
                        *(u32x2*)(wsp<bf16_t>(p, OFF_UF) + (long)row * 512 + tn * 128 + wn * 64 + ni * 16 + 4 * lq) = pack4bf(acc[mi][ni]);
                } else if (tn < 9) {
                    float ss = 0.f;
#pragma unroll
                    for (int ni = 0; ni < 4; ni++) { const f32x4 v = acc[mi][ni]; ss += v[0] * v[0] + v[1] * v[1] + v[2] * v[2] + v[3] * v[3]; }
                    ss += __shfl_xor(ss, 16); ss += __shfl_xor(ss, 32);
                    if (tn < 7) {
#pragma unroll
                        for (int ni = 0; ni < 4; ni++)
                            *(u32x2*)(wsp<bf16_t>(p, OFF_UQ) + (long)row * 384 + (tn - 4) * 128 + wn * 64 + ni * 16 + 4 * lq) = pack4bf(acc[mi][ni]);
                        if (lq == 0) wsp<float>(p, OFF_SSQ)[row * 6 + (tn - 4) * 2 + wn] = ss;
                    } else {
#pragma unroll
                        for (int ni = 0; ni < 4; ni++)
                            *(u32x2*)(wsp<bf16_t>(p, OFF_UKV) + (long)row * 256 + (tn - 7) * 128 + wn * 64 + ni * 16 + 4 * lq) = pack4bf(acc[mi][ni]);
                        if (lq == 0) wsp<float>(p, OFF_SSKV)[row * 4 + (tn - 7) * 2 + wn] = ss;
                    }
                } else if (wn == 0) {
                    const float2* rp = wsp<float2>(p, OFF_ROPE) + (long)row * 16 + 4 * lq;
                    f32x4 o1, o2;
#pragma unroll
                    for (int r = 0; r < 4; r++) {
                        const float2 cs = rp[r];
                        const float x1 = acc[mi][0][r], x2 = acc[mi][1][r];
                        o1[r] = x1 * cs.x - x2 * cs.y; o2[r] = x1 * cs.y + x2 * cs.x;
                    }
                    bf16_t* kr = wsp<bf16_t>(p, OFF_KR) + (long)row * 32;
                    *(u32x2*)(kr + 4 * lq) = pack4bf(o1);
                    *(u32x2*)(kr + 16 + 4 * lq) = pack4bf(o2);
                }
            }
        });
      gemm_256x128_stream(N_M, lds, [&](int it, GemmTile& g) {
            const int tm = it / 16, tn = it % 16;
            g.A = wsp<bf16_t>(p, OFF_MEMB) + (long)tm * 256 * ND; g.lda = ND;
            g.Bt = wsp<bf16_t>(p, OFF_WMKVT) + (long)tn * 128 * ND; g.ldb = ND; g.K = ND;
        }, [&](int it, f32x4 (&acc)[4][4]) {
            const int tm = it / 16, tn = it % 16;
            const float* rm = wsp<float>(p, OFF_RMEM);
#pragma unroll
            for (int mi = 0; mi < 4; mi++) {
                const int row = tm * 256 + wm * 64 + mi * 16 + lr;
                const int b = row >> 8, m = row & 255;
                const float rs = rm[row];
#pragma unroll
                for (int ni = 0; ni < 4; ni++) {
                    const f32x4 v = acc[mi][ni] * rs;
                    const int col = tn * 128 + wn * 64 + ni * 16 + 4 * lq;
                    if (col < 1024) {
                        const int h = col >> 8, d = col & 255;
                        *(u32x2*)(wsp<bf16_t>(p, OFF_KMEM) + ((long)(b * 4 + h) * 256 + m) * 256 + d) = pack4bf(v);
                    } else {
                        const int c2 = col - 1024, h = c2 >> 8, dv = c2 & 255;
                        bf16_t* vt = wsp<bf16_t>(p, OFF_VTMEM) + ((long)(b * 4 + h) * 256 + dv) * 256 + m;
#pragma unroll
                        for (int r = 0; r < 4; r++) vt[r * 256] = (bf16_t)f2bf(v[r]);
                    }
                }
            }
        });
    }
}

template <int MI>
__device__ __forceinline__ void dft_mma(const bf16_t* Ag, int arow0, const char* ximg, int ncol0, f32x4 (&acc)[MI][4]) {
    const int lane = VTID & 63, lq = lane >> 4, lr = lane & 15;
#pragma unroll
    for (int ks = 0; ks < 4; ks++) {
        bf16x8 af[MI], bfr[4];
#pragma unroll
        for (int mi = 0; mi < MI; mi++) af[mi] = *(const bf16x8*)(Ag + (long)(arow0 + mi * 16 + lr) * 128 + ks * 32 + lq * 8);
#pragma unroll
        for (int ni = 0; ni < 4; ni++) {
            const char* bp = ximg + (ks * 32 + lq * 8) * 272 + (ncol0 + ni * 16 + lr) * 2;
#pragma unroll
            for (int j = 0; j < 8; j++) bfr[ni][j] = *(const short*)(bp + j * 272);
        }
#pragma unroll
        for (int mi = 0; mi < MI; mi++)
#pragma unroll
            for (int ni = 0; ni < 4; ni++) acc[mi][ni] = __builtin_amdgcn_mfma_f32_16x16x32_bf16(bfr[ni], af[mi], acc[mi][ni], 0, 0, 0);
    }
}

__device__ __forceinline__ void f2a_item(const Params& p, int it, char* lds) {
    const int tid = VTID, lane = tid & 63, wid = tid >> 6, wm = wid >> 1, wn = wid & 1, lq = lane >> 4, lr = lane & 15;
    const int nc = it & 3, s2 = (it >> 2) & 63, b = it >> 8;
    char* uimg = lds; char* ximg = lds + 17408;
    __syncthreads();
#pragma unroll
    for (int i = 0; i < 4; i++) {
        const int ci = tid + 256 * i, row = ci >> 4, cc = ci & 15;
        *(u32x4*)(uimg + row * 272 + cc * 16) = *(const u32x4*)(wsp<bf16_t>(p, OFF_UF) + ((long)(b * NS + 64 * row + s2)) * 512 + nc * 128 + cc * 8);
    }
    __syncthreads();
    {
        const int g2 = wid >> 1, T = wid & 1;
        f32x4 a1[4][4];
#pragma unroll
        for (int mi = 0; mi < 4; mi++)
#pragma unroll
            for (int ni = 0; ni < 4; ni++) a1[mi][ni] = (f32x4){0.f, 0.f, 0.f, 0.f};
        const bf16_t* t64 = wsp<bf16_t>(p, OFF_T64) + T * 4096;
#pragma unroll
        for (int ks = 0; ks < 2; ks++) {
            bf16x8 af[4], bfr[4];
#pragma unroll
            for (int i = 0; i < 4; i++) {
                af[i] = *(const bf16x8*)(uimg + (i * 16 + lr) * 272 + (g2 * 64 + ks * 32 + lq * 8) * 2);
                bfr[i] = *(const bf16x8*)(t64 + (i * 16 + lr) * 64 + ks * 32 + lq * 8);
            }
#pragma unroll
            for (int mi = 0; mi < 4; mi++)
#pragma unroll
                for (int ni = 0; ni < 4; ni++) a1[mi][ni] = __builtin_amdgcn_mfma_f32_16x16x32_bf16(bfr[ni], af[mi], a1[mi][ni], 0, 0, 0);
        }
#pragma unroll
        for (int mi = 0; mi < 4; mi++)
#pragma unroll
            for (int ni = 0; ni < 4; ni++)
                *(u32x2*)(ximg + (T * 64 + mi * 16 + lr) * 272 + (g2 * 64 + ni * 16 + 4 * lq) * 2) = pack4bf(a1[mi][ni]);
    }
    __syncthreads();
    f32x4 acc[4][4];
#pragma unroll
    for (int mi = 0; mi < 4; mi++)
#pragma unroll
        for (int ni = 0; ni < 4; ni++) acc[mi][ni] = (f32x4){0.f, 0.f, 0.f, 0.f};
    dft_mma<4>(wsp<bf16_t>(p, OFF_M1), wm * 64, ximg, wn * 64, acc);
    const float2* tw = wsp<float2>(p, OFF_TW);
#pragma unroll
    for (int m2 = 0; m2 < 2; m2++) {
        const int k1 = 32 * wm + 16 * m2 + lr;
        float2 cs; { const float rev = (float)((s2 * k1) & 4095) * (1.0f / 4096.0f); cs.x = __builtin_amdgcn_cosf(rev); cs.y = __builtin_amdgcn_sinf(rev); (void)tw; }
        const long base = ((long)(b * 64 + k1) * 64 + s2) * 512 + nc * 128 + wn * 64 + 4 * lq;
#pragma unroll
        for (int ni = 0; ni < 4; ni++) {
            const f32x4 yr = acc[m2][ni], yi = acc[m2 + 2][ni];
            const f32x4 orr = yr * cs.x - yi * cs.y, oi = yi * cs.x + yr * cs.y;
            *(u32x2*)(wsp<bf16_t>(p, OFF_YR) + base + ni * 16) = pack4bf(orr);
            *(u32x2*)(wsp<bf16_t>(p, OFF_YI) + base + ni * 16) = pack4bf(oi);
        }
    }
}

__device__ __forceinline__ void f2b_item(const Params& p, int it, char* lds) {
    const int tid = VTID, lane = tid & 63, wid = tid >> 6, wm = wid >> 1, wn = wid & 1, lq = lane >> 4, lr = lane & 15;
    const int nc = it & 3, k1 = (it >> 2) & 63, b = it >> 8;
    char* ximg = lds; char* zimg = lds + 34816;
    __syncthreads();
#pragma unroll
    for (int i = 0; i < 8; i++) {
        const int ci = tid + 256 * i, row = ci >> 4, cc = ci & 15;
        const bf16_t* src = (row < 64 ? wsp<bf16_t>(p, OFF_YR) : wsp<bf16_t>(p, OFF_YI)) + ((long)(b * 64 + k1) * 64 + (row & 63)) * 512 + nc * 128 + cc * 8;
        *(u32x4*)(ximg + row * 272 + cc * 16) = *(const u32x4*)src;
    }
    __syncthreads();
    f32x4 acc[2][4];
#pragma unroll
    for (int mi = 0; mi < 2; mi++)
#pragma unroll
        for (int ni = 0; ni < 4; ni++) acc[mi][ni] = (f32x4){0.f, 0.f, 0.f, 0.f};
    dft_mma<2>(wsp<bf16_t>(p, OFF_M3), wm * 32, ximg, wn * 64, acc);
#pragma unroll
    for (int mi = 0; mi < 2; mi++)
#pragma unroll
        for (int ni = 0; ni < 4; ni++)
            *(u32x2*)(zimg + (wm * 32 + mi * 16 + lr) * 272 + (wn * 64 + ni * 16 + 4 * lq) * 2) = pack4bf(acc[mi][ni] * (1.0f / 512.0f));
    __syncthreads();
    f32x4 a3[2][4];
#pragma unroll
    for (int mi = 0; mi < 2; mi++)
#pragma unroll
        for (int ni = 0; ni < 4; ni++) a3[mi][ni] = (f32x4){0.f, 0.f, 0.f, 0.f};
    const bf16_t* wft = wsp<bf16_t>(p, OFF_WFT) + (long)(nc * 2 + wn) * 4096;
#pragma unroll
    for (int ks = 0; ks < 2; ks++) {
        bf16x8 af[2], bfr[4];
#pragma unroll
        for (int i = 0; i < 2; i++) af[i] = *(const bf16x8*)(zimg + (wm * 32 + i * 16 + lr) * 272 + (wn * 64 + ks * 32 + lq * 8) * 2);
#pragma unroll
        for (int i = 0; i < 4; i++) bfr[i] = *(const bf16x8*)(wft + (i * 16 + lr) * 64 + ks * 32 + lq * 8);
#pragma unroll
        for (int mi = 0; mi < 2; mi++)
#pragma unroll
            for (int ni = 0; ni < 4; ni++) a3[mi][ni] = __builtin_amdgcn_mfma_f32_16x16x32_bf16(bfr[ni], af[mi], a3[mi][ni], 0, 0, 0);
    }
#pragma unroll
    for (int mi = 0; mi < 2; mi++) {
        const int k2 = wm * 32 + mi * 16 + lr;
        bf16_t* dst = wsp<bf16_t>(p, OFF_ZA) + ((long)(b * NS + k1 + 64 * k2)) * 1024 + nc * 128 + wn * 64 + 4 * lq;
#pragma unroll
        for (int ni = 0; ni < 4; ni++) *(u32x2*)(dst + ni * 16) = pack4bf(a3[mi][ni]);
    }
}

__device__ __forceinline__ void phase2(const Params& p, char* lds) {
    const int tid = threadIdx.x, lane = tid & 63, wid = tid >> 6, wm = wid >> 1, wn = wid & 1, lq = lane >> 4, lr = lane & 15;
    constexpr int N_Q = 64 * 6, N_KV = 64 * 8;
    {
      gemm_256x128_stream(N_Q, lds, [&](int item, GemmTile& g) {
            const int tm = item / 6, tn = item % 6;
            g.A = wsp<bf16_t>(p, OFF_UQ) + (long)tm * 256 * 384; g.lda = 384;
            g.Bt = wsp<bf16_t>(p, OFF_WQT) + (long)tn * 128 * 384; g.ldb = 384; g.K = 384;
        }, [&](int item, f32x4 (&acc)[4][4]) {
            const int tm = item / 6, tn = item % 6;
            const float qmul = 0.10206207261596575f * 1.4426950408889634f;
#pragma unroll
            for (int mi = 0; mi < 4; mi++) {
                const int row = tm * 256 + wm * 64 + mi * 16 + lr;
                const int b = row >> 12, s = row & 4095;
                const float* sq = wsp<float>(p, OFF_SSQ) + (long)row * 6;
                const float ss = sq[0] + sq[1] + sq[2] + sq[3] + sq[4] + sq[5];
                const float rs = rsqrtf(ss * (1.f / 384.f) + 1e-6f) * qmul;
                const int cb0 = tn * 128 + wn * 64;
#pragma unroll
                for (int ni = 0; ni < 4; ni++) {
                    const int cb = cb0 + ni * 16, hd = cb / 96, hob = cb % 96;
                    bf16_t* qd = wsp<bf16_t>(p, OFF_Q) + ((long)(b * 8 + hd) * NS + s) * 96;
                    if (hob < 64) {
                        *(u32x2*)(qd + hob + 4 * lq) = pack4bf(acc[mi][ni] * rs);
                    } else if (hob == 64) {
                        if (ni < 3) {
                            const float2* rp = wsp<float2>(p, OFF_ROPE) + (long)row * 16 + 4 * lq;
                            f32x4 o1, o2;
#pragma unroll
                            for (int r = 0; r < 4; r++) {
                                const float2 cs = rp[r];
                                const float x1 = acc[mi][ni][r] * rs, x2 = acc[mi][ni < 3 ? ni + 1 : 3][r] * rs;
                                o1[r] = x1 * cs.x - x2 * cs.y; o2[r] = x1 * cs.y + x2 * cs.x;
                            }
                            *(u32x2*)(qd + 64 + 4 * lq) = pack4bf(o1);
                            *(u32x2*)(qd + 80 + 4 * lq) = pack4bf(o2);
                        }
                    }
                }
            }
        });
      gemm_256x128_stream(N_KV, lds, [&](int it, GemmTile& g) {
            const int tm = it >> 3, hd = it & 7;
            g.A = wsp<bf16_t>(p, OFF_UKV) + (long)tm * 256 * 256; g.lda = 256;
            g.Bt = wsp<bf16_t>(p, OFF_WKVT) + (long)hd * 128 * 256; g.ldb = 256; g.K = 256;
        }, [&](int it, f32x4 (&acc)[4][4]) {
            const int tm = it >> 3, hd = it & 7;
#pragma unroll
            for (int mi = 0; mi < 4; mi++) {
                const int row = tm * 256 + wm * 64 + mi * 16 + lr;
                const int b = row >> 12, s = row & 4095;
                const float* sq = wsp<float>(p, OFF_SSKV) + (long)row * 4;
                const float rs = rsqrtf((sq[0] + sq[1] + sq[2] + sq[3]) * (1.f / 256.f) + 1e-6f);
                if (wn == 0) {
                    bf16_t* kd = wsp<bf16_t>(p, OFF_K) + ((long)(b * 8 + hd) * NS + s) * 96;
#pragma unroll
                    for (int ni = 0; ni < 4; ni++) *(u32x2*)(kd + ni * 16 + 4 * lq) = pack4bf(acc[mi][ni] * rs);
                } else {
#pragma unroll
                    for (int ni = 0; ni < 4; ni++) {
                        bf16_t* vd = wsp<bf16_t>(p, OFF_VT) + ((long)(b * 8 + hd) * 64 + ni * 16 + 4 * lq) * NS + s;
#pragma unroll
                        for (int r = 0; r < 4; r++) vd[(long)r * NS] = (bf16_t)f2bf(acc[mi][ni][r] * rs);
                    }
                }
            }
#pragma unroll
            for (int i = 0; i < 2; i++) {
                const int ci = tid + 512 * i, r = ci >> 2, cc = ci & 3;
                const int row = tm * 256 + r, b = row >> 12, s = row & 4095;
                *(u32x4*)(wsp<bf16_t>(p, OFF_K) + ((long)(b * 8 + hd) * NS + s) * 96 + 64 + cc * 8) = *(const u32x4*)(wsp<bf16_t>(p, OFF_KR) + (long)row * 32 + cc * 8);
            }
        });
    }
}


__device__ __forceinline__ void phase2_f2a(const Params& p, char* lds) {
    FOR_XCD_ITEMS(it, 1024) { f2a_item(p, it, lds); }
}

__device__ __forceinline__ void expert_tr_job(const Params& p, int j, char* lds) {
    const int which = j >> 11, r = j & 2047, e = r >> 7, t = r & 127;
    const int k0 = (t >> 3) * 64, n0 = (t & 7) * 128;
    if (which == 0) tr_tile(p.w_exp_gate + (long)e * 1048576, 1024, k0, n0, 1024, p.g_ffn, wsp<bf16_t>(p, OFF_WGUT) + (long)e * 2048 * 1024, 1024, 1, lds);
    else if (which == 1) tr_tile(p.w_exp_up + (long)e * 1048576, 1024, k0, n0, 1024, p.g_ffn, wsp<bf16_t>(p, OFF_WGUT) + (long)e * 2048 * 1024, 1024, 2, lds);
    else tr_tile(p.w_exp_down + (long)e * 1048576, 1024, k0, n0, 1024, nullptr, wsp<bf16_t>(p, OFF_WDT) + (long)e * 1048576, 1024, 0, lds);
}

__device__ __forceinline__ void phase3_tr(const Params& p, char* lds) {
    for (int j = VBLK; j < 6144; j += VGRID) expert_tr_job(p, j, lds);
}
__device__ __forceinline__ void phase3_f2b(const Params& p, char* lds) {
    FOR_XCD_ITEMS(it, 1024) { f2b_item(p, it, lds); }
}

__device__ __forceinline__ void phase_resid(const Params& p, char* lds, size_t offA, size_t offW, const float* residf, const bf16_t* residb, size_t offXb, size_t offSS) {
    const int tid = VTID, lane = tid & 63, wid = tid >> 6, wm = wid >> 1, wn = wid & 1, lq = lane >> 4, lr = lane & 15;
    FOR_XCD_ITEMS(item, 128 * 8) {
        const int tm = item >> 3, tn = item & 7;
        f32x4 acc[4][4];
        GemmTile g; g.A = wsp<bf16_t>(p, offA) + (long)tm * 128 * ND; g.lda = ND; g.arow = nullptr;
        g.Bt = wsp<bf16_t>(p, offW) + (long)tn * 128 * ND; g.ldb = ND; g.K = ND;
        gemm_tile_128(g, lds, acc);
#pragma unroll
        for (int mi = 0; mi < 4; mi++) {
            const int row = tm * 128 + wm * 64 + mi * 16 + lr;
            float ss = 0.f;
#pragma unroll
            for (int ni = 0; ni < 4; ni++) {
                const long o = (long)row * ND + tn * 128 + wn * 64 + ni * 16 + 4 * lq;
                f32x4 rv;
                if (residf) rv = *(const f32x4*)(residf + o);
                else { const u32x2 w = *(const u32x2*)(residb + o); rv = (f32x4){__uint_as_float(w.x << 16), __uint_as_float(w.x & 0xFFFF0000u), __uint_as_float(w.y << 16), __uint_as_float(w.y & 0xFFFF0000u)}; }
                const f32x4 v = rv + acc[mi][ni];
                *(u32x2*)(wsp<bf16_t>(p, offXb) + o) = pack4bf(v);
                ss += v[0] * v[0] + v[1] * v[1] + v[2] * v[2] + v[3] * v[3];
            }
            ss += __shfl_xor(ss, 16); ss += __shfl_xor(ss, 32);
            if (lq == 0) wsp<float>(p, offSS)[row * 16 + tn * 2 + wn] = ss;
        }
    }
}
__device__ __forceinline__ float row_rs16(const float* ss) {
    const f32x4 a = *(const f32x4*)ss, b = *(const f32x4*)(ss + 4), c = *(const f32x4*)(ss + 8), d = *(const f32x4*)(ss + 12);
    const f32x4 t = (a + b) + (c + d);
    return rsqrtf(((t[0] + t[1]) + (t[2] + t[3])) * (1.f / 1024.f) + 1e-6f);
}

__device__ __forceinline__ void phase5a(const Params& p, char* lds) {
    const int tid = VTID, lane = tid & 63, wid = tid >> 6, wm = wid >> 1, wn = wid & 1, lq = lane >> 4, lr = lane & 15;
    FOR_XCD_ITEMS(item, 128 * 8) {
        const int tm = item >> 3, tn = item & 7;
        f32x4 acc[4][4];
        GemmTile g; g.A = wsp<bf16_t>(p, OFF_X1B) + (long)tm * 128 * ND; g.lda = ND; g.arow = nullptr;
        g.Bt = wsp<bf16_t>(p, OFF_WMQT) + (long)tn * 128 * ND; g.ldb = ND; g.K = ND;
        gemm_tile_128(g, lds, acc);
        const int h = tn >> 1;
#pragma unroll
        for (int mi = 0; mi < 4; mi++) {
            const int row = tm * 128 + wm * 64 + mi * 16 + lr, b = row >> 12, s = row & 4095;
            const float rs = row_rs16(wsp<float>(p, OFF_SS1) + (long)row * 16) * (0.0625f * 1.4426950408889634f);
            bf16_t* qd = wsp<bf16_t>(p, OFF_QM) + ((long)(b * 4 + h) * NS + s) * 256 + (tn & 1) * 128 + wn * 64 + 4 * lq;
#pragma unroll
            for (int ni = 0; ni < 4; ni++) *(u32x2*)(qd + ni * 16) = pack4bf(acc[mi][ni] * rs);
        }
    }
}
__device__ __forceinline__ void phase5b(const Params& p, char* lds) {
    FOR_XCD_ITEMS(item, NB * 4 * 32 * 2) {
        const int dvh = item & 1, qt = (item >> 1) & 31, h = (item >> 6) & 3, b = item >> 8;
        const bf16_t* Qp = wsp<bf16_t>(p, OFF_QM) + ((long)(b * 4 + h) * NS + qt * 128) * 256;
        const bf16_t* Kp = wsp<bf16_t>(p, OFF_KMEM) + ((long)(b * 4 + h) * 256) * 256;
        const bf16_t* Vtp = wsp<bf16_t>(p, OFF_VTMEM) + ((long)(b * 4 + h) * 256 + dvh * 128) * 256;
        bf16_t* Op = wsp<bf16_t>(p, OFF_OM) + ((long)b * NS + qt * 128) * 1024 + h * 256 + dvh * 128;
        attn_block<256, 128, 32, 256>(Qp, Kp, Vtp, 256L, 256, lds, [&](int q, int dv, f32x4 v) { *(u32x2*)(Op + (long)q * 1024 + dv) = pack4bf(v); });
    }
}

__device__ __forceinline__ void phase7(const Params& p, char* lds) {
    const int tid = threadIdx.x, lane = tid & 63, wid = tid >> 6, lq = lane >> 4, lr = lane & 15;
    __syncthreads();
    {
        f32x4 w0[4], w1[4];
#pragma unroll
        for (int it = 0; it < 4; it++) {
            const int u = tid + 512 * it, kp = u >> 2, eq = u & 3;
            w0[it] = *(const f32x4*)(p.w_router + (size_t)(2 * kp) * 16 + eq * 4);
            w1[it] = *(const f32x4*)(p.w_router + (size_t)(2 * kp + 1) * 16 + eq * 4);
        }
#pragma unroll
        for (int it = 0; it < 4; it++) {
            const int u = tid + 512 * it, kp = u >> 2, eq = u & 3, k = 2 * kp;
            const float g0 = p.g_ffn[k], g1 = p.g_ffn[k + 1];
#pragma unroll
            for (int j = 0; j < 4; j++) {
                const int e = eq * 4 + j;
                const float a0 = w0[it][j] * g0, a1 = w1[it][j] * g1;
                const unsigned h0 = f2bf(a0), h1 = f2bf(a1);
                const float r0 = a0 - __uint_as_float(h0 << 16), r1 = a1 - __uint_as_float(h1 << 16);
                const unsigned l0 = f2bf(r0), l1 = f2bf(r1);
                const int off = e * 2048 + ((((k >> 3) ^ e) & 127) << 4) + (k & 7) * 2;
                *(unsigned*)(lds + off) = h0 | (h1 << 16);
                *(unsigned*)(lds + 32768 + off) = l0 | (l1 << 16);
            }
        }
    }
    __syncthreads();
    for (int g = wid * (int)gridDim.x + (int)blockIdx.x; g < NT / 16; g += 8 * (int)gridDim.x) {
        const int t0 = g * 16;
        const bf16_t* xr = wsp<bf16_t>(p, OFF_X2B) + (long)(t0 + lr) * ND + lq * 8;
        bf16x8 xa[32];
#pragma unroll
        for (int ks = 0; ks < 32; ks++) xa[ks] = *(const bf16x8*)(xr + ks * 32);
        const float rsv = row_rs16(wsp<float>(p, OFF_SS2) + (long)(t0 + lr) * 16);
        if (lane < 16) wsp<float>(p, OFF_RS2)[t0 + lane] = rsv;
        f32x4 acc = (f32x4){0.f, 0.f, 0.f, 0.f};
#pragma unroll
        for (int ks = 0; ks < 32; ks++) {
            const int off = lr * 2048 + ((((ks * 4 + lq) ^ lr) & 127) << 4);
            const bf16x8 bh = *(const bf16x8*)(lds + off), bl = *(const bf16x8*)(lds + 32768 + off);
            acc = __builtin_amdgcn_mfma_f32_16x16x32_bf16(xa[ks], bh, acc, 0, 0, 0);
            acc = __builtin_amdgcn_mfma_f32_16x16x32_bf16(xa[ks], bl, acc, 0, 0, 0);
            if ((ks & 3) == 3) asm volatile("" ::: "memory");
        }
        f32x4 af4;
#pragma unroll
        for (int r = 0; r < 4; r++) {
            const float lg = acc[r] * __shfl(rsv, lq * 4 + r);
            float mx = lg;
#pragma unroll
            for (int o = 1; o < 16; o <<= 1) mx = fmaxf(mx, __shfl_xor(mx, o));
            const float ex = expf(lg - mx);
            float sm = ex;
#pragma unroll
            for (int o = 1; o < 16; o <<= 1) sm += __shfl_xor(sm, o);
            af4[r] = ex / sm;
        }
        {
            const int tk = t0 + lq * 4, bb = tk >> 12, ss = tk & 4095;
            *(f32x4*)(wsp<float>(p, OFF_AFF) + ((long)(bb * NE + lr) * NS + ss)) = af4;
        }
    }
}

__device__ __forceinline__ int block_sum_i(int v, int* red) {
    const int lane = VTID & 63, wid = VTID >> 6;
#pragma unroll
    for (int o = 32; o > 0; o >>= 1) v += __shfl_xor(v, o);
    __syncthreads();
    if (lane == 0) red[wid] = v;
    __syncthreads();
    return red[0] + red[1] + red[2] + red[3];
}
__device__ __forceinline__ int block_excl_scan_i(int v, int* red, int& total) {
    const int lane = VTID & 63, wid = VTID >> 6;
    int inc = v;
#pragma unroll
    for (int o = 1; o < 64; o <<= 1) { const int t = __shfl_up(inc, o); if (lane >= o) inc += t; }
    __syncthreads();
    if (lane == 63) red[wid] = inc;
    __syncthreads();
    int base = 0;
#pragma unroll
    for (int w = 0; w < 4; w++) if (w < wid) base += red[w];
    total = red[0] + red[1] + red[2] + red[3];
    return base + inc - v;
}
__device__ __forceinline__ void phase8(const Params& p, char* lds) {
    int* red = (int*)lds;
    const int tid = threadIdx.x, lane = tid & 63, wid = tid >> 6;
    for (int item = blockIdx.x; item < NB * NE; item += gridDim.x) {
        const int e = item & 15, b = item >> 4;
        const unsigned* aff = (const unsigned*)(wsp<float>(p, OFF_AFF) + (long)(b * NE + e) * NS) + tid * 8;
        unsigned v[8];
        { const u32x4 v0 = *(const u32x4*)aff, v1 = *(const u32x4*)(aff + 4);
          v[0] = v0.x; v[1] = v0.y; v[2] = v0.z; v[3] = v0.w; v[4] = v1.x; v[5] = v1.y; v[6] = v1.z; v[7] = v1.w; }
        const float* rs2p = wsp<float>(p, OFF_RS2) + (long)b * NS + tid * 8;
        const f32x4 rsa = *(const f32x4*)rs2p, rsb = *(const f32x4*)(rs2p + 4);
        __syncthreads();
        unsigned T = 0;
        for (int bit = 30; bit >= 0; bit--) {
            const unsigned cand = T | (1u << bit);
            int c = 0;
#pragma unroll
            for (int i = 0; i < 8; i++) c += __popcll(__ballot(v[i] >= cand));
            int* rb = red + (bit & 1) * 8;
            if (lane == 0) rb[wid] = c;
            __syncthreads();
            const i32x4 s0 = *(const i32x4*)rb, s1 = *(const i32x4*)(rb + 4);
            const int tot = (s0.x + s0.y) + (s0.z + s0.w) + (s1.x + s1.y) + (s1.z + s1.w);
            if (tot >= CAP) T = cand;
        }
        int cg = 0, ce = 0;
#pragma unroll
        for (int i = 0; i < 8; i++) { cg += (v[i] > T) ? 1 : 0; ce += (v[i] == T) ? 1 : 0; }
        const int pv = cg | (ce << 16);
        int inc = pv;
#pragma unroll
        for (int o = 1; o < 64; o <<= 1) { const int t = __shfl_up(inc, o); if (lane >= o) inc += t; }
        if (lane == 63) red[16 + wid] = inc;
        __syncthreads();
        int base = 0, tot = 0;
#pragma unroll
        for (int w = 0; w < 8; w++) { const int x = red[16 + w]; if (w < wid) base += x; tot += x; }
        const int pk = base + inc - pv;
        const int need = CAP - (tot & 0xFFFF);
        const int pg = pk & 0xFFFF;
        int eqs = pk >> 16;
        int slot = pg + (eqs < need ? eqs : need);
        int* slots = wsp<int>(p, OFF_SLOTS) + (long)(b * NE + e) * NS + tid * 8;
        int* idx = wsp<int>(p, OFF_IDX) + (long)(b * NE + e) * CAP;
        float* gate = wsp<float>(p, OFF_GATE) + (long)(b * NE + e) * CAP;
        float* rss = wsp<float>(p, OFF_RSS) + (long)(b * NE + e) * CAP;
        int so[8];
#pragma unroll
        for (int i = 0; i < 8; i++) {
            const int t = tid * 8 + i;
            bool sel = v[i] > T;
            if (v[i] == T) { sel = eqs < need; eqs++; }
            so[i] = -1;
            if (sel) { so[i] = slot; idx[slot] = b * NS + t; gate[slot] = __uint_as_float(v[i]); rss[slot] = i < 4 ? rsa[i & 3] : rsb[i & 3]; slot++; }
        }
        *(i32x4*)slots = (i32x4){so[0], so[1], so[2], so[3]};
        *(i32x4*)(slots + 4) = (i32x4){so[4], so[5], so[6], so[7]};
    }
}

__device__ __forceinline__ void phase9(const Params& p, char* lds) {
    const int tid = VTID, lane = tid & 63, wid = tid >> 6, wm = wid >> 1, wn = wid & 1, lq = lane >> 4, lr = lane & 15;
    FOR_XCD_ITEMS(item, NE * 16 * NB * 4) {
        const int rt = item & 3, b = (item >> 2) & 3, ct = (item >> 4) & 15, e = item >> 8;
        const int* arow = wsp<int>(p, OFF_IDX) + (long)(b * NE + e) * CAP + rt * 128;
        f32x4 acc[4][4];
        GemmTile g; g.A = wsp<bf16_t>(p, OFF_X2B); g.lda = ND; g.arow = arow;
        g.Bt = wsp<bf16_t>(p, OFF_WGUT) + ((long)e * 2048 + ct * 128) * ND; g.ldb = ND; g.K = ND;
        gemm_tile_128(g, lds, acc);
#pragma unroll
        for (int mi = 0; mi < 4; mi++) {
            const int r = wm * 64 + mi * 16 + lr;
            const int tok = arow[r];
            const float rs = row_rs16(wsp<float>(p, OFF_SS2) + (long)tok * 16);
            bf16_t* ad = wsp<bf16_t>(p, OFF_ACT) + ((long)(e * NB + b) * CAP + rt * 128 + r) * ND + ct * 64 + wn * 32 + 4 * lq;
#pragma unroll
            for (int pp = 0; pp < 2; pp++) {
                f32x4 o;
#pragma unroll
                for (int q = 0; q < 4; q++) {
                    const float ga = acc[mi][2 * pp][q] * rs, up = acc[mi][2 * pp + 1][q] * rs;
                    o[q] = ga / (1.f + __expf(-ga)) * up;
                }
                *(u32x2*)(ad + pp * 16) = pack4bf(o);
            }
        }
    }
}
__device__ __forceinline__ void phase10(const Params& p, char* lds) {
    const int tid = VTID, lane = tid & 63, wid = tid >> 6, wm = wid >> 1, wn = wid & 1, lq = lane >> 4, lr = lane & 15;
    FOR_XCD_ITEMS(item, NE * 8 * NB * 4) {
        const int rt = item & 3, b = (item >> 2) & 3, ct = (item >> 4) & 7, e = item >> 7;
        const long row0 = (long)(e * NB + b) * CAP + rt * 128;
        f32x4 acc[4][4];
        GemmTile g; g.A = wsp<bf16_t>(p, OFF_ACT) + row0 * ND; g.lda = ND; g.arow = nullptr;
        g.Bt = wsp<bf16_t>(p, OFF_WDT) + ((long)e * 1024 + ct * 128) * ND; g.ldb = ND; g.K = ND;
        gemm_tile_128(g, lds, acc);
        const float* gate = wsp<float>(p, OFF_GATE) + (long)(b * NE + e) * CAP + rt * 128;
#pragma unroll
        for (int mi = 0; mi < 4; mi++) {
            const int r = wm * 64 + mi * 16 + lr;
            const float gv = gate[r];
            bf16_t* yd = wsp<bf16_t>(p, OFF_Y) + (row0 + r) * ND + ct * 128 + wn * 64 + 4 * lq;
#pragma unroll
            for (int ni = 0; ni < 4; ni++) *(u32x2*)(yd + ni * 16) = pack4bf(acc[mi][ni] * gv);
        }
    }
}

__device__ __forceinline__ void phase11(const Params& p, char* lds) {
    const int tid = VTID, lane = tid & 63, wid = tid >> 6;
    const int* slots = wsp<int>(p, OFF_SLOTS);
    auto slot_of = [&](int tok) { const int b = tok >> 12, t = tok & 4095; return slots[(long)(b * NE + (lane & 15)) * NS + t]; };
    int tok = VBLK * 4 + wid;
    int sl_next = tok < NT ? slot_of(tok) : -1;
    u32x2 xn[4];
#pragma unroll
    for (int i = 0; i < 4; i++) xn[i] = *(const u32x2*)(wsp<bf16_t>(p, OFF_X2B) + (long)(tok < NT ? tok : 0) * ND + i * 256 + lane * 4);
    for (; tok < NT; tok += VGRID * 4) {
        const int b = tok >> 12;
        float* xr = p.out + (long)tok * ND;
        const int slv = sl_next;
        f32x4 v[4];
#pragma unroll
        for (int i = 0; i < 4; i++)
            v[i] = (f32x4){__uint_as_float(xn[i].x << 16), __uint_as_float(xn[i].x & 0xFFFF0000u), __uint_as_float(xn[i].y << 16), __uint_as_float(xn[i].y & 0xFFFF0000u)};
        {
            const int tn = tok + VGRID * 4;
            sl_next = tn < NT ? slot_of(tn) : -1;
#pragma unroll
            for (int i = 0; i < 4; i++) xn[i] = *(const u32x2*)(wsp<bf16_t>(p, OFF_X2B) + (long)(tn < NT ? tn : tok) * ND + i * 256 + lane * 4);
        }
        unsigned long long sel = __ballot(slv >= 0) & 0xFFFFull;
        while (sel) {
            const int e = __builtin_ctzll(sel); sel &= sel - 1;
            const int sl = __builtin_amdgcn_readlane(slv, e);
            const bf16_t* yr = wsp<bf16_t>(p, OFF_Y) + ((long)(e * NB + b) * CAP + sl) * ND;
#pragma unroll
            for (int i = 0; i < 4; i++) {
                const u32x2 w = *(const u32x2*)(yr + i * 256 + lane * 4);
                v[i][0] += __uint_as_float(w.x << 16); v[i][1] += __uint_as_float(w.x & 0xFFFF0000u);
                v[i][2] += __uint_as_float(w.y << 16); v[i][3] += __uint_as_float(w.y & 0xFFFF0000u);
            }
        }
        float ss = 0.f;
#pragma unroll
        for (int i = 0; i < 4; i++) ss += v[i][0] * v[i][0] + v[i][1] * v[i][1] + v[i][2] * v[i][2] + v[i][3] * v[i][3];
        ss = wave_sum(ss);
        const float rs = rsqrtf(ss * (1.f / ND) + 1e-6f);
#pragma unroll
        for (int i = 0; i < 4; i++) {
            const f32x4 gf = *(const f32x4*)(p.g_final + i * 256 + lane * 4);
            *(f32x4*)(xr + i * 256 + lane * 4) = v[i] * rs * gf;
        }
    }
}


__device__ __forceinline__ void phase_resid8(const Params& p, char* lds, size_t offA, size_t offW, const float* residf, const bf16_t* residb, size_t offXb, size_t offSS) {
    const int tid = threadIdx.x, lane = tid & 63, wid = tid >> 6, wm = wid >> 2, wn = wid & 3, lq = lane >> 4, lr = lane & 15;
    FOR_XCD_ITEMS_R(item, 64 * 4) {
        const int tm = item >> 2, tn = item & 3;
        f32x4 acc[8][4];
        GemmTile g; g.A = wsp<bf16_t>(p, offA) + (long)tm * 256 * ND; g.lda = ND; g.arow = nullptr;
        g.Bt = wsp<bf16_t>(p, offW) + (long)tn * 256 * ND; g.ldb = ND; g.K = ND;
        gemm_tile_256sq(g, lds, acc);
#pragma unroll
        for (int mi = 0; mi < 8; mi++) {
            const int row = tm * 256 + wm * 128 + mi * 16 + lr;
            float ss = 0.f;
#pragma unroll
            for (int ni = 0; ni < 4; ni++) {
                const long o = (long)row * ND + tn * 256 + wn * 64 + ni * 16 + 4 * lq;
                f32x4 rv;
                if (residf) rv = *(const f32x4*)(residf + o);
                else { const u32x2 w = *(const u32x2*)(residb + o); rv = (f32x4){__uint_as_float(w.x << 16), __uint_as_float(w.x & 0xFFFF0000u), __uint_as_float(w.y << 16), __uint_as_float(w.y & 0xFFFF0000u)}; }
                const f32x4 v = rv + acc[mi][ni];
                *(u32x2*)(wsp<bf16_t>(p, offXb) + o) = pack4bf(v);
                ss += v[0] * v[0] + v[1] * v[1] + v[2] * v[2] + v[3] * v[3];
            }
            ss += __shfl_xor(ss, 16); ss += __shfl_xor(ss, 32);
            if (lq == 0) wsp<float>(p, offSS)[row * 16 + tn * 4 + wn] = ss;
        }
    }
}
__device__ __forceinline__ void phase5a8(const Params& p, char* lds) {
    const int tid = threadIdx.x, lane = tid & 63, wid = tid >> 6, wm = wid >> 2, wn = wid & 3, lq = lane >> 4, lr = lane & 15;
    FOR_XCD_ITEMS_R(item, 64 * 4) {
        const int tm = item >> 2, tn = item & 3;
        f32x4 acc[8][4];
        GemmTile g; g.A = wsp<bf16_t>(p, OFF_X1B) + (long)tm * 256 * ND; g.lda = ND; g.arow = nullptr;
        g.Bt = wsp<bf16_t>(p, OFF_WMQT) + (long)tn * 256 * ND; g.ldb = ND; g.K = ND;
        gemm_tile_256sq(g, lds, acc);
#pragma unroll
        for (int mi = 0; mi < 8; mi++) {
            const int row = tm * 256 + wm * 128 + mi * 16 + lr, b = row >> 12, s = row & 4095;
            const float rs = row_rs16(wsp<float>(p, OFF_SS1) + (long)row * 16) * (0.0625f * 1.4426950408889634f);
            bf16_t* qd = wsp<bf16_t>(p, OFF_QM) + ((long)(b * 4 + tn) * NS + s) * 256 + wn * 64 + 4 * lq;
#pragma unroll
            for (int ni = 0; ni < 4; ni++) *(u32x2*)(qd + ni * 16) = pack4bf(acc[mi][ni] * rs);
        }
    }
}


template <class Epi>
__device__ __forceinline__ void gemm_256sq_multi(const bf16_t* A, int lda, const int* arow, const bf16_t* Bt, int ldb, long bstep,
                                                 int K, int ntile, char* lds, Epi epi) {
    const int tid = threadIdx.x, lane = tid & 63, wid = tid >> 6, wm = wid >> 2, wn = wid & 3;
    const int lrow = lane >> 3, pc = lane & 7;
    const char* Ab = (const char*)A; const char* Bb = (const char*)Bt;
    unsigned ao[4], bo[4];
#pragma unroll
    for (int i = 0; i < 4; i++) {
        const int r = (wid * 4 + i) * 8 + lrow;
        const int c = pc ^ ((r >> 1) & 7);
        ao[i] = (unsigned)((arow ? arow[r] : r) * lda + c * 8) * 2u;
        bo[i] = (unsigned)(r * ldb + c * 8) * 2u;
    }
    const int nk = K >> 6;
    auto stage = [&](int kt, long boff, char* st) {
        const char* a0 = Ab + kt * 128;
        const char* b0 = Bb + boff * 2 + kt * 128;
#pragma unroll
        for (int i = 0; i < 4; i++) {
            __builtin_amdgcn_global_load_lds((const unsigned*)(a0 + ao[i]), (unsigned*)(st + (wid * 4 + i) * 1024), 16, 0, 0);
            __builtin_amdgcn_global_load_lds((const unsigned*)(b0 + bo[i]), (unsigned*)(st + 32768 + (wid * 4 + i) * 1024), 16, 0, 0);
        }
    };
    f32x4 acc[8][4];
    __syncthreads();
    stage(0, 0, lds);
    asm volatile("s_waitcnt vmcnt(0)" ::: "memory");
    __syncthreads();
    int q = 0;
    for (int t = 0; t < ntile; t++) {
#pragma unroll
        for (int mi = 0; mi < 8; mi++)
#pragma unroll
            for (int ni = 0; ni < 4; ni++) acc[mi][ni] = (f32x4){0.f, 0.f, 0.f, 0.f};
        const long boff = (long)t * bstep;
        for (int kt = 0; kt < nk; kt++, q++) {
            char* cur = lds + (q & 1) * 65536;
            char* nxt = lds + ((q + 1) & 1) * 65536;
            if (kt + 1 < nk) stage(kt + 1, boff, nxt);
            else if (t + 1 < ntile) stage(0, boff + bstep, nxt);
#pragma unroll
            for (int ks = 0; ks < 2; ks++) {
                bf16x8 af[8], bfr[4];
#pragma unroll
                for (int i = 0; i < 8; i++) af[i] = *(const bf16x8*)(cur + tile_off(wm * 128 + i * 16 + (lane & 15), ks * 4 + (lane >> 4)));
#pragma unroll
                for (int i = 0; i < 4; i++) bfr[i] = *(const bf16x8*)(cur + 32768 + tile_off(wn * 64 + i * 16 + (lane & 15), ks * 4 + (lane >> 4)));
                __builtin_amdgcn_s_setprio(1);
#pragma unroll
                for (int mi = 0; mi < 8; mi++)
#pragma unroll
                    for (int ni = 0; ni < 4; ni++)
                        acc[mi][ni] = __builtin_amdgcn_mfma_f32_16x16x32_bf16(bfr[ni], af[mi], acc[mi][ni], 0, 0, 0);
                __builtin_amdgcn_s_setprio(0);
            }
            asm volatile("s_waitcnt vmcnt(0)" ::: "memory");
            __syncthreads();
        }
        epi(t, acc);
    }
}
__device__ __forceinline__ void phase9_8(const Params& p, char* lds) {
    const int tid = threadIdx.x, lane = tid & 63, wid = tid >> 6, wm = wid >> 2, wn = wid & 3, lq = lane >> 4, lr = lane & 15;
    FOR_XCD_ITEMS_R(si, NE * NB * 2 * 2) {
        const int cth = si & 1, rt = (si >> 1) & 1, b = (si >> 2) & 3, e = si >> 4;
        const int* arow = wsp<int>(p, OFF_IDX) + (long)(b * NE + e) * CAP + rt * 256;
        const float* rss = wsp<float>(p, OFF_RSS) + (long)(b * NE + e) * CAP + rt * 256;
        gemm_256sq_multi(wsp<bf16_t>(p, OFF_X2B), ND, arow, wsp<bf16_t>(p, OFF_WGUT) + ((long)e * 2048 + cth * 1024) * ND, ND, 256L * ND,
                         ND, 4, lds, [&](int t, f32x4 (&acc)[8][4]) {
            const int ct = cth * 4 + t;
            char* adb = (char*)(wsp<bf16_t>(p, OFF_ACT) + ((long)(e * NB + b) * CAP + rt * 256) * ND + ct * 128);
            const unsigned ado = (unsigned)((wm * 128 + lr) * ND + wn * 32 + 4 * lq) * 2u;
#pragma unroll
            for (int mi = 0; mi < 8; mi++) {
                const float rs = rss[wm * 128 + mi * 16 + lr];
#pragma unroll
                for (int pp = 0; pp < 2; pp++) {
                    f32x4 o;
#pragma unroll
                    for (int q = 0; q < 4; q++) {
                        const float ga = acc[mi][2 * pp][q] * rs, up = acc[mi][2 * pp + 1][q] * rs;
                        o[q] = ga / (1.f + __expf(-ga)) * up;
                    }
                    *(u32x2*)(adb + (ado + (unsigned)(mi * 16 * ND * 2 + pp * 32))) = pack4bf(o);
                }
            }
        });
    }
}
__device__ __forceinline__ void phase10_8(const Params& p, char* lds) {
    const int tid = threadIdx.x, lane = tid & 63, wid = tid >> 6, wm = wid >> 2, wn = wid & 3, lq = lane >> 4, lr = lane & 15;
    FOR_XCD_ITEMS_R(si, NE * NB * 2 * 2) {
        const int cth = si & 1, rt = (si >> 1) & 1, b = (si >> 2) & 3, e = si >> 4;
        const long row0 = (long)(e * NB + b) * CAP + rt * 256;
        const float* gate = wsp<float>(p, OFF_GATE) + (long)(b * NE + e) * CAP + rt * 256;
        gemm_256sq_multi(wsp<bf16_t>(p, OFF_ACT) + row0 * ND, ND, nullptr, wsp<bf16_t>(p, OFF_WDT) + ((long)e * 1024 + cth * 512) * ND, ND, 256L * ND,
                         ND, 2, lds, [&](int t, f32x4 (&acc)[8][4]) {
            const int ct = cth * 2 + t;
            char* yb = (char*)(wsp<bf16_t>(p, OFF_Y) + row0 * ND + ct * 256);
            const unsigned yo = (unsigned)((wm * 128 + lr) * ND + wn * 64 + 4 * lq) * 2u;
#pragma unroll
            for (int mi = 0; mi < 8; mi++) {
                const float gv = gate[wm * 128 + mi * 16 + lr];
#pragma unroll
                for (int ni = 0; ni < 4; ni++) *(u32x2*)(yb + (yo + (unsigned)(mi * 16 * ND * 2 + ni * 32))) = pack4bf(acc[mi][ni] * gv);
            }
        });
    }
}


__device__ __forceinline__ void phase1_big(const Params& p, char* lds) {
    const int tid = threadIdx.x, lane = tid & 63, wid = tid >> 6, wm = wid >> 2, wn = wid & 3, lq = lane >> 4, lr = lane & 15;
    FOR_XCD_ITEMS_R(item, 64 * 4) {
        const int tm = item >> 2, tn = item & 3;
        f32x4 acc[8][4];
        GemmTile g; g.A = wsp<bf16_t>(p, OFF_XB) + (long)tm * 256 * ND; g.lda = ND; g.arow = nullptr;
        g.Bt = wsp<bf16_t>(p, OFF_W1T) + (long)tn * 256 * ND; g.ldb = ND; g.K = ND;
        gemm_tile_256sq(g, lds, acc);
        const float* r0 = wsp<float>(p, OFF_R0);
        const int col0 = tn * 256 + wn * 64;
#pragma unroll
        for (int mi = 0; mi < 8; mi++) {
            const int row = tm * 256 + wm * 128 + mi * 16 + lr;
            const float rs = r0[row];
#pragma unroll
            for (int ni = 0; ni < 4; ni++) acc[mi][ni] *= rs;
            if (col0 < 512) {
#pragma unroll
                for (int ni = 0; ni < 4; ni++)
                    *(u32x2*)(wsp<bf16_t>(p, OFF_UF) + (long)row * 512 + col0 + ni * 16 + 4 * lq) = pack4bf(acc[mi][ni]);
            } else {
                float ss = 0.f;
#pragma unroll
                for (int ni = 0; ni < 4; ni++) { const f32x4 v = acc[mi][ni]; ss += v[0] * v[0] + v[1] * v[1] + v[2] * v[2] + v[3] * v[3]; }
                ss += __shfl_xor(ss, 16); ss += __shfl_xor(ss, 32);
                if (col0 < 896) {
#pragma unroll
                    for (int ni = 0; ni < 4; ni++)
                        *(u32x2*)(wsp<bf16_t>(p, OFF_UQ) + (long)row * 384 + (col0 - 512) + ni * 16 + 4 * lq) = pack4bf(acc[mi][ni]);
                    if (lq == 0) wsp<float>(p, OFF_SSQ)[row * 6 + ((col0 - 512) >> 6)] = ss;
                } else {
#pragma unroll
                    for (int ni = 0; ni < 4; ni++)
                        *(u32x2*)(wsp<bf16_t>(p, OFF_UKV) + (long)row * 256 + (col0 - 896) + ni * 16 + 4 * lq) = pack4bf(acc[mi][ni]);
                    if (lq == 0) wsp<float>(p, OFF_SSKV)[row * 4 + ((col0 - 896) >> 6)] = ss;
                }
            }
        }
    }
}


__device__ __forceinline__ void phase3_attn8(const Params& p, char* lds) {
    FOR_XCD_ITEMS_R(item, NB * 8 * (NS / 256)) {
        const int qt = item & 15, h = (item >> 4) & 7, b = item >> 7;
        const bf16_t* Qp = wsp<bf16_t>(p, OFF_Q) + ((long)(b * 8 + h) * NS + qt * 256) * 96;
        const bf16_t* Kp = wsp<bf16_t>(p, OFF_K) + ((long)(b * 8 + h) * NS) * 96;
        const bf16_t* Vtp = wsp<bf16_t>(p, OFF_VT) + ((long)(b * 8 + h) * 64) * NS;
        bf16_t* Op = wsp<bf16_t>(p, OFF_ZA) + ((long)b * NS + qt * 256) * 1024 + 512 + h * 64;
        attn_block<96, 64, 128, 512>(Qp, Kp, Vtp, (long)NS, NS, lds, [&](int q, int dv, f32x4 v) { *(u32x2*)(Op + (long)q * 1024 + dv) = pack4bf(v); });
    }
}
__device__ __forceinline__ void phase5b_8(const Params& p, char* lds) {
    FOR_XCD_ITEMS_R(item, NB * 4 * 16 * 2) {
        const int dvh = item & 1, qt = (item >> 1) & 15, h = (item >> 5) & 3, b = item >> 7;
        const bf16_t* Qp = wsp<bf16_t>(p, OFF_QM) + ((long)(b * 4 + h) * NS + qt * 256) * 256;
        const bf16_t* Kp = wsp<bf16_t>(p, OFF_KMEM) + ((long)(b * 4 + h) * 256) * 256;
        const bf16_t* Vtp = wsp<bf16_t>(p, OFF_VTMEM) + ((long)(b * 4 + h) * 256 + dvh * 128) * 256;
        bf16_t* Op = wsp<bf16_t>(p, OFF_OM) + ((long)b * NS + qt * 256) * 1024 + h * 256 + dvh * 128;
        attn_block<256, 128, 32, 512>(Qp, Kp, Vtp, 256L, 256, lds, [&](int q, int dv, f32x4 v) { *(u32x2*)(Op + (long)q * 1024 + dv) = pack4bf(v); });
    }
}

__global__ void __launch_bounds__(512, 1) k_fwd(Params p, int ph_lo, int ph_hi) {
    extern __shared__ __attribute__((aligned(16))) char lds_all[];
    char* lds = lds_all + VHALF * LDS_HALF;
    volatile LAS unsigned* st = (volatile LAS unsigned*)(lds_all + LDS_MAIN);
    if (threadIdx.x == 0) { st[0] = 0u; st[1] = 0u; }
    __syncthreads();
    XcdBarrier bar = xcd_barrier_post(wsp<unsigned>(p, OFF_BAR), st);
#if USE_CG_SYNC
#define GRID_BARRIER() do { asm volatile("s_waitcnt vmcnt(0)" ::: "memory"); __syncthreads(); cg::this_grid().sync(); asm volatile("s_waitcnt vmcnt(0)" ::: "memory"); __syncthreads(); } while (0)
#else
#define GRID_BARRIER() xcd_barrier(bar)
#endif
#define RUN_PHASE(k, call) if (ph_lo <= (k) && (k) < ph_hi) { if ((k) > ph_lo) { GRID_BARRIER(); } call; }
    RUN_PHASE(0, phase0(p, lds))
    RUN_PHASE(1, (phase1_big(p, lds_all), phase1(p, lds_all)))
    RUN_PHASE(2, (phase2(p, lds_all), phase2_f2a(p, lds)))
    RUN_PHASE(3, ((blockIdx.x & 1) ? phase3_tr(p, lds) : (void)0, phase3_attn8(p, lds_all), phase3_f2b(p, lds), (blockIdx.x & 1) ? (void)0 : phase3_tr(p, lds)))
    RUN_PHASE(4, phase_resid8(p, lds_all, OFF_ZA, OFF_WOUTT, p.x, nullptr, OFF_X1B, OFF_SS1))
    RUN_PHASE(5, phase5a8(p, lds_all))
    RUN_PHASE(6, phase5b_8(p, lds_all))
    RUN_PHASE(7, phase_resid8(p, lds_all, OFF_OM, OFF_WMOT, nullptr, wsp<bf16_t>(p, OFF_X1B), OFF_X2B, OFF_SS2))
    RUN_PHASE(8, phase7(p, lds_all))
    RUN_PHASE(9, phase8(p, lds_all))
    RUN_PHASE(10, phase9_8(p, lds_all))
    RUN_PHASE(11, phase10_8(p, lds_all))
    RUN_PHASE(12, phase11(p, lds))
}

extern "C" void kernel_launch(void* const* d_in, const int* in_sizes, int n_in,
                              void* d_out, int out_size, void* d_ws, size_t ws_size,
                              hipStream_t stream) {
    static int grid = 0;
    if (grid == 0) {
        if (n_in != 22 || ws_size < WS_END) { fprintf(stderr, "kernel_launch: unexpected inputs (n_in %d, ws %zu < %zu)\n", n_in, ws_size, (size_t)WS_END); grid = -1; return; }
        int dev = 0, cus = 0, per_cu = 0;
        (void)hipGetDevice(&dev);
        (void)hipDeviceGetAttribute(&cus, hipDeviceAttributeMultiprocessorCount, dev);
        if (hipFuncSetAttribute((const void*)k_fwd, hipFuncAttributeMaxDynamicSharedMemorySize, LDS_TOTAL) != hipSuccess) { fprintf(stderr, "kernel_launch: hipFuncSetAttribute failed\n"); grid = -1; return; }
        if (hipOccupancyMaxActiveBlocksPerMultiprocessor(&per_cu, (const void*)k_fwd, 512, LDS_TOTAL) != hipSuccess || per_cu < 1) { fprintf(stderr, "kernel_launch: occupancy query failed (%d)\n", per_cu); (void)hipGetLastError(); per_cu = 1; }
        if (per_cu > 1) per_cu = 1;
        grid = (cus * per_cu) & ~7;
        if (grid < 8) { fprintf(stderr, "kernel_launch: unexpected device (%d CUs)\n", cus); grid = -1; return; }
        fprintf(stderr, "kernel_launch: %d CUs x %d blocks\n", cus, per_cu);
    }
    if (grid < 0) return;
    Params p{};
    p.x = (const float*)d_in[0]; p.mem = (const float*)d_in[1]; p.pos = (const int*)d_in[2];
    p.g_mix = (const float*)d_in[3]; p.w_in = (const float*)d_in[4]; p.g_q_lat = (const float*)d_in[5]; p.w_q_up = (const float*)d_in[6];
    p.g_kv_lat = (const float*)d_in[7]; p.w_kv_up = (const float*)d_in[8]; p.w_fourier = (const float*)d_in[9]; p.w_out = (const float*)d_in[10];
    p.g_mem_q = (const float*)d_in[11]; p.g_mem_kv = (const float*)d_in[12]; p.w_mem_q = (const float*)d_in[13]; p.w_mem_kv = (const float*)d_in[14];
    p.w_mem_o = (const float*)d_in[15]; p.g_ffn = (const float*)d_in[16]; p.w_router = (const float*)d_in[17];
    p.w_exp_gate = (const float*)d_in[18]; p.w_exp_up = (const float*)d_in[19]; p.w_exp_down = (const float*)d_in[20]; p.g_final = (const float*)d_in[21];
    p.out = (float*)d_out; p.ws = (char*)d_ws;
    static const int cuts[] = MK_CUTS;
    const int ncut = (int)(sizeof(cuts) / sizeof(int));
    for (int li = 0; li + 1 < ncut; li++) {
        (void)hipMemsetAsync((char*)d_ws + OFF_BAR, 0, 16384, stream);
        int lo = cuts[li], hi = cuts[li + 1];
        void* args[] = {&p, &lo, &hi};
        hipError_t e = hipLaunchCooperativeKernel((const void*)k_fwd, dim3(grid), dim3(512), args, LDS_TOTAL, stream);
        if (e != hipSuccess) fprintf(stderr, "cooperative launch failed: %s (grid %d)\n", hipGetErrorString(e), grid);
    }
}
```

```cpp
#include <hip/hip_runtime.h>
#include <stdint.h>
#include <cstdio>
#include <hip/hip_cooperative_groups.h>
namespace cg = cooperative_groups;
#ifndef USE_CG_SYNC
#define USE_CG_SYNC 0
#endif

#ifndef MK_CUTS
#define MK_CUTS {0, 13}
#endif

#define NB 4
#define NS 4096
#define ND 1024
#define NT (NB * NS)
#define INW 1184
#define NE 16
#define CAP 512
#define MEML 256
#define NPHASE 13
#define VTID ((int)(threadIdx.x & 255))
#define VHALF (__builtin_amdgcn_readfirstlane((int)(threadIdx.x >> 8)))
#define VBLK ((int)(blockIdx.x * 2) + VHALF)
#define VGRID ((int)(gridDim.x * 2))

typedef unsigned short bf16_t;
typedef short bf16x8 __attribute__((ext_vector_type(8)));
typedef float f32x4 __attribute__((ext_vector_type(4)));
typedef float f32x16 __attribute__((ext_vector_type(16)));
typedef unsigned u32x4 __attribute__((ext_vector_type(4)));
typedef int i32x4 __attribute__((ext_vector_type(4)));
typedef unsigned u32x2 __attribute__((ext_vector_type(2)));

__device__ __forceinline__ unsigned f2bf(float f) {
    unsigned u = __float_as_uint(f);
    u += 0x7FFFu + ((u >> 16) & 1u);
    return u >> 16;
}
typedef __bf16 hbf2 __attribute__((ext_vector_type(2)));
typedef float f32x2 __attribute__((ext_vector_type(2)));
__device__ __forceinline__ unsigned pack2bf(float lo, float hi) { f32x2 v = {lo, hi}; return __builtin_bit_cast(unsigned, __builtin_convertvector(v, hbf2)); }
__device__ __forceinline__ float bf2f(unsigned short b) { return __uint_as_float(((unsigned)b) << 16); }

__device__ __forceinline__ int tile_off(int row, int chunk) { return row * 128 + ((chunk ^ ((row >> 1) & 7)) << 4); }

#define GT_LDS_BYTES 65536

struct GemmTile { const bf16_t* A; long lda; const int* arow; const bf16_t* Bt; long ldb; int K; };

__device__ __forceinline__ void gemm_tile_128(const GemmTile& g, char* lds, f32x4 (&acc)[4][4]) {
    const int tid = VTID, lane = tid & 63, wid = tid >> 6, wm = wid >> 1, wn = wid & 1;
    const int lrow = lane >> 3, pc = lane & 7;
    const bf16_t* ap[4]; const bf16_t* bp[4];
#pragma unroll
    for (int i = 0; i < 4; i++) {
        const int r = (wid * 4 + i) * 8 + lrow;
        const int c = pc ^ ((r >> 1) & 7);
        const long ro = g.arow ? (long)g.arow[r] * g.lda : (long)r * g.lda;
        ap[i] = g.A + ro + c * 8;
        bp[i] = g.Bt + (long)r * g.ldb + c * 8;
    }
#pragma unroll
    for (int mi = 0; mi < 4; mi++)
#pragma unroll
        for (int ni = 0; ni < 4; ni++) acc[mi][ni] = (f32x4){0.f, 0.f, 0.f, 0.f};
    const int nk = g.K >> 6;
    auto stage = [&](int kt, char* st) {
#pragma unroll
        for (int i = 0; i < 4; i++) {
            __builtin_amdgcn_global_load_lds((const unsigned*)(ap[i] + kt * 64), (unsigned*)(st + (wid * 4 + i) * 1024), 16, 0, 0);
            __builtin_amdgcn_global_load_lds((const unsigned*)(bp[i] + kt * 64), (unsigned*)(st + 16384 + (wid * 4 + i) * 1024), 16, 0, 0);
        }
    };
    __syncthreads();
    stage(0, lds);
    asm volatile("s_waitcnt vmcnt(0)" ::: "memory");
    __syncthreads();
    for (int kt = 0; kt < nk; kt++) {
        char* cur = lds + (kt & 1) * 32768;
        if (kt + 1 < nk) stage(kt + 1, lds + ((kt + 1) & 1) * 32768);
        bf16x8 af[2][4], bfr[2][4];
#pragma unroll
        for (int ks = 0; ks < 2; ks++)
#pragma unroll
            for (int i = 0; i < 4; i++) {
                af[ks][i] = *(const bf16x8*)(cur + tile_off(wm * 64 + i * 16 + (lane & 15), ks * 4 + (lane >> 4)));
                bfr[ks][i] = *(const bf16x8*)(cur + 16384 + tile_off(wn * 64 + i * 16 + (lane & 15), ks * 4 + (lane >> 4)));
            }
        __builtin_amdgcn_s_setprio(1);
#pragma unroll
        for (int ks = 0; ks < 2; ks++)
#pragma unroll
            for (int mi = 0; mi < 4; mi++)
#pragma unroll
                for (int ni = 0; ni < 4; ni++)
                    acc[mi][ni] = __builtin_amdgcn_mfma_f32_16x16x32_bf16(bfr[ks][ni], af[ks][mi], acc[mi][ni], 0, 0, 0);
        __builtin_amdgcn_s_setprio(0);
        asm volatile("s_waitcnt vmcnt(0)" ::: "memory");
        __syncthreads();
    }
}

template <int DQK, int DVT, int KT>
struct AttnCfg {
    static constexpr int KROW = DQK * 2 + 16;
    static constexpr int VROW = KT * 2 + 8;
    static constexpr int KBYTES = KT * KROW;
    static constexpr int VBYTES = DVT * VROW;
    static constexpr int STAGE = KBYTES + VBYTES;
    static constexpr int LDS = 2 * STAGE;
};

template <int DQK, int DVT, int KT, int NTH, class Out>
__device__ __forceinline__ void attn_block(const bf16_t* Qp, const bf16_t* Kp, const bf16_t* Vtp, long ldv, int nk, char* lds, Out&& out) {
    typedef AttnCfg<DQK, DVT, KT> C;
    constexpr int NKS = DQK / 16, NST = KT / 32, NDT = DVT / 32, NPS = KT / 16;
    constexpr int KCPR = DQK / 8;
    constexpr int KTOT = KT * KCPR, KCH = (KTOT + NTH - 1) / NTH;
    constexpr int VCPR = KT / 8;
    constexpr int VTOT = DVT * VCPR, VCH = (VTOT + NTH - 1) / NTH;
    const int tid = NTH == 512 ? (int)threadIdx.x : VTID, lane = tid & 63, wid = tid >> 6, h = lane >> 5, c = lane & 31;

    bf16x8 qf[NKS];
    {
        const bf16_t* qrow = Qp + (long)(wid * 32 + c) * DQK + 8 * h;
#pragma unroll
        for (int ks = 0; ks < NKS; ks++) qf[ks] = *(const bf16x8*)(qrow + 16 * ks);
    }
    f32x16 o[NDT];
#pragma unroll
    for (int dt = 0; dt < NDT; dt++)
#pragma unroll
        for (int r = 0; r < 16; r++) o[dt][r] = 0.f;
    float m = 0.f, l = 0.f;

    u32x4 kr[KCH], vr[VCH];
    auto gload = [&](int t) {
#pragma unroll
        for (int i = 0; i < KCH; i++) {
            const int ci = tid + NTH * i, row = ci / KCPR, cc = ci % KCPR;
            if (KTOT % NTH == 0 || ci < KTOT) kr[i] = *(const u32x4*)(Kp + (long)(t * KT + row) * DQK + cc * 8);
        }
#pragma unroll
        for (int i = 0; i < VCH; i++) {
            const int ci = tid + NTH * i, row = ci / VCPR, cc = ci % VCPR;
            if (VTOT % NTH == 0 || ci < VTOT) vr[i] = *(const u32x4*)(Vtp + (long)row * ldv + t * KT + cc * 8);
        }
    };
    auto lwrite = [&](char* st) {
#pragma unroll
        for (int i = 0; i < KCH; i++) {
            const int ci = tid + NTH * i, row = ci / KCPR, cc = ci % KCPR;
            if (KTOT % NTH == 0 || ci < KTOT) *(u32x4*)(st + row * C::KROW + cc * 16) = kr[i];
        }
#pragma unroll
        for (int i = 0; i < VCH; i++) {
            const int ci = tid + NTH * i, row = ci / VCPR, cc = ci % VCPR;
            if (VTOT % NTH == 0 || ci < VTOT) {
                char* p = st + C::KBYTES + row * C::VROW + cc * 16;
                *(u32x2*)(p) = (u32x2){vr[i].x, vr[i].y};
                *(u32x2*)(p + 8) = (u32x2){vr[i].z, vr[i].w};
            }
        }
    };
    const int nt = nk / KT;
    gload(0);
    __syncthreads();
    lwrite(lds);
    __syncthreads();
    for (int t = 0; t < nt; t++) {
        char* cur = lds + (t & 1) * C::STAGE;
        if (t + 1 < nt) gload(t + 1);
        f32x16 s[NST];
        const float negm = -m;
#pragma unroll
        for (int st = 0; st < NST; st++) {
#pragma unroll
            for (int r = 0; r < 16; r++) s[st][r] = negm;
#pragma unroll
            for (int ks = 0; ks < NKS; ks++) {
                const bf16x8 kf = *(const bf16x8*)(cur + (st * 32 + c) * C::KROW + ks * 32 + h * 16);
                s[st] = __builtin_amdgcn_mfma_f32_32x32x16_bf16(kf, qf[ks], s[st], 0, 0, 0);
            }
        }
        float mx = s[0][0];
#pragma unroll
        for (int st = 0; st < NST; st++)
#pragma unroll
            for (int r = 0; r < 16; r++) mx = fmaxf(mx, s[st][r]);
        mx = fmaxf(mx, __shfl_xor(mx, 32));
        if (__any(mx > 8.0f)) {
            const float d = fmaxf(mx, 0.f);
            const float alpha = __builtin_amdgcn_exp2f(-d);
            m += d;
            l *= alpha;
#pragma unroll
            for (int dt = 0; dt < NDT; dt++)
#pragma unroll
                for (int r = 0; r < 16; r++) o[dt][r] *= alpha;
#pragma unroll
            for (int st = 0; st < NST; st++)
#pragma unroll
                for (int r = 0; r < 16; r++) s[st][r] -= d;
        }
        float rs = 0.f;
#pragma unroll
        for (int st = 0; st < NST; st++)
#pragma unroll
            for (int r = 0; r < 16; r++) { const float p = __builtin_amdgcn_exp2f(s[st][r]); rs += p; s[st][r] = p; }
        l += rs;
#pragma unroll
        for (int ps = 0; ps < NPS; ps++) {
            const int st = ps >> 1, u = ps & 1;
            u32x4 pw;
            pw.x = pack2bf(s[st][8 * u + 0], s[st][8 * u + 1]);
            pw.y = pack2bf(s[st][8 * u + 2], s[st][8 * u + 3]);
            pw.z = pack2bf(s[st][8 * u + 4], s[st][8 * u + 5]);
            pw.w = pack2bf(s[st][8 * u + 6], s[st][8 * u + 7]);
            const bf16x8 pf = __builtin_bit_cast(bf16x8, pw);
#pragma unroll
            for (int dt = 0; dt < NDT; dt++) {
                const char* vp = cur + C::KBYTES + (dt * 32 + c) * C::VROW + (ps * 16 + 4 * h) * 2;
                const u32x2 v0 = *(const u32x2*)(vp);
                const u32x2 v1 = *(const u32x2*)(vp + 16);
                const bf16x8 vf = __builtin_bit_cast(bf16x8, ((u32x4){v0.x, v0.y, v1.x, v1.y}));
                o[dt] = __builtin_amdgcn_mfma_f32_32x32x16_bf16(vf, pf, o[dt], 0, 0, 0);
            }
        }
        if (t + 1 < nt) lwrite(lds + ((t + 1) & 1) * C::STAGE);
        __syncthreads();
    }
    l += __shfl_xor(l, 32);
    const float inv = 1.f / l;
#pragma unroll
    for (int dt = 0; dt < NDT; dt++)
#pragma unroll
        for (int g4 = 0; g4 < 4; g4++) {
            f32x4 v = {o[dt][4 * g4 + 0] * inv, o[dt][4 * g4 + 1] * inv, o[dt][4 * g4 + 2] * inv, o[dt][4 * g4 + 3] * inv};
            out(wid * 32 + c, dt * 32 + 8 * g4 + 4 * h, v);
        }
}


constexpr size_t SLOT = 33554432;
constexpr size_t OFF_W1T = 0;
constexpr size_t OFF_WQT = OFF_W1T + 1280UL * 1024 * 2;
constexpr size_t OFF_WKVT = OFF_WQT + 768UL * 384 * 2;
constexpr size_t OFF_WOUTT = OFF_WKVT + 1024UL * 256 * 2;
constexpr size_t OFF_WMQT = OFF_WOUTT + 1024UL * 1024 * 2;
constexpr size_t OFF_WMKVT = OFF_WMQT + 1024UL * 1024 * 2;
constexpr size_t OFF_WMOT = OFF_WMKVT + 2048UL * 1024 * 2;
constexpr size_t OFF_WGUT = OFF_WMOT + 1024UL * 1024 * 2;
constexpr size_t OFF_WDT = OFF_WGUT + 16UL * 2048 * 1024 * 2;
constexpr size_t OFF_T64 = OFF_WDT + 16UL * 1024 * 1024 * 2;
constexpr size_t OFF_M1 = OFF_T64 + 16384;
constexpr size_t OFF_M3 = OFF_M1 + 32768;
constexpr size_t OFF_WFT = OFF_M3 + 16384;
constexpr size_t OFF_TW = OFF_WFT + 65536;
constexpr size_t OFF_ROPE = OFF_TW + 32768;
constexpr size_t OFF_R0 = OFF_ROPE + (size_t)NT * 16 * 8;
constexpr size_t OFF_RMEM = OFF_R0 + (size_t)NT * 4;
constexpr size_t OFF_SSQ = OFF_RMEM + 4096;
constexpr size_t OFF_SSKV = OFF_SSQ + (size_t)NT * 6 * 4;
constexpr size_t OFF_SS1 = OFF_SSKV + (size_t)NT * 4 * 4;
constexpr size_t OFF_SS2 = OFF_SS1 + (size_t)NT * 16 * 4;
constexpr size_t OFF_AFF = OFF_SS2 + (size_t)NT * 16 * 4;
constexpr size_t OFF_SLOTS = OFF_AFF + (size_t)NT * 16 * 4;
constexpr size_t OFF_IDX = OFF_SLOTS + 4UL * 16 * 4096 * 4;
constexpr size_t OFF_GATE = OFF_IDX + 4UL * 16 * 512 * 4;
constexpr size_t OFF_MEMB = OFF_GATE + 4UL * 16 * 512 * 4;
constexpr size_t OFF_KMEM = OFF_MEMB + 1024UL * 1024 * 2;
constexpr size_t OFF_VTMEM = OFF_KMEM + 1024UL * 1024 * 2;
constexpr size_t OFF_KR = OFF_VTMEM + 1024UL * 1024 * 2;
constexpr size_t OFF_BAR = OFF_KR + (size_t)NT * 32 * 2;
constexpr size_t OFF_RS2 = OFF_BAR + 16384;
constexpr size_t OFF_RSS = OFF_RS2 + (size_t)NT * 4;
constexpr size_t OFF_S0 = (OFF_RSS + 4UL * 16 * 512 * 4 + 255) / 256 * 256;
constexpr size_t OFF_S1 = OFF_S0 + SLOT;
constexpr size_t OFF_S2 = OFF_S1 + SLOT;
constexpr size_t OFF_S3 = OFF_S2 + SLOT;
constexpr size_t OFF_S4 = OFF_S3 + SLOT;
constexpr size_t WS_END = OFF_S4 + SLOT;
static_assert(WS_END <= 300964352UL, "workspace map exceeds the guaranteed scratch size");
constexpr size_t OFF_XB = OFF_S0, OFF_YR = OFF_S0, OFF_YI = OFF_S0 + SLOT / 2, OFF_X1B = OFF_S3, OFF_OM = OFF_S0, OFF_ACT = OFF_S0;
constexpr size_t OFF_UF = OFF_S1, OFF_UQ = OFF_S1 + (size_t)NT * 512 * 2, OFF_ZA = OFF_S1, OFF_QM = OFF_S1;
constexpr size_t OFF_Q = OFF_S2, OFF_UKV = OFF_S2 + (size_t)NT * 768 * 2, OFF_X2B = OFF_S2;
constexpr size_t OFF_K = OFF_S3, OFF_Y = OFF_S3;
constexpr size_t OFF_VT = OFF_S4;

struct Params {
    const float *x, *mem; const int* pos;
    const float *g_mix, *w_in, *g_q_lat, *w_q_up, *g_kv_lat, *w_kv_up, *w_fourier, *w_out, *g_mem_q, *g_mem_kv, *w_mem_q, *w_mem_kv, *w_mem_o,
        *g_ffn, *w_router, *w_exp_gate, *w_exp_up, *w_exp_down, *g_final;
    float* out; char* ws;
};
template <class T> __device__ __forceinline__ T* wsp(const Params& p, size_t off) { return (T*)(p.ws + off); }

#define LDS_HALF 65536
#define LDS_MAIN 131072
#define LDS_TOTAL (LDS_MAIN + 16)
#define LAS __attribute__((address_space(3)))

#define XB_TMO      128
#define XB_XCNT(j)  (256  + 64 * (j))
#define XB_XSUB(j)  (1280 + 64 * (j))
#define XB_XGEN(j)  (2304 + 64 * (j))
#define XB_TOP      3328
#define XB_TOPGEN   3392
#define XCD_BAR_WORDS 3456
#define XB_SPIN_CAP (1u << 25)
__device__ __forceinline__ unsigned xb_ld(unsigned* p)              { return __hip_atomic_load(p, __ATOMIC_RELAXED, __HIP_MEMORY_SCOPE_AGENT); }
__device__ __forceinline__ unsigned xb_add(unsigned* p, unsigned v) { return __hip_atomic_fetch_add(p, v, __ATOMIC_RELAXED, __HIP_MEMORY_SCOPE_AGENT); }
__device__ __forceinline__ unsigned xb_xcc_id() { return (unsigned)__builtin_amdgcn_s_getreg((3 << 11) | 20) & 0xFu; }
#define XB_SPIN(cond, bar) do { unsigned _sp = 0; while (cond) { __builtin_amdgcn_s_sleep(1); \
    if ((++_sp & 255u) == 0u) { if (xb_ld(&(bar)[XB_TMO])) break; if (_sp > XB_SPIN_CAP) { atomicAdd(&(bar)[XB_TMO], 1u); break; } } } } while (0)
struct XcdBarrier { unsigned* bar; unsigned x; volatile LAS unsigned* st; };
__device__ __forceinline__ XcdBarrier xcd_barrier_post(unsigned* bar, volatile LAS unsigned* st) {
    XcdBarrier b; b.bar = bar; b.x = xb_xcc_id(); b.st = st;
    if (threadIdx.x == 0) (void)xb_add(&bar[XB_XCNT(b.x)], 1u);
    return b;
}
__device__ __forceinline__ void xcd_barrier_complete(unsigned* bar, unsigned x, unsigned& nloc, unsigned& nx) {
    const unsigned G = gridDim.x * gridDim.y * gridDim.z;
    unsigned sum, cnt, mine, sp = 0u;
    for (;;) {
        sum = 0u; cnt = 0u; mine = 0u;
#pragma unroll
        for (unsigned j = 0; j < 16; ++j) { const unsigned c = xb_ld(&bar[XB_XCNT(j)]); sum += c; cnt += (c > 0u) ? 1u : 0u; mine = (j == x) ? c : mine; }
        if (sum == G) break;
        __builtin_amdgcn_s_sleep(1);
        if ((++sp & 255u) == 0u) { if (xb_ld(&bar[XB_TMO])) break; if (sp > XB_SPIN_CAP) { atomicAdd(&bar[XB_TMO], 1u); break; } }
    }
    nloc = mine > 0u ? mine : 1u; nx = cnt > 0u ? cnt : 1u;
}
__device__ __forceinline__ void xcd_barrier(const XcdBarrier& b) {
    asm volatile("s_waitcnt vmcnt(0)" ::: "memory");
    __syncthreads();
    if (threadIdx.x == 0) {
        unsigned* bar = b.bar;
        __builtin_amdgcn_s_waitcnt(0);
        unsigned nloc = b.st[0], nx = b.st[1];
        if (nloc == 0u) { xcd_barrier_complete(bar, b.x, nloc, nx); b.st[0] = nloc; b.st[1] = nx; }
        const unsigned old = xb_add(&bar[XB_XSUB(b.x)], 1u);
        const unsigned gen = old / nloc;
        if (old + 1u == (gen + 1u) * nloc) {
            __builtin_amdgcn_fence(__ATOMIC_RELEASE, "agent");
            asm volatile("s_waitcnt vmcnt(0)" ::: "memory");
            const unsigned og = xb_add(&bar[XB_TOP], 1u);
            const unsigned tg = og / nx;
            if (og + 1u == (tg + 1u) * nx) xb_add(&bar[XB_TOPGEN], 1u);
            else XB_SPIN(xb_ld(&bar[XB_TOPGEN]) == tg, bar);
            __builtin_amdgcn_fence(__ATOMIC_ACQUIRE, "agent");
            xb_add(&bar[XB_XGEN(b.x)], 1u);
            asm volatile("s_waitcnt vmcnt(0)" ::: "memory");
        } else {
            XB_SPIN(xb_ld(&bar[XB_XGEN(b.x)]) == gen, bar);
            __builtin_amdgcn_fence(__ATOMIC_ACQUIRE, "agent");
            asm volatile("s_waitcnt vmcnt(0)" ::: "memory");
        }
    }
    __syncthreads();
}

#define FOR_XCD_ITEMS(item, N) for (int _L = (int)((blockIdx.x >> 3) << 1) | VHALF, item; _L < (N) / 8 && ((item = (int)(blockIdx.x & 7) * ((N) / 8) + _L), true); _L += (int)(gridDim.x >> 2))

__device__ __forceinline__ u32x2 pack4bf(float a, float b, float c, float d) { return (u32x2){pack2bf(a, b), pack2bf(c, d)}; }
__device__ __forceinline__ u32x2 pack4bf(f32x4 v) { return (u32x2){pack2bf(v[0], v[1]), pack2bf(v[2], v[3])}; }
__device__ __forceinline__ float wave_sum(float v) {
#pragma unroll
    for (int o = 32; o > 0; o >>= 1) v += __shfl_xor(v, o);
    return v;
}

__device__ __forceinline__ void tr_tile(const float* W, long ldw, int k0, int n0, int nvalid, const float* gain, bf16_t* Wt, long ldt, int mode, char* lds) {
    float (*t)[132] = (float (*)[132])lds;
    const int tid = VTID, c4 = tid & 31, r0 = tid >> 5;
    f32x4 v[8];
#pragma unroll
    for (int i = 0; i < 8; i++) {
        const int kk = r0 + 8 * i, n = n0 + c4 * 4;
        v[i] = (n < nvalid) ? *(const f32x4*)(W + (long)(k0 + kk) * ldw + n) : (f32x4){0.f, 0.f, 0.f, 0.f};
        if (gain) v[i] *= gain[k0 + kk];
    }
    __syncthreads();
#pragma unroll
    for (int i = 0; i < 8; i++) *(f32x4*)(&t[r0 + 8 * i][c4 * 4]) = v[i];
    __syncthreads();
#pragma unroll
    for (int i = 0; i < 4; i++) {
        const int ci = tid + 256 * i, nn = ci >> 3, kc = ci & 7;
        const int n = n0 + nn;
        int row = n;
        if (mode) row = (n >> 5) * 64 + ((n >> 4) & 1) * 32 + (mode - 1) * 16 + (n & 15);
        u32x4 w;
        w.x = pack2bf(t[kc * 8 + 0][nn], t[kc * 8 + 1][nn]);
        w.y = pack2bf(t[kc * 8 + 2][nn], t[kc * 8 + 3][nn]);
        w.z = pack2bf(t[kc * 8 + 4][nn], t[kc * 8 + 5][nn]);
        w.w = pack2bf(t[kc * 8 + 6][nn], t[kc * 8 + 7][nn]);
        *(u32x4*)(Wt + (long)row * ldt + k0 + kc * 8) = w;
    }
}

__device__ __forceinline__ void phase0(const Params& p, char* lds) {
    constexpr int J_W1 = 160, J_WQ = 36, J_WKV = 32, J_WOUT = 128, J_WMQ = 128, J_WMKV = 256, J_WMO = 128, J_WG = 0, J_WU = 0, J_WD = 0;
    constexpr int J_TR = J_W1 + J_WQ + J_WKV + J_WOUT + J_WMQ + J_WMKV + J_WMO + J_WG + J_WU + J_WD;
    constexpr int J_XR = NT / 16, J_MR = 1024 / 16, J_ROPE = NT * 16 / 256, J_TAB = (4096 + 8192 + 16384 + 8192 + 32768) / 256;
    constexpr int J_ALL = J_TR + J_XR + J_MR + J_ROPE + J_TAB;
    const int tid = VTID, lane = tid & 63, wid = tid >> 6;
    const double PI2 = 6.283185307179586476925286766559;
    for (int job = VBLK; job < J_ALL; job += VGRID) {
        int j = job;
        if (j < J_TR) {
            if (j < J_W1) { tr_tile(p.w_in, INW, (j / 10) * 64, (j % 10) * 128, INW, p.g_mix, wsp<bf16_t>(p, OFF_W1T), 1024, 0, lds); continue; } j -= J_W1;
            if (j < J_WQ) { tr_tile(p.w_q_up, 768, (j / 6) * 64, (j % 6) * 128, 768, p.g_q_lat, wsp<bf16_t>(p, OFF_WQT), 384, 0, lds); continue; } j -= J_WQ;
            if (j < J_WKV) { tr_tile(p.w_kv_up, 1024, (j / 8) * 64, (j % 8) * 128, 1024, p.g_kv_lat, wsp<bf16_t>(p, OFF_WKVT), 256, 0, lds); continue; } j -= J_WKV;
            if (j < J_WOUT) { tr_tile(p.w_out, 1024, (j / 8) * 64, (j % 8) * 128, 1024, nullptr, wsp<bf16_t>(p, OFF_WOUTT), 1024, 0, lds); continue; } j -= J_WOUT;
            if (j < J_WMQ) { tr_tile(p.w_mem_q, 1024, (j / 8) * 64, (j % 8) * 128, 1024, p.g_mem_q, wsp<bf16_t>(p, OFF_WMQT), 1024, 0, lds); continue; } j -= J_WMQ;
            if (j < J_WMKV) { tr_tile(p.w_mem_kv, 2048, (j / 16) * 64, (j % 16) * 128, 2048, p.g_mem_kv, wsp<bf16_t>(p, OFF_WMKVT), 1024, 0, lds); continue; } j -= J_WMKV;
            if (j < J_WMO) { tr_tile(p.w_mem_o, 1024, (j / 8) * 64, (j % 8) * 128, 1024, nullptr, wsp<bf16_t>(p, OFF_WMOT), 1024, 0, lds); continue; } j -= J_WMO;
            if (j < J_WG) { const int e = j >> 7, r = j & 127; tr_tile(p.w_exp_gate + (long)e * 1048576, 1024, (r / 8) * 64, (r % 8) * 128, 1024, p.g_ffn, wsp<bf16_t>(p, OFF_WGUT) + (long)e * 2048 * 1024, 1024, 1, lds); continue; } j -= J_WG;
            if (j < J_WU) { const int e = j >> 7, r = j & 127; tr_tile(p.w_exp_up + (long)e * 1048576, 1024, (r / 8) * 64, (r % 8) * 128, 1024, p.g_ffn, wsp<bf16_t>(p, OFF_WGUT) + (long)e * 2048 * 1024, 1024, 2, lds); continue; } j -= J_WU;
            { const int e = j >> 7, r = j & 127; tr_tile(p.w_exp_down + (long)e * 1048576, 1024, (r / 8) * 64, (r % 8) * 128, 1024, nullptr, wsp<bf16_t>(p, OFF_WDT) + (long)e * 1048576, 1024, 0, lds); continue; }
        }
        j -= J_TR;
        if (j < J_XR + J_MR) {
            const bool isx = j < J_XR;
            const int row0 = (isx ? j : j - J_XR) * 16 + wid * 4;
            const float* src = (isx ? p.x : p.mem) + (long)row0 * ND;
            bf16_t* dst = (isx ? wsp<bf16_t>(p, OFF_XB) : wsp<bf16_t>(p, OFF_MEMB)) + (long)row0 * ND;
            f32x4 v[4][4];
#pragma unroll
            for (int r = 0; r < 4; r++)
#pragma unroll
                for (int i = 0; i < 4; i++) v[r][i] = *(const f32x4*)(src + (long)r * ND + i * 256 + lane * 4);
#pragma unroll
            for (int r = 0; r < 4; r++) {
                float ss = 0.f;
#pragma unroll
                for (int i = 0; i < 4; i++) {
                    ss += v[r][i][0] * v[r][i][0] + v[r][i][1] * v[r][i][1] + v[r][i][2] * v[r][i][2] + v[r][i][3] * v[r][i][3];
                    *(u32x2*)(dst + (long)r * ND + i * 256 + lane * 4) = pack4bf(v[r][i]);
                }
                ss = wave_sum(ss);
                if (lane == 0) (isx ? wsp<float>(p, OFF_R0) : wsp<float>(p, OFF_RMEM))[row0 + r] = rsqrtf(ss * (1.f / ND) + 1e-6f);
            }
            continue;
        }
        j -= J_XR + J_MR;
        if (j < J_ROPE) {
            const int i = j * 256 + tid; const int t = i >> 4, jj = i & 15;
            const double f = pow(10000.0, -(double)(2 * jj) / 32.0);
            const double ang = (double)p.pos[t] * f;
            wsp<float2>(p, OFF_ROPE)[i] = make_float2((float)cos(ang), (float)sin(ang));
            continue;
        }
        j -= J_ROPE;
        {
            int i = j * 256 + tid;
            if (i < 4096) { const double a = PI2 * (double)i / 4096.0; wsp<float2>(p, OFF_TW)[i] = make_float2((float)cos(a), (float)sin(a)); continue; } i -= 4096;
            if (i < 8192) {
                const int T = i >> 12, a = (i >> 6) & 63, b = i & 63;
                const double th = PI2 * (double)((a * b) & 63) / 64.0;
                wsp<bf16_t>(p, OFF_T64)[i] = (bf16_t)f2bf((float)(T ? sin(th) : cos(th))); continue;
            } i -= 8192;
            if (i < 16384) {
                const int rho = i >> 7, k = i & 127;
                const int wm = rho >> 6, mi = (rho >> 4) & 3, lr = rho & 15, ri = mi >> 1, k1 = 32 * wm + 16 * (mi & 1) + lr, ab = k >> 6, s1 = k & 63;
                const double th = PI2 * (double)((k1 * s1) & 63) / 64.0;
                const double c = cos(th), s = sin(th);
                const double v = ri == 0 ? (ab == 0 ? c : -s) : (ab == 0 ? s : c);
                wsp<bf16_t>(p, OFF_M1)[i] = (bf16_t)f2bf((float)v); continue;
            } i -= 16384;
            if (i < 8192) {
                const int k2 = i >> 7, k = i & 127, s2 = k & 63;
                const double th = PI2 * (double)((k2 * s2) & 63) / 64.0;
                wsp<bf16_t>(p, OFF_M3)[i] = (bf16_t)f2bf((float)(k < 64 ? cos(th) : -sin(th))); continue;
            } i -= 8192;
            if (i < 32768) {
                const int g = i >> 12, e = (i >> 6) & 63, ch = i & 63;
                wsp<bf16_t>(p, OFF_WFT)[i] = (bf16_t)f2bf(p.w_fourier[(g * 64 + ch) * 64 + e]); continue;
            }
        }
    }
}

#define FOR_XCD_ITEMS_R(item, N) for (int _L = (int)(blockIdx.x >> 3), item; _L < (N) / 8 && ((item = (int)(blockIdx.x & 7) * ((N) / 8) + _L), true); _L += (int)(gridDim.x >> 3))
__device__ __forceinline__ void gemm_tile_256sq(const GemmTile& g, char* lds, f32x4 (&acc)[8][4]) {
    const int tid = threadIdx.x, lane = tid & 63, wid = tid >> 6, wm = wid >> 2, wn = wid & 3;
    const int lrow = lane >> 3, pc = lane & 7;
    const bf16_t* ap[4]; const bf16_t* bp[4];
#pragma unroll
    for (int i = 0; i < 4; i++) {
        const int r = (wid * 4 + i) * 8 + lrow;
        const int c = pc ^ ((r >> 1) & 7);
        const long ro = g.arow ? (long)g.arow[r] * g.lda : (long)r * g.lda;
        ap[i] = g.A + ro + c * 8;
        bp[i] = g.Bt + (long)r * g.ldb + c * 8;
    }
#pragma unroll
    for (int mi = 0; mi < 8; mi++)
#pragma unroll
        for (int ni = 0; ni < 4; ni++) acc[mi][ni] = (f32x4){0.f, 0.f, 0.f, 0.f};
    const int nk = g.K >> 6;
    auto stage = [&](int kt, char* st) {
#pragma unroll
        for (int i = 0; i < 4; i++) {
            __builtin_amdgcn_global_load_lds((const unsigned*)(ap[i] + kt * 64), (unsigned*)(st + (wid * 4 + i) * 1024), 16, 0, 0);
            __builtin_amdgcn_global_load_lds((const unsigned*)(bp[i] + kt * 64), (unsigned*)(st + 32768 + (wid * 4 + i) * 1024), 16, 0, 0);
        }
    };
    __syncthreads();
    stage(0, lds);
    asm volatile("s_waitcnt vmcnt(0)" ::: "memory");
    __syncthreads();
    for (int kt = 0; kt < nk; kt++) {
        char* cur = lds + (kt & 1) * 65536;
        if (kt + 1 < nk) stage(kt + 1, lds + ((kt + 1) & 1) * 65536);
#pragma unroll
        for (int ks = 0; ks < 2; ks++) {
            bf16x8 af[8], bfr[4];
#pragma unroll
            for (int i = 0; i < 8; i++) af[i] = *(const bf16x8*)(cur + tile_off(wm * 128 + i * 16 + (lane & 15), ks * 4 + (lane >> 4)));
#pragma unroll
            for (int i = 0; i < 4; i++) bfr[i] = *(const bf16x8*)(cur + 32768 + tile_off(wn * 64 + i * 16 + (lane & 15), ks * 4 + (lane >> 4)));
            __builtin_amdgcn_s_setprio(1);
#pragma unroll
            for (int mi = 0; mi < 8; mi++)
#pragma unroll
                for (int ni = 0; ni < 4; ni++)
                    acc[mi][ni] = __builtin_amdgcn_mfma_f32_16x16x32_bf16(bfr[ni], af[mi], acc[mi][ni], 0, 0, 0);
            __builtin_amdgcn_s_setprio(0);
        }
        asm volatile("s_waitcnt vmcnt(0)" ::: "memory");
        __syncthreads();
    }
}


__device__ __forceinline__ void gemm_tile_256x128(const GemmTile& g, char* lds, f32x4 (&acc)[4][4]) {
    const int tid = threadIdx.x, lane = tid & 63, wid = tid >> 6, wm = wid >> 1, wn = wid & 1;
    const int lrow = lane >> 3, pc = lane & 7;
    const bf16_t* ap[4]; const bf16_t* bp[2];
#pragma unroll
    for (int i = 0; i < 4; i++) {
        const int r = (wid * 4 + i) * 8 + lrow;
        const int c = pc ^ ((r >> 1) & 7);
        const long ro = g.arow ? (long)g.arow[r] * g.lda : (long)r * g.lda;
        ap[i] = g.A + ro + c * 8;
    }
#pragma unroll
    for (int i = 0; i < 2; i++) {
        const int r = (wid * 2 + i) * 8 + lrow;
        const int c = pc ^ ((r >> 1) & 7);
        bp[i] = g.Bt + (long)r * g.ldb + c * 8;
    }
#pragma unroll
    for (int mi = 0; mi < 4; mi++)
#pragma unroll
        for (int ni = 0; ni < 4; ni++) acc[mi][ni] = (f32x4){0.f, 0.f, 0.f, 0.f};
    const int nk = g.K >> 6;
    auto stage = [&](int kt, char* st) {
#pragma unroll
        for (int i = 0; i < 4; i++)
            __builtin_amdgcn_global_load_lds((const unsigned*)(ap[i] + kt * 64), (unsigned*)(st + (wid * 4 + i) * 1024), 16, 0, 0);
#pragma unroll
        for (int i = 0; i < 2; i++)
            __builtin_amdgcn_global_load_lds((const unsigned*)(bp[i] + kt * 64), (unsigned*)(st + 32768 + (wid * 2 + i) * 1024), 16, 0, 0);
    };
    __syncthreads();
    stage(0, lds);
    asm volatile("s_waitcnt vmcnt(0)" ::: "memory");
    __syncthreads();
    for (int kt = 0; kt < nk; kt++) {
        char* cur = lds + (kt & 1) * 49152;
        if (kt + 1 < nk) stage(kt + 1, lds + ((kt + 1) & 1) * 49152);
        bf16x8 af[2][4], bfr[2][4];
#pragma unroll
        for (int ks = 0; ks < 2; ks++)
#pragma unroll
            for (int i = 0; i < 4; i++) {
                af[ks][i] = *(const bf16x8*)(cur + tile_off(wm * 64 + i * 16 + (lane & 15), ks * 4 + (lane >> 4)));
                bfr[ks][i] = *(const bf16x8*)(cur + 32768 + tile_off(wn * 64 + i * 16 + (lane & 15), ks * 4 + (lane >> 4)));
            }
        __builtin_amdgcn_s_setprio(1);
#pragma unroll
        for (int ks = 0; ks < 2; ks++)
#pragma unroll
            for (int mi = 0; mi < 4; mi++)
#pragma unroll
                for (int ni = 0; ni < 4; ni++)
                    acc[mi][ni] = __builtin_amdgcn_mfma_f32_16x16x32_bf16(bfr[ks][ni], af[ks][mi], acc[mi][ni], 0, 0, 0);
        __builtin_amdgcn_s_setprio(0);
        asm volatile("s_waitcnt vmcnt(0)" ::: "memory");
        __syncthreads();
    }
}

template <class Setup, class Epi>
__device__ __forceinline__ void gemm_256x128_stream(int nitems, char* lds, Setup setup, Epi epi) {
    const int tid = threadIdx.x, lane = tid & 63, wid = tid >> 6, wm = wid >> 1, wn = wid & 1;
    const int lrow = lane >> 3, pc = lane & 7;
    const int LN = nitems / 8, LS = (int)(gridDim.x >> 3), xb = (int)(blockIdx.x & 7) * LN;
    int L = (int)(blockIdx.x >> 3);
    if (L >= LN) return;
    const bf16_t* ap[4]; const bf16_t* bp[2];
    auto setptr = [&](const GemmTile& g) {
#pragma unroll
        for (int i = 0; i < 4; i++) {
            const int r = (wid * 4 + i) * 8 + lrow;
            const int c = pc ^ ((r >> 1) & 7);
            ap[i] = g.A + (long)r * g.lda + c * 8;
        }
#pragma unroll
        for (int i = 0; i < 2; i++) {
            const int r = (wid * 2 + i) * 8 + lrow;
            const int c = pc ^ ((r >> 1) & 7);
            bp[i] = g.Bt + (long)r * g.ldb + c * 8;
        }
    };
    auto stage = [&](int kt, char* st) {
#pragma unroll
        for (int i = 0; i < 4; i++)
            __builtin_amdgcn_global_load_lds((const unsigned*)(ap[i] + kt * 64), (unsigned*)(st + (wid * 4 + i) * 1024), 16, 0, 0);
#pragma unroll
        for (int i = 0; i < 2; i++)
            __builtin_amdgcn_global_load_lds((const unsigned*)(bp[i] + kt * 64), (unsigned*)(st + 32768 + (wid * 2 + i) * 1024), 16, 0, 0);
    };
    GemmTile g; g.arow = nullptr;
    setup(xb + L, g);
    const int nk = g.K >> 6;
    setptr(g);
    __syncthreads();
    stage(0, lds);
    asm volatile("s_waitcnt vmcnt(0)" ::: "memory");
    __syncthreads();
    int q = 0;
    for (; L < LN; L += LS) {
        f32x4 acc[4][4];
#pragma unroll
        for (int mi = 0; mi < 4; mi++)
#pragma unroll
            for (int ni = 0; ni < 4; ni++) acc[mi][ni] = (f32x4){0.f, 0.f, 0.f, 0.f};
        for (int kt = 0; kt < nk; kt++, q++) {
            char* cur = lds + (q & 1) * 49152;
            char* nxt = lds + ((q + 1) & 1) * 49152;
            if (kt + 1 < nk) stage(kt + 1, nxt);
            else if (L + LS < LN) { setup(xb + L + LS, g); setptr(g); stage(0, nxt); }
            bf16x8 af[2][4], bfr[2][4];
#pragma unroll
            for (int ks = 0; ks < 2; ks++)
#pragma unroll
                for (int i = 0; i < 4; i++) {
                    af[ks][i] = *(const bf16x8*)(cur + tile_off(wm * 64 + i * 16 + (lane & 15), ks * 4 + (lane >> 4)));
                    bfr[ks][i] = *(const bf16x8*)(cur + 32768 + tile_off(wn * 64 + i * 16 + (lane & 15), ks * 4 + (lane >> 4)));
                }
            __builtin_amdgcn_s_setprio(1);
#pragma unroll
            for (int ks = 0; ks < 2; ks++)
#pragma unroll
                for (int mi = 0; mi < 4; mi++)
#pragma unroll
                    for (int ni = 0; ni < 4; ni++)
                        acc[mi][ni] = __builtin_amdgcn_mfma_f32_16x16x32_bf16(bfr[ks][ni], af[ks][mi], acc[mi][ni], 0, 0, 0);
            __builtin_amdgcn_s_setprio(0);
            asm volatile("s_waitcnt vmcnt(0)" ::: "memory");
            __syncthreads();
        }
        epi(xb + L, acc);
    }
}


__device__ __forceinline__ void phase1(const Params& p, char* lds) {
    const int tid = threadIdx.x, lane = tid & 63, wid = tid >> 6, wm = wid >> 1, wn = wid & 1, lq = lane >> 4, lr = lane & 15;
    constexpr int N_U = 64 * 2, N_M = 4 * 16;
    {
      gemm_256x128_stream(N_U, lds, [&](int item, GemmTile& g) {
            const int tm = item >> 1, tn = 8 + (item & 1);
            g.A = wsp<bf16_t>(p, OFF_XB) + (long)tm * 256 * ND; g.lda = ND;
            g.Bt = wsp<bf16_t>(p, OFF_W1T) + (long)tn * 128 * ND; g.ldb = ND; g.K = ND;
        }, [&](int item, f32x4 (&acc)[4][4]) {
            const int tm = item >> 1, tn = 8 + (item & 1);
            const float* r0 = wsp<float>(p, OFF_R0);
#pragma unroll
            for (int mi = 0; mi < 4; mi++) {
                const int row = tm * 256 + wm * 64 + mi * 16 + lr;
                const float rs = r0[row];
#pragma unroll
                for (int ni = 0; ni < 4; ni++) acc[mi][ni] *= rs;
                if (tn < 4) {
#pragma unroll
                    for (int ni = 0; ni < 4; ni++)
                        *(u32x2*)(wsp<bf16_t>(p, OFF_UF) + (long)row * 512 + tn * 128 + wn * 64 + ni * 16 + 4 * lq) = pack4bf(acc[mi][ni]);
                } else if (tn < 9) {
                    float ss = 0.f;
#pragma unroll
                    for (int ni = 0; ni < 4; ni++) { const f32x4 v = acc[mi][ni]; ss += v[0] * v[0] + v[1] * v[1] + v[2] * v[2] + v[3] * v[3]; }
                    ss += __shfl_xor(ss, 16); ss += __shfl_xor(ss, 32);
                    if (tn < 7) {
#pragma unroll
                        for (int ni = 0; ni < 4; ni++)
                            *(u32x2*)(wsp<bf16_t>(p, OFF_UQ) + (long)row * 384 + (tn - 4) * 128 + wn * 64 + ni * 16 + 4 * lq) = pack4bf(acc[mi][ni]);
                        if (lq == 0) wsp<float>(p, OFF_SSQ)[row * 6 + (tn - 4) * 2 + wn] = ss;
                    } else {
#pragma unroll
                        for (int ni = 0; ni < 4; ni++)
                            *(u32x2*)(wsp<bf16_t>(p, OFF_UKV) + (long)row * 256 + (tn - 7) * 128 + wn * 64 + ni * 16 + 4 * lq) = pack4bf(acc[mi][ni]);
                        if (lq == 0) wsp<float>(p, OFF_SSKV)[row * 4 + (tn - 7) * 2 + wn] = ss;
                    }
                } else if (wn == 0) {
                    const float2* rp = wsp<float2>(p, OFF_ROPE) + (long)row * 16 + 4 * lq;
                    f32x4 o1, o2;
#pragma unroll
                    for (int r = 0; r < 4; r++) {
                        const float2 cs = rp[r];
                        const float x1 = acc[mi][0][r], x2 = acc[mi][1][r];
                        o1[r] = x1 * cs.x - x2 * cs.y; o2[r] = x1 * cs.y + x2 * cs.x;
                    }
                    bf16_t* kr = wsp<bf16_t>(p, OFF_KR) + (long)row * 32;
                    *(u32x2*)(kr + 4 * lq) = pack4bf(o1);
                    *(u32x2*)(kr + 16 + 4 * lq) = pack4bf(o2);
                }
            }
        });
      gemm_256x128_stream(N_M, lds, [&](int it, GemmTile& g) {
            const int tm = it / 16, tn = it % 16;
            g.A = wsp<bf16_t>(p, OFF_MEMB) + (long)tm * 256 * ND; g.lda = ND;
            g.Bt = wsp<bf16_t>(p, OFF_WMKVT) + (long)tn * 128 * ND; g.ldb = ND; g.K = ND;
        }, [&](int it, f32x4 (&acc)[4][4]) {
            const int tm = it / 16, tn = it % 16;
            const float* rm = wsp<float>(p, OFF_RMEM);
#pragma unroll
            for (int mi = 0; mi < 4; mi++) {
                const int row = tm * 256 + wm * 64 + mi * 16 + lr;
                const int b = row >> 8, m = row & 255;
                const float rs = rm[row];
#pragma unroll
                for (int ni = 0; ni < 4; ni++) {
                    const f32x4 v = acc[mi][ni] * rs;
                    const int col = tn * 128 + wn * 64 + ni * 16 + 4 * lq;
                    if (col < 1024) {
                        const int h = col >> 8, d = col & 255;
                        *(u32x2*)(wsp<bf16_t>(p, OFF_KMEM) + ((long)(b * 4 + h) * 256 + m) * 256 + d) = pack4bf(v);
                    } else {
                        const int c2 = col - 1024, h = c2 >> 8, dv = c2 & 255;
                        bf16_t* vt = wsp<bf16_t>(p, OFF_VTMEM) + ((long)(b * 4 + h) * 256 + dv) * 256 + m;
#pragma unroll
                        for (int r = 0; r < 4; r++) vt[r * 256] = (bf16_t)f2bf(v[r]);
                    }
                }
            }
        });
    }
}

template <int MI>
__device__ __forceinline__ void dft_mma(const bf16_t* Ag, int arow0, const char* ximg, int ncol0, f32x4 (&acc)[MI][4]) {
    const int lane = VTID & 63, lq = lane >> 4, lr = lane & 15;
#pragma unroll
    for (int ks = 0; ks < 4; ks++) {
        bf16x8 af[MI], bfr[4];
#pragma unroll
        for (int mi = 0; mi < MI; mi++) af[mi] = *(const bf16x8*)(Ag + (long)(arow0 + mi * 16 + lr) * 128 + ks * 32 + lq * 8);
#pragma unroll
        for (int ni = 0; ni < 4; ni++) {
            const char* bp = ximg + (ks * 32 + lq * 8) * 272 + (ncol0 + ni * 16 + lr) * 2;
#pragma unroll
            for (int j = 0; j < 8; j++) bfr[ni][j] = *(const short*)(bp + j * 272);
        }
#pragma unroll
        for (int mi = 0; mi < MI; mi++)
#pragma unroll
            for (int ni = 0; ni < 4; ni++) acc[mi][ni] = __builtin_amdgcn_mfma_f32_16x16x32_bf16(bfr[ni], af[mi], acc[mi][ni], 0, 0, 0);
    }
}

__device__ __forceinline__ void f2a_item(const Params& p, int it, char* lds) {
    const int tid = VTID, lane = tid & 63, wid = tid >> 6, wm = wid >> 1, wn = wid & 1, lq = lane >> 4, lr = lane & 15;
    const int nc = it & 3, s2 = (it >> 2) & 63, b = it >> 8;
    char* uimg = lds; char* ximg = lds + 17408;
    __syncthreads();
#pragma unroll
    for (int i = 0; i < 4; i++) {
        const int ci = tid + 256 * i, row = ci >> 4, cc = ci & 15;
        *(u32x4*)(uimg + row * 272 + cc * 16) = *(const u32x4*)(wsp<bf16_t>(p, OFF_UF) + ((long)(b * NS + 64 * row + s2)) * 512 + nc * 128 + cc * 8);
    }
    __syncthreads();
    {
        const int g2 = wid >> 1, T = wid & 1;
        f32x4 a1[4][4];
#pragma unroll
        for (int mi = 0; mi < 4; mi++)
#pragma unroll
            for (int ni = 0; ni < 4; ni++) a1[mi][ni] = (f32x4){0.f, 0.f, 0.f, 0.f};
        const bf16_t* t64 = wsp<bf16_t>(p, OFF_T64) + T * 4096;
#pragma unroll
        for (int ks = 0; ks < 2; ks++) {
            bf16x8 af[4], bfr[4];
#pragma unroll
            for (int i = 0; i < 4; i++) {
                af[i] = *(const bf16x8*)(uimg + (i * 16 + lr) * 272 + (g2 * 64 + ks * 32 + lq * 8) * 2);
                bfr[i] = *(const bf16x8*)(t64 + (i * 16 + lr) * 64 + ks * 32 + lq * 8);
            }
#pragma unroll
            for (int mi = 0; mi < 4; mi++)
#pragma unroll
                for (int ni = 0; ni < 4; ni++) a1[mi][ni] = __builtin_amdgcn_mfma_f32_16x16x32_bf16(bfr[ni], af[mi], a1[mi][ni], 0, 0, 0);
        }
#pragma unroll
        for (int mi = 0; mi < 4; mi++)
#pragma unroll
            for (int ni = 0; ni < 4; ni++)
                *(u32x2*)(ximg + (T * 64 + mi * 16 + lr) * 272 + (g2 * 64 + ni * 16 + 4 * lq) * 2) = pack4bf(a1[mi][ni]);
    }
    __syncthreads();
    f32x4 acc[4][4];
#pragma unroll
    for (int mi = 0; mi < 4; mi++)
#pragma unroll
        for (int ni = 0; ni < 4; ni++) acc[mi][ni] = (f32x4){0.f, 0.f, 0.f, 0.f};
    dft_mma<4>(wsp<bf16_t>(p, OFF_M1), wm * 64, ximg, wn * 64, acc);
    const float2* tw = wsp<float2>(p, OFF_TW);
#pragma unroll
    for (int m2 = 0; m2 < 2; m2++) {
        const int k1 = 32 * wm + 16 * m2 + lr;
        float2 cs; { const float rev = (float)((s2 * k1) & 4095) * (1.0f / 4096.0f); cs.x = __builtin_amdgcn_cosf(rev); cs.y = __builtin_amdgcn_sinf(rev); (void)tw; }
        const long base = ((long)(b * 64 + k1) * 64 + s2) * 512 + nc * 128 + wn * 64 + 4 * lq;
#pragma unroll
        for (int ni = 0; ni < 4; ni++) {
            const f32x4 yr = acc[m2][ni], yi = acc[m2 + 2][ni];
            const f32x4 orr = yr * cs.x - yi * cs.y, oi = yi * cs.x + yr * cs.y;
            *(u32x2*)(wsp<bf16_t>(p, OFF_YR) + base + ni * 16) = pack4bf(orr);
            *(u32x2*)(wsp<bf16_t>(p, OFF_YI) + base + ni * 16) = pack4bf(oi);
        }
    }
}

__device__ __forceinline__ void f2b_item(const Params& p, int it, char* lds) {
    const int tid = VTID, lane = tid & 63, wid = tid >> 6, wm = wid >> 1, wn = wid & 1, lq = lane >> 4, lr = lane & 15;
    const int nc = it & 3, k1 = (it >> 2) & 63, b = it >> 8;
    char* ximg = lds; char* zimg = lds + 34816;
    __syncthreads();
#pragma unroll
    for (int i = 0; i < 8; i++) {
        const int ci = tid + 256 * i, row = ci >> 4, cc = ci & 15;
        const bf16_t* src = (row < 64 ? wsp<bf16_t>(p, OFF_YR) : wsp<bf16_t>(p, OFF_YI)) + ((long)(b * 64 + k1) * 64 + (row & 63)) * 512 + nc * 128 + cc * 8;
        *(u32x4*)(ximg + row * 272 + cc * 16) = *(const u32x4*)src;
    }
    __syncthreads();
    f32x4 acc[2][4];
#pragma unroll
    for (int mi = 0; mi < 2; mi++)
#pragma unroll
        for (int ni = 0; ni < 4; ni++) acc[mi][ni] = (f32x4){0.f, 0.f, 0.f, 0.f};
    dft_mma<2>(wsp<bf16_t>(p, OFF_M3), wm * 32, ximg, wn * 64, acc);
#pragma unroll
    for (int mi = 0; mi < 2; mi++)
#pragma unroll
        for (int ni = 0; ni < 4; ni++)
            *(u32x2*)(zimg + (wm * 32 + mi * 16 + lr) * 272 + (wn * 64 + ni * 16 + 4 * lq) * 2) = pack4bf(acc[mi][ni] * (1.0f / 512.0f));
    __syncthreads();
    f32x4 a3[2][4];
#pragma unroll
    for (int mi = 0; mi < 2; mi++)
#pragma unroll
        for (int ni = 0; ni < 4; ni++) a3[mi][ni] = (f32x4){0.f, 0.f, 0.f, 0.f};
    const bf16_t* wft = wsp<bf16_t>(p, OFF_WFT) + (long)(nc * 2 + wn) * 4096;
#pragma unroll
    for (int ks = 0; ks < 2; ks++) {
        bf16x8 af[2], bfr[4];
#pragma unroll
        for (int i = 0; i < 2; i++) af[i] = *(const bf16x8*)(zimg + (wm * 32 + i * 16 + lr) * 272 + (wn * 64 + ks * 32 + lq * 8) * 2);
#pragma unroll
        for (int i = 0; i < 4; i++) bfr[i] = *(const bf16x8*)(wft + (i * 16 + lr) * 64 + ks * 32 + lq * 8);
#pragma unroll
        for (int mi = 0; mi < 2; mi++)
#pragma unroll
            for (int ni = 0; ni < 4; ni++) a3[mi][ni] = __builtin_amdgcn_mfma_f32_16x16x32_bf16(bfr[ni], af[mi], a3[mi][ni], 0, 0, 0);
    }
#pragma unroll
    for (int mi = 0; mi < 2; mi++) {
        const int k2 = wm * 32 + mi * 16 + lr;
        bf16_t* dst = wsp<bf16_t>(p, OFF_ZA) + ((long)(b * NS + k1 + 64 * k2)) * 1024 + nc * 128 + wn * 64 + 4 * lq;
#pragma unroll
        for (int ni = 0; ni < 4; ni++) *(u32x2*)(dst + ni * 16) = pack4bf(a3[mi][ni]);
    }
}

__device__ __forceinline__ void phase2(const Params& p, char* lds) {
    const int tid = threadIdx.x, lane = tid & 63, wid = tid >> 6, wm = wid >> 1, wn = wid & 1, lq = lane >> 4, lr = lane & 15;
    constexpr int N_Q = 64 * 6, N_KV = 64 * 8;
    {
      gemm_256x128_stream(N_Q, lds, [&](int item, GemmTile& g) {
            const int tm = item / 6, tn = item % 6;
            g.A = wsp<bf16_t>(p, OFF_UQ) + (long)tm * 256 * 384; g.lda = 384;
            g.Bt = wsp<bf16_t>(p, OFF_WQT) + (long)tn * 128 * 384; g.ldb = 384; g.K = 384;
        }, [&](int item, f32x4 (&acc)[4][4]) {
            const int tm = item / 6, tn = item % 6;
            const float qmul = 0.10206207261596575f * 1.4426950408889634f;
#pragma unroll
            for (int mi = 0; mi < 4; mi++) {
                const int row = tm * 256 + wm * 64 + mi * 16 + lr;
                const int b = row >> 12, s = row & 4095;
                const float* sq = wsp<float>(p, OFF_SSQ) + (long)row * 6;
                const float ss = sq[0] + sq[1] + sq[2] + sq[3] + sq[4] + sq[5];
                const float rs = rsqrtf(ss * (1.f / 384.f) + 1e-6f) * qmul;
                const int cb0 = tn * 128 + wn * 64;
#pragma unroll
                for (int ni = 0; ni < 4; ni++) {
                    const int cb = cb0 + ni * 16, hd = cb / 96, hob = cb % 96;
                    bf16_t* qd = wsp<bf16_t>(p, OFF_Q) + ((long)(b * 8 + hd) * NS + s) * 96;
                    if (hob < 64) {
                        *(u32x2*)(qd + hob + 4 * lq) = pack4bf(acc[mi][ni] * rs);
                    } else if (hob == 64) {
                        if (ni < 3) {
                            const float2* rp = wsp<float2>(p, OFF_ROPE) + (long)row * 16 + 4 * lq;
                            f32x4 o1, o2;
#pragma unroll
                            for (int r = 0; r < 4; r++) {
                                const float2 cs = rp[r];
                                const float x1 = acc[mi][ni][r] * rs, x2 = acc[mi][ni < 3 ? ni + 1 : 3][r] * rs;
                                o1[r] = x1 * cs.x - x2 * cs.y; o2[r] = x1 * cs.y + x2 * cs.x;
                            }
                            *(u32x2*)(qd + 64 + 4 * lq) = pack4bf(o1);
                            *(u32x2*)(qd + 80 + 4 * lq) = pack4bf(o2);
                        }
                    }
                }
            }
        });
      gemm_256x128_stream(N_KV, lds, [&](int it, GemmTile& g) {
            const int tm = it >> 3, hd = it & 7;
            g.A = wsp<bf16_t>(p, OFF_UKV) + (long)tm * 256 * 256; g.lda = 256;
            g.Bt = wsp<bf16_t>(p, OFF_WKVT) + (long)hd * 128 * 256; g.ldb = 256; g.K = 256;
        }, [&](int it, f32x4 (&acc)[4][4]) {
            const int tm = it >> 3, hd = it & 7;
#pragma unroll
            for (int mi = 0; mi < 4; mi++) {
                const int row = tm * 256 + wm * 64 + mi * 16 + lr;
                const int b = row >> 12, s = row & 4095;
                const float* sq = wsp<float>(p, OFF_SSKV) + (long)row * 4;
                const float rs = rsqrtf((sq[0] + sq[1] + sq[2] + sq[3]) * (1.f / 256.f) + 1e-6f);
                if (wn == 0) {
                    bf16_t* kd = wsp<bf16_t>(p, OFF_K) + ((long)(b * 8 + hd) * NS + s) * 96;
#pragma unroll
                    for (int ni = 0; ni < 4; ni++) *(u32x2*)(kd + ni * 16 + 4 * lq) = pack4bf(acc[mi][ni] * rs);
                } else {
#pragma unroll
                    for (int ni = 0; ni < 4; ni++) {
                        bf16_t* vd = wsp<bf16_t>(p, OFF_VT) + ((long)(b * 8 + hd) * 64 + ni * 16 + 4 * lq) * NS + s;
#pragma unroll
                        for (int r = 0; r < 4; r++) vd[(long)r * NS] = (bf16_t)f2bf(acc[mi][ni][r] * rs);
                    }
                }
            }
#pragma unroll
            for (int i = 0; i < 2; i++) {
                const int ci = tid + 512 * i, r = ci >> 2, cc = ci & 3;
                const int row = tm * 256 + r, b = row >> 12, s = row & 4095;
                *(u32x4*)(wsp<bf16_t>(p, OFF_K) + ((long)(b * 8 + hd) * NS + s) * 96 + 64 + cc * 8) = *(const u32x4*)(wsp<bf16_t>(p, OFF_KR) + (long)row * 32 + cc * 8);
            }
        });
    }
}


__device__ __forceinline__ void phase2_f2a(const Params& p, char* lds) {
    FOR_XCD_ITEMS(it, 1024) { f2a_item(p, it, lds); }
}

__device__ __forceinline__ void expert_tr_job(const Params& p, int j, char* lds) {
    const int which = j >> 11, r = j & 2047, e = r >> 7, t = r & 127;
    const int k0 = (t >> 3) * 64, n0 = (t & 7) * 128;
    if (which == 0) tr_tile(p.w_exp_gate + (long)e * 1048576, 1024, k0, n0, 1024, p.g_ffn, wsp<bf16_t>(p, OFF_WGUT) + (long)e * 2048 * 1024, 1024, 1, lds);
    else if (which == 1) tr_tile(p.w_exp_up + (long)e * 1048576, 1024, k0, n0, 1024, p.g_ffn, wsp<bf16_t>(p, OFF_WGUT) + (long)e * 2048 * 1024, 1024, 2, lds);
    else tr_tile(p.w_exp_down + (long)e * 1048576, 1024, k0, n0, 1024, nullptr, wsp<bf16_t>(p, OFF_WDT) + (long)e * 1048576, 1024, 0, lds);
}

__device__ __forceinline__ void phase3_tr(const Params& p, char* lds) {
    float (*t)[132] = (float (*)[132])lds;
    const int tid = VTID, c4 = tid & 31, r0 = tid >> 5;
    f32x4 v[8]; float gv[8];
    auto issue = [&](int j) {
        const int which = j >> 11, r = j & 2047, e = r >> 7, tt = r & 127;
        const int k0 = (tt >> 3) * 64, n0 = (tt & 7) * 128;
        const float* W = (which == 0 ? p.w_exp_gate : which == 1 ? p.w_exp_up : p.w_exp_down) + (long)e * 1048576;
#pragma unroll
        for (int i = 0; i < 8; i++) {
            const int kk = r0 + 8 * i;
            v[i] = *(const f32x4*)(W + (long)(k0 + kk) * 1024 + n0 + c4 * 4);
            gv[i] = which < 2 ? p.g_ffn[k0 + kk] : 1.f;
        }
    };
    int j = VBLK;
    if (j < 6144) issue(j);
    while (j < 6144) {
        const int which = j >> 11, r = j & 2047, e = r >> 7, tt = r & 127;
        const int k0 = (tt >> 3) * 64, n0 = (tt & 7) * 128;
        __syncthreads();
#pragma unroll
        for (int i = 0; i < 8; i++) *(f32x4*)(&t[r0 + 8 * i][c4 * 4]) = v[i] * gv[i];
        __syncthreads();
        const int jn = j + VGRID;
        if (jn < 6144) issue(jn);
        bf16_t* Wt = which < 2 ? wsp<bf16_t>(p, OFF_WGUT) + (long)e * 2048 * 1024 : wsp<bf16_t>(p, OFF_WDT) + (long)e * 1048576;
#pragma unroll
        for (int i = 0; i < 4; i++) {
            const int ci = tid + 256 * i, nn = ci >> 3, kc = ci & 7;
            const int n = n0 + nn;
            int row = n;
            if (which < 2) row = (n >> 5) * 64 + ((n >> 4) & 1) * 32 + which * 16 + (n & 15);
            u32x4 w;
            w.x = pack2bf(t[kc * 8 + 0][nn], t[kc * 8 + 1][nn]);
            w.y = pack2bf(t[kc * 8 + 2][nn], t[kc * 8 + 3][nn]);
            w.z = pack2bf(t[kc * 8 + 4][nn], t[kc * 8 + 5][nn]);
            w.w = pack2bf(t[kc * 8 + 6][nn], t[kc * 8 + 7][nn]);
            *(u32x4*)(Wt + (long)row * 1024 + k0 + kc * 8) = w;
        }
        j = jn;
    }
}
__device__ __forceinline__ void phase3_f2b(const Params& p, char* lds) {
    FOR_XCD_ITEMS(it, 1024) { f2b_item(p, it, lds); }
}

__device__ __forceinline__ void phase_resid(const Params& p, char* lds, size_t offA, size_t offW, const float* residf, const bf16_t* residb, size_t offXb, size_t offSS) {
    const int tid = VTID, lane = tid & 63, wid = tid >> 6, wm = wid >> 1, wn = wid & 1, lq = lane >> 4, lr = lane & 15;
    FOR_XCD_ITEMS(item, 128 * 8) {
        const int tm = item >> 3, tn = item & 7;
        f32x4 acc[4][4];
        GemmTile g; g.A = wsp<bf16_t>(p, offA) + (long)tm * 128 * ND; g.lda = ND; g.arow = nullptr;
        g.Bt = wsp<bf16_t>(p, offW) + (long)tn * 128 * ND; g.ldb = ND; g.K = ND;
        gemm_tile_128(g, lds, acc);
#pragma unroll
        for (int mi = 0; mi < 4; mi++) {
            const int row = tm * 128 + wm * 64 + mi * 16 + lr;
            float ss = 0.f;
#pragma unroll
            for (int ni = 0; ni < 4; ni++) {
                const long o = (long)row * ND + tn * 128 + wn * 64 + ni * 16 + 4 * lq;
                f32x4 rv;
                if (residf) rv = *(const f32x4*)(residf + o);
                else { const u32x2 w = *(const u32x2*)(residb + o); rv = (f32x4){__uint_as_float(w.x << 16), __uint_as_float(w.x & 0xFFFF0000u), __uint_as_float(w.y << 16), __uint_as_float(w.y & 0xFFFF0000u)}; }
                const f32x4 v = rv + acc[mi][ni];
                *(u32x2*)(wsp<bf16_t>(p, offXb) + o) = pack4bf(v);
                ss += v[0] * v[0] + v[1] * v[1] + v[2] * v[2] + v[3] * v[3];
            }
            ss += __shfl_xor(ss, 16); ss += __shfl_xor(ss, 32);
            if (lq == 0) wsp<float>(p, offSS)[row * 16 + tn * 2 + wn] = ss;
        }
    }
}
__device__ __forceinline__ float row_rs16(const float* ss) {
    const f32x4 a = *(const f32x4*)ss, b = *(const f32x4*)(ss + 4), c = *(const f32x4*)(ss + 8), d = *(const f32x4*)(ss + 12);
    const f32x4 t = (a + b) + (c + d);
    return rsqrtf(((t[0] + t[1]) + (t[2] + t[3])) * (1.f / 1024.f) + 1e-6f);
}

__device__ __forceinline__ void phase5a(const Params& p, char* lds) {
    const int tid = VTID, lane = tid & 63, wid = tid >> 6, wm = wid >> 1, wn = wid & 1, lq = lane >> 4, lr = lane & 15;
    FOR_XCD_ITEMS(item, 128 * 8) {
        const int tm = item >> 3, tn = item & 7;
        f32x4 acc[4][4];
        GemmTile g; g.A = wsp<bf16_t>(p, OFF_X1B) + (long)tm * 128 * ND; g.lda = ND; g.arow = nullptr;
        g.Bt = wsp<bf16_t>(p, OFF_WMQT) + (long)tn * 128 * ND; g.ldb = ND; g.K = ND;
        gemm_tile_128(g, lds, acc);
        const int h = tn >> 1;
#pragma unroll
        for (int mi = 0; mi < 4; mi++) {
            const int row = tm * 128 + wm * 64 + mi * 16 + lr, b = row >> 12, s = row & 4095;
            const float rs = row_rs16(wsp<float>(p, OFF_SS1) + (long)row * 16) * (0.0625f * 1.4426950408889634f);
            bf16_t* qd = wsp<bf16_t>(p, OFF_QM) + ((long)(b * 4 + h) * NS + s) * 256 + (tn & 1) * 128 + wn * 64 + 4 * lq;
#pragma unroll
            for (int ni = 0; ni < 4; ni++) *(u32x2*)(qd + ni * 16) = pack4bf(acc[mi][ni] * rs);
        }
    }
}
__device__ __forceinline__ void phase5b(const Params& p, char* lds) {
    FOR_XCD_ITEMS(item, NB * 4 * 32 * 2) {
        const int dvh = item & 1, qt = (item >> 1) & 31, h = (item >> 6) & 3, b = item >> 8;
        const bf16_t* Qp = wsp<bf16_t>(p, OFF_QM) + ((long)(b * 4 + h) * NS + qt * 128) * 256;
        const bf16_t* Kp = wsp<bf16_t>(p, OFF_KMEM) + ((long)(b * 4 + h) * 256) * 256;
        const bf16_t* Vtp = wsp<bf16_t>(p, OFF_VTMEM) + ((long)(b * 4 + h) * 256 + dvh * 128) * 256;
        bf16_t* Op = wsp<bf16_t>(p, OFF_OM) + ((long)b * NS + qt * 128) * 1024 + h * 256 + dvh * 128;
        attn_block<256, 128, 32, 256>(Qp, Kp, Vtp, 256L, 256, lds, [&](int q, int dv, f32x4 v) { *(u32x2*)(Op + (long)q * 1024 + dv) = pack4bf(v); });
    }
}

__device__ __forceinline__ void phase7(const Params& p, char* lds) {
    const int tid = threadIdx.x, lane = tid & 63, wid = tid >> 6, lq = lane >> 4, lr = lane & 15;
    __syncthreads();
    {
        f32x4 w0[4], w1[4];
#pragma unroll
        for (int it = 0; it < 4; it++) {
            const int u = tid + 512 * it, kp = u >> 2, eq = u & 3;
            w0[it] = *(const f32x4*)(p.w_router + (size_t)(2 * kp) * 16 + eq * 4);
            w1[it] = *(const f32x4*)(p.w_router + (size_t)(2 * kp + 1) * 16 + eq * 4);
        }
#pragma unroll
        for (int it = 0; it < 4; it++) {
            const int u = tid + 512 * it, kp = u >> 2, eq = u & 3, k = 2 * kp;
            const float g0 = p.g_ffn[k], g1 = p.g_ffn[k + 1];
#pragma unroll
            for (int j = 0; j < 4; j++) {
                const int e = eq * 4 + j;
                const float a0 = w0[it][j] * g0, a1 = w1[it][j] * g1;
                const unsigned h0 = f2bf(a0), h1 = f2bf(a1);
                const float r0 = a0 - __uint_as_float(h0 << 16), r1 = a1 - __uint_as_float(h1 << 16);
                const unsigned l0 = f2bf(r0), l1 = f2bf(r1);
                const int off = e * 2048 + ((((k >> 3) ^ e) & 127) << 4) + (k & 7) * 2;
                *(unsigned*)(lds + off) = h0 | (h1 << 16);
                *(unsigned*)(lds + 32768 + off) = l0 | (l1 << 16);
            }
        }
    }
    __syncthreads();
    for (int g = wid * (int)gridDim.x + (int)blockIdx.x; g < NT / 16; g += 8 * (int)gridDim.x) {
        const int t0 = g * 16;
        const bf16_t* xr = wsp<bf16_t>(p, OFF_X2B) + (long)(t0 + lr) * ND + lq * 8;
        bf16x8 xa[32];
#pragma unroll
        for (int ks = 0; ks < 32; ks++) xa[ks] = *(const bf16x8*)(xr + ks * 32);
        const float rsv = row_rs16(wsp<float>(p, OFF_SS2) + (long)(t0 + lr) * 16);
        if (lane < 16) wsp<float>(p, OFF_RS2)[t0 + lane] = rsv;
        f32x4 acc = (f32x4){0.f, 0.f, 0.f, 0.f};
#pragma unroll
        for (int ks = 0; ks < 32; ks++) {
            const int off = lr * 2048 + ((((ks * 4 + lq) ^ lr) & 127) << 4);
            const bf16x8 bh = *(const bf16x8*)(lds + off), bl = *(const bf16x8*)(lds + 32768 + off);
            acc = __builtin_amdgcn_mfma_f32_16x16x32_bf16(xa[ks], bh, acc, 0, 0, 0);
            acc = __builtin_amdgcn_mfma_f32_16x16x32_bf16(xa[ks], bl, acc, 0, 0, 0);
            if ((ks & 3) == 3) asm volatile("" ::: "memory");
        }
        f32x4 af4;
#pragma unroll
        for (int r = 0; r < 4; r++) {
            const float lg = acc[r] * __shfl(rsv, lq * 4 + r);
            float mx = lg;
#pragma unroll
            for (int o = 1; o < 16; o <<= 1) mx = fmaxf(mx, __shfl_xor(mx, o));
            const float ex = expf(lg - mx);
            float sm = ex;
#pragma unroll
            for (int o = 1; o < 16; o <<= 1) sm += __shfl_xor(sm, o);
            af4[r] = ex / sm;
        }
        {
            const int tk = t0 + lq * 4, bb = tk >> 12, ss = tk & 4095;
            *(f32x4*)(wsp<float>(p, OFF_AFF) + ((long)(bb * NE + lr) * NS + ss)) = af4;
        }
    }
}

__device__ __forceinline__ int block_sum_i(int v, int* red) {
    const int lane = VTID & 63, wid = VTID >> 6;
#pragma unroll
    for (int o = 32; o > 0; o >>= 1) v += __shfl_xor(v, o);
    __syncthreads();
    if (lane == 0) red[wid] = v;
    __syncthreads();
    return red[0] + red[1] + red[2] + red[3];
}
__device__ __forceinline__ int block_excl_scan_i(int v, int* red, int& total) {
    const int lane = VTID & 63, wid = VTID >> 6;
    int inc = v;
#pragma unroll
    for (int o = 1; o < 64; o <<= 1) { const int t = __shfl_up(inc, o); if (lane >= o) inc += t; }
    __syncthreads();
    if (lane == 63) red[wid] = inc;
    __syncthreads();
    int base = 0;
#pragma unroll
    for (int w = 0; w < 4; w++) if (w < wid) base += red[w];
    total = red[0] + red[1] + red[2] + red[3];
    return base + inc - v;
}
__device__ __forceinline__ void phase8(const Params& p, char* lds) {
    int* red = (int*)lds;
    const int tid = threadIdx.x, lane = tid & 63, wid = tid >> 6;
    for (int item = blockIdx.x; item < NB * NE; item += gridDim.x) {
        const int e = item & 15, b = item >> 4;
        const unsigned* aff = (const unsigned*)(wsp<float>(p, OFF_AFF) + (long)(b * NE + e) * NS) + tid * 8;
        unsigned v[8];
        { const u32x4 v0 = *(const u32x4*)aff, v1 = *(const u32x4*)(aff + 4);
          v[0] = v0.x; v[1] = v0.y; v[2] = v0.z; v[3] = v0.w; v[4] = v1.x; v[5] = v1.y; v[6] = v1.z; v[7] = v1.w; }
        const float* rs2p = wsp<float>(p, OFF_RS2) + (long)b * NS + tid * 8;
        const f32x4 rsa = *(const f32x4*)rs2p, rsb = *(const f32x4*)(rs2p + 4);
        __syncthreads();
        unsigned T = 0;
        for (int bit = 30; bit >= 0; bit--) {
            const unsigned cand = T | (1u << bit);
            int c = 0;
#pragma unroll
            for (int i = 0; i < 8; i++) c += __popcll(__ballot(v[i] >= cand));
            int* rb = red + (bit & 1) * 8;
            if (lane == 0) rb[wid] = c;
            __syncthreads();
            const i32x4 s0 = *(const i32x4*)rb, s1 = *(const i32x4*)(rb + 4);
            const int tot = (s0.x + s0.y) + (s0.z + s0.w) + (s1.x + s1.y) + (s1.z + s1.w);
            if (tot >= CAP) T = cand;
        }
        int cg = 0, ce = 0;
#pragma unroll
        for (int i = 0; i < 8; i++) { cg += (v[i] > T) ? 1 : 0; ce += (v[i] == T) ? 1 : 0; }
        const int pv = cg | (ce << 16);
        int inc = pv;
#pragma unroll
        for (int o = 1; o < 64; o <<= 1) { const int t = __shfl_up(inc, o); if (lane >= o) inc += t; }
        if (lane == 63) red[16 + wid] = inc;
        __syncthreads();
        int base = 0, tot = 0;
#pragma unroll
        for (int w = 0; w < 8; w++) { const int x = red[16 + w]; if (w < wid) base += x; tot += x; }
        const int pk = base + inc - pv;
        const int need = CAP - (tot & 0xFFFF);
        const int pg = pk & 0xFFFF;
        int eqs = pk >> 16;
        int slot = pg + (eqs < need ? eqs : need);
        int* slots = wsp<int>(p, OFF_SLOTS) + (long)(b * NE + e) * NS + tid * 8;
        int* idx = wsp<int>(p, OFF_IDX) + (long)(b * NE + e) * CAP;
        float* gate = wsp<float>(p, OFF_GATE) + (long)(b * NE + e) * CAP;
        float* rss = wsp<float>(p, OFF_RSS) + (long)(b * NE + e) * CAP;
        int so[8];
#pragma unroll
        for (int i = 0; i < 8; i++) {
            const int t = tid * 8 + i;
            bool sel = v[i] > T;
            if (v[i] == T) { sel = eqs < need; eqs++; }
            so[i] = -1;
            if (sel) { so[i] = slot; idx[slot] = b * NS + t; gate[slot] = __uint_as_float(v[i]); rss[slot] = i < 4 ? rsa[i & 3] : rsb[i & 3]; slot++; }
        }
        *(i32x4*)slots = (i32x4){so[0], so[1], so[2], so[3]};
        *(i32x4*)(slots + 4) = (i32x4){so[4], so[5], so[6], so[7]};
    }
}

__device__ __forceinline__ void phase9(const Params& p, char* lds) {
    const int tid = VTID, lane = tid & 63, wid = tid >> 6, wm = wid >> 1, wn = wid & 1, lq = lane >> 4, lr = lane & 15;
    FOR_XCD_ITEMS(item, NE * 16 * NB * 4) {
        const int rt = item & 3, b = (item >> 2) & 3, ct = (item >> 4) & 15, e = item >> 8;
        const int* arow = wsp<int>(p, OFF_IDX) + (long)(b * NE + e) * CAP + rt * 128;
        f32x4 acc[4][4];
        GemmTile g; g.A = wsp<bf16_t>(p, OFF_X2B); g.lda = ND; g.arow = arow;
        g.Bt = wsp<bf16_t>(p, OFF_WGUT) + ((long)e * 2048 + ct * 128) * ND; g.ldb = ND; g.K = ND;
        gemm_tile_128(g, lds, acc);
#pragma unroll
        for (int mi = 0; mi < 4; mi++) {
            const int r = wm * 64 + mi * 16 + lr;
            const int tok = arow[r];
            const float rs = row_rs16(wsp<float>(p, OFF_SS2) + (long)tok * 16);
            bf16_t* ad = wsp<bf16_t>(p, OFF_ACT) + ((long)(e * NB + b) * CAP + rt * 128 + r) * ND + ct * 64 + wn * 32 + 4 * lq;
#pragma unroll
            for (int pp = 0; pp < 2; pp++) {
                f32x4 o;
#pragma unroll
                for (int q = 0; q < 4; q++) {
                    const float ga = acc[mi][2 * pp][q] * rs, up = acc[mi][2 * pp + 1][q] * rs;
                    o[q] = ga / (1.f + __expf(-ga)) * up;
                }
                *(u32x2*)(ad + pp * 16) = pack4bf(o);
            }
        }
    }
}
__device__ __forceinline__ void phase10(const Params& p, char* lds) {
    const int tid = VTID, lane = tid & 63, wid = tid >> 6, wm = wid >> 1, wn = wid & 1, lq = lane >> 4, lr = lane & 15;
    FOR_XCD_ITEMS(item, NE * 8 * NB * 4) {
        const int rt = item & 3, b = (item >> 2) & 3, ct = (item >> 4) & 7, e = item >> 7;
        const long row0 = (long)(e * NB + b) * CAP + rt * 128;
        f32x4 acc[4][4];
        GemmTile g; g.A = wsp<bf16_t>(p, OFF_ACT) + row0 * ND; g.lda = ND; g.arow = nullptr;
        g.Bt = wsp<bf16_t>(p, OFF_WDT) + ((long)e * 1024 + ct * 128) * ND; g.ldb = ND; g.K = ND;
        gemm_tile_128(g, lds, acc);
        const float* gate = wsp<float>(p, OFF_GATE) + (long)(b * NE + e) * CAP + rt * 128;
#pragma unroll
        for (int mi = 0; mi < 4; mi++) {
            const int r = wm * 64 + mi * 16 + lr;
            const float gv = gate[r];
            bf16_t* yd = wsp<bf16_t>(p, OFF_Y) + (row0 + r) * ND + ct * 128 + wn * 64 + 4 * lq;
#pragma unroll
            for (int ni = 0; ni < 4; ni++) *(u32x2*)(yd + ni * 16) = pack4bf(acc[mi][ni] * gv);
        }
    }
}

__device__ __forceinline__ void phase11(const Params& p, char* lds) {
    const int tid = VTID, lane = tid & 63, wid = tid >> 6;
    const int* slots = wsp<int>(p, OFF_SLOTS);
    auto slot_of = [&](int tok) { const int b = tok >> 12, t = tok & 4095; return slots[(long)(b * NE + (lane & 15)) * NS + t]; };
    int tok = VBLK * 4 + wid;
    int sl_next = tok < NT ? slot_of(tok) : -1;
    u32x2 xn[4];
#pragma unroll
    for (int i = 0; i < 4; i++) xn[i] = *(const u32x2*)(wsp<bf16_t>(p, OFF_X2B) + (long)(tok < NT ? tok : 0) * ND + i * 256 + lane * 4);
    for (; tok < NT; tok += VGRID * 4) {
        const int b = tok >> 12;
        float* xr = p.out + (long)tok * ND;
        const int slv = sl_next;
        f32x4 v[4];
#pragma unroll
        for (int i = 0; i < 4; i++)
            v[i] = (f32x4){__uint_as_float(xn[i].x << 16), __uint_as_float(xn[i].x & 0xFFFF0000u), __uint_as_float(xn[i].y << 16), __uint_as_float(xn[i].y & 0xFFFF0000u)};
        {
            const int tn = tok + VGRID * 4;
            sl_next = tn < NT ? slot_of(tn) : -1;
#pragma unroll
            for (int i = 0; i < 4; i++) xn[i] = *(const u32x2*)(wsp<bf16_t>(p, OFF_X2B) + (long)(tn < NT ? tn : tok) * ND + i * 256 + lane * 4);
        }
        unsigned long long sel = __ballot(slv >= 0) & 0xFFFFull;
        while (sel) {
            const int e = __builtin_ctzll(sel); sel &= sel - 1;
            const int sl = __builtin_amdgcn_readlane(slv, e);
            const bf16_t* yr = wsp<bf16_t>(p, OFF_Y) + ((long)(e * NB + b) * CAP + sl) * ND;
#pragma unroll
            for (int i = 0; i < 4; i++) {
                const u32x2 w = *(const u32x2*)(yr + i * 256 + lane * 4);
                v[i][0] += __uint_as_float(w.x << 16); v[i][1] += __uint_as_float(w.x & 0xFFFF0000u);
                v[i][2] += __uint_as_float(w.y << 16); v[i][3] += __uint_as_float(w.y & 0xFFFF0000u);
            }
        }
        float ss = 0.f;
#pragma unroll
        for (int i = 0; i < 4; i++) ss += v[i][0] * v[i][0] + v[i][1] * v[i][1] + v[i][2] * v[i][2] + v[i][3] * v[i][3];
        ss = wave_sum(ss);
        const float rs = rsqrtf(ss * (1.f / ND) + 1e-6f);
#pragma unroll
        for (int i = 0; i < 4; i++) {
            const f32x4 gf = *(const f32x4*)(p.g_final + i * 256 + lane * 4);
            *(f32x4*)(xr + i * 256 + lane * 4) = v[i] * rs * gf;
        }
    }
}


__device__ __forceinline__ void phase_resid8(const Params& p, char* lds, size_t offA, size_t offW, const float* residf, const bf16_t* residb, size_t offXb, size_t offSS) {
    const int tid = threadIdx.x, lane = tid & 63, wid = tid >> 6, wm = wid >> 2, wn = wid & 3, lq = lane >> 4, lr = lane & 15;
    FOR_XCD_ITEMS_R(item, 64 * 4) {
        const int tm = item >> 2, tn = item & 3;
        f32x4 acc[8][4];
        GemmTile g; g.A = wsp<bf16_t>(p, offA) + (long)tm * 256 * ND; g.lda = ND; g.arow = nullptr;
        g.Bt = wsp<bf16_t>(p, offW) + (long)tn * 256 * ND; g.ldb = ND; g.K = ND;
        gemm_tile_256sq(g, lds, acc);
#pragma unroll
        for (int mi = 0; mi < 8; mi++) {
            const int row = tm * 256 + wm * 128 + mi * 16 + lr;
            float ss = 0.f;
#pragma unroll
            for (int ni = 0; ni < 4; ni++) {
                const long o = (long)row * ND + tn * 256 + wn * 64 + ni * 16 + 4 * lq;
                f32x4 rv;
                if (residf) rv = *(const f32x4*)(residf + o);
                else { const u32x2 w = *(const u32x2*)(residb + o); rv = (f32x4){__uint_as_float(w.x << 16), __uint_as_float(w.x & 0xFFFF0000u), __uint_as_float(w.y << 16), __uint_as_float(w.y & 0xFFFF0000u)}; }
                const f32x4 v = rv + acc[mi][ni];
                *(u32x2*)(wsp<bf16_t>(p, offXb) + o) = pack4bf(v);
                ss += v[0] * v[0] + v[1] * v[1] + v[2] * v[2] + v[3] * v[3];
            }
            ss += __shfl_xor(ss, 16); ss += __shfl_xor(ss, 32);
            if (lq == 0) wsp<float>(p, offSS)[row * 16 + tn * 4 + wn] = ss;
        }
    }
}
__device__ __forceinline__ void phase5a8(const Params& p, char* lds) {
    const int tid = threadIdx.x, lane = tid & 63, wid = tid >> 6, wm = wid >> 2, wn = wid & 3, lq = lane >> 4, lr = lane & 15;
    FOR_XCD_ITEMS_R(item, 64 * 4) {
        const int tm = item >> 2, tn = item & 3;
        f32x4 acc[8][4];
        GemmTile g; g.A = wsp<bf16_t>(p, OFF_X1B) + (long)tm * 256 * ND; g.lda = ND; g.arow = nullptr;
        g.Bt = wsp<bf16_t>(p, OFF_WMQT) + (long)tn * 256 * ND; g.ldb = ND; g.K = ND;
        gemm_tile_256sq(g, lds, acc);
#pragma unroll
        for (int mi = 0; mi < 8; mi++) {
            const int row = tm * 256 + wm * 128 + mi * 16 + lr, b = row >> 12, s = row & 4095;
            const float rs = row_rs16(wsp<float>(p, OFF_SS1) + (long)row * 16) * (0.0625f * 1.4426950408889634f);
            bf16_t* qd = wsp<bf16_t>(p, OFF_QM) + ((long)(b * 4 + tn) * NS + s) * 256 + wn * 64 + 4 * lq;
#pragma unroll
            for (int ni = 0; ni < 4; ni++) *(u32x2*)(qd + ni * 16) = pack4bf(acc[mi][ni] * rs);
        }
    }
}


template <class Epi>
__device__ __forceinline__ void gemm_256sq_multi(const bf16_t* A, int lda, const int* arow, const bf16_t* Bt, int ldb, long bstep,
                                                 int K, int ntile, char* lds, Epi epi) {
    const int tid = threadIdx.x, lane = tid & 63, wid = tid >> 6, wm = wid >> 2, wn = wid & 3;
    const int lrow = lane >> 3, pc = lane & 7;
    const char* Ab = (const char*)A; const char* Bb = (const char*)Bt;
    unsigned ao[4], bo[4];
#pragma unroll
    for (int i = 0; i < 4; i++) {
        const int r = (wid * 4 + i) * 8 + lrow;
        const int c = pc ^ ((r >> 1) & 7);
        ao[i] = (unsigned)((arow ? arow[r] : r) * lda + c * 8) * 2u;
        bo[i] = (unsigned)(r * ldb + c * 8) * 2u;
    }
    const int nk = K >> 6;
    auto stage = [&](int kt, long boff, char* st) {
        const char* a0 = Ab + kt * 128;
        const char* b0 = Bb + boff * 2 + kt * 128;
#pragma unroll
        for (int i = 0; i < 4; i++) {
            __builtin_amdgcn_global_load_lds((const unsigned*)(a0 + ao[i]), (unsigned*)(st + (wid * 4 + i) * 1024), 16, 0, 0);
            __builtin_amdgcn_global_load_lds((const unsigned*)(b0 + bo[i]), (unsigned*)(st + 32768 + (wid * 4 + i) * 1024), 16, 0, 0);
        }
    };
    f32x4 acc[8][4];
    __syncthreads();
    stage(0, 0, lds);
    asm volatile("s_waitcnt vmcnt(0)" ::: "memory");
    __syncthreads();
    int q = 0;
    for (int t = 0; t < ntile; t++) {
#pragma unroll
        for (int mi = 0; mi < 8; mi++)
#pragma unroll
            for (int ni = 0; ni < 4; ni++) acc[mi][ni] = (f32x4){0.f, 0.f, 0.f, 0.f};
        const long boff = (long)t * bstep;
        for (int kt = 0; kt < nk; kt++, q++) {
            char* cur = lds + (q & 1) * 65536;
            char* nxt = lds + ((q + 1) & 1) * 65536;
            if (kt + 1 < nk) stage(kt + 1, boff, nxt);
            else if (t + 1 < ntile) stage(0, boff + bstep, nxt);
#pragma unroll
            for (int ks = 0; ks < 2; ks++) {
                bf16x8 af[8], bfr[4];
#pragma unroll
                for (int i = 0; i < 8; i++) af[i] = *(const bf16x8*)(cur + tile_off(wm * 128 + i * 16 + (lane & 15), ks * 4 + (lane >> 4)));
#pragma unroll
                for (int i = 0; i < 4; i++) bfr[i] = *(const bf16x8*)(cur + 32768 + tile_off(wn * 64 + i * 16 + (lane & 15), ks * 4 + (lane >> 4)));
                __builtin_amdgcn_s_setprio(1);
#pragma unroll
                for (int mi = 0; mi < 8; mi++)
#pragma unroll
                    for (int ni = 0; ni < 4; ni++)
                        acc[mi][ni] = __builtin_amdgcn_mfma_f32_16x16x32_bf16(bfr[ni], af[mi], acc[mi][ni], 0, 0, 0);
                __builtin_amdgcn_s_setprio(0);
            }
            asm volatile("s_waitcnt vmcnt(0)" ::: "memory");
            __syncthreads();
        }
        epi(t, acc);
    }
}
__device__ __forceinline__ void phase9_8(const Params& p, char* lds) {
    const int tid = threadIdx.x, lane = tid & 63, wid = tid >> 6, wm = wid >> 2, wn = wid & 3, lq = lane >> 4, lr = lane & 15;
    FOR_XCD_ITEMS_R(si, NE * NB * 2 * 2) {
        const int cth = si & 1, rt = (si >> 1) & 1, b = (si >> 2) & 3, e = si >> 4;
        const int* arow = wsp<int>(p, OFF_IDX) + (long)(b * NE + e) * CAP + rt * 256;
        const float* rss = wsp<float>(p, OFF_RSS) + (long)(b * NE + e) * CAP + rt * 256;
        gemm_256sq_multi(wsp<bf16_t>(p, OFF_X2B), ND, arow, wsp<bf16_t>(p, OFF_WGUT) + ((long)e * 2048 + cth * 1024) * ND, ND, 256L * ND,
                         ND, 4, lds, [&](int t, f32x4 (&acc)[8][4]) {
            const int ct = cth * 4 + t;
            char* adb = (char*)(wsp<bf16_t>(p, OFF_ACT) + ((long)(e * NB + b) * CAP + rt * 256) * ND + ct * 128);
            const unsigned ado = (unsigned)((wm * 128 + lr) * ND + wn * 32 + 4 * lq) * 2u;
#pragma unroll
            for (int mi = 0; mi < 8; mi++) {
                const float rs = rss[wm * 128 + mi * 16 + lr];
#pragma unroll
                for (int pp = 0; pp < 2; pp++) {
                    f32x4 o;
#pragma unroll
                    for (int q = 0; q < 4; q++) {
                        const float ga = acc[mi][2 * pp][q] * rs, up = acc[mi][2 * pp + 1][q] * rs;
                        o[q] = ga / (1.f + __expf(-ga)) * up;
                    }
                    *(u32x2*)(adb + (ado + (unsigned)(mi * 16 * ND * 2 + pp * 32))) = pack4bf(o);
                }
            }
        });
    }
}
__device__ __forceinline__ void phase10_8(const Params& p, char* lds) {
    const int tid = threadIdx.x, lane = tid & 63, wid = tid >> 6, wm = wid >> 2, wn = wid & 3, lq = lane >> 4, lr = lane & 15;
    FOR_XCD_ITEMS_R(si, NE * NB * 2 * 2) {
        const int cth = si & 1, rt = (si >> 1) & 1, b = (si >> 2) & 3, e = si >> 4;
        const long row0 = (long)(e * NB + b) * CAP + rt * 256;
        const float* gate = wsp<float>(p, OFF_GATE) + (long)(b * NE + e) * CAP + rt * 256;
        gemm_256sq_multi(wsp<bf16_t>(p, OFF_ACT) + row0 * ND, ND, nullptr, wsp<bf16_t>(p, OFF_WDT) + ((long)e * 1024 + cth * 512) * ND, ND, 256L * ND,
                         ND, 2, lds, [&](int t, f32x4 (&acc)[8][4]) {
            const int ct = cth * 2 + t;
            char* yb = (char*)(wsp<bf16_t>(p, OFF_Y) + row0 * ND + ct * 256);
            const unsigned yo = (unsigned)((wm * 128 + lr) * ND + wn * 64 + 4 * lq) * 2u;
#pragma unroll
            for (int mi = 0; mi < 8; mi++) {
                const float gv = gate[wm * 128 + mi * 16 + lr];
#pragma unroll
                for (int ni = 0; ni < 4; ni++) *(u32x2*)(yb + (yo + (unsigned)(mi * 16 * ND * 2 + ni * 32))) = pack4bf(acc[mi][ni] * gv);
            }
        });
    }
}


__device__ __forceinline__ void phase1_big(const Params& p, char* lds) {
    const int tid = threadIdx.x, lane = tid & 63, wid = tid >> 6, wm = wid >> 2, wn = wid & 3, lq = lane >> 4, lr = lane & 15;
    FOR_XCD_ITEMS_R(item, 64 * 4) {
        const int tm = item >> 2, tn = item & 3;
        f32x4 acc[8][4];
        GemmTile g; g.A = wsp<bf16_t>(p, OFF_XB) + (long)tm * 256 * ND; g.lda = ND; g.arow = nullptr;
        g.Bt = wsp<bf16_t>(p, OFF_W1T) + (long)tn * 256 * ND; g.ldb = ND; g.K = ND;
        gemm_tile_256sq(g, lds, acc);
        const float* r0 = wsp<float>(p, OFF_R0);
        const int col0 = tn * 256 + wn * 64;
#pragma unroll
        for (int mi = 0; mi < 8; mi++) {
            const int row = tm * 256 + wm * 128 + mi * 16 + lr;
            const float rs = r0[row];
#pragma unroll
            for (int ni = 0; ni < 4; ni++) acc[mi][ni] *= rs;
            if (col0 < 512) {
#pragma unroll
                for (int ni = 0; ni < 4; ni++)
                    *(u32x2*)(wsp<bf16_t>(p, OFF_UF) + (long)row * 512 + col0 + ni * 16 + 4 * lq) = pack4bf(acc[mi][ni]);
            } else {
                float ss = 0.f;
#pragma unroll
                for (int ni = 0; ni < 4; ni++) { const f32x4 v = acc[mi][ni]; ss += v[0] * v[0] + v[1] * v[1] + v[2] * v[2] + v[3] * v[3]; }
                ss += __shfl_xor(ss, 16); ss += __shfl_xor(ss, 32);
                if (col0 < 896) {
#pragma unroll
                    for (int ni = 0; ni < 4; ni++)
                        *(u32x2*)(wsp<bf16_t>(p, OFF_UQ) + (long)row * 384 + (col0 - 512) + ni * 16 + 4 * lq) = pack4bf(acc[mi][ni]);
                    if (lq == 0) wsp<float>(p, OFF_SSQ)[row * 6 + ((col0 - 512) >> 6)] = ss;
                } else {
#pragma unroll
                    for (int ni = 0; ni < 4; ni++)
                        *(u32x2*)(wsp<bf16_t>(p, OFF_UKV) + (long)row * 256 + (col0 - 896) + ni * 16 + 4 * lq) = pack4bf(acc[mi][ni]);
                    if (lq == 0) wsp<float>(p, OFF_SSKV)[row * 4 + ((col0 - 896) >> 6)] = ss;
                }
            }
        }
    }
}


__device__ __forceinline__ void phase3_attn8(const Params& p, char* lds) {
    FOR_XCD_ITEMS_R(item, NB * 8 * (NS / 256)) {
        const int qt = item & 15, h = (item >> 4) & 7, b = item >> 7;
        const bf16_t* Qp = wsp<bf16_t>(p, OFF_Q) + ((long)(b * 8 + h) * NS + qt * 256) * 96;
        const bf16_t* Kp = wsp<bf16_t>(p, OFF_K) + ((long)(b * 8 + h) * NS) * 96;
        const bf16_t* Vtp = wsp<bf16_t>(p, OFF_VT) + ((long)(b * 8 + h) * 64) * NS;
        bf16_t* Op = wsp<bf16_t>(p, OFF_ZA) + ((long)b * NS + qt * 256) * 1024 + 512 + h * 64;
        attn_block<96, 64, 128, 512>(Qp, Kp, Vtp, (long)NS, NS, lds, [&](int q, int dv, f32x4 v) { *(u32x2*)(Op + (long)q * 1024 + dv) = pack4bf(v); });
    }
}
__device__ __forceinline__ void phase5b_8(const Params& p, char* lds) {
    FOR_XCD_ITEMS_R(item, NB * 4 * 16 * 2) {
        const int dvh = item & 1, qt = (item >> 1) & 15, h = (item >> 5) & 3, b = item >> 7;
        const bf16_t* Qp = wsp<bf16_t>(p, OFF_QM) + ((long)(b * 4 + h) * NS + qt * 256) * 256;
        const bf16_t* Kp = wsp<bf16_t>(p, OFF_KMEM) + ((long)(b * 4 + h) * 256) * 256;
        const bf16_t* Vtp = wsp<bf16_t>(p, OFF_VTMEM) + ((long)(b * 4 + h) * 256 + dvh * 128) * 256;
        bf16_t* Op = wsp<bf16_t>(p, OFF_OM) + ((long)b * NS + qt * 256) * 1024 + h * 256 + dvh * 128;
        attn_block<256, 128, 32, 512>(Qp, Kp, Vtp, 256L, 256, lds, [&](int q, int dv, f32x4 v) { *(u32x2*)(Op + (long)q * 1024 + dv) = pack4bf(v); });
    }
}

__global__ void __launch_bounds__(512, 1) k_fwd(Params p, int ph_lo, int ph_hi) {
    extern __shared__ __attribute__((aligned(16))) char lds_all[];
    char* lds = lds_all + VHALF * LDS_HALF;
    volatile LAS unsigned* st = (volatile LAS unsigned*)(lds_all + LDS_MAIN);
    if (threadIdx.x == 0) { st[0] = 0u; st[1] = 0u; }
    __syncthreads();
    XcdBarrier bar = xcd_barrier_post(wsp<unsigned>(p, OFF_BAR), st);
#if USE_CG_SYNC
#define GRID_BARRIER() do { asm volatile("s_waitcnt vmcnt(0)" ::: "memory"); __syncthreads(); cg::this_grid().sync(); asm volatile("s_waitcnt vmcnt(0)" ::: "memory"); __syncthreads(); } while (0)
#else
#define GRID_BARRIER() xcd_barrier(bar)
#endif
#define RUN_PHASE(k, call) if (ph_lo <= (k) && (k) < ph_hi) { if ((k) > ph_lo) { GRID_BARRIER(); } call; }
    RUN_PHASE(0, phase0(p, lds))
    RUN_PHASE(1, (phase1_big(p, lds_all), phase1(p, lds_all)))
    RUN_PHASE(2, (phase2(p, lds_all), phase2_f2a(p, lds)))
    RUN_PHASE(3, ((blockIdx.x & 1) ? phase3_tr(p, lds) : (void)0, phase3_attn8(p, lds_all), phase3_f2b(p, lds), (blockIdx.x & 1) ? (void)0 : phase3_tr(p, lds)))
    RUN_PHASE(4, phase_resid8(p, lds_all, OFF_ZA, OFF_WOUTT, p.x, nullptr, OFF_X1B, OFF_SS1))
    RUN_PHASE(5, phase5a8(p, lds_all))
    RUN_PHASE(6, phase5b_8(p, lds_all))
    RUN_PHASE(7, phase_resid8(p, lds_all, OFF_OM, OFF_WMOT, nullptr, wsp<bf16_t>(p, OFF_X1B), OFF_X2B, OFF_SS2))
    RUN_PHASE(8, phase7(p, lds_all))
    RUN_PHASE(9, phase8(p, lds_all))
    RUN_PHASE(10, phase9_8(p, lds_all))
    RUN_PHASE(11, phase10_8(p, lds_all))
    RUN_PHASE(12, phase11(p, lds))
}

extern "C" void kernel_launch(void* const* d_in, const int* in_sizes, int n_in,
                              void* d_out, int out_size, void* d_ws, size_t ws_size,
                              hipStream_t stream) {
    static int grid = 0;
    if (grid == 0) {
        if (n_in != 22 || ws_size < WS_END) { fprintf(stderr, "kernel_launch: unexpected inputs (n_in %d, ws %zu < %zu)\n", n_in, ws_size, (size_t)WS_END); grid = -1; return; }
        int dev = 0, cus = 0, per_cu = 0;
        (void)hipGetDevice(&dev);
        (void)hipDeviceGetAttribute(&cus, hipDeviceAttributeMultiprocessorCount, dev);
        if (hipFuncSetAttribute((const void*)k_fwd, hipFuncAttributeMaxDynamicSharedMemorySize, LDS_TOTAL) != hipSuccess) { fprintf(stderr, "kernel_launch: hipFuncSetAttribute failed\n"); grid = -1; return; }
        if (hipOccupancyMaxActiveBlocksPerMultiprocessor(&per_cu, (const void*)k_fwd, 512, LDS_TOTAL) != hipSuccess || per_cu < 1) { fprintf(stderr, "kernel_launch: occupancy query failed (%d)\n", per_cu); (void)hipGetLastError(); per_cu = 1; }
        if (per_cu > 1) per_cu = 1;
        grid = (cus * per_cu) & ~7;
        if (grid < 8) { fprintf(stderr, "kernel_launch: unexpected device (%d CUs)\n", cus); grid = -1; return; }
        fprintf(stderr, "kernel_launch: %d CUs x %d blocks\n", cus, per_cu);
    }
    if (grid < 0) return;
    Params p{};
    p.x = (const float*)d_in[0]; p.mem = (const float*)d_in[1]; p.pos = (const int*)d_in[2];
    p.g_mix = (const float*)d_in[3]; p.w_in = (const float*)d_in[4]; p.g_q_lat = (const float*)d_in[5]; p.w_q_up = (const float*)d_in[6];
    p.g_kv_lat = (const float*)d_in[7]; p.w_kv_up = (const float*)d_in[8]; p.w_fourier = (const float*)d_in[9]; p.w_out = (const float*)d_in[10];
    p.g_mem_q = (const float*)d_in[11]; p.g_mem_kv = (const float*)d_in[12]; p.w_mem_q = (const float*)d_in[13]; p.w_mem_kv = (const float*)d_in[14];
    p.w_mem_o = (const float*)d_in[15]; p.g_ffn = (const float*)d_in[16]; p.w_router = (const float*)d_in[17];
    p.w_exp_gate = (const float*)d_in[18]; p.w_exp_up = (const float*)d_in[19]; p.w_exp_down = (const float*)d_in[20]; p.g_final = (const float*)d_in[21];
    p.out = (float*)d_out; p.ws = (char*)d_ws;
    static const int cuts[] = MK_CUTS;
    const int ncut = (int)(sizeof(cuts) / sizeof(int));
    for (int li = 0; li + 1 < ncut; li++) {
        (void)hipMemsetAsync((char*)d_ws + OFF_BAR, 0, 16384, stream);
        int lo = cuts[li], hi = cuts[li + 1];
        void* args[] = {&p, &lo, &hi};
        hipError_t e = hipLaunchCooperativeKernel((const void*)k_fwd, dim3(grid), dim3(512), args, LDS_TOTAL, stream);
        if (e != hipSuccess) fprintf(stderr, "cooperative launch failed: %s (grid %d)\n", hipGetErrorString(e), grid);
    }
}
```

```cpp
#include <hip/hip_runtime.h>
#include <stdint.h>
#include <cstdio>
#include <hip/hip_cooperative_groups.h>
namespace cg = cooperative_groups;
#ifndef USE_CG_SYNC
#define USE_CG_SYNC 0
#endif

#ifndef MK_CUTS
#define MK_CUTS {0, 13}
#endif

#define NB 4
#define NS 4096
#define ND 1024
#define NT (NB * NS)
#define INW 1184
#define NE 16
#define CAP 512
#define MEML 256
#define NPHASE 13
#define VTID ((int)(threadIdx.x & 255))
#define VHALF (__builtin_amdgcn_readfirstlane((int)(threadIdx.x >> 8)))
#define VBLK ((int)(blockIdx.x * 2) + VHALF)
#define VGRID ((int)(gridDim.x * 2))

typedef unsigned short bf16_t;
typedef short bf16x8 __attribute__((ext_vector_type(8)));
typedef float f32x4 __attribute__((ext_vector_type(4)));
typedef float f32x16 __attribute__((ext_vector_type(16)));
typedef unsigned u32x4 __attribute__((ext_vector_type(4)));
typedef int i32x4 __attribute__((ext_vector_type(4)));
typedef unsigned u32x2 __attribute__((ext_vector_type(2)));

__device__ __forceinline__ unsigned f2bf(float f) {
    unsigned u = __float_as_uint(f);
    u += 0x7FFFu + ((u >> 16) & 1u);
    return u >> 16;
}
typedef __bf16 hbf2 __attribute__((ext_vector_type(2)));
typedef float f32x2 __attribute__((ext_vector_type(2)));
__device__ __forceinline__ unsigned pack2bf(float lo, float hi) { f32x2 v = {lo, hi}; return __builtin_bit_cast(unsigned, __builtin_convertvector(v, hbf2)); }
__device__ __forceinline__ float bf2f(unsigned short b) { return __uint_as_float(((unsigned)b) << 16); }

__device__ __forceinline__ int tile_off(int row, int chunk) { return row * 128 + ((chunk ^ ((row >> 1) & 7)) << 4); }

#define GT_LDS_BYTES 65536

struct GemmTile { const bf16_t* A; long lda; const int* arow; const bf16_t* Bt; long ldb; int K; };

__device__ __forceinline__ void gemm_tile_128(const GemmTile& g, char* lds, f32x4 (&acc)[4][4]) {
    const int tid = VTID, lane = tid & 63, wid = tid >> 6, wm = wid >> 1, wn = wid & 1;
    const int lrow = lane >> 3, pc = lane & 7;
    const bf16_t* ap[4]; const bf16_t* bp[4];
#pragma unroll
    for (int i = 0; i < 4; i++) {
        const int r = (wid * 4 + i) * 8 + lrow;
        const int c = pc ^ ((r >> 1) & 7);
        const long ro = g.arow ? (long)g.arow[r] * g.lda : (long)r * g.lda;
        ap[i] = g.A + ro + c * 8;
        bp[i] = g.Bt + (long)r * g.ldb + c * 8;
    }
#pragma unroll
    for (int mi = 0; mi < 4; mi++)
#pragma unroll
        for (int ni = 0; ni < 4; ni++) acc[mi][ni] = (f32x4){0.f, 0.f, 0.f, 0.f};
    const int nk = g.K >> 6;
    auto stage = [&](int kt, char* st) {
#pragma unroll
        for (int i = 0; i < 4; i++) {
            __builtin_amdgcn_global_load_lds((const unsigned*)(ap[i] + kt * 64), (unsigned*)(st + (wid * 4 + i) * 1024), 16, 0, 0);
            __builtin_amdgcn_global_load_lds((const unsigned*)(bp[i] + kt * 64), (unsigned*)(st + 16384 + (wid * 4 + i) * 1024), 16, 0, 0);
        }
    };
    __syncthreads();
    stage(0, lds);
    asm volatile("s_waitcnt vmcnt(0)" ::: "memory");
    __syncthreads();
    for (int kt = 0; kt < nk; kt++) {
        char* cur = lds + (kt & 1) * 32768;
        if (kt + 1 < nk) stage(kt + 1, lds + ((kt + 1) & 1) * 32768);
        bf16x8 af[2][4], bfr[2][4];
#pragma unroll
        for (int ks = 0; ks < 2; ks++)
#pragma unroll
            for (int i = 0; i < 4; i++) {
                af[ks][i] = *(const bf16x8*)(cur + tile_off(wm * 64 + i * 16 + (lane & 15), ks * 4 + (lane >> 4)));
                bfr[ks][i] = *(const bf16x8*)(cur + 16384 + tile_off(wn * 64 + i * 16 + (lane & 15), ks * 4 + (lane >> 4)));
            }
        __builtin_amdgcn_s_setprio(1);
#pragma unroll
        for (int ks = 0; ks < 2; ks++)
#pragma unroll
            for (int mi = 0; mi < 4; mi++)
#pragma unroll
                for (int ni = 0; ni < 4; ni++)
                    acc[mi][ni] = __builtin_amdgcn_mfma_f32_16x16x32_bf16(bfr[ks][ni], af[ks][mi], acc[mi][ni], 0, 0, 0);
        __builtin_amdgcn_s_setprio(0);
        asm volatile("s_waitcnt vmcnt(0)" ::: "memory");
        __syncthreads();
    }
}

template <int DQK, int DVT, int KT>
struct AttnCfg {
    static constexpr int KROW = DQK * 2 + 16;
    static constexpr int VROW = KT * 2 + 8;
    static constexpr int KBYTES = KT * KROW;
    static constexpr int VBYTES = DVT * VROW;
    static constexpr int STAGE = KBYTES + VBYTES;
    static constexpr int LDS = 2 * STAGE;
};

template <int DQK, int DVT, int KT, int NTH, class Out>
__device__ __forceinline__ void attn_block(const bf16_t* Qp, const bf16_t* Kp, const bf16_t* Vtp, long ldv, int nk, char* lds, Out&& out) {
    typedef AttnCfg<DQK, DVT, KT> C;
    constexpr int NKS = DQK / 16, NST = KT / 32, NDT = DVT / 32, NPS = KT / 16;
    constexpr int KCPR = DQK / 8;
    constexpr int KTOT = KT * KCPR, KCH = (KTOT + NTH - 1) / NTH;
    constexpr int VCPR = KT / 8;
    constexpr int VTOT = DVT * VCPR, VCH = (VTOT + NTH - 1) / NTH;
    const int tid = NTH == 512 ? (int)threadIdx.x : VTID, lane = tid & 63, wid = tid >> 6, h = lane >> 5, c = lane & 31;

    bf16x8 qf[NKS];
    {
        const bf16_t* qrow = Qp + (long)(wid * 32 + c) * DQK + 8 * h;
#pragma unroll
        for (int ks = 0; ks < NKS; ks++) qf[ks] = *(const bf16x8*)(qrow + 16 * ks);
    }
    f32x16 o[NDT];
#pragma unroll
    for (int dt = 0; dt < NDT; dt++)
#pragma unroll
        for (int r = 0; r < 16; r++) o[dt][r] = 0.f;
    float m = 0.f, l = 0.f;

    u32x4 kr[KCH], vr[VCH];
    auto gload = [&](int t) {
#pragma unroll
        for (int i = 0; i < KCH; i++) {
            const int ci = tid + NTH * i, row = ci / KCPR, cc = ci % KCPR;
            if (KTOT % NTH == 0 || ci < KTOT) kr[i] = *(const u32x4*)(Kp + (long)(t * KT + row) * DQK + cc * 8);
        }
#pragma unroll
        for (int i = 0; i < VCH; i++) {
            const int ci = tid + NTH * i, row = ci / VCPR, cc = ci % VCPR;
            if (VTOT % NTH == 0 || ci < VTOT) vr[i] = *(const u32x4*)(Vtp + (long)row * ldv + t * KT + cc * 8);
        }
    };
    auto lwrite = [&](char* st) {
#pragma unroll
        for (int i = 0; i < KCH; i++) {
            const int ci = tid + NTH * i, row = ci / KCPR, cc = ci % KCPR;
            if (KTOT % NTH == 0 || ci < KTOT) *(u32x4*)(st + row * C::KROW + cc * 16) = kr[i];
        }
#pragma unroll
        for (int i = 0; i < VCH; i++) {
            const int ci = tid + NTH * i, row = ci / VCPR, cc = ci % VCPR;
            if (VTOT % NTH == 0 || ci < VTOT) {
                char* p = st + C::KBYTES + row * C::VROW + cc * 16;
                *(u32x2*)(p) = (u32x2){vr[i].x, vr[i].y};
                *(u32x2*)(p + 8) = (u32x2){vr[i].z, vr[i].w};
            }
        }
    };
    const int nt = nk / KT;
    gload(0);
    __syncthreads();
    lwrite(lds);
    __syncthreads();
    for (int t = 0; t < nt; t++) {
        char* cur = lds + (t & 1) * C::STAGE;
        if (t + 1 < nt) gload(t + 1);
        f32x16 s[NST];
        const float negm = -m;
#pragma unroll
        for (int st = 0; st < NST; st++) {
#pragma unroll
            for (int r = 0; r < 16; r++) s[st][r] = negm;
#pragma unroll
            for (int ks = 0; ks < NKS; ks++) {
                const bf16x8 kf = *(const bf16x8*)(cur + (st * 32 + c) * C::KROW + ks * 32 + h * 16);
                s[st] = __builtin_amdgcn_mfma_f32_32x32x16_bf16(kf, qf[ks], s[st], 0, 0, 0);
            }
        }
        float mx = s[0][0];
#pragma unroll
        for (int st = 0; st < NST; st++)
#pragma unroll
            for (int r = 0; r < 16; r++) mx = fmaxf(mx, s[st][r]);
        mx = fmaxf(mx, __shfl_xor(mx, 32));
        if (__any(mx > 8.0f)) {
            const float d = fmaxf(mx, 0.f);
            const float alpha = __builtin_amdgcn_exp2f(-d);
            m += d;
            l *= alpha;
#pragma unroll
            for (int dt = 0; dt < NDT; dt++)
#pragma unroll
                for (int r = 0; r < 16; r++) o[dt][r] *= alpha;
#pragma unroll
            for (int st = 0; st < NST; st++)
#pragma unroll
                for (int r = 0; r < 16; r++) s[st][r] -= d;
        }
        float rs = 0.f;
#pragma unroll
        for (int st = 0; st < NST; st++)
#pragma unroll
            for (int r = 0; r < 16; r++) { const float p = __builtin_amdgcn_exp2f(s[st][r]); rs += p; s[st][r] = p; }
        l += rs;
#pragma unroll
        for (int ps = 0; ps < NPS; ps++) {
            const int st = ps >> 1, u = ps & 1;
            u32x4 pw;
            pw.x = pack2bf(s[st][8 * u + 0], s[st][8 * u + 1]);
            pw.y = pack2bf(s[st][8 * u + 2], s[st][8 * u + 3]);
            pw.z = pack2bf(s[st][8 * u + 4], s[st][8 * u + 5]);
            pw.w = pack2bf(s[st][8 * u + 6], s[st][8 * u + 7]);
            const bf16x8 pf = __builtin_bit_cast(bf16x8, pw);
#pragma unroll
            for (int dt = 0; dt < NDT; dt++) {
                const char* vp = cur + C::KBYTES + (dt * 32 + c) * C::VROW + (ps * 16 + 4 * h) * 2;
                const u32x2 v0 = *(const u32x2*)(vp);
                const u32x2 v1 = *(const u32x2*)(vp + 16);
                const bf16x8 vf = __builtin_bit_cast(bf16x8, ((u32x4){v0.x, v0.y, v1.x, v1.y}));
                o[dt] = __builtin_amdgcn_mfma_f32_32x32x16_bf16(vf, pf, o[dt], 0, 0, 0);
            }
        }
        if (t + 1 < nt) lwrite(lds + ((t + 1) & 1) * C::STAGE);
        __syncthreads();
    }
    l += __shfl_xor(l, 32);
    const float inv = 1.f / l;
#pragma unroll
    for (int dt = 0; dt < NDT; dt++)
#pragma unroll
        for (int g4 = 0; g4 < 4; g4++) {
            f32x4 v = {o[dt][4 * g4 + 0] * inv, o[dt][4 * g4 + 1] * inv, o[dt][4 * g4 + 2] * inv, o[dt][4 * g4 + 3] * inv};
            out(wid * 32 + c, dt * 32 + 8 * g4 + 4 * h, v);
        }
}


constexpr size_t SLOT = 33554432;
constexpr size_t OFF_W1T = 0;
constexpr size_t OFF_WQT = OFF_W1T + 1280UL * 1024 * 2;
constexpr size_t OFF_WKVT = OFF_WQT + 768UL * 384 * 2;
constexpr size_t OFF_WOUTT = OFF_WKVT + 1024UL * 256 * 2;
constexpr size_t OFF_WMQT = OFF_WOUTT + 1024UL * 1024 * 2;
constexpr size_t OFF_WMKVT = OFF_WMQT + 1024UL * 1024 * 2;
constexpr size_t OFF_WMOT = OFF_WMKVT + 2048UL * 1024 * 2;
constexpr size_t OFF_WGUT = OFF_WMOT + 1024UL * 1024 * 2;
constexpr size_t OFF_WDT = OFF_WGUT + 16UL * 2048 * 1024 * 2;
constexpr size_t OFF_T64 = OFF_WDT + 16UL * 1024 * 1024 * 2;
constexpr size_t OFF_M1 = OFF_T64 + 16384;
constexpr size_t OFF_M3 = OFF_M1 + 32768;
constexpr size_t OFF_WFT = OFF_M3 + 16384;
constexpr size_t OFF_TW = OFF_WFT + 65536;
constexpr size_t OFF_ROPE = OFF_TW + 32768;
constexpr size_t OFF_R0 = OFF_ROPE + (size_t)NT * 16 * 8;
constexpr size_t OFF_RMEM = OFF_R0 + (size_t)NT * 4;
constexpr size_t OFF_SSQ = OFF_RMEM + 4096;
constexpr size_t OFF_SSKV = OFF_SSQ + (size_t)NT * 6 * 4;
constexpr size_t OFF_SS1 = OFF_SSKV + (size_t)NT * 4 * 4;
constexpr size_t OFF_SS2 = OFF_SS1 + (size_t)NT * 16 * 4;
constexpr size_t OFF_AFF = OFF_SS2 + (size_t)NT * 16 * 4;
constexpr size_t OFF_SLOTS = OFF_AFF + (size_t)NT * 16 * 4;
constexpr size_t OFF_IDX = OFF_SLOTS + 4UL * 16 * 4096 * 4;
constexpr size_t OFF_GATE = OFF_IDX + 4UL * 16 * 512 * 4;
constexpr size_t OFF_MEMB = OFF_GATE + 4UL * 16 * 512 * 4;
constexpr size_t OFF_KMEM = OFF_MEMB + 1024UL * 1024 * 2;
constexpr size_t OFF_VTMEM = OFF_KMEM + 1024UL * 1024 * 2;
constexpr size_t OFF_KR = OFF_VTMEM + 1024UL * 1024 * 2;
constexpr size_t OFF_BAR = OFF_KR + (size_t)NT * 32 * 2;
constexpr size_t OFF_RS2 = OFF_BAR + 16384;
constexpr size_t OFF_RSS = OFF_RS2 + (size_t)NT * 4;
constexpr size_t OFF_S0 = (OFF_RSS + 4UL * 16 * 512 * 4 + 255) / 256 * 256;
constexpr size_t OFF_S1 = OFF_S0 + SLOT;
constexpr size_t OFF_S2 = OFF_S1 + SLOT;
constexpr size_t OFF_S3 = OFF_S2 + SLOT;
constexpr size_t OFF_S4 = OFF_S3 + SLOT;
constexpr size_t WS_END = OFF_S4 + SLOT;
static_assert(WS_END <= 300964352UL, "workspace map exceeds the guaranteed scratch size");
constexpr size_t OFF_XB = OFF_S0, OFF_YR = OFF_S0, OFF_YI = OFF_S0 + SLOT / 2, OFF_X1B = OFF_S3, OFF_OM = OFF_S0, OFF_ACT = OFF_S0;
constexpr size_t OFF_UF = OFF_S1, OFF_UQ = OFF_S1 + (size_t)NT * 512 * 2, OFF_ZA = OFF_S1, OFF_QM = OFF_S1;
constexpr size_t OFF_Q = OFF_S2, OFF_UKV = OFF_S2 + (size_t)NT * 768 * 2, OFF_X2B = OFF_S2;
constexpr size_t OFF_K = OFF_S3, OFF_Y = OFF_S3;
constexpr size_t OFF_VT = OFF_S4;

struct Params {
    const float *x, *mem; const int* pos;
    const float *g_mix, *w_in, *g_q_lat, *w_q_up, *g_kv_lat, *w_kv_up, *w_fourier, *w_out, *g_mem_q, *g_mem_kv, *w_mem_q, *w_mem_kv, *w_mem_o,
        *g_ffn, *w_router, *w_exp_gate, *w_exp_up, *w_exp_down, *g_final;
    float* out; char* ws;
};
template <class T> __device__ __forceinline__ T* wsp(const Params& p, size_t off) { return (T*)(p.ws + off); }

#define LDS_HALF 65536
#define LDS_MAIN 131072
#define LDS_TOTAL (LDS_MAIN + 16)
#define LAS __attribute__((address_space(3)))

#define XB_TMO      128
#define XB_XCNT(j)  (256  + 64 * (j))
#define XB_XSUB(j)  (1280 + 64 * (j))
#define XB_XGEN(j)  (2304 + 64 * (j))
#define XB_TOP      3328
#define XB_TOPGEN   3392
#define XCD_BAR_WORDS 3456
#define XB_SPIN_CAP (1u << 25)
__device__ __forceinline__ unsigned xb_ld(unsigned* p)              { return __hip_atomic_load(p, __ATOMIC_RELAXED, __HIP_MEMORY_SCOPE_AGENT); }
__device__ __forceinline__ unsigned xb_add(unsigned* p, unsigned v) { return __hip_atomic_fetch_add(p, v, __ATOMIC_RELAXED, __HIP_MEMORY_SCOPE_AGENT); }
__device__ __forceinline__ unsigned xb_xcc_id() { return (unsigned)__builtin_amdgcn_s_getreg((3 << 11) | 20) & 0xFu; }
#define XB_SPIN(cond, bar) do { unsigned _sp = 0; while (cond) { __builtin_amdgcn_s_sleep(1); \
    if ((++_sp & 255u) == 0u) { if (xb_ld(&(bar)[XB_TMO])) break; if (_sp > XB_SPIN_CAP) { atomicAdd(&(bar)[XB_TMO], 1u); break; } } } } while (0)
struct XcdBarrier { unsigned* bar; unsigned x; volatile LAS unsigned* st; };
__device__ __forceinline__ XcdBarrier xcd_barrier_post(unsigned* bar, volatile LAS unsigned* st) {
    XcdBarrier b; b.bar = bar; b.x = xb_xcc_id(); b.st = st;
    if (threadIdx.x == 0) (void)xb_add(&bar[XB_XCNT(b.x)], 1u);
    return b;
}
__device__ __forceinline__ void xcd_barrier_complete(unsigned* bar, unsigned x, unsigned& nloc, unsigned& nx) {
    const unsigned G = gridDim.x * gridDim.y * gridDim.z;
    unsigned sum, cnt, mine, sp = 0u;
    for (;;) {
        sum = 0u; cnt = 0u; mine = 0u;
#pragma unroll
        for (unsigned j = 0; j < 16; ++j) { const unsigned c = xb_ld(&bar[XB_XCNT(j)]); sum += c; cnt += (c > 0u) ? 1u : 0u; mine = (j == x) ? c : mine; }
        if (sum == G) break;
        __builtin_amdgcn_s_sleep(1);
        if ((++sp & 255u) == 0u) { if (xb_ld(&bar[XB_TMO])) break; if (sp > XB_SPIN_CAP) { atomicAdd(&bar[XB_TMO], 1u); break; } }
    }
    nloc = mine > 0u ? mine : 1u; nx = cnt > 0u ? cnt : 1u;
}
__device__ __forceinline__ void xcd_barrier(const XcdBarrier& b) {
    asm volatile("s_waitcnt vmcnt(0)" ::: "memory");
    __syncthreads();
    if (threadIdx.x == 0) {
        unsigned* bar = b.bar;
        __builtin_amdgcn_s_waitcnt(0);
        unsigned nloc = b.st[0], nx = b.st[1];
        if (nloc == 0u) { xcd_barrier_complete(bar, b.x, nloc, nx); b.st[0] = nloc; b.st[1] = nx; }
        const unsigned old = xb_add(&bar[XB_XSUB(b.x)], 1u);
        const unsigned gen = old / nloc;
        if (old + 1u == (gen + 1u) * nloc) {
            __builtin_amdgcn_fence(__ATOMIC_RELEASE, "agent");
            asm volatile("s_waitcnt vmcnt(0)" ::: "memory");
            const unsigned og = xb_add(&bar[XB_TOP], 1u);
            const unsigned tg = og / nx;
            if (og + 1u == (tg + 1u) * nx) xb_add(&bar[XB_TOPGEN], 1u);
            else XB_SPIN(xb_ld(&bar[XB_TOPGEN]) == tg, bar);
            __builtin_amdgcn_fence(__ATOMIC_ACQUIRE, "agent");
            xb_add(&bar[XB_XGEN(b.x)], 1u);
            asm volatile("s_waitcnt vmcnt(0)" ::: "memory");
        } else {
            XB_SPIN(xb_ld(&bar[XB_XGEN(b.x)]) == gen, bar);
            __builtin_amdgcn_fence(__ATOMIC_ACQUIRE, "agent");
            asm volatile("s_waitcnt vmcnt(0)" ::: "memory");
        }
    }
    __syncthreads();
}

#define FOR_XCD_ITEMS(item, N) for (int _L = (int)((blockIdx.x >> 3) << 1) | VHALF, item; _L < (N) / 8 && ((item = (int)(blockIdx.x & 7) * ((N) / 8) + _L), true); _L += (int)(gridDim.x >> 2))

__device__ __forceinline__ u32x2 pack4bf(float a, float b, float c, float d) { return (u32x2){pack2bf(a, b), pack2bf(c, d)}; }
__device__ __forceinline__ u32x2 pack4bf(f32x4 v) { return (u32x2){pack2bf(v[0], v[1]), pack2bf(v[2], v[3])}; }
__device__ __forceinline__ float wave_sum(float v) {
#pragma unroll
    for (int o = 32; o > 0; o >>= 1) v += __shfl_xor(v, o);
    return v;
}

__device__ __forceinline__ void tr_tile(const float* W, long ldw, int k0, int n0, int nvalid, const float* gain, bf16_t* Wt, long ldt, int mode, char* lds) {
    float (*t)[132] = (float (*)[132])lds;
    const int tid = VTID, c4 = tid & 31, r0 = tid >> 5;
    f32x4 v[8];
#pragma unroll
    for (int i = 0; i < 8; i++) {
        const int kk = r0 + 8 * i, n = n0 + c4 * 4;
        v[i] = (n < nvalid) ? *(const f32x4*)(W + (long)(k0 + kk) * ldw + n) : (f32x4){0.f, 0.f, 0.f, 0.f};
        if (gain) v[i] *= gain[k0 + kk];
    }
    __syncthreads();
#pragma unroll
    for (int i = 0; i < 8; i++) *(f32x4*)(&t[r0 + 8 * i][c4 * 4]) = v[i];
    __syncthreads();
#pragma unroll
    for (int i = 0; i < 4; i++) {
        const int ci = tid + 256 * i, nn = ci >> 3, kc = ci & 7;
        const int n = n0 + nn;
        int row = n;
        if (mode) row = (n >> 5) * 64 + ((n >> 4) & 1) * 32 + (mode - 1) * 16 + (n & 15);
        u32x4 w;
        w.x = pack2bf(t[kc * 8 + 0][nn], t[kc * 8 + 1][nn]);
        w.y = pack2bf(t[kc * 8 + 2][nn], t[kc * 8 + 3][nn]);
        w.z = pack2bf(t[kc * 8 + 4][nn], t[kc * 8 + 5][nn]);
        w.w = pack2bf(t[kc * 8 + 6][nn], t[kc * 8 + 7][nn]);
        *(u32x4*)(Wt + (long)row * ldt + k0 + kc * 8) = w;
    }
}

__device__ __forceinline__ void phase0(const Params& p, char* lds) {
    constexpr int J_W1 = 160, J_WQ = 36, J_WKV = 32, J_WOUT = 128, J_WMQ = 128, J_WMKV = 256, J_WMO = 128, J_WG = 0, J_WU = 0, J_WD = 0;
    constexpr int J_TR = J_W1 + J_WQ + J_WKV + J_WOUT + J_WMQ + J_WMKV + J_WMO + J_WG + J_WU + J_WD;
    constexpr int J_XR = NT / 16, J_MR = 1024 / 16, J_ROPE = NT * 16 / 256, J_TAB = (4096 + 8192 + 16384 + 8192 + 32768) / 256;
    constexpr int J_ALL = J_TR + J_XR + J_MR + J_ROPE + J_TAB;
    const int tid = VTID, lane = tid & 63, wid = tid >> 6;
    const double PI2 = 6.283185307179586476925286766559;
    for (int job = VBLK; job < J_ALL; job += VGRID) {
        int j = job;
        if (j < J_TR) {
            if (j < J_W1) { tr_tile(p.w_in, INW, (j / 10) * 64, (j % 10) * 128, INW, p.g_mix, wsp<bf16_t>(p, OFF_W1T), 1024, 0, lds); continue; } j -= J_W1;
            if (j < J_WQ) { tr_tile(p.w_q_up, 768, (j / 6) * 64, (j % 6) * 128, 768, p.g_q_lat, wsp<bf16_t>(p, OFF_WQT), 384, 0, lds); continue; } j -= J_WQ;
            if (j < J_WKV) { tr_tile(p.w_kv_up, 1024, (j / 8) * 64, (j % 8) * 128, 1024, p.g_kv_lat, wsp<bf16_t>(p, OFF_WKVT), 256, 0, lds); continue; } j -= J_WKV;
            if (j < J_WOUT) { tr_tile(p.w_out, 1024, (j / 8) * 64, (j % 8) * 128, 1024, nullptr, wsp<bf16_t>(p, OFF_WOUTT), 1024, 0, lds); continue; } j -= J_WOUT;
            if (j < J_WMQ) { tr_tile(p.w_mem_q, 1024, (j / 8) * 64, (j % 8) * 128, 1024, p.g_mem_q, wsp<bf16_t>(p, OFF_WMQT), 1024, 0, lds); continue; } j -= J_WMQ;
            if (j < J_WMKV) { tr_tile(p.w_mem_kv, 2048, (j / 16) * 64, (j % 16) * 128, 2048, p.g_mem_kv, wsp<bf16_t>(p, OFF_WMKVT), 1024, 0, lds); continue; } j -= J_WMKV;
            if (j < J_WMO) { tr_tile(p.w_mem_o, 1024, (j / 8) * 64, (j % 8) * 128, 1024, nullptr, wsp<bf16_t>(p, OFF_WMOT), 1024, 0, lds); continue; } j -= J_WMO;
            if (j < J_WG) { const int e = j >> 7, r = j & 127; tr_tile(p.w_exp_gate + (long)e * 1048576, 1024, (r / 8) * 64, (r % 8) * 128, 1024, p.g_ffn, wsp<bf16_t>(p, OFF_WGUT) + (long)e * 2048 * 1024, 1024, 1, lds); continue; } j -= J_WG;
            if (j < J_WU) { const int e = j >> 7, r = j & 127; tr_tile(p.w_exp_up + (long)e * 1048576, 1024, (r / 8) * 64, (r % 8) * 128, 1024, p.g_ffn, wsp<bf16_t>(p, OFF_WGUT) + (long)e * 2048 * 1024, 1024, 2, lds); continue; } j -= J_WU;
            { const int e = j >> 7, r = j & 127; tr_tile(p.w_exp_down + (long)e * 1048576, 1024, (r / 8) * 64, (r % 8) * 128, 1024, nullptr, wsp<bf16_t>(p, OFF_WDT) + (long)e * 1048576, 1024, 0, lds); continue; }
        }
        j -= J_TR;
        if (j < J_XR + J_MR) {
            const bool isx = j < J_XR;
            const int row0 = (isx ? j : j - J_XR) * 16 + wid * 4;
            const float* src = (isx ? p.x : p.mem) + (long)row0 * ND;
            bf16_t* dst = (isx ? wsp<bf16_t>(p, OFF_XB) : wsp<bf16_t>(p, OFF_MEMB)) + (long)row0 * ND;
            f32x4 v[4][4];
#pragma unroll
            for (int r = 0; r < 4; r++)
#pragma unroll
                for (int i = 0; i < 4; i++) v[r][i] = *(const f32x4*)(src + (long)r * ND + i * 256 + lane * 4);
#pragma unroll
            for (int r = 0; r < 4; r++) {
                float ss = 0.f;
#pragma unroll
                for (int i = 0; i < 4; i++) {
                    ss += v[r][i][0] * v[r][i][0] + v[r][i][1] * v[r][i][1] + v[r][i][2] * v[r][i][2] + v[r][i][3] * v[r][i][3];
                    *(u32x2*)(dst + (long)r * ND + i * 256 + lane * 4) = pack4bf(v[r][i]);
                }
                ss = wave_sum(ss);
                if (lane == 0) (isx ? wsp<float>(p, OFF_R0) : wsp<float>(p, OFF_RMEM))[row0 + r] = rsqrtf(ss * (1.f / ND) + 1e-6f);
            }
            continue;
        }
        j -= J_XR + J_MR;
        if (j < J_ROPE) {
            const int i = j * 256 + tid; const int t = i >> 4, jj = i & 15;
            const double f = pow(10000.0, -(double)(2 * jj) / 32.0);
            const double ang = (double)p.pos[t] * f;
            wsp<float2>(p, OFF_ROPE)[i] = make_float2((float)cos(ang), (float)sin(ang));
            continue;
        }
        j -= J_ROPE;
        {
            int i = j * 256 + tid;
            if (i < 4096) { const double a = PI2 * (double)i / 4096.0; wsp<float2>(p, OFF_TW)[i] = make_float2((float)cos(a), (float)sin(a)); continue; } i -= 4096;
            if (i < 8192) {
                const int T = i >> 12, a = (i >> 6) & 63, b = i & 63;
                const double th = PI2 * (double)((a * b) & 63) / 64.0;
                wsp<bf16_t>(p, OFF_T64)[i] = (bf16_t)f2bf((float)(T ? sin(th) : cos(th))); continue;
            } i -= 8192;
            if (i < 16384) {
                const int rho = i >> 7, k = i & 127;
                const int wm = rho >> 6, mi = (rho >> 4) & 3, lr = rho & 15, ri = mi >> 1, k1 = 32 * wm + 16 * (mi & 1) + lr, ab = k >> 6, s1 = k & 63;
                const double th = PI2 * (double)((k1 * s1) & 63) / 64.0;
                const double c = cos(th), s = sin(th);
                const double v = ri == 0 ? (ab == 0 ? c : -s) : (ab == 0 ? s : c);
                wsp<bf16_t>(p, OFF_M1)[i] = (bf16_t)f2bf((float)v); continue;
            } i -= 16384;
            if (i < 8192) {
                const int k2 = i >> 7, k = i & 127, s2 = k & 63;
                const double th = PI2 * (double)((k2 * s2) & 63) / 64.0;
                wsp<bf16_t>(p, OFF_M3)[i] = (bf16_t)f2bf((float)(k < 64 ? cos(th) : -sin(th))); continue;
            } i -= 8192;
            if (i < 32768) {
                const int g = i >> 12, e = (i >> 6) & 63, ch = i & 63;
                wsp<bf16_t>(p, OFF_WFT)[i] = (bf16_t)f2bf(p.w_fourier[(g * 64 + ch) * 64 + e]); continue;
            }
        }
    }
}

#define FOR_XCD_ITEMS_R(item, N) for (int _L = (int)(blockIdx.x >> 3), item; _L < (N) / 8 && ((item = (int)(blockIdx.x & 7) * ((N) / 8) + _L), true); _L += (int)(gridDim.x >> 3))
__device__ __forceinline__ void gemm_tile_256sq(const GemmTile& g, char* lds, f32x4 (&acc)[8][4]) {
    const int tid = threadIdx.x, lane = tid & 63, wid = tid >> 6, wm = wid >> 2, wn = wid & 3;
    const int lrow = lane >> 3, pc = lane & 7;
    const bf16_t* ap[4]; const bf16_t* bp[4];
#pragma unroll
    for (int i = 0; i < 4; i++) {
        const int r = (wid * 4 + i) * 8 + lrow;
        const int c = pc ^ ((r >> 1) & 7);
        const long ro = g.arow ? (long)g.arow[r] * g.lda : (long)r * g.lda;
        ap[i] = g.A + ro + c * 8;
        bp[i] = g.Bt + (long)r * g.ldb + c * 8;
    }
#pragma unroll
    for (int mi = 0; mi < 8; mi++)
#pragma unroll
        for (int ni = 0; ni < 4; ni++) acc[mi][ni] = (f32x4){0.f, 0.f, 0.f, 0.f};
    const int nk = g.K >> 6;
    auto stage = [&](int kt, char* st) {
#pragma unroll
        for (int i = 0; i < 4; i++) {
            __builtin_amdgcn_global_load_lds((const unsigned*)(ap[i] + kt * 64), (unsigned*)(st + (wid * 4 + i) * 1024), 16, 0, 0);
            __builtin_amdgcn_global_load_lds((const unsigned*)(bp[i] + kt * 64), (unsigned*)(st + 32768 + (wid * 4 + i) * 1024), 16, 0, 0);
        }
    };
    __syncthreads();
    stage(0, lds);
    asm volatile("s_waitcnt vmcnt(0)" ::: "memory");
    __syncthreads();
    for (int kt = 0; kt < nk; kt++) {
        char* cur = lds + (kt & 1) * 65536;
        if (kt + 1 < nk) stage(kt + 1, lds + ((kt + 1) & 1) * 65536);
#pragma unroll
        for (int ks = 0; ks < 2; ks++) {
            bf16x8 af[8], bfr[4];
#pragma unroll
            for (int i = 0; i < 8; i++) af[i] = *(const bf16x8*)(cur + tile_off(wm * 128 + i * 16 + (lane & 15), ks * 4 + (lane >> 4)));
#pragma unroll
            for (int i = 0; i < 4; i++) bfr[i] = *(const bf16x8*)(cur + 32768 + tile_off(wn * 64 + i * 16 + (lane & 15), ks * 4 + (lane >> 4)));
            __builtin_amdgcn_s_setprio(1);
#pragma unroll
            for (int mi = 0; mi < 8; mi++)
#pragma unroll
                for (int ni = 0; ni < 4; ni++)
                    acc[mi][ni] = __builtin_amdgcn_mfma_f32_16x16x32_bf16(bfr[ni], af[mi], acc[mi][ni], 0, 0, 0);
            __builtin_amdgcn_s_setprio(0);
        }
        asm volatile("s_waitcnt vmcnt(0)" ::: "memory");
        __syncthreads();
    }
}


__device__ __forceinline__ void gemm_tile_256x128(const GemmTile& g, char* lds, f32x4 (&acc)[4][4]) {
    const int tid = threadIdx.x, lane = tid & 63, wid = tid >> 6, wm = wid >> 1, wn = wid & 1;
    const int lrow = lane >> 3, pc = lane & 7;
    const bf16_t* ap[4]; const bf16_t* bp[2];
#pragma unroll
    for (int i = 0; i < 4; i++) {
        const int r = (wid * 4 + i) * 8 + lrow;
        const int c = pc ^ ((r >> 1) & 7);
        const long ro = g.arow ? (long)g.arow[r] * g.lda : (long)r * g.lda;
        ap[i] = g.A + ro + c * 8;
    }
#pragma unroll
    for (int i = 0; i < 2; i++) {
        const int r = (wid * 2 + i) * 8 + lrow;
        const int c = pc ^ ((r >> 1) & 7);
        bp[i] = g.Bt + (long)r * g.ldb + c * 8;
    }
#pragma unroll
    for (int mi = 0; mi < 4; mi++)
#pragma unroll
        for (int ni = 0; ni < 4; ni++) acc[mi][ni] = (f32x4){0.f, 0.f, 0.f, 0.f};
    const int nk = g.K >> 6;
    auto stage = [&](int kt, char* st) {
#pragma unroll
        for (int i = 0; i < 4; i++)
            __builtin_amdgcn_global_load_lds((const unsigned*)(ap[i] + kt * 64), (unsigned*)(st + (wid * 4 + i) * 1024), 16, 0, 0);
#pragma unroll
        for (int i = 0; i < 2; i++)
            __builtin_amdgcn_global_load_lds((const unsigned*)(bp[i] + kt * 64), (unsigned*)(st + 32768 + (wid * 2 + i) * 1024), 16, 0, 0);
    };
    __syncthreads();
    stage(0, lds);
    asm volatile("s_waitcnt vmcnt(0)" ::: "memory");
    __syncthreads();
    for (int kt = 0; kt < nk; kt++) {
        char* cur = lds + (kt & 1) * 49152;
        if (kt + 1 < nk) stage(kt + 1, lds + ((kt + 1) & 1) * 49152);
        bf16x8 af[2][4], bfr[2][4];
#pragma unroll
        for (int ks = 0; ks < 2; ks++)
#pragma unroll
            for (int i = 0; i < 4; i++) {
                af[ks][i] = *(const bf16x8*)(cur + tile_off(wm * 64 + i * 16 + (lane & 15), ks * 4 + (lane >> 4)));
                bfr[ks][i] = *(const bf16x8*)(cur + 32768 + tile_off(wn * 64 + i * 16 + (lane & 15), ks * 4 + (lane >> 4)));
            }
        __builtin_amdgcn_s_setprio(1);
#pragma unroll
        for (int ks = 0; ks < 2; ks++)
#pragma unroll
            for (int mi = 0; mi < 4; mi++)
#pragma unroll
                for (int ni = 0; ni < 4; ni++)
                    acc[mi][ni] = __builtin_amdgcn_mfma_f32_16x16x32_bf16(bfr[ks][ni], af[ks][mi], acc[mi][ni], 0, 0, 0);
        __builtin_amdgcn_s_setprio(0);
        asm volatile("s_waitcnt vmcnt(0)" ::: "memory");
        __syncthreads();
    }
}

template <class Setup, class Epi>
__device__ __forceinline__ void gemm_256x128_stream(int nitems, int lshift, int l0, int ls, char* lds, Setup setup, Epi epi) {
    const int tid = threadIdx.x, lane = tid & 63, wid = tid >> 6, wm = wid >> 1, wn = wid & 1;
    const int lrow = lane >> 3, pc = lane & 7;
    const int LN = nitems / 8, LS = ls, xb = (int)(blockIdx.x & 7) * LN;
    int L = (int)(blockIdx.x >> 3) - l0;
    if (L < 0 || L >= LS) return;
    L = (L + LS - lshift % LS) % LS;
    if (L >= LN) return;
    const bf16_t* ap[4]; const bf16_t* bp[2];
    auto setptr = [&](const GemmTile& g) {
#pragma unroll
        for (int i = 0; i < 4; i++) {
            const int r = (wid * 4 + i) * 8 + lrow;
            const int c = pc ^ ((r >> 1) & 7);
            ap[i] = g.A + (long)r * g.lda + c * 8;
        }
#pragma unroll
        for (int i = 0; i < 2; i++) {
            const int r = (wid * 2 + i) * 8 + lrow;
            const int c = pc ^ ((r >> 1) & 7);
            bp[i] = g.Bt + (long)r * g.ldb + c * 8;
        }
    };
    auto stage = [&](int kt, char* st) {
#pragma unroll
        for (int i = 0; i < 4; i++)
            __builtin_amdgcn_global_load_lds((const unsigned*)(ap[i] + kt * 64), (unsigned*)(st + (wid * 4 + i) * 1024), 16, 0, 0);
#pragma unroll
        for (int i = 0; i < 2; i++)
            __builtin_amdgcn_global_load_lds((const unsigned*)(bp[i] + kt * 64), (unsigned*)(st + 32768 + (wid * 2 + i) * 1024), 16, 0, 0);
    };
    GemmTile g; g.arow = nullptr;
    setup(xb + L, g);
    const int nk = g.K >> 6;
    setptr(g);
    __syncthreads();
    stage(0, lds);
    asm volatile("s_waitcnt vmcnt(0)" ::: "memory");
    __syncthreads();
    int q = 0;
    for (; L < LN; L += LS) {
        f32x4 acc[4][4];
#pragma unroll
        for (int mi = 0; mi < 4; mi++)
#pragma unroll
            for (int ni = 0; ni < 4; ni++) acc[mi][ni] = (f32x4){0.f, 0.f, 0.f, 0.f};
        for (int kt = 0; kt < nk; kt++, q++) {
            char* cur = lds + (q & 1) * 49152;
            char* nxt = lds + ((q + 1) & 1) * 49152;
            if (kt + 1 < nk) stage(kt + 1, nxt);
            else if (L + LS < LN) { setup(xb + L + LS, g); setptr(g); stage(0, nxt); }
            bf16x8 af[2][4], bfr[2][4];
#pragma unroll
            for (int ks = 0; ks < 2; ks++)
#pragma unroll
                for (int i = 0; i < 4; i++) {
                    af[ks][i] = *(const bf16x8*)(cur + tile_off(wm * 64 + i * 16 + (lane & 15), ks * 4 + (lane >> 4)));
                    bfr[ks][i] = *(const bf16x8*)(cur + 32768 + tile_off(wn * 64 + i * 16 + (lane & 15), ks * 4 + (lane >> 4)));
                }
            __builtin_amdgcn_s_setprio(1);
#pragma unroll
            for (int ks = 0; ks < 2; ks++)
#pragma unroll
                for (int mi = 0; mi < 4; mi++)
#pragma unroll
                    for (int ni = 0; ni < 4; ni++)
                        acc[mi][ni] = __builtin_amdgcn_mfma_f32_16x16x32_bf16(bfr[ks][ni], af[ks][mi], acc[mi][ni], 0, 0, 0);
            __builtin_amdgcn_s_setprio(0);
            asm volatile("s_waitcnt vmcnt(0)" ::: "memory");
            __syncthreads();
        }
        epi(xb + L, acc);
    }
}


__device__ __forceinline__ void phase1(const Params& p, char* lds) {
    const int tid = threadIdx.x, lane = tid & 63, wid = tid >> 6, wm = wid >> 1, wn = wid & 1, lq = lane >> 4, lr = lane & 15;
    constexpr int N_U = 64 * 2, N_M = 4 * 16;
    {
      gemm_256x128_stream(N_U, 0, 0, (int)(gridDim.x >> 3), lds, [&](int item, GemmTile& g) {
            const int tm = item >> 1, tn = 8 + (item & 1);
            g.A = wsp<bf16_t>(p, OFF_XB) + (long)tm * 256 * ND; g.lda = ND;
            g.Bt = wsp<bf16_t>(p, OFF_W1T) + (long)tn * 128 * ND; g.ldb = ND; g.K = ND;
        }, [&](int item, f32x4 (&acc)[4][4]) {
            const int tm = item >> 1, tn = 8 + (item & 1);
            const float* r0 = wsp<float>(p, OFF_R0);
#pragma unroll
            for (int mi = 0; mi < 4; mi++) {
                const int row = tm * 256 + wm * 64 + mi * 16 + lr;
                const float rs = r0[row];
#pragma unroll
                for (int ni = 0; ni < 4; ni++) acc[mi][ni] *= rs;
                if (tn < 4) {
#pragma unroll
                    for (int ni = 0; ni < 4; ni++)
                        *(u32x2*)(wsp<bf16_t>(p, OFF_UF) + (long)row * 512 + tn * 128 + wn * 64 + ni * 16 + 4 * lq) = pack4bf(acc[mi][ni]);
                } else if (tn < 9) {
                    float ss = 0.f;
#pragma unroll
                    for (int ni = 0; ni < 4; ni++) { const f32x4 v = acc[mi][ni]; ss += v[0] * v[0] + v[1] * v[1] + v[2] * v[2] + v[3] * v[3]; }
                    ss += __shfl_xor(ss, 16); ss += __shfl_xor(ss, 32);
                    if (tn < 7) {
#pragma unroll
                        for (int ni = 0; ni < 4; ni++)
                            *(u32x2*)(wsp<bf16_t>(p, OFF_UQ) + (long)row * 384 + (tn - 4) * 128 + wn * 64 + ni * 16 + 4 * lq) = pack4bf(acc[mi][ni]);
                        if (lq == 0) wsp<float>(p, OFF_SSQ)[row * 6 + (tn - 4) * 2 + wn] = ss;
                    } else {
#pragma unroll
                        for (int ni = 0; ni < 4; ni++)
                            *(u32x2*)(wsp<bf16_t>(p, OFF_UKV) + (long)row * 256 + (tn - 7) * 128 + wn * 64 + ni * 16 + 4 * lq) = pack4bf(acc[mi][ni]);
                        if (lq == 0) wsp<float>(p, OFF_SSKV)[row * 4 + (tn - 7) * 2 + wn] = ss;
                    }
                } else if (wn == 0) {
                    const float2* rp = wsp<float2>(p, OFF_ROPE) + (long)row * 16 + 4 * lq;
                    f32x4 o1, o2;
#pragma unroll
                    for (int r = 0; r < 4; r++) {
                        const float2 cs = rp[r];
                        const float x1 = acc[mi][0][r], x2 = acc[mi][1][r];
                        o1[r] = x1 * cs.x - x2 * cs.y; o2[r] = x1 * cs.y + x2 * cs.x;
                    }
                    bf16_t* kr = wsp<bf16_t>(p, OFF_KR) + (long)row * 32;
                    *(u32x2*)(kr + 4 * lq) = pack4bf(o1);
                    *(u32x2*)(kr + 16 + 4 * lq) = pack4bf(o2);
                }
            }
        });
      gemm_256x128_stream(N_M, N_U / 8, 0, (int)(gridDim.x >> 3), lds, [&](int it, GemmTile& g) {
            const int tm = it / 16, tn = it % 16;
            g.A = wsp<bf16_t>(p, OFF_MEMB) + (long)tm * 256 * ND; g.lda = ND;
            g.Bt = wsp<bf16_t>(p, OFF_WMKVT) + (long)tn * 128 * ND; g.ldb = ND; g.K = ND;
        }, [&](int it, f32x4 (&acc)[4][4]) {
            const int tm = it / 16, tn = it % 16;
            const float* rm = wsp<float>(p, OFF_RMEM);
#pragma unroll
            for (int mi = 0; mi < 4; mi++) {
                const int row = tm * 256 + wm * 64 + mi * 16 + lr;
                const int b = row >> 8, m = row & 255;
                const float rs = rm[row];
#pragma unroll
                for (int ni = 0; ni < 4; ni++) {
                    const f32x4 v = acc[mi][ni] * rs;
                    const int col = tn * 128 + wn * 64 + ni * 16 + 4 * lq;
                    if (col < 1024) {
                        const int h = col >> 8, d = col & 255;
                        *(u32x2*)(wsp<bf16_t>(p, OFF_KMEM) + ((long)(b * 4 + h) * 256 + m) * 256 + d) = pack4bf(v);
                    } else {
                        const int c2 = col - 1024, h = c2 >> 8, dv = c2 & 255;
                        bf16_t* vt = wsp<bf16_t>(p, OFF_VTMEM) + ((long)(b * 4 + h) * 256 + dv) * 256 + m;
#pragma unroll
                        for (int r = 0; r < 4; r++) vt[r * 256] = (bf16_t)f2bf(v[r]);
                    }
                }
            }
        });
    }
}

template <int MI>
__device__ __forceinline__ void dft_mma(const bf16_t* Ag, int arow0, const char* ximg, int ncol0, f32x4 (&acc)[MI][4]) {
    const int lane = VTID & 63, lq = lane >> 4, lr = lane & 15;
#pragma unroll
    for (int ks = 0; ks < 4; ks++) {
        bf16x8 af[MI], bfr[4];
#pragma unroll
        for (int mi = 0; mi < MI; mi++) af[mi] = *(const bf16x8*)(Ag + (long)(arow0 + mi * 16 + lr) * 128 + ks * 32 + lq * 8);
#pragma unroll
        for (int ni = 0; ni < 4; ni++) {
            const char* bp = ximg + (ks * 32 + lq * 8) * 272 + (ncol0 + ni * 16 + lr) * 2;
#pragma unroll
            for (int j = 0; j < 8; j++) bfr[ni][j] = *(const short*)(bp + j * 272);
        }
#pragma unroll
        for (int mi = 0; mi < MI; mi++)
#pragma unroll
            for (int ni = 0; ni < 4; ni++) acc[mi][ni] = __builtin_amdgcn_mfma_f32_16x16x32_bf16(bfr[ni], af[mi], acc[mi][ni], 0, 0, 0);
    }
}

__device__ __forceinline__ void f2a_item(const Params& p, int it, char* lds) {
    const int tid = VTID, lane = tid & 63, wid = tid >> 6, wm = wid >> 1, wn = wid & 1, lq = lane >> 4, lr = lane & 15;
    const int nc = it & 3, s2 = (it >> 2) & 63, b = it >> 8;
    char* uimg = lds; char* ximg = lds + 17408;
    __syncthreads();
#pragma unroll
    for (int i = 0; i < 4; i++) {
        const int ci = tid + 256 * i, row = ci >> 4, cc = ci & 15;
        *(u32x4*)(uimg + row * 272 + cc * 16) = *(const u32x4*)(wsp<bf16_t>(p, OFF_UF) + ((long)(b * NS + 64 * row + s2)) * 512 + nc * 128 + cc * 8);
    }
    __syncthreads();
    {
        const int g2 = wid >> 1, T = wid & 1;
        f32x4 a1[4][4];
#pragma unroll
        for (int mi = 0; mi < 4; mi++)
#pragma unroll
            for (int ni = 0; ni < 4; ni++) a1[mi][ni] = (f32x4){0.f, 0.f, 0.f, 0.f};
        const bf16_t* t64 = wsp<bf16_t>(p, OFF_T64) + T * 4096;
#pragma unroll
        for (int ks = 0; ks < 2; ks++) {
            bf16x8 af[4], bfr[4];
#pragma unroll
            for (int i = 0; i < 4; i++) {
                af[i] = *(const bf16x8*)(uimg + (i * 16 + lr) * 272 + (g2 * 64 + ks * 32 + lq * 8) * 2);
                bfr[i] = *(const bf16x8*)(t64 + (i * 16 + lr) * 64 + ks * 32 + lq * 8);
            }
#pragma unroll
            for (int mi = 0; mi < 4; mi++)
#pragma unroll
                for (int ni = 0; ni < 4; ni++) a1[mi][ni] = __builtin_amdgcn_mfma_f32_16x16x32_bf16(bfr[ni], af[mi], a1[mi][ni], 0, 0, 0);
        }
#pragma unroll
        for (int mi = 0; mi < 4; mi++)
#pragma unroll
            for (int ni = 0; ni < 4; ni++)
                *(u32x2*)(ximg + (T * 64 + mi * 16 + lr) * 272 + (g2 * 64 + ni * 16 + 4 * lq) * 2) = pack4bf(a1[mi][ni]);
    }
    __syncthreads();
    f32x4 acc[4][4];
#pragma unroll
    for (int mi = 0; mi < 4; mi++)
#pragma unroll
        for (int ni = 0; ni < 4; ni++) acc[mi][ni] = (f32x4){0.f, 0.f, 0.f, 0.f};
    dft_mma<4>(wsp<bf16_t>(p, OFF_M1), wm * 64, ximg, wn * 64, acc);
    const float2* tw = wsp<float2>(p, OFF_TW);
#pragma unroll
    for (int m2 = 0; m2 < 2; m2++) {
        const int k1 = 32 * wm + 16 * m2 + lr;
        float2 cs; { const float rev = (float)((s2 * k1) & 4095) * (1.0f / 4096.0f); cs.x = __builtin_amdgcn_cosf(rev); cs.y = __builtin_amdgcn_sinf(rev); (void)tw; }
        const long base = ((long)(b * 64 + k1) * 64 + s2) * 512 + nc * 128 + wn * 64 + 4 * lq;
#pragma unroll
        for (int ni = 0; ni < 4; ni++) {
            const f32x4 yr = acc[m2][ni], yi = acc[m2 + 2][ni];
            const f32x4 orr = yr * cs.x - yi * cs.y, oi = yi * cs.x + yr * cs.y;
            *(u32x2*)(wsp<bf16_t>(p, OFF_YR) + base + ni * 16) = pack4bf(orr);
            *(u32x2*)(wsp<bf16_t>(p, OFF_YI) + base + ni * 16) = pack4bf(oi);
        }
    }
}

__device__ __forceinline__ void f2b_item(const Params& p, int it, char* lds) {
    const int tid = VTID, lane = tid & 63, wid = tid >> 6, wm = wid >> 1, wn = wid & 1, lq = lane >> 4, lr = lane & 15;
    const int nc = it & 3, k1 = (it >> 2) & 63, b = it >> 8;
    char* ximg = lds; char* zimg = lds + 34816;
    __syncthreads();
#pragma unroll
    for (int i = 0; i < 8; i++) {
        const int ci = tid + 256 * i, row = ci >> 4, cc = ci & 15;
        const bf16_t* src = (row < 64 ? wsp<bf16_t>(p, OFF_YR) : wsp<bf16_t>(p, OFF_YI)) + ((long)(b * 64 + k1) * 64 + (row & 63)) * 512 + nc * 128 + cc * 8;
        *(u32x4*)(ximg + row * 272 + cc * 16) = *(const u32x4*)src;
    }
    __syncthreads();
    f32x4 acc[2][4];
#pragma unroll
    for (int mi = 0; mi < 2; mi++)
#pragma unroll
        for (int ni = 0; ni < 4; ni++) acc[mi][ni] = (f32x4){0.f, 0.f, 0.f, 0.f};
    dft_mma<2>(wsp<bf16_t>(p, OFF_M3), wm * 32, ximg, wn * 64, acc);
#pragma unroll
    for (int mi = 0; mi < 2; mi++)
#pragma unroll
        for (int ni = 0; ni < 4; ni++)
            *(u32x2*)(zimg + (wm * 32 + mi * 16 + lr) * 272 + (wn * 64 + ni * 16 + 4 * lq) * 2) = pack4bf(acc[mi][ni] * (1.0f / 512.0f));
    __syncthreads();
    f32x4 a3[2][4];
#pragma unroll
    for (int mi = 0; mi < 2; mi++)
#pragma unroll
        for (int ni = 0; ni < 4; ni++) a3[mi][ni] = (f32x4){0.f, 0.f, 0.f, 0.f};
    const bf16_t* wft = wsp<bf16_t>(p, OFF_WFT) + (long)(nc * 2 + wn) * 4096;
#pragma unroll
    for (int ks = 0; ks < 2; ks++) {
        bf16x8 af[2], bfr[4];
#pragma unroll
        for (int i = 0; i < 2; i++) af[i] = *(const bf16x8*)(zimg + (wm * 32 + i * 16 + lr) * 272 + (wn * 64 + ks * 32 + lq * 8) * 2);
#pragma unroll
        for (int i = 0; i < 4; i++) bfr[i] = *(const bf16x8*)(wft + (i * 16 + lr) * 64 + ks * 32 + lq * 8);
#pragma unroll
        for (int mi = 0; mi < 2; mi++)
#pragma unroll
            for (int ni = 0; ni < 4; ni++) a3[mi][ni] = __builtin_amdgcn_mfma_f32_16x16x32_bf16(bfr[ni], af[mi], a3[mi][ni], 0, 0, 0);
    }
#pragma unroll
    for (int mi = 0; mi < 2; mi++) {
        const int k2 = wm * 32 + mi * 16 + lr;
        bf16_t* dst = wsp<bf16_t>(p, OFF_ZA) + ((long)(b * NS + k1 + 64 * k2)) * 1024 + nc * 128 + wn * 64 + 4 * lq;
#pragma unroll
        for (int ni = 0; ni < 4; ni++) *(u32x2*)(dst + ni * 16) = pack4bf(a3[mi][ni]);
    }
}

__device__ __forceinline__ void phase2(const Params& p, char* lds) {
    const int tid = threadIdx.x, lane = tid & 63, wid = tid >> 6, wm = wid >> 1, wn = wid & 1, lq = lane >> 4, lr = lane & 15;
    constexpr int N_Q = 64 * 6, N_KV = 64 * 8;
    const int lsa = (int)(gridDim.x >> 3), lsh = lsa >> 1;
    {
      gemm_256x128_stream(N_Q, 0, lsh, lsa - lsh, lds, [&](int item, GemmTile& g) {
            const int tm = item / 6, tn = item % 6;
            g.A = wsp<bf16_t>(p, OFF_UQ) + (long)tm * 256 * 384; g.lda = 384;
            g.Bt = wsp<bf16_t>(p, OFF_WQT) + (long)tn * 128 * 384; g.ldb = 384; g.K = 384;
        }, [&](int item, f32x4 (&acc)[4][4]) {
            const int tm = item / 6, tn = item % 6;
            const float qmul = 0.10206207261596575f * 1.4426950408889634f;
#pragma unroll
            for (int mi = 0; mi < 4; mi++) {
                const int row = tm * 256 + wm * 64 + mi * 16 + lr;
                const int b = row >> 12, s = row & 4095;
                const float* sq = wsp<float>(p, OFF_SSQ) + (long)row * 6;
                const float ss = sq[0] + sq[1] + sq[2] + sq[3] + sq[4] + sq[5];
                const float rs = rsqrtf(ss * (1.f / 384.f) + 1e-6f) * qmul;
                const int cb0 = tn * 128 + wn * 64;
#pragma unroll
                for (int ni = 0; ni < 4; ni++) {
                    const int cb = cb0 + ni * 16, hd = cb / 96, hob = cb % 96;
                    bf16_t* qd = wsp<bf16_t>(p, OFF_Q) + ((long)(b * 8 + hd) * NS + s) * 96;
                    if (hob < 64) {
                        *(u32x2*)(qd + hob + 4 * lq) = pack4bf(acc[mi][ni] * rs);
                    } else if (hob == 64) {
                        if (ni < 3) {
                            const float2* rp = wsp<float2>(p, OFF_ROPE) + (long)row * 16 + 4 * lq;
                            f32x4 o1, o2;
#pragma unroll
                            for (int r = 0; r < 4; r++) {
                                const float2 cs = rp[r];
                                const float x1 = acc[mi][ni][r] * rs, x2 = acc[mi][ni < 3 ? ni + 1 : 3][r] * rs;
                                o1[r] = x1 * cs.x - x2 * cs.y; o2[r] = x1 * cs.y + x2 * cs.x;
                            }
                            *(u32x2*)(qd + 64 + 4 * lq) = pack4bf(o1);
                            *(u32x2*)(qd + 80 + 4 * lq) = pack4bf(o2);
                        }
                    }
                }
            }
        });
      gemm_256x128_stream(N_KV, 0, 0, lsh ? lsh : lsa, lds, [&](int it, GemmTile& g) {
            const int tm = it >> 3, hd = it & 7;
            g.A = wsp<bf16_t>(p, OFF_UKV) + (long)tm * 256 * 256; g.lda = 256;
            g.Bt = wsp<bf16_t>(p, OFF_WKVT) + (long)hd * 128 * 256; g.ldb = 256; g.K = 256;
        }, [&](int it, f32x4 (&acc)[4][4]) {
            const int tm = it >> 3, hd = it & 7;
#pragma unroll
            for (int mi = 0; mi < 4; mi++) {
                const int row = tm * 256 + wm * 64 + mi * 16 + lr;
                const int b = row >> 12, s = row & 4095;
                const float* sq = wsp<float>(p, OFF_SSKV) + (long)row * 4;
                const float rs = rsqrtf((sq[0] + sq[1] + sq[2] + sq[3]) * (1.f / 256.f) + 1e-6f);
                if (wn == 0) {
                    bf16_t* kd = wsp<bf16_t>(p, OFF_K) + ((long)(b * 8 + hd) * NS + s) * 96;
#pragma unroll
                    for (int ni = 0; ni < 4; ni++) *(u32x2*)(kd + ni * 16 + 4 * lq) = pack4bf(acc[mi][ni] * rs);
                } else {
#pragma unroll
                    for (int ni = 0; ni < 4; ni++) {
                        bf16_t* vd = wsp<bf16_t>(p, OFF_VT) + ((long)(b * 8 + hd) * 64 + ni * 16 + 4 * lq) * NS + s;
#pragma unroll
                        for (int r = 0; r < 4; r++) vd[(long)r * NS] = (bf16_t)f2bf(acc[mi][ni][r] * rs);
                    }
                }
            }
#pragma unroll
            for (int i = 0; i < 2; i++) {
                const int ci = tid + 512 * i, r = ci >> 2, cc = ci & 3;
                const int row = tm * 256 + r, b = row >> 12, s = row & 4095;
                *(u32x4*)(wsp<bf16_t>(p, OFF_K) + ((long)(b * 8 + hd) * NS + s) * 96 + 64 + cc * 8) = *(const u32x4*)(wsp<bf16_t>(p, OFF_KR) + (long)row * 32 + cc * 8);
            }
        });
    }
}


__device__ __forceinline__ void phase2_f2a(const Params& p, char* lds) {
    FOR_XCD_ITEMS(it, 1024) { f2a_item(p, it, lds); }
}

__device__ __forceinline__ void expert_tr_job(const Params& p, int j, char* lds) {
    const int which = j >> 11, r = j & 2047, e = r >> 7, t = r & 127;
    const int k0 = (t >> 3) * 64, n0 = (t & 7) * 128;
    if (which == 0) tr_tile(p.w_exp_gate + (long)e * 1048576, 1024, k0, n0, 1024, p.g_ffn, wsp<bf16_t>(p, OFF_WGUT) + (long)e * 2048 * 1024, 1024, 1, lds);
    else if (which == 1) tr_tile(p.w_exp_up + (long)e * 1048576, 1024, k0, n0, 1024, p.g_ffn, wsp<bf16_t>(p, OFF_WGUT) + (long)e * 2048 * 1024, 1024, 2, lds);
    else tr_tile(p.w_exp_down + (long)e * 1048576, 1024, k0, n0, 1024, nullptr, wsp<bf16_t>(p, OFF_WDT) + (long)e * 1048576, 1024, 0, lds);
}

__device__ __forceinline__ void phase3_tr(const Params& p, char* lds) {
    float (*t)[132] = (float (*)[132])lds;
    const int tid = VTID, c4 = tid & 31, r0 = tid >> 5;
    f32x4 v[8]; float gv[8];
    auto issue = [&](int j) {
        const int which = j >> 11, r = j & 2047, e = r >> 7, tt = r & 127;
        const int k0 = (tt >> 3) * 64, n0 = (tt & 7) * 128;
        const float* W = (which == 0 ? p.w_exp_gate : which == 1 ? p.w_exp_up : p.w_exp_down) + (long)e * 1048576;
#pragma unroll
        for (int i = 0; i < 8; i++) {
            const int kk = r0 + 8 * i;
            v[i] = *(const f32x4*)(W + (long)(k0 + kk) * 1024 + n0 + c4 * 4);
            gv[i] = which < 2 ? p.g_ffn[k0 + kk] : 1.f;
        }
    };
    int j = VBLK;
    if (j < 6144) issue(j);
    while (j < 6144) {
        const int which = j >> 11, r = j & 2047, e = r >> 7, tt = r & 127;
        const int k0 = (tt >> 3) * 64, n0 = (tt & 7) * 128;
        __syncthreads();
#pragma unroll
        for (int i = 0; i < 8; i++) *(f32x4*)(&t[r0 + 8 * i][c4 * 4]) = v[i] * gv[i];
        __syncthreads();
        const int jn = j + VGRID;
        if (jn < 6144) issue(jn);
        bf16_t* Wt = which < 2 ? wsp<bf16_t>(p, OFF_WGUT) + (long)e * 2048 * 1024 : wsp<bf16_t>(p, OFF_WDT) + (long)e * 1048576;
#pragma unroll
        for (int i = 0; i < 4; i++) {
            const int ci = tid + 256 * i, nn = ci >> 3, kc = ci & 7;
            const int n = n0 + nn;
            int row = n;
            if (which < 2) row = (n >> 5) * 64 + ((n >> 4) & 1) * 32 + which * 16 + (n & 15);
            u32x4 w;
            w.x = pack2bf(t[kc * 8 + 0][nn], t[kc * 8 + 1][nn]);
            w.y = pack2bf(t[kc * 8 + 2][nn], t[kc * 8 + 3][nn]);
            w.z = pack2bf(t[kc * 8 + 4][nn], t[kc * 8 + 5][nn]);
            w.w = pack2bf(t[kc * 8 + 6][nn], t[kc * 8 + 7][nn]);
            *(u32x4*)(Wt + (long)row * 1024 + k0 + kc * 8) = w;
        }
        j = jn;
    }
}
__device__ __forceinline__ void phase3_f2b(const Params& p, char* lds) {
    FOR_XCD_ITEMS(it, 1024) { f2b_item(p, it, lds); }
}

__device__ __forceinline__ void phase_resid(const Params& p, char* lds, size_t offA, size_t offW, const float* residf, const bf16_t* residb, size_t offXb, size_t offSS) {
    const int tid = VTID, lane = tid & 63, wid = tid >> 6, wm = wid >> 1, wn = wid & 1, lq = lane >> 4, lr = lane & 15;
    FOR_XCD_ITEMS(item, 128 * 8) {
        const int tm = item >> 3, tn = item & 7;
        f32x4 acc[4][4];
        GemmTile g; g.A = wsp<bf16_t>(p, offA) + (long)tm * 128 * ND; g.lda = ND; g.arow = nullptr;
        g.Bt = wsp<bf16_t>(p, offW) + (long)tn * 128 * ND; g.ldb = ND; g.K = ND;
        gemm_tile_128(g, lds, acc);
#pragma unroll
        for (int mi = 0; mi < 4; mi++) {
            const int row = tm * 128 + wm * 64 + mi * 16 + lr;
            float ss = 0.f;
#pragma unroll
            for (int ni = 0; ni < 4; ni++) {
                const long o = (long)row * ND + tn * 128 + wn * 64 + ni * 16 + 4 * lq;
                f32x4 rv;
                if (residf) rv = *(const f32x4*)(residf + o);
                else { const u32x2 w = *(const u32x2*)(residb + o); rv = (f32x4){__uint_as_float(w.x << 16), __uint_as_float(w.x & 0xFFFF0000u), __uint_as_float(w.y << 16), __uint_as_float(w.y & 0xFFFF0000u)}; }
                const f32x4 v = rv + acc[mi][ni];
                *(u32x2*)(wsp<bf16_t>(p, offXb) + o) = pack4bf(v);
                ss += v[0] * v[0] + v[1] * v[1] + v[2] * v[2] + v[3] * v[3];
            }
            ss += __shfl_xor(ss, 16); ss += __shfl_xor(ss, 32);
            if (lq == 0) wsp<float>(p, offSS)[row * 16 + tn * 2 + wn] = ss;
        }
    }
}
__device__ __forceinline__ float row_rs16(const float* ss) {
    const f32x4 a = *(const f32x4*)ss, b = *(const f32x4*)(ss + 4), c = *(const f32x4*)(ss + 8), d = *(const f32x4*)(ss + 12);
    const f32x4 t = (a + b) + (c + d);
    return rsqrtf(((t[0] + t[1]) + (t[2] + t[3])) * (1.f / 1024.f) + 1e-6f);
}

__device__ __forceinline__ void phase5a(const Params& p, char* lds) {
    const int tid = VTID, lane = tid & 63, wid = tid >> 6, wm = wid >> 1, wn = wid & 1, lq = lane >> 4, lr = lane & 15;
    FOR_XCD_ITEMS(item, 128 * 8) {
        const int tm = item >> 3, tn = item & 7;
        f32x4 acc[4][4];
        GemmTile g; g.A = wsp<bf16_t>(p, OFF_X1B) + (long)tm * 128 * ND; g.lda = ND; g.arow = nullptr;
        g.Bt = wsp<bf16_t>(p, OFF_WMQT) + (long)tn * 128 * ND; g.ldb = ND; g.K = ND;
        gemm_tile_128(g, lds, acc);
        const int h = tn >> 1;
#pragma unroll
        for (int mi = 0; mi < 4; mi++) {
            const int row = tm * 128 + wm * 64 + mi * 16 + lr, b = row >> 12, s = row & 4095;
            const float rs = row_rs16(wsp<float>(p, OFF_SS1) + (long)row * 16) * (0.0625f * 1.4426950408889634f);
            bf16_t* qd = wsp<bf16_t>(p, OFF_QM) + ((long)(b * 4 + h) * NS + s) * 256 + (tn & 1) * 128 + wn * 64 + 4 * lq;
#pragma unroll
            for (int ni = 0; ni < 4; ni++) *(u32x2*)(qd + ni * 16) = pack4bf(acc[mi][ni] * rs);
        }
    }
}
__device__ __forceinline__ void phase5b(const Params& p, char* lds) {
    FOR_XCD_ITEMS(item, NB * 4 * 32 * 2) {
        const int dvh = item & 1, qt = (item >> 1) & 31, h = (item >> 6) & 3, b = item >> 8;
        const bf16_t* Qp = wsp<bf16_t>(p, OFF_QM) + ((long)(b * 4 + h) * NS + qt * 128) * 256;
        const bf16_t* Kp = wsp<bf16_t>(p, OFF_KMEM) + ((long)(b * 4 + h) * 256) * 256;
        const bf16_t* Vtp = wsp<bf16_t>(p, OFF_VTMEM) + ((long)(b * 4 + h) * 256 + dvh * 128) * 256;
        bf16_t* Op = wsp<bf16_t>(p, OFF_OM) + ((long)b * NS + qt * 128) * 1024 + h * 256 + dvh * 128;
        attn_block<256, 128, 32, 256>(Qp, Kp, Vtp, 256L, 256, lds, [&](int q, int dv, f32x4 v) { *(u32x2*)(Op + (long)q * 1024 + dv) = pack4bf(v); });
    }
}

__device__ __forceinline__ void phase7(const Params& p, char* lds) {
    const int tid = threadIdx.x, lane = tid & 63, wid = tid >> 6, lq = lane >> 4, lr = lane & 15;
    __syncthreads();
    {
        f32x4 w0[4], w1[4];
#pragma unroll
        for (int it = 0; it < 4; it++) {
            const int u = tid + 512 * it, kp = u >> 2, eq = u & 3;
            w0[it] = *(const f32x4*)(p.w_router + (size_t)(2 * kp) * 16 + eq * 4);
            w1[it] = *(const f32x4*)(p.w_router + (size_t)(2 * kp + 1) * 16 + eq * 4);
        }
#pragma unroll
        for (int it = 0; it < 4; it++) {
            const int u = tid + 512 * it, kp = u >> 2, eq = u & 3, k = 2 * kp;
            const float g0 = p.g_ffn[k], g1 = p.g_ffn[k + 1];
#pragma unroll
            for (int j = 0; j < 4; j++) {
                const int e = eq * 4 + j;
                const float a0 = w0[it][j] * g0, a1 = w1[it][j] * g1;
                const unsigned h0 = f2bf(a0), h1 = f2bf(a1);
                const float r0 = a0 - __uint_as_float(h0 << 16), r1 = a1 - __uint_as_float(h1 << 16);
                const unsigned l0 = f2bf(r0), l1 = f2bf(r1);
                const int off = e * 2048 + ((((k >> 3) ^ e) & 127) << 4) + (k & 7) * 2;
                *(unsigned*)(lds + off) = h0 | (h1 << 16);
                *(unsigned*)(lds + 32768 + off) = l0 | (l1 << 16);
            }
        }
    }
    __syncthreads();
    for (int g = wid * (int)gridDim.x + (int)blockIdx.x; g < NT / 16; g += 8 * (int)gridDim.x) {
        const int t0 = g * 16;
        const bf16_t* xr = wsp<bf16_t>(p, OFF_X2B) + (long)(t0 + lr) * ND + lq * 8;
        bf16x8 xa[32];
#pragma unroll
        for (int ks = 0; ks < 32; ks++) xa[ks] = *(const bf16x8*)(xr + ks * 32);
        const float rsv = row_rs16(wsp<float>(p, OFF_SS2) + (long)(t0 + lr) * 16);
        if (lane < 16) wsp<float>(p, OFF_RS2)[t0 + lane] = rsv;
        f32x4 acc = (f32x4){0.f, 0.f, 0.f, 0.f};
#pragma unroll
        for (int ks = 0; ks < 32; ks++) {
            const int off = lr * 2048 + ((((ks * 4 + lq) ^ lr) & 127) << 4);
            const bf16x8 bh = *(const bf16x8*)(lds + off), bl = *(const bf16x8*)(lds + 32768 + off);
            acc = __builtin_amdgcn_mfma_f32_16x16x32_bf16(xa[ks], bh, acc, 0, 0, 0);
            acc = __builtin_amdgcn_mfma_f32_16x16x32_bf16(xa[ks], bl, acc, 0, 0, 0);
            if ((ks & 3) == 3) asm volatile("" ::: "memory");
        }
        f32x4 af4;
#pragma unroll
        for (int r = 0; r < 4; r++) {
            const float lg = acc[r] * __shfl(rsv, lq * 4 + r);
            float mx = lg;
#pragma unroll
            for (int o = 1; o < 16; o <<= 1) mx = fmaxf(mx, __shfl_xor(mx, o));
            const float ex = expf(lg - mx);
            float sm = ex;
#pragma unroll
            for (int o = 1; o < 16; o <<= 1) sm += __shfl_xor(sm, o);
            af4[r] = ex / sm;
        }
        {
            const int tk = t0 + lq * 4, bb = tk >> 12, ss = tk & 4095;
            *(f32x4*)(wsp<float>(p, OFF_AFF) + ((long)(bb * NE + lr) * NS + ss)) = af4;
        }
    }
}

__device__ __forceinline__ int block_sum_i(int v, int* red) {
    const int lane = VTID & 63, wid = VTID >> 6;
#pragma unroll
    for (int o = 32; o > 0; o >>= 1) v += __shfl_xor(v, o);
    __syncthreads();
    if (lane == 0) red[wid] = v;
    __syncthreads();
    return red[0] + red[1] + red[2] + red[3];
}
__device__ __forceinline__ int block_excl_scan_i(int v, int* red, int& total) {
    const int lane = VTID & 63, wid = VTID >> 6;
    int inc = v;
#pragma unroll
    for (int o = 1; o < 64; o <<= 1) { const int t = __shfl_up(inc, o); if (lane >= o) inc += t; }
    __syncthreads();
    if (lane == 63) red[wid] = inc;
    __syncthreads();
    int base = 0;
#pragma unroll
    for (int w = 0; w < 4; w++) if (w < wid) base += red[w];
    total = red[0] + red[1] + red[2] + red[3];
    return base + inc - v;
}
__device__ __forceinline__ void phase8(const Params& p, char* lds) {
    int* red = (int*)lds;
    const int tid = threadIdx.x, lane = tid & 63, wid = tid >> 6;
    for (int item = blockIdx.x; item < NB * NE; item += gridDim.x) {
        const int e = item & 15, b = item >> 4;
        const unsigned* aff = (const unsigned*)(wsp<float>(p, OFF_AFF) + (long)(b * NE + e) * NS) + tid * 8;
        unsigned v[8];
        { const u32x4 v0 = *(const u32x4*)aff, v1 = *(const u32x4*)(aff + 4);
          v[0] = v0.x; v[1] = v0.y; v[2] = v0.z; v[3] = v0.w; v[4] = v1.x; v[5] = v1.y; v[6] = v1.z; v[7] = v1.w; }
        const float* rs2p = wsp<float>(p, OFF_RS2) + (long)b * NS + tid * 8;
        const f32x4 rsa = *(const f32x4*)rs2p, rsb = *(const f32x4*)(rs2p + 4);
        __syncthreads();
        unsigned T = 0;
        for (int bit = 30; bit >= 0; bit--) {
            const unsigned cand = T | (1u << bit);
            int c = 0;
#pragma unroll
            for (int i = 0; i < 8; i++) c += __popcll(__ballot(v[i] >= cand));
            int* rb = red + (bit & 1) * 8;
            if (lane == 0) rb[wid] = c;
            __syncthreads();
            const i32x4 s0 = *(const i32x4*)rb, s1 = *(const i32x4*)(rb + 4);
            const int tot = (s0.x + s0.y) + (s0.z + s0.w) + (s1.x + s1.y) + (s1.z + s1.w);
            if (tot >= CAP) T = cand;
        }
        int cg = 0, ce = 0;
#pragma unroll
        for (int i = 0; i < 8; i++) { cg += (v[i] > T) ? 1 : 0; ce += (v[i] == T) ? 1 : 0; }
        const int pv = cg | (ce << 16);
        int inc = pv;
#pragma unroll
        for (int o = 1; o < 64; o <<= 1) { const int t = __shfl_up(inc, o); if (lane >= o) inc += t; }
        if (lane == 63) red[16 + wid] = inc;
        __syncthreads();
        int base = 0, tot = 0;
#pragma unroll
        for (int w = 0; w < 8; w++) { const int x = red[16 + w]; if (w < wid) base += x; tot += x; }
        const int pk = base + inc - pv;
        const int need = CAP - (tot & 0xFFFF);
        const int pg = pk & 0xFFFF;
        int eqs = pk >> 16;
        int slot = pg + (eqs < need ? eqs : need);
        int* slots = wsp<int>(p, OFF_SLOTS) + (long)(b * NE + e) * NS + tid * 8;
        int* idx = wsp<int>(p, OFF_IDX) + (long)(b * NE + e) * CAP;
        float* gate = wsp<float>(p, OFF_GATE) + (long)(b * NE + e) * CAP;
        float* rss = wsp<float>(p, OFF_RSS) + (long)(b * NE + e) * CAP;
        int so[8];
#pragma unroll
        for (int i = 0; i < 8; i++) {
            const int t = tid * 8 + i;
            bool sel = v[i] > T;
            if (v[i] == T) { sel = eqs < need; eqs++; }
            so[i] = -1;
            if (sel) { so[i] = slot; idx[slot] = b * NS + t; gate[slot] = __uint_as_float(v[i]); rss[slot] = i < 4 ? rsa[i & 3] : rsb[i & 3]; slot++; }
        }
        *(i32x4*)slots = (i32x4){so[0], so[1], so[2], so[3]};
        *(i32x4*)(slots + 4) = (i32x4){so[4], so[5], so[6], so[7]};
    }
}

__device__ __forceinline__ void phase9(const Params& p, char* lds) {
    const int tid = VTID, lane = tid & 63, wid = tid >> 6, wm = wid >> 1, wn = wid & 1, lq = lane >> 4, lr = lane & 15;
    FOR_XCD_ITEMS(item, NE * 16 * NB * 4) {
        const int rt = item & 3, b = (item >> 2) & 3, ct = (item >> 4) & 15, e = item >> 8;
        const int* arow = wsp<int>(p, OFF_IDX) + (long)(b * NE + e) * CAP + rt * 128;
        f32x4 acc[4][4];
        GemmTile g; g.A = wsp<bf16_t>(p, OFF_X2B); g.lda = ND; g.arow = arow;
        g.Bt = wsp<bf16_t>(p, OFF_WGUT) + ((long)e * 2048 + ct * 128) * ND; g.ldb = ND; g.K = ND;
        gemm_tile_128(g, lds, acc);
#pragma unroll
        for (int mi = 0; mi < 4; mi++) {
            const int r = wm * 64 + mi * 16 + lr;
            const int tok = arow[r];
            const float rs = row_rs16(wsp<float>(p, OFF_SS2) + (long)tok * 16);
            bf16_t* ad = wsp<bf16_t>(p, OFF_ACT) + ((long)(e * NB + b) * CAP + rt * 128 + r) * ND + ct * 64 + wn * 32 + 4 * lq;
#pragma unroll
            for (int pp = 0; pp < 2; pp++) {
                f32x4 o;
#pragma unroll
                for (int q = 0; q < 4; q++) {
                    const float ga = acc[mi][2 * pp][q] * rs, up = acc[mi][2 * pp + 1][q] * rs;
                    o[q] = ga / (1.f + __expf(-ga)) * up;
                }
                *(u32x2*)(ad + pp * 16) = pack4bf(o);
            }
        }
    }
}
__device__ __forceinline__ void phase10(const Params& p, char* lds) {
    const int tid = VTID, lane = tid & 63, wid = tid >> 6, wm = wid >> 1, wn = wid & 1, lq = lane >> 4, lr = lane & 15;
    FOR_XCD_ITEMS(item, NE * 8 * NB * 4) {
        const int rt = item & 3, b = (item >> 2) & 3, ct = (item >> 4) & 7, e = item >> 7;
        const long row0 = (long)(e * NB + b) * CAP + rt * 128;
        f32x4 acc[4][4];
        GemmTile g; g.A = wsp<bf16_t>(p, OFF_ACT) + row0 * ND; g.lda = ND; g.arow = nullptr;
        g.Bt = wsp<bf16_t>(p, OFF_WDT) + ((long)e * 1024 + ct * 128) * ND; g.ldb = ND; g.K = ND;
        gemm_tile_128(g, lds, acc);
        const float* gate = wsp<float>(p, OFF_GATE) + (long)(b * NE + e) * CAP + rt * 128;
#pragma unroll
        for (int mi = 0; mi < 4; mi++) {
            const int r = wm * 64 + mi * 16 + lr;
            const float gv = gate[r];
            bf16_t* yd = wsp<bf16_t>(p, OFF_Y) + (row0 + r) * ND + ct * 128 + wn * 64 + 4 * lq;
#pragma unroll
            for (int ni = 0; ni < 4; ni++) *(u32x2*)(yd + ni * 16) = pack4bf(acc[mi][ni] * gv);
        }
    }
}

__device__ __forceinline__ void phase11(const Params& p, char* lds) {
    const int tid = VTID, lane = tid & 63, wid = tid >> 6;
    const int* slots = wsp<int>(p, OFF_SLOTS);
    auto slot_of = [&](int tok) { const int b = tok >> 12, t = tok & 4095; return slots[(long)(b * NE + (lane & 15)) * NS + t]; };
    int tok = VBLK * 4 + wid;
    int sl_next = tok < NT ? slot_of(tok) : -1;
    u32x2 xn[4];
#pragma unroll
    for (int i = 0; i < 4; i++) xn[i] = *(const u32x2*)(wsp<bf16_t>(p, OFF_X2B) + (long)(tok < NT ? tok : 0) * ND + i * 256 + lane * 4);
    for (; tok < NT; tok += VGRID * 4) {
        const int b = tok >> 12;
        float* xr = p.out + (long)tok * ND;
        const int slv = sl_next;
        f32x4 v[4];
#pragma unroll
        for (int i = 0; i < 4; i++)
            v[i] = (f32x4){__uint_as_float(xn[i].x << 16), __uint_as_float(xn[i].x & 0xFFFF0000u), __uint_as_float(xn[i].y << 16), __uint_as_float(xn[i].y & 0xFFFF0000u)};
        {
            const int tn = tok + VGRID * 4;
            sl_next = tn < NT ? slot_of(tn) : -1;
#pragma unroll
            for (int i = 0; i < 4; i++) xn[i] = *(const u32x2*)(wsp<bf16_t>(p, OFF_X2B) + (long)(tn < NT ? tn : tok) * ND + i * 256 + lane * 4);
        }
        unsigned long long sel = __ballot(slv >= 0) & 0xFFFFull;
        while (sel) {
            const int e = __builtin_ctzll(sel); sel &= sel - 1;
            const int sl = __builtin_amdgcn_readlane(slv, e);
            const bf16_t* yr = wsp<bf16_t>(p, OFF_Y) + ((long)(e * NB + b) * CAP + sl) * ND;
#pragma unroll
            for (int i = 0; i < 4; i++) {
                const u32x2 w = *(const u32x2*)(yr + i * 256 + lane * 4);
                v[i][0] += __uint_as_float(w.x << 16); v[i][1] += __uint_as_float(w.x & 0xFFFF0000u);
                v[i][2] += __uint_as_float(w.y << 16); v[i][3] += __uint_as_float(w.y & 0xFFFF0000u);
            }
        }
        float ss = 0.f;
#pragma unroll
        for (int i = 0; i < 4; i++) ss += v[i][0] * v[i][0] + v[i][1] * v[i][1] + v[i][2] * v[i][2] + v[i][3] * v[i][3];
        ss = wave_sum(ss);
        const float rs = rsqrtf(ss * (1.f / ND) + 1e-6f);
#pragma unroll
        for (int i = 0; i < 4; i++) {
            const f32x4 gf = *(const f32x4*)(p.g_final + i * 256 + lane * 4);
            *(f32x4*)(xr + i * 256 + lane * 4) = v[i] * rs * gf;
        }
    }
}


__device__ __forceinline__ void phase_resid8(const Params& p, char* lds, size_t offA, size_t offW, const float* residf, const bf16_t* residb, size_t offXb, size_t offSS) {
    const int tid = threadIdx.x, lane = tid & 63, wid = tid >> 6, wm = wid >> 2, wn = wid & 3, lq = lane >> 4, lr = lane & 15;
    FOR_XCD_ITEMS_R(item, 64 * 4) {
        const int tm = item >> 2, tn = item & 3;
        f32x4 acc[8][4];
        GemmTile g; g.A = wsp<bf16_t>(p, offA) + (long)tm * 256 * ND; g.lda = ND; g.arow = nullptr;
        g.Bt = wsp<bf16_t>(p, offW) + (long)tn * 256 * ND; g.ldb = ND; g.K = ND;
        gemm_tile_256sq(g, lds, acc);
#pragma unroll
        for (int mi = 0; mi < 8; mi++) {
            const int row = tm * 256 + wm * 128 + mi * 16 + lr;
            float ss = 0.f;
#pragma unroll
            for (int ni = 0; ni < 4; ni++) {
                const long o = (long)row * ND + tn * 256 + wn * 64 + ni * 16 + 4 * lq;
                f32x4 rv;
                if (residf) rv = *(const f32x4*)(residf + o);
                else { const u32x2 w = *(const u32x2*)(residb + o); rv = (f32x4){__uint_as_float(w.x << 16), __uint_as_float(w.x & 0xFFFF0000u), __uint_as_float(w.y << 16), __uint_as_float(w.y & 0xFFFF0000u)}; }
                const f32x4 v = rv + acc[mi][ni];
                *(u32x2*)(wsp<bf16_t>(p, offXb) + o) = pack4bf(v);
                ss += v[0] * v[0] + v[1] * v[1] + v[2] * v[2] + v[3] * v[3];
            }
            ss += __shfl_xor(ss, 16); ss += __shfl_xor(ss, 32);
            if (lq == 0) wsp<float>(p, offSS)[row * 16 + tn * 4 + wn] = ss;
        }
    }
}
__device__ __forceinline__ void phase5a8(const Params& p, char* lds) {
    const int tid = threadIdx.x, lane = tid & 63, wid = tid >> 6, wm = wid >> 2, wn = wid & 3, lq = lane >> 4, lr = lane & 15;
    FOR_XCD_ITEMS_R(item, 64 * 4) {
        const int tm = item >> 2, tn = item & 3;
        f32x4 acc[8][4];
        GemmTile g; g.A = wsp<bf16_t>(p, OFF_X1B) + (long)tm * 256 * ND; g.lda = ND; g.arow = nullptr;
        g.Bt = wsp<bf16_t>(p, OFF_WMQT) + (long)tn * 256 * ND; g.ldb = ND; g.K = ND;
        gemm_tile_256sq(g, lds, acc);
#pragma unroll
        for (int mi = 0; mi < 8; mi++) {
            const int row = tm * 256 + wm * 128 + mi * 16 + lr, b = row >> 12, s = row & 4095;
            const float rs = row_rs16(wsp<float>(p, OFF_SS1) + (long)row * 16) * (0.0625f * 1.4426950408889634f);
            bf16_t* qd = wsp<bf16_t>(p, OFF_QM) + ((long)(b * 4 + tn) * NS + s) * 256 + wn * 64 + 4 * lq;
#pragma unroll
            for (int ni = 0; ni < 4; ni++) *(u32x2*)(qd + ni * 16) = pack4bf(acc[mi][ni] * rs);
        }
    }
}


template <class Epi>
__device__ __forceinline__ void gemm_256sq_multi(const bf16_t* A, int lda, const int* arow, const bf16_t* Bt, int ldb, long bstep,
                                                 int K, int ntile, char* lds, Epi epi) {
    const int tid = threadIdx.x, lane = tid & 63, wid = tid >> 6, wm = wid >> 2, wn = wid & 3;
    const int lrow = lane >> 3, pc = lane & 7;
    const char* Ab = (const char*)A; const char* Bb = (const char*)Bt;
    unsigned ao[4], bo[4];
#pragma unroll
    for (int i = 0; i < 4; i++) {
        const int r = (wid * 4 + i) * 8 + lrow;
        const int c = pc ^ ((r >> 1) & 7);
        ao[i] = (unsigned)((arow ? arow[r] : r) * lda + c * 8) * 2u;
        bo[i] = (unsigned)(r * ldb + c * 8) * 2u;
    }
    const int nk = K >> 6;
    auto stage = [&](int kt, long boff, char* st) {
        const char* a0 = Ab + kt * 128;
        const char* b0 = Bb + boff * 2 + kt * 128;
#pragma unroll
        for (int i = 0; i < 4; i++) {
            __builtin_amdgcn_global_load_lds((const unsigned*)(a0 + ao[i]), (unsigned*)(st + (wid * 4 + i) * 1024), 16, 0, 0);
            __builtin_amdgcn_global_load_lds((const unsigned*)(b0 + bo[i]), (unsigned*)(st + 32768 + (wid * 4 + i) * 1024), 16, 0, 0);
        }
    };
    f32x4 acc[8][4];
    __syncthreads();
    stage(0, 0, lds);
    asm volatile("s_waitcnt vmcnt(0)" ::: "memory");
    __syncthreads();
    int q = 0;
    for (int t = 0; t < ntile; t++) {
#pragma unroll
        for (int mi = 0; mi < 8; mi++)
#pragma unroll
            for (int ni = 0; ni < 4; ni++) acc[mi][ni] = (f32x4){0.f, 0.f, 0.f, 0.f};
        const long boff = (long)t * bstep;
        for (int kt = 0; kt < nk; kt++, q++) {
            char* cur = lds + (q & 1) * 65536;
            char* nxt = lds + ((q + 1) & 1) * 65536;
            if (kt + 1 < nk) stage(kt + 1, boff, nxt);
            else if (t + 1 < ntile) stage(0, boff + bstep, nxt);
#pragma unroll
            for (int ks = 0; ks < 2; ks++) {
                bf16x8 af[8], bfr[4];
#pragma unroll
                for (int i = 0; i < 8; i++) af[i] = *(const bf16x8*)(cur + tile_off(wm * 128 + i * 16 + (lane & 15), ks * 4 + (lane >> 4)));
#pragma unroll
                for (int i = 0; i < 4; i++) bfr[i] = *(const bf16x8*)(cur + 32768 + tile_off(wn * 64 + i * 16 + (lane & 15), ks * 4 + (lane >> 4)));
                __builtin_amdgcn_s_setprio(1);
#pragma unroll
                for (int mi = 0; mi < 8; mi++)
#pragma unroll
                    for (int ni = 0; ni < 4; ni++)
                        acc[mi][ni] = __builtin_amdgcn_mfma_f32_16x16x32_bf16(bfr[ni], af[mi], acc[mi][ni], 0, 0, 0);
                __builtin_amdgcn_s_setprio(0);
            }
            asm volatile("s_waitcnt vmcnt(0)" ::: "memory");
            __syncthreads();
        }
        epi(t, acc);
    }
}
__device__ __forceinline__ void phase9_8(const Params& p, char* lds) {
    const int tid = threadIdx.x, lane = tid & 63, wid = tid >> 6, wm = wid >> 2, wn = wid & 3, lq = lane >> 4, lr = lane & 15;
    FOR_XCD_ITEMS_R(si, NE * NB * 2 * 2) {
        const int cth = si & 1, rt = (si >> 1) & 1, b = (si >> 2) & 3, e = si >> 4;
        const int* arow = wsp<int>(p, OFF_IDX) + (long)(b * NE + e) * CAP + rt * 256;
        const float* rss = wsp<float>(p, OFF_RSS) + (long)(b * NE + e) * CAP + rt * 256;
        gemm_256sq_multi(wsp<bf16_t>(p, OFF_X2B), ND, arow, wsp<bf16_t>(p, OFF_WGUT) + ((long)e * 2048 + cth * 1024) * ND, ND, 256L * ND,
                         ND, 4, lds, [&](int t, f32x4 (&acc)[8][4]) {
            const int ct = cth * 4 + t;
            char* adb = (char*)(wsp<bf16_t>(p, OFF_ACT) + ((long)(e * NB + b) * CAP + rt * 256) * ND + ct * 128);
            const unsigned ado = (unsigned)((wm * 128 + lr) * ND + wn * 32 + 4 * lq) * 2u;
#pragma unroll
            for (int mi = 0; mi < 8; mi++) {
                const float rs = rss[wm * 128 + mi * 16 + lr];
#pragma unroll
                for (int pp = 0; pp < 2; pp++) {
                    f32x4 o;
#pragma unroll
                    for (int q = 0; q < 4; q++) {
                        const float ga = acc[mi][2 * pp][q] * rs, up = acc[mi][2 * pp + 1][q] * rs;
                        o[q] = ga / (1.f + __expf(-ga)) * up;
                    }
                    *(u32x2*)(adb + (ado + (unsigned)(mi * 16 * ND * 2 + pp * 32))) = pack4bf(o);
                }
            }
        });
    }
}
__device__ __forceinline__ void phase10_8(const Params& p, char* lds) {
    const int tid = threadIdx.x, lane = tid & 63, wid = tid >> 6, wm = wid >> 2, wn = wid & 3, lq = lane >> 4, lr = lane & 15;
    FOR_XCD_ITEMS_R(si, NE * NB * 2 * 2) {
        const int cth = si & 1, rt = (si >> 1) & 1, b = (si >> 2) & 3, e = si >> 4;
        const long row0 = (long)(e * NB + b) * CAP + rt * 256;
        const float* gate = wsp<float>(p, OFF_GATE) + (long)(b * NE + e) * CAP + rt * 256;
        gemm_256sq_multi(wsp<bf16_t>(p, OFF_ACT) + row0 * ND, ND, nullptr, wsp<bf16_t>(p, OFF_WDT) + ((long)e * 1024 + cth * 512) * ND, ND, 256L * ND,
                         ND, 2, lds, [&](int t, f32x4 (&acc)[8][4]) {
            const int ct = cth * 2 + t;
            char* yb = (char*)(wsp<bf16_t>(p, OFF_Y) + row0 * ND + ct * 256);
            const unsigned yo = (unsigned)((wm * 128 + lr) * ND + wn * 64 + 4 * lq) * 2u;
#pragma unroll
            for (int mi = 0; mi < 8; mi++) {
                const float gv = gate[wm * 128 + mi * 16 + lr];
#pragma unroll
                for (int ni = 0; ni < 4; ni++) *(u32x2*)(yb + (yo + (unsigned)(mi * 16 * ND * 2 + ni * 32))) = pack4bf(acc[mi][ni] * gv);
            }
        });
    }
}


__device__ __forceinline__ void phase1_big(const Params& p, char* lds) {
    const int tid = threadIdx.x, lane = tid & 63, wid = tid >> 6, wm = wid >> 2, wn = wid & 3, lq = lane >> 4, lr = lane & 15;
    FOR_XCD_ITEMS_R(item, 64 * 4) {
        const int tm = item >> 2, tn = item & 3;
        f32x4 acc[8][4];
        GemmTile g; g.A = wsp<bf16_t>(p, OFF_XB) + (long)tm * 256 * ND; g.lda = ND; g.arow = nullptr;
        g.Bt = wsp<bf16_t>(p, OFF_W1T) + (long)tn * 256 * ND; g.ldb = ND; g.K = ND;
        gemm_tile_256sq(g, lds, acc);
        const float* r0 = wsp<float>(p, OFF_R0);
        const int col0 = tn * 256 + wn * 64;
#pragma unroll
        for (int mi = 0; mi < 8; mi++) {
            const int row = tm * 256 + wm * 128 + mi * 16 + lr;
            const float rs = r0[row];
#pragma unroll
            for (int ni = 0; ni < 4; ni++) acc[mi][ni] *= rs;
            if (col0 < 512) {
#pragma unroll
                for (int ni = 0; ni < 4; ni++)
                    *(u32x2*)(wsp<bf16_t>(p, OFF_UF) + (long)row * 512 + col0 + ni * 16 + 4 * lq) = pack4bf(acc[mi][ni]);
            } else {
                float ss = 0.f;
#pragma unroll
                for (int ni = 0; ni < 4; ni++) { const f32x4 v = acc[mi][ni]; ss += v[0] * v[0] + v[1] * v[1] + v[2] * v[2] + v[3] * v[3]; }
                ss += __shfl_xor(ss, 16); ss += __shfl_xor(ss, 32);
                if (col0 < 896) {
#pragma unroll
                    for (int ni = 0; ni < 4; ni++)
                        *(u32x2*)(wsp<bf16_t>(p, OFF_UQ) + (long)row * 384 + (col0 - 512) + ni * 16 + 4 * lq) = pack4bf(acc[mi][ni]);
                    if (lq == 0) wsp<float>(p, OFF_SSQ)[row * 6 + ((col0 - 512) >> 6)] = ss;
                } else {
#pragma unroll
                    for (int ni = 0; ni < 4; ni++)
                        *(u32x2*)(wsp<bf16_t>(p, OFF_UKV) + (long)row * 256 + (col0 - 896) + ni * 16 + 4 * lq) = pack4bf(acc[mi][ni]);
                    if (lq == 0) wsp<float>(p, OFF_SSKV)[row * 4 + ((col0 - 896) >> 6)] = ss;
                }
            }
        }
    }
}


__device__ __forceinline__ void phase3_attn8(const Params& p, char* lds) {
    FOR_XCD_ITEMS_R(item, NB * 8 * (NS / 256)) {
        const int qt = item & 15, h = (item >> 4) & 7, b = item >> 7;
        const bf16_t* Qp = wsp<bf16_t>(p, OFF_Q) + ((long)(b * 8 + h) * NS + qt * 256) * 96;
        const bf16_t* Kp = wsp<bf16_t>(p, OFF_K) + ((long)(b * 8 + h) * NS) * 96;
        const bf16_t* Vtp = wsp<bf16_t>(p, OFF_VT) + ((long)(b * 8 + h) * 64) * NS;
        bf16_t* Op = wsp<bf16_t>(p, OFF_ZA) + ((long)b * NS + qt * 256) * 1024 + 512 + h * 64;
        attn_block<96, 64, 128, 512>(Qp, Kp, Vtp, (long)NS, NS, lds, [&](int q, int dv, f32x4 v) { *(u32x2*)(Op + (long)q * 1024 + dv) = pack4bf(v); });
    }
}
__device__ __forceinline__ void phase5b_8(const Params& p, char* lds) {
    FOR_XCD_ITEMS_R(item, NB * 4 * 16 * 2) {
        const int dvh = item & 1, qt = (item >> 1) & 15, h = (item >> 5) & 3, b = item >> 7;
        const bf16_t* Qp = wsp<bf16_t>(p, OFF_QM) + ((long)(b * 4 + h) * NS + qt * 256) * 256;
        const bf16_t* Kp = wsp<bf16_t>(p, OFF_KMEM) + ((long)(b * 4 + h) * 256) * 256;
        const bf16_t* Vtp = wsp<bf16_t>(p, OFF_VTMEM) + ((long)(b * 4 + h) * 256 + dvh * 128) * 256;
        bf16_t* Op = wsp<bf16_t>(p, OFF_OM) + ((long)b * NS + qt * 256) * 1024 + h * 256 + dvh * 128;
        attn_block<256, 128, 32, 512>(Qp, Kp, Vtp, 256L, 256, lds, [&](int q, int dv, f32x4 v) { *(u32x2*)(Op + (long)q * 1024 + dv) = pack4bf(v); });
    }
}

__global__ void __launch_bounds__(512, 1) k_fwd(Params p, int ph_lo, int ph_hi) {
    extern __shared__ __attribute__((aligned(16))) char lds_all[];
    char* lds = lds_all + VHALF * LDS_HALF;
    volatile LAS unsigned* st = (volatile LAS unsigned*)(lds_all + LDS_MAIN);
    if (threadIdx.x == 0) { st[0] = 0u; st[1] = 0u; }
    __syncthreads();
    XcdBarrier bar = xcd_barrier_post(wsp<unsigned>(p, OFF_BAR), st);
#if USE_CG_SYNC
#define GRID_BARRIER() do { asm volatile("s_waitcnt vmcnt(0)" ::: "memory"); __syncthreads(); cg::this_grid().sync(); asm volatile("s_waitcnt vmcnt(0)" ::: "memory"); __syncthreads(); } while (0)
#else
#define GRID_BARRIER() xcd_barrier(bar)
#endif
#define RUN_PHASE(k, call) if (ph_lo <= (k) && (k) < ph_hi) { if ((k) > ph_lo) { GRID_BARRIER(); } call; }
    RUN_PHASE(0, phase0(p, lds))
    RUN_PHASE(1, (phase1_big(p, lds_all), phase1(p, lds_all)))
    RUN_PHASE(2, (phase2(p, lds_all), phase2_f2a(p, lds)))
    RUN_PHASE(3, ((blockIdx.x & 1) ? phase3_tr(p, lds) : (void)0, phase3_attn8(p, lds_all), phase3_f2b(p, lds), (blockIdx.x & 1) ? (void)0 : phase3_tr(p, lds)))
    RUN_PHASE(4, phase_resid8(p, lds_all, OFF_ZA, OFF_WOUTT, p.x, nullptr, OFF_X1B, OFF_SS1))
    RUN_PHASE(5, phase5a8(p, lds_all))
    RUN_PHASE(6, phase5b_8(p, lds_all))
    RUN_PHASE(7, phase_resid8(p, lds_all, OFF_OM, OFF_WMOT, nullptr, wsp<bf16_t>(p, OFF_X1B), OFF_X2B, OFF_SS2))
    RUN_PHASE(8, phase7(p, lds_all))
    RUN_PHASE(9, phase8(p, lds_all))
    RUN_PHASE(10, phase9_8(p, lds_all))
    RUN_PHASE(11, phase10_8(p, lds_all))
    RUN_PHASE(12, phase11(p, lds))
}

extern "C" void kernel_launch(void* const* d_in, const int* in_sizes, int n_in,
                              void* d_out, int out_size, void* d_ws, size_t ws_size,
                              hipStream_t stream) {
    static int grid = 0;
    if (grid == 0) {
        if (n_in != 22 || ws_size < WS_END) { fprintf(stderr, "kernel_launch: unexpected inputs (n_in %d, ws %zu < %zu)\n", n_in, ws_size, (size_t)WS_END); grid = -1; return; }
        int dev = 0, cus = 0, per_cu = 0;
        (void)hipGetDevice(&dev);
        (void)hipDeviceGetAttribute(&cus, hipDeviceAttributeMultiprocessorCount, dev);
        if (hipFuncSetAttribute((const void*)k_fwd, hipFuncAttributeMaxDynamicSharedMemorySize, LDS_TOTAL) != hipSuccess) { fprintf(stderr, "kernel_launch: hipFuncSetAttribute failed\n"); grid = -1; return; }
        if (hipOccupancyMaxActiveBlocksPerMultiprocessor(&per_cu, (const void*)k_fwd, 512, LDS_TOTAL) != hipSuccess || per_cu < 1) { fprintf(stderr, "kernel_launch: occupancy query failed (%d)\n", per_cu); (void)hipGetLastError(); per_cu = 1; }
        if (per_cu > 1) per_cu = 1;
        grid = (cus * per_cu) & ~7;
        if (grid < 8) { fprintf(stderr, "kernel_launch: unexpected device (%d CUs)\n", cus); grid = -1; return; }
        fprintf(stderr, "kernel_launch: %d CUs x %d blocks\n", cus, per_cu);
    }
    if (grid < 0) return;
    Params p{};
    p.x = (const float*)d_in[0]; p.mem = (const float*)d_in[1]; p.pos = (const int*)d_in[2];
    p.g_mix = (const float*)d_in[3]; p.w_in = (const float*)d_in[4]; p.g_q_lat = (const float*)d_in[5]; p.w_q_up = (const float*)d_in[6];
    p.g_kv_lat = (const float*)d_in[7]; p.w_kv_up = (const float*)d_in[8]; p.w_fourier = (const float*)d_in[9]; p.w_out = (const float*)d_in[10];
    p.g_mem_q = (const float*)d_in[11]; p.g_mem_kv = (const float*)d_in[12]; p.w_mem_q = (const float*)d_in[13]; p.w_mem_kv = (const float*)d_in[14];
    p.w_mem_o = (const float*)d_in[15]; p.g_ffn = (const float*)d_in[16]; p.w_router = (const float*)d_in[17];
    p.w_exp_gate = (const float*)d_in[18]; p.w_exp_up = (const float*)d_in[19]; p.w_exp_down = (const float*)d_in[20]; p.g_final = (const float*)d_in[21];
    p.out = (float*)d_out; p.ws = (char*)d_ws;
    static const int cuts[] = MK_CUTS;
    const int ncut = (int)(sizeof(cuts) / sizeof(int));
    for (int li = 0; li + 1 < ncut; li++) {
        (void)hipMemsetAsync((char*)d_ws + OFF_BAR, 0, 16384, stream);
        int lo = cuts[li], hi = cuts[li + 1];
        void* args[] = {&p, &lo, &hi};
        hipError_t e = hipLaunchCooperativeKernel((const void*)k_fwd, dim3(grid), dim3(512), args, LDS_TOTAL, stream);
        if (e != hipSuccess) fprintf(stderr, "cooperative launch failed: %s (grid %d)\n", hipGetErrorString(e), grid);
    }
}
```

```cpp
#include <hip/hip_runtime.h>
#include <stdint.h>
#include <cstdio>
#include <hip/hip_cooperative_groups.h>
namespace cg = cooperative_groups;
#ifndef USE_CG_SYNC
#define USE_CG_SYNC 0
#endif

#ifndef MK_CUTS
#define MK_CUTS {0, 12}
#endif

#define NB 4
#define NS 4096
#define ND 1024
#define NT (NB * NS)
#define INW 1184
#define NE 16
#define CAP 512
#define MEML 256
#define NPHASE 12
#define VTID ((int)(threadIdx.x & 255))
#define VHALF (__builtin_amdgcn_readfirstlane((int)(threadIdx.x >> 8)))
#define VBLK ((int)(blockIdx.x * 2) + VHALF)
#define VGRID ((int)(gridDim.x * 2))

typedef unsigned short bf16_t;
typedef short bf16x8 __attribute__((ext_vector_type(8)));
typedef float f32x4 __attribute__((ext_vector_type(4)));
typedef float f32x16 __attribute__((ext_vector_type(16)));
typedef unsigned u32x4 __attribute__((ext_vector_type(4)));
typedef int i32x4 __attribute__((ext_vector_type(4)));
typedef unsigned u32x2 __attribute__((ext_vector_type(2)));

__device__ __forceinline__ unsigned f2bf(float f) {
    unsigned u = __float_as_uint(f);
    u += 0x7FFFu + ((u >> 16) & 1u);
    return u >> 16;
}
typedef __bf16 hbf2 __attribute__((ext_vector_type(2)));
typedef float f32x2 __attribute__((ext_vector_type(2)));
__device__ __forceinline__ unsigned pack2bf(float lo, float hi) { f32x2 v = {lo, hi}; return __builtin_bit_cast(unsigned, __builtin_convertvector(v, hbf2)); }
__device__ __forceinline__ float bf2f(unsigned short b) { return __uint_as_float(((unsigned)b) << 16); }

__device__ __forceinline__ int tile_off(int row, int chunk) { return row * 128 + ((chunk ^ ((row >> 1) & 7)) << 4); }

#define GT_LDS_BYTES 65536

struct GemmTile { const bf16_t* A; long lda; const int* arow; const bf16_t* Bt; long ldb; int K; };

__device__ __forceinline__ void gemm_tile_128(const GemmTile& g, char* lds, f32x4 (&acc)[4][4]) {
    const int tid = VTID, lane = tid & 63, wid = tid >> 6, wm = wid >> 1, wn = wid & 1;
    const int lrow = lane >> 3, pc = lane & 7;
    const bf16_t* ap[4]; const bf16_t* bp[4];
#pragma unroll
    for (int i = 0; i < 4; i++) {
        const int r = (wid * 4 + i) * 8 + lrow;
        const int c = pc ^ ((r >> 1) & 7);
        const long ro = g.arow ? (long)g.arow[r] * g.lda : (long)r * g.lda;
        ap[i] = g.A + ro + c * 8;
        bp[i] = g.Bt + (long)r * g.ldb + c * 8;
    }
#pragma unroll
    for (int mi = 0; mi < 4; mi++)
#pragma unroll
        for (int ni = 0; ni < 4; ni++) acc[mi][ni] = (f32x4){0.f, 0.f, 0.f, 0.f};
    const int nk = g.K >> 6;
    auto stage = [&](int kt, char* st) {
#pragma unroll
        for (int i = 0; i < 4; i++) {
            __builtin_amdgcn_global_load_lds((const unsigned*)(ap[i] + kt * 64), (unsigned*)(st + (wid * 4 + i) * 1024), 16, 0, 0);
            __builtin_amdgcn_global_load_lds((const unsigned*)(bp[i] + kt * 64), (unsigned*)(st + 16384 + (wid * 4 + i) * 1024), 16, 0, 0);
        }
    };
    __syncthreads();
    stage(0, lds);
    asm volatile("s_waitcnt vmcnt(0)" ::: "memory");
    __syncthreads();
    for (int kt = 0; kt < nk; kt++) {
        char* cur = lds + (kt & 1) * 32768;
        if (kt + 1 < nk) stage(kt + 1, lds + ((kt + 1) & 1) * 32768);
        bf16x8 af[2][4], bfr[2][4];
#pragma unroll
        for (int ks = 0; ks < 2; ks++)
#pragma unroll
            for (int i = 0; i < 4; i++) {
                af[ks][i] = *(const bf16x8*)(cur + tile_off(wm * 64 + i * 16 + (lane & 15), ks * 4 + (lane >> 4)));
                bfr[ks][i] = *(const bf16x8*)(cur + 16384 + tile_off(wn * 64 + i * 16 + (lane & 15), ks * 4 + (lane >> 4)));
            }
        __builtin_amdgcn_s_setprio(1);
#pragma unroll
        for (int ks = 0; ks < 2; ks++)
#pragma unroll
            for (int mi = 0; mi < 4; mi++)
#pragma unroll
                for (int ni = 0; ni < 4; ni++)
                    acc[mi][ni] = __builtin_amdgcn_mfma_f32_16x16x32_bf16(bfr[ks][ni], af[ks][mi], acc[mi][ni], 0, 0, 0);
        __builtin_amdgcn_s_setprio(0);
        asm volatile("s_waitcnt vmcnt(0)" ::: "memory");
        __syncthreads();
    }
}

template <int DQK, int DVT, int KT>
struct AttnCfg {
    static constexpr int KROW = DQK * 2 + 16;
    static constexpr int VROW = KT * 2 + 8;
    static constexpr int KBYTES = KT * KROW;
    static constexpr int VBYTES = DVT * VROW;
    static constexpr int STAGE = KBYTES + VBYTES;
    static constexpr int LDS = 2 * STAGE;
};

template <int DQK, int DVT, int KT, int NTH, class Out>
__device__ __forceinline__ void attn_block(const bf16_t* Qp, const bf16_t* Kp, const bf16_t* Vtp, long ldv, int nk, char* lds, Out&& out) {
    typedef AttnCfg<DQK, DVT, KT> C;
    constexpr int NKS = DQK / 16, NST = KT / 32, NDT = DVT / 32, NPS = KT / 16;
    constexpr int KCPR = DQK / 8;
    constexpr int KTOT = KT * KCPR, KCH = (KTOT + NTH - 1) / NTH;
    constexpr int VCPR = KT / 8;
    constexpr int VTOT = DVT * VCPR, VCH = (VTOT + NTH - 1) / NTH;
    const int tid = NTH == 512 ? (int)threadIdx.x : VTID, lane = tid & 63, wid = tid >> 6, h = lane >> 5, c = lane & 31;

    bf16x8 qf[NKS];
    {
        const bf16_t* qrow = Qp + (long)(wid * 32 + c) * DQK + 8 * h;
#pragma unroll
        for (int ks = 0; ks < NKS; ks++) qf[ks] = *(const bf16x8*)(qrow + 16 * ks);
    }
    f32x16 o[NDT];
#pragma unroll
    for (int dt = 0; dt < NDT; dt++)
#pragma unroll
        for (int r = 0; r < 16; r++) o[dt][r] = 0.f;
    float m = 0.f, l = 0.f;

    u32x4 kr[KCH], vr[VCH];
    auto gload = [&](int t) {
#pragma unroll
        for (int i = 0; i < KCH; i++) {
            const int ci = tid + NTH * i, row = ci / KCPR, cc = ci % KCPR;
            if (KTOT % NTH == 0 || ci < KTOT) kr[i] = *(const u32x4*)(Kp + (long)(t * KT + row) * DQK + cc * 8);
        }
#pragma unroll
        for (int i = 0; i < VCH; i++) {
            const int ci = tid + NTH * i, row = ci / VCPR, cc = ci % VCPR;
            if (VTOT % NTH == 0 || ci < VTOT) vr[i] = *(const u32x4*)(Vtp + (long)row * ldv + t * KT + cc * 8);
        }
    };
    auto lwrite = [&](char* st) {
#pragma unroll
        for (int i = 0; i < KCH; i++) {
            const int ci = tid + NTH * i, row = ci / KCPR, cc = ci % KCPR;
            if (KTOT % NTH == 0 || ci < KTOT) *(u32x4*)(st + row * C::KROW + cc * 16) = kr[i];
        }
#pragma unroll
        for (int i = 0; i < VCH; i++) {
            const int ci = tid + NTH * i, row = ci / VCPR, cc = ci % VCPR;
            if (VTOT % NTH == 0 || ci < VTOT) {
                char* p = st + C::KBYTES + row * C::VROW + cc * 16;
                *(u32x2*)(p) = (u32x2){vr[i].x, vr[i].y};
                *(u32x2*)(p + 8) = (u32x2){vr[i].z, vr[i].w};
            }
        }
    };
    const int nt = nk / KT;
    gload(0);
    __syncthreads();
    lwrite(lds);
    __syncthreads();
    for (int t = 0; t < nt; t++) {
        char* cur = lds + (t & 1) * C::STAGE;
        if (t + 1 < nt) gload(t + 1);
        f32x16 s[NST];
        const float negm = -m;
#pragma unroll
        for (int st = 0; st < NST; st++) {
#pragma unroll
            for (int r = 0; r < 16; r++) s[st][r] = negm;
#pragma unroll
            for (int ks = 0; ks < NKS; ks++) {
                const bf16x8 kf = *(const bf16x8*)(cur + (st * 32 + c) * C::KROW + ks * 32 + h * 16);
                s[st] = __builtin_amdgcn_mfma_f32_32x32x16_bf16(kf, qf[ks], s[st], 0, 0, 0);
            }
        }
        float mx = s[0][0];
#pragma unroll
        for (int st = 0; st < NST; st++)
#pragma unroll
            for (int r = 0; r < 16; r++) mx = fmaxf(mx, s[st][r]);
        mx = fmaxf(mx, __shfl_xor(mx, 32));
        if (__any(mx > 8.0f)) {
            const float d = fmaxf(mx, 0.f);
            const float alpha = __builtin_amdgcn_exp2f(-d);
            m += d;
            l *= alpha;
#pragma unroll
            for (int dt = 0; dt < NDT; dt++)
#pragma unroll
                for (int r = 0; r < 16; r++) o[dt][r] *= alpha;
#pragma unroll
            for (int st = 0; st < NST; st++)
#pragma unroll
                for (int r = 0; r < 16; r++) s[st][r] -= d;
        }
        float rs = 0.f;
#pragma unroll
        for (int st = 0; st < NST; st++)
#pragma unroll
            for (int r = 0; r < 16; r++) { const float p = __builtin_amdgcn_exp2f(s[st][r]); rs += p; s[st][r] = p; }
        l += rs;
#pragma unroll
        for (int ps = 0; ps < NPS; ps++) {
            const int st = ps >> 1, u = ps & 1;
            u32x4 pw;
            pw.x = pack2bf(s[st][8 * u + 0], s[st][8 * u + 1]);
            pw.y = pack2bf(s[st][8 * u + 2], s[st][8 * u + 3]);
            pw.z = pack2bf(s[st][8 * u + 4], s[st][8 * u + 5]);
            pw.w = pack2bf(s[st][8 * u + 6], s[st][8 * u + 7]);
            const bf16x8 pf = __builtin_bit_cast(bf16x8, pw);
#pragma unroll
            for (int dt = 0; dt < NDT; dt++) {
                const char* vp = cur + C::KBYTES + (dt * 32 + c) * C::VROW + (ps * 16 + 4 * h) * 2;
                const u32x2 v0 = *(const u32x2*)(vp);
                const u32x2 v1 = *(const u32x2*)(vp + 16);
                const bf16x8 vf = __builtin_bit_cast(bf16x8, ((u32x4){v0.x, v0.y, v1.x, v1.y}));
                o[dt] = __builtin_amdgcn_mfma_f32_32x32x16_bf16(vf, pf, o[dt], 0, 0, 0);
            }
        }
        if (t + 1 < nt) lwrite(lds + ((t + 1) & 1) * C::STAGE);
        __syncthreads();
    }
    l += __shfl_xor(l, 32);
    const float inv = 1.f / l;
#pragma unroll
    for (int dt = 0; dt < NDT; dt++)
#pragma unroll
        for (int g4 = 0; g4 < 4; g4++) {
            f32x4 v = {o[dt][4 * g4 + 0] * inv, o[dt][4 * g4 + 1] * inv, o[dt][4 * g4 + 2] * inv, o[dt][4 * g4 + 3] * inv};
            out(wid * 32 + c, dt * 32 + 8 * g4 + 4 * h, v);
        }
}


constexpr size_t SLOT = 33554432;
constexpr size_t OFF_W1T = 0;
constexpr size_t OFF_WQT = OFF_W1T + 1280UL * 1024 * 2;
constexpr size_t OFF_WKVT = OFF_WQT + 768UL * 384 * 2;
constexpr size_t OFF_WOUTT = OFF_WKVT + 1024UL * 256 * 2;
constexpr size_t OFF_WMQT = OFF_WOUTT + 1024UL * 1024 * 2;
constexpr size_t OFF_WMKVT = OFF_WMQT + 1024UL * 1024 * 2;
constexpr size_t OFF_WMOT = OFF_WMKVT + 2048UL * 1024 * 2;
constexpr size_t OFF_WGUT = OFF_WMOT + 1024UL * 1024 * 2;
constexpr size_t OFF_WDT = OFF_WGUT + 16UL * 2048 * 1024 * 2;
constexpr size_t OFF_T64 = OFF_WDT + 16UL * 1024 * 1024 * 2;
constexpr size_t OFF_M1 = OFF_T64 + 16384;
constexpr size_t OFF_M3 = OFF_M1 + 32768;
constexpr size_t OFF_WFT = OFF_M3 + 16384;
constexpr size_t OFF_TW = OFF_WFT + 65536;
constexpr size_t OFF_ROPE = OFF_TW + 32768;
constexpr size_t OFF_R0 = OFF_ROPE + (size_t)NT * 16 * 8;
constexpr size_t OFF_RMEM = OFF_R0 + (size_t)NT * 4;
constexpr size_t OFF_SSQ = OFF_RMEM + 4096;
constexpr size_t OFF_SSKV = OFF_SSQ + (size_t)NT * 6 * 4;
constexpr size_t OFF_SS1 = OFF_SSKV + (size_t)NT * 4 * 4;
constexpr size_t OFF_SS2 = OFF_SS1 + (size_t)NT * 16 * 4;
constexpr size_t OFF_AFF = OFF_SS2 + (size_t)NT * 16 * 4;
constexpr size_t OFF_SLOTS = OFF_AFF + (size_t)NT * 16 * 4;
constexpr size_t OFF_IDX = OFF_SLOTS + 4UL * 16 * 4096 * 4;
constexpr size_t OFF_GATE = OFF_IDX + 4UL * 16 * 512 * 4;
constexpr size_t OFF_MEMB = OFF_GATE + 4UL * 16 * 512 * 4;
constexpr size_t OFF_KMEM = OFF_MEMB + 1024UL * 1024 * 2;
constexpr size_t OFF_VTMEM = OFF_KMEM + 1024UL * 1024 * 2;
constexpr size_t OFF_KR = OFF_VTMEM + 1024UL * 1024 * 2;
constexpr size_t OFF_BAR = OFF_KR + (size_t)NT * 32 * 2;
constexpr size_t OFF_RS2 = OFF_BAR + 16384;
constexpr size_t OFF_RSS = OFF_RS2 + (size_t)NT * 4;
constexpr size_t OFF_S0 = (OFF_RSS + 4UL * 16 * 512 * 4 + 255) / 256 * 256;
constexpr size_t OFF_S1 = OFF_S0 + SLOT;
constexpr size_t OFF_S2 = OFF_S1 + SLOT;
constexpr size_t OFF_S3 = OFF_S2 + SLOT;
constexpr size_t OFF_S4 = OFF_S3 + SLOT;
constexpr size_t WS_END = OFF_S4 + SLOT;
static_assert(WS_END <= 300964352UL, "workspace map exceeds the guaranteed scratch size");
constexpr size_t OFF_XB = OFF_S0, OFF_YR = OFF_S0, OFF_YI = OFF_S0 + SLOT / 2, OFF_X1B = OFF_S3, OFF_OM = OFF_S0, OFF_ACT = OFF_S0;
constexpr size_t OFF_UF = OFF_S1, OFF_UQ = OFF_S1 + (size_t)NT * 512 * 2, OFF_ZA = OFF_S1, OFF_QM = OFF_S1;
constexpr size_t OFF_Q = OFF_S2, OFF_UKV = OFF_S2 + (size_t)NT * 768 * 2, OFF_X2B = OFF_S2;
constexpr size_t OFF_K = OFF_S3, OFF_Y = OFF_S3;
constexpr size_t OFF_VT = OFF_S4;

struct Params {
    const float *x, *mem; const int* pos;
    const float *g_mix, *w_in, *g_q_lat, *w_q_up, *g_kv_lat, *w_kv_up, *w_fourier, *w_out, *g_mem_q, *g_mem_kv, *w_mem_q, *w_mem_kv, *w_mem_o,
        *g_ffn, *w_router, *w_exp_gate, *w_exp_up, *w_exp_down, *g_final;
    float* out; char* ws;
};
template <class T> __device__ __forceinline__ T* wsp(const Params& p, size_t off) { return (T*)(p.ws + off); }

#define LDS_HALF 65536
#define LDS_MAIN 131072
#define LDS_TOTAL (LDS_MAIN + 16)
#define LAS __attribute__((address_space(3)))

#define XB_TMO      128
#define XB_XCNT(j)  (256  + 64 * (j))
#define XB_XSUB(j)  (1280 + 64 * (j))
#define XB_XGEN(j)  (2304 + 64 * (j))
#define XB_TOP      3328
#define XB_TOPGEN   3392
#define XCD_BAR_WORDS 3456
#define XB_SPIN_CAP (1u << 25)
__device__ __forceinline__ unsigned xb_ld(unsigned* p)              { return __hip_atomic_load(p, __ATOMIC_RELAXED, __HIP_MEMORY_SCOPE_AGENT); }
__device__ __forceinline__ unsigned xb_add(unsigned* p, unsigned v) { return __hip_atomic_fetch_add(p, v, __ATOMIC_RELAXED, __HIP_MEMORY_SCOPE_AGENT); }
__device__ __forceinline__ unsigned xb_xcc_id() { return (unsigned)__builtin_amdgcn_s_getreg((3 << 11) | 20) & 0xFu; }
#define XB_SPIN(cond, bar) do { unsigned _sp = 0; while (cond) { __builtin_amdgcn_s_sleep(1); \
    if ((++_sp & 255u) == 0u) { if (xb_ld(&(bar)[XB_TMO])) break; if (_sp > XB_SPIN_CAP) { atomicAdd(&(bar)[XB_TMO], 1u); break; } } } } while (0)
struct XcdBarrier { unsigned* bar; unsigned x; volatile LAS unsigned* st; };
__device__ __forceinline__ XcdBarrier xcd_barrier_post(unsigned* bar, volatile LAS unsigned* st) {
    XcdBarrier b; b.bar = bar; b.x = xb_xcc_id(); b.st = st;
    if (threadIdx.x == 0) (void)xb_add(&bar[XB_XCNT(b.x)], 1u);
    return b;
}
__device__ __forceinline__ void xcd_barrier_complete(unsigned* bar, unsigned x, unsigned& nloc, unsigned& nx) {
    const unsigned G = gridDim.x * gridDim.y * gridDim.z;
    unsigned sum, cnt, mine, sp = 0u;
    for (;;) {
        sum = 0u; cnt = 0u; mine = 0u;
#pragma unroll
        for (unsigned j = 0; j < 16; ++j) { const unsigned c = xb_ld(&bar[XB_XCNT(j)]); sum += c; cnt += (c > 0u) ? 1u : 0u; mine = (j == x) ? c : mine; }
        if (sum == G) break;
        __builtin_amdgcn_s_sleep(1);
        if ((++sp & 255u) == 0u) { if (xb_ld(&bar[XB_TMO])) break; if (sp > XB_SPIN_CAP) { atomicAdd(&bar[XB_TMO], 1u); break; } }
    }
    nloc = mine > 0u ? mine : 1u; nx = cnt > 0u ? cnt : 1u;
}
__device__ __forceinline__ void xcd_barrier(const XcdBarrier& b) {
    asm volatile("s_waitcnt vmcnt(0)" ::: "memory");
    __syncthreads();
    if (threadIdx.x == 0) {
        unsigned* bar = b.bar;
        __builtin_amdgcn_s_waitcnt(0);
        unsigned nloc = b.st[0], nx = b.st[1];
        if (nloc == 0u) { xcd_barrier_complete(bar, b.x, nloc, nx); b.st[0] = nloc; b.st[1] = nx; }
        const unsigned old = xb_add(&bar[XB_XSUB(b.x)], 1u);
        const unsigned gen = old / nloc;
        if (old + 1u == (gen + 1u) * nloc) {
            __builtin_amdgcn_fence(__ATOMIC_RELEASE, "agent");
            asm volatile("s_waitcnt vmcnt(0)" ::: "memory");
            const unsigned og = xb_add(&bar[XB_TOP], 1u);
            const unsigned tg = og / nx;
            if (og + 1u == (tg + 1u) * nx) xb_add(&bar[XB_TOPGEN], 1u);
            else XB_SPIN(xb_ld(&bar[XB_TOPGEN]) == tg, bar);
            __builtin_amdgcn_fence(__ATOMIC_ACQUIRE, "agent");
            xb_add(&bar[XB_XGEN(b.x)], 1u);
            asm volatile("s_waitcnt vmcnt(0)" ::: "memory");
        } else {
            XB_SPIN(xb_ld(&bar[XB_XGEN(b.x)]) == gen, bar);
            __builtin_amdgcn_fence(__ATOMIC_ACQUIRE, "agent");
            asm volatile("s_waitcnt vmcnt(0)" ::: "memory");
        }
    }
    __syncthreads();
}

#define FOR_XCD_ITEMS(item, N) for (int _L = (int)((blockIdx.x >> 3) << 1) | VHALF, item; _L < (N) / 8 && ((item = (int)(blockIdx.x & 7) * ((N) / 8) + _L), true); _L += (int)(gridDim.x >> 2))

__device__ __forceinline__ u32x2 pack4bf(float a, float b, float c, float d) { return (u32x2){pack2bf(a, b), pack2bf(c, d)}; }
__device__ __forceinline__ u32x2 pack4bf(f32x4 v) { return (u32x2){pack2bf(v[0], v[1]), pack2bf(v[2], v[3])}; }
__device__ __forceinline__ float wave_sum(float v) {
#pragma unroll
    for (int o = 32; o > 0; o >>= 1) v += __shfl_xor(v, o);
    return v;
}

__device__ __forceinline__ void tr_tile(const float* W, long ldw, int k0, int n0, int nvalid, const float* gain, bf16_t* Wt, long ldt, int mode, char* lds) {
    float (*t)[132] = (float (*)[132])lds;
    const int tid = VTID, c4 = tid & 31, r0 = tid >> 5;
    f32x4 v[8];
#pragma unroll
    for (int i = 0; i < 8; i++) {
        const int kk = r0 + 8 * i, n = n0 + c4 * 4;
        v[i] = (n < nvalid) ? *(const f32x4*)(W + (long)(k0 + kk) * ldw + n) : (f32x4){0.f, 0.f, 0.f, 0.f};
        if (gain) v[i] *= gain[k0 + kk];
    }
    __syncthreads();
#pragma unroll
    for (int i = 0; i < 8; i++) *(f32x4*)(&t[r0 + 8 * i][c4 * 4]) = v[i];
    __syncthreads();
#pragma unroll
    for (int i = 0; i < 4; i++) {
        const int ci = tid + 256 * i, nn = ci >> 3, kc = ci & 7;
        const int n = n0 + nn;
        int row = n;
        if (mode) row = (n >> 5) * 64 + ((n >> 4) & 1) * 32 + (mode - 1) * 16 + (n & 15);
        u32x4 w;
        w.x = pack2bf(t[kc * 8 + 0][nn], t[kc * 8 + 1][nn]);
        w.y = pack2bf(t[kc * 8 + 2][nn], t[kc * 8 + 3][nn]);
        w.z = pack2bf(t[kc * 8 + 4][nn], t[kc * 8 + 5][nn]);
        w.w = pack2bf(t[kc * 8 + 6][nn], t[kc * 8 + 7][nn]);
        *(u32x4*)(Wt + (long)row * ldt + k0 + kc * 8) = w;
    }
}

__device__ __forceinline__ void phase0(const Params& p, char* lds) {
    constexpr int J_W1 = 160, J_WQ = 36, J_WKV = 32, J_WOUT = 128, J_WMQ = 128, J_WMKV = 256, J_WMO = 128, J_WG = 0, J_WU = 0, J_WD = 0;
    constexpr int J_TR = J_W1 + J_WQ + J_WKV + J_WOUT + J_WMQ + J_WMKV + J_WMO + J_WG + J_WU + J_WD;
    constexpr int J_XR = NT / 16, J_MR = 1024 / 16, J_ROPE = NT * 16 / 256, J_TAB = (4096 + 8192 + 16384 + 8192 + 32768) / 256;
    constexpr int J_ALL = J_TR + J_XR + J_MR + J_ROPE + J_TAB;
    const int tid = VTID, lane = tid & 63, wid = tid >> 6;
    const double PI2 = 6.283185307179586476925286766559;
    for (int job = VBLK; job < J_ALL; job += VGRID) {
        int j = job;
        if (j < J_TR) {
            if (j < J_W1) { tr_tile(p.w_in, INW, (j / 10) * 64, (j % 10) * 128, INW, p.g_mix, wsp<bf16_t>(p, OFF_W1T), 1024, 0, lds); continue; } j -= J_W1;
            if (j < J_WQ) { tr_tile(p.w_q_up, 768, (j / 6) * 64, (j % 6) * 128, 768, p.g_q_lat, wsp<bf16_t>(p, OFF_WQT), 384, 0, lds); continue; } j -= J_WQ;
            if (j < J_WKV) { tr_tile(p.w_kv_up, 1024, (j / 8) * 64, (j % 8) * 128, 1024, p.g_kv_lat, wsp<bf16_t>(p, OFF_WKVT), 256, 0, lds); continue; } j -= J_WKV;
            if (j < J_WOUT) { tr_tile(p.w_out, 1024, (j / 8) * 64, (j % 8) * 128, 1024, nullptr, wsp<bf16_t>(p, OFF_WOUTT), 1024, 0, lds); continue; } j -= J_WOUT;
            if (j < J_WMQ) { tr_tile(p.w_mem_q, 1024, (j / 8) * 64, (j % 8) * 128, 1024, p.g_mem_q, wsp<bf16_t>(p, OFF_WMQT), 1024, 0, lds); continue; } j -= J_WMQ;
            if (j < J_WMKV) { tr_tile(p.w_mem_kv, 2048, (j / 16) * 64, (j % 16) * 128, 2048, p.g_mem_kv, wsp<bf16_t>(p, OFF_WMKVT), 1024, 0, lds); continue; } j -= J_WMKV;
            if (j < J_WMO) { tr_tile(p.w_mem_o, 1024, (j / 8) * 64, (j % 8) * 128, 1024, nullptr, wsp<bf16_t>(p, OFF_WMOT), 1024, 0, lds); continue; } j -= J_WMO;
            if (j < J_WG) { const int e = j >> 7, r = j & 127; tr_tile(p.w_exp_gate + (long)e * 1048576, 1024, (r / 8) * 64, (r % 8) * 128, 1024, p.g_ffn, wsp<bf16_t>(p, OFF_WGUT) + (long)e * 2048 * 1024, 1024, 1, lds); continue; } j -= J_WG;
            if (j < J_WU) { const int e = j >> 7, r = j & 127; tr_tile(p.w_exp_up + (long)e * 1048576, 1024, (r / 8) * 64, (r % 8) * 128, 1024, p.g_ffn, wsp<bf16_t>(p, OFF_WGUT) + (long)e * 2048 * 1024, 1024, 2, lds); continue; } j -= J_WU;
            { const int e = j >> 7, r = j & 127; tr_tile(p.w_exp_down + (long)e * 1048576, 1024, (r / 8) * 64, (r % 8) * 128, 1024, nullptr, wsp<bf16_t>(p, OFF_WDT) + (long)e * 1048576, 1024, 0, lds); continue; }
        }
        j -= J_TR;
        if (j < J_XR + J_MR) {
            const bool isx = j < J_XR;
            const int row0 = (isx ? j : j - J_XR) * 16 + wid * 4;
            const float* src = (isx ? p.x : p.mem) + (long)row0 * ND;
            bf16_t* dst = (isx ? wsp<bf16_t>(p, OFF_XB) : wsp<bf16_t>(p, OFF_MEMB)) + (long)row0 * ND;
            f32x4 v[4][4];
#pragma unroll
            for (int r = 0; r < 4; r++)
#pragma unroll
                for (int i = 0; i < 4; i++) v[r][i] = *(const f32x4*)(src + (long)r * ND + i * 256 + lane * 4);
#pragma unroll
            for (int r = 0; r < 4; r++) {
                float ss = 0.f;
#pragma unroll
                for (int i = 0; i < 4; i++) {
                    ss += v[r][i][0] * v[r][i][0] + v[r][i][1] * v[r][i][1] + v[r][i][2] * v[r][i][2] + v[r][i][3] * v[r][i][3];
                    *(u32x2*)(dst + (long)r * ND + i * 256 + lane * 4) = pack4bf(v[r][i]);
                }
                ss = wave_sum(ss);
                if (lane == 0) (isx ? wsp<float>(p, OFF_R0) : wsp<float>(p, OFF_RMEM))[row0 + r] = rsqrtf(ss * (1.f / ND) + 1e-6f);
            }
            continue;
        }
        j -= J_XR + J_MR;
        if (j < J_ROPE) {
            const int i = j * 256 + tid; const int t = i >> 4, jj = i & 15;
            const double f = pow(10000.0, -(double)(2 * jj) / 32.0);
            const double ang = (double)p.pos[t] * f;
            wsp<float2>(p, OFF_ROPE)[i] = make_float2((float)cos(ang), (float)sin(ang));
            continue;
        }
        j -= J_ROPE;
        {
            int i = j * 256 + tid;
            if (i < 4096) { const double a = PI2 * (double)i / 4096.0; wsp<float2>(p, OFF_TW)[i] = make_float2((float)cos(a), (float)sin(a)); continue; } i -= 4096;
            if (i < 8192) {
                const int T = i >> 12, a = (i >> 6) & 63, b = i & 63;
                const double th = PI2 * (double)((a * b) & 63) / 64.0;
                wsp<bf16_t>(p, OFF_T64)[i] = (bf16_t)f2bf((float)(T ? sin(th) : cos(th))); continue;
            } i -= 8192;
            if (i < 16384) {
                const int rho = i >> 7, k = i & 127;
                const int wm = rho >> 6, mi = (rho >> 4) & 3, lr = rho & 15, ri = mi >> 1, k1 = 32 * wm + 16 * (mi & 1) + lr, ab = k >> 6, s1 = k & 63;
                const double th = PI2 * (double)((k1 * s1) & 63) / 64.0;
                const double c = cos(th), s = sin(th);
                const double v = ri == 0 ? (ab == 0 ? c : -s) : (ab == 0 ? s : c);
                wsp<bf16_t>(p, OFF_M1)[i] = (bf16_t)f2bf((float)v); continue;
            } i -= 16384;
            if (i < 8192) {
                const int k2 = i >> 7, k = i & 127, s2 = k & 63;
                const double th = PI2 * (double)((k2 * s2) & 63) / 64.0;
                wsp<bf16_t>(p, OFF_M3)[i] = (bf16_t)f2bf((float)(k < 64 ? cos(th) : -sin(th))); continue;
            } i -= 8192;
            if (i < 32768) {
                const int g = i >> 12, e = (i >> 6) & 63, ch = i & 63;
                wsp<bf16_t>(p, OFF_WFT)[i] = (bf16_t)f2bf(p.w_fourier[(g * 64 + ch) * 64 + e]); continue;
            }
        }
    }
}

#define FOR_XCD_ITEMS_R(item, N) for (int _L = (int)(blockIdx.x >> 3), item; _L < (N) / 8 && ((item = (int)(blockIdx.x & 7) * ((N) / 8) + _L), true); _L += (int)(gridDim.x >> 3))
__device__ __forceinline__ void gemm_tile_256sq(const GemmTile& g, char* lds, f32x4 (&acc)[8][4]) {
    const int tid = threadIdx.x, lane = tid & 63, wid = tid >> 6, wm = wid >> 2, wn = wid & 3;
    const int lrow = lane >> 3, pc = lane & 7;
    const bf16_t* ap[4]; const bf16_t* bp[4];
#pragma unroll
    for (int i = 0; i < 4; i++) {
        const int r = (wid * 4 + i) * 8 + lrow;
        const int c = pc ^ ((r >> 1) & 7);
        const long ro = g.arow ? (long)g.arow[r] * g.lda : (long)r * g.lda;
        ap[i] = g.A + ro + c * 8;
        bp[i] = g.Bt + (long)r * g.ldb + c * 8;
    }
#pragma unroll
    for (int mi = 0; mi < 8; mi++)
#pragma unroll
        for (int ni = 0; ni < 4; ni++) acc[mi][ni] = (f32x4){0.f, 0.f, 0.f, 0.f};
    const int nk = g.K >> 6;
    auto stage = [&](int kt, char* st) {
#pragma unroll
        for (int i = 0; i < 4; i++) {
            __builtin_amdgcn_global_load_lds((const unsigned*)(ap[i] + kt * 64), (unsigned*)(st + (wid * 4 + i) * 1024), 16, 0, 0);
            __builtin_amdgcn_global_load_lds((const unsigned*)(bp[i] + kt * 64), (unsigned*)(st + 32768 + (wid * 4 + i) * 1024), 16, 0, 0);
        }
    };
    __syncthreads();
    stage(0, lds);
    asm volatile("s_waitcnt vmcnt(0)" ::: "memory");
    __syncthreads();
    for (int kt = 0; kt < nk; kt++) {
        char* cur = lds + (kt & 1) * 65536;
        if (kt + 1 < nk) stage(kt + 1, lds + ((kt + 1) & 1) * 65536);
#pragma unroll
        for (int ks = 0; ks < 2; ks++) {
            bf16x8 af[8], bfr[4];
#pragma unroll
            for (int i = 0; i < 8; i++) af[i] = *(const bf16x8*)(cur + tile_off(wm * 128 + i * 16 + (lane & 15), ks * 4 + (lane >> 4)));
#pragma unroll
            for (int i = 0; i < 4; i++) bfr[i] = *(const bf16x8*)(cur + 32768 + tile_off(wn * 64 + i * 16 + (lane & 15), ks * 4 + (lane >> 4)));
            __builtin_amdgcn_s_setprio(1);
#pragma unroll
            for (int mi = 0; mi < 8; mi++)
#pragma unroll
                for (int ni = 0; ni < 4; ni++)
                    acc[mi][ni] = __builtin_amdgcn_mfma_f32_16x16x32_bf16(bfr[ni], af[mi], acc[mi][ni], 0, 0, 0);
            __builtin_amdgcn_s_setprio(0);
        }
        asm volatile("s_waitcnt vmcnt(0)" ::: "memory");
        __syncthreads();
    }
}


__device__ __forceinline__ void gemm_tile_256x128(const GemmTile& g, char* lds, f32x4 (&acc)[4][4]) {
    const int tid = threadIdx.x, lane = tid & 63, wid = tid >> 6, wm = wid >> 1, wn = wid & 1;
    const int lrow = lane >> 3, pc = lane & 7;
    const bf16_t* ap[4]; const bf16_t* bp[2];
#pragma unroll
    for (int i = 0; i < 4; i++) {
        const int r = (wid * 4 + i) * 8 + lrow;
        const int c = pc ^ ((r >> 1) & 7);
        const long ro = g.arow ? (long)g.arow[r] * g.lda : (long)r * g.lda;
        ap[i] = g.A + ro + c * 8;
    }
#pragma unroll
    for (int i = 0; i < 2; i++) {
        const int r = (wid * 2 + i) * 8 + lrow;
        const int c = pc ^ ((r >> 1) & 7);
        bp[i] = g.Bt + (long)r * g.ldb + c * 8;
    }
#pragma unroll
    for (int mi = 0; mi < 4; mi++)
#pragma unroll
        for (int ni = 0; ni < 4; ni++) acc[mi][ni] = (f32x4){0.f, 0.f, 0.f, 0.f};
    const int nk = g.K >> 6;
    auto stage = [&](int kt, char* st) {
#pragma unroll
        for (int i = 0; i < 4; i++)
            __builtin_amdgcn_global_load_lds((const unsigned*)(ap[i] + kt * 64), (unsigned*)(st + (wid * 4 + i) * 1024), 16, 0, 0);
#pragma unroll
        for (int i = 0; i < 2; i++)
            __builtin_amdgcn_global_load_lds((const unsigned*)(bp[i] + kt * 64), (unsigned*)(st + 32768 + (wid * 2 + i) * 1024), 16, 0, 0);
    };
    __syncthreads();
    stage(0, lds);
    asm volatile("s_waitcnt vmcnt(0)" ::: "memory");
    __syncthreads();
    for (int kt = 0; kt < nk; kt++) {
        char* cur = lds + (kt & 1) * 49152;
        if (kt + 1 < nk) stage(kt + 1, lds + ((kt + 1) & 1) * 49152);
        bf16x8 af[2][4], bfr[2][4];
#pragma unroll
        for (int ks = 0; ks < 2; ks++)
#pragma unroll
            for (int i = 0; i < 4; i++) {
                af[ks][i] = *(const bf16x8*)(cur + tile_off(wm * 64 + i * 16 + (lane & 15), ks * 4 + (lane >> 4)));
                bfr[ks][i] = *(const bf16x8*)(cur + 32768 + tile_off(wn * 64 + i * 16 + (lane & 15), ks * 4 + (lane >> 4)));
            }
        __builtin_amdgcn_s_setprio(1);
#pragma unroll
        for (int ks = 0; ks < 2; ks++)
#pragma unroll
            for (int mi = 0; mi < 4; mi++)
#pragma unroll
                for (int ni = 0; ni < 4; ni++)
                    acc[mi][ni] = __builtin_amdgcn_mfma_f32_16x16x32_bf16(bfr[ks][ni], af[ks][mi], acc[mi][ni], 0, 0, 0);
        __builtin_amdgcn_s_setprio(0);
        asm volatile("s_waitcnt vmcnt(0)" ::: "memory");
        __syncthreads();
    }
}

template <class Setup, class Epi>
__device__ __forceinline__ void gemm_256x128_stream(int nitems, int lshift, int l0, int ls, char* lds, Setup setup, Epi epi) {
    const int tid = threadIdx.x, lane = tid & 63, wid = tid >> 6, wm = wid >> 1, wn = wid & 1;
    const int lrow = lane >> 3, pc = lane & 7;
    const int LN = nitems / 8, LS = ls, xb = (int)(blockIdx.x & 7) * LN;
    int L = (int)(blockIdx.x >> 3) - l0;
    if (L < 0 || L >= LS) return;
    L = (L + LS - lshift % LS) % LS;
    if (L >= LN) return;
    const bf16_t* ap[4]; const bf16_t* bp[2];
    auto setptr = [&](const GemmTile& g) {
#pragma unroll
        for (int i = 0; i < 4; i++) {
            const int r = (wid * 4 + i) * 8 + lrow;
            const int c = pc ^ ((r >> 1) & 7);
            ap[i] = g.A + (long)r * g.lda + c * 8;
        }
#pragma unroll
        for (int i = 0; i < 2; i++) {
            const int r = (wid * 2 + i) * 8 + lrow;
            const int c = pc ^ ((r >> 1) & 7);
            bp[i] = g.Bt + (long)r * g.ldb + c * 8;
        }
    };
    auto stage = [&](int kt, char* st) {
#pragma unroll
        for (int i = 0; i < 4; i++)
            __builtin_amdgcn_global_load_lds((const unsigned*)(ap[i] + kt * 64), (unsigned*)(st + (wid * 4 + i) * 1024), 16, 0, 0);
#pragma unroll
        for (int i = 0; i < 2; i++)
            __builtin_amdgcn_global_load_lds((const unsigned*)(bp[i] + kt * 64), (unsigned*)(st + 32768 + (wid * 2 + i) * 1024), 16, 0, 0);
    };
    GemmTile g; g.arow = nullptr;
    setup(xb + L, g);
    const int nk = g.K >> 6;
    setptr(g);
    __syncthreads();
    stage(0, lds);
    asm volatile("s_waitcnt vmcnt(0)" ::: "memory");
    __syncthreads();
    int q = 0;
    for (; L < LN; L += LS) {
        f32x4 acc[4][4];
#pragma unroll
        for (int mi = 0; mi < 4; mi++)
#pragma unroll
            for (int ni = 0; ni < 4; ni++) acc[mi][ni] = (f32x4){0.f, 0.f, 0.f, 0.f};
        for (int kt = 0; kt < nk; kt++, q++) {
            char* cur = lds + (q & 1) * 49152;
            char* nxt = lds + ((q + 1) & 1) * 49152;
            if (kt + 1 < nk) stage(kt + 1, nxt);
            else if (L + LS < LN) { setup(xb + L + LS, g); setptr(g); stage(0, nxt); }
            bf16x8 af[2][4], bfr[2][4];
#pragma unroll
            for (int ks = 0; ks < 2; ks++)
#pragma unroll
                for (int i = 0; i < 4; i++) {
                    af[ks][i] = *(const bf16x8*)(cur + tile_off(wm * 64 + i * 16 + (lane & 15), ks * 4 + (lane >> 4)));
                    bfr[ks][i] = *(const bf16x8*)(cur + 32768 + tile_off(wn * 64 + i * 16 + (lane & 15), ks * 4 + (lane >> 4)));
                }
            __builtin_amdgcn_s_setprio(1);
#pragma unroll
            for (int ks = 0; ks < 2; ks++)
#pragma unroll
                for (int mi = 0; mi < 4; mi++)
#pragma unroll
                    for (int ni = 0; ni < 4; ni++)
                        acc[mi][ni] = __builtin_amdgcn_mfma_f32_16x16x32_bf16(bfr[ks][ni], af[ks][mi], acc[mi][ni], 0, 0, 0);
            __builtin_amdgcn_s_setprio(0);
            asm volatile("s_waitcnt vmcnt(0)" ::: "memory");
            __syncthreads();
        }
        epi(xb + L, acc);
    }
}


__device__ __forceinline__ void phase1(const Params& p, char* lds) {
    const int tid = threadIdx.x, lane = tid & 63, wid = tid >> 6, wm = wid >> 1, wn = wid & 1, lq = lane >> 4, lr = lane & 15;
    constexpr int N_U = 64 * 2, N_M = 4 * 16;
    {
      gemm_256x128_stream(N_U, 0, 0, (int)(gridDim.x >> 3), lds, [&](int item, GemmTile& g) {
            const int tm = item >> 1, tn = 8 + (item & 1);
            g.A = wsp<bf16_t>(p, OFF_XB) + (long)tm * 256 * ND; g.lda = ND;
            g.Bt = wsp<bf16_t>(p, OFF_W1T) + (long)tn * 128 * ND; g.ldb = ND; g.K = ND;
        }, [&](int item, f32x4 (&acc)[4][4]) {
            const int tm = item >> 1, tn = 8 + (item & 1);
            const float* r0 = wsp<float>(p, OFF_R0);
#pragma unroll
            for (int mi = 0; mi < 4; mi++) {
                const int row = tm * 256 + wm * 64 + mi * 16 + lr;
                const float rs = r0[row];
#pragma unroll
                for (int ni = 0; ni < 4; ni++) acc[mi][ni] *= rs;
                if (tn < 4) {
#pragma unroll
                    for (int ni = 0; ni < 4; ni++)
                        *(u32x2*)(wsp<bf16_t>(p, OFF_UF) + (long)row * 512 + tn * 128 + wn * 64 + ni * 16 + 4 * lq) = pack4bf(acc[mi][ni]);
                } else if (tn < 9) {
                    float ss = 0.f;
#pragma unroll
                    for (int ni = 0; ni < 4; ni++) { const f32x4 v = acc[mi][ni]; ss += v[0] * v[0] + v[1] * v[1] + v[2] * v[2] + v[3] * v[3]; }
                    ss += __shfl_xor(ss, 16); ss += __shfl_xor(ss, 32);
                    if (tn < 7) {
#pragma unroll
                        for (int ni = 0; ni < 4; ni++)
                            *(u32x2*)(wsp<bf16_t>(p, OFF_UQ) + (long)row * 384 + (tn - 4) * 128 + wn * 64 + ni * 16 + 4 * lq) = pack4bf(acc[mi][ni]);
                        if (lq == 0) wsp<float>(p, OFF_SSQ)[row * 6 + (tn - 4) * 2 + wn] = ss;
                    } else {
#pragma unroll
                        for (int ni = 0; ni < 4; ni++)
                            *(u32x2*)(wsp<bf16_t>(p, OFF_UKV) + (long)row * 256 + (tn - 7) * 128 + wn * 64 + ni * 16 + 4 * lq) = pack4bf(acc[mi][ni]);
                        if (lq == 0) wsp<float>(p, OFF_SSKV)[row * 4 + (tn - 7) * 2 + wn] = ss;
                    }
                } else if (wn == 0) {
                    const float2* rp = wsp<float2>(p, OFF_ROPE) + (long)row * 16 + 4 * lq;
                    f32x4 o1, o2;
#pragma unroll
                    for (int r = 0; r < 4; r++) {
                        const float2 cs = rp[r];
                        const float x1 = acc[mi][0][r], x2 = acc[mi][1][r];
                        o1[r] = x1 * cs.x - x2 * cs.y; o2[r] = x1 * cs.y + x2 * cs.x;
                    }
                    bf16_t* kr = wsp<bf16_t>(p, OFF_KR) + (long)row * 32;
                    *(u32x2*)(kr + 4 * lq) = pack4bf(o1);
                    *(u32x2*)(kr + 16 + 4 * lq) = pack4bf(o2);
                }
            }
        });
      gemm_256x128_stream(N_M, N_U / 8, 0, (int)(gridDim.x >> 3), lds, [&](int it, GemmTile& g) {
            const int tm = it / 16, tn = it % 16;
            g.A = wsp<bf16_t>(p, OFF_MEMB) + (long)tm * 256 * ND; g.lda = ND;
            g.Bt = wsp<bf16_t>(p, OFF_WMKVT) + (long)tn * 128 * ND; g.ldb = ND; g.K = ND;
        }, [&](int it, f32x4 (&acc)[4][4]) {
            const int tm = it / 16, tn = it % 16;
            const float* rm = wsp<float>(p, OFF_RMEM);
#pragma unroll
            for (int mi = 0; mi < 4; mi++) {
                const int row = tm * 256 + wm * 64 + mi * 16 + lr;
                const int b = row >> 8, m = row & 255;
                const float rs = rm[row];
#pragma unroll
                for (int ni = 0; ni < 4; ni++) {
                    const f32x4 v = acc[mi][ni] * rs;
                    const int col = tn * 128 + wn * 64 + ni * 16 + 4 * lq;
                    if (col < 1024) {
                        const int h = col >> 8, d = col & 255;
                        *(u32x2*)(wsp<bf16_t>(p, OFF_KMEM) + ((long)(b * 4 + h) * 256 + m) * 256 + d) = pack4bf(v);
                    } else {
                        const int c2 = col - 1024, h = c2 >> 8, dv = c2 & 255;
                        bf16_t* vt = wsp<bf16_t>(p, OFF_VTMEM) + ((long)(b * 4 + h) * 256 + dv) * 256 + m;
#pragma unroll
                        for (int r = 0; r < 4; r++) vt[r * 256] = (bf16_t)f2bf(v[r]);
                    }
                }
            }
        });
    }
}

template <int MI>
__device__ __forceinline__ void dft_mma(const bf16_t* Ag, int arow0, const char* ximg, int ncol0, f32x4 (&acc)[MI][4]) {
    const int lane = VTID & 63, lq = lane >> 4, lr = lane & 15;
#pragma unroll
    for (int ks = 0; ks < 4; ks++) {
        bf16x8 af[MI], bfr[4];
#pragma unroll
        for (int mi = 0; mi < MI; mi++) af[mi] = *(const bf16x8*)(Ag + (long)(arow0 + mi * 16 + lr) * 128 + ks * 32 + lq * 8);
#pragma unroll
        for (int ni = 0; ni < 4; ni++) {
            const char* bp = ximg + (ks * 32 + lq * 8) * 272 + (ncol0 + ni * 16 + lr) * 2;
#pragma unroll
            for (int j = 0; j < 8; j++) bfr[ni][j] = *(const short*)(bp + j * 272);
        }
#pragma unroll
        for (int mi = 0; mi < MI; mi++)
#pragma unroll
            for (int ni = 0; ni < 4; ni++) acc[mi][ni] = __builtin_amdgcn_mfma_f32_16x16x32_bf16(bfr[ni], af[mi], acc[mi][ni], 0, 0, 0);
    }
}

__device__ __forceinline__ void f2a_item(const Params& p, int it, char* lds) {
    const int tid = VTID, lane = tid & 63, wid = tid >> 6, wm = wid >> 1, wn = wid & 1, lq = lane >> 4, lr = lane & 15;
    const int nc = it & 3, s2 = (it >> 2) & 63, b = it >> 8;
    char* uimg = lds; char* ximg = lds + 17408;
    __syncthreads();
#pragma unroll
    for (int i = 0; i < 4; i++) {
        const int ci = tid + 256 * i, row = ci >> 4, cc = ci & 15;
        *(u32x4*)(uimg + row * 272 + cc * 16) = *(const u32x4*)(wsp<bf16_t>(p, OFF_UF) + ((long)(b * NS + 64 * row + s2)) * 512 + nc * 128 + cc * 8);
    }
    __syncthreads();
    {
        const int g2 = wid >> 1, T = wid & 1;
        f32x4 a1[4][4];
#pragma unroll
        for (int mi = 0; mi < 4; mi++)
#pragma unroll
            for (int ni = 0; ni < 4; ni++) a1[mi][ni] = (f32x4){0.f, 0.f, 0.f, 0.f};
        const bf16_t* t64 = wsp<bf16_t>(p, OFF_T64) + T * 4096;
#pragma unroll
        for (int ks = 0; ks < 2; ks++) {
            bf16x8 af[4], bfr[4];
#pragma unroll
            for (int i = 0; i < 4; i++) {
                af[i] = *(const bf16x8*)(uimg + (i * 16 + lr) * 272 + (g2 * 64 + ks * 32 + lq * 8) * 2);
                bfr[i] = *(const bf16x8*)(t64 + (i * 16 + lr) * 64 + ks * 32 + lq * 8);
            }
#pragma unroll
            for (int mi = 0; mi < 4; mi++)
#pragma unroll
                for (int ni = 0; ni < 4; ni++) a1[mi][ni] = __builtin_amdgcn_mfma_f32_16x16x32_bf16(bfr[ni], af[mi], a1[mi][ni], 0, 0, 0);
        }
#pragma unroll
        for (int mi = 0; mi < 4; mi++)
#pragma unroll
            for (int ni = 0; ni < 4; ni++)
                *(u32x2*)(ximg + (T * 64 + mi * 16 + lr) * 272 + (g2 * 64 + ni * 16 + 4 * lq) * 2) = pack4bf(a1[mi][ni]);
    }
    __syncthreads();
    f32x4 acc[4][4];
#pragma unroll
    for (int mi = 0; mi < 4; mi++)
#pragma unroll
        for (int ni = 0; ni < 4; ni++) acc[mi][ni] = (f32x4){0.f, 0.f, 0.f, 0.f};
    dft_mma<4>(wsp<bf16_t>(p, OFF_M1), wm * 64, ximg, wn * 64, acc);
    const float2* tw = wsp<float2>(p, OFF_TW);
#pragma unroll
    for (int m2 = 0; m2 < 2; m2++) {
        const int k1 = 32 * wm + 16 * m2 + lr;
        float2 cs; { const float rev = (float)((s2 * k1) & 4095) * (1.0f / 4096.0f); cs.x = __builtin_amdgcn_cosf(rev); cs.y = __builtin_amdgcn_sinf(rev); (void)tw; }
        const long base = ((long)(b * 64 + k1) * 64 + s2) * 512 + nc * 128 + wn * 64 + 4 * lq;
#pragma unroll
        for (int ni = 0; ni < 4; ni++) {
            const f32x4 yr = acc[m2][ni], yi = acc[m2 + 2][ni];
            const f32x4 orr = yr * cs.x - yi * cs.y, oi = yi * cs.x + yr * cs.y;
            *(u32x2*)(wsp<bf16_t>(p, OFF_YR) + base + ni * 16) = pack4bf(orr);
            *(u32x2*)(wsp<bf16_t>(p, OFF_YI) + base + ni * 16) = pack4bf(oi);
        }
    }
}

__device__ __forceinline__ void f2b_item(const Params& p, int it, char* lds) {
    const int tid = VTID, lane = tid & 63, wid = tid >> 6, wm = wid >> 1, wn = wid & 1, lq = lane >> 4, lr = lane & 15;
    const int nc = it & 3, k1 = (it >> 2) & 63, b = it >> 8;
    char* ximg = lds; char* zimg = lds + 34816;
    __syncthreads();
#pragma unroll
    for (int i = 0; i < 8; i++) {
        const int ci = tid + 256 * i, row = ci >> 4, cc = ci & 15;
        const bf16_t* src = (row < 64 ? wsp<bf16_t>(p, OFF_YR) : wsp<bf16_t>(p, OFF_YI)) + ((long)(b * 64 + k1) * 64 + (row & 63)) * 512 + nc * 128 + cc * 8;
        *(u32x4*)(ximg + row * 272 + cc * 16) = *(const u32x4*)src;
    }
    __syncthreads();
    f32x4 acc[2][4];
#pragma unroll
    for (int mi = 0; mi < 2; mi++)
#pragma unroll
        for (int ni = 0; ni < 4; ni++) acc[mi][ni] = (f32x4){0.f, 0.f, 0.f, 0.f};
    dft_mma<2>(wsp<bf16_t>(p, OFF_M3), wm * 32, ximg, wn * 64, acc);
#pragma unroll
    for (int mi = 0; mi < 2; mi++)
#pragma unroll
        for (int ni = 0; ni < 4; ni++)
            *(u32x2*)(zimg + (wm * 32 + mi * 16 + lr) * 272 + (wn * 64 + ni * 16 + 4 * lq) * 2) = pack4bf(acc[mi][ni] * (1.0f / 512.0f));
    __syncthreads();
    f32x4 a3[2][4];
#pragma unroll
    for (int mi = 0; mi < 2; mi++)
#pragma unroll
        for (int ni = 0; ni < 4; ni++) a3[mi][ni] = (f32x4){0.f, 0.f, 0.f, 0.f};
    const bf16_t* wft = wsp<bf16_t>(p, OFF_WFT) + (long)(nc * 2 + wn) * 4096;
#pragma unroll
    for (int ks = 0; ks < 2; ks++) {
        bf16x8 af[2], bfr[4];
#pragma unroll
        for (int i = 0; i < 2; i++) af[i] = *(const bf16x8*)(zimg + (wm * 32 + i * 16 + lr) * 272 + (wn * 64 + ks * 32 + lq * 8) * 2);
#pragma unroll
        for (int i = 0; i < 4; i++) bfr[i] = *(const bf16x8*)(wft + (i * 16 + lr) * 64 + ks * 32 + lq * 8);
#pragma unroll
        for (int mi = 0; mi < 2; mi++)
#pragma unroll
            for (int ni = 0; ni < 4; ni++) a3[mi][ni] = __builtin_amdgcn_mfma_f32_16x16x32_bf16(bfr[ni], af[mi], a3[mi][ni], 0, 0, 0);
    }
#pragma unroll
    for (int mi = 0; mi < 2; mi++) {
        const int k2 = wm * 32 + mi * 16 + lr;
        bf16_t* dst = wsp<bf16_t>(p, OFF_ZA) + ((long)(b * NS + k1 + 64 * k2)) * 1024 + nc * 128 + wn * 64 + 4 * lq;
#pragma unroll
        for (int ni = 0; ni < 4; ni++) *(u32x2*)(dst + ni * 16) = pack4bf(a3[mi][ni]);
    }
}

__device__ __forceinline__ void phase2(const Params& p, char* lds) {
    const int tid = threadIdx.x, lane = tid & 63, wid = tid >> 6, wm = wid >> 1, wn = wid & 1, lq = lane >> 4, lr = lane & 15;
    constexpr int N_Q = 64 * 6, N_KV = 64 * 8;
    const int lsa = (int)(gridDim.x >> 3), lsh = lsa >> 1;
    {
      gemm_256x128_stream(N_Q, 0, lsh, lsa - lsh, lds, [&](int item, GemmTile& g) {
            const int tm = item / 6, tn = item % 6;
            g.A = wsp<bf16_t>(p, OFF_UQ) + (long)tm * 256 * 384; g.lda = 384;
            g.Bt = wsp<bf16_t>(p, OFF_WQT) + (long)tn * 128 * 384; g.ldb = 384; g.K = 384;
        }, [&](int item, f32x4 (&acc)[4][4]) {
            const int tm = item / 6, tn = item % 6;
            const float qmul = 0.10206207261596575f * 1.4426950408889634f;
#pragma unroll
            for (int mi = 0; mi < 4; mi++) {
                const int row = tm * 256 + wm * 64 + mi * 16 + lr;
                const int b = row >> 12, s = row & 4095;
                const float* sq = wsp<float>(p, OFF_SSQ) + (long)row * 6;
                const float ss = sq[0] + sq[1] + sq[2] + sq[3] + sq[4] + sq[5];
                const float rs = rsqrtf(ss * (1.f / 384.f) + 1e-6f) * qmul;
                const int cb0 = tn * 128 + wn * 64;
#pragma unroll
                for (int ni = 0; ni < 4; ni++) {
                    const int cb = cb0 + ni * 16, hd = cb / 96, hob = cb % 96;
                    bf16_t* qd = wsp<bf16_t>(p, OFF_Q) + ((long)(b * 8 + hd) * NS + s) * 96;
                    if (hob < 64) {
                        *(u32x2*)(qd + hob + 4 * lq) = pack4bf(acc[mi][ni] * rs);
                    } else if (hob == 64) {
                        if (ni < 3) {
                            const float2* rp = wsp<float2>(p, OFF_ROPE) + (long)row * 16 + 4 * lq;
                            f32x4 o1, o2;
#pragma unroll
                            for (int r = 0; r < 4; r++) {
                                const float2 cs = rp[r];
                                const float x1 = acc[mi][ni][r] * rs, x2 = acc[mi][ni < 3 ? ni + 1 : 3][r] * rs;
                                o1[r] = x1 * cs.x - x2 * cs.y; o2[r] = x1 * cs.y + x2 * cs.x;
                            }
                            *(u32x2*)(qd + 64 + 4 * lq) = pack4bf(o1);
                            *(u32x2*)(qd + 80 + 4 * lq) = pack4bf(o2);
                        }
                    }
                }
            }
        });
      gemm_256x128_stream(N_KV, 0, 0, lsh ? lsh : lsa, lds, [&](int it, GemmTile& g) {
            const int tm = it >> 3, hd = it & 7;
            g.A = wsp<bf16_t>(p, OFF_UKV) + (long)tm * 256 * 256; g.lda = 256;
            g.Bt = wsp<bf16_t>(p, OFF_WKVT) + (long)hd * 128 * 256; g.ldb = 256; g.K = 256;
        }, [&](int it, f32x4 (&acc)[4][4]) {
            const int tm = it >> 3, hd = it & 7;
#pragma unroll
            for (int mi = 0; mi < 4; mi++) {
                const int row = tm * 256 + wm * 64 + mi * 16 + lr;
                const int b = row >> 12, s = row & 4095;
                const float* sq = wsp<float>(p, OFF_SSKV) + (long)row * 4;
                const float rs = rsqrtf((sq[0] + sq[1] + sq[2] + sq[3]) * (1.f / 256.f) + 1e-6f);
                if (wn == 0) {
                    bf16_t* kd = wsp<bf16_t>(p, OFF_K) + ((long)(b * 8 + hd) * NS + s) * 96;
#pragma unroll
                    for (int ni = 0; ni < 4; ni++) *(u32x2*)(kd + ni * 16 + 4 * lq) = pack4bf(acc[mi][ni] * rs);
                } else {
#pragma unroll
                    for (int ni = 0; ni < 4; ni++) {
                        bf16_t* vd = wsp<bf16_t>(p, OFF_VT) + ((long)(b * 8 + hd) * 64 + ni * 16 + 4 * lq) * NS + s;
#pragma unroll
                        for (int r = 0; r < 4; r++) vd[(long)r * NS] = (bf16_t)f2bf(acc[mi][ni][r] * rs);
                    }
                }
            }
#pragma unroll
            for (int i = 0; i < 2; i++) {
                const int ci = tid + 512 * i, r = ci >> 2, cc = ci & 3;
                const int row = tm * 256 + r, b = row >> 12, s = row & 4095;
                *(u32x4*)(wsp<bf16_t>(p, OFF_K) + ((long)(b * 8 + hd) * NS + s) * 96 + 64 + cc * 8) = *(const u32x4*)(wsp<bf16_t>(p, OFF_KR) + (long)row * 32 + cc * 8);
            }
        });
    }
}


template <int MI>
__device__ __forceinline__ void dft_mma_pre(const bf16x8 (&af)[4][MI], const char* ximg, int ncol0, f32x4 (&acc)[MI][4]) {
    const int lane = VTID & 63, lq = lane >> 4, lr = lane & 15;
#pragma unroll
    for (int ks = 0; ks < 4; ks++) {
        bf16x8 bfr[4];
#pragma unroll
        for (int ni = 0; ni < 4; ni++) {
            const char* bp = ximg + (ks * 32 + lq * 8) * 272 + (ncol0 + ni * 16 + lr) * 2;
#pragma unroll
            for (int j = 0; j < 8; j++) bfr[ni][j] = *(const short*)(bp + j * 272);
        }
#pragma unroll
        for (int mi = 0; mi < MI; mi++)
#pragma unroll
            for (int ni = 0; ni < 4; ni++) acc[mi][ni] = __builtin_amdgcn_mfma_f32_16x16x32_bf16(bfr[ni], af[ks][mi], acc[mi][ni], 0, 0, 0);
    }
}
__device__ __forceinline__ void phase2_f2a(const Params& p, char* lds) {
    const int tid = VTID, lane = tid & 63, wid = tid >> 6, wm = wid >> 1, wn = wid & 1, lq = lane >> 4, lr = lane & 15;
    char* uimg = lds; char* ximg = lds + 17408;
    const int g2 = wid >> 1, T = wid & 1;
    bf16x8 t64f[2][4], m1f[4][4];
    {
        const bf16_t* t64 = wsp<bf16_t>(p, OFF_T64) + T * 4096;
#pragma unroll
        for (int ks = 0; ks < 2; ks++)
#pragma unroll
            for (int i = 0; i < 4; i++) t64f[ks][i] = *(const bf16x8*)(t64 + (i * 16 + lr) * 64 + ks * 32 + lq * 8);
        const bf16_t* m1 = wsp<bf16_t>(p, OFF_M1);
#pragma unroll
        for (int ks = 0; ks < 4; ks++)
#pragma unroll
            for (int mi = 0; mi < 4; mi++) m1f[ks][mi] = *(const bf16x8*)(m1 + (long)(wm * 64 + mi * 16 + lr) * 128 + ks * 32 + lq * 8);
    }
    const int LN = 1024 / 8, LS = (int)(gridDim.x >> 2), xb = (int)(blockIdx.x & 7) * LN;
    int L = (int)((blockIdx.x >> 3) << 1) | VHALF;
    u32x4 ureg[4];
    auto fetch = [&](int it) {
        const int nc = it & 3, s2 = (it >> 2) & 63, b = it >> 8;
#pragma unroll
        for (int i = 0; i < 4; i++) {
            const int ci = tid + 256 * i, row = ci >> 4, cc = ci & 15;
            ureg[i] = *(const u32x4*)(wsp<bf16_t>(p, OFF_UF) + ((long)(b * NS + 64 * row + s2)) * 512 + nc * 128 + cc * 8);
        }
    };
    if (L < LN) fetch(xb + L);
    for (; L < LN; L += LS) {
        const int it = xb + L;
        const int nc = it & 3, s2 = (it >> 2) & 63, b = it >> 8;
        __syncthreads();
#pragma unroll
        for (int i = 0; i < 4; i++) {
            const int ci = tid + 256 * i, row = ci >> 4, cc = ci & 15;
            *(u32x4*)(uimg + row * 272 + cc * 16) = ureg[i];
        }
        __syncthreads();
        if (L + LS < LN) fetch(xb + L + LS);
        {
            f32x4 a1[4][4];
#pragma unroll
            for (int mi = 0; mi < 4; mi++)
#pragma unroll
                for (int ni = 0; ni < 4; ni++) a1[mi][ni] = (f32x4){0.f, 0.f, 0.f, 0.f};
#pragma unroll
            for (int ks = 0; ks < 2; ks++) {
                bf16x8 af[4];
#pragma unroll
                for (int i = 0; i < 4; i++) af[i] = *(const bf16x8*)(uimg + (i * 16 + lr) * 272 + (g2 * 64 + ks * 32 + lq * 8) * 2);
#pragma unroll
                for (int mi = 0; mi < 4; mi++)
#pragma unroll
                    for (int ni = 0; ni < 4; ni++) a1[mi][ni] = __builtin_amdgcn_mfma_f32_16x16x32_bf16(t64f[ks][ni], af[mi], a1[mi][ni], 0, 0, 0);
            }
#pragma unroll
            for (int mi = 0; mi < 4; mi++)
#pragma unroll
                for (int ni = 0; ni < 4; ni++)
                    *(u32x2*)(ximg + (T * 64 + mi * 16 + lr) * 272 + (g2 * 64 + ni * 16 + 4 * lq) * 2) = pack4bf(a1[mi][ni]);
        }
        __syncthreads();
        f32x4 acc[4][4];
#pragma unroll
        for (int mi = 0; mi < 4; mi++)
#pragma unroll
            for (int ni = 0; ni < 4; ni++) acc[mi][ni] = (f32x4){0.f, 0.f, 0.f, 0.f};
        dft_mma_pre<4>(m1f, ximg, wn * 64, acc);
#pragma unroll
        for (int m2 = 0; m2 < 2; m2++) {
            const int k1 = 32 * wm + 16 * m2 + lr;
            float2 cs; { const float rev = (float)((s2 * k1) & 4095) * (1.0f / 4096.0f); cs.x = __builtin_amdgcn_cosf(rev); cs.y = __builtin_amdgcn_sinf(rev); }
            const long base = ((long)(b * 64 + k1) * 64 + s2) * 512 + nc * 128 + wn * 64 + 4 * lq;
#pragma unroll
            for (int ni = 0; ni < 4; ni++) {
                const f32x4 yr = acc[m2][ni], yi = acc[m2 + 2][ni];
                const f32x4 orr = yr * cs.x - yi * cs.y, oi = yi * cs.x + yr * cs.y;
                *(u32x2*)(wsp<bf16_t>(p, OFF_YR) + base + ni * 16) = pack4bf(orr);
                *(u32x2*)(wsp<bf16_t>(p, OFF_YI) + base + ni * 16) = pack4bf(oi);
            }
        }
    }
}

__device__ __forceinline__ void expert_tr_job(const Params& p, int j, char* lds) {
    const int which = j >> 11, r = j & 2047, e = r >> 7, t = r & 127;
    const int k0 = (t >> 3) * 64, n0 = (t & 7) * 128;
    if (which == 0) tr_tile(p.w_exp_gate + (long)e * 1048576, 1024, k0, n0, 1024, p.g_ffn, wsp<bf16_t>(p, OFF_WGUT) + (long)e * 2048 * 1024, 1024, 1, lds);
    else if (which == 1) tr_tile(p.w_exp_up + (long)e * 1048576, 1024, k0, n0, 1024, p.g_ffn, wsp<bf16_t>(p, OFF_WGUT) + (long)e * 2048 * 1024, 1024, 2, lds);
    else tr_tile(p.w_exp_down + (long)e * 1048576, 1024, k0, n0, 1024, nullptr, wsp<bf16_t>(p, OFF_WDT) + (long)e * 1048576, 1024, 0, lds);
}

__device__ __forceinline__ void phase3_tr(const Params& p, char* lds) {
    float (*t)[132] = (float (*)[132])lds;
    const int tid = VTID, c4 = tid & 31, r0 = tid >> 5;
    f32x4 v[8]; float gv[8];
    auto issue = [&](int j) {
        const int which = j >> 11, r = j & 2047, e = r >> 7, tt = r & 127;
        const int k0 = (tt >> 3) * 64, n0 = (tt & 7) * 128;
        const float* W = (which == 0 ? p.w_exp_gate : which == 1 ? p.w_exp_up : p.w_exp_down) + (long)e * 1048576;
#pragma unroll
        for (int i = 0; i < 8; i++) {
            const int kk = r0 + 8 * i;
            v[i] = *(const f32x4*)(W + (long)(k0 + kk) * 1024 + n0 + c4 * 4);
            gv[i] = which < 2 ? p.g_ffn[k0 + kk] : 1.f;
        }
    };
    int j = VBLK;
    if (j < 6144) issue(j);
    while (j < 6144) {
        const int which = j >> 11, r = j & 2047, e = r >> 7, tt = r & 127;
        const int k0 = (tt >> 3) * 64, n0 = (tt & 7) * 128;
        __syncthreads();
#pragma unroll
        for (int i = 0; i < 8; i++) *(f32x4*)(&t[r0 + 8 * i][c4 * 4]) = v[i] * gv[i];
        __syncthreads();
        const int jn = j + VGRID;
        if (jn < 6144) issue(jn);
        bf16_t* Wt = which < 2 ? wsp<bf16_t>(p, OFF_WGUT) + (long)e * 2048 * 1024 : wsp<bf16_t>(p, OFF_WDT) + (long)e * 1048576;
#pragma unroll
        for (int i = 0; i < 4; i++) {
            const int ci = tid + 256 * i, nn = ci >> 3, kc = ci & 7;
            const int n = n0 + nn;
            int row = n;
            if (which < 2) row = (n >> 5) * 64 + ((n >> 4) & 1) * 32 + which * 16 + (n & 15);
            u32x4 w;
            w.x = pack2bf(t[kc * 8 + 0][nn], t[kc * 8 + 1][nn]);
            w.y = pack2bf(t[kc * 8 + 2][nn], t[kc * 8 + 3][nn]);
            w.z = pack2bf(t[kc * 8 + 4][nn], t[kc * 8 + 5][nn]);
            w.w = pack2bf(t[kc * 8 + 6][nn], t[kc * 8 + 7][nn]);
            *(u32x4*)(Wt + (long)row * 1024 + k0 + kc * 8) = w;
        }
        j = jn;
    }
}
__device__ __forceinline__ void phase3_f2b(const Params& p, char* lds) {
    const int tid = VTID, lane = tid & 63, wid = tid >> 6, wm = wid >> 1, wn = wid & 1, lq = lane >> 4, lr = lane & 15;
    char* ximg = lds; char* zimg = lds + 34816;
    bf16x8 m3f[4][2];
    {
        const bf16_t* m3 = wsp<bf16_t>(p, OFF_M3);
#pragma unroll
        for (int ks = 0; ks < 4; ks++)
#pragma unroll
            for (int mi = 0; mi < 2; mi++) m3f[ks][mi] = *(const bf16x8*)(m3 + (long)(wm * 32 + mi * 16 + lr) * 128 + ks * 32 + lq * 8);
    }
    const int LN = 1024 / 8, LS = (int)(gridDim.x >> 2), xb = (int)(blockIdx.x & 7) * LN;
    int L = (int)((blockIdx.x >> 3) << 1) | VHALF;
    u32x4 xreg[8];
    auto fetch = [&](int it) {
        const int nc = it & 3, k1 = (it >> 2) & 63, b = it >> 8;
#pragma unroll
        for (int i = 0; i < 8; i++) {
            const int ci = tid + 256 * i, row = ci >> 4, cc = ci & 15;
            const bf16_t* src = (row < 64 ? wsp<bf16_t>(p, OFF_YR) : wsp<bf16_t>(p, OFF_YI)) + ((long)(b * 64 + k1) * 64 + (row & 63)) * 512 + nc * 128 + cc * 8;
            xreg[i] = *(const u32x4*)src;
        }
    };
    if (L < LN) fetch(xb + L);
    for (; L < LN; L += LS) {
        const int it = xb + L;
        const int nc = it & 3, k1 = (it >> 2) & 63, b = it >> 8;
        bf16x8 wff[2][4];
        {
            const bf16_t* wft = wsp<bf16_t>(p, OFF_WFT) + (long)(nc * 2 + wn) * 4096;
#pragma unroll
            for (int ks = 0; ks < 2; ks++)
#pragma unroll
                for (int i = 0; i < 4; i++) wff[ks][i] = *(const bf16x8*)(wft + (i * 16 + lr) * 64 + ks * 32 + lq * 8);
        }
        __syncthreads();
#pragma unroll
        for (int i = 0; i < 8; i++) {
            const int ci = tid + 256 * i, row = ci >> 4, cc = ci & 15;
            *(u32x4*)(ximg + row * 272 + cc * 16) = xreg[i];
        }
        __syncthreads();
        if (L + LS < LN) fetch(xb + L + LS);
        f32x4 acc[2][4];
#pragma unroll
        for (int mi = 0; mi < 2; mi++)
#pragma unroll
            for (int ni = 0; ni < 4; ni++) acc[mi][ni] = (f32x4){0.f, 0.f, 0.f, 0.f};
        dft_mma_pre<2>(m3f, ximg, wn * 64, acc);
#pragma unroll
        for (int mi = 0; mi < 2; mi++)
#pragma unroll
            for (int ni = 0; ni < 4; ni++)
                *(u32x2*)(zimg + (wm * 32 + mi * 16 + lr) * 272 + (wn * 64 + ni * 16 + 4 * lq) * 2) = pack4bf(acc[mi][ni] * (1.0f / 512.0f));
        __syncthreads();
        f32x4 a3[2][4];
#pragma unroll
        for (int mi = 0; mi < 2; mi++)
#pragma unroll
            for (int ni = 0; ni < 4; ni++) a3[mi][ni] = (f32x4){0.f, 0.f, 0.f, 0.f};
#pragma unroll
        for (int ks = 0; ks < 2; ks++) {
            bf16x8 af[2];
#pragma unroll
            for (int i = 0; i < 2; i++) af[i] = *(const bf16x8*)(zimg + (wm * 32 + i * 16 + lr) * 272 + (wn * 64 + ks * 32 + lq * 8) * 2);
#pragma unroll
            for (int mi = 0; mi < 2; mi++)
#pragma unroll
                for (int ni = 0; ni < 4; ni++) a3[mi][ni] = __builtin_amdgcn_mfma_f32_16x16x32_bf16(wff[ks][ni], af[mi], a3[mi][ni], 0, 0, 0);
        }
#pragma unroll
        for (int mi = 0; mi < 2; mi++) {
            const int k2 = wm * 32 + mi * 16 + lr;
            bf16_t* dst = wsp<bf16_t>(p, OFF_ZA) + ((long)(b * NS + k1 + 64 * k2)) * 1024 + nc * 128 + wn * 64 + 4 * lq;
#pragma unroll
            for (int ni = 0; ni < 4; ni++) *(u32x2*)(dst + ni * 16) = pack4bf(a3[mi][ni]);
        }
    }
}

__device__ __forceinline__ void phase_resid(const Params& p, char* lds, size_t offA, size_t offW, const float* residf, const bf16_t* residb, size_t offXb, size_t offSS) {
    const int tid = VTID, lane = tid & 63, wid = tid >> 6, wm = wid >> 1, wn = wid & 1, lq = lane >> 4, lr = lane & 15;
    FOR_XCD_ITEMS(item, 128 * 8) {
        const int tm = item >> 3, tn = item & 7;
        f32x4 acc[4][4];
        GemmTile g; g.A = wsp<bf16_t>(p, offA) + (long)tm * 128 * ND; g.lda = ND; g.arow = nullptr;
        g.Bt = wsp<bf16_t>(p, offW) + (long)tn * 128 * ND; g.ldb = ND; g.K = ND;
        gemm_tile_128(g, lds, acc);
#pragma unroll
        for (int mi = 0; mi < 4; mi++) {
            const int row = tm * 128 + wm * 64 + mi * 16 + lr;
            float ss = 0.f;
#pragma unroll
            for (int ni = 0; ni < 4; ni++) {
                const long o = (long)row * ND + tn * 128 + wn * 64 + ni * 16 + 4 * lq;
                f32x4 rv;
                if (residf) rv = *(const f32x4*)(residf + o);
                else { const u32x2 w = *(const u32x2*)(residb + o); rv = (f32x4){__uint_as_float(w.x << 16), __uint_as_float(w.x & 0xFFFF0000u), __uint_as_float(w.y << 16), __uint_as_float(w.y & 0xFFFF0000u)}; }
                const f32x4 v = rv + acc[mi][ni];
                *(u32x2*)(wsp<bf16_t>(p, offXb) + o) = pack4bf(v);
                ss += v[0] * v[0] + v[1] * v[1] + v[2] * v[2] + v[3] * v[3];
            }
            ss += __shfl_xor(ss, 16); ss += __shfl_xor(ss, 32);
            if (lq == 0) wsp<float>(p, offSS)[row * 16 + tn * 2 + wn] = ss;
        }
    }
}
__device__ __forceinline__ float row_rs16(const float* ss) {
    const f32x4 a = *(const f32x4*)ss, b = *(const f32x4*)(ss + 4), c = *(const f32x4*)(ss + 8), d = *(const f32x4*)(ss + 12);
    const f32x4 t = (a + b) + (c + d);
    return rsqrtf(((t[0] + t[1]) + (t[2] + t[3])) * (1.f / 1024.f) + 1e-6f);
}

__device__ __forceinline__ void phase5a(const Params& p, char* lds) {
    const int tid = VTID, lane = tid & 63, wid = tid >> 6, wm = wid >> 1, wn = wid & 1, lq = lane >> 4, lr = lane & 15;
    FOR_XCD_ITEMS(item, 128 * 8) {
        const int tm = item >> 3, tn = item & 7;
        f32x4 acc[4][4];
        GemmTile g; g.A = wsp<bf16_t>(p, OFF_X1B) + (long)tm * 128 * ND; g.lda = ND; g.arow = nullptr;
        g.Bt = wsp<bf16_t>(p, OFF_WMQT) + (long)tn * 128 * ND; g.ldb = ND; g.K = ND;
        gemm_tile_128(g, lds, acc);
        const int h = tn >> 1;
#pragma unroll
        for (int mi = 0; mi < 4; mi++) {
            const int row = tm * 128 + wm * 64 + mi * 16 + lr, b = row >> 12, s = row & 4095;
            const float rs = row_rs16(wsp<float>(p, OFF_SS1) + (long)row * 16) * (0.0625f * 1.4426950408889634f);
            bf16_t* qd = wsp<bf16_t>(p, OFF_QM) + ((long)(b * 4 + h) * NS + s) * 256 + (tn & 1) * 128 + wn * 64 + 4 * lq;
#pragma unroll
            for (int ni = 0; ni < 4; ni++) *(u32x2*)(qd + ni * 16) = pack4bf(acc[mi][ni] * rs);
        }
    }
}
__device__ __forceinline__ void phase5b(const Params& p, char* lds) {
    FOR_XCD_ITEMS(item, NB * 4 * 32 * 2) {
        const int dvh = item & 1, qt = (item >> 1) & 31, h = (item >> 6) & 3, b = item >> 8;
        const bf16_t* Qp = wsp<bf16_t>(p, OFF_QM) + ((long)(b * 4 + h) * NS + qt * 128) * 256;
        const bf16_t* Kp = wsp<bf16_t>(p, OFF_KMEM) + ((long)(b * 4 + h) * 256) * 256;
        const bf16_t* Vtp = wsp<bf16_t>(p, OFF_VTMEM) + ((long)(b * 4 + h) * 256 + dvh * 128) * 256;
        bf16_t* Op = wsp<bf16_t>(p, OFF_OM) + ((long)b * NS + qt * 128) * 1024 + h * 256 + dvh * 128;
        attn_block<256, 128, 32, 256>(Qp, Kp, Vtp, 256L, 256, lds, [&](int q, int dv, f32x4 v) { *(u32x2*)(Op + (long)q * 1024 + dv) = pack4bf(v); });
    }
}

__device__ __forceinline__ void phase7(const Params& p, char* lds) {
    const int tid = threadIdx.x, lane = tid & 63, wid = tid >> 6, lq = lane >> 4, lr = lane & 15;
    __syncthreads();
    {
        f32x4 w0[4], w1[4];
#pragma unroll
        for (int it = 0; it < 4; it++) {
            const int u = tid + 512 * it, kp = u >> 2, eq = u & 3;
            w0[it] = *(const f32x4*)(p.w_router + (size_t)(2 * kp) * 16 + eq * 4);
            w1[it] = *(const f32x4*)(p.w_router + (size_t)(2 * kp + 1) * 16 + eq * 4);
        }
#pragma unroll
        for (int it = 0; it < 4; it++) {
            const int u = tid + 512 * it, kp = u >> 2, eq = u & 3, k = 2 * kp;
            const float g0 = p.g_ffn[k], g1 = p.g_ffn[k + 1];
#pragma unroll
            for (int j = 0; j < 4; j++) {
                const int e = eq * 4 + j;
                const float a0 = w0[it][j] * g0, a1 = w1[it][j] * g1;
                const unsigned h0 = f2bf(a0), h1 = f2bf(a1);
                const float r0 = a0 - __uint_as_float(h0 << 16), r1 = a1 - __uint_as_float(h1 << 16);
                const unsigned l0 = f2bf(r0), l1 = f2bf(r1);
                const int off = e * 2048 + ((((k >> 3) ^ e) & 127) << 4) + (k & 7) * 2;
                *(unsigned*)(lds + off) = h0 | (h1 << 16);
                *(unsigned*)(lds + 32768 + off) = l0 | (l1 << 16);
            }
        }
    }
    __syncthreads();
    for (int g = wid * (int)gridDim.x + (int)blockIdx.x; g < NT / 16; g += 8 * (int)gridDim.x) {
        const int t0 = g * 16;
        const bf16_t* xr = wsp<bf16_t>(p, OFF_X2B) + (long)(t0 + lr) * ND + lq * 8;
        bf16x8 xa[32];
#pragma unroll
        for (int ks = 0; ks < 32; ks++) xa[ks] = *(const bf16x8*)(xr + ks * 32);
        const float rsv = row_rs16(wsp<float>(p, OFF_SS2) + (long)(t0 + lr) * 16);
        if (lane < 16) wsp<float>(p, OFF_RS2)[t0 + lane] = rsv;
        f32x4 acc = (f32x4){0.f, 0.f, 0.f, 0.f};
#pragma unroll
        for (int ks = 0; ks < 32; ks++) {
            const int off = lr * 2048 + ((((ks * 4 + lq) ^ lr) & 127) << 4);
            const bf16x8 bh = *(const bf16x8*)(lds + off), bl = *(const bf16x8*)(lds + 32768 + off);
            acc = __builtin_amdgcn_mfma_f32_16x16x32_bf16(xa[ks], bh, acc, 0, 0, 0);
            acc = __builtin_amdgcn_mfma_f32_16x16x32_bf16(xa[ks], bl, acc, 0, 0, 0);
            if ((ks & 3) == 3) asm volatile("" ::: "memory");
        }
        f32x4 af4;
#pragma unroll
        for (int r = 0; r < 4; r++) {
            const float lg = acc[r] * __shfl(rsv, lq * 4 + r);
            float mx = lg;
#pragma unroll
            for (int o = 1; o < 16; o <<= 1) mx = fmaxf(mx, __shfl_xor(mx, o));
            const float ex = expf(lg - mx);
            float sm = ex;
#pragma unroll
            for (int o = 1; o < 16; o <<= 1) sm += __shfl_xor(sm, o);
            af4[r] = ex / sm;
        }
        {
            const int tk = t0 + lq * 4, bb = tk >> 12, ss = tk & 4095;
            *(f32x4*)(wsp<float>(p, OFF_AFF) + ((long)(bb * NE + lr) * NS + ss)) = af4;
        }
    }
}

__device__ __forceinline__ int block_sum_i(int v, int* red) {
    const int lane = VTID & 63, wid = VTID >> 6;
#pragma unroll
    for (int o = 32; o > 0; o >>= 1) v += __shfl_xor(v, o);
    __syncthreads();
    if (lane == 0) red[wid] = v;
    __syncthreads();
    return red[0] + red[1] + red[2] + red[3];
}
__device__ __forceinline__ int block_excl_scan_i(int v, int* red, int& total) {
    const int lane = VTID & 63, wid = VTID >> 6;
    int inc = v;
#pragma unroll
    for (int o = 1; o < 64; o <<= 1) { const int t = __shfl_up(inc, o); if (lane >= o) inc += t; }
    __syncthreads();
    if (lane == 63) red[wid] = inc;
    __syncthreads();
    int base = 0;
#pragma unroll
    for (int w = 0; w < 4; w++) if (w < wid) base += red[w];
    total = red[0] + red[1] + red[2] + red[3];
    return base + inc - v;
}
__device__ __forceinline__ void phase8(const Params& p, char* lds) {
    int* red = (int*)lds;
    const int tid = threadIdx.x, lane = tid & 63, wid = tid >> 6;
    for (int item = blockIdx.x; item < NB * NE; item += gridDim.x) {
        const int e = item & 15, b = item >> 4;
        const unsigned* aff = (const unsigned*)(wsp<float>(p, OFF_AFF) + (long)(b * NE + e) * NS) + tid * 8;
        unsigned v[8];
        { const u32x4 v0 = *(const u32x4*)aff, v1 = *(const u32x4*)(aff + 4);
          v[0] = v0.x; v[1] = v0.y; v[2] = v0.z; v[3] = v0.w; v[4] = v1.x; v[5] = v1.y; v[6] = v1.z; v[7] = v1.w; }
        const float* rs2p = wsp<float>(p, OFF_RS2) + (long)b * NS + tid * 8;
        const f32x4 rsa = *(const f32x4*)rs2p, rsb = *(const f32x4*)(rs2p + 4);
        __syncthreads();
        unsigned T = 0;
        for (int bit = 30; bit >= 0; bit--) {
            const unsigned cand = T | (1u << bit);
            int c = 0;
#pragma unroll
            for (int i = 0; i < 8; i++) c += __popcll(__ballot(v[i] >= cand));
            int* rb = red + (bit & 1) * 8;
            if (lane == 0) rb[wid] = c;
            __syncthreads();
            const i32x4 s0 = *(const i32x4*)rb, s1 = *(const i32x4*)(rb + 4);
            const int tot = (s0.x + s0.y) + (s0.z + s0.w) + (s1.x + s1.y) + (s1.z + s1.w);
            if (tot >= CAP) T = cand;
        }
        int cg = 0, ce = 0;
#pragma unroll
        for (int i = 0; i < 8; i++) { cg += (v[i] > T) ? 1 : 0; ce += (v[i] == T) ? 1 : 0; }
        const int pv = cg | (ce << 16);
        int inc = pv;
#pragma unroll
        for (int o = 1; o < 64; o <<= 1) { const int t = __shfl_up(inc, o); if (lane >= o) inc += t; }
        if (lane == 63) red[16 + wid] = inc;
        __syncthreads();
        int base = 0, tot = 0;
#pragma unroll
        for (int w = 0; w < 8; w++) { const int x = red[16 + w]; if (w < wid) base += x; tot += x; }
        const int pk = base + inc - pv;
        const int need = CAP - (tot & 0xFFFF);
        const int pg = pk & 0xFFFF;
        int eqs = pk >> 16;
        int slot = pg + (eqs < need ? eqs : need);
        int* slots = wsp<int>(p, OFF_SLOTS) + (long)(b * NE + e) * NS + tid * 8;
        int* idx = wsp<int>(p, OFF_IDX) + (long)(b * NE + e) * CAP;
        float* gate = wsp<float>(p, OFF_GATE) + (long)(b * NE + e) * CAP;
        float* rss = wsp<float>(p, OFF_RSS) + (long)(b * NE + e) * CAP;
        int so[8];
#pragma unroll
        for (int i = 0; i < 8; i++) {
            const int t = tid * 8 + i;
            bool sel = v[i] > T;
            if (v[i] == T) { sel = eqs < need; eqs++; }
            so[i] = -1;
            if (sel) { so[i] = slot; idx[slot] = b * NS + t; gate[slot] = __uint_as_float(v[i]); rss[slot] = i < 4 ? rsa[i & 3] : rsb[i & 3]; slot++; }
        }
        *(i32x4*)slots = (i32x4){so[0], so[1], so[2], so[3]};
        *(i32x4*)(slots + 4) = (i32x4){so[4], so[5], so[6], so[7]};
    }
}

__device__ __forceinline__ void phase9(const Params& p, char* lds) {
    const int tid = VTID, lane = tid & 63, wid = tid >> 6, wm = wid >> 1, wn = wid & 1, lq = lane >> 4, lr = lane & 15;
    FOR_XCD_ITEMS(item, NE * 16 * NB * 4) {
        const int rt = item & 3, b = (item >> 2) & 3, ct = (item >> 4) & 15, e = item >> 8;
        const int* arow = wsp<int>(p, OFF_IDX) + (long)(b * NE + e) * CAP + rt * 128;
        f32x4 acc[4][4];
        GemmTile g; g.A = wsp<bf16_t>(p, OFF_X2B); g.lda = ND; g.arow = arow;
        g.Bt = wsp<bf16_t>(p, OFF_WGUT) + ((long)e * 2048 + ct * 128) * ND; g.ldb = ND; g.K = ND;
        gemm_tile_128(g, lds, acc);
#pragma unroll
        for (int mi = 0; mi < 4; mi++) {
            const int r = wm * 64 + mi * 16 + lr;
            const int tok = arow[r];
            const float rs = row_rs16(wsp<float>(p, OFF_SS2) + (long)tok * 16);
            bf16_t* ad = wsp<bf16_t>(p, OFF_ACT) + ((long)(e * NB + b) * CAP + rt * 128 + r) * ND + ct * 64 + wn * 32 + 4 * lq;
#pragma unroll
            for (int pp = 0; pp < 2; pp++) {
                f32x4 o;
#pragma unroll
                for (int q = 0; q < 4; q++) {
                    const float ga = acc[mi][2 * pp][q] * rs, up = acc[mi][2 * pp + 1][q] * rs;
                    o[q] = ga / (1.f + __expf(-ga)) * up;
                }
                *(u32x2*)(ad + pp * 16) = pack4bf(o);
            }
        }
    }
}
__device__ __forceinline__ void phase10(const Params& p, char* lds) {
    const int tid = VTID, lane = tid & 63, wid = tid >> 6, wm = wid >> 1, wn = wid & 1, lq = lane >> 4, lr = lane & 15;
    FOR_XCD_ITEMS(item, NE * 8 * NB * 4) {
        const int rt = item & 3, b = (item >> 2) & 3, ct = (item >> 4) & 7, e = item >> 7;
        const long row0 = (long)(e * NB + b) * CAP + rt * 128;
        f32x4 acc[4][4];
        GemmTile g; g.A = wsp<bf16_t>(p, OFF_ACT) + row0 * ND; g.lda = ND; g.arow = nullptr;
        g.Bt = wsp<bf16_t>(p, OFF_WDT) + ((long)e * 1024 + ct * 128) * ND; g.ldb = ND; g.K = ND;
        gemm_tile_128(g, lds, acc);
        const float* gate = wsp<float>(p, OFF_GATE) + (long)(b * NE + e) * CAP + rt * 128;
#pragma unroll
        for (int mi = 0; mi < 4; mi++) {
            const int r = wm * 64 + mi * 16 + lr;
            const float gv = gate[r];
            bf16_t* yd = wsp<bf16_t>(p, OFF_Y) + (row0 + r) * ND + ct * 128 + wn * 64 + 4 * lq;
#pragma unroll
            for (int ni = 0; ni < 4; ni++) *(u32x2*)(yd + ni * 16) = pack4bf(acc[mi][ni] * gv);
        }
    }
}

__device__ __forceinline__ void phase11(const Params& p, char* lds) {
    const int tid = VTID, lane = tid & 63, wid = tid >> 6;
    const int* slots = wsp<int>(p, OFF_SLOTS);
    auto slot_of = [&](int tok) { const int b = tok >> 12, t = tok & 4095; return slots[(long)(b * NE + (lane & 15)) * NS + t]; };
    int tok = VBLK * 4 + wid;
    int sl_next = tok < NT ? slot_of(tok) : -1;
    u32x2 xn[4];
#pragma unroll
    for (int i = 0; i < 4; i++) xn[i] = *(const u32x2*)(wsp<bf16_t>(p, OFF_X2B) + (long)(tok < NT ? tok : 0) * ND + i * 256 + lane * 4);
    for (; tok < NT; tok += VGRID * 4) {
        const int b = tok >> 12;
        float* xr = p.out + (long)tok * ND;
        const int slv = sl_next;
        f32x4 v[4];
#pragma unroll
        for (int i = 0; i < 4; i++)
            v[i] = (f32x4){__uint_as_float(xn[i].x << 16), __uint_as_float(xn[i].x & 0xFFFF0000u), __uint_as_float(xn[i].y << 16), __uint_as_float(xn[i].y & 0xFFFF0000u)};
        {
            const int tn = tok + VGRID * 4;
            sl_next = tn < NT ? slot_of(tn) : -1;
#pragma unroll
            for (int i = 0; i < 4; i++) xn[i] = *(const u32x2*)(wsp<bf16_t>(p, OFF_X2B) + (long)(tn < NT ? tn : tok) * ND + i * 256 + lane * 4);
        }
        unsigned long long sel = __ballot(slv >= 0) & 0xFFFFull;
        while (sel) {
            const int e = __builtin_ctzll(sel); sel &= sel - 1;
            const int sl = __builtin_amdgcn_readlane(slv, e);
            const bf16_t* yr = wsp<bf16_t>(p, OFF_Y) + ((long)(e * NB + b) * CAP + sl) * ND;
#pragma unroll
            for (int i = 0; i < 4; i++) {
                const u32x2 w = *(const u32x2*)(yr + i * 256 + lane * 4);
                v[i][0] += __uint_as_float(w.x << 16); v[i][1] += __uint_as_float(w.x & 0xFFFF0000u);
                v[i][2] += __uint_as_float(w.y << 16); v[i][3] += __uint_as_float(w.y & 0xFFFF0000u);
            }
        }
        float ss = 0.f;
#pragma unroll
        for (int i = 0; i < 4; i++) ss += v[i][0] * v[i][0] + v[i][1] * v[i][1] + v[i][2] * v[i][2] + v[i][3] * v[i][3];
        ss = wave_sum(ss);
        const float rs = rsqrtf(ss * (1.f / ND) + 1e-6f);
#pragma unroll
        for (int i = 0; i < 4; i++) {
            const f32x4 gf = *(const f32x4*)(p.g_final + i * 256 + lane * 4);
            *(f32x4*)(xr + i * 256 + lane * 4) = v[i] * rs * gf;
        }
    }
}


__device__ __forceinline__ void phase_resid8(const Params& p, char* lds, size_t offA, size_t offW, const float* residf, const bf16_t* residb, size_t offXb, size_t offSS) {
    const int tid = threadIdx.x, lane = tid & 63, wid = tid >> 6, wm = wid >> 2, wn = wid & 3, lq = lane >> 4, lr = lane & 15;
    FOR_XCD_ITEMS_R(item, 64 * 4) {
        const int tm = item >> 2, tn = item & 3;
        f32x4 acc[8][4];
        GemmTile g; g.A = wsp<bf16_t>(p, offA) + (long)tm * 256 * ND; g.lda = ND; g.arow = nullptr;
        g.Bt = wsp<bf16_t>(p, offW) + (long)tn * 256 * ND; g.ldb = ND; g.K = ND;
        gemm_tile_256sq(g, lds, acc);
#pragma unroll
        for (int mi = 0; mi < 8; mi++) {
            const int row = tm * 256 + wm * 128 + mi * 16 + lr;
            float ss = 0.f;
#pragma unroll
            for (int ni = 0; ni < 4; ni++) {
                const long o = (long)row * ND + tn * 256 + wn * 64 + ni * 16 + 4 * lq;
                f32x4 rv;
                if (residf) rv = *(const f32x4*)(residf + o);
                else { const u32x2 w = *(const u32x2*)(residb + o); rv = (f32x4){__uint_as_float(w.x << 16), __uint_as_float(w.x & 0xFFFF0000u), __uint_as_float(w.y << 16), __uint_as_float(w.y & 0xFFFF0000u)}; }
                const f32x4 v = rv + acc[mi][ni];
                *(u32x2*)(wsp<bf16_t>(p, offXb) + o) = pack4bf(v);
                ss += v[0] * v[0] + v[1] * v[1] + v[2] * v[2] + v[3] * v[3];
            }
            ss += __shfl_xor(ss, 16); ss += __shfl_xor(ss, 32);
            if (lq == 0) wsp<float>(p, offSS)[row * 16 + tn * 4 + wn] = ss;
        }
    }
}


template <class Epi>
__device__ __forceinline__ void gemm_256sq_multi(const bf16_t* A, int lda, const int* arow, const bf16_t* Bt, int ldb, long bstep,
                                                 int K, int ntile, char* lds, Epi epi) {
    const int tid = threadIdx.x, lane = tid & 63, wid = tid >> 6, wm = wid >> 2, wn = wid & 3;
    const int lrow = lane >> 3, pc = lane & 7;
    const char* Ab = (const char*)A; const char* Bb = (const char*)Bt;
    unsigned ao[4], bo[4];
#pragma unroll
    for (int i = 0; i < 4; i++) {
        const int r = (wid * 4 + i) * 8 + lrow;
        const int c = pc ^ ((r >> 1) & 7);
        ao[i] = (unsigned)((arow ? arow[r] : r) * lda + c * 8) * 2u;
        bo[i] = (unsigned)(r * ldb + c * 8) * 2u;
    }
    const int nk = K >> 6;
    auto stage = [&](int kt, long boff, char* st) {
        const char* a0 = Ab + kt * 128;
        const char* b0 = Bb + boff * 2 + kt * 128;
#pragma unroll
        for (int i = 0; i < 4; i++) {
            __builtin_amdgcn_global_load_lds((const unsigned*)(a0 + ao[i]), (unsigned*)(st + (wid * 4 + i) * 1024), 16, 0, 0);
            __builtin_amdgcn_global_load_lds((const unsigned*)(b0 + bo[i]), (unsigned*)(st + 32768 + (wid * 4 + i) * 1024), 16, 0, 0);
        }
    };
    f32x4 acc[8][4];
    __syncthreads();
    stage(0, 0, lds);
    asm volatile("s_waitcnt vmcnt(0)" ::: "memory");
    __syncthreads();
    int q = 0;
    for (int t = 0; t < ntile; t++) {
#pragma unroll
        for (int mi = 0; mi < 8; mi++)
#pragma unroll
            for (int ni = 0; ni < 4; ni++) acc[mi][ni] = (f32x4){0.f, 0.f, 0.f, 0.f};
        const long boff = (long)t * bstep;
        for (int kt = 0; kt < nk; kt++, q++) {
            char* cur = lds + (q & 1) * 65536;
            char* nxt = lds + ((q + 1) & 1) * 65536;
            if (kt + 1 < nk) stage(kt + 1, boff, nxt);
            else if (t + 1 < ntile) stage(0, boff + bstep, nxt);
#pragma unroll
            for (int ks = 0; ks < 2; ks++) {
                bf16x8 af[8], bfr[4];
#pragma unroll
                for (int i = 0; i < 8; i++) af[i] = *(const bf16x8*)(cur + tile_off(wm * 128 + i * 16 + (lane & 15), ks * 4 + (lane >> 4)));
#pragma unroll
                for (int i = 0; i < 4; i++) bfr[i] = *(const bf16x8*)(cur + 32768 + tile_off(wn * 64 + i * 16 + (lane & 15), ks * 4 + (lane >> 4)));
                __builtin_amdgcn_s_setprio(1);
#pragma unroll
                for (int mi = 0; mi < 8; mi++)
#pragma unroll
                    for (int ni = 0; ni < 4; ni++)
                        acc[mi][ni] = __builtin_amdgcn_mfma_f32_16x16x32_bf16(bfr[ni], af[mi], acc[mi][ni], 0, 0, 0);
                __builtin_amdgcn_s_setprio(0);
            }
            asm volatile("s_waitcnt vmcnt(0)" ::: "memory");
            __syncthreads();
        }
        epi(t, acc);
    }
}
__device__ __forceinline__ void phase9_8(const Params& p, char* lds) {
    const int tid = threadIdx.x, lane = tid & 63, wid = tid >> 6, wm = wid >> 2, wn = wid & 3, lq = lane >> 4, lr = lane & 15;
    FOR_XCD_ITEMS_R(si, NE * NB * 2 * 2) {
        const int cth = si & 1, rt = (si >> 1) & 1, b = (si >> 2) & 3, e = si >> 4;
        const int* arow = wsp<int>(p, OFF_IDX) + (long)(b * NE + e) * CAP + rt * 256;
        const float* rss = wsp<float>(p, OFF_RSS) + (long)(b * NE + e) * CAP + rt * 256;
        gemm_256sq_multi(wsp<bf16_t>(p, OFF_X2B), ND, arow, wsp<bf16_t>(p, OFF_WGUT) + ((long)e * 2048 + cth * 1024) * ND, ND, 256L * ND,
                         ND, 4, lds, [&](int t, f32x4 (&acc)[8][4]) {
            const int ct = cth * 4 + t;
            char* adb = (char*)(wsp<bf16_t>(p, OFF_ACT) + ((long)(e * NB + b) * CAP + rt * 256) * ND + ct * 128);
            const unsigned ado = (unsigned)((wm * 128 + lr) * ND + wn * 32 + 4 * lq) * 2u;
#pragma unroll
            for (int mi = 0; mi < 8; mi++) {
                const float rs = rss[wm * 128 + mi * 16 + lr];
#pragma unroll
                for (int pp = 0; pp < 2; pp++) {
                    f32x4 o;
#pragma unroll
                    for (int q = 0; q < 4; q++) {
                        const float ga = acc[mi][2 * pp][q] * rs, up = acc[mi][2 * pp + 1][q] * rs;
                        o[q] = ga / (1.f + __expf(-ga)) * up;
                    }
                    *(u32x2*)(adb + (ado + (unsigned)(mi * 16 * ND * 2 + pp * 32))) = pack4bf(o);
                }
            }
        });
    }
}
__device__ __forceinline__ void phase10_8(const Params& p, char* lds) {
    const int tid = threadIdx.x, lane = tid & 63, wid = tid >> 6, wm = wid >> 2, wn = wid & 3, lq = lane >> 4, lr = lane & 15;
    FOR_XCD_ITEMS_R(si, NE * NB * 2 * 2) {
        const int cth = si & 1, rt = (si >> 1) & 1, b = (si >> 2) & 3, e = si >> 4;
        const long row0 = (long)(e * NB + b) * CAP + rt * 256;
        const float* gate = wsp<float>(p, OFF_GATE) + (long)(b * NE + e) * CAP + rt * 256;
        gemm_256sq_multi(wsp<bf16_t>(p, OFF_ACT) + row0 * ND, ND, nullptr, wsp<bf16_t>(p, OFF_WDT) + ((long)e * 1024 + cth * 512) * ND, ND, 256L * ND,
                         ND, 2, lds, [&](int t, f32x4 (&acc)[8][4]) {
            const int ct = cth * 2 + t;
            char* yb = (char*)(wsp<bf16_t>(p, OFF_Y) + row0 * ND + ct * 256);
            const unsigned yo = (unsigned)((wm * 128 + lr) * ND + wn * 64 + 4 * lq) * 2u;
#pragma unroll
            for (int mi = 0; mi < 8; mi++) {
                const float gv = gate[wm * 128 + mi * 16 + lr];
#pragma unroll
                for (int ni = 0; ni < 4; ni++) *(u32x2*)(yb + (yo + (unsigned)(mi * 16 * ND * 2 + ni * 32))) = pack4bf(acc[mi][ni] * gv);
            }
        });
    }
}


__device__ __forceinline__ void phase1_big(const Params& p, char* lds) {
    const int tid = threadIdx.x, lane = tid & 63, wid = tid >> 6, wm = wid >> 2, wn = wid & 3, lq = lane >> 4, lr = lane & 15;
    FOR_XCD_ITEMS_R(item, 64 * 4) {
        const int tm = item >> 2, tn = item & 3;
        f32x4 acc[8][4];
        GemmTile g; g.A = wsp<bf16_t>(p, OFF_XB) + (long)tm * 256 * ND; g.lda = ND; g.arow = nullptr;
        g.Bt = wsp<bf16_t>(p, OFF_W1T) + (long)tn * 256 * ND; g.ldb = ND; g.K = ND;
        gemm_tile_256sq(g, lds, acc);
        const float* r0 = wsp<float>(p, OFF_R0);
        const int col0 = tn * 256 + wn * 64;
#pragma unroll
        for (int mi = 0; mi < 8; mi++) {
            const int row = tm * 256 + wm * 128 + mi * 16 + lr;
            const float rs = r0[row];
#pragma unroll
            for (int ni = 0; ni < 4; ni++) acc[mi][ni] *= rs;
            if (col0 < 512) {
#pragma unroll
                for (int ni = 0; ni < 4; ni++)
                    *(u32x2*)(wsp<bf16_t>(p, OFF_UF) + (long)row * 512 + col0 + ni * 16 + 4 * lq) = pack4bf(acc[mi][ni]);
            } else {
                float ss = 0.f;
#pragma unroll
                for (int ni = 0; ni < 4; ni++) { const f32x4 v = acc[mi][ni]; ss += v[0] * v[0] + v[1] * v[1] + v[2] * v[2] + v[3] * v[3]; }
                ss += __shfl_xor(ss, 16); ss += __shfl_xor(ss, 32);
                if (col0 < 896) {
#pragma unroll
                    for (int ni = 0; ni < 4; ni++)
                        *(u32x2*)(wsp<bf16_t>(p, OFF_UQ) + (long)row * 384 + (col0 - 512) + ni * 16 + 4 * lq) = pack4bf(acc[mi][ni]);
                    if (lq == 0) wsp<float>(p, OFF_SSQ)[row * 6 + ((col0 - 512) >> 6)] = ss;
                } else {
#pragma unroll
                    for (int ni = 0; ni < 4; ni++)
                        *(u32x2*)(wsp<bf16_t>(p, OFF_UKV) + (long)row * 256 + (col0 - 896) + ni * 16 + 4 * lq) = pack4bf(acc[mi][ni]);
                    if (lq == 0) wsp<float>(p, OFF_SSKV)[row * 4 + ((col0 - 896) >> 6)] = ss;
                }
            }
        }
    }
}


__device__ __forceinline__ void phase3_attn8(const Params& p, char* lds) {
    FOR_XCD_ITEMS_R(item, NB * 8 * (NS / 256)) {
        const int qt = item & 15, h = (item >> 4) & 7, b = item >> 7;
        const bf16_t* Qp = wsp<bf16_t>(p, OFF_Q) + ((long)(b * 8 + h) * NS + qt * 256) * 96;
        const bf16_t* Kp = wsp<bf16_t>(p, OFF_K) + ((long)(b * 8 + h) * NS) * 96;
        const bf16_t* Vtp = wsp<bf16_t>(p, OFF_VT) + ((long)(b * 8 + h) * 64) * NS;
        bf16_t* Op = wsp<bf16_t>(p, OFF_ZA) + ((long)b * NS + qt * 256) * 1024 + 512 + h * 64;
        attn_block<96, 64, 128, 512>(Qp, Kp, Vtp, (long)NS, NS, lds, [&](int q, int dv, f32x4 v) { *(u32x2*)(Op + (long)q * 1024 + dv) = pack4bf(v); });
    }
}
__device__ __forceinline__ void cross_attn_item(const Params& p, char* lds, int b, int hd, int qt) {
    constexpr int KROW = 256 * 2 + 16, VROW = 32 * 2 + 8, SLOT = 256 * VROW;
    const int tid = threadIdx.x, lane = tid & 63, wid = tid >> 6, h = lane >> 5, c = lane & 31;
    {
        const bf16_t* Qp = wsp<bf16_t>(p, OFF_QM) + ((long)(b * 4 + hd) * NS + qt * 256) * 256;
        const bf16_t* Kp = wsp<bf16_t>(p, OFF_KMEM) + ((long)(b * 4 + hd) * 256) * 256;
        const bf16_t* Vtp = wsp<bf16_t>(p, OFF_VTMEM) + ((long)(b * 4 + hd) * 256) * 256;
        bf16_t* Op = wsp<bf16_t>(p, OFF_OM) + ((long)b * NS + qt * 256) * 1024 + hd * 256;
        u32x4 gr[2];
        auto gload = [&](int t) {
#pragma unroll
            for (int i = 0; i < 2; i++) {
                const int ci = tid + 512 * i;
                if (t < 8) { const int row = ci >> 5, cc = ci & 31; gr[i] = *(const u32x4*)(Kp + (long)(t * 32 + row) * 256 + cc * 8); }
                else { const int row = ci >> 2, cc = ci & 3; gr[i] = *(const u32x4*)(Vtp + (long)row * 256 + (t - 8) * 32 + cc * 8); }
            }
        };
        auto lwrite = [&](int t, char* st) {
#pragma unroll
            for (int i = 0; i < 2; i++) {
                const int ci = tid + 512 * i;
                if (t < 8) { const int row = ci >> 5, cc = ci & 31; *(u32x4*)(st + row * KROW + cc * 16) = gr[i]; }
                else { const int row = ci >> 2, cc = ci & 3; char* q = st + row * VROW + cc * 16; *(u32x2*)q = (u32x2){gr[i].x, gr[i].y}; *(u32x2*)(q + 8) = (u32x2){gr[i].z, gr[i].w}; }
            }
        };
        gload(0);
        bf16x8 qf[16];
        {
            const bf16_t* qrow = Qp + (long)(wid * 32 + c) * 256 + 8 * h;
#pragma unroll
            for (int ks = 0; ks < 16; ks++) qf[ks] = *(const bf16x8*)(qrow + 16 * ks);
        }
        __syncthreads();
        lwrite(0, lds);
        __syncthreads();
        f32x16 s[8];
#pragma unroll
        for (int t = 0; t < 8; t++) {
            const char* cur = lds + (t & 1) * SLOT;
            gload(t + 1);
#pragma unroll
            for (int r = 0; r < 16; r++) s[t][r] = 0.f;
#pragma unroll
            for (int ks = 0; ks < 16; ks++) {
                const bf16x8 kf = *(const bf16x8*)(cur + c * KROW + ks * 32 + h * 16);
                s[t] = __builtin_amdgcn_mfma_f32_32x32x16_bf16(kf, qf[ks], s[t], 0, 0, 0);
            }
            lwrite(t + 1, lds + ((t + 1) & 1) * SLOT);
            __syncthreads();
        }
        float mx = s[0][0];
#pragma unroll
        for (int t = 0; t < 8; t++)
#pragma unroll
            for (int r = 0; r < 16; r++) mx = fmaxf(mx, s[t][r]);
        mx = fmaxf(mx, __shfl_xor(mx, 32));
        float l = 0.f;
        bf16x8 pf[16];
#pragma unroll
        for (int t = 0; t < 8; t++) {
#pragma unroll
            for (int r = 0; r < 16; r++) { const float e = __builtin_amdgcn_exp2f(s[t][r] - mx); l += e; s[t][r] = e; }
#pragma unroll
            for (int u = 0; u < 2; u++) {
                u32x4 pw;
                pw.x = pack2bf(s[t][8 * u + 0], s[t][8 * u + 1]);
                pw.y = pack2bf(s[t][8 * u + 2], s[t][8 * u + 3]);
                pw.z = pack2bf(s[t][8 * u + 4], s[t][8 * u + 5]);
                pw.w = pack2bf(s[t][8 * u + 6], s[t][8 * u + 7]);
                pf[2 * t + u] = __builtin_bit_cast(bf16x8, pw);
            }
        }
        l += __shfl_xor(l, 32);
        f32x16 o[8];
#pragma unroll
        for (int dt = 0; dt < 8; dt++)
#pragma unroll
            for (int r = 0; r < 16; r++) o[dt][r] = 0.f;
#pragma unroll
        for (int v = 0; v < 8; v++) {
            const char* cur = lds + (v & 1) * SLOT;
            if (v + 1 < 8) gload(8 + v + 1);
#pragma unroll
            for (int u = 0; u < 2; u++)
#pragma unroll
                for (int dt = 0; dt < 8; dt++) {
                    const char* vp = cur + (dt * 32 + c) * VROW + (u * 16 + 4 * h) * 2;
                    const u32x2 v0 = *(const u32x2*)(vp);
                    const u32x2 v1 = *(const u32x2*)(vp + 16);
                    const bf16x8 vf = __builtin_bit_cast(bf16x8, ((u32x4){v0.x, v0.y, v1.x, v1.y}));
                    o[dt] = __builtin_amdgcn_mfma_f32_32x32x16_bf16(vf, pf[2 * v + u], o[dt], 0, 0, 0);
                }
            if (v + 1 < 8) lwrite(8 + v + 1, lds + ((v + 1) & 1) * SLOT);
            __syncthreads();
        }
        const float inv = 1.f / l;
#pragma unroll
        for (int dt = 0; dt < 8; dt++)
#pragma unroll
            for (int g4 = 0; g4 < 4; g4++) {
                const f32x4 v = {o[dt][4 * g4 + 0] * inv, o[dt][4 * g4 + 1] * inv, o[dt][4 * g4 + 2] * inv, o[dt][4 * g4 + 3] * inv};
                *(u32x2*)(Op + (long)(wid * 32 + c) * 1024 + dt * 32 + 8 * g4 + 4 * h) = pack4bf(v);
            }
    }
}
__device__ __forceinline__ void phase5_fused(const Params& p, char* lds) {
    const int tid = threadIdx.x, lane = tid & 63, wid = tid >> 6, wm = wid >> 2, wn = wid & 3, lq = lane >> 4, lr = lane & 15;
    FOR_XCD_ITEMS_R(item, 64 * 4) {
        const int tm = item >> 2, tn = item & 3;
        f32x4 acc[8][4];
        GemmTile g; g.A = wsp<bf16_t>(p, OFF_X1B) + (long)tm * 256 * ND; g.lda = ND; g.arow = nullptr;
        g.Bt = wsp<bf16_t>(p, OFF_WMQT) + (long)tn * 256 * ND; g.ldb = ND; g.K = ND;
        gemm_tile_256sq(g, lds, acc);
#pragma unroll
        for (int mi = 0; mi < 8; mi++) {
            const int row = tm * 256 + wm * 128 + mi * 16 + lr, b = row >> 12, s = row & 4095;
            const float rs = row_rs16(wsp<float>(p, OFF_SS1) + (long)row * 16) * (0.0625f * 1.4426950408889634f);
            bf16_t* qd = wsp<bf16_t>(p, OFF_QM) + ((long)(b * 4 + tn) * NS + s) * 256 + wn * 64 + 4 * lq;
#pragma unroll
            for (int ni = 0; ni < 4; ni++) *(u32x2*)(qd + ni * 16) = pack4bf(acc[mi][ni] * rs);
        }
    }
    __builtin_amdgcn_fence(__ATOMIC_RELEASE, "workgroup");
    asm volatile("s_waitcnt vmcnt(0)" ::: "memory");
    __syncthreads();
    __builtin_amdgcn_fence(__ATOMIC_ACQUIRE, "workgroup");
}
__device__ __forceinline__ void phase5_cross(const Params& p, char* lds) {
    FOR_XCD_ITEMS_R(item, 64 * 4) {
        const int tm = item >> 2, tn = item & 3;
        cross_attn_item(p, lds, tm >> 4, tn, tm & 15);
    }
}

__global__ void __launch_bounds__(512, 1) k_fwd(Params p, int ph_lo, int ph_hi) {
    extern __shared__ __attribute__((aligned(16))) char lds_all[];
    char* lds = lds_all + VHALF * LDS_HALF;
    volatile LAS unsigned* st = (volatile LAS unsigned*)(lds_all + LDS_MAIN);
    if (threadIdx.x == 0) { st[0] = 0u; st[1] = 0u; }
    __syncthreads();
    XcdBarrier bar = xcd_barrier_post(wsp<unsigned>(p, OFF_BAR), st);
#if USE_CG_SYNC
#define GRID_BARRIER() do { asm volatile("s_waitcnt vmcnt(0)" ::: "memory"); __syncthreads(); cg::this_grid().sync(); asm volatile("s_waitcnt vmcnt(0)" ::: "memory"); __syncthreads(); } while (0)
#else
#define GRID_BARRIER() xcd_barrier(bar)
#endif
#define RUN_PHASE(k, call) if (ph_lo <= (k) && (k) < ph_hi) { if ((k) > ph_lo) { GRID_BARRIER(); } call; }
    RUN_PHASE(0, phase0(p, lds))
    RUN_PHASE(1, (phase1_big(p, lds_all), phase1(p, lds_all)))
    RUN_PHASE(2, (phase2(p, lds_all), phase2_f2a(p, lds)))
    RUN_PHASE(3, ((blockIdx.x & 1) ? phase3_tr(p, lds) : (void)0, phase3_attn8(p, lds_all), phase3_f2b(p, lds), (blockIdx.x & 1) ? (void)0 : phase3_tr(p, lds)))
    RUN_PHASE(4, phase_resid8(p, lds_all, OFF_ZA, OFF_WOUTT, p.x, nullptr, OFF_X1B, OFF_SS1))
    RUN_PHASE(5, (phase5_fused(p, lds_all), phase5_cross(p, lds_all)))
    RUN_PHASE(6, phase_resid8(p, lds_all, OFF_OM, OFF_WMOT, nullptr, wsp<bf16_t>(p, OFF_X1B), OFF_X2B, OFF_SS2))
    RUN_PHASE(7, phase7(p, lds_all))
    RUN_PHASE(8, phase8(p, lds_all))
    RUN_PHASE(9, phase9_8(p, lds_all))
    RUN_PHASE(10, phase10_8(p, lds_all))
    RUN_PHASE(11, phase11(p, lds))
}

extern "C" void kernel_launch(void* const* d_in, const int* in_sizes, int n_in,
                              void* d_out, int out_size, void* d_ws, size_t ws_size,
                              hipStream_t stream) {
    static int grid = 0;
    if (grid == 0) {
        if (n_in != 22 || ws_size < WS_END) { fprintf(stderr, "kernel_launch: unexpected inputs (n_in %d, ws %zu < %zu)\n", n_in, ws_size, (size_t)WS_END); grid = -1; return; }
        int dev = 0, cus = 0, per_cu = 0;
        (void)hipGetDevice(&dev);
        (void)hipDeviceGetAttribute(&cus, hipDeviceAttributeMultiprocessorCount, dev);
        if (hipFuncSetAttribute((const void*)k_fwd, hipFuncAttributeMaxDynamicSharedMemorySize, LDS_TOTAL) != hipSuccess) { fprintf(stderr, "kernel_launch: hipFuncSetAttribute failed\n"); grid = -1; return; }
        if (hipOccupancyMaxActiveBlocksPerMultiprocessor(&per_cu, (const void*)k_fwd, 512, LDS_TOTAL) != hipSuccess || per_cu < 1) { fprintf(stderr, "kernel_launch: occupancy query failed (%d)\n", per_cu); (void)hipGetLastError(); per_cu = 1; }
        if (per_cu > 1) per_cu = 1;
        grid = (cus * per_cu) & ~7;
        if (grid < 8) { fprintf(stderr, "kernel_launch: unexpected device (%d CUs)\n", cus); grid = -1; return; }
        fprintf(stderr, "kernel_launch: %d CUs x %d blocks\n", cus, per_cu);
    }
    if (grid < 0) return;
    Params p{};
    p.x = (const float*)d_in[0]; p.mem = (const float*)d_in[1]; p.pos = (const int*)d_in[2];
    p.g_mix = (const float*)d_in[3]; p.w_in = (const float*)d_in[4]; p.g_q_lat = (const float*)d_in[5]; p.w_q_up = (const float*)d_in[6];
    p.g_kv_lat = (const float*)d_in[7]; p.w_kv_up = (const float*)d_in[8]; p.w_fourier = (const float*)d_in[9]; p.w_out = (const float*)d_in[10];
    p.g_mem_q = (const float*)d_in[11]; p.g_mem_kv = (const float*)d_in[12]; p.w_mem_q = (const float*)d_in[13]; p.w_mem_kv = (const float*)d_in[14];
    p.w_mem_o = (const float*)d_in[15]; p.g_ffn = (const float*)d_in[16]; p.w_router = (const float*)d_in[17];
    p.w_exp_gate = (const float*)d_in[18]; p.w_exp_up = (const float*)d_in[19]; p.w_exp_down = (const float*)d_in[20]; p.g_final = (const float*)d_in[21];
    p.out = (float*)d_out; p.ws = (char*)d_ws;
    static const int cuts[] = MK_CUTS;
    const int ncut = (int)(sizeof(cuts) / sizeof(int));
    for (int li = 0; li + 1 < ncut; li++) {
        (void)hipMemsetAsync((char*)d_ws + OFF_BAR, 0, 16384, stream);
        int lo = cuts[li], hi = cuts[li + 1];
        void* args[] = {&p, &lo, &hi};
        hipError_t e = hipLaunchCooperativeKernel((const void*)k_fwd, dim3(grid), dim3(512), args, LDS_TOTAL, stream);
        if (e != hipSuccess) fprintf(stderr, "cooperative launch failed: %s (grid %d)\n", hipGetErrorString(e), grid);
    }
}
```

```cpp
#include <hip/hip_runtime.h>
#include <stdint.h>
#include <cstdio>
#include <hip/hip_cooperative_groups.h>
namespace cg = cooperative_groups;
#ifndef USE_CG_SYNC
#define USE_CG_SYNC 0
#endif

#ifndef MK_CUTS
#define MK_CUTS {0, 12}
#endif

#define NB 4
#define NS 4096
#define ND 1024
#define NT (NB * NS)
#define INW 1184
#define NE 16
#define CAP 512
#define MEML 256
#define NPHASE 12
#define VTID ((int)(threadIdx.x & 255))
#define VHALF (__builtin_amdgcn_readfirstlane((int)(threadIdx.x >> 8)))
#define VBLK ((int)(blockIdx.x * 2) + VHALF)
#define VGRID ((int)(gridDim.x * 2))

typedef unsigned short bf16_t;
typedef short bf16x8 __attribute__((ext_vector_type(8)));
typedef float f32x4 __attribute__((ext_vector_type(4)));
typedef float f32x16 __attribute__((ext_vector_type(16)));
typedef unsigned u32x4 __attribute__((ext_vector_type(4)));
typedef int i32x4 __attribute__((ext_vector_type(4)));
typedef unsigned u32x2 __attribute__((ext_vector_type(2)));

__device__ __forceinline__ unsigned f2bf(float f) {
    unsigned u = __float_as_uint(f);
    u += 0x7FFFu + ((u >> 16) & 1u);
    return u >> 16;
}
typedef __bf16 hbf2 __attribute__((ext_vector_type(2)));
typedef float f32x2 __attribute__((ext_vector_type(2)));
__device__ __forceinline__ unsigned pack2bf(float lo, float hi) { f32x2 v = {lo, hi}; return __builtin_bit_cast(unsigned, __builtin_convertvector(v, hbf2)); }
__device__ __forceinline__ float bf2f(unsigned short b) { return __uint_as_float(((unsigned)b) << 16); }

__device__ __forceinline__ int tile_off(int row, int chunk) { return row * 128 + ((chunk ^ ((row >> 1) & 7)) << 4); }

#define GT_LDS_BYTES 65536

struct GemmTile { const bf16_t* A; long lda; const int* arow; const bf16_t* Bt; long ldb; int K; };

__device__ __forceinline__ void gemm_tile_128(const GemmTile& g, char* lds, f32x4 (&acc)[4][4]) {
    const int tid = VTID, lane = tid & 63, wid = tid >> 6, wm = wid >> 1, wn = wid & 1;
    const int lrow = lane >> 3, pc = lane & 7;
    const bf16_t* ap[4]; const bf16_t* bp[4];
#pragma unroll
    for (int i = 0; i < 4; i++) {
        const int r = (wid * 4 + i) * 8 + lrow;
        const int c = pc ^ ((r >> 1) & 7);
        const long ro = g.arow ? (long)g.arow[r] * g.lda : (long)r * g.lda;
        ap[i] = g.A + ro + c * 8;
        bp[i] = g.Bt + (long)r * g.ldb + c * 8;
    }
#pragma unroll
    for (int mi = 0; mi < 4; mi++)
#pragma unroll
        for (int ni = 0; ni < 4; ni++) acc[mi][ni] = (f32x4){0.f, 0.f, 0.f, 0.f};
    const int nk = g.K >> 6;
    auto stage = [&](int kt, char* st) {
#pragma unroll
        for (int i = 0; i < 4; i++) {
            __builtin_amdgcn_global_load_lds((const unsigned*)(ap[i] + kt * 64), (unsigned*)(st + (wid * 4 + i) * 1024), 16, 0, 0);
            __builtin_amdgcn_global_load_lds((const unsigned*)(bp[i] + kt * 64), (unsigned*)(st + 16384 + (wid * 4 + i) * 1024), 16, 0, 0);
        }
    };
    __syncthreads();
    stage(0, lds);
    asm volatile("s_waitcnt vmcnt(0)" ::: "memory");
    __syncthreads();
    for (int kt = 0; kt < nk; kt++) {
        char* cur = lds + (kt & 1) * 32768;
        if (kt + 1 < nk) stage(kt + 1, lds + ((kt + 1) & 1) * 32768);
        bf16x8 af[2][4], bfr[2][4];
#pragma unroll
        for (int ks = 0; ks < 2; ks++)
#pragma unroll
            for (int i = 0; i < 4; i++) {
                af[ks][i] = *(const bf16x8*)(cur + tile_off(wm * 64 + i * 16 + (lane & 15), ks * 4 + (lane >> 4)));
                bfr[ks][i] = *(const bf16x8*)(cur + 16384 + tile_off(wn * 64 + i * 16 + (lane & 15), ks * 4 + (lane >> 4)));
            }
        __builtin_amdgcn_s_setprio(1);
#pragma unroll
        for (int ks = 0; ks < 2; ks++)
#pragma unroll
            for (int mi = 0; mi < 4; mi++)
#pragma unroll
                for (int ni = 0; ni < 4; ni++)
                    acc[mi][ni] = __builtin_amdgcn_mfma_f32_16x16x32_bf16(bfr[ks][ni], af[ks][mi], acc[mi][ni], 0, 0, 0);
        __builtin_amdgcn_s_setprio(0);
        asm volatile("s_waitcnt vmcnt(0)" ::: "memory");
        __syncthreads();
    }
}

template <int DQK, int DVT, int KT>
struct AttnCfg {
    static constexpr int KROW = DQK * 2 + 16;
    static constexpr int VROW = KT * 2 + 8;
    static constexpr int KBYTES = KT * KROW;
    static constexpr int VBYTES = DVT * VROW;
    static constexpr int STAGE = KBYTES + VBYTES;
    static constexpr int LDS = 2 * STAGE;
};

template <int DQK, int DVT, int KT, int NTH, class Out>
__device__ __forceinline__ void attn_block(const bf16_t* Qp, const bf16_t* Kp, const bf16_t* Vtp, long ldv, int nk, char* lds, Out&& out) {
    typedef AttnCfg<DQK, DVT, KT> C;
    constexpr int NKS = DQK / 16, NST = KT / 32, NDT = DVT / 32, NPS = KT / 16;
    constexpr int KCPR = DQK / 8;
    constexpr int KTOT = KT * KCPR, KCH = (KTOT + NTH - 1) / NTH;
    constexpr int VCPR = KT / 8;
    constexpr int VTOT = DVT * VCPR, VCH = (VTOT + NTH - 1) / NTH;
    const int tid = NTH == 512 ? (int)threadIdx.x : VTID, lane = tid & 63, wid = tid >> 6, h = lane >> 5, c = lane & 31;

    bf16x8 qf[NKS];
    {
        const bf16_t* qrow = Qp + (long)(wid * 32 + c) * DQK + 8 * h;
#pragma unroll
        for (int ks = 0; ks < NKS; ks++) qf[ks] = *(const bf16x8*)(qrow + 16 * ks);
    }
    f32x16 o[NDT];
#pragma unroll
    for (int dt = 0; dt < NDT; dt++)
#pragma unroll
        for (int r = 0; r < 16; r++) o[dt][r] = 0.f;
    float m = 0.f, l = 0.f;

    u32x4 kr[KCH], vr[VCH];
    auto gload = [&](int t) {
#pragma unroll
        for (int i = 0; i < KCH; i++) {
            const int ci = tid + NTH * i, row = ci / KCPR, cc = ci % KCPR;
            if (KTOT % NTH == 0 || ci < KTOT) kr[i] = *(const u32x4*)(Kp + (long)(t * KT + row) * DQK + cc * 8);
        }
#pragma unroll
        for (int i = 0; i < VCH; i++) {
            const int ci = tid + NTH * i, row = ci / VCPR, cc = ci % VCPR;
            if (VTOT % NTH == 0 || ci < VTOT) vr[i] = *(const u32x4*)(Vtp + (long)row * ldv + t * KT + cc * 8);
        }
    };
    auto lwrite = [&](char* st) {
#pragma unroll
        for (int i = 0; i < KCH; i++) {
            const int ci = tid + NTH * i, row = ci / KCPR, cc = ci % KCPR;
            if (KTOT % NTH == 0 || ci < KTOT) *(u32x4*)(st + row * C::KROW + cc * 16) = kr[i];
        }
#pragma unroll
        for (int i = 0; i < VCH; i++) {
            const int ci = tid + NTH * i, row = ci / VCPR, cc = ci % VCPR;
            if (VTOT % NTH == 0 || ci < VTOT) {
                char* p = st + C::KBYTES + row * C::VROW + cc * 16;
                *(u32x2*)(p) = (u32x2){vr[i].x, vr[i].y};
                *(u32x2*)(p + 8) = (u32x2){vr[i].z, vr[i].w};
            }
        }
    };
    const int nt = nk / KT;
    gload(0);
    __syncthreads();
    lwrite(lds);
    __syncthreads();
    for (int t = 0; t < nt; t++) {
        char* cur = lds + (t & 1) * C::STAGE;
        if (t + 1 < nt) gload(t + 1);
        f32x16 s[NST];
        const float negm = -m;
#pragma unroll
        for (int st = 0; st < NST; st++) {
#pragma unroll
            for (int r = 0; r < 16; r++) s[st][r] = negm;
#pragma unroll
            for (int ks = 0; ks < NKS; ks++) {
                const bf16x8 kf = *(const bf16x8*)(cur + (st * 32 + c) * C::KROW + ks * 32 + h * 16);
                s[st] = __builtin_amdgcn_mfma_f32_32x32x16_bf16(kf, qf[ks], s[st], 0, 0, 0);
            }
        }
        float mx = s[0][0];
#pragma unroll
        for (int st = 0; st < NST; st++)
#pragma unroll
            for (int r = 0; r < 16; r++) mx = fmaxf(mx, s[st][r]);
        mx = fmaxf(mx, __shfl_xor(mx, 32));
        if (__any(mx > 8.0f)) {
            const float d = fmaxf(mx, 0.f);
            const float alpha = __builtin_amdgcn_exp2f(-d);
            m += d;
            l *= alpha;
#pragma unroll
            for (int dt = 0; dt < NDT; dt++)
#pragma unroll
                for (int r = 0; r < 16; r++) o[dt][r] *= alpha;
#pragma unroll
            for (int st = 0; st < NST; st++)
#pragma unroll
                for (int r = 0; r < 16; r++) s[st][r] -= d;
        }
        float rs = 0.f;
#pragma unroll
        for (int st = 0; st < NST; st++)
#pragma unroll
            for (int r = 0; r < 16; r++) { const float p = __builtin_amdgcn_exp2f(s[st][r]); rs += p; s[st][r] = p; }
        l += rs;
#pragma unroll
        for (int ps = 0; ps < NPS; ps++) {
            const int st = ps >> 1, u = ps & 1;
            u32x4 pw;
            pw.x = pack2bf(s[st][8 * u + 0], s[st][8 * u + 1]);
            pw.y = pack2bf(s[st][8 * u + 2], s[st][8 * u + 3]);
            pw.z = pack2bf(s[st][8 * u + 4], s[st][8 * u + 5]);
            pw.w = pack2bf(s[st][8 * u + 6], s[st][8 * u + 7]);
            const bf16x8 pf = __builtin_bit_cast(bf16x8, pw);
#pragma unroll
            for (int dt = 0; dt < NDT; dt++) {
                const char* vp = cur + C::KBYTES + (dt * 32 + c) * C::VROW + (ps * 16 + 4 * h) * 2;
                const u32x2 v0 = *(const u32x2*)(vp);
                const u32x2 v1 = *(const u32x2*)(vp + 16);
                const bf16x8 vf = __builtin_bit_cast(bf16x8, ((u32x4){v0.x, v0.y, v1.x, v1.y}));
                o[dt] = __builtin_amdgcn_mfma_f32_32x32x16_bf16(vf, pf, o[dt], 0, 0, 0);
            }
        }
        if (t + 1 < nt) lwrite(lds + ((t + 1) & 1) * C::STAGE);
        __syncthreads();
    }
    l += __shfl_xor(l, 32);
    const float inv = 1.f / l;
#pragma unroll
    for (int dt = 0; dt < NDT; dt++)
#pragma unroll
        for (int g4 = 0; g4 < 4; g4++) {
            f32x4 v = {o[dt][4 * g4 + 0] * inv, o[dt][4 * g4 + 1] * inv, o[dt][4 * g4 + 2] * inv, o[dt][4 * g4 + 3] * inv};
            out(wid * 32 + c, dt * 32 + 8 * g4 + 4 * h, v);
        }
}


constexpr size_t SLOT = 33554432;
constexpr size_t OFF_W1T = 0;
constexpr size_t OFF_WQT = OFF_W1T + 1280UL * 1024 * 2;
constexpr size_t OFF_WKVT = OFF_WQT + 768UL * 384 * 2;
constexpr size_t OFF_WOUTT = OFF_WKVT + 1024UL * 256 * 2;
constexpr size_t OFF_WMQT = OFF_WOUTT + 1024UL * 1024 * 2;
constexpr size_t OFF_WMKVT = OFF_WMQT + 1024UL * 1024 * 2;
constexpr size_t OFF_WMOT = OFF_WMKVT + 2048UL * 1024 * 2;
constexpr size_t OFF_WGUT = OFF_WMOT + 1024UL * 1024 * 2;
constexpr size_t OFF_WDT = OFF_WGUT + 16UL * 2048 * 1024 * 2;
constexpr size_t OFF_T64 = OFF_WDT + 16UL * 1024 * 1024 * 2;
constexpr size_t OFF_M1 = OFF_T64 + 16384;
constexpr size_t OFF_M3 = OFF_M1 + 32768;
constexpr size_t OFF_WFT = OFF_M3 + 16384;
constexpr size_t OFF_TW = OFF_WFT + 65536;
constexpr size_t OFF_ROPE = OFF_TW + 32768;
constexpr size_t OFF_R0 = OFF_ROPE + (size_t)NT * 16 * 8;
constexpr size_t OFF_RMEM = OFF_R0 + (size_t)NT * 4;
constexpr size_t OFF_SSQ = OFF_RMEM + 4096;
constexpr size_t OFF_SSKV = OFF_SSQ + (size_t)NT * 6 * 4;
constexpr size_t OFF_SS1 = OFF_SSKV + (size_t)NT * 4 * 4;
constexpr size_t OFF_SS2 = OFF_SS1 + (size_t)NT * 16 * 4;
constexpr size_t OFF_AFF = OFF_SS2 + (size_t)NT * 16 * 4;
constexpr size_t OFF_SLOTS = OFF_AFF + (size_t)NT * 16 * 4;
constexpr size_t OFF_IDX = OFF_SLOTS + 4UL * 16 * 4096 * 4;
constexpr size_t OFF_GATE = OFF_IDX + 4UL * 16 * 512 * 4;
constexpr size_t OFF_MEMB = OFF_GATE + 4UL * 16 * 512 * 4;
constexpr size_t OFF_KMEM = OFF_MEMB + 1024UL * 1024 * 2;
constexpr size_t OFF_VTMEM = OFF_KMEM + 1024UL * 1024 * 2;
constexpr size_t OFF_KR = OFF_VTMEM + 1024UL * 1024 * 2;
constexpr size_t OFF_BAR = OFF_KR + (size_t)NT * 32 * 2;
constexpr size_t OFF_RS2 = OFF_BAR + 16384;
constexpr size_t OFF_RSS = OFF_RS2 + (size_t)NT * 4;
constexpr size_t OFF_S0 = (OFF_RSS + 4UL * 16 * 512 * 4 + 255) / 256 * 256;
constexpr size_t OFF_S1 = OFF_S0 + SLOT;
constexpr size_t OFF_S2 = OFF_S1 + SLOT;
constexpr size_t OFF_S3 = OFF_S2 + SLOT;
constexpr size_t OFF_S4 = OFF_S3 + SLOT;
constexpr size_t WS_END = OFF_S4 + SLOT;
static_assert(WS_END <= 300964352UL, "workspace map exceeds the guaranteed scratch size");
constexpr size_t OFF_XB = OFF_S0, OFF_YR = OFF_S0, OFF_YI = OFF_S0 + SLOT / 2, OFF_X1B = OFF_S3, OFF_OM = OFF_S0, OFF_ACT = OFF_S0;
constexpr size_t OFF_UF = OFF_S1, OFF_UQ = OFF_S1 + (size_t)NT * 512 * 2, OFF_ZA = OFF_S1, OFF_QM = OFF_S1;
constexpr size_t OFF_Q = OFF_S2, OFF_UKV = OFF_S2 + (size_t)NT * 768 * 2, OFF_X2B = OFF_S2;
constexpr size_t OFF_K = OFF_S3, OFF_Y = OFF_S3;
constexpr size_t OFF_VT = OFF_S4;

struct Params {
    const float *x, *mem; const int* pos;
    const float *g_mix, *w_in, *g_q_lat, *w_q_up, *g_kv_lat, *w_kv_up, *w_fourier, *w_out, *g_mem_q, *g_mem_kv, *w_mem_q, *w_mem_kv, *w_mem_o,
        *g_ffn, *w_router, *w_exp_gate, *w_exp_up, *w_exp_down, *g_final;
    float* out; char* ws;
};
template <class T> __device__ __forceinline__ T* wsp(const Params& p, size_t off) { return (T*)(p.ws + off); }

#define LDS_HALF 65536
#define LDS_MAIN 131072
#define LDS_TOTAL (LDS_MAIN + 16)
#define LAS __attribute__((address_space(3)))

#define XB_TMO      128
#define XB_XCNT(j)  (256  + 64 * (j))
#define XB_XSUB(j)  (1280 + 64 * (j))
#define XB_XGEN(j)  (2304 + 64 * (j))
#define XB_TOP      3328
#define XB_TOPGEN   3392
#define XCD_BAR_WORDS 3456
#define XB_SPIN_CAP (1u << 25)
__device__ __forceinline__ unsigned xb_ld(unsigned* p)              { return __hip_atomic_load(p, __ATOMIC_RELAXED, __HIP_MEMORY_SCOPE_AGENT); }
__device__ __forceinline__ unsigned xb_add(unsigned* p, unsigned v) { return __hip_atomic_fetch_add(p, v, __ATOMIC_RELAXED, __HIP_MEMORY_SCOPE_AGENT); }
__device__ __forceinline__ unsigned xb_xcc_id() { return (unsigned)__builtin_amdgcn_s_getreg((3 << 11) | 20) & 0xFu; }
#define XB_SPIN(cond, bar) do { unsigned _sp = 0; while (cond) { __builtin_amdgcn_s_sleep(1); \
    if ((++_sp & 255u) == 0u) { if (xb_ld(&(bar)[XB_TMO])) break; if (_sp > XB_SPIN_CAP) { atomicAdd(&(bar)[XB_TMO], 1u); break; } } } } while (0)
struct XcdBarrier { unsigned* bar; unsigned x; volatile LAS unsigned* st; };
__device__ __forceinline__ XcdBarrier xcd_barrier_post(unsigned* bar, volatile LAS unsigned* st) {
    XcdBarrier b; b.bar = bar; b.x = xb_xcc_id(); b.st = st;
    if (threadIdx.x == 0) (void)xb_add(&bar[XB_XCNT(b.x)], 1u);
    return b;
}
__device__ __forceinline__ void xcd_barrier_complete(unsigned* bar, unsigned x, unsigned& nloc, unsigned& nx) {
    const unsigned G = gridDim.x * gridDim.y * gridDim.z;
    unsigned sum, cnt, mine, sp = 0u;
    for (;;) {
        sum = 0u; cnt = 0u; mine = 0u;
#pragma unroll
        for (unsigned j = 0; j < 16; ++j) { const unsigned c = xb_ld(&bar[XB_XCNT(j)]); sum += c; cnt += (c > 0u) ? 1u : 0u; mine = (j == x) ? c : mine; }
        if (sum == G) break;
        __builtin_amdgcn_s_sleep(1);
        if ((++sp & 255u) == 0u) { if (xb_ld(&bar[XB_TMO])) break; if (sp > XB_SPIN_CAP) { atomicAdd(&bar[XB_TMO], 1u); break; } }
    }
    nloc = mine > 0u ? mine : 1u; nx = cnt > 0u ? cnt : 1u;
}
__device__ __forceinline__ void xcd_barrier(const XcdBarrier& b) {
    asm volatile("s_waitcnt vmcnt(0)" ::: "memory");
    __syncthreads();
    if (threadIdx.x == 0) {
        unsigned* bar = b.bar;
        __builtin_amdgcn_s_waitcnt(0);
        unsigned nloc = b.st[0], nx = b.st[1];
        if (nloc == 0u) { xcd_barrier_complete(bar, b.x, nloc, nx); b.st[0] = nloc; b.st[1] = nx; }
        const unsigned old = xb_add(&bar[XB_XSUB(b.x)], 1u);
        const unsigned gen = old / nloc;
        if (old + 1u == (gen + 1u) * nloc) {
            __builtin_amdgcn_fence(__ATOMIC_RELEASE, "agent");
            asm volatile("s_waitcnt vmcnt(0)" ::: "memory");
            const unsigned og = xb_add(&bar[XB_TOP], 1u);
            const unsigned tg = og / nx;
            if (og + 1u == (tg + 1u) * nx) xb_add(&bar[XB_TOPGEN], 1u);
            else XB_SPIN(xb_ld(&bar[XB_TOPGEN]) == tg, bar);
            __builtin_amdgcn_fence(__ATOMIC_ACQUIRE, "agent");
            xb_add(&bar[XB_XGEN(b.x)], 1u);
            asm volatile("s_waitcnt vmcnt(0)" ::: "memory");
        } else {
            XB_SPIN(xb_ld(&bar[XB_XGEN(b.x)]) == gen, bar);
            __builtin_amdgcn_fence(__ATOMIC_ACQUIRE, "agent");
            asm volatile("s_waitcnt vmcnt(0)" ::: "memory");
        }
    }
    __syncthreads();
}

#define FOR_XCD_ITEMS(item, N) for (int _L = (int)((blockIdx.x >> 3) << 1) | VHALF, item; _L < (N) / 8 && ((item = (int)(blockIdx.x & 7) * ((N) / 8) + _L), true); _L += (int)(gridDim.x >> 2))

__device__ __forceinline__ u32x2 pack4bf(float a, float b, float c, float d) { return (u32x2){pack2bf(a, b), pack2bf(c, d)}; }
__device__ __forceinline__ u32x2 pack4bf(f32x4 v) { return (u32x2){pack2bf(v[0], v[1]), pack2bf(v[2], v[3])}; }
__device__ __forceinline__ float wave_sum(float v) {
#pragma unroll
    for (int o = 32; o > 0; o >>= 1) v += __shfl_xor(v, o);
    return v;
}

__device__ __forceinline__ void tr_tile(const float* W, long ldw, int k0, int n0, int nvalid, const float* gain, bf16_t* Wt, long ldt, int mode, char* lds) {
    float (*t)[132] = (float (*)[132])lds;
    const int tid = VTID, c4 = tid & 31, r0 = tid >> 5;
    f32x4 v[8];
#pragma unroll
    for (int i = 0; i < 8; i++) {
        const int kk = r0 + 8 * i, n = n0 + c4 * 4;
        v[i] = (n < nvalid) ? *(const f32x4*)(W + (long)(k0 + kk) * ldw + n) : (f32x4){0.f, 0.f, 0.f, 0.f};
        if (gain) v[i] *= gain[k0 + kk];
    }
    __syncthreads();
#pragma unroll
    for (int i = 0; i < 8; i++) *(f32x4*)(&t[r0 + 8 * i][c4 * 4]) = v[i];
    __syncthreads();
#pragma unroll
    for (int i = 0; i < 4; i++) {
        const int ci = tid + 256 * i, nn = ci >> 3, kc = ci & 7;
        const int n = n0 + nn;
        int row = n;
        if (mode) row = (n >> 5) * 64 + ((n >> 4) & 1) * 32 + (mode - 1) * 16 + (n & 15);
        u32x4 w;
        w.x = pack2bf(t[kc * 8 + 0][nn], t[kc * 8 + 1][nn]);
        w.y = pack2bf(t[kc * 8 + 2][nn], t[kc * 8 + 3][nn]);
        w.z = pack2bf(t[kc * 8 + 4][nn], t[kc * 8 + 5][nn]);
        w.w = pack2bf(t[kc * 8 + 6][nn], t[kc * 8 + 7][nn]);
        *(u32x4*)(Wt + (long)row * ldt + k0 + kc * 8) = w;
    }
}

__device__ __forceinline__ void phase0(const Params& p, char* lds) {
    constexpr int J_W1 = 160, J_WQ = 36, J_WKV = 32, J_WOUT = 128, J_WMQ = 128, J_WMKV = 256, J_WMO = 128, J_WG = 0, J_WU = 0, J_WD = 0;
    constexpr int J_TR = J_W1 + J_WQ + J_WKV + J_WOUT + J_WMQ + J_WMKV + J_WMO + J_WG + J_WU + J_WD;
    constexpr int J_XR = NT / 16, J_MR = 1024 / 16, J_ROPE = NT * 16 / 256, J_TAB = (4096 + 8192 + 16384 + 8192 + 32768) / 256;
    constexpr int J_ALL = J_TR + J_XR + J_MR + J_ROPE + J_TAB;
    const int tid = VTID, lane = tid & 63, wid = tid >> 6;
    const double PI2 = 6.283185307179586476925286766559;
    for (int job = VBLK; job < J_ALL; job += VGRID) {
        int j = job;
        if (j < J_TR) {
            if (j < J_W1) { tr_tile(p.w_in, INW, (j / 10) * 64, (j % 10) * 128, INW, p.g_mix, wsp<bf16_t>(p, OFF_W1T), 1024, 0, lds); continue; } j -= J_W1;
            if (j < J_WQ) { tr_tile(p.w_q_up, 768, (j / 6) * 64, (j % 6) * 128, 768, p.g_q_lat, wsp<bf16_t>(p, OFF_WQT), 384, 0, lds); continue; } j -= J_WQ;
            if (j < J_WKV) { tr_tile(p.w_kv_up, 1024, (j / 8) * 64, (j % 8) * 128, 1024, p.g_kv_lat, wsp<bf16_t>(p, OFF_WKVT), 256, 0, lds); continue; } j -= J_WKV;
            if (j < J_WOUT) { tr_tile(p.w_out, 1024, (j / 8) * 64, (j % 8) * 128, 1024, nullptr, wsp<bf16_t>(p, OFF_WOUTT), 1024, 0, lds); continue; } j -= J_WOUT;
            if (j < J_WMQ) { tr_tile(p.w_mem_q, 1024, (j / 8) * 64, (j % 8) * 128, 1024, p.g_mem_q, wsp<bf16_t>(p, OFF_WMQT), 1024, 0, lds); continue; } j -= J_WMQ;
            if (j < J_WMKV) { tr_tile(p.w_mem_kv, 2048, (j / 16) * 64, (j % 16) * 128, 2048, p.g_mem_kv, wsp<bf16_t>(p, OFF_WMKVT), 1024, 0, lds); continue; } j -= J_WMKV;
            if (j < J_WMO) { tr_tile(p.w_mem_o, 1024, (j / 8) * 64, (j % 8) * 128, 1024, nullptr, wsp<bf16_t>(p, OFF_WMOT), 1024, 0, lds); continue; } j -= J_WMO;
            if (j < J_WG) { const int e = j >> 7, r = j & 127; tr_tile(p.w_exp_gate + (long)e * 1048576, 1024, (r / 8) * 64, (r % 8) * 128, 1024, p.g_ffn, wsp<bf16_t>(p, OFF_WGUT) + (long)e * 2048 * 1024, 1024, 1, lds); continue; } j -= J_WG;
            if (j < J_WU) { const int e = j >> 7, r = j & 127; tr_tile(p.w_exp_up + (long)e * 1048576, 1024, (r / 8) * 64, (r % 8) * 128, 1024, p.g_ffn, wsp<bf16_t>(p, OFF_WGUT) + (long)e * 2048 * 1024, 1024, 2, lds); continue; } j -= J_WU;
            { const int e = j >> 7, r = j & 127; tr_tile(p.w_exp_down + (long)e * 1048576, 1024, (r / 8) * 64, (r % 8) * 128, 1024, nullptr, wsp<bf16_t>(p, OFF_WDT) + (long)e * 1048576, 1024, 0, lds); continue; }
        }
        j -= J_TR;
        if (j < J_XR + J_MR) {
            const bool isx = j < J_XR;
            const int row0 = (isx ? j : j - J_XR) * 16 + wid * 4;
            const float* src = (isx ? p.x : p.mem) + (long)row0 * ND;
            bf16_t* dst = (isx ? wsp<bf16_t>(p, OFF_XB) : wsp<bf16_t>(p, OFF_MEMB)) + (long)row0 * ND;
            f32x4 v[4][4];
#pragma unroll
            for (int r = 0; r < 4; r++)
#pragma unroll
                for (int i = 0; i < 4; i++) v[r][i] = *(const f32x4*)(src + (long)r * ND + i * 256 + lane * 4);
#pragma unroll
            for (int r = 0; r < 4; r++) {
                float ss = 0.f;
#pragma unroll
                for (int i = 0; i < 4; i++) {
                    ss += v[r][i][0] * v[r][i][0] + v[r][i][1] * v[r][i][1] + v[r][i][2] * v[r][i][2] + v[r][i][3] * v[r][i][3];
                    *(u32x2*)(dst + (long)r * ND + i * 256 + lane * 4) = pack4bf(v[r][i]);
                }
                ss = wave_sum(ss);
                if (lane == 0) (isx ? wsp<float>(p, OFF_R0) : wsp<float>(p, OFF_RMEM))[row0 + r] = rsqrtf(ss * (1.f / ND) + 1e-6f);
            }
            continue;
        }
        j -= J_XR + J_MR;
        if (j < J_ROPE) {
            const int i = j * 256 + tid; const int t = i >> 4, jj = i & 15;
            const double f = pow(10000.0, -(double)(2 * jj) / 32.0);
            const double ang = (double)p.pos[t] * f;
            wsp<float2>(p, OFF_ROPE)[i] = make_float2((float)cos(ang), (float)sin(ang));
            continue;
        }
        j -= J_ROPE;
        {
            int i = j * 256 + tid;
            if (i < 4096) { const double a = PI2 * (double)i / 4096.0; wsp<float2>(p, OFF_TW)[i] = make_float2((float)cos(a), (float)sin(a)); continue; } i -= 4096;
            if (i < 8192) {
                const int T = i >> 12, a = (i >> 6) & 63, b = i & 63;
                const double th = PI2 * (double)((a * b) & 63) / 64.0;
                wsp<bf16_t>(p, OFF_T64)[i] = (bf16_t)f2bf((float)(T ? sin(th) : cos(th))); continue;
            } i -= 8192;
            if (i < 16384) {
                const int rho = i >> 7, k = i & 127;
                const int wm = rho >> 6, mi = (rho >> 4) & 3, lr = rho & 15, ri = mi >> 1, k1 = 32 * wm + 16 * (mi & 1) + lr, ab = k >> 6, s1 = k & 63;
                const double th = PI2 * (double)((k1 * s1) & 63) / 64.0;
                const double c = cos(th), s = sin(th);
                const double v = ri == 0 ? (ab == 0 ? c : -s) : (ab == 0 ? s : c);
                wsp<bf16_t>(p, OFF_M1)[i] = (bf16_t)f2bf((float)v); continue;
            } i -= 16384;
            if (i < 8192) {
                const int k2 = i >> 7, k = i & 127, s2 = k & 63;
                const double th = PI2 * (double)((k2 * s2) & 63) / 64.0;
                wsp<bf16_t>(p, OFF_M3)[i] = (bf16_t)f2bf((float)(k < 64 ? cos(th) : -sin(th))); continue;
            } i -= 8192;
            if (i < 32768) {
                const int g = i >> 12, e = (i >> 6) & 63, ch = i & 63;
                wsp<bf16_t>(p, OFF_WFT)[i] = (bf16_t)f2bf(p.w_fourier[(g * 64 + ch) * 64 + e]); continue;
            }
        }
    }
}

#define FOR_XCD_ITEMS_R(item, N) for (int _L = (int)(blockIdx.x >> 3), item; _L < (N) / 8 && ((item = (int)(blockIdx.x & 7) * ((N) / 8) + _L), true); _L += (int)(gridDim.x >> 3))
__device__ __forceinline__ void gemm_tile_256sq(const GemmTile& g, char* lds, f32x4 (&acc)[8][4]) {
    const int tid = threadIdx.x, lane = tid & 63, wid = tid >> 6, wm = wid >> 2, wn = wid & 3;
    const int lrow = lane >> 3, pc = lane & 7;
    const bf16_t* ap[4]; const bf16_t* bp[4];
#pragma unroll
    for (int i = 0; i < 4; i++) {
        const int r = (wid * 4 + i) * 8 + lrow;
        const int c = pc ^ ((r >> 1) & 7);
        const long ro = g.arow ? (long)g.arow[r] * g.lda : (long)r * g.lda;
        ap[i] = g.A + ro + c * 8;
        bp[i] = g.Bt + (long)r * g.ldb + c * 8;
    }
#pragma unroll
    for (int mi = 0; mi < 8; mi++)
#pragma unroll
        for (int ni = 0; ni < 4; ni++) acc[mi][ni] = (f32x4){0.f, 0.f, 0.f, 0.f};
    const int nk = g.K >> 6;
    auto stage = [&](int kt, char* st) {
#pragma unroll
        for (int i = 0; i < 4; i++) {
            __builtin_amdgcn_global_load_lds((const unsigned*)(ap[i] + kt * 64), (unsigned*)(st + (wid * 4 + i) * 1024), 16, 0, 0);
            __builtin_amdgcn_global_load_lds((const unsigned*)(bp[i] + kt * 64), (unsigned*)(st + 32768 + (wid * 4 + i) * 1024), 16, 0, 0);
        }
    };
    __syncthreads();
    stage(0, lds);
    asm volatile("s_waitcnt vmcnt(0)" ::: "memory");
    __syncthreads();
    for (int kt = 0; kt < nk; kt++) {
        char* cur = lds + (kt & 1) * 65536;
        if (kt + 1 < nk) stage(kt + 1, lds + ((kt + 1) & 1) * 65536);
#pragma unroll
        for (int ks = 0; ks < 2; ks++) {
            bf16x8 af[8], bfr[4];
#pragma unroll
            for (int i = 0; i < 8; i++) af[i] = *(const bf16x8*)(cur + tile_off(wm * 128 + i * 16 + (lane & 15), ks * 4 + (lane >> 4)));
#pragma unroll
            for (int i = 0; i < 4; i++) bfr[i] = *(const bf16x8*)(cur + 32768 + tile_off(wn * 64 + i * 16 + (lane & 15), ks * 4 + (lane >> 4)));
            __builtin_amdgcn_s_setprio(1);
#pragma unroll
            for (int mi = 0; mi < 8; mi++)
#pragma unroll
                for (int ni = 0; ni < 4; ni++)
                    acc[mi][ni] = __builtin_amdgcn_mfma_f32_16x16x32_bf16(bfr[ni], af[mi], acc[mi][ni], 0, 0, 0);
            __builtin_amdgcn_s_setprio(0);
        }
        asm volatile("s_waitcnt vmcnt(0)" ::: "memory");
        __syncthreads();
    }
}


__device__ __forceinline__ void gemm_tile_256x128(const GemmTile& g, char* lds, f32x4 (&acc)[4][4]) {
    const int tid = threadIdx.x, lane = tid & 63, wid = tid >> 6, wm = wid >> 1, wn = wid & 1;
    const int lrow = lane >> 3, pc = lane & 7;
    const bf16_t* ap[4]; const bf16_t* bp[2];
#pragma unroll
    for (int i = 0; i < 4; i++) {
        const int r = (wid * 4 + i) * 8 + lrow;
        const int c = pc ^ ((r >> 1) & 7);
        const long ro = g.arow ? (long)g.arow[r] * g.lda : (long)r * g.lda;
        ap[i] = g.A + ro + c * 8;
    }
#pragma unroll
    for (int i = 0; i < 2; i++) {
        const int r = (wid * 2 + i) * 8 + lrow;
        const int c = pc ^ ((r >> 1) & 7);
        bp[i] = g.Bt + (long)r * g.ldb + c * 8;
    }
#pragma unroll
    for (int mi = 0; mi < 4; mi++)
#pragma unroll
        for (int ni = 0; ni < 4; ni++) acc[mi][ni] = (f32x4){0.f, 0.f, 0.f, 0.f};
    const int nk = g.K >> 6;
    auto stage = [&](int kt, char* st) {
#pragma unroll
        for (int i = 0; i < 4; i++)
            __builtin_amdgcn_global_load_lds((const unsigned*)(ap[i] + kt * 64), (unsigned*)(st + (wid * 4 + i) * 1024), 16, 0, 0);
#pragma unroll
        for (int i = 0; i < 2; i++)
            __builtin_amdgcn_global_load_lds((const unsigned*)(bp[i] + kt * 64), (unsigned*)(st + 32768 + (wid * 2 + i) * 1024), 16, 0, 0);
    };
    __syncthreads();
    stage(0, lds);
    asm volatile("s_waitcnt vmcnt(0)" ::: "memory");
    __syncthreads();
    for (int kt = 0; kt < nk; kt++) {
        char* cur = lds + (kt & 1) * 49152;
        if (kt + 1 < nk) stage(kt + 1, lds + ((kt + 1) & 1) * 49152);
        bf16x8 af[2][4], bfr[2][4];
#pragma unroll
        for (int ks = 0; ks < 2; ks++)
#pragma unroll
            for (int i = 0; i < 4; i++) {
                af[ks][i] = *(const bf16x8*)(cur + tile_off(wm * 64 + i * 16 + (lane & 15), ks * 4 + (lane >> 4)));
                bfr[ks][i] = *(const bf16x8*)(cur + 32768 + tile_off(wn * 64 + i * 16 + (lane & 15), ks * 4 + (lane >> 4)));
            }
        __builtin_amdgcn_s_setprio(1);
#pragma unroll
        for (int ks = 0; ks < 2; ks++)
#pragma unroll
            for (int mi = 0; mi < 4; mi++)
#pragma unroll
                for (int ni = 0; ni < 4; ni++)
                    acc[mi][ni] = __builtin_amdgcn_mfma_f32_16x16x32_bf16(bfr[ks][ni], af[ks][mi], acc[mi][ni], 0, 0, 0);
        __builtin_amdgcn_s_setprio(0);
        asm volatile("s_waitcnt vmcnt(0)" ::: "memory");
        __syncthreads();
    }
}

template <class Setup, class Epi>
__device__ __forceinline__ void gemm_256x128_stream(int nitems, int lshift, int l0, int ls, char* lds, Setup setup, Epi epi) {
    const int tid = threadIdx.x, lane = tid & 63, wid = tid >> 6, wm = wid >> 1, wn = wid & 1;
    const int lrow = lane >> 3, pc = lane & 7;
    const int LN = nitems / 8, LS = ls, xb = (int)(blockIdx.x & 7) * LN;
    int L = (int)(blockIdx.x >> 3) - l0;
    if (L < 0 || L >= LS) return;
    L = (L + LS - lshift % LS) % LS;
    if (L >= LN) return;
    const bf16_t* ap[4]; const bf16_t* bp[2];
    auto setptr = [&](const GemmTile& g) {
#pragma unroll
        for (int i = 0; i < 4; i++) {
            const int r = (wid * 4 + i) * 8 + lrow;
            const int c = pc ^ ((r >> 1) & 7);
            ap[i] = g.A + (long)r * g.lda + c * 8;
        }
#pragma unroll
        for (int i = 0; i < 2; i++) {
            const int r = (wid * 2 + i) * 8 + lrow;
            const int c = pc ^ ((r >> 1) & 7);
            bp[i] = g.Bt + (long)r * g.ldb + c * 8;
        }
    };
    auto stage = [&](int kt, char* st) {
#pragma unroll
        for (int i = 0; i < 4; i++)
            __builtin_amdgcn_global_load_lds((const unsigned*)(ap[i] + kt * 64), (unsigned*)(st + (wid * 4 + i) * 1024), 16, 0, 0);
#pragma unroll
        for (int i = 0; i < 2; i++)
            __builtin_amdgcn_global_load_lds((const unsigned*)(bp[i] + kt * 64), (unsigned*)(st + 32768 + (wid * 2 + i) * 1024), 16, 0, 0);
    };
    GemmTile g; g.arow = nullptr;
    setup(xb + L, g);
    const int nk = g.K >> 6;
    setptr(g);
    __syncthreads();
    stage(0, lds);
    asm volatile("s_waitcnt vmcnt(0)" ::: "memory");
    __syncthreads();
    int q = 0;
    for (; L < LN; L += LS) {
        f32x4 acc[4][4];
#pragma unroll
        for (int mi = 0; mi < 4; mi++)
#pragma unroll
            for (int ni = 0; ni < 4; ni++) acc[mi][ni] = (f32x4){0.f, 0.f, 0.f, 0.f};
        for (int kt = 0; kt < nk; kt++, q++) {
            char* cur = lds + (q & 1) * 49152;
            char* nxt = lds + ((q + 1) & 1) * 49152;
            if (kt + 1 < nk) stage(kt + 1, nxt);
            else if (L + LS < LN) { setup(xb + L + LS, g); setptr(g); stage(0, nxt); }
            bf16x8 af[2][4], bfr[2][4];
#pragma unroll
            for (int ks = 0; ks < 2; ks++)
#pragma unroll
                for (int i = 0; i < 4; i++) {
                    af[ks][i] = *(const bf16x8*)(cur + tile_off(wm * 64 + i * 16 + (lane & 15), ks * 4 + (lane >> 4)));
                    bfr[ks][i] = *(const bf16x8*)(cur + 32768 + tile_off(wn * 64 + i * 16 + (lane & 15), ks * 4 + (lane >> 4)));
                }
            __builtin_amdgcn_s_setprio(1);
#pragma unroll
            for (int ks = 0; ks < 2; ks++)
#pragma unroll
                for (int mi = 0; mi < 4; mi++)
#pragma unroll
                    for (int ni = 0; ni < 4; ni++)
                        acc[mi][ni] = __builtin_amdgcn_mfma_f32_16x16x32_bf16(bfr[ks][ni], af[ks][mi], acc[mi][ni], 0, 0, 0);
            __builtin_amdgcn_s_setprio(0);
            asm volatile("s_waitcnt vmcnt(0)" ::: "memory");
            __syncthreads();
        }
        epi(xb + L, acc);
    }
}


__device__ __forceinline__ void phase1(const Params& p, char* lds) {
    const int tid = threadIdx.x, lane = tid & 63, wid = tid >> 6, wm = wid >> 1, wn = wid & 1, lq = lane >> 4, lr = lane & 15;
    constexpr int N_U = 64 * 2, N_M = 4 * 16;
    {
      gemm_256x128_stream(N_U, 0, 0, (int)(gridDim.x >> 3), lds, [&](int item, GemmTile& g) {
            const int tm = item >> 1, tn = 8 + (item & 1);
            g.A = wsp<bf16_t>(p, OFF_XB) + (long)tm * 256 * ND; g.lda = ND;
            g.Bt = wsp<bf16_t>(p, OFF_W1T) + (long)tn * 128 * ND; g.ldb = ND; g.K = ND;
        }, [&](int item, f32x4 (&acc)[4][4]) {
            const int tm = item >> 1, tn = 8 + (item & 1);
            const float* r0 = wsp<float>(p, OFF_R0);
#pragma unroll
            for (int mi = 0; mi < 4; mi++) {
                const int row = tm * 256 + wm * 64 + mi * 16 + lr;
                const float rs = r0[row];
#pragma unroll
                for (int ni = 0; ni < 4; ni++) acc[mi][ni] *= rs;
                if (tn < 4) {
#pragma unroll
                    for (int ni = 0; ni < 4; ni++)
                        *(u32x2*)(wsp<bf16_t>(p, OFF_UF) + (long)row * 512 + tn * 128 + wn * 64 + ni * 16 + 4 * lq) = pack4bf(acc[mi][ni]);
                } else if (tn < 9) {
                    float ss = 0.f;
#pragma unroll
                    for (int ni = 0; ni < 4; ni++) { const f32x4 v = acc[mi][ni]; ss += v[0] * v[0] + v[1] * v[1] + v[2] * v[2] + v[3] * v[3]; }
                    ss += __shfl_xor(ss, 16); ss += __shfl_xor(ss, 32);
                    if (tn < 7) {
#pragma unroll
                        for (int ni = 0; ni < 4; ni++)
                            *(u32x2*)(wsp<bf16_t>(p, OFF_UQ) + (long)row * 384 + (tn - 4) * 128 + wn * 64 + ni * 16 + 4 * lq) = pack4bf(acc[mi][ni]);
                        if (lq == 0) wsp<float>(p, OFF_SSQ)[row * 6 + (tn - 4) * 2 + wn] = ss;
                    } else {
#pragma unroll
                        for (int ni = 0; ni < 4; ni++)
                            *(u32x2*)(wsp<bf16_t>(p, OFF_UKV) + (long)row * 256 + (tn - 7) * 128 + wn * 64 + ni * 16 + 4 * lq) = pack4bf(acc[mi][ni]);
                        if (lq == 0) wsp<float>(p, OFF_SSKV)[row * 4 + (tn - 7) * 2 + wn] = ss;
                    }
                } else if (wn == 0) {
                    const float2* rp = wsp<float2>(p, OFF_ROPE) + (long)row * 16 + 4 * lq;
                    f32x4 o1, o2;
#pragma unroll
                    for (int r = 0; r < 4; r++) {
                        const float2 cs = rp[r];
                        const float x1 = acc[mi][0][r], x2 = acc[mi][1][r];
                        o1[r] = x1 * cs.x - x2 * cs.y; o2[r] = x1 * cs.y + x2 * cs.x;
                    }
                    bf16_t* kr = wsp<bf16_t>(p, OFF_KR) + (long)row * 32;
                    *(u32x2*)(kr + 4 * lq) = pack4bf(o1);
                    *(u32x2*)(kr + 16 + 4 * lq) = pack4bf(o2);
                }
            }
        });
      gemm_256x128_stream(N_M, N_U / 8, 0, (int)(gridDim.x >> 3), lds, [&](int it, GemmTile& g) {
            const int tm = it / 16, tn = it % 16;
            g.A = wsp<bf16_t>(p, OFF_MEMB) + (long)tm * 256 * ND; g.lda = ND;
            g.Bt = wsp<bf16_t>(p, OFF_WMKVT) + (long)tn * 128 * ND; g.ldb = ND; g.K = ND;
        }, [&](int it, f32x4 (&acc)[4][4]) {
            const int tm = it / 16, tn = it % 16;
            const float* rm = wsp<float>(p, OFF_RMEM);
#pragma unroll
            for (int mi = 0; mi < 4; mi++) {
                const int row = tm * 256 + wm * 64 + mi * 16 + lr;
                const int b = row >> 8, m = row & 255;
                const float rs = rm[row];
#pragma unroll
                for (int ni = 0; ni < 4; ni++) {
                    const f32x4 v = acc[mi][ni] * rs;
                    const int col = tn * 128 + wn * 64 + ni * 16 + 4 * lq;
                    if (col < 1024) {
                        const int h = col >> 8, d = col & 255;
                        *(u32x2*)(wsp<bf16_t>(p, OFF_KMEM) + ((long)(b * 4 + h) * 256 + m) * 256 + d) = pack4bf(v);
                    } else {
                        const int c2 = col - 1024, h = c2 >> 8, dv = c2 & 255;
                        bf16_t* vt = wsp<bf16_t>(p, OFF_VTMEM) + ((long)(b * 4 + h) * 256 + dv) * 256 + m;
#pragma unroll
                        for (int r = 0; r < 4; r++) vt[r * 256] = (bf16_t)f2bf(v[r]);
                    }
                }
            }
        });
    }
}

template <int MI>
__device__ __forceinline__ void dft_mma(const bf16_t* Ag, int arow0, const char* ximg, int ncol0, f32x4 (&acc)[MI][4]) {
    const int lane = VTID & 63, lq = lane >> 4, lr = lane & 15;
#pragma unroll
    for (int ks = 0; ks < 4; ks++) {
        bf16x8 af[MI], bfr[4];
#pragma unroll
        for (int mi = 0; mi < MI; mi++) af[mi] = *(const bf16x8*)(Ag + (long)(arow0 + mi * 16 + lr) * 128 + ks * 32 + lq * 8);
#pragma unroll
        for (int ni = 0; ni < 4; ni++) {
            const char* bp = ximg + (ks * 32 + lq * 8) * 272 + (ncol0 + ni * 16 + lr) * 2;
#pragma unroll
            for (int j = 0; j < 8; j++) bfr[ni][j] = *(const short*)(bp + j * 272);
        }
#pragma unroll
        for (int mi = 0; mi < MI; mi++)
#pragma unroll
            for (int ni = 0; ni < 4; ni++) acc[mi][ni] = __builtin_amdgcn_mfma_f32_16x16x32_bf16(bfr[ni], af[mi], acc[mi][ni], 0, 0, 0);
    }
}

__device__ __forceinline__ void f2a_item(const Params& p, int it, char* lds) {
    const int tid = VTID, lane = tid & 63, wid = tid >> 6, wm = wid >> 1, wn = wid & 1, lq = lane >> 4, lr = lane & 15;
    const int nc = it & 3, s2 = (it >> 2) & 63, b = it >> 8;
    char* uimg = lds; char* ximg = lds + 17408;
    __syncthreads();
#pragma unroll
    for (int i = 0; i < 4; i++) {
        const int ci = tid + 256 * i, row = ci >> 4, cc = ci & 15;
        *(u32x4*)(uimg + row * 272 + cc * 16) = *(const u32x4*)(wsp<bf16_t>(p, OFF_UF) + ((long)(b * NS + 64 * row + s2)) * 512 + nc * 128 + cc * 8);
    }
    __syncthreads();
    {
        const int g2 = wid >> 1, T = wid & 1;
        f32x4 a1[4][4];
#pragma unroll
        for (int mi = 0; mi < 4; mi++)
#pragma unroll
            for (int ni = 0; ni < 4; ni++) a1[mi][ni] = (f32x4){0.f, 0.f, 0.f, 0.f};
        const bf16_t* t64 = wsp<bf16_t>(p, OFF_T64) + T * 4096;
#pragma unroll
        for (int ks = 0; ks < 2; ks++) {
            bf16x8 af[4], bfr[4];
#pragma unroll
            for (int i = 0; i < 4; i++) {
                af[i] = *(const bf16x8*)(uimg + (i * 16 + lr) * 272 + (g2 * 64 + ks * 32 + lq * 8) * 2);
                bfr[i] = *(const bf16x8*)(t64 + (i * 16 + lr) * 64 + ks * 32 + lq * 8);
            }
#pragma unroll
            for (int mi = 0; mi < 4; mi++)
#pragma unroll
                for (int ni = 0; ni < 4; ni++) a1[mi][ni] = __builtin_amdgcn_mfma_f32_16x16x32_bf16(bfr[ni], af[mi], a1[mi][ni], 0, 0, 0);
        }
#pragma unroll
        for (int mi = 0; mi < 4; mi++)
#pragma unroll
            for (int ni = 0; ni < 4; ni++)
                *(u32x2*)(ximg + (T * 64 + mi * 16 + lr) * 272 + (g2 * 64 + ni * 16 + 4 * lq) * 2) = pack4bf(a1[mi][ni]);
    }
    __syncthreads();
    f32x4 acc[4][4];
#pragma unroll
    for (int mi = 0; mi < 4; mi++)
#pragma unroll
        for (int ni = 0; ni < 4; ni++) acc[mi][ni] = (f32x4){0.f, 0.f, 0.f, 0.f};
    dft_mma<4>(wsp<bf16_t>(p, OFF_M1), wm * 64, ximg, wn * 64, acc);
    const float2* tw = wsp<float2>(p, OFF_TW);
#pragma unroll
    for (int m2 = 0; m2 < 2; m2++) {
        const int k1 = 32 * wm + 16 * m2 + lr;
        float2 cs; { const float rev = (float)((s2 * k1) & 4095) * (1.0f / 4096.0f); cs.x = __builtin_amdgcn_cosf(rev); cs.y = __builtin_amdgcn_sinf(rev); (void)tw; }
        const long base = ((long)(b * 64 + k1) * 64 + s2) * 512 + nc * 128 + wn * 64 + 4 * lq;
#pragma unroll
        for (int ni = 0; ni < 4; ni++) {
            const f32x4 yr = acc[m2][ni], yi = acc[m2 + 2][ni];
            const f32x4 orr = yr * cs.x - yi * cs.y, oi = yi * cs.x + yr * cs.y;
            *(u32x2*)(wsp<bf16_t>(p, OFF_YR) + base + ni * 16) = pack4bf(orr);
            *(u32x2*)(wsp<bf16_t>(p, OFF_YI) + base + ni * 16) = pack4bf(oi);
        }
    }
}

__device__ __forceinline__ void f2b_item(const Params& p, int it, char* lds) {
    const int tid = VTID, lane = tid & 63, wid = tid >> 6, wm = wid >> 1, wn = wid & 1, lq = lane >> 4, lr = lane & 15;
    const int nc = it & 3, k1 = (it >> 2) & 63, b = it >> 8;
    char* ximg = lds; char* zimg = lds + 34816;
    __syncthreads();
#pragma unroll
    for (int i = 0; i < 8; i++) {
        const int ci = tid + 256 * i, row = ci >> 4, cc = ci & 15;
        const bf16_t* src = (row < 64 ? wsp<bf16_t>(p, OFF_YR) : wsp<bf16_t>(p, OFF_YI)) + ((long)(b * 64 + k1) * 64 + (row & 63)) * 512 + nc * 128 + cc * 8;
        *(u32x4*)(ximg + row * 272 + cc * 16) = *(const u32x4*)src;
    }
    __syncthreads();
    f32x4 acc[2][4];
#pragma unroll
    for (int mi = 0; mi < 2; mi++)
#pragma unroll
        for (int ni = 0; ni < 4; ni++) acc[mi][ni] = (f32x4){0.f, 0.f, 0.f, 0.f};
    dft_mma<2>(wsp<bf16_t>(p, OFF_M3), wm * 32, ximg, wn * 64, acc);
#pragma unroll
    for (int mi = 0; mi < 2; mi++)
#pragma unroll
        for (int ni = 0; ni < 4; ni++)
            *(u32x2*)(zimg + (wm * 32 + mi * 16 + lr) * 272 + (wn * 64 + ni * 16 + 4 * lq) * 2) = pack4bf(acc[mi][ni] * (1.0f / 512.0f));
    __syncthreads();
    f32x4 a3[2][4];
#pragma unroll
    for (int mi = 0; mi < 2; mi++)
#pragma unroll
        for (int ni = 0; ni < 4; ni++) a3[mi][ni] = (f32x4){0.f, 0.f, 0.f, 0.f};
    const bf16_t* wft = wsp<bf16_t>(p, OFF_WFT) + (long)(nc * 2 + wn) * 4096;
#pragma unroll
    for (int ks = 0; ks < 2; ks++) {
        bf16x8 af[2], bfr[4];
#pragma unroll
        for (int i = 0; i < 2; i++) af[i] = *(const bf16x8*)(zimg + (wm * 32 + i * 16 + lr) * 272 + (wn * 64 + ks * 32 + lq * 8) * 2);
#pragma unroll
        for (int i = 0; i < 4; i++) bfr[i] = *(const bf16x8*)(wft + (i * 16 + lr) * 64 + ks * 32 + lq * 8);
#pragma unroll
        for (int mi = 0; mi < 2; mi++)
#pragma unroll
            for (int ni = 0; ni < 4; ni++) a3[mi][ni] = __builtin_amdgcn_mfma_f32_16x16x32_bf16(bfr[ni], af[mi], a3[mi][ni], 0, 0, 0);
    }
#pragma unroll
    for (int mi = 0; mi < 2; mi++) {
        const int k2 = wm * 32 + mi * 16 + lr;
        bf16_t* dst = wsp<bf16_t>(p, OFF_ZA) + ((long)(b * NS + k1 + 64 * k2)) * 1024 + nc * 128 + wn * 64 + 4 * lq;
#pragma unroll
        for (int ni = 0; ni < 4; ni++) *(u32x2*)(dst + ni * 16) = pack4bf(a3[mi][ni]);
    }
}

__device__ __forceinline__ void phase2(const Params& p, char* lds) {
    const int tid = threadIdx.x, lane = tid & 63, wid = tid >> 6, wm = wid >> 1, wn = wid & 1, lq = lane >> 4, lr = lane & 15;
    constexpr int N_Q = 64 * 6, N_KV = 64 * 8;
    const int lsa = (int)(gridDim.x >> 3), lsh = lsa >> 1;
    {
      gemm_256x128_stream(N_Q, 0, lsh, lsa - lsh, lds, [&](int item, GemmTile& g) {
            const int tm = item / 6, tn = item % 6;
            g.A = wsp<bf16_t>(p, OFF_UQ) + (long)tm * 256 * 384; g.lda = 384;
            g.Bt = wsp<bf16_t>(p, OFF_WQT) + (long)tn * 128 * 384; g.ldb = 384; g.K = 384;
        }, [&](int item, f32x4 (&acc)[4][4]) {
            const int tm = item / 6, tn = item % 6;
            const float qmul = 0.10206207261596575f * 1.4426950408889634f;
#pragma unroll
            for (int mi = 0; mi < 4; mi++) {
                const int row = tm * 256 + wm * 64 + mi * 16 + lr;
                const int b = row >> 12, s = row & 4095;
                const float* sq = wsp<float>(p, OFF_SSQ) + (long)row * 6;
                const float ss = sq[0] + sq[1] + sq[2] + sq[3] + sq[4] + sq[5];
                const float rs = rsqrtf(ss * (1.f / 384.f) + 1e-6f) * qmul;
                const int cb0 = tn * 128 + wn * 64;
#pragma unroll
                for (int ni = 0; ni < 4; ni++) {
                    const int cb = cb0 + ni * 16, hd = cb / 96, hob = cb % 96;
                    bf16_t* qd = wsp<bf16_t>(p, OFF_Q) + ((long)(b * 8 + hd) * NS + s) * 96;
                    if (hob < 64) {
                        *(u32x2*)(qd + hob + 4 * lq) = pack4bf(acc[mi][ni] * rs);
                    } else if (hob == 64) {
                        if (ni < 3) {
                            const float2* rp = wsp<float2>(p, OFF_ROPE) + (long)row * 16 + 4 * lq;
                            f32x4 o1, o2;
#pragma unroll
                            for (int r = 0; r < 4; r++) {
                                const float2 cs = rp[r];
                                const float x1 = acc[mi][ni][r] * rs, x2 = acc[mi][ni < 3 ? ni + 1 : 3][r] * rs;
                                o1[r] = x1 * cs.x - x2 * cs.y; o2[r] = x1 * cs.y + x2 * cs.x;
                            }
                            *(u32x2*)(qd + 64 + 4 * lq) = pack4bf(o1);
                            *(u32x2*)(qd + 80 + 4 * lq) = pack4bf(o2);
                        }
                    }
                }
            }
        });
      gemm_256x128_stream(N_KV, 0, 0, lsh ? lsh : lsa, lds, [&](int it, GemmTile& g) {
            const int tm = it >> 3, hd = it & 7;
            g.A = wsp<bf16_t>(p, OFF_UKV) + (long)tm * 256 * 256; g.lda = 256;
            g.Bt = wsp<bf16_t>(p, OFF_WKVT) + (long)hd * 128 * 256; g.ldb = 256; g.K = 256;
        }, [&](int it, f32x4 (&acc)[4][4]) {
            const int tm = it >> 3, hd = it & 7;
#pragma unroll
            for (int mi = 0; mi < 4; mi++) {
                const int row = tm * 256 + wm * 64 + mi * 16 + lr;
                const int b = row >> 12, s = row & 4095;
                const float* sq = wsp<float>(p, OFF_SSKV) + (long)row * 4;
                const float rs = rsqrtf((sq[0] + sq[1] + sq[2] + sq[3]) * (1.f / 256.f) + 1e-6f);
                if (wn == 0) {
                    bf16_t* kd = wsp<bf16_t>(p, OFF_K) + ((long)(b * 8 + hd) * NS + s) * 96;
#pragma unroll
                    for (int ni = 0; ni < 4; ni++) *(u32x2*)(kd + ni * 16 + 4 * lq) = pack4bf(acc[mi][ni] * rs);
                } else {
#pragma unroll
                    for (int ni = 0; ni < 4; ni++) {
                        bf16_t* vd = wsp<bf16_t>(p, OFF_VT) + ((long)(b * 8 + hd) * 64 + ni * 16 + 4 * lq) * NS + s;
#pragma unroll
                        for (int r = 0; r < 4; r++) vd[(long)r * NS] = (bf16_t)f2bf(acc[mi][ni][r] * rs);
                    }
                }
            }
#pragma unroll
            for (int i = 0; i < 2; i++) {
                const int ci = tid + 512 * i, r = ci >> 2, cc = ci & 3;
                const int row = tm * 256 + r, b = row >> 12, s = row & 4095;
                *(u32x4*)(wsp<bf16_t>(p, OFF_K) + ((long)(b * 8 + hd) * NS + s) * 96 + 64 + cc * 8) = *(const u32x4*)(wsp<bf16_t>(p, OFF_KR) + (long)row * 32 + cc * 8);
            }
        });
    }
}


template <int MI>
__device__ __forceinline__ void dft_mma_pre(const bf16x8 (&af)[4][MI], const char* ximg, int ncol0, f32x4 (&acc)[MI][4]) {
    const int lane = VTID & 63, lq = lane >> 4, lr = lane & 15;
#pragma unroll
    for (int ks = 0; ks < 4; ks++) {
        bf16x8 bfr[4];
#pragma unroll
        for (int ni = 0; ni < 4; ni++) {
            const char* bp = ximg + (ks * 32 + lq * 8) * 272 + (ncol0 + ni * 16 + lr) * 2;
#pragma unroll
            for (int j = 0; j < 8; j++) bfr[ni][j] = *(const short*)(bp + j * 272);
        }
#pragma unroll
        for (int mi = 0; mi < MI; mi++)
#pragma unroll
            for (int ni = 0; ni < 4; ni++) acc[mi][ni] = __builtin_amdgcn_mfma_f32_16x16x32_bf16(bfr[ni], af[ks][mi], acc[mi][ni], 0, 0, 0);
    }
}
__device__ __forceinline__ void phase2_f2a(const Params& p, char* lds) {
    const int tid = VTID, lane = tid & 63, wid = tid >> 6, wm = wid >> 1, wn = wid & 1, lq = lane >> 4, lr = lane & 15;
    char* uimg = lds; char* ximg = lds + 17408;
    const int g2 = wid >> 1, T = wid & 1;
    bf16x8 t64f[2][4], m1f[4][4];
    {
        const bf16_t* t64 = wsp<bf16_t>(p, OFF_T64) + T * 4096;
#pragma unroll
        for (int ks = 0; ks < 2; ks++)
#pragma unroll
            for (int i = 0; i < 4; i++) t64f[ks][i] = *(const bf16x8*)(t64 + (i * 16 + lr) * 64 + ks * 32 + lq * 8);
        const bf16_t* m1 = wsp<bf16_t>(p, OFF_M1);
#pragma unroll
        for (int ks = 0; ks < 4; ks++)
#pragma unroll
            for (int mi = 0; mi < 4; mi++) m1f[ks][mi] = *(const bf16x8*)(m1 + (long)(wm * 64 + mi * 16 + lr) * 128 + ks * 32 + lq * 8);
    }
    const int LN = 1024 / 8, LS = (int)(gridDim.x >> 2), xb = (int)(blockIdx.x & 7) * LN;
    int L = (int)((blockIdx.x >> 3) << 1) | VHALF;
    u32x4 ureg[4];
    auto fetch = [&](int it) {
        const int nc = it & 3, s2 = (it >> 2) & 63, b = it >> 8;
#pragma unroll
        for (int i = 0; i < 4; i++) {
            const int ci = tid + 256 * i, row = ci >> 4, cc = ci & 15;
            ureg[i] = *(const u32x4*)(wsp<bf16_t>(p, OFF_UF) + ((long)(b * NS + 64 * row + s2)) * 512 + nc * 128 + cc * 8);
        }
    };
    if (L < LN) fetch(xb + L);
    for (; L < LN; L += LS) {
        const int it = xb + L;
        const int nc = it & 3, s2 = (it >> 2) & 63, b = it >> 8;
        __syncthreads();
#pragma unroll
        for (int i = 0; i < 4; i++) {
            const int ci = tid + 256 * i, row = ci >> 4, cc = ci & 15;
            *(u32x4*)(uimg + row * 272 + cc * 16) = ureg[i];
        }
        __syncthreads();
        if (L + LS < LN) fetch(xb + L + LS);
        {
            f32x4 a1[4][4];
#pragma unroll
            for (int mi = 0; mi < 4; mi++)
#pragma unroll
                for (int ni = 0; ni < 4; ni++) a1[mi][ni] = (f32x4){0.f, 0.f, 0.f, 0.f};
#pragma unroll
            for (int ks = 0; ks < 2; ks++) {
                bf16x8 af[4];
#pragma unroll
                for (int i = 0; i < 4; i++) af[i] = *(const bf16x8*)(uimg + (i * 16 + lr) * 272 + (g2 * 64 + ks * 32 + lq * 8) * 2);
#pragma unroll
                for (int mi = 0; mi < 4; mi++)
#pragma unroll
                    for (int ni = 0; ni < 4; ni++) a1[mi][ni] = __builtin_amdgcn_mfma_f32_16x16x32_bf16(t64f[ks][ni], af[mi], a1[mi][ni], 0, 0, 0);
            }
#pragma unroll
            for (int mi = 0; mi < 4; mi++)
#pragma unroll
                for (int ni = 0; ni < 4; ni++)
                    *(u32x2*)(ximg + (T * 64 + mi * 16 + lr) * 272 + (g2 * 64 + ni * 16 + 4 * lq) * 2) = pack4bf(a1[mi][ni]);
        }
        __syncthreads();
        f32x4 acc[4][4];
#pragma unroll
        for (int mi = 0; mi < 4; mi++)
#pragma unroll
            for (int ni = 0; ni < 4; ni++) acc[mi][ni] = (f32x4){0.f, 0.f, 0.f, 0.f};
        dft_mma_pre<4>(m1f, ximg, wn * 64, acc);
#pragma unroll
        for (int m2 = 0; m2 < 2; m2++) {
            const int k1 = 32 * wm + 16 * m2 + lr;
            float2 cs; { const float rev = (float)((s2 * k1) & 4095) * (1.0f / 4096.0f); cs.x = __builtin_amdgcn_cosf(rev); cs.y = __builtin_amdgcn_sinf(rev); }
            const long base = ((long)(b * 64 + k1) * 64 + s2) * 512 + nc * 128 + wn * 64 + 4 * lq;
#pragma unroll
            for (int ni = 0; ni < 4; ni++) {
                const f32x4 yr = acc[m2][ni], yi = acc[m2 + 2][ni];
                const f32x4 orr = yr * cs.x - yi * cs.y, oi = yi * cs.x + yr * cs.y;
                *(u32x2*)(wsp<bf16_t>(p, OFF_YR) + base + ni * 16) = pack4bf(orr);
                *(u32x2*)(wsp<bf16_t>(p, OFF_YI) + base + ni * 16) = pack4bf(oi);
            }
        }
    }
}

__device__ __forceinline__ void expert_tr_job(const Params& p, int j, char* lds) {
    const int which = j >> 11, r = j & 2047, e = r >> 7, t = r & 127;
    const int k0 = (t >> 3) * 64, n0 = (t & 7) * 128;
    if (which == 0) tr_tile(p.w_exp_gate + (long)e * 1048576, 1024, k0, n0, 1024, p.g_ffn, wsp<bf16_t>(p, OFF_WGUT) + (long)e * 2048 * 1024, 1024, 1, lds);
    else if (which == 1) tr_tile(p.w_exp_up + (long)e * 1048576, 1024, k0, n0, 1024, p.g_ffn, wsp<bf16_t>(p, OFF_WGUT) + (long)e * 2048 * 1024, 1024, 2, lds);
    else tr_tile(p.w_exp_down + (long)e * 1048576, 1024, k0, n0, 1024, nullptr, wsp<bf16_t>(p, OFF_WDT) + (long)e * 1048576, 1024, 0, lds);
}

__device__ __forceinline__ void phase3_tr(const Params& p, char* lds) {
    float (*t)[132] = (float (*)[132])lds;
    const int tid = VTID, c4 = tid & 31, r0 = tid >> 5;
    f32x4 v[8]; float gv[8];
    auto issue = [&](int j) {
        const int which = j >> 11, r = j & 2047, e = r >> 7, tt = r & 127;
        const int k0 = (tt >> 3) * 64, n0 = (tt & 7) * 128;
        const float* W = (which == 0 ? p.w_exp_gate : which == 1 ? p.w_exp_up : p.w_exp_down) + (long)e * 1048576;
#pragma unroll
        for (int i = 0; i < 8; i++) {
            const int kk = r0 + 8 * i;
            v[i] = *(const f32x4*)(W + (long)(k0 + kk) * 1024 + n0 + c4 * 4);
            gv[i] = which < 2 ? p.g_ffn[k0 + kk] : 1.f;
        }
    };
    int j = VBLK;
    if (j < 6144) issue(j);
    while (j < 6144) {
        const int which = j >> 11, r = j & 2047, e = r >> 7, tt = r & 127;
        const int k0 = (tt >> 3) * 64, n0 = (tt & 7) * 128;
        __syncthreads();
#pragma unroll
        for (int i = 0; i < 8; i++) *(f32x4*)(&t[r0 + 8 * i][c4 * 4]) = v[i] * gv[i];
        __syncthreads();
        const int jn = j + VGRID;
        if (jn < 6144) issue(jn);
        bf16_t* Wt = which < 2 ? wsp<bf16_t>(p, OFF_WGUT) + (long)e * 2048 * 1024 : wsp<bf16_t>(p, OFF_WDT) + (long)e * 1048576;
#pragma unroll
        for (int i = 0; i < 4; i++) {
            const int ci = tid + 256 * i, nn = ci >> 3, kc = ci & 7;
            const int n = n0 + nn;
            int row = n;
            if (which < 2) row = (n >> 5) * 64 + ((n >> 4) & 1) * 32 + which * 16 + (n & 15);
            u32x4 w;
            w.x = pack2bf(t[kc * 8 + 0][nn], t[kc * 8 + 1][nn]);
            w.y = pack2bf(t[kc * 8 + 2][nn], t[kc * 8 + 3][nn]);
            w.z = pack2bf(t[kc * 8 + 4][nn], t[kc * 8 + 5][nn]);
            w.w = pack2bf(t[kc * 8 + 6][nn], t[kc * 8 + 7][nn]);
            *(u32x4*)(Wt + (long)row * 1024 + k0 + kc * 8) = w;
        }
        j = jn;
    }
}
__device__ __forceinline__ void phase3_f2b(const Params& p, char* lds) {
    const int tid = VTID, lane = tid & 63, wid = tid >> 6, wm = wid >> 1, wn = wid & 1, lq = lane >> 4, lr = lane & 15;
    char* ximg = lds; char* zimg = lds + 34816;
    bf16x8 m3f[4][2];
    {
        const bf16_t* m3 = wsp<bf16_t>(p, OFF_M3);
#pragma unroll
        for (int ks = 0; ks < 4; ks++)
#pragma unroll
            for (int mi = 0; mi < 2; mi++) m3f[ks][mi] = *(const bf16x8*)(m3 + (long)(wm * 32 + mi * 16 + lr) * 128 + ks * 32 + lq * 8);
    }
    const int LN = 1024 / 8, LS = (int)(gridDim.x >> 2), xb = (int)(blockIdx.x & 7) * LN;
    int L = (int)((blockIdx.x >> 3) << 1) | VHALF;
    u32x4 xreg[8];
    auto fetch = [&](int it) {
        const int nc = it & 3, k1 = (it >> 2) & 63, b = it >> 8;
#pragma unroll
        for (int i = 0; i < 8; i++) {
            const int ci = tid + 256 * i, row = ci >> 4, cc = ci & 15;
            const bf16_t* src = (row < 64 ? wsp<bf16_t>(p, OFF_YR) : wsp<bf16_t>(p, OFF_YI)) + ((long)(b * 64 + k1) * 64 + (row & 63)) * 512 + nc * 128 + cc * 8;
            xreg[i] = *(const u32x4*)src;
        }
    };
    if (L < LN) fetch(xb + L);
    for (; L < LN; L += LS) {
        const int it = xb + L;
        const int nc = it & 3, k1 = (it >> 2) & 63, b = it >> 8;
        bf16x8 wff[2][4];
        {
            const bf16_t* wft = wsp<bf16_t>(p, OFF_WFT) + (long)(nc * 2 + wn) * 4096;
#pragma unroll
            for (int ks = 0; ks < 2; ks++)
#pragma unroll
                for (int i = 0; i < 4; i++) wff[ks][i] = *(const bf16x8*)(wft + (i * 16 + lr) * 64 + ks * 32 + lq * 8);
        }
        __syncthreads();
#pragma unroll
        for (int i = 0; i < 8; i++) {
            const int ci = tid + 256 * i, row = ci >> 4, cc = ci & 15;
            *(u32x4*)(ximg + row * 272 + cc * 16) = xreg[i];
        }
        __syncthreads();
        if (L + LS < LN) fetch(xb + L + LS);
        f32x4 acc[2][4];
#pragma unroll
        for (int mi = 0; mi < 2; mi++)
#pragma unroll
            for (int ni = 0; ni < 4; ni++) acc[mi][ni] = (f32x4){0.f, 0.f, 0.f, 0.f};
        dft_mma_pre<2>(m3f, ximg, wn * 64, acc);
#pragma unroll
        for (int mi = 0; mi < 2; mi++)
#pragma unroll
            for (int ni = 0; ni < 4; ni++)
                *(u32x2*)(zimg + (wm * 32 + mi * 16 + lr) * 272 + (wn * 64 + ni * 16 + 4 * lq) * 2) = pack4bf(acc[mi][ni] * (1.0f / 512.0f));
        __syncthreads();
        f32x4 a3[2][4];
#pragma unroll
        for (int mi = 0; mi < 2; mi++)
#pragma unroll
            for (int ni = 0; ni < 4; ni++) a3[mi][ni] = (f32x4){0.f, 0.f, 0.f, 0.f};
#pragma unroll
        for (int ks = 0; ks < 2; ks++) {
            bf16x8 af[2];
#pragma unroll
            for (int i = 0; i < 2; i++) af[i] = *(const bf16x8*)(zimg + (wm * 32 + i * 16 + lr) * 272 + (wn * 64 + ks * 32 + lq * 8) * 2);
#pragma unroll
            for (int mi = 0; mi < 2; mi++)
#pragma unroll
                for (int ni = 0; ni < 4; ni++) a3[mi][ni] = __builtin_amdgcn_mfma_f32_16x16x32_bf16(wff[ks][ni], af[mi], a3[mi][ni], 0, 0, 0);
        }
#pragma unroll
        for (int mi = 0; mi < 2; mi++) {
            const int k2 = wm * 32 + mi * 16 + lr;
            bf16_t* dst = wsp<bf16_t>(p, OFF_ZA) + ((long)(b * NS + k1 + 64 * k2)) * 1024 + nc * 128 + wn * 64 + 4 * lq;
#pragma unroll
            for (int ni = 0; ni < 4; ni++) *(u32x2*)(dst + ni * 16) = pack4bf(a3[mi][ni]);
        }
    }
}

__device__ __forceinline__ void phase_resid(const Params& p, char* lds, size_t offA, size_t offW, const float* residf, const bf16_t* residb, size_t offXb, size_t offSS) {
    const int tid = VTID, lane = tid & 63, wid = tid >> 6, wm = wid >> 1, wn = wid & 1, lq = lane >> 4, lr = lane & 15;
    FOR_XCD_ITEMS(item, 128 * 8) {
        const int tm = item >> 3, tn = item & 7;
        f32x4 acc[4][4];
        GemmTile g; g.A = wsp<bf16_t>(p, offA) + (long)tm * 128 * ND; g.lda = ND; g.arow = nullptr;
        g.Bt = wsp<bf16_t>(p, offW) + (long)tn * 128 * ND; g.ldb = ND; g.K = ND;
        gemm_tile_128(g, lds, acc);
#pragma unroll
        for (int mi = 0; mi < 4; mi++) {
            const int row = tm * 128 + wm * 64 + mi * 16 + lr;
            float ss = 0.f;
#pragma unroll
            for (int ni = 0; ni < 4; ni++) {
                const long o = (long)row * ND + tn * 128 + wn * 64 + ni * 16 + 4 * lq;
                f32x4 rv;
                if (residf) rv = *(const f32x4*)(residf + o);
                else { const u32x2 w = *(const u32x2*)(residb + o); rv = (f32x4){__uint_as_float(w.x << 16), __uint_as_float(w.x & 0xFFFF0000u), __uint_as_float(w.y << 16), __uint_as_float(w.y & 0xFFFF0000u)}; }
                const f32x4 v = rv + acc[mi][ni];
                *(u32x2*)(wsp<bf16_t>(p, offXb) + o) = pack4bf(v);
                ss += v[0] * v[0] + v[1] * v[1] + v[2] * v[2] + v[3] * v[3];
            }
            ss += __shfl_xor(ss, 16); ss += __shfl_xor(ss, 32);
            if (lq == 0) wsp<float>(p, offSS)[row * 16 + tn * 2 + wn] = ss;
        }
    }
}
__device__ __forceinline__ float row_rs16(const float* ss) {
    const f32x4 a = *(const f32x4*)ss, b = *(const f32x4*)(ss + 4), c = *(const f32x4*)(ss + 8), d = *(const f32x4*)(ss + 12);
    const f32x4 t = (a + b) + (c + d);
    return rsqrtf(((t[0] + t[1]) + (t[2] + t[3])) * (1.f / 1024.f) + 1e-6f);
}

__device__ __forceinline__ void phase5a(const Params& p, char* lds) {
    const int tid = VTID, lane = tid & 63, wid = tid >> 6, wm = wid >> 1, wn = wid & 1, lq = lane >> 4, lr = lane & 15;
    FOR_XCD_ITEMS(item, 128 * 8) {
        const int tm = item >> 3, tn = item & 7;
        f32x4 acc[4][4];
        GemmTile g; g.A = wsp<bf16_t>(p, OFF_X1B) + (long)tm * 128 * ND; g.lda = ND; g.arow = nullptr;
        g.Bt = wsp<bf16_t>(p, OFF_WMQT) + (long)tn * 128 * ND; g.ldb = ND; g.K = ND;
        gemm_tile_128(g, lds, acc);
        const int h = tn >> 1;
#pragma unroll
        for (int mi = 0; mi < 4; mi++) {
            const int row = tm * 128 + wm * 64 + mi * 16 + lr, b = row >> 12, s = row & 4095;
            const float rs = row_rs16(wsp<float>(p, OFF_SS1) + (long)row * 16) * (0.0625f * 1.4426950408889634f);
            bf16_t* qd = wsp<bf16_t>(p, OFF_QM) + ((long)(b * 4 + h) * NS + s) * 256 + (tn & 1) * 128 + wn * 64 + 4 * lq;
#pragma unroll
            for (int ni = 0; ni < 4; ni++) *(u32x2*)(qd + ni * 16) = pack4bf(acc[mi][ni] * rs);
        }
    }
}
__device__ __forceinline__ void phase5b(const Params& p, char* lds) {
    FOR_XCD_ITEMS(item, NB * 4 * 32 * 2) {
        const int dvh = item & 1, qt = (item >> 1) & 31, h = (item >> 6) & 3, b = item >> 8;
        const bf16_t* Qp = wsp<bf16_t>(p, OFF_QM) + ((long)(b * 4 + h) * NS + qt * 128) * 256;
        const bf16_t* Kp = wsp<bf16_t>(p, OFF_KMEM) + ((long)(b * 4 + h) * 256) * 256;
        const bf16_t* Vtp = wsp<bf16_t>(p, OFF_VTMEM) + ((long)(b * 4 + h) * 256 + dvh * 128) * 256;
        bf16_t* Op = wsp<bf16_t>(p, OFF_OM) + ((long)b * NS + qt * 128) * 1024 + h * 256 + dvh * 128;
        attn_block<256, 128, 32, 256>(Qp, Kp, Vtp, 256L, 256, lds, [&](int q, int dv, f32x4 v) { *(u32x2*)(Op + (long)q * 1024 + dv) = pack4bf(v); });
    }
}

__device__ __forceinline__ void phase7(const Params& p, char* lds) {
    const int tid = threadIdx.x, lane = tid & 63, wid = tid >> 6, lq = lane >> 4, lr = lane & 15;
    __syncthreads();
    {
        f32x4 w0[4], w1[4];
#pragma unroll
        for (int it = 0; it < 4; it++) {
            const int u = tid + 512 * it, kp = u >> 2, eq = u & 3;
            w0[it] = *(const f32x4*)(p.w_router + (size_t)(2 * kp) * 16 + eq * 4);
            w1[it] = *(const f32x4*)(p.w_router + (size_t)(2 * kp + 1) * 16 + eq * 4);
        }
#pragma unroll
        for (int it = 0; it < 4; it++) {
            const int u = tid + 512 * it, kp = u >> 2, eq = u & 3, k = 2 * kp;
            const float g0 = p.g_ffn[k], g1 = p.g_ffn[k + 1];
#pragma unroll
            for (int j = 0; j < 4; j++) {
                const int e = eq * 4 + j;
                const float a0 = w0[it][j] * g0, a1 = w1[it][j] * g1;
                const unsigned h0 = f2bf(a0), h1 = f2bf(a1);
                const float r0 = a0 - __uint_as_float(h0 << 16), r1 = a1 - __uint_as_float(h1 << 16);
                const unsigned l0 = f2bf(r0), l1 = f2bf(r1);
                const int off = e * 2048 + ((((k >> 3) ^ e) & 127) << 4) + (k & 7) * 2;
                *(unsigned*)(lds + off) = h0 | (h1 << 16);
                *(unsigned*)(lds + 32768 + off) = l0 | (l1 << 16);
            }
        }
    }
    __syncthreads();
    for (int g = wid * (int)gridDim.x + (int)blockIdx.x; g < NT / 16; g += 8 * (int)gridDim.x) {
        const int t0 = g * 16;
        const bf16_t* xr = wsp<bf16_t>(p, OFF_X2B) + (long)(t0 + lr) * ND + lq * 8;
        bf16x8 xa[32];
#pragma unroll
        for (int ks = 0; ks < 32; ks++) xa[ks] = *(const bf16x8*)(xr + ks * 32);
        const float rsv = row_rs16(wsp<float>(p, OFF_SS2) + (long)(t0 + lr) * 16);
        if (lane < 16) wsp<float>(p, OFF_RS2)[t0 + lane] = rsv;
        f32x4 acc = (f32x4){0.f, 0.f, 0.f, 0.f};
#pragma unroll
        for (int ks = 0; ks < 32; ks++) {
            const int off = lr * 2048 + ((((ks * 4 + lq) ^ lr) & 127) << 4);
            const bf16x8 bh = *(const bf16x8*)(lds + off), bl = *(const bf16x8*)(lds + 32768 + off);
            acc = __builtin_amdgcn_mfma_f32_16x16x32_bf16(xa[ks], bh, acc, 0, 0, 0);
            acc = __builtin_amdgcn_mfma_f32_16x16x32_bf16(xa[ks], bl, acc, 0, 0, 0);
            if ((ks & 3) == 3) asm volatile("" ::: "memory");
        }
        f32x4 af4;
#pragma unroll
        for (int r = 0; r < 4; r++) {
            const float lg = acc[r] * __shfl(rsv, lq * 4 + r);
            float mx = lg;
#pragma unroll
            for (int o = 1; o < 16; o <<= 1) mx = fmaxf(mx, __shfl_xor(mx, o));
            const float ex = expf(lg - mx);
            float sm = ex;
#pragma unroll
            for (int o = 1; o < 16; o <<= 1) sm += __shfl_xor(sm, o);
            af4[r] = ex / sm;
        }
        {
            const int tk = t0 + lq * 4, bb = tk >> 12, ss = tk & 4095;
            *(f32x4*)(wsp<float>(p, OFF_AFF) + ((long)(bb * NE + lr) * NS + ss)) = af4;
        }
    }
}

__device__ __forceinline__ int block_sum_i(int v, int* red) {
    const int lane = VTID & 63, wid = VTID >> 6;
#pragma unroll
    for (int o = 32; o > 0; o >>= 1) v += __shfl_xor(v, o);
    __syncthreads();
    if (lane == 0) red[wid] = v;
    __syncthreads();
    return red[0] + red[1] + red[2] + red[3];
}
__device__ __forceinline__ int block_excl_scan_i(int v, int* red, int& total) {
    const int lane = VTID & 63, wid = VTID >> 6;
    int inc = v;
#pragma unroll
    for (int o = 1; o < 64; o <<= 1) { const int t = __shfl_up(inc, o); if (lane >= o) inc += t; }
    __syncthreads();
    if (lane == 63) red[wid] = inc;
    __syncthreads();
    int base = 0;
#pragma unroll
    for (int w = 0; w < 4; w++) if (w < wid) base += red[w];
    total = red[0] + red[1] + red[2] + red[3];
    return base + inc - v;
}
__device__ __forceinline__ void phase8(const Params& p, char* lds) {
    int* red = (int*)lds;
    const int tid = threadIdx.x, lane = tid & 63, wid = tid >> 6;
    for (int item = blockIdx.x; item < NB * NE; item += gridDim.x) {
        const int e = item & 15, b = item >> 4;
        const unsigned* aff = (const unsigned*)(wsp<float>(p, OFF_AFF) + (long)(b * NE + e) * NS) + tid * 8;
        unsigned v[8];
        { const u32x4 v0 = *(const u32x4*)aff, v1 = *(const u32x4*)(aff + 4);
          v[0] = v0.x; v[1] = v0.y; v[2] = v0.z; v[3] = v0.w; v[4] = v1.x; v[5] = v1.y; v[6] = v1.z; v[7] = v1.w; }
        const float* rs2p = wsp<float>(p, OFF_RS2) + (long)b * NS + tid * 8;
        const f32x4 rsa = *(const f32x4*)rs2p, rsb = *(const f32x4*)(rs2p + 4);
        __syncthreads();
        unsigned T = 0;
        for (int bit = 30; bit >= 0; bit--) {
            const unsigned cand = T | (1u << bit);
            int c = 0;
#pragma unroll
            for (int i = 0; i < 8; i++) c += __popcll(__ballot(v[i] >= cand));
            int* rb = red + (bit & 1) * 8;
            if (lane == 0) rb[wid] = c;
            __syncthreads();
            const i32x4 s0 = *(const i32x4*)rb, s1 = *(const i32x4*)(rb + 4);
            const int tot = (s0.x + s0.y) + (s0.z + s0.w) + (s1.x + s1.y) + (s1.z + s1.w);
            if (tot >= CAP) T = cand;
        }
        int cg = 0, ce = 0;
#pragma unroll
        for (int i = 0; i < 8; i++) { cg += (v[i] > T) ? 1 : 0; ce += (v[i] == T) ? 1 : 0; }
        const int pv = cg | (ce << 16);
        int inc = pv;
#pragma unroll
        for (int o = 1; o < 64; o <<= 1) { const int t = __shfl_up(inc, o); if (lane >= o) inc += t; }
        if (lane == 63) red[16 + wid] = inc;
        __syncthreads();
        int base = 0, tot = 0;
#pragma unroll
        for (int w = 0; w < 8; w++) { const int x = red[16 + w]; if (w < wid) base += x; tot += x; }
        const int pk = base + inc - pv;
        const int need = CAP - (tot & 0xFFFF);
        const int pg = pk & 0xFFFF;
        int eqs = pk >> 16;
        int slot = pg + (eqs < need ? eqs : need);
        int* slots = wsp<int>(p, OFF_SLOTS) + (long)(b * NE + e) * NS + tid * 8;
        int* idx = wsp<int>(p, OFF_IDX) + (long)(b * NE + e) * CAP;
        float* gate = wsp<float>(p, OFF_GATE) + (long)(b * NE + e) * CAP;
        float* rss = wsp<float>(p, OFF_RSS) + (long)(b * NE + e) * CAP;
        int so[8];
#pragma unroll
        for (int i = 0; i < 8; i++) {
            const int t = tid * 8 + i;
            bool sel = v[i] > T;
            if (v[i] == T) { sel = eqs < need; eqs++; }
            so[i] = -1;
            if (sel) { so[i] = slot; idx[slot] = b * NS + t; gate[slot] = __uint_as_float(v[i]); rss[slot] = i < 4 ? rsa[i & 3] : rsb[i & 3]; slot++; }
        }
        *(i32x4*)slots = (i32x4){so[0], so[1], so[2], so[3]};
        *(i32x4*)(slots + 4) = (i32x4){so[4], so[5], so[6], so[7]};
    }
}

__device__ __forceinline__ void phase9(const Params& p, char* lds) {
    const int tid = VTID, lane = tid & 63, wid = tid >> 6, wm = wid >> 1, wn = wid & 1, lq = lane >> 4, lr = lane & 15;
    FOR_XCD_ITEMS(item, NE * 16 * NB * 4) {
        const int rt = item & 3, b = (item >> 2) & 3, ct = (item >> 4) & 15, e = item >> 8;
        const int* arow = wsp<int>(p, OFF_IDX) + (long)(b * NE + e) * CAP + rt * 128;
        f32x4 acc[4][4];
        GemmTile g; g.A = wsp<bf16_t>(p, OFF_X2B); g.lda = ND; g.arow = arow;
        g.Bt = wsp<bf16_t>(p, OFF_WGUT) + ((long)e * 2048 + ct * 128) * ND; g.ldb = ND; g.K = ND;
        gemm_tile_128(g, lds, acc);
#pragma unroll
        for (int mi = 0; mi < 4; mi++) {
            const int r = wm * 64 + mi * 16 + lr;
            const int tok = arow[r];
            const float rs = row_rs16(wsp<float>(p, OFF_SS2) + (long)tok * 16);
            bf16_t* ad = wsp<bf16_t>(p, OFF_ACT) + ((long)(e * NB + b) * CAP + rt * 128 + r) * ND + ct * 64 + wn * 32 + 4 * lq;
#pragma unroll
            for (int pp = 0; pp < 2; pp++) {
                f32x4 o;
#pragma unroll
                for (int q = 0; q < 4; q++) {
                    const float ga = acc[mi][2 * pp][q] * rs, up = acc[mi][2 * pp + 1][q] * rs;
                    o[q] = ga * __builtin_amdgcn_rcpf(1.f + __expf(-ga)) * up;
                }
                *(u32x2*)(ad + pp * 16) = pack4bf(o);
            }
        }
    }
}
__device__ __forceinline__ void phase10(const Params& p, char* lds) {
    const int tid = VTID, lane = tid & 63, wid = tid >> 6, wm = wid >> 1, wn = wid & 1, lq = lane >> 4, lr = lane & 15;
    FOR_XCD_ITEMS(item, NE * 8 * NB * 4) {
        const int rt = item & 3, b = (item >> 2) & 3, ct = (item >> 4) & 7, e = item >> 7;
        const long row0 = (long)(e * NB + b) * CAP + rt * 128;
        f32x4 acc[4][4];
        GemmTile g; g.A = wsp<bf16_t>(p, OFF_ACT) + row0 * ND; g.lda = ND; g.arow = nullptr;
        g.Bt = wsp<bf16_t>(p, OFF_WDT) + ((long)e * 1024 + ct * 128) * ND; g.ldb = ND; g.K = ND;
        gemm_tile_128(g, lds, acc);
        const float* gate = wsp<float>(p, OFF_GATE) + (long)(b * NE + e) * CAP + rt * 128;
#pragma unroll
        for (int mi = 0; mi < 4; mi++) {
            const int r = wm * 64 + mi * 16 + lr;
            const float gv = gate[r];
            bf16_t* yd = wsp<bf16_t>(p, OFF_Y) + (row0 + r) * ND + ct * 128 + wn * 64 + 4 * lq;
#pragma unroll
            for (int ni = 0; ni < 4; ni++) *(u32x2*)(yd + ni * 16) = pack4bf(acc[mi][ni] * gv);
        }
    }
}

__device__ __forceinline__ void phase11(const Params& p, char* lds) {
    const int tid = VTID, lane = tid & 63, wid = tid >> 6;
    const int* slots = wsp<int>(p, OFF_SLOTS);
    auto slot_of = [&](int tok) { const int b = tok >> 12, t = tok & 4095; return slots[(long)(b * NE + (lane & 15)) * NS + t]; };
    int tok = VBLK * 4 + wid;
    int sl_next = tok < NT ? slot_of(tok) : -1;
    u32x2 xn[4];
#pragma unroll
    for (int i = 0; i < 4; i++) xn[i] = *(const u32x2*)(wsp<bf16_t>(p, OFF_X2B) + (long)(tok < NT ? tok : 0) * ND + i * 256 + lane * 4);
    for (; tok < NT; tok += VGRID * 4) {
        const int b = tok >> 12;
        float* xr = p.out + (long)tok * ND;
        const int slv = sl_next;
        f32x4 v[4];
#pragma unroll
        for (int i = 0; i < 4; i++)
            v[i] = (f32x4){__uint_as_float(xn[i].x << 16), __uint_as_float(xn[i].x & 0xFFFF0000u), __uint_as_float(xn[i].y << 16), __uint_as_float(xn[i].y & 0xFFFF0000u)};
        {
            const int tn = tok + VGRID * 4;
            sl_next = tn < NT ? slot_of(tn) : -1;
#pragma unroll
            for (int i = 0; i < 4; i++) xn[i] = *(const u32x2*)(wsp<bf16_t>(p, OFF_X2B) + (long)(tn < NT ? tn : tok) * ND + i * 256 + lane * 4);
        }
        unsigned long long sel = __ballot(slv >= 0) & 0xFFFFull;
        while (sel) {
            const int e = __builtin_ctzll(sel); sel &= sel - 1;
            const int sl = __builtin_amdgcn_readlane(slv, e);
            const bf16_t* yr = wsp<bf16_t>(p, OFF_Y) + ((long)(e * NB + b) * CAP + sl) * ND;
#pragma unroll
            for (int i = 0; i < 4; i++) {
                const u32x2 w = *(const u32x2*)(yr + i * 256 + lane * 4);
                v[i][0] += __uint_as_float(w.x << 16); v[i][1] += __uint_as_float(w.x & 0xFFFF0000u);
                v[i][2] += __uint_as_float(w.y << 16); v[i][3] += __uint_as_float(w.y & 0xFFFF0000u);
            }
        }
        float ss = 0.f;
#pragma unroll
        for (int i = 0; i < 4; i++) ss += v[i][0] * v[i][0] + v[i][1] * v[i][1] + v[i][2] * v[i][2] + v[i][3] * v[i][3];
        ss = wave_sum(ss);
        const float rs = rsqrtf(ss * (1.f / ND) + 1e-6f);
#pragma unroll
        for (int i = 0; i < 4; i++) {
            const f32x4 gf = *(const f32x4*)(p.g_final + i * 256 + lane * 4);
            *(f32x4*)(xr + i * 256 + lane * 4) = v[i] * rs * gf;
        }
    }
}


__device__ __forceinline__ void phase_resid8(const Params& p, char* lds, size_t offA, size_t offW, const float* residf, const bf16_t* residb, size_t offXb, size_t offSS) {
    const int tid = threadIdx.x, lane = tid & 63, wid = tid >> 6, wm = wid >> 2, wn = wid & 3, lq = lane >> 4, lr = lane & 15;
    FOR_XCD_ITEMS_R(item, 64 * 4) {
        const int tm = item >> 2, tn = item & 3;
        f32x4 acc[8][4];
        GemmTile g; g.A = wsp<bf16_t>(p, offA) + (long)tm * 256 * ND; g.lda = ND; g.arow = nullptr;
        g.Bt = wsp<bf16_t>(p, offW) + (long)tn * 256 * ND; g.ldb = ND; g.K = ND;
        gemm_tile_256sq(g, lds, acc);
#pragma unroll
        for (int mi = 0; mi < 8; mi++) {
            const int row = tm * 256 + wm * 128 + mi * 16 + lr;
            float ss = 0.f;
#pragma unroll
            for (int ni = 0; ni < 4; ni++) {
                const long o = (long)row * ND + tn * 256 + wn * 64 + ni * 16 + 4 * lq;
                f32x4 rv;
                if (residf) rv = *(const f32x4*)(residf + o);
                else { const u32x2 w = *(const u32x2*)(residb + o); rv = (f32x4){__uint_as_float(w.x << 16), __uint_as_float(w.x & 0xFFFF0000u), __uint_as_float(w.y << 16), __uint_as_float(w.y & 0xFFFF0000u)}; }
                const f32x4 v = rv + acc[mi][ni];
                *(u32x2*)(wsp<bf16_t>(p, offXb) + o) = pack4bf(v);
                ss += v[0] * v[0] + v[1] * v[1] + v[2] * v[2] + v[3] * v[3];
            }
            ss += __shfl_xor(ss, 16); ss += __shfl_xor(ss, 32);
            if (lq == 0) wsp<float>(p, offSS)[row * 16 + tn * 4 + wn] = ss;
        }
    }
}


template <class Epi>
__device__ __forceinline__ void gemm_256sq_multi(const bf16_t* A, int lda, const int* arow, const bf16_t* Bt, int ldb, long bstep,
                                                 int K, int ntile, char* lds, Epi epi) {
    const int tid = threadIdx.x, lane = tid & 63, wid = tid >> 6, wm = wid >> 2, wn = wid & 3;
    const int lrow = lane >> 3, pc = lane & 7;
    const char* Ab = (const char*)A; const char* Bb = (const char*)Bt;
    unsigned ao[4], bo[4];
#pragma unroll
    for (int i = 0; i < 4; i++) {
        const int r = (wid * 4 + i) * 8 + lrow;
        const int c = pc ^ ((r >> 1) & 7);
        ao[i] = (unsigned)((arow ? arow[r] : r) * lda + c * 8) * 2u;
        bo[i] = (unsigned)(r * ldb + c * 8) * 2u;
    }
    const int nk = K >> 6;
    auto stage = [&](int kt, long boff, char* st) {
        const char* a0 = Ab + kt * 128;
        const char* b0 = Bb + boff * 2 + kt * 128;
#pragma unroll
        for (int i = 0; i < 4; i++) {
            __builtin_amdgcn_global_load_lds((const unsigned*)(a0 + ao[i]), (unsigned*)(st + (wid * 4 + i) * 1024), 16, 0, 0);
            __builtin_amdgcn_global_load_lds((const unsigned*)(b0 + bo[i]), (unsigned*)(st + 32768 + (wid * 4 + i) * 1024), 16, 0, 0);
        }
    };
    f32x4 acc[8][4];
    __syncthreads();
    stage(0, 0, lds);
    asm volatile("s_waitcnt vmcnt(0)" ::: "memory");
    __syncthreads();
    int q = 0;
    for (int t = 0; t < ntile; t++) {
#pragma unroll
        for (int mi = 0; mi < 8; mi++)
#pragma unroll
            for (int ni = 0; ni < 4; ni++) acc[mi][ni] = (f32x4){0.f, 0.f, 0.f, 0.f};
        const long boff = (long)t * bstep;
        for (int kt = 0; kt < nk; kt++, q++) {
            char* cur = lds + (q & 1) * 65536;
            char* nxt = lds + ((q + 1) & 1) * 65536;
            if (kt + 1 < nk) stage(kt + 1, boff, nxt);
            else if (t + 1 < ntile) stage(0, boff + bstep, nxt);
#pragma unroll
            for (int ks = 0; ks < 2; ks++) {
                bf16x8 af[8], bfr[4];
#pragma unroll
                for (int i = 0; i < 8; i++) af[i] = *(const bf16x8*)(cur + tile_off(wm * 128 + i * 16 + (lane & 15), ks * 4 + (lane >> 4)));
#pragma unroll
                for (int i = 0; i < 4; i++) bfr[i] = *(const bf16x8*)(cur + 32768 + tile_off(wn * 64 + i * 16 + (lane & 15), ks * 4 + (lane >> 4)));
                __builtin_amdgcn_s_setprio(1);
#pragma unroll
                for (int mi = 0; mi < 8; mi++)
#pragma unroll
                    for (int ni = 0; ni < 4; ni++)
                        acc[mi][ni] = __builtin_amdgcn_mfma_f32_16x16x32_bf16(bfr[ni], af[mi], acc[mi][ni], 0, 0, 0);
                __builtin_amdgcn_s_setprio(0);
            }
            asm volatile("s_waitcnt vmcnt(0)" ::: "memory");
            __syncthreads();
        }
        epi(t, acc);
    }
}
__device__ __forceinline__ void phase9_8(const Params& p, char* lds) {
    const int tid = threadIdx.x, lane = tid & 63, wid = tid >> 6, wm = wid >> 2, wn = wid & 3, lq = lane >> 4, lr = lane & 15;
    FOR_XCD_ITEMS_R(si, NE * NB * 2 * 2) {
        const int cth = si & 1, rt = (si >> 1) & 1, b = (si >> 2) & 3, e = si >> 4;
        const int* arow = wsp<int>(p, OFF_IDX) + (long)(b * NE + e) * CAP + rt * 256;
        const float* rss = wsp<float>(p, OFF_RSS) + (long)(b * NE + e) * CAP + rt * 256;
        gemm_256sq_multi(wsp<bf16_t>(p, OFF_X2B), ND, arow, wsp<bf16_t>(p, OFF_WGUT) + ((long)e * 2048 + cth * 1024) * ND, ND, 256L * ND,
                         ND, 4, lds, [&](int t, f32x4 (&acc)[8][4]) {
            const int ct = cth * 4 + t;
            char* adb = (char*)(wsp<bf16_t>(p, OFF_ACT) + ((long)(e * NB + b) * CAP + rt * 256) * ND + ct * 128);
            const unsigned ado = (unsigned)((wm * 128 + lr) * ND + wn * 32 + 4 * lq) * 2u;
#pragma unroll
            for (int mi = 0; mi < 8; mi++) {
                const float rs = rss[wm * 128 + mi * 16 + lr];
#pragma unroll
                for (int pp = 0; pp < 2; pp++) {
                    f32x4 o;
#pragma unroll
                    for (int q = 0; q < 4; q++) {
                        const float ga = acc[mi][2 * pp][q] * rs, up = acc[mi][2 * pp + 1][q] * rs;
                        o[q] = ga * __builtin_amdgcn_rcpf(1.f + __expf(-ga)) * up;
                    }
                    *(u32x2*)(adb + (ado + (unsigned)(mi * 16 * ND * 2 + pp * 32))) = pack4bf(o);
                    __builtin_amdgcn_sched_barrier(0);
                }
            }
        });
    }
}
__device__ __forceinline__ void phase10_8(const Params& p, char* lds) {
    const int tid = threadIdx.x, lane = tid & 63, wid = tid >> 6, wm = wid >> 2, wn = wid & 3, lq = lane >> 4, lr = lane & 15;
    FOR_XCD_ITEMS_R(si, NE * NB * 2 * 2) {
        const int cth = si & 1, rt = (si >> 1) & 1, b = (si >> 2) & 3, e = si >> 4;
        const long row0 = (long)(e * NB + b) * CAP + rt * 256;
        const float* gate = wsp<float>(p, OFF_GATE) + (long)(b * NE + e) * CAP + rt * 256;
        gemm_256sq_multi(wsp<bf16_t>(p, OFF_ACT) + row0 * ND, ND, nullptr, wsp<bf16_t>(p, OFF_WDT) + ((long)e * 1024 + cth * 512) * ND, ND, 256L * ND,
                         ND, 2, lds, [&](int t, f32x4 (&acc)[8][4]) {
            const int ct = cth * 2 + t;
            char* yb = (char*)(wsp<bf16_t>(p, OFF_Y) + row0 * ND + ct * 256);
            const unsigned yo = (unsigned)((wm * 128 + lr) * ND + wn * 64 + 4 * lq) * 2u;
#pragma unroll
            for (int mi = 0; mi < 8; mi++) {
                const float gv = gate[wm * 128 + mi * 16 + lr];
#pragma unroll
                for (int ni = 0; ni < 4; ni++) *(u32x2*)(yb + (yo + (unsigned)(mi * 16 * ND * 2 + ni * 32))) = pack4bf(acc[mi][ni] * gv);
            }
        });
    }
}


__device__ __forceinline__ void phase1_big(const Params& p, char* lds) {
    const int tid = threadIdx.x, lane = tid & 63, wid = tid >> 6, wm = wid >> 2, wn = wid & 3, lq = lane >> 4, lr = lane & 15;
    FOR_XCD_ITEMS_R(item, 64 * 4) {
        const int tm = item >> 2, tn = item & 3;
        f32x4 acc[8][4];
        GemmTile g; g.A = wsp<bf16_t>(p, OFF_XB) + (long)tm * 256 * ND; g.lda = ND; g.arow = nullptr;
        g.Bt = wsp<bf16_t>(p, OFF_W1T) + (long)tn * 256 * ND; g.ldb = ND; g.K = ND;
        gemm_tile_256sq(g, lds, acc);
        const float* r0 = wsp<float>(p, OFF_R0);
        const int col0 = tn * 256 + wn * 64;
#pragma unroll
        for (int mi = 0; mi < 8; mi++) {
            const int row = tm * 256 + wm * 128 + mi * 16 + lr;
            const float rs = r0[row];
#pragma unroll
            for (int ni = 0; ni < 4; ni++) acc[mi][ni] *= rs;
            if (col0 < 512) {
#pragma unroll
                for (int ni = 0; ni < 4; ni++)
                    *(u32x2*)(wsp<bf16_t>(p, OFF_UF) + (long)row * 512 + col0 + ni * 16 + 4 * lq) = pack4bf(acc[mi][ni]);
            } else {
                float ss = 0.f;
#pragma unroll
                for (int ni = 0; ni < 4; ni++) { const f32x4 v = acc[mi][ni]; ss += v[0] * v[0] + v[1] * v[1] + v[2] * v[2] + v[3] * v[3]; }
                ss += __shfl_xor(ss, 16); ss += __shfl_xor(ss, 32);
                if (col0 < 896) {
#pragma unroll
                    for (int ni = 0; ni < 4; ni++)
                        *(u32x2*)(wsp<bf16_t>(p, OFF_UQ) + (long)row * 384 + (col0 - 512) + ni * 16 + 4 * lq) = pack4bf(acc[mi][ni]);
                    if (lq == 0) wsp<float>(p, OFF_SSQ)[row * 6 + ((col0 - 512) >> 6)] = ss;
                } else {
#pragma unroll
                    for (int ni = 0; ni < 4; ni++)
                        *(u32x2*)(wsp<bf16_t>(p, OFF_UKV) + (long)row * 256 + (col0 - 896) + ni * 16 + 4 * lq) = pack4bf(acc[mi][ni]);
                    if (lq == 0) wsp<float>(p, OFF_SSKV)[row * 4 + ((col0 - 896) >> 6)] = ss;
                }
            }
        }
    }
}


__device__ __forceinline__ void phase3_attn8(const Params& p, char* lds) {
    FOR_XCD_ITEMS_R(item, NB * 8 * (NS / 256)) {
        const int qt = item & 15, h = (item >> 4) & 7, b = item >> 7;
        const bf16_t* Qp = wsp<bf16_t>(p, OFF_Q) + ((long)(b * 8 + h) * NS + qt * 256) * 96;
        const bf16_t* Kp = wsp<bf16_t>(p, OFF_K) + ((long)(b * 8 + h) * NS) * 96;
        const bf16_t* Vtp = wsp<bf16_t>(p, OFF_VT) + ((long)(b * 8 + h) * 64) * NS;
        bf16_t* Op = wsp<bf16_t>(p, OFF_ZA) + ((long)b * NS + qt * 256) * 1024 + 512 + h * 64;
        attn_block<96, 64, 128, 512>(Qp, Kp, Vtp, (long)NS, NS, lds, [&](int q, int dv, f32x4 v) { *(u32x2*)(Op + (long)q * 1024 + dv) = pack4bf(v); });
    }
}
__device__ __forceinline__ void cross_attn_item(const Params& p, char* lds, int b, int hd, int qt) {
    constexpr int KROW = 256 * 2 + 16, VROW = 32 * 2 + 8, SLOT = 256 * VROW;
    const int tid = threadIdx.x, lane = tid & 63, wid = tid >> 6, h = lane >> 5, c = lane & 31;
    {
        const bf16_t* Qp = wsp<bf16_t>(p, OFF_QM) + ((long)(b * 4 + hd) * NS + qt * 256) * 256;
        const bf16_t* Kp = wsp<bf16_t>(p, OFF_KMEM) + ((long)(b * 4 + hd) * 256) * 256;
        const bf16_t* Vtp = wsp<bf16_t>(p, OFF_VTMEM) + ((long)(b * 4 + hd) * 256) * 256;
        bf16_t* Op = wsp<bf16_t>(p, OFF_OM) + ((long)b * NS + qt * 256) * 1024 + hd * 256;
        u32x4 gr[2];
        auto gload = [&](int t) {
#pragma unroll
            for (int i = 0; i < 2; i++) {
                const int ci = tid + 512 * i;
                if (t < 8) { const int row = ci >> 5, cc = ci & 31; gr[i] = *(const u32x4*)(Kp + (long)(t * 32 + row) * 256 + cc * 8); }
                else { const int row = ci >> 2, cc = ci & 3; gr[i] = *(const u32x4*)(Vtp + (long)row * 256 + (t - 8) * 32 + cc * 8); }
            }
        };
        auto lwrite = [&](int t, char* st) {
#pragma unroll
            for (int i = 0; i < 2; i++) {
                const int ci = tid + 512 * i;
                if (t < 8) { const int row = ci >> 5, cc = ci & 31; *(u32x4*)(st + row * KROW + cc * 16) = gr[i]; }
                else { const int row = ci >> 2, cc = ci & 3; char* q = st + row * VROW + cc * 16; *(u32x2*)q = (u32x2){gr[i].x, gr[i].y}; *(u32x2*)(q + 8) = (u32x2){gr[i].z, gr[i].w}; }
            }
        };
        gload(0);
        bf16x8 qf[16];
        {
            const bf16_t* qrow = Qp + (long)(wid * 32 + c) * 256 + 8 * h;
#pragma unroll
            for (int ks = 0; ks < 16; ks++) qf[ks] = *(const bf16x8*)(qrow + 16 * ks);
        }
        __syncthreads();
        lwrite(0, lds);
        __syncthreads();
        f32x16 s[8];
#pragma unroll
        for (int t = 0; t < 8; t++) {
            const char* cur = lds + (t & 1) * SLOT;
            gload(t + 1);
#pragma unroll
            for (int r = 0; r < 16; r++) s[t][r] = 0.f;
#pragma unroll
            for (int ks = 0; ks < 16; ks++) {
                const bf16x8 kf = *(const bf16x8*)(cur + c * KROW + ks * 32 + h * 16);
                s[t] = __builtin_amdgcn_mfma_f32_32x32x16_bf16(kf, qf[ks], s[t], 0, 0, 0);
            }
            lwrite(t + 1, lds + ((t + 1) & 1) * SLOT);
            __syncthreads();
        }
        float mx = s[0][0];
#pragma unroll
        for (int t = 0; t < 8; t++)
#pragma unroll
            for (int r = 0; r < 16; r++) mx = fmaxf(mx, s[t][r]);
        mx = fmaxf(mx, __shfl_xor(mx, 32));
        float l = 0.f;
        bf16x8 pf[16];
#pragma unroll
        for (int t = 0; t < 8; t++) {
#pragma unroll
            for (int r = 0; r < 16; r++) { const float e = __builtin_amdgcn_exp2f(s[t][r] - mx); l += e; s[t][r] = e; }
#pragma unroll
            for (int u = 0; u < 2; u++) {
                u32x4 pw;
                pw.x = pack2bf(s[t][8 * u + 0], s[t][8 * u + 1]);
                pw.y = pack2bf(s[t][8 * u + 2], s[t][8 * u + 3]);
                pw.z = pack2bf(s[t][8 * u + 4], s[t][8 * u + 5]);
                pw.w = pack2bf(s[t][8 * u + 6], s[t][8 * u + 7]);
                pf[2 * t + u] = __builtin_bit_cast(bf16x8, pw);
            }
        }
        l += __shfl_xor(l, 32);
        f32x16 o[8];
#pragma unroll
        for (int dt = 0; dt < 8; dt++)
#pragma unroll
            for (int r = 0; r < 16; r++) o[dt][r] = 0.f;
#pragma unroll
        for (int v = 0; v < 8; v++) {
            const char* cur = lds + (v & 1) * SLOT;
            if (v + 1 < 8) gload(8 + v + 1);
#pragma unroll
            for (int u = 0; u < 2; u++)
#pragma unroll
                for (int dt = 0; dt < 8; dt++) {
                    const char* vp = cur + (dt * 32 + c) * VROW + (u * 16 + 4 * h) * 2;
                    const u32x2 v0 = *(const u32x2*)(vp);
                    const u32x2 v1 = *(const u32x2*)(vp + 16);
                    const bf16x8 vf = __builtin_bit_cast(bf16x8, ((u32x4){v0.x, v0.y, v1.x, v1.y}));
                    o[dt] = __builtin_amdgcn_mfma_f32_32x32x16_bf16(vf, pf[2 * v + u], o[dt], 0, 0, 0);
                }
            if (v + 1 < 8) lwrite(8 + v + 1, lds + ((v + 1) & 1) * SLOT);
            __syncthreads();
        }
        const float inv = 1.f / l;
#pragma unroll
        for (int dt = 0; dt < 8; dt++)
#pragma unroll
            for (int g4 = 0; g4 < 4; g4++) {
                const f32x4 v = {o[dt][4 * g4 + 0] * inv, o[dt][4 * g4 + 1] * inv, o[dt][4 * g4 + 2] * inv, o[dt][4 * g4 + 3] * inv};
                *(u32x2*)(Op + (long)(wid * 32 + c) * 1024 + dt * 32 + 8 * g4 + 4 * h) = pack4bf(v);
            }
    }
}
__device__ __forceinline__ void phase5_fused(const Params& p, char* lds) {
    const int tid = threadIdx.x, lane = tid & 63, wid = tid >> 6, wm = wid >> 2, wn = wid & 3, lq = lane >> 4, lr = lane & 15;
    FOR_XCD_ITEMS_R(item, 64 * 4) {
        const int tm = item >> 2, tn = item & 3;
        f32x4 acc[8][4];
        GemmTile g; g.A = wsp<bf16_t>(p, OFF_X1B) + (long)tm * 256 * ND; g.lda = ND; g.arow = nullptr;
        g.Bt = wsp<bf16_t>(p, OFF_WMQT) + (long)tn * 256 * ND; g.ldb = ND; g.K = ND;
        gemm_tile_256sq(g, lds, acc);
#pragma unroll
        for (int mi = 0; mi < 8; mi++) {
            const int row = tm * 256 + wm * 128 + mi * 16 + lr, b = row >> 12, s = row & 4095;
            const float rs = row_rs16(wsp<float>(p, OFF_SS1) + (long)row * 16) * (0.0625f * 1.4426950408889634f);
            bf16_t* qd = wsp<bf16_t>(p, OFF_QM) + ((long)(b * 4 + tn) * NS + s) * 256 + wn * 64 + 4 * lq;
#pragma unroll
            for (int ni = 0; ni < 4; ni++) *(u32x2*)(qd + ni * 16) = pack4bf(acc[mi][ni] * rs);
        }
    }
    __builtin_amdgcn_fence(__ATOMIC_RELEASE, "workgroup");
    asm volatile("s_waitcnt vmcnt(0)" ::: "memory");
    __syncthreads();
    __builtin_amdgcn_fence(__ATOMIC_ACQUIRE, "workgroup");
}
__device__ __forceinline__ void phase5_cross(const Params& p, char* lds) {
    FOR_XCD_ITEMS_R(item, 64 * 4) {
        const int tm = item >> 2, tn = item & 3;
        cross_attn_item(p, lds, tm >> 4, tn, tm & 15);
    }
}

__global__ void __launch_bounds__(512, 1) k_fwd(Params p, int ph_lo, int ph_hi) {
    extern __shared__ __attribute__((aligned(16))) char lds_all[];
    char* lds = lds_all + VHALF * LDS_HALF;
    volatile LAS unsigned* st = (volatile LAS unsigned*)(lds_all + LDS_MAIN);
    if (threadIdx.x == 0) { st[0] = 0u; st[1] = 0u; }
    __syncthreads();
    XcdBarrier bar = xcd_barrier_post(wsp<unsigned>(p, OFF_BAR), st);
#if USE_CG_SYNC
#define GRID_BARRIER() do { asm volatile("s_waitcnt vmcnt(0)" ::: "memory"); __syncthreads(); cg::this_grid().sync(); asm volatile("s_waitcnt vmcnt(0)" ::: "memory"); __syncthreads(); } while (0)
#else
#define GRID_BARRIER() xcd_barrier(bar)
#endif
#define RUN_PHASE(k, call) if (ph_lo <= (k) && (k) < ph_hi) { if ((k) > ph_lo) { GRID_BARRIER(); } call; }
    RUN_PHASE(0, phase0(p, lds))
    RUN_PHASE(1, (phase1_big(p, lds_all), phase1(p, lds_all)))
    RUN_PHASE(2, (phase2(p, lds_all), phase2_f2a(p, lds)))
    RUN_PHASE(3, ((blockIdx.x & 1) ? phase3_tr(p, lds) : (void)0, phase3_attn8(p, lds_all), phase3_f2b(p, lds), (blockIdx.x & 1) ? (void)0 : phase3_tr(p, lds)))
    RUN_PHASE(4, phase_resid8(p, lds_all, OFF_ZA, OFF_WOUTT, p.x, nullptr, OFF_X1B, OFF_SS1))
    RUN_PHASE(5, (phase5_fused(p, lds_all), phase5_cross(p, lds_all)))
    RUN_PHASE(6, phase_resid8(p, lds_all, OFF_OM, OFF_WMOT, nullptr, wsp<bf16_t>(p, OFF_X1B), OFF_X2B, OFF_SS2))
    RUN_PHASE(7, phase7(p, lds_all))
    RUN_PHASE(8, phase8(p, lds_all))
    RUN_PHASE(9, phase9_8(p, lds_all))
    RUN_PHASE(10, phase10_8(p, lds_all))
    RUN_PHASE(11, phase11(p, lds))
}

extern "C" void kernel_launch(void* const* d_in, const int* in_sizes, int n_in,
                              void* d_out, int out_size, void* d_ws, size_t ws_size,
                              hipStream_t stream) {
    static int grid = 0;
    if (grid == 0) {
        if (n_in != 22 || ws_size < WS_END) { fprintf(stderr, "kernel_launch: unexpected inputs (n_in %d, ws %zu < %zu)\n", n_in, ws_size, (size_t)WS_END); grid = -1; return; }
        int dev = 0, cus = 0, per_cu = 0;
        (void)hipGetDevice(&dev);
        (void)hipDeviceGetAttribute(&cus, hipDeviceAttributeMultiprocessorCount, dev);
        if (hipFuncSetAttribute((const void*)k_fwd, hipFuncAttributeMaxDynamicSharedMemorySize, LDS_TOTAL) != hipSuccess) { fprintf(stderr, "kernel_launch: hipFuncSetAttribute failed\n"); grid = -1; return; }
        if (hipOccupancyMaxActiveBlocksPerMultiprocessor(&per_cu, (const void*)k_fwd, 512, LDS_TOTAL) != hipSuccess || per_cu < 1) { fprintf(stderr, "kernel_launch: occupancy query failed (%d)\n", per_cu); (void)hipGetLastError(); per_cu = 1; }
        if (per_cu > 1) per_cu = 1;
        grid = (cus * per_cu) & ~7;
        if (grid < 8) { fprintf(stderr, "kernel_launch: unexpected device (%d CUs)\n", cus); grid = -1; return; }
        fprintf(stderr, "kernel_launch: %d CUs x %d blocks\n", cus, per_cu);
    }
    if (grid < 0) return;
    Params p{};
    p.x = (const float*)d_in[0]; p.mem = (const float*)d_in[1]; p.pos = (const int*)d_in[2];
    p.g_mix = (const float*)d_in[3]; p.w_in = (const float*)d_in[4]; p.g_q_lat = (const float*)d_in[5]; p.w_q_up = (const float*)d_in[6];
    p.g_kv_lat = (const float*)d_in[7]; p.w_kv_up = (const float*)d_in[8]; p.w_fourier = (const float*)d_in[9]; p.w_out = (const float*)d_in[10];
    p.g_mem_q = (const float*)d_in[11]; p.g_mem_kv = (const float*)d_in[12]; p.w_mem_q = (const float*)d_in[13]; p.w_mem_kv = (const float*)d_in[14];
    p.w_mem_o = (const float*)d_in[15]; p.g_ffn = (const float*)d_in[16]; p.w_router = (const float*)d_in[17];
    p.w_exp_gate = (const float*)d_in[18]; p.w_exp_up = (const float*)d_in[19]; p.w_exp_down = (const float*)d_in[20]; p.g_final = (const float*)d_in[21];
    p.out = (float*)d_out; p.ws = (char*)d_ws;
    static const int cuts[] = MK_CUTS;
    const int ncut = (int)(sizeof(cuts) / sizeof(int));
    for (int li = 0; li + 1 < ncut; li++) {
        (void)hipMemsetAsync((char*)d_ws + OFF_BAR, 0, 16384, stream);
        int lo = cuts[li], hi = cuts[li + 1];
        void* args[] = {&p, &lo, &hi};
        hipError_t e = hipLaunchCooperativeKernel((const void*)k_fwd, dim3(grid), dim3(512), args, LDS_TOTAL, stream);
        if (e != hipSuccess) fprintf(stderr, "cooperative launch failed: %s (grid %d)\n", hipGetErrorString(e), grid);
    }
}
```

```cpp
#include <hip/hip_runtime.h>
#include <stdint.h>
#include <cstdio>
#include <hip/hip_cooperative_groups.h>
namespace cg = cooperative_groups;
#ifndef USE_CG_SYNC
#define USE_CG_SYNC 0
#endif

#ifndef MK_CUTS
#define MK_CUTS {0, 12}
#endif

#define NB 4
#define NS 4096
#define ND 1024
#define NT (NB * NS)
#define INW 1184
#define NE 16
#define CAP 512
#define MEML 256
#define NPHASE 12
#define VTID ((int)(threadIdx.x & 255))
#define VHALF (__builtin_amdgcn_readfirstlane((int)(threadIdx.x >> 8)))
#define VBLK ((int)(blockIdx.x * 2) + VHALF)
#define VGRID ((int)(gridDim.x * 2))

typedef unsigned short bf16_t;
typedef short bf16x8 __attribute__((ext_vector_type(8)));
typedef float f32x4 __attribute__((ext_vector_type(4)));
typedef float f32x16 __attribute__((ext_vector_type(16)));
typedef unsigned u32x4 __attribute__((ext_vector_type(4)));
typedef int i32x4 __attribute__((ext_vector_type(4)));
typedef unsigned u32x2 __attribute__((ext_vector_type(2)));

__device__ __forceinline__ unsigned f2bf(float f) {
    unsigned u = __float_as_uint(f);
    u += 0x7FFFu + ((u >> 16) & 1u);
    return u >> 16;
}
typedef __bf16 hbf2 __attribute__((ext_vector_type(2)));
typedef float f32x2 __attribute__((ext_vector_type(2)));
__device__ __forceinline__ unsigned pack2bf(float lo, float hi) { f32x2 v = {lo, hi}; return __builtin_bit_cast(unsigned, __builtin_convertvector(v, hbf2)); }
__device__ __forceinline__ float bf2f(unsigned short b) { return __uint_as_float(((unsigned)b) << 16); }

__device__ __forceinline__ int tile_off(int row, int chunk) { return row * 128 + ((chunk ^ ((row >> 1) & 7)) << 4); }

#define GT_LDS_BYTES 65536

struct GemmTile { const bf16_t* A; long lda; const int* arow; const bf16_t* Bt; long ldb; int K; };

__device__ __forceinline__ void gemm_tile_128(const GemmTile& g, char* lds, f32x4 (&acc)[4][4]) {
    const int tid = VTID, lane = tid & 63, wid = tid >> 6, wm = wid >> 1, wn = wid & 1;
    const int lrow = lane >> 3, pc = lane & 7;
    const bf16_t* ap[4]; const bf16_t* bp[4];
#pragma unroll
    for (int i = 0; i < 4; i++) {
        const int r = (wid * 4 + i) * 8 + lrow;
        const int c = pc ^ ((r >> 1) & 7);
        const long ro = g.arow ? (long)g.arow[r] * g.lda : (long)r * g.lda;
        ap[i] = g.A + ro + c * 8;
        bp[i] = g.Bt + (long)r * g.ldb + c * 8;
    }
#pragma unroll
    for (int mi = 0; mi < 4; mi++)
#pragma unroll
        for (int ni = 0; ni < 4; ni++) acc[mi][ni] = (f32x4){0.f, 0.f, 0.f, 0.f};
    const int nk = g.K >> 6;
    auto stage = [&](int kt, char* st) {
#pragma unroll
        for (int i = 0; i < 4; i++) {
            __builtin_amdgcn_global_load_lds((const unsigned*)(ap[i] + kt * 64), (unsigned*)(st + (wid * 4 + i) * 1024), 16, 0, 0);
            __builtin_amdgcn_global_load_lds((const unsigned*)(bp[i] + kt * 64), (unsigned*)(st + 16384 + (wid * 4 + i) * 1024), 16, 0, 0);
        }
    };
    __syncthreads();
    stage(0, lds);
    asm volatile("s_waitcnt vmcnt(0)" ::: "memory");
    __syncthreads();
    for (int kt = 0; kt < nk; kt++) {
        char* cur = lds + (kt & 1) * 32768;
        if (kt + 1 < nk) stage(kt + 1, lds + ((kt + 1) & 1) * 32768);
        bf16x8 af[2][4], bfr[2][4];
#pragma unroll
        for (int ks = 0; ks < 2; ks++)
#pragma unroll
            for (int i = 0; i < 4; i++) {
                af[ks][i] = *(const bf16x8*)(cur + tile_off(wm * 64 + i * 16 + (lane & 15), ks * 4 + (lane >> 4)));
                bfr[ks][i] = *(const bf16x8*)(cur + 16384 + tile_off(wn * 64 + i * 16 + (lane & 15), ks * 4 + (lane >> 4)));
            }
        __builtin_amdgcn_s_setprio(1);
#pragma unroll
        for (int ks = 0; ks < 2; ks++)
#pragma unroll
            for (int mi = 0; mi < 4; mi++)
#pragma unroll
                for (int ni = 0; ni < 4; ni++)
                    acc[mi][ni] = __builtin_amdgcn_mfma_f32_16x16x32_bf16(bfr[ks][ni], af[ks][mi], acc[mi][ni], 0, 0, 0);
        __builtin_amdgcn_s_setprio(0);
        asm volatile("s_waitcnt vmcnt(0)" ::: "memory");
        __syncthreads();
    }
}

template <int DQK, int DVT, int KT>
struct AttnCfg {
    static constexpr int KROW = DQK * 2 + 16;
    static constexpr int VROW = KT * 2 + 8;
    static constexpr int KBYTES = KT * KROW;
    static constexpr int VBYTES = DVT * VROW;
    static constexpr int STAGE = KBYTES + VBYTES;
    static constexpr int LDS = 2 * STAGE;
};

template <int DQK, int DVT, int KT, int NTH, class Out>
__device__ __forceinline__ void attn_block(const bf16_t* Qp, const bf16_t* Kp, const bf16_t* Vtp, long ldv, int nk, char* lds, Out&& out) {
    typedef AttnCfg<DQK, DVT, KT> C;
    constexpr int NKS = DQK / 16, NST = KT / 32, NDT = DVT / 32, NPS = KT / 16;
    constexpr int KCPR = DQK / 8;
    constexpr int KTOT = KT * KCPR, KCH = (KTOT + NTH - 1) / NTH;
    constexpr int VCPR = KT / 8;
    constexpr int VTOT = DVT * VCPR, VCH = (VTOT + NTH - 1) / NTH;
    const int tid = NTH == 512 ? (int)threadIdx.x : VTID, lane = tid & 63, wid = tid >> 6, h = lane >> 5, c = lane & 31;

    bf16x8 qf[NKS];
    {
        const bf16_t* qrow = Qp + (long)(wid * 32 + c) * DQK + 8 * h;
#pragma unroll
        for (int ks = 0; ks < NKS; ks++) qf[ks] = *(const bf16x8*)(qrow + 16 * ks);
    }
    f32x16 o[NDT];
#pragma unroll
    for (int dt = 0; dt < NDT; dt++)
#pragma unroll
        for (int r = 0; r < 16; r++) o[dt][r] = 0.f;
    float m = 0.f, l = 0.f;

    u32x4 kr[KCH], vr[VCH];
    auto gload = [&](int t) {
#pragma unroll
        for (int i = 0; i < KCH; i++) {
            const int ci = tid + NTH * i, row = ci / KCPR, cc = ci % KCPR;
            if (KTOT % NTH == 0 || ci < KTOT) kr[i] = *(const u32x4*)(Kp + (long)(t * KT + row) * DQK + cc * 8);
        }
#pragma unroll
        for (int i = 0; i < VCH; i++) {
            const int ci = tid + NTH * i, row = ci / VCPR, cc = ci % VCPR;
            if (VTOT % NTH == 0 || ci < VTOT) vr[i] = *(const u32x4*)(Vtp + (long)row * ldv + t * KT + cc * 8);
        }
    };
    auto lwrite = [&](char* st) {
#pragma unroll
        for (int i = 0; i < KCH; i++) {
            const int ci = tid + NTH * i, row = ci / KCPR, cc = ci % KCPR;
            if (KTOT % NTH == 0 || ci < KTOT) *(u32x4*)(st + row * C::KROW + cc * 16) = kr[i];
        }
#pragma unroll
        for (int i = 0; i < VCH; i++) {
            const int ci = tid + NTH * i, row = ci / VCPR, cc = ci % VCPR;
            if (VTOT % NTH == 0 || ci < VTOT) {
                char* p = st + C::KBYTES + row * C::VROW + cc * 16;
                *(u32x2*)(p) = (u32x2){vr[i].x, vr[i].y};
                *(u32x2*)(p + 8) = (u32x2){vr[i].z, vr[i].w};
            }
        }
    };
    const int nt = nk / KT;
    gload(0);
    __syncthreads();
    lwrite(lds);
    __syncthreads();
    for (int t = 0; t < nt; t++) {
        char* cur = lds + (t & 1) * C::STAGE;
        if (t + 1 < nt) gload(t + 1);
        f32x16 s[NST];
        const float negm = -m;
#pragma unroll
        for (int st = 0; st < NST; st++) {
#pragma unroll
            for (int r = 0; r < 16; r++) s[st][r] = negm;
#pragma unroll
            for (int ks = 0; ks < NKS; ks++) {
                const bf16x8 kf = *(const bf16x8*)(cur + (st * 32 + c) * C::KROW + ks * 32 + h * 16);
                s[st] = __builtin_amdgcn_mfma_f32_32x32x16_bf16(kf, qf[ks], s[st], 0, 0, 0);
            }
        }
        float mx = s[0][0];
#pragma unroll
        for (int st = 0; st < NST; st++)
#pragma unroll
            for (int r = 0; r < 16; r++) mx = fmaxf(mx, s[st][r]);
        mx = fmaxf(mx, __shfl_xor(mx, 32));
        if (__any(mx > 8.0f)) {
            const float d = fmaxf(mx, 0.f);
            const float alpha = __builtin_amdgcn_exp2f(-d);
            m += d;
            l *= alpha;
#pragma unroll
            for (int dt = 0; dt < NDT; dt++)
#pragma unroll
                for (int r = 0; r < 16; r++) o[dt][r] *= alpha;
#pragma unroll
            for (int st = 0; st < NST; st++)
#pragma unroll
                for (int r = 0; r < 16; r++) s[st][r] -= d;
        }
        float rs = 0.f;
#pragma unroll
        for (int st = 0; st < NST; st++)
#pragma unroll
            for (int r = 0; r < 16; r++) { const float p = __builtin_amdgcn_exp2f(s[st][r]); rs += p; s[st][r] = p; }
        l += rs;
#pragma unroll
        for (int ps = 0; ps < NPS; ps++) {
            const int st = ps >> 1, u = ps & 1;
            u32x4 pw;
            pw.x = pack2bf(s[st][8 * u + 0], s[st][8 * u + 1]);
            pw.y = pack2bf(s[st][8 * u + 2], s[st][8 * u + 3]);
            pw.z = pack2bf(s[st][8 * u + 4], s[st][8 * u + 5]);
            pw.w = pack2bf(s[st][8 * u + 6], s[st][8 * u + 7]);
            const bf16x8 pf = __builtin_bit_cast(bf16x8, pw);
#pragma unroll
            for (int dt = 0; dt < NDT; dt++) {
                const char* vp = cur + C::KBYTES + (dt * 32 + c) * C::VROW + (ps * 16 + 4 * h) * 2;
                const u32x2 v0 = *(const u32x2*)(vp);
                const u32x2 v1 = *(const u32x2*)(vp + 16);
                const bf16x8 vf = __builtin_bit_cast(bf16x8, ((u32x4){v0.x, v0.y, v1.x, v1.y}));
                o[dt] = __builtin_amdgcn_mfma_f32_32x32x16_bf16(vf, pf, o[dt], 0, 0, 0);
            }
        }
        if (t + 1 < nt) lwrite(lds + ((t + 1) & 1) * C::STAGE);
        __syncthreads();
    }
    l += __shfl_xor(l, 32);
    const float inv = 1.f / l;
#pragma unroll
    for (int dt = 0; dt < NDT; dt++)
#pragma unroll
        for (int g4 = 0; g4 < 4; g4++) {
            f32x4 v = {o[dt][4 * g4 + 0] * inv, o[dt][4 * g4 + 1] * inv, o[dt][4 * g4 + 2] * inv, o[dt][4 * g4 + 3] * inv};
            out(wid * 32 + c, dt * 32 + 8 * g4 + 4 * h, v);
        }
}


constexpr size_t SLOT = 33554432;
constexpr size_t OFF_W1T = 0;
constexpr size_t OFF_WQT = OFF_W1T + 1280UL * 1024 * 2;
constexpr size_t OFF_WKVT = OFF_WQT + 768UL * 384 * 2;
constexpr size_t OFF_WOUTT = OFF_WKVT + 1024UL * 256 * 2;
constexpr size_t OFF_WMQT = OFF_WOUTT + 1024UL * 1024 * 2;
constexpr size_t OFF_WMKVT = OFF_WMQT + 1024UL * 1024 * 2;
constexpr size_t OFF_WMOT = OFF_WMKVT + 2048UL * 1024 * 2;
constexpr size_t OFF_WGUT = OFF_WMOT + 1024UL * 1024 * 2;
constexpr size_t OFF_WDT = OFF_WGUT + 16UL * 2048 * 1024 * 2;
constexpr size_t OFF_T64 = OFF_WDT + 16UL * 1024 * 1024 * 2;
constexpr size_t OFF_M1 = OFF_T64 + 16384;
constexpr size_t OFF_M3 = OFF_M1 + 32768;
constexpr size_t OFF_WFT = OFF_M3 + 16384;
constexpr size_t OFF_TW = OFF_WFT + 65536;
constexpr size_t OFF_ROPE = OFF_TW + 32768;
constexpr size_t OFF_R0 = OFF_ROPE + (size_t)NT * 16 * 8;
constexpr size_t OFF_RMEM = OFF_R0 + (size_t)NT * 4;
constexpr size_t OFF_SSQ = OFF_RMEM + 4096;
constexpr size_t OFF_SSKV = OFF_SSQ + (size_t)NT * 6 * 4;
constexpr size_t OFF_SS1 = OFF_SSKV + (size_t)NT * 4 * 4;
constexpr size_t OFF_SS2 = OFF_SS1 + (size_t)NT * 16 * 4;
constexpr size_t OFF_AFF = OFF_SS2 + (size_t)NT * 16 * 4;
constexpr size_t OFF_SLOTS = OFF_AFF + (size_t)NT * 16 * 4;
constexpr size_t OFF_IDX = OFF_SLOTS + 4UL * 16 * 4096 * 4;
constexpr size_t OFF_GATE = OFF_IDX + 4UL * 16 * 512 * 4;
constexpr size_t OFF_MEMB = OFF_GATE + 4UL * 16 * 512 * 4;
constexpr size_t OFF_KMEM = OFF_MEMB + 1024UL * 1024 * 2;
constexpr size_t OFF_VTMEM = OFF_KMEM + 1024UL * 1024 * 2;
constexpr size_t OFF_KR = OFF_VTMEM + 1024UL * 1024 * 2;
constexpr size_t OFF_BAR = OFF_KR + (size_t)NT * 32 * 2;
constexpr size_t OFF_RS2 = OFF_BAR + 16384;
constexpr size_t OFF_RSS = OFF_RS2 + (size_t)NT * 4;
constexpr size_t OFF_S0 = (OFF_RSS + 4UL * 16 * 512 * 4 + 255) / 256 * 256;
constexpr size_t OFF_S1 = OFF_S0 + SLOT;
constexpr size_t OFF_S2 = OFF_S1 + SLOT;
constexpr size_t OFF_S3 = OFF_S2 + SLOT;
constexpr size_t OFF_S4 = OFF_S3 + SLOT;
constexpr size_t WS_END = OFF_S4 + SLOT;
static_assert(WS_END <= 300964352UL, "workspace map exceeds the guaranteed scratch size");
constexpr size_t OFF_XB = OFF_S0, OFF_YR = OFF_S0, OFF_YI = OFF_S0 + SLOT / 2, OFF_X1B = OFF_S3, OFF_OM = OFF_S0, OFF_ACT = OFF_S0;
constexpr size_t OFF_UF = OFF_S1, OFF_UQ = OFF_S1 + (size_t)NT * 512 * 2, OFF_ZA = OFF_S1, OFF_QM = OFF_S1;
constexpr size_t OFF_Q = OFF_S2, OFF_UKV = OFF_S2 + (size_t)NT * 768 * 2, OFF_X2B = OFF_S2;
constexpr size_t OFF_K = OFF_S3, OFF_Y = OFF_S3;
constexpr size_t OFF_VT = OFF_S4;

struct Params {
    const float *x, *mem; const int* pos;
    const float *g_mix, *w_in, *g_q_lat, *w_q_up, *g_kv_lat, *w_kv_up, *w_fourier, *w_out, *g_mem_q, *g_mem_kv, *w_mem_q, *w_mem_kv, *w_mem_o,
        *g_ffn, *w_router, *w_exp_gate, *w_exp_up, *w_exp_down, *g_final;
    float* out; char* ws;
};
template <class T> __device__ __forceinline__ T* wsp(const Params& p, size_t off) { return (T*)(p.ws + off); }

#define LDS_HALF 65536
#define LDS_MAIN 131072
#define LDS_TOTAL (LDS_MAIN + 16)
#define LAS __attribute__((address_space(3)))

#define XB_TMO      128
#define XB_XCNT(j)  (256  + 64 * (j))
#define XB_XSUB(j)  (1280 + 64 * (j))
#define XB_XGEN(j)  (2304 + 64 * (j))
#define XB_TOP      3328
#define XB_TOPGEN   3392
#define XCD_BAR_WORDS 3456
#define XB_SPIN_CAP (1u << 25)
__device__ __forceinline__ unsigned xb_ld(unsigned* p)              { return __hip_atomic_load(p, __ATOMIC_RELAXED, __HIP_MEMORY_SCOPE_AGENT); }
__device__ __forceinline__ unsigned xb_add(unsigned* p, unsigned v) { return __hip_atomic_fetch_add(p, v, __ATOMIC_RELAXED, __HIP_MEMORY_SCOPE_AGENT); }
__device__ __forceinline__ unsigned xb_xcc_id() { return (unsigned)__builtin_amdgcn_s_getreg((3 << 11) | 20) & 0xFu; }
#define XB_SPIN(cond, bar) do { unsigned _sp = 0; while (cond) { __builtin_amdgcn_s_sleep(1); \
    if ((++_sp & 255u) == 0u) { if (xb_ld(&(bar)[XB_TMO])) break; if (_sp > XB_SPIN_CAP) { atomicAdd(&(bar)[XB_TMO], 1u); break; } } } } while (0)
struct XcdBarrier { unsigned* bar; unsigned x; volatile LAS unsigned* st; };
__device__ __forceinline__ XcdBarrier xcd_barrier_post(unsigned* bar, volatile LAS unsigned* st) {
    XcdBarrier b; b.bar = bar; b.x = xb_xcc_id(); b.st = st;
    if (threadIdx.x == 0) (void)xb_add(&bar[XB_XCNT(b.x)], 1u);
    return b;
}
__device__ __forceinline__ void xcd_barrier_complete(unsigned* bar, unsigned x, unsigned& nloc, unsigned& nx) {
    const unsigned G = gridDim.x * gridDim.y * gridDim.z;
    unsigned sum, cnt, mine, sp = 0u;
    for (;;) {
        sum = 0u; cnt = 0u; mine = 0u;
#pragma unroll
        for (unsigned j = 0; j < 16; ++j) { const unsigned c = xb_ld(&bar[XB_XCNT(j)]); sum += c; cnt += (c > 0u) ? 1u : 0u; mine = (j == x) ? c : mine; }
        if (sum == G) break;
        __builtin_amdgcn_s_sleep(1);
        if ((++sp & 255u) == 0u) { if (xb_ld(&bar[XB_TMO])) break; if (sp > XB_SPIN_CAP) { atomicAdd(&bar[XB_TMO], 1u); break; } }
    }
    nloc = mine > 0u ? mine : 1u; nx = cnt > 0u ? cnt : 1u;
}
__device__ __forceinline__ void xcd_barrier(const XcdBarrier& b) {
    asm volatile("s_waitcnt vmcnt(0)" ::: "memory");
    __syncthreads();
    if (threadIdx.x == 0) {
        unsigned* bar = b.bar;
        __builtin_amdgcn_s_waitcnt(0);
        unsigned nloc = b.st[0], nx = b.st[1];
        if (nloc == 0u) { xcd_barrier_complete(bar, b.x, nloc, nx); b.st[0] = nloc; b.st[1] = nx; }
        const unsigned old = xb_add(&bar[XB_XSUB(b.x)], 1u);
        const unsigned gen = old / nloc;
        if (old + 1u == (gen + 1u) * nloc) {
            __builtin_amdgcn_fence(__ATOMIC_RELEASE, "agent");
            asm volatile("s_waitcnt vmcnt(0)" ::: "memory");
            const unsigned og = xb_add(&bar[XB_TOP], 1u);
            const unsigned tg = og / nx;
            if (og + 1u == (tg + 1u) * nx) xb_add(&bar[XB_TOPGEN], 1u);
            else XB_SPIN(xb_ld(&bar[XB_TOPGEN]) == tg, bar);
            __builtin_amdgcn_fence(__ATOMIC_ACQUIRE, "agent");
            xb_add(&bar[XB_XGEN(b.x)], 1u);
            asm volatile("s_waitcnt vmcnt(0)" ::: "memory");
        } else {
            XB_SPIN(xb_ld(&bar[XB_XGEN(b.x)]) == gen, bar);
            __builtin_amdgcn_fence(__ATOMIC_ACQUIRE, "agent");
            asm volatile("s_waitcnt vmcnt(0)" ::: "memory");
        }
    }
    __syncthreads();
}

#define FOR_XCD_ITEMS(item, N) for (int _L = (int)((blockIdx.x >> 3) << 1) | VHALF, item; _L < (N) / 8 && ((item = (int)(blockIdx.x & 7) * ((N) / 8) + _L), true); _L += (int)(gridDim.x >> 2))

__device__ __forceinline__ u32x2 pack4bf(float a, float b, float c, float d) { return (u32x2){pack2bf(a, b), pack2bf(c, d)}; }
__device__ __forceinline__ u32x2 pack4bf(f32x4 v) { return (u32x2){pack2bf(v[0], v[1]), pack2bf(v[2], v[3])}; }
__device__ __forceinline__ float wave_sum(float v) {
#pragma unroll
    for (int o = 32; o > 0; o >>= 1) v += __shfl_xor(v, o);
    return v;
}

__device__ __forceinline__ void tr_tile(const float* W, long ldw, int k0, int n0, int nvalid, const float* gain, bf16_t* Wt, long ldt, int mode, char* lds) {
    float (*t)[132] = (float (*)[132])lds;
    const int tid = VTID, c4 = tid & 31, r0 = tid >> 5;
    f32x4 v[8];
#pragma unroll
    for (int i = 0; i < 8; i++) {
        const int kk = r0 + 8 * i, n = n0 + c4 * 4;
        v[i] = (n < nvalid) ? *(const f32x4*)(W + (long)(k0 + kk) * ldw + n) : (f32x4){0.f, 0.f, 0.f, 0.f};
        if (gain) v[i] *= gain[k0 + kk];
    }
    __syncthreads();
#pragma unroll
    for (int i = 0; i < 8; i++) *(f32x4*)(&t[r0 + 8 * i][c4 * 4]) = v[i];
    __syncthreads();
#pragma unroll
    for (int i = 0; i < 4; i++) {
        const int ci = tid + 256 * i, nn = ci >> 3, kc = ci & 7;
        const int n = n0 + nn;
        int row = n;
        if (mode) row = (n >> 5) * 64 + ((n >> 4) & 1) * 32 + (mode - 1) * 16 + (n & 15);
        u32x4 w;
        w.x = pack2bf(t[kc * 8 + 0][nn], t[kc * 8 + 1][nn]);
        w.y = pack2bf(t[kc * 8 + 2][nn], t[kc * 8 + 3][nn]);
        w.z = pack2bf(t[kc * 8 + 4][nn], t[kc * 8 + 5][nn]);
        w.w = pack2bf(t[kc * 8 + 6][nn], t[kc * 8 + 7][nn]);
        *(u32x4*)(Wt + (long)row * ldt + k0 + kc * 8) = w;
    }
}

__device__ __forceinline__ void phase0(const Params& p, char* lds) {
    constexpr int J_W1 = 160, J_WQ = 36, J_WKV = 32, J_WOUT = 128, J_WMQ = 128, J_WMKV = 256, J_WMO = 128, J_WG = 0, J_WU = 0, J_WD = 0;
    constexpr int J_TR = J_W1 + J_WQ + J_WKV + J_WOUT + J_WMQ + J_WMKV + J_WMO + J_WG + J_WU + J_WD;
    constexpr int J_XR = NT / 16, J_MR = 1024 / 16, J_ROPE = NT * 16 / 256, J_TAB = (4096 + 8192 + 16384 + 8192 + 32768) / 256;
    constexpr int J_ALL = J_TR + J_XR + J_MR + J_ROPE + J_TAB;
    const int tid = VTID, lane = tid & 63, wid = tid >> 6;
    const double PI2 = 6.283185307179586476925286766559;
    for (int job = VBLK; job < J_ALL; job += VGRID) {
        int j = job;
        if (j < J_TR) {
            if (j < J_W1) { tr_tile(p.w_in, INW, (j / 10) * 64, (j % 10) * 128, INW, p.g_mix, wsp<bf16_t>(p, OFF_W1T), 1024, 0, lds); continue; } j -= J_W1;
            if (j < J_WQ) { tr_tile(p.w_q_up, 768, (j / 6) * 64, (j % 6) * 128, 768, p.g_q_lat, wsp<bf16_t>(p, OFF_WQT), 384, 0, lds); continue; } j -= J_WQ;
            if (j < J_WKV) { tr_tile(p.w_kv_up, 1024, (j / 8) * 64, (j % 8) * 128, 1024, p.g_kv_lat, wsp<bf16_t>(p, OFF_WKVT), 256, 0, lds); continue; } j -= J_WKV;
            if (j < J_WOUT) { tr_tile(p.w_out, 1024, (j / 8) * 64, (j % 8) * 128, 1024, nullptr, wsp<bf16_t>(p, OFF_WOUTT), 1024, 0, lds); continue; } j -= J_WOUT;
            if (j < J_WMQ) { tr_tile(p.w_mem_q, 1024, (j / 8) * 64, (j % 8) * 128, 1024, p.g_mem_q, wsp<bf16_t>(p, OFF_WMQT), 1024, 0, lds); continue; } j -= J_WMQ;
            if (j < J_WMKV) { tr_tile(p.w_mem_kv, 2048, (j / 16) * 64, (j % 16) * 128, 2048, p.g_mem_kv, wsp<bf16_t>(p, OFF_WMKVT), 1024, 0, lds); continue; } j -= J_WMKV;
            if (j < J_WMO) { tr_tile(p.w_mem_o, 1024, (j / 8) * 64, (j % 8) * 128, 1024, nullptr, wsp<bf16_t>(p, OFF_WMOT), 1024, 0, lds); continue; } j -= J_WMO;
            if (j < J_WG) { const int e = j >> 7, r = j & 127; tr_tile(p.w_exp_gate + (long)e * 1048576, 1024, (r / 8) * 64, (r % 8) * 128, 1024, p.g_ffn, wsp<bf16_t>(p, OFF_WGUT) + (long)e * 2048 * 1024, 1024, 1, lds); continue; } j -= J_WG;
            if (j < J_WU) { const int e = j >> 7, r = j & 127; tr_tile(p.w_exp_up + (long)e * 1048576, 1024, (r / 8) * 64, (r % 8) * 128, 1024, p.g_ffn, wsp<bf16_t>(p, OFF_WGUT) + (long)e * 2048 * 1024, 1024, 2, lds); continue; } j -= J_WU;
            { const int e = j >> 7, r = j & 127; tr_tile(p.w_exp_down + (long)e * 1048576, 1024, (r / 8) * 64, (r % 8) * 128, 1024, nullptr, wsp<bf16_t>(p, OFF_WDT) + (long)e * 1048576, 1024, 0, lds); continue; }
        }
        j -= J_TR;
        if (j < J_XR + J_MR) {
            const bool isx = j < J_XR;
            const int row0 = (isx ? j : j - J_XR) * 16 + wid * 4;
            const float* src = (isx ? p.x : p.mem) + (long)row0 * ND;
            bf16_t* dst = (isx ? wsp<bf16_t>(p, OFF_XB) : wsp<bf16_t>(p, OFF_MEMB)) + (long)row0 * ND;
            f32x4 v[4][4];
#pragma unroll
            for (int r = 0; r < 4; r++)
#pragma unroll
                for (int i = 0; i < 4; i++) v[r][i] = *(const f32x4*)(src + (long)r * ND + i * 256 + lane * 4);
#pragma unroll
            for (int r = 0; r < 4; r++) {
                float ss = 0.f;
#pragma unroll
                for (int i = 0; i < 4; i++) {
                    ss += v[r][i][0] * v[r][i][0] + v[r][i][1] * v[r][i][1] + v[r][i][2] * v[r][i][2] + v[r][i][3] * v[r][i][3];
                    *(u32x2*)(dst + (long)r * ND + i * 256 + lane * 4) = pack4bf(v[r][i]);
                }
                ss = wave_sum(ss);
                if (lane == 0) (isx ? wsp<float>(p, OFF_R0) : wsp<float>(p, OFF_RMEM))[row0 + r] = rsqrtf(ss * (1.f / ND) + 1e-6f);
            }
            continue;
        }
        j -= J_XR + J_MR;
        if (j < J_ROPE) {
            const int i = j * 256 + tid; const int t = i >> 4, jj = i & 15;
            constexpr double FR[16] = {
                0.15915494309189535, 0.08949940160889101, 0.050329212104487035, 0.0283021958306234,
                0.015915494309189534, 0.008949940160889102, 0.005032921210448704, 0.00283021958306234,
                0.0015915494309189536, 0.0008949940160889102, 0.0005032921210448703, 0.00028302195830623395,
                0.00015915494309189535, 8.949940160889102e-05, 5.0329212104487035e-05, 2.8302195830623396e-05};
            const double revd = (double)p.pos[t] * FR[jj];
            const float rev = (float)(revd - floor(revd));
            wsp<float2>(p, OFF_ROPE)[i] = make_float2(__builtin_amdgcn_cosf(rev), __builtin_amdgcn_sinf(rev));
            continue;
        }
        j -= J_ROPE;
        {
            int i = j * 256 + tid;
            if (i < 4096) { const double a = PI2 * (double)i / 4096.0; wsp<float2>(p, OFF_TW)[i] = make_float2((float)cos(a), (float)sin(a)); continue; } i -= 4096;
            if (i < 8192) {
                const int T = i >> 12, a = (i >> 6) & 63, b = i & 63;
                const double th = PI2 * (double)((a * b) & 63) / 64.0;
                wsp<bf16_t>(p, OFF_T64)[i] = (bf16_t)f2bf((float)(T ? sin(th) : cos(th))); continue;
            } i -= 8192;
            if (i < 16384) {
                const int rho = i >> 7, k = i & 127;
                const int wm = rho >> 6, mi = (rho >> 4) & 3, lr = rho & 15, ri = mi >> 1, k1 = 32 * wm + 16 * (mi & 1) + lr, ab = k >> 6, s1 = k & 63;
                const double th = PI2 * (double)((k1 * s1) & 63) / 64.0;
                const double c = cos(th), s = sin(th);
                const double v = ri == 0 ? (ab == 0 ? c : -s) : (ab == 0 ? s : c);
                wsp<bf16_t>(p, OFF_M1)[i] = (bf16_t)f2bf((float)v); continue;
            } i -= 16384;
            if (i < 8192) {
                const int k2 = i >> 7, k = i & 127, s2 = k & 63;
                const double th = PI2 * (double)((k2 * s2) & 63) / 64.0;
                wsp<bf16_t>(p, OFF_M3)[i] = (bf16_t)f2bf((float)(k < 64 ? cos(th) : -sin(th))); continue;
            } i -= 8192;
            if (i < 32768) {
                const int g = i >> 12, e = (i >> 6) & 63, ch = i & 63;
                wsp<bf16_t>(p, OFF_WFT)[i] = (bf16_t)f2bf(p.w_fourier[(g * 64 + ch) * 64 + e]); continue;
            }
        }
    }
}

#define FOR_XCD_ITEMS_R(item, N) for (int _L = (int)(blockIdx.x >> 3), item; _L < (N) / 8 && ((item = (int)(blockIdx.x & 7) * ((N) / 8) + _L), true); _L += (int)(gridDim.x >> 3))
__device__ __forceinline__ void gemm_tile_256sq(const GemmTile& g, char* lds, f32x4 (&acc)[8][4]) {
    const int tid = threadIdx.x, lane = tid & 63, wid = tid >> 6, wm = wid >> 2, wn = wid & 3;
    const int lrow = lane >> 3, pc = lane & 7;
    const bf16_t* ap[4]; const bf16_t* bp[4];
#pragma unroll
    for (int i = 0; i < 4; i++) {
        const int r = (wid * 4 + i) * 8 + lrow;
        const int c = pc ^ ((r >> 1) & 7);
        const long ro = g.arow ? (long)g.arow[r] * g.lda : (long)r * g.lda;
        ap[i] = g.A + ro + c * 8;
        bp[i] = g.Bt + (long)r * g.ldb + c * 8;
    }
#pragma unroll
    for (int mi = 0; mi < 8; mi++)
#pragma unroll
        for (int ni = 0; ni < 4; ni++) acc[mi][ni] = (f32x4){0.f, 0.f, 0.f, 0.f};
    const int nk = g.K >> 6;
    auto stage = [&](int kt, char* st) {
#pragma unroll
        for (int i = 0; i < 4; i++) {
            __builtin_amdgcn_global_load_lds((const unsigned*)(ap[i] + kt * 64), (unsigned*)(st + (wid * 4 + i) * 1024), 16, 0, 0);
            __builtin_amdgcn_global_load_lds((const unsigned*)(bp[i] + kt * 64), (unsigned*)(st + 32768 + (wid * 4 + i) * 1024), 16, 0, 0);
        }
    };
    __syncthreads();
    stage(0, lds);
    asm volatile("s_waitcnt vmcnt(0)" ::: "memory");
    __syncthreads();
    for (int kt = 0; kt < nk; kt++) {
        char* cur = lds + (kt & 1) * 65536;
        if (kt + 1 < nk) stage(kt + 1, lds + ((kt + 1) & 1) * 65536);
#pragma unroll
        for (int ks = 0; ks < 2; ks++) {
            bf16x8 af[8], bfr[4];
#pragma unroll
            for (int i = 0; i < 8; i++) af[i] = *(const bf16x8*)(cur + tile_off(wm * 128 + i * 16 + (lane & 15), ks * 4 + (lane >> 4)));
#pragma unroll
            for (int i = 0; i < 4; i++) bfr[i] = *(const bf16x8*)(cur + 32768 + tile_off(wn * 64 + i * 16 + (lane & 15), ks * 4 + (lane >> 4)));
            __builtin_amdgcn_s_setprio(1);
#pragma unroll
            for (int mi = 0; mi < 8; mi++)
#pragma unroll
                for (int ni = 0; ni < 4; ni++)
                    acc[mi][ni] = __builtin_amdgcn_mfma_f32_16x16x32_bf16(bfr[ni], af[mi], acc[mi][ni], 0, 0, 0);
            __builtin_amdgcn_s_setprio(0);
        }
        asm volatile("s_waitcnt vmcnt(0)" ::: "memory");
        __syncthreads();
    }
}


__device__ __forceinline__ void gemm_tile_256x128(const GemmTile& g, char* lds, f32x4 (&acc)[4][4]) {
    const int tid = threadIdx.x, lane = tid & 63, wid = tid >> 6, wm = wid >> 1, wn = wid & 1;
    const int lrow = lane >> 3, pc = lane & 7;
    const bf16_t* ap[4]; const bf16_t* bp[2];
#pragma unroll
    for (int i = 0; i < 4; i++) {
        const int r = (wid * 4 + i) * 8 + lrow;
        const int c = pc ^ ((r >> 1) & 7);
        const long ro = g.arow ? (long)g.arow[r] * g.lda : (long)r * g.lda;
        ap[i] = g.A + ro + c * 8;
    }
#pragma unroll
    for (int i = 0; i < 2; i++) {
        const int r = (wid * 2 + i) * 8 + lrow;
        const int c = pc ^ ((r >> 1) & 7);
        bp[i] = g.Bt + (long)r * g.ldb + c * 8;
    }
#pragma unroll
    for (int mi = 0; mi < 4; mi++)
#pragma unroll
        for (int ni = 0; ni < 4; ni++) acc[mi][ni] = (f32x4){0.f, 0.f, 0.f, 0.f};
    const int nk = g.K >> 6;
    auto stage = [&](int kt, char* st) {
#pragma unroll
        for (int i = 0; i < 4; i++)
            __builtin_amdgcn_global_load_lds((const unsigned*)(ap[i] + kt * 64), (unsigned*)(st + (wid * 4 + i) * 1024), 16, 0, 0);
#pragma unroll
        for (int i = 0; i < 2; i++)
            __builtin_amdgcn_global_load_lds((const unsigned*)(bp[i] + kt * 64), (unsigned*)(st + 32768 + (wid * 2 + i) * 1024), 16, 0, 0);
    };
    __syncthreads();
    stage(0, lds);
    asm volatile("s_waitcnt vmcnt(0)" ::: "memory");
    __syncthreads();
    for (int kt = 0; kt < nk; kt++) {
        char* cur = lds + (kt & 1) * 49152;
        if (kt + 1 < nk) stage(kt + 1, lds + ((kt + 1) & 1) * 49152);
        bf16x8 af[2][4], bfr[2][4];
#pragma unroll
        for (int ks = 0; ks < 2; ks++)
#pragma unroll
            for (int i = 0; i < 4; i++) {
                af[ks][i] = *(const bf16x8*)(cur + tile_off(wm * 64 + i * 16 + (lane & 15), ks * 4 + (lane >> 4)));
                bfr[ks][i] = *(const bf16x8*)(cur + 32768 + tile_off(wn * 64 + i * 16 + (lane & 15), ks * 4 + (lane >> 4)));
            }
        __builtin_amdgcn_s_setprio(1);
#pragma unroll
        for (int ks = 0; ks < 2; ks++)
#pragma unroll
            for (int mi = 0; mi < 4; mi++)
#pragma unroll
                for (int ni = 0; ni < 4; ni++)
                    acc[mi][ni] = __builtin_amdgcn_mfma_f32_16x16x32_bf16(bfr[ks][ni], af[ks][mi], acc[mi][ni], 0, 0, 0);
        __builtin_amdgcn_s_setprio(0);
        asm volatile("s_waitcnt vmcnt(0)" ::: "memory");
        __syncthreads();
    }
}

template <class Setup, class Epi>
__device__ __forceinline__ void gemm_256x128_stream(int nitems, int lshift, int l0, int ls, char* lds, Setup setup, Epi epi) {
    const int tid = threadIdx.x, lane = tid & 63, wid = tid >> 6, wm = wid >> 1, wn = wid & 1;
    const int lrow = lane >> 3, pc = lane & 7;
    const int LN = nitems / 8, LS = ls, xb = (int)(blockIdx.x & 7) * LN;
    int L = (int)(blockIdx.x >> 3) - l0;
    if (L < 0 || L >= LS) return;
    L = (L + LS - lshift % LS) % LS;
    if (L >= LN) return;
    const bf16_t* ap[4]; const bf16_t* bp[2];
    auto setptr = [&](const GemmTile& g) {
#pragma unroll
        for (int i = 0; i < 4; i++) {
            const int r = (wid * 4 + i) * 8 + lrow;
            const int c = pc ^ ((r >> 1) & 7);
            ap[i] = g.A + (long)r * g.lda + c * 8;
        }
#pragma unroll
        for (int i = 0; i < 2; i++) {
            const int r = (wid * 2 + i) * 8 + lrow;
            const int c = pc ^ ((r >> 1) & 7);
            bp[i] = g.Bt + (long)r * g.ldb + c * 8;
        }
    };
    auto stage = [&](int kt, char* st) {
#pragma unroll
        for (int i = 0; i < 4; i++)
            __builtin_amdgcn_global_load_lds((const unsigned*)(ap[i] + kt * 64), (unsigned*)(st + (wid * 4 + i) * 1024), 16, 0, 0);
#pragma unroll
        for (int i = 0; i < 2; i++)
            __builtin_amdgcn_global_load_lds((const unsigned*)(bp[i] + kt * 64), (unsigned*)(st + 32768 + (wid * 2 + i) * 1024), 16, 0, 0);
    };
    GemmTile g; g.arow = nullptr;
    setup(xb + L, g);
    const int nk = g.K >> 6;
    setptr(g);
    __syncthreads();
    stage(0, lds);
    asm volatile("s_waitcnt vmcnt(0)" ::: "memory");
    __syncthreads();
    int q = 0;
    for (; L < LN; L += LS) {
        f32x4 acc[4][4];
#pragma unroll
        for (int mi = 0; mi < 4; mi++)
#pragma unroll
            for (int ni = 0; ni < 4; ni++) acc[mi][ni] = (f32x4){0.f, 0.f, 0.f, 0.f};
        for (int kt = 0; kt < nk; kt++, q++) {
            char* cur = lds + (q & 1) * 49152;
            char* nxt = lds + ((q + 1) & 1) * 49152;
            if (kt + 1 < nk) stage(kt + 1, nxt);
            else if (L + LS < LN) { setup(xb + L + LS, g); setptr(g); stage(0, nxt); }
            bf16x8 af[2][4], bfr[2][4];
#pragma unroll
            for (int ks = 0; ks < 2; ks++)
#pragma unroll
                for (int i = 0; i < 4; i++) {
                    af[ks][i] = *(const bf16x8*)(cur + tile_off(wm * 64 + i * 16 + (lane & 15), ks * 4 + (lane >> 4)));
                    bfr[ks][i] = *(const bf16x8*)(cur + 32768 + tile_off(wn * 64 + i * 16 + (lane & 15), ks * 4 + (lane >> 4)));
                }
            __builtin_amdgcn_s_setprio(1);
#pragma unroll
            for (int ks = 0; ks < 2; ks++)
#pragma unroll
                for (int mi = 0; mi < 4; mi++)
#pragma unroll
                    for (int ni = 0; ni < 4; ni++)
                        acc[mi][ni] = __builtin_amdgcn_mfma_f32_16x16x32_bf16(bfr[ks][ni], af[ks][mi], acc[mi][ni], 0, 0, 0);
            __builtin_amdgcn_s_setprio(0);
            asm volatile("s_waitcnt vmcnt(0)" ::: "memory");
            __syncthreads();
        }
        epi(xb + L, acc);
    }
}


__device__ __forceinline__ void phase1(const Params& p, char* lds) {
    const int tid = threadIdx.x, lane = tid & 63, wid = tid >> 6, wm = wid >> 1, wn = wid & 1, lq = lane >> 4, lr = lane & 15;
    constexpr int N_U = 64 * 2, N_M = 4 * 16;
    {
      gemm_256x128_stream(N_U, 0, 0, (int)(gridDim.x >> 3), lds, [&](int item, GemmTile& g) {
            const int tm = item >> 1, tn = 8 + (item & 1);
            g.A = wsp<bf16_t>(p, OFF_XB) + (long)tm * 256 * ND; g.lda = ND;
            g.Bt = wsp<bf16_t>(p, OFF_W1T) + (long)tn * 128 * ND; g.ldb = ND; g.K = ND;
        }, [&](int item, f32x4 (&acc)[4][4]) {
            const int tm = item >> 1, tn = 8 + (item & 1);
            const float* r0 = wsp<float>(p, OFF_R0);
#pragma unroll
            for (int mi = 0; mi < 4; mi++) {
                const int row = tm * 256 + wm * 64 + mi * 16 + lr;
                const float rs = r0[row];
#pragma unroll
                for (int ni = 0; ni < 4; ni++) acc[mi][ni] *= rs;
                if (tn < 4) {
#pragma unroll
                    for (int ni = 0; ni < 4; ni++)
                        *(u32x2*)(wsp<bf16_t>(p, OFF_UF) + (long)row * 512 + tn * 128 + wn * 64 + ni * 16 + 4 * lq) = pack4bf(acc[mi][ni]);
                } else if (tn < 9) {
                    float ss = 0.f;
#pragma unroll
                    for (int ni = 0; ni < 4; ni++) { const f32x4 v = acc[mi][ni]; ss += v[0] * v[0] + v[1] * v[1] + v[2] * v[2] + v[3] * v[3]; }
                    ss += __shfl_xor(ss, 16); ss += __shfl_xor(ss, 32);
                    if (tn < 7) {
#pragma unroll
                        for (int ni = 0; ni < 4; ni++)
                            *(u32x2*)(wsp<bf16_t>(p, OFF_UQ) + (long)row * 384 + (tn - 4) * 128 + wn * 64 + ni * 16 + 4 * lq) = pack4bf(acc[mi][ni]);
                        if (lq == 0) wsp<float>(p, OFF_SSQ)[row * 6 + (tn - 4) * 2 + wn] = ss;
                    } else {
#pragma unroll
                        for (int ni = 0; ni < 4; ni++)
                            *(u32x2*)(wsp<bf16_t>(p, OFF_UKV) + (long)row * 256 + (tn - 7) * 128 + wn * 64 + ni * 16 + 4 * lq) = pack4bf(acc[mi][ni]);
                        if (lq == 0) wsp<float>(p, OFF_SSKV)[row * 4 + (tn - 7) * 2 + wn] = ss;
                    }
                } else if (wn == 0) {
                    const float2* rp = wsp<float2>(p, OFF_ROPE) + (long)row * 16 + 4 * lq;
                    f32x4 o1, o2;
#pragma unroll
                    for (int r = 0; r < 4; r++) {
                        const float2 cs = rp[r];
                        const float x1 = acc[mi][0][r], x2 = acc[mi][1][r];
                        o1[r] = x1 * cs.x - x2 * cs.y; o2[r] = x1 * cs.y + x2 * cs.x;
                    }
                    bf16_t* kr = wsp<bf16_t>(p, OFF_KR) + (long)row * 32;
                    *(u32x2*)(kr + 4 * lq) = pack4bf(o1);
                    *(u32x2*)(kr + 16 + 4 * lq) = pack4bf(o2);
                }
            }
        });
      gemm_256x128_stream(N_M, N_U / 8, 0, (int)(gridDim.x >> 3), lds, [&](int it, GemmTile& g) {
            const int tm = it / 16, tn = it % 16;
            g.A = wsp<bf16_t>(p, OFF_MEMB) + (long)tm * 256 * ND; g.lda = ND;
            g.Bt = wsp<bf16_t>(p, OFF_WMKVT) + (long)tn * 128 * ND; g.ldb = ND; g.K = ND;
        }, [&](int it, f32x4 (&acc)[4][4]) {
            const int tm = it / 16, tn = it % 16;
            const float* rm = wsp<float>(p, OFF_RMEM);
#pragma unroll
            for (int mi = 0; mi < 4; mi++) {
                const int row = tm * 256 + wm * 64 + mi * 16 + lr;
                const int b = row >> 8, m = row & 255;
                const float rs = rm[row];
#pragma unroll
                for (int ni = 0; ni < 4; ni++) {
                    const f32x4 v = acc[mi][ni] * rs;
                    const int col = tn * 128 + wn * 64 + ni * 16 + 4 * lq;
                    if (col < 1024) {
                        const int h = col >> 8, d = col & 255;
                        *(u32x2*)(wsp<bf16_t>(p, OFF_KMEM) + ((long)(b * 4 + h) * 256 + m) * 256 + d) = pack4bf(v);
                    } else {
                        const int c2 = col - 1024, h = c2 >> 8, dv = c2 & 255;
                        bf16_t* vt = wsp<bf16_t>(p, OFF_VTMEM) + ((long)(b * 4 + h) * 256 + dv) * 256 + m;
#pragma unroll
                        for (int r = 0; r < 4; r++) vt[r * 256] = (bf16_t)f2bf(v[r]);
                    }
                }
            }
        });
    }
}

template <int MI>
__device__ __forceinline__ void dft_mma(const bf16_t* Ag, int arow0, const char* ximg, int ncol0, f32x4 (&acc)[MI][4]) {
    const int lane = VTID & 63, lq = lane >> 4, lr = lane & 15;
#pragma unroll
    for (int ks = 0; ks < 4; ks++) {
        bf16x8 af[MI], bfr[4];
#pragma unroll
        for (int mi = 0; mi < MI; mi++) af[mi] = *(const bf16x8*)(Ag + (long)(arow0 + mi * 16 + lr) * 128 + ks * 32 + lq * 8);
#pragma unroll
        for (int ni = 0; ni < 4; ni++) {
            const char* bp = ximg + (ks * 32 + lq * 8) * 272 + (ncol0 + ni * 16 + lr) * 2;
#pragma unroll
            for (int j = 0; j < 8; j++) bfr[ni][j] = *(const short*)(bp + j * 272);
        }
#pragma unroll
        for (int mi = 0; mi < MI; mi++)
#pragma unroll
            for (int ni = 0; ni < 4; ni++) acc[mi][ni] = __builtin_amdgcn_mfma_f32_16x16x32_bf16(bfr[ni], af[mi], acc[mi][ni], 0, 0, 0);
    }
}

__device__ __forceinline__ void f2a_item(const Params& p, int it, char* lds) {
    const int tid = VTID, lane = tid & 63, wid = tid >> 6, wm = wid >> 1, wn = wid & 1, lq = lane >> 4, lr = lane & 15;
    const int nc = it & 3, s2 = (it >> 2) & 63, b = it >> 8;
    char* uimg = lds; char* ximg = lds + 17408;
    __syncthreads();
#pragma unroll
    for (int i = 0; i < 4; i++) {
        const int ci = tid + 256 * i, row = ci >> 4, cc = ci & 15;
        *(u32x4*)(uimg + row * 272 + cc * 16) = *(const u32x4*)(wsp<bf16_t>(p, OFF_UF) + ((long)(b * NS + 64 * row + s2)) * 512 + nc * 128 + cc * 8);
    }
    __syncthreads();
    {
        const int g2 = wid >> 1, T = wid & 1;
        f32x4 a1[4][4];
#pragma unroll
        for (int mi = 0; mi < 4; mi++)
#pragma unroll
            for (int ni = 0; ni < 4; ni++) a1[mi][ni] = (f32x4){0.f, 0.f, 0.f, 0.f};
        const bf16_t* t64 = wsp<bf16_t>(p, OFF_T64) + T * 4096;
#pragma unroll
        for (int ks = 0; ks < 2; ks++) {
            bf16x8 af[4], bfr[4];
#pragma unroll
            for (int i = 0; i < 4; i++) {
                af[i] = *(const bf16x8*)(uimg + (i * 16 + lr) * 272 + (g2 * 64 + ks * 32 + lq * 8) * 2);
                bfr[i] = *(const bf16x8*)(t64 + (i * 16 + lr) * 64 + ks * 32 + lq * 8);
            }
#pragma unroll
            for (int mi = 0; mi < 4; mi++)
#pragma unroll
                for (int ni = 0; ni < 4; ni++) a1[mi][ni] = __builtin_amdgcn_mfma_f32_16x16x32_bf16(bfr[ni], af[mi], a1[mi][ni], 0, 0, 0);
        }
#pragma unroll
        for (int mi = 0; mi < 4; mi++)
#pragma unroll
            for (int ni = 0; ni < 4; ni++)
                *(u32x2*)(ximg + (T * 64 + mi * 16 + lr) * 272 + (g2 * 64 + ni * 16 + 4 * lq) * 2) = pack4bf(a1[mi][ni]);
    }
    __syncthreads();
    f32x4 acc[4][4];
#pragma unroll
    for (int mi = 0; mi < 4; mi++)
#pragma unroll
        for (int ni = 0; ni < 4; ni++) acc[mi][ni] = (f32x4){0.f, 0.f, 0.f, 0.f};
    dft_mma<4>(wsp<bf16_t>(p, OFF_M1), wm * 64, ximg, wn * 64, acc);
    const float2* tw = wsp<float2>(p, OFF_TW);
#pragma unroll
    for (int m2 = 0; m2 < 2; m2++) {
        const int k1 = 32 * wm + 16 * m2 + lr;
        float2 cs; { const float rev = (float)((s2 * k1) & 4095) * (1.0f / 4096.0f); cs.x = __builtin_amdgcn_cosf(rev); cs.y = __builtin_amdgcn_sinf(rev); (void)tw; }
        const long base = ((long)(b * 64 + k1) * 64 + s2) * 512 + nc * 128 + wn * 64 + 4 * lq;
#pragma unroll
        for (int ni = 0; ni < 4; ni++) {
            const f32x4 yr = acc[m2][ni], yi = acc[m2 + 2][ni];
            const f32x4 orr = yr * cs.x - yi * cs.y, oi = yi * cs.x + yr * cs.y;
            *(u32x2*)(wsp<bf16_t>(p, OFF_YR) + base + ni * 16) = pack4bf(orr);
            *(u32x2*)(wsp<bf16_t>(p, OFF_YI) + base + ni * 16) = pack4bf(oi);
        }
    }
}

__device__ __forceinline__ void f2b_item(const Params& p, int it, char* lds) {
    const int tid = VTID, lane = tid & 63, wid = tid >> 6, wm = wid >> 1, wn = wid & 1, lq = lane >> 4, lr = lane & 15;
    const int nc = it & 3, k1 = (it >> 2) & 63, b = it >> 8;
    char* ximg = lds; char* zimg = lds + 34816;
    __syncthreads();
#pragma unroll
    for (int i = 0; i < 8; i++) {
        const int ci = tid + 256 * i, row = ci >> 4, cc = ci & 15;
        const bf16_t* src = (row < 64 ? wsp<bf16_t>(p, OFF_YR) : wsp<bf16_t>(p, OFF_YI)) + ((long)(b * 64 + k1) * 64 + (row & 63)) * 512 + nc * 128 + cc * 8;
        *(u32x4*)(ximg + row * 272 + cc * 16) = *(const u32x4*)src;
    }
    __syncthreads();
    f32x4 acc[2][4];
#pragma unroll
    for (int mi = 0; mi < 2; mi++)
#pragma unroll
        for (int ni = 0; ni < 4; ni++) acc[mi][ni] = (f32x4){0.f, 0.f, 0.f, 0.f};
    dft_mma<2>(wsp<bf16_t>(p, OFF_M3), wm * 32, ximg, wn * 64, acc);
#pragma unroll
    for (int mi = 0; mi < 2; mi++)
#pragma unroll
        for (int ni = 0; ni < 4; ni++)
            *(u32x2*)(zimg + (wm * 32 + mi * 16 + lr) * 272 + (wn * 64 + ni * 16 + 4 * lq) * 2) = pack4bf(acc[mi][ni] * (1.0f / 512.0f));
    __syncthreads();
    f32x4 a3[2][4];
#pragma unroll
    for (int mi = 0; mi < 2; mi++)
#pragma unroll
        for (int ni = 0; ni < 4; ni++) a3[mi][ni] = (f32x4){0.f, 0.f, 0.f, 0.f};
    const bf16_t* wft = wsp<bf16_t>(p, OFF_WFT) + (long)(nc * 2 + wn) * 4096;
#pragma unroll
    for (int ks = 0; ks < 2; ks++) {
        bf16x8 af[2], bfr[4];
#pragma unroll
        for (int i = 0; i < 2; i++) af[i] = *(const bf16x8*)(zimg + (wm * 32 + i * 16 + lr) * 272 + (wn * 64 + ks * 32 + lq * 8) * 2);
#pragma unroll
        for (int i = 0; i < 4; i++) bfr[i] = *(const bf16x8*)(wft + (i * 16 + lr) * 64 + ks * 32 + lq * 8);
#pragma unroll
        for (int mi = 0; mi < 2; mi++)
#pragma unroll
            for (int ni = 0; ni < 4; ni++) a3[mi][ni] = __builtin_amdgcn_mfma_f32_16x16x32_bf16(bfr[ni], af[mi], a3[mi][ni], 0, 0, 0);
    }
#pragma unroll
    for (int mi = 0; mi < 2; mi++) {
        const int k2 = wm * 32 + mi * 16 + lr;
        bf16_t* dst = wsp<bf16_t>(p, OFF_ZA) + ((long)(b * NS + k1 + 64 * k2)) * 1024 + nc * 128 + wn * 64 + 4 * lq;
#pragma unroll
        for (int ni = 0; ni < 4; ni++) *(u32x2*)(dst + ni * 16) = pack4bf(a3[mi][ni]);
    }
}

__device__ __forceinline__ void phase2(const Params& p, char* lds) {
    const int tid = threadIdx.x, lane = tid & 63, wid = tid >> 6, wm = wid >> 1, wn = wid & 1, lq = lane >> 4, lr = lane & 15;
    constexpr int N_Q = 64 * 6, N_KV = 64 * 8;
    const int lsa = (int)(gridDim.x >> 3), lsh = lsa >> 1;
    {
      gemm_256x128_stream(N_Q, 0, lsh, lsa - lsh, lds, [&](int item, GemmTile& g) {
            const int tm = item / 6, tn = item % 6;
            g.A = wsp<bf16_t>(p, OFF_UQ) + (long)tm * 256 * 384; g.lda = 384;
            g.Bt = wsp<bf16_t>(p, OFF_WQT) + (long)tn * 128 * 384; g.ldb = 384; g.K = 384;
        }, [&](int item, f32x4 (&acc)[4][4]) {
            const int tm = item / 6, tn = item % 6;
            const float qmul = 0.10206207261596575f * 1.4426950408889634f;
#pragma unroll
            for (int mi = 0; mi < 4; mi++) {
                const int row = tm * 256 + wm * 64 + mi * 16 + lr;
                const int b = row >> 12, s = row & 4095;
                const float* sq = wsp<float>(p, OFF_SSQ) + (long)row * 6;
                const float ss = sq[0] + sq[1] + sq[2] + sq[3] + sq[4] + sq[5];
                const float rs = rsqrtf(ss * (1.f / 384.f) + 1e-6f) * qmul;
                const int cb0 = tn * 128 + wn * 64;
#pragma unroll
                for (int ni = 0; ni < 4; ni++) {
                    const int cb = cb0 + ni * 16, hd = cb / 96, hob = cb % 96;
                    bf16_t* qd = wsp<bf16_t>(p, OFF_Q) + ((long)(b * 8 + hd) * NS + s) * 96;
                    if (hob < 64) {
                        *(u32x2*)(qd + hob + 4 * lq) = pack4bf(acc[mi][ni] * rs);
                    } else if (hob == 64) {
                        if (ni < 3) {
                            const float2* rp = wsp<float2>(p, OFF_ROPE) + (long)row * 16 + 4 * lq;
                            f32x4 o1, o2;
#pragma unroll
                            for (int r = 0; r < 4; r++) {
                                const float2 cs = rp[r];
                                const float x1 = acc[mi][ni][r] * rs, x2 = acc[mi][ni < 3 ? ni + 1 : 3][r] * rs;
                                o1[r] = x1 * cs.x - x2 * cs.y; o2[r] = x1 * cs.y + x2 * cs.x;
                            }
                            *(u32x2*)(qd + 64 + 4 * lq) = pack4bf(o1);
                            *(u32x2*)(qd + 80 + 4 * lq) = pack4bf(o2);
                        }
                    }
                }
            }
        });
      gemm_256x128_stream(N_KV, 0, 0, lsh ? lsh : lsa, lds, [&](int it, GemmTile& g) {
            const int tm = it >> 3, hd = it & 7;
            g.A = wsp<bf16_t>(p, OFF_UKV) + (long)tm * 256 * 256; g.lda = 256;
            g.Bt = wsp<bf16_t>(p, OFF_WKVT) + (long)hd * 128 * 256; g.ldb = 256; g.K = 256;
        }, [&](int it, f32x4 (&acc)[4][4]) {
            const int tm = it >> 3, hd = it & 7;
#pragma unroll
            for (int mi = 0; mi < 4; mi++) {
                const int row = tm * 256 + wm * 64 + mi * 16 + lr;
                const int b = row >> 12, s = row & 4095;
                const float* sq = wsp<float>(p, OFF_SSKV) + (long)row * 4;
                const float rs = rsqrtf((sq[0] + sq[1] + sq[2] + sq[3]) * (1.f / 256.f) + 1e-6f);
                if (wn == 0) {
                    bf16_t* kd = wsp<bf16_t>(p, OFF_K) + ((long)(b * 8 + hd) * NS + s) * 96;
#pragma unroll
                    for (int ni = 0; ni < 4; ni++) *(u32x2*)(kd + ni * 16 + 4 * lq) = pack4bf(acc[mi][ni] * rs);
                } else {
#pragma unroll
                    for (int ni = 0; ni < 4; ni++) {
                        bf16_t* vd = wsp<bf16_t>(p, OFF_VT) + ((long)(b * 8 + hd) * 64 + ni * 16 + 4 * lq) * NS + s;
#pragma unroll
                        for (int r = 0; r < 4; r++) vd[(long)r * NS] = (bf16_t)f2bf(acc[mi][ni][r] * rs);
                    }
                }
            }
#pragma unroll
            for (int i = 0; i < 2; i++) {
                const int ci = tid + 512 * i, r = ci >> 2, cc = ci & 3;
                const int row = tm * 256 + r, b = row >> 12, s = row & 4095;
                *(u32x4*)(wsp<bf16_t>(p, OFF_K) + ((long)(b * 8 + hd) * NS + s) * 96 + 64 + cc * 8) = *(const u32x4*)(wsp<bf16_t>(p, OFF_KR) + (long)row * 32 + cc * 8);
            }
        });
    }
}


template <int MI>
__device__ __forceinline__ void dft_mma_pre(const bf16x8 (&af)[4][MI], const char* ximg, int ncol0, f32x4 (&acc)[MI][4]) {
    const int lane = VTID & 63, lq = lane >> 4, lr = lane & 15;
#pragma unroll
    for (int ks = 0; ks < 4; ks++) {
        bf16x8 bfr[4];
#pragma unroll
        for (int ni = 0; ni < 4; ni++) {
            const char* bp = ximg + (ks * 32 + lq * 8) * 272 + (ncol0 + ni * 16 + lr) * 2;
#pragma unroll
            for (int j = 0; j < 8; j++) bfr[ni][j] = *(const short*)(bp + j * 272);
        }
#pragma unroll
        for (int mi = 0; mi < MI; mi++)
#pragma unroll
            for (int ni = 0; ni < 4; ni++) acc[mi][ni] = __builtin_amdgcn_mfma_f32_16x16x32_bf16(bfr[ni], af[ks][mi], acc[mi][ni], 0, 0, 0);
    }
}
__device__ __forceinline__ void phase2_f2a(const Params& p, char* lds) {
    const int tid = VTID, lane = tid & 63, wid = tid >> 6, wm = wid >> 1, wn = wid & 1, lq = lane >> 4, lr = lane & 15;
    char* uimg = lds; char* ximg = lds + 17408;
    const int g2 = wid >> 1, T = wid & 1;
    bf16x8 t64f[2][4], m1f[4][4];
    {
        const bf16_t* t64 = wsp<bf16_t>(p, OFF_T64) + T * 4096;
#pragma unroll
        for (int ks = 0; ks < 2; ks++)
#pragma unroll
            for (int i = 0; i < 4; i++) t64f[ks][i] = *(const bf16x8*)(t64 + (i * 16 + lr) * 64 + ks * 32 + lq * 8);
        const bf16_t* m1 = wsp<bf16_t>(p, OFF_M1);
#pragma unroll
        for (int ks = 0; ks < 4; ks++)
#pragma unroll
            for (int mi = 0; mi < 4; mi++) m1f[ks][mi] = *(const bf16x8*)(m1 + (long)(wm * 64 + mi * 16 + lr) * 128 + ks * 32 + lq * 8);
    }
    const int LN = 1024 / 8, LS = (int)(gridDim.x >> 2), xb = (int)(blockIdx.x & 7) * LN;
    int L = (int)((blockIdx.x >> 3) << 1) | VHALF;
    u32x4 ureg[4];
    auto fetch = [&](int it) {
        const int nc = it & 3, s2 = (it >> 2) & 63, b = it >> 8;
#pragma unroll
        for (int i = 0; i < 4; i++) {
            const int ci = tid + 256 * i, row = ci >> 4, cc = ci & 15;
            ureg[i] = *(const u32x4*)(wsp<bf16_t>(p, OFF_UF) + ((long)(b * NS + 64 * row + s2)) * 512 + nc * 128 + cc * 8);
        }
    };
    if (L < LN) fetch(xb + L);
    for (; L < LN; L += LS) {
        const int it = xb + L;
        const int nc = it & 3, s2 = (it >> 2) & 63, b = it >> 8;
        __syncthreads();
#pragma unroll
        for (int i = 0; i < 4; i++) {
            const int ci = tid + 256 * i, row = ci >> 4, cc = ci & 15;
            *(u32x4*)(uimg + row * 272 + cc * 16) = ureg[i];
        }
        __syncthreads();
        if (L + LS < LN) fetch(xb + L + LS);
        {
            f32x4 a1[4][4];
#pragma unroll
            for (int mi = 0; mi < 4; mi++)
#pragma unroll
                for (int ni = 0; ni < 4; ni++) a1[mi][ni] = (f32x4){0.f, 0.f, 0.f, 0.f};
#pragma unroll
            for (int ks = 0; ks < 2; ks++) {
                bf16x8 af[4];
#pragma unroll
                for (int i = 0; i < 4; i++) af[i] = *(const bf16x8*)(uimg + (i * 16 + lr) * 272 + (g2 * 64 + ks * 32 + lq * 8) * 2);
#pragma unroll
                for (int mi = 0; mi < 4; mi++)
#pragma unroll
                    for (int ni = 0; ni < 4; ni++) a1[mi][ni] = __builtin_amdgcn_mfma_f32_16x16x32_bf16(t64f[ks][ni], af[mi], a1[mi][ni], 0, 0, 0);
            }
#pragma unroll
            for (int mi = 0; mi < 4; mi++)
#pragma unroll
                for (int ni = 0; ni < 4; ni++)
                    *(u32x2*)(ximg + (T * 64 + mi * 16 + lr) * 272 + (g2 * 64 + ni * 16 + 4 * lq) * 2) = pack4bf(a1[mi][ni]);
        }
        __syncthreads();
        f32x4 acc[4][4];
#pragma unroll
        for (int mi = 0; mi < 4; mi++)
#pragma unroll
            for (int ni = 0; ni < 4; ni++) acc[mi][ni] = (f32x4){0.f, 0.f, 0.f, 0.f};
        dft_mma_pre<4>(m1f, ximg, wn * 64, acc);
#pragma unroll
        for (int m2 = 0; m2 < 2; m2++) {
            const int k1 = 32 * wm + 16 * m2 + lr;
            float2 cs; { const float rev = (float)((s2 * k1) & 4095) * (1.0f / 4096.0f); cs.x = __builtin_amdgcn_cosf(rev); cs.y = __builtin_amdgcn_sinf(rev); }
            const long base = ((long)(b * 64 + k1) * 64 + s2) * 512 + nc * 128 + wn * 64 + 4 * lq;
#pragma unroll
            for (int ni = 0; ni < 4; ni++) {
                const f32x4 yr = acc[m2][ni], yi = acc[m2 + 2][ni];
                const f32x4 orr = yr * cs.x - yi * cs.y, oi = yi * cs.x + yr * cs.y;
                *(u32x2*)(wsp<bf16_t>(p, OFF_YR) + base + ni * 16) = pack4bf(orr);
                *(u32x2*)(wsp<bf16_t>(p, OFF_YI) + base + ni * 16) = pack4bf(oi);
            }
        }
    }
}

__device__ __forceinline__ void expert_tr_job(const Params& p, int j, char* lds) {
    const int which = j >> 11, r = j & 2047, e = r >> 7, t = r & 127;
    const int k0 = (t >> 3) * 64, n0 = (t & 7) * 128;
    if (which == 0) tr_tile(p.w_exp_gate + (long)e * 1048576, 1024, k0, n0, 1024, p.g_ffn, wsp<bf16_t>(p, OFF_WGUT) + (long)e * 2048 * 1024, 1024, 1, lds);
    else if (which == 1) tr_tile(p.w_exp_up + (long)e * 1048576, 1024, k0, n0, 1024, p.g_ffn, wsp<bf16_t>(p, OFF_WGUT) + (long)e * 2048 * 1024, 1024, 2, lds);
    else tr_tile(p.w_exp_down + (long)e * 1048576, 1024, k0, n0, 1024, nullptr, wsp<bf16_t>(p, OFF_WDT) + (long)e * 1048576, 1024, 0, lds);
}

__device__ __forceinline__ void phase3_tr(const Params& p, char* lds) {
    float (*t)[132] = (float (*)[132])lds;
    const int tid = VTID, c4 = tid & 31, r0 = tid >> 5;
    f32x4 v[8]; float gv[8];
    auto issue = [&](int j) {
        const int which = j >> 11, r = j & 2047, e = r >> 7, tt = r & 127;
        const int k0 = (tt >> 3) * 64, n0 = (tt & 7) * 128;
        const float* W = (which == 0 ? p.w_exp_gate : which == 1 ? p.w_exp_up : p.w_exp_down) + (long)e * 1048576;
#pragma unroll
        for (int i = 0; i < 8; i++) {
            const int kk = r0 + 8 * i;
            v[i] = *(const f32x4*)(W + (long)(k0 + kk) * 1024 + n0 + c4 * 4);
            gv[i] = which < 2 ? p.g_ffn[k0 + kk] : 1.f;
        }
    };
    int j = VBLK;
    if (j < 6144) issue(j);
    while (j < 6144) {
        const int which = j >> 11, r = j & 2047, e = r >> 7, tt = r & 127;
        const int k0 = (tt >> 3) * 64, n0 = (tt & 7) * 128;
        __syncthreads();
#pragma unroll
        for (int i = 0; i < 8; i++) *(f32x4*)(&t[r0 + 8 * i][c4 * 4]) = v[i] * gv[i];
        __syncthreads();
        const int jn = j + VGRID;
        if (jn < 6144) issue(jn);
        bf16_t* Wt = which < 2 ? wsp<bf16_t>(p, OFF_WGUT) + (long)e * 2048 * 1024 : wsp<bf16_t>(p, OFF_WDT) + (long)e * 1048576;
#pragma unroll
        for (int i = 0; i < 4; i++) {
            const int ci = tid + 256 * i, nn = ci >> 3, kc = ci & 7;
            const int n = n0 + nn;
            int row = n;
            if (which < 2) row = (n >> 5) * 64 + ((n >> 4) & 1) * 32 + which * 16 + (n & 15);
            u32x4 w;
            w.x = pack2bf(t[kc * 8 + 0][nn], t[kc * 8 + 1][nn]);
            w.y = pack2bf(t[kc * 8 + 2][nn], t[kc * 8 + 3][nn]);
            w.z = pack2bf(t[kc * 8 + 4][nn], t[kc * 8 + 5][nn]);
            w.w = pack2bf(t[kc * 8 + 6][nn], t[kc * 8 + 7][nn]);
            *(u32x4*)(Wt + (long)row * 1024 + k0 + kc * 8) = w;
        }
        j = jn;
    }
}
__device__ __forceinline__ void phase3_f2b(const Params& p, char* lds) {
    const int tid = VTID, lane = tid & 63, wid = tid >> 6, wm = wid >> 1, wn = wid & 1, lq = lane >> 4, lr = lane & 15;
    char* ximg = lds; char* zimg = lds + 34816;
    bf16x8 m3f[4][2];
    {
        const bf16_t* m3 = wsp<bf16_t>(p, OFF_M3);
#pragma unroll
        for (int ks = 0; ks < 4; ks++)
#pragma unroll
            for (int mi = 0; mi < 2; mi++) m3f[ks][mi] = *(const bf16x8*)(m3 + (long)(wm * 32 + mi * 16 + lr) * 128 + ks * 32 + lq * 8);
    }
    const int LN = 1024 / 8, LS = (int)(gridDim.x >> 2), xb = (int)(blockIdx.x & 7) * LN;
    int L = (int)((blockIdx.x >> 3) << 1) | VHALF;
    u32x4 xreg[8];
    auto fetch = [&](int it) {
        const int nc = it & 3, k1 = (it >> 2) & 63, b = it >> 8;
#pragma unroll
        for (int i = 0; i < 8; i++) {
            const int ci = tid + 256 * i, row = ci >> 4, cc = ci & 15;
            const bf16_t* src = (row < 64 ? wsp<bf16_t>(p, OFF_YR) : wsp<bf16_t>(p, OFF_YI)) + ((long)(b * 64 + k1) * 64 + (row & 63)) * 512 + nc * 128 + cc * 8;
            xreg[i] = *(const u32x4*)src;
        }
    };
    if (L < LN) fetch(xb + L);
    for (; L < LN; L += LS) {
        const int it = xb + L;
        const int nc = it & 3, k1 = (it >> 2) & 63, b = it >> 8;
        bf16x8 wff[2][4];
        {
            const bf16_t* wft = wsp<bf16_t>(p, OFF_WFT) + (long)(nc * 2 + wn) * 4096;
#pragma unroll
            for (int ks = 0; ks < 2; ks++)
#pragma unroll
                for (int i = 0; i < 4; i++) wff[ks][i] = *(const bf16x8*)(wft + (i * 16 + lr) * 64 + ks * 32 + lq * 8);
        }
        __syncthreads();
#pragma unroll
        for (int i = 0; i < 8; i++) {
            const int ci = tid + 256 * i, row = ci >> 4, cc = ci & 15;
            *(u32x4*)(ximg + row * 272 + cc * 16) = xreg[i];
        }
        __syncthreads();
        if (L + LS < LN) fetch(xb + L + LS);
        f32x4 acc[2][4];
#pragma unroll
        for (int mi = 0; mi < 2; mi++)
#pragma unroll
            for (int ni = 0; ni < 4; ni++) acc[mi][ni] = (f32x4){0.f, 0.f, 0.f, 0.f};
        dft_mma_pre<2>(m3f, ximg, wn * 64, acc);
#pragma unroll
        for (int mi = 0; mi < 2; mi++)
#pragma unroll
            for (int ni = 0; ni < 4; ni++)
                *(u32x2*)(zimg + (wm * 32 + mi * 16 + lr) * 272 + (wn * 64 + ni * 16 + 4 * lq) * 2) = pack4bf(acc[mi][ni] * (1.0f / 512.0f));
        __syncthreads();
        f32x4 a3[2][4];
#pragma unroll
        for (int mi = 0; mi < 2; mi++)
#pragma unroll
            for (int ni = 0; ni < 4; ni++) a3[mi][ni] = (f32x4){0.f, 0.f, 0.f, 0.f};
#pragma unroll
        for (int ks = 0; ks < 2; ks++) {
            bf16x8 af[2];
#pragma unroll
            for (int i = 0; i < 2; i++) af[i] = *(const bf16x8*)(zimg + (wm * 32 + i * 16 + lr) * 272 + (wn * 64 + ks * 32 + lq * 8) * 2);
#pragma unroll
            for (int mi = 0; mi < 2; mi++)
#pragma unroll
                for (int ni = 0; ni < 4; ni++) a3[mi][ni] = __builtin_amdgcn_mfma_f32_16x16x32_bf16(wff[ks][ni], af[mi], a3[mi][ni], 0, 0, 0);
        }
#pragma unroll
        for (int mi = 0; mi < 2; mi++) {
            const int k2 = wm * 32 + mi * 16 + lr;
            bf16_t* dst = wsp<bf16_t>(p, OFF_ZA) + ((long)(b * NS + k1 + 64 * k2)) * 1024 + nc * 128 + wn * 64 + 4 * lq;
#pragma unroll
            for (int ni = 0; ni < 4; ni++) *(u32x2*)(dst + ni * 16) = pack4bf(a3[mi][ni]);
        }
    }
}

__device__ __forceinline__ void phase_resid(const Params& p, char* lds, size_t offA, size_t offW, const float* residf, const bf16_t* residb, size_t offXb, size_t offSS) {
    const int tid = VTID, lane = tid & 63, wid = tid >> 6, wm = wid >> 1, wn = wid & 1, lq = lane >> 4, lr = lane & 15;
    FOR_XCD_ITEMS(item, 128 * 8) {
        const int tm = item >> 3, tn = item & 7;
        f32x4 acc[4][4];
        GemmTile g; g.A = wsp<bf16_t>(p, offA) + (long)tm * 128 * ND; g.lda = ND; g.arow = nullptr;
        g.Bt = wsp<bf16_t>(p, offW) + (long)tn * 128 * ND; g.ldb = ND; g.K = ND;
        gemm_tile_128(g, lds, acc);
#pragma unroll
        for (int mi = 0; mi < 4; mi++) {
            const int row = tm * 128 + wm * 64 + mi * 16 + lr;
            float ss = 0.f;
#pragma unroll
            for (int ni = 0; ni < 4; ni++) {
                const long o = (long)row * ND + tn * 128 + wn * 64 + ni * 16 + 4 * lq;
                f32x4 rv;
                if (residf) rv = *(const f32x4*)(residf + o);
                else { const u32x2 w = *(const u32x2*)(residb + o); rv = (f32x4){__uint_as_float(w.x << 16), __uint_as_float(w.x & 0xFFFF0000u), __uint_as_float(w.y << 16), __uint_as_float(w.y & 0xFFFF0000u)}; }
                const f32x4 v = rv + acc[mi][ni];
                *(u32x2*)(wsp<bf16_t>(p, offXb) + o) = pack4bf(v);
                ss += v[0] * v[0] + v[1] * v[1] + v[2] * v[2] + v[3] * v[3];
            }
            ss += __shfl_xor(ss, 16); ss += __shfl_xor(ss, 32);
            if (lq == 0) wsp<float>(p, offSS)[row * 16 + tn * 2 + wn] = ss;
        }
    }
}
__device__ __forceinline__ float row_rs16(const float* ss) {
    const f32x4 a = *(const f32x4*)ss, b = *(const f32x4*)(ss + 4), c = *(const f32x4*)(ss + 8), d = *(const f32x4*)(ss + 12);
    const f32x4 t = (a + b) + (c + d);
    return rsqrtf(((t[0] + t[1]) + (t[2] + t[3])) * (1.f / 1024.f) + 1e-6f);
}

__device__ __forceinline__ void phase5a(const Params& p, char* lds) {
    const int tid = VTID, lane = tid & 63, wid = tid >> 6, wm = wid >> 1, wn = wid & 1, lq = lane >> 4, lr = lane & 15;
    FOR_XCD_ITEMS(item, 128 * 8) {
        const int tm = item >> 3, tn = item & 7;
        f32x4 acc[4][4];
        GemmTile g; g.A = wsp<bf16_t>(p, OFF_X1B) + (long)tm * 128 * ND; g.lda = ND; g.arow = nullptr;
        g.Bt = wsp<bf16_t>(p, OFF_WMQT) + (long)tn * 128 * ND; g.ldb = ND; g.K = ND;
        gemm_tile_128(g, lds, acc);
        const int h = tn >> 1;
#pragma unroll
        for (int mi = 0; mi < 4; mi++) {
            const int row = tm * 128 + wm * 64 + mi * 16 + lr, b = row >> 12, s = row & 4095;
            const float rs = row_rs16(wsp<float>(p, OFF_SS1) + (long)row * 16) * (0.0625f * 1.4426950408889634f);
            bf16_t* qd = wsp<bf16_t>(p, OFF_QM) + ((long)(b * 4 + h) * NS + s) * 256 + (tn & 1) * 128 + wn * 64 + 4 * lq;
#pragma unroll
            for (int ni = 0; ni < 4; ni++) *(u32x2*)(qd + ni * 16) = pack4bf(acc[mi][ni] * rs);
        }
    }
}
__device__ __forceinline__ void phase5b(const Params& p, char* lds) {
    FOR_XCD_ITEMS(item, NB * 4 * 32 * 2) {
        const int dvh = item & 1, qt = (item >> 1) & 31, h = (item >> 6) & 3, b = item >> 8;
        const bf16_t* Qp = wsp<bf16_t>(p, OFF_QM) + ((long)(b * 4 + h) * NS + qt * 128) * 256;
        const bf16_t* Kp = wsp<bf16_t>(p, OFF_KMEM) + ((long)(b * 4 + h) * 256) * 256;
        const bf16_t* Vtp = wsp<bf16_t>(p, OFF_VTMEM) + ((long)(b * 4 + h) * 256 + dvh * 128) * 256;
        bf16_t* Op = wsp<bf16_t>(p, OFF_OM) + ((long)b * NS + qt * 128) * 1024 + h * 256 + dvh * 128;
        attn_block<256, 128, 32, 256>(Qp, Kp, Vtp, 256L, 256, lds, [&](int q, int dv, f32x4 v) { *(u32x2*)(Op + (long)q * 1024 + dv) = pack4bf(v); });
    }
}

__device__ __forceinline__ void phase7(const Params& p, char* lds) {
    const int tid = threadIdx.x, lane = tid & 63, wid = tid >> 6, lq = lane >> 4, lr = lane & 15;
    __syncthreads();
    {
        f32x4 w0[4], w1[4];
#pragma unroll
        for (int it = 0; it < 4; it++) {
            const int u = tid + 512 * it, kp = u >> 2, eq = u & 3;
            w0[it] = *(const f32x4*)(p.w_router + (size_t)(2 * kp) * 16 + eq * 4);
            w1[it] = *(const f32x4*)(p.w_router + (size_t)(2 * kp + 1) * 16 + eq * 4);
        }
#pragma unroll
        for (int it = 0; it < 4; it++) {
            const int u = tid + 512 * it, kp = u >> 2, eq = u & 3, k = 2 * kp;
            const float g0 = p.g_ffn[k], g1 = p.g_ffn[k + 1];
#pragma unroll
            for (int j = 0; j < 4; j++) {
                const int e = eq * 4 + j;
                const float a0 = w0[it][j] * g0, a1 = w1[it][j] * g1;
                const unsigned h0 = f2bf(a0), h1 = f2bf(a1);
                const float r0 = a0 - __uint_as_float(h0 << 16), r1 = a1 - __uint_as_float(h1 << 16);
                const unsigned l0 = f2bf(r0), l1 = f2bf(r1);
                const int off = e * 2048 + ((((k >> 3) ^ e) & 127) << 4) + (k & 7) * 2;
                *(unsigned*)(lds + off) = h0 | (h1 << 16);
                *(unsigned*)(lds + 32768 + off) = l0 | (l1 << 16);
            }
        }
    }
    __syncthreads();
    for (int g = wid * (int)gridDim.x + (int)blockIdx.x; g < NT / 16; g += 8 * (int)gridDim.x) {
        const int t0 = g * 16;
        const bf16_t* xr = wsp<bf16_t>(p, OFF_X2B) + (long)(t0 + lr) * ND + lq * 8;
        bf16x8 xa[32];
#pragma unroll
        for (int ks = 0; ks < 32; ks++) xa[ks] = *(const bf16x8*)(xr + ks * 32);
        const float rsv = row_rs16(wsp<float>(p, OFF_SS2) + (long)(t0 + lr) * 16);
        if (lane < 16) wsp<float>(p, OFF_RS2)[t0 + lane] = rsv;
        f32x4 acc = (f32x4){0.f, 0.f, 0.f, 0.f};
#pragma unroll
        for (int ks = 0; ks < 32; ks++) {
            const int off = lr * 2048 + ((((ks * 4 + lq) ^ lr) & 127) << 4);
            const bf16x8 bh = *(const bf16x8*)(lds + off), bl = *(const bf16x8*)(lds + 32768 + off);
            acc = __builtin_amdgcn_mfma_f32_16x16x32_bf16(xa[ks], bh, acc, 0, 0, 0);
            acc = __builtin_amdgcn_mfma_f32_16x16x32_bf16(xa[ks], bl, acc, 0, 0, 0);
            if ((ks & 3) == 3) asm volatile("" ::: "memory");
        }
        f32x4 af4;
#pragma unroll
        for (int r = 0; r < 4; r++) {
            const float lg = acc[r] * __shfl(rsv, lq * 4 + r);
            float mx = lg;
#pragma unroll
            for (int o = 1; o < 16; o <<= 1) mx = fmaxf(mx, __shfl_xor(mx, o));
            const float ex = expf(lg - mx);
            float sm = ex;
#pragma unroll
            for (int o = 1; o < 16; o <<= 1) sm += __shfl_xor(sm, o);
            af4[r] = ex / sm;
        }
        {
            const int tk = t0 + lq * 4, bb = tk >> 12, ss = tk & 4095;
            *(f32x4*)(wsp<float>(p, OFF_AFF) + ((long)(bb * NE + lr) * NS + ss)) = af4;
        }
    }
}

__device__ __forceinline__ int block_sum_i(int v, int* red) {
    const int lane = VTID & 63, wid = VTID >> 6;
#pragma unroll
    for (int o = 32; o > 0; o >>= 1) v += __shfl_xor(v, o);
    __syncthreads();
    if (lane == 0) red[wid] = v;
    __syncthreads();
    return red[0] + red[1] + red[2] + red[3];
}
__device__ __forceinline__ int block_excl_scan_i(int v, int* red, int& total) {
    const int lane = VTID & 63, wid = VTID >> 6;
    int inc = v;
#pragma unroll
    for (int o = 1; o < 64; o <<= 1) { const int t = __shfl_up(inc, o); if (lane >= o) inc += t; }
    __syncthreads();
    if (lane == 63) red[wid] = inc;
    __syncthreads();
    int base = 0;
#pragma unroll
    for (int w = 0; w < 4; w++) if (w < wid) base += red[w];
    total = red[0] + red[1] + red[2] + red[3];
    return base + inc - v;
}
__device__ __forceinline__ void phase8(const Params& p, char* lds) {
    int* red = (int*)lds;
    const int tid = threadIdx.x, lane = tid & 63, wid = tid >> 6;
    for (int item = blockIdx.x; item < NB * NE; item += gridDim.x) {
        const int e = item & 15, b = item >> 4;
        const unsigned* aff = (const unsigned*)(wsp<float>(p, OFF_AFF) + (long)(b * NE + e) * NS) + tid * 8;
        unsigned v[8];
        { const u32x4 v0 = *(const u32x4*)aff, v1 = *(const u32x4*)(aff + 4);
          v[0] = v0.x; v[1] = v0.y; v[2] = v0.z; v[3] = v0.w; v[4] = v1.x; v[5] = v1.y; v[6] = v1.z; v[7] = v1.w; }
        const float* rs2p = wsp<float>(p, OFF_RS2) + (long)b * NS + tid * 8;
        const f32x4 rsa = *(const f32x4*)rs2p, rsb = *(const f32x4*)(rs2p + 4);
        __syncthreads();
        unsigned T = 0;
        for (int bit = 30; bit >= 0; bit--) {
            const unsigned cand = T | (1u << bit);
            int c = 0;
#pragma unroll
            for (int i = 0; i < 8; i++) c += __popcll(__ballot(v[i] >= cand));
            int* rb = red + (bit & 1) * 8;
            if (lane == 0) rb[wid] = c;
            __syncthreads();
            const i32x4 s0 = *(const i32x4*)rb, s1 = *(const i32x4*)(rb + 4);
            const int tot = (s0.x + s0.y) + (s0.z + s0.w) + (s1.x + s1.y) + (s1.z + s1.w);
            if (tot >= CAP) T = cand;
        }
        int cg = 0, ce = 0;
#pragma unroll
        for (int i = 0; i < 8; i++) { cg += (v[i] > T) ? 1 : 0; ce += (v[i] == T) ? 1 : 0; }
        const int pv = cg | (ce << 16);
        int inc = pv;
#pragma unroll
        for (int o = 1; o < 64; o <<= 1) { const int t = __shfl_up(inc, o); if (lane >= o) inc += t; }
        if (lane == 63) red[16 + wid] = inc;
        __syncthreads();
        int base = 0, tot = 0;
#pragma unroll
        for (int w = 0; w < 8; w++) { const int x = red[16 + w]; if (w < wid) base += x; tot += x; }
        const int pk = base + inc - pv;
        const int need = CAP - (tot & 0xFFFF);
        const int pg = pk & 0xFFFF;
        int eqs = pk >> 16;
        int slot = pg + (eqs < need ? eqs : need);
        int* slots = wsp<int>(p, OFF_SLOTS) + (long)(b * NE + e) * NS + tid * 8;
        int* idx = wsp<int>(p, OFF_IDX) + (long)(b * NE + e) * CAP;
        float* gate = wsp<float>(p, OFF_GATE) + (long)(b * NE + e) * CAP;
        float* rss = wsp<float>(p, OFF_RSS) + (long)(b * NE + e) * CAP;
        int so[8];
#pragma unroll
        for (int i = 0; i < 8; i++) {
            const int t = tid * 8 + i;
            bool sel = v[i] > T;
            if (v[i] == T) { sel = eqs < need; eqs++; }
            so[i] = -1;
            if (sel) { so[i] = slot; idx[slot] = b * NS + t; gate[slot] = __uint_as_float(v[i]); rss[slot] = i < 4 ? rsa[i & 3] : rsb[i & 3]; slot++; }
        }
        *(i32x4*)slots = (i32x4){so[0], so[1], so[2], so[3]};
        *(i32x4*)(slots + 4) = (i32x4){so[4], so[5], so[6], so[7]};
    }
}

__device__ __forceinline__ void phase9(const Params& p, char* lds) {
    const int tid = VTID, lane = tid & 63, wid = tid >> 6, wm = wid >> 1, wn = wid & 1, lq = lane >> 4, lr = lane & 15;
    FOR_XCD_ITEMS(item, NE * 16 * NB * 4) {
        const int rt = item & 3, b = (item >> 2) & 3, ct = (item >> 4) & 15, e = item >> 8;
        const int* arow = wsp<int>(p, OFF_IDX) + (long)(b * NE + e) * CAP + rt * 128;
        f32x4 acc[4][4];
        GemmTile g; g.A = wsp<bf16_t>(p, OFF_X2B); g.lda = ND; g.arow = arow;
        g.Bt = wsp<bf16_t>(p, OFF_WGUT) + ((long)e * 2048 + ct * 128) * ND; g.ldb = ND; g.K = ND;
        gemm_tile_128(g, lds, acc);
#pragma unroll
        for (int mi = 0; mi < 4; mi++) {
            const int r = wm * 64 + mi * 16 + lr;
            const int tok = arow[r];
            const float rs = row_rs16(wsp<float>(p, OFF_SS2) + (long)tok * 16);
            bf16_t* ad = wsp<bf16_t>(p, OFF_ACT) + ((long)(e * NB + b) * CAP + rt * 128 + r) * ND + ct * 64 + wn * 32 + 4 * lq;
#pragma unroll
            for (int pp = 0; pp < 2; pp++) {
                f32x4 o;
#pragma unroll
                for (int q = 0; q < 4; q++) {
                    const float ga = acc[mi][2 * pp][q] * rs, up = acc[mi][2 * pp + 1][q] * rs;
                    o[q] = ga * __builtin_amdgcn_rcpf(1.f + __expf(-ga)) * up;
                }
                *(u32x2*)(ad + pp * 16) = pack4bf(o);
            }
        }
    }
}
__device__ __forceinline__ void phase10(const Params& p, char* lds) {
    const int tid = VTID, lane = tid & 63, wid = tid >> 6, wm = wid >> 1, wn = wid & 1, lq = lane >> 4, lr = lane & 15;
    FOR_XCD_ITEMS(item, NE * 8 * NB * 4) {
        const int rt = item & 3, b = (item >> 2) & 3, ct = (item >> 4) & 7, e = item >> 7;
        const long row0 = (long)(e * NB + b) * CAP + rt * 128;
        f32x4 acc[4][4];
        GemmTile g; g.A = wsp<bf16_t>(p, OFF_ACT) + row0 * ND; g.lda = ND; g.arow = nullptr;
        g.Bt = wsp<bf16_t>(p, OFF_WDT) + ((long)e * 1024 + ct * 128) * ND; g.ldb = ND; g.K = ND;
        gemm_tile_128(g, lds, acc);
        const float* gate = wsp<float>(p, OFF_GATE) + (long)(b * NE + e) * CAP + rt * 128;
#pragma unroll
        for (int mi = 0; mi < 4; mi++) {
            const int r = wm * 64 + mi * 16 + lr;
            const float gv = gate[r];
            bf16_t* yd = wsp<bf16_t>(p, OFF_Y) + (row0 + r) * ND + ct * 128 + wn * 64 + 4 * lq;
#pragma unroll
            for (int ni = 0; ni < 4; ni++) *(u32x2*)(yd + ni * 16) = pack4bf(acc[mi][ni] * gv);
        }
    }
}

__device__ __forceinline__ void phase11(const Params& p, char* lds) {
    const int tid = VTID, lane = tid & 63, wid = tid >> 6;
    const int* slots = wsp<int>(p, OFF_SLOTS);
    auto slot_of = [&](int tok) { const int b = tok >> 12, t = tok & 4095; return slots[(long)(b * NE + (lane & 15)) * NS + t]; };
    int tok = VBLK * 4 + wid;
    int sl_next = tok < NT ? slot_of(tok) : -1;
    u32x2 xn[4];
#pragma unroll
    for (int i = 0; i < 4; i++) xn[i] = *(const u32x2*)(wsp<bf16_t>(p, OFF_X2B) + (long)(tok < NT ? tok : 0) * ND + i * 256 + lane * 4);
    for (; tok < NT; tok += VGRID * 4) {
        const int b = tok >> 12;
        float* xr = p.out + (long)tok * ND;
        const int slv = sl_next;
        f32x4 v[4];
#pragma unroll
        for (int i = 0; i < 4; i++)
            v[i] = (f32x4){__uint_as_float(xn[i].x << 16), __uint_as_float(xn[i].x & 0xFFFF0000u), __uint_as_float(xn[i].y << 16), __uint_as_float(xn[i].y & 0xFFFF0000u)};
        {
            const int tn = tok + VGRID * 4;
            sl_next = tn < NT ? slot_of(tn) : -1;
#pragma unroll
            for (int i = 0; i < 4; i++) xn[i] = *(const u32x2*)(wsp<bf16_t>(p, OFF_X2B) + (long)(tn < NT ? tn : tok) * ND + i * 256 + lane * 4);
        }
        unsigned long long sel = __ballot(slv >= 0) & 0xFFFFull;
        while (sel) {
            const int e = __builtin_ctzll(sel); sel &= sel - 1;
            const int sl = __builtin_amdgcn_readlane(slv, e);
            const bf16_t* yr = wsp<bf16_t>(p, OFF_Y) + ((long)(e * NB + b) * CAP + sl) * ND;
#pragma unroll
            for (int i = 0; i < 4; i++) {
                const u32x2 w = *(const u32x2*)(yr + i * 256 + lane * 4);
                v[i][0] += __uint_as_float(w.x << 16); v[i][1] += __uint_as_float(w.x & 0xFFFF0000u);
                v[i][2] += __uint_as_float(w.y << 16); v[i][3] += __uint_as_float(w.y & 0xFFFF0000u);
            }
        }
        float ss = 0.f;
#pragma unroll
        for (int i = 0; i < 4; i++) ss += v[i][0] * v[i][0] + v[i][1] * v[i][1] + v[i][2] * v[i][2] + v[i][3] * v[i][3];
        ss = wave_sum(ss);
        const float rs = rsqrtf(ss * (1.f / ND) + 1e-6f);
#pragma unroll
        for (int i = 0; i < 4; i++) {
            const f32x4 gf = *(const f32x4*)(p.g_final + i * 256 + lane * 4);
            *(f32x4*)(xr + i * 256 + lane * 4) = v[i] * rs * gf;
        }
    }
}


__device__ __forceinline__ void phase_resid8(const Params& p, char* lds, size_t offA, size_t offW, const float* residf, const bf16_t* residb, size_t offXb, size_t offSS) {
    const int tid = threadIdx.x, lane = tid & 63, wid = tid >> 6, wm = wid >> 2, wn = wid & 3, lq = lane >> 4, lr = lane & 15;
    FOR_XCD_ITEMS_R(item, 64 * 4) {
        const int tm = item >> 2, tn = item & 3;
        f32x4 acc[8][4];
        GemmTile g; g.A = wsp<bf16_t>(p, offA) + (long)tm * 256 * ND; g.lda = ND; g.arow = nullptr;
        g.Bt = wsp<bf16_t>(p, offW) + (long)tn * 256 * ND; g.ldb = ND; g.K = ND;
        gemm_tile_256sq(g, lds, acc);
#pragma unroll
        for (int mi = 0; mi < 8; mi++) {
            const int row = tm * 256 + wm * 128 + mi * 16 + lr;
            float ss = 0.f;
#pragma unroll
            for (int ni = 0; ni < 4; ni++) {
                const long o = (long)row * ND + tn * 256 + wn * 64 + ni * 16 + 4 * lq;
                f32x4 rv;
                if (residf) rv = *(const f32x4*)(residf + o);
                else { const u32x2 w = *(const u32x2*)(residb + o); rv = (f32x4){__uint_as_float(w.x << 16), __uint_as_float(w.x & 0xFFFF0000u), __uint_as_float(w.y << 16), __uint_as_float(w.y & 0xFFFF0000u)}; }
                const f32x4 v = rv + acc[mi][ni];
                *(u32x2*)(wsp<bf16_t>(p, offXb) + o) = pack4bf(v);
                ss += v[0] * v[0] + v[1] * v[1] + v[2] * v[2] + v[3] * v[3];
            }
            ss += __shfl_xor(ss, 16); ss += __shfl_xor(ss, 32);
            if (lq == 0) wsp<float>(p, offSS)[row * 16 + tn * 4 + wn] = ss;
        }
    }
}


template <class Epi>
__device__ __forceinline__ void gemm_256sq_multi(const bf16_t* A, int lda, const int* arow, const bf16_t* Bt, int ldb, long bstep,
                                                 int K, int ntile, char* lds, Epi epi) {
    const int tid = threadIdx.x, lane = tid & 63, wid = tid >> 6, wm = wid >> 2, wn = wid & 3;
    const int lrow = lane >> 3, pc = lane & 7;
    const char* Ab = (const char*)A; const char* Bb = (const char*)Bt;
    unsigned ao[4], bo[4];
#pragma unroll
    for (int i = 0; i < 4; i++) {
        const int r = (wid * 4 + i) * 8 + lrow;
        const int c = pc ^ ((r >> 1) & 7);
        ao[i] = (unsigned)((arow ? arow[r] : r) * lda + c * 8) * 2u;
        bo[i] = (unsigned)(r * ldb + c * 8) * 2u;
    }
    const int nk = K >> 6;
    auto stage = [&](int kt, long boff, char* st) {
        const char* a0 = Ab + kt * 128;
        const char* b0 = Bb + boff * 2 + kt * 128;
#pragma unroll
        for (int i = 0; i < 4; i++) {
            __builtin_amdgcn_global_load_lds((const unsigned*)(a0 + ao[i]), (unsigned*)(st + (wid * 4 + i) * 1024), 16, 0, 0);
            __builtin_amdgcn_global_load_lds((const unsigned*)(b0 + bo[i]), (unsigned*)(st + 32768 + (wid * 4 + i) * 1024), 16, 0, 0);
        }
    };
    f32x4 acc[8][4];
    __syncthreads();
    stage(0, 0, lds);
    asm volatile("s_waitcnt vmcnt(0)" ::: "memory");
    __syncthreads();
    int q = 0;
    for (int t = 0; t < ntile; t++) {
#pragma unroll
        for (int mi = 0; mi < 8; mi++)
#pragma unroll
            for (int ni = 0; ni < 4; ni++) acc[mi][ni] = (f32x4){0.f, 0.f, 0.f, 0.f};
        const long boff = (long)t * bstep;
        for (int kt = 0; kt < nk; kt++, q++) {
            char* cur = lds + (q & 1) * 65536;
            char* nxt = lds + ((q + 1) & 1) * 65536;
            if (kt + 1 < nk) stage(kt + 1, boff, nxt);
            else if (t + 1 < ntile) stage(0, boff + bstep, nxt);
#pragma unroll
            for (int ks = 0; ks < 2; ks++) {
                bf16x8 af[8], bfr[4];
#pragma unroll
                for (int i = 0; i < 8; i++) af[i] = *(const bf16x8*)(cur + tile_off(wm * 128 + i * 16 + (lane & 15), ks * 4 + (lane >> 4)));
#pragma unroll
                for (int i = 0; i < 4; i++) bfr[i] = *(const bf16x8*)(cur + 32768 + tile_off(wn * 64 + i * 16 + (lane & 15), ks * 4 + (lane >> 4)));
                __builtin_amdgcn_s_setprio(1);
#pragma unroll
                for (int mi = 0; mi < 8; mi++)
#pragma unroll
                    for (int ni = 0; ni < 4; ni++)
                        acc[mi][ni] = __builtin_amdgcn_mfma_f32_16x16x32_bf16(bfr[ni], af[mi], acc[mi][ni], 0, 0, 0);
                __builtin_amdgcn_s_setprio(0);
            }
            asm volatile("s_waitcnt vmcnt(0)" ::: "memory");
            __syncthreads();
        }
        epi(t, acc);
    }
}
__device__ __forceinline__ void phase9_8(const Params& p, char* lds) {
    const int tid = threadIdx.x, lane = tid & 63, wid = tid >> 6, wm = wid >> 2, wn = wid & 3, lq = lane >> 4, lr = lane & 15;
    FOR_XCD_ITEMS_R(si, NE * NB * 2 * 2) {
        const int cth = si & 1, rt = (si >> 1) & 1, b = (si >> 2) & 3, e = si >> 4;
        const int* arow = wsp<int>(p, OFF_IDX) + (long)(b * NE + e) * CAP + rt * 256;
        const float* rss = wsp<float>(p, OFF_RSS) + (long)(b * NE + e) * CAP + rt * 256;
        gemm_256sq_multi(wsp<bf16_t>(p, OFF_X2B), ND, arow, wsp<bf16_t>(p, OFF_WGUT) + ((long)e * 2048 + cth * 1024) * ND, ND, 256L * ND,
                         ND, 4, lds, [&](int t, f32x4 (&acc)[8][4]) {
            const int ct = cth * 4 + t;
            char* adb = (char*)(wsp<bf16_t>(p, OFF_ACT) + ((long)(e * NB + b) * CAP + rt * 256) * ND + ct * 128);
            const unsigned ado = (unsigned)((wm * 128 + lr) * ND + wn * 32 + 4 * lq) * 2u;
#pragma unroll
            for (int mi = 0; mi < 8; mi++) {
                const float rs = rss[wm * 128 + mi * 16 + lr];
#pragma unroll
                for (int pp = 0; pp < 2; pp++) {
                    f32x4 o;
#pragma unroll
                    for (int q = 0; q < 4; q++) {
                        const float ga = acc[mi][2 * pp][q] * rs, up = acc[mi][2 * pp + 1][q] * rs;
                        o[q] = ga * __builtin_amdgcn_rcpf(1.f + __expf(-ga)) * up;
                    }
                    *(u32x2*)(adb + (ado + (unsigned)(mi * 16 * ND * 2 + pp * 32))) = pack4bf(o);
                    __builtin_amdgcn_sched_barrier(0);
                }
            }
        });
    }
}
__device__ __forceinline__ void phase10_8(const Params& p, char* lds) {
    const int tid = threadIdx.x, lane = tid & 63, wid = tid >> 6, wm = wid >> 2, wn = wid & 3, lq = lane >> 4, lr = lane & 15;
    FOR_XCD_ITEMS_R(si, NE * NB * 2 * 2) {
        const int cth = si & 1, rt = (si >> 1) & 1, b = (si >> 2) & 3, e = si >> 4;
        const long row0 = (long)(e * NB + b) * CAP + rt * 256;
        const float* gate = wsp<float>(p, OFF_GATE) + (long)(b * NE + e) * CAP + rt * 256;
        gemm_256sq_multi(wsp<bf16_t>(p, OFF_ACT) + row0 * ND, ND, nullptr, wsp<bf16_t>(p, OFF_WDT) + ((long)e * 1024 + cth * 512) * ND, ND, 256L * ND,
                         ND, 2, lds, [&](int t, f32x4 (&acc)[8][4]) {
            const int ct = cth * 2 + t;
            char* yb = (char*)(wsp<bf16_t>(p, OFF_Y) + row0 * ND + ct * 256);
            const unsigned yo = (unsigned)((wm * 128 + lr) * ND + wn * 64 + 4 * lq) * 2u;
#pragma unroll
            for (int mi = 0; mi < 8; mi++) {
                const float gv = gate[wm * 128 + mi * 16 + lr];
#pragma unroll
                for (int ni = 0; ni < 4; ni++) *(u32x2*)(yb + (yo + (unsigned)(mi * 16 * ND * 2 + ni * 32))) = pack4bf(acc[mi][ni] * gv);
            }
        });
    }
}


__device__ __forceinline__ void phase1_big(const Params& p, char* lds) {
    const int tid = threadIdx.x, lane = tid & 63, wid = tid >> 6, wm = wid >> 2, wn = wid & 3, lq = lane >> 4, lr = lane & 15;
    FOR_XCD_ITEMS_R(item, 64 * 4) {
        const int tm = item >> 2, tn = item & 3;
        f32x4 acc[8][4];
        GemmTile g; g.A = wsp<bf16_t>(p, OFF_XB) + (long)tm * 256 * ND; g.lda = ND; g.arow = nullptr;
        g.Bt = wsp<bf16_t>(p, OFF_W1T) + (long)tn * 256 * ND; g.ldb = ND; g.K = ND;
        gemm_tile_256sq(g, lds, acc);
        const float* r0 = wsp<float>(p, OFF_R0);
        const int col0 = tn * 256 + wn * 64;
#pragma unroll
        for (int mi = 0; mi < 8; mi++) {
            const int row = tm * 256 + wm * 128 + mi * 16 + lr;
            const float rs = r0[row];
#pragma unroll
            for (int ni = 0; ni < 4; ni++) acc[mi][ni] *= rs;
            if (col0 < 512) {
#pragma unroll
                for (int ni = 0; ni < 4; ni++)
                    *(u32x2*)(wsp<bf16_t>(p, OFF_UF) + (long)row * 512 + col0 + ni * 16 + 4 * lq) = pack4bf(acc[mi][ni]);
            } else {
                float ss = 0.f;
#pragma unroll
                for (int ni = 0; ni < 4; ni++) { const f32x4 v = acc[mi][ni]; ss += v[0] * v[0] + v[1] * v[1] + v[2] * v[2] + v[3] * v[3]; }
                ss += __shfl_xor(ss, 16); ss += __shfl_xor(ss, 32);
                if (col0 < 896) {
#pragma unroll
                    for (int ni = 0; ni < 4; ni++)
                        *(u32x2*)(wsp<bf16_t>(p, OFF_UQ) + (long)row * 384 + (col0 - 512) + ni * 16 + 4 * lq) = pack4bf(acc[mi][ni]);
                    if (lq == 0) wsp<float>(p, OFF_SSQ)[row * 6 + ((col0 - 512) >> 6)] = ss;
                } else {
#pragma unroll
                    for (int ni = 0; ni < 4; ni++)
                        *(u32x2*)(wsp<bf16_t>(p, OFF_UKV) + (long)row * 256 + (col0 - 896) + ni * 16 + 4 * lq) = pack4bf(acc[mi][ni]);
                    if (lq == 0) wsp<float>(p, OFF_SSKV)[row * 4 + ((col0 - 896) >> 6)] = ss;
                }
            }
        }
    }
}


__device__ __forceinline__ void phase3_attn8(const Params& p, char* lds) {
    FOR_XCD_ITEMS_R(item, NB * 8 * (NS / 256)) {
        const int qt = item & 15, h = (item >> 4) & 7, b = item >> 7;
        const bf16_t* Qp = wsp<bf16_t>(p, OFF_Q) + ((long)(b * 8 + h) * NS + qt * 256) * 96;
        const bf16_t* Kp = wsp<bf16_t>(p, OFF_K) + ((long)(b * 8 + h) * NS) * 96;
        const bf16_t* Vtp = wsp<bf16_t>(p, OFF_VT) + ((long)(b * 8 + h) * 64) * NS;
        bf16_t* Op = wsp<bf16_t>(p, OFF_ZA) + ((long)b * NS + qt * 256) * 1024 + 512 + h * 64;
        attn_block<96, 64, 128, 512>(Qp, Kp, Vtp, (long)NS, NS, lds, [&](int q, int dv, f32x4 v) { *(u32x2*)(Op + (long)q * 1024 + dv) = pack4bf(v); });
    }
}
__device__ __forceinline__ void cross_attn_item(const Params& p, char* lds, int b, int hd, int qt) {
    constexpr int KROW = 256 * 2 + 16, VROW = 32 * 2 + 8, SLOT = 256 * VROW;
    const int tid = threadIdx.x, lane = tid & 63, wid = tid >> 6, h = lane >> 5, c = lane & 31;
    {
        const bf16_t* Qp = wsp<bf16_t>(p, OFF_QM) + ((long)(b * 4 + hd) * NS + qt * 256) * 256;
        const bf16_t* Kp = wsp<bf16_t>(p, OFF_KMEM) + ((long)(b * 4 + hd) * 256) * 256;
        const bf16_t* Vtp = wsp<bf16_t>(p, OFF_VTMEM) + ((long)(b * 4 + hd) * 256) * 256;
        bf16_t* Op = wsp<bf16_t>(p, OFF_OM) + ((long)b * NS + qt * 256) * 1024 + hd * 256;
        u32x4 gr[2];
        auto gload = [&](int t) {
#pragma unroll
            for (int i = 0; i < 2; i++) {
                const int ci = tid + 512 * i;
                if (t < 8) { const int row = ci >> 5, cc = ci & 31; gr[i] = *(const u32x4*)(Kp + (long)(t * 32 + row) * 256 + cc * 8); }
                else { const int row = ci >> 2, cc = ci & 3; gr[i] = *(const u32x4*)(Vtp + (long)row * 256 + (t - 8) * 32 + cc * 8); }
            }
        };
        auto lwrite = [&](int t, char* st) {
#pragma unroll
            for (int i = 0; i < 2; i++) {
                const int ci = tid + 512 * i;
                if (t < 8) { const int row = ci >> 5, cc = ci & 31; *(u32x4*)(st + row * KROW + cc * 16) = gr[i]; }
                else { const int row = ci >> 2, cc = ci & 3; char* q = st + row * VROW + cc * 16; *(u32x2*)q = (u32x2){gr[i].x, gr[i].y}; *(u32x2*)(q + 8) = (u32x2){gr[i].z, gr[i].w}; }
            }
        };
        gload(0);
        bf16x8 qf[16];
        {
            const bf16_t* qrow = Qp + (long)(wid * 32 + c) * 256 + 8 * h;
#pragma unroll
            for (int ks = 0; ks < 16; ks++) qf[ks] = *(const bf16x8*)(qrow + 16 * ks);
        }
        __syncthreads();
        lwrite(0, lds);
        __syncthreads();
        f32x16 s[8];
#pragma unroll
        for (int t = 0; t < 8; t++) {
            const char* cur = lds + (t & 1) * SLOT;
            gload(t + 1);
#pragma unroll
            for (int r = 0; r < 16; r++) s[t][r] = 0.f;
#pragma unroll
            for (int ks = 0; ks < 16; ks++) {
                const bf16x8 kf = *(const bf16x8*)(cur + c * KROW + ks * 32 + h * 16);
                s[t] = __builtin_amdgcn_mfma_f32_32x32x16_bf16(kf, qf[ks], s[t], 0, 0, 0);
            }
            lwrite(t + 1, lds + ((t + 1) & 1) * SLOT);
            __syncthreads();
        }
        float mx = s[0][0];
#pragma unroll
        for (int t = 0; t < 8; t++)
#pragma unroll
            for (int r = 0; r < 16; r++) mx = fmaxf(mx, s[t][r]);
        mx = fmaxf(mx, __shfl_xor(mx, 32));
        float l = 0.f;
        bf16x8 pf[16];
#pragma unroll
        for (int t = 0; t < 8; t++) {
#pragma unroll
            for (int r = 0; r < 16; r++) { const float e = __builtin_amdgcn_exp2f(s[t][r] - mx); l += e; s[t][r] = e; }
#pragma unroll
            for (int u = 0; u < 2; u++) {
                u32x4 pw;
                pw.x = pack2bf(s[t][8 * u + 0], s[t][8 * u + 1]);
                pw.y = pack2bf(s[t][8 * u + 2], s[t][8 * u + 3]);
                pw.z = pack2bf(s[t][8 * u + 4], s[t][8 * u + 5]);
                pw.w = pack2bf(s[t][8 * u + 6], s[t][8 * u + 7]);
                pf[2 * t + u] = __builtin_bit_cast(bf16x8, pw);
            }
        }
        l += __shfl_xor(l, 32);
        f32x16 o[8];
#pragma unroll
        for (int dt = 0; dt < 8; dt++)
#pragma unroll
            for (int r = 0; r < 16; r++) o[dt][r] = 0.f;
#pragma unroll
        for (int v = 0; v < 8; v++) {
            const char* cur = lds + (v & 1) * SLOT;
            if (v + 1 < 8) gload(8 + v + 1);
#pragma unroll
            for (int u = 0; u < 2; u++)
#pragma unroll
                for (int dt = 0; dt < 8; dt++) {
                    const char* vp = cur + (dt * 32 + c) * VROW + (u * 16 + 4 * h) * 2;
                    const u32x2 v0 = *(const u32x2*)(vp);
                    const u32x2 v1 = *(const u32x2*)(vp + 16);
                    const bf16x8 vf = __builtin_bit_cast(bf16x8, ((u32x4){v0.x, v0.y, v1.x, v1.y}));
                    o[dt] = __builtin_amdgcn_mfma_f32_32x32x16_bf16(vf, pf[2 * v + u], o[dt], 0, 0, 0);
                }
            if (v + 1 < 8) lwrite(8 + v + 1, lds + ((v + 1) & 1) * SLOT);
            __syncthreads();
        }
        const float inv = 1.f / l;
#pragma unroll
        for (int dt = 0; dt < 8; dt++)
#pragma unroll
            for (int g4 = 0; g4 < 4; g4++) {
                const f32x4 v = {o[dt][4 * g4 + 0] * inv, o[dt][4 * g4 + 1] * inv, o[dt][4 * g4 + 2] * inv, o[dt][4 * g4 + 3] * inv};
                *(u32x2*)(Op + (long)(wid * 32 + c) * 1024 + dt * 32 + 8 * g4 + 4 * h) = pack4bf(v);
            }
    }
}
__device__ __forceinline__ void phase5_fused(const Params& p, char* lds) {
    const int tid = threadIdx.x, lane = tid & 63, wid = tid >> 6, wm = wid >> 2, wn = wid & 3, lq = lane >> 4, lr = lane & 15;
    FOR_XCD_ITEMS_R(item, 64 * 4) {
        const int tm = item >> 2, tn = item & 3;
        f32x4 acc[8][4];
        GemmTile g; g.A = wsp<bf16_t>(p, OFF_X1B) + (long)tm * 256 * ND; g.lda = ND; g.arow = nullptr;
        g.Bt = wsp<bf16_t>(p, OFF_WMQT) + (long)tn * 256 * ND; g.ldb = ND; g.K = ND;
        gemm_tile_256sq(g, lds, acc);
#pragma unroll
        for (int mi = 0; mi < 8; mi++) {
            const int row = tm * 256 + wm * 128 + mi * 16 + lr, b = row >> 12, s = row & 4095;
            const float rs = row_rs16(wsp<float>(p, OFF_SS1) + (long)row * 16) * (0.0625f * 1.4426950408889634f);
            bf16_t* qd = wsp<bf16_t>(p, OFF_QM) + ((long)(b * 4 + tn) * NS + s) * 256 + wn * 64 + 4 * lq;
#pragma unroll
            for (int ni = 0; ni < 4; ni++) *(u32x2*)(qd + ni * 16) = pack4bf(acc[mi][ni] * rs);
        }
    }
    __builtin_amdgcn_fence(__ATOMIC_RELEASE, "workgroup");
    asm volatile("s_waitcnt vmcnt(0)" ::: "memory");
    __syncthreads();
    __builtin_amdgcn_fence(__ATOMIC_ACQUIRE, "workgroup");
}
__device__ __forceinline__ void phase5_cross(const Params& p, char* lds) {
    FOR_XCD_ITEMS_R(item, 64 * 4) {
        const int tm = item >> 2, tn = item & 3;
        cross_attn_item(p, lds, tm >> 4, tn, tm & 15);
    }
}

__global__ void __launch_bounds__(512, 1) k_fwd(Params p, int ph_lo, int ph_hi) {
    extern __shared__ __attribute__((aligned(16))) char lds_all[];
    char* lds = lds_all + VHALF * LDS_HALF;
    volatile LAS unsigned* st = (volatile LAS unsigned*)(lds_all + LDS_MAIN);
    if (threadIdx.x == 0) { st[0] = 0u; st[1] = 0u; }
    __syncthreads();
    XcdBarrier bar = xcd_barrier_post(wsp<unsigned>(p, OFF_BAR), st);
#if USE_CG_SYNC
#define GRID_BARRIER() do { asm volatile("s_waitcnt vmcnt(0)" ::: "memory"); __syncthreads(); cg::this_grid().sync(); asm volatile("s_waitcnt vmcnt(0)" ::: "memory"); __syncthreads(); } while (0)
#else
#define GRID_BARRIER() xcd_barrier(bar)
#endif
#define RUN_PHASE(k, call) if (ph_lo <= (k) && (k) < ph_hi) { if ((k) > ph_lo) { GRID_BARRIER(); } call; }
    RUN_PHASE(0, phase0(p, lds))
    RUN_PHASE(1, (phase1_big(p, lds_all), phase1(p, lds_all)))
    RUN_PHASE(2, (phase2(p, lds_all), phase2_f2a(p, lds)))
    RUN_PHASE(3, ((blockIdx.x & 1) ? phase3_tr(p, lds) : (void)0, phase3_attn8(p, lds_all), phase3_f2b(p, lds), (blockIdx.x & 1) ? (void)0 : phase3_tr(p, lds)))
    RUN_PHASE(4, phase_resid8(p, lds_all, OFF_ZA, OFF_WOUTT, p.x, nullptr, OFF_X1B, OFF_SS1))
    RUN_PHASE(5, (phase5_fused(p, lds_all), phase5_cross(p, lds_all)))
    RUN_PHASE(6, phase_resid8(p, lds_all, OFF_OM, OFF_WMOT, nullptr, wsp<bf16_t>(p, OFF_X1B), OFF_X2B, OFF_SS2))
    RUN_PHASE(7, phase7(p, lds_all))
    RUN_PHASE(8, phase8(p, lds_all))
    RUN_PHASE(9, phase9_8(p, lds_all))
    RUN_PHASE(10, phase10_8(p, lds_all))
    RUN_PHASE(11, phase11(p, lds))
}

extern "C" void kernel_launch(void* const* d_in, const int* in_sizes, int n_in,
                              void* d_out, int out_size, void* d_ws, size_t ws_size,
                              hipStream_t stream) {
    static int grid = 0;
    if (grid == 0) {
        if (n_in != 22 || ws_size < WS_END) { fprintf(stderr, "kernel_launch: unexpected inputs (n_in %d, ws %zu < %zu)\n", n_in, ws_size, (size_t)WS_END); grid = -1; return; }
        int dev = 0, cus = 0, per_cu = 0;
        (void)hipGetDevice(&dev);
        (void)hipDeviceGetAttribute(&cus, hipDeviceAttributeMultiprocessorCount, dev);
        if (hipFuncSetAttribute((const void*)k_fwd, hipFuncAttributeMaxDynamicSharedMemorySize, LDS_TOTAL) != hipSuccess) { fprintf(stderr, "kernel_launch: hipFuncSetAttribute failed\n"); grid = -1; return; }
        if (hipOccupancyMaxActiveBlocksPerMultiprocessor(&per_cu, (const void*)k_fwd, 512, LDS_TOTAL) != hipSuccess || per_cu < 1) { fprintf(stderr, "kernel_launch: occupancy query failed (%d)\n", per_cu); (void)hipGetLastError(); per_cu = 1; }
        if (per_cu > 1) per_cu = 1;
        grid = (cus * per_cu) & ~7;
        if (grid < 8) { fprintf(stderr, "kernel_launch: unexpected device (%d CUs)\n", cus); grid = -1; return; }
        fprintf(stderr, "kernel_launch: %d CUs x %d blocks\n", cus, per_cu);
    }
    if (grid < 0) return;
    Params p{};
    p.x = (const float*)d_in[0]; p.mem = (const float*)d_in[1]; p.pos = (const int*)d_in[2];
    p.g_mix = (const float*)d_in[3]; p.w_in = (const float*)d_in[4]; p.g_q_lat = (const float*)d_in[5]; p.w_q_up = (const float*)d_in[6];
    p.g_kv_lat = (const float*)d_in[7]; p.w_kv_up = (const float*)d_in[8]; p.w_fourier = (const float*)d_in[9]; p.w_out = (const float*)d_in[10];
    p.g_mem_q = (const float*)d_in[11]; p.g_mem_kv = (const float*)d_in[12]; p.w_mem_q = (const float*)d_in[13]; p.w_mem_kv = (const float*)d_in[14];
    p.w_mem_o = (const float*)d_in[15]; p.g_ffn = (const float*)d_in[16]; p.w_router = (const float*)d_in[17];
    p.w_exp_gate = (const float*)d_in[18]; p.w_exp_up = (const float*)d_in[19]; p.w_exp_down = (const float*)d_in[20]; p.g_final = (const float*)d_in[21];
    p.out = (float*)d_out; p.ws = (char*)d_ws;
    static const int cuts[] = MK_CUTS;
    const int ncut = (int)(sizeof(cuts) / sizeof(int));
    for (int li = 0; li + 1 < ncut; li++) {
        (void)hipMemsetAsync((char*)d_ws + OFF_BAR, 0, 16384, stream);
        int lo = cuts[li], hi = cuts[li + 1];
        void* args[] = {&p, &lo, &hi};
        hipError_t e = hipLaunchCooperativeKernel((const void*)k_fwd, dim3(grid), dim3(512), args, LDS_TOTAL, stream);
        if (e != hipSuccess) fprintf(stderr, "cooperative launch failed: %s (grid %d)\n", hipGetErrorString(e), grid);
    }
}
```

```cpp
#include <hip/hip_runtime.h>
#include <stdint.h>
#include <cstdio>
#include <hip/hip_cooperative_groups.h>
namespace cg = cooperative_groups;
#ifndef USE_CG_SYNC
#define USE_CG_SYNC 0
#endif

#ifndef MK_CUTS
#define MK_CUTS {0, 12}
#endif

#define NB 4
#define NS 4096
#define ND 1024
#define NT (NB * NS)
#define INW 1184
#define NE 16
#define CAP 512
#define MEML 256
#define NPHASE 12
#define VTID ((int)(threadIdx.x & 255))
#define VHALF (__builtin_amdgcn_readfirstlane((int)(threadIdx.x >> 8)))
#define VBLK ((int)(blockIdx.x * 2) + VHALF)
#define VGRID ((int)(gridDim.x * 2))

typedef unsigned short bf16_t;
typedef short bf16x8 __attribute__((ext_vector_type(8)));
typedef float f32x4 __attribute__((ext_vector_type(4)));
typedef float f32x16 __attribute__((ext_vector_type(16)));
typedef unsigned u32x4 __attribute__((ext_vector_type(4)));
typedef int i32x4 __attribute__((ext_vector_type(4)));
typedef unsigned u32x2 __attribute__((ext_vector_type(2)));

__device__ __forceinline__ unsigned f2bf(float f) {
    unsigned u = __float_as_uint(f);
    u += 0x7FFFu + ((u >> 16) & 1u);
    return u >> 16;
}
typedef __bf16 hbf2 __attribute__((ext_vector_type(2)));
typedef float f32x2 __attribute__((ext_vector_type(2)));
__device__ __forceinline__ unsigned pack2bf(float lo, float hi) { f32x2 v = {lo, hi}; return __builtin_bit_cast(unsigned, __builtin_convertvector(v, hbf2)); }
__device__ __forceinline__ float bf2f(unsigned short b) { return __uint_as_float(((unsigned)b) << 16); }

__device__ __forceinline__ int tile_off(int row, int chunk) { return row * 128 + ((chunk ^ ((row >> 1) & 7)) << 4); }

#define GT_LDS_BYTES 65536

struct GemmTile { const bf16_t* A; long lda; const int* arow; const bf16_t* Bt; long ldb; int K; };

__device__ __forceinline__ void gemm_tile_128(const GemmTile& g, char* lds, f32x4 (&acc)[4][4]) {
    const int tid = VTID, lane = tid & 63, wid = tid >> 6, wm = wid >> 1, wn = wid & 1;
    const int lrow = lane >> 3, pc = lane & 7;
    const bf16_t* ap[4]; const bf16_t* bp[4];
#pragma unroll
    for (int i = 0; i < 4; i++) {
        const int r = (wid * 4 + i) * 8 + lrow;
        const int c = pc ^ ((r >> 1) & 7);
        const long ro = g.arow ? (long)g.arow[r] * g.lda : (long)r * g.lda;
        ap[i] = g.A + ro + c * 8;
        bp[i] = g.Bt + (long)r * g.ldb + c * 8;
    }
#pragma unroll
    for (int mi = 0; mi < 4; mi++)
#pragma unroll
        for (int ni = 0; ni < 4; ni++) acc[mi][ni] = (f32x4){0.f, 0.f, 0.f, 0.f};
    const int nk = g.K >> 6;
    auto stage = [&](int kt, char* st) {
#pragma unroll
        for (int i = 0; i < 4; i++) {
            __builtin_amdgcn_global_load_lds((const unsigned*)(ap[i] + kt * 64), (unsigned*)(st + (wid * 4 + i) * 1024), 16, 0, 0);
            __builtin_amdgcn_global_load_lds((const unsigned*)(bp[i] + kt * 64), (unsigned*)(st + 16384 + (wid * 4 + i) * 1024), 16, 0, 0);
        }
    };
    __syncthreads();
    stage(0, lds);
    asm volatile("s_waitcnt vmcnt(0)" ::: "memory");
    __syncthreads();
    for (int kt = 0; kt < nk; kt++) {
        char* cur = lds + (kt & 1) * 32768;
        if (kt + 1 < nk) stage(kt + 1, lds + ((kt + 1) & 1) * 32768);
        bf16x8 af[2][4], bfr[2][4];
#pragma unroll
        for (int ks = 0; ks < 2; ks++)
#pragma unroll
            for (int i = 0; i < 4; i++) {
                af[ks][i] = *(const bf16x8*)(cur + tile_off(wm * 64 + i * 16 + (lane & 15), ks * 4 + (lane >> 4)));
                bfr[ks][i] = *(const bf16x8*)(cur + 16384 + tile_off(wn * 64 + i * 16 + (lane & 15), ks * 4 + (lane >> 4)));
            }
        __builtin_amdgcn_s_setprio(1);
#pragma unroll
        for (int ks = 0; ks < 2; ks++)
#pragma unroll
            for (int mi = 0; mi < 4; mi++)
#pragma unroll
                for (int ni = 0; ni < 4; ni++)
                    acc[mi][ni] = __builtin_amdgcn_mfma_f32_16x16x32_bf16(bfr[ks][ni], af[ks][mi], acc[mi][ni], 0, 0, 0);
        __builtin_amdgcn_s_setprio(0);
        asm volatile("s_waitcnt vmcnt(0)" ::: "memory");
        __syncthreads();
    }
}

template <int DQK, int DVT, int KT, bool VPERM = false>
struct AttnCfg {
    static constexpr int KROW = DQK * 2 + 16;
    static constexpr int VROW = VPERM ? KT * 2 + 16 : KT * 2 + 8;
    static constexpr int KBYTES = KT * KROW;
    static constexpr int VBYTES = DVT * VROW;
    static constexpr int STAGE = KBYTES + VBYTES;
    static constexpr int LDS = 2 * STAGE;
};

template <int DQK, int DVT, int KT, int NTH, bool VPERM = false, class Out>
__device__ __forceinline__ void attn_block(const bf16_t* Qp, const bf16_t* Kp, const bf16_t* Vtp, long ldv, int nk, char* lds, Out&& out) {
    typedef AttnCfg<DQK, DVT, KT, VPERM> C;
    constexpr int NKS = DQK / 16, NST = KT / 32, NDT = DVT / 32, NPS = KT / 16;
    constexpr int KCPR = DQK / 8;
    constexpr int KTOT = KT * KCPR, KCH = (KTOT + NTH - 1) / NTH;
    constexpr int VCPR = KT / 8;
    constexpr int VTOT = DVT * VCPR, VCH = (VTOT + NTH - 1) / NTH;
    const int tid = NTH == 512 ? (int)threadIdx.x : VTID, lane = tid & 63, wid = tid >> 6, h = lane >> 5, c = lane & 31;

    bf16x8 qf[NKS];
    {
        const bf16_t* qrow = Qp + (long)(wid * 32 + c) * DQK + 8 * h;
#pragma unroll
        for (int ks = 0; ks < NKS; ks++) qf[ks] = *(const bf16x8*)(qrow + 16 * ks);
    }
    f32x16 o[NDT];
#pragma unroll
    for (int dt = 0; dt < NDT; dt++)
#pragma unroll
        for (int r = 0; r < 16; r++) o[dt][r] = 0.f;
    float m = 0.f, l = 0.f;

    u32x4 kr[KCH], vr[VCH];
    auto gload = [&](int t) {
#pragma unroll
        for (int i = 0; i < KCH; i++) {
            const int ci = tid + NTH * i, row = ci / KCPR, cc = ci % KCPR;
            if (KTOT % NTH == 0 || ci < KTOT) kr[i] = *(const u32x4*)(Kp + (long)(t * KT + row) * DQK + cc * 8);
        }
#pragma unroll
        for (int i = 0; i < VCH; i++) {
            const int ci = tid + NTH * i, row = ci / VCPR, cc = ci % VCPR;
            if (VTOT % NTH == 0 || ci < VTOT) vr[i] = *(const u32x4*)(Vtp + (long)row * ldv + t * KT + cc * 8);
        }
    };
    auto lwrite = [&](char* st) {
#pragma unroll
        for (int i = 0; i < KCH; i++) {
            const int ci = tid + NTH * i, row = ci / KCPR, cc = ci % KCPR;
            if (KTOT % NTH == 0 || ci < KTOT) *(u32x4*)(st + row * C::KROW + cc * 16) = kr[i];
        }
#pragma unroll
        for (int i = 0; i < VCH; i++) {
            const int ci = tid + NTH * i, row = ci / VCPR, cc = ci % VCPR;
            if (VTOT % NTH == 0 || ci < VTOT) {
                char* p = st + C::KBYTES + row * C::VROW + cc * 16;
                if (VPERM) *(u32x4*)(p) = vr[i];
                else { *(u32x2*)(p) = (u32x2){vr[i].x, vr[i].y}; *(u32x2*)(p + 8) = (u32x2){vr[i].z, vr[i].w}; }
            }
        }
    };
    const int nt = nk / KT;
    gload(0);
    __syncthreads();
    lwrite(lds);
    __syncthreads();
    for (int t = 0; t < nt; t++) {
        char* cur = lds + (t & 1) * C::STAGE;
        if (t + 1 < nt) gload(t + 1);
        f32x16 s[NST];
        const float negm = -m;
#pragma unroll
        for (int st = 0; st < NST; st++) {
#pragma unroll
            for (int r = 0; r < 16; r++) s[st][r] = negm;
#pragma unroll
            for (int ks = 0; ks < NKS; ks++) {
                const bf16x8 kf = *(const bf16x8*)(cur + (st * 32 + c) * C::KROW + ks * 32 + h * 16);
                s[st] = __builtin_amdgcn_mfma_f32_32x32x16_bf16(kf, qf[ks], s[st], 0, 0, 0);
            }
        }
        float mx = s[0][0];
#pragma unroll
        for (int st = 0; st < NST; st++)
#pragma unroll
            for (int r = 0; r < 16; r++) mx = fmaxf(mx, s[st][r]);
        mx = fmaxf(mx, __shfl_xor(mx, 32));
        if (__any(mx > 8.0f)) {
            const float d = fmaxf(mx, 0.f);
            const float alpha = __builtin_amdgcn_exp2f(-d);
            m += d;
            l *= alpha;
#pragma unroll
            for (int dt = 0; dt < NDT; dt++)
#pragma unroll
                for (int r = 0; r < 16; r++) o[dt][r] *= alpha;
#pragma unroll
            for (int st = 0; st < NST; st++)
#pragma unroll
                for (int r = 0; r < 16; r++) s[st][r] -= d;
        }
        float rs = 0.f;
#pragma unroll
        for (int st = 0; st < NST; st++)
#pragma unroll
            for (int r = 0; r < 16; r++) { const float p = __builtin_amdgcn_exp2f(s[st][r]); rs += p; s[st][r] = p; }
        l += rs;
        if (t + 1 < nt) lwrite(lds + ((t + 1) & 1) * C::STAGE);
#pragma unroll
        for (int ps = 0; ps < NPS; ps++) {
            const int st = ps >> 1, u = ps & 1;
            u32x4 pw;
            pw.x = pack2bf(s[st][8 * u + 0], s[st][8 * u + 1]);
            pw.y = pack2bf(s[st][8 * u + 2], s[st][8 * u + 3]);
            pw.z = pack2bf(s[st][8 * u + 4], s[st][8 * u + 5]);
            pw.w = pack2bf(s[st][8 * u + 6], s[st][8 * u + 7]);
            const bf16x8 pf = __builtin_bit_cast(bf16x8, pw);
#pragma unroll
            for (int dt = 0; dt < NDT; dt++) {
                bf16x8 vf;
                if (VPERM) vf = *(const bf16x8*)(cur + C::KBYTES + (dt * 32 + c) * C::VROW + ps * 32 + h * 16);
                else {
                    const char* vp = cur + C::KBYTES + (dt * 32 + c) * C::VROW + (ps * 16 + 4 * h) * 2;
                    const u32x2 v0 = *(const u32x2*)(vp);
                    const u32x2 v1 = *(const u32x2*)(vp + 16);
                    vf = __builtin_bit_cast(bf16x8, ((u32x4){v0.x, v0.y, v1.x, v1.y}));
                }
                o[dt] = __builtin_amdgcn_mfma_f32_32x32x16_bf16(vf, pf, o[dt], 0, 0, 0);
            }
        }
        __syncthreads();
    }
    l += __shfl_xor(l, 32);
    const float inv = 1.f / l;
#pragma unroll
    for (int dt = 0; dt < NDT; dt++)
#pragma unroll
        for (int g4 = 0; g4 < 4; g4++) {
            f32x4 v = {o[dt][4 * g4 + 0] * inv, o[dt][4 * g4 + 1] * inv, o[dt][4 * g4 + 2] * inv, o[dt][4 * g4 + 3] * inv};
            out(wid * 32 + c, dt * 32 + 8 * g4 + 4 * h, v);
        }
}


constexpr size_t SLOT = 33554432;
constexpr size_t OFF_W1T = 0;
constexpr size_t OFF_WQT = OFF_W1T + 1280UL * 1024 * 2;
constexpr size_t OFF_WKVT = OFF_WQT + 768UL * 384 * 2;
constexpr size_t OFF_WOUTT = OFF_WKVT + 1024UL * 256 * 2;
constexpr size_t OFF_WMQT = OFF_WOUTT + 1024UL * 1024 * 2;
constexpr size_t OFF_WMKVT = OFF_WMQT + 1024UL * 1024 * 2;
constexpr size_t OFF_WMOT = OFF_WMKVT + 2048UL * 1024 * 2;
constexpr size_t OFF_WGUT = OFF_WMOT + 1024UL * 1024 * 2;
constexpr size_t OFF_WDT = OFF_WGUT + 16UL * 2048 * 1024 * 2;
constexpr size_t OFF_T64 = OFF_WDT + 16UL * 1024 * 1024 * 2;
constexpr size_t OFF_M1 = OFF_T64 + 16384;
constexpr size_t OFF_M3 = OFF_M1 + 32768;
constexpr size_t OFF_WFT = OFF_M3 + 16384;
constexpr size_t OFF_TW = OFF_WFT + 65536;
constexpr size_t OFF_ROPE = OFF_TW + 32768;
constexpr size_t OFF_R0 = OFF_ROPE + (size_t)NT * 16 * 8;
constexpr size_t OFF_RMEM = OFF_R0 + (size_t)NT * 4;
constexpr size_t OFF_SSQ = OFF_RMEM + 4096;
constexpr size_t OFF_SSKV = OFF_SSQ + (size_t)NT * 6 * 4;
constexpr size_t OFF_SS1 = OFF_SSKV + (size_t)NT * 4 * 4;
constexpr size_t OFF_SS2 = OFF_SS1 + (size_t)NT * 16 * 4;
constexpr size_t OFF_AFF = OFF_SS2 + (size_t)NT * 16 * 4;
constexpr size_t OFF_SLOTS = OFF_AFF + (size_t)NT * 16 * 4;
constexpr size_t OFF_IDX = OFF_SLOTS + 4UL * 16 * 4096 * 4;
constexpr size_t OFF_GATE = OFF_IDX + 4UL * 16 * 512 * 4;
constexpr size_t OFF_MEMB = OFF_GATE + 4UL * 16 * 512 * 4;
constexpr size_t OFF_KMEM = OFF_MEMB + 1024UL * 1024 * 2;
constexpr size_t OFF_VTMEM = OFF_KMEM + 1024UL * 1024 * 2;
constexpr size_t OFF_KR = OFF_VTMEM + 1024UL * 1024 * 2;
constexpr size_t OFF_BAR = OFF_KR + (size_t)NT * 32 * 2;
constexpr size_t OFF_RS2 = OFF_BAR + 16384;
constexpr size_t OFF_RSS = OFF_RS2 + (size_t)NT * 4;
constexpr size_t OFF_S0 = (OFF_RSS + 4UL * 16 * 512 * 4 + 255) / 256 * 256;
constexpr size_t OFF_S1 = OFF_S0 + SLOT;
constexpr size_t OFF_S2 = OFF_S1 + SLOT;
constexpr size_t OFF_S3 = OFF_S2 + SLOT;
constexpr size_t OFF_S4 = OFF_S3 + SLOT;
constexpr size_t WS_END = OFF_S4 + SLOT;
static_assert(WS_END <= 300964352UL, "workspace map exceeds the guaranteed scratch size");
constexpr size_t OFF_XB = OFF_S0, OFF_YR = OFF_S0, OFF_YI = OFF_S0 + SLOT / 2, OFF_X1B = OFF_S3, OFF_OM = OFF_S0, OFF_ACT = OFF_S0;
constexpr size_t OFF_UF = OFF_S1, OFF_UQ = OFF_S1 + (size_t)NT * 512 * 2, OFF_ZA = OFF_S1, OFF_QM = OFF_S1;
constexpr size_t OFF_Q = OFF_S2, OFF_UKV = OFF_S2 + (size_t)NT * 768 * 2, OFF_X2B = OFF_S2;
constexpr size_t OFF_K = OFF_S3, OFF_Y = OFF_S3;
constexpr size_t OFF_VT = OFF_S4;

struct Params {
    const float *x, *mem; const int* pos;
    const float *g_mix, *w_in, *g_q_lat, *w_q_up, *g_kv_lat, *w_kv_up, *w_fourier, *w_out, *g_mem_q, *g_mem_kv, *w_mem_q, *w_mem_kv, *w_mem_o,
        *g_ffn, *w_router, *w_exp_gate, *w_exp_up, *w_exp_down, *g_final;
    float* out; char* ws;
};
template <class T> __device__ __forceinline__ T* wsp(const Params& p, size_t off) { return (T*)(p.ws + off); }

#define LDS_HALF 65536
#define LDS_MAIN 131072
#define LDS_TOTAL (LDS_MAIN + 16)
#define LAS __attribute__((address_space(3)))

#define XB_TMO      128
#define XB_XCNT(j)  (256  + 64 * (j))
#define XB_XSUB(j)  (1280 + 64 * (j))
#define XB_XGEN(j)  (2304 + 64 * (j))
#define XB_TOP      3328
#define XB_TOPGEN   3392
#define XCD_BAR_WORDS 3456
#define XB_SPIN_CAP (1u << 25)
__device__ __forceinline__ unsigned xb_ld(unsigned* p)              { return __hip_atomic_load(p, __ATOMIC_RELAXED, __HIP_MEMORY_SCOPE_AGENT); }
__device__ __forceinline__ unsigned xb_add(unsigned* p, unsigned v) { return __hip_atomic_fetch_add(p, v, __ATOMIC_RELAXED, __HIP_MEMORY_SCOPE_AGENT); }
__device__ __forceinline__ unsigned xb_xcc_id() { return (unsigned)__builtin_amdgcn_s_getreg((3 << 11) | 20) & 0xFu; }
#define XB_SPIN(cond, bar) do { unsigned _sp = 0; while (cond) { __builtin_amdgcn_s_sleep(1); \
    if ((++_sp & 255u) == 0u) { if (xb_ld(&(bar)[XB_TMO])) break; if (_sp > XB_SPIN_CAP) { atomicAdd(&(bar)[XB_TMO], 1u); break; } } } } while (0)
struct XcdBarrier { unsigned* bar; unsigned x; volatile LAS unsigned* st; };
__device__ __forceinline__ XcdBarrier xcd_barrier_post(unsigned* bar, volatile LAS unsigned* st) {
    XcdBarrier b; b.bar = bar; b.x = xb_xcc_id(); b.st = st;
    if (threadIdx.x == 0) (void)xb_add(&bar[XB_XCNT(b.x)], 1u);
    return b;
}
__device__ __forceinline__ void xcd_barrier_complete(unsigned* bar, unsigned x, unsigned& nloc, unsigned& nx) {
    const unsigned G = gridDim.x * gridDim.y * gridDim.z;
    unsigned sum, cnt, mine, sp = 0u;
    for (;;) {
        sum = 0u; cnt = 0u; mine = 0u;
#pragma unroll
        for (unsigned j = 0; j < 16; ++j) { const unsigned c = xb_ld(&bar[XB_XCNT(j)]); sum += c; cnt += (c > 0u) ? 1u : 0u; mine = (j == x) ? c : mine; }
        if (sum == G) break;
        __builtin_amdgcn_s_sleep(1);
        if ((++sp & 255u) == 0u) { if (xb_ld(&bar[XB_TMO])) break; if (sp > XB_SPIN_CAP) { atomicAdd(&bar[XB_TMO], 1u); break; } }
    }
    nloc = mine > 0u ? mine : 1u; nx = cnt > 0u ? cnt : 1u;
}
__device__ __forceinline__ void xcd_barrier(const XcdBarrier& b) {
    asm volatile("s_waitcnt vmcnt(0)" ::: "memory");
    __syncthreads();
    if (threadIdx.x == 0) {
        unsigned* bar = b.bar;
        __builtin_amdgcn_s_waitcnt(0);
        unsigned nloc = b.st[0], nx = b.st[1];
        if (nloc == 0u) { xcd_barrier_complete(bar, b.x, nloc, nx); b.st[0] = nloc; b.st[1] = nx; }
        const unsigned old = xb_add(&bar[XB_XSUB(b.x)], 1u);
        const unsigned gen = old / nloc;
        if (old + 1u == (gen + 1u) * nloc) {
            __builtin_amdgcn_fence(__ATOMIC_RELEASE, "agent");
            asm volatile("s_waitcnt vmcnt(0)" ::: "memory");
            const unsigned og = xb_add(&bar[XB_TOP], 1u);
            const unsigned tg = og / nx;
            if (og + 1u == (tg + 1u) * nx) xb_add(&bar[XB_TOPGEN], 1u);
            else XB_SPIN(xb_ld(&bar[XB_TOPGEN]) == tg, bar);
            __builtin_amdgcn_fence(__ATOMIC_ACQUIRE, "agent");
            xb_add(&bar[XB_XGEN(b.x)], 1u);
            asm volatile("s_waitcnt vmcnt(0)" ::: "memory");
        } else {
            XB_SPIN(xb_ld(&bar[XB_XGEN(b.x)]) == gen, bar);
            __builtin_amdgcn_fence(__ATOMIC_ACQUIRE, "agent");
            asm volatile("s_waitcnt vmcnt(0)" ::: "memory");
        }
    }
    __syncthreads();
}

#define FOR_XCD_ITEMS(item, N) for (int _L = (int)((blockIdx.x >> 3) << 1) | VHALF, item; _L < (N) / 8 && ((item = (int)(blockIdx.x & 7) * ((N) / 8) + _L), true); _L += (int)(gridDim.x >> 2))

__device__ __forceinline__ u32x2 pack4bf(float a, float b, float c, float d) { return (u32x2){pack2bf(a, b), pack2bf(c, d)}; }
__device__ __forceinline__ u32x2 pack4bf(f32x4 v) { return (u32x2){pack2bf(v[0], v[1]), pack2bf(v[2], v[3])}; }
__device__ __forceinline__ float wave_sum(float v) {
#pragma unroll
    for (int o = 32; o > 0; o >>= 1) v += __shfl_xor(v, o);
    return v;
}

__device__ __forceinline__ void tr_tile(const float* W, long ldw, int k0, int n0, int nvalid, const float* gain, bf16_t* Wt, long ldt, int mode, char* lds) {
    float (*t)[132] = (float (*)[132])lds;
    const int tid = VTID, c4 = tid & 31, r0 = tid >> 5;
    f32x4 v[8];
#pragma unroll
    for (int i = 0; i < 8; i++) {
        const int kk = r0 + 8 * i, n = n0 + c4 * 4;
        v[i] = (n < nvalid) ? *(const f32x4*)(W + (long)(k0 + kk) * ldw + n) : (f32x4){0.f, 0.f, 0.f, 0.f};
        if (gain) v[i] *= gain[k0 + kk];
    }
    __syncthreads();
#pragma unroll
    for (int i = 0; i < 8; i++) *(f32x4*)(&t[r0 + 8 * i][c4 * 4]) = v[i];
    __syncthreads();
#pragma unroll
    for (int i = 0; i < 4; i++) {
        const int ci = tid + 256 * i, nn = ci >> 3, kc = ci & 7;
        const int n = n0 + nn;
        int row = n;
        if (mode) row = (n >> 5) * 64 + ((n >> 4) & 1) * 32 + (mode - 1) * 16 + (n & 15);
        u32x4 w;
        w.x = pack2bf(t[kc * 8 + 0][nn], t[kc * 8 + 1][nn]);
        w.y = pack2bf(t[kc * 8 + 2][nn], t[kc * 8 + 3][nn]);
        w.z = pack2bf(t[kc * 8 + 4][nn], t[kc * 8 + 5][nn]);
        w.w = pack2bf(t[kc * 8 + 6][nn], t[kc * 8 + 7][nn]);
        *(u32x4*)(Wt + (long)row * ldt + k0 + kc * 8) = w;
    }
}

__device__ __forceinline__ void phase0(const Params& p, char* lds) {
    constexpr int J_W1 = 160, J_WQ = 36, J_WKV = 32, J_WOUT = 128, J_WMQ = 128, J_WMKV = 256, J_WMO = 128, J_WG = 0, J_WU = 0, J_WD = 0;
    constexpr int J_TR = J_W1 + J_WQ + J_WKV + J_WOUT + J_WMQ + J_WMKV + J_WMO + J_WG + J_WU + J_WD;
    constexpr int J_XR = NT / 16, J_MR = 1024 / 16, J_ROPE = NT * 16 / 256, J_TAB = (4096 + 8192 + 16384 + 8192 + 32768) / 256;
    constexpr int J_ALL = J_TR + J_XR + J_MR + J_ROPE + J_TAB;
    const int tid = VTID, lane = tid & 63, wid = tid >> 6;
    const double PI2 = 6.283185307179586476925286766559;
    for (int job = VBLK; job < J_ALL; job += VGRID) {
        int j = job;
        if (j < J_TR) {
            if (j < J_W1) { tr_tile(p.w_in, INW, (j / 10) * 64, (j % 10) * 128, INW, p.g_mix, wsp<bf16_t>(p, OFF_W1T), 1024, 0, lds); continue; } j -= J_W1;
            if (j < J_WQ) { tr_tile(p.w_q_up, 768, (j / 6) * 64, (j % 6) * 128, 768, p.g_q_lat, wsp<bf16_t>(p, OFF_WQT), 384, 0, lds); continue; } j -= J_WQ;
            if (j < J_WKV) { tr_tile(p.w_kv_up, 1024, (j / 8) * 64, (j % 8) * 128, 1024, p.g_kv_lat, wsp<bf16_t>(p, OFF_WKVT), 256, 0, lds); continue; } j -= J_WKV;
            if (j < J_WOUT) { tr_tile(p.w_out, 1024, (j / 8) * 64, (j % 8) * 128, 1024, nullptr, wsp<bf16_t>(p, OFF_WOUTT), 1024, 0, lds); continue; } j -= J_WOUT;
            if (j < J_WMQ) { tr_tile(p.w_mem_q, 1024, (j / 8) * 64, (j % 8) * 128, 1024, p.g_mem_q, wsp<bf16_t>(p, OFF_WMQT), 1024, 0, lds); continue; } j -= J_WMQ;
            if (j < J_WMKV) { tr_tile(p.w_mem_kv, 2048, (j / 16) * 64, (j % 16) * 128, 2048, p.g_mem_kv, wsp<bf16_t>(p, OFF_WMKVT), 1024, 0, lds); continue; } j -= J_WMKV;
            if (j < J_WMO) { tr_tile(p.w_mem_o, 1024, (j / 8) * 64, (j % 8) * 128, 1024, nullptr, wsp<bf16_t>(p, OFF_WMOT), 1024, 0, lds); continue; } j -= J_WMO;
            if (j < J_WG) { const int e = j >> 7, r = j & 127; tr_tile(p.w_exp_gate + (long)e * 1048576, 1024, (r / 8) * 64, (r % 8) * 128, 1024, p.g_ffn, wsp<bf16_t>(p, OFF_WGUT) + (long)e * 2048 * 1024, 1024, 1, lds); continue; } j -= J_WG;
            if (j < J_WU) { const int e = j >> 7, r = j & 127; tr_tile(p.w_exp_up + (long)e * 1048576, 1024, (r / 8) * 64, (r % 8) * 128, 1024, p.g_ffn, wsp<bf16_t>(p, OFF_WGUT) + (long)e * 2048 * 1024, 1024, 2, lds); continue; } j -= J_WU;
            { const int e = j >> 7, r = j & 127; tr_tile(p.w_exp_down + (long)e * 1048576, 1024, (r / 8) * 64, (r % 8) * 128, 1024, nullptr, wsp<bf16_t>(p, OFF_WDT) + (long)e * 1048576, 1024, 0, lds); continue; }
        }
        j -= J_TR;
        if (j < J_XR + J_MR) {
            const bool isx = j < J_XR;
            const int row0 = (isx ? j : j - J_XR) * 16 + wid * 4;
            const float* src = (isx ? p.x : p.mem) + (long)row0 * ND;
            bf16_t* dst = (isx ? wsp<bf16_t>(p, OFF_XB) : wsp<bf16_t>(p, OFF_MEMB)) + (long)row0 * ND;
            f32x4 v[4][4];
#pragma unroll
            for (int r = 0; r < 4; r++)
#pragma unroll
                for (int i = 0; i < 4; i++) v[r][i] = *(const f32x4*)(src + (long)r * ND + i * 256 + lane * 4);
#pragma unroll
            for (int r = 0; r < 4; r++) {
                float ss = 0.f;
#pragma unroll
                for (int i = 0; i < 4; i++) {
                    ss += v[r][i][0] * v[r][i][0] + v[r][i][1] * v[r][i][1] + v[r][i][2] * v[r][i][2] + v[r][i][3] * v[r][i][3];
                    *(u32x2*)(dst + (long)r * ND + i * 256 + lane * 4) = pack4bf(v[r][i]);
                }
                ss = wave_sum(ss);
                if (lane == 0) (isx ? wsp<float>(p, OFF_R0) : wsp<float>(p, OFF_RMEM))[row0 + r] = rsqrtf(ss * (1.f / ND) + 1e-6f);
            }
            continue;
        }
        j -= J_XR + J_MR;
        if (j < J_ROPE) {
            const int i = j * 256 + tid; const int t = i >> 4, jj = i & 15;
            constexpr double FR[16] = {
                0.15915494309189535, 0.08949940160889101, 0.050329212104487035, 0.0283021958306234,
                0.015915494309189534, 0.008949940160889102, 0.005032921210448704, 0.00283021958306234,
                0.0015915494309189536, 0.0008949940160889102, 0.0005032921210448703, 0.00028302195830623395,
                0.00015915494309189535, 8.949940160889102e-05, 5.0329212104487035e-05, 2.8302195830623396e-05};
            const double revd = (double)p.pos[t] * FR[jj];
            const float rev = (float)(revd - floor(revd));
            wsp<float2>(p, OFF_ROPE)[i] = make_float2(__builtin_amdgcn_cosf(rev), __builtin_amdgcn_sinf(rev));
            continue;
        }
        j -= J_ROPE;
        {
            int i = j * 256 + tid;
            if (i < 4096) { const double a = PI2 * (double)i / 4096.0; wsp<float2>(p, OFF_TW)[i] = make_float2((float)cos(a), (float)sin(a)); continue; } i -= 4096;
            if (i < 8192) {
                const int T = i >> 12, a = (i >> 6) & 63, b = i & 63;
                const double th = PI2 * (double)((a * b) & 63) / 64.0;
                wsp<bf16_t>(p, OFF_T64)[i] = (bf16_t)f2bf((float)(T ? sin(th) : cos(th))); continue;
            } i -= 8192;
            if (i < 16384) {
                const int rho = i >> 7, k = i & 127;
                const int wm = rho >> 6, mi = (rho >> 4) & 3, lr = rho & 15, ri = mi >> 1, k1 = 32 * wm + 16 * (mi & 1) + lr, ab = k >> 6, s1 = k & 63;
                const double th = PI2 * (double)((k1 * s1) & 63) / 64.0;
                const double c = cos(th), s = sin(th);
                const double v = ri == 0 ? (ab == 0 ? c : -s) : (ab == 0 ? s : c);
                wsp<bf16_t>(p, OFF_M1)[i] = (bf16_t)f2bf((float)v); continue;
            } i -= 16384;
            if (i < 8192) {
                const int k2 = i >> 7, k = i & 127, s2 = k & 63;
                const double th = PI2 * (double)((k2 * s2) & 63) / 64.0;
                wsp<bf16_t>(p, OFF_M3)[i] = (bf16_t)f2bf((float)(k < 64 ? cos(th) : -sin(th))); continue;
            } i -= 8192;
            if (i < 32768) {
                const int g = i >> 12, e = (i >> 6) & 63, ch = i & 63;
                wsp<bf16_t>(p, OFF_WFT)[i] = (bf16_t)f2bf(p.w_fourier[(g * 64 + ch) * 64 + e]); continue;
            }
        }
    }
}

#define FOR_XCD_ITEMS_R(item, N) for (int _L = (int)(blockIdx.x >> 3), item; _L < (N) / 8 && ((item = (int)(blockIdx.x & 7) * ((N) / 8) + _L), true); _L += (int)(gridDim.x >> 3))
__device__ __forceinline__ void gemm_tile_256sq(const GemmTile& g, char* lds, f32x4 (&acc)[8][4]) {
    const int tid = threadIdx.x, lane = tid & 63, wid = tid >> 6, wm = wid >> 2, wn = wid & 3;
    const int lrow = lane >> 3, pc = lane & 7;
    const bf16_t* ap[4]; const bf16_t* bp[4];
#pragma unroll
    for (int i = 0; i < 4; i++) {
        const int r = (wid * 4 + i) * 8 + lrow;
        const int c = pc ^ ((r >> 1) & 7);
        const long ro = g.arow ? (long)g.arow[r] * g.lda : (long)r * g.lda;
        ap[i] = g.A + ro + c * 8;
        bp[i] = g.Bt + (long)r * g.ldb + c * 8;
    }
#pragma unroll
    for (int mi = 0; mi < 8; mi++)
#pragma unroll
        for (int ni = 0; ni < 4; ni++) acc[mi][ni] = (f32x4){0.f, 0.f, 0.f, 0.f};
    const int nk = g.K >> 6;
    auto stage = [&](int kt, char* st) {
#pragma unroll
        for (int i = 0; i < 4; i++) {
            __builtin_amdgcn_global_load_lds((const unsigned*)(ap[i] + kt * 64), (unsigned*)(st + (wid * 4 + i) * 1024), 16, 0, 0);
            __builtin_amdgcn_global_load_lds((const unsigned*)(bp[i] + kt * 64), (unsigned*)(st + 32768 + (wid * 4 + i) * 1024), 16, 0, 0);
        }
    };
    __syncthreads();
    stage(0, lds);
    asm volatile("s_waitcnt vmcnt(0)" ::: "memory");
    __syncthreads();
    for (int kt = 0; kt < nk; kt++) {
        char* cur = lds + (kt & 1) * 65536;
        if (kt + 1 < nk) stage(kt + 1, lds + ((kt + 1) & 1) * 65536);
#pragma unroll
        for (int ks = 0; ks < 2; ks++) {
            bf16x8 af[8], bfr[4];
#pragma unroll
            for (int i = 0; i < 8; i++) af[i] = *(const bf16x8*)(cur + tile_off(wm * 128 + i * 16 + (lane & 15), ks * 4 + (lane >> 4)));
#pragma unroll
            for (int i = 0; i < 4; i++) bfr[i] = *(const bf16x8*)(cur + 32768 + tile_off(wn * 64 + i * 16 + (lane & 15), ks * 4 + (lane >> 4)));
            __builtin_amdgcn_s_setprio(1);
#pragma unroll
            for (int mi = 0; mi < 8; mi++)
#pragma unroll
                for (int ni = 0; ni < 4; ni++)
                    acc[mi][ni] = __builtin_amdgcn_mfma_f32_16x16x32_bf16(bfr[ni], af[mi], acc[mi][ni], 0, 0, 0);
            __builtin_amdgcn_s_setprio(0);
        }
        asm volatile("s_waitcnt vmcnt(0)" ::: "memory");
        __syncthreads();
    }
}


__device__ __forceinline__ void gemm_tile_256x128(const GemmTile& g, char* lds, f32x4 (&acc)[4][4]) {
    const int tid = threadIdx.x, lane = tid & 63, wid = tid >> 6, wm = wid >> 1, wn = wid & 1;
    const int lrow = lane >> 3, pc = lane & 7;
    const bf16_t* ap[4]; const bf16_t* bp[2];
#pragma unroll
    for (int i = 0; i < 4; i++) {
        const int r = (wid * 4 + i) * 8 + lrow;
        const int c = pc ^ ((r >> 1) & 7);
        const long ro = g.arow ? (long)g.arow[r] * g.lda : (long)r * g.lda;
        ap[i] = g.A + ro + c * 8;
    }
#pragma unroll
    for (int i = 0; i < 2; i++) {
        const int r = (wid * 2 + i) * 8 + lrow;
        const int c = pc ^ ((r >> 1) & 7);
        bp[i] = g.Bt + (long)r * g.ldb + c * 8;
    }
#pragma unroll
    for (int mi = 0; mi < 4; mi++)
#pragma unroll
        for (int ni = 0; ni < 4; ni++) acc[mi][ni] = (f32x4){0.f, 0.f, 0.f, 0.f};
    const int nk = g.K >> 6;
    auto stage = [&](int kt, char* st) {
#pragma unroll
        for (int i = 0; i < 4; i++)
            __builtin_amdgcn_global_load_lds((const unsigned*)(ap[i] + kt * 64), (unsigned*)(st + (wid * 4 + i) * 1024), 16, 0, 0);
#pragma unroll
        for (int i = 0; i < 2; i++)
            __builtin_amdgcn_global_load_lds((const unsigned*)(bp[i] + kt * 64), (unsigned*)(st + 32768 + (wid * 2 + i) * 1024), 16, 0, 0);
    };
    __syncthreads();
    stage(0, lds);
    asm volatile("s_waitcnt vmcnt(0)" ::: "memory");
    __syncthreads();
    for (int kt = 0; kt < nk; kt++) {
        char* cur = lds + (kt & 1) * 49152;
        if (kt + 1 < nk) stage(kt + 1, lds + ((kt + 1) & 1) * 49152);
        bf16x8 af[2][4], bfr[2][4];
#pragma unroll
        for (int ks = 0; ks < 2; ks++)
#pragma unroll
            for (int i = 0; i < 4; i++) {
                af[ks][i] = *(const bf16x8*)(cur + tile_off(wm * 64 + i * 16 + (lane & 15), ks * 4 + (lane >> 4)));
                bfr[ks][i] = *(const bf16x8*)(cur + 32768 + tile_off(wn * 64 + i * 16 + (lane & 15), ks * 4 + (lane >> 4)));
            }
        __builtin_amdgcn_s_setprio(1);
#pragma unroll
        for (int ks = 0; ks < 2; ks++)
#pragma unroll
            for (int mi = 0; mi < 4; mi++)
#pragma unroll
                for (int ni = 0; ni < 4; ni++)
                    acc[mi][ni] = __builtin_amdgcn_mfma_f32_16x16x32_bf16(bfr[ks][ni], af[ks][mi], acc[mi][ni], 0, 0, 0);
        __builtin_amdgcn_s_setprio(0);
        asm volatile("s_waitcnt vmcnt(0)" ::: "memory");
        __syncthreads();
    }
}

template <class Setup, class Epi>
__device__ __forceinline__ void gemm_256x128_stream(int nitems, int lshift, int l0, int ls, char* lds, Setup setup, Epi epi) {
    const int tid = threadIdx.x, lane = tid & 63, wid = tid >> 6, wm = wid >> 1, wn = wid & 1;
    const int lrow = lane >> 3, pc = lane & 7;
    const int LN = nitems / 8, LS = ls, xb = (int)(blockIdx.x & 7) * LN;
    int L = (int)(blockIdx.x >> 3) - l0;
    if (L < 0 || L >= LS) return;
    L = (L + LS - lshift % LS) % LS;
    if (L >= LN) return;
    const bf16_t* ap[4]; const bf16_t* bp[2];
    auto setptr = [&](const GemmTile& g) {
#pragma unroll
        for (int i = 0; i < 4; i++) {
            const int r = (wid * 4 + i) * 8 + lrow;
            const int c = pc ^ ((r >> 1) & 7);
            ap[i] = g.A + (long)r * g.lda + c * 8;
        }
#pragma unroll
        for (int i = 0; i < 2; i++) {
            const int r = (wid * 2 + i) * 8 + lrow;
            const int c = pc ^ ((r >> 1) & 7);
            bp[i] = g.Bt + (long)r * g.ldb + c * 8;
        }
    };
    auto stage = [&](int kt, char* st) {
#pragma unroll
        for (int i = 0; i < 4; i++)
            __builtin_amdgcn_global_load_lds((const unsigned*)(ap[i] + kt * 64), (unsigned*)(st + (wid * 4 + i) * 1024), 16, 0, 0);
#pragma unroll
        for (int i = 0; i < 2; i++)
            __builtin_amdgcn_global_load_lds((const unsigned*)(bp[i] + kt * 64), (unsigned*)(st + 32768 + (wid * 2 + i) * 1024), 16, 0, 0);
    };
    GemmTile g; g.arow = nullptr;
    setup(xb + L, g);
    const int nk = g.K >> 6;
    setptr(g);
    __syncthreads();
    stage(0, lds);
    asm volatile("s_waitcnt vmcnt(0)" ::: "memory");
    __syncthreads();
    int q = 0;
    for (; L < LN; L += LS) {
        f32x4 acc[4][4];
#pragma unroll
        for (int mi = 0; mi < 4; mi++)
#pragma unroll
            for (int ni = 0; ni < 4; ni++) acc[mi][ni] = (f32x4){0.f, 0.f, 0.f, 0.f};
        for (int kt = 0; kt < nk; kt++, q++) {
            char* cur = lds + (q & 1) * 49152;
            char* nxt = lds + ((q + 1) & 1) * 49152;
            if (kt + 1 < nk) stage(kt + 1, nxt);
            else if (L + LS < LN) { setup(xb + L + LS, g); setptr(g); stage(0, nxt); }
            bf16x8 af[2][4], bfr[2][4];
#pragma unroll
            for (int ks = 0; ks < 2; ks++)
#pragma unroll
                for (int i = 0; i < 4; i++) {
                    af[ks][i] = *(const bf16x8*)(cur + tile_off(wm * 64 + i * 16 + (lane & 15), ks * 4 + (lane >> 4)));
                    bfr[ks][i] = *(const bf16x8*)(cur + 32768 + tile_off(wn * 64 + i * 16 + (lane & 15), ks * 4 + (lane >> 4)));
                }
            __builtin_amdgcn_s_setprio(1);
#pragma unroll
            for (int ks = 0; ks < 2; ks++)
#pragma unroll
                for (int mi = 0; mi < 4; mi++)
#pragma unroll
                    for (int ni = 0; ni < 4; ni++)
                        acc[mi][ni] = __builtin_amdgcn_mfma_f32_16x16x32_bf16(bfr[ks][ni], af[ks][mi], acc[mi][ni], 0, 0, 0);
            __builtin_amdgcn_s_setprio(0);
            asm volatile("s_waitcnt vmcnt(0)" ::: "memory");
            __syncthreads();
        }
        epi(xb + L, acc);
    }
}


__device__ __forceinline__ void phase1(const Params& p, char* lds) {
    const int tid = threadIdx.x, lane = tid & 63, wid = tid >> 6, wm = wid >> 1, wn = wid & 1, lq = lane >> 4, lr = lane & 15;
    constexpr int N_U = 64 * 2, N_M = 4 * 16;
    {
      gemm_256x128_stream(N_U, 0, 0, (int)(gridDim.x >> 3), lds, [&](int item, GemmTile& g) {
            const int tm = item >> 1, tn = 8 + (item & 1);
            g.A = wsp<bf16_t>(p, OFF_XB) + (long)tm * 256 * ND; g.lda = ND;
            g.Bt = wsp<bf16_t>(p, OFF_W1T) + (long)tn * 128 * ND; g.ldb = ND; g.K = ND;
        }, [&](int item, f32x4 (&acc)[4][4]) {
            const int tm = item >> 1, tn = 8 + (item & 1);
            const float* r0 = wsp<float>(p, OFF_R0);
#pragma unroll
            for (int mi = 0; mi < 4; mi++) {
                const int row = tm * 256 + wm * 64 + mi * 16 + lr;
                const float rs = r0[row];
#pragma unroll
                for (int ni = 0; ni < 4; ni++) acc[mi][ni] *= rs;
                if (tn < 4) {
#pragma unroll
                    for (int ni = 0; ni < 4; ni++)
                        *(u32x2*)(wsp<bf16_t>(p, OFF_UF) + (long)row * 512 + tn * 128 + wn * 64 + ni * 16 + 4 * lq) = pack4bf(acc[mi][ni]);
                } else if (tn < 9) {
                    float ss = 0.f;
#pragma unroll
                    for (int ni = 0; ni < 4; ni++) { const f32x4 v = acc[mi][ni]; ss += v[0] * v[0] + v[1] * v[1] + v[2] * v[2] + v[3] * v[3]; }
                    ss += __shfl_xor(ss, 16); ss += __shfl_xor(ss, 32);
                    if (tn < 7) {
#pragma unroll
                        for (int ni = 0; ni < 4; ni++)
                            *(u32x2*)(wsp<bf16_t>(p, OFF_UQ) + (long)row * 384 + (tn - 4) * 128 + wn * 64 + ni * 16 + 4 * lq) = pack4bf(acc[mi][ni]);
                        if (lq == 0) wsp<float>(p, OFF_SSQ)[row * 6 + (tn - 4) * 2 + wn] = ss;
                    } else {
#pragma unroll
                        for (int ni = 0; ni < 4; ni++)
                            *(u32x2*)(wsp<bf16_t>(p, OFF_UKV) + (long)row * 256 + (tn - 7) * 128 + wn * 64 + ni * 16 + 4 * lq) = pack4bf(acc[mi][ni]);
                        if (lq == 0) wsp<float>(p, OFF_SSKV)[row * 4 + (tn - 7) * 2 + wn] = ss;
                    }
                } else if (wn == 0) {
                    const float2* rp = wsp<float2>(p, OFF_ROPE) + (long)row * 16 + 4 * lq;
                    f32x4 o1, o2;
#pragma unroll
                    for (int r = 0; r < 4; r++) {
                        const float2 cs = rp[r];
                        const float x1 = acc[mi][0][r], x2 = acc[mi][1][r];
                        o1[r] = x1 * cs.x - x2 * cs.y; o2[r] = x1 * cs.y + x2 * cs.x;
                    }
                    bf16_t* kr = wsp<bf16_t>(p, OFF_KR) + (long)row * 32;
                    *(u32x2*)(kr + 4 * lq) = pack4bf(o1);
                    *(u32x2*)(kr + 16 + 4 * lq) = pack4bf(o2);
                }
            }
        });
      gemm_256x128_stream(N_M, N_U / 8, 0, (int)(gridDim.x >> 3), lds, [&](int it, GemmTile& g) {
            const int tm = it / 16, tn = it % 16;
            g.A = wsp<bf16_t>(p, OFF_MEMB) + (long)tm * 256 * ND; g.lda = ND;
            g.Bt = wsp<bf16_t>(p, OFF_WMKVT) + (long)tn * 128 * ND; g.ldb = ND; g.K = ND;
        }, [&](int it, f32x4 (&acc)[4][4]) {
            const int tm = it / 16, tn = it % 16;
            const float* rm = wsp<float>(p, OFF_RMEM);
#pragma unroll
            for (int mi = 0; mi < 4; mi++) {
                const int row = tm * 256 + wm * 64 + mi * 16 + lr;
                const int b = row >> 8, m = row & 255;
                const float rs = rm[row];
#pragma unroll
                for (int ni = 0; ni < 4; ni++) {
                    const f32x4 v = acc[mi][ni] * rs;
                    const int col = tn * 128 + wn * 64 + ni * 16 + 4 * lq;
                    if (col < 1024) {
                        const int h = col >> 8, d = col & 255;
                        *(u32x2*)(wsp<bf16_t>(p, OFF_KMEM) + ((long)(b * 4 + h) * 256 + m) * 256 + d) = pack4bf(v);
                    } else {
                        const int c2 = col - 1024, h = c2 >> 8, dv = c2 & 255;
                        bf16_t* vt = wsp<bf16_t>(p, OFF_VTMEM) + ((long)(b * 4 + h) * 256 + dv) * 256 + m;
#pragma unroll
                        for (int r = 0; r < 4; r++) vt[r * 256] = (bf16_t)f2bf(v[r]);
                    }
                }
            }
        });
    }
}

template <int MI>
__device__ __forceinline__ void dft_mma(const bf16_t* Ag, int arow0, const char* ximg, int ncol0, f32x4 (&acc)[MI][4]) {
    const int lane = VTID & 63, lq = lane >> 4, lr = lane & 15;
#pragma unroll
    for (int ks = 0; ks < 4; ks++) {
        bf16x8 af[MI], bfr[4];
#pragma unroll
        for (int mi = 0; mi < MI; mi++) af[mi] = *(const bf16x8*)(Ag + (long)(arow0 + mi * 16 + lr) * 128 + ks * 32 + lq * 8);
#pragma unroll
        for (int ni = 0; ni < 4; ni++) {
            const char* bp = ximg + (ks * 32 + lq * 8) * 272 + (ncol0 + ni * 16 + lr) * 2;
#pragma unroll
            for (int j = 0; j < 8; j++) bfr[ni][j] = *(const short*)(bp + j * 272);
        }
#pragma unroll
        for (int mi = 0; mi < MI; mi++)
#pragma unroll
            for (int ni = 0; ni < 4; ni++) acc[mi][ni] = __builtin_amdgcn_mfma_f32_16x16x32_bf16(bfr[ni], af[mi], acc[mi][ni], 0, 0, 0);
    }
}

__device__ __forceinline__ void f2a_item(const Params& p, int it, char* lds) {
    const int tid = VTID, lane = tid & 63, wid = tid >> 6, wm = wid >> 1, wn = wid & 1, lq = lane >> 4, lr = lane & 15;
    const int nc = it & 3, s2 = (it >> 2) & 63, b = it >> 8;
    char* uimg = lds; char* ximg = lds + 17408;
    __syncthreads();
#pragma unroll
    for (int i = 0; i < 4; i++) {
        const int ci = tid + 256 * i, row = ci >> 4, cc = ci & 15;
        *(u32x4*)(uimg + row * 272 + cc * 16) = *(const u32x4*)(wsp<bf16_t>(p, OFF_UF) + ((long)(b * NS + 64 * row + s2)) * 512 + nc * 128 + cc * 8);
    }
    __syncthreads();
    {
        const int g2 = wid >> 1, T = wid & 1;
        f32x4 a1[4][4];
#pragma unroll
        for (int mi = 0; mi < 4; mi++)
#pragma unroll
            for (int ni = 0; ni < 4; ni++) a1[mi][ni] = (f32x4){0.f, 0.f, 0.f, 0.f};
        const bf16_t* t64 = wsp<bf16_t>(p, OFF_T64) + T * 4096;
#pragma unroll
        for (int ks = 0; ks < 2; ks++) {
            bf16x8 af[4], bfr[4];
#pragma unroll
            for (int i = 0; i < 4; i++) {
                af[i] = *(const bf16x8*)(uimg + (i * 16 + lr) * 272 + (g2 * 64 + ks * 32 + lq * 8) * 2);
                bfr[i] = *(const bf16x8*)(t64 + (i * 16 + lr) * 64 + ks * 32 + lq * 8);
            }
#pragma unroll
            for (int mi = 0; mi < 4; mi++)
#pragma unroll
                for (int ni = 0; ni < 4; ni++) a1[mi][ni] = __builtin_amdgcn_mfma_f32_16x16x32_bf16(bfr[ni], af[mi], a1[mi][ni], 0, 0, 0);
        }
#pragma unroll
        for (int mi = 0; mi < 4; mi++)
#pragma unroll
            for (int ni = 0; ni < 4; ni++)
                *(u32x2*)(ximg + (T * 64 + mi * 16 + lr) * 272 + (g2 * 64 + ni * 16 + 4 * lq) * 2) = pack4bf(a1[mi][ni]);
    }
    __syncthreads();
    f32x4 acc[4][4];
#pragma unroll
    for (int mi = 0; mi < 4; mi++)
#pragma unroll
        for (int ni = 0; ni < 4; ni++) acc[mi][ni] = (f32x4){0.f, 0.f, 0.f, 0.f};
    dft_mma<4>(wsp<bf16_t>(p, OFF_M1), wm * 64, ximg, wn * 64, acc);
    const float2* tw = wsp<float2>(p, OFF_TW);
#pragma unroll
    for (int m2 = 0; m2 < 2; m2++) {
        const int k1 = 32 * wm + 16 * m2 + lr;
        float2 cs; { const float rev = (float)((s2 * k1) & 4095) * (1.0f / 4096.0f); cs.x = __builtin_amdgcn_cosf(rev); cs.y = __builtin_amdgcn_sinf(rev); (void)tw; }
        const long base = ((long)(b * 64 + k1) * 64 + s2) * 512 + nc * 128 + wn * 64 + 4 * lq;
#pragma unroll
        for (int ni = 0; ni < 4; ni++) {
            const f32x4 yr = acc[m2][ni], yi = acc[m2 + 2][ni];
            const f32x4 orr = yr * cs.x - yi * cs.y, oi = yi * cs.x + yr * cs.y;
            *(u32x2*)(wsp<bf16_t>(p, OFF_YR) + base + ni * 16) = pack4bf(orr);
            *(u32x2*)(wsp<bf16_t>(p, OFF_YI) + base + ni * 16) = pack4bf(oi);
        }
    }
}

__device__ __forceinline__ void f2b_item(const Params& p, int it, char* lds) {
    const int tid = VTID, lane = tid & 63, wid = tid >> 6, wm = wid >> 1, wn = wid & 1, lq = lane >> 4, lr = lane & 15;
    const int nc = it & 3, k1 = (it >> 2) & 63, b = it >> 8;
    char* ximg = lds; char* zimg = lds + 34816;
    __syncthreads();
#pragma unroll
    for (int i = 0; i < 8; i++) {
        const int ci = tid + 256 * i, row = ci >> 4, cc = ci & 15;
        const bf16_t* src = (row < 64 ? wsp<bf16_t>(p, OFF_YR) : wsp<bf16_t>(p, OFF_YI)) + ((long)(b * 64 + k1) * 64 + (row & 63)) * 512 + nc * 128 + cc * 8;
        *(u32x4*)(ximg + row * 272 + cc * 16) = *(const u32x4*)src;
    }
    __syncthreads();
    f32x4 acc[2][4];
#pragma unroll
    for (int mi = 0; mi < 2; mi++)
#pragma unroll
        for (int ni = 0; ni < 4; ni++) acc[mi][ni] = (f32x4){0.f, 0.f, 0.f, 0.f};
    dft_mma<2>(wsp<bf16_t>(p, OFF_M3), wm * 32, ximg, wn * 64, acc);
#pragma unroll
    for (int mi = 0; mi < 2; mi++)
#pragma unroll
        for (int ni = 0; ni < 4; ni++)
            *(u32x2*)(zimg + (wm * 32 + mi * 16 + lr) * 272 + (wn * 64 + ni * 16 + 4 * lq) * 2) = pack4bf(acc[mi][ni] * (1.0f / 512.0f));
    __syncthreads();
    f32x4 a3[2][4];
#pragma unroll
    for (int mi = 0; mi < 2; mi++)
#pragma unroll
        for (int ni = 0; ni < 4; ni++) a3[mi][ni] = (f32x4){0.f, 0.f, 0.f, 0.f};
    const bf16_t* wft = wsp<bf16_t>(p, OFF_WFT) + (long)(nc * 2 + wn) * 4096;
#pragma unroll
    for (int ks = 0; ks < 2; ks++) {
        bf16x8 af[2], bfr[4];
#pragma unroll
        for (int i = 0; i < 2; i++) af[i] = *(const bf16x8*)(zimg + (wm * 32 + i * 16 + lr) * 272 + (wn * 64 + ks * 32 + lq * 8) * 2);
#pragma unroll
        for (int i = 0; i < 4; i++) bfr[i] = *(const bf16x8*)(wft + (i * 16 + lr) * 64 + ks * 32 + lq * 8);
#pragma unroll
        for (int mi = 0; mi < 2; mi++)
#pragma unroll
            for (int ni = 0; ni < 4; ni++) a3[mi][ni] = __builtin_amdgcn_mfma_f32_16x16x32_bf16(bfr[ni], af[mi], a3[mi][ni], 0, 0, 0);
    }
#pragma unroll
    for (int mi = 0; mi < 2; mi++) {
        const int k2 = wm * 32 + mi * 16 + lr;
        bf16_t* dst = wsp<bf16_t>(p, OFF_ZA) + ((long)(b * NS + k1 + 64 * k2)) * 1024 + nc * 128 + wn * 64 + 4 * lq;
#pragma unroll
        for (int ni = 0; ni < 4; ni++) *(u32x2*)(dst + ni * 16) = pack4bf(a3[mi][ni]);
    }
}

__device__ __forceinline__ void phase2(const Params& p, char* lds) {
    const int tid = threadIdx.x, lane = tid & 63, wid = tid >> 6, wm = wid >> 1, wn = wid & 1, lq = lane >> 4, lr = lane & 15;
    constexpr int N_Q = 64 * 6, N_KV = 64 * 8;
    const int lsa = (int)(gridDim.x >> 3), lsh = lsa >> 1;
    {
      gemm_256x128_stream(N_Q, 0, lsh, lsa - lsh, lds, [&](int item, GemmTile& g) {
            const int tm = item / 6, tn = item % 6;
            g.A = wsp<bf16_t>(p, OFF_UQ) + (long)tm * 256 * 384; g.lda = 384;
            g.Bt = wsp<bf16_t>(p, OFF_WQT) + (long)tn * 128 * 384; g.ldb = 384; g.K = 384;
        }, [&](int item, f32x4 (&acc)[4][4]) {
            const int tm = item / 6, tn = item % 6;
            const float qmul = 0.10206207261596575f * 1.4426950408889634f;
#pragma unroll
            for (int mi = 0; mi < 4; mi++) {
                const int row = tm * 256 + wm * 64 + mi * 16 + lr;
                const int b = row >> 12, s = row & 4095;
                const float* sq = wsp<float>(p, OFF_SSQ) + (long)row * 6;
                const float ss = sq[0] + sq[1] + sq[2] + sq[3] + sq[4] + sq[5];
                const float rs = rsqrtf(ss * (1.f / 384.f) + 1e-6f) * qmul;
                const int cb0 = tn * 128 + wn * 64;
#pragma unroll
                for (int ni = 0; ni < 4; ni++) {
                    const int cb = cb0 + ni * 16, hd = cb / 96, hob = cb % 96;
                    bf16_t* qd = wsp<bf16_t>(p, OFF_Q) + ((long)(b * 8 + hd) * NS + s) * 96;
                    if (hob < 64) {
                        *(u32x2*)(qd + hob + 4 * lq) = pack4bf(acc[mi][ni] * rs);
                    } else if (hob == 64) {
                        if (ni < 3) {
                            const float2* rp = wsp<float2>(p, OFF_ROPE) + (long)row * 16 + 4 * lq;
                            f32x4 o1, o2;
#pragma unroll
                            for (int r = 0; r < 4; r++) {
                                const float2 cs = rp[r];
                                const float x1 = acc[mi][ni][r] * rs, x2 = acc[mi][ni < 3 ? ni + 1 : 3][r] * rs;
                                o1[r] = x1 * cs.x - x2 * cs.y; o2[r] = x1 * cs.y + x2 * cs.x;
                            }
                            *(u32x2*)(qd + 64 + 4 * lq) = pack4bf(o1);
                            *(u32x2*)(qd + 80 + 4 * lq) = pack4bf(o2);
                        }
                    }
                }
            }
        });
      gemm_256x128_stream(N_KV, 0, 0, lsh ? lsh : lsa, lds, [&](int it, GemmTile& g) {
            const int tm = it >> 3, hd = it & 7;
            g.A = wsp<bf16_t>(p, OFF_UKV) + (long)tm * 256 * 256; g.lda = 256;
            g.Bt = wsp<bf16_t>(p, OFF_WKVT) + (long)hd * 128 * 256; g.ldb = 256; g.K = 256;
        }, [&](int it, f32x4 (&acc)[4][4]) {
            const int tm = it >> 3, hd = it & 7;
#pragma unroll
            for (int mi = 0; mi < 4; mi++) {
                const int row = tm * 256 + wm * 64 + mi * 16 + lr;
                const int b = row >> 12, s = row & 4095;
                const float* sq = wsp<float>(p, OFF_SSKV) + (long)row * 4;
                const float rs = rsqrtf((sq[0] + sq[1] + sq[2] + sq[3]) * (1.f / 256.f) + 1e-6f);
                if (wn == 0) {
                    bf16_t* kd = wsp<bf16_t>(p, OFF_K) + ((long)(b * 8 + hd) * NS + s) * 96;
#pragma unroll
                    for (int ni = 0; ni < 4; ni++) *(u32x2*)(kd + ni * 16 + 4 * lq) = pack4bf(acc[mi][ni] * rs);
                } else {
#pragma unroll
                    for (int ni = 0; ni < 4; ni++) {
                        const int sp = (s & ~12) | ((s & 4) << 1) | ((s & 8) >> 1);
                        bf16_t* vd = wsp<bf16_t>(p, OFF_VT) + ((long)(b * 8 + hd) * 64 + ni * 16 + 4 * lq) * NS + sp;
#pragma unroll
                        for (int r = 0; r < 4; r++) vd[(long)r * NS] = (bf16_t)f2bf(acc[mi][ni][r] * rs);
                    }
                }
            }
#pragma unroll
            for (int i = 0; i < 2; i++) {
                const int ci = tid + 512 * i, r = ci >> 2, cc = ci & 3;
                const int row = tm * 256 + r, b = row >> 12, s = row & 4095;
                *(u32x4*)(wsp<bf16_t>(p, OFF_K) + ((long)(b * 8 + hd) * NS + s) * 96 + 64 + cc * 8) = *(const u32x4*)(wsp<bf16_t>(p, OFF_KR) + (long)row * 32 + cc * 8);
            }
        });
    }
}


template <int MI>
__device__ __forceinline__ void dft_mma_pre(const bf16x8 (&af)[4][MI], const char* ximg, int ncol0, f32x4 (&acc)[MI][4]) {
    const int lane = VTID & 63, lq = lane >> 4, lr = lane & 15;
#pragma unroll
    for (int ks = 0; ks < 4; ks++) {
        bf16x8 bfr[4];
#pragma unroll
        for (int ni = 0; ni < 4; ni++) {
            const char* bp = ximg + (ks * 32 + lq * 8) * 272 + (ncol0 + ni * 16 + lr) * 2;
#pragma unroll
            for (int j = 0; j < 8; j++) bfr[ni][j] = *(const short*)(bp + j * 272);
        }
#pragma unroll
        for (int mi = 0; mi < MI; mi++)
#pragma unroll
            for (int ni = 0; ni < 4; ni++) acc[mi][ni] = __builtin_amdgcn_mfma_f32_16x16x32_bf16(bfr[ni], af[ks][mi], acc[mi][ni], 0, 0, 0);
    }
}
__device__ __forceinline__ void phase2_f2a(const Params& p, char* lds) {
    const int tid = VTID, lane = tid & 63, wid = tid >> 6, wm = wid >> 1, wn = wid & 1, lq = lane >> 4, lr = lane & 15;
    char* uimg = lds; char* ximg = lds + 17408;
    const int g2 = wid >> 1, T = wid & 1;
    bf16x8 t64f[2][4], m1f[4][4];
    {
        const bf16_t* t64 = wsp<bf16_t>(p, OFF_T64) + T * 4096;
#pragma unroll
        for (int ks = 0; ks < 2; ks++)
#pragma unroll
            for (int i = 0; i < 4; i++) t64f[ks][i] = *(const bf16x8*)(t64 + (i * 16 + lr) * 64 + ks * 32 + lq * 8);
        const bf16_t* m1 = wsp<bf16_t>(p, OFF_M1);
#pragma unroll
        for (int ks = 0; ks < 4; ks++)
#pragma unroll
            for (int mi = 0; mi < 4; mi++) m1f[ks][mi] = *(const bf16x8*)(m1 + (long)(wm * 64 + mi * 16 + lr) * 128 + ks * 32 + lq * 8);
    }
    const int LN = 1024 / 8, LS = (int)(gridDim.x >> 2), xb = (int)(blockIdx.x & 7) * LN;
    int L = (int)((blockIdx.x >> 3) << 1) | VHALF;
    u32x4 ureg[4];
    auto fetch = [&](int it) {
        const int nc = it & 3, s2 = (it >> 2) & 63, b = it >> 8;
#pragma unroll
        for (int i = 0; i < 4; i++) {
            const int ci = tid + 256 * i, row = ci >> 4, cc = ci & 15;
            ureg[i] = *(const u32x4*)(wsp<bf16_t>(p, OFF_UF) + ((long)(b * NS + 64 * row + s2)) * 512 + nc * 128 + cc * 8);
        }
    };
    if (L < LN) fetch(xb + L);
    for (; L < LN; L += LS) {
        const int it = xb + L;
        const int nc = it & 3, s2 = (it >> 2) & 63, b = it >> 8;
        __syncthreads();
#pragma unroll
        for (int i = 0; i < 4; i++) {
            const int ci = tid + 256 * i, row = ci >> 4, cc = ci & 15;
            *(u32x4*)(uimg + row * 272 + cc * 16) = ureg[i];
        }
        __syncthreads();
        if (L + LS < LN) fetch(xb + L + LS);
        {
            f32x4 a1[4][4];
#pragma unroll
            for (int mi = 0; mi < 4; mi++)
#pragma unroll
                for (int ni = 0; ni < 4; ni++) a1[mi][ni] = (f32x4){0.f, 0.f, 0.f, 0.f};
#pragma unroll
            for (int ks = 0; ks < 2; ks++) {
                bf16x8 af[4];
#pragma unroll
                for (int i = 0; i < 4; i++) af[i] = *(const bf16x8*)(uimg + (i * 16 + lr) * 272 + (g2 * 64 + ks * 32 + lq * 8) * 2);
#pragma unroll
                for (int mi = 0; mi < 4; mi++)
#pragma unroll
                    for (int ni = 0; ni < 4; ni++) a1[mi][ni] = __builtin_amdgcn_mfma_f32_16x16x32_bf16(t64f[ks][ni], af[mi], a1[mi][ni], 0, 0, 0);
            }
#pragma unroll
            for (int mi = 0; mi < 4; mi++)
#pragma unroll
                for (int ni = 0; ni < 4; ni++)
                    *(u32x2*)(ximg + (T * 64 + mi * 16 + lr) * 272 + (g2 * 64 + ni * 16 + 4 * lq) * 2) = pack4bf(a1[mi][ni]);
        }
        __syncthreads();
        f32x4 acc[4][4];
#pragma unroll
        for (int mi = 0; mi < 4; mi++)
#pragma unroll
            for (int ni = 0; ni < 4; ni++) acc[mi][ni] = (f32x4){0.f, 0.f, 0.f, 0.f};
        dft_mma_pre<4>(m1f, ximg, wn * 64, acc);
#pragma unroll
        for (int m2 = 0; m2 < 2; m2++) {
            const int k1 = 32 * wm + 16 * m2 + lr;
            float2 cs; { const float rev = (float)((s2 * k1) & 4095) * (1.0f / 4096.0f); cs.x = __builtin_amdgcn_cosf(rev); cs.y = __builtin_amdgcn_sinf(rev); }
            const long base = ((long)(b * 64 + k1) * 64 + s2) * 512 + nc * 128 + wn * 64 + 4 * lq;
#pragma unroll
            for (int ni = 0; ni < 4; ni++) {
                const f32x4 yr = acc[m2][ni], yi = acc[m2 + 2][ni];
                const f32x4 orr = yr * cs.x - yi * cs.y, oi = yi * cs.x + yr * cs.y;
                *(u32x2*)(wsp<bf16_t>(p, OFF_YR) + base + ni * 16) = pack4bf(orr);
                *(u32x2*)(wsp<bf16_t>(p, OFF_YI) + base + ni * 16) = pack4bf(oi);
            }
        }
    }
}

__device__ __forceinline__ void expert_tr_job(const Params& p, int j, char* lds) {
    const int which = j >> 11, r = j & 2047, e = r >> 7, t = r & 127;
    const int k0 = (t >> 3) * 64, n0 = (t & 7) * 128;
    if (which == 0) tr_tile(p.w_exp_gate + (long)e * 1048576, 1024, k0, n0, 1024, p.g_ffn, wsp<bf16_t>(p, OFF_WGUT) + (long)e * 2048 * 1024, 1024, 1, lds);
    else if (which == 1) tr_tile(p.w_exp_up + (long)e * 1048576, 1024, k0, n0, 1024, p.g_ffn, wsp<bf16_t>(p, OFF_WGUT) + (long)e * 2048 * 1024, 1024, 2, lds);
    else tr_tile(p.w_exp_down + (long)e * 1048576, 1024, k0, n0, 1024, nullptr, wsp<bf16_t>(p, OFF_WDT) + (long)e * 1048576, 1024, 0, lds);
}

__device__ __forceinline__ void phase3_tr(const Params& p, char* lds) {
    float (*t)[132] = (float (*)[132])lds;
    const int tid = VTID, c4 = tid & 31, r0 = tid >> 5;
    f32x4 v[8]; float gv[8];
    auto issue = [&](int j) {
        const int which = j >> 11, r = j & 2047, e = r >> 7, tt = r & 127;
        const int k0 = (tt >> 3) * 64, n0 = (tt & 7) * 128;
        const float* W = (which == 0 ? p.w_exp_gate : which == 1 ? p.w_exp_up : p.w_exp_down) + (long)e * 1048576;
#pragma unroll
        for (int i = 0; i < 8; i++) {
            const int kk = r0 + 8 * i;
            v[i] = *(const f32x4*)(W + (long)(k0 + kk) * 1024 + n0 + c4 * 4);
            gv[i] = which < 2 ? p.g_ffn[k0 + kk] : 1.f;
        }
    };
    int j = VBLK;
    if (j < 6144) issue(j);
    while (j < 6144) {
        const int which = j >> 11, r = j & 2047, e = r >> 7, tt = r & 127;
        const int k0 = (tt >> 3) * 64, n0 = (tt & 7) * 128;
        __syncthreads();
#pragma unroll
        for (int i = 0; i < 8; i++) *(f32x4*)(&t[r0 + 8 * i][c4 * 4]) = v[i] * gv[i];
        __syncthreads();
        const int jn = j + VGRID;
        if (jn < 6144) issue(jn);
        bf16_t* Wt = which < 2 ? wsp<bf16_t>(p, OFF_WGUT) + (long)e * 2048 * 1024 : wsp<bf16_t>(p, OFF_WDT) + (long)e * 1048576;
#pragma unroll
        for (int i = 0; i < 4; i++) {
            const int ci = tid + 256 * i, nn = ci >> 3, kc = ci & 7;
            const int n = n0 + nn;
            int row = n;
            if (which < 2) row = (n >> 5) * 64 + ((n >> 4) & 1) * 32 + which * 16 + (n & 15);
            u32x4 w;
            w.x = pack2bf(t[kc * 8 + 0][nn], t[kc * 8 + 1][nn]);
            w.y = pack2bf(t[kc * 8 + 2][nn], t[kc * 8 + 3][nn]);
            w.z = pack2bf(t[kc * 8 + 4][nn], t[kc * 8 + 5][nn]);
            w.w = pack2bf(t[kc * 8 + 6][nn], t[kc * 8 + 7][nn]);
            *(u32x4*)(Wt + (long)row * 1024 + k0 + kc * 8) = w;
        }
        j = jn;
    }
}
__device__ __forceinline__ void phase3_f2b(const Params& p, char* lds) {
    const int tid = VTID, lane = tid & 63, wid = tid >> 6, wm = wid >> 1, wn = wid & 1, lq = lane >> 4, lr = lane & 15;
    char* ximg = lds; char* zimg = lds + 34816;
    bf16x8 m3f[4][2];
    {
        const bf16_t* m3 = wsp<bf16_t>(p, OFF_M3);
#pragma unroll
        for (int ks = 0; ks < 4; ks++)
#pragma unroll
            for (int mi = 0; mi < 2; mi++) m3f[ks][mi] = *(const bf16x8*)(m3 + (long)(wm * 32 + mi * 16 + lr) * 128 + ks * 32 + lq * 8);
    }
    const int LN = 1024 / 8, LS = (int)(gridDim.x >> 2), xb = (int)(blockIdx.x & 7) * LN;
    int L = (int)((blockIdx.x >> 3) << 1) | VHALF;
    u32x4 xreg[8];
    auto fetch = [&](int it) {
        const int nc = it & 3, k1 = (it >> 2) & 63, b = it >> 8;
#pragma unroll
        for (int i = 0; i < 8; i++) {
            const int ci = tid + 256 * i, row = ci >> 4, cc = ci & 15;
            const bf16_t* src = (row < 64 ? wsp<bf16_t>(p, OFF_YR) : wsp<bf16_t>(p, OFF_YI)) + ((long)(b * 64 + k1) * 64 + (row & 63)) * 512 + nc * 128 + cc * 8;
            xreg[i] = *(const u32x4*)src;
        }
    };
    if (L < LN) fetch(xb + L);
    for (; L < LN; L += LS) {
        const int it = xb + L;
        const int nc = it & 3, k1 = (it >> 2) & 63, b = it >> 8;
        bf16x8 wff[2][4];
        {
            const bf16_t* wft = wsp<bf16_t>(p, OFF_WFT) + (long)(nc * 2 + wn) * 4096;
#pragma unroll
            for (int ks = 0; ks < 2; ks++)
#pragma unroll
                for (int i = 0; i < 4; i++) wff[ks][i] = *(const bf16x8*)(wft + (i * 16 + lr) * 64 + ks * 32 + lq * 8);
        }
        __syncthreads();
#pragma unroll
        for (int i = 0; i < 8; i++) {
            const int ci = tid + 256 * i, row = ci >> 4, cc = ci & 15;
            *(u32x4*)(ximg + row * 272 + cc * 16) = xreg[i];
        }
        __syncthreads();
        if (L + LS < LN) fetch(xb + L + LS);
        f32x4 acc[2][4];
#pragma unroll
        for (int mi = 0; mi < 2; mi++)
#pragma unroll
            for (int ni = 0; ni < 4; ni++) acc[mi][ni] = (f32x4){0.f, 0.f, 0.f, 0.f};
        dft_mma_pre<2>(m3f, ximg, wn * 64, acc);
#pragma unroll
        for (int mi = 0; mi < 2; mi++)
#pragma unroll
            for (int ni = 0; ni < 4; ni++)
                *(u32x2*)(zimg + (wm * 32 + mi * 16 + lr) * 272 + (wn * 64 + ni * 16 + 4 * lq) * 2) = pack4bf(acc[mi][ni] * (1.0f / 512.0f));
        __syncthreads();
        f32x4 a3[2][4];
#pragma unroll
        for (int mi = 0; mi < 2; mi++)
#pragma unroll
            for (int ni = 0; ni < 4; ni++) a3[mi][ni] = (f32x4){0.f, 0.f, 0.f, 0.f};
#pragma unroll
        for (int ks = 0; ks < 2; ks++) {
            bf16x8 af[2];
#pragma unroll
            for (int i = 0; i < 2; i++) af[i] = *(const bf16x8*)(zimg + (wm * 32 + i * 16 + lr) * 272 + (wn * 64 + ks * 32 + lq * 8) * 2);
#pragma unroll
            for (int mi = 0; mi < 2; mi++)
#pragma unroll
                for (int ni = 0; ni < 4; ni++) a3[mi][ni] = __builtin_amdgcn_mfma_f32_16x16x32_bf16(wff[ks][ni], af[mi], a3[mi][ni], 0, 0, 0);
        }
#pragma unroll
        for (int mi = 0; mi < 2; mi++) {
            const int k2 = wm * 32 + mi * 16 + lr;
            bf16_t* dst = wsp<bf16_t>(p, OFF_ZA) + ((long)(b * NS + k1 + 64 * k2)) * 1024 + nc * 128 + wn * 64 + 4 * lq;
#pragma unroll
            for (int ni = 0; ni < 4; ni++) *(u32x2*)(dst + ni * 16) = pack4bf(a3[mi][ni]);
        }
    }
}

__device__ __forceinline__ void phase_resid(const Params& p, char* lds, size_t offA, size_t offW, const float* residf, const bf16_t* residb, size_t offXb, size_t offSS) {
    const int tid = VTID, lane = tid & 63, wid = tid >> 6, wm = wid >> 1, wn = wid & 1, lq = lane >> 4, lr = lane & 15;
    FOR_XCD_ITEMS(item, 128 * 8) {
        const int tm = item >> 3, tn = item & 7;
        f32x4 acc[4][4];
        GemmTile g; g.A = wsp<bf16_t>(p, offA) + (long)tm * 128 * ND; g.lda = ND; g.arow = nullptr;
        g.Bt = wsp<bf16_t>(p, offW) + (long)tn * 128 * ND; g.ldb = ND; g.K = ND;
        gemm_tile_128(g, lds, acc);
#pragma unroll
        for (int mi = 0; mi < 4; mi++) {
            const int row = tm * 128 + wm * 64 + mi * 16 + lr;
            float ss = 0.f;
#pragma unroll
            for (int ni = 0; ni < 4; ni++) {
                const long o = (long)row * ND + tn * 128 + wn * 64 + ni * 16 + 4 * lq;
                f32x4 rv;
                if (residf) rv = *(const f32x4*)(residf + o);
                else { const u32x2 w = *(const u32x2*)(residb + o); rv = (f32x4){__uint_as_float(w.x << 16), __uint_as_float(w.x & 0xFFFF0000u), __uint_as_float(w.y << 16), __uint_as_float(w.y & 0xFFFF0000u)}; }
                const f32x4 v = rv + acc[mi][ni];
                *(u32x2*)(wsp<bf16_t>(p, offXb) + o) = pack4bf(v);
                ss += v[0] * v[0] + v[1] * v[1] + v[2] * v[2] + v[3] * v[3];
            }
            ss += __shfl_xor(ss, 16); ss += __shfl_xor(ss, 32);
            if (lq == 0) wsp<float>(p, offSS)[row * 16 + tn * 2 + wn] = ss;
        }
    }
}
__device__ __forceinline__ float row_rs16(const float* ss) {
    const f32x4 a = *(const f32x4*)ss, b = *(const f32x4*)(ss + 4), c = *(const f32x4*)(ss + 8), d = *(const f32x4*)(ss + 12);
    const f32x4 t = (a + b) + (c + d);
    return rsqrtf(((t[0] + t[1]) + (t[2] + t[3])) * (1.f / 1024.f) + 1e-6f);
}

__device__ __forceinline__ void phase5a(const Params& p, char* lds) {
    const int tid = VTID, lane = tid & 63, wid = tid >> 6, wm = wid >> 1, wn = wid & 1, lq = lane >> 4, lr = lane & 15;
    FOR_XCD_ITEMS(item, 128 * 8) {
        const int tm = item >> 3, tn = item & 7;
        f32x4 acc[4][4];
        GemmTile g; g.A = wsp<bf16_t>(p, OFF_X1B) + (long)tm * 128 * ND; g.lda = ND; g.arow = nullptr;
        g.Bt = wsp<bf16_t>(p, OFF_WMQT) + (long)tn * 128 * ND; g.ldb = ND; g.K = ND;
        gemm_tile_128(g, lds, acc);
        const int h = tn >> 1;
#pragma unroll
        for (int mi = 0; mi < 4; mi++) {
            const int row = tm * 128 + wm * 64 + mi * 16 + lr, b = row >> 12, s = row & 4095;
            const float rs = row_rs16(wsp<float>(p, OFF_SS1) + (long)row * 16) * (0.0625f * 1.4426950408889634f);
            bf16_t* qd = wsp<bf16_t>(p, OFF_QM) + ((long)(b * 4 + h) * NS + s) * 256 + (tn & 1) * 128 + wn * 64 + 4 * lq;
#pragma unroll
            for (int ni = 0; ni < 4; ni++) *(u32x2*)(qd + ni * 16) = pack4bf(acc[mi][ni] * rs);
        }
    }
}
__device__ __forceinline__ void phase5b(const Params& p, char* lds) {
    FOR_XCD_ITEMS(item, NB * 4 * 32 * 2) {
        const int dvh = item & 1, qt = (item >> 1) & 31, h = (item >> 6) & 3, b = item >> 8;
        const bf16_t* Qp = wsp<bf16_t>(p, OFF_QM) + ((long)(b * 4 + h) * NS + qt * 128) * 256;
        const bf16_t* Kp = wsp<bf16_t>(p, OFF_KMEM) + ((long)(b * 4 + h) * 256) * 256;
        const bf16_t* Vtp = wsp<bf16_t>(p, OFF_VTMEM) + ((long)(b * 4 + h) * 256 + dvh * 128) * 256;
        bf16_t* Op = wsp<bf16_t>(p, OFF_OM) + ((long)b * NS + qt * 128) * 1024 + h * 256 + dvh * 128;
        attn_block<256, 128, 32, 256>(Qp, Kp, Vtp, 256L, 256, lds, [&](int q, int dv, f32x4 v) { *(u32x2*)(Op + (long)q * 1024 + dv) = pack4bf(v); });
    }
}

__device__ __forceinline__ void phase7(const Params& p, char* lds) {
    const int tid = threadIdx.x, lane = tid & 63, wid = tid >> 6, lq = lane >> 4, lr = lane & 15;
    __syncthreads();
    {
        f32x4 w0[4], w1[4];
#pragma unroll
        for (int it = 0; it < 4; it++) {
            const int u = tid + 512 * it, kp = u >> 2, eq = u & 3;
            w0[it] = *(const f32x4*)(p.w_router + (size_t)(2 * kp) * 16 + eq * 4);
            w1[it] = *(const f32x4*)(p.w_router + (size_t)(2 * kp + 1) * 16 + eq * 4);
        }
#pragma unroll
        for (int it = 0; it < 4; it++) {
            const int u = tid + 512 * it, kp = u >> 2, eq = u & 3, k = 2 * kp;
            const float g0 = p.g_ffn[k], g1 = p.g_ffn[k + 1];
#pragma unroll
            for (int j = 0; j < 4; j++) {
                const int e = eq * 4 + j;
                const float a0 = w0[it][j] * g0, a1 = w1[it][j] * g1;
                const unsigned h0 = f2bf(a0), h1 = f2bf(a1);
                const float r0 = a0 - __uint_as_float(h0 << 16), r1 = a1 - __uint_as_float(h1 << 16);
                const unsigned l0 = f2bf(r0), l1 = f2bf(r1);
                const int off = e * 2048 + ((((k >> 3) ^ e) & 127) << 4) + (k & 7) * 2;
                *(unsigned*)(lds + off) = h0 | (h1 << 16);
                *(unsigned*)(lds + 32768 + off) = l0 | (l1 << 16);
            }
        }
    }
    __syncthreads();
    for (int g = wid * (int)gridDim.x + (int)blockIdx.x; g < NT / 16; g += 8 * (int)gridDim.x) {
        const int t0 = g * 16;
        const bf16_t* xr = wsp<bf16_t>(p, OFF_X2B) + (long)(t0 + lr) * ND + lq * 8;
        bf16x8 xa[32];
#pragma unroll
        for (int ks = 0; ks < 32; ks++) xa[ks] = *(const bf16x8*)(xr + ks * 32);
        const float rsv = row_rs16(wsp<float>(p, OFF_SS2) + (long)(t0 + lr) * 16);
        if (lane < 16) wsp<float>(p, OFF_RS2)[t0 + lane] = rsv;
        f32x4 acc = (f32x4){0.f, 0.f, 0.f, 0.f};
#pragma unroll
        for (int ks = 0; ks < 32; ks++) {
            const int off = lr * 2048 + ((((ks * 4 + lq) ^ lr) & 127) << 4);
            const bf16x8 bh = *(const bf16x8*)(lds + off), bl = *(const bf16x8*)(lds + 32768 + off);
            acc = __builtin_amdgcn_mfma_f32_16x16x32_bf16(xa[ks], bh, acc, 0, 0, 0);
            acc = __builtin_amdgcn_mfma_f32_16x16x32_bf16(xa[ks], bl, acc, 0, 0, 0);
            if ((ks & 3) == 3) asm volatile("" ::: "memory");
        }
        f32x4 af4;
#pragma unroll
        for (int r = 0; r < 4; r++) {
            const float lg = acc[r] * __shfl(rsv, lq * 4 + r);
            float mx = lg;
#pragma unroll
            for (int o = 1; o < 16; o <<= 1) mx = fmaxf(mx, __shfl_xor(mx, o));
            const float ex = expf(lg - mx);
            float sm = ex;
#pragma unroll
            for (int o = 1; o < 16; o <<= 1) sm += __shfl_xor(sm, o);
            af4[r] = ex / sm;
        }
        {
            const int tk = t0 + lq * 4, bb = tk >> 12, ss = tk & 4095;
            *(f32x4*)(wsp<float>(p, OFF_AFF) + ((long)(bb * NE + lr) * NS + ss)) = af4;
        }
    }
}

__device__ __forceinline__ int block_sum_i(int v, int* red) {
    const int lane = VTID & 63, wid = VTID >> 6;
#pragma unroll
    for (int o = 32; o > 0; o >>= 1) v += __shfl_xor(v, o);
    __syncthreads();
    if (lane == 0) red[wid] = v;
    __syncthreads();
    return red[0] + red[1] + red[2] + red[3];
}
__device__ __forceinline__ int block_excl_scan_i(int v, int* red, int& total) {
    const int lane = VTID & 63, wid = VTID >> 6;
    int inc = v;
#pragma unroll
    for (int o = 1; o < 64; o <<= 1) { const int t = __shfl_up(inc, o); if (lane >= o) inc += t; }
    __syncthreads();
    if (lane == 63) red[wid] = inc;
    __syncthreads();
    int base = 0;
#pragma unroll
    for (int w = 0; w < 4; w++) if (w < wid) base += red[w];
    total = red[0] + red[1] + red[2] + red[3];
    return base + inc - v;
}
__device__ __forceinline__ void phase8(const Params& p, char* lds) {
    int* red = (int*)lds;
    const int tid = threadIdx.x, lane = tid & 63, wid = tid >> 6;
    for (int item = blockIdx.x; item < NB * NE; item += gridDim.x) {
        const int e = item & 15, b = item >> 4;
        const unsigned* aff = (const unsigned*)(wsp<float>(p, OFF_AFF) + (long)(b * NE + e) * NS) + tid * 8;
        unsigned v[8];
        { const u32x4 v0 = *(const u32x4*)aff, v1 = *(const u32x4*)(aff + 4);
          v[0] = v0.x; v[1] = v0.y; v[2] = v0.z; v[3] = v0.w; v[4] = v1.x; v[5] = v1.y; v[6] = v1.z; v[7] = v1.w; }
        const float* rs2p = wsp<float>(p, OFF_RS2) + (long)b * NS + tid * 8;
        const f32x4 rsa = *(const f32x4*)rs2p, rsb = *(const f32x4*)(rs2p + 4);
        __syncthreads();
        unsigned T = 0;
        for (int bit = 30; bit >= 0; bit--) {
            const unsigned cand = T | (1u << bit);
            int c = 0;
#pragma unroll
            for (int i = 0; i < 8; i++) c += __popcll(__ballot(v[i] >= cand));
            int* rb = red + (bit & 1) * 8;
            if (lane == 0) rb[wid] = c;
            __syncthreads();
            const i32x4 s0 = *(const i32x4*)rb, s1 = *(const i32x4*)(rb + 4);
            const int tot = (s0.x + s0.y) + (s0.z + s0.w) + (s1.x + s1.y) + (s1.z + s1.w);
            if (tot >= CAP) T = cand;
        }
        int cg = 0, ce = 0;
#pragma unroll
        for (int i = 0; i < 8; i++) { cg += (v[i] > T) ? 1 : 0; ce += (v[i] == T) ? 1 : 0; }
        const int pv = cg | (ce << 16);
        int inc = pv;
#pragma unroll
        for (int o = 1; o < 64; o <<= 1) { const int t = __shfl_up(inc, o); if (lane >= o) inc += t; }
        if (lane == 63) red[16 + wid] = inc;
        __syncthreads();
        int base = 0, tot = 0;
#pragma unroll
        for (int w = 0; w < 8; w++) { const int x = red[16 + w]; if (w < wid) base += x; tot += x; }
        const int pk = base + inc - pv;
        const int need = CAP - (tot & 0xFFFF);
        const int pg = pk & 0xFFFF;
        int eqs = pk >> 16;
        int slot = pg + (eqs < need ? eqs : need);
        int* slots = wsp<int>(p, OFF_SLOTS) + (long)(b * NE + e) * NS + tid * 8;
        int* idx = wsp<int>(p, OFF_IDX) + (long)(b * NE + e) * CAP;
        float* gate = wsp<float>(p, OFF_GATE) + (long)(b * NE + e) * CAP;
        float* rss = wsp<float>(p, OFF_RSS) + (long)(b * NE + e) * CAP;
        int so[8];
#pragma unroll
        for (int i = 0; i < 8; i++) {
            const int t = tid * 8 + i;
            bool sel = v[i] > T;
            if (v[i] == T) { sel = eqs < need; eqs++; }
            so[i] = -1;
            if (sel) { so[i] = slot; idx[slot] = b * NS + t; gate[slot] = __uint_as_float(v[i]); rss[slot] = i < 4 ? rsa[i & 3] : rsb[i & 3]; slot++; }
        }
        *(i32x4*)slots = (i32x4){so[0], so[1], so[2], so[3]};
        *(i32x4*)(slots + 4) = (i32x4){so[4], so[5], so[6], so[7]};
    }
}

__device__ __forceinline__ void phase9(const Params& p, char* lds) {
    const int tid = VTID, lane = tid & 63, wid = tid >> 6, wm = wid >> 1, wn = wid & 1, lq = lane >> 4, lr = lane & 15;
    FOR_XCD_ITEMS(item, NE * 16 * NB * 4) {
        const int rt = item & 3, b = (item >> 2) & 3, ct = (item >> 4) & 15, e = item >> 8;
        const int* arow = wsp<int>(p, OFF_IDX) + (long)(b * NE + e) * CAP + rt * 128;
        f32x4 acc[4][4];
        GemmTile g; g.A = wsp<bf16_t>(p, OFF_X2B); g.lda = ND; g.arow = arow;
        g.Bt = wsp<bf16_t>(p, OFF_WGUT) + ((long)e * 2048 + ct * 128) * ND; g.ldb = ND; g.K = ND;
        gemm_tile_128(g, lds, acc);
#pragma unroll
        for (int mi = 0; mi < 4; mi++) {
            const int r = wm * 64 + mi * 16 + lr;
            const int tok = arow[r];
            const float rs = row_rs16(wsp<float>(p, OFF_SS2) + (long)tok * 16);
            bf16_t* ad = wsp<bf16_t>(p, OFF_ACT) + ((long)(e * NB + b) * CAP + rt * 128 + r) * ND + ct * 64 + wn * 32 + 4 * lq;
#pragma unroll
            for (int pp = 0; pp < 2; pp++) {
                f32x4 o;
#pragma unroll
                for (int q = 0; q < 4; q++) {
                    const float ga = acc[mi][2 * pp][q] * rs, up = acc[mi][2 * pp + 1][q] * rs;
                    o[q] = ga * __builtin_amdgcn_rcpf(1.f + __expf(-ga)) * up;
                }
                *(u32x2*)(ad + pp * 16) = pack4bf(o);
            }
        }
    }
}
__device__ __forceinline__ void phase10(const Params& p, char* lds) {
    const int tid = VTID, lane = tid & 63, wid = tid >> 6, wm = wid >> 1, wn = wid & 1, lq = lane >> 4, lr = lane & 15;
    FOR_XCD_ITEMS(item, NE * 8 * NB * 4) {
        const int rt = item & 3, b = (item >> 2) & 3, ct = (item >> 4) & 7, e = item >> 7;
        const long row0 = (long)(e * NB + b) * CAP + rt * 128;
        f32x4 acc[4][4];
        GemmTile g; g.A = wsp<bf16_t>(p, OFF_ACT) + row0 * ND; g.lda = ND; g.arow = nullptr;
        g.Bt = wsp<bf16_t>(p, OFF_WDT) + ((long)e * 1024 + ct * 128) * ND; g.ldb = ND; g.K = ND;
        gemm_tile_128(g, lds, acc);
        const float* gate = wsp<float>(p, OFF_GATE) + (long)(b * NE + e) * CAP + rt * 128;
#pragma unroll
        for (int mi = 0; mi < 4; mi++) {
            const int r = wm * 64 + mi * 16 + lr;
            const float gv = gate[r];
            bf16_t* yd = wsp<bf16_t>(p, OFF_Y) + (row0 + r) * ND + ct * 128 + wn * 64 + 4 * lq;
#pragma unroll
            for (int ni = 0; ni < 4; ni++) *(u32x2*)(yd + ni * 16) = pack4bf(acc[mi][ni] * gv);
        }
    }
}

__device__ __forceinline__ void phase11(const Params& p, char* lds) {
    const int tid = VTID, lane = tid & 63, wid = tid >> 6;
    const int* slots = wsp<int>(p, OFF_SLOTS);
    auto slot_of = [&](int tok) { const int b = tok >> 12, t = tok & 4095; return slots[(long)(b * NE + (lane & 15)) * NS + t]; };
    int tok = VBLK * 4 + wid;
    int sl_next = tok < NT ? slot_of(tok) : -1;
    u32x2 xn[4];
#pragma unroll
    for (int i = 0; i < 4; i++) xn[i] = *(const u32x2*)(wsp<bf16_t>(p, OFF_X2B) + (long)(tok < NT ? tok : 0) * ND + i * 256 + lane * 4);
    for (; tok < NT; tok += VGRID * 4) {
        const int b = tok >> 12;
        float* xr = p.out + (long)tok * ND;
        const int slv = sl_next;
        f32x4 v[4];
#pragma unroll
        for (int i = 0; i < 4; i++)
            v[i] = (f32x4){__uint_as_float(xn[i].x << 16), __uint_as_float(xn[i].x & 0xFFFF0000u), __uint_as_float(xn[i].y << 16), __uint_as_float(xn[i].y & 0xFFFF0000u)};
        {
            const int tn = tok + VGRID * 4;
            sl_next = tn < NT ? slot_of(tn) : -1;
#pragma unroll
            for (int i = 0; i < 4; i++) xn[i] = *(const u32x2*)(wsp<bf16_t>(p, OFF_X2B) + (long)(tn < NT ? tn : tok) * ND + i * 256 + lane * 4);
        }
        unsigned long long sel = __ballot(slv >= 0) & 0xFFFFull;
        while (sel) {
            const int e = __builtin_ctzll(sel); sel &= sel - 1;
            const int sl = __builtin_amdgcn_readlane(slv, e);
            const bf16_t* yr = wsp<bf16_t>(p, OFF_Y) + ((long)(e * NB + b) * CAP + sl) * ND;
#pragma unroll
            for (int i = 0; i < 4; i++) {
                const u32x2 w = *(const u32x2*)(yr + i * 256 + lane * 4);
                v[i][0] += __uint_as_float(w.x << 16); v[i][1] += __uint_as_float(w.x & 0xFFFF0000u);
                v[i][2] += __uint_as_float(w.y << 16); v[i][3] += __uint_as_float(w.y & 0xFFFF0000u);
            }
        }
        float ss = 0.f;
#pragma unroll
        for (int i = 0; i < 4; i++) ss += v[i][0] * v[i][0] + v[i][1] * v[i][1] + v[i][2] * v[i][2] + v[i][3] * v[i][3];
        ss = wave_sum(ss);
        const float rs = rsqrtf(ss * (1.f / ND) + 1e-6f);
#pragma unroll
        for (int i = 0; i < 4; i++) {
            const f32x4 gf = *(const f32x4*)(p.g_final + i * 256 + lane * 4);
            *(f32x4*)(xr + i * 256 + lane * 4) = v[i] * rs * gf;
        }
    }
}


__device__ __forceinline__ void phase_resid8(const Params& p, char* lds, size_t offA, size_t offW, const float* residf, const bf16_t* residb, size_t offXb, size_t offSS) {
    const int tid = threadIdx.x, lane = tid & 63, wid = tid >> 6, wm = wid >> 2, wn = wid & 3, lq = lane >> 4, lr = lane & 15;
    FOR_XCD_ITEMS_R(item, 64 * 4) {
        const int tm = item >> 2, tn = item & 3;
        f32x4 acc[8][4];
        GemmTile g; g.A = wsp<bf16_t>(p, offA) + (long)tm * 256 * ND; g.lda = ND; g.arow = nullptr;
        g.Bt = wsp<bf16_t>(p, offW) + (long)tn * 256 * ND; g.ldb = ND; g.K = ND;
        gemm_tile_256sq(g, lds, acc);
#pragma unroll
        for (int mi = 0; mi < 8; mi++) {
            const int row = tm * 256 + wm * 128 + mi * 16 + lr;
            float ss = 0.f;
#pragma unroll
            for (int ni = 0; ni < 4; ni++) {
                const long o = (long)row * ND + tn * 256 + wn * 64 + ni * 16 + 4 * lq;
                f32x4 rv;
                if (residf) rv = *(const f32x4*)(residf + o);
                else { const u32x2 w = *(const u32x2*)(residb + o); rv = (f32x4){__uint_as_float(w.x << 16), __uint_as_float(w.x & 0xFFFF0000u), __uint_as_float(w.y << 16), __uint_as_float(w.y & 0xFFFF0000u)}; }
                const f32x4 v = rv + acc[mi][ni];
                *(u32x2*)(wsp<bf16_t>(p, offXb) + o) = pack4bf(v);
                ss += v[0] * v[0] + v[1] * v[1] + v[2] * v[2] + v[3] * v[3];
            }
            ss += __shfl_xor(ss, 16); ss += __shfl_xor(ss, 32);
            if (lq == 0) wsp<float>(p, offSS)[row * 16 + tn * 4 + wn] = ss;
        }
    }
}


template <class Epi>
__device__ __forceinline__ void gemm_256sq_multi(const bf16_t* A, int lda, const int* arow, const bf16_t* Bt, int ldb, long bstep,
                                                 int K, int ntile, char* lds, Epi epi) {
    const int tid = threadIdx.x, lane = tid & 63, wid = tid >> 6, wm = wid >> 2, wn = wid & 3;
    const int lrow = lane >> 3, pc = lane & 7;
    const char* Ab = (const char*)A; const char* Bb = (const char*)Bt;
    unsigned ao[4], bo[4];
#pragma unroll
    for (int i = 0; i < 4; i++) {
        const int r = (wid * 4 + i) * 8 + lrow;
        const int c = pc ^ ((r >> 1) & 7);
        ao[i] = (unsigned)((arow ? arow[r] : r) * lda + c * 8) * 2u;
        bo[i] = (unsigned)(r * ldb + c * 8) * 2u;
    }
    const int nk = K >> 6;
    auto stage = [&](int kt, long boff, char* st) {
        const char* a0 = Ab + kt * 128;
        const char* b0 = Bb + boff * 2 + kt * 128;
#pragma unroll
        for (int i = 0; i < 4; i++) {
            __builtin_amdgcn_global_load_lds((const unsigned*)(a0 + ao[i]), (unsigned*)(st + (wid * 4 + i) * 1024), 16, 0, 0);
            __builtin_amdgcn_global_load_lds((const unsigned*)(b0 + bo[i]), (unsigned*)(st + 32768 + (wid * 4 + i) * 1024), 16, 0, 0);
        }
    };
    f32x4 acc[8][4];
    __syncthreads();
    stage(0, 0, lds);
    asm volatile("s_waitcnt vmcnt(0)" ::: "memory");
    __syncthreads();
    int q = 0;
    for (int t = 0; t < ntile; t++) {
#pragma unroll
        for (int mi = 0; mi < 8; mi++)
#pragma unroll
            for (int ni = 0; ni < 4; ni++) acc[mi][ni] = (f32x4){0.f, 0.f, 0.f, 0.f};
        const long boff = (long)t * bstep;
        for (int kt = 0; kt < nk; kt++, q++) {
            char* cur = lds + (q & 1) * 65536;
            char* nxt = lds + ((q + 1) & 1) * 65536;
            if (kt + 1 < nk) stage(kt + 1, boff, nxt);
            else if (t + 1 < ntile) stage(0, boff + bstep, nxt);
#pragma unroll
            for (int ks = 0; ks < 2; ks++) {
                bf16x8 af[8], bfr[4];
#pragma unroll
                for (int i = 0; i < 8; i++) af[i] = *(const bf16x8*)(cur + tile_off(wm * 128 + i * 16 + (lane & 15), ks * 4 + (lane >> 4)));
#pragma unroll
                for (int i = 0; i < 4; i++) bfr[i] = *(const bf16x8*)(cur + 32768 + tile_off(wn * 64 + i * 16 + (lane & 15), ks * 4 + (lane >> 4)));
                __builtin_amdgcn_s_setprio(1);
#pragma unroll
                for (int mi = 0; mi < 8; mi++)
#pragma unroll
                    for (int ni = 0; ni < 4; ni++)
                        acc[mi][ni] = __builtin_amdgcn_mfma_f32_16x16x32_bf16(bfr[ni], af[mi], acc[mi][ni], 0, 0, 0);
                __builtin_amdgcn_s_setprio(0);
            }
            asm volatile("s_waitcnt vmcnt(0)" ::: "memory");
            __syncthreads();
        }
        epi(t, acc);
    }
}
__device__ __forceinline__ void phase9_8(const Params& p, char* lds) {
    const int tid = threadIdx.x, lane = tid & 63, wid = tid >> 6, wm = wid >> 2, wn = wid & 3, lq = lane >> 4, lr = lane & 15;
    FOR_XCD_ITEMS_R(si, NE * NB * 2 * 2) {
        const int cth = si & 1, rt = (si >> 1) & 1, b = (si >> 2) & 3, e = si >> 4;
        const int* arow = wsp<int>(p, OFF_IDX) + (long)(b * NE + e) * CAP + rt * 256;
        const float* rss = wsp<float>(p, OFF_RSS) + (long)(b * NE + e) * CAP + rt * 256;
        gemm_256sq_multi(wsp<bf16_t>(p, OFF_X2B), ND, arow, wsp<bf16_t>(p, OFF_WGUT) + ((long)e * 2048 + cth * 1024) * ND, ND, 256L * ND,
                         ND, 4, lds, [&](int t, f32x4 (&acc)[8][4]) {
            const int ct = cth * 4 + t;
            char* adb = (char*)(wsp<bf16_t>(p, OFF_ACT) + ((long)(e * NB + b) * CAP + rt * 256) * ND + ct * 128);
            const unsigned ado = (unsigned)((wm * 128 + lr) * ND + wn * 32 + 4 * lq) * 2u;
#pragma unroll
            for (int mi = 0; mi < 8; mi++) {
                const float rs = rss[wm * 128 + mi * 16 + lr];
#pragma unroll
                for (int pp = 0; pp < 2; pp++) {
                    f32x4 o;
#pragma unroll
                    for (int q = 0; q < 4; q++) {
                        const float ga = acc[mi][2 * pp][q] * rs, up = acc[mi][2 * pp + 1][q] * rs;
                        o[q] = ga * __builtin_amdgcn_rcpf(1.f + __expf(-ga)) * up;
                    }
                    *(u32x2*)(adb + (ado + (unsigned)(mi * 16 * ND * 2 + pp * 32))) = pack4bf(o);
                    __builtin_amdgcn_sched_barrier(0);
                }
            }
        });
    }
}
__device__ __forceinline__ void phase10_8(const Params& p, char* lds) {
    const int tid = threadIdx.x, lane = tid & 63, wid = tid >> 6, wm = wid >> 2, wn = wid & 3, lq = lane >> 4, lr = lane & 15;
    FOR_XCD_ITEMS_R(si, NE * NB * 2 * 2) {
        const int cth = si & 1, rt = (si >> 1) & 1, b = (si >> 2) & 3, e = si >> 4;
        const long row0 = (long)(e * NB + b) * CAP + rt * 256;
        const float* gate = wsp<float>(p, OFF_GATE) + (long)(b * NE + e) * CAP + rt * 256;
        gemm_256sq_multi(wsp<bf16_t>(p, OFF_ACT) + row0 * ND, ND, nullptr, wsp<bf16_t>(p, OFF_WDT) + ((long)e * 1024 + cth * 512) * ND, ND, 256L * ND,
                         ND, 2, lds, [&](int t, f32x4 (&acc)[8][4]) {
            const int ct = cth * 2 + t;
            char* yb = (char*)(wsp<bf16_t>(p, OFF_Y) + row0 * ND + ct * 256);
            const unsigned yo = (unsigned)((wm * 128 + lr) * ND + wn * 64 + 4 * lq) * 2u;
#pragma unroll
            for (int mi = 0; mi < 8; mi++) {
                const float gv = gate[wm * 128 + mi * 16 + lr];
#pragma unroll
                for (int ni = 0; ni < 4; ni++) *(u32x2*)(yb + (yo + (unsigned)(mi * 16 * ND * 2 + ni * 32))) = pack4bf(acc[mi][ni] * gv);
            }
        });
    }
}


__device__ __forceinline__ void phase1_big(const Params& p, char* lds) {
    const int tid = threadIdx.x, lane = tid & 63, wid = tid >> 6, wm = wid >> 2, wn = wid & 3, lq = lane >> 4, lr = lane & 15;
    FOR_XCD_ITEMS_R(item, 64 * 4) {
        const int tm = item >> 2, tn = item & 3;
        f32x4 acc[8][4];
        GemmTile g; g.A = wsp<bf16_t>(p, OFF_XB) + (long)tm * 256 * ND; g.lda = ND; g.arow = nullptr;
        g.Bt = wsp<bf16_t>(p, OFF_W1T) + (long)tn * 256 * ND; g.ldb = ND; g.K = ND;
        gemm_tile_256sq(g, lds, acc);
        const float* r0 = wsp<float>(p, OFF_R0);
        const int col0 = tn * 256 + wn * 64;
#pragma unroll
        for (int mi = 0; mi < 8; mi++) {
            const int row = tm * 256 + wm * 128 + mi * 16 + lr;
            const float rs = r0[row];
#pragma unroll
            for (int ni = 0; ni < 4; ni++) acc[mi][ni] *= rs;
            if (col0 < 512) {
#pragma unroll
                for (int ni = 0; ni < 4; ni++)
                    *(u32x2*)(wsp<bf16_t>(p, OFF_UF) + (long)row * 512 + col0 + ni * 16 + 4 * lq) = pack4bf(acc[mi][ni]);
            } else {
                float ss = 0.f;
#pragma unroll
                for (int ni = 0; ni < 4; ni++) { const f32x4 v = acc[mi][ni]; ss += v[0] * v[0] + v[1] * v[1] + v[2] * v[2] + v[3] * v[3]; }
                ss += __shfl_xor(ss, 16); ss += __shfl_xor(ss, 32);
                if (col0 < 896) {
#pragma unroll
                    for (int ni = 0; ni < 4; ni++)
                        *(u32x2*)(wsp<bf16_t>(p, OFF_UQ) + (long)row * 384 + (col0 - 512) + ni * 16 + 4 * lq) = pack4bf(acc[mi][ni]);
                    if (lq == 0) wsp<float>(p, OFF_SSQ)[row * 6 + ((col0 - 512) >> 6)] = ss;
                } else {
#pragma unroll
                    for (int ni = 0; ni < 4; ni++)
                        *(u32x2*)(wsp<bf16_t>(p, OFF_UKV) + (long)row * 256 + (col0 - 896) + ni * 16 + 4 * lq) = pack4bf(acc[mi][ni]);
                    if (lq == 0) wsp<float>(p, OFF_SSKV)[row * 4 + ((col0 - 896) >> 6)] = ss;
                }
            }
        }
    }
}


__device__ __forceinline__ void phase3_attn8(const Params& p, char* lds) {
    FOR_XCD_ITEMS_R(item, NB * 8 * (NS / 256)) {
        const int qt = item & 15, h = (item >> 4) & 7, b = item >> 7;
        const bf16_t* Qp = wsp<bf16_t>(p, OFF_Q) + ((long)(b * 8 + h) * NS + qt * 256) * 96;
        const bf16_t* Kp = wsp<bf16_t>(p, OFF_K) + ((long)(b * 8 + h) * NS) * 96;
        const bf16_t* Vtp = wsp<bf16_t>(p, OFF_VT) + ((long)(b * 8 + h) * 64) * NS;
        bf16_t* Op = wsp<bf16_t>(p, OFF_ZA) + ((long)b * NS + qt * 256) * 1024 + 512 + h * 64;
        attn_block<96, 64, 128, 512, true>(Qp, Kp, Vtp, (long)NS, NS, lds, [&](int q, int dv, f32x4 v) { *(u32x2*)(Op + (long)q * 1024 + dv) = pack4bf(v); });
    }
}
__device__ __forceinline__ void cross_attn_item(const Params& p, char* lds, int b, int hd, int qt) {
    constexpr int KROW = 256 * 2 + 16, VROW = 32 * 2 + 8, SLOT = 256 * VROW;
    const int tid = threadIdx.x, lane = tid & 63, wid = tid >> 6, h = lane >> 5, c = lane & 31;
    {
        const bf16_t* Qp = wsp<bf16_t>(p, OFF_QM) + ((long)(b * 4 + hd) * NS + qt * 256) * 256;
        const bf16_t* Kp = wsp<bf16_t>(p, OFF_KMEM) + ((long)(b * 4 + hd) * 256) * 256;
        const bf16_t* Vtp = wsp<bf16_t>(p, OFF_VTMEM) + ((long)(b * 4 + hd) * 256) * 256;
        bf16_t* Op = wsp<bf16_t>(p, OFF_OM) + ((long)b * NS + qt * 256) * 1024 + hd * 256;
        u32x4 gr[2];
        auto gload = [&](int t) {
#pragma unroll
            for (int i = 0; i < 2; i++) {
                const int ci = tid + 512 * i;
                if (t < 8) { const int row = ci >> 5, cc = ci & 31; gr[i] = *(const u32x4*)(Kp + (long)(t * 32 + row) * 256 + cc * 8); }
                else { const int row = ci >> 2, cc = ci & 3; gr[i] = *(const u32x4*)(Vtp + (long)row * 256 + (t - 8) * 32 + cc * 8); }
            }
        };
        auto lwrite = [&](int t, char* st) {
#pragma unroll
            for (int i = 0; i < 2; i++) {
                const int ci = tid + 512 * i;
                if (t < 8) { const int row = ci >> 5, cc = ci & 31; *(u32x4*)(st + row * KROW + cc * 16) = gr[i]; }
                else { const int row = ci >> 2, cc = ci & 3; char* q = st + row * VROW + cc * 16; *(u32x2*)q = (u32x2){gr[i].x, gr[i].y}; *(u32x2*)(q + 8) = (u32x2){gr[i].z, gr[i].w}; }
            }
        };
        gload(0);
        bf16x8 qf[16];
        {
            const bf16_t* qrow = Qp + (long)(wid * 32 + c) * 256 + 8 * h;
#pragma unroll
            for (int ks = 0; ks < 16; ks++) qf[ks] = *(const bf16x8*)(qrow + 16 * ks);
        }
        __syncthreads();
        lwrite(0, lds);
        __syncthreads();
        f32x16 s[8];
#pragma unroll
        for (int t = 0; t < 8; t++) {
            const char* cur = lds + (t & 1) * SLOT;
            gload(t + 1);
#pragma unroll
            for (int r = 0; r < 16; r++) s[t][r] = 0.f;
#pragma unroll
            for (int ks = 0; ks < 16; ks++) {
                const bf16x8 kf = *(const bf16x8*)(cur + c * KROW + ks * 32 + h * 16);
                s[t] = __builtin_amdgcn_mfma_f32_32x32x16_bf16(kf, qf[ks], s[t], 0, 0, 0);
            }
            lwrite(t + 1, lds + ((t + 1) & 1) * SLOT);
            __syncthreads();
        }
        float mx = s[0][0];
#pragma unroll
        for (int t = 0; t < 8; t++)
#pragma unroll
            for (int r = 0; r < 16; r++) mx = fmaxf(mx, s[t][r]);
        mx = fmaxf(mx, __shfl_xor(mx, 32));
        float l = 0.f;
        bf16x8 pf[16];
#pragma unroll
        for (int t = 0; t < 8; t++) {
#pragma unroll
            for (int r = 0; r < 16; r++) { const float e = __builtin_amdgcn_exp2f(s[t][r] - mx); l += e; s[t][r] = e; }
#pragma unroll
            for (int u = 0; u < 2; u++) {
                u32x4 pw;
                pw.x = pack2bf(s[t][8 * u + 0], s[t][8 * u + 1]);
                pw.y = pack2bf(s[t][8 * u + 2], s[t][8 * u + 3]);
                pw.z = pack2bf(s[t][8 * u + 4], s[t][8 * u + 5]);
                pw.w = pack2bf(s[t][8 * u + 6], s[t][8 * u + 7]);
                pf[2 * t + u] = __builtin_bit_cast(bf16x8, pw);
            }
        }
        l += __shfl_xor(l, 32);
        f32x16 o[8];
#pragma unroll
        for (int dt = 0; dt < 8; dt++)
#pragma unroll
            for (int r = 0; r < 16; r++) o[dt][r] = 0.f;
#pragma unroll
        for (int v = 0; v < 8; v++) {
            const char* cur = lds + (v & 1) * SLOT;
            if (v + 1 < 8) gload(8 + v + 1);
#pragma unroll
            for (int u = 0; u < 2; u++)
#pragma unroll
                for (int dt = 0; dt < 8; dt++) {
                    const char* vp = cur + (dt * 32 + c) * VROW + (u * 16 + 4 * h) * 2;
                    const u32x2 v0 = *(const u32x2*)(vp);
                    const u32x2 v1 = *(const u32x2*)(vp + 16);
                    const bf16x8 vf = __builtin_bit_cast(bf16x8, ((u32x4){v0.x, v0.y, v1.x, v1.y}));
                    o[dt] = __builtin_amdgcn_mfma_f32_32x32x16_bf16(vf, pf[2 * v + u], o[dt], 0, 0, 0);
                }
            if (v + 1 < 8) lwrite(8 + v + 1, lds + ((v + 1) & 1) * SLOT);
            __syncthreads();
        }
        const float inv = 1.f / l;
#pragma unroll
        for (int dt = 0; dt < 8; dt++)
#pragma unroll
            for (int g4 = 0; g4 < 4; g4++) {
                const f32x4 v = {o[dt][4 * g4 + 0] * inv, o[dt][4 * g4 + 1] * inv, o[dt][4 * g4 + 2] * inv, o[dt][4 * g4 + 3] * inv};
                *(u32x2*)(Op + (long)(wid * 32 + c) * 1024 + dt * 32 + 8 * g4 + 4 * h) = pack4bf(v);
            }
    }
}
__device__ __forceinline__ void phase5_fused(const Params& p, char* lds) {
    const int tid = threadIdx.x, lane = tid & 63, wid = tid >> 6, wm = wid >> 2, wn = wid & 3, lq = lane >> 4, lr = lane & 15;
    FOR_XCD_ITEMS_R(item, 64 * 4) {
        const int tm = item >> 2, tn = item & 3;
        f32x4 acc[8][4];
        GemmTile g; g.A = wsp<bf16_t>(p, OFF_X1B) + (long)tm * 256 * ND; g.lda = ND; g.arow = nullptr;
        g.Bt = wsp<bf16_t>(p, OFF_WMQT) + (long)tn * 256 * ND; g.ldb = ND; g.K = ND;
        gemm_tile_256sq(g, lds, acc);
#pragma unroll
        for (int mi = 0; mi < 8; mi++) {
            const int row = tm * 256 + wm * 128 + mi * 16 + lr, b = row >> 12, s = row & 4095;
            const float rs = row_rs16(wsp<float>(p, OFF_SS1) + (long)row * 16) * (0.0625f * 1.4426950408889634f);
            bf16_t* qd = wsp<bf16_t>(p, OFF_QM) + ((long)(b * 4 + tn) * NS + s) * 256 + wn * 64 + 4 * lq;
#pragma unroll
            for (int ni = 0; ni < 4; ni++) *(u32x2*)(qd + ni * 16) = pack4bf(acc[mi][ni] * rs);
        }
    }
    __builtin_amdgcn_fence(__ATOMIC_RELEASE, "workgroup");
    asm volatile("s_waitcnt vmcnt(0)" ::: "memory");
    __syncthreads();
    __builtin_amdgcn_fence(__ATOMIC_ACQUIRE, "workgroup");
}
__device__ __forceinline__ void phase5_cross(const Params& p, char* lds) {
    FOR_XCD_ITEMS_R(item, 64 * 4) {
        const int tm = item >> 2, tn = item & 3;
        cross_attn_item(p, lds, tm >> 4, tn, tm & 15);
    }
}

__global__ void __launch_bounds__(512, 1) k_fwd(Params p, int ph_lo, int ph_hi) {
    extern __shared__ __attribute__((aligned(16))) char lds_all[];
    char* lds = lds_all + VHALF * LDS_HALF;
    volatile LAS unsigned* st = (volatile LAS unsigned*)(lds_all + LDS_MAIN);
    if (threadIdx.x == 0) { st[0] = 0u; st[1] = 0u; }
    __syncthreads();
    XcdBarrier bar = xcd_barrier_post(wsp<unsigned>(p, OFF_BAR), st);
#if USE_CG_SYNC
#define GRID_BARRIER() do { asm volatile("s_waitcnt vmcnt(0)" ::: "memory"); __syncthreads(); cg::this_grid().sync(); asm volatile("s_waitcnt vmcnt(0)" ::: "memory"); __syncthreads(); } while (0)
#else
#define GRID_BARRIER() xcd_barrier(bar)
#endif
#define RUN_PHASE(k, call) if (ph_lo <= (k) && (k) < ph_hi) { if ((k) > ph_lo) { GRID_BARRIER(); } call; }
    RUN_PHASE(0, phase0(p, lds))
    RUN_PHASE(1, (phase1_big(p, lds_all), phase1(p, lds_all)))
    RUN_PHASE(2, (phase2(p, lds_all), phase2_f2a(p, lds)))
    RUN_PHASE(3, ((blockIdx.x & 1) ? phase3_tr(p, lds) : (void)0, phase3_attn8(p, lds_all), phase3_f2b(p, lds), (blockIdx.x & 1) ? (void)0 : phase3_tr(p, lds)))
    RUN_PHASE(4, phase_resid8(p, lds_all, OFF_ZA, OFF_WOUTT, p.x, nullptr, OFF_X1B, OFF_SS1))
    RUN_PHASE(5, (phase5_fused(p, lds_all), phase5_cross(p, lds_all)))
    RUN_PHASE(6, phase_resid8(p, lds_all, OFF_OM, OFF_WMOT, nullptr, wsp<bf16_t>(p, OFF_X1B), OFF_X2B, OFF_SS2))
    RUN_PHASE(7, phase7(p, lds_all))
    RUN_PHASE(8, phase8(p, lds_all))
    RUN_PHASE(9, phase9_8(p, lds_all))
    RUN_PHASE(10, phase10_8(p, lds_all))
    RUN_PHASE(11, phase11(p, lds))
}

extern "C" void kernel_launch(void* const* d_in, const int* in_sizes, int n_in,
                              void* d_out, int out_size, void* d_ws, size_t ws_size,
                              hipStream_t stream) {
    static int grid = 0;
    if (grid == 0) {
        if (n_in != 22 || ws_size < WS_END) { fprintf(stderr, "kernel_launch: unexpected inputs (n_in %d, ws %zu < %zu)\n", n_in, ws_size, (size_t)WS_END); grid = -1; return; }
        int dev = 0, cus = 0, per_cu = 0;
        (void)hipGetDevice(&dev);
        (void)hipDeviceGetAttribute(&cus, hipDeviceAttributeMultiprocessorCount, dev);
        if (hipFuncSetAttribute((const void*)k_fwd, hipFuncAttributeMaxDynamicSharedMemorySize, LDS_TOTAL) != hipSuccess) { fprintf(stderr, "kernel_launch: hipFuncSetAttribute failed\n"); grid = -1; return; }
        if (hipOccupancyMaxActiveBlocksPerMultiprocessor(&per_cu, (const void*)k_fwd, 512, LDS_TOTAL) != hipSuccess || per_cu < 1) { fprintf(stderr, "kernel_launch: occupancy query failed (%d)\n", per_cu); (void)hipGetLastError(); per_cu = 1; }
        if (per_cu > 1) per_cu = 1;
        grid = (cus * per_cu) & ~7;
        if (grid < 8) { fprintf(stderr, "kernel_launch: unexpected device (%d CUs)\n", cus); grid = -1; return; }
        fprintf(stderr, "kernel_launch: %d CUs x %d blocks\n", cus, per_cu);
    }
    if (grid < 0) return;
    Params p{};
    p.x = (const float*)d_in[0]; p.mem = (const float*)d_in[1]; p.pos = (const int*)d_in[2];
    p.g_mix = (const float*)d_in[3]; p.w_in = (const float*)d_in[4]; p.g_q_lat = (const float*)d_in[5]; p.w_q_up = (const float*)d_in[6];
    p.g_kv_lat = (const float*)d_in[7]; p.w_kv_up = (const float*)d_in[8]; p.w_fourier = (const float*)d_in[9]; p.w_out = (const float*)d_in[10];
    p.g_mem_q = (const float*)d_in[11]; p.g_mem_kv = (const float*)d_in[12]; p.w_mem_q = (const float*)d_in[13]; p.w_mem_kv = (const float*)d_in[14];
    p.w_mem_o = (const float*)d_in[15]; p.g_ffn = (const float*)d_in[16]; p.w_router = (const float*)d_in[17];
    p.w_exp_gate = (const float*)d_in[18]; p.w_exp_up = (const float*)d_in[19]; p.w_exp_down = (const float*)d_in[20]; p.g_final = (const float*)d_in[21];
    p.out = (float*)d_out; p.ws = (char*)d_ws;
    static const int cuts[] = MK_CUTS;
    const int ncut = (int)(sizeof(cuts) / sizeof(int));
    for (int li = 0; li + 1 < ncut; li++) {
        (void)hipMemsetAsync((char*)d_ws + OFF_BAR, 0, 16384, stream);
        int lo = cuts[li], hi = cuts[li + 1];
        void* args[] = {&p, &lo, &hi};
        hipError_t e = hipLaunchCooperativeKernel((const void*)k_fwd, dim3(grid), dim3(512), args, LDS_TOTAL, stream);
        if (e != hipSuccess) fprintf(stderr, "cooperative launch failed: %s (grid %d)\n", hipGetErrorString(e), grid);
    }
}
```
